# Optimizing an MI355X kernel written in HIP

```python
import jax
import jax.numpy as jnp
from jax import lax
import numpy as np

D_MODEL = 1024
BATCH = 16
SEQ = 2048
DEPTH = 2

EPS = 1e-6
GLA_HEADS = 4
GLA_DK = 64
GLA_DV = 128
GLA_GATE_RANK = 16
GLA_TAU = 16.0
GLA_CHUNK = 64
DSA_HEADS = 8
DSA_Q_RANK = 256
DSA_KV_RANK = 128
DSA_HEAD_DIM = 64
DSA_V_DIM = 64
IDX_HEADS = 8
IDX_DIM = 32
DSA_TOPK_MAX = 256
Q_BLOCK = 128
MLSTM_HEADS = 4
MLSTM_DQK = 64
MLSTM_DV = 128
MLSTM_CONV = 4
MLSTM_CHUNK = 64
N_EXPERTS = 64
TOP_K = 6
N_GROUPS = 8
TOPK_GROUPS = 4
EXPERT_FF = 256
SHARED_FF = 256
ROUTED_SCALE = 2.5
TOKEN_BLOCK = 128

GLA_QK = GLA_HEADS * GLA_DK
GLA_V = GLA_HEADS * GLA_DV
DSA_V = DSA_HEADS * DSA_V_DIM
MLSTM_QK = MLSTM_HEADS * MLSTM_DQK
MLSTM_V = MLSTM_HEADS * MLSTM_DV
IN_SIZES = (GLA_QK, GLA_QK, GLA_V, GLA_V, GLA_GATE_RANK,
            DSA_Q_RANK, DSA_KV_RANK, IDX_DIM, IDX_HEADS,
            MLSTM_QK, MLSTM_QK, MLSTM_V, MLSTM_HEADS, MLSTM_HEADS, MLSTM_V,
            3 * D_MODEL)
N_IN = sum(IN_SIZES)

kernel_name = 'hybrid_gla_dsa_mlstm_moe'


def _rms(x, g):
    xf = x.astype(jnp.float32)
    y = xf * lax.rsqrt(jnp.mean(xf * xf, axis=-1, keepdims=True) + EPS)
    return (y * g.astype(jnp.float32)).astype(x.dtype)


def _head_rms(x, g):
    xf = x.astype(jnp.float32)
    y = xf * lax.rsqrt(jnp.mean(xf * xf, axis=-1, keepdims=True) + EPS)
    return y.reshape(x.shape[0], x.shape[1], -1) * g.astype(jnp.float32)


def _to_chunks(t, L):
    b, s = t.shape[0], t.shape[1]
    return jnp.moveaxis(t.reshape((b, s // L, L) + t.shape[2:]), 1, 0)


def _from_chunks(t):
    t = jnp.moveaxis(t, 0, 1)
    return t.reshape((t.shape[0], t.shape[1] * t.shape[2]) + t.shape[3:])


def _causal_dwconv(x, w):
    K, C = w.shape
    return lax.conv_general_dilated(x, w[:, None, :].astype(x.dtype), window_strides=(1,),
                                    padding=[(K - 1, 0)], dimension_numbers=('NWC', 'WIO', 'NWC'),
                                    feature_group_count=C)


def _gla(q, k, v, log_a):
    f32 = jnp.float32
    b, s, nh, dk = q.shape
    dv = v.shape[-1]
    L = GLA_CHUNK
    causal = jnp.tril(jnp.ones((L, L), dtype=bool))[None, :, :, None, None]
    xs = tuple(_to_chunks(t.astype(f32), L) for t in (q * dk ** -0.5, k, v, log_a))

    def step(state, inp):
        qb, kb, vb, ab = inp
        cum = jnp.cumsum(ab, axis=1)
        inter = jnp.einsum('blhk,bhkv->blhv', qb * jnp.exp(cum), state)
        rel = jnp.exp(jnp.where(causal, cum[:, :, None] - cum[:, None, :], -jnp.inf))
        scores = jnp.einsum('bthk,btshk,bshk->btsh', qb, rel, kb)
        intra = jnp.einsum('btsh,bshv->bthv', scores, vb)
        tot = cum[:, -1]
        k_dec = kb * jnp.exp(tot[:, None] - cum)
        state = state * jnp.exp(tot)[..., None] + jnp.einsum('blhk,blhv->bhkv', k_dec, vb)
        return state, inter + intra

    _, out = lax.scan(step, jnp.zeros((b, nh, dk, dv), f32), xs)
    return _from_chunks(out)


def _mlstm(q, k, v, i_pre, log_f):
    f32 = jnp.float32
    b, s, nh, dk = q.shape
    dv = v.shape[-1]
    L = MLSTM_CHUNK
    causal = jnp.tril(jnp.ones((L, L), dtype=bool))[None, :, :, None]
    xs = tuple(_to_chunks(t.astype(f32), L) for t in (q * dk ** -0.5, k, v, i_pre, log_f))

    def step(carry, inp):
        C, n, m = carry
        qb, kb, vb, ib, fb = inp
        bcum = jnp.cumsum(fb, axis=1)
        dlog = jnp.where(causal, bcum[:, :, None] - bcum[:, None, :] + ib[:, None], -jnp.inf)
        inter_log = bcum + m[:, None]
        m_t = jnp.maximum(inter_log, jnp.max(dlog, axis=2))
        w_intra = jnp.exp(dlog - m_t[:, :, None])
        w_inter = jnp.exp(inter_log - m_t)
        qk = jnp.einsum('bthk,bshk->btsh', qb, kb) * w_intra
        num = jnp.einsum('btsh,bshv->bthv', qk, vb) + w_inter[..., None] * jnp.einsum('bthk,bhkv->bthv', qb, C)
        den = jnp.sum(qk, axis=2) + w_inter * jnp.einsum('bthk,bhk->bth', qb, n)
        h = num / jnp.maximum(jnp.abs(den), jnp.exp(-m_t))[..., None]
        tot = bcum[:, -1]
        g_log = tot[:, None] - bcum + ib
        m_new = jnp.maximum(tot + m, jnp.max(g_log, axis=1))
        w_s = jnp.exp(g_log - m_new[:, None])
        w_c = jnp.exp(tot + m - m_new)
        C = C * w_c[..., None, None] + jnp.einsum('blh,blhk,blhv->bhkv', w_s, kb, vb)
        n = n * w_c[..., None] + jnp.einsum('blh,blhk->bhk', w_s, kb)
        return (C, n, m_new), h

    init = (jnp.zeros((b, nh, dk, dv), f32), jnp.zeros((b, nh, dk), f32), jnp.zeros((b, nh), f32))
    _, out = lax.scan(step, init, xs)
    return _from_chunks(out)


def _dsa(cq, ckv, k_idx, w_idx, w_uq, w_uk, w_uv, w_qi):
    f32 = jnp.float32
    b, s, _ = cq.shape
    topk = min(DSA_TOPK_MAX, s // 4)
    q = jnp.einsum('bsr,rhd->bshd', cq, w_uq)
    q_lat = jnp.einsum('bshd,chd->bshc', q, w_uk) * DSA_HEAD_DIM ** -0.5
    q_idx = jnp.einsum('bsr,rhd->bshd', cq, w_qi) * IDX_DIM ** -0.5
    w_head = w_idx * IDX_HEADS ** -0.5
    slopes = 2.0 ** (-8.0 * jnp.arange(1, DSA_HEADS + 1, dtype=f32) / DSA_HEADS)
    key_pos = jnp.arange(s)

    def block(inp):
        ql, qi, wh, pos = inp
        idx_scores = jnp.einsum('bthd,bsd->bths', qi, k_idx)
        I = jnp.einsum('bth,bths->bts', wh, jax.nn.relu(idx_scores)).astype(f32)
        I = jnp.where((key_pos[None, :] <= pos[:, None])[None], I, -jnp.inf)
        _, sel = lax.top_k(I, topk)
        kv = jax.vmap(lambda cb, ib: cb[ib])(ckv, sel)
        dist = (pos[None, :, None] - sel).astype(f32)
        logits = jnp.einsum('bthr,btkr->bthk', ql, kv).astype(f32) - slopes[:, None] * dist[:, :, None, :]
        logits = jnp.where((dist >= 0)[:, :, None, :], logits, -jnp.inf)
        p = jax.nn.softmax(logits, axis=-1).astype(kv.dtype)
        return jnp.einsum('bthk,btkr->bthr', p, kv)

    xs = (_to_chunks(q_lat, Q_BLOCK), _to_chunks(q_idx, Q_BLOCK), _to_chunks(w_head, Q_BLOCK),
          key_pos.reshape(-1, Q_BLOCK))
    o_lat = _from_chunks(lax.map(block, xs))
    o = jnp.einsum('bshr,rhv->bshv', o_lat, w_uv)
    return o.reshape(b, s, -1)


def _hybrid_mixer(h, w_in, gla_w_a2, gla_b_a, gla_norm, dsa_norm_q, dsa_norm_kv, dsa_w_uq, dsa_w_uk,
                  dsa_w_uv, dsa_w_qi, mlstm_conv, mlstm_b_i, mlstm_b_f, mlstm_norm,
                  w_up_a, w_up_b, w_up_c, w_o):
    b, s, _ = h.shape
    f32 = jnp.float32
    split_points = [int(v) for v in np.cumsum(IN_SIZES)[:-1]]
    (qa, ka, va, ga, a_lr, cq, ckv, k_idx, w_idx,
     qc, kc, vc, ic, fc, oc, gates) = jnp.split(h @ w_in, split_points, axis=-1)

    log_a = jax.nn.log_sigmoid((a_lr @ gla_w_a2 + gla_b_a).astype(f32)) / GLA_TAU
    oa = _gla(qa.reshape(b, s, GLA_HEADS, GLA_DK), ka.reshape(b, s, GLA_HEADS, GLA_DK),
              va.reshape(b, s, GLA_HEADS, GLA_DV), log_a.reshape(b, s, GLA_HEADS, GLA_DK))
    ya = (_head_rms(oa, gla_norm) * jax.nn.silu(ga.astype(f32))).astype(h.dtype) @ w_up_a

    ob = _dsa(_rms(cq, dsa_norm_q), _rms(ckv, dsa_norm_kv), k_idx, w_idx,
              dsa_w_uq, dsa_w_uk, dsa_w_uv, dsa_w_qi)
    yb = ob @ w_up_b

    qk = jax.nn.silu(_causal_dwconv(jnp.concatenate([qc, kc], axis=-1), mlstm_conv))
    qc, kc = jnp.split(qk, 2, axis=-1)
    i_pre = (ic + mlstm_b_i).astype(f32)
    log_f = jax.nn.log_sigmoid((fc + mlstm_b_f).astype(f32))
    o_c = _mlstm(qc.reshape(b, s, MLSTM_HEADS, MLSTM_DQK), kc.reshape(b, s, MLSTM_HEADS, MLSTM_DQK),
                 vc.reshape(b, s, MLSTM_HEADS, MLSTM_DV), i_pre, log_f)
    yc = (_head_rms(o_c, mlstm_norm) * jax.nn.sigmoid(oc.astype(f32))).astype(h.dtype) @ w_up_c

    g_a, g_b, g_c = jnp.split(jax.nn.sigmoid(gates.astype(f32)).astype(h.dtype), 3, axis=-1)
    return (g_a * ya + g_b * yb + g_c * yc) @ w_o


def _moe(h, router_w, router_bias, w_gate, w_up, w_down, s_gate, s_up, s_down):
    b, s, d = h.shape
    t = h.reshape(-1, d)
    scores = jax.nn.sigmoid(jnp.einsum('td,de->te', t, router_w).astype(jnp.float32))
    sel = scores + router_bias.astype(jnp.float32)
    grp = sel.reshape(-1, N_GROUPS, N_EXPERTS // N_GROUPS)
    grp_score = jnp.sum(lax.top_k(grp, 2)[0], axis=-1)
    _, grp_idx = lax.top_k(grp_score, TOPK_GROUPS)
    grp_mask = jnp.sum(jax.nn.one_hot(grp_idx, N_GROUPS, dtype=jnp.float32), axis=1) > 0
    sel = jnp.where(jnp.repeat(grp_mask, N_EXPERTS // N_GROUPS, axis=1), sel, -jnp.inf)
    _, idx = lax.top_k(sel, TOP_K)
    w = jnp.take_along_axis(scores, idx, axis=1)
    w = w / jnp.sum(w, axis=-1, keepdims=True) * ROUTED_SCALE
    gates = jnp.sum(jax.nn.one_hot(idx, N_EXPERTS, dtype=jnp.float32) * w[..., None], axis=1)

    def block(inp):
        xb, gb = inp
        a = jnp.einsum('td,edf->tef', xb, w_gate)
        u = jnp.einsum('td,edf->tef', xb, w_up)
        return jnp.einsum('tef,efd->td', jax.nn.silu(a) * u * gb[..., None], w_down)

    xs = (t.reshape(-1, TOKEN_BLOCK, d), gates.astype(t.dtype).reshape(-1, TOKEN_BLOCK, N_EXPERTS))
    routed = lax.map(block, xs).reshape(-1, d)
    shared = (jax.nn.silu(t @ s_gate) * (t @ s_up)) @ s_down
    return (routed + shared).reshape(b, s, d)


def setup_inputs(seed: int = 0) -> dict:
    key = jax.random.key(seed)
    keys = jax.random.split(key, 40)
    cnt = [0]

    def nxt():
        cnt[0] += 1
        return keys[cnt[0] - 1]

    def nrm(shape, scale):
        return jax.random.normal(nxt(), shape, jnp.float32) * scale

    def gain(shape):
        return 1.0 + 0.05 * jax.random.normal(nxt(), shape, jnp.float32)

    D, L, E, F = D_MODEL, DEPTH, N_EXPERTS, EXPERT_FF
    return {
        'x': nrm((BATCH, SEQ, D), 1.0),
        'c': nrm((BATCH, D), 1.0),
        'ada_w': nrm((L, D, 6 * D), 0.3 * D ** -0.5),
        'ada_b': nrm((L, 6 * D), 0.02),
        'norm_mix': gain((L, D)),
        'norm_ffn': gain((L, D)),
        'w_in': nrm((L, D, N_IN), D ** -0.5),
        'gla_w_a2': nrm((L, GLA_GATE_RANK, GLA_QK), GLA_GATE_RANK ** -0.5),
        'gla_b_a': nrm((L, GLA_QK), 0.1),
        'gla_norm': gain((L, GLA_V)),
        'dsa_norm_q': gain((L, DSA_Q_RANK)),
        'dsa_norm_kv': gain((L, DSA_KV_RANK)),
        'dsa_w_uq': nrm((L, DSA_Q_RANK, DSA_HEADS, DSA_HEAD_DIM), DSA_Q_RANK ** -0.5),
        'dsa_w_uk': nrm((L, DSA_KV_RANK, DSA_HEADS, DSA_HEAD_DIM), DSA_KV_RANK ** -0.5),
        'dsa_w_uv': nrm((L, DSA_KV_RANK, DSA_HEADS, DSA_V_DIM), DSA_KV_RANK ** -0.5),
        'dsa_w_qi': nrm((L, DSA_Q_RANK, IDX_HEADS, IDX_DIM), DSA_Q_RANK ** -0.5),
        'mlstm_conv': nrm((L, MLSTM_CONV, 2 * MLSTM_QK), MLSTM_CONV ** -0.5),
        'mlstm_b_i': nrm((L, MLSTM_HEADS), 0.1),
        'mlstm_b_f': 3.0 + nrm((L, MLSTM_HEADS), 0.5),
        'mlstm_norm': gain((L, MLSTM_V)),
        'w_up_a': nrm((L, GLA_V, D), GLA_V ** -0.5),
        'w_up_b': nrm((L, DSA_V, D), DSA_V ** -0.5),
        'w_up_c': nrm((L, MLSTM_V, D), MLSTM_V ** -0.5),
        'w_o': nrm((L, D, D), D ** -0.5),
        'router_w': nrm((L, D, E), D ** -0.5),
        'router_bias': nrm((L, E), 0.01),
        'exp_w_gate': nrm((L, E, D, F), D ** -0.5),
        'exp_w_up': nrm((L, E, D, F), D ** -0.5),
        'exp_w_down': nrm((L, E, F, D), F ** -0.5),
        'sh_w_gate': nrm((L, D, SHARED_FF), D ** -0.5),
        'sh_w_up': nrm((L, D, SHARED_FF), D ** -0.5),
        'sh_w_down': nrm((L, SHARED_FF, D), SHARED_FF ** -0.5),
        'norm_final': gain((D,)),
    }


def reference(x, c, ada_w, ada_b, norm_mix, norm_ffn, w_in, gla_w_a2, gla_b_a, gla_norm,
              dsa_norm_q, dsa_norm_kv, dsa_w_uq, dsa_w_uk, dsa_w_uv, dsa_w_qi,
              mlstm_conv, mlstm_b_i, mlstm_b_f, mlstm_norm,
              w_up_a, w_up_b, w_up_c, w_o,
              router_w, router_bias, exp_w_gate, exp_w_up, exp_w_down,
              sh_w_gate, sh_w_up, sh_w_down, norm_final):
    cs = jax.nn.silu(c)
    for l in range(DEPTH):
        mod = cs @ ada_w[l] + ada_b[l]
        sh1, sc1, g1, sh2, sc2, g2 = jnp.split(mod[:, None, :], 6, axis=-1)
        h = _rms(x, norm_mix[l]) * (1 + sc1) + sh1
        x = x + g1 * _hybrid_mixer(h, w_in[l], gla_w_a2[l], gla_b_a[l], gla_norm[l],
                                   dsa_norm_q[l], dsa_norm_kv[l], dsa_w_uq[l], dsa_w_uk[l],
                                   dsa_w_uv[l], dsa_w_qi[l], mlstm_conv[l], mlstm_b_i[l],
                                   mlstm_b_f[l], mlstm_norm[l], w_up_a[l], w_up_b[l],
                                   w_up_c[l], w_o[l])
        h = _rms(x, norm_ffn[l]) * (1 + sc2) + sh2
        x = x + g2 * _moe(h, router_w[l], router_bias[l], exp_w_gate[l], exp_w_up[l],
                          exp_w_down[l], sh_w_gate[l], sh_w_up[l], sh_w_down[l])
    return _rms(x, norm_final)
```

```cpp
#include <hip/hip_runtime.h>
#include <cstdio>
#include <cstdint>

#define LAS __attribute__((address_space(3)))
#define GAS __attribute__((address_space(1)))
typedef unsigned short bf16;
typedef short bf16x8 __attribute__((ext_vector_type(8)));
typedef float f32x4 __attribute__((ext_vector_type(4)));
typedef float f32x2 __attribute__((ext_vector_type(2)));
typedef unsigned u32x4 __attribute__((ext_vector_type(4)));
typedef unsigned u32x2 __attribute__((ext_vector_type(2)));
typedef GAS unsigned gu32;

#ifndef MK_ONE_LAUNCH
#define MK_ONE_LAUNCH 0
#endif

constexpr int NB = 16, SEQ = 2048, D = 1024, T = NB * SEQ, NL = 2;
constexpr int NIN = 6592, NPB = 3584, NG = 3072, NINP = NPB + NG;
constexpr int NE = 64, NEX = 65, EFF = 256, TOPK = 6;
constexpr int HALF_T = T / 2;
constexpr int DSA_K = 256;
constexpr float EPS = 1e-6f;
constexpr int NTHR = 512, NWAVES = 8;

constexpr int PB_QA = 0, PB_KA = 256, PB_VA = 512, PB_GA = 1024, PB_CQ = 1536, PB_CKV = 1792, PB_QC = 2048, PB_KC = 2304, PB_VC = 2560, PB_OC = 3072;
constexpr int SM_KIDX = 0, SM_ALR = 32, SM_WIDX = 48, SM_IC = 56, SM_FC = 60;

constexpr size_t MiB = 1u << 20;
constexpr size_t WS_CTL = 0, CTL_BYTES = 1 * MiB;
constexpr size_t WS_MOD = 1 * MiB;
constexpr size_t WS_RSTDQ = 2 * MiB;
constexpr size_t WS_TOKPOS = 3 * MiB;
constexpr size_t WS_WIN = 4 * MiB;
constexpr size_t WS_WQ = 30 * MiB;
constexpr size_t WS_WUPA = 32 * MiB;
constexpr size_t WS_WUPC = 34 * MiB;
constexpr size_t WS_WUVB = 36 * MiB;
constexpr size_t WS_WO = 40 * MiB;
constexpr size_t WS_WGU = 44 * MiB;
constexpr size_t WS_WD = 109 * MiB;
constexpr size_t WS_XN = 142 * MiB;
constexpr size_t WS_OLAT = WS_XN;
constexpr size_t WS_UA = 206 * MiB;
constexpr size_t WS_UC = 238 * MiB;
constexpr size_t WS_XN2 = 206 * MiB;
constexpr size_t WS_QLAT = 270 * MiB;
constexpr size_t WS_M1 = WS_QLAT;
constexpr size_t WS_QIDX = 334 * MiB;
constexpr size_t WS_CKVN = 350 * MiB;
constexpr size_t WS_KIDX = 358 * MiB;
constexpr size_t WS_SM = 360 * MiB;
constexpr size_t WS_PB = 376 * MiB;
constexpr size_t WS_G = WS_PB;
constexpr size_t WS_HID = 270 * MiB;
constexpr size_t WS_Y = 334 * MiB;
constexpr size_t WS_ROWL = 590 * MiB;
constexpr size_t WS_WL = 598 * MiB;
constexpr size_t WS_END = 606 * MiB;
static_assert(WS_PB + (size_t)T * NPB * 2 <= 600 * MiB, "PB");
static_assert(WS_Y + (size_t)131072 * 1024 * 2 <= WS_ROWL, "Y");

constexpr int CW_BAR = 4096;
constexpr int CW_CNT = 16384;

constexpr int LDS_BYTES = 147456;
constexpr int LDS_MISC = 145408;

__device__ __forceinline__ unsigned f2bf(float f) { unsigned u = __builtin_bit_cast(unsigned, f); return (u + 0x7fffu + ((u >> 16) & 1u)) >> 16; }
__device__ __forceinline__ float bf2f(unsigned b) { return __builtin_bit_cast(float, b << 16); }
__device__ __forceinline__ unsigned pk2(float lo, float hi) { return f2bf(lo) | (f2bf(hi) << 16); }
__device__ __forceinline__ float bflo(unsigned w) { return __builtin_bit_cast(float, w << 16); }
__device__ __forceinline__ float bfhi(unsigned w) { return __builtin_bit_cast(float, w & 0xffff0000u); }
__device__ __forceinline__ float wave_sum(float v) {
#pragma unroll
    for (int o = 1; o < 64; o <<= 1) v += __shfl_xor(v, o);
    return v;
}
__device__ __forceinline__ float wave_max(float v) {
#pragma unroll
    for (int o = 1; o < 64; o <<= 1) v = fmaxf(v, __shfl_xor(v, o));
    return v;
}
__device__ __forceinline__ int wave_sum_i(int v) {
#pragma unroll
    for (int o = 1; o < 64; o <<= 1) v += __shfl_xor(v, o);
    return v;
}
__device__ __forceinline__ float sigmoidf_(float x) { return 1.f / (1.f + __expf(-x)); }
__device__ __forceinline__ float siluf_(float x) { return x / (1.f + __expf(-x)); }
__device__ __forceinline__ float logsigmoidf_(float x) { return fminf(x, 0.f) - log1pf(__expf(-fabsf(x))); }
__device__ __forceinline__ void st_bf4(bf16* p, f32x4 v) { u32x2 w; w.x = pk2(v[0], v[1]); w.y = pk2(v[2], v[3]); *(u32x2*)p = w; }
__device__ __forceinline__ f32x4 ld_bf4(const bf16* p) { u32x2 w = *(const u32x2*)p; return (f32x4){bflo(w.x), bfhi(w.x), bflo(w.y), bfhi(w.y)}; }

#define XB_TMO      128
#define XB_XCNT(j)  (256  + 64 * (j))
#define XB_XSUB(j)  (1280 + 64 * (j))
#define XB_XGEN(j)  (2304 + 64 * (j))
#define XB_TOP      3328
#define XB_TOPGEN   3392
#define XCD_BAR_WORDS 3456
#define XB_SPIN_CAP (1u << 22)
__device__ __forceinline__ unsigned xb_ld(unsigned* p)              { return __hip_atomic_load(p, __ATOMIC_RELAXED, __HIP_MEMORY_SCOPE_AGENT); }
__device__ __forceinline__ unsigned xb_add(unsigned* p, unsigned v) { return __hip_atomic_fetch_add(p, v, __ATOMIC_RELAXED, __HIP_MEMORY_SCOPE_AGENT); }
__device__ __forceinline__ unsigned xb_xcc_id() { return (unsigned)__builtin_amdgcn_s_getreg((3 << 11) | 20) & 0xFu; }
#define XB_SPIN(cond, bar) do { unsigned _sp = 0; while (cond) { __builtin_amdgcn_s_sleep(1); \
    if ((++_sp & 255u) == 0u) { if (xb_ld(&(bar)[XB_TMO])) break; if (_sp > XB_SPIN_CAP) { atomicAdd(&(bar)[XB_TMO], 1u); break; } } } } while (0)
struct XcdBarrier { unsigned* bar; unsigned x; volatile LAS unsigned* st; };
__device__ __forceinline__ XcdBarrier xcd_barrier_post(unsigned* bar, volatile LAS unsigned* st) {
    XcdBarrier b; b.bar = bar; b.x = xb_xcc_id(); b.st = st;
    if (threadIdx.x == 0) (void)xb_add(&bar[XB_XCNT(b.x)], 1u);
    return b;
}
__device__ __forceinline__ void xcd_barrier_complete(unsigned* bar, unsigned x, unsigned& nloc, unsigned& nx) {
    const unsigned G = gridDim.x * gridDim.y * gridDim.z;
    unsigned sum, cnt, mine, sp = 0u;
    for (;;) {
        sum = 0u; cnt = 0u; mine = 0u;
#pragma unroll
        for (unsigned j = 0; j < 16; ++j) { const unsigned c = xb_ld(&bar[XB_XCNT(j)]); sum += c; cnt += (c > 0u) ? 1u : 0u; mine = (j == x) ? c : mine; }
        if (sum == G) break;
        __builtin_amdgcn_s_sleep(1);
        if ((++sp & 255u) == 0u) { if (xb_ld(&bar[XB_TMO])) break; if (sp > XB_SPIN_CAP) { atomicAdd(&bar[XB_TMO], 1u); break; } }
    }
    nloc = mine > 0u ? mine : 1u; nx = cnt > 0u ? cnt : 1u;
}
__device__ __forceinline__ void xcd_barrier(const XcdBarrier& b) {
    asm volatile("s_waitcnt vmcnt(0)" ::: "memory");
    __syncthreads();
    if (threadIdx.x == 0) {
        unsigned* bar = b.bar;
        __builtin_amdgcn_s_waitcnt(0);
        unsigned nloc = b.st[0], nx = b.st[1];
        if (nloc == 0u) { xcd_barrier_complete(bar, b.x, nloc, nx); b.st[0] = nloc; b.st[1] = nx; }
        const unsigned old = xb_add(&bar[XB_XSUB(b.x)], 1u);
        const unsigned gen = old / nloc;
        if (old + 1u == (gen + 1u) * nloc) {
            __builtin_amdgcn_fence(__ATOMIC_RELEASE, "agent");
            asm volatile("s_waitcnt vmcnt(0)" ::: "memory");
            const unsigned og = xb_add(&bar[XB_TOP], 1u);
            const unsigned tg = og / nx;
            if (og + 1u == (tg + 1u) * nx) xb_add(&bar[XB_TOPGEN], 1u);
            else XB_SPIN(xb_ld(&bar[XB_TOPGEN]) == tg, bar);
            __builtin_amdgcn_fence(__ATOMIC_ACQUIRE, "agent");
            xb_add(&bar[XB_XGEN(b.x)], 1u);
            asm volatile("s_waitcnt vmcnt(0)" ::: "memory");
        } else {
            XB_SPIN(xb_ld(&bar[XB_XGEN(b.x)]) == gen, bar);
            __builtin_amdgcn_fence(__ATOMIC_ACQUIRE, "agent");
            asm volatile("s_waitcnt vmcnt(0)" ::: "memory");
        }
    }
    __syncthreads();
}

struct Args { const float* in[33]; float* out; unsigned char* ws; int ph_lo, ph_hi; };

struct Ctx {
    LAS unsigned char* lds;
    int tid, lane, wave, bid, nblk;
    const float* const* in;
    float* out; unsigned char* ws;
};
#define IN_X 0
#define IN_C 1
#define IN_ADAW 2
#define IN_ADAB 3
#define IN_NMIX 4
#define IN_NFFN 5
#define IN_WIN 6
#define IN_GLA_WA2 7
#define IN_GLA_BA 8
#define IN_GLA_NORM 9
#define IN_DSA_NQ 10
#define IN_DSA_NKV 11
#define IN_DSA_WUQ 12
#define IN_DSA_WUK 13
#define IN_DSA_WUV 14
#define IN_DSA_WQI 15
#define IN_ML_CONV 16
#define IN_ML_BI 17
#define IN_ML_BF 18
#define IN_ML_NORM 19
#define IN_WUPA 20
#define IN_WUPB 21
#define IN_WUPC 22
#define IN_WO 23
#define IN_RW 24
#define IN_RB 25
#define IN_EWG 26
#define IN_EWU 27
#define IN_EWD 28
#define IN_SWG 29
#define IN_SWU 30
#define IN_SWD 31
#define IN_NFIN 32

template <class SrcF>
__device__ __forceinline__ void tr_item(const SrcF& src, bf16* dst, int dst_ld, int n0, int k0, LAS float* scr, int lane) {
    const int j = lane & 31;
    const float* colp = src(n0 + j);
    const long ld = src.ld;
#pragma unroll 8
    for (int i = 0; i < 32; ++i) { const int kk = 2 * i + (lane >> 5); scr[kk * 33 + j] = colp ? colp[(long)(k0 + kk) * ld] : 0.f; }
    asm volatile("s_waitcnt lgkmcnt(0)" ::: "memory");
    const int c = lane & 7;
#pragma unroll
    for (int jj = 0; jj < 4; ++jj) { const int n = (lane >> 3) + 8 * jj; const LAS float* s = scr + (8 * c) * 33 + n;
        u32x4 o; o.x = pk2(s[0 * 33], s[1 * 33]); o.y = pk2(s[2 * 33], s[3 * 33]); o.z = pk2(s[4 * 33], s[5 * 33]); o.w = pk2(s[6 * 33], s[7 * 33]);
        *(u32x4*)(dst + (size_t)(n0 + n) * dst_ld + k0 + 8 * c) = o; }
    asm volatile("s_waitcnt lgkmcnt(0)" ::: "memory");
}
struct SrcPlain { const float* W; long ld; __device__ __forceinline__ const float* operator()(int n) const { return W + n; } };
__device__ __forceinline__ int win_src_col(int r) {
    if (r < 1536) return r;
    if (r < 1792) return 1552 + (r - 1536);
    if (r < 1920) return 1808 + (r - 1792);
    if (r < 1952) return 1936 + (r - 1920);
    if (r < 1968) return 1536 + (r - 1952);
    if (r < 1976) return 1968 + (r - 1968);
    if (r < 1980) return 3000 + (r - 1976);
    if (r < 1984) return 3004 + (r - 1980);
    if (r < 2048) return -1;
    if (r < 2560) return 1976 + (r - 2048);
    if (r < 3072) return 2488 + (r - 2560);
    if (r < 3584) return 3008 + (r - 3072);
    return 3520 + (r - 3584);
}
struct SrcWin { const float* W; long ld; __device__ __forceinline__ const float* operator()(int n) const { const int c = win_src_col(n); return c < 0 ? nullptr : W + c; } };
struct SrcGU { const float* Wg; const float* Wu; long ld;
    __device__ __forceinline__ const float* operator()(int r) const { const int pn = r >> 8, w = r & 255, j = 128 * pn + (w & 127); return (w < 128 ? Wg : Wu) + j; } };

constexpr int SG_LD = 40;
template <class Epi>
__device__ __forceinline__ void sgemm_unit(const Ctx& c, const bf16* A, int lda, const int* rowlist, int nvalid, int arow0, const bf16* Bt, int K, const Epi& E, int erow0, int ecol0) {
    LAS bf16* As = (LAS bf16*)c.lds;
    LAS bf16* Bs = (LAS bf16*)(c.lds + 128 * SG_LD * 2);
    const int tid = c.tid, lane = c.lane, wave = c.wave, wr = wave >> 2, wc = wave & 3, fr = lane & 15, fq = lane >> 4;
    const int lr = tid >> 2, ch = tid & 3;
    int srow = arow0 + lr;
    if (rowlist) { srow = (arow0 + lr < nvalid) ? rowlist[arow0 + lr] : 0; }
    const bf16* ap = A + (size_t)srow * lda + ch * 8;
    const bf16* bp0 = Bt + (size_t)lr * K + ch * 8;
    const bf16* bp1 = Bt + (size_t)(128 + lr) * K + ch * 8;
    f32x4 acc[2][4][2];
#pragma unroll
    for (int a = 0; a < 2; ++a)
#pragma unroll
        for (int m = 0; m < 4; ++m)
#pragma unroll
            for (int n = 0; n < 2; ++n) acc[a][m][n] = (f32x4){0.f, 0.f, 0.f, 0.f};
    u32x4 ra = *(const u32x4*)ap, rb0 = *(const u32x4*)bp0, rb1 = *(const u32x4*)bp1;
    for (int k0 = 0; k0 < K; k0 += 32) {
        __syncthreads();
        *(LAS u32x4*)(As + lr * SG_LD + ch * 8) = ra;
        *(LAS u32x4*)(Bs + lr * SG_LD + ch * 8) = rb0;
        *(LAS u32x4*)(Bs + (128 + lr) * SG_LD + ch * 8) = rb1;
        __syncthreads();
        if (k0 + 32 < K) { ra = *(const u32x4*)(ap + k0 + 32); rb0 = *(const u32x4*)(bp0 + k0 + 32); rb1 = *(const u32x4*)(bp1 + k0 + 32); }
        bf16x8 af[4], bfr[2][2];
#pragma unroll
        for (int m = 0; m < 4; ++m) af[m] = *(const LAS bf16x8*)(As + (wr * 64 + m * 16 + fr) * SG_LD + fq * 8);
#pragma unroll
        for (int bj = 0; bj < 2; ++bj)
#pragma unroll
            for (int n = 0; n < 2; ++n) bfr[bj][n] = *(const LAS bf16x8*)(Bs + (bj * 128 + wc * 32 + n * 16 + fr) * SG_LD + fq * 8);
#pragma unroll
        for (int bj = 0; bj < 2; ++bj)
#pragma unroll
            for (int m = 0; m < 4; ++m)
#pragma unroll
                for (int n = 0; n < 2; ++n) acc[bj][m][n] = __builtin_amdgcn_mfma_f32_16x16x32_bf16(bfr[bj][n], af[m], acc[bj][m][n], 0, 0, 0);
    }
#pragma unroll
    for (int m = 0; m < 4; ++m)
#pragma unroll
        for (int n = 0; n < 2; ++n) E(erow0 + wr * 64 + m * 16 + fr, ecol0 + wc * 32 + n * 16 + 4 * fq, acc[0][m][n], acc[1][m][n]);
}
template <class Epi>
__device__ __forceinline__ void sgemm_phase(const Ctx& c, const bf16* A, int lda, int M, const bf16* Bt, int ntn, int K, const Epi& E) {
    const int nu = (M / 128) * ntn;
    for (int u = c.bid; u < nu; u += c.nblk) {
        const int pm = u / ntn, pn = u % ntn;
        sgemm_unit(c, A, lda, nullptr, 0, pm * 128, Bt + (size_t)pn * 256 * K, K, E, pm * 128, pn * 256);
    }
    __syncthreads();
}

struct EpiInPB { bf16* PB; float* SM;
    __device__ __forceinline__ void operator()(int row, int col, f32x4 lo, f32x4 hi) const {
        st_bf4(PB + (size_t)row * NPB + col, lo);
        if ((col >> 8) == 7) *(f32x4*)(SM + (size_t)row * 128 + (col & 127)) = hi;
        else st_bf4(PB + (size_t)row * NPB + col + 128, hi);
    } };
struct EpiQ { bf16* QLAT; bf16* QIDX; const float* rstd;
    __device__ __forceinline__ void operator()(int row, int col, f32x4 lo, f32x4 hi) const {
        const float r = rstd[row];
        if (col < 1024) { st_bf4(QLAT + (size_t)row * 1024 + col, lo * r); st_bf4(QLAT + (size_t)row * 1024 + col + 128, hi * r); }
        else { st_bf4(QIDX + (size_t)row * 256 + (col - 1024), lo * r); st_bf4(QIDX + (size_t)row * 256 + (col - 1024) + 128, hi * r); }
    } };
struct EpiGate { bf16* G;
    __device__ __forceinline__ void operator()(int row, int col, f32x4 lo, f32x4 hi) const {
        f32x4 a, b;
#pragma unroll
        for (int i = 0; i < 4; ++i) { a[i] = sigmoidf_(lo[i]); b[i] = sigmoidf_(hi[i]); }
        st_bf4(G + (size_t)row * NG + col, a); st_bf4(G + (size_t)row * NG + col + 128, b);
    } };
struct EpiUp { bf16* M1; const bf16* G; int goff; int first;
    __device__ __forceinline__ void operator()(int row, int col, f32x4 lo, f32x4 hi) const {
        bf16* m = M1 + (size_t)row * 1024 + col; const bf16* g = G + (size_t)row * NG + goff + col;
        f32x4 a = ld_bf4(g) * lo, b = ld_bf4(g + 128) * hi;
        if (!first) { a += ld_bf4(m); b += ld_bf4(m + 128); }
        st_bf4(m, a); st_bf4(m + 128, b);
    } };
struct EpiWo { const float* res; float* out; const float* g1;
    __device__ __forceinline__ void operator()(int row, int col, f32x4 lo, f32x4 hi) const {
        const float* gp = g1 + (size_t)(row >> 11) * 6144 + col; const size_t o = (size_t)row * 1024 + col;
        const f32x4 ga = *(const f32x4*)gp, gb = *(const f32x4*)(gp + 128);
        const f32x4 ra = *(const f32x4*)(res + o), rb = *(const f32x4*)(res + o + 128);
        *(f32x4*)(out + o) = ra + ga * lo; *(f32x4*)(out + o + 128) = rb + gb * hi;
    } };
struct EpiG1 { bf16* HID; const float* wl; int cnt; int orow0;
    __device__ __forceinline__ void operator()(int row, int col, f32x4 lo, f32x4 hi) const {
        const int hc = col - 128 * (col >> 8);
        f32x4 v = (f32x4){0.f, 0.f, 0.f, 0.f};
        if (row < cnt) { const float w = wl ? wl[row] : 1.f;
#pragma unroll
            for (int i = 0; i < 4; ++i) v[i] = siluf_(lo[i]) * hi[i] * w; }
        st_bf4(HID + (size_t)(orow0 + row) * 256 + hc, v);
    } };
struct EpiG2 { bf16* Y; int orow0;
    __device__ __forceinline__ void operator()(int row, int col, f32x4 lo, f32x4 hi) const {
        st_bf4(Y + (size_t)(orow0 + row) * 1024 + col, lo); st_bf4(Y + (size_t)(orow0 + row) * 1024 + col + 128, hi);
    } };

__device__ __forceinline__ void phase_prologue(const Ctx& c) {
    {
        LAS float* cs = (LAS float*)c.lds;
        LAS float* red = (LAS float*)(c.lds + 65536);
        const float* cin = c.in[IN_C];
        if (c.bid < 192) {
            for (int i = c.tid; i < 16 * 1024; i += NTHR) cs[i] = siluf_(cin[i]);
            __syncthreads();
        }
        float* MOD = (float*)(c.ws + WS_MOD);
        for (int it = c.bid; it < 192; it += c.nblk) {
            const int l = it / 96, cg = it % 96, col = cg * 64 + c.lane;
            const float* W = c.in[IN_ADAW] + (size_t)l * 1024 * 6144 + col;
            float acc[16];
#pragma unroll
            for (int b = 0; b < 16; ++b) acc[b] = 0.f;
            const int kbeg = c.wave * 128;
            for (int k = kbeg; k < kbeg + 128; k += 4) {
                const float w0 = W[(size_t)k * 6144], w1 = W[(size_t)(k + 1) * 6144], w2 = W[(size_t)(k + 2) * 6144], w3 = W[(size_t)(k + 3) * 6144];
#pragma unroll
                for (int b = 0; b < 16; ++b) { const f32x4 v = *(const LAS f32x4*)(cs + b * 1024 + k); acc[b] += v[0] * w0 + v[1] * w1 + v[2] * w2 + v[3] * w3; }
            }
#pragma unroll
            for (int b = 0; b < 16; ++b) red[(c.wave * 16 + b) * 64 + c.lane] = acc[b];
            __syncthreads();
            for (int i = c.tid; i < 16 * 64; i += NTHR) { const int b = i >> 6, ln = i & 63; float s = 0.f;
#pragma unroll
                for (int w = 0; w < 8; ++w) s += red[(w * 16 + b) * 64 + ln];
                MOD[((size_t)l * 16 + b) * 6144 + cg * 64 + ln] = s + c.in[IN_ADAB][l * 6144 + cg * 64 + ln]; }
            __syncthreads();
        }
        __syncthreads();
    }
    {
        LAS float* scr = (LAS float*)(c.lds + c.wave * 16384);
        const int gw = c.bid * NWAVES + c.wave, NGW = c.nblk * NWAVES;
        constexpr int I_WIN = (NINP / 32) * (1024 / 64), I_UP = (1024 / 32) * (512 / 64), I_WO = (1024 / 32) * (1024 / 64);
        constexpr int PER_L = I_WIN + 2 * I_UP + I_WO;
        for (int it = gw; it < NL * PER_L; it += NGW) {
            const int l = it / PER_L; int r = it % PER_L;
            if (r < I_WIN) { SrcWin s{c.in[IN_WIN] + (size_t)l * 1024 * NIN, NIN}; tr_item(s, (bf16*)(c.ws + WS_WIN) + (size_t)l * NINP * 1024, 1024, (r / 16) * 32, (r % 16) * 64, scr, c.lane); continue; }
            r -= I_WIN;
            if (r < I_UP) { SrcPlain s{c.in[IN_WUPA] + (size_t)l * 512 * 1024, 1024}; tr_item(s, (bf16*)(c.ws + WS_WUPA) + (size_t)l * 1024 * 512, 512, (r / 8) * 32, (r % 8) * 64, scr, c.lane); continue; }
            r -= I_UP;
            if (r < I_UP) { SrcPlain s{c.in[IN_WUPC] + (size_t)l * 512 * 1024, 1024}; tr_item(s, (bf16*)(c.ws + WS_WUPC) + (size_t)l * 1024 * 512, 512, (r / 8) * 32, (r % 8) * 64, scr, c.lane); continue; }
            r -= I_UP;
            { SrcPlain s{c.in[IN_WO] + (size_t)l * 1024 * 1024, 1024}; tr_item(s, (bf16*)(c.ws + WS_WO) + (size_t)l * 1024 * 1024, 1024, (r / 16) * 32, (r % 16) * 64, scr, c.lane); }
        }
    }
    {
        const int gt = c.bid * NTHR + c.tid, NGT = c.nblk * NTHR;
        for (int it = gt; it < NL * 1280 * 32; it += NGT) {
            const int l = it / (1280 * 32), rem = it % (1280 * 32), n = rem / 32, r0 = (rem % 32) * 8;
            const float* gq = c.in[IN_DSA_NQ] + l * 256;
            float o[8];
            if (n < 1024) {
                const int h = n >> 7, cc = n & 127;
                const float* uk = c.in[IN_DSA_WUK] + (size_t)l * 128 * 512 + (size_t)cc * 512 + h * 64;
#pragma unroll
                for (int i = 0; i < 8; ++i) { const float* uq = c.in[IN_DSA_WUQ] + (size_t)l * 256 * 512 + (size_t)(r0 + i) * 512 + h * 64; float s = 0.f;
                    for (int d = 0; d < 64; ++d) s += uq[d] * uk[d];
                    o[i] = s * 0.125f * gq[r0 + i]; }
            } else {
                const int m = n - 1024;
#pragma unroll
                for (int i = 0; i < 8; ++i) o[i] = c.in[IN_DSA_WQI][(size_t)l * 256 * 256 + (size_t)(r0 + i) * 256 + m] * 0.17677669529663687f * gq[r0 + i];
            }
            u32x4 w; w.x = pk2(o[0], o[1]); w.y = pk2(o[2], o[3]); w.z = pk2(o[4], o[5]); w.w = pk2(o[6], o[7]);
            *(u32x4*)((bf16*)(c.ws + WS_WQ) + (size_t)l * 1280 * 256 + (size_t)n * 256 + r0) = w;
        }
    }
    {
        const int gt = c.bid * NTHR + c.tid, NGT = c.nblk * NTHR;
        for (int it = gt; it < NL * 128 * 1024; it += NGT) {
            const int l = it / (128 * 1024), rem = it % (128 * 1024), kc = rem / 1024, n = rem % 1024;
            const int h = kc >> 4, r0 = (kc & 15) * 8;
            const float* uv = c.in[IN_DSA_WUV] + (size_t)l * 128 * 512;
            const float* ub = c.in[IN_WUPB] + (size_t)l * 512 * 1024 + (size_t)(h * 64) * 1024 + n;
            float o[8];
#pragma unroll
            for (int i = 0; i < 8; ++i) o[i] = 0.f;
            for (int v = 0; v < 64; ++v) { const float b = ub[(size_t)v * 1024];
#pragma unroll
                for (int i = 0; i < 8; ++i) o[i] += uv[(size_t)(r0 + i) * 512 + h * 64 + v] * b; }
            u32x4 w; w.x = pk2(o[0], o[1]); w.y = pk2(o[2], o[3]); w.z = pk2(o[4], o[5]); w.w = pk2(o[6], o[7]);
            *(u32x4*)((bf16*)(c.ws + WS_WUVB) + (size_t)l * 1024 * 1024 + (size_t)n * 1024 + h * 128 + r0) = w;
        }
    }
}

__device__ __forceinline__ void norm_mod_row(const float* xrow, const float* gain, const float* sh, const float* sc, bf16* orow, int lane) {
    f32x4 v[4]; float s = 0.f;
#pragma unroll
    for (int j = 0; j < 4; ++j) { v[j] = *(const f32x4*)(xrow + 4 * (lane + 64 * j)); s += v[j][0] * v[j][0] + v[j][1] * v[j][1] + v[j][2] * v[j][2] + v[j][3] * v[j][3]; }
    const float rstd = rsqrtf(wave_sum(s) * (1.f / D) + EPS);
#pragma unroll
    for (int j = 0; j < 4; ++j) { const int cc = 4 * (lane + 64 * j);
        const f32x4 g = *(const f32x4*)(gain + cc), a = *(const f32x4*)(sc + cc), b = *(const f32x4*)(sh + cc);
        st_bf4(orow + cc, v[j] * rstd * g * (a + 1.f) + b); }
}
__device__ __forceinline__ void phase_norm1(const Ctx& c, int l, const float* xsrc) {
    const int gw = c.bid * NWAVES + c.wave, NGW = c.nblk * NWAVES;
    const float* MOD = (const float*)(c.ws + WS_MOD) + (size_t)l * 16 * 6144;
    bf16* XN = (bf16*)(c.ws + WS_XN);
    for (int t = gw; t < T; t += NGW) { const int b = t >> 11;
        norm_mod_row(xsrc + (size_t)t * D, c.in[IN_NMIX] + l * D, MOD + (size_t)b * 6144, MOD + (size_t)b * 6144 + 1024, XN + (size_t)t * D, c.lane); }
}

__device__ __forceinline__ void phase_prep(const Ctx& c, int l) {
    const int gw = c.bid * NWAVES + c.wave, NGW = c.nblk * NWAVES;
    const bf16* PB = (const bf16*)(c.ws + WS_PB); const float* SM = (const float*)(c.ws + WS_SM);
    bf16* CKVN = (bf16*)(c.ws + WS_CKVN); bf16* KIDX = (bf16*)(c.ws + WS_KIDX); float* RSTDQ = (float*)(c.ws + WS_RSTDQ);
    const float* gkv = c.in[IN_DSA_NKV] + l * 128;
    for (int t = gw; t < T; t += NGW) {
        const bf16* row = PB + (size_t)t * NPB;
        const unsigned kv = *(const unsigned*)(row + PB_CKV + 2 * c.lane);
        const float k0 = bflo(kv), k1 = bfhi(kv);
        const float rs = rsqrtf(wave_sum(k0 * k0 + k1 * k1) * (1.f / 128.f) + EPS);
        *(unsigned*)(CKVN + (size_t)t * 128 + 2 * c.lane) = pk2(k0 * rs * gkv[2 * c.lane], k1 * rs * gkv[2 * c.lane + 1]);
        const f32x4 q = ld_bf4(row + PB_CQ + 4 * c.lane);
        const float rq = rsqrtf(wave_sum(q[0] * q[0] + q[1] * q[1] + q[2] * q[2] + q[3] * q[3]) * (1.f / 256.f) + EPS);
        if (c.lane == 0) RSTDQ[t] = rq;
        if (c.lane < 32) KIDX[(size_t)t * 32 + c.lane] = (bf16)f2bf(SM[(size_t)t * 128 + SM_KIDX + c.lane]);
    }
}

constexpr int TS = 16;
__device__ __forceinline__ void scan_gla_item(const Ctx& c, int l, int b, int h) {
    LAS float* q_s = (LAS float*)c.lds;
    LAS float* k_s = q_s + TS * 64;
    LAS float* a_s = k_s + TS * 64;
    LAS float* v_s = a_s + TS * 64;
    LAS float* part = v_s + TS * 128;
    LAS float* wa2 = part + TS * 4 * 128;
    LAS float* ba = wa2 + 16 * 64;
    LAS float* alr = ba + 64;
    const bf16* PB = (const bf16*)(c.ws + WS_PB); const float* SM = (const float*)(c.ws + WS_SM);
    bf16* UA = (bf16*)(c.ws + WS_UA);
    const float* gn = c.in[IN_GLA_NORM] + l * 512 + h * 128;
    for (int i = c.tid; i < 16 * 64; i += NTHR) wa2[i] = c.in[IN_GLA_WA2][(size_t)l * 16 * 256 + (i >> 6) * 256 + h * 64 + (i & 63)];
    if (c.tid < 64) ba[c.tid] = c.in[IN_GLA_BA][l * 256 + h * 64 + c.tid];
    const int v = c.tid & 127, kg = c.tid >> 7;
    float S[16];
#pragma unroll
    for (int i = 0; i < 16; ++i) S[i] = 0.f;
    for (int t0 = 0; t0 < SEQ; t0 += TS) {
        __syncthreads();
        const size_t rb = (size_t)b * SEQ + t0;
        for (int i = c.tid; i < TS * 64; i += NTHR) { const int s = i >> 6, cc = i & 63; const bf16* row = PB + (rb + s) * NPB;
            q_s[i] = bf2f(row[PB_QA + h * 64 + cc]) * 0.125f; k_s[i] = bf2f(row[PB_KA + h * 64 + cc]); }
        for (int i = c.tid; i < TS * 128; i += NTHR) { const int s = i >> 7, cc = i & 127; v_s[i] = bf2f(PB[(rb + s) * NPB + PB_VA + h * 128 + cc]); }
        if (c.tid < TS * 16) alr[c.tid] = SM[(rb + (c.tid >> 4)) * 128 + SM_ALR + (c.tid & 15)];
        __syncthreads();
        for (int i = c.tid; i < TS * 64; i += NTHR) { const int s = i >> 6, cc = i & 63; float x = ba[cc];
#pragma unroll
            for (int j = 0; j < 16; ++j) x += alr[s * 16 + j] * wa2[j * 64 + cc];
            a_s[i] = __expf(logsigmoidf_(x) * (1.f / 16.f)); }
        __syncthreads();
#pragma unroll 1
        for (int s = 0; s < TS; ++s) {
            const float vv = v_s[s * 128 + v]; float acc = 0.f;
#pragma unroll
            for (int i4 = 0; i4 < 4; ++i4) {
                const f32x4 a4 = *(const LAS f32x4*)(a_s + s * 64 + kg * 16 + i4 * 4), k4 = *(const LAS f32x4*)(k_s + s * 64 + kg * 16 + i4 * 4), q4 = *(const LAS f32x4*)(q_s + s * 64 + kg * 16 + i4 * 4);
#pragma unroll
                for (int j = 0; j < 4; ++j) { S[i4 * 4 + j] = a4[j] * S[i4 * 4 + j] + k4[j] * vv; acc += q4[j] * S[i4 * 4 + j]; }
            }
            part[(s * 4 + kg) * 128 + v] = acc;
        }
        __syncthreads();
        {
            const int s = c.tid >> 5, vq = c.tid & 31, v0 = vq * 4;
            f32x4 o = (f32x4){0.f, 0.f, 0.f, 0.f};
#pragma unroll
            for (int g = 0; g < 4; ++g) o += *(const LAS f32x4*)(part + (s * 4 + g) * 128 + v0);
            float ss = o[0] * o[0] + o[1] * o[1] + o[2] * o[2] + o[3] * o[3];
#pragma unroll
            for (int m = 1; m < 32; m <<= 1) ss += __shfl_xor(ss, m);
            const float rstd = rsqrtf(ss * (1.f / 128.f) + EPS);
            const f32x4 ga = ld_bf4(PB + (rb + s) * NPB + PB_GA + h * 128 + v0);
            f32x4 r;
#pragma unroll
            for (int j = 0; j < 4; ++j) r[j] = o[j] * rstd * gn[v0 + j] * siluf_(ga[j]);
            st_bf4(UA + (rb + s) * 512 + h * 128 + v0, r);
        }
    }
    __syncthreads();
}
__device__ __forceinline__ void scan_mlstm_item(const Ctx& c, int l, int b, int h) {
    LAS float* q_s = (LAS float*)c.lds;
    LAS float* k_s = q_s + TS * 64;
    LAS float* v_s = k_s + TS * 64;
    LAS float* part = v_s + TS * 128;
    LAS float* dpart = part + TS * 4 * 128;
    LAS float* lf_s = dpart + TS * 4;
    LAS float* ip_s = lf_s + TS;
    LAS float* m_s = ip_s + TS;
    LAS float* cw = m_s + TS;
    const bf16* PB = (const bf16*)(c.ws + WS_PB); const float* SM = (const float*)(c.ws + WS_SM);
    bf16* UC = (bf16*)(c.ws + WS_UC);
    const float* mn = c.in[IN_ML_NORM] + l * 512 + h * 128;
    if (c.tid < 4 * 128) { const int j = c.tid >> 7, cc = c.tid & 127; cw[c.tid] = c.in[IN_ML_CONV][(size_t)l * 4 * 512 + j * 512 + (cc < 64 ? h * 64 + cc : 256 + h * 64 + (cc - 64))]; }
    const float bi = c.in[IN_ML_BI][l * 4 + h], bfv = c.in[IN_ML_BF][l * 4 + h];
    const int v = c.tid & 127, kg = c.tid >> 7;
    float C[16], n[16]; float m = 0.f;
#pragma unroll
    for (int i = 0; i < 16; ++i) { C[i] = 0.f; n[i] = 0.f; }
    for (int t0 = 0; t0 < SEQ; t0 += TS) {
        __syncthreads();
        const size_t rb = (size_t)b * SEQ + t0;
        for (int i = c.tid; i < TS * 128; i += NTHR) { const int s = i >> 7, cc = i & 127;
            const int col = cc < 64 ? PB_QC + h * 64 + cc : PB_KC + h * 64 + (cc - 64);
            float x = 0.f;
#pragma unroll
            for (int j = 0; j < 4; ++j) { const int tt = t0 + s - 3 + j; if (tt >= 0) x += cw[j * 128 + cc] * bf2f(PB[((size_t)b * SEQ + tt) * NPB + col]); }
            x = siluf_(x);
            if (cc < 64) q_s[s * 64 + cc] = x * 0.125f; else k_s[s * 64 + (cc - 64)] = x; }
        for (int i = c.tid; i < TS * 128; i += NTHR) { const int s = i >> 7, cc = i & 127; v_s[i] = bf2f(PB[(rb + s) * NPB + PB_VC + h * 128 + cc]); }
        if (c.tid < TS) { ip_s[c.tid] = SM[(rb + c.tid) * 128 + SM_IC + h] + bi; lf_s[c.tid] = logsigmoidf_(SM[(rb + c.tid) * 128 + SM_FC + h] + bfv); }
        __syncthreads();
#pragma unroll 1
        for (int s = 0; s < TS; ++s) {
            const float lf = lf_s[s], ip = ip_s[s];
            const float mnew = fmaxf(lf + m, ip), fg = __expf(lf + m - mnew), ig = __expf(ip - mnew);
            m = mnew;
            const float vv = v_s[s * 128 + v] * ig; float num = 0.f, den = 0.f;
#pragma unroll
            for (int i4 = 0; i4 < 4; ++i4) {
                const f32x4 k4 = *(const LAS f32x4*)(k_s + s * 64 + kg * 16 + i4 * 4), q4 = *(const LAS f32x4*)(q_s + s * 64 + kg * 16 + i4 * 4);
#pragma unroll
                for (int j = 0; j < 4; ++j) { C[i4 * 4 + j] = fg * C[i4 * 4 + j] + k4[j] * vv; n[i4 * 4 + j] = fg * n[i4 * 4 + j] + ig * k4[j]; num += q4[j] * C[i4 * 4 + j]; den += q4[j] * n[i4 * 4 + j]; }
            }
            part[(s * 4 + kg) * 128 + v] = num;
            if (v == 0) dpart[s * 4 + kg] = den;
            if (c.tid == 0) m_s[s] = m;
        }
        __syncthreads();
        {
            const int s = c.tid >> 5, vq = c.tid & 31, v0 = vq * 4;
            f32x4 o = (f32x4){0.f, 0.f, 0.f, 0.f};
#pragma unroll
            for (int g = 0; g < 4; ++g) o += *(const LAS f32x4*)(part + (s * 4 + g) * 128 + v0);
            const float den = dpart[s * 4] + dpart[s * 4 + 1] + dpart[s * 4 + 2] + dpart[s * 4 + 3];
            const float dd = 1.f / fmaxf(fabsf(den), __expf(-m_s[s]));
            o = o * dd;
            float ss = o[0] * o[0] + o[1] * o[1] + o[2] * o[2] + o[3] * o[3];
#pragma unroll
            for (int mm = 1; mm < 32; mm <<= 1) ss += __shfl_xor(ss, mm);
            const float rstd = rsqrtf(ss * (1.f / 128.f) + EPS);
            const f32x4 oc = ld_bf4(PB + (rb + s) * NPB + PB_OC + h * 128 + v0);
            f32x4 r;
#pragma unroll
            for (int j = 0; j < 4; ++j) r[j] = o[j] * rstd * mn[v0 + j] * sigmoidf_(oc[j]);
            st_bf4(UC + (rb + s) * 512 + h * 128 + v0, r);
        }
    }
    __syncthreads();
}
__device__ __forceinline__ void phase_scans(const Ctx& c, int l) {
    for (int it = c.bid; it < 128; it += c.nblk) {
        if (it < 64) scan_gla_item(c, l, it >> 2, it & 3);
        else scan_mlstm_item(c, l, (it - 64) >> 2, (it - 64) & 3);
    }
}

__device__ __forceinline__ unsigned ord_key(float f) { const unsigned u = __builtin_bit_cast(unsigned, f); return (u & 0x80000000u) ? ~u : (u | 0x80000000u); }
__device__ __forceinline__ void phase_dsa(const Ctx& c, int l) {
    LAS unsigned char* wl = c.lds + c.wave * 14336;
    LAS float* I_s = (LAS float*)wl;
    LAS int* list = (LAS int*)(wl + 8192);
    LAS float* qi_s = (LAS float*)(wl + 9216);
    LAS float* ql_s = (LAS float*)(wl + 10240);
    const bf16* QLAT = (const bf16*)(c.ws + WS_QLAT); const bf16* QIDX = (const bf16*)(c.ws + WS_QIDX);
    const bf16* CKVN = (const bf16*)(c.ws + WS_CKVN); const float* SM = (const float*)(c.ws + WS_SM);
    bf16* OLAT = (bf16*)(c.ws + WS_OLAT);
    const int gw = c.bid * NWAVES + c.wave, NGW = c.nblk * NWAVES, lane = c.lane;
    for (int tq = gw; tq < T; tq += NGW) {
        const int b = tq >> 11, pos = tq & 2047, nvalid = pos + 1;
        const size_t kb = (size_t)b * SEQ;
        { const f32x4 q = ld_bf4(QIDX + (size_t)tq * 256 + 4 * lane); *(LAS f32x4*)(qi_s + 4 * lane) = q;
#pragma unroll
          for (int j = 0; j < 4; ++j) { const f32x4 ql = ld_bf4(QLAT + (size_t)tq * 1024 + 4 * (lane + 64 * j)); *(LAS f32x4*)(ql_s + 4 * (lane + 64 * j)) = ql; } }
        float wh[8];
#pragma unroll
        for (int hh = 0; hh < 8; ++hh) wh[hh] = SM[(size_t)tq * 128 + SM_WIDX + hh] * 0.35355339059327373f;
        asm volatile("s_waitcnt lgkmcnt(0)" ::: "memory");
        int nsel;
        if (nvalid <= DSA_K) {
            for (int i = lane; i < DSA_K; i += 64) list[i] = i;
            nsel = nvalid;
        } else {
            const int nj = (nvalid + 63) >> 6;
            for (int j = 0; j < nj; ++j) {
                const int s = lane + 64 * j;
                float val = -INFINITY;
                if (s < nvalid) {
                    const float* kr = SM + (kb + s) * 128 + SM_KIDX;
                    f32x4 kk[8];
#pragma unroll
                    for (int i = 0; i < 8; ++i) kk[i] = *(const f32x4*)(kr + 4 * i);
                    val = 0.f;
#pragma unroll
                    for (int hh = 0; hh < 8; ++hh) { float d = 0.f;
#pragma unroll
                        for (int i = 0; i < 8; ++i) { const f32x4 q = *(const LAS f32x4*)(qi_s + hh * 32 + 4 * i); d += q[0] * kk[i][0] + q[1] * kk[i][1] + q[2] * kk[i][2] + q[3] * kk[i][3]; }
                        val += wh[hh] * fmaxf(d, 0.f); }
                }
                I_s[s] = val;
            }
            for (int j = nj; j < 32; ++j) I_s[lane + 64 * j] = -INFINITY;
            asm volatile("s_waitcnt lgkmcnt(0)" ::: "memory");
            LAS unsigned* K_s = (LAS unsigned*)I_s;
#pragma unroll 4
            for (int j = 0; j < 32; ++j) K_s[lane + 64 * j] = ord_key(I_s[lane + 64 * j]);
            unsigned thr = 0u;
#pragma unroll 1
            for (int bit = 31; bit >= 0; --bit) {
                const unsigned cand = thr | (1u << bit); int cnt = 0;
#pragma unroll 8
                for (int j = 0; j < 32; ++j) cnt += (K_s[lane + 64 * j] >= cand) ? 1 : 0;
                cnt = wave_sum_i(cnt);
                if (cnt >= DSA_K) thr = cand;
            }
            int cgt = 0;
#pragma unroll 8
            for (int j = 0; j < 32; ++j) cgt += (K_s[lane + 64 * j] > thr) ? 1 : 0;
            cgt = wave_sum_i(cgt);
            int need = DSA_K - cgt, base = 0;
            const unsigned long long lt = (1ull << lane) - 1ull;
#pragma unroll 2
            for (int j = 0; j < 32; ++j) {
                const unsigned kj = K_s[lane + 64 * j];
                const bool gt = kj > thr, eq = kj == thr;
                const unsigned long long meq = __ballot(eq);
                const int rk = __popcll(meq & lt);
                const bool sel = gt || (eq && rk < need);
                need -= __popcll(meq); if (need < 0) need = 0;
                const unsigned long long ms = __ballot(sel);
                if (sel) list[base + __popcll(ms & lt)] = lane + 64 * j;
                base += __popcll(ms);
            }
            nsel = DSA_K;
        }
        asm volatile("s_waitcnt lgkmcnt(0)" ::: "memory");
        int ks[4]; float lg[4][8];
#pragma unroll
        for (int i = 0; i < 4; ++i) { const int li = lane + 64 * i; ks[i] = (li < nsel) ? list[li] : 0;
#pragma unroll
            for (int hh = 0; hh < 8; ++hh) lg[i][hh] = 0.f; }
#pragma unroll 1
        for (int ch = 0; ch < 16; ++ch) {
            f32x4 ka[4], kc[4];
#pragma unroll
            for (int i = 0; i < 4; ++i) { const u32x4 w = *(const u32x4*)(CKVN + (kb + ks[i]) * 128 + ch * 8);
                ka[i] = (f32x4){bflo(w.x), bfhi(w.x), bflo(w.y), bfhi(w.y)}; kc[i] = (f32x4){bflo(w.z), bfhi(w.z), bflo(w.w), bfhi(w.w)}; }
#pragma unroll
            for (int hh = 0; hh < 8; ++hh) { const f32x4 qa = *(const LAS f32x4*)(ql_s + hh * 128 + ch * 8), qb = *(const LAS f32x4*)(ql_s + hh * 128 + ch * 8 + 4);
#pragma unroll
                for (int i = 0; i < 4; ++i) lg[i][hh] += qa[0] * ka[i][0] + qa[1] * ka[i][1] + qa[2] * ka[i][2] + qa[3] * ka[i][3] + qb[0] * kc[i][0] + qb[1] * kc[i][1] + qb[2] * kc[i][2] + qb[3] * kc[i][3]; }
        }
#pragma unroll
        for (int hh = 0; hh < 8; ++hh) {
            const float slope = exp2f(-(float)(hh + 1));
            float mx = -INFINITY;
#pragma unroll
            for (int i = 0; i < 4; ++i) { const bool ok = (lane + 64 * i) < nsel; lg[i][hh] = ok ? lg[i][hh] - slope * (float)(pos - ks[i]) : -INFINITY; mx = fmaxf(mx, lg[i][hh]); }
            mx = wave_max(mx);
            float sm = 0.f;
#pragma unroll
            for (int i = 0; i < 4; ++i) { lg[i][hh] = __expf(lg[i][hh] - mx); sm += lg[i][hh]; }
            sm = wave_sum(sm);
            const float inv = 1.f / sm;
#pragma unroll
            for (int i = 0; i < 4; ++i) lg[i][hh] *= inv;
        }
#pragma unroll
        for (int i = 0; i < 4; ++i) { const int li = lane + 64 * i;
            *(LAS f32x4*)(I_s + li * 8) = (f32x4){lg[i][0], lg[i][1], lg[i][2], lg[i][3]}; *(LAS f32x4*)(I_s + li * 8 + 4) = (f32x4){lg[i][4], lg[i][5], lg[i][6], lg[i][7]}; }
        asm volatile("s_waitcnt lgkmcnt(0)" ::: "memory");
        float o0[8], o1[8];
#pragma unroll
        for (int hh = 0; hh < 8; ++hh) { o0[hh] = 0.f; o1[hh] = 0.f; }
#pragma unroll 2
        for (int kidx = 0; kidx < nsel; ++kidx) {
            const int s = list[kidx];
            const unsigned w = *(const unsigned*)(CKVN + (kb + s) * 128 + 2 * lane);
            const float v0 = bflo(w), v1 = bfhi(w);
            const f32x4 pa = *(const LAS f32x4*)(I_s + kidx * 8), pb = *(const LAS f32x4*)(I_s + kidx * 8 + 4);
            o0[0] += pa[0] * v0; o1[0] += pa[0] * v1; o0[1] += pa[1] * v0; o1[1] += pa[1] * v1; o0[2] += pa[2] * v0; o1[2] += pa[2] * v1; o0[3] += pa[3] * v0; o1[3] += pa[3] * v1;
            o0[4] += pb[0] * v0; o1[4] += pb[0] * v1; o0[5] += pb[1] * v0; o1[5] += pb[1] * v1; o0[6] += pb[2] * v0; o1[6] += pb[2] * v1; o0[7] += pb[3] * v0; o1[7] += pb[3] * v1;
        }
#pragma unroll
        for (int hh = 0; hh < 8; ++hh) *(unsigned*)(OLAT + (size_t)tq * 1024 + hh * 128 + 2 * lane) = pk2(o0[hh], o1[hh]);
        asm volatile("s_waitcnt lgkmcnt(0)" ::: "memory");
    }
}

__device__ __forceinline__ void route_one(int t, float logit, float rbias, int lane, unsigned* CNT, int* ROWL, float* WL, unsigned* TOKPOS) {
    const float score = sigmoidf_(logit), sel = score + rbias;
    const int g = lane >> 3;
    int rk8 = 0;
#pragma unroll
    for (int d = 1; d < 8; ++d) { const int ol = (lane & ~7) | ((lane + d) & 7); const float o = __shfl(sel, ol); rk8 += (o > sel || (o == sel && ol < lane)) ? 1 : 0; }
    float t2 = rk8 < 2 ? sel : 0.f;
    t2 += __shfl_xor(t2, 1); t2 += __shfl_xor(t2, 2); t2 += __shfl_xor(t2, 4);
    int rkg = 0;
#pragma unroll
    for (int d = 1; d < 8; ++d) { const int og = (g + d) & 7; const float o = __shfl(t2, og * 8); rkg += (o > t2 || (o == t2 && og < g)) ? 1 : 0; }
    const bool gsel = rkg < 4;
    bool chosen = false; float cur = gsel ? sel : -INFINITY;
#pragma unroll 1
    for (int it6 = 0; it6 < TOPK; ++it6) {
        const float mx = wave_max(cur);
        const unsigned long long me = __ballot(cur == mx);
        const int win = __ffsll((long long)me) - 1;
        if (lane == win) { chosen = true; cur = -INFINITY; }
    }
    const float wsum = wave_sum(chosen ? score : 0.f);
    const unsigned long long mk = __ballot(chosen);
    if (chosen) {
        const int hf = t >= HALF_T ? 1 : 0;
        const int kk = __popcll(mk & ((1ull << lane) - 1ull));
        const unsigned slot = atomicAdd(&CNT[hf * 64 + lane], 1u);
        ROWL[((size_t)hf * 64 + lane) * 16384 + slot] = t;
        WL[((size_t)hf * 64 + lane) * 16384 + slot] = score / wsum * 2.5f;
        if (kk < TOPK) TOKPOS[(size_t)t * 6 + kk] = ((unsigned)lane << 16) | slot;
    }
}
__device__ __forceinline__ void phase_route(const Ctx& c, int l, const float* x1) {
    {
        LAS float* scr = (LAS float*)(c.lds + c.wave * 16384);
        const int gw = c.bid * NWAVES + c.wave, NGW = c.nblk * NWAVES;
        constexpr int I_GU = (512 / 32) * (1024 / 64), I_D = (1024 / 32) * (256 / 64), PER_E = I_GU + I_D;
        for (int it = gw; it < NEX * PER_E; it += NGW) {
            const int e = it / PER_E; int r = it % PER_E;
            if (r < I_GU) {
                const int n0 = (r / 16) * 32, pn = n0 >> 8, wi = n0 & 255, j0 = 128 * pn + (wi & 127);
                const float* Wg; const float* Wu;
                if (e < NE) { Wg = c.in[IN_EWG] + ((size_t)l * NE + e) * 1024 * 256; Wu = c.in[IN_EWU] + ((size_t)l * NE + e) * 1024 * 256; }
                else { Wg = c.in[IN_SWG] + (size_t)l * 1024 * 256; Wu = c.in[IN_SWU] + (size_t)l * 1024 * 256; }
                if (wi < 128) { SrcPlain s{Wg + j0 - n0, 256}; tr_item(s, (bf16*)(c.ws + WS_WGU) + (size_t)e * 512 * 1024, 1024, n0, (r % 16) * 64, scr, c.lane); }
                else { SrcPlain s{Wu + j0 - n0, 256}; tr_item(s, (bf16*)(c.ws + WS_WGU) + (size_t)e * 512 * 1024, 1024, n0, (r % 16) * 64, scr, c.lane); }
            } else { r -= I_GU;
                SrcPlain s; s.ld = 1024; s.W = e < NE ? c.in[IN_EWD] + ((size_t)l * NE + e) * 256 * 1024 : c.in[IN_SWD] + (size_t)l * 256 * 1024;
                tr_item(s, (bf16*)(c.ws + WS_WD) + (size_t)e * 1024 * 256, 256, (r / 4) * 32, (r % 4) * 64, scr, c.lane);
            }
        }
    }
    __syncthreads();
    {
        LAS float* h_s = (LAS float*)(c.lds + c.wave * 16384);
        const int gw = c.bid * NWAVES + c.wave, NGW = c.nblk * NWAVES, lane = c.lane;
        const float* MOD = (const float*)(c.ws + WS_MOD) + (size_t)l * 16 * 6144;
        bf16* XN2 = (bf16*)(c.ws + WS_XN2);
        const float* RW = c.in[IN_RW] + (size_t)l * 1024 * 64; const float rbias = c.in[IN_RB][l * 64 + lane];
        unsigned* CNT = (unsigned*)(c.ws + WS_CTL) + CW_CNT + l * 128;
        int* ROWL = (int*)(c.ws + WS_ROWL); float* WL = (float*)(c.ws + WS_WL); unsigned* TOKPOS = (unsigned*)(c.ws + WS_TOKPOS);
        for (int it = gw; it < T / 4; it += NGW) {
            const int t0 = it * 4, b = t0 >> 11;
            const float* gain = c.in[IN_NFFN] + l * D; const float* sh = MOD + (size_t)b * 6144 + 3072; const float* sc = MOD + (size_t)b * 6144 + 4096;
#pragma unroll
            for (int r = 0; r < 4; ++r) {
                const float* xrow = x1 + (size_t)(t0 + r) * D;
                f32x4 v[4]; float s = 0.f;
#pragma unroll
                for (int j = 0; j < 4; ++j) { v[j] = *(const f32x4*)(xrow + 4 * (lane + 64 * j)); s += v[j][0] * v[j][0] + v[j][1] * v[j][1] + v[j][2] * v[j][2] + v[j][3] * v[j][3]; }
                const float rstd = rsqrtf(wave_sum(s) * (1.f / D) + EPS);
#pragma unroll
                for (int j = 0; j < 4; ++j) { const int cc = 4 * (lane + 64 * j);
                    const f32x4 g = *(const f32x4*)(gain + cc), a = *(const f32x4*)(sc + cc), bb = *(const f32x4*)(sh + cc);
                    const f32x4 hv = v[j] * rstd * g * (a + 1.f) + bb;
                    st_bf4(XN2 + (size_t)(t0 + r) * D + cc, hv); *(LAS f32x4*)(h_s + r * 1024 + cc) = hv; }
            }
            asm volatile("s_waitcnt lgkmcnt(0)" ::: "memory");
            float lg[4] = {0.f, 0.f, 0.f, 0.f};
#pragma unroll 2
            for (int k = 0; k < 1024; k += 4) {
                const float w0 = RW[(size_t)k * 64 + lane], w1 = RW[(size_t)(k + 1) * 64 + lane], w2 = RW[(size_t)(k + 2) * 64 + lane], w3 = RW[(size_t)(k + 3) * 64 + lane];
#pragma unroll
                for (int r = 0; r < 4; ++r) { const f32x4 hv = *(const LAS f32x4*)(h_s + r * 1024 + k); lg[r] += hv[0] * w0 + hv[1] * w1 + hv[2] * w2 + hv[3] * w3; }
            }
            route_one(t0 + 0, lg[0], rbias, lane, CNT, ROWL, WL, TOKPOS);
            route_one(t0 + 1, lg[1], rbias, lane, CNT, ROWL, WL, TOKPOS);
            route_one(t0 + 2, lg[2], rbias, lane, CNT, ROWL, WL, TOKPOS);
            route_one(t0 + 3, lg[3], rbias, lane, CNT, ROWL, WL, TOKPOS);
        }
    }
}

__device__ __forceinline__ void moe_tables(const Ctx& c, int l, int hf) {
    LAS int* cnt = (LAS int*)(c.lds + 140000); LAS int* off = cnt + 65; LAS int* tst = off + 65;
    __syncthreads();
    if (c.tid == 0) {
        const unsigned* CNT = (const unsigned*)(c.ws + WS_CTL) + CW_CNT + l * 128 + hf * 64;
        int o = 0, ts = 0;
        for (int e = 0; e < NEX; ++e) { const int n = e < NE ? (int)CNT[e] : HALF_T; cnt[e] = n; off[e] = o; tst[e] = ts; o += (n + 255) & ~255; ts += (n + 127) >> 7; }
        tst[NEX] = ts;
    }
    __syncthreads();
}
__device__ __forceinline__ void phase_gemm1(const Ctx& c, int l, int hf) {
    moe_tables(c, l, hf);
    LAS int* cnt = (LAS int*)(c.lds + 140000); LAS int* off = cnt + 65; LAS int* tst = off + 65;
    const int nu = tst[NEX] * 2;
    const bf16* XN2 = (const bf16*)(c.ws + WS_XN2); bf16* HID = (bf16*)(c.ws + WS_HID);
    for (int u = c.bid; u < nu; u += c.nblk) {
        const int rt = u >> 1, pn = u & 1;
        int e = 0; while (tst[e + 1] <= rt) ++e;
        const int r0 = (rt - tst[e]) * 128;
        const bf16* Bt = (const bf16*)(c.ws + WS_WGU) + (size_t)e * 512 * 1024 + (size_t)pn * 256 * 1024;
        if (e < NE) {
            const int* rl = (const int*)(c.ws + WS_ROWL) + ((size_t)hf * 64 + e) * 16384;
            const float* wl = (const float*)(c.ws + WS_WL) + ((size_t)hf * 64 + e) * 16384;
            EpiG1 E{HID, wl, cnt[e], off[e]};
            sgemm_unit(c, XN2, 1024, rl, cnt[e], r0, Bt, 1024, E, r0, pn * 256);
        } else {
            EpiG1 E{HID, nullptr, cnt[e], off[e]};
            sgemm_unit(c, XN2 + (size_t)hf * HALF_T * 1024, 1024, nullptr, 0, r0, Bt, 1024, E, r0, pn * 256);
        }
    }
    __syncthreads();
}
__device__ __forceinline__ void phase_gemm2(const Ctx& c, int l, int hf) {
    moe_tables(c, l, hf);
    LAS int* cnt = (LAS int*)(c.lds + 140000); LAS int* off = cnt + 65; LAS int* tst = off + 65;
    const int nu = tst[NEX] * 4;
    const bf16* HID = (const bf16*)(c.ws + WS_HID); bf16* Y = (bf16*)(c.ws + WS_Y);
    for (int u = c.bid; u < nu; u += c.nblk) {
        const int rt = u >> 2, pn = u & 3;
        int e = 0; while (tst[e + 1] <= rt) ++e;
        const int r0 = (rt - tst[e]) * 128;
        const bf16* Bt = (const bf16*)(c.ws + WS_WD) + (size_t)e * 1024 * 256 + (size_t)pn * 256 * 256;
        EpiG2 E{Y, off[e]};
        sgemm_unit(c, HID + (size_t)off[e] * 256, 256, nullptr, 0, r0, Bt, 256, E, r0, pn * 256);
    }
    __syncthreads();
}
__device__ __forceinline__ void phase_combine(const Ctx& c, int l, int hf, float* xio) {
    moe_tables(c, l, hf);
    LAS int* off = (LAS int*)(c.lds + 140000) + 65;
    const int gw = c.bid * NWAVES + c.wave, NGW = c.nblk * NWAVES, lane = c.lane;
    const bf16* Y = (const bf16*)(c.ws + WS_Y); const unsigned* TOKPOS = (const unsigned*)(c.ws + WS_TOKPOS);
    const float* MODl = (const float*)(c.ws + WS_MOD) + (size_t)l * 16 * 6144;
    const float* MODn = (const float*)(c.ws + WS_MOD) + (size_t)1 * 16 * 6144;
    bf16* XN = (bf16*)(c.ws + WS_XN);
    for (int tt = gw; tt < HALF_T; tt += NGW) {
        const int t = hf * HALF_T + tt, b = t >> 11;
        f32x4 acc[4];
        { const bf16* yr = Y + (size_t)(off[NE] + tt) * 1024;
#pragma unroll
          for (int j = 0; j < 4; ++j) acc[j] = ld_bf4(yr + 4 * (lane + 64 * j)); }
#pragma unroll
        for (int kk = 0; kk < TOPK; ++kk) {
            const unsigned tp = TOKPOS[(size_t)t * 6 + kk]; const int e = tp >> 16, slot = tp & 0xffff;
            const bf16* yr = Y + (size_t)(off[e] + slot) * 1024;
#pragma unroll
            for (int j = 0; j < 4; ++j) acc[j] += ld_bf4(yr + 4 * (lane + 64 * j));
        }
        float* xr = xio + (size_t)t * D; const float* g2 = MODl + (size_t)b * 6144 + 5120;
        f32x4 v[4]; float s = 0.f;
#pragma unroll
        for (int j = 0; j < 4; ++j) { const int cc = 4 * (lane + 64 * j); v[j] = *(const f32x4*)(xr + cc) + *(const f32x4*)(g2 + cc) * acc[j]; s += v[j][0] * v[j][0] + v[j][1] * v[j][1] + v[j][2] * v[j][2] + v[j][3] * v[j][3]; }
        const float rstd = rsqrtf(wave_sum(s) * (1.f / D) + EPS);
        if (l == 0) {
#pragma unroll
            for (int j = 0; j < 4; ++j) { const int cc = 4 * (lane + 64 * j); *(f32x4*)(xr + cc) = v[j];
                const f32x4 g = *(const f32x4*)(c.in[IN_NMIX] + D + cc), a = *(const f32x4*)(MODn + (size_t)b * 6144 + 1024 + cc), bb = *(const f32x4*)(MODn + (size_t)b * 6144 + cc);
                st_bf4(XN + (size_t)t * D + cc, v[j] * rstd * g * (a + 1.f) + bb); }
        } else {
#pragma unroll
            for (int j = 0; j < 4; ++j) { const int cc = 4 * (lane + 64 * j); *(f32x4*)(xr + cc) = v[j] * rstd * *(const f32x4*)(c.in[IN_NFIN] + cc); }
        }
    }
}

constexpr int PH_PER_L = 18, N_PHASES = 1 + NL * PH_PER_L;
#ifndef PH_MASK
#define PH_MASK 0xFFFFFFFFu
#endif
#define IN(k) (lo <= (k) && (k) < hi)
#define EN(b) ((PH_MASK >> (b)) & 1u)
#define SEAM(k) do { if (MK_ONE_LAUNCH && IN(k) && IN((k) + 1)) xcd_barrier(bar); } while (0)
template <int l>
__device__ __forceinline__ void layer_program(const Ctx& c, const XcdBarrier& bar, int lo, int hi) {
        const int P = 1 + l * PH_PER_L;
        const float* xin = l == 0 ? c.in[IN_X] : c.out;
        bf16* PB = (bf16*)(c.ws + WS_PB); float* SM = (float*)(c.ws + WS_SM);
        const bf16* XN = (const bf16*)(c.ws + WS_XN);
        const bf16* WIN = (const bf16*)(c.ws + WS_WIN) + (size_t)l * NINP * 1024;
        if (EN(1) && IN(P + 0)) { if (l == 0) phase_norm1(c, 0, c.in[IN_X]); } SEAM(P + 0);
        if (EN(2) && IN(P + 1)) { EpiInPB E{PB, SM}; sgemm_phase(c, XN, 1024, T, WIN, NPB / 256, 1024, E); } SEAM(P + 1);
        if (EN(3) && IN(P + 2)) { phase_prep(c, l); } SEAM(P + 2);
        if (EN(4) && IN(P + 3)) { phase_scans(c, l); } SEAM(P + 3);
        if (EN(5) && IN(P + 4)) { EpiQ E{(bf16*)(c.ws + WS_QLAT), (bf16*)(c.ws + WS_QIDX), (const float*)(c.ws + WS_RSTDQ)};
            sgemm_phase(c, PB + PB_CQ, NPB, T, (const bf16*)(c.ws + WS_WQ) + (size_t)l * 1280 * 256, 5, 256, E); } SEAM(P + 4);
        if (EN(6) && IN(P + 5)) { EpiGate E{(bf16*)(c.ws + WS_G)}; sgemm_phase(c, XN, 1024, T, WIN + (size_t)NPB * 1024, NG / 256, 1024, E); } SEAM(P + 5);
        if (EN(7) && IN(P + 6)) { phase_dsa(c, l); } SEAM(P + 6);
        if (EN(8) && IN(P + 7)) { EpiUp E{(bf16*)(c.ws + WS_M1), (const bf16*)(c.ws + WS_G), 0, 1};
            sgemm_phase(c, (const bf16*)(c.ws + WS_UA), 512, T, (const bf16*)(c.ws + WS_WUPA) + (size_t)l * 1024 * 512, 4, 512, E); } SEAM(P + 7);
        if (EN(9) && IN(P + 8)) { EpiUp E{(bf16*)(c.ws + WS_M1), (const bf16*)(c.ws + WS_G), 1024, 0};
            sgemm_phase(c, (const bf16*)(c.ws + WS_OLAT), 1024, T, (const bf16*)(c.ws + WS_WUVB) + (size_t)l * 1024 * 1024, 4, 1024, E); } SEAM(P + 8);
        if (EN(10) && IN(P + 9)) { EpiUp E{(bf16*)(c.ws + WS_M1), (const bf16*)(c.ws + WS_G), 2048, 0};
            sgemm_phase(c, (const bf16*)(c.ws + WS_UC), 512, T, (const bf16*)(c.ws + WS_WUPC) + (size_t)l * 1024 * 512, 4, 512, E); } SEAM(P + 9);
        if (EN(11) && IN(P + 10)) { EpiWo E{xin, c.out, (const float*)(c.ws + WS_MOD) + (size_t)l * 16 * 6144 + 2048};
            sgemm_phase(c, (const bf16*)(c.ws + WS_M1), 1024, T, (const bf16*)(c.ws + WS_WO) + (size_t)l * 1024 * 1024, 4, 1024, E); } SEAM(P + 10);
        if (EN(12) && IN(P + 11)) { phase_route(c, l, c.out); } SEAM(P + 11);
        if (EN(13) && IN(P + 12)) { phase_gemm1(c, l, 0); } SEAM(P + 12);
        if (EN(14) && IN(P + 13)) { phase_gemm2(c, l, 0); } SEAM(P + 13);
        if (EN(15) && IN(P + 14)) { phase_combine(c, l, 0, c.out); } SEAM(P + 14);
        if (EN(16) && IN(P + 15)) { phase_gemm1(c, l, 1); } SEAM(P + 15);
        if (EN(17) && IN(P + 16)) { phase_gemm2(c, l, 1); } SEAM(P + 16);
        if (EN(18) && IN(P + 17)) { phase_combine(c, l, 1, c.out); } SEAM(P + 17);
    }
__global__ void __launch_bounds__(NTHR, 2) fwd(Args args) {
    extern __shared__ __attribute__((aligned(16))) unsigned char lds_raw[];
    Ctx c;
    c.lds = (LAS unsigned char*)lds_raw;
    c.tid = threadIdx.x; c.lane = c.tid & 63; c.wave = __builtin_amdgcn_readfirstlane(c.tid >> 6);
    c.bid = blockIdx.x; c.nblk = gridDim.x;
    c.in = args.in; c.out = args.out; c.ws = args.ws;
    for (int u = c.tid; u < (LDS_BYTES - LDS_MISC) / 4; u += NTHR) ((LAS unsigned*)(c.lds + LDS_MISC))[u] = 0u;
    __syncthreads();
    XcdBarrier bar; bar.bar = (unsigned*)(c.ws + WS_CTL) + CW_BAR; bar.x = 0; bar.st = (volatile LAS unsigned*)(c.lds + LDS_MISC);
    if (MK_ONE_LAUNCH) bar = xcd_barrier_post((unsigned*)(c.ws + WS_CTL) + CW_BAR, (volatile LAS unsigned*)(c.lds + LDS_MISC));
    const int lo = args.ph_lo, hi = args.ph_hi;
    if (EN(0) && IN(0)) { phase_prologue(c); } SEAM(0);
    layer_program<0>(c, bar, lo, hi);
    layer_program<1>(c, bar, lo, hi);
#undef IN
#undef SEAM
}

extern "C" void kernel_launch(void* const* d_in, const int* in_sizes, int n_in, void* d_out, int out_size, void* d_ws, size_t ws_size, hipStream_t stream) {
    static int grid = 0;
    if (grid == 0) {
        if (n_in != 33 || out_size != T * D || ws_size < WS_END) { fprintf(stderr, "kernel_launch: unexpected problem (n_in %d out %d ws %zu)\n", n_in, out_size, ws_size); grid = -1; return; }
        int dev = 0, cus = 0, per_cu = 0;
        if (hipGetDevice(&dev) != hipSuccess || hipDeviceGetAttribute(&cus, hipDeviceAttributeMultiprocessorCount, dev) != hipSuccess) { grid = -1; return; }
        if (hipFuncSetAttribute((const void*)fwd, hipFuncAttributeMaxDynamicSharedMemorySize, LDS_BYTES) != hipSuccess) { fprintf(stderr, "kernel_launch: hipFuncSetAttribute failed\n"); grid = -1; return; }
        if (hipOccupancyMaxActiveBlocksPerMultiprocessor(&per_cu, (const void*)fwd, NTHR, LDS_BYTES) != hipSuccess || per_cu < 1) { fprintf(stderr, "kernel_launch: occupancy query says %d\n", per_cu); }
        (void)hipGetLastError();
        grid = cus;
    }
    if (grid < 0) return;
    (void)hipMemsetAsync((char*)d_ws + WS_CTL, 0, CTL_BYTES, stream);
    Args a{};
    for (int i = 0; i < 33; ++i) a.in[i] = (const float*)d_in[i];
    a.out = (float*)d_out; a.ws = (unsigned char*)d_ws;
#if MK_ONE_LAUNCH
    a.ph_lo = 0; a.ph_hi = N_PHASES;
    hipLaunchKernelGGL(fwd, dim3(grid), dim3(NTHR), LDS_BYTES, stream, a);
#else
    for (int p = 0; p < N_PHASES; ++p) {
        if (p == 1 + PH_PER_L) continue;
        a.ph_lo = p; a.ph_hi = p + 1;
        hipLaunchKernelGGL(fwd, dim3(grid), dim3(NTHR), LDS_BYTES, stream, a);
    }
#endif
}
```

```cpp
#include <hip/hip_runtime.h>
#include <cstdio>
#include <cstdint>

#define LAS __attribute__((address_space(3)))
#define GAS __attribute__((address_space(1)))
typedef unsigned short bf16;
typedef short bf16x8 __attribute__((ext_vector_type(8)));
typedef float f32x4 __attribute__((ext_vector_type(4)));
typedef float f32x2 __attribute__((ext_vector_type(2)));
typedef unsigned u32x4 __attribute__((ext_vector_type(4)));
typedef unsigned u32x2 __attribute__((ext_vector_type(2)));
typedef GAS unsigned gu32;

#ifndef MK_ONE_LAUNCH
#define MK_ONE_LAUNCH 1
#endif

constexpr int NB = 16, SEQ = 2048, D = 1024, T = NB * SEQ, NL = 2;
constexpr int NIN = 6592, NPB = 3584, NG = 3072, NINP = NPB + NG;
constexpr int NE = 64, NEX = 65, EFF = 256, TOPK = 6;
constexpr int HALF_T = T / 2;
constexpr int DSA_K = 256;
constexpr float EPS = 1e-6f;
constexpr int NTHR = 512, NWAVES = 8;

constexpr int PB_QA = 0, PB_KA = 256, PB_VA = 512, PB_GA = 1024, PB_CQ = 1536, PB_CKV = 1792, PB_QC = 2048, PB_KC = 2304, PB_VC = 2560, PB_OC = 3072;
constexpr int SM_KIDX = 0, SM_ALR = 32, SM_WIDX = 48, SM_IC = 56, SM_FC = 60;

constexpr size_t MiB = 1u << 20;
constexpr size_t WS_CTL = 0, CTL_BYTES = 1 * MiB;
constexpr size_t WS_MOD = 1 * MiB;
constexpr size_t WS_RSTDQ = 2 * MiB;
constexpr size_t WS_TOKPOS = 3 * MiB;
constexpr size_t WS_WIN = 4 * MiB;
constexpr size_t WS_WQ = 30 * MiB;
constexpr size_t WS_WUPA = 32 * MiB;
constexpr size_t WS_WUPC = 34 * MiB;
constexpr size_t WS_WUVB = 36 * MiB;
constexpr size_t WS_WO = 40 * MiB;
constexpr size_t WS_WGU = 44 * MiB;
constexpr size_t WS_WD = 109 * MiB;
constexpr size_t WS_XN = 142 * MiB;
constexpr size_t WS_OLAT = WS_XN;
constexpr size_t WS_UA = 206 * MiB;
constexpr size_t WS_UC = 238 * MiB;
constexpr size_t WS_XN2 = 206 * MiB;
constexpr size_t WS_QLAT = 270 * MiB;
constexpr size_t WS_M1 = WS_QLAT;
constexpr size_t WS_QIDX = 334 * MiB;
constexpr size_t WS_CKVN = 350 * MiB;
constexpr size_t WS_KIDX = 358 * MiB;
constexpr size_t WS_SM = 360 * MiB;
constexpr size_t WS_PB = 376 * MiB;
constexpr size_t WS_G = WS_PB;
constexpr size_t WS_HID = 270 * MiB;
constexpr size_t WS_Y = 334 * MiB;
constexpr size_t WS_ROWL = 590 * MiB;
constexpr size_t WS_WL = 598 * MiB;
constexpr size_t WS_END = 606 * MiB;
static_assert(WS_PB + (size_t)T * NPB * 2 <= 600 * MiB, "PB");
static_assert(WS_Y + (size_t)131072 * 1024 * 2 <= WS_ROWL, "Y");

constexpr int CW_BAR = 4096;
constexpr int CW_CNT = 16384;

constexpr int LDS_BYTES = 147456;
constexpr int LDS_MISC = 145408;

__device__ __forceinline__ unsigned f2bf(float f) { unsigned u = __builtin_bit_cast(unsigned, f); return (u + 0x7fffu + ((u >> 16) & 1u)) >> 16; }
__device__ __forceinline__ float bf2f(unsigned b) { return __builtin_bit_cast(float, b << 16); }
__device__ __forceinline__ unsigned pk2(float lo, float hi) { return f2bf(lo) | (f2bf(hi) << 16); }
__device__ __forceinline__ float bflo(unsigned w) { return __builtin_bit_cast(float, w << 16); }
__device__ __forceinline__ float bfhi(unsigned w) { return __builtin_bit_cast(float, w & 0xffff0000u); }
__device__ __forceinline__ float wave_sum(float v) {
#pragma unroll
    for (int o = 1; o < 64; o <<= 1) v += __shfl_xor(v, o);
    return v;
}
__device__ __forceinline__ float wave_max(float v) {
#pragma unroll
    for (int o = 1; o < 64; o <<= 1) v = fmaxf(v, __shfl_xor(v, o));
    return v;
}
__device__ __forceinline__ int wave_sum_i(int v) {
#pragma unroll
    for (int o = 1; o < 64; o <<= 1) v += __shfl_xor(v, o);
    return v;
}
__device__ __forceinline__ float sigmoidf_(float x) { return 1.f / (1.f + __expf(-x)); }
__device__ __forceinline__ float siluf_(float x) { return x / (1.f + __expf(-x)); }
__device__ __forceinline__ float logsigmoidf_(float x) { return fminf(x, 0.f) - log1pf(__expf(-fabsf(x))); }
__device__ __forceinline__ void st_bf4(bf16* p, f32x4 v) { u32x2 w; w.x = pk2(v[0], v[1]); w.y = pk2(v[2], v[3]); *(u32x2*)p = w; }
__device__ __forceinline__ f32x4 ld_bf4(const bf16* p) { u32x2 w = *(const u32x2*)p; return (f32x4){bflo(w.x), bfhi(w.x), bflo(w.y), bfhi(w.y)}; }

#define XB_TMO      128
#define XB_XCNT(j)  (256  + 64 * (j))
#define XB_XSUB(j)  (1280 + 64 * (j))
#define XB_XGEN(j)  (2304 + 64 * (j))
#define XB_TOP      3328
#define XB_TOPGEN   3392
#define XCD_BAR_WORDS 3456
#define XB_SPIN_CAP (1u << 22)
__device__ __forceinline__ unsigned xb_ld(unsigned* p)              { return __hip_atomic_load(p, __ATOMIC_RELAXED, __HIP_MEMORY_SCOPE_AGENT); }
__device__ __forceinline__ unsigned xb_add(unsigned* p, unsigned v) { return __hip_atomic_fetch_add(p, v, __ATOMIC_RELAXED, __HIP_MEMORY_SCOPE_AGENT); }
__device__ __forceinline__ unsigned xb_xcc_id() { return (unsigned)__builtin_amdgcn_s_getreg((3 << 11) | 20) & 0xFu; }
#define XB_SPIN(cond, bar) do { unsigned _sp = 0; while (cond) { __builtin_amdgcn_s_sleep(1); \
    if ((++_sp & 255u) == 0u) { if (xb_ld(&(bar)[XB_TMO])) break; if (_sp > XB_SPIN_CAP) { atomicAdd(&(bar)[XB_TMO], 1u); break; } } } } while (0)
struct XcdBarrier { unsigned* bar; unsigned x; volatile LAS unsigned* st; };
__device__ __forceinline__ XcdBarrier xcd_barrier_post(unsigned* bar, volatile LAS unsigned* st) {
    XcdBarrier b; b.bar = bar; b.x = xb_xcc_id(); b.st = st;
    if (threadIdx.x == 0) (void)xb_add(&bar[XB_XCNT(b.x)], 1u);
    return b;
}
__device__ __forceinline__ void xcd_barrier_complete(unsigned* bar, unsigned x, unsigned& nloc, unsigned& nx) {
    const unsigned G = gridDim.x * gridDim.y * gridDim.z;
    unsigned sum, cnt, mine, sp = 0u;
    for (;;) {
        sum = 0u; cnt = 0u; mine = 0u;
#pragma unroll
        for (unsigned j = 0; j < 16; ++j) { const unsigned c = xb_ld(&bar[XB_XCNT(j)]); sum += c; cnt += (c > 0u) ? 1u : 0u; mine = (j == x) ? c : mine; }
        if (sum == G) break;
        __builtin_amdgcn_s_sleep(1);
        if ((++sp & 255u) == 0u) { if (xb_ld(&bar[XB_TMO])) break; if (sp > XB_SPIN_CAP) { atomicAdd(&bar[XB_TMO], 1u); break; } }
    }
    nloc = mine > 0u ? mine : 1u; nx = cnt > 0u ? cnt : 1u;
}
__device__ __forceinline__ void xcd_barrier(const XcdBarrier& b) {
    asm volatile("s_waitcnt vmcnt(0)" ::: "memory");
    __syncthreads();
    if (threadIdx.x == 0) {
        unsigned* bar = b.bar;
        __builtin_amdgcn_s_waitcnt(0);
        unsigned nloc = b.st[0], nx = b.st[1];
        if (nloc == 0u) { xcd_barrier_complete(bar, b.x, nloc, nx); b.st[0] = nloc; b.st[1] = nx; }
        const unsigned old = xb_add(&bar[XB_XSUB(b.x)], 1u);
        const unsigned gen = old / nloc;
        if (old + 1u == (gen + 1u) * nloc) {
            __builtin_amdgcn_fence(__ATOMIC_RELEASE, "agent");
            asm volatile("s_waitcnt vmcnt(0)" ::: "memory");
            const unsigned og = xb_add(&bar[XB_TOP], 1u);
            const unsigned tg = og / nx;
            if (og + 1u == (tg + 1u) * nx) xb_add(&bar[XB_TOPGEN], 1u);
            else XB_SPIN(xb_ld(&bar[XB_TOPGEN]) == tg, bar);
            __builtin_amdgcn_fence(__ATOMIC_ACQUIRE, "agent");
            xb_add(&bar[XB_XGEN(b.x)], 1u);
            asm volatile("s_waitcnt vmcnt(0)" ::: "memory");
        } else {
            XB_SPIN(xb_ld(&bar[XB_XGEN(b.x)]) == gen, bar);
            __builtin_amdgcn_fence(__ATOMIC_ACQUIRE, "agent");
            asm volatile("s_waitcnt vmcnt(0)" ::: "memory");
        }
    }
    __syncthreads();
}

struct Args { const float* in[33]; float* out; unsigned char* ws; int ph_lo, ph_hi; };

struct Ctx {
    LAS unsigned char* lds;
    int tid, lane, wave, bid, nblk;
    const float* const* in;
    float* out; unsigned char* ws;
};
#define IN_X 0
#define IN_C 1
#define IN_ADAW 2
#define IN_ADAB 3
#define IN_NMIX 4
#define IN_NFFN 5
#define IN_WIN 6
#define IN_GLA_WA2 7
#define IN_GLA_BA 8
#define IN_GLA_NORM 9
#define IN_DSA_NQ 10
#define IN_DSA_NKV 11
#define IN_DSA_WUQ 12
#define IN_DSA_WUK 13
#define IN_DSA_WUV 14
#define IN_DSA_WQI 15
#define IN_ML_CONV 16
#define IN_ML_BI 17
#define IN_ML_BF 18
#define IN_ML_NORM 19
#define IN_WUPA 20
#define IN_WUPB 21
#define IN_WUPC 22
#define IN_WO 23
#define IN_RW 24
#define IN_RB 25
#define IN_EWG 26
#define IN_EWU 27
#define IN_EWD 28
#define IN_SWG 29
#define IN_SWU 30
#define IN_SWD 31
#define IN_NFIN 32

template <class SrcF>
__device__ __forceinline__ void tr_item(const SrcF& src, bf16* dst, int dst_ld, int n0, int k0, LAS float* scr, int lane) {
    const int j = lane & 31;
    const float* colp = src(n0 + j);
    const long ld = src.ld;
#pragma unroll 8
    for (int i = 0; i < 32; ++i) { const int kk = 2 * i + (lane >> 5); scr[kk * 33 + j] = colp ? colp[(long)(k0 + kk) * ld] : 0.f; }
    asm volatile("s_waitcnt lgkmcnt(0)" ::: "memory");
    const int c = lane & 7;
#pragma unroll
    for (int jj = 0; jj < 4; ++jj) { const int n = (lane >> 3) + 8 * jj; const LAS float* s = scr + (8 * c) * 33 + n;
        u32x4 o; o.x = pk2(s[0 * 33], s[1 * 33]); o.y = pk2(s[2 * 33], s[3 * 33]); o.z = pk2(s[4 * 33], s[5 * 33]); o.w = pk2(s[6 * 33], s[7 * 33]);
        *(u32x4*)(dst + (size_t)(n0 + n) * dst_ld + k0 + 8 * c) = o; }
    asm volatile("s_waitcnt lgkmcnt(0)" ::: "memory");
}
struct SrcPlain { const float* W; long ld; __device__ __forceinline__ const float* operator()(int n) const { return W + n; } };
__device__ __forceinline__ int win_src_col(int r) {
    if (r < 1536) return r;
    if (r < 1792) return 1552 + (r - 1536);
    if (r < 1920) return 1808 + (r - 1792);
    if (r < 1952) return 1936 + (r - 1920);
    if (r < 1968) return 1536 + (r - 1952);
    if (r < 1976) return 1968 + (r - 1968);
    if (r < 1980) return 3000 + (r - 1976);
    if (r < 1984) return 3004 + (r - 1980);
    if (r < 2048) return -1;
    if (r < 2560) return 1976 + (r - 2048);
    if (r < 3072) return 2488 + (r - 2560);
    if (r < 3584) return 3008 + (r - 3072);
    return 3520 + (r - 3584);
}
struct SrcWin { const float* W; long ld; __device__ __forceinline__ const float* operator()(int n) const { const int c = win_src_col(n); return c < 0 ? nullptr : W + c; } };
struct SrcGU { const float* Wg; const float* Wu; long ld;
    __device__ __forceinline__ const float* operator()(int r) const { const int pn = r >> 8, w = r & 255, j = 128 * pn + (w & 127); return (w < 128 ? Wg : Wu) + j; } };

constexpr int SG_LD = 40;
template <class Epi>
__device__ __forceinline__ void sgemm_unit(const Ctx& c, const bf16* A, int lda, const int* rowlist, int nvalid, int arow0, const bf16* Bt, int K, const Epi& E, int erow0, int ecol0) {
    LAS bf16* As = (LAS bf16*)c.lds;
    LAS bf16* Bs = (LAS bf16*)(c.lds + 128 * SG_LD * 2);
    const int tid = c.tid, lane = c.lane, wave = c.wave, wr = wave >> 2, wc = wave & 3, fr = lane & 15, fq = lane >> 4;
    const int lr = tid >> 2, ch = tid & 3;
    int srow = arow0 + lr;
    if (rowlist) { srow = (arow0 + lr < nvalid) ? rowlist[arow0 + lr] : 0; }
    const bf16* ap = A + (size_t)srow * lda + ch * 8;
    const bf16* bp0 = Bt + (size_t)lr * K + ch * 8;
    const bf16* bp1 = Bt + (size_t)(128 + lr) * K + ch * 8;
    f32x4 acc[2][4][2];
#pragma unroll
    for (int a = 0; a < 2; ++a)
#pragma unroll
        for (int m = 0; m < 4; ++m)
#pragma unroll
            for (int n = 0; n < 2; ++n) acc[a][m][n] = (f32x4){0.f, 0.f, 0.f, 0.f};
    u32x4 ra = *(const u32x4*)ap, rb0 = *(const u32x4*)bp0, rb1 = *(const u32x4*)bp1;
    for (int k0 = 0; k0 < K; k0 += 32) {
        __syncthreads();
        *(LAS u32x4*)(As + lr * SG_LD + ch * 8) = ra;
        *(LAS u32x4*)(Bs + lr * SG_LD + ch * 8) = rb0;
        *(LAS u32x4*)(Bs + (128 + lr) * SG_LD + ch * 8) = rb1;
        __syncthreads();
        if (k0 + 32 < K) { ra = *(const u32x4*)(ap + k0 + 32); rb0 = *(const u32x4*)(bp0 + k0 + 32); rb1 = *(const u32x4*)(bp1 + k0 + 32); }
        bf16x8 af[4], bfr[2][2];
#pragma unroll
        for (int m = 0; m < 4; ++m) af[m] = *(const LAS bf16x8*)(As + (wr * 64 + m * 16 + fr) * SG_LD + fq * 8);
#pragma unroll
        for (int bj = 0; bj < 2; ++bj)
#pragma unroll
            for (int n = 0; n < 2; ++n) bfr[bj][n] = *(const LAS bf16x8*)(Bs + (bj * 128 + wc * 32 + n * 16 + fr) * SG_LD + fq * 8);
#pragma unroll
        for (int bj = 0; bj < 2; ++bj)
#pragma unroll
            for (int m = 0; m < 4; ++m)
#pragma unroll
                for (int n = 0; n < 2; ++n) acc[bj][m][n] = __builtin_amdgcn_mfma_f32_16x16x32_bf16(bfr[bj][n], af[m], acc[bj][m][n], 0, 0, 0);
    }
#pragma unroll
    for (int m = 0; m < 4; ++m)
#pragma unroll
        for (int n = 0; n < 2; ++n) E(erow0 + wr * 64 + m * 16 + fr, ecol0 + wc * 32 + n * 16 + 4 * fq, acc[0][m][n], acc[1][m][n]);
}
template <class Epi>
__device__ __forceinline__ void sgemm_phase(const Ctx& c, const bf16* A, int lda, int M, const bf16* Bt, int ntn, int K, const Epi& E) {
    const int nu = (M / 128) * ntn;
    for (int u = c.bid; u < nu; u += c.nblk) {
        const int pm = u / ntn, pn = u % ntn;
        sgemm_unit(c, A, lda, nullptr, 0, pm * 128, Bt + (size_t)pn * 256 * K, K, E, pm * 128, pn * 256);
    }
    __syncthreads();
}

struct EpiInPB { bf16* PB; float* SM;
    __device__ __forceinline__ void operator()(int row, int col, f32x4 lo, f32x4 hi) const {
        st_bf4(PB + (size_t)row * NPB + col, lo);
        if ((col >> 8) == 7) *(f32x4*)(SM + (size_t)row * 128 + (col & 127)) = hi;
        else st_bf4(PB + (size_t)row * NPB + col + 128, hi);
    } };
struct EpiQ { bf16* QLAT; bf16* QIDX; const float* rstd;
    __device__ __forceinline__ void operator()(int row, int col, f32x4 lo, f32x4 hi) const {
        const float r = rstd[row];
        if (col < 1024) { st_bf4(QLAT + (size_t)row * 1024 + col, lo * r); st_bf4(QLAT + (size_t)row * 1024 + col + 128, hi * r); }
        else { st_bf4(QIDX + (size_t)row * 256 + (col - 1024), lo * r); st_bf4(QIDX + (size_t)row * 256 + (col - 1024) + 128, hi * r); }
    } };
struct EpiGate { bf16* G;
    __device__ __forceinline__ void operator()(int row, int col, f32x4 lo, f32x4 hi) const {
        f32x4 a, b;
#pragma unroll
        for (int i = 0; i < 4; ++i) { a[i] = sigmoidf_(lo[i]); b[i] = sigmoidf_(hi[i]); }
        st_bf4(G + (size_t)row * NG + col, a); st_bf4(G + (size_t)row * NG + col + 128, b);
    } };
struct EpiUp { bf16* M1; const bf16* G; int goff; int first;
    __device__ __forceinline__ void operator()(int row, int col, f32x4 lo, f32x4 hi) const {
        bf16* m = M1 + (size_t)row * 1024 + col; const bf16* g = G + (size_t)row * NG + goff + col;
        f32x4 a = ld_bf4(g) * lo, b = ld_bf4(g + 128) * hi;
        if (!first) { a += ld_bf4(m); b += ld_bf4(m + 128); }
        st_bf4(m, a); st_bf4(m + 128, b);
    } };
struct EpiWo { const float* res; float* out; const float* g1;
    __device__ __forceinline__ void operator()(int row, int col, f32x4 lo, f32x4 hi) const {
        const float* gp = g1 + (size_t)(row >> 11) * 6144 + col; const size_t o = (size_t)row * 1024 + col;
        const f32x4 ga = *(const f32x4*)gp, gb = *(const f32x4*)(gp + 128);
        const f32x4 ra = *(const f32x4*)(res + o), rb = *(const f32x4*)(res + o + 128);
        *(f32x4*)(out + o) = ra + ga * lo; *(f32x4*)(out + o + 128) = rb + gb * hi;
    } };
struct EpiG1 { bf16* HID; const float* wl; int cnt; int orow0;
    __device__ __forceinline__ void operator()(int row, int col, f32x4 lo, f32x4 hi) const {
        const int hc = col - 128 * (col >> 8);
        f32x4 v = (f32x4){0.f, 0.f, 0.f, 0.f};
        if (row < cnt) { const float w = wl ? wl[row] : 1.f;
#pragma unroll
            for (int i = 0; i < 4; ++i) v[i] = siluf_(lo[i]) * hi[i] * w; }
        st_bf4(HID + (size_t)(orow0 + row) * 256 + hc, v);
    } };
struct EpiG2 { bf16* Y; int orow0;
    __device__ __forceinline__ void operator()(int row, int col, f32x4 lo, f32x4 hi) const {
        st_bf4(Y + (size_t)(orow0 + row) * 1024 + col, lo); st_bf4(Y + (size_t)(orow0 + row) * 1024 + col + 128, hi);
    } };

__device__ __forceinline__ void phase_prologue(const Ctx& c) {
    {
        LAS float* cs = (LAS float*)c.lds;
        LAS float* red = (LAS float*)(c.lds + 65536);
        const float* cin = c.in[IN_C];
        if (c.bid < 192) {
            for (int i = c.tid; i < 16 * 1024; i += NTHR) cs[i] = siluf_(cin[i]);
            __syncthreads();
        }
        float* MOD = (float*)(c.ws + WS_MOD);
        for (int it = c.bid; it < 192; it += c.nblk) {
            const int l = it / 96, cg = it % 96, col = cg * 64 + c.lane;
            const float* W = c.in[IN_ADAW] + (size_t)l * 1024 * 6144 + col;
            float acc[16];
#pragma unroll
            for (int b = 0; b < 16; ++b) acc[b] = 0.f;
            const int kbeg = c.wave * 128;
            for (int k = kbeg; k < kbeg + 128; k += 4) {
                const float w0 = W[(size_t)k * 6144], w1 = W[(size_t)(k + 1) * 6144], w2 = W[(size_t)(k + 2) * 6144], w3 = W[(size_t)(k + 3) * 6144];
#pragma unroll
                for (int b = 0; b < 16; ++b) { const f32x4 v = *(const LAS f32x4*)(cs + b * 1024 + k); acc[b] += v[0] * w0 + v[1] * w1 + v[2] * w2 + v[3] * w3; }
            }
#pragma unroll
            for (int b = 0; b < 16; ++b) red[(c.wave * 16 + b) * 64 + c.lane] = acc[b];
            __syncthreads();
            for (int i = c.tid; i < 16 * 64; i += NTHR) { const int b = i >> 6, ln = i & 63; float s = 0.f;
#pragma unroll
                for (int w = 0; w < 8; ++w) s += red[(w * 16 + b) * 64 + ln];
                MOD[((size_t)l * 16 + b) * 6144 + cg * 64 + ln] = s + c.in[IN_ADAB][l * 6144 + cg * 64 + ln]; }
            __syncthreads();
        }
        __syncthreads();
    }
    {
        LAS float* scr = (LAS float*)(c.lds + c.wave * 16384);
        const int gw = c.bid * NWAVES + c.wave, NGW = c.nblk * NWAVES;
        constexpr int I_WIN = (NINP / 32) * (1024 / 64), I_UP = (1024 / 32) * (512 / 64), I_WO = (1024 / 32) * (1024 / 64);
        constexpr int PER_L = I_WIN + 2 * I_UP + I_WO;
        for (int it = gw; it < NL * PER_L; it += NGW) {
            const int l = it / PER_L; int r = it % PER_L;
            if (r < I_WIN) { SrcWin s{c.in[IN_WIN] + (size_t)l * 1024 * NIN, NIN}; tr_item(s, (bf16*)(c.ws + WS_WIN) + (size_t)l * NINP * 1024, 1024, (r / 16) * 32, (r % 16) * 64, scr, c.lane); continue; }
            r -= I_WIN;
            if (r < I_UP) { SrcPlain s{c.in[IN_WUPA] + (size_t)l * 512 * 1024, 1024}; tr_item(s, (bf16*)(c.ws + WS_WUPA) + (size_t)l * 1024 * 512, 512, (r / 8) * 32, (r % 8) * 64, scr, c.lane); continue; }
            r -= I_UP;
            if (r < I_UP) { SrcPlain s{c.in[IN_WUPC] + (size_t)l * 512 * 1024, 1024}; tr_item(s, (bf16*)(c.ws + WS_WUPC) + (size_t)l * 1024 * 512, 512, (r / 8) * 32, (r % 8) * 64, scr, c.lane); continue; }
            r -= I_UP;
            { SrcPlain s{c.in[IN_WO] + (size_t)l * 1024 * 1024, 1024}; tr_item(s, (bf16*)(c.ws + WS_WO) + (size_t)l * 1024 * 1024, 1024, (r / 16) * 32, (r % 16) * 64, scr, c.lane); }
        }
    }
    {
        const int gt = c.bid * NTHR + c.tid, NGT = c.nblk * NTHR;
        for (int it = gt; it < NL * 1280 * 32; it += NGT) {
            const int l = it / (1280 * 32), rem = it % (1280 * 32), n = rem / 32, r0 = (rem % 32) * 8;
            const float* gq = c.in[IN_DSA_NQ] + l * 256;
            float o[8];
            if (n < 1024) {
                const int h = n >> 7, cc = n & 127;
                const float* uk = c.in[IN_DSA_WUK] + (size_t)l * 128 * 512 + (size_t)cc * 512 + h * 64;
#pragma unroll
                for (int i = 0; i < 8; ++i) { const float* uq = c.in[IN_DSA_WUQ] + (size_t)l * 256 * 512 + (size_t)(r0 + i) * 512 + h * 64; float s = 0.f;
                    for (int d = 0; d < 64; ++d) s += uq[d] * uk[d];
                    o[i] = s * 0.125f * gq[r0 + i]; }
            } else {
                const int m = n - 1024;
#pragma unroll
                for (int i = 0; i < 8; ++i) o[i] = c.in[IN_DSA_WQI][(size_t)l * 256 * 256 + (size_t)(r0 + i) * 256 + m] * 0.17677669529663687f * gq[r0 + i];
            }
            u32x4 w; w.x = pk2(o[0], o[1]); w.y = pk2(o[2], o[3]); w.z = pk2(o[4], o[5]); w.w = pk2(o[6], o[7]);
            *(u32x4*)((bf16*)(c.ws + WS_WQ) + (size_t)l * 1280 * 256 + (size_t)n * 256 + r0) = w;
        }
    }
    {
        const int gt = c.bid * NTHR + c.tid, NGT = c.nblk * NTHR;
        for (int it = gt; it < NL * 128 * 1024; it += NGT) {
            const int l = it / (128 * 1024), rem = it % (128 * 1024), kc = rem / 1024, n = rem % 1024;
            const int h = kc >> 4, r0 = (kc & 15) * 8;
            const float* uv = c.in[IN_DSA_WUV] + (size_t)l * 128 * 512;
            const float* ub = c.in[IN_WUPB] + (size_t)l * 512 * 1024 + (size_t)(h * 64) * 1024 + n;
            float o[8];
#pragma unroll
            for (int i = 0; i < 8; ++i) o[i] = 0.f;
            for (int v = 0; v < 64; ++v) { const float b = ub[(size_t)v * 1024];
#pragma unroll
                for (int i = 0; i < 8; ++i) o[i] += uv[(size_t)(r0 + i) * 512 + h * 64 + v] * b; }
            u32x4 w; w.x = pk2(o[0], o[1]); w.y = pk2(o[2], o[3]); w.z = pk2(o[4], o[5]); w.w = pk2(o[6], o[7]);
            *(u32x4*)((bf16*)(c.ws + WS_WUVB) + (size_t)l * 1024 * 1024 + (size_t)n * 1024 + h * 128 + r0) = w;
        }
    }
}

__device__ __forceinline__ void norm_mod_row(const float* xrow, const float* gain, const float* sh, const float* sc, bf16* orow, int lane) {
    f32x4 v[4]; float s = 0.f;
#pragma unroll
    for (int j = 0; j < 4; ++j) { v[j] = *(const f32x4*)(xrow + 4 * (lane + 64 * j)); s += v[j][0] * v[j][0] + v[j][1] * v[j][1] + v[j][2] * v[j][2] + v[j][3] * v[j][3]; }
    const float rstd = rsqrtf(wave_sum(s) * (1.f / D) + EPS);
#pragma unroll
    for (int j = 0; j < 4; ++j) { const int cc = 4 * (lane + 64 * j);
        const f32x4 g = *(const f32x4*)(gain + cc), a = *(const f32x4*)(sc + cc), b = *(const f32x4*)(sh + cc);
        st_bf4(orow + cc, v[j] * rstd * g * (a + 1.f) + b); }
}
__device__ __forceinline__ void phase_norm1(const Ctx& c, int l, const float* xsrc) {
    const int gw = c.bid * NWAVES + c.wave, NGW = c.nblk * NWAVES;
    const float* MOD = (const float*)(c.ws + WS_MOD) + (size_t)l * 16 * 6144;
    bf16* XN = (bf16*)(c.ws + WS_XN);
    for (int t = gw; t < T; t += NGW) { const int b = t >> 11;
        norm_mod_row(xsrc + (size_t)t * D, c.in[IN_NMIX] + l * D, MOD + (size_t)b * 6144, MOD + (size_t)b * 6144 + 1024, XN + (size_t)t * D, c.lane); }
}

__device__ __forceinline__ void phase_prep(const Ctx& c, int l) {
    const int gw = c.bid * NWAVES + c.wave, NGW = c.nblk * NWAVES;
    const bf16* PB = (const bf16*)(c.ws + WS_PB); const float* SM = (const float*)(c.ws + WS_SM);
    bf16* CKVN = (bf16*)(c.ws + WS_CKVN); bf16* KIDX = (bf16*)(c.ws + WS_KIDX); float* RSTDQ = (float*)(c.ws + WS_RSTDQ);
    const float* gkv = c.in[IN_DSA_NKV] + l * 128;
    for (int t = gw; t < T; t += NGW) {
        const bf16* row = PB + (size_t)t * NPB;
        const unsigned kv = *(const unsigned*)(row + PB_CKV + 2 * c.lane);
        const float k0 = bflo(kv), k1 = bfhi(kv);
        const float rs = rsqrtf(wave_sum(k0 * k0 + k1 * k1) * (1.f / 128.f) + EPS);
        *(unsigned*)(CKVN + (size_t)t * 128 + 2 * c.lane) = pk2(k0 * rs * gkv[2 * c.lane], k1 * rs * gkv[2 * c.lane + 1]);
        const f32x4 q = ld_bf4(row + PB_CQ + 4 * c.lane);
        const float rq = rsqrtf(wave_sum(q[0] * q[0] + q[1] * q[1] + q[2] * q[2] + q[3] * q[3]) * (1.f / 256.f) + EPS);
        if (c.lane == 0) RSTDQ[t] = rq;
        if (c.lane < 32) KIDX[(size_t)t * 32 + c.lane] = (bf16)f2bf(SM[(size_t)t * 128 + SM_KIDX + c.lane]);
    }
}

constexpr int TS = 16;
__device__ __forceinline__ void scan_gla_item(const Ctx& c, int l, int b, int h) {
    LAS float* q_s = (LAS float*)c.lds;
    LAS float* k_s = q_s + TS * 64;
    LAS float* a_s = k_s + TS * 64;
    LAS float* v_s = a_s + TS * 64;
    LAS float* part = v_s + TS * 128;
    LAS float* wa2 = part + TS * 4 * 128;
    LAS float* ba = wa2 + 16 * 64;
    LAS float* alr = ba + 64;
    const bf16* PB = (const bf16*)(c.ws + WS_PB); const float* SM = (const float*)(c.ws + WS_SM);
    bf16* UA = (bf16*)(c.ws + WS_UA);
    const float* gn = c.in[IN_GLA_NORM] + l * 512 + h * 128;
    for (int i = c.tid; i < 16 * 64; i += NTHR) wa2[i] = c.in[IN_GLA_WA2][(size_t)l * 16 * 256 + (i >> 6) * 256 + h * 64 + (i & 63)];
    if (c.tid < 64) ba[c.tid] = c.in[IN_GLA_BA][l * 256 + h * 64 + c.tid];
    const int v = c.tid & 127, kg = c.tid >> 7;
    float S[16];
#pragma unroll
    for (int i = 0; i < 16; ++i) S[i] = 0.f;
    for (int t0 = 0; t0 < SEQ; t0 += TS) {
        __syncthreads();
        const size_t rb = (size_t)b * SEQ + t0;
        for (int i = c.tid; i < TS * 64; i += NTHR) { const int s = i >> 6, cc = i & 63; const bf16* row = PB + (rb + s) * NPB;
            q_s[i] = bf2f(row[PB_QA + h * 64 + cc]) * 0.125f; k_s[i] = bf2f(row[PB_KA + h * 64 + cc]); }
        for (int i = c.tid; i < TS * 128; i += NTHR) { const int s = i >> 7, cc = i & 127; v_s[i] = bf2f(PB[(rb + s) * NPB + PB_VA + h * 128 + cc]); }
        if (c.tid < TS * 16) alr[c.tid] = SM[(rb + (c.tid >> 4)) * 128 + SM_ALR + (c.tid & 15)];
        __syncthreads();
        for (int i = c.tid; i < TS * 64; i += NTHR) { const int s = i >> 6, cc = i & 63; float x = ba[cc];
#pragma unroll
            for (int j = 0; j < 16; ++j) x += alr[s * 16 + j] * wa2[j * 64 + cc];
            a_s[i] = __expf(logsigmoidf_(x) * (1.f / 16.f)); }
        __syncthreads();
#pragma unroll 1
        for (int s = 0; s < TS; ++s) {
            const float vv = v_s[s * 128 + v]; float acc = 0.f;
#pragma unroll
            for (int i4 = 0; i4 < 4; ++i4) {
                const f32x4 a4 = *(const LAS f32x4*)(a_s + s * 64 + kg * 16 + i4 * 4), k4 = *(const LAS f32x4*)(k_s + s * 64 + kg * 16 + i4 * 4), q4 = *(const LAS f32x4*)(q_s + s * 64 + kg * 16 + i4 * 4);
#pragma unroll
                for (int j = 0; j < 4; ++j) { S[i4 * 4 + j] = a4[j] * S[i4 * 4 + j] + k4[j] * vv; acc += q4[j] * S[i4 * 4 + j]; }
            }
            part[(s * 4 + kg) * 128 + v] = acc;
        }
        __syncthreads();
        {
            const int s = c.tid >> 5, vq = c.tid & 31, v0 = vq * 4;
            f32x4 o = (f32x4){0.f, 0.f, 0.f, 0.f};
#pragma unroll
            for (int g = 0; g < 4; ++g) o += *(const LAS f32x4*)(part + (s * 4 + g) * 128 + v0);
            float ss = o[0] * o[0] + o[1] * o[1] + o[2] * o[2] + o[3] * o[3];
#pragma unroll
            for (int m = 1; m < 32; m <<= 1) ss += __shfl_xor(ss, m);
            const float rstd = rsqrtf(ss * (1.f / 128.f) + EPS);
            const f32x4 ga = ld_bf4(PB + (rb + s) * NPB + PB_GA + h * 128 + v0);
            f32x4 r;
#pragma unroll
            for (int j = 0; j < 4; ++j) r[j] = o[j] * rstd * gn[v0 + j] * siluf_(ga[j]);
            st_bf4(UA + (rb + s) * 512 + h * 128 + v0, r);
        }
    }
    __syncthreads();
}
__device__ __forceinline__ void scan_mlstm_item(const Ctx& c, int l, int b, int h) {
    LAS float* q_s = (LAS float*)c.lds;
    LAS float* k_s = q_s + TS * 64;
    LAS float* v_s = k_s + TS * 64;
    LAS float* part = v_s + TS * 128;
    LAS float* dpart = part + TS * 4 * 128;
    LAS float* lf_s = dpart + TS * 4;
    LAS float* ip_s = lf_s + TS;
    LAS float* m_s = ip_s + TS;
    LAS float* cw = m_s + TS;
    const bf16* PB = (const bf16*)(c.ws + WS_PB); const float* SM = (const float*)(c.ws + WS_SM);
    bf16* UC = (bf16*)(c.ws + WS_UC);
    const float* mn = c.in[IN_ML_NORM] + l * 512 + h * 128;
    if (c.tid < 4 * 128) { const int j = c.tid >> 7, cc = c.tid & 127; cw[c.tid] = c.in[IN_ML_CONV][(size_t)l * 4 * 512 + j * 512 + (cc < 64 ? h * 64 + cc : 256 + h * 64 + (cc - 64))]; }
    const float bi = c.in[IN_ML_BI][l * 4 + h], bfv = c.in[IN_ML_BF][l * 4 + h];
    const int v = c.tid & 127, kg = c.tid >> 7;
    float C[16], n[16]; float m = 0.f;
#pragma unroll
    for (int i = 0; i < 16; ++i) { C[i] = 0.f; n[i] = 0.f; }
    for (int t0 = 0; t0 < SEQ; t0 += TS) {
        __syncthreads();
        const size_t rb = (size_t)b * SEQ + t0;
        for (int i = c.tid; i < TS * 128; i += NTHR) { const int s = i >> 7, cc = i & 127;
            const int col = cc < 64 ? PB_QC + h * 64 + cc : PB_KC + h * 64 + (cc - 64);
            float x = 0.f;
#pragma unroll
            for (int j = 0; j < 4; ++j) { const int tt = t0 + s - 3 + j; if (tt >= 0) x += cw[j * 128 + cc] * bf2f(PB[((size_t)b * SEQ + tt) * NPB + col]); }
            x = siluf_(x);
            if (cc < 64) q_s[s * 64 + cc] = x * 0.125f; else k_s[s * 64 + (cc - 64)] = x; }
        for (int i = c.tid; i < TS * 128; i += NTHR) { const int s = i >> 7, cc = i & 127; v_s[i] = bf2f(PB[(rb + s) * NPB + PB_VC + h * 128 + cc]); }
        if (c.tid < TS) { ip_s[c.tid] = SM[(rb + c.tid) * 128 + SM_IC + h] + bi; lf_s[c.tid] = logsigmoidf_(SM[(rb + c.tid) * 128 + SM_FC + h] + bfv); }
        __syncthreads();
#pragma unroll 1
        for (int s = 0; s < TS; ++s) {
            const float lf = lf_s[s], ip = ip_s[s];
            const float mnew = fmaxf(lf + m, ip), fg = __expf(lf + m - mnew), ig = __expf(ip - mnew);
            m = mnew;
            const float vv = v_s[s * 128 + v] * ig; float num = 0.f, den = 0.f;
#pragma unroll
            for (int i4 = 0; i4 < 4; ++i4) {
                const f32x4 k4 = *(const LAS f32x4*)(k_s + s * 64 + kg * 16 + i4 * 4), q4 = *(const LAS f32x4*)(q_s + s * 64 + kg * 16 + i4 * 4);
#pragma unroll
                for (int j = 0; j < 4; ++j) { C[i4 * 4 + j] = fg * C[i4 * 4 + j] + k4[j] * vv; n[i4 * 4 + j] = fg * n[i4 * 4 + j] + ig * k4[j]; num += q4[j] * C[i4 * 4 + j]; den += q4[j] * n[i4 * 4 + j]; }
            }
            part[(s * 4 + kg) * 128 + v] = num;
            if (v == 0) dpart[s * 4 + kg] = den;
            if (c.tid == 0) m_s[s] = m;
        }
        __syncthreads();
        {
            const int s = c.tid >> 5, vq = c.tid & 31, v0 = vq * 4;
            f32x4 o = (f32x4){0.f, 0.f, 0.f, 0.f};
#pragma unroll
            for (int g = 0; g < 4; ++g) o += *(const LAS f32x4*)(part + (s * 4 + g) * 128 + v0);
            const float den = dpart[s * 4] + dpart[s * 4 + 1] + dpart[s * 4 + 2] + dpart[s * 4 + 3];
            const float dd = 1.f / fmaxf(fabsf(den), __expf(-m_s[s]));
            o = o * dd;
            float ss = o[0] * o[0] + o[1] * o[1] + o[2] * o[2] + o[3] * o[3];
#pragma unroll
            for (int mm = 1; mm < 32; mm <<= 1) ss += __shfl_xor(ss, mm);
            const float rstd = rsqrtf(ss * (1.f / 128.f) + EPS);
            const f32x4 oc = ld_bf4(PB + (rb + s) * NPB + PB_OC + h * 128 + v0);
            f32x4 r;
#pragma unroll
            for (int j = 0; j < 4; ++j) r[j] = o[j] * rstd * mn[v0 + j] * sigmoidf_(oc[j]);
            st_bf4(UC + (rb + s) * 512 + h * 128 + v0, r);
        }
    }
    __syncthreads();
}
__device__ __forceinline__ void phase_scans(const Ctx& c, int l) {
    for (int it = c.bid; it < 128; it += c.nblk) {
        if (it < 64) scan_gla_item(c, l, it >> 2, it & 3);
        else scan_mlstm_item(c, l, (it - 64) >> 2, (it - 64) & 3);
    }
}

__device__ __forceinline__ unsigned ord_key(float f) { const unsigned u = __builtin_bit_cast(unsigned, f); return (u & 0x80000000u) ? ~u : (u | 0x80000000u); }
__device__ __forceinline__ void phase_dsa(const Ctx& c, int l) {
    LAS unsigned char* wl = c.lds + c.wave * 14336;
    LAS float* I_s = (LAS float*)wl;
    LAS int* list = (LAS int*)(wl + 8192);
    LAS float* qi_s = (LAS float*)(wl + 9216);
    LAS float* ql_s = (LAS float*)(wl + 10240);
    const bf16* QLAT = (const bf16*)(c.ws + WS_QLAT); const bf16* QIDX = (const bf16*)(c.ws + WS_QIDX);
    const bf16* CKVN = (const bf16*)(c.ws + WS_CKVN); const float* SM = (const float*)(c.ws + WS_SM);
    bf16* OLAT = (bf16*)(c.ws + WS_OLAT);
    const int gw = c.bid * NWAVES + c.wave, NGW = c.nblk * NWAVES, lane = c.lane;
    for (int tq = gw; tq < T; tq += NGW) {
        const int b = tq >> 11, pos = tq & 2047, nvalid = pos + 1;
        const size_t kb = (size_t)b * SEQ;
        { const f32x4 q = ld_bf4(QIDX + (size_t)tq * 256 + 4 * lane); *(LAS f32x4*)(qi_s + 4 * lane) = q;
#pragma unroll
          for (int j = 0; j < 4; ++j) { const f32x4 ql = ld_bf4(QLAT + (size_t)tq * 1024 + 4 * (lane + 64 * j)); *(LAS f32x4*)(ql_s + 4 * (lane + 64 * j)) = ql; } }
        float wh[8];
#pragma unroll
        for (int hh = 0; hh < 8; ++hh) wh[hh] = SM[(size_t)tq * 128 + SM_WIDX + hh] * 0.35355339059327373f;
        asm volatile("s_waitcnt lgkmcnt(0)" ::: "memory");
        int nsel;
        if (nvalid <= DSA_K) {
            for (int i = lane; i < DSA_K; i += 64) list[i] = i;
            nsel = nvalid;
        } else {
            const int nj = (nvalid + 63) >> 6;
            for (int j = 0; j < nj; ++j) {
                const int s = lane + 64 * j;
                float val = -INFINITY;
                if (s < nvalid) {
                    const float* kr = SM + (kb + s) * 128 + SM_KIDX;
                    f32x4 kk[8];
#pragma unroll
                    for (int i = 0; i < 8; ++i) kk[i] = *(const f32x4*)(kr + 4 * i);
                    val = 0.f;
#pragma unroll
                    for (int hh = 0; hh < 8; ++hh) { float d = 0.f;
#pragma unroll
                        for (int i = 0; i < 8; ++i) { const f32x4 q = *(const LAS f32x4*)(qi_s + hh * 32 + 4 * i); d += q[0] * kk[i][0] + q[1] * kk[i][1] + q[2] * kk[i][2] + q[3] * kk[i][3]; }
                        val += wh[hh] * fmaxf(d, 0.f); }
                }
                I_s[s] = val;
            }
            for (int j = nj; j < 32; ++j) I_s[lane + 64 * j] = -INFINITY;
            asm volatile("s_waitcnt lgkmcnt(0)" ::: "memory");
            LAS unsigned* K_s = (LAS unsigned*)I_s;
#pragma unroll 4
            for (int j = 0; j < 32; ++j) K_s[lane + 64 * j] = ord_key(I_s[lane + 64 * j]);
            unsigned thr = 0u;
#pragma unroll 1
            for (int bit = 31; bit >= 0; --bit) {
                const unsigned cand = thr | (1u << bit); int cnt = 0;
#pragma unroll 8
                for (int j = 0; j < 32; ++j) cnt += (K_s[lane + 64 * j] >= cand) ? 1 : 0;
                cnt = wave_sum_i(cnt);
                if (cnt >= DSA_K) thr = cand;
            }
            int cgt = 0;
#pragma unroll 8
            for (int j = 0; j < 32; ++j) cgt += (K_s[lane + 64 * j] > thr) ? 1 : 0;
            cgt = wave_sum_i(cgt);
            int need = DSA_K - cgt, base = 0;
            const unsigned long long lt = (1ull << lane) - 1ull;
#pragma unroll 2
            for (int j = 0; j < 32; ++j) {
                const unsigned kj = K_s[lane + 64 * j];
                const bool gt = kj > thr, eq = kj == thr;
                const unsigned long long meq = __ballot(eq);
                const int rk = __popcll(meq & lt);
                const bool sel = gt || (eq && rk < need);
                need -= __popcll(meq); if (need < 0) need = 0;
                const unsigned long long ms = __ballot(sel);
                if (sel) list[base + __popcll(ms & lt)] = lane + 64 * j;
                base += __popcll(ms);
            }
            nsel = DSA_K;
        }
        asm volatile("s_waitcnt lgkmcnt(0)" ::: "memory");
        int ks[4]; float lg[4][8];
#pragma unroll
        for (int i = 0; i < 4; ++i) { const int li = lane + 64 * i; ks[i] = (li < nsel) ? list[li] : 0;
#pragma unroll
            for (int hh = 0; hh < 8; ++hh) lg[i][hh] = 0.f; }
#pragma unroll 1
        for (int ch = 0; ch < 16; ++ch) {
            f32x4 ka[4], kc[4];
#pragma unroll
            for (int i = 0; i < 4; ++i) { const u32x4 w = *(const u32x4*)(CKVN + (kb + ks[i]) * 128 + ch * 8);
                ka[i] = (f32x4){bflo(w.x), bfhi(w.x), bflo(w.y), bfhi(w.y)}; kc[i] = (f32x4){bflo(w.z), bfhi(w.z), bflo(w.w), bfhi(w.w)}; }
#pragma unroll
            for (int hh = 0; hh < 8; ++hh) { const f32x4 qa = *(const LAS f32x4*)(ql_s + hh * 128 + ch * 8), qb = *(const LAS f32x4*)(ql_s + hh * 128 + ch * 8 + 4);
#pragma unroll
                for (int i = 0; i < 4; ++i) lg[i][hh] += qa[0] * ka[i][0] + qa[1] * ka[i][1] + qa[2] * ka[i][2] + qa[3] * ka[i][3] + qb[0] * kc[i][0] + qb[1] * kc[i][1] + qb[2] * kc[i][2] + qb[3] * kc[i][3]; }
        }
#pragma unroll
        for (int hh = 0; hh < 8; ++hh) {
            const float slope = exp2f(-(float)(hh + 1));
            float mx = -INFINITY;
#pragma unroll
            for (int i = 0; i < 4; ++i) { const bool ok = (lane + 64 * i) < nsel; lg[i][hh] = ok ? lg[i][hh] - slope * (float)(pos - ks[i]) : -INFINITY; mx = fmaxf(mx, lg[i][hh]); }
            mx = wave_max(mx);
            float sm = 0.f;
#pragma unroll
            for (int i = 0; i < 4; ++i) { lg[i][hh] = __expf(lg[i][hh] - mx); sm += lg[i][hh]; }
            sm = wave_sum(sm);
            const float inv = 1.f / sm;
#pragma unroll
            for (int i = 0; i < 4; ++i) lg[i][hh] *= inv;
        }
#pragma unroll
        for (int i = 0; i < 4; ++i) { const int li = lane + 64 * i;
            *(LAS f32x4*)(I_s + li * 8) = (f32x4){lg[i][0], lg[i][1], lg[i][2], lg[i][3]}; *(LAS f32x4*)(I_s + li * 8 + 4) = (f32x4){lg[i][4], lg[i][5], lg[i][6], lg[i][7]}; }
        asm volatile("s_waitcnt lgkmcnt(0)" ::: "memory");
        float o0[8], o1[8];
#pragma unroll
        for (int hh = 0; hh < 8; ++hh) { o0[hh] = 0.f; o1[hh] = 0.f; }
#pragma unroll 2
        for (int kidx = 0; kidx < nsel; ++kidx) {
            const int s = list[kidx];
            const unsigned w = *(const unsigned*)(CKVN + (kb + s) * 128 + 2 * lane);
            const float v0 = bflo(w), v1 = bfhi(w);
            const f32x4 pa = *(const LAS f32x4*)(I_s + kidx * 8), pb = *(const LAS f32x4*)(I_s + kidx * 8 + 4);
            o0[0] += pa[0] * v0; o1[0] += pa[0] * v1; o0[1] += pa[1] * v0; o1[1] += pa[1] * v1; o0[2] += pa[2] * v0; o1[2] += pa[2] * v1; o0[3] += pa[3] * v0; o1[3] += pa[3] * v1;
            o0[4] += pb[0] * v0; o1[4] += pb[0] * v1; o0[5] += pb[1] * v0; o1[5] += pb[1] * v1; o0[6] += pb[2] * v0; o1[6] += pb[2] * v1; o0[7] += pb[3] * v0; o1[7] += pb[3] * v1;
        }
#pragma unroll
        for (int hh = 0; hh < 8; ++hh) *(unsigned*)(OLAT + (size_t)tq * 1024 + hh * 128 + 2 * lane) = pk2(o0[hh], o1[hh]);
        asm volatile("s_waitcnt lgkmcnt(0)" ::: "memory");
    }
}

__device__ __forceinline__ void route_one(int t, float logit, float rbias, int lane, unsigned* CNT, int* ROWL, float* WL, unsigned* TOKPOS) {
    const float score = sigmoidf_(logit), sel = score + rbias;
    const int g = lane >> 3;
    int rk8 = 0;
#pragma unroll
    for (int d = 1; d < 8; ++d) { const int ol = (lane & ~7) | ((lane + d) & 7); const float o = __shfl(sel, ol); rk8 += (o > sel || (o == sel && ol < lane)) ? 1 : 0; }
    float t2 = rk8 < 2 ? sel : 0.f;
    t2 += __shfl_xor(t2, 1); t2 += __shfl_xor(t2, 2); t2 += __shfl_xor(t2, 4);
    int rkg = 0;
#pragma unroll
    for (int d = 1; d < 8; ++d) { const int og = (g + d) & 7; const float o = __shfl(t2, og * 8); rkg += (o > t2 || (o == t2 && og < g)) ? 1 : 0; }
    const bool gsel = rkg < 4;
    bool chosen = false; float cur = gsel ? sel : -INFINITY;
#pragma unroll 1
    for (int it6 = 0; it6 < TOPK; ++it6) {
        const float mx = wave_max(cur);
        const unsigned long long me = __ballot(cur == mx);
        const int win = __ffsll((long long)me) - 1;
        if (lane == win) { chosen = true; cur = -INFINITY; }
    }
    const float wsum = wave_sum(chosen ? score : 0.f);
    const unsigned long long mk = __ballot(chosen);
    if (chosen) {
        const int hf = t >= HALF_T ? 1 : 0;
        const int kk = __popcll(mk & ((1ull << lane) - 1ull));
        const unsigned slot = atomicAdd(&CNT[hf * 64 + lane], 1u);
        ROWL[((size_t)hf * 64 + lane) * 16384 + slot] = t;
        WL[((size_t)hf * 64 + lane) * 16384 + slot] = score / wsum * 2.5f;
        if (kk < TOPK) TOKPOS[(size_t)t * 6 + kk] = ((unsigned)lane << 16) | slot;
    }
}
__device__ __forceinline__ void phase_route(const Ctx& c, int l, const float* x1) {
    {
        LAS float* scr = (LAS float*)(c.lds + c.wave * 16384);
        const int gw = c.bid * NWAVES + c.wave, NGW = c.nblk * NWAVES;
        constexpr int I_GU = (512 / 32) * (1024 / 64), I_D = (1024 / 32) * (256 / 64), PER_E = I_GU + I_D;
        for (int it = gw; it < NEX * PER_E; it += NGW) {
            const int e = it / PER_E; int r = it % PER_E;
            if (r < I_GU) {
                const int n0 = (r / 16) * 32, pn = n0 >> 8, wi = n0 & 255, j0 = 128 * pn + (wi & 127);
                const float* Wg; const float* Wu;
                if (e < NE) { Wg = c.in[IN_EWG] + ((size_t)l * NE + e) * 1024 * 256; Wu = c.in[IN_EWU] + ((size_t)l * NE + e) * 1024 * 256; }
                else { Wg = c.in[IN_SWG] + (size_t)l * 1024 * 256; Wu = c.in[IN_SWU] + (size_t)l * 1024 * 256; }
                if (wi < 128) { SrcPlain s{Wg + j0 - n0, 256}; tr_item(s, (bf16*)(c.ws + WS_WGU) + (size_t)e * 512 * 1024, 1024, n0, (r % 16) * 64, scr, c.lane); }
                else { SrcPlain s{Wu + j0 - n0, 256}; tr_item(s, (bf16*)(c.ws + WS_WGU) + (size_t)e * 512 * 1024, 1024, n0, (r % 16) * 64, scr, c.lane); }
            } else { r -= I_GU;
                SrcPlain s; s.ld = 1024; s.W = e < NE ? c.in[IN_EWD] + ((size_t)l * NE + e) * 256 * 1024 : c.in[IN_SWD] + (size_t)l * 256 * 1024;
                tr_item(s, (bf16*)(c.ws + WS_WD) + (size_t)e * 1024 * 256, 256, (r / 4) * 32, (r % 4) * 64, scr, c.lane);
            }
        }
    }
    __syncthreads();
    {
        LAS float* h_s = (LAS float*)(c.lds + c.wave * 16384);
        const int gw = c.bid * NWAVES + c.wave, NGW = c.nblk * NWAVES, lane = c.lane;
        const float* MOD = (const float*)(c.ws + WS_MOD) + (size_t)l * 16 * 6144;
        bf16* XN2 = (bf16*)(c.ws + WS_XN2);
        const float* RW = c.in[IN_RW] + (size_t)l * 1024 * 64; const float rbias = c.in[IN_RB][l * 64 + lane];
        unsigned* CNT = (unsigned*)(c.ws + WS_CTL) + CW_CNT + l * 128;
        int* ROWL = (int*)(c.ws + WS_ROWL); float* WL = (float*)(c.ws + WS_WL); unsigned* TOKPOS = (unsigned*)(c.ws + WS_TOKPOS);
        for (int it = gw; it < T / 4; it += NGW) {
            const int t0 = it * 4, b = t0 >> 11;
            const float* gain = c.in[IN_NFFN] + l * D; const float* sh = MOD + (size_t)b * 6144 + 3072; const float* sc = MOD + (size_t)b * 6144 + 4096;
#pragma unroll
            for (int r = 0; r < 4; ++r) {
                const float* xrow = x1 + (size_t)(t0 + r) * D;
                f32x4 v[4]; float s = 0.f;
#pragma unroll
                for (int j = 0; j < 4; ++j) { v[j] = *(const f32x4*)(xrow + 4 * (lane + 64 * j)); s += v[j][0] * v[j][0] + v[j][1] * v[j][1] + v[j][2] * v[j][2] + v[j][3] * v[j][3]; }
                const float rstd = rsqrtf(wave_sum(s) * (1.f / D) + EPS);
#pragma unroll
                for (int j = 0; j < 4; ++j) { const int cc = 4 * (lane + 64 * j);
                    const f32x4 g = *(const f32x4*)(gain + cc), a = *(const f32x4*)(sc + cc), bb = *(const f32x4*)(sh + cc);
                    const f32x4 hv = v[j] * rstd * g * (a + 1.f) + bb;
                    st_bf4(XN2 + (size_t)(t0 + r) * D + cc, hv); *(LAS f32x4*)(h_s + r * 1024 + cc) = hv; }
            }
            asm volatile("s_waitcnt lgkmcnt(0)" ::: "memory");
            float lg[4] = {0.f, 0.f, 0.f, 0.f};
#pragma unroll 2
            for (int k = 0; k < 1024; k += 4) {
                const float w0 = RW[(size_t)k * 64 + lane], w1 = RW[(size_t)(k + 1) * 64 + lane], w2 = RW[(size_t)(k + 2) * 64 + lane], w3 = RW[(size_t)(k + 3) * 64 + lane];
#pragma unroll
                for (int r = 0; r < 4; ++r) { const f32x4 hv = *(const LAS f32x4*)(h_s + r * 1024 + k); lg[r] += hv[0] * w0 + hv[1] * w1 + hv[2] * w2 + hv[3] * w3; }
            }
            route_one(t0 + 0, lg[0], rbias, lane, CNT, ROWL, WL, TOKPOS);
            route_one(t0 + 1, lg[1], rbias, lane, CNT, ROWL, WL, TOKPOS);
            route_one(t0 + 2, lg[2], rbias, lane, CNT, ROWL, WL, TOKPOS);
            route_one(t0 + 3, lg[3], rbias, lane, CNT, ROWL, WL, TOKPOS);
        }
    }
}

__device__ __forceinline__ void moe_tables(const Ctx& c, int l, int hf) {
    LAS int* cnt = (LAS int*)(c.lds + 140000); LAS int* off = cnt + 65; LAS int* tst = off + 65;
    __syncthreads();
    if (c.tid == 0) {
        const unsigned* CNT = (const unsigned*)(c.ws + WS_CTL) + CW_CNT + l * 128 + hf * 64;
        int o = 0, ts = 0;
        for (int e = 0; e < NEX; ++e) { const int n = e < NE ? (int)CNT[e] : HALF_T; cnt[e] = n; off[e] = o; tst[e] = ts; o += (n + 255) & ~255; ts += (n + 127) >> 7; }
        tst[NEX] = ts;
    }
    __syncthreads();
}
__device__ __forceinline__ void phase_gemm1(const Ctx& c, int l, int hf) {
    moe_tables(c, l, hf);
    LAS int* cnt = (LAS int*)(c.lds + 140000); LAS int* off = cnt + 65; LAS int* tst = off + 65;
    const int nu = tst[NEX] * 2;
    const bf16* XN2 = (const bf16*)(c.ws + WS_XN2); bf16* HID = (bf16*)(c.ws + WS_HID);
    for (int u = c.bid; u < nu; u += c.nblk) {
        const int rt = u >> 1, pn = u & 1;
        int e = 0; while (tst[e + 1] <= rt) ++e;
        const int r0 = (rt - tst[e]) * 128;
        const bf16* Bt = (const bf16*)(c.ws + WS_WGU) + (size_t)e * 512 * 1024 + (size_t)pn * 256 * 1024;
        if (e < NE) {
            const int* rl = (const int*)(c.ws + WS_ROWL) + ((size_t)hf * 64 + e) * 16384;
            const float* wl = (const float*)(c.ws + WS_WL) + ((size_t)hf * 64 + e) * 16384;
            EpiG1 E{HID, wl, cnt[e], off[e]};
            sgemm_unit(c, XN2, 1024, rl, cnt[e], r0, Bt, 1024, E, r0, pn * 256);
        } else {
            EpiG1 E{HID, nullptr, cnt[e], off[e]};
            sgemm_unit(c, XN2 + (size_t)hf * HALF_T * 1024, 1024, nullptr, 0, r0, Bt, 1024, E, r0, pn * 256);
        }
    }
    __syncthreads();
}
__device__ __forceinline__ void phase_gemm2(const Ctx& c, int l, int hf) {
    moe_tables(c, l, hf);
    LAS int* cnt = (LAS int*)(c.lds + 140000); LAS int* off = cnt + 65; LAS int* tst = off + 65;
    const int nu = tst[NEX] * 4;
    const bf16* HID = (const bf16*)(c.ws + WS_HID); bf16* Y = (bf16*)(c.ws + WS_Y);
    for (int u = c.bid; u < nu; u += c.nblk) {
        const int rt = u >> 2, pn = u & 3;
        int e = 0; while (tst[e + 1] <= rt) ++e;
        const int r0 = (rt - tst[e]) * 128;
        const bf16* Bt = (const bf16*)(c.ws + WS_WD) + (size_t)e * 1024 * 256 + (size_t)pn * 256 * 256;
        EpiG2 E{Y, off[e]};
        sgemm_unit(c, HID + (size_t)off[e] * 256, 256, nullptr, 0, r0, Bt, 256, E, r0, pn * 256);
    }
    __syncthreads();
}
__device__ __forceinline__ void phase_combine(const Ctx& c, int l, int hf, float* xio) {
    moe_tables(c, l, hf);
    LAS int* off = (LAS int*)(c.lds + 140000) + 65;
    const int gw = c.bid * NWAVES + c.wave, NGW = c.nblk * NWAVES, lane = c.lane;
    const bf16* Y = (const bf16*)(c.ws + WS_Y); const unsigned* TOKPOS = (const unsigned*)(c.ws + WS_TOKPOS);
    const float* MODl = (const float*)(c.ws + WS_MOD) + (size_t)l * 16 * 6144;
    const float* MODn = (const float*)(c.ws + WS_MOD) + (size_t)1 * 16 * 6144;
    bf16* XN = (bf16*)(c.ws + WS_XN);
    for (int tt = gw; tt < HALF_T; tt += NGW) {
        const int t = hf * HALF_T + tt, b = t >> 11;
        f32x4 acc[4];
        { const bf16* yr = Y + (size_t)(off[NE] + tt) * 1024;
#pragma unroll
          for (int j = 0; j < 4; ++j) acc[j] = ld_bf4(yr + 4 * (lane + 64 * j)); }
#pragma unroll
        for (int kk = 0; kk < TOPK; ++kk) {
            const unsigned tp = TOKPOS[(size_t)t * 6 + kk]; const int e = tp >> 16, slot = tp & 0xffff;
            const bf16* yr = Y + (size_t)(off[e] + slot) * 1024;
#pragma unroll
            for (int j = 0; j < 4; ++j) acc[j] += ld_bf4(yr + 4 * (lane + 64 * j));
        }
        float* xr = xio + (size_t)t * D; const float* g2 = MODl + (size_t)b * 6144 + 5120;
        f32x4 v[4]; float s = 0.f;
#pragma unroll
        for (int j = 0; j < 4; ++j) { const int cc = 4 * (lane + 64 * j); v[j] = *(const f32x4*)(xr + cc) + *(const f32x4*)(g2 + cc) * acc[j]; s += v[j][0] * v[j][0] + v[j][1] * v[j][1] + v[j][2] * v[j][2] + v[j][3] * v[j][3]; }
        const float rstd = rsqrtf(wave_sum(s) * (1.f / D) + EPS);
        if (l == 0) {
#pragma unroll
            for (int j = 0; j < 4; ++j) { const int cc = 4 * (lane + 64 * j); *(f32x4*)(xr + cc) = v[j];
                const f32x4 g = *(const f32x4*)(c.in[IN_NMIX] + D + cc), a = *(const f32x4*)(MODn + (size_t)b * 6144 + 1024 + cc), bb = *(const f32x4*)(MODn + (size_t)b * 6144 + cc);
                st_bf4(XN + (size_t)t * D + cc, v[j] * rstd * g * (a + 1.f) + bb); }
        } else {
#pragma unroll
            for (int j = 0; j < 4; ++j) { const int cc = 4 * (lane + 64 * j); *(f32x4*)(xr + cc) = v[j] * rstd * *(const f32x4*)(c.in[IN_NFIN] + cc); }
        }
    }
}

constexpr int PH_PER_L = 18, N_PHASES = 1 + NL * PH_PER_L;
#ifndef PH_MASK
#define PH_MASK 0xFFFFFFFFu
#endif
#define IN(k) (lo <= (k) && (k) < hi)
#define EN(b) ((PH_MASK >> (b)) & 1u)
#define SEAM(k) do { if (MK_ONE_LAUNCH && IN(k) && IN((k) + 1)) xcd_barrier(bar); } while (0)
template <int l>
__device__ __forceinline__ void layer_program(const Ctx& c, const XcdBarrier& bar, int lo, int hi) {
        const int P = 1 + l * PH_PER_L;
        const float* xin = l == 0 ? c.in[IN_X] : c.out;
        bf16* PB = (bf16*)(c.ws + WS_PB); float* SM = (float*)(c.ws + WS_SM);
        const bf16* XN = (const bf16*)(c.ws + WS_XN);
        const bf16* WIN = (const bf16*)(c.ws + WS_WIN) + (size_t)l * NINP * 1024;
        if (EN(1) && IN(P + 0)) { if (l == 0) phase_norm1(c, 0, c.in[IN_X]); } SEAM(P + 0);
        if (EN(2) && IN(P + 1)) { EpiInPB E{PB, SM}; sgemm_phase(c, XN, 1024, T, WIN, NPB / 256, 1024, E); } SEAM(P + 1);
        if (EN(3) && IN(P + 2)) { phase_prep(c, l); } SEAM(P + 2);
        if (EN(4) && IN(P + 3)) { phase_scans(c, l); } SEAM(P + 3);
        if (EN(5) && IN(P + 4)) { EpiQ E{(bf16*)(c.ws + WS_QLAT), (bf16*)(c.ws + WS_QIDX), (const float*)(c.ws + WS_RSTDQ)};
            sgemm_phase(c, PB + PB_CQ, NPB, T, (const bf16*)(c.ws + WS_WQ) + (size_t)l * 1280 * 256, 5, 256, E); } SEAM(P + 4);
        if (EN(6) && IN(P + 5)) { EpiGate E{(bf16*)(c.ws + WS_G)}; sgemm_phase(c, XN, 1024, T, WIN + (size_t)NPB * 1024, NG / 256, 1024, E); } SEAM(P + 5);
        if (EN(7) && IN(P + 6)) { phase_dsa(c, l); } SEAM(P + 6);
        if (EN(8) && IN(P + 7)) { EpiUp E{(bf16*)(c.ws + WS_M1), (const bf16*)(c.ws + WS_G), 0, 1};
            sgemm_phase(c, (const bf16*)(c.ws + WS_UA), 512, T, (const bf16*)(c.ws + WS_WUPA) + (size_t)l * 1024 * 512, 4, 512, E); } SEAM(P + 7);
        if (EN(9) && IN(P + 8)) { EpiUp E{(bf16*)(c.ws + WS_M1), (const bf16*)(c.ws + WS_G), 1024, 0};
            sgemm_phase(c, (const bf16*)(c.ws + WS_OLAT), 1024, T, (const bf16*)(c.ws + WS_WUVB) + (size_t)l * 1024 * 1024, 4, 1024, E); } SEAM(P + 8);
        if (EN(10) && IN(P + 9)) { EpiUp E{(bf16*)(c.ws + WS_M1), (const bf16*)(c.ws + WS_G), 2048, 0};
            sgemm_phase(c, (const bf16*)(c.ws + WS_UC), 512, T, (const bf16*)(c.ws + WS_WUPC) + (size_t)l * 1024 * 512, 4, 512, E); } SEAM(P + 9);
        if (EN(11) && IN(P + 10)) { EpiWo E{xin, c.out, (const float*)(c.ws + WS_MOD) + (size_t)l * 16 * 6144 + 2048};
            sgemm_phase(c, (const bf16*)(c.ws + WS_M1), 1024, T, (const bf16*)(c.ws + WS_WO) + (size_t)l * 1024 * 1024, 4, 1024, E); } SEAM(P + 10);
        if (EN(12) && IN(P + 11)) { phase_route(c, l, c.out); } SEAM(P + 11);
        if (EN(13) && IN(P + 12)) { phase_gemm1(c, l, 0); } SEAM(P + 12);
        if (EN(14) && IN(P + 13)) { phase_gemm2(c, l, 0); } SEAM(P + 13);
        if (EN(15) && IN(P + 14)) { phase_combine(c, l, 0, c.out); } SEAM(P + 14);
        if (EN(16) && IN(P + 15)) { phase_gemm1(c, l, 1); } SEAM(P + 15);
        if (EN(17) && IN(P + 16)) { phase_gemm2(c, l, 1); } SEAM(P + 16);
        if (EN(18) && IN(P + 17)) { phase_combine(c, l, 1, c.out); } SEAM(P + 17);
    }
__global__ void __launch_bounds__(NTHR, 2) fwd(Args args) {
    extern __shared__ __attribute__((aligned(16))) unsigned char lds_raw[];
    Ctx c;
    c.lds = (LAS unsigned char*)lds_raw;
    c.tid = threadIdx.x; c.lane = c.tid & 63; c.wave = __builtin_amdgcn_readfirstlane(c.tid >> 6);
    c.bid = blockIdx.x; c.nblk = gridDim.x;
    c.in = args.in; c.out = args.out; c.ws = args.ws;
    for (int u = c.tid; u < (LDS_BYTES - LDS_MISC) / 4; u += NTHR) ((LAS unsigned*)(c.lds + LDS_MISC))[u] = 0u;
    __syncthreads();
    XcdBarrier bar; bar.bar = (unsigned*)(c.ws + WS_CTL) + CW_BAR; bar.x = 0; bar.st = (volatile LAS unsigned*)(c.lds + LDS_MISC);
    if (MK_ONE_LAUNCH) bar = xcd_barrier_post((unsigned*)(c.ws + WS_CTL) + CW_BAR, (volatile LAS unsigned*)(c.lds + LDS_MISC));
    const int lo = args.ph_lo, hi = args.ph_hi;
    if (EN(0) && IN(0)) { phase_prologue(c); } SEAM(0);
    layer_program<0>(c, bar, lo, hi);
    layer_program<1>(c, bar, lo, hi);
#undef IN
#undef SEAM
}

extern "C" void kernel_launch(void* const* d_in, const int* in_sizes, int n_in, void* d_out, int out_size, void* d_ws, size_t ws_size, hipStream_t stream) {
    static int grid = 0;
    if (grid == 0) {
        if (n_in != 33 || out_size != T * D || ws_size < WS_END) { fprintf(stderr, "kernel_launch: unexpected problem (n_in %d out %d ws %zu)\n", n_in, out_size, ws_size); grid = -1; return; }
        int dev = 0, cus = 0, per_cu = 0;
        if (hipGetDevice(&dev) != hipSuccess || hipDeviceGetAttribute(&cus, hipDeviceAttributeMultiprocessorCount, dev) != hipSuccess) { grid = -1; return; }
        if (hipFuncSetAttribute((const void*)fwd, hipFuncAttributeMaxDynamicSharedMemorySize, LDS_BYTES) != hipSuccess) { fprintf(stderr, "kernel_launch: hipFuncSetAttribute failed\n"); grid = -1; return; }
        if (hipOccupancyMaxActiveBlocksPerMultiprocessor(&per_cu, (const void*)fwd, NTHR, LDS_BYTES) != hipSuccess || per_cu < 1) { fprintf(stderr, "kernel_launch: occupancy query says %d\n", per_cu); }
        (void)hipGetLastError();
        grid = cus;
    }
    if (grid < 0) return;
    (void)hipMemsetAsync((char*)d_ws + WS_CTL, 0, CTL_BYTES, stream);
    Args a{};
    for (int i = 0; i < 33; ++i) a.in[i] = (const float*)d_in[i];
    a.out = (float*)d_out; a.ws = (unsigned char*)d_ws;
#if MK_ONE_LAUNCH
    a.ph_lo = 0; a.ph_hi = N_PHASES;
    hipLaunchKernelGGL(fwd, dim3(grid), dim3(NTHR), LDS_BYTES, stream, a);
#else
    for (int p = 0; p < N_PHASES; ++p) {
        if (p == 1 + PH_PER_L) continue;
        a.ph_lo = p; a.ph_hi = p + 1;
        hipLaunchKernelGGL(fwd, dim3(grid), dim3(NTHR), LDS_BYTES, stream, a);
    }
#endif
}
```

```cpp
#include <hip/hip_runtime.h>
#include <cstdio>
#include <cstdint>

#define LAS __attribute__((address_space(3)))
#define GAS __attribute__((address_space(1)))
typedef unsigned short bf16;
typedef short bf16x8 __attribute__((ext_vector_type(8)));
typedef float f32x4 __attribute__((ext_vector_type(4)));
typedef float f32x2 __attribute__((ext_vector_type(2)));
typedef unsigned u32x4 __attribute__((ext_vector_type(4)));
typedef unsigned u32x2 __attribute__((ext_vector_type(2)));
typedef GAS unsigned gu32;

#ifndef SCAN_RECURRENT
#define SCAN_RECURRENT 0
#endif
#ifndef MK_ONE_LAUNCH
#define MK_ONE_LAUNCH 1
#endif

constexpr int NB = 16, SEQ = 2048, D = 1024, T = NB * SEQ, NL = 2;
constexpr int NIN = 6592, NPB = 3584, NG = 3072, NINP = NPB + NG;
constexpr int NE = 64, NEX = 65, EFF = 256, TOPK = 6;
constexpr int HALF_T = T / 2;
constexpr int DSA_K = 256;
constexpr float EPS = 1e-6f;
constexpr int NTHR = 512, NWAVES = 8;

constexpr int PB_QA = 0, PB_KA = 256, PB_VA = 512, PB_GA = 1024, PB_CQ = 1536, PB_CKV = 1792, PB_QC = 2048, PB_KC = 2304, PB_VC = 2560, PB_OC = 3072;
constexpr int SM_KIDX = 0, SM_ALR = 32, SM_WIDX = 48, SM_IC = 56, SM_FC = 60;

constexpr size_t MiB = 1u << 20;
constexpr size_t WS_CTL = 0, CTL_BYTES = 1 * MiB;
constexpr size_t WS_MOD = 1 * MiB;
constexpr size_t WS_RSTDQ = 2 * MiB;
constexpr size_t WS_TOKPOS = 3 * MiB;
constexpr size_t WS_IDENT = 3 * MiB + 800 * 1024;
constexpr size_t WS_WIN = 4 * MiB;
constexpr size_t WS_WQ = 30 * MiB;
constexpr size_t WS_WUPA = 32 * MiB;
constexpr size_t WS_WUPC = 34 * MiB;
constexpr size_t WS_WUVB = 36 * MiB;
constexpr size_t WS_WO = 40 * MiB;
constexpr size_t WS_WGU = 44 * MiB;
constexpr size_t WS_WD = 109 * MiB;
constexpr size_t WS_XN = 142 * MiB;
constexpr size_t WS_OLAT = WS_XN;
constexpr size_t WS_UA = 206 * MiB;
constexpr size_t WS_UC = 238 * MiB;
constexpr size_t WS_XN2 = 206 * MiB;
constexpr size_t WS_QLAT = 270 * MiB;
constexpr size_t WS_M1 = WS_QLAT;
constexpr size_t WS_QIDX = 334 * MiB;
constexpr size_t WS_CKVN = 350 * MiB;
constexpr size_t WS_KIDX = 358 * MiB;
constexpr size_t WS_SM = 360 * MiB;
constexpr size_t WS_PB = 376 * MiB;
constexpr size_t WS_G = WS_PB;
constexpr size_t WS_HID = 270 * MiB;
constexpr size_t WS_Y = 334 * MiB;
constexpr size_t WS_ROWL = 590 * MiB;
constexpr size_t WS_WL = 598 * MiB;
constexpr size_t WS_END = 606 * MiB;
static_assert(WS_PB + (size_t)T * NPB * 2 <= 600 * MiB, "PB");
static_assert(WS_Y + (size_t)131072 * 1024 * 2 <= WS_ROWL, "Y");

constexpr int CW_BAR = 4096;
constexpr int CW_CNT = 16384;

constexpr int LDS_BYTES = 147456;
constexpr int LDS_MISC = 145408;

__device__ __forceinline__ unsigned f2bf(float f) { unsigned u = __builtin_bit_cast(unsigned, f); return (u + 0x7fffu + ((u >> 16) & 1u)) >> 16; }
__device__ __forceinline__ float bf2f(unsigned b) { return __builtin_bit_cast(float, b << 16); }
__device__ __forceinline__ unsigned pk2(float lo, float hi) { return f2bf(lo) | (f2bf(hi) << 16); }
__device__ __forceinline__ float bflo(unsigned w) { return __builtin_bit_cast(float, w << 16); }
__device__ __forceinline__ float bfhi(unsigned w) { return __builtin_bit_cast(float, w & 0xffff0000u); }
__device__ __forceinline__ float wave_sum(float v) {
#pragma unroll
    for (int o = 1; o < 64; o <<= 1) v += __shfl_xor(v, o);
    return v;
}
__device__ __forceinline__ float wave_max(float v) {
#pragma unroll
    for (int o = 1; o < 64; o <<= 1) v = fmaxf(v, __shfl_xor(v, o));
    return v;
}
__device__ __forceinline__ int wave_sum_i(int v) {
#pragma unroll
    for (int o = 1; o < 64; o <<= 1) v += __shfl_xor(v, o);
    return v;
}
__device__ __forceinline__ float sigmoidf_(float x) { return 1.f / (1.f + __expf(-x)); }
__device__ __forceinline__ float siluf_(float x) { return x / (1.f + __expf(-x)); }
__device__ __forceinline__ float logsigmoidf_(float x) { return fminf(x, 0.f) - log1pf(__expf(-fabsf(x))); }
__device__ __forceinline__ float logsigmoid_fast(float x) { return fminf(x, 0.f) - __logf(1.f + __expf(-fabsf(x))); }
__device__ __forceinline__ void st_bf4(bf16* p, f32x4 v) { u32x2 w; w.x = pk2(v[0], v[1]); w.y = pk2(v[2], v[3]); *(u32x2*)p = w; }
__device__ __forceinline__ f32x4 ld_bf4(const bf16* p) { u32x2 w = *(const u32x2*)p; return (f32x4){bflo(w.x), bfhi(w.x), bflo(w.y), bfhi(w.y)}; }

#define XB_TMO      128
#define XB_XCNT(j)  (256  + 64 * (j))
#define XB_XSUB(j)  (1280 + 64 * (j))
#define XB_XGEN(j)  (2304 + 64 * (j))
#define XB_TOP      3328
#define XB_TOPGEN   3392
#define XCD_BAR_WORDS 3456
#define XB_SPIN_CAP (1u << 22)
__device__ __forceinline__ unsigned xb_ld(unsigned* p)              { return __hip_atomic_load(p, __ATOMIC_RELAXED, __HIP_MEMORY_SCOPE_AGENT); }
__device__ __forceinline__ unsigned xb_add(unsigned* p, unsigned v) { return __hip_atomic_fetch_add(p, v, __ATOMIC_RELAXED, __HIP_MEMORY_SCOPE_AGENT); }
__device__ __forceinline__ unsigned xb_xcc_id() { return (unsigned)__builtin_amdgcn_s_getreg((3 << 11) | 20) & 0xFu; }
#define XB_SPIN(cond, bar) do { unsigned _sp = 0; while (cond) { __builtin_amdgcn_s_sleep(1); \
    if ((++_sp & 255u) == 0u) { if (xb_ld(&(bar)[XB_TMO])) break; if (_sp > XB_SPIN_CAP) { atomicAdd(&(bar)[XB_TMO], 1u); break; } } } } while (0)
struct XcdBarrier { unsigned* bar; unsigned x; volatile LAS unsigned* st; };
__device__ __forceinline__ XcdBarrier xcd_barrier_post(unsigned* bar, volatile LAS unsigned* st) {
    XcdBarrier b; b.bar = bar; b.x = xb_xcc_id(); b.st = st;
    if (threadIdx.x == 0) (void)xb_add(&bar[XB_XCNT(b.x)], 1u);
    return b;
}
__device__ __forceinline__ void xcd_barrier_complete(unsigned* bar, unsigned x, unsigned& nloc, unsigned& nx) {
    const unsigned G = gridDim.x * gridDim.y * gridDim.z;
    unsigned sum, cnt, mine, sp = 0u;
    for (;;) {
        sum = 0u; cnt = 0u; mine = 0u;
#pragma unroll
        for (unsigned j = 0; j < 16; ++j) { const unsigned c = xb_ld(&bar[XB_XCNT(j)]); sum += c; cnt += (c > 0u) ? 1u : 0u; mine = (j == x) ? c : mine; }
        if (sum == G) break;
        __builtin_amdgcn_s_sleep(1);
        if ((++sp & 255u) == 0u) { if (xb_ld(&bar[XB_TMO])) break; if (sp > XB_SPIN_CAP) { atomicAdd(&bar[XB_TMO], 1u); break; } }
    }
    nloc = mine > 0u ? mine : 1u; nx = cnt > 0u ? cnt : 1u;
}
__device__ __forceinline__ void xcd_barrier(const XcdBarrier& b) {
    asm volatile("s_waitcnt vmcnt(0)" ::: "memory");
    __syncthreads();
    if (threadIdx.x == 0) {
        unsigned* bar = b.bar;
        __builtin_amdgcn_s_waitcnt(0);
        unsigned nloc = b.st[0], nx = b.st[1];
        if (nloc == 0u) { xcd_barrier_complete(bar, b.x, nloc, nx); b.st[0] = nloc; b.st[1] = nx; }
        const unsigned old = xb_add(&bar[XB_XSUB(b.x)], 1u);
        const unsigned gen = old / nloc;
        if (old + 1u == (gen + 1u) * nloc) {
            __builtin_amdgcn_fence(__ATOMIC_RELEASE, "agent");
            asm volatile("s_waitcnt vmcnt(0)" ::: "memory");
            const unsigned og = xb_add(&bar[XB_TOP], 1u);
            const unsigned tg = og / nx;
            if (og + 1u == (tg + 1u) * nx) xb_add(&bar[XB_TOPGEN], 1u);
            else XB_SPIN(xb_ld(&bar[XB_TOPGEN]) == tg, bar);
            __builtin_amdgcn_fence(__ATOMIC_ACQUIRE, "agent");
            xb_add(&bar[XB_XGEN(b.x)], 1u);
            asm volatile("s_waitcnt vmcnt(0)" ::: "memory");
        } else {
            XB_SPIN(xb_ld(&bar[XB_XGEN(b.x)]) == gen, bar);
            __builtin_amdgcn_fence(__ATOMIC_ACQUIRE, "agent");
            asm volatile("s_waitcnt vmcnt(0)" ::: "memory");
        }
    }
    __syncthreads();
}

struct Args { const float* in[33]; float* out; unsigned char* ws; int ph_lo, ph_hi; };

struct Ctx {
    LAS unsigned char* lds;
    int tid, lane, wave, bid, nblk;
    const float* const* in;
    float* out; unsigned char* ws;
};
#define IN_X 0
#define IN_C 1
#define IN_ADAW 2
#define IN_ADAB 3
#define IN_NMIX 4
#define IN_NFFN 5
#define IN_WIN 6
#define IN_GLA_WA2 7
#define IN_GLA_BA 8
#define IN_GLA_NORM 9
#define IN_DSA_NQ 10
#define IN_DSA_NKV 11
#define IN_DSA_WUQ 12
#define IN_DSA_WUK 13
#define IN_DSA_WUV 14
#define IN_DSA_WQI 15
#define IN_ML_CONV 16
#define IN_ML_BI 17
#define IN_ML_BF 18
#define IN_ML_NORM 19
#define IN_WUPA 20
#define IN_WUPB 21
#define IN_WUPC 22
#define IN_WO 23
#define IN_RW 24
#define IN_RB 25
#define IN_EWG 26
#define IN_EWU 27
#define IN_EWD 28
#define IN_SWG 29
#define IN_SWU 30
#define IN_SWD 31
#define IN_NFIN 32

template <class SrcF>
__device__ __forceinline__ void tr_item(const SrcF& src, bf16* dst, int dst_ld, int n0, int k0, LAS float* scr, int lane) {
    const int j = lane & 31;
    const float* colp = src(n0 + j);
    const long ld = src.ld;
#pragma unroll 8
    for (int i = 0; i < 32; ++i) { const int kk = 2 * i + (lane >> 5); scr[kk * 33 + j] = colp ? colp[(long)(k0 + kk) * ld] : 0.f; }
    asm volatile("s_waitcnt lgkmcnt(0)" ::: "memory");
    const int c = lane & 7;
#pragma unroll
    for (int jj = 0; jj < 4; ++jj) { const int n = (lane >> 3) + 8 * jj; const LAS float* s = scr + (8 * c) * 33 + n;
        u32x4 o; o.x = pk2(s[0 * 33], s[1 * 33]); o.y = pk2(s[2 * 33], s[3 * 33]); o.z = pk2(s[4 * 33], s[5 * 33]); o.w = pk2(s[6 * 33], s[7 * 33]);
        *(u32x4*)(dst + (size_t)(n0 + n) * dst_ld + k0 + 8 * c) = o; }
    asm volatile("s_waitcnt lgkmcnt(0)" ::: "memory");
}
struct SrcPlain { const float* W; long ld; __device__ __forceinline__ const float* operator()(int n) const { return W + n; } };
__device__ __forceinline__ int win_src_col(int r) {
    if (r < 1536) return r;
    if (r < 1792) return 1552 + (r - 1536);
    if (r < 1920) return 1808 + (r - 1792);
    if (r < 1952) return 1936 + (r - 1920);
    if (r < 1968) return 1536 + (r - 1952);
    if (r < 1976) return 1968 + (r - 1968);
    if (r < 1980) return 3000 + (r - 1976);
    if (r < 1984) return 3004 + (r - 1980);
    if (r < 2048) return -1;
    if (r < 2560) return 1976 + (r - 2048);
    if (r < 3072) return 2488 + (r - 2560);
    if (r < 3584) return 3008 + (r - 3072);
    return 3520 + (r - 3584);
}
struct SrcWin { const float* W; long ld; __device__ __forceinline__ const float* operator()(int n) const { const int c = win_src_col(n); return c < 0 ? nullptr : W + c; } };
struct SrcGU { const float* Wg; const float* Wu; long ld;
    __device__ __forceinline__ const float* operator()(int r) const { const int pn = r >> 8, w = r & 255, j = 128 * pn + (w & 127); return (w < 128 ? Wg : Wu) + j; } };

constexpr int SG_LD = 40;
template <class Epi>
__device__ __forceinline__ void sgemm_unit(const Ctx& c, const bf16* A, int lda, const int* rowlist, int nvalid, int arow0, const bf16* Bt, int K, const Epi& E, int erow0, int ecol0) {
    LAS bf16* As = (LAS bf16*)c.lds;
    LAS bf16* Bs = (LAS bf16*)(c.lds + 128 * SG_LD * 2);
    const int tid = c.tid, lane = c.lane, wave = c.wave, wr = wave >> 2, wc = wave & 3, fr = lane & 15, fq = lane >> 4;
    const int lr = tid >> 2, ch = tid & 3;
    int srow = arow0 + lr;
    if (rowlist) { srow = (arow0 + lr < nvalid) ? rowlist[arow0 + lr] : 0; }
    const bf16* ap = A + (size_t)srow * lda + ch * 8;
    const bf16* bp0 = Bt + (size_t)lr * K + ch * 8;
    const bf16* bp1 = Bt + (size_t)(128 + lr) * K + ch * 8;
    f32x4 acc[2][4][2];
#pragma unroll
    for (int a = 0; a < 2; ++a)
#pragma unroll
        for (int m = 0; m < 4; ++m)
#pragma unroll
            for (int n = 0; n < 2; ++n) acc[a][m][n] = (f32x4){0.f, 0.f, 0.f, 0.f};
    u32x4 ra = *(const u32x4*)ap, rb0 = *(const u32x4*)bp0, rb1 = *(const u32x4*)bp1;
    for (int k0 = 0; k0 < K; k0 += 32) {
        __syncthreads();
        *(LAS u32x4*)(As + lr * SG_LD + ch * 8) = ra;
        *(LAS u32x4*)(Bs + lr * SG_LD + ch * 8) = rb0;
        *(LAS u32x4*)(Bs + (128 + lr) * SG_LD + ch * 8) = rb1;
        __syncthreads();
        if (k0 + 32 < K) { ra = *(const u32x4*)(ap + k0 + 32); rb0 = *(const u32x4*)(bp0 + k0 + 32); rb1 = *(const u32x4*)(bp1 + k0 + 32); }
        bf16x8 af[4], bfr[2][2];
#pragma unroll
        for (int m = 0; m < 4; ++m) af[m] = *(const LAS bf16x8*)(As + (wr * 64 + m * 16 + fr) * SG_LD + fq * 8);
#pragma unroll
        for (int bj = 0; bj < 2; ++bj)
#pragma unroll
            for (int n = 0; n < 2; ++n) bfr[bj][n] = *(const LAS bf16x8*)(Bs + (bj * 128 + wc * 32 + n * 16 + fr) * SG_LD + fq * 8);
#pragma unroll
        for (int bj = 0; bj < 2; ++bj)
#pragma unroll
            for (int m = 0; m < 4; ++m)
#pragma unroll
                for (int n = 0; n < 2; ++n) acc[bj][m][n] = __builtin_amdgcn_mfma_f32_16x16x32_bf16(bfr[bj][n], af[m], acc[bj][m][n], 0, 0, 0);
    }
#pragma unroll
    for (int m = 0; m < 4; ++m)
#pragma unroll
        for (int n = 0; n < 2; ++n) E(erow0 + wr * 64 + m * 16 + fr, ecol0 + wc * 32 + n * 16 + 4 * fq, acc[0][m][n], acc[1][m][n]);
}
template <class Epi>
__device__ __forceinline__ void sgemm_phase(const Ctx& c, const bf16* A, int lda, int M, const bf16* Bt, int ntn, int K, const Epi& E) {
    const int nu = (M / 128) * ntn;
    for (int u = c.bid; u < nu; u += c.nblk) {
        const int pm = u / ntn, pn = u % ntn;
        sgemm_unit(c, A, lda, nullptr, 0, pm * 128, Bt + (size_t)pn * 256 * K, K, E, pm * 128, pn * 256);
    }
    __syncthreads();
}


namespace g8 {
constexpr int BM = 256, BK = 64, HALF = 128, HTB = HALF * BK * 2, STAGE_BYTES = 8 * HTB, NXCD = 8, WGM = 8;
__host__ __device__ __forceinline__ int lds_byte(int r, int c) { const int st = (r >> 4) * 2 + (c >> 5), rr = r & 15, cc = c & 31, ob = rr * 64 + cc * 2; return st * 1024 + (ob ^ (((ob >> 9) & 1) << 5)); }
__host__ __device__ __forceinline__ void stage_rc(int b, int& R, int& C) { const int st = b / 1024, sb = b % 1024, swz = sb ^ (((sb >> 9) & 1) << 5); R = (st >> 1) * 16 + swz / 64; C = (st & 1) * 32 + (swz % 64) / 2; }
struct GUnit { const char* A; const char* B; const int* rl; int nvalid; int erow0, ecol0; int x0; const float* xp; };
__device__ __forceinline__ bool static_order(int nM, int nN, int G, int c, int i, int& pm, int& pn) {
    const int nwg = nM * nN; const long L = (long)i * G + c; if (L >= nwg) return false;
    int wgid = (int)L; { const int q = nwg / NXCD, r = nwg % NXCD, xcd = wgid % NXCD, off = wgid / NXCD; wgid = (xcd < r ? xcd * (q + 1) : r * (q + 1) + (xcd - r) * q) + off; }
    const int nig = WGM * nN, gid = wgid / nig, fm = gid * WGM, gsz = (nM - fm) < WGM ? (nM - fm) : WGM;
    pm = fm + ((wgid % nig) % gsz); pn = (wgid % nig) / gsz; return true;
}
struct DenseSched { const char* A; const char* Bt; size_t ldaB, ldbB; int nM, nN, G, c;
    __device__ __forceinline__ bool next(int i, GUnit& u) const { int pm, pn; if (!static_order(nM, nN, G, c, i, pm, pn)) return false;
        u.A = A + (size_t)pm * 256 * ldaB; u.B = Bt + (size_t)pn * 256 * ldbB; u.rl = nullptr; u.nvalid = 0; u.erow0 = pm * 256; u.ecol0 = pn * 256; u.x0 = 0; u.xp = nullptr; return true; } };

template <bool GATHER, class Epi, class Sched>
__device__ __forceinline__ void gemm_phase(LAS unsigned char* lds, unsigned ldaB, int K, const Sched& S, const Epi& E) {
    const int tid = threadIdx.x, wid = __builtin_amdgcn_readfirstlane(tid >> 6), lane = tid & 63, wr = wid >> 2, wc = wid & 3, fr = lane & 15, fq = lane >> 4;
    const int nt = K / BK;
    int R0, C0, R1, C1; stage_rc(tid * 16, R0, C0); stage_rc(tid * 16 + 8192, R1, C1);
    unsigned voffB[2]; voffB[0] = (unsigned)(R0 * K + C0) * 2u; voffB[1] = (unsigned)(R1 * K + C1) * 2u;
    unsigned ac0[2], ac1[2], an0[2], an1[2];
    const size_t kstep = (size_t)(BK * 2);
    const size_t hstepB = (size_t)HALF * K * 2;
    const unsigned ldsw = (unsigned)wid * 1024u;
    const int aoff = lds_byte(wr * 64 + fr, fq * 8), boff = lds_byte(wc * 32 + fr, fq * 8);
#define G8_SA(b, h) (((b) * 2 + (h)) * HTB)
#define G8_SB(b, h) ((4 + (b) * 2 + (h)) * HTB)
#define G8_STAGE(bufoff, gbase, voff) do { _Pragma("unroll") for (int _i = 0; _i < 2; ++_i) \
        __builtin_amdgcn_global_load_lds((const unsigned*)((const char*)(gbase) + (voff)[_i]), (LAS unsigned*)(lds + (bufoff) + ldsw + _i * 8192), 16, 0, 0); } while (0)
#define G8_LDA(dst, b, h) do { _Pragma("unroll") for (int m = 0; m < 4; ++m) _Pragma("unroll") for (int k = 0; k < 2; ++k) dst[m][k] = *(const LAS bf16x8*)(lds + G8_SA(b, h) + aoff + m * 2048 + k * 1024); } while (0)
#define G8_LDB(dst, b, h) do { _Pragma("unroll") for (int n = 0; n < 2; ++n) _Pragma("unroll") for (int k = 0; k < 2; ++k) dst[n][k] = *(const LAS bf16x8*)(lds + G8_SB(b, h) + boff + n * 2048 + k * 1024); } while (0)
#define G8_MMA(ai, bj, At, Bt) do { __builtin_amdgcn_s_setprio(1); _Pragma("unroll") for (int m = 0; m < 4; ++m) _Pragma("unroll") for (int n = 0; n < 2; ++n) _Pragma("unroll") for (int k = 0; k < 2; ++k) \
        acc[ai][bj][m][n] = __builtin_amdgcn_mfma_f32_16x16x32_bf16(Bt[n][k], At[m][k], acc[ai][bj][m][n], 0, 0, 0); __builtin_amdgcn_s_setprio(0); } while (0)
#define G8_WAIT_V(n) asm volatile("s_waitcnt vmcnt(" #n ")" ::: "memory")
#define G8_WAIT_L(n) asm volatile("s_waitcnt lgkmcnt(" #n ")" ::: "memory")
#define G8_BAR __builtin_amdgcn_s_barrier()
#define G8_SCHED __builtin_amdgcn_sched_barrier(0)
#define G8_XLOAD(u) __builtin_amdgcn_global_load_lds((const unsigned*)((u).rl + lane * 4), (LAS unsigned*)(lds + STAGE_BYTES + wid * 1024), 16, 0, 0)
#define G8_AOFF(u, o0, o1) do { if (GATHER) { const LAS int* _rs = (const LAS int*)(lds + STAGE_BYTES + wid * 1024); const int _nv = (u).nvalid - 1; \
        const int _r00 = _rs[min(R0, _nv)], _r01 = _rs[min(R1, _nv)], _r10 = _rs[min(128 + R0, _nv)], _r11 = _rs[min(128 + R1, _nv)]; \
        o0[0] = (unsigned)_r00 * ldaB + (unsigned)C0 * 2u; o0[1] = (unsigned)_r01 * ldaB + (unsigned)C1 * 2u; o1[0] = (unsigned)_r10 * ldaB + (unsigned)C0 * 2u; o1[1] = (unsigned)_r11 * ldaB + (unsigned)C1 * 2u; \
    } else { o0[0] = (unsigned)R0 * ldaB + (unsigned)C0 * 2u; o0[1] = (unsigned)R1 * ldaB + (unsigned)C1 * 2u; o1[0] = (unsigned)(128 + R0) * ldaB + (unsigned)C0 * 2u; o1[1] = (unsigned)(128 + R1) * ldaB + (unsigned)C1 * 2u; } } while (0)
    GUnit cur, nxt; int ui = 0;
    if (!S.next(0, cur)) return;
    f32x4 acc[2][2][4][2];
#pragma unroll
    for (int a = 0; a < 2; ++a)
#pragma unroll
        for (int b = 0; b < 2; ++b)
#pragma unroll
            for (int m = 0; m < 4; ++m)
#pragma unroll
                for (int n = 0; n < 2; ++n) acc[a][b][m][n] = (f32x4){0.f, 0.f, 0.f, 0.f};
    bf16x8 At[4][2], B0[2][2], B1[2][2];
    if (GATHER) { G8_XLOAD(cur); G8_WAIT_V(0); }
    G8_AOFF(cur, ac0, ac1);
    if (GATHER) { G8_WAIT_L(0); }
    const char* cA = cur.A; const char* cB = cur.B;
    G8_STAGE(G8_SB(0, 0), cB, voffB); G8_STAGE(G8_SB(0, 1), cB + hstepB, voffB); G8_STAGE(G8_SA(0, 0), cA, ac0); G8_STAGE(G8_SA(0, 1), cA, ac1);
    if (wr == 1) G8_BAR;
    G8_WAIT_V(2); G8_BAR;
    G8_STAGE(G8_SB(1, 0), cB + kstep, voffB); G8_STAGE(G8_SA(1, 0), cA + kstep, ac0); G8_STAGE(G8_SB(1, 1), cB + hstepB + kstep, voffB);
    G8_WAIT_V(6); G8_BAR;
    for (;;) {
        const bool has_next = S.next(ui + 1, nxt);
        const char* nA = has_next ? nxt.A : cA; const char* nB = has_next ? nxt.B : cB;
        an0[0] = ac0[0]; an0[1] = ac0[1]; an1[0] = ac1[0]; an1[1] = ac1[1];
        const bool xload = GATHER && has_next;
        if (xload) { G8_XLOAD(nxt); }
#pragma unroll 1
        for (int t = 0; t < nt; t += 2) {
            const bool last = (t == nt - 2);
            const char* a1 = cA + (size_t)(t + 1) * kstep;
            const char* a2 = last ? nA : cA + (size_t)(t + 2) * kstep; const char* b2 = last ? nB : cB + (size_t)(t + 2) * kstep;
            const char* a3 = a2 + kstep; const char* b3 = b2 + kstep;
            unsigned* x0 = last ? an0 : ac0; unsigned* x1 = last ? an1 : ac1;
            unsigned s0[2], s1[2]; s0[0] = x0[0]; s0[1] = x0[1]; s1[0] = x1[0]; s1[1] = x1[1];
            G8_LDB(B0, 0, 0); G8_LDB(B1, 0, 1); G8_SCHED; G8_LDA(At, 0, 0); G8_STAGE(G8_SA(1, 1), a1, ac1);
            if (xload && t == 0) { G8_WAIT_V(9); } else { G8_WAIT_V(8); }
            G8_WAIT_L(0); G8_BAR; G8_MMA(0, 0, At, B0); G8_MMA(0, 1, At, B1); G8_BAR; G8_SCHED;
            G8_LDA(At, 0, 1); G8_STAGE(G8_SB(0, 0), b2, voffB); G8_STAGE(G8_SB(0, 1), b2 + hstepB, voffB); G8_STAGE(G8_SA(0, 0), a2, s0);
            G8_WAIT_V(8); G8_WAIT_L(0); G8_BAR; G8_MMA(1, 0, At, B0); G8_MMA(1, 1, At, B1); G8_BAR; G8_SCHED;
            if (xload && t == 0) { G8_AOFF(nxt, an0, an1); }
            G8_LDB(B0, 1, 0); G8_LDB(B1, 1, 1); G8_SCHED; G8_LDA(At, 1, 0); G8_STAGE(G8_SA(0, 1), a2, s1);
            G8_WAIT_V(8); G8_WAIT_L(0); G8_BAR; G8_MMA(0, 0, At, B0); G8_MMA(0, 1, At, B1); G8_BAR; G8_SCHED;
            G8_LDA(At, 1, 1); G8_STAGE(G8_SB(1, 0), b3, voffB); G8_STAGE(G8_SB(1, 1), b3 + hstepB, voffB); G8_STAGE(G8_SA(1, 0), a3, s0);
            G8_WAIT_V(8); G8_WAIT_L(0); G8_BAR; G8_MMA(1, 0, At, B0); G8_MMA(1, 1, At, B1); G8_BAR; G8_SCHED;
        }
        if (wr == 0) G8_BAR;
#pragma unroll
        for (int ai = 0; ai < 2; ++ai)
#pragma unroll
            for (int m = 0; m < 4; ++m)
#pragma unroll
                for (int n = 0; n < 2; ++n) E(cur, cur.erow0 + ai * HALF + wr * 64 + m * 16 + fr, cur.ecol0 + wc * 32 + n * 16 + 4 * fq, acc[ai][0][m][n], acc[ai][1][m][n]);
        if (!has_next) break;
#pragma unroll
        for (int a = 0; a < 2; ++a)
#pragma unroll
            for (int b = 0; b < 2; ++b)
#pragma unroll
                for (int m = 0; m < 4; ++m)
#pragma unroll
                    for (int n = 0; n < 2; ++n) acc[a][b][m][n] = (f32x4){0.f, 0.f, 0.f, 0.f};
        cur = nxt; cA = nA; cB = nB; ++ui;
        ac0[0] = an0[0]; ac0[1] = an0[1]; ac1[0] = an1[0]; ac1[1] = an1[1];
        if (wr == 1) G8_BAR;
    }
    G8_WAIT_V(0);
    G8_BAR;
#undef G8_SA
#undef G8_SB
#undef G8_STAGE
#undef G8_LDA
#undef G8_LDB
#undef G8_MMA
#undef G8_WAIT_V
#undef G8_WAIT_L
#undef G8_BAR
#undef G8_SCHED
#undef G8_AOFF
#undef G8_XLOAD
}
}
template <class Epi>
__device__ __forceinline__ void dgemm_phase(const Ctx& c, const bf16* A, int lda, int M, const bf16* Bt, int ntn, int K, const Epi& E) {
    g8::DenseSched S{(const char*)A, (const char*)Bt, (size_t)lda * 2, (size_t)K * 2, M / 256, ntn, c.nblk, c.bid};
    g8::gemm_phase<false>(c.lds, (unsigned)lda * 2u, K, S, E);
    __syncthreads();
}

struct EpiInPB { bf16* PB; float* SM;
    __device__ __forceinline__ void operator()(int row, int col, f32x4 lo, f32x4 hi) const {
        st_bf4(PB + (size_t)row * NPB + col, lo);
        if ((col >> 8) == 7) *(f32x4*)(SM + (size_t)row * 128 + (col & 127)) = hi;
        else st_bf4(PB + (size_t)row * NPB + col + 128, hi);
    } };
struct EpiQ { bf16* QLAT; bf16* QIDX; const float* rstd;
    __device__ __forceinline__ void operator()(int row, int col, f32x4 lo, f32x4 hi) const {
        const float r = rstd[row];
        if (col < 1024) { st_bf4(QLAT + (size_t)row * 1024 + col, lo * r); st_bf4(QLAT + (size_t)row * 1024 + col + 128, hi * r); }
        else { st_bf4(QIDX + (size_t)row * 256 + (col - 1024), lo * r); st_bf4(QIDX + (size_t)row * 256 + (col - 1024) + 128, hi * r); }
    } };
struct EpiGate { bf16* G;
    __device__ __forceinline__ void operator()(int row, int col, f32x4 lo, f32x4 hi) const {
        f32x4 a, b;
#pragma unroll
        for (int i = 0; i < 4; ++i) { a[i] = sigmoidf_(lo[i]); b[i] = sigmoidf_(hi[i]); }
        st_bf4(G + (size_t)row * NG + col, a); st_bf4(G + (size_t)row * NG + col + 128, b);
    } };
struct EpiUp { bf16* M1; const bf16* G; int goff; int first;
    __device__ __forceinline__ void operator()(int row, int col, f32x4 lo, f32x4 hi) const {
        bf16* m = M1 + (size_t)row * 1024 + col; const bf16* g = G + (size_t)row * NG + goff + col;
        f32x4 a = ld_bf4(g) * lo, b = ld_bf4(g + 128) * hi;
        if (!first) { a += ld_bf4(m); b += ld_bf4(m + 128); }
        st_bf4(m, a); st_bf4(m + 128, b);
    } };
struct EpiWo { const float* res; float* out; const float* g1;
    __device__ __forceinline__ void operator()(int row, int col, f32x4 lo, f32x4 hi) const {
        const float* gp = g1 + (size_t)(row >> 11) * 6144 + col; const size_t o = (size_t)row * 1024 + col;
        const f32x4 ga = *(const f32x4*)gp, gb = *(const f32x4*)(gp + 128);
        const f32x4 ra = *(const f32x4*)(res + o), rb = *(const f32x4*)(res + o + 128);
        *(f32x4*)(out + o) = ra + ga * lo; *(f32x4*)(out + o + 128) = rb + gb * hi;
    } };
struct EpiG1 { bf16* HID; const float* wl; int cnt; int orow0;
    __device__ __forceinline__ void operator()(int row, int col, f32x4 lo, f32x4 hi) const {
        const int hc = col - 128 * (col >> 8);
        f32x4 v = (f32x4){0.f, 0.f, 0.f, 0.f};
        if (row < cnt) { const float w = wl ? wl[row] : 1.f;
#pragma unroll
            for (int i = 0; i < 4; ++i) v[i] = siluf_(lo[i]) * hi[i] * w; }
        st_bf4(HID + (size_t)(orow0 + row) * 256 + hc, v);
    } };
struct EpiG2 { bf16* Y; int orow0;
    __device__ __forceinline__ void operator()(int row, int col, f32x4 lo, f32x4 hi) const {
        st_bf4(Y + (size_t)(orow0 + row) * 1024 + col, lo); st_bf4(Y + (size_t)(orow0 + row) * 1024 + col + 128, hi);
    } };


template <class F> struct EpiU { F f; __device__ __forceinline__ void operator()(const g8::GUnit&, int row, int col, f32x4 lo, f32x4 hi) const { f(row, col, lo, hi); } };

__device__ __forceinline__ void phase_prologue(const Ctx& c) {
    {
        LAS float* cs = (LAS float*)c.lds;
        LAS float* red = (LAS float*)(c.lds + 65536);
        const float* cin = c.in[IN_C];
        if (c.bid < 192) {
            for (int i = c.tid; i < 16 * 1024; i += NTHR) cs[i] = siluf_(cin[i]);
            __syncthreads();
        }
        float* MOD = (float*)(c.ws + WS_MOD);
        for (int it = c.bid; it < 192; it += c.nblk) {
            const int l = it / 96, cg = it % 96, col = cg * 64 + c.lane;
            const float* W = c.in[IN_ADAW] + (size_t)l * 1024 * 6144 + col;
            float acc[16];
#pragma unroll
            for (int b = 0; b < 16; ++b) acc[b] = 0.f;
            const int kbeg = c.wave * 128;
            for (int k = kbeg; k < kbeg + 128; k += 4) {
                const float w0 = W[(size_t)k * 6144], w1 = W[(size_t)(k + 1) * 6144], w2 = W[(size_t)(k + 2) * 6144], w3 = W[(size_t)(k + 3) * 6144];
#pragma unroll
                for (int b = 0; b < 16; ++b) { const f32x4 v = *(const LAS f32x4*)(cs + b * 1024 + k); acc[b] += v[0] * w0 + v[1] * w1 + v[2] * w2 + v[3] * w3; }
            }
#pragma unroll
            for (int b = 0; b < 16; ++b) red[(c.wave * 16 + b) * 64 + c.lane] = acc[b];
            __syncthreads();
            for (int i = c.tid; i < 16 * 64; i += NTHR) { const int b = i >> 6, ln = i & 63; float s = 0.f;
#pragma unroll
                for (int w = 0; w < 8; ++w) s += red[(w * 16 + b) * 64 + ln];
                MOD[((size_t)l * 16 + b) * 6144 + cg * 64 + ln] = s + c.in[IN_ADAB][l * 6144 + cg * 64 + ln]; }
            __syncthreads();
        }
        __syncthreads();
    }
    {
        LAS float* scr = (LAS float*)(c.lds + c.wave * 16384);
        const int gw = c.bid * NWAVES + c.wave, NGW = c.nblk * NWAVES;
        constexpr int I_WIN = (NINP / 32) * (1024 / 64), I_UP = (1024 / 32) * (512 / 64), I_WO = (1024 / 32) * (1024 / 64);
        constexpr int PER_L = I_WIN + 2 * I_UP + I_WO;
        for (int it = gw; it < NL * PER_L; it += NGW) {
            const int l = it / PER_L; int r = it % PER_L;
            if (r < I_WIN) { SrcWin s{c.in[IN_WIN] + (size_t)l * 1024 * NIN, NIN}; tr_item(s, (bf16*)(c.ws + WS_WIN) + (size_t)l * NINP * 1024, 1024, (r / 16) * 32, (r % 16) * 64, scr, c.lane); continue; }
            r -= I_WIN;
            if (r < I_UP) { SrcPlain s{c.in[IN_WUPA] + (size_t)l * 512 * 1024, 1024}; tr_item(s, (bf16*)(c.ws + WS_WUPA) + (size_t)l * 1024 * 512, 512, (r / 8) * 32, (r % 8) * 64, scr, c.lane); continue; }
            r -= I_UP;
            if (r < I_UP) { SrcPlain s{c.in[IN_WUPC] + (size_t)l * 512 * 1024, 1024}; tr_item(s, (bf16*)(c.ws + WS_WUPC) + (size_t)l * 1024 * 512, 512, (r / 8) * 32, (r % 8) * 64, scr, c.lane); continue; }
            r -= I_UP;
            { SrcPlain s{c.in[IN_WO] + (size_t)l * 1024 * 1024, 1024}; tr_item(s, (bf16*)(c.ws + WS_WO) + (size_t)l * 1024 * 1024, 1024, (r / 16) * 32, (r % 16) * 64, scr, c.lane); }
        }
    }
    {
        const int gt = c.bid * NTHR + c.tid, NGT = c.nblk * NTHR;
        for (int i = gt; i < T; i += NGT) ((int*)(c.ws + WS_IDENT))[i] = i;
        for (int it = gt; it < NL * 1280 * 32; it += NGT) {
            const int l = it / (1280 * 32), rem = it % (1280 * 32), n = rem / 32, r0 = (rem % 32) * 8;
            const float* gq = c.in[IN_DSA_NQ] + l * 256;
            float o[8];
            if (n < 1024) {
                const int h = n >> 7, cc = n & 127;
                const float* uk = c.in[IN_DSA_WUK] + (size_t)l * 128 * 512 + (size_t)cc * 512 + h * 64;
#pragma unroll
                for (int i = 0; i < 8; ++i) { const float* uq = c.in[IN_DSA_WUQ] + (size_t)l * 256 * 512 + (size_t)(r0 + i) * 512 + h * 64; float s = 0.f;
                    for (int d = 0; d < 64; ++d) s += uq[d] * uk[d];
                    o[i] = s * 0.125f * gq[r0 + i]; }
            } else {
                const int m = n - 1024;
#pragma unroll
                for (int i = 0; i < 8; ++i) o[i] = c.in[IN_DSA_WQI][(size_t)l * 256 * 256 + (size_t)(r0 + i) * 256 + m] * 0.17677669529663687f * gq[r0 + i];
            }
            u32x4 w; w.x = pk2(o[0], o[1]); w.y = pk2(o[2], o[3]); w.z = pk2(o[4], o[5]); w.w = pk2(o[6], o[7]);
            *(u32x4*)((bf16*)(c.ws + WS_WQ) + (size_t)l * 1280 * 256 + (size_t)n * 256 + r0) = w;
        }
    }
    {
        const int gt = c.bid * NTHR + c.tid, NGT = c.nblk * NTHR;
        for (int it = gt; it < NL * 128 * 1024; it += NGT) {
            const int l = it / (128 * 1024), rem = it % (128 * 1024), kc = rem / 1024, n = rem % 1024;
            const int h = kc >> 4, r0 = (kc & 15) * 8;
            const float* uv = c.in[IN_DSA_WUV] + (size_t)l * 128 * 512;
            const float* ub = c.in[IN_WUPB] + (size_t)l * 512 * 1024 + (size_t)(h * 64) * 1024 + n;
            float o[8];
#pragma unroll
            for (int i = 0; i < 8; ++i) o[i] = 0.f;
            for (int v = 0; v < 64; ++v) { const float b = ub[(size_t)v * 1024];
#pragma unroll
                for (int i = 0; i < 8; ++i) o[i] += uv[(size_t)(r0 + i) * 512 + h * 64 + v] * b; }
            u32x4 w; w.x = pk2(o[0], o[1]); w.y = pk2(o[2], o[3]); w.z = pk2(o[4], o[5]); w.w = pk2(o[6], o[7]);
            *(u32x4*)((bf16*)(c.ws + WS_WUVB) + (size_t)l * 1024 * 1024 + (size_t)n * 1024 + h * 128 + r0) = w;
        }
    }
}

__device__ __forceinline__ void norm_mod_row(const float* xrow, const float* gain, const float* sh, const float* sc, bf16* orow, int lane) {
    f32x4 v[4]; float s = 0.f;
#pragma unroll
    for (int j = 0; j < 4; ++j) { v[j] = *(const f32x4*)(xrow + 4 * (lane + 64 * j)); s += v[j][0] * v[j][0] + v[j][1] * v[j][1] + v[j][2] * v[j][2] + v[j][3] * v[j][3]; }
    const float rstd = rsqrtf(wave_sum(s) * (1.f / D) + EPS);
#pragma unroll
    for (int j = 0; j < 4; ++j) { const int cc = 4 * (lane + 64 * j);
        const f32x4 g = *(const f32x4*)(gain + cc), a = *(const f32x4*)(sc + cc), b = *(const f32x4*)(sh + cc);
        st_bf4(orow + cc, v[j] * rstd * g * (a + 1.f) + b); }
}
__device__ __forceinline__ void phase_norm1(const Ctx& c, int l, const float* xsrc) {
    const int gw = c.bid * NWAVES + c.wave, NGW = c.nblk * NWAVES;
    const float* MOD = (const float*)(c.ws + WS_MOD) + (size_t)l * 16 * 6144;
    bf16* XN = (bf16*)(c.ws + WS_XN);
    for (int t = gw; t < T; t += NGW) { const int b = t >> 11;
        norm_mod_row(xsrc + (size_t)t * D, c.in[IN_NMIX] + l * D, MOD + (size_t)b * 6144, MOD + (size_t)b * 6144 + 1024, XN + (size_t)t * D, c.lane); }
}

__device__ __forceinline__ void phase_prep(const Ctx& c, int l) {
    const int gw = c.bid * NWAVES + c.wave, NGW = c.nblk * NWAVES;
    const bf16* PB = (const bf16*)(c.ws + WS_PB); const float* SM = (const float*)(c.ws + WS_SM);
    bf16* CKVN = (bf16*)(c.ws + WS_CKVN); bf16* KIDX = (bf16*)(c.ws + WS_KIDX); float* RSTDQ = (float*)(c.ws + WS_RSTDQ);
    const float* gkv = c.in[IN_DSA_NKV] + l * 128;
    for (int t = gw; t < T; t += NGW) {
        const bf16* row = PB + (size_t)t * NPB;
        const unsigned kv = *(const unsigned*)(row + PB_CKV + 2 * c.lane);
        const float k0 = bflo(kv), k1 = bfhi(kv);
        const float rs = rsqrtf(wave_sum(k0 * k0 + k1 * k1) * (1.f / 128.f) + EPS);
        *(unsigned*)(CKVN + (size_t)t * 128 + 2 * c.lane) = pk2(k0 * rs * gkv[2 * c.lane], k1 * rs * gkv[2 * c.lane + 1]);
        const f32x4 q = ld_bf4(row + PB_CQ + 4 * c.lane);
        const float rq = rsqrtf(wave_sum(q[0] * q[0] + q[1] * q[1] + q[2] * q[2] + q[3] * q[3]) * (1.f / 256.f) + EPS);
        if (c.lane == 0) RSTDQ[t] = rq;
        if (c.lane < 32) KIDX[(size_t)t * 32 + c.lane] = (bf16)f2bf(SM[(size_t)t * 128 + SM_KIDX + c.lane]);
    }
}

constexpr int TS = 16;
__device__ __forceinline__ void scan_gla_item(const Ctx& c, int l, int b, int h) {
    LAS float* q_s = (LAS float*)c.lds;
    LAS float* k_s = q_s + TS * 64;
    LAS float* a_s = k_s + TS * 64;
    LAS float* v_s = a_s + TS * 64;
    LAS float* part = v_s + TS * 128;
    LAS float* wa2 = part + TS * 4 * 128;
    LAS float* ba = wa2 + 16 * 64;
    LAS float* alr = ba + 64;
    const bf16* PB = (const bf16*)(c.ws + WS_PB); const float* SM = (const float*)(c.ws + WS_SM);
    bf16* UA = (bf16*)(c.ws + WS_UA);
    const float* gn = c.in[IN_GLA_NORM] + l * 512 + h * 128;
    for (int i = c.tid; i < 16 * 64; i += NTHR) wa2[i] = c.in[IN_GLA_WA2][(size_t)l * 16 * 256 + (i >> 6) * 256 + h * 64 + (i & 63)];
    if (c.tid < 64) ba[c.tid] = c.in[IN_GLA_BA][l * 256 + h * 64 + c.tid];
    const int v = c.tid & 127, kg = c.tid >> 7;
    float S[16];
#pragma unroll
    for (int i = 0; i < 16; ++i) S[i] = 0.f;
    for (int t0 = 0; t0 < SEQ; t0 += TS) {
        __syncthreads();
        const size_t rb = (size_t)b * SEQ + t0;
        for (int i = c.tid; i < TS * 64; i += NTHR) { const int s = i >> 6, cc = i & 63; const bf16* row = PB + (rb + s) * NPB;
            q_s[i] = bf2f(row[PB_QA + h * 64 + cc]) * 0.125f; k_s[i] = bf2f(row[PB_KA + h * 64 + cc]); }
        for (int i = c.tid; i < TS * 128; i += NTHR) { const int s = i >> 7, cc = i & 127; v_s[i] = bf2f(PB[(rb + s) * NPB + PB_VA + h * 128 + cc]); }
        if (c.tid < TS * 16) alr[c.tid] = SM[(rb + (c.tid >> 4)) * 128 + SM_ALR + (c.tid & 15)];
        __syncthreads();
        for (int i = c.tid; i < TS * 64; i += NTHR) { const int s = i >> 6, cc = i & 63; float x = ba[cc];
#pragma unroll
            for (int j = 0; j < 16; ++j) x += alr[s * 16 + j] * wa2[j * 64 + cc];
            a_s[i] = __expf(logsigmoidf_(x) * (1.f / 16.f)); }
        __syncthreads();
#pragma unroll 1
        for (int s = 0; s < TS; ++s) {
            const float vv = v_s[s * 128 + v]; float acc = 0.f;
#pragma unroll
            for (int i4 = 0; i4 < 4; ++i4) {
                const f32x4 a4 = *(const LAS f32x4*)(a_s + s * 64 + kg * 16 + i4 * 4), k4 = *(const LAS f32x4*)(k_s + s * 64 + kg * 16 + i4 * 4), q4 = *(const LAS f32x4*)(q_s + s * 64 + kg * 16 + i4 * 4);
#pragma unroll
                for (int j = 0; j < 4; ++j) { S[i4 * 4 + j] = a4[j] * S[i4 * 4 + j] + k4[j] * vv; acc += q4[j] * S[i4 * 4 + j]; }
            }
            part[(s * 4 + kg) * 128 + v] = acc;
        }
        __syncthreads();
        {
            const int s = c.tid >> 5, vq = c.tid & 31, v0 = vq * 4;
            f32x4 o = (f32x4){0.f, 0.f, 0.f, 0.f};
#pragma unroll
            for (int g = 0; g < 4; ++g) o += *(const LAS f32x4*)(part + (s * 4 + g) * 128 + v0);
            float ss = o[0] * o[0] + o[1] * o[1] + o[2] * o[2] + o[3] * o[3];
#pragma unroll
            for (int m = 1; m < 32; m <<= 1) ss += __shfl_xor(ss, m);
            const float rstd = rsqrtf(ss * (1.f / 128.f) + EPS);
            const f32x4 ga = ld_bf4(PB + (rb + s) * NPB + PB_GA + h * 128 + v0);
            f32x4 r;
#pragma unroll
            for (int j = 0; j < 4; ++j) r[j] = o[j] * rstd * gn[v0 + j] * siluf_(ga[j]);
            st_bf4(UA + (rb + s) * 512 + h * 128 + v0, r);
        }
    }
    __syncthreads();
}
__device__ __forceinline__ void scan_mlstm_item(const Ctx& c, int l, int b, int h) {
    LAS float* q_s = (LAS float*)c.lds;
    LAS float* k_s = q_s + TS * 64;
    LAS float* v_s = k_s + TS * 64;
    LAS float* part = v_s + TS * 128;
    LAS float* dpart = part + TS * 4 * 128;
    LAS float* lf_s = dpart + TS * 4;
    LAS float* ip_s = lf_s + TS;
    LAS float* m_s = ip_s + TS;
    LAS float* cw = m_s + TS;
    const bf16* PB = (const bf16*)(c.ws + WS_PB); const float* SM = (const float*)(c.ws + WS_SM);
    bf16* UC = (bf16*)(c.ws + WS_UC);
    const float* mn = c.in[IN_ML_NORM] + l * 512 + h * 128;
    if (c.tid < 4 * 128) { const int j = c.tid >> 7, cc = c.tid & 127; cw[c.tid] = c.in[IN_ML_CONV][(size_t)l * 4 * 512 + j * 512 + (cc < 64 ? h * 64 + cc : 256 + h * 64 + (cc - 64))]; }
    const float bi = c.in[IN_ML_BI][l * 4 + h], bfv = c.in[IN_ML_BF][l * 4 + h];
    const int v = c.tid & 127, kg = c.tid >> 7;
    float C[16], n[16]; float m = 0.f;
#pragma unroll
    for (int i = 0; i < 16; ++i) { C[i] = 0.f; n[i] = 0.f; }
    for (int t0 = 0; t0 < SEQ; t0 += TS) {
        __syncthreads();
        const size_t rb = (size_t)b * SEQ + t0;
        for (int i = c.tid; i < TS * 128; i += NTHR) { const int s = i >> 7, cc = i & 127;
            const int col = cc < 64 ? PB_QC + h * 64 + cc : PB_KC + h * 64 + (cc - 64);
            float x = 0.f;
#pragma unroll
            for (int j = 0; j < 4; ++j) { const int tt = t0 + s - 3 + j; if (tt >= 0) x += cw[j * 128 + cc] * bf2f(PB[((size_t)b * SEQ + tt) * NPB + col]); }
            x = siluf_(x);
            if (cc < 64) q_s[s * 64 + cc] = x * 0.125f; else k_s[s * 64 + (cc - 64)] = x; }
        for (int i = c.tid; i < TS * 128; i += NTHR) { const int s = i >> 7, cc = i & 127; v_s[i] = bf2f(PB[(rb + s) * NPB + PB_VC + h * 128 + cc]); }
        if (c.tid < TS) { ip_s[c.tid] = SM[(rb + c.tid) * 128 + SM_IC + h] + bi; lf_s[c.tid] = logsigmoidf_(SM[(rb + c.tid) * 128 + SM_FC + h] + bfv); }
        __syncthreads();
#pragma unroll 1
        for (int s = 0; s < TS; ++s) {
            const float lf = lf_s[s], ip = ip_s[s];
            const float mnew = fmaxf(lf + m, ip), fg = __expf(lf + m - mnew), ig = __expf(ip - mnew);
            m = mnew;
            const float vv = v_s[s * 128 + v] * ig; float num = 0.f, den = 0.f;
#pragma unroll
            for (int i4 = 0; i4 < 4; ++i4) {
                const f32x4 k4 = *(const LAS f32x4*)(k_s + s * 64 + kg * 16 + i4 * 4), q4 = *(const LAS f32x4*)(q_s + s * 64 + kg * 16 + i4 * 4);
#pragma unroll
                for (int j = 0; j < 4; ++j) { C[i4 * 4 + j] = fg * C[i4 * 4 + j] + k4[j] * vv; n[i4 * 4 + j] = fg * n[i4 * 4 + j] + ig * k4[j]; num += q4[j] * C[i4 * 4 + j]; den += q4[j] * n[i4 * 4 + j]; }
            }
            part[(s * 4 + kg) * 128 + v] = num;
            if (v == 0) dpart[s * 4 + kg] = den;
            if (c.tid == 0) m_s[s] = m;
        }
        __syncthreads();
        {
            const int s = c.tid >> 5, vq = c.tid & 31, v0 = vq * 4;
            f32x4 o = (f32x4){0.f, 0.f, 0.f, 0.f};
#pragma unroll
            for (int g = 0; g < 4; ++g) o += *(const LAS f32x4*)(part + (s * 4 + g) * 128 + v0);
            const float den = dpart[s * 4] + dpart[s * 4 + 1] + dpart[s * 4 + 2] + dpart[s * 4 + 3];
            const float dd = 1.f / fmaxf(fabsf(den), __expf(-m_s[s]));
            o = o * dd;
            float ss = o[0] * o[0] + o[1] * o[1] + o[2] * o[2] + o[3] * o[3];
#pragma unroll
            for (int mm = 1; mm < 32; mm <<= 1) ss += __shfl_xor(ss, mm);
            const float rstd = rsqrtf(ss * (1.f / 128.f) + EPS);
            const f32x4 oc = ld_bf4(PB + (rb + s) * NPB + PB_OC + h * 128 + v0);
            f32x4 r;
#pragma unroll
            for (int j = 0; j < 4; ++j) r[j] = o[j] * rstd * mn[v0 + j] * sigmoidf_(oc[j]);
            st_bf4(UC + (rb + s) * 512 + h * 128 + v0, r);
        }
    }
    __syncthreads();
}

constexpr int LQ = 72;
constexpr int SC_QT = 0, SC_KT = 9216, SC_KTT = 18432, SC_Q2 = 27648, SC_SC = 36864, SC_VT = 46080, SC_ST = 66816, SC_FL = 108288;
__device__ __forceinline__ float wave_scan_add(float x, int lane) {
#pragma unroll
    for (int d = 1; d < 64; d <<= 1) { const float y = __shfl_up(x, d); if (lane >= d) x += y; }
    return x;
}
__device__ __forceinline__ float wave_scan_max(float x, int lane) {
#pragma unroll
    for (int d = 1; d < 64; d <<= 1) { const float y = __shfl_up(x, d); if (lane >= d) x = fmaxf(x, y); }
    return x;
}
__device__ __forceinline__ void unpack8(u32x4 w, float (&f)[8]) { f[0] = bflo(w.x); f[1] = bfhi(w.x); f[2] = bflo(w.y); f[3] = bfhi(w.y); f[4] = bflo(w.z); f[5] = bfhi(w.z); f[6] = bflo(w.w); f[7] = bfhi(w.w); }
__device__ __forceinline__ u32x4 pack8(const float (&f)[8]) { u32x4 w; w.x = pk2(f[0], f[1]); w.y = pk2(f[2], f[3]); w.z = pk2(f[4], f[5]); w.w = pk2(f[6], f[7]); return w; }
template <bool ML>
__device__ __forceinline__ void scan_chunked_item(const Ctx& c, int l, int b, int h) {
    LAS bf16* Qt0 = (LAS bf16*)(c.lds + SC_QT); LAS bf16* Kt0 = (LAS bf16*)(c.lds + SC_KT); LAS bf16* KtT0 = (LAS bf16*)(c.lds + SC_KTT);
    LAS bf16* Q20 = (LAS bf16*)(c.lds + SC_Q2); LAS bf16* Sc0 = (LAS bf16*)(c.lds + SC_SC); LAS bf16* VT0 = (LAS bf16*)(c.lds + SC_VT);
    LAS bf16* ST0 = (LAS bf16*)(c.lds + SC_ST);
    LAS float* segtot = (LAS float*)(c.lds + SC_FL);
    LAS float* etot = segtot + 512;
    LAS float* ssq = etot + 64;
    LAS float* dn = ssq + 512;
    LAS float* wa2 = dn + 64;
    LAS float* ba = wa2 + 1024;
    LAS float* cw = ba + 64;
    const int tid = c.tid, lane = c.lane, w = c.wave, fr = lane & 15, fq = lane >> 4;
    const int srow = tid >> 3, kg = tid & 7, k8 = kg * 8, vrow = tid >> 4, vc8 = (tid & 15) * 8;
    const bf16* PB = (const bf16*)(c.ws + WS_PB); const float* SM = (const float*)(c.ws + WS_SM);
    bf16* UO = (bf16*)(c.ws + (ML ? WS_UC : WS_UA));
    const int QCOL = (ML ? PB_QC : PB_QA) + h * 64, KCOL = (ML ? PB_KC : PB_KA) + h * 64, VCOL = (ML ? PB_VC : PB_VA) + h * 128, GCOL = (ML ? PB_OC : PB_GA) + h * 128;
    const float* gnorm = c.in[ML ? IN_ML_NORM : IN_GLA_NORM] + l * 512 + h * 128;
    __syncthreads();
    if (!ML) { for (int i = tid; i < 1024; i += NTHR) wa2[i] = c.in[IN_GLA_WA2][(size_t)l * 16 * 256 + (i >> 6) * 256 + h * 64 + (i & 63)];
               if (tid < 64) ba[tid] = c.in[IN_GLA_BA][l * 256 + h * 64 + tid]; }
    else { if (tid < 512) { const int j = tid >> 7, cc = tid & 127; cw[tid] = c.in[IN_ML_CONV][(size_t)l * 4 * 512 + j * 512 + (cc < 64 ? h * 64 + cc : 256 + h * 64 + (cc - 64))]; } }
    for (int i = tid; i < 144 * LQ / 2; i += NTHR) ((LAS unsigned*)ST0)[i] = 0u;
    if (ML) { for (int i = tid; i < 16 * LQ; i += NTHR) VT0[128 * LQ + i] = (i < 64) ? (bf16)0x3f80u : (bf16)0u; }
    const float bi = ML ? c.in[IN_ML_BI][l * 4 + h] : 0.f, bfv = ML ? c.in[IN_ML_BF][l * 4 + h] : 0.f;
    float m_prev = 0.f;
    f32x4 Sacc[4], Nacc = (f32x4){0.f, 0.f, 0.f, 0.f};
#pragma unroll
    for (int i = 0; i < 4; ++i) Sacc[i] = (f32x4){0.f, 0.f, 0.f, 0.f};
    u32x4 rq[ML ? 4 : 1], rk[ML ? 4 : 1], rv[2]; f32x4 ra[4]; float ric = 0.f, rfc = 0.f;
    const u32x4 z4 = (u32x4){0u, 0u, 0u, 0u};
#define SC_LOAD(cch) do { const size_t _g = (size_t)b * SEQ + (size_t)(cch) * 64; \
        if (ML) { _Pragma("unroll") for (int _j = 0; _j < 4; ++_j) { const int _tt = (cch) * 64 + srow - 3 + _j; \
                rq[_j] = _tt >= 0 ? *(const u32x4*)(PB + ((size_t)b * SEQ + _tt) * NPB + QCOL + k8) : z4; rk[_j] = _tt >= 0 ? *(const u32x4*)(PB + ((size_t)b * SEQ + _tt) * NPB + KCOL + k8) : z4; } \
            ric = SM[(_g + lane) * 128 + SM_IC + h]; rfc = SM[(_g + lane) * 128 + SM_FC + h]; } \
        else { rq[0] = *(const u32x4*)(PB + (_g + srow) * NPB + QCOL + k8); rk[0] = *(const u32x4*)(PB + (_g + srow) * NPB + KCOL + k8); \
            _Pragma("unroll") for (int _j = 0; _j < 4; ++_j) ra[_j] = *(const f32x4*)(SM + (_g + srow) * 128 + SM_ALR + 4 * _j); } \
        rv[0] = *(const u32x4*)(PB + (_g + vrow) * NPB + VCOL + vc8); rv[1] = *(const u32x4*)(PB + (_g + 32 + vrow) * NPB + VCOL + vc8); } while (0)
    SC_LOAD(0);
    __syncthreads();
#pragma unroll 1
    for (int cch = 0; cch < SEQ / 64; ++cch) {
        const size_t grow = (size_t)b * SEQ + (size_t)cch * 64;
        int lz; asm volatile("v_mov_b32 %0, 0" : "=v"(lz));
        LAS bf16* Qt = Qt0 + lz; LAS bf16* Kt = Kt0 + lz; LAS bf16* KtT = KtT0 + lz; LAS bf16* Q2 = Q20 + lz; LAS bf16* Sc = Sc0 + lz; LAS bf16* VT = VT0 + lz; LAS bf16* ST = ST0 + lz;
        LAS bf16* STc = ST + (cch & 1) * 144 * LQ; LAS bf16* STn = ST + ((cch & 1) ^ 1) * 144 * LQ;
        float qv[8], kv[8];
        float g_a = 0.f, g_M = 0.f, g_bc = 0.f, M63 = 0.f, wc = 1.f;
        if (!ML) {
            unpack8(rq[0], qv); unpack8(rk[0], kv);
            float la[8];
#pragma unroll
            for (int i = 0; i < 8; ++i) la[i] = ba[k8 + i];
#pragma unroll
            for (int j4 = 0; j4 < 4; ++j4)
#pragma unroll
                for (int jj = 0; jj < 4; ++jj) { const float a = ra[j4][jj]; const LAS float* wr_ = wa2 + (j4 * 4 + jj) * 64 + k8;
                    const f32x4 w0 = *(const LAS f32x4*)wr_, w1 = *(const LAS f32x4*)(wr_ + 4);
                    la[0] += a * w0[0]; la[1] += a * w0[1]; la[2] += a * w0[2]; la[3] += a * w0[3]; la[4] += a * w1[0]; la[5] += a * w1[1]; la[6] += a * w1[2]; la[7] += a * w1[3]; }
#pragma unroll
            for (int i = 0; i < 8; ++i) { float x = logsigmoid_fast(la[i]) * (1.f / 16.f);
#pragma unroll
                for (int d = 8; d < 64; d <<= 1) { const float y = __shfl_up(x, d); if (lane >= d) x += y; }
                la[i] = x; }
            if ((lane >> 3) == 7) { *(LAS f32x4*)(segtot + w * 64 + k8) = (f32x4){la[0], la[1], la[2], la[3]}; *(LAS f32x4*)(segtot + w * 64 + k8 + 4) = (f32x4){la[4], la[5], la[6], la[7]}; }
            __syncthreads();
            float tot[8];
#pragma unroll
            for (int i = 0; i < 8; ++i) tot[i] = 0.f;
#pragma unroll
            for (int ww = 0; ww < 8; ++ww) { const f32x4 s0 = *(const LAS f32x4*)(segtot + ww * 64 + k8), s1 = *(const LAS f32x4*)(segtot + ww * 64 + k8 + 4);
                const float sel = ww < w ? 1.f : 0.f;
                la[0] += sel * s0[0]; la[1] += sel * s0[1]; la[2] += sel * s0[2]; la[3] += sel * s0[3]; la[4] += sel * s1[0]; la[5] += sel * s1[1]; la[6] += sel * s1[2]; la[7] += sel * s1[3];
                tot[0] += s0[0]; tot[1] += s0[1]; tot[2] += s0[2]; tot[3] += s0[3]; tot[4] += s1[0]; tot[5] += s1[1]; tot[6] += s1[2]; tot[7] += s1[3]; }
            if (tid < 8) {
#pragma unroll
                for (int i = 0; i < 8; ++i) etot[k8 + i] = __expf(tot[i]); }
            float kt[8];
#pragma unroll
            for (int i = 0; i < 8; ++i) { qv[i] = qv[i] * 0.125f * __expf(la[i]); kt[i] = kv[i] * __expf(-la[i]); }
            *(LAS u32x4*)(Qt + srow * LQ + k8) = pack8(qv); *(LAS u32x4*)(Kt + srow * LQ + k8) = pack8(kt);
#pragma unroll
            for (int i = 0; i < 8; ++i) KtT[(k8 + i) * LQ + srow] = (bf16)f2bf(kt[i]);
        } else {
            float x4[4][8];
#pragma unroll
            for (int j = 0; j < 4; ++j) unpack8(rq[j], x4[j]);
#pragma unroll
            for (int i = 0; i < 8; ++i) { float x = 0.f;
#pragma unroll
                for (int j = 0; j < 4; ++j) x += cw[j * 128 + k8 + i] * x4[j][i];
                qv[i] = siluf_(x) * 0.125f; }
#pragma unroll
            for (int j = 0; j < 4; ++j) unpack8(rk[j], x4[j]);
#pragma unroll
            for (int i = 0; i < 8; ++i) { float x = 0.f;
#pragma unroll
                for (int j = 0; j < 4; ++j) x += cw[j * 128 + 64 + k8 + i] * x4[j][i];
                kv[i] = siluf_(x); }
            const float lf = logsigmoid_fast(rfc + bfv), ip = ric + bi;
            g_bc = wave_scan_add(lf, lane); g_a = ip - g_bc;
            const float pm = wave_scan_max(g_a, lane); g_M = fmaxf(m_prev, pm);
            M63 = __shfl(g_M, 63); const float totb = __shfl(g_bc, 63);
            wc = __expf(m_prev - M63);
            const float Ms = __shfl(g_M, srow), as = __shfl(g_a, srow);
            const float e1 = __expf(m_prev - Ms), e2 = __expf(as - M63);
            float q2[8], kw[8];
#pragma unroll
            for (int i = 0; i < 8; ++i) { q2[i] = qv[i] * e1; kw[i] = kv[i] * e2; }
            *(LAS u32x4*)(Qt + srow * LQ + k8) = pack8(qv); *(LAS u32x4*)(Kt + srow * LQ + k8) = pack8(kv); *(LAS u32x4*)(Q2 + srow * LQ + k8) = pack8(q2);
#pragma unroll
            for (int i = 0; i < 8; ++i) KtT[(k8 + i) * LQ + srow] = (bf16)f2bf(kw[i]);
            m_prev = totb + M63;
        }
        { float v0[8], v1[8]; unpack8(rv[0], v0); unpack8(rv[1], v1);
#pragma unroll
          for (int i = 0; i < 8; ++i) { VT[(vc8 + i) * LQ + vrow] = (bf16)f2bf(v0[i]); VT[(vc8 + i) * LQ + 32 + vrow] = (bf16)f2bf(v1[i]); } }
        u32x2 gate[4];
#pragma unroll
        for (int ti = 0; ti < 4; ++ti) gate[ti] = *(const u32x2*)(PB + (grow + 16 * ti + fr) * NPB + GCOL + 16 * w + 4 * fq);
        if (cch + 1 < SEQ / 64) SC_LOAD(cch + 1);
        __syncthreads();
        {
            const int ti = w >> 1;
#pragma unroll
            for (int u = 0; u < 2; ++u) {
                const int sj = 2 * (w & 1) + u;
                f32x4 d = (f32x4){0.f, 0.f, 0.f, 0.f};
                if (sj <= ti) {
#pragma unroll
                    for (int ks = 0; ks < 2; ++ks) { const bf16x8 a = *(const LAS bf16x8*)(Kt + (16 * sj + fr) * LQ + 32 * ks + 8 * fq), bb = *(const LAS bf16x8*)(Qt + (16 * ti + fr) * LQ + 32 * ks + 8 * fq);
                        d = __builtin_amdgcn_mfma_f32_16x16x32_bf16(a, bb, d, 0, 0, 0); }
                    const int t = 16 * ti + fr, s0 = 16 * sj + 4 * fq;
                    if (ML) { const float Mt = __shfl(g_M, t);
#pragma unroll
                        for (int r = 0; r < 4; ++r) { const float as = __shfl(g_a, s0 + r); d[r] = (s0 + r <= t) ? d[r] * __expf(as - Mt) : 0.f; } }
                    else {
#pragma unroll
                        for (int r = 0; r < 4; ++r) d[r] = (s0 + r <= t) ? d[r] : 0.f; }
                }
                { u32x2 pk; pk.x = pk2(d[0], d[1]); pk.y = pk2(d[2], d[3]); *(LAS u32x2*)(Sc + (16 * ti + fr) * LQ + 16 * sj + 4 * fq) = pk; }
            }
        }
        __syncthreads();
        const LAS bf16* Qm = ML ? Q2 : Qt;
        f32x4 o[4];
        {
            bf16x8 vt[2], stf[2];
#pragma unroll
            for (int ks = 0; ks < 2; ++ks) { vt[ks] = *(const LAS bf16x8*)(VT + (16 * w + fr) * LQ + 32 * ks + 8 * fq); stf[ks] = *(const LAS bf16x8*)(STc + (16 * w + fr) * LQ + 32 * ks + 8 * fq); }
#pragma unroll
            for (int ti = 0; ti < 4; ++ti) {
                f32x4 d = (f32x4){0.f, 0.f, 0.f, 0.f};
#pragma unroll
                for (int ks = 0; ks < 2; ++ks) { const bf16x8 sc = *(const LAS bf16x8*)(Sc + (16 * ti + fr) * LQ + 32 * ks + 8 * fq); d = __builtin_amdgcn_mfma_f32_16x16x32_bf16(vt[ks], sc, d, 0, 0, 0); }
#pragma unroll
                for (int ks = 0; ks < 2; ++ks) { const bf16x8 qq = *(const LAS bf16x8*)(Qm + (16 * ti + fr) * LQ + 32 * ks + 8 * fq); d = __builtin_amdgcn_mfma_f32_16x16x32_bf16(stf[ks], qq, d, 0, 0, 0); }
                o[ti] = d;
            }
#pragma unroll
            for (int kj = 0; kj < 4; ++kj) {
                f32x4 d = (f32x4){0.f, 0.f, 0.f, 0.f};
#pragma unroll
                for (int ks = 0; ks < 2; ++ks) { const bf16x8 kk = *(const LAS bf16x8*)(KtT + (16 * kj + fr) * LQ + 32 * ks + 8 * fq); d = __builtin_amdgcn_mfma_f32_16x16x32_bf16(kk, vt[ks], d, 0, 0, 0); }
                if (ML) Sacc[kj] = Sacc[kj] * wc + d;
                else { const f32x4 e4 = *(const LAS f32x4*)(etot + 16 * kj + 4 * fq); Sacc[kj] = e4 * (Sacc[kj] + d); }
                u32x2 pk; pk.x = pk2(Sacc[kj][0], Sacc[kj][1]); pk.y = pk2(Sacc[kj][2], Sacc[kj][3]);
                *(LAS u32x2*)(STn + (16 * w + fr) * LQ + 16 * kj + 4 * fq) = pk;
            }
            if (ML) {
                if (w < 4) {
                    f32x4 d = (f32x4){0.f, 0.f, 0.f, 0.f};
#pragma unroll
                    for (int ks = 0; ks < 2; ++ks) { const bf16x8 a = *(const LAS bf16x8*)(VT + (128 + fr) * LQ + 32 * ks + 8 * fq), sc = *(const LAS bf16x8*)(Sc + (16 * w + fr) * LQ + 32 * ks + 8 * fq);
                        d = __builtin_amdgcn_mfma_f32_16x16x32_bf16(a, sc, d, 0, 0, 0); }
#pragma unroll
                    for (int ks = 0; ks < 2; ++ks) { const bf16x8 a = *(const LAS bf16x8*)(STc + (128 + fr) * LQ + 32 * ks + 8 * fq), qq = *(const LAS bf16x8*)(Qm + (16 * w + fr) * LQ + 32 * ks + 8 * fq);
                        d = __builtin_amdgcn_mfma_f32_16x16x32_bf16(a, qq, d, 0, 0, 0); }
                    if (fq == 0) dn[16 * w + fr] = d[0];
                } else {
                    const int kj = w - 4;
                    f32x4 d = (f32x4){0.f, 0.f, 0.f, 0.f};
#pragma unroll
                    for (int ks = 0; ks < 2; ++ks) { const bf16x8 kk = *(const LAS bf16x8*)(KtT + (16 * kj + fr) * LQ + 32 * ks + 8 * fq), a = *(const LAS bf16x8*)(VT + (128 + fr) * LQ + 32 * ks + 8 * fq);
                        d = __builtin_amdgcn_mfma_f32_16x16x32_bf16(kk, a, d, 0, 0, 0); }
                    Nacc = Nacc * wc + d;
                    u32x2 pk; pk.x = pk2(Nacc[0], Nacc[1]); pk.y = pk2(Nacc[2], Nacc[3]);
                    *(LAS u32x2*)(STn + (128 + fr) * LQ + 16 * kj + 4 * fq) = pk;
                }
            }
        }
#pragma unroll
        for (int ti = 0; ti < 4; ++ti) { float p = o[ti][0] * o[ti][0] + o[ti][1] * o[ti][1] + o[ti][2] * o[ti][2] + o[ti][3] * o[ti][3];
            p += __shfl_xor(p, 16); p += __shfl_xor(p, 32);
            if (fq == 0) ssq[w * 64 + 16 * ti + fr] = p; }
        __syncthreads();
#pragma unroll
        for (int ti = 0; ti < 4; ++ti) {
            const int t = 16 * ti + fr;
            float ss = 0.f;
#pragma unroll
            for (int ww = 0; ww < 8; ++ww) ss += ssq[ww * 64 + t];
            float dd = 1.f;
            if (ML) { const float bc = __shfl(g_bc, t), Mt = __shfl(g_M, t); dd = 1.f / fmaxf(fabsf(dn[t]), __expf(-(bc + Mt))); }
            const float rstd = rsqrtf(ss * dd * dd * (1.f / 128.f) + EPS) * dd;
            const f32x4 gn = *(const f32x4*)(gnorm + 16 * w + 4 * fq);
            const float g0 = bflo(gate[ti].x), g1 = bfhi(gate[ti].x), g2 = bflo(gate[ti].y), g3 = bfhi(gate[ti].y);
            f32x4 r;
            if (ML) { r[0] = o[ti][0] * rstd * gn[0] * sigmoidf_(g0); r[1] = o[ti][1] * rstd * gn[1] * sigmoidf_(g1); r[2] = o[ti][2] * rstd * gn[2] * sigmoidf_(g2); r[3] = o[ti][3] * rstd * gn[3] * sigmoidf_(g3); }
            else { r[0] = o[ti][0] * rstd * gn[0] * siluf_(g0); r[1] = o[ti][1] * rstd * gn[1] * siluf_(g1); r[2] = o[ti][2] * rstd * gn[2] * siluf_(g2); r[3] = o[ti][3] * rstd * gn[3] * siluf_(g3); }
            st_bf4(UO + (grow + t) * 512 + h * 128 + 16 * w + 4 * fq, r);
        }
    }
#undef SC_LOAD
    __syncthreads();
}
__device__ __forceinline__ void phase_scans(const Ctx& c, int l) {
    for (int it = c.bid; it < 128; it += c.nblk) {
#if SCAN_RECURRENT
        if (it < 64) scan_gla_item(c, l, it >> 2, it & 3);
        else scan_mlstm_item(c, l, (it - 64) >> 2, (it - 64) & 3);
#else
        if (it < 64) scan_chunked_item<false>(c, l, it >> 2, it & 3);
        else scan_chunked_item<true>(c, l, (it - 64) >> 2, (it - 64) & 3);
#endif
    }
}

__device__ __forceinline__ unsigned ord_key(float f) { const unsigned u = __builtin_bit_cast(unsigned, f); return (u & 0x80000000u) ? ~u : (u | 0x80000000u); }
__device__ __forceinline__ void phase_dsa(const Ctx& c, int l) {
    LAS unsigned char* wl = c.lds + c.wave * 14336;
    LAS float* I_s = (LAS float*)wl;
    LAS int* list = (LAS int*)(wl + 8192);
    LAS float* qi_s = (LAS float*)(wl + 9216);
    LAS float* ql_s = (LAS float*)(wl + 10240);
    const bf16* QLAT = (const bf16*)(c.ws + WS_QLAT); const bf16* QIDX = (const bf16*)(c.ws + WS_QIDX);
    const bf16* CKVN = (const bf16*)(c.ws + WS_CKVN); const float* SM = (const float*)(c.ws + WS_SM);
    bf16* OLAT = (bf16*)(c.ws + WS_OLAT);
    const int gw = c.bid * NWAVES + c.wave, NGW = c.nblk * NWAVES, lane = c.lane;
    for (int tq = gw; tq < T; tq += NGW) {
        const int b = tq >> 11, pos = tq & 2047, nvalid = pos + 1;
        const size_t kb = (size_t)b * SEQ;
        { const f32x4 q = ld_bf4(QIDX + (size_t)tq * 256 + 4 * lane); *(LAS f32x4*)(qi_s + 4 * lane) = q;
#pragma unroll
          for (int j = 0; j < 4; ++j) { const f32x4 ql = ld_bf4(QLAT + (size_t)tq * 1024 + 4 * (lane + 64 * j)); *(LAS f32x4*)(ql_s + 4 * (lane + 64 * j)) = ql; } }
        float wh[8];
#pragma unroll
        for (int hh = 0; hh < 8; ++hh) wh[hh] = SM[(size_t)tq * 128 + SM_WIDX + hh] * 0.35355339059327373f;
        asm volatile("s_waitcnt lgkmcnt(0)" ::: "memory");
        int nsel;
        if (nvalid <= DSA_K) {
            for (int i = lane; i < DSA_K; i += 64) list[i] = i;
            nsel = nvalid;
        } else {
            const int nj = (nvalid + 63) >> 6;
            for (int j = 0; j < nj; ++j) {
                const int s = lane + 64 * j;
                float val = -INFINITY;
                if (s < nvalid) {
                    const float* kr = SM + (kb + s) * 128 + SM_KIDX;
                    f32x4 kk[8];
#pragma unroll
                    for (int i = 0; i < 8; ++i) kk[i] = *(const f32x4*)(kr + 4 * i);
                    val = 0.f;
#pragma unroll
                    for (int hh = 0; hh < 8; ++hh) { float d = 0.f;
#pragma unroll
                        for (int i = 0; i < 8; ++i) { const f32x4 q = *(const LAS f32x4*)(qi_s + hh * 32 + 4 * i); d += q[0] * kk[i][0] + q[1] * kk[i][1] + q[2] * kk[i][2] + q[3] * kk[i][3]; }
                        val += wh[hh] * fmaxf(d, 0.f); }
                }
                I_s[s] = val;
            }
            for (int j = nj; j < 32; ++j) I_s[lane + 64 * j] = -INFINITY;
            asm volatile("s_waitcnt lgkmcnt(0)" ::: "memory");
            LAS unsigned* K_s = (LAS unsigned*)I_s;
#pragma unroll 4
            for (int j = 0; j < 32; ++j) K_s[lane + 64 * j] = ord_key(I_s[lane + 64 * j]);
            unsigned thr = 0u;
#pragma unroll 1
            for (int bit = 31; bit >= 0; --bit) {
                const unsigned cand = thr | (1u << bit); int cnt = 0;
#pragma unroll 8
                for (int j = 0; j < 32; ++j) cnt += (K_s[lane + 64 * j] >= cand) ? 1 : 0;
                cnt = wave_sum_i(cnt);
                if (cnt >= DSA_K) thr = cand;
            }
            int cgt = 0;
#pragma unroll 8
            for (int j = 0; j < 32; ++j) cgt += (K_s[lane + 64 * j] > thr) ? 1 : 0;
            cgt = wave_sum_i(cgt);
            int need = DSA_K - cgt, base = 0;
            const unsigned long long lt = (1ull << lane) - 1ull;
#pragma unroll 2
            for (int j = 0; j < 32; ++j) {
                const unsigned kj = K_s[lane + 64 * j];
                const bool gt = kj > thr, eq = kj == thr;
                const unsigned long long meq = __ballot(eq);
                const int rk = __popcll(meq & lt);
                const bool sel = gt || (eq && rk < need);
                need -= __popcll(meq); if (need < 0) need = 0;
                const unsigned long long ms = __ballot(sel);
                if (sel) list[base + __popcll(ms & lt)] = lane + 64 * j;
                base += __popcll(ms);
            }
            nsel = DSA_K;
        }
        asm volatile("s_waitcnt lgkmcnt(0)" ::: "memory");
        int ks[4]; float lg[4][8];
#pragma unroll
        for (int i = 0; i < 4; ++i) { const int li = lane + 64 * i; ks[i] = (li < nsel) ? list[li] : 0;
#pragma unroll
            for (int hh = 0; hh < 8; ++hh) lg[i][hh] = 0.f; }
#pragma unroll 1
        for (int ch = 0; ch < 16; ++ch) {
            f32x4 ka[4], kc[4];
#pragma unroll
            for (int i = 0; i < 4; ++i) { const u32x4 w = *(const u32x4*)(CKVN + (kb + ks[i]) * 128 + ch * 8);
                ka[i] = (f32x4){bflo(w.x), bfhi(w.x), bflo(w.y), bfhi(w.y)}; kc[i] = (f32x4){bflo(w.z), bfhi(w.z), bflo(w.w), bfhi(w.w)}; }
#pragma unroll
            for (int hh = 0; hh < 8; ++hh) { const f32x4 qa = *(const LAS f32x4*)(ql_s + hh * 128 + ch * 8), qb = *(const LAS f32x4*)(ql_s + hh * 128 + ch * 8 + 4);
#pragma unroll
                for (int i = 0; i < 4; ++i) lg[i][hh] += qa[0] * ka[i][0] + qa[1] * ka[i][1] + qa[2] * ka[i][2] + qa[3] * ka[i][3] + qb[0] * kc[i][0] + qb[1] * kc[i][1] + qb[2] * kc[i][2] + qb[3] * kc[i][3]; }
        }
#pragma unroll
        for (int hh = 0; hh < 8; ++hh) {
            const float slope = exp2f(-(float)(hh + 1));
            float mx = -INFINITY;
#pragma unroll
            for (int i = 0; i < 4; ++i) { const bool ok = (lane + 64 * i) < nsel; lg[i][hh] = ok ? lg[i][hh] - slope * (float)(pos - ks[i]) : -INFINITY; mx = fmaxf(mx, lg[i][hh]); }
            mx = wave_max(mx);
            float sm = 0.f;
#pragma unroll
            for (int i = 0; i < 4; ++i) { lg[i][hh] = __expf(lg[i][hh] - mx); sm += lg[i][hh]; }
            sm = wave_sum(sm);
            const float inv = 1.f / sm;
#pragma unroll
            for (int i = 0; i < 4; ++i) lg[i][hh] *= inv;
        }
#pragma unroll
        for (int i = 0; i < 4; ++i) { const int li = lane + 64 * i;
            *(LAS f32x4*)(I_s + li * 8) = (f32x4){lg[i][0], lg[i][1], lg[i][2], lg[i][3]}; *(LAS f32x4*)(I_s + li * 8 + 4) = (f32x4){lg[i][4], lg[i][5], lg[i][6], lg[i][7]}; }
        asm volatile("s_waitcnt lgkmcnt(0)" ::: "memory");
        float o0[8], o1[8];
#pragma unroll
        for (int hh = 0; hh < 8; ++hh) { o0[hh] = 0.f; o1[hh] = 0.f; }
#pragma unroll 2
        for (int kidx = 0; kidx < nsel; ++kidx) {
            const int s = list[kidx];
            const unsigned w = *(const unsigned*)(CKVN + (kb + s) * 128 + 2 * lane);
            const float v0 = bflo(w), v1 = bfhi(w);
            const f32x4 pa = *(const LAS f32x4*)(I_s + kidx * 8), pb = *(const LAS f32x4*)(I_s + kidx * 8 + 4);
            o0[0] += pa[0] * v0; o1[0] += pa[0] * v1; o0[1] += pa[1] * v0; o1[1] += pa[1] * v1; o0[2] += pa[2] * v0; o1[2] += pa[2] * v1; o0[3] += pa[3] * v0; o1[3] += pa[3] * v1;
            o0[4] += pb[0] * v0; o1[4] += pb[0] * v1; o0[5] += pb[1] * v0; o1[5] += pb[1] * v1; o0[6] += pb[2] * v0; o1[6] += pb[2] * v1; o0[7] += pb[3] * v0; o1[7] += pb[3] * v1;
        }
#pragma unroll
        for (int hh = 0; hh < 8; ++hh) *(unsigned*)(OLAT + (size_t)tq * 1024 + hh * 128 + 2 * lane) = pk2(o0[hh], o1[hh]);
        asm volatile("s_waitcnt lgkmcnt(0)" ::: "memory");
    }
}

__device__ __forceinline__ void route_one(int t, float logit, float rbias, int lane, unsigned* CNT, int* ROWL, float* WL, unsigned* TOKPOS) {
    const float score = sigmoidf_(logit), sel = score + rbias;
    const int g = lane >> 3;
    int rk8 = 0;
#pragma unroll
    for (int d = 1; d < 8; ++d) { const int ol = (lane & ~7) | ((lane + d) & 7); const float o = __shfl(sel, ol); rk8 += (o > sel || (o == sel && ol < lane)) ? 1 : 0; }
    float t2 = rk8 < 2 ? sel : 0.f;
    t2 += __shfl_xor(t2, 1); t2 += __shfl_xor(t2, 2); t2 += __shfl_xor(t2, 4);
    int rkg = 0;
#pragma unroll
    for (int d = 1; d < 8; ++d) { const int og = (g + d) & 7; const float o = __shfl(t2, og * 8); rkg += (o > t2 || (o == t2 && og < g)) ? 1 : 0; }
    const bool gsel = rkg < 4;
    bool chosen = false; float cur = gsel ? sel : -INFINITY;
#pragma unroll 1
    for (int it6 = 0; it6 < TOPK; ++it6) {
        const float mx = wave_max(cur);
        const unsigned long long me = __ballot(cur == mx);
        const int win = __ffsll((long long)me) - 1;
        if (lane == win) { chosen = true; cur = -INFINITY; }
    }
    const float wsum = wave_sum(chosen ? score : 0.f);
    const unsigned long long mk = __ballot(chosen);
    if (chosen) {
        const int hf = t >= HALF_T ? 1 : 0;
        const int kk = __popcll(mk & ((1ull << lane) - 1ull));
        const unsigned slot = atomicAdd(&CNT[hf * 64 + lane], 1u);
        ROWL[((size_t)hf * 64 + lane) * 16384 + slot] = t;
        WL[((size_t)hf * 64 + lane) * 16384 + slot] = score / wsum * 2.5f;
        if (kk < TOPK) TOKPOS[(size_t)t * 6 + kk] = ((unsigned)lane << 16) | slot;
    }
}
__device__ __forceinline__ void phase_route(const Ctx& c, int l, const float* x1) {
    {
        LAS float* scr = (LAS float*)(c.lds + c.wave * 16384);
        const int gw = c.bid * NWAVES + c.wave, NGW = c.nblk * NWAVES;
        constexpr int I_GU = (512 / 32) * (1024 / 64), I_D = (1024 / 32) * (256 / 64), PER_E = I_GU + I_D;
        for (int it = gw; it < NEX * PER_E; it += NGW) {
            const int e = it / PER_E; int r = it % PER_E;
            if (r < I_GU) {
                const int n0 = (r / 16) * 32, pn = n0 >> 8, wi = n0 & 255, j0 = 128 * pn + (wi & 127);
                const float* Wg; const float* Wu;
                if (e < NE) { Wg = c.in[IN_EWG] + ((size_t)l * NE + e) * 1024 * 256; Wu = c.in[IN_EWU] + ((size_t)l * NE + e) * 1024 * 256; }
                else { Wg = c.in[IN_SWG] + (size_t)l * 1024 * 256; Wu = c.in[IN_SWU] + (size_t)l * 1024 * 256; }
                if (wi < 128) { SrcPlain s{Wg + j0 - n0, 256}; tr_item(s, (bf16*)(c.ws + WS_WGU) + (size_t)e * 512 * 1024, 1024, n0, (r % 16) * 64, scr, c.lane); }
                else { SrcPlain s{Wu + j0 - n0, 256}; tr_item(s, (bf16*)(c.ws + WS_WGU) + (size_t)e * 512 * 1024, 1024, n0, (r % 16) * 64, scr, c.lane); }
            } else { r -= I_GU;
                SrcPlain s; s.ld = 1024; s.W = e < NE ? c.in[IN_EWD] + ((size_t)l * NE + e) * 256 * 1024 : c.in[IN_SWD] + (size_t)l * 256 * 1024;
                tr_item(s, (bf16*)(c.ws + WS_WD) + (size_t)e * 1024 * 256, 256, (r / 4) * 32, (r % 4) * 64, scr, c.lane);
            }
        }
    }
    __syncthreads();
    {
        LAS float* h_s = (LAS float*)(c.lds + c.wave * 16384);
        const int gw = c.bid * NWAVES + c.wave, NGW = c.nblk * NWAVES, lane = c.lane;
        const float* MOD = (const float*)(c.ws + WS_MOD) + (size_t)l * 16 * 6144;
        bf16* XN2 = (bf16*)(c.ws + WS_XN2);
        const float* RW = c.in[IN_RW] + (size_t)l * 1024 * 64; const float rbias = c.in[IN_RB][l * 64 + lane];
        unsigned* CNT = (unsigned*)(c.ws + WS_CTL) + CW_CNT + l * 128;
        int* ROWL = (int*)(c.ws + WS_ROWL); float* WL = (float*)(c.ws + WS_WL); unsigned* TOKPOS = (unsigned*)(c.ws + WS_TOKPOS);
        for (int it = gw; it < T / 4; it += NGW) {
            const int t0 = it * 4, b = t0 >> 11;
            const float* gain = c.in[IN_NFFN] + l * D; const float* sh = MOD + (size_t)b * 6144 + 3072; const float* sc = MOD + (size_t)b * 6144 + 4096;
#pragma unroll
            for (int r = 0; r < 4; ++r) {
                const float* xrow = x1 + (size_t)(t0 + r) * D;
                f32x4 v[4]; float s = 0.f;
#pragma unroll
                for (int j = 0; j < 4; ++j) { v[j] = *(const f32x4*)(xrow + 4 * (lane + 64 * j)); s += v[j][0] * v[j][0] + v[j][1] * v[j][1] + v[j][2] * v[j][2] + v[j][3] * v[j][3]; }
                const float rstd = rsqrtf(wave_sum(s) * (1.f / D) + EPS);
#pragma unroll
                for (int j = 0; j < 4; ++j) { const int cc = 4 * (lane + 64 * j);
                    const f32x4 g = *(const f32x4*)(gain + cc), a = *(const f32x4*)(sc + cc), bb = *(const f32x4*)(sh + cc);
                    const f32x4 hv = v[j] * rstd * g * (a + 1.f) + bb;
                    st_bf4(XN2 + (size_t)(t0 + r) * D + cc, hv); *(LAS f32x4*)(h_s + r * 1024 + cc) = hv; }
            }
            asm volatile("s_waitcnt lgkmcnt(0)" ::: "memory");
            float lg[4] = {0.f, 0.f, 0.f, 0.f};
#pragma unroll 2
            for (int k = 0; k < 1024; k += 4) {
                const float w0 = RW[(size_t)k * 64 + lane], w1 = RW[(size_t)(k + 1) * 64 + lane], w2 = RW[(size_t)(k + 2) * 64 + lane], w3 = RW[(size_t)(k + 3) * 64 + lane];
#pragma unroll
                for (int r = 0; r < 4; ++r) { const f32x4 hv = *(const LAS f32x4*)(h_s + r * 1024 + k); lg[r] += hv[0] * w0 + hv[1] * w1 + hv[2] * w2 + hv[3] * w3; }
            }
            route_one(t0 + 0, lg[0], rbias, lane, CNT, ROWL, WL, TOKPOS);
            route_one(t0 + 1, lg[1], rbias, lane, CNT, ROWL, WL, TOKPOS);
            route_one(t0 + 2, lg[2], rbias, lane, CNT, ROWL, WL, TOKPOS);
            route_one(t0 + 3, lg[3], rbias, lane, CNT, ROWL, WL, TOKPOS);
        }
    }
}

__device__ __forceinline__ void moe_tables(const Ctx& c, int l, int hf) {
    LAS int* cnt = (LAS int*)(c.lds + 140000); LAS int* off = cnt + 65; LAS int* tst = off + 65;
    __syncthreads();
    if (c.tid == 0) {
        const unsigned* CNT = (const unsigned*)(c.ws + WS_CTL) + CW_CNT + l * 128 + hf * 64;
        int o = 0, ts = 0;
        for (int e = 0; e < NEX; ++e) { const int n = e < NE ? (int)CNT[e] : HALF_T; cnt[e] = n; off[e] = o; tst[e] = ts; o += (n + 255) & ~255; ts += (n + 255) >> 8; }
        tst[NEX] = ts;
    }
    __syncthreads();
}
struct MoeSched1 { LAS const int* cnt; LAS const int* off; LAS const int* tst; int G, c; const char* XN2; const char* WGU; const int* ROWL; const float* WL; const int* IDENT;
    __device__ __forceinline__ bool next(int i, g8::GUnit& u) const {
        const int L = i * G + c; if (L >= 2 * tst[NEX]) return false;
        const int rt = L >> 1, pn = L & 1; int e = 0; while (tst[e + 1] <= rt) ++e;
        const int r0 = (rt - tst[e]) * 256;
        u.A = XN2; u.B = WGU + ((size_t)e * 512 + (size_t)pn * 256) * 2048;
        u.rl = e < NE ? ROWL + (size_t)e * 16384 + r0 : IDENT + r0; u.nvalid = cnt[e] - r0; u.erow0 = 0; u.ecol0 = pn * 256; u.x0 = off[e] + r0; u.xp = e < NE ? WL + (size_t)e * 16384 + r0 : nullptr; return true; } };
struct MoeSched2 { LAS const int* cnt; LAS const int* off; LAS const int* tst; int G, c; const char* HID; const char* WD;
    __device__ __forceinline__ bool next(int i, g8::GUnit& u) const {
        const int L = i * G + c; if (L >= 4 * tst[NEX]) return false;
        const int rt = L >> 2, pn = L & 3; int e = 0; while (tst[e + 1] <= rt) ++e;
        const int r0 = (rt - tst[e]) * 256;
        u.A = HID + (size_t)(off[e] + r0) * 512; u.B = WD + ((size_t)e * 1024 + (size_t)pn * 256) * 512;
        u.rl = nullptr; u.nvalid = 0; u.erow0 = 0; u.ecol0 = pn * 256; u.x0 = off[e] + r0; u.xp = nullptr; return true; } };
struct EpiG1u { bf16* HID;
    __device__ __forceinline__ void operator()(const g8::GUnit& u, int row, int col, f32x4 lo, f32x4 hi) const {
        const int hc = col - 128 * (col >> 8);
        f32x4 v = (f32x4){0.f, 0.f, 0.f, 0.f};
        if (row < u.nvalid) { const float w = u.xp ? u.xp[row] : 1.f;
#pragma unroll
            for (int i = 0; i < 4; ++i) v[i] = siluf_(lo[i]) * hi[i] * w; }
        st_bf4(HID + (size_t)(u.x0 + row) * 256 + hc, v);
    } };
struct EpiG2u { bf16* Y;
    __device__ __forceinline__ void operator()(const g8::GUnit& u, int row, int col, f32x4 lo, f32x4 hi) const {
        st_bf4(Y + (size_t)(u.x0 + row) * 1024 + col, lo); st_bf4(Y + (size_t)(u.x0 + row) * 1024 + col + 128, hi);
    } };
__device__ __forceinline__ void phase_gemm1(const Ctx& c, int l, int hf) {
    moe_tables(c, l, hf);
    LAS int* cnt = (LAS int*)(c.lds + 140000); LAS int* off = cnt + 65; LAS int* tst = off + 65;
    MoeSched1 S{cnt, off, tst, c.nblk, c.bid, (const char*)(c.ws + WS_XN2), (const char*)(c.ws + WS_WGU), (const int*)(c.ws + WS_ROWL) + (size_t)hf * 64 * 16384, (const float*)(c.ws + WS_WL) + (size_t)hf * 64 * 16384,
                (const int*)(c.ws + WS_IDENT) + (size_t)hf * HALF_T};
    EpiG1u E{(bf16*)(c.ws + WS_HID)};
    g8::gemm_phase<true>(c.lds, 2048u, 1024, S, E);
    __syncthreads();
}
__device__ __forceinline__ void phase_gemm2(const Ctx& c, int l, int hf) {
    moe_tables(c, l, hf);
    LAS int* cnt = (LAS int*)(c.lds + 140000); LAS int* off = cnt + 65; LAS int* tst = off + 65;
    MoeSched2 S{cnt, off, tst, c.nblk, c.bid, (const char*)(c.ws + WS_HID), (const char*)(c.ws + WS_WD)};
    EpiG2u E{(bf16*)(c.ws + WS_Y)};
    g8::gemm_phase<false>(c.lds, 512u, 256, S, E);
    __syncthreads();
}
__device__ __forceinline__ void phase_combine(const Ctx& c, int l, int hf, float* xio) {
    moe_tables(c, l, hf);
    LAS int* off = (LAS int*)(c.lds + 140000) + 65;
    const int gw = c.bid * NWAVES + c.wave, NGW = c.nblk * NWAVES, lane = c.lane;
    const bf16* Y = (const bf16*)(c.ws + WS_Y); const unsigned* TOKPOS = (const unsigned*)(c.ws + WS_TOKPOS);
    const float* MODl = (const float*)(c.ws + WS_MOD) + (size_t)l * 16 * 6144;
    const float* MODn = (const float*)(c.ws + WS_MOD) + (size_t)1 * 16 * 6144;
    bf16* XN = (bf16*)(c.ws + WS_XN);
    for (int tt = gw; tt < HALF_T; tt += NGW) {
        const int t = hf * HALF_T + tt, b = t >> 11;
        f32x4 acc[4];
        { const bf16* yr = Y + (size_t)(off[NE] + tt) * 1024;
#pragma unroll
          for (int j = 0; j < 4; ++j) acc[j] = ld_bf4(yr + 4 * (lane + 64 * j)); }
#pragma unroll
        for (int kk = 0; kk < TOPK; ++kk) {
            const unsigned tp = TOKPOS[(size_t)t * 6 + kk]; const int e = tp >> 16, slot = tp & 0xffff;
            const bf16* yr = Y + (size_t)(off[e] + slot) * 1024;
#pragma unroll
            for (int j = 0; j < 4; ++j) acc[j] += ld_bf4(yr + 4 * (lane + 64 * j));
        }
        float* xr = xio + (size_t)t * D; const float* g2 = MODl + (size_t)b * 6144 + 5120;
        f32x4 v[4]; float s = 0.f;
#pragma unroll
        for (int j = 0; j < 4; ++j) { const int cc = 4 * (lane + 64 * j); v[j] = *(const f32x4*)(xr + cc) + *(const f32x4*)(g2 + cc) * acc[j]; s += v[j][0] * v[j][0] + v[j][1] * v[j][1] + v[j][2] * v[j][2] + v[j][3] * v[j][3]; }
        const float rstd = rsqrtf(wave_sum(s) * (1.f / D) + EPS);
        if (l == 0) {
#pragma unroll
            for (int j = 0; j < 4; ++j) { const int cc = 4 * (lane + 64 * j); *(f32x4*)(xr + cc) = v[j];
                const f32x4 g = *(const f32x4*)(c.in[IN_NMIX] + D + cc), a = *(const f32x4*)(MODn + (size_t)b * 6144 + 1024 + cc), bb = *(const f32x4*)(MODn + (size_t)b * 6144 + cc);
                st_bf4(XN + (size_t)t * D + cc, v[j] * rstd * g * (a + 1.f) + bb); }
        } else {
#pragma unroll
            for (int j = 0; j < 4; ++j) { const int cc = 4 * (lane + 64 * j); *(f32x4*)(xr + cc) = v[j] * rstd * *(const f32x4*)(c.in[IN_NFIN] + cc); }
        }
    }
}

constexpr int PH_PER_L = 18, N_PHASES = 1 + NL * PH_PER_L;
#ifndef PH_MASK
#define PH_MASK 0xFFFFFFFFu
#endif
#define IN(k) (lo <= (k) && (k) < hi)
#define EN(b) ((PH_MASK >> (b)) & 1u)
#ifndef REP_MASK
#define REP_MASK 0u
#endif
#define REPN(b) (((REP_MASK >> (b)) & 1u) ? 2 : 1)
#define SEAM(k) do { if (MK_ONE_LAUNCH && IN(k) && IN((k) + 1)) xcd_barrier(bar); } while (0)
template <int l>
__device__ __forceinline__ void layer_program(const Ctx& c, const XcdBarrier& bar, int lo, int hi) {
        const int P = 1 + l * PH_PER_L;
        const float* xin = l == 0 ? c.in[IN_X] : c.out;
        bf16* PB = (bf16*)(c.ws + WS_PB); float* SM = (float*)(c.ws + WS_SM);
        const bf16* XN = (const bf16*)(c.ws + WS_XN);
        const bf16* WIN = (const bf16*)(c.ws + WS_WIN) + (size_t)l * NINP * 1024;
        if (EN(1) && IN(P + 0)) { for (int rep = 0; rep < REPN(1); ++rep) {  if (l == 0) phase_norm1(c, 0, c.in[IN_X]);  if (rep + 1 < REPN(1)) xcd_barrier(bar); } } SEAM(P + 0);
        if (EN(2) && IN(P + 1)) { for (int rep = 0; rep < REPN(2); ++rep) {  EpiInPB E{PB, SM}; dgemm_phase(c, XN, 1024, T, WIN, NPB / 256, 1024, EpiU<decltype(E)>{E});  if (rep + 1 < REPN(2)) xcd_barrier(bar); } } SEAM(P + 1);
        if (EN(3) && IN(P + 2)) { for (int rep = 0; rep < REPN(3); ++rep) {  phase_prep(c, l);  if (rep + 1 < REPN(3)) xcd_barrier(bar); } } SEAM(P + 2);
        if (EN(4) && IN(P + 3)) { for (int rep = 0; rep < REPN(4); ++rep) {  phase_scans(c, l);  if (rep + 1 < REPN(4)) xcd_barrier(bar); } } SEAM(P + 3);
        if (EN(5) && IN(P + 4)) { for (int rep = 0; rep < REPN(5); ++rep) {  EpiQ E{(bf16*)(c.ws + WS_QLAT), (bf16*)(c.ws + WS_QIDX), (const float*)(c.ws + WS_RSTDQ)};
            dgemm_phase(c, PB + PB_CQ, NPB, T, (const bf16*)(c.ws + WS_WQ) + (size_t)l * 1280 * 256, 5, 256, EpiU<decltype(E)>{E});  if (rep + 1 < REPN(5)) xcd_barrier(bar); } } SEAM(P + 4);
        if (EN(6) && IN(P + 5)) { for (int rep = 0; rep < REPN(6); ++rep) {  EpiGate E{(bf16*)(c.ws + WS_G)}; dgemm_phase(c, XN, 1024, T, WIN + (size_t)NPB * 1024, NG / 256, 1024, EpiU<decltype(E)>{E});  if (rep + 1 < REPN(6)) xcd_barrier(bar); } } SEAM(P + 5);
        if (EN(7) && IN(P + 6)) { for (int rep = 0; rep < REPN(7); ++rep) {  phase_dsa(c, l);  if (rep + 1 < REPN(7)) xcd_barrier(bar); } } SEAM(P + 6);
        if (EN(8) && IN(P + 7)) { for (int rep = 0; rep < REPN(8); ++rep) {  EpiUp E{(bf16*)(c.ws + WS_M1), (const bf16*)(c.ws + WS_G), 0, 1};
            dgemm_phase(c, (const bf16*)(c.ws + WS_UA), 512, T, (const bf16*)(c.ws + WS_WUPA) + (size_t)l * 1024 * 512, 4, 512, EpiU<decltype(E)>{E});  if (rep + 1 < REPN(8)) xcd_barrier(bar); } } SEAM(P + 7);
        if (EN(9) && IN(P + 8)) { for (int rep = 0; rep < REPN(9); ++rep) {  EpiUp E{(bf16*)(c.ws + WS_M1), (const bf16*)(c.ws + WS_G), 1024, 0};
            dgemm_phase(c, (const bf16*)(c.ws + WS_OLAT), 1024, T, (const bf16*)(c.ws + WS_WUVB) + (size_t)l * 1024 * 1024, 4, 1024, EpiU<decltype(E)>{E});  if (rep + 1 < REPN(9)) xcd_barrier(bar); } } SEAM(P + 8);
        if (EN(10) && IN(P + 9)) { for (int rep = 0; rep < REPN(10); ++rep) {  EpiUp E{(bf16*)(c.ws + WS_M1), (const bf16*)(c.ws + WS_G), 2048, 0};
            dgemm_phase(c, (const bf16*)(c.ws + WS_UC), 512, T, (const bf16*)(c.ws + WS_WUPC) + (size_t)l * 1024 * 512, 4, 512, EpiU<decltype(E)>{E});  if (rep + 1 < REPN(10)) xcd_barrier(bar); } } SEAM(P + 9);
        if (EN(11) && IN(P + 10)) { for (int rep = 0; rep < REPN(11); ++rep) {  EpiWo E{xin, c.out, (const float*)(c.ws + WS_MOD) + (size_t)l * 16 * 6144 + 2048};
            dgemm_phase(c, (const bf16*)(c.ws + WS_M1), 1024, T, (const bf16*)(c.ws + WS_WO) + (size_t)l * 1024 * 1024, 4, 1024, EpiU<decltype(E)>{E});  if (rep + 1 < REPN(11)) xcd_barrier(bar); } } SEAM(P + 10);
        if (EN(12) && IN(P + 11)) { for (int rep = 0; rep < REPN(12); ++rep) {  phase_route(c, l, c.out);  if (rep + 1 < REPN(12)) xcd_barrier(bar); } } SEAM(P + 11);
        if (EN(13) && IN(P + 12)) { for (int rep = 0; rep < REPN(13); ++rep) {  phase_gemm1(c, l, 0);  if (rep + 1 < REPN(13)) xcd_barrier(bar); } } SEAM(P + 12);
        if (EN(14) && IN(P + 13)) { for (int rep = 0; rep < REPN(14); ++rep) {  phase_gemm2(c, l, 0);  if (rep + 1 < REPN(14)) xcd_barrier(bar); } } SEAM(P + 13);
        if (EN(15) && IN(P + 14)) { for (int rep = 0; rep < REPN(15); ++rep) {  phase_combine(c, l, 0, c.out);  if (rep + 1 < REPN(15)) xcd_barrier(bar); } } SEAM(P + 14);
        if (EN(16) && IN(P + 15)) { for (int rep = 0; rep < REPN(16); ++rep) {  phase_gemm1(c, l, 1);  if (rep + 1 < REPN(16)) xcd_barrier(bar); } } SEAM(P + 15);
        if (EN(17) && IN(P + 16)) { for (int rep = 0; rep < REPN(17); ++rep) {  phase_gemm2(c, l, 1);  if (rep + 1 < REPN(17)) xcd_barrier(bar); } } SEAM(P + 16);
        if (EN(18) && IN(P + 17)) { for (int rep = 0; rep < REPN(18); ++rep) {  phase_combine(c, l, 1, c.out);  if (rep + 1 < REPN(18)) xcd_barrier(bar); } } SEAM(P + 17);
    }
__global__ void __launch_bounds__(NTHR, 2) fwd(Args args) {
    extern __shared__ __attribute__((aligned(16))) unsigned char lds_raw[];
    Ctx c;
    c.lds = (LAS unsigned char*)lds_raw;
    c.tid = threadIdx.x; c.lane = c.tid & 63; c.wave = __builtin_amdgcn_readfirstlane(c.tid >> 6);
    c.bid = blockIdx.x; c.nblk = gridDim.x;
    c.in = args.in; c.out = args.out; c.ws = args.ws;
    for (int u = c.tid; u < (LDS_BYTES - LDS_MISC) / 4; u += NTHR) ((LAS unsigned*)(c.lds + LDS_MISC))[u] = 0u;
    __syncthreads();
    XcdBarrier bar; bar.bar = (unsigned*)(c.ws + WS_CTL) + CW_BAR; bar.x = 0; bar.st = (volatile LAS unsigned*)(c.lds + LDS_MISC);
    if (MK_ONE_LAUNCH) bar = xcd_barrier_post((unsigned*)(c.ws + WS_CTL) + CW_BAR, (volatile LAS unsigned*)(c.lds + LDS_MISC));
    const int lo = args.ph_lo, hi = args.ph_hi;
    if (EN(0) && IN(0)) { for (int rep = 0; rep < REPN(0); ++rep) { phase_prologue(c); if (rep + 1 < REPN(0)) xcd_barrier(bar); } } SEAM(0);
    layer_program<0>(c, bar, lo, hi);
    layer_program<1>(c, bar, lo, hi);
#undef IN
#undef SEAM
}

extern "C" void kernel_launch(void* const* d_in, const int* in_sizes, int n_in, void* d_out, int out_size, void* d_ws, size_t ws_size, hipStream_t stream) {
    static int grid = 0;
    if (grid == 0) {
        if (n_in != 33 || out_size != T * D || ws_size < WS_END) { fprintf(stderr, "kernel_launch: unexpected problem (n_in %d out %d ws %zu)\n", n_in, out_size, ws_size); grid = -1; return; }
        int dev = 0, cus = 0, per_cu = 0;
        if (hipGetDevice(&dev) != hipSuccess || hipDeviceGetAttribute(&cus, hipDeviceAttributeMultiprocessorCount, dev) != hipSuccess) { grid = -1; return; }
        if (hipFuncSetAttribute((const void*)fwd, hipFuncAttributeMaxDynamicSharedMemorySize, LDS_BYTES) != hipSuccess) { fprintf(stderr, "kernel_launch: hipFuncSetAttribute failed\n"); grid = -1; return; }
        if (hipOccupancyMaxActiveBlocksPerMultiprocessor(&per_cu, (const void*)fwd, NTHR, LDS_BYTES) != hipSuccess || per_cu < 1) { fprintf(stderr, "kernel_launch: occupancy query says %d\n", per_cu); }
        (void)hipGetLastError();
        grid = cus;
    }
    if (grid < 0) return;
    (void)hipMemsetAsync((char*)d_ws + WS_CTL, 0, CTL_BYTES, stream);
    Args a{};
    for (int i = 0; i < 33; ++i) a.in[i] = (const float*)d_in[i];
    a.out = (float*)d_out; a.ws = (unsigned char*)d_ws;
#if MK_ONE_LAUNCH
    a.ph_lo = 0; a.ph_hi = N_PHASES;
    hipLaunchKernelGGL(fwd, dim3(grid), dim3(NTHR), LDS_BYTES, stream, a);
#else
    for (int p = 0; p < N_PHASES; ++p) {
        if (p == 1 + PH_PER_L) continue;
        a.ph_lo = p; a.ph_hi = p + 1;
        hipLaunchKernelGGL(fwd, dim3(grid), dim3(NTHR), LDS_BYTES, stream, a);
    }
#endif
}
```

```cpp
#include <hip/hip_runtime.h>
#include <cstdio>
#include <cstdint>

#define LAS __attribute__((address_space(3)))
#define GAS __attribute__((address_space(1)))
typedef unsigned short bf16;
typedef short bf16x8 __attribute__((ext_vector_type(8)));
typedef float f32x4 __attribute__((ext_vector_type(4)));
typedef float f32x2 __attribute__((ext_vector_type(2)));
typedef unsigned u32x4 __attribute__((ext_vector_type(4)));
typedef unsigned u32x2 __attribute__((ext_vector_type(2)));
typedef GAS unsigned gu32;

#ifndef SCAN_RECURRENT
#define SCAN_RECURRENT 0
#endif
#ifndef MK_ONE_LAUNCH
#define MK_ONE_LAUNCH 1
#endif

constexpr int NB = 16, SEQ = 2048, D = 1024, T = NB * SEQ, NL = 2;
constexpr int NIN = 6592, NPB = 3584, NG = 3072, NINP = NPB + NG;
constexpr int NE = 64, NEX = 65, EFF = 256, TOPK = 6;
constexpr int HALF_T = T / 2;
constexpr int DSA_K = 256;
constexpr float EPS = 1e-6f;
constexpr int NTHR = 512, NWAVES = 8;

constexpr int PB_QA = 0, PB_KA = 256, PB_VA = 512, PB_GA = 1024, PB_CQ = 1536, PB_CKV = 1792, PB_QC = 2048, PB_KC = 2304, PB_VC = 2560, PB_OC = 3072;
constexpr int SM_KIDX = 0, SM_ALR = 32, SM_WIDX = 48, SM_IC = 56, SM_FC = 60;

constexpr size_t MiB = 1u << 20;
constexpr size_t WS_CTL = 0, CTL_BYTES = 1 * MiB;
constexpr size_t WS_MOD = 1 * MiB;
constexpr size_t WS_RSTDQ = 2 * MiB;
constexpr size_t WS_TOKPOS = 3 * MiB;
constexpr size_t WS_IDENT = 3 * MiB + 800 * 1024;
constexpr size_t WS_WIN = 4 * MiB;
constexpr size_t WS_WQ = 30 * MiB;
constexpr size_t WS_WUPA = 32 * MiB;
constexpr size_t WS_WUPC = 34 * MiB;
constexpr size_t WS_WUVB = 36 * MiB;
constexpr size_t WS_WO = 40 * MiB;
constexpr size_t WS_WGU = 44 * MiB;
constexpr size_t WS_WD = 109 * MiB;
constexpr size_t WS_XN = 142 * MiB;
constexpr size_t WS_OLAT = WS_XN;
constexpr size_t WS_UA = 206 * MiB;
constexpr size_t WS_UC = 238 * MiB;
constexpr size_t WS_XN2 = 206 * MiB;
constexpr size_t WS_QLAT = 270 * MiB;
constexpr size_t WS_M1 = WS_QLAT;
constexpr size_t WS_QIDX = 334 * MiB;
constexpr size_t WS_CKVN = 350 * MiB;
constexpr size_t WS_KIDX = 358 * MiB;
constexpr size_t WS_SM = 360 * MiB;
constexpr size_t WS_PB = 376 * MiB;
constexpr size_t WS_G = WS_PB;
constexpr size_t WS_HID = 270 * MiB;
constexpr size_t WS_Y = 334 * MiB;
constexpr size_t WS_ROWL = 590 * MiB;
constexpr size_t WS_WL = 598 * MiB;
constexpr size_t WS_CKVT = 576 * MiB;
constexpr size_t WS_MASK = 584 * MiB;
static_assert(WS_CKVT >= WS_G + (size_t)T * NG * 2 && WS_MASK + (size_t)T * 64 * 4 <= WS_PB + (size_t)T * NPB * 2, "CKVT/MASK placement");
constexpr size_t WS_END = 606 * MiB;
static_assert(WS_PB + (size_t)T * NPB * 2 <= 600 * MiB, "PB");
static_assert(WS_Y + (size_t)131072 * 1024 * 2 <= WS_ROWL, "Y");

constexpr int CW_BAR = 4096;
constexpr int CW_CNT = 16384;

constexpr int LDS_BYTES = 147456;
constexpr int LDS_MISC = 145408;

__device__ __forceinline__ unsigned f2bf(float f) { unsigned u = __builtin_bit_cast(unsigned, f); return (u + 0x7fffu + ((u >> 16) & 1u)) >> 16; }
__device__ __forceinline__ float bf2f(unsigned b) { return __builtin_bit_cast(float, b << 16); }
__device__ __forceinline__ unsigned pk2(float lo, float hi) { return f2bf(lo) | (f2bf(hi) << 16); }
__device__ __forceinline__ float bflo(unsigned w) { return __builtin_bit_cast(float, w << 16); }
__device__ __forceinline__ float bfhi(unsigned w) { return __builtin_bit_cast(float, w & 0xffff0000u); }
__device__ __forceinline__ float wave_sum(float v) {
#pragma unroll
    for (int o = 1; o < 64; o <<= 1) v += __shfl_xor(v, o);
    return v;
}
__device__ __forceinline__ float wave_max(float v) {
#pragma unroll
    for (int o = 1; o < 64; o <<= 1) v = fmaxf(v, __shfl_xor(v, o));
    return v;
}
__device__ __forceinline__ int wave_sum_i(int v) {
#pragma unroll
    for (int o = 1; o < 64; o <<= 1) v += __shfl_xor(v, o);
    return v;
}
__device__ __forceinline__ float sigmoidf_(float x) { return 1.f / (1.f + __expf(-x)); }
__device__ __forceinline__ float siluf_(float x) { return x / (1.f + __expf(-x)); }
__device__ __forceinline__ float logsigmoidf_(float x) { return fminf(x, 0.f) - log1pf(__expf(-fabsf(x))); }
__device__ __forceinline__ float logsigmoid_fast(float x) { return fminf(x, 0.f) - __logf(1.f + __expf(-fabsf(x))); }
__device__ __forceinline__ void st_bf4(bf16* p, f32x4 v) { u32x2 w; w.x = pk2(v[0], v[1]); w.y = pk2(v[2], v[3]); *(u32x2*)p = w; }
__device__ __forceinline__ f32x4 ld_bf4(const bf16* p) { u32x2 w = *(const u32x2*)p; return (f32x4){bflo(w.x), bfhi(w.x), bflo(w.y), bfhi(w.y)}; }

#define XB_TMO      128
#define XB_XCNT(j)  (256  + 64 * (j))
#define XB_XSUB(j)  (1280 + 64 * (j))
#define XB_XGEN(j)  (2304 + 64 * (j))
#define XB_TOP      3328
#define XB_TOPGEN   3392
#define XCD_BAR_WORDS 3456
#define XB_SPIN_CAP (1u << 22)
__device__ __forceinline__ unsigned xb_ld(unsigned* p)              { return __hip_atomic_load(p, __ATOMIC_RELAXED, __HIP_MEMORY_SCOPE_AGENT); }
__device__ __forceinline__ unsigned xb_add(unsigned* p, unsigned v) { return __hip_atomic_fetch_add(p, v, __ATOMIC_RELAXED, __HIP_MEMORY_SCOPE_AGENT); }
__device__ __forceinline__ unsigned xb_xcc_id() { return (unsigned)__builtin_amdgcn_s_getreg((3 << 11) | 20) & 0xFu; }
#define XB_SPIN(cond, bar) do { unsigned _sp = 0; while (cond) { __builtin_amdgcn_s_sleep(1); \
    if ((++_sp & 255u) == 0u) { if (xb_ld(&(bar)[XB_TMO])) break; if (_sp > XB_SPIN_CAP) { atomicAdd(&(bar)[XB_TMO], 1u); break; } } } } while (0)
struct XcdBarrier { unsigned* bar; unsigned x; volatile LAS unsigned* st; };
__device__ __forceinline__ XcdBarrier xcd_barrier_post(unsigned* bar, volatile LAS unsigned* st) {
    XcdBarrier b; b.bar = bar; b.x = xb_xcc_id(); b.st = st;
    if (threadIdx.x == 0) (void)xb_add(&bar[XB_XCNT(b.x)], 1u);
    return b;
}
__device__ __forceinline__ void xcd_barrier_complete(unsigned* bar, unsigned x, unsigned& nloc, unsigned& nx) {
    const unsigned G = gridDim.x * gridDim.y * gridDim.z;
    unsigned sum, cnt, mine, sp = 0u;
    for (;;) {
        sum = 0u; cnt = 0u; mine = 0u;
#pragma unroll
        for (unsigned j = 0; j < 16; ++j) { const unsigned c = xb_ld(&bar[XB_XCNT(j)]); sum += c; cnt += (c > 0u) ? 1u : 0u; mine = (j == x) ? c : mine; }
        if (sum == G) break;
        __builtin_amdgcn_s_sleep(1);
        if ((++sp & 255u) == 0u) { if (xb_ld(&bar[XB_TMO])) break; if (sp > XB_SPIN_CAP) { atomicAdd(&bar[XB_TMO], 1u); break; } }
    }
    nloc = mine > 0u ? mine : 1u; nx = cnt > 0u ? cnt : 1u;
}
__device__ __forceinline__ void xcd_barrier(const XcdBarrier& b) {
    asm volatile("s_waitcnt vmcnt(0)" ::: "memory");
    __syncthreads();
    if (threadIdx.x == 0) {
        unsigned* bar = b.bar;
        __builtin_amdgcn_s_waitcnt(0);
        unsigned nloc = b.st[0], nx = b.st[1];
        if (nloc == 0u) { xcd_barrier_complete(bar, b.x, nloc, nx); b.st[0] = nloc; b.st[1] = nx; }
        const unsigned old = xb_add(&bar[XB_XSUB(b.x)], 1u);
        const unsigned gen = old / nloc;
        if (old + 1u == (gen + 1u) * nloc) {
            __builtin_amdgcn_fence(__ATOMIC_RELEASE, "agent");
            asm volatile("s_waitcnt vmcnt(0)" ::: "memory");
            const unsigned og = xb_add(&bar[XB_TOP], 1u);
            const unsigned tg = og / nx;
            if (og + 1u == (tg + 1u) * nx) xb_add(&bar[XB_TOPGEN], 1u);
            else XB_SPIN(xb_ld(&bar[XB_TOPGEN]) == tg, bar);
            __builtin_amdgcn_fence(__ATOMIC_ACQUIRE, "agent");
            xb_add(&bar[XB_XGEN(b.x)], 1u);
            asm volatile("s_waitcnt vmcnt(0)" ::: "memory");
        } else {
            XB_SPIN(xb_ld(&bar[XB_XGEN(b.x)]) == gen, bar);
            __builtin_amdgcn_fence(__ATOMIC_ACQUIRE, "agent");
            asm volatile("s_waitcnt vmcnt(0)" ::: "memory");
        }
    }
    __syncthreads();
}

struct Args { const float* in[33]; float* out; unsigned char* ws; int ph_lo, ph_hi; };

struct Ctx {
    LAS unsigned char* lds;
    int tid, lane, wave, bid, nblk;
    const float* const* in;
    float* out; unsigned char* ws;
};
#define IN_X 0
#define IN_C 1
#define IN_ADAW 2
#define IN_ADAB 3
#define IN_NMIX 4
#define IN_NFFN 5
#define IN_WIN 6
#define IN_GLA_WA2 7
#define IN_GLA_BA 8
#define IN_GLA_NORM 9
#define IN_DSA_NQ 10
#define IN_DSA_NKV 11
#define IN_DSA_WUQ 12
#define IN_DSA_WUK 13
#define IN_DSA_WUV 14
#define IN_DSA_WQI 15
#define IN_ML_CONV 16
#define IN_ML_BI 17
#define IN_ML_BF 18
#define IN_ML_NORM 19
#define IN_WUPA 20
#define IN_WUPB 21
#define IN_WUPC 22
#define IN_WO 23
#define IN_RW 24
#define IN_RB 25
#define IN_EWG 26
#define IN_EWU 27
#define IN_EWD 28
#define IN_SWG 29
#define IN_SWU 30
#define IN_SWD 31
#define IN_NFIN 32

template <class SrcF>
__device__ __forceinline__ void tr_item(const SrcF& src, bf16* dst, int dst_ld, int n0, int k0, LAS float* scr, int lane) {
    const int j = lane & 31;
    const float* colp = src(n0 + j);
    const long ld = src.ld;
#pragma unroll 8
    for (int i = 0; i < 32; ++i) { const int kk = 2 * i + (lane >> 5); scr[kk * 33 + j] = colp ? colp[(long)(k0 + kk) * ld] : 0.f; }
    asm volatile("s_waitcnt lgkmcnt(0)" ::: "memory");
    const int c = lane & 7;
#pragma unroll
    for (int jj = 0; jj < 4; ++jj) { const int n = (lane >> 3) + 8 * jj; const LAS float* s = scr + (8 * c) * 33 + n;
        u32x4 o; o.x = pk2(s[0 * 33], s[1 * 33]); o.y = pk2(s[2 * 33], s[3 * 33]); o.z = pk2(s[4 * 33], s[5 * 33]); o.w = pk2(s[6 * 33], s[7 * 33]);
        *(u32x4*)(dst + (size_t)(n0 + n) * dst_ld + k0 + 8 * c) = o; }
    asm volatile("s_waitcnt lgkmcnt(0)" ::: "memory");
}
struct SrcPlain { const float* W; long ld; __device__ __forceinline__ const float* operator()(int n) const { return W + n; } };
__device__ __forceinline__ int win_src_col(int r) {
    if (r < 1536) return r;
    if (r < 1792) return 1552 + (r - 1536);
    if (r < 1920) return 1808 + (r - 1792);
    if (r < 1952) return 1936 + (r - 1920);
    if (r < 1968) return 1536 + (r - 1952);
    if (r < 1976) return 1968 + (r - 1968);
    if (r < 1980) return 3000 + (r - 1976);
    if (r < 1984) return 3004 + (r - 1980);
    if (r < 2048) return -1;
    if (r < 2560) return 1976 + (r - 2048);
    if (r < 3072) return 2488 + (r - 2560);
    if (r < 3584) return 3008 + (r - 3072);
    return 3520 + (r - 3584);
}
struct SrcWin { const float* W; long ld; __device__ __forceinline__ const float* operator()(int n) const { const int c = win_src_col(n); return c < 0 ? nullptr : W + c; } };
struct SrcGU { const float* Wg; const float* Wu; long ld;
    __device__ __forceinline__ const float* operator()(int r) const { const int pn = r >> 8, w = r & 255, j = 128 * pn + (w & 127); return (w < 128 ? Wg : Wu) + j; } };

constexpr int SG_LD = 40;
template <class Epi>
__device__ __forceinline__ void sgemm_unit(const Ctx& c, const bf16* A, int lda, const int* rowlist, int nvalid, int arow0, const bf16* Bt, int K, const Epi& E, int erow0, int ecol0) {
    LAS bf16* As = (LAS bf16*)c.lds;
    LAS bf16* Bs = (LAS bf16*)(c.lds + 128 * SG_LD * 2);
    const int tid = c.tid, lane = c.lane, wave = c.wave, wr = wave >> 2, wc = wave & 3, fr = lane & 15, fq = lane >> 4;
    const int lr = tid >> 2, ch = tid & 3;
    int srow = arow0 + lr;
    if (rowlist) { srow = (arow0 + lr < nvalid) ? rowlist[arow0 + lr] : 0; }
    const bf16* ap = A + (size_t)srow * lda + ch * 8;
    const bf16* bp0 = Bt + (size_t)lr * K + ch * 8;
    const bf16* bp1 = Bt + (size_t)(128 + lr) * K + ch * 8;
    f32x4 acc[2][4][2];
#pragma unroll
    for (int a = 0; a < 2; ++a)
#pragma unroll
        for (int m = 0; m < 4; ++m)
#pragma unroll
            for (int n = 0; n < 2; ++n) acc[a][m][n] = (f32x4){0.f, 0.f, 0.f, 0.f};
    u32x4 ra = *(const u32x4*)ap, rb0 = *(const u32x4*)bp0, rb1 = *(const u32x4*)bp1;
    for (int k0 = 0; k0 < K; k0 += 32) {
        __syncthreads();
        *(LAS u32x4*)(As + lr * SG_LD + ch * 8) = ra;
        *(LAS u32x4*)(Bs + lr * SG_LD + ch * 8) = rb0;
        *(LAS u32x4*)(Bs + (128 + lr) * SG_LD + ch * 8) = rb1;
        __syncthreads();
        if (k0 + 32 < K) { ra = *(const u32x4*)(ap + k0 + 32); rb0 = *(const u32x4*)(bp0 + k0 + 32); rb1 = *(const u32x4*)(bp1 + k0 + 32); }
        bf16x8 af[4], bfr[2][2];
#pragma unroll
        for (int m = 0; m < 4; ++m) af[m] = *(const LAS bf16x8*)(As + (wr * 64 + m * 16 + fr) * SG_LD + fq * 8);
#pragma unroll
        for (int bj = 0; bj < 2; ++bj)
#pragma unroll
            for (int n = 0; n < 2; ++n) bfr[bj][n] = *(const LAS bf16x8*)(Bs + (bj * 128 + wc * 32 + n * 16 + fr) * SG_LD + fq * 8);
#pragma unroll
        for (int bj = 0; bj < 2; ++bj)
#pragma unroll
            for (int m = 0; m < 4; ++m)
#pragma unroll
                for (int n = 0; n < 2; ++n) acc[bj][m][n] = __builtin_amdgcn_mfma_f32_16x16x32_bf16(bfr[bj][n], af[m], acc[bj][m][n], 0, 0, 0);
    }
#pragma unroll
    for (int m = 0; m < 4; ++m)
#pragma unroll
        for (int n = 0; n < 2; ++n) E(erow0 + wr * 64 + m * 16 + fr, ecol0 + wc * 32 + n * 16 + 4 * fq, acc[0][m][n], acc[1][m][n]);
}
template <class Epi>
__device__ __forceinline__ void sgemm_phase(const Ctx& c, const bf16* A, int lda, int M, const bf16* Bt, int ntn, int K, const Epi& E) {
    const int nu = (M / 128) * ntn;
    for (int u = c.bid; u < nu; u += c.nblk) {
        const int pm = u / ntn, pn = u % ntn;
        sgemm_unit(c, A, lda, nullptr, 0, pm * 128, Bt + (size_t)pn * 256 * K, K, E, pm * 128, pn * 256);
    }
    __syncthreads();
}


namespace g8 {
constexpr int BM = 256, BK = 64, HALF = 128, HTB = HALF * BK * 2, STAGE_BYTES = 8 * HTB, NXCD = 8, WGM = 8;
__host__ __device__ __forceinline__ int lds_byte(int r, int c) { const int st = (r >> 4) * 2 + (c >> 5), rr = r & 15, cc = c & 31, ob = rr * 64 + cc * 2; return st * 1024 + (ob ^ (((ob >> 9) & 1) << 5)); }
__host__ __device__ __forceinline__ void stage_rc(int b, int& R, int& C) { const int st = b / 1024, sb = b % 1024, swz = sb ^ (((sb >> 9) & 1) << 5); R = (st >> 1) * 16 + swz / 64; C = (st & 1) * 32 + (swz % 64) / 2; }
struct GUnit { const char* A; const char* B; const int* rl; int nvalid; int erow0, ecol0; int x0; const float* xp; };
__device__ __forceinline__ bool static_order(int nM, int nN, int G, int c, int i, int& pm, int& pn) {
    const int nwg = nM * nN; const long L = (long)i * G + c; if (L >= nwg) return false;
    int wgid = (int)L; { const int q = nwg / NXCD, r = nwg % NXCD, xcd = wgid % NXCD, off = wgid / NXCD; wgid = (xcd < r ? xcd * (q + 1) : r * (q + 1) + (xcd - r) * q) + off; }
    const int nig = WGM * nN, gid = wgid / nig, fm = gid * WGM, gsz = (nM - fm) < WGM ? (nM - fm) : WGM;
    pm = fm + ((wgid % nig) % gsz); pn = (wgid % nig) / gsz; return true;
}
struct DenseSched { const char* A; const char* Bt; size_t ldaB, ldbB; int nM, nN, G, c;
    __device__ __forceinline__ bool next(int i, GUnit& u) const { int pm, pn; if (!static_order(nM, nN, G, c, i, pm, pn)) return false;
        u.A = A + (size_t)pm * 256 * ldaB; u.B = Bt + (size_t)pn * 256 * ldbB; u.rl = nullptr; u.nvalid = 0; u.erow0 = pm * 256; u.ecol0 = pn * 256; u.x0 = 0; u.xp = nullptr; return true; } };

template <bool GATHER, class Epi, class Sched>
__device__ __forceinline__ void gemm_phase(LAS unsigned char* lds, unsigned ldaB, int K, const Sched& S, const Epi& E) {
    const int tid = threadIdx.x, wid = __builtin_amdgcn_readfirstlane(tid >> 6), lane = tid & 63, wr = wid >> 2, wc = wid & 3, fr = lane & 15, fq = lane >> 4;
    const int nt = K / BK;
    int R0, C0, R1, C1; stage_rc(tid * 16, R0, C0); stage_rc(tid * 16 + 8192, R1, C1);
    unsigned voffB[2]; voffB[0] = (unsigned)(R0 * K + C0) * 2u; voffB[1] = (unsigned)(R1 * K + C1) * 2u;
    unsigned ac0[2], ac1[2], an0[2], an1[2];
    const size_t kstep = (size_t)(BK * 2);
    const size_t hstepB = (size_t)HALF * K * 2;
    const unsigned ldsw = (unsigned)wid * 1024u;
    const int aoff = lds_byte(wr * 64 + fr, fq * 8), boff = lds_byte(wc * 32 + fr, fq * 8);
#define G8_SA(b, h) (((b) * 2 + (h)) * HTB)
#define G8_SB(b, h) ((4 + (b) * 2 + (h)) * HTB)
#define G8_STAGE(bufoff, gbase, voff) do { _Pragma("unroll") for (int _i = 0; _i < 2; ++_i) \
        __builtin_amdgcn_global_load_lds((const unsigned*)((const char*)(gbase) + (voff)[_i]), (LAS unsigned*)(lds + (bufoff) + ldsw + _i * 8192), 16, 0, 0); } while (0)
#define G8_LDA(dst, b, h) do { _Pragma("unroll") for (int m = 0; m < 4; ++m) _Pragma("unroll") for (int k = 0; k < 2; ++k) dst[m][k] = *(const LAS bf16x8*)(lds + G8_SA(b, h) + aoff + m * 2048 + k * 1024); } while (0)
#define G8_LDB(dst, b, h) do { _Pragma("unroll") for (int n = 0; n < 2; ++n) _Pragma("unroll") for (int k = 0; k < 2; ++k) dst[n][k] = *(const LAS bf16x8*)(lds + G8_SB(b, h) + boff + n * 2048 + k * 1024); } while (0)
#define G8_MMA(ai, bj, At, Bt) do { __builtin_amdgcn_s_setprio(1); _Pragma("unroll") for (int m = 0; m < 4; ++m) _Pragma("unroll") for (int n = 0; n < 2; ++n) _Pragma("unroll") for (int k = 0; k < 2; ++k) \
        acc[ai][bj][m][n] = __builtin_amdgcn_mfma_f32_16x16x32_bf16(Bt[n][k], At[m][k], acc[ai][bj][m][n], 0, 0, 0); __builtin_amdgcn_s_setprio(0); } while (0)
#define G8_WAIT_V(n) asm volatile("s_waitcnt vmcnt(" #n ")" ::: "memory")
#define G8_WAIT_L(n) asm volatile("s_waitcnt lgkmcnt(" #n ")" ::: "memory")
#define G8_BAR __builtin_amdgcn_s_barrier()
#define G8_SCHED __builtin_amdgcn_sched_barrier(0)
#define G8_XLOAD(u) __builtin_amdgcn_global_load_lds((const unsigned*)((u).rl + lane * 4), (LAS unsigned*)(lds + STAGE_BYTES + wid * 1024), 16, 0, 0)
#define G8_AOFF(u, o0, o1) do { if (GATHER) { const LAS int* _rs = (const LAS int*)(lds + STAGE_BYTES + wid * 1024); const int _nv = (u).nvalid - 1; \
        const int _r00 = _rs[min(R0, _nv)], _r01 = _rs[min(R1, _nv)], _r10 = _rs[min(128 + R0, _nv)], _r11 = _rs[min(128 + R1, _nv)]; \
        o0[0] = (unsigned)_r00 * ldaB + (unsigned)C0 * 2u; o0[1] = (unsigned)_r01 * ldaB + (unsigned)C1 * 2u; o1[0] = (unsigned)_r10 * ldaB + (unsigned)C0 * 2u; o1[1] = (unsigned)_r11 * ldaB + (unsigned)C1 * 2u; \
    } else { o0[0] = (unsigned)R0 * ldaB + (unsigned)C0 * 2u; o0[1] = (unsigned)R1 * ldaB + (unsigned)C1 * 2u; o1[0] = (unsigned)(128 + R0) * ldaB + (unsigned)C0 * 2u; o1[1] = (unsigned)(128 + R1) * ldaB + (unsigned)C1 * 2u; } } while (0)
    GUnit cur, nxt; int ui = 0;
    if (!S.next(0, cur)) return;
    f32x4 acc[2][2][4][2];
#pragma unroll
    for (int a = 0; a < 2; ++a)
#pragma unroll
        for (int b = 0; b < 2; ++b)
#pragma unroll
            for (int m = 0; m < 4; ++m)
#pragma unroll
                for (int n = 0; n < 2; ++n) acc[a][b][m][n] = (f32x4){0.f, 0.f, 0.f, 0.f};
    bf16x8 At[4][2], B0[2][2], B1[2][2];
    if (GATHER) { G8_XLOAD(cur); G8_WAIT_V(0); }
    G8_AOFF(cur, ac0, ac1);
    if (GATHER) { G8_WAIT_L(0); }
    const char* cA = cur.A; const char* cB = cur.B;
    G8_STAGE(G8_SB(0, 0), cB, voffB); G8_STAGE(G8_SB(0, 1), cB + hstepB, voffB); G8_STAGE(G8_SA(0, 0), cA, ac0); G8_STAGE(G8_SA(0, 1), cA, ac1);
    if (wr == 1) G8_BAR;
    G8_WAIT_V(2); G8_BAR;
    G8_STAGE(G8_SB(1, 0), cB + kstep, voffB); G8_STAGE(G8_SA(1, 0), cA + kstep, ac0); G8_STAGE(G8_SB(1, 1), cB + hstepB + kstep, voffB);
    G8_WAIT_V(6); G8_BAR;
    for (;;) {
        const bool has_next = S.next(ui + 1, nxt);
        const char* nA = has_next ? nxt.A : cA; const char* nB = has_next ? nxt.B : cB;
        an0[0] = ac0[0]; an0[1] = ac0[1]; an1[0] = ac1[0]; an1[1] = ac1[1];
        const bool xload = GATHER && has_next;
        if (xload) { G8_XLOAD(nxt); }
#pragma unroll 1
        for (int t = 0; t < nt; t += 2) {
            const bool last = (t == nt - 2);
            const char* a1 = cA + (size_t)(t + 1) * kstep;
            const char* a2 = last ? nA : cA + (size_t)(t + 2) * kstep; const char* b2 = last ? nB : cB + (size_t)(t + 2) * kstep;
            const char* a3 = a2 + kstep; const char* b3 = b2 + kstep;
            unsigned* x0 = last ? an0 : ac0; unsigned* x1 = last ? an1 : ac1;
            unsigned s0[2], s1[2]; s0[0] = x0[0]; s0[1] = x0[1]; s1[0] = x1[0]; s1[1] = x1[1];
            G8_LDB(B0, 0, 0); G8_LDB(B1, 0, 1); G8_SCHED; G8_LDA(At, 0, 0); G8_STAGE(G8_SA(1, 1), a1, ac1);
            if (xload && t == 0) { G8_WAIT_V(9); } else { G8_WAIT_V(8); }
            G8_WAIT_L(0); G8_BAR; G8_MMA(0, 0, At, B0); G8_MMA(0, 1, At, B1); G8_BAR; G8_SCHED;
            G8_LDA(At, 0, 1); G8_STAGE(G8_SB(0, 0), b2, voffB); G8_STAGE(G8_SB(0, 1), b2 + hstepB, voffB); G8_STAGE(G8_SA(0, 0), a2, s0);
            G8_WAIT_V(8); G8_WAIT_L(0); G8_BAR; G8_MMA(1, 0, At, B0); G8_MMA(1, 1, At, B1); G8_BAR; G8_SCHED;
            if (xload && t == 0) { G8_AOFF(nxt, an0, an1); }
            G8_LDB(B0, 1, 0); G8_LDB(B1, 1, 1); G8_SCHED; G8_LDA(At, 1, 0); G8_STAGE(G8_SA(0, 1), a2, s1);
            G8_WAIT_V(8); G8_WAIT_L(0); G8_BAR; G8_MMA(0, 0, At, B0); G8_MMA(0, 1, At, B1); G8_BAR; G8_SCHED;
            G8_LDA(At, 1, 1); G8_STAGE(G8_SB(1, 0), b3, voffB); G8_STAGE(G8_SB(1, 1), b3 + hstepB, voffB); G8_STAGE(G8_SA(1, 0), a3, s0);
            G8_WAIT_V(8); G8_WAIT_L(0); G8_BAR; G8_MMA(1, 0, At, B0); G8_MMA(1, 1, At, B1); G8_BAR; G8_SCHED;
        }
        if (wr == 0) G8_BAR;
#pragma unroll
        for (int ai = 0; ai < 2; ++ai)
#pragma unroll
            for (int m = 0; m < 4; ++m)
#pragma unroll
                for (int n = 0; n < 2; ++n) E(cur, cur.erow0 + ai * HALF + wr * 64 + m * 16 + fr, cur.ecol0 + wc * 32 + n * 16 + 4 * fq, acc[ai][0][m][n], acc[ai][1][m][n]);
        if (!has_next) break;
#pragma unroll
        for (int a = 0; a < 2; ++a)
#pragma unroll
            for (int b = 0; b < 2; ++b)
#pragma unroll
                for (int m = 0; m < 4; ++m)
#pragma unroll
                    for (int n = 0; n < 2; ++n) acc[a][b][m][n] = (f32x4){0.f, 0.f, 0.f, 0.f};
        cur = nxt; cA = nA; cB = nB; ++ui;
        ac0[0] = an0[0]; ac0[1] = an0[1]; ac1[0] = an1[0]; ac1[1] = an1[1];
        if (wr == 1) G8_BAR;
    }
    G8_WAIT_V(0);
    G8_BAR;
#undef G8_SA
#undef G8_SB
#undef G8_STAGE
#undef G8_LDA
#undef G8_LDB
#undef G8_MMA
#undef G8_WAIT_V
#undef G8_WAIT_L
#undef G8_BAR
#undef G8_SCHED
#undef G8_AOFF
#undef G8_XLOAD
}
}
template <class Epi>
__device__ __forceinline__ void dgemm_phase(const Ctx& c, const bf16* A, int lda, int M, const bf16* Bt, int ntn, int K, const Epi& E) {
    g8::DenseSched S{(const char*)A, (const char*)Bt, (size_t)lda * 2, (size_t)K * 2, M / 256, ntn, c.nblk, c.bid};
    g8::gemm_phase<false>(c.lds, (unsigned)lda * 2u, K, S, E);
    __syncthreads();
}

struct EpiInPB { bf16* PB; float* SM;
    __device__ __forceinline__ void operator()(int row, int col, f32x4 lo, f32x4 hi) const {
        st_bf4(PB + (size_t)row * NPB + col, lo);
        if ((col >> 8) == 7) *(f32x4*)(SM + (size_t)row * 128 + (col & 127)) = hi;
        else st_bf4(PB + (size_t)row * NPB + col + 128, hi);
    } };
struct EpiQ { bf16* QLAT; bf16* QIDX; const float* rstd;
    __device__ __forceinline__ void operator()(int row, int col, f32x4 lo, f32x4 hi) const {
        const float r = rstd[row];
        if (col < 1024) { st_bf4(QLAT + (size_t)row * 1024 + col, lo * r); st_bf4(QLAT + (size_t)row * 1024 + col + 128, hi * r); }
        else { st_bf4(QIDX + (size_t)row * 256 + (col - 1024), lo * r); st_bf4(QIDX + (size_t)row * 256 + (col - 1024) + 128, hi * r); }
    } };
struct EpiGate { bf16* G;
    __device__ __forceinline__ void operator()(int row, int col, f32x4 lo, f32x4 hi) const {
        f32x4 a, b;
#pragma unroll
        for (int i = 0; i < 4; ++i) { a[i] = sigmoidf_(lo[i]); b[i] = sigmoidf_(hi[i]); }
        st_bf4(G + (size_t)row * NG + col, a); st_bf4(G + (size_t)row * NG + col + 128, b);
    } };
struct EpiUp { bf16* M1; const bf16* G; int goff; int first;
    __device__ __forceinline__ void operator()(int row, int col, f32x4 lo, f32x4 hi) const {
        bf16* m = M1 + (size_t)row * 1024 + col; const bf16* g = G + (size_t)row * NG + goff + col;
        f32x4 a = ld_bf4(g) * lo, b = ld_bf4(g + 128) * hi;
        if (!first) { a += ld_bf4(m); b += ld_bf4(m + 128); }
        st_bf4(m, a); st_bf4(m + 128, b);
    } };
struct EpiWo { const float* res; float* out; const float* g1;
    __device__ __forceinline__ void operator()(int row, int col, f32x4 lo, f32x4 hi) const {
        const float* gp = g1 + (size_t)(row >> 11) * 6144 + col; const size_t o = (size_t)row * 1024 + col;
        const f32x4 ga = *(const f32x4*)gp, gb = *(const f32x4*)(gp + 128);
        const f32x4 ra = *(const f32x4*)(res + o), rb = *(const f32x4*)(res + o + 128);
        *(f32x4*)(out + o) = ra + ga * lo; *(f32x4*)(out + o + 128) = rb + gb * hi;
    } };
struct EpiG1 { bf16* HID; const float* wl; int cnt; int orow0;
    __device__ __forceinline__ void operator()(int row, int col, f32x4 lo, f32x4 hi) const {
        const int hc = col - 128 * (col >> 8);
        f32x4 v = (f32x4){0.f, 0.f, 0.f, 0.f};
        if (row < cnt) { const float w = wl ? wl[row] : 1.f;
#pragma unroll
            for (int i = 0; i < 4; ++i) v[i] = siluf_(lo[i]) * hi[i] * w; }
        st_bf4(HID + (size_t)(orow0 + row) * 256 + hc, v);
    } };
struct EpiG2 { bf16* Y; int orow0;
    __device__ __forceinline__ void operator()(int row, int col, f32x4 lo, f32x4 hi) const {
        st_bf4(Y + (size_t)(orow0 + row) * 1024 + col, lo); st_bf4(Y + (size_t)(orow0 + row) * 1024 + col + 128, hi);
    } };


template <class F> struct EpiU { F f; __device__ __forceinline__ void operator()(const g8::GUnit&, int row, int col, f32x4 lo, f32x4 hi) const { f(row, col, lo, hi); } };

__device__ __forceinline__ void phase_prologue(const Ctx& c) {
    {
        LAS float* cs = (LAS float*)c.lds;
        LAS float* red = (LAS float*)(c.lds + 65536);
        const float* cin = c.in[IN_C];
        if (c.bid < 192) {
            for (int i = c.tid; i < 16 * 1024; i += NTHR) cs[i] = siluf_(cin[i]);
            __syncthreads();
        }
        float* MOD = (float*)(c.ws + WS_MOD);
        for (int it = c.bid; it < 192; it += c.nblk) {
            const int l = it / 96, cg = it % 96, col = cg * 64 + c.lane;
            const float* W = c.in[IN_ADAW] + (size_t)l * 1024 * 6144 + col;
            float acc[16];
#pragma unroll
            for (int b = 0; b < 16; ++b) acc[b] = 0.f;
            const int kbeg = c.wave * 128;
            for (int k = kbeg; k < kbeg + 128; k += 4) {
                const float w0 = W[(size_t)k * 6144], w1 = W[(size_t)(k + 1) * 6144], w2 = W[(size_t)(k + 2) * 6144], w3 = W[(size_t)(k + 3) * 6144];
#pragma unroll
                for (int b = 0; b < 16; ++b) { const f32x4 v = *(const LAS f32x4*)(cs + b * 1024 + k); acc[b] += v[0] * w0 + v[1] * w1 + v[2] * w2 + v[3] * w3; }
            }
#pragma unroll
            for (int b = 0; b < 16; ++b) red[(c.wave * 16 + b) * 64 + c.lane] = acc[b];
            __syncthreads();
            for (int i = c.tid; i < 16 * 64; i += NTHR) { const int b = i >> 6, ln = i & 63; float s = 0.f;
#pragma unroll
                for (int w = 0; w < 8; ++w) s += red[(w * 16 + b) * 64 + ln];
                MOD[((size_t)l * 16 + b) * 6144 + cg * 64 + ln] = s + c.in[IN_ADAB][l * 6144 + cg * 64 + ln]; }
            __syncthreads();
        }
        __syncthreads();
    }
    {
        LAS float* scr = (LAS float*)(c.lds + c.wave * 16384);
        const int gw = c.bid * NWAVES + c.wave, NGW = c.nblk * NWAVES;
        constexpr int I_WIN = (NINP / 32) * (1024 / 64), I_UP = (1024 / 32) * (512 / 64), I_WO = (1024 / 32) * (1024 / 64);
        constexpr int PER_L = I_WIN + 2 * I_UP + I_WO;
        for (int it = gw; it < NL * PER_L; it += NGW) {
            const int l = it / PER_L; int r = it % PER_L;
            if (r < I_WIN) { SrcWin s{c.in[IN_WIN] + (size_t)l * 1024 * NIN, NIN}; tr_item(s, (bf16*)(c.ws + WS_WIN) + (size_t)l * NINP * 1024, 1024, (r / 16) * 32, (r % 16) * 64, scr, c.lane); continue; }
            r -= I_WIN;
            if (r < I_UP) { SrcPlain s{c.in[IN_WUPA] + (size_t)l * 512 * 1024, 1024}; tr_item(s, (bf16*)(c.ws + WS_WUPA) + (size_t)l * 1024 * 512, 512, (r / 8) * 32, (r % 8) * 64, scr, c.lane); continue; }
            r -= I_UP;
            if (r < I_UP) { SrcPlain s{c.in[IN_WUPC] + (size_t)l * 512 * 1024, 1024}; tr_item(s, (bf16*)(c.ws + WS_WUPC) + (size_t)l * 1024 * 512, 512, (r / 8) * 32, (r % 8) * 64, scr, c.lane); continue; }
            r -= I_UP;
            { SrcPlain s{c.in[IN_WO] + (size_t)l * 1024 * 1024, 1024}; tr_item(s, (bf16*)(c.ws + WS_WO) + (size_t)l * 1024 * 1024, 1024, (r / 16) * 32, (r % 16) * 64, scr, c.lane); }
        }
    }
    {
        const int gt = c.bid * NTHR + c.tid, NGT = c.nblk * NTHR;
        for (int i = gt; i < T; i += NGT) ((int*)(c.ws + WS_IDENT))[i] = i;
        for (int it = gt; it < NL * 1280 * 32; it += NGT) {
            const int l = it / (1280 * 32), rem = it % (1280 * 32), n = rem / 32, r0 = (rem % 32) * 8;
            const float* gq = c.in[IN_DSA_NQ] + l * 256;
            float o[8];
            if (n < 1024) {
                const int h = n >> 7, cc = n & 127;
                const float* uk = c.in[IN_DSA_WUK] + (size_t)l * 128 * 512 + (size_t)cc * 512 + h * 64;
#pragma unroll
                for (int i = 0; i < 8; ++i) { const float* uq = c.in[IN_DSA_WUQ] + (size_t)l * 256 * 512 + (size_t)(r0 + i) * 512 + h * 64; float s = 0.f;
                    for (int d = 0; d < 64; ++d) s += uq[d] * uk[d];
                    o[i] = s * 0.125f * gq[r0 + i]; }
            } else {
                const int m = n - 1024;
#pragma unroll
                for (int i = 0; i < 8; ++i) o[i] = c.in[IN_DSA_WQI][(size_t)l * 256 * 256 + (size_t)(r0 + i) * 256 + m] * 0.17677669529663687f * gq[r0 + i];
            }
            u32x4 w; w.x = pk2(o[0], o[1]); w.y = pk2(o[2], o[3]); w.z = pk2(o[4], o[5]); w.w = pk2(o[6], o[7]);
            *(u32x4*)((bf16*)(c.ws + WS_WQ) + (size_t)l * 1280 * 256 + (size_t)n * 256 + r0) = w;
        }
    }
    {
        const int gt = c.bid * NTHR + c.tid, NGT = c.nblk * NTHR;
        for (int it = gt; it < NL * 128 * 1024; it += NGT) {
            const int l = it / (128 * 1024), rem = it % (128 * 1024), kc = rem / 1024, n = rem % 1024;
            const int h = kc >> 4, r0 = (kc & 15) * 8;
            const float* uv = c.in[IN_DSA_WUV] + (size_t)l * 128 * 512;
            const float* ub = c.in[IN_WUPB] + (size_t)l * 512 * 1024 + (size_t)(h * 64) * 1024 + n;
            float o[8];
#pragma unroll
            for (int i = 0; i < 8; ++i) o[i] = 0.f;
            for (int v = 0; v < 64; ++v) { const float b = ub[(size_t)v * 1024];
#pragma unroll
                for (int i = 0; i < 8; ++i) o[i] += uv[(size_t)(r0 + i) * 512 + h * 64 + v] * b; }
            u32x4 w; w.x = pk2(o[0], o[1]); w.y = pk2(o[2], o[3]); w.z = pk2(o[4], o[5]); w.w = pk2(o[6], o[7]);
            *(u32x4*)((bf16*)(c.ws + WS_WUVB) + (size_t)l * 1024 * 1024 + (size_t)n * 1024 + h * 128 + r0) = w;
        }
    }
}

__device__ __forceinline__ void norm_mod_row(const float* xrow, const float* gain, const float* sh, const float* sc, bf16* orow, int lane) {
    f32x4 v[4]; float s = 0.f;
#pragma unroll
    for (int j = 0; j < 4; ++j) { v[j] = *(const f32x4*)(xrow + 4 * (lane + 64 * j)); s += v[j][0] * v[j][0] + v[j][1] * v[j][1] + v[j][2] * v[j][2] + v[j][3] * v[j][3]; }
    const float rstd = rsqrtf(wave_sum(s) * (1.f / D) + EPS);
#pragma unroll
    for (int j = 0; j < 4; ++j) { const int cc = 4 * (lane + 64 * j);
        const f32x4 g = *(const f32x4*)(gain + cc), a = *(const f32x4*)(sc + cc), b = *(const f32x4*)(sh + cc);
        st_bf4(orow + cc, v[j] * rstd * g * (a + 1.f) + b); }
}
__device__ __forceinline__ void phase_norm1(const Ctx& c, int l, const float* xsrc) {
    const int gw = c.bid * NWAVES + c.wave, NGW = c.nblk * NWAVES;
    const float* MOD = (const float*)(c.ws + WS_MOD) + (size_t)l * 16 * 6144;
    bf16* XN = (bf16*)(c.ws + WS_XN);
    for (int t = gw; t < T; t += NGW) { const int b = t >> 11;
        norm_mod_row(xsrc + (size_t)t * D, c.in[IN_NMIX] + l * D, MOD + (size_t)b * 6144, MOD + (size_t)b * 6144 + 1024, XN + (size_t)t * D, c.lane); }
}

__device__ __forceinline__ void phase_prep(const Ctx& c, int l) {
    const int gw = c.bid * NWAVES + c.wave, NGW = c.nblk * NWAVES;
    const bf16* PB = (const bf16*)(c.ws + WS_PB); const float* SM = (const float*)(c.ws + WS_SM);
    bf16* CKVN = (bf16*)(c.ws + WS_CKVN); bf16* KIDX = (bf16*)(c.ws + WS_KIDX); float* RSTDQ = (float*)(c.ws + WS_RSTDQ);
    const float* gkv = c.in[IN_DSA_NKV] + l * 128;
    const float g0 = gkv[2 * c.lane], g1 = gkv[2 * c.lane + 1];
    for (int t = gw; t < T; t += NGW) {
        const bf16* row = PB + (size_t)t * NPB;
        const unsigned kv = *(const unsigned*)(row + PB_CKV + 2 * c.lane);
        const float k0 = bflo(kv), k1 = bfhi(kv);
        const float rs = rsqrtf(wave_sum(k0 * k0 + k1 * k1) * (1.f / 128.f) + EPS);
        *(unsigned*)(CKVN + (size_t)t * 128 + 2 * c.lane) = pk2(k0 * rs * g0, k1 * rs * g1);
        const f32x4 q = ld_bf4(row + PB_CQ + 4 * c.lane);
        const float rq = rsqrtf(wave_sum(q[0] * q[0] + q[1] * q[1] + q[2] * q[2] + q[3] * q[3]) * (1.f / 256.f) + EPS);
        if (c.lane == 0) RSTDQ[t] = rq;
        if (c.lane < 32) KIDX[(size_t)t * 32 + c.lane] = (bf16)f2bf(SM[(size_t)t * 128 + SM_KIDX + c.lane]);
    }
}
__device__ __forceinline__ void phase_ckvt(const Ctx& c) {
    const bf16* CKVN = (const bf16*)(c.ws + WS_CKVN); bf16* CKVT = (bf16*)(c.ws + WS_CKVT);
    LAS bf16* tile = (LAS bf16*)c.lds;
    for (int it = c.bid; it < T / 64; it += c.nblk) {
        const int tb = it * 64, b = tb >> 11, p0 = tb & 2047;
        __syncthreads();
        { const int r = c.tid >> 3, ch = (c.tid & 7) * 8;
          *(LAS u32x4*)(tile + r * 136 + ch) = *(const u32x4*)(CKVN + (size_t)(tb + r) * 128 + ch); *(LAS u32x4*)(tile + r * 136 + 64 + ch) = *(const u32x4*)(CKVN + (size_t)(tb + r) * 128 + 64 + ch); }
        __syncthreads();
        { const int r = c.tid >> 2, part = c.tid & 3;
          unsigned w[8];
#pragma unroll
          for (int j = 0; j < 8; ++j) w[j] = (unsigned)tile[(16 * part + 2 * j) * 136 + r] | ((unsigned)tile[(16 * part + 2 * j + 1) * 136 + r] << 16);
          bf16* dst = CKVT + ((size_t)b * 128 + r) * 2048 + p0 + 16 * part;
          *(u32x4*)dst = (u32x4){w[0], w[1], w[2], w[3]}; *(u32x4*)(dst + 8) = (u32x4){w[4], w[5], w[6], w[7]}; }
    }
    __syncthreads();
}

constexpr int TS = 16;
__device__ __forceinline__ void scan_gla_item(const Ctx& c, int l, int b, int h) {
    LAS float* q_s = (LAS float*)c.lds;
    LAS float* k_s = q_s + TS * 64;
    LAS float* a_s = k_s + TS * 64;
    LAS float* v_s = a_s + TS * 64;
    LAS float* part = v_s + TS * 128;
    LAS float* wa2 = part + TS * 4 * 128;
    LAS float* ba = wa2 + 16 * 64;
    LAS float* alr = ba + 64;
    const bf16* PB = (const bf16*)(c.ws + WS_PB); const float* SM = (const float*)(c.ws + WS_SM);
    bf16* UA = (bf16*)(c.ws + WS_UA);
    const float* gn = c.in[IN_GLA_NORM] + l * 512 + h * 128;
    for (int i = c.tid; i < 16 * 64; i += NTHR) wa2[i] = c.in[IN_GLA_WA2][(size_t)l * 16 * 256 + (i >> 6) * 256 + h * 64 + (i & 63)];
    if (c.tid < 64) ba[c.tid] = c.in[IN_GLA_BA][l * 256 + h * 64 + c.tid];
    const int v = c.tid & 127, kg = c.tid >> 7;
    float S[16];
#pragma unroll
    for (int i = 0; i < 16; ++i) S[i] = 0.f;
    for (int t0 = 0; t0 < SEQ; t0 += TS) {
        __syncthreads();
        const size_t rb = (size_t)b * SEQ + t0;
        for (int i = c.tid; i < TS * 64; i += NTHR) { const int s = i >> 6, cc = i & 63; const bf16* row = PB + (rb + s) * NPB;
            q_s[i] = bf2f(row[PB_QA + h * 64 + cc]) * 0.125f; k_s[i] = bf2f(row[PB_KA + h * 64 + cc]); }
        for (int i = c.tid; i < TS * 128; i += NTHR) { const int s = i >> 7, cc = i & 127; v_s[i] = bf2f(PB[(rb + s) * NPB + PB_VA + h * 128 + cc]); }
        if (c.tid < TS * 16) alr[c.tid] = SM[(rb + (c.tid >> 4)) * 128 + SM_ALR + (c.tid & 15)];
        __syncthreads();
        for (int i = c.tid; i < TS * 64; i += NTHR) { const int s = i >> 6, cc = i & 63; float x = ba[cc];
#pragma unroll
            for (int j = 0; j < 16; ++j) x += alr[s * 16 + j] * wa2[j * 64 + cc];
            a_s[i] = __expf(logsigmoidf_(x) * (1.f / 16.f)); }
        __syncthreads();
#pragma unroll 1
        for (int s = 0; s < TS; ++s) {
            const float vv = v_s[s * 128 + v]; float acc = 0.f;
#pragma unroll
            for (int i4 = 0; i4 < 4; ++i4) {
                const f32x4 a4 = *(const LAS f32x4*)(a_s + s * 64 + kg * 16 + i4 * 4), k4 = *(const LAS f32x4*)(k_s + s * 64 + kg * 16 + i4 * 4), q4 = *(const LAS f32x4*)(q_s + s * 64 + kg * 16 + i4 * 4);
#pragma unroll
                for (int j = 0; j < 4; ++j) { S[i4 * 4 + j] = a4[j] * S[i4 * 4 + j] + k4[j] * vv; acc += q4[j] * S[i4 * 4 + j]; }
            }
            part[(s * 4 + kg) * 128 + v] = acc;
        }
        __syncthreads();
        {
            const int s = c.tid >> 5, vq = c.tid & 31, v0 = vq * 4;
            f32x4 o = (f32x4){0.f, 0.f, 0.f, 0.f};
#pragma unroll
            for (int g = 0; g < 4; ++g) o += *(const LAS f32x4*)(part + (s * 4 + g) * 128 + v0);
            float ss = o[0] * o[0] + o[1] * o[1] + o[2] * o[2] + o[3] * o[3];
#pragma unroll
            for (int m = 1; m < 32; m <<= 1) ss += __shfl_xor(ss, m);
            const float rstd = rsqrtf(ss * (1.f / 128.f) + EPS);
            const f32x4 ga = ld_bf4(PB + (rb + s) * NPB + PB_GA + h * 128 + v0);
            f32x4 r;
#pragma unroll
            for (int j = 0; j < 4; ++j) r[j] = o[j] * rstd * gn[v0 + j] * siluf_(ga[j]);
            st_bf4(UA + (rb + s) * 512 + h * 128 + v0, r);
        }
    }
    __syncthreads();
}
__device__ __forceinline__ void scan_mlstm_item(const Ctx& c, int l, int b, int h) {
    LAS float* q_s = (LAS float*)c.lds;
    LAS float* k_s = q_s + TS * 64;
    LAS float* v_s = k_s + TS * 64;
    LAS float* part = v_s + TS * 128;
    LAS float* dpart = part + TS * 4 * 128;
    LAS float* lf_s = dpart + TS * 4;
    LAS float* ip_s = lf_s + TS;
    LAS float* m_s = ip_s + TS;
    LAS float* cw = m_s + TS;
    const bf16* PB = (const bf16*)(c.ws + WS_PB); const float* SM = (const float*)(c.ws + WS_SM);
    bf16* UC = (bf16*)(c.ws + WS_UC);
    const float* mn = c.in[IN_ML_NORM] + l * 512 + h * 128;
    if (c.tid < 4 * 128) { const int j = c.tid >> 7, cc = c.tid & 127; cw[c.tid] = c.in[IN_ML_CONV][(size_t)l * 4 * 512 + j * 512 + (cc < 64 ? h * 64 + cc : 256 + h * 64 + (cc - 64))]; }
    const float bi = c.in[IN_ML_BI][l * 4 + h], bfv = c.in[IN_ML_BF][l * 4 + h];
    const int v = c.tid & 127, kg = c.tid >> 7;
    float C[16], n[16]; float m = 0.f;
#pragma unroll
    for (int i = 0; i < 16; ++i) { C[i] = 0.f; n[i] = 0.f; }
    for (int t0 = 0; t0 < SEQ; t0 += TS) {
        __syncthreads();
        const size_t rb = (size_t)b * SEQ + t0;
        for (int i = c.tid; i < TS * 128; i += NTHR) { const int s = i >> 7, cc = i & 127;
            const int col = cc < 64 ? PB_QC + h * 64 + cc : PB_KC + h * 64 + (cc - 64);
            float x = 0.f;
#pragma unroll
            for (int j = 0; j < 4; ++j) { const int tt = t0 + s - 3 + j; if (tt >= 0) x += cw[j * 128 + cc] * bf2f(PB[((size_t)b * SEQ + tt) * NPB + col]); }
            x = siluf_(x);
            if (cc < 64) q_s[s * 64 + cc] = x * 0.125f; else k_s[s * 64 + (cc - 64)] = x; }
        for (int i = c.tid; i < TS * 128; i += NTHR) { const int s = i >> 7, cc = i & 127; v_s[i] = bf2f(PB[(rb + s) * NPB + PB_VC + h * 128 + cc]); }
        if (c.tid < TS) { ip_s[c.tid] = SM[(rb + c.tid) * 128 + SM_IC + h] + bi; lf_s[c.tid] = logsigmoidf_(SM[(rb + c.tid) * 128 + SM_FC + h] + bfv); }
        __syncthreads();
#pragma unroll 1
        for (int s = 0; s < TS; ++s) {
            const float lf = lf_s[s], ip = ip_s[s];
            const float mnew = fmaxf(lf + m, ip), fg = __expf(lf + m - mnew), ig = __expf(ip - mnew);
            m = mnew;
            const float vv = v_s[s * 128 + v] * ig; float num = 0.f, den = 0.f;
#pragma unroll
            for (int i4 = 0; i4 < 4; ++i4) {
                const f32x4 k4 = *(const LAS f32x4*)(k_s + s * 64 + kg * 16 + i4 * 4), q4 = *(const LAS f32x4*)(q_s + s * 64 + kg * 16 + i4 * 4);
#pragma unroll
                for (int j = 0; j < 4; ++j) { C[i4 * 4 + j] = fg * C[i4 * 4 + j] + k4[j] * vv; n[i4 * 4 + j] = fg * n[i4 * 4 + j] + ig * k4[j]; num += q4[j] * C[i4 * 4 + j]; den += q4[j] * n[i4 * 4 + j]; }
            }
            part[(s * 4 + kg) * 128 + v] = num;
            if (v == 0) dpart[s * 4 + kg] = den;
            if (c.tid == 0) m_s[s] = m;
        }
        __syncthreads();
        {
            const int s = c.tid >> 5, vq = c.tid & 31, v0 = vq * 4;
            f32x4 o = (f32x4){0.f, 0.f, 0.f, 0.f};
#pragma unroll
            for (int g = 0; g < 4; ++g) o += *(const LAS f32x4*)(part + (s * 4 + g) * 128 + v0);
            const float den = dpart[s * 4] + dpart[s * 4 + 1] + dpart[s * 4 + 2] + dpart[s * 4 + 3];
            const float dd = 1.f / fmaxf(fabsf(den), __expf(-m_s[s]));
            o = o * dd;
            float ss = o[0] * o[0] + o[1] * o[1] + o[2] * o[2] + o[3] * o[3];
#pragma unroll
            for (int mm = 1; mm < 32; mm <<= 1) ss += __shfl_xor(ss, mm);
            const float rstd = rsqrtf(ss * (1.f / 128.f) + EPS);
            const f32x4 oc = ld_bf4(PB + (rb + s) * NPB + PB_OC + h * 128 + v0);
            f32x4 r;
#pragma unroll
            for (int j = 0; j < 4; ++j) r[j] = o[j] * rstd * mn[v0 + j] * sigmoidf_(oc[j]);
            st_bf4(UC + (rb + s) * 512 + h * 128 + v0, r);
        }
    }
    __syncthreads();
}

constexpr int LQ = 72;
constexpr int SC_QT = 0, SC_KT = 9216, SC_KTT = 18432, SC_Q2 = 27648, SC_SC = 36864, SC_VT = 46080, SC_ST = 66816, SC_FL = 108288;
__device__ __forceinline__ float wave_scan_add(float x, int lane) {
#pragma unroll
    for (int d = 1; d < 64; d <<= 1) { const float y = __shfl_up(x, d); if (lane >= d) x += y; }
    return x;
}
__device__ __forceinline__ float wave_scan_max(float x, int lane) {
#pragma unroll
    for (int d = 1; d < 64; d <<= 1) { const float y = __shfl_up(x, d); if (lane >= d) x = fmaxf(x, y); }
    return x;
}
__device__ __forceinline__ void unpack8(u32x4 w, float (&f)[8]) { f[0] = bflo(w.x); f[1] = bfhi(w.x); f[2] = bflo(w.y); f[3] = bfhi(w.y); f[4] = bflo(w.z); f[5] = bfhi(w.z); f[6] = bflo(w.w); f[7] = bfhi(w.w); }
__device__ __forceinline__ u32x4 pack8(const float (&f)[8]) { u32x4 w; w.x = pk2(f[0], f[1]); w.y = pk2(f[2], f[3]); w.z = pk2(f[4], f[5]); w.w = pk2(f[6], f[7]); return w; }
template <bool ML>
__device__ __forceinline__ void scan_chunked_item(const Ctx& c, int l, int b, int h) {
    LAS bf16* Qt0 = (LAS bf16*)(c.lds + SC_QT); LAS bf16* Kt0 = (LAS bf16*)(c.lds + SC_KT); LAS bf16* KtT0 = (LAS bf16*)(c.lds + SC_KTT);
    LAS bf16* Q20 = (LAS bf16*)(c.lds + SC_Q2); LAS bf16* Sc0 = (LAS bf16*)(c.lds + SC_SC); LAS bf16* VT0 = (LAS bf16*)(c.lds + SC_VT);
    LAS bf16* ST0 = (LAS bf16*)(c.lds + SC_ST);
    LAS float* segtot = (LAS float*)(c.lds + SC_FL);
    LAS float* etot = segtot + 512;
    LAS float* ssq = etot + 64;
    LAS float* dn = ssq + 512;
    LAS float* wa2 = dn + 64;
    LAS float* ba = wa2 + 1024;
    LAS float* cw = ba + 64;
    const int tid = c.tid, lane = c.lane, w = c.wave, fr = lane & 15, fq = lane >> 4;
    const int srow = tid >> 3, kg = tid & 7, k8 = kg * 8, vrow = tid >> 4, vc8 = (tid & 15) * 8;
    const bf16* PB = (const bf16*)(c.ws + WS_PB); const float* SM = (const float*)(c.ws + WS_SM);
    bf16* UO = (bf16*)(c.ws + (ML ? WS_UC : WS_UA));
    const int QCOL = (ML ? PB_QC : PB_QA) + h * 64, KCOL = (ML ? PB_KC : PB_KA) + h * 64, VCOL = (ML ? PB_VC : PB_VA) + h * 128, GCOL = (ML ? PB_OC : PB_GA) + h * 128;
    const float* gnorm = c.in[ML ? IN_ML_NORM : IN_GLA_NORM] + l * 512 + h * 128;
    __syncthreads();
    if (!ML) { for (int i = tid; i < 1024; i += NTHR) wa2[i] = c.in[IN_GLA_WA2][(size_t)l * 16 * 256 + (i >> 6) * 256 + h * 64 + (i & 63)];
               if (tid < 64) ba[tid] = c.in[IN_GLA_BA][l * 256 + h * 64 + tid]; }
    else { if (tid < 512) { const int j = tid >> 7, cc = tid & 127; cw[tid] = c.in[IN_ML_CONV][(size_t)l * 4 * 512 + j * 512 + (cc < 64 ? h * 64 + cc : 256 + h * 64 + (cc - 64))]; } }
    for (int i = tid; i < 144 * LQ / 2; i += NTHR) ((LAS unsigned*)ST0)[i] = 0u;
    if (ML) { for (int i = tid; i < 16 * LQ; i += NTHR) VT0[128 * LQ + i] = (i < 64) ? (bf16)0x3f80u : (bf16)0u; }
    const float bi = ML ? c.in[IN_ML_BI][l * 4 + h] : 0.f, bfv = ML ? c.in[IN_ML_BF][l * 4 + h] : 0.f;
    float m_prev = 0.f;
    f32x4 Sacc[4], Nacc = (f32x4){0.f, 0.f, 0.f, 0.f};
#pragma unroll
    for (int i = 0; i < 4; ++i) Sacc[i] = (f32x4){0.f, 0.f, 0.f, 0.f};
    u32x4 rq[ML ? 4 : 1], rk[ML ? 4 : 1], rv[2]; f32x4 ra[4]; float ric = 0.f, rfc = 0.f;
    const u32x4 z4 = (u32x4){0u, 0u, 0u, 0u};
#define SC_LOAD(cch) do { const size_t _g = (size_t)b * SEQ + (size_t)(cch) * 64; \
        if (ML) { _Pragma("unroll") for (int _j = 0; _j < 4; ++_j) { const int _tt = (cch) * 64 + srow - 3 + _j; \
                rq[_j] = _tt >= 0 ? *(const u32x4*)(PB + ((size_t)b * SEQ + _tt) * NPB + QCOL + k8) : z4; rk[_j] = _tt >= 0 ? *(const u32x4*)(PB + ((size_t)b * SEQ + _tt) * NPB + KCOL + k8) : z4; } \
            ric = SM[(_g + lane) * 128 + SM_IC + h]; rfc = SM[(_g + lane) * 128 + SM_FC + h]; } \
        else { rq[0] = *(const u32x4*)(PB + (_g + srow) * NPB + QCOL + k8); rk[0] = *(const u32x4*)(PB + (_g + srow) * NPB + KCOL + k8); \
            _Pragma("unroll") for (int _j = 0; _j < 4; ++_j) ra[_j] = *(const f32x4*)(SM + (_g + srow) * 128 + SM_ALR + 4 * _j); } \
        rv[0] = *(const u32x4*)(PB + (_g + vrow) * NPB + VCOL + vc8); rv[1] = *(const u32x4*)(PB + (_g + 32 + vrow) * NPB + VCOL + vc8); } while (0)
    SC_LOAD(0);
    __syncthreads();
#pragma unroll 1
    for (int cch = 0; cch < SEQ / 64; ++cch) {
        const size_t grow = (size_t)b * SEQ + (size_t)cch * 64;
        int lz; asm volatile("v_mov_b32 %0, 0" : "=v"(lz));
        LAS bf16* Qt = Qt0 + lz; LAS bf16* Kt = Kt0 + lz; LAS bf16* KtT = KtT0 + lz; LAS bf16* Q2 = Q20 + lz; LAS bf16* Sc = Sc0 + lz; LAS bf16* VT = VT0 + lz; LAS bf16* ST = ST0 + lz;
        LAS bf16* STc = ST + (cch & 1) * 144 * LQ; LAS bf16* STn = ST + ((cch & 1) ^ 1) * 144 * LQ;
        float qv[8], kv[8];
        float g_a = 0.f, g_M = 0.f, g_bc = 0.f, M63 = 0.f, wc = 1.f;
        if (!ML) {
            unpack8(rq[0], qv); unpack8(rk[0], kv);
            float la[8];
#pragma unroll
            for (int i = 0; i < 8; ++i) la[i] = ba[k8 + i];
#pragma unroll
            for (int j4 = 0; j4 < 4; ++j4)
#pragma unroll
                for (int jj = 0; jj < 4; ++jj) { const float a = ra[j4][jj]; const LAS float* wr_ = wa2 + (j4 * 4 + jj) * 64 + k8;
                    const f32x4 w0 = *(const LAS f32x4*)wr_, w1 = *(const LAS f32x4*)(wr_ + 4);
                    la[0] += a * w0[0]; la[1] += a * w0[1]; la[2] += a * w0[2]; la[3] += a * w0[3]; la[4] += a * w1[0]; la[5] += a * w1[1]; la[6] += a * w1[2]; la[7] += a * w1[3]; }
#pragma unroll
            for (int i = 0; i < 8; ++i) { float x = logsigmoid_fast(la[i]) * (1.f / 16.f);
#pragma unroll
                for (int d = 8; d < 64; d <<= 1) { const float y = __shfl_up(x, d); if (lane >= d) x += y; }
                la[i] = x; }
            if ((lane >> 3) == 7) { *(LAS f32x4*)(segtot + w * 64 + k8) = (f32x4){la[0], la[1], la[2], la[3]}; *(LAS f32x4*)(segtot + w * 64 + k8 + 4) = (f32x4){la[4], la[5], la[6], la[7]}; }
            __syncthreads();
            float tot[8];
#pragma unroll
            for (int i = 0; i < 8; ++i) tot[i] = 0.f;
#pragma unroll
            for (int ww = 0; ww < 8; ++ww) { const f32x4 s0 = *(const LAS f32x4*)(segtot + ww * 64 + k8), s1 = *(const LAS f32x4*)(segtot + ww * 64 + k8 + 4);
                const float sel = ww < w ? 1.f : 0.f;
                la[0] += sel * s0[0]; la[1] += sel * s0[1]; la[2] += sel * s0[2]; la[3] += sel * s0[3]; la[4] += sel * s1[0]; la[5] += sel * s1[1]; la[6] += sel * s1[2]; la[7] += sel * s1[3];
                tot[0] += s0[0]; tot[1] += s0[1]; tot[2] += s0[2]; tot[3] += s0[3]; tot[4] += s1[0]; tot[5] += s1[1]; tot[6] += s1[2]; tot[7] += s1[3]; }
            if (tid < 8) {
#pragma unroll
                for (int i = 0; i < 8; ++i) etot[k8 + i] = __expf(tot[i]); }
            float kt[8];
#pragma unroll
            for (int i = 0; i < 8; ++i) { qv[i] = qv[i] * 0.125f * __expf(la[i]); kt[i] = kv[i] * __expf(-la[i]); }
            *(LAS u32x4*)(Qt + srow * LQ + k8) = pack8(qv); *(LAS u32x4*)(Kt + srow * LQ + k8) = pack8(kt);
#pragma unroll
            for (int i = 0; i < 8; ++i) KtT[(k8 + i) * LQ + srow] = (bf16)f2bf(kt[i]);
        } else {
            float x4[4][8];
#pragma unroll
            for (int j = 0; j < 4; ++j) unpack8(rq[j], x4[j]);
#pragma unroll
            for (int i = 0; i < 8; ++i) { float x = 0.f;
#pragma unroll
                for (int j = 0; j < 4; ++j) x += cw[j * 128 + k8 + i] * x4[j][i];
                qv[i] = siluf_(x) * 0.125f; }
#pragma unroll
            for (int j = 0; j < 4; ++j) unpack8(rk[j], x4[j]);
#pragma unroll
            for (int i = 0; i < 8; ++i) { float x = 0.f;
#pragma unroll
                for (int j = 0; j < 4; ++j) x += cw[j * 128 + 64 + k8 + i] * x4[j][i];
                kv[i] = siluf_(x); }
            const float lf = logsigmoid_fast(rfc + bfv), ip = ric + bi;
            g_bc = wave_scan_add(lf, lane); g_a = ip - g_bc;
            const float pm = wave_scan_max(g_a, lane); g_M = fmaxf(m_prev, pm);
            M63 = __shfl(g_M, 63); const float totb = __shfl(g_bc, 63);
            wc = __expf(m_prev - M63);
            const float Ms = __shfl(g_M, srow), as = __shfl(g_a, srow);
            const float e1 = __expf(m_prev - Ms), e2 = __expf(as - M63);
            float q2[8], kw[8];
#pragma unroll
            for (int i = 0; i < 8; ++i) { q2[i] = qv[i] * e1; kw[i] = kv[i] * e2; }
            *(LAS u32x4*)(Qt + srow * LQ + k8) = pack8(qv); *(LAS u32x4*)(Kt + srow * LQ + k8) = pack8(kv); *(LAS u32x4*)(Q2 + srow * LQ + k8) = pack8(q2);
#pragma unroll
            for (int i = 0; i < 8; ++i) KtT[(k8 + i) * LQ + srow] = (bf16)f2bf(kw[i]);
            m_prev = totb + M63;
        }
        { float v0[8], v1[8]; unpack8(rv[0], v0); unpack8(rv[1], v1);
#pragma unroll
          for (int i = 0; i < 8; ++i) { VT[(vc8 + i) * LQ + vrow] = (bf16)f2bf(v0[i]); VT[(vc8 + i) * LQ + 32 + vrow] = (bf16)f2bf(v1[i]); } }
        u32x2 gate[4];
#pragma unroll
        for (int ti = 0; ti < 4; ++ti) gate[ti] = *(const u32x2*)(PB + (grow + 16 * ti + fr) * NPB + GCOL + 16 * w + 4 * fq);
        if (cch + 1 < SEQ / 64) SC_LOAD(cch + 1);
        __syncthreads();
        {
            const int ti = w >> 1;
#pragma unroll
            for (int u = 0; u < 2; ++u) {
                const int sj = 2 * (w & 1) + u;
                f32x4 d = (f32x4){0.f, 0.f, 0.f, 0.f};
                if (sj <= ti) {
#pragma unroll
                    for (int ks = 0; ks < 2; ++ks) { const bf16x8 a = *(const LAS bf16x8*)(Kt + (16 * sj + fr) * LQ + 32 * ks + 8 * fq), bb = *(const LAS bf16x8*)(Qt + (16 * ti + fr) * LQ + 32 * ks + 8 * fq);
                        d = __builtin_amdgcn_mfma_f32_16x16x32_bf16(a, bb, d, 0, 0, 0); }
                    const int t = 16 * ti + fr, s0 = 16 * sj + 4 * fq;
                    if (ML) { const float Mt = __shfl(g_M, t);
#pragma unroll
                        for (int r = 0; r < 4; ++r) { const float as = __shfl(g_a, s0 + r); d[r] = (s0 + r <= t) ? d[r] * __expf(as - Mt) : 0.f; } }
                    else {
#pragma unroll
                        for (int r = 0; r < 4; ++r) d[r] = (s0 + r <= t) ? d[r] : 0.f; }
                }
                { u32x2 pk; pk.x = pk2(d[0], d[1]); pk.y = pk2(d[2], d[3]); *(LAS u32x2*)(Sc + (16 * ti + fr) * LQ + 16 * sj + 4 * fq) = pk; }
            }
        }
        __syncthreads();
        const LAS bf16* Qm = ML ? Q2 : Qt;
        f32x4 o[4];
        {
            bf16x8 vt[2], stf[2];
#pragma unroll
            for (int ks = 0; ks < 2; ++ks) { vt[ks] = *(const LAS bf16x8*)(VT + (16 * w + fr) * LQ + 32 * ks + 8 * fq); stf[ks] = *(const LAS bf16x8*)(STc + (16 * w + fr) * LQ + 32 * ks + 8 * fq); }
#pragma unroll
            for (int ti = 0; ti < 4; ++ti) {
                f32x4 d = (f32x4){0.f, 0.f, 0.f, 0.f};
#pragma unroll
                for (int ks = 0; ks < 2; ++ks) { const bf16x8 sc = *(const LAS bf16x8*)(Sc + (16 * ti + fr) * LQ + 32 * ks + 8 * fq); d = __builtin_amdgcn_mfma_f32_16x16x32_bf16(vt[ks], sc, d, 0, 0, 0); }
#pragma unroll
                for (int ks = 0; ks < 2; ++ks) { const bf16x8 qq = *(const LAS bf16x8*)(Qm + (16 * ti + fr) * LQ + 32 * ks + 8 * fq); d = __builtin_amdgcn_mfma_f32_16x16x32_bf16(stf[ks], qq, d, 0, 0, 0); }
                o[ti] = d;
            }
#pragma unroll
            for (int kj = 0; kj < 4; ++kj) {
                f32x4 d = (f32x4){0.f, 0.f, 0.f, 0.f};
#pragma unroll
                for (int ks = 0; ks < 2; ++ks) { const bf16x8 kk = *(const LAS bf16x8*)(KtT + (16 * kj + fr) * LQ + 32 * ks + 8 * fq); d = __builtin_amdgcn_mfma_f32_16x16x32_bf16(kk, vt[ks], d, 0, 0, 0); }
                if (ML) Sacc[kj] = Sacc[kj] * wc + d;
                else { const f32x4 e4 = *(const LAS f32x4*)(etot + 16 * kj + 4 * fq); Sacc[kj] = e4 * (Sacc[kj] + d); }
                u32x2 pk; pk.x = pk2(Sacc[kj][0], Sacc[kj][1]); pk.y = pk2(Sacc[kj][2], Sacc[kj][3]);
                *(LAS u32x2*)(STn + (16 * w + fr) * LQ + 16 * kj + 4 * fq) = pk;
            }
            if (ML) {
                if (w < 4) {
                    f32x4 d = (f32x4){0.f, 0.f, 0.f, 0.f};
#pragma unroll
                    for (int ks = 0; ks < 2; ++ks) { const bf16x8 a = *(const LAS bf16x8*)(VT + (128 + fr) * LQ + 32 * ks + 8 * fq), sc = *(const LAS bf16x8*)(Sc + (16 * w + fr) * LQ + 32 * ks + 8 * fq);
                        d = __builtin_amdgcn_mfma_f32_16x16x32_bf16(a, sc, d, 0, 0, 0); }
#pragma unroll
                    for (int ks = 0; ks < 2; ++ks) { const bf16x8 a = *(const LAS bf16x8*)(STc + (128 + fr) * LQ + 32 * ks + 8 * fq), qq = *(const LAS bf16x8*)(Qm + (16 * w + fr) * LQ + 32 * ks + 8 * fq);
                        d = __builtin_amdgcn_mfma_f32_16x16x32_bf16(a, qq, d, 0, 0, 0); }
                    if (fq == 0) dn[16 * w + fr] = d[0];
                } else {
                    const int kj = w - 4;
                    f32x4 d = (f32x4){0.f, 0.f, 0.f, 0.f};
#pragma unroll
                    for (int ks = 0; ks < 2; ++ks) { const bf16x8 kk = *(const LAS bf16x8*)(KtT + (16 * kj + fr) * LQ + 32 * ks + 8 * fq), a = *(const LAS bf16x8*)(VT + (128 + fr) * LQ + 32 * ks + 8 * fq);
                        d = __builtin_amdgcn_mfma_f32_16x16x32_bf16(kk, a, d, 0, 0, 0); }
                    Nacc = Nacc * wc + d;
                    u32x2 pk; pk.x = pk2(Nacc[0], Nacc[1]); pk.y = pk2(Nacc[2], Nacc[3]);
                    *(LAS u32x2*)(STn + (128 + fr) * LQ + 16 * kj + 4 * fq) = pk;
                }
            }
        }
#pragma unroll
        for (int ti = 0; ti < 4; ++ti) { float p = o[ti][0] * o[ti][0] + o[ti][1] * o[ti][1] + o[ti][2] * o[ti][2] + o[ti][3] * o[ti][3];
            p += __shfl_xor(p, 16); p += __shfl_xor(p, 32);
            if (fq == 0) ssq[w * 64 + 16 * ti + fr] = p; }
        __syncthreads();
#pragma unroll
        for (int ti = 0; ti < 4; ++ti) {
            const int t = 16 * ti + fr;
            float ss = 0.f;
#pragma unroll
            for (int ww = 0; ww < 8; ++ww) ss += ssq[ww * 64 + t];
            float dd = 1.f;
            if (ML) { const float bc = __shfl(g_bc, t), Mt = __shfl(g_M, t); dd = 1.f / fmaxf(fabsf(dn[t]), __expf(-(bc + Mt))); }
            const float rstd = rsqrtf(ss * dd * dd * (1.f / 128.f) + EPS) * dd;
            const f32x4 gn = *(const f32x4*)(gnorm + 16 * w + 4 * fq);
            const float g0 = bflo(gate[ti].x), g1 = bfhi(gate[ti].x), g2 = bflo(gate[ti].y), g3 = bfhi(gate[ti].y);
            f32x4 r;
            if (ML) { r[0] = o[ti][0] * rstd * gn[0] * sigmoidf_(g0); r[1] = o[ti][1] * rstd * gn[1] * sigmoidf_(g1); r[2] = o[ti][2] * rstd * gn[2] * sigmoidf_(g2); r[3] = o[ti][3] * rstd * gn[3] * sigmoidf_(g3); }
            else { r[0] = o[ti][0] * rstd * gn[0] * siluf_(g0); r[1] = o[ti][1] * rstd * gn[1] * siluf_(g1); r[2] = o[ti][2] * rstd * gn[2] * siluf_(g2); r[3] = o[ti][3] * rstd * gn[3] * siluf_(g3); }
            st_bf4(UO + (grow + t) * 512 + h * 128 + 16 * w + 4 * fq, r);
        }
    }
#undef SC_LOAD
    __syncthreads();
}
__device__ __forceinline__ void phase_scans(const Ctx& c, int l) {
    for (int it = c.bid; it < 128; it += c.nblk) {
#if SCAN_RECURRENT
        if (it < 64) scan_gla_item(c, l, it >> 2, it & 3);
        else scan_mlstm_item(c, l, (it - 64) >> 2, (it - 64) & 3);
#else
        if (it < 64) scan_chunked_item<false>(c, l, it >> 2, it & 3);
        else scan_chunked_item<true>(c, l, (it - 64) >> 2, (it - 64) & 3);
#endif
    }
}

__device__ __forceinline__ unsigned ord_key(float f) { const unsigned u = __builtin_bit_cast(unsigned, f); return (u & 0x80000000u) ? ~u : (u | 0x80000000u); }
__device__ __forceinline__ void phase_dsa(const Ctx& c, int l) {
    LAS unsigned char* wl = c.lds + c.wave * 14336;
    LAS float* I_s = (LAS float*)wl;
    LAS int* list = (LAS int*)(wl + 8192);
    LAS float* qi_s = (LAS float*)(wl + 9216);
    LAS float* ql_s = (LAS float*)(wl + 10240);
    const bf16* QLAT = (const bf16*)(c.ws + WS_QLAT); const bf16* QIDX = (const bf16*)(c.ws + WS_QIDX);
    const bf16* CKVN = (const bf16*)(c.ws + WS_CKVN); const float* SM = (const float*)(c.ws + WS_SM);
    bf16* OLAT = (bf16*)(c.ws + WS_OLAT);
    const int gw = c.bid * NWAVES + c.wave, NGW = c.nblk * NWAVES, lane = c.lane;
    for (int tq = gw; tq < T; tq += NGW) {
        const int b = tq >> 11, pos = tq & 2047, nvalid = pos + 1;
        const size_t kb = (size_t)b * SEQ;
        { const f32x4 q = ld_bf4(QIDX + (size_t)tq * 256 + 4 * lane); *(LAS f32x4*)(qi_s + 4 * lane) = q;
#pragma unroll
          for (int j = 0; j < 4; ++j) { const f32x4 ql = ld_bf4(QLAT + (size_t)tq * 1024 + 4 * (lane + 64 * j)); *(LAS f32x4*)(ql_s + 4 * (lane + 64 * j)) = ql; } }
        float wh[8];
#pragma unroll
        for (int hh = 0; hh < 8; ++hh) wh[hh] = SM[(size_t)tq * 128 + SM_WIDX + hh] * 0.35355339059327373f;
        asm volatile("s_waitcnt lgkmcnt(0)" ::: "memory");
        int nsel;
        if (nvalid <= DSA_K) {
            for (int i = lane; i < DSA_K; i += 64) list[i] = i;
            nsel = nvalid;
        } else {
            const int nj = (nvalid + 63) >> 6;
            for (int j = 0; j < nj; ++j) {
                const int s = lane + 64 * j;
                float val = -INFINITY;
                if (s < nvalid) {
                    const float* kr = SM + (kb + s) * 128 + SM_KIDX;
                    f32x4 kk[8];
#pragma unroll
                    for (int i = 0; i < 8; ++i) kk[i] = *(const f32x4*)(kr + 4 * i);
                    val = 0.f;
#pragma unroll
                    for (int hh = 0; hh < 8; ++hh) { float d = 0.f;
#pragma unroll
                        for (int i = 0; i < 8; ++i) { const f32x4 q = *(const LAS f32x4*)(qi_s + hh * 32 + 4 * i); d += q[0] * kk[i][0] + q[1] * kk[i][1] + q[2] * kk[i][2] + q[3] * kk[i][3]; }
                        val += wh[hh] * fmaxf(d, 0.f); }
                }
                I_s[s] = val;
            }
            for (int j = nj; j < 32; ++j) I_s[lane + 64 * j] = -INFINITY;
            asm volatile("s_waitcnt lgkmcnt(0)" ::: "memory");
            LAS unsigned* K_s = (LAS unsigned*)I_s;
#pragma unroll 4
            for (int j = 0; j < 32; ++j) K_s[lane + 64 * j] = ord_key(I_s[lane + 64 * j]);
            unsigned thr = 0u;
#pragma unroll 1
            for (int bit = 31; bit >= 0; --bit) {
                const unsigned cand = thr | (1u << bit); int cnt = 0;
#pragma unroll 8
                for (int j = 0; j < 32; ++j) cnt += (K_s[lane + 64 * j] >= cand) ? 1 : 0;
                cnt = wave_sum_i(cnt);
                if (cnt >= DSA_K) thr = cand;
            }
            int cgt = 0;
#pragma unroll 8
            for (int j = 0; j < 32; ++j) cgt += (K_s[lane + 64 * j] > thr) ? 1 : 0;
            cgt = wave_sum_i(cgt);
            int need = DSA_K - cgt, base = 0;
            const unsigned long long lt = (1ull << lane) - 1ull;
#pragma unroll 2
            for (int j = 0; j < 32; ++j) {
                const unsigned kj = K_s[lane + 64 * j];
                const bool gt = kj > thr, eq = kj == thr;
                const unsigned long long meq = __ballot(eq);
                const int rk = __popcll(meq & lt);
                const bool sel = gt || (eq && rk < need);
                need -= __popcll(meq); if (need < 0) need = 0;
                const unsigned long long ms = __ballot(sel);
                if (sel) list[base + __popcll(ms & lt)] = lane + 64 * j;
                base += __popcll(ms);
            }
            nsel = DSA_K;
        }
        asm volatile("s_waitcnt lgkmcnt(0)" ::: "memory");
        int ks[4]; float lg[4][8];
#pragma unroll
        for (int i = 0; i < 4; ++i) { const int li = lane + 64 * i; ks[i] = (li < nsel) ? list[li] : 0;
#pragma unroll
            for (int hh = 0; hh < 8; ++hh) lg[i][hh] = 0.f; }
#pragma unroll 1
        for (int ch = 0; ch < 16; ++ch) {
            f32x4 ka[4], kc[4];
#pragma unroll
            for (int i = 0; i < 4; ++i) { const u32x4 w = *(const u32x4*)(CKVN + (kb + ks[i]) * 128 + ch * 8);
                ka[i] = (f32x4){bflo(w.x), bfhi(w.x), bflo(w.y), bfhi(w.y)}; kc[i] = (f32x4){bflo(w.z), bfhi(w.z), bflo(w.w), bfhi(w.w)}; }
#pragma unroll
            for (int hh = 0; hh < 8; ++hh) { const f32x4 qa = *(const LAS f32x4*)(ql_s + hh * 128 + ch * 8), qb = *(const LAS f32x4*)(ql_s + hh * 128 + ch * 8 + 4);
#pragma unroll
                for (int i = 0; i < 4; ++i) lg[i][hh] += qa[0] * ka[i][0] + qa[1] * ka[i][1] + qa[2] * ka[i][2] + qa[3] * ka[i][3] + qb[0] * kc[i][0] + qb[1] * kc[i][1] + qb[2] * kc[i][2] + qb[3] * kc[i][3]; }
        }
#pragma unroll
        for (int hh = 0; hh < 8; ++hh) {
            const float slope = exp2f(-(float)(hh + 1));
            float mx = -INFINITY;
#pragma unroll
            for (int i = 0; i < 4; ++i) { const bool ok = (lane + 64 * i) < nsel; lg[i][hh] = ok ? lg[i][hh] - slope * (float)(pos - ks[i]) : -INFINITY; mx = fmaxf(mx, lg[i][hh]); }
            mx = wave_max(mx);
            float sm = 0.f;
#pragma unroll
            for (int i = 0; i < 4; ++i) { lg[i][hh] = __expf(lg[i][hh] - mx); sm += lg[i][hh]; }
            sm = wave_sum(sm);
            const float inv = 1.f / sm;
#pragma unroll
            for (int i = 0; i < 4; ++i) lg[i][hh] *= inv;
        }
#pragma unroll
        for (int i = 0; i < 4; ++i) { const int li = lane + 64 * i;
            *(LAS f32x4*)(I_s + li * 8) = (f32x4){lg[i][0], lg[i][1], lg[i][2], lg[i][3]}; *(LAS f32x4*)(I_s + li * 8 + 4) = (f32x4){lg[i][4], lg[i][5], lg[i][6], lg[i][7]}; }
        asm volatile("s_waitcnt lgkmcnt(0)" ::: "memory");
        float o0[8], o1[8];
#pragma unroll
        for (int hh = 0; hh < 8; ++hh) { o0[hh] = 0.f; o1[hh] = 0.f; }
#pragma unroll 2
        for (int kidx = 0; kidx < nsel; ++kidx) {
            const int s = list[kidx];
            const unsigned w = *(const unsigned*)(CKVN + (kb + s) * 128 + 2 * lane);
            const float v0 = bflo(w), v1 = bfhi(w);
            const f32x4 pa = *(const LAS f32x4*)(I_s + kidx * 8), pb = *(const LAS f32x4*)(I_s + kidx * 8 + 4);
            o0[0] += pa[0] * v0; o1[0] += pa[0] * v1; o0[1] += pa[1] * v0; o1[1] += pa[1] * v1; o0[2] += pa[2] * v0; o1[2] += pa[2] * v1; o0[3] += pa[3] * v0; o1[3] += pa[3] * v1;
            o0[4] += pb[0] * v0; o1[4] += pb[0] * v1; o0[5] += pb[1] * v0; o1[5] += pb[1] * v1; o0[6] += pb[2] * v0; o1[6] += pb[2] * v1; o0[7] += pb[3] * v0; o1[7] += pb[3] * v1;
        }
#pragma unroll
        for (int hh = 0; hh < 8; ++hh) *(unsigned*)(OLAT + (size_t)tq * 1024 + hh * 128 + 2 * lane) = pk2(o0[hh], o1[hh]);
        asm volatile("s_waitcnt lgkmcnt(0)" ::: "memory");
    }
}


typedef float f32x16 __attribute__((ext_vector_type(16)));
__device__ __forceinline__ void phase_dsa_sel(const Ctx& c, int l) {
    const bf16* QIDX = (const bf16*)(c.ws + WS_QIDX); const bf16* KIDX = (const bf16*)(c.ws + WS_KIDX); const float* SM = (const float*)(c.ws + WS_SM);
    unsigned* MASK = (unsigned*)(c.ws + WS_MASK);
    const int lane = c.lane, hf = lane >> 5, l31 = lane & 31;
    const int rho = l31, tl = 2 * ((rho >> 2) & 1) + (rho >> 4), hd = (rho & 3) + 4 * ((rho >> 3) & 1);
    const unsigned ltmask = (1u << l31) - 1u;
    LAS unsigned* KL = (LAS unsigned*)(c.lds + c.wave * 16384);
    LAS unsigned* MW = (LAS unsigned*)(c.lds + 131072 + c.wave * 512);
    const int npass = (c.nblk == 256) ? 2 : (T / 64 + c.nblk - 1) / c.nblk;
#pragma unroll 1
    for (int ps = 0; ps < npass; ++ps) {
        int b, q64;
        if (c.nblk == 256) { b = c.bid & 15; q64 = ps == 0 ? 31 - (c.bid >> 4) : (c.bid >> 4); }
        else { const int it = c.bid + ps * c.nblk; if (it >= T / 64) break; b = it >> 5; q64 = it & 31; }
        const int pb = q64 * 64;
#pragma unroll 1
        for (int wi = 0; wi < 2; ++wi) {
        const int pos0 = pb + 8 * c.wave + 4 * wi, t0 = b * SEQ + pos0;
        unsigned wA0 = 0u, wB0 = 0u, wA1 = 0u, wB1 = 0u;
        if (pos0 + 3 < DSA_K) {
            const int p_0 = pos0 + 2 * hf, p_1 = p_0 + 1;
            { const int lo = 32 * l31; wA0 = p_0 >= lo + 31 ? 0xffffffffu : (p_0 < lo ? 0u : ((2u << (p_0 - lo)) - 1u)); wA1 = p_1 >= lo + 31 ? 0xffffffffu : (p_1 < lo ? 0u : ((2u << (p_1 - lo)) - 1u)); }
        } else {
            const int ng = ((pos0 + 3) / 32 + 4) / 4, nkt = 4 * ng;
            bf16x8 af[2];
#pragma unroll
            for (int ks = 0; ks < 2; ++ks) af[ks] = *(const bf16x8*)(QIDX + (size_t)(t0 + tl) * 256 + hd * 32 + 16 * ks + 8 * hf);
            const bf16* kbase = KIDX + ((size_t)b * SEQ + l31) * 32 + 8 * hf;
#pragma unroll 1
            for (int tsel = 0; tsel < 2; ++tsel) {
                float whv[8];
#pragma unroll
                for (int r = 0; r < 8; ++r) whv[r] = SM[(size_t)(t0 + 2 * hf + tsel) * 128 + SM_WIDX + r] * 0.35355339059327373f;
                const int p_t = pos0 + 2 * hf + tsel;
                bf16x8 bq[4][2], bn[4][2];
#pragma unroll
                for (int j = 0; j < 4; ++j) { bq[j][0] = *(const bf16x8*)(kbase + (size_t)(32 * j) * 32); bq[j][1] = *(const bf16x8*)(kbase + (size_t)(32 * j) * 32 + 16); }
#pragma unroll 1
                for (int g = 0; g < ng; ++g) {
                    const int gn = (g + 1 < ng) ? g + 1 : g;
#pragma unroll
                    for (int j = 0; j < 4; ++j) { bn[j][0] = *(const bf16x8*)(kbase + (size_t)(32 * (4 * gn + j)) * 32); bn[j][1] = *(const bf16x8*)(kbase + (size_t)(32 * (4 * gn + j)) * 32 + 16); }
#pragma unroll
                    for (int j = 0; j < 4; ++j) {
                        f32x16 d;
#pragma unroll
                        for (int r = 0; r < 16; ++r) d[r] = 0.f;
                        d = __builtin_amdgcn_mfma_f32_32x32x16_bf16(af[0], bq[j][0], d, 0, 0, 0);
                        d = __builtin_amdgcn_mfma_f32_32x32x16_bf16(af[1], bq[j][1], d, 0, 0, 0);
                        float iv = 0.f;
                        if (tsel == 0) {
#pragma unroll
                            for (int r = 0; r < 8; ++r) iv += whv[r] * fmaxf(d[r], 0.f);
                        } else {
#pragma unroll
                            for (int r = 0; r < 8; ++r) iv += whv[r] * fmaxf(d[8 + r], 0.f);
                        }
                        const int kt = 4 * g + j, row = 32 * kt + l31;
                        KL[kt * 64 + lane] = row <= p_t ? ord_key(iv) : 0u;
                    }
#pragma unroll
                    for (int j = 0; j < 4; ++j) { bq[j][0] = bn[j][0]; bq[j][1] = bn[j][1]; }
                }
                unsigned thr = 0u;
#pragma unroll 1
                for (int bit = 31; bit >= 0; --bit) {
                    const unsigned cand = thr | (1u << bit); int clo = 0, chi = 0;
#pragma unroll 4
                    for (int kt = 0; kt < nkt; ++kt) { const unsigned long long m = __ballot(KL[kt * 64 + lane] >= cand); clo += __popc((unsigned)m); chi += __popc((unsigned)(m >> 32)); }
                    const int cnt = hf ? chi : clo; if (cnt >= DSA_K) thr = cand;
                }
                int glo = 0, ghi = 0;
#pragma unroll 4
                for (int kt = 0; kt < nkt; ++kt) { const unsigned long long m = __ballot(KL[kt * 64 + lane] > thr); glo += __popc((unsigned)m); ghi += __popc((unsigned)(m >> 32)); }
                int nlo = DSA_K - glo, nhi = DSA_K - ghi;
                MW[lane] = 0u; MW[64 + lane] = 0u;
#pragma unroll 2
                for (int kt = 0; kt < nkt; ++kt) {
                    const unsigned kv = KL[kt * 64 + lane];
                    const bool gt = kv > thr, eq = kv == thr;
                    const unsigned long long meq = __ballot(eq); const unsigned mh = hf ? (unsigned)(meq >> 32) : (unsigned)meq;
                    const int need = hf ? nhi : nlo;
                    const bool sel = gt || (eq && (__popc(mh & ltmask) < need));
                    nlo -= __popc((unsigned)meq); nhi -= __popc((unsigned)(meq >> 32)); nlo = nlo < 0 ? 0 : nlo; nhi = nhi < 0 ? 0 : nhi;
                    const unsigned long long ms = __ballot(sel);
                    if (l31 == 0) MW[hf * 64 + kt] = hf ? (unsigned)(ms >> 32) : (unsigned)ms;
                }
                const unsigned wA = MW[hf * 64 + l31], wB = MW[hf * 64 + 32 + l31];
                if (tsel == 0) { wA0 = wA; wB0 = wB; } else { wA1 = wA; wB1 = wB; }
            }
        }
        unsigned* m0 = MASK + (size_t)(t0 + 2 * hf) * 64;
        m0[l31] = wA0; m0[32 + l31] = wB0; m0[64 + l31] = wA1; m0[96 + l31] = wB1;
        }
    }
    __syncthreads();
}

constexpr int AT_KN_LD = 136, AT_KT_LD = 72;
constexpr int AT_KN_BYTES = 64 * AT_KN_LD * 2, AT_KT_BYTES = 128 * AT_KT_LD * 2, AT_STAGE = AT_KN_BYTES + AT_KT_BYTES;
__device__ __forceinline__ void phase_dsa_att(const Ctx& c, int l) {
    const bf16* QLAT = (const bf16*)(c.ws + WS_QLAT); const bf16* CKVN = (const bf16*)(c.ws + WS_CKVN); const bf16* CKVT = (const bf16*)(c.ws + WS_CKVT);
    const unsigned* MASK = (const unsigned*)(c.ws + WS_MASK); bf16* OLAT = (bf16*)(c.ws + WS_OLAT);
    const int tid = c.tid, lane = c.lane, h = c.wave, fr = lane & 15, fq = lane >> 4;
    const float slope = exp2f(-(float)(h + 1));
    const float L2E = 1.4426950408889634f;
    const int knr = tid >> 3, knc = (tid & 7) * 8;
    const int ktr = tid >> 2, ktc = (tid & 3) * 16;
#pragma unroll 1
    for (int k4 = 0; k4 < 1024; ++k4) {
        const int idx = c.bid + c.nblk * k4; if (idx >= 1024) break;
        const int b = idx & 15, g = idx >> 4, gk = g >> 4, gi = g & 15;
        const int qt = 63 - 16 * gk - ((gk & 1) ? (15 - gi) : gi);
        const int tq0 = qt * 32;
        const size_t tg0 = (size_t)b * SEQ + tq0;
        const int nkt = (tq0 + 31) / 64 + 1;
        bf16x8 Qf[2][4];
#pragma unroll
        for (int rt = 0; rt < 2; ++rt)
#pragma unroll
            for (int ks = 0; ks < 4; ++ks) Qf[rt][ks] = *(const bf16x8*)(QLAT + (tg0 + 16 * rt + fr) * 1024 + h * 128 + 32 * ks + 8 * fq);
        f32x4 O[2][8];
        float mrun[2], lrun[2];
#pragma unroll
        for (int rt = 0; rt < 2; ++rt) { mrun[rt] = -1e30f; lrun[rt] = 0.f;
#pragma unroll
            for (int n = 0; n < 8; ++n) O[rt][n] = (f32x4){0.f, 0.f, 0.f, 0.f}; }
        u32x4 pn0, pn1, pt0, pt1;
#define AT_LOAD(kt) do { const size_t _kb = (size_t)b * SEQ + 64 * (kt); \
            pn0 = *(const u32x4*)(CKVN + (_kb + knr) * 128 + knc); pn1 = *(const u32x4*)(CKVN + (_kb + knr) * 128 + 64 + knc); \
            pt0 = *(const u32x4*)(CKVT + ((size_t)b * 128 + ktr) * 2048 + 64 * (kt) + ktc); pt1 = *(const u32x4*)(CKVT + ((size_t)b * 128 + ktr) * 2048 + 64 * (kt) + ktc + 8); } while (0)
        AT_LOAD(0);
#pragma unroll 1
        for (int kt = 0; kt < nkt; ++kt) {
            int lz; asm volatile("v_mov_b32 %0, 0" : "=v"(lz));
            LAS bf16* Kn = (LAS bf16*)(c.lds + (kt & 1) * AT_STAGE) + lz; LAS bf16* KT = (LAS bf16*)(c.lds + (kt & 1) * AT_STAGE + AT_KN_BYTES) + lz;
            *(LAS u32x4*)(Kn + knr * AT_KN_LD + knc) = pn0; *(LAS u32x4*)(Kn + knr * AT_KN_LD + 64 + knc) = pn1;
            *(LAS u32x4*)(KT + ktr * AT_KT_LD + ktc) = pt0; *(LAS u32x4*)(KT + ktr * AT_KT_LD + ktc + 8) = pt1;
            u32x2 mw[2];
#pragma unroll
            for (int rt = 0; rt < 2; ++rt) mw[rt] = *(const u32x2*)(MASK + (tg0 + 16 * rt + fr) * 64 + 2 * kt);
            if (kt + 1 < nkt) AT_LOAD(kt + 1);
            __syncthreads();
#pragma unroll
            for (int rt = 0; rt < 2; ++rt) {
                f32x4 S[4];
#pragma unroll
                for (int j = 0; j < 4; ++j) {
                    f32x4 d = (f32x4){0.f, 0.f, 0.f, 0.f};
#pragma unroll
                    for (int ks = 0; ks < 4; ++ks) { const bf16x8 kf = *(const LAS bf16x8*)(Kn + (16 * j + fr) * AT_KN_LD + 32 * ks + 8 * fq); d = __builtin_amdgcn_mfma_f32_16x16x32_bf16(kf, Qf[rt][ks], d, 0, 0, 0); }
                    S[j] = d;
                    __builtin_amdgcn_sched_barrier(0);
                }
                const int tpos = tq0 + 16 * rt + fr;
                const float base = -slope * (float)(tpos - 64 * kt - 4 * fq);
                float mx = -1e30f;
#pragma unroll
                for (int j = 0; j < 4; ++j) { const unsigned wsel = (j < 2) ? mw[rt].x : mw[rt].y; const int sh = 16 * (j & 1) + 4 * fq;
#pragma unroll
                    for (int r = 0; r < 4; ++r) { const bool on = (wsel >> (sh + r)) & 1u;
                        const float v = S[j][r] + base + slope * (float)(16 * j + r);
                        S[j][r] = on ? v : -INFINITY; mx = fmaxf(mx, S[j][r]); } }
                mx = fmaxf(mx, __shfl_xor(mx, 16)); mx = fmaxf(mx, __shfl_xor(mx, 32));
                const float mnew = fmaxf(mrun[rt], mx);
                const float alpha = exp2f((mrun[rt] - mnew) * L2E);
                float rs = 0.f;
#pragma unroll
                for (int j = 0; j < 4; ++j)
#pragma unroll
                    for (int r = 0; r < 4; ++r) { const float p = exp2f((S[j][r] - mnew) * L2E); S[j][r] = p; rs += p; }
                rs += __shfl_xor(rs, 16); rs += __shfl_xor(rs, 32);
                lrun[rt] = lrun[rt] * alpha + rs; mrun[rt] = mnew;
#pragma unroll
                for (int n = 0; n < 8; ++n) O[rt][n] *= alpha;
                bf16x8 Pf[2];
#pragma unroll
                for (int ks2 = 0; ks2 < 2; ++ks2) { u32x4 w; w.x = pk2(S[2 * ks2][0], S[2 * ks2][1]); w.y = pk2(S[2 * ks2][2], S[2 * ks2][3]);
                    w.z = pk2(S[2 * ks2 + 1][0], S[2 * ks2 + 1][1]); w.w = pk2(S[2 * ks2 + 1][2], S[2 * ks2 + 1][3]);
                    Pf[ks2] = __builtin_bit_cast(bf16x8, w); }
#pragma unroll
                for (int n = 0; n < 8; ++n)
#pragma unroll
                    for (int ks2 = 0; ks2 < 2; ++ks2) {
                        const u32x2 a0 = *(const LAS u32x2*)(KT + (16 * n + fr) * AT_KT_LD + 32 * ks2 + 4 * fq), a1 = *(const LAS u32x2*)(KT + (16 * n + fr) * AT_KT_LD + 32 * ks2 + 16 + 4 * fq);
                        const bf16x8 af = __builtin_bit_cast(bf16x8, (u32x4){a0.x, a0.y, a1.x, a1.y});
                        O[rt][n] = __builtin_amdgcn_mfma_f32_16x16x32_bf16(af, Pf[ks2], O[rt][n], 0, 0, 0);
                        if (ks2 == 1 && (n & 1)) __builtin_amdgcn_sched_barrier(0);
                    }
            }
        }
#undef AT_LOAD
#pragma unroll
        for (int rt = 0; rt < 2; ++rt) { const float inv = 1.f / lrun[rt];
#pragma unroll
            for (int n = 0; n < 8; ++n) st_bf4(OLAT + (tg0 + 16 * rt + fr) * 1024 + h * 128 + 16 * n + 4 * fq, O[rt][n] * inv); }
        __syncthreads();
    }
}

__device__ __forceinline__ void route_one(int t, float logit, float rbias, int lane, unsigned* CNT, int* ROWL, float* WL, unsigned* TOKPOS) {
    const float score = sigmoidf_(logit), sel = score + rbias;
    const int g = lane >> 3;
    int rk8 = 0;
#pragma unroll
    for (int d = 1; d < 8; ++d) { const int ol = (lane & ~7) | ((lane + d) & 7); const float o = __shfl(sel, ol); rk8 += (o > sel || (o == sel && ol < lane)) ? 1 : 0; }
    float t2 = rk8 < 2 ? sel : 0.f;
    t2 += __shfl_xor(t2, 1); t2 += __shfl_xor(t2, 2); t2 += __shfl_xor(t2, 4);
    int rkg = 0;
#pragma unroll
    for (int d = 1; d < 8; ++d) { const int og = (g + d) & 7; const float o = __shfl(t2, og * 8); rkg += (o > t2 || (o == t2 && og < g)) ? 1 : 0; }
    const bool gsel = rkg < 4;
    bool chosen = false; float cur = gsel ? sel : -INFINITY;
#pragma unroll 1
    for (int it6 = 0; it6 < TOPK; ++it6) {
        const float mx = wave_max(cur);
        const unsigned long long me = __ballot(cur == mx);
        const int win = __ffsll((long long)me) - 1;
        if (lane == win) { chosen = true; cur = -INFINITY; }
    }
    const float wsum = wave_sum(chosen ? score : 0.f);
    const unsigned long long mk = __ballot(chosen);
    if (chosen) {
        const int hf = t >= HALF_T ? 1 : 0;
        const int kk = __popcll(mk & ((1ull << lane) - 1ull));
        const unsigned slot = atomicAdd(&CNT[hf * 64 + lane], 1u);
        ROWL[((size_t)hf * 64 + lane) * 16384 + slot] = t;
        WL[((size_t)hf * 64 + lane) * 16384 + slot] = score / wsum * 2.5f;
        if (kk < TOPK) TOKPOS[(size_t)t * 6 + kk] = ((unsigned)lane << 16) | slot;
    }
}
__device__ __forceinline__ void phase_route(const Ctx& c, int l, const float* x1) {
    {
        LAS float* scr = (LAS float*)(c.lds + c.wave * 16384);
        const int gw = c.bid * NWAVES + c.wave, NGW = c.nblk * NWAVES;
        constexpr int I_GU = (512 / 32) * (1024 / 64), I_D = (1024 / 32) * (256 / 64), PER_E = I_GU + I_D;
        for (int it = gw; it < NEX * PER_E; it += NGW) {
            const int e = it / PER_E; int r = it % PER_E;
            if (r < I_GU) {
                const int n0 = (r / 16) * 32, pn = n0 >> 8, wi = n0 & 255, j0 = 128 * pn + (wi & 127);
                const float* Wg; const float* Wu;
                if (e < NE) { Wg = c.in[IN_EWG] + ((size_t)l * NE + e) * 1024 * 256; Wu = c.in[IN_EWU] + ((size_t)l * NE + e) * 1024 * 256; }
                else { Wg = c.in[IN_SWG] + (size_t)l * 1024 * 256; Wu = c.in[IN_SWU] + (size_t)l * 1024 * 256; }
                if (wi < 128) { SrcPlain s{Wg + j0 - n0, 256}; tr_item(s, (bf16*)(c.ws + WS_WGU) + (size_t)e * 512 * 1024, 1024, n0, (r % 16) * 64, scr, c.lane); }
                else { SrcPlain s{Wu + j0 - n0, 256}; tr_item(s, (bf16*)(c.ws + WS_WGU) + (size_t)e * 512 * 1024, 1024, n0, (r % 16) * 64, scr, c.lane); }
            } else { r -= I_GU;
                SrcPlain s; s.ld = 1024; s.W = e < NE ? c.in[IN_EWD] + ((size_t)l * NE + e) * 256 * 1024 : c.in[IN_SWD] + (size_t)l * 256 * 1024;
                tr_item(s, (bf16*)(c.ws + WS_WD) + (size_t)e * 1024 * 256, 256, (r / 4) * 32, (r % 4) * 64, scr, c.lane);
            }
        }
    }
    __syncthreads();
    {
        LAS float* h_s = (LAS float*)(c.lds + c.wave * 16384);
        const int gw = c.bid * NWAVES + c.wave, NGW = c.nblk * NWAVES, lane = c.lane;
        const float* MOD = (const float*)(c.ws + WS_MOD) + (size_t)l * 16 * 6144;
        bf16* XN2 = (bf16*)(c.ws + WS_XN2);
        const float* RW = c.in[IN_RW] + (size_t)l * 1024 * 64; const float rbias = c.in[IN_RB][l * 64 + lane];
        unsigned* CNT = (unsigned*)(c.ws + WS_CTL) + CW_CNT + l * 128;
        int* ROWL = (int*)(c.ws + WS_ROWL); float* WL = (float*)(c.ws + WS_WL); unsigned* TOKPOS = (unsigned*)(c.ws + WS_TOKPOS);
        for (int it = gw; it < T / 4; it += NGW) {
            const int t0 = it * 4, b = t0 >> 11;
            const float* gain = c.in[IN_NFFN] + l * D; const float* sh = MOD + (size_t)b * 6144 + 3072; const float* sc = MOD + (size_t)b * 6144 + 4096;
#pragma unroll
            for (int r = 0; r < 4; ++r) {
                const float* xrow = x1 + (size_t)(t0 + r) * D;
                f32x4 v[4]; float s = 0.f;
#pragma unroll
                for (int j = 0; j < 4; ++j) { v[j] = *(const f32x4*)(xrow + 4 * (lane + 64 * j)); s += v[j][0] * v[j][0] + v[j][1] * v[j][1] + v[j][2] * v[j][2] + v[j][3] * v[j][3]; }
                const float rstd = rsqrtf(wave_sum(s) * (1.f / D) + EPS);
#pragma unroll
                for (int j = 0; j < 4; ++j) { const int cc = 4 * (lane + 64 * j);
                    const f32x4 g = *(const f32x4*)(gain + cc), a = *(const f32x4*)(sc + cc), bb = *(const f32x4*)(sh + cc);
                    const f32x4 hv = v[j] * rstd * g * (a + 1.f) + bb;
                    st_bf4(XN2 + (size_t)(t0 + r) * D + cc, hv); *(LAS f32x4*)(h_s + r * 1024 + cc) = hv; }
            }
            asm volatile("s_waitcnt lgkmcnt(0)" ::: "memory");
            float lg[4] = {0.f, 0.f, 0.f, 0.f};
#pragma unroll 2
            for (int k = 0; k < 1024; k += 4) {
                const float w0 = RW[(size_t)k * 64 + lane], w1 = RW[(size_t)(k + 1) * 64 + lane], w2 = RW[(size_t)(k + 2) * 64 + lane], w3 = RW[(size_t)(k + 3) * 64 + lane];
#pragma unroll
                for (int r = 0; r < 4; ++r) { const f32x4 hv = *(const LAS f32x4*)(h_s + r * 1024 + k); lg[r] += hv[0] * w0 + hv[1] * w1 + hv[2] * w2 + hv[3] * w3; }
            }
            route_one(t0 + 0, lg[0], rbias, lane, CNT, ROWL, WL, TOKPOS);
            route_one(t0 + 1, lg[1], rbias, lane, CNT, ROWL, WL, TOKPOS);
            route_one(t0 + 2, lg[2], rbias, lane, CNT, ROWL, WL, TOKPOS);
            route_one(t0 + 3, lg[3], rbias, lane, CNT, ROWL, WL, TOKPOS);
        }
    }
}

__device__ __forceinline__ void moe_tables(const Ctx& c, int l, int hf) {
    LAS int* cnt = (LAS int*)(c.lds + 140000); LAS int* off = cnt + 65; LAS int* tst = off + 65;
    __syncthreads();
    if (c.tid == 0) {
        const unsigned* CNT = (const unsigned*)(c.ws + WS_CTL) + CW_CNT + l * 128 + hf * 64;
        int o = 0, ts = 0;
        for (int e = 0; e < NEX; ++e) { const int n = e < NE ? (int)CNT[e] : HALF_T; cnt[e] = n; off[e] = o; tst[e] = ts; o += (n + 255) & ~255; ts += (n + 255) >> 8; }
        tst[NEX] = ts;
    }
    __syncthreads();
}
struct MoeSched1 { LAS const int* cnt; LAS const int* off; LAS const int* tst; int G, c; const char* XN2; const char* WGU; const int* ROWL; const float* WL; const int* IDENT;
    __device__ __forceinline__ bool next(int i, g8::GUnit& u) const {
        const int L = i * G + c; if (L >= 2 * tst[NEX]) return false;
        const int rt = L >> 1, pn = L & 1; int e = 0; while (tst[e + 1] <= rt) ++e;
        const int r0 = (rt - tst[e]) * 256;
        u.A = XN2; u.B = WGU + ((size_t)e * 512 + (size_t)pn * 256) * 2048;
        u.rl = e < NE ? ROWL + (size_t)e * 16384 + r0 : IDENT + r0; u.nvalid = cnt[e] - r0; u.erow0 = 0; u.ecol0 = pn * 256; u.x0 = off[e] + r0; u.xp = e < NE ? WL + (size_t)e * 16384 + r0 : nullptr; return true; } };
struct MoeSched2 { LAS const int* cnt; LAS const int* off; LAS const int* tst; int G, c; const char* HID; const char* WD;
    __device__ __forceinline__ bool next(int i, g8::GUnit& u) const {
        const int L = i * G + c; if (L >= 4 * tst[NEX]) return false;
        const int rt = L >> 2, pn = L & 3; int e = 0; while (tst[e + 1] <= rt) ++e;
        const int r0 = (rt - tst[e]) * 256;
        u.A = HID + (size_t)(off[e] + r0) * 512; u.B = WD + ((size_t)e * 1024 + (size_t)pn * 256) * 512;
        u.rl = nullptr; u.nvalid = 0; u.erow0 = 0; u.ecol0 = pn * 256; u.x0 = off[e] + r0; u.xp = nullptr; return true; } };
struct EpiG1u { bf16* HID;
    __device__ __forceinline__ void operator()(const g8::GUnit& u, int row, int col, f32x4 lo, f32x4 hi) const {
        const int hc = col - 128 * (col >> 8);
        f32x4 v = (f32x4){0.f, 0.f, 0.f, 0.f};
        if (row < u.nvalid) { const float w = u.xp ? u.xp[row] : 1.f;
#pragma unroll
            for (int i = 0; i < 4; ++i) v[i] = siluf_(lo[i]) * hi[i] * w; }
        st_bf4(HID + (size_t)(u.x0 + row) * 256 + hc, v);
    } };
struct EpiG2u { bf16* Y;
    __device__ __forceinline__ void operator()(const g8::GUnit& u, int row, int col, f32x4 lo, f32x4 hi) const {
        st_bf4(Y + (size_t)(u.x0 + row) * 1024 + col, lo); st_bf4(Y + (size_t)(u.x0 + row) * 1024 + col + 128, hi);
    } };
__device__ __forceinline__ void phase_gemm1(const Ctx& c, int l, int hf) {
    moe_tables(c, l, hf);
    LAS int* cnt = (LAS int*)(c.lds + 140000); LAS int* off = cnt + 65; LAS int* tst = off + 65;
    MoeSched1 S{cnt, off, tst, c.nblk, c.bid, (const char*)(c.ws + WS_XN2), (const char*)(c.ws + WS_WGU), (const int*)(c.ws + WS_ROWL) + (size_t)hf * 64 * 16384, (const float*)(c.ws + WS_WL) + (size_t)hf * 64 * 16384,
                (const int*)(c.ws + WS_IDENT) + (size_t)hf * HALF_T};
    EpiG1u E{(bf16*)(c.ws + WS_HID)};
    g8::gemm_phase<true>(c.lds, 2048u, 1024, S, E);
    __syncthreads();
}
__device__ __forceinline__ void phase_gemm2(const Ctx& c, int l, int hf) {
    moe_tables(c, l, hf);
    LAS int* cnt = (LAS int*)(c.lds + 140000); LAS int* off = cnt + 65; LAS int* tst = off + 65;
    MoeSched2 S{cnt, off, tst, c.nblk, c.bid, (const char*)(c.ws + WS_HID), (const char*)(c.ws + WS_WD)};
    EpiG2u E{(bf16*)(c.ws + WS_Y)};
    g8::gemm_phase<false>(c.lds, 512u, 256, S, E);
    __syncthreads();
}
__device__ __forceinline__ void phase_combine(const Ctx& c, int l, int hf, float* xio) {
    moe_tables(c, l, hf);
    LAS int* off = (LAS int*)(c.lds + 140000) + 65;
    const int gw = c.bid * NWAVES + c.wave, NGW = c.nblk * NWAVES, lane = c.lane;
    const bf16* Y = (const bf16*)(c.ws + WS_Y); const unsigned* TOKPOS = (const unsigned*)(c.ws + WS_TOKPOS);
    const float* MODl = (const float*)(c.ws + WS_MOD) + (size_t)l * 16 * 6144;
    const float* MODn = (const float*)(c.ws + WS_MOD) + (size_t)1 * 16 * 6144;
    bf16* XN = (bf16*)(c.ws + WS_XN);
    for (int tt = gw; tt < HALF_T; tt += NGW) {
        const int t = hf * HALF_T + tt, b = t >> 11;
        f32x4 acc[4];
        { const bf16* yr = Y + (size_t)(off[NE] + tt) * 1024;
#pragma unroll
          for (int j = 0; j < 4; ++j) acc[j] = ld_bf4(yr + 4 * (lane + 64 * j)); }
#pragma unroll
        for (int kk = 0; kk < TOPK; ++kk) {
            const unsigned tp = TOKPOS[(size_t)t * 6 + kk]; const int e = tp >> 16, slot = tp & 0xffff;
            const bf16* yr = Y + (size_t)(off[e] + slot) * 1024;
#pragma unroll
            for (int j = 0; j < 4; ++j) acc[j] += ld_bf4(yr + 4 * (lane + 64 * j));
        }
        float* xr = xio + (size_t)t * D; const float* g2 = MODl + (size_t)b * 6144 + 5120;
        f32x4 v[4]; float s = 0.f;
#pragma unroll
        for (int j = 0; j < 4; ++j) { const int cc = 4 * (lane + 64 * j); v[j] = *(const f32x4*)(xr + cc) + *(const f32x4*)(g2 + cc) * acc[j]; s += v[j][0] * v[j][0] + v[j][1] * v[j][1] + v[j][2] * v[j][2] + v[j][3] * v[j][3]; }
        const float rstd = rsqrtf(wave_sum(s) * (1.f / D) + EPS);
        if (l == 0) {
#pragma unroll
            for (int j = 0; j < 4; ++j) { const int cc = 4 * (lane + 64 * j); *(f32x4*)(xr + cc) = v[j];
                const f32x4 g = *(const f32x4*)(c.in[IN_NMIX] + D + cc), a = *(const f32x4*)(MODn + (size_t)b * 6144 + 1024 + cc), bb = *(const f32x4*)(MODn + (size_t)b * 6144 + cc);
                st_bf4(XN + (size_t)t * D + cc, v[j] * rstd * g * (a + 1.f) + bb); }
        } else {
#pragma unroll
            for (int j = 0; j < 4; ++j) { const int cc = 4 * (lane + 64 * j); *(f32x4*)(xr + cc) = v[j] * rstd * *(const f32x4*)(c.in[IN_NFIN] + cc); }
        }
    }
}

#ifdef DSA_NO_SEL
#define DSA_SEL_CALL
#else
#define DSA_SEL_CALL phase_ckvt(c); phase_dsa_sel(c, l);
#endif
#ifdef DSA_NO_ATT
#define DSA_ATT_CALL
#else
#define DSA_ATT_CALL phase_dsa_att(c, l);
#endif
constexpr int PH_PER_L = 18, N_PHASES = 1 + NL * PH_PER_L;
#ifndef PH_MASK
#define PH_MASK 0xFFFFFFFFu
#endif
#define IN(k) (lo <= (k) && (k) < hi)
#define EN(b) ((PH_MASK >> (b)) & 1u)
#ifndef REP_MASK
#define REP_MASK 0u
#endif
#define REPN(b) (((REP_MASK >> (b)) & 1u) ? 2 : 1)
#define SEAM(k) do { if (MK_ONE_LAUNCH && IN(k) && IN((k) + 1)) xcd_barrier(bar); } while (0)
template <int l>
__device__ __forceinline__ void layer_program(const Ctx& c, const XcdBarrier& bar, int lo, int hi) {
        const int P = 1 + l * PH_PER_L;
        const float* xin = l == 0 ? c.in[IN_X] : c.out;
        bf16* PB = (bf16*)(c.ws + WS_PB); float* SM = (float*)(c.ws + WS_SM);
        const bf16* XN = (const bf16*)(c.ws + WS_XN);
        const bf16* WIN = (const bf16*)(c.ws + WS_WIN) + (size_t)l * NINP * 1024;
        if (EN(1) && IN(P + 0)) { for (int rep = 0; rep < REPN(1); ++rep) {  if (l == 0) phase_norm1(c, 0, c.in[IN_X]);  if (rep + 1 < REPN(1)) xcd_barrier(bar); } } SEAM(P + 0);
        if (EN(2) && IN(P + 1)) { for (int rep = 0; rep < REPN(2); ++rep) {  EpiInPB E{PB, SM}; dgemm_phase(c, XN, 1024, T, WIN, NPB / 256, 1024, EpiU<decltype(E)>{E});  if (rep + 1 < REPN(2)) xcd_barrier(bar); } } SEAM(P + 1);
        if (EN(3) && IN(P + 2)) { for (int rep = 0; rep < REPN(3); ++rep) {  phase_prep(c, l);  if (rep + 1 < REPN(3)) xcd_barrier(bar); } } SEAM(P + 2);
        if (EN(4) && IN(P + 3)) { for (int rep = 0; rep < REPN(4); ++rep) {  phase_scans(c, l);  if (rep + 1 < REPN(4)) xcd_barrier(bar); } } SEAM(P + 3);
        if (EN(5) && IN(P + 4)) { for (int rep = 0; rep < REPN(5); ++rep) {  EpiQ E{(bf16*)(c.ws + WS_QLAT), (bf16*)(c.ws + WS_QIDX), (const float*)(c.ws + WS_RSTDQ)};
            dgemm_phase(c, PB + PB_CQ, NPB, T, (const bf16*)(c.ws + WS_WQ) + (size_t)l * 1280 * 256, 5, 256, EpiU<decltype(E)>{E});  if (rep + 1 < REPN(5)) xcd_barrier(bar); } } SEAM(P + 4);
        if (EN(6) && IN(P + 5)) { for (int rep = 0; rep < REPN(6); ++rep) {  EpiGate E{(bf16*)(c.ws + WS_G)}; dgemm_phase(c, XN, 1024, T, WIN + (size_t)NPB * 1024, NG / 256, 1024, EpiU<decltype(E)>{E});  if (rep + 1 < REPN(6)) xcd_barrier(bar); } } SEAM(P + 5);
        if (EN(7) && IN(P + 6)) { for (int rep = 0; rep < REPN(7); ++rep) {  DSA_SEL_CALL xcd_barrier(bar); DSA_ATT_CALL  if (rep + 1 < REPN(7)) xcd_barrier(bar); } } SEAM(P + 6);
        if (EN(8) && IN(P + 7)) { for (int rep = 0; rep < REPN(8); ++rep) {  EpiUp E{(bf16*)(c.ws + WS_M1), (const bf16*)(c.ws + WS_G), 0, 1};
            dgemm_phase(c, (const bf16*)(c.ws + WS_UA), 512, T, (const bf16*)(c.ws + WS_WUPA) + (size_t)l * 1024 * 512, 4, 512, EpiU<decltype(E)>{E});  if (rep + 1 < REPN(8)) xcd_barrier(bar); } } SEAM(P + 7);
        if (EN(9) && IN(P + 8)) { for (int rep = 0; rep < REPN(9); ++rep) {  EpiUp E{(bf16*)(c.ws + WS_M1), (const bf16*)(c.ws + WS_G), 1024, 0};
            dgemm_phase(c, (const bf16*)(c.ws + WS_OLAT), 1024, T, (const bf16*)(c.ws + WS_WUVB) + (size_t)l * 1024 * 1024, 4, 1024, EpiU<decltype(E)>{E});  if (rep + 1 < REPN(9)) xcd_barrier(bar); } } SEAM(P + 8);
        if (EN(10) && IN(P + 9)) { for (int rep = 0; rep < REPN(10); ++rep) {  EpiUp E{(bf16*)(c.ws + WS_M1), (const bf16*)(c.ws + WS_G), 2048, 0};
            dgemm_phase(c, (const bf16*)(c.ws + WS_UC), 512, T, (const bf16*)(c.ws + WS_WUPC) + (size_t)l * 1024 * 512, 4, 512, EpiU<decltype(E)>{E});  if (rep + 1 < REPN(10)) xcd_barrier(bar); } } SEAM(P + 9);
        if (EN(11) && IN(P + 10)) { for (int rep = 0; rep < REPN(11); ++rep) {  EpiWo E{xin, c.out, (const float*)(c.ws + WS_MOD) + (size_t)l * 16 * 6144 + 2048};
            dgemm_phase(c, (const bf16*)(c.ws + WS_M1), 1024, T, (const bf16*)(c.ws + WS_WO) + (size_t)l * 1024 * 1024, 4, 1024, EpiU<decltype(E)>{E});  if (rep + 1 < REPN(11)) xcd_barrier(bar); } } SEAM(P + 10);
        if (EN(12) && IN(P + 11)) { for (int rep = 0; rep < REPN(12); ++rep) {  phase_route(c, l, c.out);  if (rep + 1 < REPN(12)) xcd_barrier(bar); } } SEAM(P + 11);
        if (EN(13) && IN(P + 12)) { for (int rep = 0; rep < REPN(13); ++rep) {  phase_gemm1(c, l, 0);  if (rep + 1 < REPN(13)) xcd_barrier(bar); } } SEAM(P + 12);
        if (EN(14) && IN(P + 13)) { for (int rep = 0; rep < REPN(14); ++rep) {  phase_gemm2(c, l, 0);  if (rep + 1 < REPN(14)) xcd_barrier(bar); } } SEAM(P + 13);
        if (EN(15) && IN(P + 14)) { for (int rep = 0; rep < REPN(15); ++rep) {  phase_combine(c, l, 0, c.out);  if (rep + 1 < REPN(15)) xcd_barrier(bar); } } SEAM(P + 14);
        if (EN(16) && IN(P + 15)) { for (int rep = 0; rep < REPN(16); ++rep) {  phase_gemm1(c, l, 1);  if (rep + 1 < REPN(16)) xcd_barrier(bar); } } SEAM(P + 15);
        if (EN(17) && IN(P + 16)) { for (int rep = 0; rep < REPN(17); ++rep) {  phase_gemm2(c, l, 1);  if (rep + 1 < REPN(17)) xcd_barrier(bar); } } SEAM(P + 16);
        if (EN(18) && IN(P + 17)) { for (int rep = 0; rep < REPN(18); ++rep) {  phase_combine(c, l, 1, c.out);  if (rep + 1 < REPN(18)) xcd_barrier(bar); } } SEAM(P + 17);
    }
__global__ void __launch_bounds__(NTHR, 2) fwd(Args args) {
    extern __shared__ __attribute__((aligned(16))) unsigned char lds_raw[];
    Ctx c;
    c.lds = (LAS unsigned char*)lds_raw;
    c.tid = threadIdx.x; c.lane = c.tid & 63; c.wave = __builtin_amdgcn_readfirstlane(c.tid >> 6);
    c.bid = blockIdx.x; c.nblk = gridDim.x;
    c.in = args.in; c.out = args.out; c.ws = args.ws;
    for (int u = c.tid; u < (LDS_BYTES - LDS_MISC) / 4; u += NTHR) ((LAS unsigned*)(c.lds + LDS_MISC))[u] = 0u;
    __syncthreads();
    XcdBarrier bar; bar.bar = (unsigned*)(c.ws + WS_CTL) + CW_BAR; bar.x = 0; bar.st = (volatile LAS unsigned*)(c.lds + LDS_MISC);
    if (MK_ONE_LAUNCH) bar = xcd_barrier_post((unsigned*)(c.ws + WS_CTL) + CW_BAR, (volatile LAS unsigned*)(c.lds + LDS_MISC));
    const int lo = args.ph_lo, hi = args.ph_hi;
    if (EN(0) && IN(0)) { for (int rep = 0; rep < REPN(0); ++rep) { phase_prologue(c); if (rep + 1 < REPN(0)) xcd_barrier(bar); } } SEAM(0);
    layer_program<0>(c, bar, lo, hi);
    layer_program<1>(c, bar, lo, hi);
#undef IN
#undef SEAM
}

extern "C" void kernel_launch(void* const* d_in, const int* in_sizes, int n_in, void* d_out, int out_size, void* d_ws, size_t ws_size, hipStream_t stream) {
    static int grid = 0;
    if (grid == 0) {
        if (n_in != 33 || out_size != T * D || ws_size < WS_END) { fprintf(stderr, "kernel_launch: unexpected problem (n_in %d out %d ws %zu)\n", n_in, out_size, ws_size); grid = -1; return; }
        int dev = 0, cus = 0, per_cu = 0;
        if (hipGetDevice(&dev) != hipSuccess || hipDeviceGetAttribute(&cus, hipDeviceAttributeMultiprocessorCount, dev) != hipSuccess) { grid = -1; return; }
        if (hipFuncSetAttribute((const void*)fwd, hipFuncAttributeMaxDynamicSharedMemorySize, LDS_BYTES) != hipSuccess) { fprintf(stderr, "kernel_launch: hipFuncSetAttribute failed\n"); grid = -1; return; }
        if (hipOccupancyMaxActiveBlocksPerMultiprocessor(&per_cu, (const void*)fwd, NTHR, LDS_BYTES) != hipSuccess || per_cu < 1) { fprintf(stderr, "kernel_launch: occupancy query says %d\n", per_cu); }
        (void)hipGetLastError();
        grid = cus;
    }
    if (grid < 0) return;
    (void)hipMemsetAsync((char*)d_ws + WS_CTL, 0, CTL_BYTES, stream);
    Args a{};
    for (int i = 0; i < 33; ++i) a.in[i] = (const float*)d_in[i];
    a.out = (float*)d_out; a.ws = (unsigned char*)d_ws;
#if MK_ONE_LAUNCH
    a.ph_lo = 0; a.ph_hi = N_PHASES;
    hipLaunchKernelGGL(fwd, dim3(grid), dim3(NTHR), LDS_BYTES, stream, a);
#else
    for (int p = 0; p < N_PHASES; ++p) {
        if (p == 1 + PH_PER_L) continue;
        a.ph_lo = p; a.ph_hi = p + 1;
        hipLaunchKernelGGL(fwd, dim3(grid), dim3(NTHR), LDS_BYTES, stream, a);
    }
#endif
}
```

```cpp
#include <hip/hip_runtime.h>
#include <cstdio>
#include <cstdint>

#define LAS __attribute__((address_space(3)))
#define GAS __attribute__((address_space(1)))
typedef unsigned short bf16;
typedef short bf16x8 __attribute__((ext_vector_type(8)));
typedef float f32x4 __attribute__((ext_vector_type(4)));
typedef float f32x2 __attribute__((ext_vector_type(2)));
typedef unsigned u32x4 __attribute__((ext_vector_type(4)));
typedef unsigned u32x2 __attribute__((ext_vector_type(2)));
typedef GAS unsigned gu32;

#ifndef SCAN_RECURRENT
#define SCAN_RECURRENT 0
#endif
#ifndef MK_ONE_LAUNCH
#define MK_ONE_LAUNCH 1
#endif

constexpr int NB = 16, SEQ = 2048, D = 1024, T = NB * SEQ, NL = 2;
constexpr int NIN = 6592, NPB = 3584, NG = 3072, NINP = NPB + NG;
constexpr int NE = 64, NEX = 65, EFF = 256, TOPK = 6;
constexpr int HALF_T = T / 2;
constexpr int DSA_K = 256;
constexpr float EPS = 1e-6f;
constexpr int NTHR = 512, NWAVES = 8;

constexpr int PB_QA = 0, PB_KA = 256, PB_VA = 512, PB_GA = 1024, PB_CQ = 1536, PB_CKV = 1792, PB_QC = 2048, PB_KC = 2304, PB_VC = 2560, PB_OC = 3072;
constexpr int SM_KIDX = 0, SM_ALR = 32, SM_WIDX = 48, SM_IC = 56, SM_FC = 60;

constexpr size_t MiB = 1u << 20;
constexpr size_t WS_CTL = 0, CTL_BYTES = 1 * MiB;
constexpr size_t WS_MOD = 1 * MiB;
constexpr size_t WS_RSTDQ = 2 * MiB;
constexpr size_t WS_TOKPOS = 3 * MiB;
constexpr size_t WS_IDENT = 3 * MiB + 800 * 1024;
constexpr size_t WS_WIN = 4 * MiB;
constexpr size_t WS_WQ = 30 * MiB;
constexpr size_t WS_WUPA = 32 * MiB;
constexpr size_t WS_WUPC = 34 * MiB;
constexpr size_t WS_WUVB = 36 * MiB;
constexpr size_t WS_WO = 40 * MiB;
constexpr size_t WS_WGU = 44 * MiB;
constexpr size_t WS_WD = 109 * MiB;
constexpr size_t WS_XN = 142 * MiB;
constexpr size_t WS_OLAT = WS_XN;
constexpr size_t WS_UA = 206 * MiB;
constexpr size_t WS_UC = 238 * MiB;
constexpr size_t WS_XN2 = 206 * MiB;
constexpr size_t WS_QLAT = 270 * MiB;
constexpr size_t WS_M1 = WS_QLAT;
constexpr size_t WS_QIDX = 334 * MiB;
constexpr size_t WS_CKVN = 350 * MiB;
constexpr size_t WS_KIDX = 358 * MiB;
constexpr size_t WS_SM = 360 * MiB;
constexpr size_t WS_PB = 376 * MiB;
constexpr size_t WS_G = WS_PB;
constexpr size_t WS_HID = 270 * MiB;
constexpr size_t WS_Y = 334 * MiB;
constexpr size_t WS_ROWL = 590 * MiB;
constexpr size_t WS_WL = 598 * MiB;
constexpr size_t WS_CKVT = 576 * MiB;
constexpr size_t WS_MASK = 584 * MiB;
static_assert(WS_CKVT >= WS_G + (size_t)T * NG * 2 && WS_MASK + (size_t)T * 64 * 4 <= WS_PB + (size_t)T * NPB * 2, "CKVT/MASK placement");
constexpr size_t WS_END = 606 * MiB;
static_assert(WS_PB + (size_t)T * NPB * 2 <= 600 * MiB, "PB");
static_assert(WS_Y + (size_t)131072 * 1024 * 2 <= WS_ROWL, "Y");

constexpr int CW_BAR = 4096;
constexpr int CW_CNT = 16384;

constexpr int LDS_BYTES = 147456;
constexpr int LDS_MISC = 145408;

__device__ __forceinline__ unsigned f2bf(float f) { unsigned u = __builtin_bit_cast(unsigned, f); return (u + 0x7fffu + ((u >> 16) & 1u)) >> 16; }
__device__ __forceinline__ float bf2f(unsigned b) { return __builtin_bit_cast(float, b << 16); }
__device__ __forceinline__ unsigned pk2(float lo, float hi) { return f2bf(lo) | (f2bf(hi) << 16); }
__device__ __forceinline__ float bflo(unsigned w) { return __builtin_bit_cast(float, w << 16); }
__device__ __forceinline__ float bfhi(unsigned w) { return __builtin_bit_cast(float, w & 0xffff0000u); }
__device__ __forceinline__ float wave_sum(float v) {
#pragma unroll
    for (int o = 1; o < 64; o <<= 1) v += __shfl_xor(v, o);
    return v;
}
__device__ __forceinline__ float wave_max(float v) {
#pragma unroll
    for (int o = 1; o < 64; o <<= 1) v = fmaxf(v, __shfl_xor(v, o));
    return v;
}
__device__ __forceinline__ int wave_sum_i(int v) {
#pragma unroll
    for (int o = 1; o < 64; o <<= 1) v += __shfl_xor(v, o);
    return v;
}
__device__ __forceinline__ void lds_barrier() { asm volatile("s_waitcnt lgkmcnt(0)" ::: "memory"); __builtin_amdgcn_s_barrier(); asm volatile("" ::: "memory"); }
__device__ __forceinline__ float sigmoidf_(float x) { return 1.f / (1.f + __expf(-x)); }
__device__ __forceinline__ float siluf_(float x) { return x / (1.f + __expf(-x)); }
__device__ __forceinline__ float logsigmoidf_(float x) { return fminf(x, 0.f) - log1pf(__expf(-fabsf(x))); }
__device__ __forceinline__ float logsigmoid_fast(float x) { return fminf(x, 0.f) - __logf(1.f + __expf(-fabsf(x))); }
__device__ __forceinline__ void st_bf4(bf16* p, f32x4 v) { u32x2 w; w.x = pk2(v[0], v[1]); w.y = pk2(v[2], v[3]); *(u32x2*)p = w; }
__device__ __forceinline__ f32x4 ld_bf4(const bf16* p) { u32x2 w = *(const u32x2*)p; return (f32x4){bflo(w.x), bfhi(w.x), bflo(w.y), bfhi(w.y)}; }

#define XB_TMO      128
#define XB_XCNT(j)  (256  + 64 * (j))
#define XB_XSUB(j)  (1280 + 64 * (j))
#define XB_XGEN(j)  (2304 + 64 * (j))
#define XB_TOP      3328
#define XB_TOPGEN   3392
#define XCD_BAR_WORDS 3456
#define XB_SPIN_CAP (1u << 22)
__device__ __forceinline__ unsigned xb_ld(unsigned* p)              { return __hip_atomic_load(p, __ATOMIC_RELAXED, __HIP_MEMORY_SCOPE_AGENT); }
__device__ __forceinline__ unsigned xb_add(unsigned* p, unsigned v) { return __hip_atomic_fetch_add(p, v, __ATOMIC_RELAXED, __HIP_MEMORY_SCOPE_AGENT); }
__device__ __forceinline__ unsigned xb_xcc_id() { return (unsigned)__builtin_amdgcn_s_getreg((3 << 11) | 20) & 0xFu; }
#define XB_SPIN(cond, bar) do { unsigned _sp = 0; while (cond) { __builtin_amdgcn_s_sleep(1); \
    if ((++_sp & 255u) == 0u) { if (xb_ld(&(bar)[XB_TMO])) break; if (_sp > XB_SPIN_CAP) { atomicAdd(&(bar)[XB_TMO], 1u); break; } } } } while (0)
struct XcdBarrier { unsigned* bar; unsigned x; volatile LAS unsigned* st; };
__device__ __forceinline__ XcdBarrier xcd_barrier_post(unsigned* bar, volatile LAS unsigned* st) {
    XcdBarrier b; b.bar = bar; b.x = xb_xcc_id(); b.st = st;
    if (threadIdx.x == 0) (void)xb_add(&bar[XB_XCNT(b.x)], 1u);
    return b;
}
__device__ __forceinline__ void xcd_barrier_complete(unsigned* bar, unsigned x, unsigned& nloc, unsigned& nx) {
    const unsigned G = gridDim.x * gridDim.y * gridDim.z;
    unsigned sum, cnt, mine, sp = 0u;
    for (;;) {
        sum = 0u; cnt = 0u; mine = 0u;
#pragma unroll
        for (unsigned j = 0; j < 16; ++j) { const unsigned c = xb_ld(&bar[XB_XCNT(j)]); sum += c; cnt += (c > 0u) ? 1u : 0u; mine = (j == x) ? c : mine; }
        if (sum == G) break;
        __builtin_amdgcn_s_sleep(1);
        if ((++sp & 255u) == 0u) { if (xb_ld(&bar[XB_TMO])) break; if (sp > XB_SPIN_CAP) { atomicAdd(&bar[XB_TMO], 1u); break; } }
    }
    nloc = mine > 0u ? mine : 1u; nx = cnt > 0u ? cnt : 1u;
}
__device__ __forceinline__ void xcd_barrier(const XcdBarrier& b) {
    asm volatile("s_waitcnt vmcnt(0)" ::: "memory");
    __syncthreads();
    if (threadIdx.x == 0) {
        unsigned* bar = b.bar;
        __builtin_amdgcn_s_waitcnt(0);
        unsigned nloc = b.st[0], nx = b.st[1];
        if (nloc == 0u) { xcd_barrier_complete(bar, b.x, nloc, nx); b.st[0] = nloc; b.st[1] = nx; }
        const unsigned old = xb_add(&bar[XB_XSUB(b.x)], 1u);
        const unsigned gen = old / nloc;
        if (old + 1u == (gen + 1u) * nloc) {
            __builtin_amdgcn_fence(__ATOMIC_RELEASE, "agent");
            asm volatile("s_waitcnt vmcnt(0)" ::: "memory");
            const unsigned og = xb_add(&bar[XB_TOP], 1u);
            const unsigned tg = og / nx;
            if (og + 1u == (tg + 1u) * nx) xb_add(&bar[XB_TOPGEN], 1u);
            else XB_SPIN(xb_ld(&bar[XB_TOPGEN]) == tg, bar);
            __builtin_amdgcn_fence(__ATOMIC_ACQUIRE, "agent");
            xb_add(&bar[XB_XGEN(b.x)], 1u);
            asm volatile("s_waitcnt vmcnt(0)" ::: "memory");
        } else {
            XB_SPIN(xb_ld(&bar[XB_XGEN(b.x)]) == gen, bar);
            __builtin_amdgcn_fence(__ATOMIC_ACQUIRE, "agent");
            asm volatile("s_waitcnt vmcnt(0)" ::: "memory");
        }
    }
    __syncthreads();
}

struct Args { const float* in[33]; float* out; unsigned char* ws; int ph_lo, ph_hi; };

struct Ctx {
    LAS unsigned char* lds;
    int tid, lane, wave, bid, nblk;
    const float* const* in;
    float* out; unsigned char* ws;
};
#define IN_X 0
#define IN_C 1
#define IN_ADAW 2
#define IN_ADAB 3
#define IN_NMIX 4
#define IN_NFFN 5
#define IN_WIN 6
#define IN_GLA_WA2 7
#define IN_GLA_BA 8
#define IN_GLA_NORM 9
#define IN_DSA_NQ 10
#define IN_DSA_NKV 11
#define IN_DSA_WUQ 12
#define IN_DSA_WUK 13
#define IN_DSA_WUV 14
#define IN_DSA_WQI 15
#define IN_ML_CONV 16
#define IN_ML_BI 17
#define IN_ML_BF 18
#define IN_ML_NORM 19
#define IN_WUPA 20
#define IN_WUPB 21
#define IN_WUPC 22
#define IN_WO 23
#define IN_RW 24
#define IN_RB 25
#define IN_EWG 26
#define IN_EWU 27
#define IN_EWD 28
#define IN_SWG 29
#define IN_SWU 30
#define IN_SWD 31
#define IN_NFIN 32

template <class SrcF>
__device__ __forceinline__ void tr_item(const SrcF& src, bf16* dst, int dst_ld, int n0, int k0, LAS float* scr, int lane) {
    const int j = lane & 31;
    const float* colp = src(n0 + j);
    const long ld = src.ld;
#pragma unroll 8
    for (int i = 0; i < 32; ++i) { const int kk = 2 * i + (lane >> 5); scr[kk * 33 + j] = colp ? colp[(long)(k0 + kk) * ld] : 0.f; }
    asm volatile("s_waitcnt lgkmcnt(0)" ::: "memory");
    const int c = lane & 7;
#pragma unroll
    for (int jj = 0; jj < 4; ++jj) { const int n = (lane >> 3) + 8 * jj; const LAS float* s = scr + (8 * c) * 33 + n;
        u32x4 o; o.x = pk2(s[0 * 33], s[1 * 33]); o.y = pk2(s[2 * 33], s[3 * 33]); o.z = pk2(s[4 * 33], s[5 * 33]); o.w = pk2(s[6 * 33], s[7 * 33]);
        *(u32x4*)(dst + (size_t)(n0 + n) * dst_ld + k0 + 8 * c) = o; }
    asm volatile("s_waitcnt lgkmcnt(0)" ::: "memory");
}
struct SrcPlain { const float* W; long ld; __device__ __forceinline__ const float* operator()(int n) const { return W + n; } };
__device__ __forceinline__ int win_src_col(int r) {
    if (r < 1536) return r;
    if (r < 1792) return 1552 + (r - 1536);
    if (r < 1920) return 1808 + (r - 1792);
    if (r < 1952) return 1936 + (r - 1920);
    if (r < 1968) return 1536 + (r - 1952);
    if (r < 1976) return 1968 + (r - 1968);
    if (r < 1980) return 3000 + (r - 1976);
    if (r < 1984) return 3004 + (r - 1980);
    if (r < 2048) return -1;
    if (r < 2560) return 1976 + (r - 2048);
    if (r < 3072) return 2488 + (r - 2560);
    if (r < 3584) return 3008 + (r - 3072);
    return 3520 + (r - 3584);
}
struct SrcWin { const float* W; long ld; __device__ __forceinline__ const float* operator()(int n) const { const int c = win_src_col(n); return c < 0 ? nullptr : W + c; } };
struct SrcGU { const float* Wg; const float* Wu; long ld;
    __device__ __forceinline__ const float* operator()(int r) const { const int pn = r >> 8, w = r & 255, j = 128 * pn + (w & 127); return (w < 128 ? Wg : Wu) + j; } };

constexpr int SG_LD = 40;
template <class Epi>
__device__ __forceinline__ void sgemm_unit(const Ctx& c, const bf16* A, int lda, const int* rowlist, int nvalid, int arow0, const bf16* Bt, int K, const Epi& E, int erow0, int ecol0) {
    LAS bf16* As = (LAS bf16*)c.lds;
    LAS bf16* Bs = (LAS bf16*)(c.lds + 128 * SG_LD * 2);
    const int tid = c.tid, lane = c.lane, wave = c.wave, wr = wave >> 2, wc = wave & 3, fr = lane & 15, fq = lane >> 4;
    const int lr = tid >> 2, ch = tid & 3;
    int srow = arow0 + lr;
    if (rowlist) { srow = (arow0 + lr < nvalid) ? rowlist[arow0 + lr] : 0; }
    const bf16* ap = A + (size_t)srow * lda + ch * 8;
    const bf16* bp0 = Bt + (size_t)lr * K + ch * 8;
    const bf16* bp1 = Bt + (size_t)(128 + lr) * K + ch * 8;
    f32x4 acc[2][4][2];
#pragma unroll
    for (int a = 0; a < 2; ++a)
#pragma unroll
        for (int m = 0; m < 4; ++m)
#pragma unroll
            for (int n = 0; n < 2; ++n) acc[a][m][n] = (f32x4){0.f, 0.f, 0.f, 0.f};
    u32x4 ra = *(const u32x4*)ap, rb0 = *(const u32x4*)bp0, rb1 = *(const u32x4*)bp1;
    for (int k0 = 0; k0 < K; k0 += 32) {
        __syncthreads();
        *(LAS u32x4*)(As + lr * SG_LD + ch * 8) = ra;
        *(LAS u32x4*)(Bs + lr * SG_LD + ch * 8) = rb0;
        *(LAS u32x4*)(Bs + (128 + lr) * SG_LD + ch * 8) = rb1;
        __syncthreads();
        if (k0 + 32 < K) { ra = *(const u32x4*)(ap + k0 + 32); rb0 = *(const u32x4*)(bp0 + k0 + 32); rb1 = *(const u32x4*)(bp1 + k0 + 32); }
        bf16x8 af[4], bfr[2][2];
#pragma unroll
        for (int m = 0; m < 4; ++m) af[m] = *(const LAS bf16x8*)(As + (wr * 64 + m * 16 + fr) * SG_LD + fq * 8);
#pragma unroll
        for (int bj = 0; bj < 2; ++bj)
#pragma unroll
            for (int n = 0; n < 2; ++n) bfr[bj][n] = *(const LAS bf16x8*)(Bs + (bj * 128 + wc * 32 + n * 16 + fr) * SG_LD + fq * 8);
#pragma unroll
        for (int bj = 0; bj < 2; ++bj)
#pragma unroll
            for (int m = 0; m < 4; ++m)
#pragma unroll
                for (int n = 0; n < 2; ++n) acc[bj][m][n] = __builtin_amdgcn_mfma_f32_16x16x32_bf16(bfr[bj][n], af[m], acc[bj][m][n], 0, 0, 0);
    }
#pragma unroll
    for (int m = 0; m < 4; ++m)
#pragma unroll
        for (int n = 0; n < 2; ++n) E(erow0 + wr * 64 + m * 16 + fr, ecol0 + wc * 32 + n * 16 + 4 * fq, acc[0][m][n], acc[1][m][n]);
}
template <class Epi>
__device__ __forceinline__ void sgemm_phase(const Ctx& c, const bf16* A, int lda, int M, const bf16* Bt, int ntn, int K, const Epi& E) {
    const int nu = (M / 128) * ntn;
    for (int u = c.bid; u < nu; u += c.nblk) {
        const int pm = u / ntn, pn = u % ntn;
        sgemm_unit(c, A, lda, nullptr, 0, pm * 128, Bt + (size_t)pn * 256 * K, K, E, pm * 128, pn * 256);
    }
    __syncthreads();
}


namespace g8 {
constexpr int BM = 256, BK = 64, HALF = 128, HTB = HALF * BK * 2, STAGE_BYTES = 8 * HTB, NXCD = 8, WGM = 8;
__host__ __device__ __forceinline__ int lds_byte(int r, int c) { const int st = (r >> 4) * 2 + (c >> 5), rr = r & 15, cc = c & 31, ob = rr * 64 + cc * 2; return st * 1024 + (ob ^ (((ob >> 9) & 1) << 5)); }
__host__ __device__ __forceinline__ void stage_rc(int b, int& R, int& C) { const int st = b / 1024, sb = b % 1024, swz = sb ^ (((sb >> 9) & 1) << 5); R = (st >> 1) * 16 + swz / 64; C = (st & 1) * 32 + (swz % 64) / 2; }
struct GUnit { const char* A; const char* B; const int* rl; int nvalid; int erow0, ecol0; int x0; const float* xp; };
__device__ __forceinline__ bool static_order(int nM, int nN, int G, int c, int i, int& pm, int& pn) {
    const int nwg = nM * nN; const long L = (long)i * G + c; if (L >= nwg) return false;
    int wgid = (int)L; { const int q = nwg / NXCD, r = nwg % NXCD, xcd = wgid % NXCD, off = wgid / NXCD; wgid = (xcd < r ? xcd * (q + 1) : r * (q + 1) + (xcd - r) * q) + off; }
    const int nig = WGM * nN, gid = wgid / nig, fm = gid * WGM, gsz = (nM - fm) < WGM ? (nM - fm) : WGM;
    pm = fm + ((wgid % nig) % gsz); pn = (wgid % nig) / gsz; return true;
}
struct DenseSched { const char* A; const char* Bt; size_t ldaB, ldbB; int nM, nN, G, c;
    __device__ __forceinline__ bool next(int i, GUnit& u) const { int pm, pn; if (!static_order(nM, nN, G, c, i, pm, pn)) return false;
        u.A = A + (size_t)pm * 256 * ldaB; u.B = Bt + (size_t)pn * 256 * ldbB; u.rl = nullptr; u.nvalid = 0; u.erow0 = pm * 256; u.ecol0 = pn * 256; u.x0 = 0; u.xp = nullptr; return true; } };

template <bool GATHER, class Epi, class Sched>
__device__ __forceinline__ void gemm_phase(LAS unsigned char* lds, unsigned ldaB, int K, const Sched& S, const Epi& E) {
    const int tid = threadIdx.x, wid = __builtin_amdgcn_readfirstlane(tid >> 6), lane = tid & 63, wr = wid >> 2, wc = wid & 3, fr = lane & 15, fq = lane >> 4;
    const int nt = K / BK;
    int R0, C0, R1, C1; stage_rc(tid * 16, R0, C0); stage_rc(tid * 16 + 8192, R1, C1);
    unsigned voffB[2]; voffB[0] = (unsigned)(R0 * K + C0) * 2u; voffB[1] = (unsigned)(R1 * K + C1) * 2u;
    unsigned ac0[2], ac1[2], an0[2], an1[2];
    const size_t kstep = (size_t)(BK * 2);
    const size_t hstepB = (size_t)HALF * K * 2;
    const unsigned ldsw = (unsigned)wid * 1024u;
    const int aoff = lds_byte(wr * 64 + fr, fq * 8), boff = lds_byte(wc * 32 + fr, fq * 8);
#define G8_SA(b, h) (((b) * 2 + (h)) * HTB)
#define G8_SB(b, h) ((4 + (b) * 2 + (h)) * HTB)
#define G8_STAGE(bufoff, gbase, voff) do { _Pragma("unroll") for (int _i = 0; _i < 2; ++_i) \
        __builtin_amdgcn_global_load_lds((const unsigned*)((const char*)(gbase) + (voff)[_i]), (LAS unsigned*)(lds + (bufoff) + ldsw + _i * 8192), 16, 0, 0); } while (0)
#define G8_LDA(dst, b, h) do { _Pragma("unroll") for (int m = 0; m < 4; ++m) _Pragma("unroll") for (int k = 0; k < 2; ++k) dst[m][k] = *(const LAS bf16x8*)(lds + G8_SA(b, h) + aoff + m * 2048 + k * 1024); } while (0)
#define G8_LDB(dst, b, h) do { _Pragma("unroll") for (int n = 0; n < 2; ++n) _Pragma("unroll") for (int k = 0; k < 2; ++k) dst[n][k] = *(const LAS bf16x8*)(lds + G8_SB(b, h) + boff + n * 2048 + k * 1024); } while (0)
#define G8_MMA(ai, bj, At, Bt) do { __builtin_amdgcn_s_setprio(1); _Pragma("unroll") for (int m = 0; m < 4; ++m) _Pragma("unroll") for (int n = 0; n < 2; ++n) _Pragma("unroll") for (int k = 0; k < 2; ++k) \
        acc[ai][bj][m][n] = __builtin_amdgcn_mfma_f32_16x16x32_bf16(Bt[n][k], At[m][k], acc[ai][bj][m][n], 0, 0, 0); __builtin_amdgcn_s_setprio(0); } while (0)
#define G8_WAIT_V(n) asm volatile("s_waitcnt vmcnt(" #n ")" ::: "memory")
#define G8_WAIT_L(n) asm volatile("s_waitcnt lgkmcnt(" #n ")" ::: "memory")
#define G8_BAR __builtin_amdgcn_s_barrier()
#define G8_SCHED __builtin_amdgcn_sched_barrier(0)
#define G8_XLOAD(u) __builtin_amdgcn_global_load_lds((const unsigned*)((u).rl + lane * 4), (LAS unsigned*)(lds + STAGE_BYTES + wid * 1024), 16, 0, 0)
#define G8_AOFF(u, o0, o1) do { if (GATHER) { const LAS int* _rs = (const LAS int*)(lds + STAGE_BYTES + wid * 1024); const int _nv = (u).nvalid - 1; \
        const int _r00 = _rs[min(R0, _nv)], _r01 = _rs[min(R1, _nv)], _r10 = _rs[min(128 + R0, _nv)], _r11 = _rs[min(128 + R1, _nv)]; \
        o0[0] = (unsigned)_r00 * ldaB + (unsigned)C0 * 2u; o0[1] = (unsigned)_r01 * ldaB + (unsigned)C1 * 2u; o1[0] = (unsigned)_r10 * ldaB + (unsigned)C0 * 2u; o1[1] = (unsigned)_r11 * ldaB + (unsigned)C1 * 2u; \
    } else { o0[0] = (unsigned)R0 * ldaB + (unsigned)C0 * 2u; o0[1] = (unsigned)R1 * ldaB + (unsigned)C1 * 2u; o1[0] = (unsigned)(128 + R0) * ldaB + (unsigned)C0 * 2u; o1[1] = (unsigned)(128 + R1) * ldaB + (unsigned)C1 * 2u; } } while (0)
    GUnit cur, nxt; int ui = 0;
    if (!S.next(0, cur)) return;
    f32x4 acc[2][2][4][2];
#pragma unroll
    for (int a = 0; a < 2; ++a)
#pragma unroll
        for (int b = 0; b < 2; ++b)
#pragma unroll
            for (int m = 0; m < 4; ++m)
#pragma unroll
                for (int n = 0; n < 2; ++n) acc[a][b][m][n] = (f32x4){0.f, 0.f, 0.f, 0.f};
    bf16x8 At[4][2], B0[2][2], B1[2][2];
    if (GATHER) { G8_XLOAD(cur); G8_WAIT_V(0); }
    G8_AOFF(cur, ac0, ac1);
    if (GATHER) { G8_WAIT_L(0); }
    const char* cA = cur.A; const char* cB = cur.B;
    G8_STAGE(G8_SB(0, 0), cB, voffB); G8_STAGE(G8_SB(0, 1), cB + hstepB, voffB); G8_STAGE(G8_SA(0, 0), cA, ac0); G8_STAGE(G8_SA(0, 1), cA, ac1);
    if (wr == 1) G8_BAR;
    G8_WAIT_V(2); G8_BAR;
    G8_STAGE(G8_SB(1, 0), cB + kstep, voffB); G8_STAGE(G8_SA(1, 0), cA + kstep, ac0); G8_STAGE(G8_SB(1, 1), cB + hstepB + kstep, voffB);
    G8_WAIT_V(6); G8_BAR;
    for (;;) {
        const bool has_next = S.next(ui + 1, nxt);
        const char* nA = has_next ? nxt.A : cA; const char* nB = has_next ? nxt.B : cB;
        an0[0] = ac0[0]; an0[1] = ac0[1]; an1[0] = ac1[0]; an1[1] = ac1[1];
        const bool xload = GATHER && has_next;
        if (xload) { G8_XLOAD(nxt); }
#pragma unroll 1
        for (int t = 0; t < nt; t += 2) {
            const bool last = (t == nt - 2);
            const char* a1 = cA + (size_t)(t + 1) * kstep;
            const char* a2 = last ? nA : cA + (size_t)(t + 2) * kstep; const char* b2 = last ? nB : cB + (size_t)(t + 2) * kstep;
            const char* a3 = a2 + kstep; const char* b3 = b2 + kstep;
            unsigned* x0 = last ? an0 : ac0; unsigned* x1 = last ? an1 : ac1;
            unsigned s0[2], s1[2]; s0[0] = x0[0]; s0[1] = x0[1]; s1[0] = x1[0]; s1[1] = x1[1];
            G8_LDB(B0, 0, 0); G8_LDB(B1, 0, 1); G8_SCHED; G8_LDA(At, 0, 0); G8_STAGE(G8_SA(1, 1), a1, ac1);
            if (xload && t == 0) { G8_WAIT_V(9); } else { G8_WAIT_V(8); }
            G8_WAIT_L(0); G8_BAR; G8_MMA(0, 0, At, B0); G8_MMA(0, 1, At, B1); G8_BAR; G8_SCHED;
            G8_LDA(At, 0, 1); G8_STAGE(G8_SB(0, 0), b2, voffB); G8_STAGE(G8_SB(0, 1), b2 + hstepB, voffB); G8_STAGE(G8_SA(0, 0), a2, s0);
            G8_WAIT_V(8); G8_WAIT_L(0); G8_BAR; G8_MMA(1, 0, At, B0); G8_MMA(1, 1, At, B1); G8_BAR; G8_SCHED;
            if (xload && t == 0) { G8_AOFF(nxt, an0, an1); }
            G8_LDB(B0, 1, 0); G8_LDB(B1, 1, 1); G8_SCHED; G8_LDA(At, 1, 0); G8_STAGE(G8_SA(0, 1), a2, s1);
            G8_WAIT_V(8); G8_WAIT_L(0); G8_BAR; G8_MMA(0, 0, At, B0); G8_MMA(0, 1, At, B1); G8_BAR; G8_SCHED;
            G8_LDA(At, 1, 1); G8_STAGE(G8_SB(1, 0), b3, voffB); G8_STAGE(G8_SB(1, 1), b3 + hstepB, voffB); G8_STAGE(G8_SA(1, 0), a3, s0);
            G8_WAIT_V(8); G8_WAIT_L(0); G8_BAR; G8_MMA(1, 0, At, B0); G8_MMA(1, 1, At, B1); G8_BAR; G8_SCHED;
        }
        if (wr == 0) G8_BAR;
#pragma unroll
        for (int ai = 0; ai < 2; ++ai)
#pragma unroll
            for (int m = 0; m < 4; ++m)
#pragma unroll
                for (int n = 0; n < 2; ++n) E(cur, cur.erow0 + ai * HALF + wr * 64 + m * 16 + fr, cur.ecol0 + wc * 32 + n * 16 + 4 * fq, acc[ai][0][m][n], acc[ai][1][m][n]);
        if (!has_next) break;
#pragma unroll
        for (int a = 0; a < 2; ++a)
#pragma unroll
            for (int b = 0; b < 2; ++b)
#pragma unroll
                for (int m = 0; m < 4; ++m)
#pragma unroll
                    for (int n = 0; n < 2; ++n) acc[a][b][m][n] = (f32x4){0.f, 0.f, 0.f, 0.f};
        cur = nxt; cA = nA; cB = nB; ++ui;
        ac0[0] = an0[0]; ac0[1] = an0[1]; ac1[0] = an1[0]; ac1[1] = an1[1];
        if (wr == 1) G8_BAR;
    }
    G8_WAIT_V(0);
    G8_BAR;
#undef G8_SA
#undef G8_SB
#undef G8_STAGE
#undef G8_LDA
#undef G8_LDB
#undef G8_MMA
#undef G8_WAIT_V
#undef G8_WAIT_L
#undef G8_BAR
#undef G8_SCHED
#undef G8_AOFF
#undef G8_XLOAD
}
}
template <class Epi>
__device__ __forceinline__ void dgemm_phase(const Ctx& c, const bf16* A, int lda, int M, const bf16* Bt, int ntn, int K, const Epi& E, int G = -1, int cid = -1) {
    g8::DenseSched S{(const char*)A, (const char*)Bt, (size_t)lda * 2, (size_t)K * 2, M / 256, ntn, G < 0 ? c.nblk : G, cid < 0 ? c.bid : cid};
    g8::gemm_phase<false>(c.lds, (unsigned)lda * 2u, K, S, E);
    __syncthreads();
}

struct EpiInPB { bf16* PB; float* SM;
    __device__ __forceinline__ void operator()(int row, int col, f32x4 lo, f32x4 hi) const {
        st_bf4(PB + (size_t)row * NPB + col, lo);
        if ((col >> 8) == 7) *(f32x4*)(SM + (size_t)row * 128 + (col & 127)) = hi;
        else st_bf4(PB + (size_t)row * NPB + col + 128, hi);
    } };
struct EpiQ { bf16* QLAT; bf16* QIDX; const float* rstd;
    __device__ __forceinline__ void operator()(int row, int col, f32x4 lo, f32x4 hi) const {
        const float r = rstd[row];
        if (col < 1024) { st_bf4(QLAT + (size_t)row * 1024 + col, lo * r); st_bf4(QLAT + (size_t)row * 1024 + col + 128, hi * r); }
        else { st_bf4(QIDX + (size_t)row * 256 + (col - 1024), lo * r); st_bf4(QIDX + (size_t)row * 256 + (col - 1024) + 128, hi * r); }
    } };
struct EpiGate { bf16* G;
    __device__ __forceinline__ void operator()(int row, int col, f32x4 lo, f32x4 hi) const {
        f32x4 a, b;
#pragma unroll
        for (int i = 0; i < 4; ++i) { a[i] = sigmoidf_(lo[i]); b[i] = sigmoidf_(hi[i]); }
        st_bf4(G + (size_t)row * NG + col, a); st_bf4(G + (size_t)row * NG + col + 128, b);
    } };
struct EpiUp { bf16* M1; const bf16* G; int goff; int first;
    __device__ __forceinline__ void operator()(int row, int col, f32x4 lo, f32x4 hi) const {
        bf16* m = M1 + (size_t)row * 1024 + col; const bf16* g = G + (size_t)row * NG + goff + col;
        f32x4 a = ld_bf4(g) * lo, b = ld_bf4(g + 128) * hi;
        if (!first) { a += ld_bf4(m); b += ld_bf4(m + 128); }
        st_bf4(m, a); st_bf4(m + 128, b);
    } };
struct EpiWo { const float* res; float* out; const float* g1;
    __device__ __forceinline__ void operator()(int row, int col, f32x4 lo, f32x4 hi) const {
        const float* gp = g1 + (size_t)(row >> 11) * 6144 + col; const size_t o = (size_t)row * 1024 + col;
        const f32x4 ga = *(const f32x4*)gp, gb = *(const f32x4*)(gp + 128);
        const f32x4 ra = *(const f32x4*)(res + o), rb = *(const f32x4*)(res + o + 128);
        *(f32x4*)(out + o) = ra + ga * lo; *(f32x4*)(out + o + 128) = rb + gb * hi;
    } };
struct EpiG1 { bf16* HID; const float* wl; int cnt; int orow0;
    __device__ __forceinline__ void operator()(int row, int col, f32x4 lo, f32x4 hi) const {
        const int hc = col - 128 * (col >> 8);
        f32x4 v = (f32x4){0.f, 0.f, 0.f, 0.f};
        if (row < cnt) { const float w = wl ? wl[row] : 1.f;
#pragma unroll
            for (int i = 0; i < 4; ++i) v[i] = siluf_(lo[i]) * hi[i] * w; }
        st_bf4(HID + (size_t)(orow0 + row) * 256 + hc, v);
    } };
struct EpiG2 { bf16* Y; int orow0;
    __device__ __forceinline__ void operator()(int row, int col, f32x4 lo, f32x4 hi) const {
        st_bf4(Y + (size_t)(orow0 + row) * 1024 + col, lo); st_bf4(Y + (size_t)(orow0 + row) * 1024 + col + 128, hi);
    } };


template <class F> struct EpiU { F f; __device__ __forceinline__ void operator()(const g8::GUnit&, int row, int col, f32x4 lo, f32x4 hi) const { f(row, col, lo, hi); } };

__device__ __forceinline__ void phase_prologue(const Ctx& c) {
    {
        LAS float* cs = (LAS float*)c.lds;
        LAS float* red = (LAS float*)(c.lds + 65536);
        const float* cin = c.in[IN_C];
        if (c.bid < 192) {
            for (int i = c.tid; i < 16 * 1024; i += NTHR) cs[i] = siluf_(cin[i]);
            __syncthreads();
        }
        float* MOD = (float*)(c.ws + WS_MOD);
        for (int it = c.bid; it < 192; it += c.nblk) {
            const int l = it / 96, cg = it % 96, col = cg * 64 + c.lane;
            const float* W = c.in[IN_ADAW] + (size_t)l * 1024 * 6144 + col;
            float acc[16];
#pragma unroll
            for (int b = 0; b < 16; ++b) acc[b] = 0.f;
            const int kbeg = c.wave * 128;
            for (int k = kbeg; k < kbeg + 128; k += 4) {
                const float w0 = W[(size_t)k * 6144], w1 = W[(size_t)(k + 1) * 6144], w2 = W[(size_t)(k + 2) * 6144], w3 = W[(size_t)(k + 3) * 6144];
#pragma unroll
                for (int b = 0; b < 16; ++b) { const f32x4 v = *(const LAS f32x4*)(cs + b * 1024 + k); acc[b] += v[0] * w0 + v[1] * w1 + v[2] * w2 + v[3] * w3; }
            }
#pragma unroll
            for (int b = 0; b < 16; ++b) red[(c.wave * 16 + b) * 64 + c.lane] = acc[b];
            __syncthreads();
            for (int i = c.tid; i < 16 * 64; i += NTHR) { const int b = i >> 6, ln = i & 63; float s = 0.f;
#pragma unroll
                for (int w = 0; w < 8; ++w) s += red[(w * 16 + b) * 64 + ln];
                MOD[((size_t)l * 16 + b) * 6144 + cg * 64 + ln] = s + c.in[IN_ADAB][l * 6144 + cg * 64 + ln]; }
            __syncthreads();
        }
        __syncthreads();
    }
    {
        LAS float* scr = (LAS float*)(c.lds + c.wave * 16384);
        const int gw = c.bid * NWAVES + c.wave, NGW = c.nblk * NWAVES;
        constexpr int I_WIN = (NINP / 32) * (1024 / 64), I_UP = (1024 / 32) * (512 / 64), I_WO = (1024 / 32) * (1024 / 64);
        constexpr int PER_L = I_WIN + 2 * I_UP + I_WO;
        for (int it = gw; it < NL * PER_L; it += NGW) {
            const int l = it / PER_L; int r = it % PER_L;
            if (r < I_WIN) { SrcWin s{c.in[IN_WIN] + (size_t)l * 1024 * NIN, NIN}; tr_item(s, (bf16*)(c.ws + WS_WIN) + (size_t)l * NINP * 1024, 1024, (r / 16) * 32, (r % 16) * 64, scr, c.lane); continue; }
            r -= I_WIN;
            if (r < I_UP) { SrcPlain s{c.in[IN_WUPA] + (size_t)l * 512 * 1024, 1024}; tr_item(s, (bf16*)(c.ws + WS_WUPA) + (size_t)l * 1024 * 512, 512, (r / 8) * 32, (r % 8) * 64, scr, c.lane); continue; }
            r -= I_UP;
            if (r < I_UP) { SrcPlain s{c.in[IN_WUPC] + (size_t)l * 512 * 1024, 1024}; tr_item(s, (bf16*)(c.ws + WS_WUPC) + (size_t)l * 1024 * 512, 512, (r / 8) * 32, (r % 8) * 64, scr, c.lane); continue; }
            r -= I_UP;
            { SrcPlain s{c.in[IN_WO] + (size_t)l * 1024 * 1024, 1024}; tr_item(s, (bf16*)(c.ws + WS_WO) + (size_t)l * 1024 * 1024, 1024, (r / 16) * 32, (r % 16) * 64, scr, c.lane); }
        }
    }
    {
        const int gt = c.bid * NTHR + c.tid, NGT = c.nblk * NTHR;
        for (int i = gt; i < T; i += NGT) ((int*)(c.ws + WS_IDENT))[i] = i;
        for (int it = gt; it < NL * 1280 * 32; it += NGT) {
            const int l = it / (1280 * 32), rem = it % (1280 * 32), n = rem / 32, r0 = (rem % 32) * 8;
            const float* gq = c.in[IN_DSA_NQ] + l * 256;
            float o[8];
            if (n < 1024) {
                const int h = n >> 7, cc = n & 127;
                const float* uk = c.in[IN_DSA_WUK] + (size_t)l * 128 * 512 + (size_t)cc * 512 + h * 64;
#pragma unroll
                for (int i = 0; i < 8; ++i) { const float* uq = c.in[IN_DSA_WUQ] + (size_t)l * 256 * 512 + (size_t)(r0 + i) * 512 + h * 64; float s = 0.f;
                    for (int d = 0; d < 64; ++d) s += uq[d] * uk[d];
                    o[i] = s * 0.125f * gq[r0 + i]; }
            } else {
                const int m = n - 1024;
#pragma unroll
                for (int i = 0; i < 8; ++i) o[i] = c.in[IN_DSA_WQI][(size_t)l * 256 * 256 + (size_t)(r0 + i) * 256 + m] * 0.17677669529663687f * gq[r0 + i];
            }
            u32x4 w; w.x = pk2(o[0], o[1]); w.y = pk2(o[2], o[3]); w.z = pk2(o[4], o[5]); w.w = pk2(o[6], o[7]);
            *(u32x4*)((bf16*)(c.ws + WS_WQ) + (size_t)l * 1280 * 256 + (size_t)n * 256 + r0) = w;
        }
    }
    {
        const int gt = c.bid * NTHR + c.tid, NGT = c.nblk * NTHR;
        for (int it = gt; it < NL * 128 * 1024; it += NGT) {
            const int l = it / (128 * 1024), rem = it % (128 * 1024), kc = rem / 1024, n = rem % 1024;
            const int h = kc >> 4, r0 = (kc & 15) * 8;
            const float* uv = c.in[IN_DSA_WUV] + (size_t)l * 128 * 512;
            const float* ub = c.in[IN_WUPB] + (size_t)l * 512 * 1024 + (size_t)(h * 64) * 1024 + n;
            float o[8];
#pragma unroll
            for (int i = 0; i < 8; ++i) o[i] = 0.f;
            for (int v = 0; v < 64; ++v) { const float b = ub[(size_t)v * 1024];
#pragma unroll
                for (int i = 0; i < 8; ++i) o[i] += uv[(size_t)(r0 + i) * 512 + h * 64 + v] * b; }
            u32x4 w; w.x = pk2(o[0], o[1]); w.y = pk2(o[2], o[3]); w.z = pk2(o[4], o[5]); w.w = pk2(o[6], o[7]);
            *(u32x4*)((bf16*)(c.ws + WS_WUVB) + (size_t)l * 1024 * 1024 + (size_t)n * 1024 + h * 128 + r0) = w;
        }
    }
}

__device__ __forceinline__ void norm_mod_row(const float* xrow, const float* gain, const float* sh, const float* sc, bf16* orow, int lane) {
    f32x4 v[4]; float s = 0.f;
#pragma unroll
    for (int j = 0; j < 4; ++j) { v[j] = *(const f32x4*)(xrow + 4 * (lane + 64 * j)); s += v[j][0] * v[j][0] + v[j][1] * v[j][1] + v[j][2] * v[j][2] + v[j][3] * v[j][3]; }
    const float rstd = rsqrtf(wave_sum(s) * (1.f / D) + EPS);
#pragma unroll
    for (int j = 0; j < 4; ++j) { const int cc = 4 * (lane + 64 * j);
        const f32x4 g = *(const f32x4*)(gain + cc), a = *(const f32x4*)(sc + cc), b = *(const f32x4*)(sh + cc);
        st_bf4(orow + cc, v[j] * rstd * g * (a + 1.f) + b); }
}
__device__ __forceinline__ void phase_norm1(const Ctx& c, int l, const float* xsrc) {
    const int gw = c.bid * NWAVES + c.wave, NGW = c.nblk * NWAVES;
    const float* MOD = (const float*)(c.ws + WS_MOD) + (size_t)l * 16 * 6144;
    bf16* XN = (bf16*)(c.ws + WS_XN);
    for (int t = gw; t < T; t += NGW) { const int b = t >> 11;
        norm_mod_row(xsrc + (size_t)t * D, c.in[IN_NMIX] + l * D, MOD + (size_t)b * 6144, MOD + (size_t)b * 6144 + 1024, XN + (size_t)t * D, c.lane); }
}

__device__ __forceinline__ void phase_prep(const Ctx& c, int l) {
    const int gw = c.bid * NWAVES + c.wave, NGW = c.nblk * NWAVES;
    const bf16* PB = (const bf16*)(c.ws + WS_PB); const float* SM = (const float*)(c.ws + WS_SM);
    bf16* CKVN = (bf16*)(c.ws + WS_CKVN); bf16* KIDX = (bf16*)(c.ws + WS_KIDX); float* RSTDQ = (float*)(c.ws + WS_RSTDQ);
    const float* gkv = c.in[IN_DSA_NKV] + l * 128;
    const float g0 = gkv[2 * c.lane], g1 = gkv[2 * c.lane + 1];
    for (int t = gw; t < T; t += NGW) {
        const bf16* row = PB + (size_t)t * NPB;
        const unsigned kv = *(const unsigned*)(row + PB_CKV + 2 * c.lane);
        const float k0 = bflo(kv), k1 = bfhi(kv);
        const float rs = rsqrtf(wave_sum(k0 * k0 + k1 * k1) * (1.f / 128.f) + EPS);
        *(unsigned*)(CKVN + (size_t)t * 128 + 2 * c.lane) = pk2(k0 * rs * g0, k1 * rs * g1);
        const f32x4 q = ld_bf4(row + PB_CQ + 4 * c.lane);
        const float rq = rsqrtf(wave_sum(q[0] * q[0] + q[1] * q[1] + q[2] * q[2] + q[3] * q[3]) * (1.f / 256.f) + EPS);
        if (c.lane == 0) RSTDQ[t] = rq;
        if (c.lane < 32) KIDX[(size_t)t * 32 + c.lane] = (bf16)f2bf(SM[(size_t)t * 128 + SM_KIDX + c.lane]);
    }
}
__device__ __forceinline__ void phase_ckvt(const Ctx& c) {
    const bf16* CKVN = (const bf16*)(c.ws + WS_CKVN); bf16* CKVT = (bf16*)(c.ws + WS_CKVT);
    LAS bf16* tile = (LAS bf16*)c.lds;
    for (int it = c.bid; it < T / 64; it += c.nblk) {
        const int tb = it * 64, b = tb >> 11, p0 = tb & 2047;
        __syncthreads();
        { const int r = c.tid >> 3, ch = (c.tid & 7) * 8;
          *(LAS u32x4*)(tile + r * 136 + ch) = *(const u32x4*)(CKVN + (size_t)(tb + r) * 128 + ch); *(LAS u32x4*)(tile + r * 136 + 64 + ch) = *(const u32x4*)(CKVN + (size_t)(tb + r) * 128 + 64 + ch); }
        __syncthreads();
        { const int r = c.tid >> 2, part = c.tid & 3;
          unsigned w[8];
#pragma unroll
          for (int j = 0; j < 8; ++j) w[j] = (unsigned)tile[(16 * part + 2 * j) * 136 + r] | ((unsigned)tile[(16 * part + 2 * j + 1) * 136 + r] << 16);
          bf16* dst = CKVT + ((size_t)b * 128 + r) * 2048 + p0 + 16 * part;
          *(u32x4*)dst = (u32x4){w[0], w[1], w[2], w[3]}; *(u32x4*)(dst + 8) = (u32x4){w[4], w[5], w[6], w[7]}; }
    }
    __syncthreads();
}

constexpr int TS = 16;
__device__ __forceinline__ void scan_gla_item(const Ctx& c, int l, int b, int h) {
    LAS float* q_s = (LAS float*)c.lds;
    LAS float* k_s = q_s + TS * 64;
    LAS float* a_s = k_s + TS * 64;
    LAS float* v_s = a_s + TS * 64;
    LAS float* part = v_s + TS * 128;
    LAS float* wa2 = part + TS * 4 * 128;
    LAS float* ba = wa2 + 16 * 64;
    LAS float* alr = ba + 64;
    const bf16* PB = (const bf16*)(c.ws + WS_PB); const float* SM = (const float*)(c.ws + WS_SM);
    bf16* UA = (bf16*)(c.ws + WS_UA);
    const float* gn = c.in[IN_GLA_NORM] + l * 512 + h * 128;
    for (int i = c.tid; i < 16 * 64; i += NTHR) wa2[i] = c.in[IN_GLA_WA2][(size_t)l * 16 * 256 + (i >> 6) * 256 + h * 64 + (i & 63)];
    if (c.tid < 64) ba[c.tid] = c.in[IN_GLA_BA][l * 256 + h * 64 + c.tid];
    const int v = c.tid & 127, kg = c.tid >> 7;
    float S[16];
#pragma unroll
    for (int i = 0; i < 16; ++i) S[i] = 0.f;
    for (int t0 = 0; t0 < SEQ; t0 += TS) {
        __syncthreads();
        const size_t rb = (size_t)b * SEQ + t0;
        for (int i = c.tid; i < TS * 64; i += NTHR) { const int s = i >> 6, cc = i & 63; const bf16* row = PB + (rb + s) * NPB;
            q_s[i] = bf2f(row[PB_QA + h * 64 + cc]) * 0.125f; k_s[i] = bf2f(row[PB_KA + h * 64 + cc]); }
        for (int i = c.tid; i < TS * 128; i += NTHR) { const int s = i >> 7, cc = i & 127; v_s[i] = bf2f(PB[(rb + s) * NPB + PB_VA + h * 128 + cc]); }
        if (c.tid < TS * 16) alr[c.tid] = SM[(rb + (c.tid >> 4)) * 128 + SM_ALR + (c.tid & 15)];
        __syncthreads();
        for (int i = c.tid; i < TS * 64; i += NTHR) { const int s = i >> 6, cc = i & 63; float x = ba[cc];
#pragma unroll
            for (int j = 0; j < 16; ++j) x += alr[s * 16 + j] * wa2[j * 64 + cc];
            a_s[i] = __expf(logsigmoidf_(x) * (1.f / 16.f)); }
        __syncthreads();
#pragma unroll 1
        for (int s = 0; s < TS; ++s) {
            const float vv = v_s[s * 128 + v]; float acc = 0.f;
#pragma unroll
            for (int i4 = 0; i4 < 4; ++i4) {
                const f32x4 a4 = *(const LAS f32x4*)(a_s + s * 64 + kg * 16 + i4 * 4), k4 = *(const LAS f32x4*)(k_s + s * 64 + kg * 16 + i4 * 4), q4 = *(const LAS f32x4*)(q_s + s * 64 + kg * 16 + i4 * 4);
#pragma unroll
                for (int j = 0; j < 4; ++j) { S[i4 * 4 + j] = a4[j] * S[i4 * 4 + j] + k4[j] * vv; acc += q4[j] * S[i4 * 4 + j]; }
            }
            part[(s * 4 + kg) * 128 + v] = acc;
        }
        __syncthreads();
        {
            const int s = c.tid >> 5, vq = c.tid & 31, v0 = vq * 4;
            f32x4 o = (f32x4){0.f, 0.f, 0.f, 0.f};
#pragma unroll
            for (int g = 0; g < 4; ++g) o += *(const LAS f32x4*)(part + (s * 4 + g) * 128 + v0);
            float ss = o[0] * o[0] + o[1] * o[1] + o[2] * o[2] + o[3] * o[3];
#pragma unroll
            for (int m = 1; m < 32; m <<= 1) ss += __shfl_xor(ss, m);
            const float rstd = rsqrtf(ss * (1.f / 128.f) + EPS);
            const f32x4 ga = ld_bf4(PB + (rb + s) * NPB + PB_GA + h * 128 + v0);
            f32x4 r;
#pragma unroll
            for (int j = 0; j < 4; ++j) r[j] = o[j] * rstd * gn[v0 + j] * siluf_(ga[j]);
            st_bf4(UA + (rb + s) * 512 + h * 128 + v0, r);
        }
    }
    __syncthreads();
}
__device__ __forceinline__ void scan_mlstm_item(const Ctx& c, int l, int b, int h) {
    LAS float* q_s = (LAS float*)c.lds;
    LAS float* k_s = q_s + TS * 64;
    LAS float* v_s = k_s + TS * 64;
    LAS float* part = v_s + TS * 128;
    LAS float* dpart = part + TS * 4 * 128;
    LAS float* lf_s = dpart + TS * 4;
    LAS float* ip_s = lf_s + TS;
    LAS float* m_s = ip_s + TS;
    LAS float* cw = m_s + TS;
    const bf16* PB = (const bf16*)(c.ws + WS_PB); const float* SM = (const float*)(c.ws + WS_SM);
    bf16* UC = (bf16*)(c.ws + WS_UC);
    const float* mn = c.in[IN_ML_NORM] + l * 512 + h * 128;
    if (c.tid < 4 * 128) { const int j = c.tid >> 7, cc = c.tid & 127; cw[c.tid] = c.in[IN_ML_CONV][(size_t)l * 4 * 512 + j * 512 + (cc < 64 ? h * 64 + cc : 256 + h * 64 + (cc - 64))]; }
    const float bi = c.in[IN_ML_BI][l * 4 + h], bfv = c.in[IN_ML_BF][l * 4 + h];
    const int v = c.tid & 127, kg = c.tid >> 7;
    float C[16], n[16]; float m = 0.f;
#pragma unroll
    for (int i = 0; i < 16; ++i) { C[i] = 0.f; n[i] = 0.f; }
    for (int t0 = 0; t0 < SEQ; t0 += TS) {
        __syncthreads();
        const size_t rb = (size_t)b * SEQ + t0;
        for (int i = c.tid; i < TS * 128; i += NTHR) { const int s = i >> 7, cc = i & 127;
            const int col = cc < 64 ? PB_QC + h * 64 + cc : PB_KC + h * 64 + (cc - 64);
            float x = 0.f;
#pragma unroll
            for (int j = 0; j < 4; ++j) { const int tt = t0 + s - 3 + j; if (tt >= 0) x += cw[j * 128 + cc] * bf2f(PB[((size_t)b * SEQ + tt) * NPB + col]); }
            x = siluf_(x);
            if (cc < 64) q_s[s * 64 + cc] = x * 0.125f; else k_s[s * 64 + (cc - 64)] = x; }
        for (int i = c.tid; i < TS * 128; i += NTHR) { const int s = i >> 7, cc = i & 127; v_s[i] = bf2f(PB[(rb + s) * NPB + PB_VC + h * 128 + cc]); }
        if (c.tid < TS) { ip_s[c.tid] = SM[(rb + c.tid) * 128 + SM_IC + h] + bi; lf_s[c.tid] = logsigmoidf_(SM[(rb + c.tid) * 128 + SM_FC + h] + bfv); }
        __syncthreads();
#pragma unroll 1
        for (int s = 0; s < TS; ++s) {
            const float lf = lf_s[s], ip = ip_s[s];
            const float mnew = fmaxf(lf + m, ip), fg = __expf(lf + m - mnew), ig = __expf(ip - mnew);
            m = mnew;
            const float vv = v_s[s * 128 + v] * ig; float num = 0.f, den = 0.f;
#pragma unroll
            for (int i4 = 0; i4 < 4; ++i4) {
                const f32x4 k4 = *(const LAS f32x4*)(k_s + s * 64 + kg * 16 + i4 * 4), q4 = *(const LAS f32x4*)(q_s + s * 64 + kg * 16 + i4 * 4);
#pragma unroll
                for (int j = 0; j < 4; ++j) { C[i4 * 4 + j] = fg * C[i4 * 4 + j] + k4[j] * vv; n[i4 * 4 + j] = fg * n[i4 * 4 + j] + ig * k4[j]; num += q4[j] * C[i4 * 4 + j]; den += q4[j] * n[i4 * 4 + j]; }
            }
            part[(s * 4 + kg) * 128 + v] = num;
            if (v == 0) dpart[s * 4 + kg] = den;
            if (c.tid == 0) m_s[s] = m;
        }
        __syncthreads();
        {
            const int s = c.tid >> 5, vq = c.tid & 31, v0 = vq * 4;
            f32x4 o = (f32x4){0.f, 0.f, 0.f, 0.f};
#pragma unroll
            for (int g = 0; g < 4; ++g) o += *(const LAS f32x4*)(part + (s * 4 + g) * 128 + v0);
            const float den = dpart[s * 4] + dpart[s * 4 + 1] + dpart[s * 4 + 2] + dpart[s * 4 + 3];
            const float dd = 1.f / fmaxf(fabsf(den), __expf(-m_s[s]));
            o = o * dd;
            float ss = o[0] * o[0] + o[1] * o[1] + o[2] * o[2] + o[3] * o[3];
#pragma unroll
            for (int mm = 1; mm < 32; mm <<= 1) ss += __shfl_xor(ss, mm);
            const float rstd = rsqrtf(ss * (1.f / 128.f) + EPS);
            const f32x4 oc = ld_bf4(PB + (rb + s) * NPB + PB_OC + h * 128 + v0);
            f32x4 r;
#pragma unroll
            for (int j = 0; j < 4; ++j) r[j] = o[j] * rstd * mn[v0 + j] * sigmoidf_(oc[j]);
            st_bf4(UC + (rb + s) * 512 + h * 128 + v0, r);
        }
    }
    __syncthreads();
}

constexpr int LQ = 72;
constexpr int SC_QT = 0, SC_KT = 9216, SC_KTT = 18432, SC_Q2 = 27648, SC_SC = 36864, SC_VT = 46080, SC_ST = 66816, SC_FL = 108288;
__device__ __forceinline__ float wave_scan_add(float x, int lane) {
#pragma unroll
    for (int d = 1; d < 64; d <<= 1) { const float y = __shfl_up(x, d); if (lane >= d) x += y; }
    return x;
}
__device__ __forceinline__ float wave_scan_max(float x, int lane) {
#pragma unroll
    for (int d = 1; d < 64; d <<= 1) { const float y = __shfl_up(x, d); if (lane >= d) x = fmaxf(x, y); }
    return x;
}
__device__ __forceinline__ void unpack8(u32x4 w, float (&f)[8]) { f[0] = bflo(w.x); f[1] = bfhi(w.x); f[2] = bflo(w.y); f[3] = bfhi(w.y); f[4] = bflo(w.z); f[5] = bfhi(w.z); f[6] = bflo(w.w); f[7] = bfhi(w.w); }
__device__ __forceinline__ u32x4 pack8(const float (&f)[8]) { u32x4 w; w.x = pk2(f[0], f[1]); w.y = pk2(f[2], f[3]); w.z = pk2(f[4], f[5]); w.w = pk2(f[6], f[7]); return w; }
template <bool ML>
__device__ __forceinline__ void scan_chunked_item(const Ctx& c, int l, int b, int h) {
    LAS bf16* Qt0 = (LAS bf16*)(c.lds + SC_QT); LAS bf16* Kt0 = (LAS bf16*)(c.lds + SC_KT); LAS bf16* KtT0 = (LAS bf16*)(c.lds + SC_KTT);
    LAS bf16* Q20 = (LAS bf16*)(c.lds + SC_Q2); LAS bf16* Sc0 = (LAS bf16*)(c.lds + SC_SC); LAS bf16* VT0 = (LAS bf16*)(c.lds + SC_VT);
    LAS bf16* ST0 = (LAS bf16*)(c.lds + SC_ST);
    LAS float* segtot = (LAS float*)(c.lds + SC_FL);
    LAS float* etot = segtot + 512;
    LAS float* ssq = etot + 64;
    LAS float* dn = ssq + 512;
    LAS float* wa2 = dn + 64;
    LAS float* ba = wa2 + 1024;
    LAS float* cw = ba + 64;
    const int tid = c.tid, lane = c.lane, w = c.wave, fr = lane & 15, fq = lane >> 4;
    const int srow = tid >> 3, kg = tid & 7, k8 = kg * 8, vrow = tid >> 4, vc8 = (tid & 15) * 8;
    const bf16* PB = (const bf16*)(c.ws + WS_PB); const float* SM = (const float*)(c.ws + WS_SM);
    bf16* UO = (bf16*)(c.ws + (ML ? WS_UC : WS_UA));
    const int QCOL = (ML ? PB_QC : PB_QA) + h * 64, KCOL = (ML ? PB_KC : PB_KA) + h * 64, VCOL = (ML ? PB_VC : PB_VA) + h * 128, GCOL = (ML ? PB_OC : PB_GA) + h * 128;
    const float* gnorm = c.in[ML ? IN_ML_NORM : IN_GLA_NORM] + l * 512 + h * 128;
    __syncthreads();
    if (!ML) { for (int i = tid; i < 1024; i += NTHR) wa2[i] = c.in[IN_GLA_WA2][(size_t)l * 16 * 256 + (i >> 6) * 256 + h * 64 + (i & 63)];
               if (tid < 64) ba[tid] = c.in[IN_GLA_BA][l * 256 + h * 64 + tid]; }
    else { if (tid < 512) { const int j = tid >> 7, cc = tid & 127; cw[tid] = c.in[IN_ML_CONV][(size_t)l * 4 * 512 + j * 512 + (cc < 64 ? h * 64 + cc : 256 + h * 64 + (cc - 64))]; } }
    for (int i = tid; i < 144 * LQ / 2; i += NTHR) ((LAS unsigned*)ST0)[i] = 0u;
    if (ML) { for (int i = tid; i < 16 * LQ; i += NTHR) VT0[128 * LQ + i] = (i < 64) ? (bf16)0x3f80u : (bf16)0u; }
    const float bi = ML ? c.in[IN_ML_BI][l * 4 + h] : 0.f, bfv = ML ? c.in[IN_ML_BF][l * 4 + h] : 0.f;
    float m_prev = 0.f;
    f32x4 Sacc[4], Nacc = (f32x4){0.f, 0.f, 0.f, 0.f};
#pragma unroll
    for (int i = 0; i < 4; ++i) Sacc[i] = (f32x4){0.f, 0.f, 0.f, 0.f};
    u32x4 rq[ML ? 4 : 1], rk[ML ? 4 : 1], rv[2]; f32x4 ra[4]; float ric = 0.f, rfc = 0.f;
    const u32x4 z4 = (u32x4){0u, 0u, 0u, 0u};
#define SC_LOAD(cch) do { const size_t _g = (size_t)b * SEQ + (size_t)(cch) * 64; \
        if (ML) { _Pragma("unroll") for (int _j = 0; _j < 4; ++_j) { const int _tt = (cch) * 64 + srow - 3 + _j; \
                rq[_j] = _tt >= 0 ? *(const u32x4*)(PB + ((size_t)b * SEQ + _tt) * NPB + QCOL + k8) : z4; rk[_j] = _tt >= 0 ? *(const u32x4*)(PB + ((size_t)b * SEQ + _tt) * NPB + KCOL + k8) : z4; } \
            ric = SM[(_g + lane) * 128 + SM_IC + h]; rfc = SM[(_g + lane) * 128 + SM_FC + h]; } \
        else { rq[0] = *(const u32x4*)(PB + (_g + srow) * NPB + QCOL + k8); rk[0] = *(const u32x4*)(PB + (_g + srow) * NPB + KCOL + k8); \
            _Pragma("unroll") for (int _j = 0; _j < 4; ++_j) ra[_j] = *(const f32x4*)(SM + (_g + srow) * 128 + SM_ALR + 4 * _j); } \
        rv[0] = *(const u32x4*)(PB + (_g + vrow) * NPB + VCOL + vc8); rv[1] = *(const u32x4*)(PB + (_g + 32 + vrow) * NPB + VCOL + vc8); } while (0)
    SC_LOAD(0);
    __syncthreads();
#pragma unroll 1
    for (int cch = 0; cch < SEQ / 64; ++cch) {
        const size_t grow = (size_t)b * SEQ + (size_t)cch * 64;
        int lz; asm volatile("v_mov_b32 %0, 0" : "=v"(lz));
        LAS bf16* Qt = Qt0 + lz; LAS bf16* Kt = Kt0 + lz; LAS bf16* KtT = KtT0 + lz; LAS bf16* Q2 = Q20 + lz; LAS bf16* Sc = Sc0 + lz; LAS bf16* VT = VT0 + lz; LAS bf16* ST = ST0 + lz;
        LAS bf16* STc = ST + (cch & 1) * 144 * LQ; LAS bf16* STn = ST + ((cch & 1) ^ 1) * 144 * LQ;
        float qv[8], kv[8];
        float g_a = 0.f, g_M = 0.f, g_bc = 0.f, M63 = 0.f, wc = 1.f;
        if (!ML) {
            unpack8(rq[0], qv); unpack8(rk[0], kv);
            float la[8];
#pragma unroll
            for (int i = 0; i < 8; ++i) la[i] = ba[k8 + i];
#pragma unroll
            for (int j4 = 0; j4 < 4; ++j4)
#pragma unroll
                for (int jj = 0; jj < 4; ++jj) { const float a = ra[j4][jj]; const LAS float* wr_ = wa2 + (j4 * 4 + jj) * 64 + k8;
                    const f32x4 w0 = *(const LAS f32x4*)wr_, w1 = *(const LAS f32x4*)(wr_ + 4);
                    la[0] += a * w0[0]; la[1] += a * w0[1]; la[2] += a * w0[2]; la[3] += a * w0[3]; la[4] += a * w1[0]; la[5] += a * w1[1]; la[6] += a * w1[2]; la[7] += a * w1[3]; }
#pragma unroll
            for (int i = 0; i < 8; ++i) { float x = logsigmoid_fast(la[i]) * (1.f / 16.f);
#pragma unroll
                for (int d = 8; d < 64; d <<= 1) { const float y = __shfl_up(x, d); if (lane >= d) x += y; }
                la[i] = x; }
            if ((lane >> 3) == 7) { *(LAS f32x4*)(segtot + w * 64 + k8) = (f32x4){la[0], la[1], la[2], la[3]}; *(LAS f32x4*)(segtot + w * 64 + k8 + 4) = (f32x4){la[4], la[5], la[6], la[7]}; }
            lds_barrier();
            float tot[8];
#pragma unroll
            for (int i = 0; i < 8; ++i) tot[i] = 0.f;
#pragma unroll
            for (int ww = 0; ww < 8; ++ww) { const f32x4 s0 = *(const LAS f32x4*)(segtot + ww * 64 + k8), s1 = *(const LAS f32x4*)(segtot + ww * 64 + k8 + 4);
                const float sel = ww < w ? 1.f : 0.f;
                la[0] += sel * s0[0]; la[1] += sel * s0[1]; la[2] += sel * s0[2]; la[3] += sel * s0[3]; la[4] += sel * s1[0]; la[5] += sel * s1[1]; la[6] += sel * s1[2]; la[7] += sel * s1[3];
                tot[0] += s0[0]; tot[1] += s0[1]; tot[2] += s0[2]; tot[3] += s0[3]; tot[4] += s1[0]; tot[5] += s1[1]; tot[6] += s1[2]; tot[7] += s1[3]; }
            if (tid < 8) {
#pragma unroll
                for (int i = 0; i < 8; ++i) etot[k8 + i] = __expf(tot[i]); }
            float kt[8];
#pragma unroll
            for (int i = 0; i < 8; ++i) { qv[i] = qv[i] * 0.125f * __expf(la[i]); kt[i] = kv[i] * __expf(-la[i]); }
            *(LAS u32x4*)(Qt + srow * LQ + k8) = pack8(qv); *(LAS u32x4*)(Kt + srow * LQ + k8) = pack8(kt);
#pragma unroll
            for (int i = 0; i < 8; ++i) KtT[(k8 + i) * LQ + srow] = (bf16)f2bf(kt[i]);
        } else {
            float x4[4][8];
#pragma unroll
            for (int j = 0; j < 4; ++j) unpack8(rq[j], x4[j]);
#pragma unroll
            for (int i = 0; i < 8; ++i) { float x = 0.f;
#pragma unroll
                for (int j = 0; j < 4; ++j) x += cw[j * 128 + k8 + i] * x4[j][i];
                qv[i] = siluf_(x) * 0.125f; }
#pragma unroll
            for (int j = 0; j < 4; ++j) unpack8(rk[j], x4[j]);
#pragma unroll
            for (int i = 0; i < 8; ++i) { float x = 0.f;
#pragma unroll
                for (int j = 0; j < 4; ++j) x += cw[j * 128 + 64 + k8 + i] * x4[j][i];
                kv[i] = siluf_(x); }
            const float lf = logsigmoid_fast(rfc + bfv), ip = ric + bi;
            g_bc = wave_scan_add(lf, lane); g_a = ip - g_bc;
            const float pm = wave_scan_max(g_a, lane); g_M = fmaxf(m_prev, pm);
            M63 = __shfl(g_M, 63); const float totb = __shfl(g_bc, 63);
            wc = __expf(m_prev - M63);
            const float Ms = __shfl(g_M, srow), as = __shfl(g_a, srow);
            const float e1 = __expf(m_prev - Ms), e2 = __expf(as - M63);
            float q2[8], kw[8];
#pragma unroll
            for (int i = 0; i < 8; ++i) { q2[i] = qv[i] * e1; kw[i] = kv[i] * e2; }
            *(LAS u32x4*)(Qt + srow * LQ + k8) = pack8(qv); *(LAS u32x4*)(Kt + srow * LQ + k8) = pack8(kv); *(LAS u32x4*)(Q2 + srow * LQ + k8) = pack8(q2);
#pragma unroll
            for (int i = 0; i < 8; ++i) KtT[(k8 + i) * LQ + srow] = (bf16)f2bf(kw[i]);
            m_prev = totb + M63;
        }
        { float v0[8], v1[8]; unpack8(rv[0], v0); unpack8(rv[1], v1);
#pragma unroll
          for (int i = 0; i < 8; ++i) { VT[(vc8 + i) * LQ + vrow] = (bf16)f2bf(v0[i]); VT[(vc8 + i) * LQ + 32 + vrow] = (bf16)f2bf(v1[i]); } }
        u32x2 gate[4];
#pragma unroll
        for (int ti = 0; ti < 4; ++ti) gate[ti] = *(const u32x2*)(PB + (grow + 16 * ti + fr) * NPB + GCOL + 16 * w + 4 * fq);
        if (cch + 1 < SEQ / 64) SC_LOAD(cch + 1);
        lds_barrier();
        {
            const int ti = w >> 1;
#pragma unroll
            for (int u = 0; u < 2; ++u) {
                const int sj = 2 * (w & 1) + u;
                f32x4 d = (f32x4){0.f, 0.f, 0.f, 0.f};
                if (sj <= ti) {
#pragma unroll
                    for (int ks = 0; ks < 2; ++ks) { const bf16x8 a = *(const LAS bf16x8*)(Kt + (16 * sj + fr) * LQ + 32 * ks + 8 * fq), bb = *(const LAS bf16x8*)(Qt + (16 * ti + fr) * LQ + 32 * ks + 8 * fq);
                        d = __builtin_amdgcn_mfma_f32_16x16x32_bf16(a, bb, d, 0, 0, 0); }
                    const int t = 16 * ti + fr, s0 = 16 * sj + 4 * fq;
                    if (ML) { const float Mt = __shfl(g_M, t);
#pragma unroll
                        for (int r = 0; r < 4; ++r) { const float as = __shfl(g_a, s0 + r); d[r] = (s0 + r <= t) ? d[r] * __expf(as - Mt) : 0.f; } }
                    else {
#pragma unroll
                        for (int r = 0; r < 4; ++r) d[r] = (s0 + r <= t) ? d[r] : 0.f; }
                }
                { u32x2 pk; pk.x = pk2(d[0], d[1]); pk.y = pk2(d[2], d[3]); *(LAS u32x2*)(Sc + (16 * ti + fr) * LQ + 16 * sj + 4 * fq) = pk; }
            }
        }
        lds_barrier();
        const LAS bf16* Qm = ML ? Q2 : Qt;
        f32x4 o[4];
        {
            bf16x8 vt[2], stf[2];
#pragma unroll
            for (int ks = 0; ks < 2; ++ks) { vt[ks] = *(const LAS bf16x8*)(VT + (16 * w + fr) * LQ + 32 * ks + 8 * fq); stf[ks] = *(const LAS bf16x8*)(STc + (16 * w + fr) * LQ + 32 * ks + 8 * fq); }
#pragma unroll
            for (int ti = 0; ti < 4; ++ti) {
                f32x4 d = (f32x4){0.f, 0.f, 0.f, 0.f};
#pragma unroll
                for (int ks = 0; ks < 2; ++ks) { const bf16x8 sc = *(const LAS bf16x8*)(Sc + (16 * ti + fr) * LQ + 32 * ks + 8 * fq); d = __builtin_amdgcn_mfma_f32_16x16x32_bf16(vt[ks], sc, d, 0, 0, 0); }
#pragma unroll
                for (int ks = 0; ks < 2; ++ks) { const bf16x8 qq = *(const LAS bf16x8*)(Qm + (16 * ti + fr) * LQ + 32 * ks + 8 * fq); d = __builtin_amdgcn_mfma_f32_16x16x32_bf16(stf[ks], qq, d, 0, 0, 0); }
                o[ti] = d;
            }
#pragma unroll
            for (int kj = 0; kj < 4; ++kj) {
                f32x4 d = (f32x4){0.f, 0.f, 0.f, 0.f};
#pragma unroll
                for (int ks = 0; ks < 2; ++ks) { const bf16x8 kk = *(const LAS bf16x8*)(KtT + (16 * kj + fr) * LQ + 32 * ks + 8 * fq); d = __builtin_amdgcn_mfma_f32_16x16x32_bf16(kk, vt[ks], d, 0, 0, 0); }
                if (ML) Sacc[kj] = Sacc[kj] * wc + d;
                else { const f32x4 e4 = *(const LAS f32x4*)(etot + 16 * kj + 4 * fq); Sacc[kj] = e4 * (Sacc[kj] + d); }
                u32x2 pk; pk.x = pk2(Sacc[kj][0], Sacc[kj][1]); pk.y = pk2(Sacc[kj][2], Sacc[kj][3]);
                *(LAS u32x2*)(STn + (16 * w + fr) * LQ + 16 * kj + 4 * fq) = pk;
            }
            if (ML) {
                if (w < 4) {
                    f32x4 d = (f32x4){0.f, 0.f, 0.f, 0.f};
#pragma unroll
                    for (int ks = 0; ks < 2; ++ks) { const bf16x8 a = *(const LAS bf16x8*)(VT + (128 + fr) * LQ + 32 * ks + 8 * fq), sc = *(const LAS bf16x8*)(Sc + (16 * w + fr) * LQ + 32 * ks + 8 * fq);
                        d = __builtin_amdgcn_mfma_f32_16x16x32_bf16(a, sc, d, 0, 0, 0); }
#pragma unroll
                    for (int ks = 0; ks < 2; ++ks) { const bf16x8 a = *(const LAS bf16x8*)(STc + (128 + fr) * LQ + 32 * ks + 8 * fq), qq = *(const LAS bf16x8*)(Qm + (16 * w + fr) * LQ + 32 * ks + 8 * fq);
                        d = __builtin_amdgcn_mfma_f32_16x16x32_bf16(a, qq, d, 0, 0, 0); }
                    if (fq == 0) dn[16 * w + fr] = d[0];
                } else {
                    const int kj = w - 4;
                    f32x4 d = (f32x4){0.f, 0.f, 0.f, 0.f};
#pragma unroll
                    for (int ks = 0; ks < 2; ++ks) { const bf16x8 kk = *(const LAS bf16x8*)(KtT + (16 * kj + fr) * LQ + 32 * ks + 8 * fq), a = *(const LAS bf16x8*)(VT + (128 + fr) * LQ + 32 * ks + 8 * fq);
                        d = __builtin_amdgcn_mfma_f32_16x16x32_bf16(kk, a, d, 0, 0, 0); }
                    Nacc = Nacc * wc + d;
                    u32x2 pk; pk.x = pk2(Nacc[0], Nacc[1]); pk.y = pk2(Nacc[2], Nacc[3]);
                    *(LAS u32x2*)(STn + (128 + fr) * LQ + 16 * kj + 4 * fq) = pk;
                }
            }
        }
#pragma unroll
        for (int ti = 0; ti < 4; ++ti) { float p = o[ti][0] * o[ti][0] + o[ti][1] * o[ti][1] + o[ti][2] * o[ti][2] + o[ti][3] * o[ti][3];
            p += __shfl_xor(p, 16); p += __shfl_xor(p, 32);
            if (fq == 0) ssq[w * 64 + 16 * ti + fr] = p; }
        lds_barrier();
#pragma unroll
        for (int ti = 0; ti < 4; ++ti) {
            const int t = 16 * ti + fr;
            float ss = 0.f;
#pragma unroll
            for (int ww = 0; ww < 8; ++ww) ss += ssq[ww * 64 + t];
            float dd = 1.f;
            if (ML) { const float bc = __shfl(g_bc, t), Mt = __shfl(g_M, t); dd = 1.f / fmaxf(fabsf(dn[t]), __expf(-(bc + Mt))); }
            const float rstd = rsqrtf(ss * dd * dd * (1.f / 128.f) + EPS) * dd;
            const f32x4 gn = *(const f32x4*)(gnorm + 16 * w + 4 * fq);
            const float g0 = bflo(gate[ti].x), g1 = bfhi(gate[ti].x), g2 = bflo(gate[ti].y), g3 = bfhi(gate[ti].y);
            f32x4 r;
            if (ML) { r[0] = o[ti][0] * rstd * gn[0] * sigmoidf_(g0); r[1] = o[ti][1] * rstd * gn[1] * sigmoidf_(g1); r[2] = o[ti][2] * rstd * gn[2] * sigmoidf_(g2); r[3] = o[ti][3] * rstd * gn[3] * sigmoidf_(g3); }
            else { r[0] = o[ti][0] * rstd * gn[0] * siluf_(g0); r[1] = o[ti][1] * rstd * gn[1] * siluf_(g1); r[2] = o[ti][2] * rstd * gn[2] * siluf_(g2); r[3] = o[ti][3] * rstd * gn[3] * siluf_(g3); }
            st_bf4(UO + (grow + t) * 512 + h * 128 + 16 * w + 4 * fq, r);
        }
    }
#undef SC_LOAD
    __syncthreads();
}
__device__ __forceinline__ void phase_scans(const Ctx& c, int l) {
    for (int it = c.bid; it < 128; it += c.nblk) {
#if SCAN_RECURRENT
        if (it < 64) scan_gla_item(c, l, it >> 2, it & 3);
        else scan_mlstm_item(c, l, (it - 64) >> 2, (it - 64) & 3);
#else
        if (it < 64) scan_chunked_item<false>(c, l, it >> 2, it & 3);
        else scan_chunked_item<true>(c, l, (it - 64) >> 2, (it - 64) & 3);
#endif
    }
}

__device__ __forceinline__ unsigned ord_key(float f) { const unsigned u = __builtin_bit_cast(unsigned, f); return (u & 0x80000000u) ? ~u : (u | 0x80000000u); }
__device__ __forceinline__ void phase_dsa(const Ctx& c, int l) {
    LAS unsigned char* wl = c.lds + c.wave * 14336;
    LAS float* I_s = (LAS float*)wl;
    LAS int* list = (LAS int*)(wl + 8192);
    LAS float* qi_s = (LAS float*)(wl + 9216);
    LAS float* ql_s = (LAS float*)(wl + 10240);
    const bf16* QLAT = (const bf16*)(c.ws + WS_QLAT); const bf16* QIDX = (const bf16*)(c.ws + WS_QIDX);
    const bf16* CKVN = (const bf16*)(c.ws + WS_CKVN); const float* SM = (const float*)(c.ws + WS_SM);
    bf16* OLAT = (bf16*)(c.ws + WS_OLAT);
    const int gw = c.bid * NWAVES + c.wave, NGW = c.nblk * NWAVES, lane = c.lane;
    for (int tq = gw; tq < T; tq += NGW) {
        const int b = tq >> 11, pos = tq & 2047, nvalid = pos + 1;
        const size_t kb = (size_t)b * SEQ;
        { const f32x4 q = ld_bf4(QIDX + (size_t)tq * 256 + 4 * lane); *(LAS f32x4*)(qi_s + 4 * lane) = q;
#pragma unroll
          for (int j = 0; j < 4; ++j) { const f32x4 ql = ld_bf4(QLAT + (size_t)tq * 1024 + 4 * (lane + 64 * j)); *(LAS f32x4*)(ql_s + 4 * (lane + 64 * j)) = ql; } }
        float wh[8];
#pragma unroll
        for (int hh = 0; hh < 8; ++hh) wh[hh] = SM[(size_t)tq * 128 + SM_WIDX + hh] * 0.35355339059327373f;
        asm volatile("s_waitcnt lgkmcnt(0)" ::: "memory");
        int nsel;
        if (nvalid <= DSA_K) {
            for (int i = lane; i < DSA_K; i += 64) list[i] = i;
            nsel = nvalid;
        } else {
            const int nj = (nvalid + 63) >> 6;
            for (int j = 0; j < nj; ++j) {
                const int s = lane + 64 * j;
                float val = -INFINITY;
                if (s < nvalid) {
                    const float* kr = SM + (kb + s) * 128 + SM_KIDX;
                    f32x4 kk[8];
#pragma unroll
                    for (int i = 0; i < 8; ++i) kk[i] = *(const f32x4*)(kr + 4 * i);
                    val = 0.f;
#pragma unroll
                    for (int hh = 0; hh < 8; ++hh) { float d = 0.f;
#pragma unroll
                        for (int i = 0; i < 8; ++i) { const f32x4 q = *(const LAS f32x4*)(qi_s + hh * 32 + 4 * i); d += q[0] * kk[i][0] + q[1] * kk[i][1] + q[2] * kk[i][2] + q[3] * kk[i][3]; }
                        val += wh[hh] * fmaxf(d, 0.f); }
                }
                I_s[s] = val;
            }
            for (int j = nj; j < 32; ++j) I_s[lane + 64 * j] = -INFINITY;
            asm volatile("s_waitcnt lgkmcnt(0)" ::: "memory");
            LAS unsigned* K_s = (LAS unsigned*)I_s;
#pragma unroll 4
            for (int j = 0; j < 32; ++j) K_s[lane + 64 * j] = ord_key(I_s[lane + 64 * j]);
            unsigned thr = 0u;
#pragma unroll 1
            for (int bit = 31; bit >= 0; --bit) {
                const unsigned cand = thr | (1u << bit); int cnt = 0;
#pragma unroll 8
                for (int j = 0; j < 32; ++j) cnt += (K_s[lane + 64 * j] >= cand) ? 1 : 0;
                cnt = wave_sum_i(cnt);
                if (cnt >= DSA_K) thr = cand;
            }
            int cgt = 0;
#pragma unroll 8
            for (int j = 0; j < 32; ++j) cgt += (K_s[lane + 64 * j] > thr) ? 1 : 0;
            cgt = wave_sum_i(cgt);
            int need = DSA_K - cgt, base = 0;
            const unsigned long long lt = (1ull << lane) - 1ull;
#pragma unroll 2
            for (int j = 0; j < 32; ++j) {
                const unsigned kj = K_s[lane + 64 * j];
                const bool gt = kj > thr, eq = kj == thr;
                const unsigned long long meq = __ballot(eq);
                const int rk = __popcll(meq & lt);
                const bool sel = gt || (eq && rk < need);
                need -= __popcll(meq); if (need < 0) need = 0;
                const unsigned long long ms = __ballot(sel);
                if (sel) list[base + __popcll(ms & lt)] = lane + 64 * j;
                base += __popcll(ms);
            }
            nsel = DSA_K;
        }
        asm volatile("s_waitcnt lgkmcnt(0)" ::: "memory");
        int ks[4]; float lg[4][8];
#pragma unroll
        for (int i = 0; i < 4; ++i) { const int li = lane + 64 * i; ks[i] = (li < nsel) ? list[li] : 0;
#pragma unroll
            for (int hh = 0; hh < 8; ++hh) lg[i][hh] = 0.f; }
#pragma unroll 1
        for (int ch = 0; ch < 16; ++ch) {
            f32x4 ka[4], kc[4];
#pragma unroll
            for (int i = 0; i < 4; ++i) { const u32x4 w = *(const u32x4*)(CKVN + (kb + ks[i]) * 128 + ch * 8);
                ka[i] = (f32x4){bflo(w.x), bfhi(w.x), bflo(w.y), bfhi(w.y)}; kc[i] = (f32x4){bflo(w.z), bfhi(w.z), bflo(w.w), bfhi(w.w)}; }
#pragma unroll
            for (int hh = 0; hh < 8; ++hh) { const f32x4 qa = *(const LAS f32x4*)(ql_s + hh * 128 + ch * 8), qb = *(const LAS f32x4*)(ql_s + hh * 128 + ch * 8 + 4);
#pragma unroll
                for (int i = 0; i < 4; ++i) lg[i][hh] += qa[0] * ka[i][0] + qa[1] * ka[i][1] + qa[2] * ka[i][2] + qa[3] * ka[i][3] + qb[0] * kc[i][0] + qb[1] * kc[i][1] + qb[2] * kc[i][2] + qb[3] * kc[i][3]; }
        }
#pragma unroll
        for (int hh = 0; hh < 8; ++hh) {
            const float slope = exp2f(-(float)(hh + 1));
            float mx = -INFINITY;
#pragma unroll
            for (int i = 0; i < 4; ++i) { const bool ok = (lane + 64 * i) < nsel; lg[i][hh] = ok ? lg[i][hh] - slope * (float)(pos - ks[i]) : -INFINITY; mx = fmaxf(mx, lg[i][hh]); }
            mx = wave_max(mx);
            float sm = 0.f;
#pragma unroll
            for (int i = 0; i < 4; ++i) { lg[i][hh] = __expf(lg[i][hh] - mx); sm += lg[i][hh]; }
            sm = wave_sum(sm);
            const float inv = 1.f / sm;
#pragma unroll
            for (int i = 0; i < 4; ++i) lg[i][hh] *= inv;
        }
#pragma unroll
        for (int i = 0; i < 4; ++i) { const int li = lane + 64 * i;
            *(LAS f32x4*)(I_s + li * 8) = (f32x4){lg[i][0], lg[i][1], lg[i][2], lg[i][3]}; *(LAS f32x4*)(I_s + li * 8 + 4) = (f32x4){lg[i][4], lg[i][5], lg[i][6], lg[i][7]}; }
        asm volatile("s_waitcnt lgkmcnt(0)" ::: "memory");
        float o0[8], o1[8];
#pragma unroll
        for (int hh = 0; hh < 8; ++hh) { o0[hh] = 0.f; o1[hh] = 0.f; }
#pragma unroll 2
        for (int kidx = 0; kidx < nsel; ++kidx) {
            const int s = list[kidx];
            const unsigned w = *(const unsigned*)(CKVN + (kb + s) * 128 + 2 * lane);
            const float v0 = bflo(w), v1 = bfhi(w);
            const f32x4 pa = *(const LAS f32x4*)(I_s + kidx * 8), pb = *(const LAS f32x4*)(I_s + kidx * 8 + 4);
            o0[0] += pa[0] * v0; o1[0] += pa[0] * v1; o0[1] += pa[1] * v0; o1[1] += pa[1] * v1; o0[2] += pa[2] * v0; o1[2] += pa[2] * v1; o0[3] += pa[3] * v0; o1[3] += pa[3] * v1;
            o0[4] += pb[0] * v0; o1[4] += pb[0] * v1; o0[5] += pb[1] * v0; o1[5] += pb[1] * v1; o0[6] += pb[2] * v0; o1[6] += pb[2] * v1; o0[7] += pb[3] * v0; o1[7] += pb[3] * v1;
        }
#pragma unroll
        for (int hh = 0; hh < 8; ++hh) *(unsigned*)(OLAT + (size_t)tq * 1024 + hh * 128 + 2 * lane) = pk2(o0[hh], o1[hh]);
        asm volatile("s_waitcnt lgkmcnt(0)" ::: "memory");
    }
}


typedef float f32x16 __attribute__((ext_vector_type(16)));
__device__ __forceinline__ void phase_dsa_sel(const Ctx& c, int l) {
    const bf16* QIDX = (const bf16*)(c.ws + WS_QIDX); const bf16* KIDX = (const bf16*)(c.ws + WS_KIDX); const float* SM = (const float*)(c.ws + WS_SM);
    unsigned* MASK = (unsigned*)(c.ws + WS_MASK);
    const int lane = c.lane, hf = lane >> 5, l31 = lane & 31;
    const int rho = l31, tl = 2 * ((rho >> 2) & 1) + (rho >> 4), hd = (rho & 3) + 4 * ((rho >> 3) & 1);
    const unsigned ltmask = (1u << l31) - 1u;
    LAS unsigned* KL = (LAS unsigned*)(c.lds + c.wave * 16384);
    LAS unsigned* MW = (LAS unsigned*)(c.lds + 131072 + c.wave * 512);
    const int npass = (c.nblk == 256) ? 2 : (T / 64 + c.nblk - 1) / c.nblk;
#pragma unroll 1
    for (int ps = 0; ps < npass; ++ps) {
        int b, q64;
        if (c.nblk == 256) { b = c.bid & 15; q64 = ps == 0 ? 31 - (c.bid >> 4) : (c.bid >> 4); }
        else { const int it = c.bid + ps * c.nblk; if (it >= T / 64) break; b = it >> 5; q64 = it & 31; }
        const int pb = q64 * 64;
#pragma unroll 1
        for (int wi = 0; wi < 2; ++wi) {
        const int pos0 = pb + 8 * c.wave + 4 * wi, t0 = b * SEQ + pos0;
        unsigned wA0 = 0u, wB0 = 0u, wA1 = 0u, wB1 = 0u;
        if (pos0 + 3 < DSA_K) {
            const int p_0 = pos0 + 2 * hf, p_1 = p_0 + 1;
            { const int lo = 32 * l31; wA0 = p_0 >= lo + 31 ? 0xffffffffu : (p_0 < lo ? 0u : ((2u << (p_0 - lo)) - 1u)); wA1 = p_1 >= lo + 31 ? 0xffffffffu : (p_1 < lo ? 0u : ((2u << (p_1 - lo)) - 1u)); }
        } else {
            const int ng = ((pos0 + 3) / 32 + 4) / 4, nkt = 4 * ng;
            bf16x8 af[2];
#pragma unroll
            for (int ks = 0; ks < 2; ++ks) af[ks] = *(const bf16x8*)(QIDX + (size_t)(t0 + tl) * 256 + hd * 32 + 16 * ks + 8 * hf);
            const bf16* kbase = KIDX + ((size_t)b * SEQ + l31) * 32 + 8 * hf;
#pragma unroll 1
            for (int tsel = 0; tsel < 2; ++tsel) {
                float whv[8];
#pragma unroll
                for (int r = 0; r < 8; ++r) whv[r] = SM[(size_t)(t0 + 2 * hf + tsel) * 128 + SM_WIDX + r] * 0.35355339059327373f;
                const int p_t = pos0 + 2 * hf + tsel;
                bf16x8 bq[4][2], bn[4][2];
#pragma unroll
                for (int j = 0; j < 4; ++j) { bq[j][0] = *(const bf16x8*)(kbase + (size_t)(32 * j) * 32); bq[j][1] = *(const bf16x8*)(kbase + (size_t)(32 * j) * 32 + 16); }
#pragma unroll 1
                for (int g = 0; g < ng; ++g) {
                    const int gn = (g + 1 < ng) ? g + 1 : g;
#pragma unroll
                    for (int j = 0; j < 4; ++j) { bn[j][0] = *(const bf16x8*)(kbase + (size_t)(32 * (4 * gn + j)) * 32); bn[j][1] = *(const bf16x8*)(kbase + (size_t)(32 * (4 * gn + j)) * 32 + 16); }
#pragma unroll
                    for (int j = 0; j < 4; ++j) {
                        f32x16 d;
#pragma unroll
                        for (int r = 0; r < 16; ++r) d[r] = 0.f;
                        d = __builtin_amdgcn_mfma_f32_32x32x16_bf16(af[0], bq[j][0], d, 0, 0, 0);
                        d = __builtin_amdgcn_mfma_f32_32x32x16_bf16(af[1], bq[j][1], d, 0, 0, 0);
                        float iv = 0.f;
                        if (tsel == 0) {
#pragma unroll
                            for (int r = 0; r < 8; ++r) iv += whv[r] * fmaxf(d[r], 0.f);
                        } else {
#pragma unroll
                            for (int r = 0; r < 8; ++r) iv += whv[r] * fmaxf(d[8 + r], 0.f);
                        }
                        const int kt = 4 * g + j, row = 32 * kt + l31;
                        KL[kt * 64 + lane] = row <= p_t ? ord_key(iv) : 0u;
                    }
#pragma unroll
                    for (int j = 0; j < 4; ++j) { bq[j][0] = bn[j][0]; bq[j][1] = bn[j][1]; }
                }
                unsigned thr = 0u; bool dlo = false, dhi = false;
#pragma unroll 1
                for (int bit = 31; bit >= 0 && !(dlo && dhi); --bit) {
                    const unsigned cand = thr | (1u << bit); int clo = 0, chi = 0;
#pragma unroll 16
                    for (int kt = 0; kt < nkt; ++kt) { const unsigned long long m = __ballot(KL[kt * 64 + lane] >= cand); clo += __popc((unsigned)m); chi += __popc((unsigned)(m >> 32)); }
                    const bool tlo = !dlo && clo >= DSA_K, thi = !dhi && chi >= DSA_K;
                    if (hf ? thi : tlo) thr = cand;
                    dlo = dlo || clo == DSA_K; dhi = dhi || chi == DSA_K;
                }
                int glo = 0, ghi = 0;
#pragma unroll 16
                for (int kt = 0; kt < nkt; ++kt) { const unsigned long long m = __ballot(KL[kt * 64 + lane] > thr); glo += __popc((unsigned)m); ghi += __popc((unsigned)(m >> 32)); }
                int nlo = DSA_K - glo, nhi = DSA_K - ghi;
                MW[lane] = 0u; MW[64 + lane] = 0u;
#pragma unroll 2
                for (int kt = 0; kt < nkt; ++kt) {
                    const unsigned kv = KL[kt * 64 + lane];
                    const bool gt = kv > thr, eq = kv == thr;
                    const unsigned long long meq = __ballot(eq); const unsigned mh = hf ? (unsigned)(meq >> 32) : (unsigned)meq;
                    const int need = hf ? nhi : nlo;
                    const bool sel = gt || (eq && (__popc(mh & ltmask) < need));
                    nlo -= __popc((unsigned)meq); nhi -= __popc((unsigned)(meq >> 32)); nlo = nlo < 0 ? 0 : nlo; nhi = nhi < 0 ? 0 : nhi;
                    const unsigned long long ms = __ballot(sel);
                    if (l31 == 0) MW[hf * 64 + kt] = hf ? (unsigned)(ms >> 32) : (unsigned)ms;
                }
                const unsigned wA = MW[hf * 64 + l31], wB = MW[hf * 64 + 32 + l31];
                if (tsel == 0) { wA0 = wA; wB0 = wB; } else { wA1 = wA; wB1 = wB; }
            }
        }
        unsigned* m0 = MASK + (size_t)(t0 + 2 * hf) * 64;
        m0[l31] = wA0; m0[32 + l31] = wB0; m0[64 + l31] = wA1; m0[96 + l31] = wB1;
        }
    }
    __syncthreads();
}

constexpr int AT_KN_LD = 136, AT_KT_LD = 72;
constexpr int AT_KN_BYTES = 64 * AT_KN_LD * 2, AT_KT_BYTES = 128 * AT_KT_LD * 2, AT_STAGE = AT_KN_BYTES + AT_KT_BYTES;
__device__ __forceinline__ void phase_dsa_att(const Ctx& c, int l) {
    const bf16* QLAT = (const bf16*)(c.ws + WS_QLAT); const bf16* CKVN = (const bf16*)(c.ws + WS_CKVN); const bf16* CKVT = (const bf16*)(c.ws + WS_CKVT);
    const unsigned* MASK = (const unsigned*)(c.ws + WS_MASK); bf16* OLAT = (bf16*)(c.ws + WS_OLAT);
    const int tid = c.tid, lane = c.lane, h = c.wave, fr = lane & 15, fq = lane >> 4;
    const float slope = exp2f(-(float)(h + 1));
    const float L2E = 1.4426950408889634f;
    const int knr = tid >> 3, knc = (tid & 7) * 8;
    const int ktr = tid >> 2, ktc = (tid & 3) * 16;
#pragma unroll 1
    for (int k4 = 0; k4 < 1024; ++k4) {
        const int idx = c.bid + c.nblk * k4; if (idx >= 1024) break;
        const int b = idx & 15, g = idx >> 4, gk = g >> 4, gi = g & 15;
        const int qt = 63 - 16 * gk - ((gk & 1) ? (15 - gi) : gi);
        const int tq0 = qt * 32;
        const size_t tg0 = (size_t)b * SEQ + tq0;
        const int nkt = (tq0 + 31) / 64 + 1;
        bf16x8 Qf[2][4];
#pragma unroll
        for (int rt = 0; rt < 2; ++rt)
#pragma unroll
            for (int ks = 0; ks < 4; ++ks) Qf[rt][ks] = *(const bf16x8*)(QLAT + (tg0 + 16 * rt + fr) * 1024 + h * 128 + 32 * ks + 8 * fq);
        f32x4 O[2][8];
        float mrun[2], lrun[2];
#pragma unroll
        for (int rt = 0; rt < 2; ++rt) { mrun[rt] = -1e30f; lrun[rt] = 0.f;
#pragma unroll
            for (int n = 0; n < 8; ++n) O[rt][n] = (f32x4){0.f, 0.f, 0.f, 0.f}; }
        u32x4 pn0, pn1, pt0, pt1;
#define AT_LOAD(kt) do { const size_t _kb = (size_t)b * SEQ + 64 * (kt); \
            pn0 = *(const u32x4*)(CKVN + (_kb + knr) * 128 + knc); pn1 = *(const u32x4*)(CKVN + (_kb + knr) * 128 + 64 + knc); \
            pt0 = *(const u32x4*)(CKVT + ((size_t)b * 128 + ktr) * 2048 + 64 * (kt) + ktc); pt1 = *(const u32x4*)(CKVT + ((size_t)b * 128 + ktr) * 2048 + 64 * (kt) + ktc + 8); } while (0)
        AT_LOAD(0);
#pragma unroll 1
        for (int kt = 0; kt < nkt; ++kt) {
            int lz; asm volatile("v_mov_b32 %0, 0" : "=v"(lz));
            LAS bf16* Kn = (LAS bf16*)(c.lds + (kt & 1) * AT_STAGE) + lz; LAS bf16* KT = (LAS bf16*)(c.lds + (kt & 1) * AT_STAGE + AT_KN_BYTES) + lz;
            *(LAS u32x4*)(Kn + knr * AT_KN_LD + knc) = pn0; *(LAS u32x4*)(Kn + knr * AT_KN_LD + 64 + knc) = pn1;
            *(LAS u32x4*)(KT + ktr * AT_KT_LD + ktc) = pt0; *(LAS u32x4*)(KT + ktr * AT_KT_LD + ktc + 8) = pt1;
            u32x2 mw[2];
#pragma unroll
            for (int rt = 0; rt < 2; ++rt) mw[rt] = *(const u32x2*)(MASK + (tg0 + 16 * rt + fr) * 64 + 2 * kt);
            if (kt + 1 < nkt) AT_LOAD(kt + 1);
            lds_barrier();
#pragma unroll
            for (int rt = 0; rt < 2; ++rt) {
                f32x4 S[4];
#pragma unroll
                for (int j = 0; j < 4; ++j) {
                    f32x4 d = (f32x4){0.f, 0.f, 0.f, 0.f};
#pragma unroll
                    for (int ks = 0; ks < 4; ++ks) { const bf16x8 kf = *(const LAS bf16x8*)(Kn + (16 * j + fr) * AT_KN_LD + 32 * ks + 8 * fq); d = __builtin_amdgcn_mfma_f32_16x16x32_bf16(kf, Qf[rt][ks], d, 0, 0, 0); }
                    S[j] = d;
                    __builtin_amdgcn_sched_barrier(0);
                }
                const int tpos = tq0 + 16 * rt + fr;
                const float base = -slope * (float)(tpos - 64 * kt - 4 * fq);
                float mx = -1e30f;
#pragma unroll
                for (int j = 0; j < 4; ++j) { const unsigned wsel = (j < 2) ? mw[rt].x : mw[rt].y; const int sh = 16 * (j & 1) + 4 * fq;
#pragma unroll
                    for (int r = 0; r < 4; ++r) { const bool on = (wsel >> (sh + r)) & 1u;
                        const float v = S[j][r] + base + slope * (float)(16 * j + r);
                        S[j][r] = on ? v : -INFINITY; mx = fmaxf(mx, S[j][r]); } }
                mx = fmaxf(mx, __shfl_xor(mx, 16)); mx = fmaxf(mx, __shfl_xor(mx, 32));
                const float mnew = fmaxf(mrun[rt], mx);
                const float alpha = exp2f((mrun[rt] - mnew) * L2E);
                float rs = 0.f;
#pragma unroll
                for (int j = 0; j < 4; ++j)
#pragma unroll
                    for (int r = 0; r < 4; ++r) { const float p = exp2f((S[j][r] - mnew) * L2E); S[j][r] = p; rs += p; }
                rs += __shfl_xor(rs, 16); rs += __shfl_xor(rs, 32);
                lrun[rt] = lrun[rt] * alpha + rs; mrun[rt] = mnew;
#pragma unroll
                for (int n = 0; n < 8; ++n) O[rt][n] *= alpha;
                bf16x8 Pf[2];
#pragma unroll
                for (int ks2 = 0; ks2 < 2; ++ks2) { u32x4 w; w.x = pk2(S[2 * ks2][0], S[2 * ks2][1]); w.y = pk2(S[2 * ks2][2], S[2 * ks2][3]);
                    w.z = pk2(S[2 * ks2 + 1][0], S[2 * ks2 + 1][1]); w.w = pk2(S[2 * ks2 + 1][2], S[2 * ks2 + 1][3]);
                    Pf[ks2] = __builtin_bit_cast(bf16x8, w); }
#pragma unroll
                for (int n = 0; n < 8; ++n)
#pragma unroll
                    for (int ks2 = 0; ks2 < 2; ++ks2) {
                        const u32x2 a0 = *(const LAS u32x2*)(KT + (16 * n + fr) * AT_KT_LD + 32 * ks2 + 4 * fq), a1 = *(const LAS u32x2*)(KT + (16 * n + fr) * AT_KT_LD + 32 * ks2 + 16 + 4 * fq);
                        const bf16x8 af = __builtin_bit_cast(bf16x8, (u32x4){a0.x, a0.y, a1.x, a1.y});
                        O[rt][n] = __builtin_amdgcn_mfma_f32_16x16x32_bf16(af, Pf[ks2], O[rt][n], 0, 0, 0);
                        if (ks2 == 1 && (n & 1)) __builtin_amdgcn_sched_barrier(0);
                    }
            }
        }
#undef AT_LOAD
#pragma unroll
        for (int rt = 0; rt < 2; ++rt) { const float inv = 1.f / lrun[rt];
#pragma unroll
            for (int n = 0; n < 8; ++n) st_bf4(OLAT + (tg0 + 16 * rt + fr) * 1024 + h * 128 + 16 * n + 4 * fq, O[rt][n] * inv); }
        __syncthreads();
    }
}

__device__ __forceinline__ void expert_convert(const Ctx& c, int l, int gw, int NGW) {

        LAS float* scr = (LAS float*)(c.lds + c.wave * 16384);
        constexpr int I_GU = (512 / 32) * (1024 / 64), I_D = (1024 / 32) * (256 / 64), PER_E = I_GU + I_D;
        for (int it = gw; it < NEX * PER_E; it += NGW) {
            const int e = it / PER_E; int r = it % PER_E;
            if (r < I_GU) {
                const int n0 = (r / 16) * 32, pn = n0 >> 8, wi = n0 & 255, j0 = 128 * pn + (wi & 127);
                const float* Wg; const float* Wu;
                if (e < NE) { Wg = c.in[IN_EWG] + ((size_t)l * NE + e) * 1024 * 256; Wu = c.in[IN_EWU] + ((size_t)l * NE + e) * 1024 * 256; }
                else { Wg = c.in[IN_SWG] + (size_t)l * 1024 * 256; Wu = c.in[IN_SWU] + (size_t)l * 1024 * 256; }
                if (wi < 128) { SrcPlain s{Wg + j0 - n0, 256}; tr_item(s, (bf16*)(c.ws + WS_WGU) + (size_t)e * 512 * 1024, 1024, n0, (r % 16) * 64, scr, c.lane); }
                else { SrcPlain s{Wu + j0 - n0, 256}; tr_item(s, (bf16*)(c.ws + WS_WGU) + (size_t)e * 512 * 1024, 1024, n0, (r % 16) * 64, scr, c.lane); }
            } else { r -= I_GU;
                SrcPlain s; s.ld = 1024; s.W = e < NE ? c.in[IN_EWD] + ((size_t)l * NE + e) * 256 * 1024 : c.in[IN_SWD] + (size_t)l * 256 * 1024;
                tr_item(s, (bf16*)(c.ws + WS_WD) + (size_t)e * 1024 * 256, 256, (r / 4) * 32, (r % 4) * 64, scr, c.lane);
            }
        }
    }
__device__ __forceinline__ void route_one(int t, float logit, float rbias, int lane, unsigned* CNT, int* ROWL, float* WL, unsigned* TOKPOS) {
    const float score = sigmoidf_(logit), sel = score + rbias;
    const int g = lane >> 3;
    int rk8 = 0;
#pragma unroll
    for (int d = 1; d < 8; ++d) { const int ol = (lane & ~7) | ((lane + d) & 7); const float o = __shfl(sel, ol); rk8 += (o > sel || (o == sel && ol < lane)) ? 1 : 0; }
    float t2 = rk8 < 2 ? sel : 0.f;
    t2 += __shfl_xor(t2, 1); t2 += __shfl_xor(t2, 2); t2 += __shfl_xor(t2, 4);
    int rkg = 0;
#pragma unroll
    for (int d = 1; d < 8; ++d) { const int og = (g + d) & 7; const float o = __shfl(t2, og * 8); rkg += (o > t2 || (o == t2 && og < g)) ? 1 : 0; }
    const bool gsel = rkg < 4;
    bool chosen = false; float cur = gsel ? sel : -INFINITY;
#pragma unroll 1
    for (int it6 = 0; it6 < TOPK; ++it6) {
        const float mx = wave_max(cur);
        const unsigned long long me = __ballot(cur == mx);
        const int win = __ffsll((long long)me) - 1;
        if (lane == win) { chosen = true; cur = -INFINITY; }
    }
    const float wsum = wave_sum(chosen ? score : 0.f);
    const unsigned long long mk = __ballot(chosen);
    if (chosen) {
        const int hf = t >= HALF_T ? 1 : 0;
        const int kk = __popcll(mk & ((1ull << lane) - 1ull));
        const unsigned slot = atomicAdd(&CNT[hf * 64 + lane], 1u);
        ROWL[((size_t)hf * 64 + lane) * 16384 + slot] = t;
        WL[((size_t)hf * 64 + lane) * 16384 + slot] = score / wsum * 2.5f;
        if (kk < TOPK) TOKPOS[(size_t)t * 6 + kk] = ((unsigned)lane << 16) | slot;
    }
}
__device__ __forceinline__ void phase_route(const Ctx& c, int l, const float* x1) {
    if (c.nblk <= 128) expert_convert(c, l, c.bid * NWAVES + c.wave, c.nblk * NWAVES);
    __syncthreads();
    {
        LAS float* h_s = (LAS float*)(c.lds + c.wave * 16384);
        const int gw = c.bid * NWAVES + c.wave, NGW = c.nblk * NWAVES, lane = c.lane;
        const float* MOD = (const float*)(c.ws + WS_MOD) + (size_t)l * 16 * 6144;
        bf16* XN2 = (bf16*)(c.ws + WS_XN2);
        const float* RW = c.in[IN_RW] + (size_t)l * 1024 * 64; const float rbias = c.in[IN_RB][l * 64 + lane];
        unsigned* CNT = (unsigned*)(c.ws + WS_CTL) + CW_CNT + l * 128;
        int* ROWL = (int*)(c.ws + WS_ROWL); float* WL = (float*)(c.ws + WS_WL); unsigned* TOKPOS = (unsigned*)(c.ws + WS_TOKPOS);
        for (int it = gw; it < T / 4; it += NGW) {
            const int t0 = it * 4, b = t0 >> 11;
            const float* gain = c.in[IN_NFFN] + l * D; const float* sh = MOD + (size_t)b * 6144 + 3072; const float* sc = MOD + (size_t)b * 6144 + 4096;
#pragma unroll
            for (int r = 0; r < 4; ++r) {
                const float* xrow = x1 + (size_t)(t0 + r) * D;
                f32x4 v[4]; float s = 0.f;
#pragma unroll
                for (int j = 0; j < 4; ++j) { v[j] = *(const f32x4*)(xrow + 4 * (lane + 64 * j)); s += v[j][0] * v[j][0] + v[j][1] * v[j][1] + v[j][2] * v[j][2] + v[j][3] * v[j][3]; }
                const float rstd = rsqrtf(wave_sum(s) * (1.f / D) + EPS);
#pragma unroll
                for (int j = 0; j < 4; ++j) { const int cc = 4 * (lane + 64 * j);
                    const f32x4 g = *(const f32x4*)(gain + cc), a = *(const f32x4*)(sc + cc), bb = *(const f32x4*)(sh + cc);
                    const f32x4 hv = v[j] * rstd * g * (a + 1.f) + bb;
                    st_bf4(XN2 + (size_t)(t0 + r) * D + cc, hv); *(LAS f32x4*)(h_s + r * 1024 + cc) = hv; }
            }
            asm volatile("s_waitcnt lgkmcnt(0)" ::: "memory");
            float lg[4] = {0.f, 0.f, 0.f, 0.f};
#pragma unroll 2
            for (int k = 0; k < 1024; k += 4) {
                const float w0 = RW[(size_t)k * 64 + lane], w1 = RW[(size_t)(k + 1) * 64 + lane], w2 = RW[(size_t)(k + 2) * 64 + lane], w3 = RW[(size_t)(k + 3) * 64 + lane];
#pragma unroll
                for (int r = 0; r < 4; ++r) { const f32x4 hv = *(const LAS f32x4*)(h_s + r * 1024 + k); lg[r] += hv[0] * w0 + hv[1] * w1 + hv[2] * w2 + hv[3] * w3; }
            }
            route_one(t0 + 0, lg[0], rbias, lane, CNT, ROWL, WL, TOKPOS);
            route_one(t0 + 1, lg[1], rbias, lane, CNT, ROWL, WL, TOKPOS);
            route_one(t0 + 2, lg[2], rbias, lane, CNT, ROWL, WL, TOKPOS);
            route_one(t0 + 3, lg[3], rbias, lane, CNT, ROWL, WL, TOKPOS);
        }
    }
}

__device__ __forceinline__ void moe_tables(const Ctx& c, int l, int hf) {
    LAS int* cnt = (LAS int*)(c.lds + 140000); LAS int* off = cnt + 65; LAS int* tst = off + 65;
    __syncthreads();
    if (c.tid == 0) {
        const unsigned* CNT = (const unsigned*)(c.ws + WS_CTL) + CW_CNT + l * 128 + hf * 64;
        int o = 0, ts = 0;
        for (int e = 0; e < NEX; ++e) { const int n = e < NE ? (int)CNT[e] : HALF_T; cnt[e] = n; off[e] = o; tst[e] = ts; o += (n + 255) & ~255; ts += (n + 255) >> 8; }
        tst[NEX] = ts;
    }
    __syncthreads();
}
struct MoeSched1 { LAS const int* cnt; LAS const int* off; LAS const int* tst; int G, c; const char* XN2; const char* WGU; const int* ROWL; const float* WL; const int* IDENT;
    __device__ __forceinline__ bool next(int i, g8::GUnit& u) const {
        const int L = i * G + c; if (L >= 2 * tst[NEX]) return false;
        const int rt = L >> 1, pn = L & 1; int e = 0; while (tst[e + 1] <= rt) ++e;
        const int r0 = (rt - tst[e]) * 256;
        u.A = XN2; u.B = WGU + ((size_t)e * 512 + (size_t)pn * 256) * 2048;
        u.rl = e < NE ? ROWL + (size_t)e * 16384 + r0 : IDENT + r0; u.nvalid = cnt[e] - r0; u.erow0 = 0; u.ecol0 = pn * 256; u.x0 = off[e] + r0; u.xp = e < NE ? WL + (size_t)e * 16384 + r0 : nullptr; return true; } };
struct MoeSched2 { LAS const int* cnt; LAS const int* off; LAS const int* tst; int G, c; const char* HID; const char* WD;
    __device__ __forceinline__ bool next(int i, g8::GUnit& u) const {
        const int L = i * G + c; if (L >= 4 * tst[NEX]) return false;
        const int rt = L >> 2, pn = L & 3; int e = 0; while (tst[e + 1] <= rt) ++e;
        const int r0 = (rt - tst[e]) * 256;
        u.A = HID + (size_t)(off[e] + r0) * 512; u.B = WD + ((size_t)e * 1024 + (size_t)pn * 256) * 512;
        u.rl = nullptr; u.nvalid = 0; u.erow0 = 0; u.ecol0 = pn * 256; u.x0 = off[e] + r0; u.xp = nullptr; return true; } };
struct EpiG1u { bf16* HID;
    __device__ __forceinline__ void operator()(const g8::GUnit& u, int row, int col, f32x4 lo, f32x4 hi) const {
        const int hc = col - 128 * (col >> 8);
        f32x4 v = (f32x4){0.f, 0.f, 0.f, 0.f};
        if (row < u.nvalid) { const float w = u.xp ? u.xp[row] : 1.f;
#pragma unroll
            for (int i = 0; i < 4; ++i) v[i] = siluf_(lo[i]) * hi[i] * w; }
        st_bf4(HID + (size_t)(u.x0 + row) * 256 + hc, v);
    } };
struct EpiG2u { bf16* Y;
    __device__ __forceinline__ void operator()(const g8::GUnit& u, int row, int col, f32x4 lo, f32x4 hi) const {
        st_bf4(Y + (size_t)(u.x0 + row) * 1024 + col, lo); st_bf4(Y + (size_t)(u.x0 + row) * 1024 + col + 128, hi);
    } };
__device__ __forceinline__ void phase_gemm1(const Ctx& c, int l, int hf) {
    moe_tables(c, l, hf);
    LAS int* cnt = (LAS int*)(c.lds + 140000); LAS int* off = cnt + 65; LAS int* tst = off + 65;
    MoeSched1 S{cnt, off, tst, c.nblk, c.bid, (const char*)(c.ws + WS_XN2), (const char*)(c.ws + WS_WGU), (const int*)(c.ws + WS_ROWL) + (size_t)hf * 64 * 16384, (const float*)(c.ws + WS_WL) + (size_t)hf * 64 * 16384,
                (const int*)(c.ws + WS_IDENT) + (size_t)hf * HALF_T};
    EpiG1u E{(bf16*)(c.ws + WS_HID)};
    g8::gemm_phase<true>(c.lds, 2048u, 1024, S, E);
    __syncthreads();
}
__device__ __forceinline__ void phase_gemm2(const Ctx& c, int l, int hf) {
    moe_tables(c, l, hf);
    LAS int* cnt = (LAS int*)(c.lds + 140000); LAS int* off = cnt + 65; LAS int* tst = off + 65;
    MoeSched2 S{cnt, off, tst, c.nblk, c.bid, (const char*)(c.ws + WS_HID), (const char*)(c.ws + WS_WD)};
    EpiG2u E{(bf16*)(c.ws + WS_Y)};
    g8::gemm_phase<false>(c.lds, 512u, 256, S, E);
    __syncthreads();
}
__device__ __forceinline__ void phase_combine(const Ctx& c, int l, int hf, float* xio) {
    moe_tables(c, l, hf);
    LAS int* off = (LAS int*)(c.lds + 140000) + 65;
    const int gw = c.bid * NWAVES + c.wave, NGW = c.nblk * NWAVES, lane = c.lane;
    const bf16* Y = (const bf16*)(c.ws + WS_Y); const unsigned* TOKPOS = (const unsigned*)(c.ws + WS_TOKPOS);
    const float* MODl = (const float*)(c.ws + WS_MOD) + (size_t)l * 16 * 6144;
    const float* MODn = (const float*)(c.ws + WS_MOD) + (size_t)1 * 16 * 6144;
    bf16* XN = (bf16*)(c.ws + WS_XN);
    for (int tt = gw; tt < HALF_T; tt += NGW) {
        const int t = hf * HALF_T + tt, b = t >> 11;
        f32x4 acc[4];
        { const bf16* yr = Y + (size_t)(off[NE] + tt) * 1024;
#pragma unroll
          for (int j = 0; j < 4; ++j) acc[j] = ld_bf4(yr + 4 * (lane + 64 * j)); }
#pragma unroll
        for (int kk = 0; kk < TOPK; ++kk) {
            const unsigned tp = TOKPOS[(size_t)t * 6 + kk]; const int e = tp >> 16, slot = tp & 0xffff;
            const bf16* yr = Y + (size_t)(off[e] + slot) * 1024;
#pragma unroll
            for (int j = 0; j < 4; ++j) acc[j] += ld_bf4(yr + 4 * (lane + 64 * j));
        }
        float* xr = xio + (size_t)t * D; const float* g2 = MODl + (size_t)b * 6144 + 5120;
        f32x4 v[4]; float s = 0.f;
#pragma unroll
        for (int j = 0; j < 4; ++j) { const int cc = 4 * (lane + 64 * j); v[j] = *(const f32x4*)(xr + cc) + *(const f32x4*)(g2 + cc) * acc[j]; s += v[j][0] * v[j][0] + v[j][1] * v[j][1] + v[j][2] * v[j][2] + v[j][3] * v[j][3]; }
        const float rstd = rsqrtf(wave_sum(s) * (1.f / D) + EPS);
        if (l == 0) {
#pragma unroll
            for (int j = 0; j < 4; ++j) { const int cc = 4 * (lane + 64 * j); *(f32x4*)(xr + cc) = v[j];
                const f32x4 g = *(const f32x4*)(c.in[IN_NMIX] + D + cc), a = *(const f32x4*)(MODn + (size_t)b * 6144 + 1024 + cc), bb = *(const f32x4*)(MODn + (size_t)b * 6144 + cc);
                st_bf4(XN + (size_t)t * D + cc, v[j] * rstd * g * (a + 1.f) + bb); }
        } else {
#pragma unroll
            for (int j = 0; j < 4; ++j) { const int cc = 4 * (lane + 64 * j); *(f32x4*)(xr + cc) = v[j] * rstd * *(const f32x4*)(c.in[IN_NFIN] + cc); }
        }
    }
}

#ifdef DSA_NO_SEL
#define DSA_SEL_CALL
#else
#define DSA_SEL_CALL phase_ckvt(c); for (int r2 = 0; r2 < REPN(20); ++r2) phase_dsa_sel(c, l);
#endif
#ifdef DSA_NO_ATT
#define DSA_ATT_CALL
#else
#define DSA_ATT_CALL for (int r2 = 0; r2 < REPN(21); ++r2) phase_dsa_att(c, l);
#endif
constexpr int PH_PER_L = 18, N_PHASES = 1 + NL * PH_PER_L;
#ifndef PH_MASK
#define PH_MASK 0xFFFFFFFFu
#endif
#define IN(k) (lo <= (k) && (k) < hi)
#define EN(b) ((PH_MASK >> (b)) & 1u)
#ifndef REP_MASK
#define REP_MASK 0u
#endif
#define REPN(b) (((REP_MASK >> (b)) & 1u) ? 2 : 1)
#define SEAM(k) do { if (MK_ONE_LAUNCH && IN(k) && IN((k) + 1)) xcd_barrier(bar); } while (0)
template <int l>
__device__ __forceinline__ void layer_program(const Ctx& c, const XcdBarrier& bar, int lo, int hi) {
        const int P = 1 + l * PH_PER_L;
        const float* xin = l == 0 ? c.in[IN_X] : c.out;
        bf16* PB = (bf16*)(c.ws + WS_PB); float* SM = (float*)(c.ws + WS_SM);
        const bf16* XN = (const bf16*)(c.ws + WS_XN);
        const bf16* WIN = (const bf16*)(c.ws + WS_WIN) + (size_t)l * NINP * 1024;
        if (EN(1) && IN(P + 0)) { for (int rep = 0; rep < REPN(1); ++rep) {  if (l == 0) phase_norm1(c, 0, c.in[IN_X]);  if (rep + 1 < REPN(1)) xcd_barrier(bar); } } SEAM(P + 0);
        if (EN(2) && IN(P + 1)) { for (int rep = 0; rep < REPN(2); ++rep) {  EpiInPB E{PB, SM}; dgemm_phase(c, XN, 1024, T, WIN, NPB / 256, 1024, EpiU<decltype(E)>{E});  if (rep + 1 < REPN(2)) xcd_barrier(bar); } } SEAM(P + 1);
        if (EN(3) && IN(P + 2)) { for (int rep = 0; rep < REPN(3); ++rep) {  phase_prep(c, l);  if (rep + 1 < REPN(3)) xcd_barrier(bar); } } SEAM(P + 2);
        if (EN(4) && IN(P + 3)) { for (int rep = 0; rep < REPN(4); ++rep) {
            if (c.nblk > 128 && c.bid >= 128) {
                expert_convert(c, l, (c.bid - 128) * NWAVES + c.wave, (c.nblk - 128) * NWAVES);
                __syncthreads();
                EpiQ E{(bf16*)(c.ws + WS_QLAT), (bf16*)(c.ws + WS_QIDX), (const float*)(c.ws + WS_RSTDQ)};
                dgemm_phase(c, PB + PB_CQ, NPB, T, (const bf16*)(c.ws + WS_WQ) + (size_t)l * 1280 * 256, 5, 256, EpiU<decltype(E)>{E}, c.nblk - 128, c.bid - 128);
            } else phase_scans(c, l);
            if (rep + 1 < REPN(4)) xcd_barrier(bar); } } SEAM(P + 3);
        if (EN(5) && IN(P + 4) && c.nblk <= 128) { for (int rep = 0; rep < REPN(5); ++rep) {  EpiQ E{(bf16*)(c.ws + WS_QLAT), (bf16*)(c.ws + WS_QIDX), (const float*)(c.ws + WS_RSTDQ)};
            dgemm_phase(c, PB + PB_CQ, NPB, T, (const bf16*)(c.ws + WS_WQ) + (size_t)l * 1280 * 256, 5, 256, EpiU<decltype(E)>{E});  if (rep + 1 < REPN(5)) xcd_barrier(bar); } } SEAM(P + 4);
        if (EN(6) && IN(P + 5)) { for (int rep = 0; rep < REPN(6); ++rep) {  EpiGate E{(bf16*)(c.ws + WS_G)}; dgemm_phase(c, XN, 1024, T, WIN + (size_t)NPB * 1024, NG / 256, 1024, EpiU<decltype(E)>{E});  if (rep + 1 < REPN(6)) xcd_barrier(bar); } } SEAM(P + 5);
        if (EN(7) && IN(P + 6)) { for (int rep = 0; rep < REPN(7); ++rep) {  DSA_SEL_CALL xcd_barrier(bar); DSA_ATT_CALL  if (rep + 1 < REPN(7)) xcd_barrier(bar); } } SEAM(P + 6);
        if (EN(8) && IN(P + 7)) { for (int rep = 0; rep < REPN(8); ++rep) {  EpiUp E{(bf16*)(c.ws + WS_M1), (const bf16*)(c.ws + WS_G), 0, 1};
            dgemm_phase(c, (const bf16*)(c.ws + WS_UA), 512, T, (const bf16*)(c.ws + WS_WUPA) + (size_t)l * 1024 * 512, 4, 512, EpiU<decltype(E)>{E});  if (rep + 1 < REPN(8)) xcd_barrier(bar); } } SEAM(P + 7);
        if (EN(9) && IN(P + 8)) { for (int rep = 0; rep < REPN(9); ++rep) {  EpiUp E{(bf16*)(c.ws + WS_M1), (const bf16*)(c.ws + WS_G), 1024, 0};
            dgemm_phase(c, (const bf16*)(c.ws + WS_OLAT), 1024, T, (const bf16*)(c.ws + WS_WUVB) + (size_t)l * 1024 * 1024, 4, 1024, EpiU<decltype(E)>{E});  if (rep + 1 < REPN(9)) xcd_barrier(bar); } } SEAM(P + 8);
        if (EN(10) && IN(P + 9)) { for (int rep = 0; rep < REPN(10); ++rep) {  EpiUp E{(bf16*)(c.ws + WS_M1), (const bf16*)(c.ws + WS_G), 2048, 0};
            dgemm_phase(c, (const bf16*)(c.ws + WS_UC), 512, T, (const bf16*)(c.ws + WS_WUPC) + (size_t)l * 1024 * 512, 4, 512, EpiU<decltype(E)>{E});  if (rep + 1 < REPN(10)) xcd_barrier(bar); } } SEAM(P + 9);
        if (EN(11) && IN(P + 10)) { for (int rep = 0; rep < REPN(11); ++rep) {  EpiWo E{xin, c.out, (const float*)(c.ws + WS_MOD) + (size_t)l * 16 * 6144 + 2048};
            dgemm_phase(c, (const bf16*)(c.ws + WS_M1), 1024, T, (const bf16*)(c.ws + WS_WO) + (size_t)l * 1024 * 1024, 4, 1024, EpiU<decltype(E)>{E});  if (rep + 1 < REPN(11)) xcd_barrier(bar); } } SEAM(P + 10);
        if (EN(12) && IN(P + 11)) { for (int rep = 0; rep < REPN(12); ++rep) {  phase_route(c, l, c.out);  if (rep + 1 < REPN(12)) xcd_barrier(bar); } } SEAM(P + 11);
        if (EN(13) && IN(P + 12)) { for (int rep = 0; rep < REPN(13); ++rep) {  phase_gemm1(c, l, 0);  if (rep + 1 < REPN(13)) xcd_barrier(bar); } } SEAM(P + 12);
        if (EN(14) && IN(P + 13)) { for (int rep = 0; rep < REPN(14); ++rep) {  phase_gemm2(c, l, 0);  if (rep + 1 < REPN(14)) xcd_barrier(bar); } } SEAM(P + 13);
        if (EN(15) && IN(P + 14)) { for (int rep = 0; rep < REPN(15); ++rep) {  phase_combine(c, l, 0, c.out);  if (rep + 1 < REPN(15)) xcd_barrier(bar); } } SEAM(P + 14);
        if (EN(16) && IN(P + 15)) { for (int rep = 0; rep < REPN(16); ++rep) {  phase_gemm1(c, l, 1);  if (rep + 1 < REPN(16)) xcd_barrier(bar); } } SEAM(P + 15);
        if (EN(17) && IN(P + 16)) { for (int rep = 0; rep < REPN(17); ++rep) {  phase_gemm2(c, l, 1);  if (rep + 1 < REPN(17)) xcd_barrier(bar); } } SEAM(P + 16);
        if (EN(18) && IN(P + 17)) { for (int rep = 0; rep < REPN(18); ++rep) {  phase_combine(c, l, 1, c.out);  if (rep + 1 < REPN(18)) xcd_barrier(bar); } } SEAM(P + 17);
    }
__global__ void __launch_bounds__(NTHR, 2) fwd(Args args) {
    extern __shared__ __attribute__((aligned(16))) unsigned char lds_raw[];
    Ctx c;
    c.lds = (LAS unsigned char*)lds_raw;
    c.tid = threadIdx.x; c.lane = c.tid & 63; c.wave = __builtin_amdgcn_readfirstlane(c.tid >> 6);
    c.bid = blockIdx.x; c.nblk = gridDim.x;
    c.in = args.in; c.out = args.out; c.ws = args.ws;
    for (int u = c.tid; u < (LDS_BYTES - LDS_MISC) / 4; u += NTHR) ((LAS unsigned*)(c.lds + LDS_MISC))[u] = 0u;
    __syncthreads();
    XcdBarrier bar; bar.bar = (unsigned*)(c.ws + WS_CTL) + CW_BAR; bar.x = 0; bar.st = (volatile LAS unsigned*)(c.lds + LDS_MISC);
    if (MK_ONE_LAUNCH) bar = xcd_barrier_post((unsigned*)(c.ws + WS_CTL) + CW_BAR, (volatile LAS unsigned*)(c.lds + LDS_MISC));
    const int lo = args.ph_lo, hi = args.ph_hi;
    if (EN(0) && IN(0)) { for (int rep = 0; rep < REPN(0); ++rep) { phase_prologue(c); if (rep + 1 < REPN(0)) xcd_barrier(bar); } } SEAM(0);
    layer_program<0>(c, bar, lo, hi);
    layer_program<1>(c, bar, lo, hi);
#undef IN
#undef SEAM
}

extern "C" void kernel_launch(void* const* d_in, const int* in_sizes, int n_in, void* d_out, int out_size, void* d_ws, size_t ws_size, hipStream_t stream) {
    static int grid = 0;
    if (grid == 0) {
        if (n_in != 33 || out_size != T * D || ws_size < WS_END) { fprintf(stderr, "kernel_launch: unexpected problem (n_in %d out %d ws %zu)\n", n_in, out_size, ws_size); grid = -1; return; }
        int dev = 0, cus = 0, per_cu = 0;
        if (hipGetDevice(&dev) != hipSuccess || hipDeviceGetAttribute(&cus, hipDeviceAttributeMultiprocessorCount, dev) != hipSuccess) { grid = -1; return; }
        if (hipFuncSetAttribute((const void*)fwd, hipFuncAttributeMaxDynamicSharedMemorySize, LDS_BYTES) != hipSuccess) { fprintf(stderr, "kernel_launch: hipFuncSetAttribute failed\n"); grid = -1; return; }
        if (hipOccupancyMaxActiveBlocksPerMultiprocessor(&per_cu, (const void*)fwd, NTHR, LDS_BYTES) != hipSuccess || per_cu < 1) { fprintf(stderr, "kernel_launch: occupancy query says %d\n", per_cu); }
        (void)hipGetLastError();
        grid = cus;
    }
    if (grid < 0) return;
    (void)hipMemsetAsync((char*)d_ws + WS_CTL, 0, CTL_BYTES, stream);
    Args a{};
    for (int i = 0; i < 33; ++i) a.in[i] = (const float*)d_in[i];
    a.out = (float*)d_out; a.ws = (unsigned char*)d_ws;
#if MK_ONE_LAUNCH
    a.ph_lo = 0; a.ph_hi = N_PHASES;
    hipLaunchKernelGGL(fwd, dim3(grid), dim3(NTHR), LDS_BYTES, stream, a);
#else
    for (int p = 0; p < N_PHASES; ++p) {
        if (p == 1 + PH_PER_L) continue;
        a.ph_lo = p; a.ph_hi = p + 1;
        hipLaunchKernelGGL(fwd, dim3(grid), dim3(NTHR), LDS_BYTES, stream, a);
    }
#endif
}
```

```cpp
#include <hip/hip_runtime.h>
#include <cstdio>
#include <cstdint>

#define LAS __attribute__((address_space(3)))
#define GAS __attribute__((address_space(1)))
typedef unsigned short bf16;
typedef short bf16x8 __attribute__((ext_vector_type(8)));
typedef float f32x4 __attribute__((ext_vector_type(4)));
typedef float f32x2 __attribute__((ext_vector_type(2)));
typedef unsigned u32x4 __attribute__((ext_vector_type(4)));
typedef unsigned u32x2 __attribute__((ext_vector_type(2)));
typedef GAS unsigned gu32;

#ifndef SCAN_3PASS
#define SCAN_3PASS 1
#endif
#ifndef SCAN_RECURRENT
#define SCAN_RECURRENT 0
#endif
#ifndef MK_ONE_LAUNCH
#define MK_ONE_LAUNCH 1
#endif

constexpr int NB = 16, SEQ = 2048, D = 1024, T = NB * SEQ, NL = 2;
constexpr int NIN = 6592, NPB = 3584, NG = 3072, NINP = NPB + NG;
constexpr int NE = 64, NEX = 65, EFF = 256, TOPK = 6;
constexpr int HALF_T = T / 2;
constexpr int DSA_K = 256;
constexpr float EPS = 1e-6f;
constexpr int NTHR = 512, NWAVES = 8;

constexpr int PB_QA = 0, PB_KA = 256, PB_VA = 512, PB_GA = 1024, PB_CQ = 1536, PB_CKV = 1792, PB_QC = 2048, PB_KC = 2304, PB_VC = 2560, PB_OC = 3072;
constexpr int SM_KIDX = 0, SM_ALR = 32, SM_WIDX = 48, SM_IC = 56, SM_FC = 60;

constexpr size_t MiB = 1u << 20;
constexpr size_t WS_CTL = 0, CTL_BYTES = 1 * MiB;
constexpr size_t WS_MOD = 1 * MiB;
constexpr size_t WS_RSTDQ = 2 * MiB;
constexpr size_t WS_TOKPOS = 3 * MiB;
constexpr size_t WS_IDENT = 3 * MiB + 800 * 1024;
constexpr size_t WS_WIN = 4 * MiB;
constexpr size_t WS_WQ = 30 * MiB;
constexpr size_t WS_WUPA = 32 * MiB;
constexpr size_t WS_WUPC = 34 * MiB;
constexpr size_t WS_WUVB = 36 * MiB;
constexpr size_t WS_WO = 40 * MiB;
constexpr size_t WS_WGU = 44 * MiB;
constexpr size_t WS_WD = 109 * MiB;
constexpr size_t WS_XN = 142 * MiB;
constexpr size_t WS_OLAT = WS_XN;
constexpr size_t WS_UA = 206 * MiB;
constexpr size_t WS_UC = 238 * MiB;
constexpr size_t WS_XN2 = 206 * MiB;
constexpr size_t WS_QLAT = 270 * MiB;
constexpr size_t WS_M1 = WS_QLAT;
constexpr size_t WS_QIDX = 334 * MiB;
constexpr size_t WS_CKVN = 350 * MiB;
constexpr size_t WS_KIDX = 358 * MiB;
constexpr size_t WS_SM = 360 * MiB;
constexpr size_t WS_PB = 376 * MiB;
constexpr size_t WS_G = WS_PB;
constexpr size_t WS_HID = 270 * MiB;
constexpr size_t WS_Y = 334 * MiB;
constexpr size_t WS_ROWL = 590 * MiB;
constexpr size_t WS_WL = 598 * MiB;
constexpr size_t WS_CKVT = 576 * MiB;
constexpr size_t WS_MASK = 584 * MiB;
static_assert(WS_CKVT >= WS_G + (size_t)T * NG * 2 && WS_MASK + (size_t)T * 64 * 4 <= WS_PB + (size_t)T * NPB * 2, "CKVT/MASK placement");
constexpr size_t WS_QS = 270 * MiB;
constexpr size_t WS_DSG = 302 * MiB;
constexpr size_t WS_DSM = 600 * MiB;
constexpr size_t WS_ET = 334 * MiB;
constexpr size_t WS_CT = 335 * MiB;
constexpr size_t WS_MP = 335 * MiB + 512 * 1024;
constexpr size_t WS_GPM = 336 * MiB;
constexpr size_t WS_GBC = 337 * MiB;
constexpr size_t WS_DN = 338 * MiB;
constexpr size_t WS_END = 636 * MiB;
static_assert(WS_PB + (size_t)T * NPB * 2 <= 600 * MiB, "PB");
static_assert(WS_Y + (size_t)131072 * 1024 * 2 <= WS_ROWL, "Y");

constexpr int CW_BAR = 4096;
constexpr int CW_CNT = 16384;

constexpr int LDS_BYTES = 147456;
constexpr int LDS_MISC = 145408;

__device__ __forceinline__ unsigned f2bf(float f) { unsigned u = __builtin_bit_cast(unsigned, f); return (u + 0x7fffu + ((u >> 16) & 1u)) >> 16; }
__device__ __forceinline__ float bf2f(unsigned b) { return __builtin_bit_cast(float, b << 16); }
__device__ __forceinline__ unsigned pk2(float lo, float hi) { return f2bf(lo) | (f2bf(hi) << 16); }
__device__ __forceinline__ float bflo(unsigned w) { return __builtin_bit_cast(float, w << 16); }
__device__ __forceinline__ float bfhi(unsigned w) { return __builtin_bit_cast(float, w & 0xffff0000u); }
__device__ __forceinline__ float wave_sum(float v) {
#pragma unroll
    for (int o = 1; o < 64; o <<= 1) v += __shfl_xor(v, o);
    return v;
}
__device__ __forceinline__ float wave_max(float v) {
#pragma unroll
    for (int o = 1; o < 64; o <<= 1) v = fmaxf(v, __shfl_xor(v, o));
    return v;
}
__device__ __forceinline__ int wave_sum_i(int v) {
#pragma unroll
    for (int o = 1; o < 64; o <<= 1) v += __shfl_xor(v, o);
    return v;
}
__device__ __forceinline__ void lds_barrier() { asm volatile("s_waitcnt lgkmcnt(0)" ::: "memory"); __builtin_amdgcn_s_barrier(); asm volatile("" ::: "memory"); }
__device__ __forceinline__ float sigmoidf_(float x) { return 1.f / (1.f + __expf(-x)); }
__device__ __forceinline__ float siluf_(float x) { return x / (1.f + __expf(-x)); }
__device__ __forceinline__ float logsigmoidf_(float x) { return fminf(x, 0.f) - log1pf(__expf(-fabsf(x))); }
__device__ __forceinline__ float logsigmoid_fast(float x) { return fminf(x, 0.f) - __logf(1.f + __expf(-fabsf(x))); }
__device__ __forceinline__ void st_bf4(bf16* p, f32x4 v) { u32x2 w; w.x = pk2(v[0], v[1]); w.y = pk2(v[2], v[3]); *(u32x2*)p = w; }
__device__ __forceinline__ f32x4 ld_bf4(const bf16* p) { u32x2 w = *(const u32x2*)p; return (f32x4){bflo(w.x), bfhi(w.x), bflo(w.y), bfhi(w.y)}; }

#define XB_TMO      128
#define XB_XCNT(j)  (256  + 64 * (j))
#define XB_XSUB(j)  (1280 + 64 * (j))
#define XB_XGEN(j)  (2304 + 64 * (j))
#define XB_TOP      3328
#define XB_TOPGEN   3392
#define XCD_BAR_WORDS 3456
#define XB_SPIN_CAP (1u << 22)
__device__ __forceinline__ unsigned xb_ld(unsigned* p)              { return __hip_atomic_load(p, __ATOMIC_RELAXED, __HIP_MEMORY_SCOPE_AGENT); }
__device__ __forceinline__ unsigned xb_add(unsigned* p, unsigned v) { return __hip_atomic_fetch_add(p, v, __ATOMIC_RELAXED, __HIP_MEMORY_SCOPE_AGENT); }
__device__ __forceinline__ unsigned xb_xcc_id() { return (unsigned)__builtin_amdgcn_s_getreg((3 << 11) | 20) & 0xFu; }
#define XB_SPIN(cond, bar) do { unsigned _sp = 0; while (cond) { __builtin_amdgcn_s_sleep(1); \
    if ((++_sp & 255u) == 0u) { if (xb_ld(&(bar)[XB_TMO])) break; if (_sp > XB_SPIN_CAP) { atomicAdd(&(bar)[XB_TMO], 1u); break; } } } } while (0)
struct XcdBarrier { unsigned* bar; unsigned x; volatile LAS unsigned* st; };
__device__ __forceinline__ XcdBarrier xcd_barrier_post(unsigned* bar, volatile LAS unsigned* st) {
    XcdBarrier b; b.bar = bar; b.x = xb_xcc_id(); b.st = st;
    if (threadIdx.x == 0) (void)xb_add(&bar[XB_XCNT(b.x)], 1u);
    return b;
}
__device__ __forceinline__ void xcd_barrier_complete(unsigned* bar, unsigned x, unsigned& nloc, unsigned& nx) {
    const unsigned G = gridDim.x * gridDim.y * gridDim.z;
    unsigned sum, cnt, mine, sp = 0u;
    for (;;) {
        sum = 0u; cnt = 0u; mine = 0u;
#pragma unroll
        for (unsigned j = 0; j < 16; ++j) { const unsigned c = xb_ld(&bar[XB_XCNT(j)]); sum += c; cnt += (c > 0u) ? 1u : 0u; mine = (j == x) ? c : mine; }
        if (sum == G) break;
        __builtin_amdgcn_s_sleep(1);
        if ((++sp & 255u) == 0u) { if (xb_ld(&bar[XB_TMO])) break; if (sp > XB_SPIN_CAP) { atomicAdd(&bar[XB_TMO], 1u); break; } }
    }
    nloc = mine > 0u ? mine : 1u; nx = cnt > 0u ? cnt : 1u;
}
__device__ __forceinline__ void xcd_barrier(const XcdBarrier& b) {
    asm volatile("s_waitcnt vmcnt(0)" ::: "memory");
    __syncthreads();
    if (threadIdx.x == 0) {
        unsigned* bar = b.bar;
        __builtin_amdgcn_s_waitcnt(0);
        unsigned nloc = b.st[0], nx = b.st[1];
        if (nloc == 0u) { xcd_barrier_complete(bar, b.x, nloc, nx); b.st[0] = nloc; b.st[1] = nx; }
        const unsigned old = xb_add(&bar[XB_XSUB(b.x)], 1u);
        const unsigned gen = old / nloc;
        if (old + 1u == (gen + 1u) * nloc) {
            __builtin_amdgcn_fence(__ATOMIC_RELEASE, "agent");
            asm volatile("s_waitcnt vmcnt(0)" ::: "memory");
            const unsigned og = xb_add(&bar[XB_TOP], 1u);
            const unsigned tg = og / nx;
            if (og + 1u == (tg + 1u) * nx) xb_add(&bar[XB_TOPGEN], 1u);
            else XB_SPIN(xb_ld(&bar[XB_TOPGEN]) == tg, bar);
            __builtin_amdgcn_fence(__ATOMIC_ACQUIRE, "agent");
            xb_add(&bar[XB_XGEN(b.x)], 1u);
            asm volatile("s_waitcnt vmcnt(0)" ::: "memory");
        } else {
            XB_SPIN(xb_ld(&bar[XB_XGEN(b.x)]) == gen, bar);
            __builtin_amdgcn_fence(__ATOMIC_ACQUIRE, "agent");
            asm volatile("s_waitcnt vmcnt(0)" ::: "memory");
        }
    }
    __syncthreads();
}

struct Args { const float* in[33]; float* out; unsigned char* ws; int ph_lo, ph_hi; };

struct Ctx {
    LAS unsigned char* lds;
    int tid, lane, wave, bid, nblk;
    const float* const* in;
    float* out; unsigned char* ws;
};
#define IN_X 0
#define IN_C 1
#define IN_ADAW 2
#define IN_ADAB 3
#define IN_NMIX 4
#define IN_NFFN 5
#define IN_WIN 6
#define IN_GLA_WA2 7
#define IN_GLA_BA 8
#define IN_GLA_NORM 9
#define IN_DSA_NQ 10
#define IN_DSA_NKV 11
#define IN_DSA_WUQ 12
#define IN_DSA_WUK 13
#define IN_DSA_WUV 14
#define IN_DSA_WQI 15
#define IN_ML_CONV 16
#define IN_ML_BI 17
#define IN_ML_BF 18
#define IN_ML_NORM 19
#define IN_WUPA 20
#define IN_WUPB 21
#define IN_WUPC 22
#define IN_WO 23
#define IN_RW 24
#define IN_RB 25
#define IN_EWG 26
#define IN_EWU 27
#define IN_EWD 28
#define IN_SWG 29
#define IN_SWU 30
#define IN_SWD 31
#define IN_NFIN 32

template <class SrcF>
__device__ __forceinline__ void tr_item(const SrcF& src, bf16* dst, int dst_ld, int n0, int k0, LAS float* scr, int lane) {
    const int j = lane & 31;
    const float* colp = src(n0 + j);
    const long ld = src.ld;
    float tv[32];
#pragma unroll
    for (int i = 0; i < 32; ++i) { const int kk = 2 * i + (lane >> 5); tv[i] = colp ? colp[(long)(k0 + kk) * ld] : 0.f; }
#pragma unroll
    for (int i = 0; i < 32; ++i) { const int kk = 2 * i + (lane >> 5); scr[kk * 33 + j] = tv[i]; }
    asm volatile("s_waitcnt lgkmcnt(0)" ::: "memory");
    const int c = lane & 7;
#pragma unroll
    for (int jj = 0; jj < 4; ++jj) { const int n = (lane >> 3) + 8 * jj; const LAS float* s = scr + (8 * c) * 33 + n;
        u32x4 o; o.x = pk2(s[0 * 33], s[1 * 33]); o.y = pk2(s[2 * 33], s[3 * 33]); o.z = pk2(s[4 * 33], s[5 * 33]); o.w = pk2(s[6 * 33], s[7 * 33]);
        *(u32x4*)(dst + (size_t)(n0 + n) * dst_ld + k0 + 8 * c) = o; }
    asm volatile("s_waitcnt lgkmcnt(0)" ::: "memory");
}
struct SrcPlain { const float* W; long ld; __device__ __forceinline__ const float* operator()(int n) const { return W + n; } };
__device__ __forceinline__ int win_src_col(int r) {
    if (r < 1536) return r;
    if (r < 1792) return 1552 + (r - 1536);
    if (r < 1920) return 1808 + (r - 1792);
    if (r < 1952) return 1936 + (r - 1920);
    if (r < 1968) return 1536 + (r - 1952);
    if (r < 1976) return 1968 + (r - 1968);
    if (r < 1980) return 3000 + (r - 1976);
    if (r < 1984) return 3004 + (r - 1980);
    if (r < 2048) return -1;
    if (r < 2560) return 1976 + (r - 2048);
    if (r < 3072) return 2488 + (r - 2560);
    if (r < 3584) return 3008 + (r - 3072);
    return 3520 + (r - 3584);
}
struct SrcWin { const float* W; long ld; __device__ __forceinline__ const float* operator()(int n) const { const int c = win_src_col(n); return c < 0 ? nullptr : W + c; } };
struct SrcGU { const float* Wg; const float* Wu; long ld;
    __device__ __forceinline__ const float* operator()(int r) const { const int pn = r >> 8, w = r & 255, j = 128 * pn + (w & 127); return (w < 128 ? Wg : Wu) + j; } };

constexpr int SG_LD = 40;
template <class Epi>
__device__ __forceinline__ void sgemm_unit(const Ctx& c, const bf16* A, int lda, const int* rowlist, int nvalid, int arow0, const bf16* Bt, int K, const Epi& E, int erow0, int ecol0) {
    LAS bf16* As = (LAS bf16*)c.lds;
    LAS bf16* Bs = (LAS bf16*)(c.lds + 128 * SG_LD * 2);
    const int tid = c.tid, lane = c.lane, wave = c.wave, wr = wave >> 2, wc = wave & 3, fr = lane & 15, fq = lane >> 4;
    const int lr = tid >> 2, ch = tid & 3;
    int srow = arow0 + lr;
    if (rowlist) { srow = (arow0 + lr < nvalid) ? rowlist[arow0 + lr] : 0; }
    const bf16* ap = A + (size_t)srow * lda + ch * 8;
    const bf16* bp0 = Bt + (size_t)lr * K + ch * 8;
    const bf16* bp1 = Bt + (size_t)(128 + lr) * K + ch * 8;
    f32x4 acc[2][4][2];
#pragma unroll
    for (int a = 0; a < 2; ++a)
#pragma unroll
        for (int m = 0; m < 4; ++m)
#pragma unroll
            for (int n = 0; n < 2; ++n) acc[a][m][n] = (f32x4){0.f, 0.f, 0.f, 0.f};
    u32x4 ra = *(const u32x4*)ap, rb0 = *(const u32x4*)bp0, rb1 = *(const u32x4*)bp1;
    for (int k0 = 0; k0 < K; k0 += 32) {
        __syncthreads();
        *(LAS u32x4*)(As + lr * SG_LD + ch * 8) = ra;
        *(LAS u32x4*)(Bs + lr * SG_LD + ch * 8) = rb0;
        *(LAS u32x4*)(Bs + (128 + lr) * SG_LD + ch * 8) = rb1;
        __syncthreads();
        if (k0 + 32 < K) { ra = *(const u32x4*)(ap + k0 + 32); rb0 = *(const u32x4*)(bp0 + k0 + 32); rb1 = *(const u32x4*)(bp1 + k0 + 32); }
        bf16x8 af[4], bfr[2][2];
#pragma unroll
        for (int m = 0; m < 4; ++m) af[m] = *(const LAS bf16x8*)(As + (wr * 64 + m * 16 + fr) * SG_LD + fq * 8);
#pragma unroll
        for (int bj = 0; bj < 2; ++bj)
#pragma unroll
            for (int n = 0; n < 2; ++n) bfr[bj][n] = *(const LAS bf16x8*)(Bs + (bj * 128 + wc * 32 + n * 16 + fr) * SG_LD + fq * 8);
#pragma unroll
        for (int bj = 0; bj < 2; ++bj)
#pragma unroll
            for (int m = 0; m < 4; ++m)
#pragma unroll
                for (int n = 0; n < 2; ++n) acc[bj][m][n] = __builtin_amdgcn_mfma_f32_16x16x32_bf16(bfr[bj][n], af[m], acc[bj][m][n], 0, 0, 0);
    }
#pragma unroll
    for (int m = 0; m < 4; ++m)
#pragma unroll
        for (int n = 0; n < 2; ++n) E(erow0 + wr * 64 + m * 16 + fr, ecol0 + wc * 32 + n * 16 + 4 * fq, acc[0][m][n], acc[1][m][n]);
}
template <class Epi>
__device__ __forceinline__ void sgemm_phase(const Ctx& c, const bf16* A, int lda, int M, const bf16* Bt, int ntn, int K, const Epi& E) {
    const int nu = (M / 128) * ntn;
    for (int u = c.bid; u < nu; u += c.nblk) {
        const int pm = u / ntn, pn = u % ntn;
        sgemm_unit(c, A, lda, nullptr, 0, pm * 128, Bt + (size_t)pn * 256 * K, K, E, pm * 128, pn * 256);
    }
    __syncthreads();
}


namespace g8 {
constexpr int BM = 256, BK = 64, HALF = 128, HTB = HALF * BK * 2, STAGE_BYTES = 8 * HTB, NXCD = 8, WGM = 8;
__host__ __device__ __forceinline__ int lds_byte(int r, int c) { const int st = (r >> 4) * 2 + (c >> 5), rr = r & 15, cc = c & 31, ob = rr * 64 + cc * 2; return st * 1024 + (ob ^ (((ob >> 9) & 1) << 5)); }
__host__ __device__ __forceinline__ void stage_rc(int b, int& R, int& C) { const int st = b / 1024, sb = b % 1024, swz = sb ^ (((sb >> 9) & 1) << 5); R = (st >> 1) * 16 + swz / 64; C = (st & 1) * 32 + (swz % 64) / 2; }
struct GUnit { const char* A; const char* B; const int* rl; int nvalid; int erow0, ecol0; int x0; const float* xp; };
__device__ __forceinline__ bool static_order(int nM, int nN, int G, int c, int i, int& pm, int& pn) {
    const int nwg = nM * nN; const long L = (long)i * G + c; if (L >= nwg) return false;
    int wgid = (int)L; { const int q = nwg / NXCD, r = nwg % NXCD, xcd = wgid % NXCD, off = wgid / NXCD; wgid = (xcd < r ? xcd * (q + 1) : r * (q + 1) + (xcd - r) * q) + off; }
    const int nig = WGM * nN, gid = wgid / nig, fm = gid * WGM, gsz = (nM - fm) < WGM ? (nM - fm) : WGM;
    pm = fm + ((wgid % nig) % gsz); pn = (wgid % nig) / gsz; return true;
}
struct DenseSched { const char* A; const char* Bt; size_t ldaB, ldbB; int nM, nN, G, c;
    __device__ __forceinline__ bool next(int i, GUnit& u) const { int pm, pn; if (!static_order(nM, nN, G, c, i, pm, pn)) return false;
        u.A = A + (size_t)pm * 256 * ldaB; u.B = Bt + (size_t)pn * 256 * ldbB; u.rl = nullptr; u.nvalid = 0; u.erow0 = pm * 256; u.ecol0 = pn * 256; u.x0 = 0; u.xp = nullptr; return true; } };

template <bool GATHER, class Epi, class Sched>
__device__ __forceinline__ void gemm_phase(LAS unsigned char* lds, unsigned ldaB, int K, const Sched& S, const Epi& E) {
    const int tid = threadIdx.x, wid = __builtin_amdgcn_readfirstlane(tid >> 6), lane = tid & 63, wr = wid >> 2, wc = wid & 3, fr = lane & 15, fq = lane >> 4;
    const int nt = K / BK;
    int R0, C0, R1, C1; stage_rc(tid * 16, R0, C0); stage_rc(tid * 16 + 8192, R1, C1);
    unsigned voffB[2]; voffB[0] = (unsigned)(R0 * K + C0) * 2u; voffB[1] = (unsigned)(R1 * K + C1) * 2u;
    unsigned ac0[2], ac1[2], an0[2], an1[2];
    const size_t kstep = (size_t)(BK * 2);
    const size_t hstepB = (size_t)HALF * K * 2;
    const unsigned ldsw = (unsigned)wid * 1024u;
    const int aoff = lds_byte(wr * 64 + fr, fq * 8), boff = lds_byte(wc * 32 + fr, fq * 8);
#define G8_SA(b, h) (((b) * 2 + (h)) * HTB)
#define G8_SB(b, h) ((4 + (b) * 2 + (h)) * HTB)
#define G8_STAGE(bufoff, gbase, voff) do { _Pragma("unroll") for (int _i = 0; _i < 2; ++_i) \
        __builtin_amdgcn_global_load_lds((const unsigned*)((const char*)(gbase) + (voff)[_i]), (LAS unsigned*)(lds + (bufoff) + ldsw + _i * 8192), 16, 0, 0); } while (0)
#define G8_LDA(dst, b, h) do { _Pragma("unroll") for (int m = 0; m < 4; ++m) _Pragma("unroll") for (int k = 0; k < 2; ++k) dst[m][k] = *(const LAS bf16x8*)(lds + G8_SA(b, h) + aoff + m * 2048 + k * 1024); } while (0)
#define G8_LDB(dst, b, h) do { _Pragma("unroll") for (int n = 0; n < 2; ++n) _Pragma("unroll") for (int k = 0; k < 2; ++k) dst[n][k] = *(const LAS bf16x8*)(lds + G8_SB(b, h) + boff + n * 2048 + k * 1024); } while (0)
#define G8_MMA(ai, bj, At, Bt) do { __builtin_amdgcn_s_setprio(1); _Pragma("unroll") for (int m = 0; m < 4; ++m) _Pragma("unroll") for (int n = 0; n < 2; ++n) _Pragma("unroll") for (int k = 0; k < 2; ++k) \
        acc[ai][bj][m][n] = __builtin_amdgcn_mfma_f32_16x16x32_bf16(Bt[n][k], At[m][k], acc[ai][bj][m][n], 0, 0, 0); __builtin_amdgcn_s_setprio(0); } while (0)
#define G8_WAIT_V(n) asm volatile("s_waitcnt vmcnt(" #n ")" ::: "memory")
#define G8_WAIT_L(n) asm volatile("s_waitcnt lgkmcnt(" #n ")" ::: "memory")
#define G8_BAR __builtin_amdgcn_s_barrier()
#define G8_SCHED __builtin_amdgcn_sched_barrier(0)
#define G8_XLOAD(u) __builtin_amdgcn_global_load_lds((const unsigned*)((u).rl + lane * 4), (LAS unsigned*)(lds + STAGE_BYTES + wid * 1024), 16, 0, 0)
#define G8_AOFF(u, o0, o1) do { if (GATHER) { const LAS int* _rs = (const LAS int*)(lds + STAGE_BYTES + wid * 1024); const int _nv = (u).nvalid - 1; \
        const int _r00 = _rs[min(R0, _nv)], _r01 = _rs[min(R1, _nv)], _r10 = _rs[min(128 + R0, _nv)], _r11 = _rs[min(128 + R1, _nv)]; \
        o0[0] = (unsigned)_r00 * ldaB + (unsigned)C0 * 2u; o0[1] = (unsigned)_r01 * ldaB + (unsigned)C1 * 2u; o1[0] = (unsigned)_r10 * ldaB + (unsigned)C0 * 2u; o1[1] = (unsigned)_r11 * ldaB + (unsigned)C1 * 2u; \
    } else { o0[0] = (unsigned)R0 * ldaB + (unsigned)C0 * 2u; o0[1] = (unsigned)R1 * ldaB + (unsigned)C1 * 2u; o1[0] = (unsigned)(128 + R0) * ldaB + (unsigned)C0 * 2u; o1[1] = (unsigned)(128 + R1) * ldaB + (unsigned)C1 * 2u; } } while (0)
    GUnit cur, nxt; int ui = 0;
    if (!S.next(0, cur)) return;
    f32x4 acc[2][2][4][2];
#pragma unroll
    for (int a = 0; a < 2; ++a)
#pragma unroll
        for (int b = 0; b < 2; ++b)
#pragma unroll
            for (int m = 0; m < 4; ++m)
#pragma unroll
                for (int n = 0; n < 2; ++n) acc[a][b][m][n] = (f32x4){0.f, 0.f, 0.f, 0.f};
    bf16x8 At[4][2], B0[2][2], B1[2][2];
    if (GATHER) { G8_XLOAD(cur); G8_WAIT_V(0); }
    G8_AOFF(cur, ac0, ac1);
    if (GATHER) { G8_WAIT_L(0); }
    const char* cA = cur.A; const char* cB = cur.B;
    G8_STAGE(G8_SB(0, 0), cB, voffB); G8_STAGE(G8_SB(0, 1), cB + hstepB, voffB); G8_STAGE(G8_SA(0, 0), cA, ac0); G8_STAGE(G8_SA(0, 1), cA, ac1);
    if (wr == 1) G8_BAR;
    G8_WAIT_V(2); G8_BAR;
    G8_STAGE(G8_SB(1, 0), cB + kstep, voffB); G8_STAGE(G8_SA(1, 0), cA + kstep, ac0); G8_STAGE(G8_SB(1, 1), cB + hstepB + kstep, voffB);
    G8_WAIT_V(6); G8_BAR;
    for (;;) {
        const bool has_next = S.next(ui + 1, nxt);
        const char* nA = has_next ? nxt.A : cA; const char* nB = has_next ? nxt.B : cB;
        an0[0] = ac0[0]; an0[1] = ac0[1]; an1[0] = ac1[0]; an1[1] = ac1[1];
        const bool xload = GATHER && has_next;
        if (xload) { G8_XLOAD(nxt); }
#pragma unroll 1
        for (int t = 0; t < nt; t += 2) {
            const bool last = (t == nt - 2);
            const char* a1 = cA + (size_t)(t + 1) * kstep;
            const char* a2 = last ? nA : cA + (size_t)(t + 2) * kstep; const char* b2 = last ? nB : cB + (size_t)(t + 2) * kstep;
            const char* a3 = a2 + kstep; const char* b3 = b2 + kstep;
            unsigned* x0 = last ? an0 : ac0; unsigned* x1 = last ? an1 : ac1;
            unsigned s0[2], s1[2]; s0[0] = x0[0]; s0[1] = x0[1]; s1[0] = x1[0]; s1[1] = x1[1];
            G8_LDB(B0, 0, 0); G8_LDB(B1, 0, 1); G8_SCHED; G8_LDA(At, 0, 0); G8_STAGE(G8_SA(1, 1), a1, ac1);
            if (xload && t == 0) { G8_WAIT_V(9); } else { G8_WAIT_V(8); }
            G8_WAIT_L(0); G8_BAR; G8_MMA(0, 0, At, B0); G8_MMA(0, 1, At, B1); G8_BAR; G8_SCHED;
            G8_LDA(At, 0, 1); G8_STAGE(G8_SB(0, 0), b2, voffB); G8_STAGE(G8_SB(0, 1), b2 + hstepB, voffB); G8_STAGE(G8_SA(0, 0), a2, s0);
            G8_WAIT_V(8); G8_WAIT_L(0); G8_BAR; G8_MMA(1, 0, At, B0); G8_MMA(1, 1, At, B1); G8_BAR; G8_SCHED;
            if (xload && t == 0) { G8_AOFF(nxt, an0, an1); }
            G8_LDB(B0, 1, 0); G8_LDB(B1, 1, 1); G8_SCHED; G8_LDA(At, 1, 0); G8_STAGE(G8_SA(0, 1), a2, s1);
            G8_WAIT_V(8); G8_WAIT_L(0); G8_BAR; G8_MMA(0, 0, At, B0); G8_MMA(0, 1, At, B1); G8_BAR; G8_SCHED;
            G8_LDA(At, 1, 1); G8_STAGE(G8_SB(1, 0), b3, voffB); G8_STAGE(G8_SB(1, 1), b3 + hstepB, voffB); G8_STAGE(G8_SA(1, 0), a3, s0);
            G8_WAIT_V(8); G8_WAIT_L(0); G8_BAR; G8_MMA(1, 0, At, B0); G8_MMA(1, 1, At, B1); G8_BAR; G8_SCHED;
        }
        if (wr == 0) G8_BAR;
#pragma unroll
        for (int ai = 0; ai < 2; ++ai)
#pragma unroll
            for (int m = 0; m < 4; ++m)
#pragma unroll
                for (int n = 0; n < 2; ++n) E(cur, cur.erow0 + ai * HALF + wr * 64 + m * 16 + fr, cur.ecol0 + wc * 32 + n * 16 + 4 * fq, acc[ai][0][m][n], acc[ai][1][m][n]);
        if (!has_next) break;
#pragma unroll
        for (int a = 0; a < 2; ++a)
#pragma unroll
            for (int b = 0; b < 2; ++b)
#pragma unroll
                for (int m = 0; m < 4; ++m)
#pragma unroll
                    for (int n = 0; n < 2; ++n) acc[a][b][m][n] = (f32x4){0.f, 0.f, 0.f, 0.f};
        cur = nxt; cA = nA; cB = nB; ++ui;
        ac0[0] = an0[0]; ac0[1] = an0[1]; ac1[0] = an1[0]; ac1[1] = an1[1];
        if (wr == 1) G8_BAR;
    }
    G8_WAIT_V(0);
    G8_BAR;
#undef G8_SA
#undef G8_SB
#undef G8_STAGE
#undef G8_LDA
#undef G8_LDB
#undef G8_MMA
#undef G8_WAIT_V
#undef G8_WAIT_L
#undef G8_BAR
#undef G8_SCHED
#undef G8_AOFF
#undef G8_XLOAD
}
}
template <class Epi>
__device__ __forceinline__ void dgemm_phase(const Ctx& c, const bf16* A, int lda, int M, const bf16* Bt, int ntn, int K, const Epi& E, int G = -1, int cid = -1) {
    g8::DenseSched S{(const char*)A, (const char*)Bt, (size_t)lda * 2, (size_t)K * 2, M / 256, ntn, G < 0 ? c.nblk : G, cid < 0 ? c.bid : cid};
    g8::gemm_phase<false>(c.lds, (unsigned)lda * 2u, K, S, E);
    __syncthreads();
}

struct EpiInPB { bf16* PB; float* SM;
    __device__ __forceinline__ void operator()(int row, int col, f32x4 lo, f32x4 hi) const {
        st_bf4(PB + (size_t)row * NPB + col, lo);
        if ((col >> 8) == 7) *(f32x4*)(SM + (size_t)row * 128 + (col & 127)) = hi;
        else st_bf4(PB + (size_t)row * NPB + col + 128, hi);
    } };
struct EpiQ { bf16* QLAT; bf16* QIDX; const float* rstd;
    __device__ __forceinline__ void operator()(int row, int col, f32x4 lo, f32x4 hi) const {
        const float r = rstd[row];
        if (col < 1024) { st_bf4(QLAT + (size_t)row * 1024 + col, lo * r); st_bf4(QLAT + (size_t)row * 1024 + col + 128, hi * r); }
        else { st_bf4(QIDX + (size_t)row * 256 + (col - 1024), lo * r); st_bf4(QIDX + (size_t)row * 256 + (col - 1024) + 128, hi * r); }
    } };
struct EpiGate { bf16* G;
    __device__ __forceinline__ void operator()(int row, int col, f32x4 lo, f32x4 hi) const {
        f32x4 a, b;
#pragma unroll
        for (int i = 0; i < 4; ++i) { a[i] = sigmoidf_(lo[i]); b[i] = sigmoidf_(hi[i]); }
        st_bf4(G + (size_t)row * NG + col, a); st_bf4(G + (size_t)row * NG + col + 128, b);
    } };
struct EpiUp { bf16* M1; const bf16* G; int goff; int first;
    __device__ __forceinline__ void operator()(int row, int col, f32x4 lo, f32x4 hi) const {
        bf16* m = M1 + (size_t)row * 1024 + col; const bf16* g = G + (size_t)row * NG + goff + col;
        f32x4 a = ld_bf4(g) * lo, b = ld_bf4(g + 128) * hi;
        if (!first) { a += ld_bf4(m); b += ld_bf4(m + 128); }
        st_bf4(m, a); st_bf4(m + 128, b);
    } };
struct EpiWo { const float* res; float* out; const float* g1;
    __device__ __forceinline__ void operator()(int row, int col, f32x4 lo, f32x4 hi) const {
        const float* gp = g1 + (size_t)(row >> 11) * 6144 + col; const size_t o = (size_t)row * 1024 + col;
        const f32x4 ga = *(const f32x4*)gp, gb = *(const f32x4*)(gp + 128);
        const f32x4 ra = *(const f32x4*)(res + o), rb = *(const f32x4*)(res + o + 128);
        *(f32x4*)(out + o) = ra + ga * lo; *(f32x4*)(out + o + 128) = rb + gb * hi;
    } };
struct EpiG1 { bf16* HID; const float* wl; int cnt; int orow0;
    __device__ __forceinline__ void operator()(int row, int col, f32x4 lo, f32x4 hi) const {
        const int hc = col - 128 * (col >> 8);
        f32x4 v = (f32x4){0.f, 0.f, 0.f, 0.f};
        if (row < cnt) { const float w = wl ? wl[row] : 1.f;
#pragma unroll
            for (int i = 0; i < 4; ++i) v[i] = siluf_(lo[i]) * hi[i] * w; }
        st_bf4(HID + (size_t)(orow0 + row) * 256 + hc, v);
    } };
struct EpiG2 { bf16* Y; int orow0;
    __device__ __forceinline__ void operator()(int row, int col, f32x4 lo, f32x4 hi) const {
        st_bf4(Y + (size_t)(orow0 + row) * 1024 + col, lo); st_bf4(Y + (size_t)(orow0 + row) * 1024 + col + 128, hi);
    } };


template <class F> struct EpiU { F f; __device__ __forceinline__ void operator()(const g8::GUnit&, int row, int col, f32x4 lo, f32x4 hi) const { f(row, col, lo, hi); } };

__device__ __forceinline__ void phase_prologue(const Ctx& c) {
    {
        LAS float* cs = (LAS float*)c.lds;
        LAS float* red = (LAS float*)(c.lds + 65536);
        const float* cin = c.in[IN_C];
        if (c.bid < 192) {
            for (int i = c.tid; i < 16 * 1024; i += NTHR) cs[i] = siluf_(cin[i]);
            __syncthreads();
        }
        float* MOD = (float*)(c.ws + WS_MOD);
        for (int it = c.bid; it < 192; it += c.nblk) {
            const int l = it / 96, cg = it % 96, col = cg * 64 + c.lane;
            const float* W = c.in[IN_ADAW] + (size_t)l * 1024 * 6144 + col;
            float acc[16];
#pragma unroll
            for (int b = 0; b < 16; ++b) acc[b] = 0.f;
            const int kbeg = c.wave * 128;
            for (int k = kbeg; k < kbeg + 128; k += 4) {
                const float w0 = W[(size_t)k * 6144], w1 = W[(size_t)(k + 1) * 6144], w2 = W[(size_t)(k + 2) * 6144], w3 = W[(size_t)(k + 3) * 6144];
#pragma unroll
                for (int b = 0; b < 16; ++b) { const f32x4 v = *(const LAS f32x4*)(cs + b * 1024 + k); acc[b] += v[0] * w0 + v[1] * w1 + v[2] * w2 + v[3] * w3; }
            }
#pragma unroll
            for (int b = 0; b < 16; ++b) red[(c.wave * 16 + b) * 64 + c.lane] = acc[b];
            __syncthreads();
            for (int i = c.tid; i < 16 * 64; i += NTHR) { const int b = i >> 6, ln = i & 63; float s = 0.f;
#pragma unroll
                for (int w = 0; w < 8; ++w) s += red[(w * 16 + b) * 64 + ln];
                MOD[((size_t)l * 16 + b) * 6144 + cg * 64 + ln] = s + c.in[IN_ADAB][l * 6144 + cg * 64 + ln]; }
            __syncthreads();
        }
        __syncthreads();
    }
    {
        LAS float* scr = (LAS float*)(c.lds + c.wave * 16384);
        const int gw = c.bid * NWAVES + c.wave, NGW = c.nblk * NWAVES;
        constexpr int I_WIN = (NINP / 32) * (1024 / 64), I_UP = (1024 / 32) * (512 / 64), I_WO = (1024 / 32) * (1024 / 64);
        constexpr int PER_L = I_WIN + 2 * I_UP + I_WO;
        for (int it = gw; it < NL * PER_L; it += NGW) {
            const int l = it / PER_L; int r = it % PER_L;
            if (r < I_WIN) { SrcWin s{c.in[IN_WIN] + (size_t)l * 1024 * NIN, NIN}; tr_item(s, (bf16*)(c.ws + WS_WIN) + (size_t)l * NINP * 1024, 1024, (r / 16) * 32, (r % 16) * 64, scr, c.lane); continue; }
            r -= I_WIN;
            if (r < I_UP) { SrcPlain s{c.in[IN_WUPA] + (size_t)l * 512 * 1024, 1024}; tr_item(s, (bf16*)(c.ws + WS_WUPA) + (size_t)l * 1024 * 512, 512, (r / 8) * 32, (r % 8) * 64, scr, c.lane); continue; }
            r -= I_UP;
            if (r < I_UP) { SrcPlain s{c.in[IN_WUPC] + (size_t)l * 512 * 1024, 1024}; tr_item(s, (bf16*)(c.ws + WS_WUPC) + (size_t)l * 1024 * 512, 512, (r / 8) * 32, (r % 8) * 64, scr, c.lane); continue; }
            r -= I_UP;
            { SrcPlain s{c.in[IN_WO] + (size_t)l * 1024 * 1024, 1024}; tr_item(s, (bf16*)(c.ws + WS_WO) + (size_t)l * 1024 * 1024, 1024, (r / 16) * 32, (r % 16) * 64, scr, c.lane); }
        }
    }
    {
        const int gt = c.bid * NTHR + c.tid, NGT = c.nblk * NTHR;
        for (int i = gt; i < T; i += NGT) ((int*)(c.ws + WS_IDENT))[i] = i;
        for (int it = gt; it < NL * 1280 * 32; it += NGT) {
            const int l = it / (1280 * 32), rem = it % (1280 * 32), n = rem / 32, r0 = (rem % 32) * 8;
            const float* gq = c.in[IN_DSA_NQ] + l * 256;
            float o[8];
            if (n < 1024) {
                const int h = n >> 7, cc = n & 127;
                const float* uk = c.in[IN_DSA_WUK] + (size_t)l * 128 * 512 + (size_t)cc * 512 + h * 64;
#pragma unroll
                for (int i = 0; i < 8; ++i) { const float* uq = c.in[IN_DSA_WUQ] + (size_t)l * 256 * 512 + (size_t)(r0 + i) * 512 + h * 64; float s = 0.f;
                    for (int d = 0; d < 64; ++d) s += uq[d] * uk[d];
                    o[i] = s * (0.125f * 1.4426950408889634f) * gq[r0 + i]; }
            } else {
                const int m = n - 1024;
#pragma unroll
                for (int i = 0; i < 8; ++i) o[i] = c.in[IN_DSA_WQI][(size_t)l * 256 * 256 + (size_t)(r0 + i) * 256 + m] * 0.17677669529663687f * gq[r0 + i];
            }
            u32x4 w; w.x = pk2(o[0], o[1]); w.y = pk2(o[2], o[3]); w.z = pk2(o[4], o[5]); w.w = pk2(o[6], o[7]);
            *(u32x4*)((bf16*)(c.ws + WS_WQ) + (size_t)l * 1280 * 256 + (size_t)n * 256 + r0) = w;
        }
    }
    {
        const int gt = c.bid * NTHR + c.tid, NGT = c.nblk * NTHR;
        for (int it = gt; it < NL * 128 * 1024; it += NGT) {
            const int l = it / (128 * 1024), rem = it % (128 * 1024), kc = rem / 1024, n = rem % 1024;
            const int h = kc >> 4, r0 = (kc & 15) * 8;
            const float* uv = c.in[IN_DSA_WUV] + (size_t)l * 128 * 512;
            const float* ub = c.in[IN_WUPB] + (size_t)l * 512 * 1024 + (size_t)(h * 64) * 1024 + n;
            float o[8];
#pragma unroll
            for (int i = 0; i < 8; ++i) o[i] = 0.f;
            for (int v = 0; v < 64; ++v) { const float b = ub[(size_t)v * 1024];
#pragma unroll
                for (int i = 0; i < 8; ++i) o[i] += uv[(size_t)(r0 + i) * 512 + h * 64 + v] * b; }
            u32x4 w; w.x = pk2(o[0], o[1]); w.y = pk2(o[2], o[3]); w.z = pk2(o[4], o[5]); w.w = pk2(o[6], o[7]);
            *(u32x4*)((bf16*)(c.ws + WS_WUVB) + (size_t)l * 1024 * 1024 + (size_t)n * 1024 + h * 128 + r0) = w;
        }
    }
}

__device__ __forceinline__ void norm_mod_row(const float* xrow, const float* gain, const float* sh, const float* sc, bf16* orow, int lane) {
    f32x4 v[4]; float s = 0.f;
#pragma unroll
    for (int j = 0; j < 4; ++j) { v[j] = *(const f32x4*)(xrow + 4 * (lane + 64 * j)); s += v[j][0] * v[j][0] + v[j][1] * v[j][1] + v[j][2] * v[j][2] + v[j][3] * v[j][3]; }
    const float rstd = rsqrtf(wave_sum(s) * (1.f / D) + EPS);
#pragma unroll
    for (int j = 0; j < 4; ++j) { const int cc = 4 * (lane + 64 * j);
        const f32x4 g = *(const f32x4*)(gain + cc), a = *(const f32x4*)(sc + cc), b = *(const f32x4*)(sh + cc);
        st_bf4(orow + cc, v[j] * rstd * g * (a + 1.f) + b); }
}
__device__ __forceinline__ void phase_norm1(const Ctx& c, int l, const float* xsrc) {
    const int gw = c.bid * NWAVES + c.wave, NGW = c.nblk * NWAVES;
    const float* MOD = (const float*)(c.ws + WS_MOD) + (size_t)l * 16 * 6144;
    bf16* XN = (bf16*)(c.ws + WS_XN);
    for (int t = gw; t < T; t += NGW) { const int b = t >> 11;
        norm_mod_row(xsrc + (size_t)t * D, c.in[IN_NMIX] + l * D, MOD + (size_t)b * 6144, MOD + (size_t)b * 6144 + 1024, XN + (size_t)t * D, c.lane); }
}

__device__ __forceinline__ void phase_prep(const Ctx& c, int l) {
    const int gw = c.bid * NWAVES + c.wave, NGW = c.nblk * NWAVES;
    const bf16* PB = (const bf16*)(c.ws + WS_PB); const float* SM = (const float*)(c.ws + WS_SM);
    bf16* CKVN = (bf16*)(c.ws + WS_CKVN); bf16* KIDX = (bf16*)(c.ws + WS_KIDX); float* RSTDQ = (float*)(c.ws + WS_RSTDQ);
    const float* gkv = c.in[IN_DSA_NKV] + l * 128;
    const float g0 = gkv[2 * c.lane], g1 = gkv[2 * c.lane + 1];
    for (int t = gw; t < T; t += NGW) {
        const bf16* row = PB + (size_t)t * NPB;
        const unsigned kv = *(const unsigned*)(row + PB_CKV + 2 * c.lane);
        const float k0 = bflo(kv), k1 = bfhi(kv);
        const float rs = rsqrtf(wave_sum(k0 * k0 + k1 * k1) * (1.f / 128.f) + EPS);
        *(unsigned*)(CKVN + (size_t)t * 128 + 2 * c.lane) = pk2(k0 * rs * g0, k1 * rs * g1);
        const f32x4 q = ld_bf4(row + PB_CQ + 4 * c.lane);
        const float rq = rsqrtf(wave_sum(q[0] * q[0] + q[1] * q[1] + q[2] * q[2] + q[3] * q[3]) * (1.f / 256.f) + EPS);
        if (c.lane == 0) RSTDQ[t] = rq;
        if (c.lane < 32) KIDX[(size_t)t * 32 + c.lane] = (bf16)f2bf(SM[(size_t)t * 128 + SM_KIDX + c.lane]);
    }
}
__device__ __forceinline__ void phase_ckvt(const Ctx& c) {
    const bf16* CKVN = (const bf16*)(c.ws + WS_CKVN); bf16* CKVT = (bf16*)(c.ws + WS_CKVT);
    LAS bf16* tile = (LAS bf16*)c.lds;
    for (int it = c.bid; it < T / 64; it += c.nblk) {
        const int tb = it * 64, b = tb >> 11, p0 = tb & 2047;
        __syncthreads();
        { const int r = c.tid >> 3, ch = (c.tid & 7) * 8;
          *(LAS u32x4*)(tile + r * 136 + ch) = *(const u32x4*)(CKVN + (size_t)(tb + r) * 128 + ch); *(LAS u32x4*)(tile + r * 136 + 64 + ch) = *(const u32x4*)(CKVN + (size_t)(tb + r) * 128 + 64 + ch); }
        __syncthreads();
        { const int r = c.tid >> 2, part = c.tid & 3;
          unsigned w[8];
#pragma unroll
          for (int j = 0; j < 8; ++j) w[j] = (unsigned)tile[(16 * part + 2 * j) * 136 + r] | ((unsigned)tile[(16 * part + 2 * j + 1) * 136 + r] << 16);
          bf16* dst = CKVT + ((size_t)b * 128 + r) * 2048 + p0 + 16 * part;
          *(u32x4*)dst = (u32x4){w[0], w[1], w[2], w[3]}; *(u32x4*)(dst + 8) = (u32x4){w[4], w[5], w[6], w[7]}; }
    }
    __syncthreads();
}

constexpr int TS = 16;
__device__ __forceinline__ void scan_gla_item(const Ctx& c, int l, int b, int h) {
    LAS float* q_s = (LAS float*)c.lds;
    LAS float* k_s = q_s + TS * 64;
    LAS float* a_s = k_s + TS * 64;
    LAS float* v_s = a_s + TS * 64;
    LAS float* part = v_s + TS * 128;
    LAS float* wa2 = part + TS * 4 * 128;
    LAS float* ba = wa2 + 16 * 64;
    LAS float* alr = ba + 64;
    const bf16* PB = (const bf16*)(c.ws + WS_PB); const float* SM = (const float*)(c.ws + WS_SM);
    bf16* UA = (bf16*)(c.ws + WS_UA);
    const float* gn = c.in[IN_GLA_NORM] + l * 512 + h * 128;
    for (int i = c.tid; i < 16 * 64; i += NTHR) wa2[i] = c.in[IN_GLA_WA2][(size_t)l * 16 * 256 + (i >> 6) * 256 + h * 64 + (i & 63)];
    if (c.tid < 64) ba[c.tid] = c.in[IN_GLA_BA][l * 256 + h * 64 + c.tid];
    const int v = c.tid & 127, kg = c.tid >> 7;
    float S[16];
#pragma unroll
    for (int i = 0; i < 16; ++i) S[i] = 0.f;
    for (int t0 = 0; t0 < SEQ; t0 += TS) {
        __syncthreads();
        const size_t rb = (size_t)b * SEQ + t0;
        for (int i = c.tid; i < TS * 64; i += NTHR) { const int s = i >> 6, cc = i & 63; const bf16* row = PB + (rb + s) * NPB;
            q_s[i] = bf2f(row[PB_QA + h * 64 + cc]) * 0.125f; k_s[i] = bf2f(row[PB_KA + h * 64 + cc]); }
        for (int i = c.tid; i < TS * 128; i += NTHR) { const int s = i >> 7, cc = i & 127; v_s[i] = bf2f(PB[(rb + s) * NPB + PB_VA + h * 128 + cc]); }
        if (c.tid < TS * 16) alr[c.tid] = SM[(rb + (c.tid >> 4)) * 128 + SM_ALR + (c.tid & 15)];
        __syncthreads();
        for (int i = c.tid; i < TS * 64; i += NTHR) { const int s = i >> 6, cc = i & 63; float x = ba[cc];
#pragma unroll
            for (int j = 0; j < 16; ++j) x += alr[s * 16 + j] * wa2[j * 64 + cc];
            a_s[i] = __expf(logsigmoidf_(x) * (1.f / 16.f)); }
        __syncthreads();
#pragma unroll 1
        for (int s = 0; s < TS; ++s) {
            const float vv = v_s[s * 128 + v]; float acc = 0.f;
#pragma unroll
            for (int i4 = 0; i4 < 4; ++i4) {
                const f32x4 a4 = *(const LAS f32x4*)(a_s + s * 64 + kg * 16 + i4 * 4), k4 = *(const LAS f32x4*)(k_s + s * 64 + kg * 16 + i4 * 4), q4 = *(const LAS f32x4*)(q_s + s * 64 + kg * 16 + i4 * 4);
#pragma unroll
                for (int j = 0; j < 4; ++j) { S[i4 * 4 + j] = a4[j] * S[i4 * 4 + j] + k4[j] * vv; acc += q4[j] * S[i4 * 4 + j]; }
            }
            part[(s * 4 + kg) * 128 + v] = acc;
        }
        __syncthreads();
        {
            const int s = c.tid >> 5, vq = c.tid & 31, v0 = vq * 4;
            f32x4 o = (f32x4){0.f, 0.f, 0.f, 0.f};
#pragma unroll
            for (int g = 0; g < 4; ++g) o += *(const LAS f32x4*)(part + (s * 4 + g) * 128 + v0);
            float ss = o[0] * o[0] + o[1] * o[1] + o[2] * o[2] + o[3] * o[3];
#pragma unroll
            for (int m = 1; m < 32; m <<= 1) ss += __shfl_xor(ss, m);
            const float rstd = rsqrtf(ss * (1.f / 128.f) + EPS);
            const f32x4 ga = ld_bf4(PB + (rb + s) * NPB + PB_GA + h * 128 + v0);
            f32x4 r;
#pragma unroll
            for (int j = 0; j < 4; ++j) r[j] = o[j] * rstd * gn[v0 + j] * siluf_(ga[j]);
            st_bf4(UA + (rb + s) * 512 + h * 128 + v0, r);
        }
    }
    __syncthreads();
}
__device__ __forceinline__ void scan_mlstm_item(const Ctx& c, int l, int b, int h) {
    LAS float* q_s = (LAS float*)c.lds;
    LAS float* k_s = q_s + TS * 64;
    LAS float* v_s = k_s + TS * 64;
    LAS float* part = v_s + TS * 128;
    LAS float* dpart = part + TS * 4 * 128;
    LAS float* lf_s = dpart + TS * 4;
    LAS float* ip_s = lf_s + TS;
    LAS float* m_s = ip_s + TS;
    LAS float* cw = m_s + TS;
    const bf16* PB = (const bf16*)(c.ws + WS_PB); const float* SM = (const float*)(c.ws + WS_SM);
    bf16* UC = (bf16*)(c.ws + WS_UC);
    const float* mn = c.in[IN_ML_NORM] + l * 512 + h * 128;
    if (c.tid < 4 * 128) { const int j = c.tid >> 7, cc = c.tid & 127; cw[c.tid] = c.in[IN_ML_CONV][(size_t)l * 4 * 512 + j * 512 + (cc < 64 ? h * 64 + cc : 256 + h * 64 + (cc - 64))]; }
    const float bi = c.in[IN_ML_BI][l * 4 + h], bfv = c.in[IN_ML_BF][l * 4 + h];
    const int v = c.tid & 127, kg = c.tid >> 7;
    float C[16], n[16]; float m = 0.f;
#pragma unroll
    for (int i = 0; i < 16; ++i) { C[i] = 0.f; n[i] = 0.f; }
    for (int t0 = 0; t0 < SEQ; t0 += TS) {
        __syncthreads();
        const size_t rb = (size_t)b * SEQ + t0;
        for (int i = c.tid; i < TS * 128; i += NTHR) { const int s = i >> 7, cc = i & 127;
            const int col = cc < 64 ? PB_QC + h * 64 + cc : PB_KC + h * 64 + (cc - 64);
            float x = 0.f;
#pragma unroll
            for (int j = 0; j < 4; ++j) { const int tt = t0 + s - 3 + j; if (tt >= 0) x += cw[j * 128 + cc] * bf2f(PB[((size_t)b * SEQ + tt) * NPB + col]); }
            x = siluf_(x);
            if (cc < 64) q_s[s * 64 + cc] = x * 0.125f; else k_s[s * 64 + (cc - 64)] = x; }
        for (int i = c.tid; i < TS * 128; i += NTHR) { const int s = i >> 7, cc = i & 127; v_s[i] = bf2f(PB[(rb + s) * NPB + PB_VC + h * 128 + cc]); }
        if (c.tid < TS) { ip_s[c.tid] = SM[(rb + c.tid) * 128 + SM_IC + h] + bi; lf_s[c.tid] = logsigmoidf_(SM[(rb + c.tid) * 128 + SM_FC + h] + bfv); }
        __syncthreads();
#pragma unroll 1
        for (int s = 0; s < TS; ++s) {
            const float lf = lf_s[s], ip = ip_s[s];
            const float mnew = fmaxf(lf + m, ip), fg = __expf(lf + m - mnew), ig = __expf(ip - mnew);
            m = mnew;
            const float vv = v_s[s * 128 + v] * ig; float num = 0.f, den = 0.f;
#pragma unroll
            for (int i4 = 0; i4 < 4; ++i4) {
                const f32x4 k4 = *(const LAS f32x4*)(k_s + s * 64 + kg * 16 + i4 * 4), q4 = *(const LAS f32x4*)(q_s + s * 64 + kg * 16 + i4 * 4);
#pragma unroll
                for (int j = 0; j < 4; ++j) { C[i4 * 4 + j] = fg * C[i4 * 4 + j] + k4[j] * vv; n[i4 * 4 + j] = fg * n[i4 * 4 + j] + ig * k4[j]; num += q4[j] * C[i4 * 4 + j]; den += q4[j] * n[i4 * 4 + j]; }
            }
            part[(s * 4 + kg) * 128 + v] = num;
            if (v == 0) dpart[s * 4 + kg] = den;
            if (c.tid == 0) m_s[s] = m;
        }
        __syncthreads();
        {
            const int s = c.tid >> 5, vq = c.tid & 31, v0 = vq * 4;
            f32x4 o = (f32x4){0.f, 0.f, 0.f, 0.f};
#pragma unroll
            for (int g = 0; g < 4; ++g) o += *(const LAS f32x4*)(part + (s * 4 + g) * 128 + v0);
            const float den = dpart[s * 4] + dpart[s * 4 + 1] + dpart[s * 4 + 2] + dpart[s * 4 + 3];
            const float dd = 1.f / fmaxf(fabsf(den), __expf(-m_s[s]));
            o = o * dd;
            float ss = o[0] * o[0] + o[1] * o[1] + o[2] * o[2] + o[3] * o[3];
#pragma unroll
            for (int mm = 1; mm < 32; mm <<= 1) ss += __shfl_xor(ss, mm);
            const float rstd = rsqrtf(ss * (1.f / 128.f) + EPS);
            const f32x4 oc = ld_bf4(PB + (rb + s) * NPB + PB_OC + h * 128 + v0);
            f32x4 r;
#pragma unroll
            for (int j = 0; j < 4; ++j) r[j] = o[j] * rstd * mn[v0 + j] * sigmoidf_(oc[j]);
            st_bf4(UC + (rb + s) * 512 + h * 128 + v0, r);
        }
    }
    __syncthreads();
}

constexpr int LQ = 72;
constexpr int SC_QT = 0, SC_KT = 9216, SC_KTT = 18432, SC_Q2 = 27648, SC_SC = 36864, SC_VT = 46080, SC_ST = 66816, SC_FL = 108288;
__device__ __forceinline__ float wave_scan_add(float x, int lane) {
#pragma unroll
    for (int d = 1; d < 64; d <<= 1) { const float y = __shfl_up(x, d); if (lane >= d) x += y; }
    return x;
}
__device__ __forceinline__ float wave_scan_max(float x, int lane) {
#pragma unroll
    for (int d = 1; d < 64; d <<= 1) { const float y = __shfl_up(x, d); if (lane >= d) x = fmaxf(x, y); }
    return x;
}
__device__ __forceinline__ void unpack8(u32x4 w, float (&f)[8]) { f[0] = bflo(w.x); f[1] = bfhi(w.x); f[2] = bflo(w.y); f[3] = bfhi(w.y); f[4] = bflo(w.z); f[5] = bfhi(w.z); f[6] = bflo(w.w); f[7] = bfhi(w.w); }
__device__ __forceinline__ u32x4 pack8(const float (&f)[8]) { u32x4 w; w.x = pk2(f[0], f[1]); w.y = pk2(f[2], f[3]); w.z = pk2(f[4], f[5]); w.w = pk2(f[6], f[7]); return w; }
template <bool ML>
__device__ __forceinline__ void scan_chunked_item(const Ctx& c, int l, int b, int h) {
    LAS bf16* Qt0 = (LAS bf16*)(c.lds + SC_QT); LAS bf16* Kt0 = (LAS bf16*)(c.lds + SC_KT); LAS bf16* KtT0 = (LAS bf16*)(c.lds + SC_KTT);
    LAS bf16* Q20 = (LAS bf16*)(c.lds + SC_Q2); LAS bf16* Sc0 = (LAS bf16*)(c.lds + SC_SC); LAS bf16* VT0 = (LAS bf16*)(c.lds + SC_VT);
    LAS bf16* ST0 = (LAS bf16*)(c.lds + SC_ST);
    LAS float* segtot = (LAS float*)(c.lds + SC_FL);
    LAS float* etot = segtot + 512;
    LAS float* ssq = etot + 64;
    LAS float* dn = ssq + 512;
    LAS float* wa2 = dn + 64;
    LAS float* ba = wa2 + 1024;
    LAS float* cw = ba + 64;
    const int tid = c.tid, lane = c.lane, w = c.wave, fr = lane & 15, fq = lane >> 4;
    const int srow = tid >> 3, kg = tid & 7, k8 = kg * 8, vrow = tid >> 4, vc8 = (tid & 15) * 8;
    const bf16* PB = (const bf16*)(c.ws + WS_PB); const float* SM = (const float*)(c.ws + WS_SM);
    bf16* UO = (bf16*)(c.ws + (ML ? WS_UC : WS_UA));
    const int QCOL = (ML ? PB_QC : PB_QA) + h * 64, KCOL = (ML ? PB_KC : PB_KA) + h * 64, VCOL = (ML ? PB_VC : PB_VA) + h * 128, GCOL = (ML ? PB_OC : PB_GA) + h * 128;
    const float* gnorm = c.in[ML ? IN_ML_NORM : IN_GLA_NORM] + l * 512 + h * 128;
    __syncthreads();
    if (!ML) { for (int i = tid; i < 1024; i += NTHR) wa2[i] = c.in[IN_GLA_WA2][(size_t)l * 16 * 256 + (i >> 6) * 256 + h * 64 + (i & 63)];
               if (tid < 64) ba[tid] = c.in[IN_GLA_BA][l * 256 + h * 64 + tid]; }
    else { if (tid < 512) { const int j = tid >> 7, cc = tid & 127; cw[tid] = c.in[IN_ML_CONV][(size_t)l * 4 * 512 + j * 512 + (cc < 64 ? h * 64 + cc : 256 + h * 64 + (cc - 64))]; } }
    for (int i = tid; i < 144 * LQ / 2; i += NTHR) ((LAS unsigned*)ST0)[i] = 0u;
    if (ML) { for (int i = tid; i < 16 * LQ; i += NTHR) VT0[128 * LQ + i] = (i < 64) ? (bf16)0x3f80u : (bf16)0u; }
    const float bi = ML ? c.in[IN_ML_BI][l * 4 + h] : 0.f, bfv = ML ? c.in[IN_ML_BF][l * 4 + h] : 0.f;
    float m_prev = 0.f;
    f32x4 Sacc[4], Nacc = (f32x4){0.f, 0.f, 0.f, 0.f};
#pragma unroll
    for (int i = 0; i < 4; ++i) Sacc[i] = (f32x4){0.f, 0.f, 0.f, 0.f};
    u32x4 rq[ML ? 4 : 1], rk[ML ? 4 : 1], rv[2]; f32x4 ra[4]; float ric = 0.f, rfc = 0.f;
    const u32x4 z4 = (u32x4){0u, 0u, 0u, 0u};
#define SC_LOAD(cch) do { const size_t _g = (size_t)b * SEQ + (size_t)(cch) * 64; \
        if (ML) { _Pragma("unroll") for (int _j = 0; _j < 4; ++_j) { const int _tt = (cch) * 64 + srow - 3 + _j; \
                rq[_j] = _tt >= 0 ? *(const u32x4*)(PB + ((size_t)b * SEQ + _tt) * NPB + QCOL + k8) : z4; rk[_j] = _tt >= 0 ? *(const u32x4*)(PB + ((size_t)b * SEQ + _tt) * NPB + KCOL + k8) : z4; } \
            ric = SM[(_g + lane) * 128 + SM_IC + h]; rfc = SM[(_g + lane) * 128 + SM_FC + h]; } \
        else { rq[0] = *(const u32x4*)(PB + (_g + srow) * NPB + QCOL + k8); rk[0] = *(const u32x4*)(PB + (_g + srow) * NPB + KCOL + k8); \
            _Pragma("unroll") for (int _j = 0; _j < 4; ++_j) ra[_j] = *(const f32x4*)(SM + (_g + srow) * 128 + SM_ALR + 4 * _j); } \
        rv[0] = *(const u32x4*)(PB + (_g + vrow) * NPB + VCOL + vc8); rv[1] = *(const u32x4*)(PB + (_g + 32 + vrow) * NPB + VCOL + vc8); } while (0)
    SC_LOAD(0);
    __syncthreads();
#pragma unroll 1
    for (int cch = 0; cch < SEQ / 64; ++cch) {
        const size_t grow = (size_t)b * SEQ + (size_t)cch * 64;
        int lz; asm volatile("v_mov_b32 %0, 0" : "=v"(lz));
        LAS bf16* Qt = Qt0 + lz; LAS bf16* Kt = Kt0 + lz; LAS bf16* KtT = KtT0 + lz; LAS bf16* Q2 = Q20 + lz; LAS bf16* Sc = Sc0 + lz; LAS bf16* VT = VT0 + lz; LAS bf16* ST = ST0 + lz;
        LAS bf16* STc = ST + (cch & 1) * 144 * LQ; LAS bf16* STn = ST + ((cch & 1) ^ 1) * 144 * LQ;
        float qv[8], kv[8];
        float g_a = 0.f, g_M = 0.f, g_bc = 0.f, M63 = 0.f, wc = 1.f;
        if (!ML) {
            unpack8(rq[0], qv); unpack8(rk[0], kv);
            float la[8];
#pragma unroll
            for (int i = 0; i < 8; ++i) la[i] = ba[k8 + i];
#pragma unroll
            for (int j4 = 0; j4 < 4; ++j4)
#pragma unroll
                for (int jj = 0; jj < 4; ++jj) { const float a = ra[j4][jj]; const LAS float* wr_ = wa2 + (j4 * 4 + jj) * 64 + k8;
                    const f32x4 w0 = *(const LAS f32x4*)wr_, w1 = *(const LAS f32x4*)(wr_ + 4);
                    la[0] += a * w0[0]; la[1] += a * w0[1]; la[2] += a * w0[2]; la[3] += a * w0[3]; la[4] += a * w1[0]; la[5] += a * w1[1]; la[6] += a * w1[2]; la[7] += a * w1[3]; }
#pragma unroll
            for (int i = 0; i < 8; ++i) { float x = logsigmoid_fast(la[i]) * (1.f / 16.f);
#pragma unroll
                for (int d = 8; d < 64; d <<= 1) { const float y = __shfl_up(x, d); if (lane >= d) x += y; }
                la[i] = x; }
            if ((lane >> 3) == 7) { *(LAS f32x4*)(segtot + w * 64 + k8) = (f32x4){la[0], la[1], la[2], la[3]}; *(LAS f32x4*)(segtot + w * 64 + k8 + 4) = (f32x4){la[4], la[5], la[6], la[7]}; }
            lds_barrier();
            float tot[8];
#pragma unroll
            for (int i = 0; i < 8; ++i) tot[i] = 0.f;
#pragma unroll
            for (int ww = 0; ww < 8; ++ww) { const f32x4 s0 = *(const LAS f32x4*)(segtot + ww * 64 + k8), s1 = *(const LAS f32x4*)(segtot + ww * 64 + k8 + 4);
                const float sel = ww < w ? 1.f : 0.f;
                la[0] += sel * s0[0]; la[1] += sel * s0[1]; la[2] += sel * s0[2]; la[3] += sel * s0[3]; la[4] += sel * s1[0]; la[5] += sel * s1[1]; la[6] += sel * s1[2]; la[7] += sel * s1[3];
                tot[0] += s0[0]; tot[1] += s0[1]; tot[2] += s0[2]; tot[3] += s0[3]; tot[4] += s1[0]; tot[5] += s1[1]; tot[6] += s1[2]; tot[7] += s1[3]; }
            if (tid < 8) {
#pragma unroll
                for (int i = 0; i < 8; ++i) etot[k8 + i] = __expf(tot[i]); }
            float kt[8];
#pragma unroll
            for (int i = 0; i < 8; ++i) { qv[i] = qv[i] * 0.125f * __expf(la[i]); kt[i] = kv[i] * __expf(-la[i]); }
            *(LAS u32x4*)(Qt + srow * LQ + k8) = pack8(qv); *(LAS u32x4*)(Kt + srow * LQ + k8) = pack8(kt);
#pragma unroll
            for (int i = 0; i < 8; ++i) KtT[(k8 + i) * LQ + srow] = (bf16)f2bf(kt[i]);
        } else {
            float x4[4][8];
#pragma unroll
            for (int j = 0; j < 4; ++j) unpack8(rq[j], x4[j]);
#pragma unroll
            for (int i = 0; i < 8; ++i) { float x = 0.f;
#pragma unroll
                for (int j = 0; j < 4; ++j) x += cw[j * 128 + k8 + i] * x4[j][i];
                qv[i] = siluf_(x) * 0.125f; }
#pragma unroll
            for (int j = 0; j < 4; ++j) unpack8(rk[j], x4[j]);
#pragma unroll
            for (int i = 0; i < 8; ++i) { float x = 0.f;
#pragma unroll
                for (int j = 0; j < 4; ++j) x += cw[j * 128 + 64 + k8 + i] * x4[j][i];
                kv[i] = siluf_(x); }
            const float lf = logsigmoid_fast(rfc + bfv), ip = ric + bi;
            g_bc = wave_scan_add(lf, lane); g_a = ip - g_bc;
            const float pm = wave_scan_max(g_a, lane); g_M = fmaxf(m_prev, pm);
            M63 = __shfl(g_M, 63); const float totb = __shfl(g_bc, 63);
            wc = __expf(m_prev - M63);
            const float Ms = __shfl(g_M, srow), as = __shfl(g_a, srow);
            const float e1 = __expf(m_prev - Ms), e2 = __expf(as - M63);
            float q2[8], kw[8];
#pragma unroll
            for (int i = 0; i < 8; ++i) { q2[i] = qv[i] * e1; kw[i] = kv[i] * e2; }
            *(LAS u32x4*)(Qt + srow * LQ + k8) = pack8(qv); *(LAS u32x4*)(Kt + srow * LQ + k8) = pack8(kv); *(LAS u32x4*)(Q2 + srow * LQ + k8) = pack8(q2);
#pragma unroll
            for (int i = 0; i < 8; ++i) KtT[(k8 + i) * LQ + srow] = (bf16)f2bf(kw[i]);
            m_prev = totb + M63;
        }
        { float v0[8], v1[8]; unpack8(rv[0], v0); unpack8(rv[1], v1);
#pragma unroll
          for (int i = 0; i < 8; ++i) { VT[(vc8 + i) * LQ + vrow] = (bf16)f2bf(v0[i]); VT[(vc8 + i) * LQ + 32 + vrow] = (bf16)f2bf(v1[i]); } }
        u32x2 gate[4];
#pragma unroll
        for (int ti = 0; ti < 4; ++ti) gate[ti] = *(const u32x2*)(PB + (grow + 16 * ti + fr) * NPB + GCOL + 16 * w + 4 * fq);
        if (cch + 1 < SEQ / 64) SC_LOAD(cch + 1);
        lds_barrier();
        {
            const int ti = w >> 1;
#pragma unroll
            for (int u = 0; u < 2; ++u) {
                const int sj = 2 * (w & 1) + u;
                f32x4 d = (f32x4){0.f, 0.f, 0.f, 0.f};
                if (sj <= ti) {
#pragma unroll
                    for (int ks = 0; ks < 2; ++ks) { const bf16x8 a = *(const LAS bf16x8*)(Kt + (16 * sj + fr) * LQ + 32 * ks + 8 * fq), bb = *(const LAS bf16x8*)(Qt + (16 * ti + fr) * LQ + 32 * ks + 8 * fq);
                        d = __builtin_amdgcn_mfma_f32_16x16x32_bf16(a, bb, d, 0, 0, 0); }
                    const int t = 16 * ti + fr, s0 = 16 * sj + 4 * fq;
                    if (ML) { const float Mt = __shfl(g_M, t);
#pragma unroll
                        for (int r = 0; r < 4; ++r) { const float as = __shfl(g_a, s0 + r); d[r] = (s0 + r <= t) ? d[r] * __expf(as - Mt) : 0.f; } }
                    else {
#pragma unroll
                        for (int r = 0; r < 4; ++r) d[r] = (s0 + r <= t) ? d[r] : 0.f; }
                }
                { u32x2 pk; pk.x = pk2(d[0], d[1]); pk.y = pk2(d[2], d[3]); *(LAS u32x2*)(Sc + (16 * ti + fr) * LQ + 16 * sj + 4 * fq) = pk; }
            }
        }
        lds_barrier();
        const LAS bf16* Qm = ML ? Q2 : Qt;
        f32x4 o[4];
        {
            bf16x8 vt[2], stf[2];
#pragma unroll
            for (int ks = 0; ks < 2; ++ks) { vt[ks] = *(const LAS bf16x8*)(VT + (16 * w + fr) * LQ + 32 * ks + 8 * fq); stf[ks] = *(const LAS bf16x8*)(STc + (16 * w + fr) * LQ + 32 * ks + 8 * fq); }
#pragma unroll
            for (int ti = 0; ti < 4; ++ti) {
                f32x4 d = (f32x4){0.f, 0.f, 0.f, 0.f};
#pragma unroll
                for (int ks = 0; ks < 2; ++ks) { const bf16x8 sc = *(const LAS bf16x8*)(Sc + (16 * ti + fr) * LQ + 32 * ks + 8 * fq); d = __builtin_amdgcn_mfma_f32_16x16x32_bf16(vt[ks], sc, d, 0, 0, 0); }
#pragma unroll
                for (int ks = 0; ks < 2; ++ks) { const bf16x8 qq = *(const LAS bf16x8*)(Qm + (16 * ti + fr) * LQ + 32 * ks + 8 * fq); d = __builtin_amdgcn_mfma_f32_16x16x32_bf16(stf[ks], qq, d, 0, 0, 0); }
                o[ti] = d;
            }
#pragma unroll
            for (int kj = 0; kj < 4; ++kj) {
                f32x4 d = (f32x4){0.f, 0.f, 0.f, 0.f};
#pragma unroll
                for (int ks = 0; ks < 2; ++ks) { const bf16x8 kk = *(const LAS bf16x8*)(KtT + (16 * kj + fr) * LQ + 32 * ks + 8 * fq); d = __builtin_amdgcn_mfma_f32_16x16x32_bf16(kk, vt[ks], d, 0, 0, 0); }
                if (ML) Sacc[kj] = Sacc[kj] * wc + d;
                else { const f32x4 e4 = *(const LAS f32x4*)(etot + 16 * kj + 4 * fq); Sacc[kj] = e4 * (Sacc[kj] + d); }
                u32x2 pk; pk.x = pk2(Sacc[kj][0], Sacc[kj][1]); pk.y = pk2(Sacc[kj][2], Sacc[kj][3]);
                *(LAS u32x2*)(STn + (16 * w + fr) * LQ + 16 * kj + 4 * fq) = pk;
            }
            if (ML) {
                if (w < 4) {
                    f32x4 d = (f32x4){0.f, 0.f, 0.f, 0.f};
#pragma unroll
                    for (int ks = 0; ks < 2; ++ks) { const bf16x8 a = *(const LAS bf16x8*)(VT + (128 + fr) * LQ + 32 * ks + 8 * fq), sc = *(const LAS bf16x8*)(Sc + (16 * w + fr) * LQ + 32 * ks + 8 * fq);
                        d = __builtin_amdgcn_mfma_f32_16x16x32_bf16(a, sc, d, 0, 0, 0); }
#pragma unroll
                    for (int ks = 0; ks < 2; ++ks) { const bf16x8 a = *(const LAS bf16x8*)(STc + (128 + fr) * LQ + 32 * ks + 8 * fq), qq = *(const LAS bf16x8*)(Qm + (16 * w + fr) * LQ + 32 * ks + 8 * fq);
                        d = __builtin_amdgcn_mfma_f32_16x16x32_bf16(a, qq, d, 0, 0, 0); }
                    if (fq == 0) dn[16 * w + fr] = d[0];
                } else {
                    const int kj = w - 4;
                    f32x4 d = (f32x4){0.f, 0.f, 0.f, 0.f};
#pragma unroll
                    for (int ks = 0; ks < 2; ++ks) { const bf16x8 kk = *(const LAS bf16x8*)(KtT + (16 * kj + fr) * LQ + 32 * ks + 8 * fq), a = *(const LAS bf16x8*)(VT + (128 + fr) * LQ + 32 * ks + 8 * fq);
                        d = __builtin_amdgcn_mfma_f32_16x16x32_bf16(kk, a, d, 0, 0, 0); }
                    Nacc = Nacc * wc + d;
                    u32x2 pk; pk.x = pk2(Nacc[0], Nacc[1]); pk.y = pk2(Nacc[2], Nacc[3]);
                    *(LAS u32x2*)(STn + (128 + fr) * LQ + 16 * kj + 4 * fq) = pk;
                }
            }
        }
#pragma unroll
        for (int ti = 0; ti < 4; ++ti) { float p = o[ti][0] * o[ti][0] + o[ti][1] * o[ti][1] + o[ti][2] * o[ti][2] + o[ti][3] * o[ti][3];
            p += __shfl_xor(p, 16); p += __shfl_xor(p, 32);
            if (fq == 0) ssq[w * 64 + 16 * ti + fr] = p; }
        lds_barrier();
#pragma unroll
        for (int ti = 0; ti < 4; ++ti) {
            const int t = 16 * ti + fr;
            float ss = 0.f;
#pragma unroll
            for (int ww = 0; ww < 8; ++ww) ss += ssq[ww * 64 + t];
            float dd = 1.f;
            if (ML) { const float bc = __shfl(g_bc, t), Mt = __shfl(g_M, t); dd = 1.f / fmaxf(fabsf(dn[t]), __expf(-(bc + Mt))); }
            const float rstd = rsqrtf(ss * dd * dd * (1.f / 128.f) + EPS) * dd;
            const f32x4 gn = *(const f32x4*)(gnorm + 16 * w + 4 * fq);
            const float g0 = bflo(gate[ti].x), g1 = bfhi(gate[ti].x), g2 = bflo(gate[ti].y), g3 = bfhi(gate[ti].y);
            f32x4 r;
            if (ML) { r[0] = o[ti][0] * rstd * gn[0] * sigmoidf_(g0); r[1] = o[ti][1] * rstd * gn[1] * sigmoidf_(g1); r[2] = o[ti][2] * rstd * gn[2] * sigmoidf_(g2); r[3] = o[ti][3] * rstd * gn[3] * sigmoidf_(g3); }
            else { r[0] = o[ti][0] * rstd * gn[0] * siluf_(g0); r[1] = o[ti][1] * rstd * gn[1] * siluf_(g1); r[2] = o[ti][2] * rstd * gn[2] * siluf_(g2); r[3] = o[ti][3] * rstd * gn[3] * siluf_(g3); }
            st_bf4(UO + (grow + t) * 512 + h * 128 + 16 * w + 4 * fq, r);
        }
    }
#undef SC_LOAD
    __syncthreads();
}

template <bool ML>
__device__ __forceinline__ void scanA_loop(const Ctx& c, int l, int it0, int it_end, int stride) {
    LAS bf16* Qt0 = (LAS bf16*)(c.lds + SC_QT); LAS bf16* Kt0 = (LAS bf16*)(c.lds + SC_KT); LAS bf16* KtT0 = (LAS bf16*)(c.lds + SC_KTT);
    LAS bf16* Sc0 = (LAS bf16*)(c.lds + SC_SC); LAS bf16* VT0 = (LAS bf16*)(c.lds + SC_VT);
    LAS float* segtot = (LAS float*)(c.lds + SC_FL);
    LAS float* wa2 = segtot + 512 + 64 + 512 + 64;
    LAS float* ba = wa2 + 1024;
    LAS float* cw = ba + 64;
    const int tid = c.tid, lane = c.lane, w = c.wave, fr = lane & 15, fq = lane >> 4;
    const int srow = tid >> 3, kg = tid & 7, k8 = kg * 8, vrow = tid >> 4, vc8 = (tid & 15) * 8;
    const bf16* PB = (const bf16*)(c.ws + WS_PB); const float* SM = (const float*)(c.ws + WS_SM);
    bf16* UO = (bf16*)(c.ws + (ML ? WS_UC : WS_UA));
    bf16* QS = (bf16*)(c.ws + WS_QS) + (ML ? (size_t)T * 256 : 0);
    u32x4 rq[ML ? 4 : 1], rk[ML ? 4 : 1], rv[2]; f32x4 ra[4]; float ric = 0.f, rfc = 0.f;
    const u32x4 z4 = (u32x4){0u, 0u, 0u, 0u};
#define SA_LOAD(it_) do { const int _rem = (it_) & 2047, _seq = _rem >> 5, _cch = _rem & 31, _b = _seq >> 2, _h = _seq & 3; \
        const size_t _g = (size_t)_b * SEQ + (size_t)_cch * 64; \
        const int _qc = (ML ? PB_QC : PB_QA) + _h * 64, _kc = (ML ? PB_KC : PB_KA) + _h * 64, _vc = (ML ? PB_VC : PB_VA) + _h * 128; \
        if (ML) { _Pragma("unroll") for (int _j = 0; _j < 4; ++_j) { const int _tt = _cch * 64 + srow - 3 + _j; \
                rq[_j] = _tt >= 0 ? *(const u32x4*)(PB + ((size_t)_b * SEQ + _tt) * NPB + _qc + k8) : z4; rk[_j] = _tt >= 0 ? *(const u32x4*)(PB + ((size_t)_b * SEQ + _tt) * NPB + _kc + k8) : z4; } \
            ric = SM[(_g + lane) * 128 + SM_IC + _h]; rfc = SM[(_g + lane) * 128 + SM_FC + _h]; } \
        else { rq[0] = *(const u32x4*)(PB + (_g + srow) * NPB + _qc + k8); rk[0] = *(const u32x4*)(PB + (_g + srow) * NPB + _kc + k8); \
            _Pragma("unroll") for (int _j = 0; _j < 4; ++_j) ra[_j] = *(const f32x4*)(SM + (_g + srow) * 128 + SM_ALR + 4 * _j); } \
        rv[0] = *(const u32x4*)(PB + (_g + vrow) * NPB + _vc + vc8); rv[1] = *(const u32x4*)(PB + (_g + 32 + vrow) * NPB + _vc + vc8); } while (0)
    if (it0 < it_end) SA_LOAD(it0);
    int hprev = -1;
#pragma unroll 1
    for (int it = it0; it < it_end; it += stride) {
    const int rem_ = it & 2047, seq_ = rem_ >> 5, cch = rem_ & 31, b = seq_ >> 2, h = seq_ & 3;
    const int slot = (b * 4 + h) * 32 + cch;
    bf16* DS = ML ? (bf16*)(c.ws + WS_DSM) + (size_t)slot * 144 * 64 : (bf16*)(c.ws + WS_DSG) + (size_t)slot * 128 * 64;
    const size_t grow = (size_t)b * SEQ + (size_t)cch * 64;
    int lz; asm volatile("v_mov_b32 %0, 0" : "=v"(lz));
    LAS bf16* Qt = Qt0 + lz; LAS bf16* Kt = Kt0 + lz; LAS bf16* KtT = KtT0 + lz; LAS bf16* Sc = Sc0 + lz; LAS bf16* VT = VT0 + lz;
    __syncthreads();
    if (h != hprev) {
        if (!ML) { for (int i = tid; i < 1024; i += NTHR) wa2[i] = c.in[IN_GLA_WA2][(size_t)l * 16 * 256 + (i >> 6) * 256 + h * 64 + (i & 63)];
                   if (tid < 64) ba[tid] = c.in[IN_GLA_BA][l * 256 + h * 64 + tid]; }
        else { { const int j = tid >> 7, cc = tid & 127; cw[tid] = c.in[IN_ML_CONV][(size_t)l * 4 * 512 + j * 512 + (cc < 64 ? h * 64 + cc : 256 + h * 64 + (cc - 64))]; }
               for (int i = tid; i < 16 * LQ; i += NTHR) VT[128 * LQ + i] = (i < 64) ? (bf16)0x3f80u : (bf16)0u; }
        hprev = h;
        __syncthreads();
    }
    const float bi = ML ? c.in[IN_ML_BI][l * 4 + h] : 0.f, bfv = ML ? c.in[IN_ML_BF][l * 4 + h] : 0.f;
    float qv[8], kv[8];
    float g_a = 0.f, g_pm = 0.f;
    if (!ML) {
        unpack8(rq[0], qv); unpack8(rk[0], kv);
        float la[8];
#pragma unroll
        for (int i = 0; i < 8; ++i) la[i] = ba[k8 + i];
#pragma unroll
        for (int j4 = 0; j4 < 4; ++j4)
#pragma unroll
            for (int jj = 0; jj < 4; ++jj) { const float a = ra[j4][jj]; const LAS float* wr_ = wa2 + (j4 * 4 + jj) * 64 + k8;
                const f32x4 w0 = *(const LAS f32x4*)wr_, w1 = *(const LAS f32x4*)(wr_ + 4);
                la[0] += a * w0[0]; la[1] += a * w0[1]; la[2] += a * w0[2]; la[3] += a * w0[3]; la[4] += a * w1[0]; la[5] += a * w1[1]; la[6] += a * w1[2]; la[7] += a * w1[3]; }
#pragma unroll
        for (int i = 0; i < 8; ++i) { float x = logsigmoid_fast(la[i]) * (1.f / 16.f);
#pragma unroll
            for (int d = 8; d < 64; d <<= 1) { const float y = __shfl_up(x, d); if (lane >= d) x += y; }
            la[i] = x; }
        if ((lane >> 3) == 7) { *(LAS f32x4*)(segtot + w * 64 + k8) = (f32x4){la[0], la[1], la[2], la[3]}; *(LAS f32x4*)(segtot + w * 64 + k8 + 4) = (f32x4){la[4], la[5], la[6], la[7]}; }
        lds_barrier();
        float tot[8];
#pragma unroll
        for (int i = 0; i < 8; ++i) tot[i] = 0.f;
#pragma unroll
        for (int ww = 0; ww < 8; ++ww) { const f32x4 s0 = *(const LAS f32x4*)(segtot + ww * 64 + k8), s1 = *(const LAS f32x4*)(segtot + ww * 64 + k8 + 4);
            const float sel = ww < w ? 1.f : 0.f;
            la[0] += sel * s0[0]; la[1] += sel * s0[1]; la[2] += sel * s0[2]; la[3] += sel * s0[3]; la[4] += sel * s1[0]; la[5] += sel * s1[1]; la[6] += sel * s1[2]; la[7] += sel * s1[3];
            tot[0] += s0[0]; tot[1] += s0[1]; tot[2] += s0[2]; tot[3] += s0[3]; tot[4] += s1[0]; tot[5] += s1[1]; tot[6] += s1[2]; tot[7] += s1[3]; }
        if (tid < 8) { float* et = (float*)(c.ws + WS_ET) + (size_t)slot * 64 + k8;
            *(f32x4*)et = (f32x4){__expf(tot[0]), __expf(tot[1]), __expf(tot[2]), __expf(tot[3])}; *(f32x4*)(et + 4) = (f32x4){__expf(tot[4]), __expf(tot[5]), __expf(tot[6]), __expf(tot[7])}; }
        float kt[8];
#pragma unroll
        for (int i = 0; i < 8; ++i) { qv[i] = qv[i] * 0.125f * __expf(la[i]); kt[i] = kv[i] * __expf(-la[i]); }
        const u32x4 qp = pack8(qv);
        *(LAS u32x4*)(Qt + srow * LQ + k8) = qp; *(LAS u32x4*)(Kt + srow * LQ + k8) = pack8(kt);
        *(u32x4*)(QS + (grow + srow) * 256 + h * 64 + k8) = qp;
#pragma unroll
        for (int i = 0; i < 8; ++i) KtT[(k8 + i) * LQ + srow] = (bf16)f2bf(kt[i]);
    } else {
        float x4[4][8];
#pragma unroll
        for (int j = 0; j < 4; ++j) unpack8(rq[j], x4[j]);
#pragma unroll
        for (int i = 0; i < 8; ++i) { float x = 0.f;
#pragma unroll
            for (int j = 0; j < 4; ++j) x += cw[j * 128 + k8 + i] * x4[j][i];
            qv[i] = siluf_(x) * 0.125f; }
#pragma unroll
        for (int j = 0; j < 4; ++j) unpack8(rk[j], x4[j]);
#pragma unroll
        for (int i = 0; i < 8; ++i) { float x = 0.f;
#pragma unroll
            for (int j = 0; j < 4; ++j) x += cw[j * 128 + 64 + k8 + i] * x4[j][i];
            kv[i] = siluf_(x); }
        const float lf = logsigmoid_fast(rfc + bfv), ip = ric + bi;
        const float g_bc = wave_scan_add(lf, lane); g_a = ip - g_bc;
        g_pm = wave_scan_max(g_a, lane);
        const float pm63 = __shfl(g_pm, 63), totb = __shfl(g_bc, 63);
        if (w == 0) { ((float*)(c.ws + WS_GPM))[(grow + lane) * 4 + h] = g_pm; ((float*)(c.ws + WS_GBC))[(grow + lane) * 4 + h] = g_bc;
            if (lane == 0) { float* ct = (float*)(c.ws + WS_CT) + (size_t)slot * 2; ct[0] = totb; ct[1] = pm63; } }
        const float as = __shfl(g_a, srow);
        const float e2 = __expf(as - pm63);
        float kw[8];
#pragma unroll
        for (int i = 0; i < 8; ++i) kw[i] = kv[i] * e2;
        const u32x4 qp = pack8(qv);
        *(LAS u32x4*)(Qt + srow * LQ + k8) = qp; *(LAS u32x4*)(Kt + srow * LQ + k8) = pack8(kv);
        *(u32x4*)(QS + (grow + srow) * 256 + h * 64 + k8) = qp;
#pragma unroll
        for (int i = 0; i < 8; ++i) KtT[(k8 + i) * LQ + srow] = (bf16)f2bf(kw[i]);
    }
    { float v0[8], v1[8]; unpack8(rv[0], v0); unpack8(rv[1], v1);
#pragma unroll
      for (int i = 0; i < 8; ++i) { VT[(vc8 + i) * LQ + vrow] = (bf16)f2bf(v0[i]); VT[(vc8 + i) * LQ + 32 + vrow] = (bf16)f2bf(v1[i]); } }
    if (it + stride < it_end) SA_LOAD(it + stride);
    lds_barrier();
    {
        const int ti = w >> 1;
#pragma unroll
        for (int u = 0; u < 2; ++u) {
            const int sj = 2 * (w & 1) + u;
            f32x4 d = (f32x4){0.f, 0.f, 0.f, 0.f};
            if (sj <= ti) {
#pragma unroll
                for (int ks = 0; ks < 2; ++ks) { const bf16x8 a = *(const LAS bf16x8*)(Kt + (16 * sj + fr) * LQ + 32 * ks + 8 * fq), bb = *(const LAS bf16x8*)(Qt + (16 * ti + fr) * LQ + 32 * ks + 8 * fq);
                    d = __builtin_amdgcn_mfma_f32_16x16x32_bf16(a, bb, d, 0, 0, 0); }
                const int t = 16 * ti + fr, s0 = 16 * sj + 4 * fq;
                if (ML) { const float pt = __shfl(g_pm, t);
#pragma unroll
                    for (int r = 0; r < 4; ++r) { const float as = __shfl(g_a, s0 + r); d[r] = (s0 + r <= t) ? d[r] * __expf(as - pt) : 0.f; } }
                else {
#pragma unroll
                    for (int r = 0; r < 4; ++r) d[r] = (s0 + r <= t) ? d[r] : 0.f; }
            }
            { u32x2 pk; pk.x = pk2(d[0], d[1]); pk.y = pk2(d[2], d[3]); *(LAS u32x2*)(Sc + (16 * ti + fr) * LQ + 16 * sj + 4 * fq) = pk; }
        }
    }
    lds_barrier();
    {
        bf16x8 vt[2];
#pragma unroll
        for (int ks = 0; ks < 2; ++ks) vt[ks] = *(const LAS bf16x8*)(VT + (16 * w + fr) * LQ + 32 * ks + 8 * fq);
#pragma unroll
        for (int ti = 0; ti < 4; ++ti) {
            f32x4 d = (f32x4){0.f, 0.f, 0.f, 0.f};
#pragma unroll
            for (int ks = 0; ks < 2; ++ks) { const bf16x8 sc = *(const LAS bf16x8*)(Sc + (16 * ti + fr) * LQ + 32 * ks + 8 * fq); d = __builtin_amdgcn_mfma_f32_16x16x32_bf16(vt[ks], sc, d, 0, 0, 0); }
            st_bf4(UO + (grow + 16 * ti + fr) * 512 + h * 128 + 16 * w + 4 * fq, d);
        }
#pragma unroll
        for (int kj = 0; kj < 4; ++kj) {
            f32x4 d = (f32x4){0.f, 0.f, 0.f, 0.f};
#pragma unroll
            for (int ks = 0; ks < 2; ++ks) { const bf16x8 kk = *(const LAS bf16x8*)(KtT + (16 * kj + fr) * LQ + 32 * ks + 8 * fq); d = __builtin_amdgcn_mfma_f32_16x16x32_bf16(kk, vt[ks], d, 0, 0, 0); }
            st_bf4(DS + (16 * w + fr) * 64 + 16 * kj + 4 * fq, d);
        }
        if (ML) {
            if (w < 4) {
                f32x4 d = (f32x4){0.f, 0.f, 0.f, 0.f};
#pragma unroll
                for (int ks = 0; ks < 2; ++ks) { const bf16x8 a = *(const LAS bf16x8*)(VT + (128 + fr) * LQ + 32 * ks + 8 * fq), sc = *(const LAS bf16x8*)(Sc + (16 * w + fr) * LQ + 32 * ks + 8 * fq);
                    d = __builtin_amdgcn_mfma_f32_16x16x32_bf16(a, sc, d, 0, 0, 0); }
                if (fq == 0) ((float*)(c.ws + WS_DN))[(grow + 16 * w + fr) * 4 + h] = d[0];
            } else {
                const int kj = w - 4;
                f32x4 d = (f32x4){0.f, 0.f, 0.f, 0.f};
#pragma unroll
                for (int ks = 0; ks < 2; ++ks) { const bf16x8 kk = *(const LAS bf16x8*)(KtT + (16 * kj + fr) * LQ + 32 * ks + 8 * fq), a = *(const LAS bf16x8*)(VT + (128 + fr) * LQ + 32 * ks + 8 * fq);
                    d = __builtin_amdgcn_mfma_f32_16x16x32_bf16(kk, a, d, 0, 0, 0); }
                st_bf4(DS + (128 + fr) * 64 + 16 * kj + 4 * fq, d);
            }
        }
    }
    }
#undef SA_LOAD
}
__device__ __forceinline__ void scanB(const Ctx& c) {
    const int gt = c.bid * NTHR + c.tid, NGT = c.nblk * NTHR;
    constexpr int NG = 64 * 128 * 8, NM = 64 * 144 * 8;
    for (int idx = gt; idx < NG + NM; idx += NGT) {
        float S[8];
#pragma unroll
        for (int i = 0; i < 8; ++i) S[i] = 0.f;
        if (idx < NG) {
            const int seq = idx >> 10, v = (idx >> 3) & 127, kg = idx & 7;
            bf16* p = (bf16*)(c.ws + WS_DSG) + (size_t)seq * 32 * 8192 + v * 64 + kg * 8;
            const float* et = (const float*)(c.ws + WS_ET) + (size_t)seq * 32 * 64 + kg * 8;
#pragma unroll 1
            for (int c4 = 0; c4 < 32; c4 += 4) {
                u32x4 dv[4]; f32x4 e0[4], e1[4];
#pragma unroll
                for (int j = 0; j < 4; ++j) { dv[j] = *(const u32x4*)(p + (size_t)(c4 + j) * 8192); e0[j] = *(const f32x4*)(et + (c4 + j) * 64); e1[j] = *(const f32x4*)(et + (c4 + j) * 64 + 4); }
#pragma unroll
                for (int j = 0; j < 4; ++j) {
                    float d[8]; unpack8(dv[j], d);
                    const u32x4 sp = pack8(S);
                    S[0] = e0[j][0] * (S[0] + d[0]); S[1] = e0[j][1] * (S[1] + d[1]); S[2] = e0[j][2] * (S[2] + d[2]); S[3] = e0[j][3] * (S[3] + d[3]);
                    S[4] = e1[j][0] * (S[4] + d[4]); S[5] = e1[j][1] * (S[5] + d[5]); S[6] = e1[j][2] * (S[6] + d[6]); S[7] = e1[j][3] * (S[7] + d[7]);
                    *(u32x4*)(p + (size_t)(c4 + j) * 8192) = sp;
                }
            }
        } else {
            const int j0 = idx - NG, seq = j0 / 1152, rem = j0 % 1152, v = rem >> 3, kg = rem & 7;
            bf16* p = (bf16*)(c.ws + WS_DSM) + (size_t)seq * 32 * 9216 + v * 64 + kg * 8;
            const float* ct = (const float*)(c.ws + WS_CT) + (size_t)seq * 32 * 2;
            float* mp = (float*)(c.ws + WS_MP) + (size_t)seq * 32;
            float m = 0.f;
#pragma unroll 1
            for (int c4 = 0; c4 < 32; c4 += 4) {
                u32x4 dv[4]; f32x2 cc[4];
#pragma unroll
                for (int j = 0; j < 4; ++j) { dv[j] = *(const u32x4*)(p + (size_t)(c4 + j) * 9216); cc[j] = *(const f32x2*)(ct + (c4 + j) * 2); }
#pragma unroll
                for (int j = 0; j < 4; ++j) {
                    float d[8]; unpack8(dv[j], d);
                    const float M63 = fmaxf(m, cc[j][1]), wc = __expf(m - M63), ws = __expf(cc[j][1] - M63);
                    const u32x4 sp = pack8(S);
                    if (rem == 0) mp[c4 + j] = m;
#pragma unroll
                    for (int i = 0; i < 8; ++i) S[i] = wc * S[i] + ws * d[i];
                    m = cc[j][0] + M63;
                    *(u32x4*)(p + (size_t)(c4 + j) * 9216) = sp;
                }
            }
        }
    }
}
template <bool ML>
__device__ __forceinline__ void scanC_wave(const Ctx& c, int l, int b, int h, int cch, int ti) {
    const int lane = c.lane, fr = lane & 15, fq = lane >> 4;
    const bf16* PB = (const bf16*)(c.ws + WS_PB);
    bf16* UO = (bf16*)(c.ws + (ML ? WS_UC : WS_UA));
    const bf16* QS = (const bf16*)(c.ws + WS_QS) + (ML ? (size_t)T * 256 : 0);
    const int slot = (b * 4 + h) * 32 + cch;
    const bf16* SP = ML ? (const bf16*)(c.ws + WS_DSM) + (size_t)slot * 144 * 64 : (const bf16*)(c.ws + WS_DSG) + (size_t)slot * 128 * 64;
    const int GCOL = (ML ? PB_OC : PB_GA) + h * 128;
    const float* gnorm = c.in[ML ? IN_ML_NORM : IN_GLA_NORM] + l * 512 + h * 128;
    const size_t trow = (size_t)b * SEQ + (size_t)cch * 64 + 16 * ti + fr;
    bf16x8 qf[2], sf[8][2], nf[2];
#pragma unroll
    for (int ks = 0; ks < 2; ++ks) qf[ks] = *(const bf16x8*)(QS + trow * 256 + h * 64 + 32 * ks + 8 * fq);
#pragma unroll
    for (int n = 0; n < 8; ++n)
#pragma unroll
        for (int ks = 0; ks < 2; ++ks) sf[n][ks] = *(const bf16x8*)(SP + (16 * n + fr) * 64 + 32 * ks + 8 * fq);
    if (ML) {
#pragma unroll
        for (int ks = 0; ks < 2; ++ks) nf[ks] = *(const bf16x8*)(SP + (128 + fr) * 64 + 32 * ks + 8 * fq); }
    u32x2 gate[8], oi[8];
#pragma unroll
    for (int n = 0; n < 8; ++n) { gate[n] = *(const u32x2*)(PB + trow * NPB + GCOL + 16 * n + 4 * fq); oi[n] = *(const u32x2*)(UO + trow * 512 + h * 128 + 16 * n + 4 * fq); }
    float e_in = 1.f, e_st = 1.f, dd = 1.f;
    if (ML) {
        const float pm = ((const float*)(c.ws + WS_GPM))[trow * 4 + h], bc = ((const float*)(c.ws + WS_GBC))[trow * 4 + h], m_prev = ((const float*)(c.ws + WS_MP))[slot], dni = ((const float*)(c.ws + WS_DN))[trow * 4 + h];
        const float Mt = fmaxf(m_prev, pm); e_in = __expf(pm - Mt); e_st = __expf(m_prev - Mt);
        f32x4 d = (f32x4){0.f, 0.f, 0.f, 0.f};
#pragma unroll
        for (int ks = 0; ks < 2; ++ks) d = __builtin_amdgcn_mfma_f32_16x16x32_bf16(nf[ks], qf[ks], d, 0, 0, 0);
        const float dst = __shfl(d[0], fr);
        const float den = dni * e_in + dst * e_st;
        dd = 1.f / fmaxf(fabsf(den), __expf(-(bc + Mt)));
    }
    f32x4 o[8]; float ss = 0.f;
#pragma unroll
    for (int n = 0; n < 8; ++n) {
        f32x4 d = (f32x4){0.f, 0.f, 0.f, 0.f};
#pragma unroll
        for (int ks = 0; ks < 2; ++ks) d = __builtin_amdgcn_mfma_f32_16x16x32_bf16(sf[n][ks], qf[ks], d, 0, 0, 0);
        const f32x4 oiv = (f32x4){bflo(oi[n].x), bfhi(oi[n].x), bflo(oi[n].y), bfhi(oi[n].y)};
        o[n] = ML ? oiv * e_in + d * e_st : oiv + d;
        ss += o[n][0] * o[n][0] + o[n][1] * o[n][1] + o[n][2] * o[n][2] + o[n][3] * o[n][3];
    }
    ss += __shfl_xor(ss, 16); ss += __shfl_xor(ss, 32);
    const float rstd = rsqrtf(ss * dd * dd * (1.f / 128.f) + EPS) * dd;
#pragma unroll
    for (int n = 0; n < 8; ++n) {
        const f32x4 gn = *(const f32x4*)(gnorm + 16 * n + 4 * fq);
        const float g0 = bflo(gate[n].x), g1 = bfhi(gate[n].x), g2 = bflo(gate[n].y), g3 = bfhi(gate[n].y);
        f32x4 r;
        if (ML) { r[0] = o[n][0] * rstd * gn[0] * sigmoidf_(g0); r[1] = o[n][1] * rstd * gn[1] * sigmoidf_(g1); r[2] = o[n][2] * rstd * gn[2] * sigmoidf_(g2); r[3] = o[n][3] * rstd * gn[3] * sigmoidf_(g3); }
        else { r[0] = o[n][0] * rstd * gn[0] * siluf_(g0); r[1] = o[n][1] * rstd * gn[1] * siluf_(g1); r[2] = o[n][2] * rstd * gn[2] * siluf_(g2); r[3] = o[n][3] * rstd * gn[3] * siluf_(g3); }
        st_bf4(UO + trow * 512 + h * 128 + 16 * n + 4 * fq, r);
    }
}
__device__ __forceinline__ void phase_scanA(const Ctx& c, int l) {
    const int nG = c.bid < 2048 ? (2048 - c.bid + c.nblk - 1) / c.nblk : 0;
    const int firstM = c.bid + nG * c.nblk;
    scanA_loop<false>(c, l, c.bid, 2048, c.nblk);
    scanA_loop<true>(c, l, firstM, 4096, c.nblk);
    __syncthreads();
}
__device__ __forceinline__ void phase_scanC(const Ctx& c, int l) {
    const int gw = c.bid * NWAVES + c.wave, NGW = c.nblk * NWAVES;
#pragma unroll 1
    for (int it = gw; it < 16384; it += NGW) { const int br = it >> 13, rem = it & 8191, seq = rem >> 7, cch = (rem >> 2) & 31, ti = rem & 3;
        if (br == 0) scanC_wave<false>(c, l, seq >> 2, seq & 3, cch, ti); else scanC_wave<true>(c, l, seq >> 2, seq & 3, cch, ti); }
}
__device__ __forceinline__ void phase_scans(const Ctx& c, int l) {
    for (int it = c.bid; it < 128; it += c.nblk) {
#if SCAN_RECURRENT
        if (it < 64) scan_gla_item(c, l, it >> 2, it & 3);
        else scan_mlstm_item(c, l, (it - 64) >> 2, (it - 64) & 3);
#else
        if (it < 64) scan_chunked_item<false>(c, l, it >> 2, it & 3);
        else scan_chunked_item<true>(c, l, (it - 64) >> 2, (it - 64) & 3);
#endif
    }
}

__device__ __forceinline__ unsigned ord_key(float f) { const unsigned u = __builtin_bit_cast(unsigned, f); return (u & 0x80000000u) ? ~u : (u | 0x80000000u); }
__device__ __forceinline__ void phase_dsa(const Ctx& c, int l) {
    LAS unsigned char* wl = c.lds + c.wave * 14336;
    LAS float* I_s = (LAS float*)wl;
    LAS int* list = (LAS int*)(wl + 8192);
    LAS float* qi_s = (LAS float*)(wl + 9216);
    LAS float* ql_s = (LAS float*)(wl + 10240);
    const bf16* QLAT = (const bf16*)(c.ws + WS_QLAT); const bf16* QIDX = (const bf16*)(c.ws + WS_QIDX);
    const bf16* CKVN = (const bf16*)(c.ws + WS_CKVN); const float* SM = (const float*)(c.ws + WS_SM);
    bf16* OLAT = (bf16*)(c.ws + WS_OLAT);
    const int gw = c.bid * NWAVES + c.wave, NGW = c.nblk * NWAVES, lane = c.lane;
    for (int tq = gw; tq < T; tq += NGW) {
        const int b = tq >> 11, pos = tq & 2047, nvalid = pos + 1;
        const size_t kb = (size_t)b * SEQ;
        { const f32x4 q = ld_bf4(QIDX + (size_t)tq * 256 + 4 * lane); *(LAS f32x4*)(qi_s + 4 * lane) = q;
#pragma unroll
          for (int j = 0; j < 4; ++j) { const f32x4 ql = ld_bf4(QLAT + (size_t)tq * 1024 + 4 * (lane + 64 * j)); *(LAS f32x4*)(ql_s + 4 * (lane + 64 * j)) = ql; } }
        float wh[8];
#pragma unroll
        for (int hh = 0; hh < 8; ++hh) wh[hh] = SM[(size_t)tq * 128 + SM_WIDX + hh] * 0.35355339059327373f;
        asm volatile("s_waitcnt lgkmcnt(0)" ::: "memory");
        int nsel;
        if (nvalid <= DSA_K) {
            for (int i = lane; i < DSA_K; i += 64) list[i] = i;
            nsel = nvalid;
        } else {
            const int nj = (nvalid + 63) >> 6;
            for (int j = 0; j < nj; ++j) {
                const int s = lane + 64 * j;
                float val = -INFINITY;
                if (s < nvalid) {
                    const float* kr = SM + (kb + s) * 128 + SM_KIDX;
                    f32x4 kk[8];
#pragma unroll
                    for (int i = 0; i < 8; ++i) kk[i] = *(const f32x4*)(kr + 4 * i);
                    val = 0.f;
#pragma unroll
                    for (int hh = 0; hh < 8; ++hh) { float d = 0.f;
#pragma unroll
                        for (int i = 0; i < 8; ++i) { const f32x4 q = *(const LAS f32x4*)(qi_s + hh * 32 + 4 * i); d += q[0] * kk[i][0] + q[1] * kk[i][1] + q[2] * kk[i][2] + q[3] * kk[i][3]; }
                        val += wh[hh] * fmaxf(d, 0.f); }
                }
                I_s[s] = val;
            }
            for (int j = nj; j < 32; ++j) I_s[lane + 64 * j] = -INFINITY;
            asm volatile("s_waitcnt lgkmcnt(0)" ::: "memory");
            LAS unsigned* K_s = (LAS unsigned*)I_s;
#pragma unroll 4
            for (int j = 0; j < 32; ++j) K_s[lane + 64 * j] = ord_key(I_s[lane + 64 * j]);
            unsigned thr = 0u;
#pragma unroll 1
            for (int bit = 31; bit >= 0; --bit) {
                const unsigned cand = thr | (1u << bit); int cnt = 0;
#pragma unroll 8
                for (int j = 0; j < 32; ++j) cnt += (K_s[lane + 64 * j] >= cand) ? 1 : 0;
                cnt = wave_sum_i(cnt);
                if (cnt >= DSA_K) thr = cand;
            }
            int cgt = 0;
#pragma unroll 8
            for (int j = 0; j < 32; ++j) cgt += (K_s[lane + 64 * j] > thr) ? 1 : 0;
            cgt = wave_sum_i(cgt);
            int need = DSA_K - cgt, base = 0;
            const unsigned long long lt = (1ull << lane) - 1ull;
#pragma unroll 2
            for (int j = 0; j < 32; ++j) {
                const unsigned kj = K_s[lane + 64 * j];
                const bool gt = kj > thr, eq = kj == thr;
                const unsigned long long meq = __ballot(eq);
                const int rk = __popcll(meq & lt);
                const bool sel = gt || (eq && rk < need);
                need -= __popcll(meq); if (need < 0) need = 0;
                const unsigned long long ms = __ballot(sel);
                if (sel) list[base + __popcll(ms & lt)] = lane + 64 * j;
                base += __popcll(ms);
            }
            nsel = DSA_K;
        }
        asm volatile("s_waitcnt lgkmcnt(0)" ::: "memory");
        int ks[4]; float lg[4][8];
#pragma unroll
        for (int i = 0; i < 4; ++i) { const int li = lane + 64 * i; ks[i] = (li < nsel) ? list[li] : 0;
#pragma unroll
            for (int hh = 0; hh < 8; ++hh) lg[i][hh] = 0.f; }
#pragma unroll 1
        for (int ch = 0; ch < 16; ++ch) {
            f32x4 ka[4], kc[4];
#pragma unroll
            for (int i = 0; i < 4; ++i) { const u32x4 w = *(const u32x4*)(CKVN + (kb + ks[i]) * 128 + ch * 8);
                ka[i] = (f32x4){bflo(w.x), bfhi(w.x), bflo(w.y), bfhi(w.y)}; kc[i] = (f32x4){bflo(w.z), bfhi(w.z), bflo(w.w), bfhi(w.w)}; }
#pragma unroll
            for (int hh = 0; hh < 8; ++hh) { const f32x4 qa = *(const LAS f32x4*)(ql_s + hh * 128 + ch * 8), qb = *(const LAS f32x4*)(ql_s + hh * 128 + ch * 8 + 4);
#pragma unroll
                for (int i = 0; i < 4; ++i) lg[i][hh] += qa[0] * ka[i][0] + qa[1] * ka[i][1] + qa[2] * ka[i][2] + qa[3] * ka[i][3] + qb[0] * kc[i][0] + qb[1] * kc[i][1] + qb[2] * kc[i][2] + qb[3] * kc[i][3]; }
        }
#pragma unroll
        for (int hh = 0; hh < 8; ++hh) {
            const float slope = exp2f(-(float)(hh + 1));
            float mx = -INFINITY;
#pragma unroll
            for (int i = 0; i < 4; ++i) { const bool ok = (lane + 64 * i) < nsel; lg[i][hh] = ok ? lg[i][hh] - slope * (float)(pos - ks[i]) : -INFINITY; mx = fmaxf(mx, lg[i][hh]); }
            mx = wave_max(mx);
            float sm = 0.f;
#pragma unroll
            for (int i = 0; i < 4; ++i) { lg[i][hh] = __expf(lg[i][hh] - mx); sm += lg[i][hh]; }
            sm = wave_sum(sm);
            const float inv = 1.f / sm;
#pragma unroll
            for (int i = 0; i < 4; ++i) lg[i][hh] *= inv;
        }
#pragma unroll
        for (int i = 0; i < 4; ++i) { const int li = lane + 64 * i;
            *(LAS f32x4*)(I_s + li * 8) = (f32x4){lg[i][0], lg[i][1], lg[i][2], lg[i][3]}; *(LAS f32x4*)(I_s + li * 8 + 4) = (f32x4){lg[i][4], lg[i][5], lg[i][6], lg[i][7]}; }
        asm volatile("s_waitcnt lgkmcnt(0)" ::: "memory");
        float o0[8], o1[8];
#pragma unroll
        for (int hh = 0; hh < 8; ++hh) { o0[hh] = 0.f; o1[hh] = 0.f; }
#pragma unroll 2
        for (int kidx = 0; kidx < nsel; ++kidx) {
            const int s = list[kidx];
            const unsigned w = *(const unsigned*)(CKVN + (kb + s) * 128 + 2 * lane);
            const float v0 = bflo(w), v1 = bfhi(w);
            const f32x4 pa = *(const LAS f32x4*)(I_s + kidx * 8), pb = *(const LAS f32x4*)(I_s + kidx * 8 + 4);
            o0[0] += pa[0] * v0; o1[0] += pa[0] * v1; o0[1] += pa[1] * v0; o1[1] += pa[1] * v1; o0[2] += pa[2] * v0; o1[2] += pa[2] * v1; o0[3] += pa[3] * v0; o1[3] += pa[3] * v1;
            o0[4] += pb[0] * v0; o1[4] += pb[0] * v1; o0[5] += pb[1] * v0; o1[5] += pb[1] * v1; o0[6] += pb[2] * v0; o1[6] += pb[2] * v1; o0[7] += pb[3] * v0; o1[7] += pb[3] * v1;
        }
#pragma unroll
        for (int hh = 0; hh < 8; ++hh) *(unsigned*)(OLAT + (size_t)tq * 1024 + hh * 128 + 2 * lane) = pk2(o0[hh], o1[hh]);
        asm volatile("s_waitcnt lgkmcnt(0)" ::: "memory");
    }
}


typedef float f32x16 __attribute__((ext_vector_type(16)));
__device__ __forceinline__ void phase_dsa_sel(const Ctx& c, int l) {
    const bf16* QIDX = (const bf16*)(c.ws + WS_QIDX); const bf16* KIDX = (const bf16*)(c.ws + WS_KIDX); const float* SM = (const float*)(c.ws + WS_SM);
    unsigned* MASK = (unsigned*)(c.ws + WS_MASK);
    const int lane = c.lane, hf = lane >> 5, l31 = lane & 31;
    const int rho = l31, tl = 2 * ((rho >> 2) & 1) + (rho >> 4), hd = (rho & 3) + 4 * ((rho >> 3) & 1);
    const unsigned ltmask = (1u << l31) - 1u;
    LAS unsigned* KL = (LAS unsigned*)(c.lds + c.wave * 16384);
    LAS unsigned* MW = (LAS unsigned*)(c.lds + 131072 + c.wave * 512);
    const int npass = (c.nblk == 256) ? 2 : (T / 64 + c.nblk - 1) / c.nblk;
#pragma unroll 1
    for (int ps = 0; ps < npass; ++ps) {
        int b, q64;
        if (c.nblk == 256) { b = c.bid & 15; q64 = ps == 0 ? 31 - (c.bid >> 4) : (c.bid >> 4); }
        else { const int it = c.bid + ps * c.nblk; if (it >= T / 64) break; b = it >> 5; q64 = it & 31; }
        const int pb = q64 * 64;
#pragma unroll 1
        for (int wi = 0; wi < 2; ++wi) {
        const int pos0 = pb + 8 * c.wave + 4 * wi, t0 = b * SEQ + pos0;
        unsigned wA0 = 0u, wB0 = 0u, wA1 = 0u, wB1 = 0u;
        if (pos0 + 3 < DSA_K) {
            const int p_0 = pos0 + 2 * hf, p_1 = p_0 + 1;
            { const int lo = 32 * l31; wA0 = p_0 >= lo + 31 ? 0xffffffffu : (p_0 < lo ? 0u : ((2u << (p_0 - lo)) - 1u)); wA1 = p_1 >= lo + 31 ? 0xffffffffu : (p_1 < lo ? 0u : ((2u << (p_1 - lo)) - 1u)); }
        } else {
            const int ng = ((pos0 + 3) / 32 + 4) / 4, nkt = 4 * ng;
            bf16x8 af[2];
#pragma unroll
            for (int ks = 0; ks < 2; ++ks) af[ks] = *(const bf16x8*)(QIDX + (size_t)(t0 + tl) * 256 + hd * 32 + 16 * ks + 8 * hf);
            const bf16* kbase = KIDX + ((size_t)b * SEQ + l31) * 32 + 8 * hf;
#pragma unroll 1
            for (int tsel = 0; tsel < 2; ++tsel) {
                float whv[8];
#pragma unroll
                for (int r = 0; r < 8; ++r) whv[r] = SM[(size_t)(t0 + 2 * hf + tsel) * 128 + SM_WIDX + r] * 0.35355339059327373f;
                const int p_t = pos0 + 2 * hf + tsel;
                bf16x8 bq[4][2], bn[4][2];
#pragma unroll
                for (int j = 0; j < 4; ++j) { bq[j][0] = *(const bf16x8*)(kbase + (size_t)(32 * j) * 32); bq[j][1] = *(const bf16x8*)(kbase + (size_t)(32 * j) * 32 + 16); }
#pragma unroll 1
                for (int g = 0; g < ng; ++g) {
                    const int gn = (g + 1 < ng) ? g + 1 : g;
#pragma unroll
                    for (int j = 0; j < 4; ++j) { bn[j][0] = *(const bf16x8*)(kbase + (size_t)(32 * (4 * gn + j)) * 32); bn[j][1] = *(const bf16x8*)(kbase + (size_t)(32 * (4 * gn + j)) * 32 + 16); }
#pragma unroll
                    for (int j = 0; j < 4; ++j) {
                        f32x16 d;
#pragma unroll
                        for (int r = 0; r < 16; ++r) d[r] = 0.f;
                        d = __builtin_amdgcn_mfma_f32_32x32x16_bf16(af[0], bq[j][0], d, 0, 0, 0);
                        d = __builtin_amdgcn_mfma_f32_32x32x16_bf16(af[1], bq[j][1], d, 0, 0, 0);
                        float iv = 0.f;
                        if (tsel == 0) {
#pragma unroll
                            for (int r = 0; r < 8; ++r) iv += whv[r] * fmaxf(d[r], 0.f);
                        } else {
#pragma unroll
                            for (int r = 0; r < 8; ++r) iv += whv[r] * fmaxf(d[8 + r], 0.f);
                        }
                        const int kt = 4 * g + j, row = 32 * kt + l31;
                        KL[kt * 64 + lane] = row <= p_t ? ord_key(iv) : 0u;
                    }
#pragma unroll
                    for (int j = 0; j < 4; ++j) { bq[j][0] = bn[j][0]; bq[j][1] = bn[j][1]; }
                }
                unsigned thr = 0u; bool dlo = false, dhi = false;
#pragma unroll 1
                for (int bit = 31; bit >= 0 && !(dlo && dhi); --bit) {
                    const unsigned cand = thr | (1u << bit); int clo = 0, chi = 0;
#pragma unroll 16
                    for (int kt = 0; kt < nkt; ++kt) { const unsigned long long m = __ballot(KL[kt * 64 + lane] >= cand); clo += __popc((unsigned)m); chi += __popc((unsigned)(m >> 32)); }
                    const bool tlo = !dlo && clo >= DSA_K, thi = !dhi && chi >= DSA_K;
                    if (hf ? thi : tlo) thr = cand;
                    dlo = dlo || clo == DSA_K; dhi = dhi || chi == DSA_K;
                }
                int glo = 0, ghi = 0;
#pragma unroll 16
                for (int kt = 0; kt < nkt; ++kt) { const unsigned long long m = __ballot(KL[kt * 64 + lane] > thr); glo += __popc((unsigned)m); ghi += __popc((unsigned)(m >> 32)); }
                int nlo = DSA_K - glo, nhi = DSA_K - ghi;
                MW[lane] = 0u; MW[64 + lane] = 0u;
#pragma unroll 2
                for (int kt = 0; kt < nkt; ++kt) {
                    const unsigned kv = KL[kt * 64 + lane];
                    const bool gt = kv > thr, eq = kv == thr;
                    const unsigned long long meq = __ballot(eq); const unsigned mh = hf ? (unsigned)(meq >> 32) : (unsigned)meq;
                    const int need = hf ? nhi : nlo;
                    const bool sel = gt || (eq && (__popc(mh & ltmask) < need));
                    nlo -= __popc((unsigned)meq); nhi -= __popc((unsigned)(meq >> 32)); nlo = nlo < 0 ? 0 : nlo; nhi = nhi < 0 ? 0 : nhi;
                    const unsigned long long ms = __ballot(sel);
                    if (l31 == 0) MW[hf * 64 + kt] = hf ? (unsigned)(ms >> 32) : (unsigned)ms;
                }
                const unsigned wA = MW[hf * 64 + l31], wB = MW[hf * 64 + 32 + l31];
                if (tsel == 0) { wA0 = wA; wB0 = wB; } else { wA1 = wA; wB1 = wB; }
            }
        }
        unsigned* m0 = MASK + (size_t)(t0 + 2 * hf) * 64;
        m0[l31] = wA0; m0[32 + l31] = wB0; m0[64 + l31] = wA1; m0[96 + l31] = wB1;
        }
    }
    __syncthreads();
}

constexpr int AT_KN_LD = 136, AT_KT_LD = 72;
constexpr int AT_KN_BYTES = 64 * AT_KN_LD * 2, AT_KT_BYTES = 128 * AT_KT_LD * 2, AT_STAGE = AT_KN_BYTES + AT_KT_BYTES;
__device__ __forceinline__ void phase_dsa_att(const Ctx& c, int l) {
    const bf16* QLAT = (const bf16*)(c.ws + WS_QLAT); const bf16* CKVN = (const bf16*)(c.ws + WS_CKVN); const bf16* CKVT = (const bf16*)(c.ws + WS_CKVT);
    const unsigned* MASK = (const unsigned*)(c.ws + WS_MASK); bf16* OLAT = (bf16*)(c.ws + WS_OLAT);
    const int tid = c.tid, lane = c.lane, h = c.wave, fr = lane & 15, fq = lane >> 4;
    const float slope2 = exp2f(-(float)(h + 1)) * 1.4426950408889634f;
    const int knr = tid >> 3, knc = (tid & 7) * 8;
    const int ktr = tid >> 2, ktc = (tid & 3) * 16;
#pragma unroll 1
    for (int k4 = 0; k4 < 1024; ++k4) {
        const int idx = c.bid + c.nblk * k4; if (idx >= 1024) break;
        const int b = idx & 15, g = idx >> 4, gk = g >> 4, gi = g & 15;
        const int qt = 63 - 16 * gk - ((gk & 1) ? (15 - gi) : gi);
        const int tq0 = qt * 32;
        const size_t tg0 = (size_t)b * SEQ + tq0;
        const int nkt = (tq0 + 31) / 64 + 1;
        bf16x8 Qf[2][4];
#pragma unroll
        for (int rt = 0; rt < 2; ++rt)
#pragma unroll
            for (int ks = 0; ks < 4; ++ks) Qf[rt][ks] = *(const bf16x8*)(QLAT + (tg0 + 16 * rt + fr) * 1024 + h * 128 + 32 * ks + 8 * fq);
        f32x4 O[2][8];
        float mrun[2], lrun[2];
#pragma unroll
        for (int rt = 0; rt < 2; ++rt) { mrun[rt] = -1e30f; lrun[rt] = 0.f;
#pragma unroll
            for (int n = 0; n < 8; ++n) O[rt][n] = (f32x4){0.f, 0.f, 0.f, 0.f}; }
        u32x4 pn0, pn1, pt0, pt1;
#define AT_LOAD(kt) do { const size_t _kb = (size_t)b * SEQ + 64 * (kt); \
            pn0 = *(const u32x4*)(CKVN + (_kb + knr) * 128 + knc); pn1 = *(const u32x4*)(CKVN + (_kb + knr) * 128 + 64 + knc); \
            pt0 = *(const u32x4*)(CKVT + ((size_t)b * 128 + ktr) * 2048 + 64 * (kt) + ktc); pt1 = *(const u32x4*)(CKVT + ((size_t)b * 128 + ktr) * 2048 + 64 * (kt) + ktc + 8); } while (0)
        AT_LOAD(0);
#pragma unroll 1
        for (int kt = 0; kt < nkt; ++kt) {
            int lz; asm volatile("v_mov_b32 %0, 0" : "=v"(lz));
            LAS bf16* Kn = (LAS bf16*)(c.lds + (kt & 1) * AT_STAGE) + lz; LAS bf16* KT = (LAS bf16*)(c.lds + (kt & 1) * AT_STAGE + AT_KN_BYTES) + lz;
            *(LAS u32x4*)(Kn + knr * AT_KN_LD + knc) = pn0; *(LAS u32x4*)(Kn + knr * AT_KN_LD + 64 + knc) = pn1;
            *(LAS u32x4*)(KT + ktr * AT_KT_LD + ktc) = pt0; *(LAS u32x4*)(KT + ktr * AT_KT_LD + ktc + 8) = pt1;
            u32x2 mw[2];
#pragma unroll
            for (int rt = 0; rt < 2; ++rt) mw[rt] = *(const u32x2*)(MASK + (tg0 + 16 * rt + fr) * 64 + 2 * kt);
            if (kt + 1 < nkt) AT_LOAD(kt + 1);
            lds_barrier();
            float kbias[4][4];
#pragma unroll
            for (int j = 0; j < 4; ++j)
#pragma unroll
                for (int r = 0; r < 4; ++r) kbias[j][r] = slope2 * (float)(64 * kt + 16 * j + 4 * fq + r);
#pragma unroll
            for (int rt = 0; rt < 2; ++rt) {
                f32x4 S[4];
#pragma unroll
                for (int j = 0; j < 4; ++j) {
                    f32x4 d = (f32x4){0.f, 0.f, 0.f, 0.f};
#pragma unroll
                    for (int ks = 0; ks < 4; ++ks) { const bf16x8 kf = *(const LAS bf16x8*)(Kn + (16 * j + fr) * AT_KN_LD + 32 * ks + 8 * fq); d = __builtin_amdgcn_mfma_f32_16x16x32_bf16(kf, Qf[rt][ks], d, 0, 0, 0); }
                    S[j] = d;
                    __builtin_amdgcn_sched_barrier(0);
                }
                float mx = -1e30f;
#pragma unroll
                for (int j = 0; j < 4; ++j) { const unsigned wsel = ((j < 2) ? mw[rt].x : mw[rt].y) >> (4 * fq);
#pragma unroll
                    for (int r = 0; r < 4; ++r) { const bool on = wsel & (1u << (16 * (j & 1) + r));
                        const float v = S[j][r] + kbias[j][r];
                        S[j][r] = on ? v : -INFINITY; mx = fmaxf(mx, S[j][r]); } }
                mx = fmaxf(mx, __shfl_xor(mx, 16)); mx = fmaxf(mx, __shfl_xor(mx, 32));
                const float mnew = fmaxf(mrun[rt], mx);
                const float alpha = __builtin_amdgcn_exp2f(mrun[rt] - mnew);
                float rs = 0.f;
#pragma unroll
                for (int j = 0; j < 4; ++j)
#pragma unroll
                    for (int r = 0; r < 4; ++r) { const float p = __builtin_amdgcn_exp2f(S[j][r] - mnew); S[j][r] = p; rs += p; }
                rs += __shfl_xor(rs, 16); rs += __shfl_xor(rs, 32);
                lrun[rt] = lrun[rt] * alpha + rs; mrun[rt] = mnew;
#pragma unroll
                for (int n = 0; n < 8; ++n) O[rt][n] *= alpha;
                bf16x8 Pf[2];
#pragma unroll
                for (int ks2 = 0; ks2 < 2; ++ks2) { u32x4 w; w.x = pk2(S[2 * ks2][0], S[2 * ks2][1]); w.y = pk2(S[2 * ks2][2], S[2 * ks2][3]);
                    w.z = pk2(S[2 * ks2 + 1][0], S[2 * ks2 + 1][1]); w.w = pk2(S[2 * ks2 + 1][2], S[2 * ks2 + 1][3]);
                    Pf[ks2] = __builtin_bit_cast(bf16x8, w); }
#pragma unroll
                for (int n = 0; n < 8; ++n)
#pragma unroll
                    for (int ks2 = 0; ks2 < 2; ++ks2) {
                        const u32x2 a0 = *(const LAS u32x2*)(KT + (16 * n + fr) * AT_KT_LD + 32 * ks2 + 4 * fq), a1 = *(const LAS u32x2*)(KT + (16 * n + fr) * AT_KT_LD + 32 * ks2 + 16 + 4 * fq);
                        const bf16x8 af = __builtin_bit_cast(bf16x8, (u32x4){a0.x, a0.y, a1.x, a1.y});
                        O[rt][n] = __builtin_amdgcn_mfma_f32_16x16x32_bf16(af, Pf[ks2], O[rt][n], 0, 0, 0);
                        if (ks2 == 1 && (n & 1)) __builtin_amdgcn_sched_barrier(0);
                    }
            }
        }
#undef AT_LOAD
#pragma unroll
        for (int rt = 0; rt < 2; ++rt) { const float inv = 1.f / lrun[rt];
#pragma unroll
            for (int n = 0; n < 8; ++n) st_bf4(OLAT + (tg0 + 16 * rt + fr) * 1024 + h * 128 + 16 * n + 4 * fq, O[rt][n] * inv); }
        __syncthreads();
    }
}

__device__ __forceinline__ void expert_convert(const Ctx& c, int l, int gw, int NGW) {

        LAS float* scr = (LAS float*)(c.lds + c.wave * 16384);
        constexpr int I_GU = (512 / 32) * (1024 / 64), I_D = (1024 / 32) * (256 / 64), PER_E = I_GU + I_D;
        for (int it = gw; it < NEX * PER_E; it += NGW) {
            const int e = it / PER_E; int r = it % PER_E;
            if (r < I_GU) {
                const int n0 = (r / 16) * 32, pn = n0 >> 8, wi = n0 & 255, j0 = 128 * pn + (wi & 127);
                const float* Wg; const float* Wu;
                if (e < NE) { Wg = c.in[IN_EWG] + ((size_t)l * NE + e) * 1024 * 256; Wu = c.in[IN_EWU] + ((size_t)l * NE + e) * 1024 * 256; }
                else { Wg = c.in[IN_SWG] + (size_t)l * 1024 * 256; Wu = c.in[IN_SWU] + (size_t)l * 1024 * 256; }
                if (wi < 128) { SrcPlain s{Wg + j0 - n0, 256}; tr_item(s, (bf16*)(c.ws + WS_WGU) + (size_t)e * 512 * 1024, 1024, n0, (r % 16) * 64, scr, c.lane); }
                else { SrcPlain s{Wu + j0 - n0, 256}; tr_item(s, (bf16*)(c.ws + WS_WGU) + (size_t)e * 512 * 1024, 1024, n0, (r % 16) * 64, scr, c.lane); }
            } else { r -= I_GU;
                SrcPlain s; s.ld = 1024; s.W = e < NE ? c.in[IN_EWD] + ((size_t)l * NE + e) * 256 * 1024 : c.in[IN_SWD] + (size_t)l * 256 * 1024;
                tr_item(s, (bf16*)(c.ws + WS_WD) + (size_t)e * 1024 * 256, 256, (r / 4) * 32, (r % 4) * 64, scr, c.lane);
            }
        }
    }
__device__ __forceinline__ void route_one(int t, float logit, float rbias, int lane, unsigned* CNT, int* ROWL, float* WL, unsigned* TOKPOS) {
    const float score = sigmoidf_(logit), sel = score + rbias;
    const int g = lane >> 3;
    int rk8 = 0;
#pragma unroll
    for (int d = 1; d < 8; ++d) { const int ol = (lane & ~7) | ((lane + d) & 7); const float o = __shfl(sel, ol); rk8 += (o > sel || (o == sel && ol < lane)) ? 1 : 0; }
    float t2 = rk8 < 2 ? sel : 0.f;
    t2 += __shfl_xor(t2, 1); t2 += __shfl_xor(t2, 2); t2 += __shfl_xor(t2, 4);
    int rkg = 0;
#pragma unroll
    for (int d = 1; d < 8; ++d) { const int og = (g + d) & 7; const float o = __shfl(t2, og * 8); rkg += (o > t2 || (o == t2 && og < g)) ? 1 : 0; }
    const bool gsel = rkg < 4;
    bool chosen = false; float cur = gsel ? sel : -INFINITY;
#pragma unroll 1
    for (int it6 = 0; it6 < TOPK; ++it6) {
        const float mx = wave_max(cur);
        const unsigned long long me = __ballot(cur == mx);
        const int win = __ffsll((long long)me) - 1;
        if (lane == win) { chosen = true; cur = -INFINITY; }
    }
    const float wsum = wave_sum(chosen ? score : 0.f);
    const unsigned long long mk = __ballot(chosen);
    if (chosen) {
        const int hf = t >= HALF_T ? 1 : 0;
        const int kk = __popcll(mk & ((1ull << lane) - 1ull));
        const unsigned slot = atomicAdd(&CNT[hf * 64 + lane], 1u);
        ROWL[((size_t)hf * 64 + lane) * 16384 + slot] = t;
        WL[((size_t)hf * 64 + lane) * 16384 + slot] = score / wsum * 2.5f;
        if (kk < TOPK) TOKPOS[(size_t)t * 6 + kk] = ((unsigned)lane << 16) | slot;
    }
}
__device__ __forceinline__ void phase_route(const Ctx& c, int l, const float* x1) {
    expert_convert(c, l, c.bid * NWAVES + c.wave, c.nblk * NWAVES);
    __syncthreads();
    {
        LAS float* H = (LAS float*)c.lds;
        const int lane = c.lane, w = c.wave;
        const float* MOD = (const float*)(c.ws + WS_MOD) + (size_t)l * 16 * 6144;
        bf16* XN2 = (bf16*)(c.ws + WS_XN2);
        const float* RW = c.in[IN_RW] + (size_t)l * 1024 * 64; const float rbias = c.in[IN_RB][l * 64 + lane];
        unsigned* CNT = (unsigned*)(c.ws + WS_CTL) + CW_CNT + l * 128;
        int* ROWL = (int*)(c.ws + WS_ROWL); float* WL = (float*)(c.ws + WS_WL); unsigned* TOKPOS = (unsigned*)(c.ws + WS_TOKPOS);
        const float* gain = c.in[IN_NFFN] + l * D;
        for (int it = c.bid; it < T / 32; it += c.nblk) {
            const int t0 = it * 32, b = t0 >> 11;
            const float* sh = MOD + (size_t)b * 6144 + 3072; const float* sc = MOD + (size_t)b * 6144 + 4096;
            __syncthreads();
#pragma unroll
            for (int r = 0; r < 4; ++r) {
                const int rr = 4 * w + r;
                const float* xrow = x1 + (size_t)(t0 + rr) * D;
                f32x4 v[4]; float ssum = 0.f;
#pragma unroll
                for (int j = 0; j < 4; ++j) { v[j] = *(const f32x4*)(xrow + 4 * (lane + 64 * j)); ssum += v[j][0] * v[j][0] + v[j][1] * v[j][1] + v[j][2] * v[j][2] + v[j][3] * v[j][3]; }
                const float rstd = rsqrtf(wave_sum(ssum) * (1.f / D) + EPS);
#pragma unroll
                for (int j = 0; j < 4; ++j) { const int cc = 4 * (lane + 64 * j);
                    const f32x4 g = *(const f32x4*)(gain + cc), a4 = *(const f32x4*)(sc + cc), bb = *(const f32x4*)(sh + cc);
                    const f32x4 hv = v[j] * rstd * g * (a4 + 1.f) + bb;
                    st_bf4(XN2 + (size_t)(t0 + rr) * D + cc, hv); *(LAS f32x4*)(H + rr * 1024 + cc) = hv; }
            }
            __syncthreads();
            float acc[32];
#pragma unroll
            for (int r = 0; r < 32; ++r) acc[r] = 0.f;
            const float* rwp = RW + (size_t)(128 * w) * 64 + lane;
#pragma unroll 2
            for (int k = 0; k < 128; k += 4) {
                const float w0 = rwp[(size_t)k * 64], w1 = rwp[(size_t)(k + 1) * 64], w2 = rwp[(size_t)(k + 2) * 64], w3 = rwp[(size_t)(k + 3) * 64];
#pragma unroll
                for (int r = 0; r < 32; ++r) { const f32x4 hv = *(const LAS f32x4*)(H + r * 1024 + 128 * w + k); acc[r] += hv[0] * w0 + hv[1] * w1 + hv[2] * w2 + hv[3] * w3; }
            }
            __syncthreads();
#pragma unroll
            for (int r = 0; r < 32; ++r) H[(w * 32 + r) * 64 + lane] = acc[r];
            __syncthreads();
#pragma unroll 1
            for (int r = 0; r < 4; ++r) {
                const int rr = 4 * w + r; float lg = 0.f;
#pragma unroll
                for (int ww = 0; ww < 8; ++ww) lg += H[(ww * 32 + rr) * 64 + lane];
                route_one(t0 + rr, lg, rbias, lane, CNT, ROWL, WL, TOKPOS);
            }
        }
        __syncthreads();
    }
}

__device__ __forceinline__ void moe_tables(const Ctx& c, int l, int hf) {
    LAS int* cnt = (LAS int*)(c.lds + 140000); LAS int* off = cnt + 65; LAS int* tst = off + 65;
    __syncthreads();
    if (c.tid == 0) {
        const unsigned* CNT = (const unsigned*)(c.ws + WS_CTL) + CW_CNT + l * 128 + hf * 64;
        int o = 0, ts = 0;
        for (int e = 0; e < NEX; ++e) { const int n = e < NE ? (int)CNT[e] : HALF_T; cnt[e] = n; off[e] = o; tst[e] = ts; o += (n + 255) & ~255; ts += (n + 255) >> 8; }
        tst[NEX] = ts;
    }
    __syncthreads();
}
struct MoeSched1 { LAS const int* cnt; LAS const int* off; LAS const int* tst; int G, c; const char* XN2; const char* WGU; const int* ROWL; const float* WL; const int* IDENT;
    __device__ __forceinline__ bool next(int i, g8::GUnit& u) const {
        const int L = i * G + c; if (L >= 2 * tst[NEX]) return false;
        const int rt = L >> 1, pn = L & 1; int e = 0; while (tst[e + 1] <= rt) ++e;
        const int r0 = (rt - tst[e]) * 256;
        u.A = XN2; u.B = WGU + ((size_t)e * 512 + (size_t)pn * 256) * 2048;
        u.rl = e < NE ? ROWL + (size_t)e * 16384 + r0 : IDENT + r0; u.nvalid = cnt[e] - r0; u.erow0 = 0; u.ecol0 = pn * 256; u.x0 = off[e] + r0; u.xp = e < NE ? WL + (size_t)e * 16384 + r0 : nullptr; return true; } };
struct MoeSched2 { LAS const int* cnt; LAS const int* off; LAS const int* tst; int G, c; const char* HID; const char* WD;
    __device__ __forceinline__ bool next(int i, g8::GUnit& u) const {
        const int L = i * G + c; if (L >= 4 * tst[NEX]) return false;
        const int rt = L >> 2, pn = L & 3; int e = 0; while (tst[e + 1] <= rt) ++e;
        const int r0 = (rt - tst[e]) * 256;
        u.A = HID + (size_t)(off[e] + r0) * 512; u.B = WD + ((size_t)e * 1024 + (size_t)pn * 256) * 512;
        u.rl = nullptr; u.nvalid = 0; u.erow0 = 0; u.ecol0 = pn * 256; u.x0 = off[e] + r0; u.xp = nullptr; return true; } };
struct EpiG1u { bf16* HID;
    __device__ __forceinline__ void operator()(const g8::GUnit& u, int row, int col, f32x4 lo, f32x4 hi) const {
        const int hc = col - 128 * (col >> 8);
        f32x4 v = (f32x4){0.f, 0.f, 0.f, 0.f};
        if (row < u.nvalid) { const float w = u.xp ? u.xp[row] : 1.f;
#pragma unroll
            for (int i = 0; i < 4; ++i) v[i] = siluf_(lo[i]) * hi[i] * w; }
        st_bf4(HID + (size_t)(u.x0 + row) * 256 + hc, v);
    } };
struct EpiG2u { bf16* Y;
    __device__ __forceinline__ void operator()(const g8::GUnit& u, int row, int col, f32x4 lo, f32x4 hi) const {
        st_bf4(Y + (size_t)(u.x0 + row) * 1024 + col, lo); st_bf4(Y + (size_t)(u.x0 + row) * 1024 + col + 128, hi);
    } };
__device__ __forceinline__ void phase_gemm1(const Ctx& c, int l, int hf) {
    moe_tables(c, l, hf);
    LAS int* cnt = (LAS int*)(c.lds + 140000); LAS int* off = cnt + 65; LAS int* tst = off + 65;
    MoeSched1 S{cnt, off, tst, c.nblk, c.bid, (const char*)(c.ws + WS_XN2), (const char*)(c.ws + WS_WGU), (const int*)(c.ws + WS_ROWL) + (size_t)hf * 64 * 16384, (const float*)(c.ws + WS_WL) + (size_t)hf * 64 * 16384,
                (const int*)(c.ws + WS_IDENT) + (size_t)hf * HALF_T};
    EpiG1u E{(bf16*)(c.ws + WS_HID)};
    g8::gemm_phase<true>(c.lds, 2048u, 1024, S, E);
    __syncthreads();
}
__device__ __forceinline__ void phase_gemm2(const Ctx& c, int l, int hf) {
    moe_tables(c, l, hf);
    LAS int* cnt = (LAS int*)(c.lds + 140000); LAS int* off = cnt + 65; LAS int* tst = off + 65;
    MoeSched2 S{cnt, off, tst, c.nblk, c.bid, (const char*)(c.ws + WS_HID), (const char*)(c.ws + WS_WD)};
    EpiG2u E{(bf16*)(c.ws + WS_Y)};
    g8::gemm_phase<false>(c.lds, 512u, 256, S, E);
    __syncthreads();
}
__device__ __forceinline__ void phase_combine(const Ctx& c, int l, int hf, float* xio) {
    moe_tables(c, l, hf);
    LAS int* off = (LAS int*)(c.lds + 140000) + 65;
    const int gw = c.bid * NWAVES + c.wave, NGW = c.nblk * NWAVES, lane = c.lane;
    const bf16* Y = (const bf16*)(c.ws + WS_Y); const unsigned* TOKPOS = (const unsigned*)(c.ws + WS_TOKPOS);
    const float* MODl = (const float*)(c.ws + WS_MOD) + (size_t)l * 16 * 6144;
    const float* MODn = (const float*)(c.ws + WS_MOD) + (size_t)1 * 16 * 6144;
    bf16* XN = (bf16*)(c.ws + WS_XN);
    for (int tt = gw; tt < HALF_T; tt += NGW) {
        const int t = hf * HALF_T + tt, b = t >> 11;
        f32x4 acc[4];
        { const bf16* yr = Y + (size_t)(off[NE] + tt) * 1024;
#pragma unroll
          for (int j = 0; j < 4; ++j) acc[j] = ld_bf4(yr + 4 * (lane + 64 * j)); }
#pragma unroll
        for (int kk = 0; kk < TOPK; ++kk) {
            const unsigned tp = TOKPOS[(size_t)t * 6 + kk]; const int e = tp >> 16, slot = tp & 0xffff;
            const bf16* yr = Y + (size_t)(off[e] + slot) * 1024;
#pragma unroll
            for (int j = 0; j < 4; ++j) acc[j] += ld_bf4(yr + 4 * (lane + 64 * j));
        }
        float* xr = xio + (size_t)t * D; const float* g2 = MODl + (size_t)b * 6144 + 5120;
        f32x4 v[4]; float s = 0.f;
#pragma unroll
        for (int j = 0; j < 4; ++j) { const int cc = 4 * (lane + 64 * j); v[j] = *(const f32x4*)(xr + cc) + *(const f32x4*)(g2 + cc) * acc[j]; s += v[j][0] * v[j][0] + v[j][1] * v[j][1] + v[j][2] * v[j][2] + v[j][3] * v[j][3]; }
        const float rstd = rsqrtf(wave_sum(s) * (1.f / D) + EPS);
        if (l == 0) {
#pragma unroll
            for (int j = 0; j < 4; ++j) { const int cc = 4 * (lane + 64 * j); *(f32x4*)(xr + cc) = v[j];
                const f32x4 g = *(const f32x4*)(c.in[IN_NMIX] + D + cc), a = *(const f32x4*)(MODn + (size_t)b * 6144 + 1024 + cc), bb = *(const f32x4*)(MODn + (size_t)b * 6144 + cc);
                st_bf4(XN + (size_t)t * D + cc, v[j] * rstd * g * (a + 1.f) + bb); }
        } else {
#pragma unroll
            for (int j = 0; j < 4; ++j) { const int cc = 4 * (lane + 64 * j); *(f32x4*)(xr + cc) = v[j] * rstd * *(const f32x4*)(c.in[IN_NFIN] + cc); }
        }
    }
}

#ifdef DSA_NO_SEL
#define DSA_SEL_CALL
#else
#define DSA_SEL_CALL phase_ckvt(c); for (int r2 = 0; r2 < REPN(20); ++r2) phase_dsa_sel(c, l);
#endif
#ifdef DSA_NO_ATT
#define DSA_ATT_CALL
#else
#define DSA_ATT_CALL for (int r2 = 0; r2 < REPN(21); ++r2) phase_dsa_att(c, l);
#endif
constexpr int PH_PER_L = 18, N_PHASES = 1 + NL * PH_PER_L;
#ifndef PH_MASK
#define PH_MASK 0xFFFFFFFFu
#endif
#define IN(k) (lo <= (k) && (k) < hi)
#define EN(b) ((PH_MASK >> (b)) & 1u)
#ifndef REP_MASK
#define REP_MASK 0u
#endif
#define REPN(b) (((REP_MASK >> (b)) & 1u) ? 2 : 1)
#define SEAM(k) do { if (MK_ONE_LAUNCH && IN(k) && IN((k) + 1)) xcd_barrier(bar); } while (0)
template <int l>
__device__ __forceinline__ void layer_program(const Ctx& c, const XcdBarrier& bar, int lo, int hi) {
        const int P = 1 + l * PH_PER_L;
        const float* xin = l == 0 ? c.in[IN_X] : c.out;
        bf16* PB = (bf16*)(c.ws + WS_PB); float* SM = (float*)(c.ws + WS_SM);
        const bf16* XN = (const bf16*)(c.ws + WS_XN);
        const bf16* WIN = (const bf16*)(c.ws + WS_WIN) + (size_t)l * NINP * 1024;
        if (EN(1) && IN(P + 0)) { for (int rep = 0; rep < REPN(1); ++rep) {  if (l == 0) phase_norm1(c, 0, c.in[IN_X]);  if (rep + 1 < REPN(1)) xcd_barrier(bar); } } SEAM(P + 0);
        if (EN(2) && IN(P + 1)) { for (int rep = 0; rep < REPN(2); ++rep) {  EpiInPB E{PB, SM}; dgemm_phase(c, XN, 1024, T, WIN, NPB / 256, 1024, EpiU<decltype(E)>{E});  if (rep + 1 < REPN(2)) xcd_barrier(bar); } } SEAM(P + 1);
        if (EN(3) && IN(P + 2)) { for (int rep = 0; rep < REPN(3); ++rep) {  phase_prep(c, l);  if (rep + 1 < REPN(3)) xcd_barrier(bar); } } SEAM(P + 2);
        if (EN(4) && IN(P + 3)) { for (int rep = 0; rep < REPN(4); ++rep) {
#if SCAN_3PASS
            for (int r2 = 0; r2 < REPN(22); ++r2) phase_scanA(c, l);
            xcd_barrier(bar); scanB(c); xcd_barrier(bar); phase_scanC(c, l);
#else
            phase_scans(c, l);
#endif
            if (rep + 1 < REPN(4)) xcd_barrier(bar); } } SEAM(P + 3);
        if (EN(5) && IN(P + 4)) { for (int rep = 0; rep < REPN(5); ++rep) {  EpiQ E{(bf16*)(c.ws + WS_QLAT), (bf16*)(c.ws + WS_QIDX), (const float*)(c.ws + WS_RSTDQ)};
            dgemm_phase(c, PB + PB_CQ, NPB, T, (const bf16*)(c.ws + WS_WQ) + (size_t)l * 1280 * 256, 5, 256, EpiU<decltype(E)>{E});  if (rep + 1 < REPN(5)) xcd_barrier(bar); } } SEAM(P + 4);
        if (EN(6) && IN(P + 5)) { for (int rep = 0; rep < REPN(6); ++rep) {  EpiGate E{(bf16*)(c.ws + WS_G)}; dgemm_phase(c, XN, 1024, T, WIN + (size_t)NPB * 1024, NG / 256, 1024, EpiU<decltype(E)>{E});  if (rep + 1 < REPN(6)) xcd_barrier(bar); } } SEAM(P + 5);
        if (EN(7) && IN(P + 6)) { for (int rep = 0; rep < REPN(7); ++rep) {  DSA_SEL_CALL xcd_barrier(bar); DSA_ATT_CALL  if (rep + 1 < REPN(7)) xcd_barrier(bar); } } SEAM(P + 6);
        if (EN(8) && IN(P + 7)) { for (int rep = 0; rep < REPN(8); ++rep) {  EpiUp E{(bf16*)(c.ws + WS_M1), (const bf16*)(c.ws + WS_G), 0, 1};
            dgemm_phase(c, (const bf16*)(c.ws + WS_UA), 512, T, (const bf16*)(c.ws + WS_WUPA) + (size_t)l * 1024 * 512, 4, 512, EpiU<decltype(E)>{E});  if (rep + 1 < REPN(8)) xcd_barrier(bar); } } SEAM(P + 7);
        if (EN(9) && IN(P + 8)) { for (int rep = 0; rep < REPN(9); ++rep) {  EpiUp E{(bf16*)(c.ws + WS_M1), (const bf16*)(c.ws + WS_G), 1024, 0};
            dgemm_phase(c, (const bf16*)(c.ws + WS_OLAT), 1024, T, (const bf16*)(c.ws + WS_WUVB) + (size_t)l * 1024 * 1024, 4, 1024, EpiU<decltype(E)>{E});  if (rep + 1 < REPN(9)) xcd_barrier(bar); } } SEAM(P + 8);
        if (EN(10) && IN(P + 9)) { for (int rep = 0; rep < REPN(10); ++rep) {  EpiUp E{(bf16*)(c.ws + WS_M1), (const bf16*)(c.ws + WS_G), 2048, 0};
            dgemm_phase(c, (const bf16*)(c.ws + WS_UC), 512, T, (const bf16*)(c.ws + WS_WUPC) + (size_t)l * 1024 * 512, 4, 512, EpiU<decltype(E)>{E});  if (rep + 1 < REPN(10)) xcd_barrier(bar); } } SEAM(P + 9);
        if (EN(11) && IN(P + 10)) { for (int rep = 0; rep < REPN(11); ++rep) {  EpiWo E{xin, c.out, (const float*)(c.ws + WS_MOD) + (size_t)l * 16 * 6144 + 2048};
            dgemm_phase(c, (const bf16*)(c.ws + WS_M1), 1024, T, (const bf16*)(c.ws + WS_WO) + (size_t)l * 1024 * 1024, 4, 1024, EpiU<decltype(E)>{E});  if (rep + 1 < REPN(11)) xcd_barrier(bar); } } SEAM(P + 10);
        if (EN(12) && IN(P + 11)) { for (int rep = 0; rep < REPN(12); ++rep) {  phase_route(c, l, c.out);  if (rep + 1 < REPN(12)) xcd_barrier(bar); } } SEAM(P + 11);
        if (EN(13) && IN(P + 12)) { for (int rep = 0; rep < REPN(13); ++rep) {  phase_gemm1(c, l, 0);  if (rep + 1 < REPN(13)) xcd_barrier(bar); } } SEAM(P + 12);
        if (EN(14) && IN(P + 13)) { for (int rep = 0; rep < REPN(14); ++rep) {  phase_gemm2(c, l, 0);  if (rep + 1 < REPN(14)) xcd_barrier(bar); } } SEAM(P + 13);
        if (EN(15) && IN(P + 14)) { for (int rep = 0; rep < REPN(15); ++rep) {  phase_combine(c, l, 0, c.out);  if (rep + 1 < REPN(15)) xcd_barrier(bar); } } SEAM(P + 14);
        if (EN(16) && IN(P + 15)) { for (int rep = 0; rep < REPN(16); ++rep) {  phase_gemm1(c, l, 1);  if (rep + 1 < REPN(16)) xcd_barrier(bar); } } SEAM(P + 15);
        if (EN(17) && IN(P + 16)) { for (int rep = 0; rep < REPN(17); ++rep) {  phase_gemm2(c, l, 1);  if (rep + 1 < REPN(17)) xcd_barrier(bar); } } SEAM(P + 16);
        if (EN(18) && IN(P + 17)) { for (int rep = 0; rep < REPN(18); ++rep) {  phase_combine(c, l, 1, c.out);  if (rep + 1 < REPN(18)) xcd_barrier(bar); } } SEAM(P + 17);
    }
__global__ void __launch_bounds__(NTHR, 2) fwd(Args args) {
    extern __shared__ __attribute__((aligned(16))) unsigned char lds_raw[];
    Ctx c;
    c.lds = (LAS unsigned char*)lds_raw;
    c.tid = threadIdx.x; c.lane = c.tid & 63; c.wave = __builtin_amdgcn_readfirstlane(c.tid >> 6);
    c.bid = blockIdx.x; c.nblk = gridDim.x;
    c.in = args.in; c.out = args.out; c.ws = args.ws;
    for (int u = c.tid; u < (LDS_BYTES - LDS_MISC) / 4; u += NTHR) ((LAS unsigned*)(c.lds + LDS_MISC))[u] = 0u;
    __syncthreads();
    XcdBarrier bar; bar.bar = (unsigned*)(c.ws + WS_CTL) + CW_BAR; bar.x = 0; bar.st = (volatile LAS unsigned*)(c.lds + LDS_MISC);
    if (MK_ONE_LAUNCH) bar = xcd_barrier_post((unsigned*)(c.ws + WS_CTL) + CW_BAR, (volatile LAS unsigned*)(c.lds + LDS_MISC));
    const int lo = args.ph_lo, hi = args.ph_hi;
    if (EN(0) && IN(0)) { for (int rep = 0; rep < REPN(0); ++rep) { phase_prologue(c); if (rep + 1 < REPN(0)) xcd_barrier(bar); } } SEAM(0);
    layer_program<0>(c, bar, lo, hi);
    layer_program<1>(c, bar, lo, hi);
#undef IN
#undef SEAM
}

extern "C" void kernel_launch(void* const* d_in, const int* in_sizes, int n_in, void* d_out, int out_size, void* d_ws, size_t ws_size, hipStream_t stream) {
    static int grid = 0;
    if (grid == 0) {
        if (n_in != 33 || out_size != T * D || ws_size < WS_END) { fprintf(stderr, "kernel_launch: unexpected problem (n_in %d out %d ws %zu)\n", n_in, out_size, ws_size); grid = -1; return; }
        int dev = 0, cus = 0, per_cu = 0;
        if (hipGetDevice(&dev) != hipSuccess || hipDeviceGetAttribute(&cus, hipDeviceAttributeMultiprocessorCount, dev) != hipSuccess) { grid = -1; return; }
        if (hipFuncSetAttribute((const void*)fwd, hipFuncAttributeMaxDynamicSharedMemorySize, LDS_BYTES) != hipSuccess) { fprintf(stderr, "kernel_launch: hipFuncSetAttribute failed\n"); grid = -1; return; }
        if (hipOccupancyMaxActiveBlocksPerMultiprocessor(&per_cu, (const void*)fwd, NTHR, LDS_BYTES) != hipSuccess || per_cu < 1) { fprintf(stderr, "kernel_launch: occupancy query says %d\n", per_cu); }
        (void)hipGetLastError();
        grid = cus;
    }
    if (grid < 0) return;
    (void)hipMemsetAsync((char*)d_ws + WS_CTL, 0, CTL_BYTES, stream);
    Args a{};
    for (int i = 0; i < 33; ++i) a.in[i] = (const float*)d_in[i];
    a.out = (float*)d_out; a.ws = (unsigned char*)d_ws;
#if MK_ONE_LAUNCH
    a.ph_lo = 0; a.ph_hi = N_PHASES;
    hipLaunchKernelGGL(fwd, dim3(grid), dim3(NTHR), LDS_BYTES, stream, a);
#else
    for (int p = 0; p < N_PHASES; ++p) {
        if (p == 1 + PH_PER_L) continue;
        a.ph_lo = p; a.ph_hi = p + 1;
        hipLaunchKernelGGL(fwd, dim3(grid), dim3(NTHR), LDS_BYTES, stream, a);
    }
#endif
}
```

```cpp
#include <hip/hip_runtime.h>
#include <cstdio>
#include <cstdint>

#define LAS __attribute__((address_space(3)))
#define GAS __attribute__((address_space(1)))
typedef unsigned short bf16;
typedef short bf16x8 __attribute__((ext_vector_type(8)));
typedef float f32x4 __attribute__((ext_vector_type(4)));
typedef float f32x2 __attribute__((ext_vector_type(2)));
typedef unsigned u32x4 __attribute__((ext_vector_type(4)));
typedef unsigned u32x2 __attribute__((ext_vector_type(2)));
typedef GAS unsigned gu32;

#ifndef SCAN_3PASS
#define SCAN_3PASS 1
#endif
#ifndef SCAN_RECURRENT
#define SCAN_RECURRENT 0
#endif
#ifndef MK_ONE_LAUNCH
#define MK_ONE_LAUNCH 1
#endif

constexpr int NB = 16, SEQ = 2048, D = 1024, T = NB * SEQ, NL = 2;
constexpr int NIN = 6592, NPB = 3584, NG = 3072, NINP = NPB + NG;
constexpr int NE = 64, NEX = 65, EFF = 256, TOPK = 6;
constexpr int HALF_T = T / 2;
constexpr int DSA_K = 256;
constexpr float EPS = 1e-6f;
constexpr int NTHR = 512, NWAVES = 8;

constexpr int PB_QA = 0, PB_KA = 256, PB_VA = 512, PB_GA = 1024, PB_CQ = 1536, PB_CKV = 1792, PB_QC = 2048, PB_KC = 2304, PB_VC = 2560, PB_OC = 3072;
constexpr int SM_KIDX = 0, SM_ALR = 32, SM_WIDX = 48, SM_IC = 56, SM_FC = 60;

constexpr size_t MiB = 1u << 20;
constexpr size_t WS_CTL = 0, CTL_BYTES = 1 * MiB;
constexpr size_t WS_MOD = 1 * MiB;
constexpr size_t WS_RSTDQ = 2 * MiB;
constexpr size_t WS_TOKPOS = 3 * MiB;
constexpr size_t WS_IDENT = 3 * MiB + 800 * 1024;
constexpr size_t WS_WIN = 4 * MiB;
constexpr size_t WS_WQ = 30 * MiB;
constexpr size_t WS_WUPA = 32 * MiB;
constexpr size_t WS_WUPC = 34 * MiB;
constexpr size_t WS_WUVB = 36 * MiB;
constexpr size_t WS_WO = 40 * MiB;
constexpr size_t WS_WGU = 44 * MiB;
constexpr size_t WS_WD = 109 * MiB;
constexpr size_t WS_XN = 142 * MiB;
constexpr size_t WS_OLAT = WS_XN;
constexpr size_t WS_UA = 206 * MiB;
constexpr size_t WS_UC = 238 * MiB;
constexpr size_t WS_XN2 = 206 * MiB;
constexpr size_t WS_QLAT = 270 * MiB;
constexpr size_t WS_M1 = WS_QLAT;
constexpr size_t WS_QIDX = 334 * MiB;
constexpr size_t WS_CKVN = 350 * MiB;
constexpr size_t WS_KIDX = 358 * MiB;
constexpr size_t WS_SM = 360 * MiB;
constexpr size_t WS_PB = 376 * MiB;
constexpr size_t WS_G = WS_PB;
constexpr size_t WS_HID = 270 * MiB;
constexpr size_t WS_Y = 334 * MiB;
constexpr size_t WS_ROWL = 590 * MiB;
constexpr size_t WS_WL = 598 * MiB;
constexpr size_t WS_CKVT = 576 * MiB;
constexpr size_t WS_MASK = 584 * MiB;
static_assert(WS_CKVT >= WS_G + (size_t)T * NG * 2 && WS_MASK + (size_t)T * 64 * 4 <= WS_PB + (size_t)T * NPB * 2, "CKVT/MASK placement");
constexpr size_t WS_QS = 44 * MiB;
constexpr size_t WS_DSG = 76 * MiB;
constexpr size_t WS_DSM = 600 * MiB;
constexpr size_t WS_ET = 108 * MiB;
constexpr size_t WS_CT = 108 * MiB + 512 * 1024;
constexpr size_t WS_MP = 108 * MiB + 768 * 1024;
constexpr size_t WS_GPM = 109 * MiB;
constexpr size_t WS_GBC = 110 * MiB;
constexpr size_t WS_DN = 111 * MiB;
constexpr size_t WS_END = 636 * MiB;
static_assert(WS_PB + (size_t)T * NPB * 2 <= 600 * MiB, "PB");
static_assert(WS_Y + (size_t)131072 * 1024 * 2 <= WS_ROWL, "Y");

constexpr int CW_BAR = 4096;
constexpr int CW_CNT = 16384;

constexpr int LDS_BYTES = 147456;
constexpr int LDS_MISC = 145408;

__device__ __forceinline__ unsigned f2bf(float f) { unsigned u = __builtin_bit_cast(unsigned, f); return (u + 0x7fffu + ((u >> 16) & 1u)) >> 16; }
__device__ __forceinline__ float bf2f(unsigned b) { return __builtin_bit_cast(float, b << 16); }
typedef __bf16 bf16x2_t __attribute__((ext_vector_type(2)));
__device__ __forceinline__ unsigned pk2(float lo, float hi) { const f32x2 v = {lo, hi}; const bf16x2_t b = __builtin_convertvector(v, bf16x2_t); return __builtin_bit_cast(unsigned, b); }
__device__ __forceinline__ float bflo(unsigned w) { return __builtin_bit_cast(float, w << 16); }
__device__ __forceinline__ float bfhi(unsigned w) { return __builtin_bit_cast(float, w & 0xffff0000u); }
__device__ __forceinline__ float wave_sum(float v) {
#pragma unroll
    for (int o = 1; o < 64; o <<= 1) v += __shfl_xor(v, o);
    return v;
}
__device__ __forceinline__ float wave_max(float v) {
#pragma unroll
    for (int o = 1; o < 64; o <<= 1) v = fmaxf(v, __shfl_xor(v, o));
    return v;
}
__device__ __forceinline__ int wave_sum_i(int v) {
#pragma unroll
    for (int o = 1; o < 64; o <<= 1) v += __shfl_xor(v, o);
    return v;
}
__device__ __forceinline__ void lds_barrier() { asm volatile("s_waitcnt lgkmcnt(0)" ::: "memory"); __builtin_amdgcn_s_barrier(); asm volatile("" ::: "memory"); }
__device__ __forceinline__ float sigmoidf_(float x) { return 1.f / (1.f + __expf(-x)); }
__device__ __forceinline__ float siluf_(float x) { return x / (1.f + __expf(-x)); }
__device__ __forceinline__ float logsigmoidf_(float x) { return fminf(x, 0.f) - log1pf(__expf(-fabsf(x))); }
__device__ __forceinline__ float logsigmoid_fast(float x) { return fminf(x, 0.f) - __logf(1.f + __expf(-fabsf(x))); }
__device__ __forceinline__ void st_bf4(bf16* p, f32x4 v) { u32x2 w; w.x = pk2(v[0], v[1]); w.y = pk2(v[2], v[3]); *(u32x2*)p = w; }
__device__ __forceinline__ f32x4 ld_bf4_l2(const bf16* p) { const unsigned long long q = __hip_atomic_load((const unsigned long long*)p, __ATOMIC_RELAXED, __HIP_MEMORY_SCOPE_AGENT); const unsigned lo = (unsigned)q, hi = (unsigned)(q >> 32); return (f32x4){bflo(lo), bfhi(lo), bflo(hi), bfhi(hi)}; }
__device__ __forceinline__ f32x4 ld_bf4(const bf16* p) { u32x2 w = *(const u32x2*)p; return (f32x4){bflo(w.x), bfhi(w.x), bflo(w.y), bfhi(w.y)}; }

#define XB_TMO      128
#define XB_XCNT(j)  (256  + 64 * (j))
#define XB_XSUB(j)  (1280 + 64 * (j))
#define XB_XGEN(j)  (2304 + 64 * (j))
#define XB_TOP      3328
#define XB_TOPGEN   3392
#define XCD_BAR_WORDS 3456
#define XB_SPIN_CAP (1u << 22)
__device__ __forceinline__ unsigned xb_ld(unsigned* p)              { return __hip_atomic_load(p, __ATOMIC_RELAXED, __HIP_MEMORY_SCOPE_AGENT); }
__device__ __forceinline__ unsigned xb_add(unsigned* p, unsigned v) { return __hip_atomic_fetch_add(p, v, __ATOMIC_RELAXED, __HIP_MEMORY_SCOPE_AGENT); }
__device__ __forceinline__ unsigned xb_xcc_id() { return (unsigned)__builtin_amdgcn_s_getreg((3 << 11) | 20) & 0xFu; }
#define XB_SPIN(cond, bar) do { unsigned _sp = 0; while (cond) { __builtin_amdgcn_s_sleep(1); \
    if ((++_sp & 255u) == 0u) { if (xb_ld(&(bar)[XB_TMO])) break; if (_sp > XB_SPIN_CAP) { atomicAdd(&(bar)[XB_TMO], 1u); break; } } } } while (0)
struct XcdBarrier { unsigned* bar; unsigned x; volatile LAS unsigned* st; };
__device__ __forceinline__ XcdBarrier xcd_barrier_post(unsigned* bar, volatile LAS unsigned* st) {
    XcdBarrier b; b.bar = bar; b.x = xb_xcc_id(); b.st = st;
    if (threadIdx.x == 0) (void)xb_add(&bar[XB_XCNT(b.x)], 1u);
    return b;
}
__device__ __forceinline__ void xcd_barrier_complete(unsigned* bar, unsigned x, unsigned& nloc, unsigned& nx) {
    const unsigned G = gridDim.x * gridDim.y * gridDim.z;
    unsigned sum, cnt, mine, sp = 0u;
    for (;;) {
        sum = 0u; cnt = 0u; mine = 0u;
#pragma unroll
        for (unsigned j = 0; j < 16; ++j) { const unsigned c = xb_ld(&bar[XB_XCNT(j)]); sum += c; cnt += (c > 0u) ? 1u : 0u; mine = (j == x) ? c : mine; }
        if (sum == G) break;
        __builtin_amdgcn_s_sleep(1);
        if ((++sp & 255u) == 0u) { if (xb_ld(&bar[XB_TMO])) break; if (sp > XB_SPIN_CAP) { atomicAdd(&bar[XB_TMO], 1u); break; } }
    }
    nloc = mine > 0u ? mine : 1u; nx = cnt > 0u ? cnt : 1u;
}
__device__ __forceinline__ void xcd_barrier(const XcdBarrier& b) {
    asm volatile("s_waitcnt vmcnt(0)" ::: "memory");
    __syncthreads();
    if (threadIdx.x == 0) {
        unsigned* bar = b.bar;
        __builtin_amdgcn_s_waitcnt(0);
        unsigned nloc = b.st[0], nx = b.st[1];
        if (nloc == 0u) { xcd_barrier_complete(bar, b.x, nloc, nx); b.st[0] = nloc; b.st[1] = nx; }
        const unsigned old = xb_add(&bar[XB_XSUB(b.x)], 1u);
        const unsigned gen = old / nloc;
        if (old + 1u == (gen + 1u) * nloc) {
            __builtin_amdgcn_fence(__ATOMIC_RELEASE, "agent");
            asm volatile("s_waitcnt vmcnt(0)" ::: "memory");
            const unsigned og = xb_add(&bar[XB_TOP], 1u);
            const unsigned tg = og / nx;
            if (og + 1u == (tg + 1u) * nx) xb_add(&bar[XB_TOPGEN], 1u);
            else XB_SPIN(xb_ld(&bar[XB_TOPGEN]) == tg, bar);
            __builtin_amdgcn_fence(__ATOMIC_ACQUIRE, "agent");
            xb_add(&bar[XB_XGEN(b.x)], 1u);
            asm volatile("s_waitcnt vmcnt(0)" ::: "memory");
        } else {
            XB_SPIN(xb_ld(&bar[XB_XGEN(b.x)]) == gen, bar);
            __builtin_amdgcn_fence(__ATOMIC_ACQUIRE, "agent");
            asm volatile("s_waitcnt vmcnt(0)" ::: "memory");
        }
    }
    __syncthreads();
}

struct Args { const float* in[33]; float* out; unsigned char* ws; int ph_lo, ph_hi; };

struct Ctx {
    LAS unsigned char* lds;
    int tid, lane, wave, bid, nblk;
    const float* const* in;
    float* out; unsigned char* ws;
};
#define IN_X 0
#define IN_C 1
#define IN_ADAW 2
#define IN_ADAB 3
#define IN_NMIX 4
#define IN_NFFN 5
#define IN_WIN 6
#define IN_GLA_WA2 7
#define IN_GLA_BA 8
#define IN_GLA_NORM 9
#define IN_DSA_NQ 10
#define IN_DSA_NKV 11
#define IN_DSA_WUQ 12
#define IN_DSA_WUK 13
#define IN_DSA_WUV 14
#define IN_DSA_WQI 15
#define IN_ML_CONV 16
#define IN_ML_BI 17
#define IN_ML_BF 18
#define IN_ML_NORM 19
#define IN_WUPA 20
#define IN_WUPB 21
#define IN_WUPC 22
#define IN_WO 23
#define IN_RW 24
#define IN_RB 25
#define IN_EWG 26
#define IN_EWU 27
#define IN_EWD 28
#define IN_SWG 29
#define IN_SWU 30
#define IN_SWD 31
#define IN_NFIN 32

template <class SrcF>
__device__ __forceinline__ void tr_item(const SrcF& src, bf16* dst, int dst_ld, int n0, int k0, LAS float* scr, int lane) {
    const int j = lane & 31;
    const float* colp = src(n0 + j);
    const long ld = src.ld;
    float tv[32];
#pragma unroll
    for (int i = 0; i < 32; ++i) { const int kk = 2 * i + (lane >> 5); tv[i] = colp ? colp[(long)(k0 + kk) * ld] : 0.f; }
#pragma unroll
    for (int i = 0; i < 32; ++i) { const int kk = 2 * i + (lane >> 5); scr[kk * 33 + j] = tv[i]; }
    asm volatile("s_waitcnt lgkmcnt(0)" ::: "memory");
    const int c = lane & 7;
#pragma unroll
    for (int jj = 0; jj < 4; ++jj) { const int n = (lane >> 3) + 8 * jj; const LAS float* s = scr + (8 * c) * 33 + n;
        u32x4 o; o.x = pk2(s[0 * 33], s[1 * 33]); o.y = pk2(s[2 * 33], s[3 * 33]); o.z = pk2(s[4 * 33], s[5 * 33]); o.w = pk2(s[6 * 33], s[7 * 33]);
        *(u32x4*)(dst + (size_t)(n0 + n) * dst_ld + k0 + 8 * c) = o; }
    asm volatile("s_waitcnt lgkmcnt(0)" ::: "memory");
}
struct SrcPlain { const float* W; long ld; __device__ __forceinline__ const float* operator()(int n) const { return W + n; } };
__device__ __forceinline__ int win_src_col(int r) {
    if (r < 1536) return r;
    if (r < 1792) return 1552 + (r - 1536);
    if (r < 1920) return 1808 + (r - 1792);
    if (r < 1952) return 1936 + (r - 1920);
    if (r < 1968) return 1536 + (r - 1952);
    if (r < 1976) return 1968 + (r - 1968);
    if (r < 1980) return 3000 + (r - 1976);
    if (r < 1984) return 3004 + (r - 1980);
    if (r < 2048) return -1;
    if (r < 2560) return 1976 + (r - 2048);
    if (r < 3072) return 2488 + (r - 2560);
    if (r < 3584) return 3008 + (r - 3072);
    return 3520 + (r - 3584);
}
struct SrcWin { const float* W; long ld; __device__ __forceinline__ const float* operator()(int n) const { const int c = win_src_col(n); return c < 0 ? nullptr : W + c; } };
struct SrcGU { const float* Wg; const float* Wu; long ld;
    __device__ __forceinline__ const float* operator()(int r) const { const int pn = r >> 8, w = r & 255, j = 128 * pn + (w & 127); return (w < 128 ? Wg : Wu) + j; } };

constexpr int SG_LD = 40;
template <class Epi>
__device__ __forceinline__ void sgemm_unit(const Ctx& c, const bf16* A, int lda, const int* rowlist, int nvalid, int arow0, const bf16* Bt, int K, const Epi& E, int erow0, int ecol0) {
    LAS bf16* As = (LAS bf16*)c.lds;
    LAS bf16* Bs = (LAS bf16*)(c.lds + 128 * SG_LD * 2);
    const int tid = c.tid, lane = c.lane, wave = c.wave, wr = wave >> 2, wc = wave & 3, fr = lane & 15, fq = lane >> 4;
    const int lr = tid >> 2, ch = tid & 3;
    int srow = arow0 + lr;
    if (rowlist) { srow = (arow0 + lr < nvalid) ? rowlist[arow0 + lr] : 0; }
    const bf16* ap = A + (size_t)srow * lda + ch * 8;
    const bf16* bp0 = Bt + (size_t)lr * K + ch * 8;
    const bf16* bp1 = Bt + (size_t)(128 + lr) * K + ch * 8;
    f32x4 acc[2][4][2];
#pragma unroll
    for (int a = 0; a < 2; ++a)
#pragma unroll
        for (int m = 0; m < 4; ++m)
#pragma unroll
            for (int n = 0; n < 2; ++n) acc[a][m][n] = (f32x4){0.f, 0.f, 0.f, 0.f};
    u32x4 ra = *(const u32x4*)ap, rb0 = *(const u32x4*)bp0, rb1 = *(const u32x4*)bp1;
    for (int k0 = 0; k0 < K; k0 += 32) {
        __syncthreads();
        *(LAS u32x4*)(As + lr * SG_LD + ch * 8) = ra;
        *(LAS u32x4*)(Bs + lr * SG_LD + ch * 8) = rb0;
        *(LAS u32x4*)(Bs + (128 + lr) * SG_LD + ch * 8) = rb1;
        __syncthreads();
        if (k0 + 32 < K) { ra = *(const u32x4*)(ap + k0 + 32); rb0 = *(const u32x4*)(bp0 + k0 + 32); rb1 = *(const u32x4*)(bp1 + k0 + 32); }
        bf16x8 af[4], bfr[2][2];
#pragma unroll
        for (int m = 0; m < 4; ++m) af[m] = *(const LAS bf16x8*)(As + (wr * 64 + m * 16 + fr) * SG_LD + fq * 8);
#pragma unroll
        for (int bj = 0; bj < 2; ++bj)
#pragma unroll
            for (int n = 0; n < 2; ++n) bfr[bj][n] = *(const LAS bf16x8*)(Bs + (bj * 128 + wc * 32 + n * 16 + fr) * SG_LD + fq * 8);
#pragma unroll
        for (int bj = 0; bj < 2; ++bj)
#pragma unroll
            for (int m = 0; m < 4; ++m)
#pragma unroll
                for (int n = 0; n < 2; ++n) acc[bj][m][n] = __builtin_amdgcn_mfma_f32_16x16x32_bf16(bfr[bj][n], af[m], acc[bj][m][n], 0, 0, 0);
    }
#pragma unroll
    for (int m = 0; m < 4; ++m)
#pragma unroll
        for (int n = 0; n < 2; ++n) E(erow0 + wr * 64 + m * 16 + fr, ecol0 + wc * 32 + n * 16 + 4 * fq, acc[0][m][n], acc[1][m][n]);
}
template <class Epi>
__device__ __forceinline__ void sgemm_phase(const Ctx& c, const bf16* A, int lda, int M, const bf16* Bt, int ntn, int K, const Epi& E) {
    const int nu = (M / 128) * ntn;
    for (int u = c.bid; u < nu; u += c.nblk) {
        const int pm = u / ntn, pn = u % ntn;
        sgemm_unit(c, A, lda, nullptr, 0, pm * 128, Bt + (size_t)pn * 256 * K, K, E, pm * 128, pn * 256);
    }
    __syncthreads();
}


namespace g8 {
constexpr int BM = 256, BK = 64, HALF = 128, HTB = HALF * BK * 2, STAGE_BYTES = 8 * HTB, NXCD = 8, WGM = 8;
__host__ __device__ __forceinline__ int lds_byte(int r, int c) { const int st = (r >> 4) * 2 + (c >> 5), rr = r & 15, cc = c & 31, ob = rr * 64 + cc * 2; return st * 1024 + (ob ^ (((ob >> 9) & 1) << 5)); }
__host__ __device__ __forceinline__ void stage_rc(int b, int& R, int& C) { const int st = b / 1024, sb = b % 1024, swz = sb ^ (((sb >> 9) & 1) << 5); R = (st >> 1) * 16 + swz / 64; C = (st & 1) * 32 + (swz % 64) / 2; }
struct GUnit { const char* A; const char* B; const int* rl; int nvalid; int erow0, ecol0; int x0; const float* xp; };
__device__ __forceinline__ bool static_order(int nM, int nN, int G, int c, int i, int& pm, int& pn) {
    const int nwg = nM * nN; const long L = (long)i * G + c; if (L >= nwg) return false;
    int wgid = (int)L; { const int q = nwg / NXCD, r = nwg % NXCD, xcd = wgid % NXCD, off = wgid / NXCD; wgid = (xcd < r ? xcd * (q + 1) : r * (q + 1) + (xcd - r) * q) + off; }
    const int nig = WGM * nN, gid = wgid / nig, fm = gid * WGM, gsz = (nM - fm) < WGM ? (nM - fm) : WGM;
    pm = fm + ((wgid % nig) % gsz); pn = (wgid % nig) / gsz; return true;
}
struct DenseSched { const char* A; const char* Bt; size_t ldaB, ldbB; int nM, nN, G, c;
    __device__ __forceinline__ bool next(int i, GUnit& u) const { int pm, pn; if (!static_order(nM, nN, G, c, i, pm, pn)) return false;
        u.A = A + (size_t)pm * 256 * ldaB; u.B = Bt + (size_t)pn * 256 * ldbB; u.rl = nullptr; u.nvalid = 0; u.erow0 = pm * 256; u.ecol0 = pn * 256; u.x0 = 0; u.xp = nullptr; return true; } };

template <bool GATHER, class Epi, class Sched>
__device__ __forceinline__ void gemm_phase(LAS unsigned char* lds, unsigned ldaB, int K, const Sched& S, const Epi& E) {
    const int tid = threadIdx.x, wid = __builtin_amdgcn_readfirstlane(tid >> 6), lane = tid & 63, wr = wid >> 2, wc = wid & 3, fr = lane & 15, fq = lane >> 4;
    const int nt = K / BK;
    int R0, C0, R1, C1; stage_rc(tid * 16, R0, C0); stage_rc(tid * 16 + 8192, R1, C1);
    unsigned voffB[2]; voffB[0] = (unsigned)(R0 * K + C0) * 2u; voffB[1] = (unsigned)(R1 * K + C1) * 2u;
    unsigned ac0[2], ac1[2], an0[2], an1[2];
    const size_t kstep = (size_t)(BK * 2);
    const size_t hstepB = (size_t)HALF * K * 2;
    const unsigned ldsw = (unsigned)wid * 1024u;
    const int aoff = lds_byte(wr * 64 + fr, fq * 8), boff = lds_byte(wc * 32 + fr, fq * 8);
#define G8_SA(b, h) (((b) * 2 + (h)) * HTB)
#define G8_SB(b, h) ((4 + (b) * 2 + (h)) * HTB)
#define G8_STAGE(bufoff, gbase, voff) do { _Pragma("unroll") for (int _i = 0; _i < 2; ++_i) \
        __builtin_amdgcn_global_load_lds((const unsigned*)((const char*)(gbase) + (voff)[_i]), (LAS unsigned*)(lds + (bufoff) + ldsw + _i * 8192), 16, 0, 0); } while (0)
#define G8_LDA(dst, b, h) do { _Pragma("unroll") for (int m = 0; m < 4; ++m) _Pragma("unroll") for (int k = 0; k < 2; ++k) dst[m][k] = *(const LAS bf16x8*)(lds + G8_SA(b, h) + aoff + m * 2048 + k * 1024); } while (0)
#define G8_LDB(dst, b, h) do { _Pragma("unroll") for (int n = 0; n < 2; ++n) _Pragma("unroll") for (int k = 0; k < 2; ++k) dst[n][k] = *(const LAS bf16x8*)(lds + G8_SB(b, h) + boff + n * 2048 + k * 1024); } while (0)
#define G8_MMA(ai, bj, At, Bt) do { __builtin_amdgcn_s_setprio(1); _Pragma("unroll") for (int m = 0; m < 4; ++m) _Pragma("unroll") for (int n = 0; n < 2; ++n) _Pragma("unroll") for (int k = 0; k < 2; ++k) \
        acc[ai][bj][m][n] = __builtin_amdgcn_mfma_f32_16x16x32_bf16(Bt[n][k], At[m][k], acc[ai][bj][m][n], 0, 0, 0); __builtin_amdgcn_s_setprio(0); } while (0)
#define G8_WAIT_V(n) asm volatile("s_waitcnt vmcnt(" #n ")" ::: "memory")
#define G8_WAIT_L(n) asm volatile("s_waitcnt lgkmcnt(" #n ")" ::: "memory")
#define G8_BAR __builtin_amdgcn_s_barrier()
#define G8_SCHED __builtin_amdgcn_sched_barrier(0)
#define G8_XLOAD(u) __builtin_amdgcn_global_load_lds((const unsigned*)((u).rl + lane * 4), (LAS unsigned*)(lds + STAGE_BYTES + wid * 1024), 16, 0, 0)
#define G8_AOFF(u, o0, o1) do { if (GATHER) { const LAS int* _rs = (const LAS int*)(lds + STAGE_BYTES + wid * 1024); const int _nv = (u).nvalid - 1; \
        const int _r00 = _rs[min(R0, _nv)], _r01 = _rs[min(R1, _nv)], _r10 = _rs[min(128 + R0, _nv)], _r11 = _rs[min(128 + R1, _nv)]; \
        o0[0] = (unsigned)_r00 * ldaB + (unsigned)C0 * 2u; o0[1] = (unsigned)_r01 * ldaB + (unsigned)C1 * 2u; o1[0] = (unsigned)_r10 * ldaB + (unsigned)C0 * 2u; o1[1] = (unsigned)_r11 * ldaB + (unsigned)C1 * 2u; \
    } else { o0[0] = (unsigned)R0 * ldaB + (unsigned)C0 * 2u; o0[1] = (unsigned)R1 * ldaB + (unsigned)C1 * 2u; o1[0] = (unsigned)(128 + R0) * ldaB + (unsigned)C0 * 2u; o1[1] = (unsigned)(128 + R1) * ldaB + (unsigned)C1 * 2u; } } while (0)
    GUnit cur, nxt; int ui = 0;
    if (!S.next(0, cur)) return;
    f32x4 acc[2][2][4][2];
#pragma unroll
    for (int a = 0; a < 2; ++a)
#pragma unroll
        for (int b = 0; b < 2; ++b)
#pragma unroll
            for (int m = 0; m < 4; ++m)
#pragma unroll
                for (int n = 0; n < 2; ++n) acc[a][b][m][n] = (f32x4){0.f, 0.f, 0.f, 0.f};
    bf16x8 At[4][2], B0[2][2], B1[2][2];
    if (GATHER) { G8_XLOAD(cur); G8_WAIT_V(0); }
    G8_AOFF(cur, ac0, ac1);
    if (GATHER) { G8_WAIT_L(0); }
    const char* cA = cur.A; const char* cB = cur.B;
    G8_STAGE(G8_SB(0, 0), cB, voffB); G8_STAGE(G8_SB(0, 1), cB + hstepB, voffB); G8_STAGE(G8_SA(0, 0), cA, ac0); G8_STAGE(G8_SA(0, 1), cA, ac1);
    if (wr == 1) G8_BAR;
    G8_WAIT_V(2); G8_BAR;
    G8_STAGE(G8_SB(1, 0), cB + kstep, voffB); G8_STAGE(G8_SA(1, 0), cA + kstep, ac0); G8_STAGE(G8_SB(1, 1), cB + hstepB + kstep, voffB);
    G8_WAIT_V(6); G8_BAR;
    for (;;) {
        const bool has_next = S.next(ui + 1, nxt);
        const char* nA = has_next ? nxt.A : cA; const char* nB = has_next ? nxt.B : cB;
        an0[0] = ac0[0]; an0[1] = ac0[1]; an1[0] = ac1[0]; an1[1] = ac1[1];
        const bool xload = GATHER && has_next;
        if (xload) { G8_XLOAD(nxt); }
#pragma unroll 1
        for (int t = 0; t < nt; t += 2) {
            const bool last = (t == nt - 2);
            const char* a1 = cA + (size_t)(t + 1) * kstep;
            const char* a2 = last ? nA : cA + (size_t)(t + 2) * kstep; const char* b2 = last ? nB : cB + (size_t)(t + 2) * kstep;
            const char* a3 = a2 + kstep; const char* b3 = b2 + kstep;
            unsigned* x0 = last ? an0 : ac0; unsigned* x1 = last ? an1 : ac1;
            unsigned s0[2], s1[2]; s0[0] = x0[0]; s0[1] = x0[1]; s1[0] = x1[0]; s1[1] = x1[1];
            G8_LDB(B0, 0, 0); G8_LDB(B1, 0, 1); G8_SCHED; G8_LDA(At, 0, 0); G8_STAGE(G8_SA(1, 1), a1, ac1);
            if (xload && t == 0) { G8_WAIT_V(9); } else { G8_WAIT_V(8); }
            G8_WAIT_L(0); G8_BAR; G8_MMA(0, 0, At, B0); G8_MMA(0, 1, At, B1); G8_BAR; G8_SCHED;
            G8_LDA(At, 0, 1); G8_STAGE(G8_SB(0, 0), b2, voffB); G8_STAGE(G8_SB(0, 1), b2 + hstepB, voffB); G8_STAGE(G8_SA(0, 0), a2, s0);
            G8_WAIT_V(8); G8_WAIT_L(0); G8_BAR; G8_MMA(1, 0, At, B0); G8_MMA(1, 1, At, B1); G8_BAR; G8_SCHED;
            if (xload && t == 0) { G8_AOFF(nxt, an0, an1); }
            G8_LDB(B0, 1, 0); G8_LDB(B1, 1, 1); G8_SCHED; G8_LDA(At, 1, 0); G8_STAGE(G8_SA(0, 1), a2, s1);
            G8_WAIT_V(8); G8_WAIT_L(0); G8_BAR; G8_MMA(0, 0, At, B0); G8_MMA(0, 1, At, B1); G8_BAR; G8_SCHED;
            G8_LDA(At, 1, 1); G8_STAGE(G8_SB(1, 0), b3, voffB); G8_STAGE(G8_SB(1, 1), b3 + hstepB, voffB); G8_STAGE(G8_SA(1, 0), a3, s0);
            G8_WAIT_V(8); G8_WAIT_L(0); G8_BAR; G8_MMA(1, 0, At, B0); G8_MMA(1, 1, At, B1); G8_BAR; G8_SCHED;
        }
        if (wr == 0) G8_BAR;
#pragma unroll
        for (int ai = 0; ai < 2; ++ai)
#pragma unroll
            for (int m = 0; m < 4; ++m)
#pragma unroll
                for (int n = 0; n < 2; ++n) E(cur, cur.erow0 + ai * HALF + wr * 64 + m * 16 + fr, cur.ecol0 + wc * 32 + n * 16 + 4 * fq, acc[ai][0][m][n], acc[ai][1][m][n]);
        if (!has_next) break;
#pragma unroll
        for (int a = 0; a < 2; ++a)
#pragma unroll
            for (int b = 0; b < 2; ++b)
#pragma unroll
                for (int m = 0; m < 4; ++m)
#pragma unroll
                    for (int n = 0; n < 2; ++n) acc[a][b][m][n] = (f32x4){0.f, 0.f, 0.f, 0.f};
        cur = nxt; cA = nA; cB = nB; ++ui;
        ac0[0] = an0[0]; ac0[1] = an0[1]; ac1[0] = an1[0]; ac1[1] = an1[1];
        if (wr == 1) G8_BAR;
    }
    G8_WAIT_V(0);
    G8_BAR;
#undef G8_SA
#undef G8_SB
#undef G8_STAGE
#undef G8_LDA
#undef G8_LDB
#undef G8_MMA
#undef G8_WAIT_V
#undef G8_WAIT_L
#undef G8_BAR
#undef G8_SCHED
#undef G8_AOFF
#undef G8_XLOAD
}
}
template <class Epi>
__device__ __forceinline__ void dgemm_phase(const Ctx& c, const bf16* A, int lda, int M, const bf16* Bt, int ntn, int K, const Epi& E, int G = -1, int cid = -1) {
    g8::DenseSched S{(const char*)A, (const char*)Bt, (size_t)lda * 2, (size_t)K * 2, M / 256, ntn, G < 0 ? c.nblk : G, cid < 0 ? c.bid : cid};
    g8::gemm_phase<false>(c.lds, (unsigned)lda * 2u, K, S, E);
    __syncthreads();
}

struct EpiInPB { bf16* PB; float* SM;
    __device__ __forceinline__ void operator()(int row, int col, f32x4 lo, f32x4 hi) const {
        st_bf4(PB + (size_t)row * NPB + col, lo);
        if ((col >> 8) == 7) *(f32x4*)(SM + (size_t)row * 128 + (col & 127)) = hi;
        else st_bf4(PB + (size_t)row * NPB + col + 128, hi);
    } };
struct EpiQ { bf16* QLAT; bf16* QIDX; const float* rstd;
    __device__ __forceinline__ void operator()(int row, int col, f32x4 lo, f32x4 hi) const {
        const float r = rstd[row];
        if (col < 1024) { st_bf4(QLAT + (size_t)row * 1024 + col, lo * r); st_bf4(QLAT + (size_t)row * 1024 + col + 128, hi * r); }
        else { st_bf4(QIDX + (size_t)row * 256 + (col - 1024), lo * r); st_bf4(QIDX + (size_t)row * 256 + (col - 1024) + 128, hi * r); }
    } };
struct EpiGate { bf16* G;
    __device__ __forceinline__ void operator()(int row, int col, f32x4 lo, f32x4 hi) const {
        f32x4 a, b;
#pragma unroll
        for (int i = 0; i < 4; ++i) { a[i] = sigmoidf_(lo[i]); b[i] = sigmoidf_(hi[i]); }
        st_bf4(G + (size_t)row * NG + col, a); st_bf4(G + (size_t)row * NG + col + 128, b);
    } };
struct EpiUp { bf16* M1; const bf16* G; int goff; int first;
    __device__ __forceinline__ void operator()(int row, int col, f32x4 lo, f32x4 hi) const {
        bf16* m = M1 + (size_t)row * 1024 + col; const bf16* g = G + (size_t)row * NG + goff + col;
        f32x4 a = ld_bf4(g) * lo, b = ld_bf4(g + 128) * hi;
        if (!first) { a += ld_bf4_l2(m); b += ld_bf4_l2(m + 128); }
        st_bf4(m, a); st_bf4(m + 128, b);
    } };
struct EpiWo { const float* res; float* out; const float* g1;
    __device__ __forceinline__ void operator()(int row, int col, f32x4 lo, f32x4 hi) const {
        const float* gp = g1 + (size_t)(row >> 11) * 6144 + col; const size_t o = (size_t)row * 1024 + col;
        const f32x4 ga = *(const f32x4*)gp, gb = *(const f32x4*)(gp + 128);
        const f32x4 ra = *(const f32x4*)(res + o), rb = *(const f32x4*)(res + o + 128);
        *(f32x4*)(out + o) = ra + ga * lo; *(f32x4*)(out + o + 128) = rb + gb * hi;
    } };
struct EpiG1 { bf16* HID; const float* wl; int cnt; int orow0;
    __device__ __forceinline__ void operator()(int row, int col, f32x4 lo, f32x4 hi) const {
        const int hc = col - 128 * (col >> 8);
        f32x4 v = (f32x4){0.f, 0.f, 0.f, 0.f};
        if (row < cnt) { const float w = wl ? wl[row] : 1.f;
#pragma unroll
            for (int i = 0; i < 4; ++i) v[i] = siluf_(lo[i]) * hi[i] * w; }
        st_bf4(HID + (size_t)(orow0 + row) * 256 + hc, v);
    } };
struct EpiG2 { bf16* Y; int orow0;
    __device__ __forceinline__ void operator()(int row, int col, f32x4 lo, f32x4 hi) const {
        st_bf4(Y + (size_t)(orow0 + row) * 1024 + col, lo); st_bf4(Y + (size_t)(orow0 + row) * 1024 + col + 128, hi);
    } };


template <class F> struct EpiU { F f; __device__ __forceinline__ void operator()(const g8::GUnit&, int row, int col, f32x4 lo, f32x4 hi) const { f(row, col, lo, hi); } };

__device__ __forceinline__ void phase_prologue(const Ctx& c) {
    {
        LAS float* cs = (LAS float*)c.lds;
        LAS float* red = (LAS float*)(c.lds + 65536);
        const float* cin = c.in[IN_C];
        if (c.bid < 192) {
            for (int i = c.tid; i < 16 * 1024; i += NTHR) cs[i] = siluf_(cin[i]);
            __syncthreads();
        }
        float* MOD = (float*)(c.ws + WS_MOD);
        for (int it = c.bid; it < 192; it += c.nblk) {
            const int l = it / 96, cg = it % 96, col = cg * 64 + c.lane;
            const float* W = c.in[IN_ADAW] + (size_t)l * 1024 * 6144 + col;
            float acc[16];
#pragma unroll
            for (int b = 0; b < 16; ++b) acc[b] = 0.f;
            const int kbeg = c.wave * 128;
            for (int k = kbeg; k < kbeg + 128; k += 4) {
                const float w0 = W[(size_t)k * 6144], w1 = W[(size_t)(k + 1) * 6144], w2 = W[(size_t)(k + 2) * 6144], w3 = W[(size_t)(k + 3) * 6144];
#pragma unroll
                for (int b = 0; b < 16; ++b) { const f32x4 v = *(const LAS f32x4*)(cs + b * 1024 + k); acc[b] += v[0] * w0 + v[1] * w1 + v[2] * w2 + v[3] * w3; }
            }
#pragma unroll
            for (int b = 0; b < 16; ++b) red[(c.wave * 16 + b) * 64 + c.lane] = acc[b];
            __syncthreads();
            for (int i = c.tid; i < 16 * 64; i += NTHR) { const int b = i >> 6, ln = i & 63; float s = 0.f;
#pragma unroll
                for (int w = 0; w < 8; ++w) s += red[(w * 16 + b) * 64 + ln];
                MOD[((size_t)l * 16 + b) * 6144 + cg * 64 + ln] = s + c.in[IN_ADAB][l * 6144 + cg * 64 + ln]; }
            __syncthreads();
        }
        __syncthreads();
    }
    {
        LAS float* scr = (LAS float*)(c.lds + c.wave * 16384);
        const int gw = c.bid * NWAVES + c.wave, NGW = c.nblk * NWAVES;
        constexpr int I_WIN = (NINP / 32) * (1024 / 64), I_UP = (1024 / 32) * (512 / 64), I_WO = (1024 / 32) * (1024 / 64);
        constexpr int PER_L = I_WIN + 2 * I_UP + I_WO;
        for (int it = gw; it < NL * PER_L; it += NGW) {
            const int l = it / PER_L; int r = it % PER_L;
            if (r < I_WIN) { SrcWin s{c.in[IN_WIN] + (size_t)l * 1024 * NIN, NIN}; tr_item(s, (bf16*)(c.ws + WS_WIN) + (size_t)l * NINP * 1024, 1024, (r / 16) * 32, (r % 16) * 64, scr, c.lane); continue; }
            r -= I_WIN;
            if (r < I_UP) { SrcPlain s{c.in[IN_WUPA] + (size_t)l * 512 * 1024, 1024}; tr_item(s, (bf16*)(c.ws + WS_WUPA) + (size_t)l * 1024 * 512, 512, (r / 8) * 32, (r % 8) * 64, scr, c.lane); continue; }
            r -= I_UP;
            if (r < I_UP) { SrcPlain s{c.in[IN_WUPC] + (size_t)l * 512 * 1024, 1024}; tr_item(s, (bf16*)(c.ws + WS_WUPC) + (size_t)l * 1024 * 512, 512, (r / 8) * 32, (r % 8) * 64, scr, c.lane); continue; }
            r -= I_UP;
            { SrcPlain s{c.in[IN_WO] + (size_t)l * 1024 * 1024, 1024}; tr_item(s, (bf16*)(c.ws + WS_WO) + (size_t)l * 1024 * 1024, 1024, (r / 16) * 32, (r % 16) * 64, scr, c.lane); }
        }
    }
    {
        const int gt = c.bid * NTHR + c.tid, NGT = c.nblk * NTHR;
        for (int i = gt; i < T; i += NGT) ((int*)(c.ws + WS_IDENT))[i] = i;
        for (int it = gt; it < NL * 1280 * 32; it += NGT) {
            const int l = it / (1280 * 32), rem = it % (1280 * 32), n = rem / 32, r0 = (rem % 32) * 8;
            const float* gq = c.in[IN_DSA_NQ] + l * 256;
            float o[8];
            if (n < 1024) {
                const int h = n >> 7, cc = n & 127;
                const float* uk = c.in[IN_DSA_WUK] + (size_t)l * 128 * 512 + (size_t)cc * 512 + h * 64;
#pragma unroll
                for (int i = 0; i < 8; ++i) { const float* uq = c.in[IN_DSA_WUQ] + (size_t)l * 256 * 512 + (size_t)(r0 + i) * 512 + h * 64; float s = 0.f;
                    for (int d = 0; d < 64; ++d) s += uq[d] * uk[d];
                    o[i] = s * (0.125f * 1.4426950408889634f) * gq[r0 + i]; }
            } else {
                const int m = n - 1024;
#pragma unroll
                for (int i = 0; i < 8; ++i) o[i] = c.in[IN_DSA_WQI][(size_t)l * 256 * 256 + (size_t)(r0 + i) * 256 + m] * 0.17677669529663687f * gq[r0 + i];
            }
            u32x4 w; w.x = pk2(o[0], o[1]); w.y = pk2(o[2], o[3]); w.z = pk2(o[4], o[5]); w.w = pk2(o[6], o[7]);
            *(u32x4*)((bf16*)(c.ws + WS_WQ) + (size_t)l * 1280 * 256 + (size_t)n * 256 + r0) = w;
        }
    }
    {
        const int gt = c.bid * NTHR + c.tid, NGT = c.nblk * NTHR;
        for (int it = gt; it < NL * 128 * 1024; it += NGT) {
            const int l = it / (128 * 1024), rem = it % (128 * 1024), kc = rem / 1024, n = rem % 1024;
            const int h = kc >> 4, r0 = (kc & 15) * 8;
            const float* uv = c.in[IN_DSA_WUV] + (size_t)l * 128 * 512;
            const float* ub = c.in[IN_WUPB] + (size_t)l * 512 * 1024 + (size_t)(h * 64) * 1024 + n;
            float o[8];
#pragma unroll
            for (int i = 0; i < 8; ++i) o[i] = 0.f;
            for (int v = 0; v < 64; ++v) { const float b = ub[(size_t)v * 1024];
#pragma unroll
                for (int i = 0; i < 8; ++i) o[i] += uv[(size_t)(r0 + i) * 512 + h * 64 + v] * b; }
            u32x4 w; w.x = pk2(o[0], o[1]); w.y = pk2(o[2], o[3]); w.z = pk2(o[4], o[5]); w.w = pk2(o[6], o[7]);
            *(u32x4*)((bf16*)(c.ws + WS_WUVB) + (size_t)l * 1024 * 1024 + (size_t)n * 1024 + h * 128 + r0) = w;
        }
    }
}

__device__ __forceinline__ void norm_mod_row(const float* xrow, const float* gain, const float* sh, const float* sc, bf16* orow, int lane) {
    f32x4 v[4]; float s = 0.f;
#pragma unroll
    for (int j = 0; j < 4; ++j) { v[j] = *(const f32x4*)(xrow + 4 * (lane + 64 * j)); s += v[j][0] * v[j][0] + v[j][1] * v[j][1] + v[j][2] * v[j][2] + v[j][3] * v[j][3]; }
    const float rstd = rsqrtf(wave_sum(s) * (1.f / D) + EPS);
#pragma unroll
    for (int j = 0; j < 4; ++j) { const int cc = 4 * (lane + 64 * j);
        const f32x4 g = *(const f32x4*)(gain + cc), a = *(const f32x4*)(sc + cc), b = *(const f32x4*)(sh + cc);
        st_bf4(orow + cc, v[j] * rstd * g * (a + 1.f) + b); }
}
__device__ __forceinline__ void phase_norm1(const Ctx& c, int l, const float* xsrc) {
    const int gw = c.bid * NWAVES + c.wave, NGW = c.nblk * NWAVES;
    const float* MOD = (const float*)(c.ws + WS_MOD) + (size_t)l * 16 * 6144;
    bf16* XN = (bf16*)(c.ws + WS_XN);
    for (int t = gw; t < T; t += NGW) { const int b = t >> 11;
        norm_mod_row(xsrc + (size_t)t * D, c.in[IN_NMIX] + l * D, MOD + (size_t)b * 6144, MOD + (size_t)b * 6144 + 1024, XN + (size_t)t * D, c.lane); }
}

__device__ __forceinline__ void phase_prep(const Ctx& c, int l) {
    const int gw = c.bid * NWAVES + c.wave, NGW = c.nblk * NWAVES;
    const bf16* PB = (const bf16*)(c.ws + WS_PB); const float* SM = (const float*)(c.ws + WS_SM);
    bf16* CKVN = (bf16*)(c.ws + WS_CKVN); bf16* KIDX = (bf16*)(c.ws + WS_KIDX); float* RSTDQ = (float*)(c.ws + WS_RSTDQ);
    const float* gkv = c.in[IN_DSA_NKV] + l * 128;
    const float g0 = gkv[2 * c.lane], g1 = gkv[2 * c.lane + 1];
    for (int t = gw; t < T; t += NGW) {
        const bf16* row = PB + (size_t)t * NPB;
        const unsigned kv = *(const unsigned*)(row + PB_CKV + 2 * c.lane);
        const float k0 = bflo(kv), k1 = bfhi(kv);
        const float rs = rsqrtf(wave_sum(k0 * k0 + k1 * k1) * (1.f / 128.f) + EPS);
        *(unsigned*)(CKVN + (size_t)t * 128 + 2 * c.lane) = pk2(k0 * rs * g0, k1 * rs * g1);
        const f32x4 q = ld_bf4(row + PB_CQ + 4 * c.lane);
        const float rq = rsqrtf(wave_sum(q[0] * q[0] + q[1] * q[1] + q[2] * q[2] + q[3] * q[3]) * (1.f / 256.f) + EPS);
        if (c.lane == 0) RSTDQ[t] = rq;
        if (c.lane < 32) KIDX[(size_t)t * 32 + c.lane] = (bf16)f2bf(SM[(size_t)t * 128 + SM_KIDX + c.lane]);
    }
}
__device__ __forceinline__ void phase_ckvt(const Ctx& c) {
    const bf16* CKVN = (const bf16*)(c.ws + WS_CKVN); bf16* CKVT = (bf16*)(c.ws + WS_CKVT);
    LAS bf16* tile = (LAS bf16*)c.lds;
    for (int it = c.bid; it < T / 64; it += c.nblk) {
        const int tb = it * 64, b = tb >> 11, p0 = tb & 2047;
        __syncthreads();
        { const int r = c.tid >> 3, ch = (c.tid & 7) * 8;
          *(LAS u32x4*)(tile + r * 136 + ch) = *(const u32x4*)(CKVN + (size_t)(tb + r) * 128 + ch); *(LAS u32x4*)(tile + r * 136 + 64 + ch) = *(const u32x4*)(CKVN + (size_t)(tb + r) * 128 + 64 + ch); }
        __syncthreads();
        { const int r = c.tid >> 2, part = c.tid & 3;
          unsigned w[8];
#pragma unroll
          for (int j = 0; j < 8; ++j) w[j] = (unsigned)tile[(16 * part + 2 * j) * 136 + r] | ((unsigned)tile[(16 * part + 2 * j + 1) * 136 + r] << 16);
          bf16* dst = CKVT + ((size_t)b * 128 + r) * 2048 + p0 + 16 * part;
          *(u32x4*)dst = (u32x4){w[0], w[1], w[2], w[3]}; *(u32x4*)(dst + 8) = (u32x4){w[4], w[5], w[6], w[7]}; }
    }
    __syncthreads();
}

constexpr int TS = 16;
__device__ __forceinline__ void scan_gla_item(const Ctx& c, int l, int b, int h) {
    LAS float* q_s = (LAS float*)c.lds;
    LAS float* k_s = q_s + TS * 64;
    LAS float* a_s = k_s + TS * 64;
    LAS float* v_s = a_s + TS * 64;
    LAS float* part = v_s + TS * 128;
    LAS float* wa2 = part + TS * 4 * 128;
    LAS float* ba = wa2 + 16 * 64;
    LAS float* alr = ba + 64;
    const bf16* PB = (const bf16*)(c.ws + WS_PB); const float* SM = (const float*)(c.ws + WS_SM);
    bf16* UA = (bf16*)(c.ws + WS_UA);
    const float* gn = c.in[IN_GLA_NORM] + l * 512 + h * 128;
    for (int i = c.tid; i < 16 * 64; i += NTHR) wa2[i] = c.in[IN_GLA_WA2][(size_t)l * 16 * 256 + (i >> 6) * 256 + h * 64 + (i & 63)];
    if (c.tid < 64) ba[c.tid] = c.in[IN_GLA_BA][l * 256 + h * 64 + c.tid];
    const int v = c.tid & 127, kg = c.tid >> 7;
    float S[16];
#pragma unroll
    for (int i = 0; i < 16; ++i) S[i] = 0.f;
    for (int t0 = 0; t0 < SEQ; t0 += TS) {
        __syncthreads();
        const size_t rb = (size_t)b * SEQ + t0;
        for (int i = c.tid; i < TS * 64; i += NTHR) { const int s = i >> 6, cc = i & 63; const bf16* row = PB + (rb + s) * NPB;
            q_s[i] = bf2f(row[PB_QA + h * 64 + cc]) * 0.125f; k_s[i] = bf2f(row[PB_KA + h * 64 + cc]); }
        for (int i = c.tid; i < TS * 128; i += NTHR) { const int s = i >> 7, cc = i & 127; v_s[i] = bf2f(PB[(rb + s) * NPB + PB_VA + h * 128 + cc]); }
        if (c.tid < TS * 16) alr[c.tid] = SM[(rb + (c.tid >> 4)) * 128 + SM_ALR + (c.tid & 15)];
        __syncthreads();
        for (int i = c.tid; i < TS * 64; i += NTHR) { const int s = i >> 6, cc = i & 63; float x = ba[cc];
#pragma unroll
            for (int j = 0; j < 16; ++j) x += alr[s * 16 + j] * wa2[j * 64 + cc];
            a_s[i] = __expf(logsigmoidf_(x) * (1.f / 16.f)); }
        __syncthreads();
#pragma unroll 1
        for (int s = 0; s < TS; ++s) {
            const float vv = v_s[s * 128 + v]; float acc = 0.f;
#pragma unroll
            for (int i4 = 0; i4 < 4; ++i4) {
                const f32x4 a4 = *(const LAS f32x4*)(a_s + s * 64 + kg * 16 + i4 * 4), k4 = *(const LAS f32x4*)(k_s + s * 64 + kg * 16 + i4 * 4), q4 = *(const LAS f32x4*)(q_s + s * 64 + kg * 16 + i4 * 4);
#pragma unroll
                for (int j = 0; j < 4; ++j) { S[i4 * 4 + j] = a4[j] * S[i4 * 4 + j] + k4[j] * vv; acc += q4[j] * S[i4 * 4 + j]; }
            }
            part[(s * 4 + kg) * 128 + v] = acc;
        }
        __syncthreads();
        {
            const int s = c.tid >> 5, vq = c.tid & 31, v0 = vq * 4;
            f32x4 o = (f32x4){0.f, 0.f, 0.f, 0.f};
#pragma unroll
            for (int g = 0; g < 4; ++g) o += *(const LAS f32x4*)(part + (s * 4 + g) * 128 + v0);
            float ss = o[0] * o[0] + o[1] * o[1] + o[2] * o[2] + o[3] * o[3];
#pragma unroll
            for (int m = 1; m < 32; m <<= 1) ss += __shfl_xor(ss, m);
            const float rstd = rsqrtf(ss * (1.f / 128.f) + EPS);
            const f32x4 ga = ld_bf4(PB + (rb + s) * NPB + PB_GA + h * 128 + v0);
            f32x4 r;
#pragma unroll
            for (int j = 0; j < 4; ++j) r[j] = o[j] * rstd * gn[v0 + j] * siluf_(ga[j]);
            st_bf4(UA + (rb + s) * 512 + h * 128 + v0, r);
        }
    }
    __syncthreads();
}
__device__ __forceinline__ void scan_mlstm_item(const Ctx& c, int l, int b, int h) {
    LAS float* q_s = (LAS float*)c.lds;
    LAS float* k_s = q_s + TS * 64;
    LAS float* v_s = k_s + TS * 64;
    LAS float* part = v_s + TS * 128;
    LAS float* dpart = part + TS * 4 * 128;
    LAS float* lf_s = dpart + TS * 4;
    LAS float* ip_s = lf_s + TS;
    LAS float* m_s = ip_s + TS;
    LAS float* cw = m_s + TS;
    const bf16* PB = (const bf16*)(c.ws + WS_PB); const float* SM = (const float*)(c.ws + WS_SM);
    bf16* UC = (bf16*)(c.ws + WS_UC);
    const float* mn = c.in[IN_ML_NORM] + l * 512 + h * 128;
    if (c.tid < 4 * 128) { const int j = c.tid >> 7, cc = c.tid & 127; cw[c.tid] = c.in[IN_ML_CONV][(size_t)l * 4 * 512 + j * 512 + (cc < 64 ? h * 64 + cc : 256 + h * 64 + (cc - 64))]; }
    const float bi = c.in[IN_ML_BI][l * 4 + h], bfv = c.in[IN_ML_BF][l * 4 + h];
    const int v = c.tid & 127, kg = c.tid >> 7;
    float C[16], n[16]; float m = 0.f;
#pragma unroll
    for (int i = 0; i < 16; ++i) { C[i] = 0.f; n[i] = 0.f; }
    for (int t0 = 0; t0 < SEQ; t0 += TS) {
        __syncthreads();
        const size_t rb = (size_t)b * SEQ + t0;
        for (int i = c.tid; i < TS * 128; i += NTHR) { const int s = i >> 7, cc = i & 127;
            const int col = cc < 64 ? PB_QC + h * 64 + cc : PB_KC + h * 64 + (cc - 64);
            float x = 0.f;
#pragma unroll
            for (int j = 0; j < 4; ++j) { const int tt = t0 + s - 3 + j; if (tt >= 0) x += cw[j * 128 + cc] * bf2f(PB[((size_t)b * SEQ + tt) * NPB + col]); }
            x = siluf_(x);
            if (cc < 64) q_s[s * 64 + cc] = x * 0.125f; else k_s[s * 64 + (cc - 64)] = x; }
        for (int i = c.tid; i < TS * 128; i += NTHR) { const int s = i >> 7, cc = i & 127; v_s[i] = bf2f(PB[(rb + s) * NPB + PB_VC + h * 128 + cc]); }
        if (c.tid < TS) { ip_s[c.tid] = SM[(rb + c.tid) * 128 + SM_IC + h] + bi; lf_s[c.tid] = logsigmoidf_(SM[(rb + c.tid) * 128 + SM_FC + h] + bfv); }
        __syncthreads();
#pragma unroll 1
        for (int s = 0; s < TS; ++s) {
            const float lf = lf_s[s], ip = ip_s[s];
            const float mnew = fmaxf(lf + m, ip), fg = __expf(lf + m - mnew), ig = __expf(ip - mnew);
            m = mnew;
            const float vv = v_s[s * 128 + v] * ig; float num = 0.f, den = 0.f;
#pragma unroll
            for (int i4 = 0; i4 < 4; ++i4) {
                const f32x4 k4 = *(const LAS f32x4*)(k_s + s * 64 + kg * 16 + i4 * 4), q4 = *(const LAS f32x4*)(q_s + s * 64 + kg * 16 + i4 * 4);
#pragma unroll
                for (int j = 0; j < 4; ++j) { C[i4 * 4 + j] = fg * C[i4 * 4 + j] + k4[j] * vv; n[i4 * 4 + j] = fg * n[i4 * 4 + j] + ig * k4[j]; num += q4[j] * C[i4 * 4 + j]; den += q4[j] * n[i4 * 4 + j]; }
            }
            part[(s * 4 + kg) * 128 + v] = num;
            if (v == 0) dpart[s * 4 + kg] = den;
            if (c.tid == 0) m_s[s] = m;
        }
        __syncthreads();
        {
            const int s = c.tid >> 5, vq = c.tid & 31, v0 = vq * 4;
            f32x4 o = (f32x4){0.f, 0.f, 0.f, 0.f};
#pragma unroll
            for (int g = 0; g < 4; ++g) o += *(const LAS f32x4*)(part + (s * 4 + g) * 128 + v0);
            const float den = dpart[s * 4] + dpart[s * 4 + 1] + dpart[s * 4 + 2] + dpart[s * 4 + 3];
            const float dd = 1.f / fmaxf(fabsf(den), __expf(-m_s[s]));
            o = o * dd;
            float ss = o[0] * o[0] + o[1] * o[1] + o[2] * o[2] + o[3] * o[3];
#pragma unroll
            for (int mm = 1; mm < 32; mm <<= 1) ss += __shfl_xor(ss, mm);
            const float rstd = rsqrtf(ss * (1.f / 128.f) + EPS);
            const f32x4 oc = ld_bf4(PB + (rb + s) * NPB + PB_OC + h * 128 + v0);
            f32x4 r;
#pragma unroll
            for (int j = 0; j < 4; ++j) r[j] = o[j] * rstd * mn[v0 + j] * sigmoidf_(oc[j]);
            st_bf4(UC + (rb + s) * 512 + h * 128 + v0, r);
        }
    }
    __syncthreads();
}

constexpr int LQ = 72;
constexpr int SC_QT = 0, SC_KT = 9216, SC_KTT = 18432, SC_Q2 = 27648, SC_SC = 36864, SC_VT = 46080, SC_ST = 66816, SC_FL = 108288;
__device__ __forceinline__ float wave_scan_add(float x, int lane) {
#pragma unroll
    for (int d = 1; d < 64; d <<= 1) { const float y = __shfl_up(x, d); if (lane >= d) x += y; }
    return x;
}
__device__ __forceinline__ float wave_scan_max(float x, int lane) {
#pragma unroll
    for (int d = 1; d < 64; d <<= 1) { const float y = __shfl_up(x, d); if (lane >= d) x = fmaxf(x, y); }
    return x;
}
__device__ __forceinline__ void unpack8(u32x4 w, float (&f)[8]) { f[0] = bflo(w.x); f[1] = bfhi(w.x); f[2] = bflo(w.y); f[3] = bfhi(w.y); f[4] = bflo(w.z); f[5] = bfhi(w.z); f[6] = bflo(w.w); f[7] = bfhi(w.w); }
__device__ __forceinline__ u32x4 pack8(const float (&f)[8]) { u32x4 w; w.x = pk2(f[0], f[1]); w.y = pk2(f[2], f[3]); w.z = pk2(f[4], f[5]); w.w = pk2(f[6], f[7]); return w; }
template <bool ML>
__device__ __forceinline__ void scan_chunked_item(const Ctx& c, int l, int b, int h) {
    LAS bf16* Qt0 = (LAS bf16*)(c.lds + SC_QT); LAS bf16* Kt0 = (LAS bf16*)(c.lds + SC_KT); LAS bf16* KtT0 = (LAS bf16*)(c.lds + SC_KTT);
    LAS bf16* Q20 = (LAS bf16*)(c.lds + SC_Q2); LAS bf16* Sc0 = (LAS bf16*)(c.lds + SC_SC); LAS bf16* VT0 = (LAS bf16*)(c.lds + SC_VT);
    LAS bf16* ST0 = (LAS bf16*)(c.lds + SC_ST);
    LAS float* segtot = (LAS float*)(c.lds + SC_FL);
    LAS float* etot = segtot + 512;
    LAS float* ssq = etot + 64;
    LAS float* dn = ssq + 512;
    LAS float* wa2 = dn + 64;
    LAS float* ba = wa2 + 1024;
    LAS float* cw = ba + 64;
    const int tid = c.tid, lane = c.lane, w = c.wave, fr = lane & 15, fq = lane >> 4;
    const int srow = tid >> 3, kg = tid & 7, k8 = kg * 8, vrow = tid >> 4, vc8 = (tid & 15) * 8;
    const bf16* PB = (const bf16*)(c.ws + WS_PB); const float* SM = (const float*)(c.ws + WS_SM);
    bf16* UO = (bf16*)(c.ws + (ML ? WS_UC : WS_UA));
    const int QCOL = (ML ? PB_QC : PB_QA) + h * 64, KCOL = (ML ? PB_KC : PB_KA) + h * 64, VCOL = (ML ? PB_VC : PB_VA) + h * 128, GCOL = (ML ? PB_OC : PB_GA) + h * 128;
    const float* gnorm = c.in[ML ? IN_ML_NORM : IN_GLA_NORM] + l * 512 + h * 128;
    __syncthreads();
    if (!ML) { for (int i = tid; i < 1024; i += NTHR) wa2[i] = c.in[IN_GLA_WA2][(size_t)l * 16 * 256 + (i >> 6) * 256 + h * 64 + (i & 63)];
               if (tid < 64) ba[tid] = c.in[IN_GLA_BA][l * 256 + h * 64 + tid]; }
    else { if (tid < 512) { const int j = tid >> 7, cc = tid & 127; cw[tid] = c.in[IN_ML_CONV][(size_t)l * 4 * 512 + j * 512 + (cc < 64 ? h * 64 + cc : 256 + h * 64 + (cc - 64))]; } }
    for (int i = tid; i < 144 * LQ / 2; i += NTHR) ((LAS unsigned*)ST0)[i] = 0u;
    if (ML) { for (int i = tid; i < 16 * LQ; i += NTHR) VT0[128 * LQ + i] = (i < 64) ? (bf16)0x3f80u : (bf16)0u; }
    const float bi = ML ? c.in[IN_ML_BI][l * 4 + h] : 0.f, bfv = ML ? c.in[IN_ML_BF][l * 4 + h] : 0.f;
    float m_prev = 0.f;
    f32x4 Sacc[4], Nacc = (f32x4){0.f, 0.f, 0.f, 0.f};
#pragma unroll
    for (int i = 0; i < 4; ++i) Sacc[i] = (f32x4){0.f, 0.f, 0.f, 0.f};
    u32x4 rq[ML ? 4 : 1], rk[ML ? 4 : 1], rv[2]; f32x4 ra[4]; float ric = 0.f, rfc = 0.f;
    const u32x4 z4 = (u32x4){0u, 0u, 0u, 0u};
#define SC_LOAD(cch) do { const size_t _g = (size_t)b * SEQ + (size_t)(cch) * 64; \
        if (ML) { _Pragma("unroll") for (int _j = 0; _j < 4; ++_j) { const int _tt = (cch) * 64 + srow - 3 + _j; \
                rq[_j] = _tt >= 0 ? *(const u32x4*)(PB + ((size_t)b * SEQ + _tt) * NPB + QCOL + k8) : z4; rk[_j] = _tt >= 0 ? *(const u32x4*)(PB + ((size_t)b * SEQ + _tt) * NPB + KCOL + k8) : z4; } \
            ric = SM[(_g + lane) * 128 + SM_IC + h]; rfc = SM[(_g + lane) * 128 + SM_FC + h]; } \
        else { rq[0] = *(const u32x4*)(PB + (_g + srow) * NPB + QCOL + k8); rk[0] = *(const u32x4*)(PB + (_g + srow) * NPB + KCOL + k8); \
            _Pragma("unroll") for (int _j = 0; _j < 4; ++_j) ra[_j] = *(const f32x4*)(SM + (_g + srow) * 128 + SM_ALR + 4 * _j); } \
        rv[0] = *(const u32x4*)(PB + (_g + vrow) * NPB + VCOL + vc8); rv[1] = *(const u32x4*)(PB + (_g + 32 + vrow) * NPB + VCOL + vc8); } while (0)
    SC_LOAD(0);
    __syncthreads();
#pragma unroll 1
    for (int cch = 0; cch < SEQ / 64; ++cch) {
        const size_t grow = (size_t)b * SEQ + (size_t)cch * 64;
        int lz; asm volatile("v_mov_b32 %0, 0" : "=v"(lz));
        LAS bf16* Qt = Qt0 + lz; LAS bf16* Kt = Kt0 + lz; LAS bf16* KtT = KtT0 + lz; LAS bf16* Q2 = Q20 + lz; LAS bf16* Sc = Sc0 + lz; LAS bf16* VT = VT0 + lz; LAS bf16* ST = ST0 + lz;
        LAS bf16* STc = ST + (cch & 1) * 144 * LQ; LAS bf16* STn = ST + ((cch & 1) ^ 1) * 144 * LQ;
        float qv[8], kv[8];
        float g_a = 0.f, g_M = 0.f, g_bc = 0.f, M63 = 0.f, wc = 1.f;
        if (!ML) {
            unpack8(rq[0], qv); unpack8(rk[0], kv);
            float la[8];
#pragma unroll
            for (int i = 0; i < 8; ++i) la[i] = ba[k8 + i];
#pragma unroll
            for (int j4 = 0; j4 < 4; ++j4)
#pragma unroll
                for (int jj = 0; jj < 4; ++jj) { const float a = ra[j4][jj]; const LAS float* wr_ = wa2 + (j4 * 4 + jj) * 64 + k8;
                    const f32x4 w0 = *(const LAS f32x4*)wr_, w1 = *(const LAS f32x4*)(wr_ + 4);
                    la[0] += a * w0[0]; la[1] += a * w0[1]; la[2] += a * w0[2]; la[3] += a * w0[3]; la[4] += a * w1[0]; la[5] += a * w1[1]; la[6] += a * w1[2]; la[7] += a * w1[3]; }
#pragma unroll
            for (int i = 0; i < 8; ++i) { float x = logsigmoid_fast(la[i]) * (1.f / 16.f);
#pragma unroll
                for (int d = 8; d < 64; d <<= 1) { const float y = __shfl_up(x, d); if (lane >= d) x += y; }
                la[i] = x; }
            if ((lane >> 3) == 7) { *(LAS f32x4*)(segtot + w * 64 + k8) = (f32x4){la[0], la[1], la[2], la[3]}; *(LAS f32x4*)(segtot + w * 64 + k8 + 4) = (f32x4){la[4], la[5], la[6], la[7]}; }
            lds_barrier();
            float tot[8];
#pragma unroll
            for (int i = 0; i < 8; ++i) tot[i] = 0.f;
#pragma unroll
            for (int ww = 0; ww < 8; ++ww) { const f32x4 s0 = *(const LAS f32x4*)(segtot + ww * 64 + k8), s1 = *(const LAS f32x4*)(segtot + ww * 64 + k8 + 4);
                const float sel = ww < w ? 1.f : 0.f;
                la[0] += sel * s0[0]; la[1] += sel * s0[1]; la[2] += sel * s0[2]; la[3] += sel * s0[3]; la[4] += sel * s1[0]; la[5] += sel * s1[1]; la[6] += sel * s1[2]; la[7] += sel * s1[3];
                tot[0] += s0[0]; tot[1] += s0[1]; tot[2] += s0[2]; tot[3] += s0[3]; tot[4] += s1[0]; tot[5] += s1[1]; tot[6] += s1[2]; tot[7] += s1[3]; }
            if (tid < 8) {
#pragma unroll
                for (int i = 0; i < 8; ++i) etot[k8 + i] = __expf(tot[i]); }
            float kt[8];
#pragma unroll
            for (int i = 0; i < 8; ++i) { qv[i] = qv[i] * 0.125f * __expf(la[i]); kt[i] = kv[i] * __expf(-la[i]); }
            *(LAS u32x4*)(Qt + srow * LQ + k8) = pack8(qv); *(LAS u32x4*)(Kt + srow * LQ + k8) = pack8(kt);
#pragma unroll
            for (int i = 0; i < 8; ++i) KtT[(k8 + i) * LQ + srow] = (bf16)f2bf(kt[i]);
        } else {
            float x4[4][8];
#pragma unroll
            for (int j = 0; j < 4; ++j) unpack8(rq[j], x4[j]);
#pragma unroll
            for (int i = 0; i < 8; ++i) { float x = 0.f;
#pragma unroll
                for (int j = 0; j < 4; ++j) x += cw[j * 128 + k8 + i] * x4[j][i];
                qv[i] = siluf_(x) * 0.125f; }
#pragma unroll
            for (int j = 0; j < 4; ++j) unpack8(rk[j], x4[j]);
#pragma unroll
            for (int i = 0; i < 8; ++i) { float x = 0.f;
#pragma unroll
                for (int j = 0; j < 4; ++j) x += cw[j * 128 + 64 + k8 + i] * x4[j][i];
                kv[i] = siluf_(x); }
            const float lf = logsigmoid_fast(rfc + bfv), ip = ric + bi;
            g_bc = wave_scan_add(lf, lane); g_a = ip - g_bc;
            const float pm = wave_scan_max(g_a, lane); g_M = fmaxf(m_prev, pm);
            M63 = __shfl(g_M, 63); const float totb = __shfl(g_bc, 63);
            wc = __expf(m_prev - M63);
            const float Ms = __shfl(g_M, srow), as = __shfl(g_a, srow);
            const float e1 = __expf(m_prev - Ms), e2 = __expf(as - M63);
            float q2[8], kw[8];
#pragma unroll
            for (int i = 0; i < 8; ++i) { q2[i] = qv[i] * e1; kw[i] = kv[i] * e2; }
            *(LAS u32x4*)(Qt + srow * LQ + k8) = pack8(qv); *(LAS u32x4*)(Kt + srow * LQ + k8) = pack8(kv); *(LAS u32x4*)(Q2 + srow * LQ + k8) = pack8(q2);
#pragma unroll
            for (int i = 0; i < 8; ++i) KtT[(k8 + i) * LQ + srow] = (bf16)f2bf(kw[i]);
            m_prev = totb + M63;
        }
        { float v0[8], v1[8]; unpack8(rv[0], v0); unpack8(rv[1], v1);
#pragma unroll
          for (int i = 0; i < 8; ++i) { VT[(vc8 + i) * LQ + vrow] = (bf16)f2bf(v0[i]); VT[(vc8 + i) * LQ + 32 + vrow] = (bf16)f2bf(v1[i]); } }
        u32x2 gate[4];
#pragma unroll
        for (int ti = 0; ti < 4; ++ti) gate[ti] = *(const u32x2*)(PB + (grow + 16 * ti + fr) * NPB + GCOL + 16 * w + 4 * fq);
        if (cch + 1 < SEQ / 64) SC_LOAD(cch + 1);
        lds_barrier();
        {
            const int ti = w >> 1;
#pragma unroll
            for (int u = 0; u < 2; ++u) {
                const int sj = 2 * (w & 1) + u;
                f32x4 d = (f32x4){0.f, 0.f, 0.f, 0.f};
                if (sj <= ti) {
#pragma unroll
                    for (int ks = 0; ks < 2; ++ks) { const bf16x8 a = *(const LAS bf16x8*)(Kt + (16 * sj + fr) * LQ + 32 * ks + 8 * fq), bb = *(const LAS bf16x8*)(Qt + (16 * ti + fr) * LQ + 32 * ks + 8 * fq);
                        d = __builtin_amdgcn_mfma_f32_16x16x32_bf16(a, bb, d, 0, 0, 0); }
                    const int t = 16 * ti + fr, s0 = 16 * sj + 4 * fq;
                    if (ML) { const float Mt = __shfl(g_M, t);
#pragma unroll
                        for (int r = 0; r < 4; ++r) { const float as = __shfl(g_a, s0 + r); d[r] = (s0 + r <= t) ? d[r] * __expf(as - Mt) : 0.f; } }
                    else {
#pragma unroll
                        for (int r = 0; r < 4; ++r) d[r] = (s0 + r <= t) ? d[r] : 0.f; }
                }
                { u32x2 pk; pk.x = pk2(d[0], d[1]); pk.y = pk2(d[2], d[3]); *(LAS u32x2*)(Sc + (16 * ti + fr) * LQ + 16 * sj + 4 * fq) = pk; }
            }
        }
        lds_barrier();
        const LAS bf16* Qm = ML ? Q2 : Qt;
        f32x4 o[4];
        {
            bf16x8 vt[2], stf[2];
#pragma unroll
            for (int ks = 0; ks < 2; ++ks) { vt[ks] = *(const LAS bf16x8*)(VT + (16 * w + fr) * LQ + 32 * ks + 8 * fq); stf[ks] = *(const LAS bf16x8*)(STc + (16 * w + fr) * LQ + 32 * ks + 8 * fq); }
#pragma unroll
            for (int ti = 0; ti < 4; ++ti) {
                f32x4 d = (f32x4){0.f, 0.f, 0.f, 0.f};
#pragma unroll
                for (int ks = 0; ks < 2; ++ks) { const bf16x8 sc = *(const LAS bf16x8*)(Sc + (16 * ti + fr) * LQ + 32 * ks + 8 * fq); d = __builtin_amdgcn_mfma_f32_16x16x32_bf16(vt[ks], sc, d, 0, 0, 0); }
#pragma unroll
                for (int ks = 0; ks < 2; ++ks) { const bf16x8 qq = *(const LAS bf16x8*)(Qm + (16 * ti + fr) * LQ + 32 * ks + 8 * fq); d = __builtin_amdgcn_mfma_f32_16x16x32_bf16(stf[ks], qq, d, 0, 0, 0); }
                o[ti] = d;
            }
#pragma unroll
            for (int kj = 0; kj < 4; ++kj) {
                f32x4 d = (f32x4){0.f, 0.f, 0.f, 0.f};
#pragma unroll
                for (int ks = 0; ks < 2; ++ks) { const bf16x8 kk = *(const LAS bf16x8*)(KtT + (16 * kj + fr) * LQ + 32 * ks + 8 * fq); d = __builtin_amdgcn_mfma_f32_16x16x32_bf16(kk, vt[ks], d, 0, 0, 0); }
                if (ML) Sacc[kj] = Sacc[kj] * wc + d;
                else { const f32x4 e4 = *(const LAS f32x4*)(etot + 16 * kj + 4 * fq); Sacc[kj] = e4 * (Sacc[kj] + d); }
                u32x2 pk; pk.x = pk2(Sacc[kj][0], Sacc[kj][1]); pk.y = pk2(Sacc[kj][2], Sacc[kj][3]);
                *(LAS u32x2*)(STn + (16 * w + fr) * LQ + 16 * kj + 4 * fq) = pk;
            }
            if (ML) {
                if (w < 4) {
                    f32x4 d = (f32x4){0.f, 0.f, 0.f, 0.f};
#pragma unroll
                    for (int ks = 0; ks < 2; ++ks) { const bf16x8 a = *(const LAS bf16x8*)(VT + (128 + fr) * LQ + 32 * ks + 8 * fq), sc = *(const LAS bf16x8*)(Sc + (16 * w + fr) * LQ + 32 * ks + 8 * fq);
                        d = __builtin_amdgcn_mfma_f32_16x16x32_bf16(a, sc, d, 0, 0, 0); }
#pragma unroll
                    for (int ks = 0; ks < 2; ++ks) { const bf16x8 a = *(const LAS bf16x8*)(STc + (128 + fr) * LQ + 32 * ks + 8 * fq), qq = *(const LAS bf16x8*)(Qm + (16 * w + fr) * LQ + 32 * ks + 8 * fq);
                        d = __builtin_amdgcn_mfma_f32_16x16x32_bf16(a, qq, d, 0, 0, 0); }
                    if (fq == 0) dn[16 * w + fr] = d[0];
                } else {
                    const int kj = w - 4;
                    f32x4 d = (f32x4){0.f, 0.f, 0.f, 0.f};
#pragma unroll
                    for (int ks = 0; ks < 2; ++ks) { const bf16x8 kk = *(const LAS bf16x8*)(KtT + (16 * kj + fr) * LQ + 32 * ks + 8 * fq), a = *(const LAS bf16x8*)(VT + (128 + fr) * LQ + 32 * ks + 8 * fq);
                        d = __builtin_amdgcn_mfma_f32_16x16x32_bf16(kk, a, d, 0, 0, 0); }
                    Nacc = Nacc * wc + d;
                    u32x2 pk; pk.x = pk2(Nacc[0], Nacc[1]); pk.y = pk2(Nacc[2], Nacc[3]);
                    *(LAS u32x2*)(STn + (128 + fr) * LQ + 16 * kj + 4 * fq) = pk;
                }
            }
        }
#pragma unroll
        for (int ti = 0; ti < 4; ++ti) { float p = o[ti][0] * o[ti][0] + o[ti][1] * o[ti][1] + o[ti][2] * o[ti][2] + o[ti][3] * o[ti][3];
            p += __shfl_xor(p, 16); p += __shfl_xor(p, 32);
            if (fq == 0) ssq[w * 64 + 16 * ti + fr] = p; }
        lds_barrier();
#pragma unroll
        for (int ti = 0; ti < 4; ++ti) {
            const int t = 16 * ti + fr;
            float ss = 0.f;
#pragma unroll
            for (int ww = 0; ww < 8; ++ww) ss += ssq[ww * 64 + t];
            float dd = 1.f;
            if (ML) { const float bc = __shfl(g_bc, t), Mt = __shfl(g_M, t); dd = 1.f / fmaxf(fabsf(dn[t]), __expf(-(bc + Mt))); }
            const float rstd = rsqrtf(ss * dd * dd * (1.f / 128.f) + EPS) * dd;
            const f32x4 gn = *(const f32x4*)(gnorm + 16 * w + 4 * fq);
            const float g0 = bflo(gate[ti].x), g1 = bfhi(gate[ti].x), g2 = bflo(gate[ti].y), g3 = bfhi(gate[ti].y);
            f32x4 r;
            if (ML) { r[0] = o[ti][0] * rstd * gn[0] * sigmoidf_(g0); r[1] = o[ti][1] * rstd * gn[1] * sigmoidf_(g1); r[2] = o[ti][2] * rstd * gn[2] * sigmoidf_(g2); r[3] = o[ti][3] * rstd * gn[3] * sigmoidf_(g3); }
            else { r[0] = o[ti][0] * rstd * gn[0] * siluf_(g0); r[1] = o[ti][1] * rstd * gn[1] * siluf_(g1); r[2] = o[ti][2] * rstd * gn[2] * siluf_(g2); r[3] = o[ti][3] * rstd * gn[3] * siluf_(g3); }
            st_bf4(UO + (grow + t) * 512 + h * 128 + 16 * w + 4 * fq, r);
        }
    }
#undef SC_LOAD
    __syncthreads();
}

template <bool ML>
__device__ __forceinline__ void scanA_loop(const Ctx& c, int l, int it0, int it_end, int stride) {
    LAS bf16* Qt0 = (LAS bf16*)(c.lds + SC_QT); LAS bf16* Kt0 = (LAS bf16*)(c.lds + SC_KT); LAS bf16* KtT0 = (LAS bf16*)(c.lds + SC_KTT);
    LAS bf16* Sc0 = (LAS bf16*)(c.lds + SC_SC); LAS bf16* VT0 = (LAS bf16*)(c.lds + SC_VT);
    LAS float* segtot = (LAS float*)(c.lds + SC_FL);
    LAS float* wa2 = segtot + 512 + 64 + 512 + 64;
    LAS float* ba = wa2 + 1024;
    LAS float* cw = ba + 64;
    const int tid = c.tid, lane = c.lane, w = c.wave, fr = lane & 15, fq = lane >> 4;
    const int srow = tid >> 3, kg = tid & 7, k8 = kg * 8, vrow = tid >> 4, vc8 = (tid & 15) * 8;
    const bf16* PB = (const bf16*)(c.ws + WS_PB); const float* SM = (const float*)(c.ws + WS_SM);
    bf16* UO = (bf16*)(c.ws + (ML ? WS_UC : WS_UA));
    bf16* QS = (bf16*)(c.ws + WS_QS) + (ML ? (size_t)T * 256 : 0);
    u32x4 rq[ML ? 4 : 1], rk[ML ? 4 : 1], rv[2]; f32x4 ra[4]; float ric = 0.f, rfc = 0.f;
    const u32x4 z4 = (u32x4){0u, 0u, 0u, 0u};
#define SA_LOAD(it_) do { const int _rem = (it_) & 2047, _seq = _rem >> 5, _cch = _rem & 31, _b = _seq >> 2, _h = _seq & 3; \
        const size_t _g = (size_t)_b * SEQ + (size_t)_cch * 64; \
        const int _qc = (ML ? PB_QC : PB_QA) + _h * 64, _kc = (ML ? PB_KC : PB_KA) + _h * 64, _vc = (ML ? PB_VC : PB_VA) + _h * 128; \
        if (ML) { _Pragma("unroll") for (int _j = 0; _j < 4; ++_j) { const int _tt = _cch * 64 + srow - 3 + _j; \
                rq[_j] = _tt >= 0 ? *(const u32x4*)(PB + ((size_t)_b * SEQ + _tt) * NPB + _qc + k8) : z4; rk[_j] = _tt >= 0 ? *(const u32x4*)(PB + ((size_t)_b * SEQ + _tt) * NPB + _kc + k8) : z4; } \
            ric = SM[(_g + lane) * 128 + SM_IC + _h]; rfc = SM[(_g + lane) * 128 + SM_FC + _h]; } \
        else { rq[0] = *(const u32x4*)(PB + (_g + srow) * NPB + _qc + k8); rk[0] = *(const u32x4*)(PB + (_g + srow) * NPB + _kc + k8); \
            _Pragma("unroll") for (int _j = 0; _j < 4; ++_j) ra[_j] = *(const f32x4*)(SM + (_g + srow) * 128 + SM_ALR + 4 * _j); } \
        rv[0] = *(const u32x4*)(PB + (_g + vrow) * NPB + _vc + vc8); rv[1] = *(const u32x4*)(PB + (_g + 32 + vrow) * NPB + _vc + vc8); } while (0)
    if (it0 < it_end) SA_LOAD(it0);
    int hprev = -1;
#pragma unroll 1
    for (int it = it0; it < it_end; it += stride) {
    const int rem_ = it & 2047, seq_ = rem_ >> 5, cch = rem_ & 31, b = seq_ >> 2, h = seq_ & 3;
    const int slot = (b * 4 + h) * 32 + cch;
    bf16* DS = ML ? (bf16*)(c.ws + WS_DSM) + (size_t)slot * 144 * 64 : (bf16*)(c.ws + WS_DSG) + (size_t)slot * 128 * 64;
    const size_t grow = (size_t)b * SEQ + (size_t)cch * 64;
    int lz; asm volatile("v_mov_b32 %0, 0" : "=v"(lz));
    LAS bf16* Qt = Qt0 + lz; LAS bf16* Kt = Kt0 + lz; LAS bf16* KtT = KtT0 + lz; LAS bf16* Sc = Sc0 + lz; LAS bf16* VT = VT0 + lz;
    __syncthreads();
    if (h != hprev) {
        if (!ML) { for (int i = tid; i < 1024; i += NTHR) wa2[i] = c.in[IN_GLA_WA2][(size_t)l * 16 * 256 + (i >> 6) * 256 + h * 64 + (i & 63)];
                   if (tid < 64) ba[tid] = c.in[IN_GLA_BA][l * 256 + h * 64 + tid]; }
        else { { const int j = tid >> 7, cc = tid & 127; cw[tid] = c.in[IN_ML_CONV][(size_t)l * 4 * 512 + j * 512 + (cc < 64 ? h * 64 + cc : 256 + h * 64 + (cc - 64))]; }
               for (int i = tid; i < 16 * LQ; i += NTHR) VT[128 * LQ + i] = (i < 64) ? (bf16)0x3f80u : (bf16)0u; }
        hprev = h;
        __syncthreads();
    }
    const float bi = ML ? c.in[IN_ML_BI][l * 4 + h] : 0.f, bfv = ML ? c.in[IN_ML_BF][l * 4 + h] : 0.f;
    float qv[8], kv[8];
    float g_a = 0.f, g_pm = 0.f;
    if (!ML) {
        unpack8(rq[0], qv); unpack8(rk[0], kv);
        float la[8];
#pragma unroll
        for (int i = 0; i < 8; ++i) la[i] = ba[k8 + i];
#pragma unroll
        for (int j4 = 0; j4 < 4; ++j4)
#pragma unroll
            for (int jj = 0; jj < 4; ++jj) { const float a = ra[j4][jj]; const LAS float* wr_ = wa2 + (j4 * 4 + jj) * 64 + k8;
                const f32x4 w0 = *(const LAS f32x4*)wr_, w1 = *(const LAS f32x4*)(wr_ + 4);
                la[0] += a * w0[0]; la[1] += a * w0[1]; la[2] += a * w0[2]; la[3] += a * w0[3]; la[4] += a * w1[0]; la[5] += a * w1[1]; la[6] += a * w1[2]; la[7] += a * w1[3]; }
#pragma unroll
        for (int i = 0; i < 8; ++i) { float x = logsigmoid_fast(la[i]) * (1.f / 16.f);
#pragma unroll
            for (int d = 8; d < 64; d <<= 1) { const float y = __shfl_up(x, d); if (lane >= d) x += y; }
            la[i] = x; }
        if ((lane >> 3) == 7) { *(LAS f32x4*)(segtot + w * 64 + k8) = (f32x4){la[0], la[1], la[2], la[3]}; *(LAS f32x4*)(segtot + w * 64 + k8 + 4) = (f32x4){la[4], la[5], la[6], la[7]}; }
        lds_barrier();
        float tot[8];
#pragma unroll
        for (int i = 0; i < 8; ++i) tot[i] = 0.f;
#pragma unroll
        for (int ww = 0; ww < 8; ++ww) { const f32x4 s0 = *(const LAS f32x4*)(segtot + ww * 64 + k8), s1 = *(const LAS f32x4*)(segtot + ww * 64 + k8 + 4);
            const float sel = ww < w ? 1.f : 0.f;
            la[0] += sel * s0[0]; la[1] += sel * s0[1]; la[2] += sel * s0[2]; la[3] += sel * s0[3]; la[4] += sel * s1[0]; la[5] += sel * s1[1]; la[6] += sel * s1[2]; la[7] += sel * s1[3];
            tot[0] += s0[0]; tot[1] += s0[1]; tot[2] += s0[2]; tot[3] += s0[3]; tot[4] += s1[0]; tot[5] += s1[1]; tot[6] += s1[2]; tot[7] += s1[3]; }
        if (tid < 8) { float* et = (float*)(c.ws + WS_ET) + (size_t)slot * 64 + k8;
            *(f32x4*)et = (f32x4){__expf(tot[0]), __expf(tot[1]), __expf(tot[2]), __expf(tot[3])}; *(f32x4*)(et + 4) = (f32x4){__expf(tot[4]), __expf(tot[5]), __expf(tot[6]), __expf(tot[7])}; }
        float kt[8];
#pragma unroll
        for (int i = 0; i < 8; ++i) { qv[i] = qv[i] * 0.125f * __expf(la[i]); kt[i] = kv[i] * __expf(-la[i]); }
        const u32x4 qp = pack8(qv);
        *(LAS u32x4*)(Qt + srow * LQ + k8) = qp; *(LAS u32x4*)(Kt + srow * LQ + k8) = pack8(kt);
        *(u32x4*)(QS + (grow + srow) * 256 + h * 64 + k8) = qp;
#pragma unroll
        for (int i = 0; i < 8; ++i) KtT[(k8 + i) * LQ + srow] = (bf16)f2bf(kt[i]);
    } else {
        float x4[4][8];
#pragma unroll
        for (int j = 0; j < 4; ++j) unpack8(rq[j], x4[j]);
#pragma unroll
        for (int i = 0; i < 8; ++i) { float x = 0.f;
#pragma unroll
            for (int j = 0; j < 4; ++j) x += cw[j * 128 + k8 + i] * x4[j][i];
            qv[i] = siluf_(x) * 0.125f; }
#pragma unroll
        for (int j = 0; j < 4; ++j) unpack8(rk[j], x4[j]);
#pragma unroll
        for (int i = 0; i < 8; ++i) { float x = 0.f;
#pragma unroll
            for (int j = 0; j < 4; ++j) x += cw[j * 128 + 64 + k8 + i] * x4[j][i];
            kv[i] = siluf_(x); }
        const float lf = logsigmoid_fast(rfc + bfv), ip = ric + bi;
        const float g_bc = wave_scan_add(lf, lane); g_a = ip - g_bc;
        g_pm = wave_scan_max(g_a, lane);
        const float pm63 = __shfl(g_pm, 63), totb = __shfl(g_bc, 63);
        if (w == 0) { ((float*)(c.ws + WS_GPM))[(grow + lane) * 4 + h] = g_pm; ((float*)(c.ws + WS_GBC))[(grow + lane) * 4 + h] = g_bc;
            if (lane == 0) { float* ct = (float*)(c.ws + WS_CT) + (size_t)slot * 2; ct[0] = totb; ct[1] = pm63; } }
        const float as = __shfl(g_a, srow);
        const float e2 = __expf(as - pm63);
        float kw[8];
#pragma unroll
        for (int i = 0; i < 8; ++i) kw[i] = kv[i] * e2;
        const u32x4 qp = pack8(qv);
        *(LAS u32x4*)(Qt + srow * LQ + k8) = qp; *(LAS u32x4*)(Kt + srow * LQ + k8) = pack8(kv);
        *(u32x4*)(QS + (grow + srow) * 256 + h * 64 + k8) = qp;
#pragma unroll
        for (int i = 0; i < 8; ++i) KtT[(k8 + i) * LQ + srow] = (bf16)f2bf(kw[i]);
    }
    { float v0[8], v1[8]; unpack8(rv[0], v0); unpack8(rv[1], v1);
#pragma unroll
      for (int i = 0; i < 8; ++i) { VT[(vc8 + i) * LQ + vrow] = (bf16)f2bf(v0[i]); VT[(vc8 + i) * LQ + 32 + vrow] = (bf16)f2bf(v1[i]); } }
    if (it + stride < it_end) SA_LOAD(it + stride);
    lds_barrier();
    {
        const int ti = w >> 1;
#pragma unroll
        for (int u = 0; u < 2; ++u) {
            const int sj = 2 * (w & 1) + u;
            f32x4 d = (f32x4){0.f, 0.f, 0.f, 0.f};
            if (sj <= ti) {
#pragma unroll
                for (int ks = 0; ks < 2; ++ks) { const bf16x8 a = *(const LAS bf16x8*)(Kt + (16 * sj + fr) * LQ + 32 * ks + 8 * fq), bb = *(const LAS bf16x8*)(Qt + (16 * ti + fr) * LQ + 32 * ks + 8 * fq);
                    d = __builtin_amdgcn_mfma_f32_16x16x32_bf16(a, bb, d, 0, 0, 0); }
                const int t = 16 * ti + fr, s0 = 16 * sj + 4 * fq;
                if (ML) { const float pt = __shfl(g_pm, t);
#pragma unroll
                    for (int r = 0; r < 4; ++r) { const float as = __shfl(g_a, s0 + r); d[r] = (s0 + r <= t) ? d[r] * __expf(as - pt) : 0.f; } }
                else {
#pragma unroll
                    for (int r = 0; r < 4; ++r) d[r] = (s0 + r <= t) ? d[r] : 0.f; }
            }
            { u32x2 pk; pk.x = pk2(d[0], d[1]); pk.y = pk2(d[2], d[3]); *(LAS u32x2*)(Sc + (16 * ti + fr) * LQ + 16 * sj + 4 * fq) = pk; }
        }
    }
    lds_barrier();
    {
        bf16x8 vt[2];
#pragma unroll
        for (int ks = 0; ks < 2; ++ks) vt[ks] = *(const LAS bf16x8*)(VT + (16 * w + fr) * LQ + 32 * ks + 8 * fq);
#pragma unroll
        for (int ti = 0; ti < 4; ++ti) {
            f32x4 d = (f32x4){0.f, 0.f, 0.f, 0.f};
#pragma unroll
            for (int ks = 0; ks < 2; ++ks) { const bf16x8 sc = *(const LAS bf16x8*)(Sc + (16 * ti + fr) * LQ + 32 * ks + 8 * fq); d = __builtin_amdgcn_mfma_f32_16x16x32_bf16(vt[ks], sc, d, 0, 0, 0); }
            st_bf4(UO + (grow + 16 * ti + fr) * 512 + h * 128 + 16 * w + 4 * fq, d);
        }
#pragma unroll
        for (int kj = 0; kj < 4; ++kj) {
            f32x4 d = (f32x4){0.f, 0.f, 0.f, 0.f};
#pragma unroll
            for (int ks = 0; ks < 2; ++ks) { const bf16x8 kk = *(const LAS bf16x8*)(KtT + (16 * kj + fr) * LQ + 32 * ks + 8 * fq); d = __builtin_amdgcn_mfma_f32_16x16x32_bf16(kk, vt[ks], d, 0, 0, 0); }
            st_bf4(DS + (16 * w + fr) * 64 + 16 * kj + 4 * fq, d);
        }
        if (ML) {
            if (w < 4) {
                f32x4 d = (f32x4){0.f, 0.f, 0.f, 0.f};
#pragma unroll
                for (int ks = 0; ks < 2; ++ks) { const bf16x8 a = *(const LAS bf16x8*)(VT + (128 + fr) * LQ + 32 * ks + 8 * fq), sc = *(const LAS bf16x8*)(Sc + (16 * w + fr) * LQ + 32 * ks + 8 * fq);
                    d = __builtin_amdgcn_mfma_f32_16x16x32_bf16(a, sc, d, 0, 0, 0); }
                if (fq == 0) ((float*)(c.ws + WS_DN))[(grow + 16 * w + fr) * 4 + h] = d[0];
            } else {
                const int kj = w - 4;
                f32x4 d = (f32x4){0.f, 0.f, 0.f, 0.f};
#pragma unroll
                for (int ks = 0; ks < 2; ++ks) { const bf16x8 kk = *(const LAS bf16x8*)(KtT + (16 * kj + fr) * LQ + 32 * ks + 8 * fq), a = *(const LAS bf16x8*)(VT + (128 + fr) * LQ + 32 * ks + 8 * fq);
                    d = __builtin_amdgcn_mfma_f32_16x16x32_bf16(kk, a, d, 0, 0, 0); }
                st_bf4(DS + (128 + fr) * 64 + 16 * kj + 4 * fq, d);
            }
        }
    }
    }
#undef SA_LOAD
}
__device__ __forceinline__ void scanB(const Ctx& c) {
    const int gt = c.bid * NTHR + c.tid, NGT = c.nblk * NTHR;
    constexpr int NG = 64 * 128 * 8, NM = 64 * 144 * 8;
    for (int idx = gt; idx < NG + NM; idx += NGT) {
        float S[8];
#pragma unroll
        for (int i = 0; i < 8; ++i) S[i] = 0.f;
        if (idx < NG) {
            const int seq = idx >> 10, v = (idx >> 3) & 127, kg = idx & 7;
            bf16* p = (bf16*)(c.ws + WS_DSG) + (size_t)seq * 32 * 8192 + v * 64 + kg * 8;
            const float* et = (const float*)(c.ws + WS_ET) + (size_t)seq * 32 * 64 + kg * 8;
#pragma unroll 1
            for (int c4 = 0; c4 < 32; c4 += 4) {
                u32x4 dv[4]; f32x4 e0[4], e1[4];
#pragma unroll
                for (int j = 0; j < 4; ++j) { dv[j] = *(const u32x4*)(p + (size_t)(c4 + j) * 8192); e0[j] = *(const f32x4*)(et + (c4 + j) * 64); e1[j] = *(const f32x4*)(et + (c4 + j) * 64 + 4); }
#pragma unroll
                for (int j = 0; j < 4; ++j) {
                    float d[8]; unpack8(dv[j], d);
                    const u32x4 sp = pack8(S);
                    S[0] = e0[j][0] * (S[0] + d[0]); S[1] = e0[j][1] * (S[1] + d[1]); S[2] = e0[j][2] * (S[2] + d[2]); S[3] = e0[j][3] * (S[3] + d[3]);
                    S[4] = e1[j][0] * (S[4] + d[4]); S[5] = e1[j][1] * (S[5] + d[5]); S[6] = e1[j][2] * (S[6] + d[6]); S[7] = e1[j][3] * (S[7] + d[7]);
                    *(u32x4*)(p + (size_t)(c4 + j) * 8192) = sp;
                }
            }
        } else {
            const int j0 = idx - NG, seq = j0 / 1152, rem = j0 % 1152, v = rem >> 3, kg = rem & 7;
            bf16* p = (bf16*)(c.ws + WS_DSM) + (size_t)seq * 32 * 9216 + v * 64 + kg * 8;
            const float* ct = (const float*)(c.ws + WS_CT) + (size_t)seq * 32 * 2;
            float* mp = (float*)(c.ws + WS_MP) + (size_t)seq * 32;
            float m = 0.f;
#pragma unroll 1
            for (int c4 = 0; c4 < 32; c4 += 4) {
                u32x4 dv[4]; f32x2 cc[4];
#pragma unroll
                for (int j = 0; j < 4; ++j) { dv[j] = *(const u32x4*)(p + (size_t)(c4 + j) * 9216); cc[j] = *(const f32x2*)(ct + (c4 + j) * 2); }
#pragma unroll
                for (int j = 0; j < 4; ++j) {
                    float d[8]; unpack8(dv[j], d);
                    const float M63 = fmaxf(m, cc[j][1]), wc = __expf(m - M63), ws = __expf(cc[j][1] - M63);
                    const u32x4 sp = pack8(S);
                    if (rem == 0) mp[c4 + j] = m;
#pragma unroll
                    for (int i = 0; i < 8; ++i) S[i] = wc * S[i] + ws * d[i];
                    m = cc[j][0] + M63;
                    *(u32x4*)(p + (size_t)(c4 + j) * 9216) = sp;
                }
            }
        }
    }
}
template <bool ML>
__device__ __forceinline__ void scanC_wave(const Ctx& c, int l, int b, int h, int cch, int ti) {
    const int lane = c.lane, fr = lane & 15, fq = lane >> 4;
    const bf16* PB = (const bf16*)(c.ws + WS_PB);
    bf16* UO = (bf16*)(c.ws + (ML ? WS_UC : WS_UA));
    const bf16* QS = (const bf16*)(c.ws + WS_QS) + (ML ? (size_t)T * 256 : 0);
    const int slot = (b * 4 + h) * 32 + cch;
    const bf16* SP = ML ? (const bf16*)(c.ws + WS_DSM) + (size_t)slot * 144 * 64 : (const bf16*)(c.ws + WS_DSG) + (size_t)slot * 128 * 64;
    const int GCOL = (ML ? PB_OC : PB_GA) + h * 128;
    const float* gnorm = c.in[ML ? IN_ML_NORM : IN_GLA_NORM] + l * 512 + h * 128;
    const size_t trow = (size_t)b * SEQ + (size_t)cch * 64 + 16 * ti + fr;
    bf16x8 qf[2], sf[8][2], nf[2];
#pragma unroll
    for (int ks = 0; ks < 2; ++ks) qf[ks] = *(const bf16x8*)(QS + trow * 256 + h * 64 + 32 * ks + 8 * fq);
#pragma unroll
    for (int n = 0; n < 8; ++n)
#pragma unroll
        for (int ks = 0; ks < 2; ++ks) sf[n][ks] = *(const bf16x8*)(SP + (16 * n + fr) * 64 + 32 * ks + 8 * fq);
    if (ML) {
#pragma unroll
        for (int ks = 0; ks < 2; ++ks) nf[ks] = *(const bf16x8*)(SP + (128 + fr) * 64 + 32 * ks + 8 * fq); }
    u32x2 gate[8], oi[8];
#pragma unroll
    for (int n = 0; n < 8; ++n) { gate[n] = *(const u32x2*)(PB + trow * NPB + GCOL + 16 * n + 4 * fq); oi[n] = *(const u32x2*)(UO + trow * 512 + h * 128 + 16 * n + 4 * fq); }
    float e_in = 1.f, e_st = 1.f, dd = 1.f;
    if (ML) {
        const float pm = ((const float*)(c.ws + WS_GPM))[trow * 4 + h], bc = ((const float*)(c.ws + WS_GBC))[trow * 4 + h], m_prev = ((const float*)(c.ws + WS_MP))[slot], dni = ((const float*)(c.ws + WS_DN))[trow * 4 + h];
        const float Mt = fmaxf(m_prev, pm); e_in = __expf(pm - Mt); e_st = __expf(m_prev - Mt);
        f32x4 d = (f32x4){0.f, 0.f, 0.f, 0.f};
#pragma unroll
        for (int ks = 0; ks < 2; ++ks) d = __builtin_amdgcn_mfma_f32_16x16x32_bf16(nf[ks], qf[ks], d, 0, 0, 0);
        const float dst = __shfl(d[0], fr);
        const float den = dni * e_in + dst * e_st;
        dd = 1.f / fmaxf(fabsf(den), __expf(-(bc + Mt)));
    }
    f32x4 o[8]; float ss = 0.f;
#pragma unroll
    for (int n = 0; n < 8; ++n) {
        f32x4 d = (f32x4){0.f, 0.f, 0.f, 0.f};
#pragma unroll
        for (int ks = 0; ks < 2; ++ks) d = __builtin_amdgcn_mfma_f32_16x16x32_bf16(sf[n][ks], qf[ks], d, 0, 0, 0);
        const f32x4 oiv = (f32x4){bflo(oi[n].x), bfhi(oi[n].x), bflo(oi[n].y), bfhi(oi[n].y)};
        o[n] = ML ? oiv * e_in + d * e_st : oiv + d;
        ss += o[n][0] * o[n][0] + o[n][1] * o[n][1] + o[n][2] * o[n][2] + o[n][3] * o[n][3];
    }
    ss += __shfl_xor(ss, 16); ss += __shfl_xor(ss, 32);
    const float rstd = rsqrtf(ss * dd * dd * (1.f / 128.f) + EPS) * dd;
#pragma unroll
    for (int n = 0; n < 8; ++n) {
        const f32x4 gn = *(const f32x4*)(gnorm + 16 * n + 4 * fq);
        const float g0 = bflo(gate[n].x), g1 = bfhi(gate[n].x), g2 = bflo(gate[n].y), g3 = bfhi(gate[n].y);
        f32x4 r;
        if (ML) { r[0] = o[n][0] * rstd * gn[0] * sigmoidf_(g0); r[1] = o[n][1] * rstd * gn[1] * sigmoidf_(g1); r[2] = o[n][2] * rstd * gn[2] * sigmoidf_(g2); r[3] = o[n][3] * rstd * gn[3] * sigmoidf_(g3); }
        else { r[0] = o[n][0] * rstd * gn[0] * siluf_(g0); r[1] = o[n][1] * rstd * gn[1] * siluf_(g1); r[2] = o[n][2] * rstd * gn[2] * siluf_(g2); r[3] = o[n][3] * rstd * gn[3] * siluf_(g3); }
        st_bf4(UO + trow * 512 + h * 128 + 16 * n + 4 * fq, r);
    }
}
__device__ __forceinline__ void phase_scanA(const Ctx& c, int l) {
    const int nG = c.bid < 2048 ? (2048 - c.bid + c.nblk - 1) / c.nblk : 0;
    const int firstM = c.bid + nG * c.nblk;
    scanA_loop<false>(c, l, c.bid, 2048, c.nblk);
    scanA_loop<true>(c, l, firstM, 4096, c.nblk);
    __syncthreads();
}
__device__ __forceinline__ void phase_scanC(const Ctx& c, int l) {
    const int gw = c.bid * NWAVES + c.wave, NGW = c.nblk * NWAVES;
#pragma unroll 1
    for (int it = gw; it < 16384; it += NGW) { const int br = it >> 13, rem = it & 8191, seq = rem >> 7, cch = (rem >> 2) & 31, ti = rem & 3;
        if (br == 0) scanC_wave<false>(c, l, seq >> 2, seq & 3, cch, ti); else scanC_wave<true>(c, l, seq >> 2, seq & 3, cch, ti); }
}
__device__ __forceinline__ void phase_scans(const Ctx& c, int l) {
    for (int it = c.bid; it < 128; it += c.nblk) {
#if SCAN_RECURRENT
        if (it < 64) scan_gla_item(c, l, it >> 2, it & 3);
        else scan_mlstm_item(c, l, (it - 64) >> 2, (it - 64) & 3);
#else
        if (it < 64) scan_chunked_item<false>(c, l, it >> 2, it & 3);
        else scan_chunked_item<true>(c, l, (it - 64) >> 2, (it - 64) & 3);
#endif
    }
}

__device__ __forceinline__ unsigned ord_key(float f) { const unsigned u = __builtin_bit_cast(unsigned, f); return (u & 0x80000000u) ? ~u : (u | 0x80000000u); }
__device__ __forceinline__ void phase_dsa(const Ctx& c, int l) {
    LAS unsigned char* wl = c.lds + c.wave * 14336;
    LAS float* I_s = (LAS float*)wl;
    LAS int* list = (LAS int*)(wl + 8192);
    LAS float* qi_s = (LAS float*)(wl + 9216);
    LAS float* ql_s = (LAS float*)(wl + 10240);
    const bf16* QLAT = (const bf16*)(c.ws + WS_QLAT); const bf16* QIDX = (const bf16*)(c.ws + WS_QIDX);
    const bf16* CKVN = (const bf16*)(c.ws + WS_CKVN); const float* SM = (const float*)(c.ws + WS_SM);
    bf16* OLAT = (bf16*)(c.ws + WS_OLAT);
    const int gw = c.bid * NWAVES + c.wave, NGW = c.nblk * NWAVES, lane = c.lane;
    for (int tq = gw; tq < T; tq += NGW) {
        const int b = tq >> 11, pos = tq & 2047, nvalid = pos + 1;
        const size_t kb = (size_t)b * SEQ;
        { const f32x4 q = ld_bf4(QIDX + (size_t)tq * 256 + 4 * lane); *(LAS f32x4*)(qi_s + 4 * lane) = q;
#pragma unroll
          for (int j = 0; j < 4; ++j) { const f32x4 ql = ld_bf4(QLAT + (size_t)tq * 1024 + 4 * (lane + 64 * j)); *(LAS f32x4*)(ql_s + 4 * (lane + 64 * j)) = ql; } }
        float wh[8];
#pragma unroll
        for (int hh = 0; hh < 8; ++hh) wh[hh] = SM[(size_t)tq * 128 + SM_WIDX + hh] * 0.35355339059327373f;
        asm volatile("s_waitcnt lgkmcnt(0)" ::: "memory");
        int nsel;
        if (nvalid <= DSA_K) {
            for (int i = lane; i < DSA_K; i += 64) list[i] = i;
            nsel = nvalid;
        } else {
            const int nj = (nvalid + 63) >> 6;
            for (int j = 0; j < nj; ++j) {
                const int s = lane + 64 * j;
                float val = -INFINITY;
                if (s < nvalid) {
                    const float* kr = SM + (kb + s) * 128 + SM_KIDX;
                    f32x4 kk[8];
#pragma unroll
                    for (int i = 0; i < 8; ++i) kk[i] = *(const f32x4*)(kr + 4 * i);
                    val = 0.f;
#pragma unroll
                    for (int hh = 0; hh < 8; ++hh) { float d = 0.f;
#pragma unroll
                        for (int i = 0; i < 8; ++i) { const f32x4 q = *(const LAS f32x4*)(qi_s + hh * 32 + 4 * i); d += q[0] * kk[i][0] + q[1] * kk[i][1] + q[2] * kk[i][2] + q[3] * kk[i][3]; }
                        val += wh[hh] * fmaxf(d, 0.f); }
                }
                I_s[s] = val;
            }
            for (int j = nj; j < 32; ++j) I_s[lane + 64 * j] = -INFINITY;
            asm volatile("s_waitcnt lgkmcnt(0)" ::: "memory");
            LAS unsigned* K_s = (LAS unsigned*)I_s;
#pragma unroll 4
            for (int j = 0; j < 32; ++j) K_s[lane + 64 * j] = ord_key(I_s[lane + 64 * j]);
            unsigned thr = 0u;
#pragma unroll 1
            for (int bit = 31; bit >= 0; --bit) {
                const unsigned cand = thr | (1u << bit); int cnt = 0;
#pragma unroll 8
                for (int j = 0; j < 32; ++j) cnt += (K_s[lane + 64 * j] >= cand) ? 1 : 0;
                cnt = wave_sum_i(cnt);
                if (cnt >= DSA_K) thr = cand;
            }
            int cgt = 0;
#pragma unroll 8
            for (int j = 0; j < 32; ++j) cgt += (K_s[lane + 64 * j] > thr) ? 1 : 0;
            cgt = wave_sum_i(cgt);
            int need = DSA_K - cgt, base = 0;
            const unsigned long long lt = (1ull << lane) - 1ull;
#pragma unroll 2
            for (int j = 0; j < 32; ++j) {
                const unsigned kj = K_s[lane + 64 * j];
                const bool gt = kj > thr, eq = kj == thr;
                const unsigned long long meq = __ballot(eq);
                const int rk = __popcll(meq & lt);
                const bool sel = gt || (eq && rk < need);
                need -= __popcll(meq); if (need < 0) need = 0;
                const unsigned long long ms = __ballot(sel);
                if (sel) list[base + __popcll(ms & lt)] = lane + 64 * j;
                base += __popcll(ms);
            }
            nsel = DSA_K;
        }
        asm volatile("s_waitcnt lgkmcnt(0)" ::: "memory");
        int ks[4]; float lg[4][8];
#pragma unroll
        for (int i = 0; i < 4; ++i) { const int li = lane + 64 * i; ks[i] = (li < nsel) ? list[li] : 0;
#pragma unroll
            for (int hh = 0; hh < 8; ++hh) lg[i][hh] = 0.f; }
#pragma unroll 1
        for (int ch = 0; ch < 16; ++ch) {
            f32x4 ka[4], kc[4];
#pragma unroll
            for (int i = 0; i < 4; ++i) { const u32x4 w = *(const u32x4*)(CKVN + (kb + ks[i]) * 128 + ch * 8);
                ka[i] = (f32x4){bflo(w.x), bfhi(w.x), bflo(w.y), bfhi(w.y)}; kc[i] = (f32x4){bflo(w.z), bfhi(w.z), bflo(w.w), bfhi(w.w)}; }
#pragma unroll
            for (int hh = 0; hh < 8; ++hh) { const f32x4 qa = *(const LAS f32x4*)(ql_s + hh * 128 + ch * 8), qb = *(const LAS f32x4*)(ql_s + hh * 128 + ch * 8 + 4);
#pragma unroll
                for (int i = 0; i < 4; ++i) lg[i][hh] += qa[0] * ka[i][0] + qa[1] * ka[i][1] + qa[2] * ka[i][2] + qa[3] * ka[i][3] + qb[0] * kc[i][0] + qb[1] * kc[i][1] + qb[2] * kc[i][2] + qb[3] * kc[i][3]; }
        }
#pragma unroll
        for (int hh = 0; hh < 8; ++hh) {
            const float slope = exp2f(-(float)(hh + 1));
            float mx = -INFINITY;
#pragma unroll
            for (int i = 0; i < 4; ++i) { const bool ok = (lane + 64 * i) < nsel; lg[i][hh] = ok ? lg[i][hh] - slope * (float)(pos - ks[i]) : -INFINITY; mx = fmaxf(mx, lg[i][hh]); }
            mx = wave_max(mx);
            float sm = 0.f;
#pragma unroll
            for (int i = 0; i < 4; ++i) { lg[i][hh] = __expf(lg[i][hh] - mx); sm += lg[i][hh]; }
            sm = wave_sum(sm);
            const float inv = 1.f / sm;
#pragma unroll
            for (int i = 0; i < 4; ++i) lg[i][hh] *= inv;
        }
#pragma unroll
        for (int i = 0; i < 4; ++i) { const int li = lane + 64 * i;
            *(LAS f32x4*)(I_s + li * 8) = (f32x4){lg[i][0], lg[i][1], lg[i][2], lg[i][3]}; *(LAS f32x4*)(I_s + li * 8 + 4) = (f32x4){lg[i][4], lg[i][5], lg[i][6], lg[i][7]}; }
        asm volatile("s_waitcnt lgkmcnt(0)" ::: "memory");
        float o0[8], o1[8];
#pragma unroll
        for (int hh = 0; hh < 8; ++hh) { o0[hh] = 0.f; o1[hh] = 0.f; }
#pragma unroll 2
        for (int kidx = 0; kidx < nsel; ++kidx) {
            const int s = list[kidx];
            const unsigned w = *(const unsigned*)(CKVN + (kb + s) * 128 + 2 * lane);
            const float v0 = bflo(w), v1 = bfhi(w);
            const f32x4 pa = *(const LAS f32x4*)(I_s + kidx * 8), pb = *(const LAS f32x4*)(I_s + kidx * 8 + 4);
            o0[0] += pa[0] * v0; o1[0] += pa[0] * v1; o0[1] += pa[1] * v0; o1[1] += pa[1] * v1; o0[2] += pa[2] * v0; o1[2] += pa[2] * v1; o0[3] += pa[3] * v0; o1[3] += pa[3] * v1;
            o0[4] += pb[0] * v0; o1[4] += pb[0] * v1; o0[5] += pb[1] * v0; o1[5] += pb[1] * v1; o0[6] += pb[2] * v0; o1[6] += pb[2] * v1; o0[7] += pb[3] * v0; o1[7] += pb[3] * v1;
        }
#pragma unroll
        for (int hh = 0; hh < 8; ++hh) *(unsigned*)(OLAT + (size_t)tq * 1024 + hh * 128 + 2 * lane) = pk2(o0[hh], o1[hh]);
        asm volatile("s_waitcnt lgkmcnt(0)" ::: "memory");
    }
}


typedef float f32x16 __attribute__((ext_vector_type(16)));
__device__ __forceinline__ void phase_dsa_sel(const Ctx& c, int l) {
    const bf16* QIDX = (const bf16*)(c.ws + WS_QIDX); const bf16* KIDX = (const bf16*)(c.ws + WS_KIDX); const float* SM = (const float*)(c.ws + WS_SM);
    unsigned* MASK = (unsigned*)(c.ws + WS_MASK);
    const int lane = c.lane, hf = lane >> 5, l31 = lane & 31;
    const int rho = l31, tl = 2 * ((rho >> 2) & 1) + (rho >> 4), hd = (rho & 3) + 4 * ((rho >> 3) & 1);
    const unsigned ltmask = (1u << l31) - 1u;
    LAS unsigned* KL = (LAS unsigned*)(c.lds + c.wave * 16384);
    LAS unsigned* MW = (LAS unsigned*)(c.lds + 131072 + c.wave * 512);
    const int npass = (c.nblk == 256) ? 2 : (T / 64 + c.nblk - 1) / c.nblk;
#pragma unroll 1
    for (int ps = 0; ps < npass; ++ps) {
        int b, q64;
        if (c.nblk == 256) { b = c.bid & 15; q64 = ps == 0 ? 31 - (c.bid >> 4) : (c.bid >> 4); }
        else { const int it = c.bid + ps * c.nblk; if (it >= T / 64) break; b = it >> 5; q64 = it & 31; }
        const int pb = q64 * 64;
#pragma unroll 1
        for (int wi = 0; wi < 2; ++wi) {
        const int pos0 = pb + 8 * c.wave + 4 * wi, t0 = b * SEQ + pos0;
        unsigned wA0 = 0u, wB0 = 0u, wA1 = 0u, wB1 = 0u;
        if (pos0 + 3 < DSA_K) {
            const int p_0 = pos0 + 2 * hf, p_1 = p_0 + 1;
            { const int lo = 32 * l31; wA0 = p_0 >= lo + 31 ? 0xffffffffu : (p_0 < lo ? 0u : ((2u << (p_0 - lo)) - 1u)); wA1 = p_1 >= lo + 31 ? 0xffffffffu : (p_1 < lo ? 0u : ((2u << (p_1 - lo)) - 1u)); }
        } else {
            const int ng = ((pos0 + 3) / 32 + 4) / 4, nkt = 4 * ng;
            bf16x8 af[2];
#pragma unroll
            for (int ks = 0; ks < 2; ++ks) af[ks] = *(const bf16x8*)(QIDX + (size_t)(t0 + tl) * 256 + hd * 32 + 16 * ks + 8 * hf);
            const bf16* kbase = KIDX + ((size_t)b * SEQ + l31) * 32 + 8 * hf;
#pragma unroll 1
            for (int tsel = 0; tsel < 2; ++tsel) {
                float whv[8];
#pragma unroll
                for (int r = 0; r < 8; ++r) whv[r] = SM[(size_t)(t0 + 2 * hf + tsel) * 128 + SM_WIDX + r] * 0.35355339059327373f;
                const int p_t = pos0 + 2 * hf + tsel;
                bf16x8 bq[4][2], bn[4][2];
#pragma unroll
                for (int j = 0; j < 4; ++j) { bq[j][0] = *(const bf16x8*)(kbase + (size_t)(32 * j) * 32); bq[j][1] = *(const bf16x8*)(kbase + (size_t)(32 * j) * 32 + 16); }
#pragma unroll 1
                for (int g = 0; g < ng; ++g) {
                    const int gn = (g + 1 < ng) ? g + 1 : g;
#pragma unroll
                    for (int j = 0; j < 4; ++j) { bn[j][0] = *(const bf16x8*)(kbase + (size_t)(32 * (4 * gn + j)) * 32); bn[j][1] = *(const bf16x8*)(kbase + (size_t)(32 * (4 * gn + j)) * 32 + 16); }
#pragma unroll
                    for (int j = 0; j < 4; ++j) {
                        f32x16 d;
#pragma unroll
                        for (int r = 0; r < 16; ++r) d[r] = 0.f;
                        d = __builtin_amdgcn_mfma_f32_32x32x16_bf16(af[0], bq[j][0], d, 0, 0, 0);
                        d = __builtin_amdgcn_mfma_f32_32x32x16_bf16(af[1], bq[j][1], d, 0, 0, 0);
                        float iv = 0.f;
                        if (tsel == 0) {
#pragma unroll
                            for (int r = 0; r < 8; ++r) iv += whv[r] * fmaxf(d[r], 0.f);
                        } else {
#pragma unroll
                            for (int r = 0; r < 8; ++r) iv += whv[r] * fmaxf(d[8 + r], 0.f);
                        }
                        const int kt = 4 * g + j, row = 32 * kt + l31;
                        KL[kt * 64 + lane] = row <= p_t ? ord_key(iv) : 0u;
                    }
#pragma unroll
                    for (int j = 0; j < 4; ++j) { bq[j][0] = bn[j][0]; bq[j][1] = bn[j][1]; }
                }
                unsigned thr = 0u; bool dlo = false, dhi = false;
#pragma unroll 1
                for (int bit = 31; bit >= 0 && !(dlo && dhi); --bit) {
                    const unsigned cand = thr | (1u << bit); int clo = 0, chi = 0;
#pragma unroll 16
                    for (int kt = 0; kt < nkt; ++kt) { const unsigned long long m = __ballot(KL[kt * 64 + lane] >= cand); clo += __popc((unsigned)m); chi += __popc((unsigned)(m >> 32)); }
                    const bool tlo = !dlo && clo >= DSA_K, thi = !dhi && chi >= DSA_K;
                    if (hf ? thi : tlo) thr = cand;
                    dlo = dlo || clo == DSA_K; dhi = dhi || chi == DSA_K;
                }
                int glo = 0, ghi = 0;
#pragma unroll 16
                for (int kt = 0; kt < nkt; ++kt) { const unsigned long long m = __ballot(KL[kt * 64 + lane] > thr); glo += __popc((unsigned)m); ghi += __popc((unsigned)(m >> 32)); }
                int nlo = DSA_K - glo, nhi = DSA_K - ghi;
                MW[lane] = 0u; MW[64 + lane] = 0u;
#pragma unroll 2
                for (int kt = 0; kt < nkt; ++kt) {
                    const unsigned kv = KL[kt * 64 + lane];
                    const bool gt = kv > thr, eq = kv == thr;
                    const unsigned long long meq = __ballot(eq); const unsigned mh = hf ? (unsigned)(meq >> 32) : (unsigned)meq;
                    const int need = hf ? nhi : nlo;
                    const bool sel = gt || (eq && (__popc(mh & ltmask) < need));
                    nlo -= __popc((unsigned)meq); nhi -= __popc((unsigned)(meq >> 32)); nlo = nlo < 0 ? 0 : nlo; nhi = nhi < 0 ? 0 : nhi;
                    const unsigned long long ms = __ballot(sel);
                    if (l31 == 0) MW[hf * 64 + kt] = hf ? (unsigned)(ms >> 32) : (unsigned)ms;
                }
                const unsigned wA = MW[hf * 64 + l31], wB = MW[hf * 64 + 32 + l31];
                if (tsel == 0) { wA0 = wA; wB0 = wB; } else { wA1 = wA; wB1 = wB; }
            }
        }
        unsigned* m0 = MASK + (size_t)(t0 + 2 * hf) * 64;
        m0[l31] = wA0; m0[32 + l31] = wB0; m0[64 + l31] = wA1; m0[96 + l31] = wB1;
        }
    }
    __syncthreads();
}

constexpr int AT_KN_LD = 136, AT_KT_LD = 72;
constexpr int AT_KN_BYTES = 64 * AT_KN_LD * 2, AT_KT_BYTES = 128 * AT_KT_LD * 2, AT_STAGE = AT_KN_BYTES + AT_KT_BYTES;
__device__ __forceinline__ void phase_dsa_att(const Ctx& c, int l) {
    const bf16* QLAT = (const bf16*)(c.ws + WS_QLAT); const bf16* CKVN = (const bf16*)(c.ws + WS_CKVN); const bf16* CKVT = (const bf16*)(c.ws + WS_CKVT);
    const unsigned* MASK = (const unsigned*)(c.ws + WS_MASK); bf16* OLAT = (bf16*)(c.ws + WS_OLAT);
    const int tid = c.tid, lane = c.lane, h = c.wave, fr = lane & 15, fq = lane >> 4;
    const float slope2 = exp2f(-(float)(h + 1)) * 1.4426950408889634f;
    const int knr = tid >> 3, knc = (tid & 7) * 8;
    const int ktr = tid >> 2, ktc = (tid & 3) * 16;
#pragma unroll 1
    for (int k4 = 0; k4 < 1024; ++k4) {
        const int idx = c.bid + c.nblk * k4; if (idx >= 1024) break;
        const int b = idx & 15, g = idx >> 4, gk = g >> 4, gi = g & 15;
        const int qt = 63 - 16 * gk - ((gk & 1) ? (15 - gi) : gi);
        const int tq0 = qt * 32;
        const size_t tg0 = (size_t)b * SEQ + tq0;
        const int nkt = (tq0 + 31) / 64 + 1;
        bf16x8 Qf[2][4];
#pragma unroll
        for (int rt = 0; rt < 2; ++rt)
#pragma unroll
            for (int ks = 0; ks < 4; ++ks) Qf[rt][ks] = *(const bf16x8*)(QLAT + (tg0 + 16 * rt + fr) * 1024 + h * 128 + 32 * ks + 8 * fq);
        f32x4 O[2][8];
        float mrun[2], lrun[2];
#pragma unroll
        for (int rt = 0; rt < 2; ++rt) { mrun[rt] = -1e30f; lrun[rt] = 0.f;
#pragma unroll
            for (int n = 0; n < 8; ++n) O[rt][n] = (f32x4){0.f, 0.f, 0.f, 0.f}; }
        u32x4 pn0, pn1, pt0, pt1; u32x2 mwn[2];
#define AT_LOAD(kt) do { const size_t _kb = (size_t)b * SEQ + 64 * (kt); \
            pn0 = *(const u32x4*)(CKVN + (_kb + knr) * 128 + knc); pn1 = *(const u32x4*)(CKVN + (_kb + knr) * 128 + 64 + knc); \
            pt0 = *(const u32x4*)(CKVT + ((size_t)b * 128 + ktr) * 2048 + 64 * (kt) + ktc); pt1 = *(const u32x4*)(CKVT + ((size_t)b * 128 + ktr) * 2048 + 64 * (kt) + ktc + 8); } while (0)
        AT_LOAD(0);
#pragma unroll
        for (int rt = 0; rt < 2; ++rt) mwn[rt] = *(const u32x2*)(MASK + (tg0 + 16 * rt + fr) * 64);
#pragma unroll 1
        for (int kt = 0; kt < nkt; ++kt) {
            int lz; asm volatile("v_mov_b32 %0, 0" : "=v"(lz));
            LAS bf16* Kn = (LAS bf16*)(c.lds + (kt & 1) * AT_STAGE) + lz; LAS bf16* KT = (LAS bf16*)(c.lds + (kt & 1) * AT_STAGE + AT_KN_BYTES) + lz;
            *(LAS u32x4*)(Kn + knr * AT_KN_LD + knc) = pn0; *(LAS u32x4*)(Kn + knr * AT_KN_LD + 64 + knc) = pn1;
            *(LAS u32x4*)(KT + ktr * AT_KT_LD + ktc) = pt0; *(LAS u32x4*)(KT + ktr * AT_KT_LD + ktc + 8) = pt1;
            u32x2 mw[2]; mw[0] = mwn[0]; mw[1] = mwn[1];
            if (kt + 1 < nkt) { AT_LOAD(kt + 1);
#pragma unroll
                for (int rt = 0; rt < 2; ++rt) mwn[rt] = *(const u32x2*)(MASK + (tg0 + 16 * rt + fr) * 64 + 2 * (kt + 1)); }
            lds_barrier();
            float kbias[4][4];
#pragma unroll
            for (int j = 0; j < 4; ++j)
#pragma unroll
                for (int r = 0; r < 4; ++r) kbias[j][r] = slope2 * (float)(64 * kt + 16 * j + 4 * fq + r);
#pragma unroll
            for (int rt = 0; rt < 2; ++rt) {
                f32x4 S[4];
#pragma unroll
                for (int j = 0; j < 4; ++j) {
                    f32x4 d = (f32x4){0.f, 0.f, 0.f, 0.f};
#pragma unroll
                    for (int ks = 0; ks < 4; ++ks) { const bf16x8 kf = *(const LAS bf16x8*)(Kn + (16 * j + fr) * AT_KN_LD + 32 * ks + 8 * fq); d = __builtin_amdgcn_mfma_f32_16x16x32_bf16(kf, Qf[rt][ks], d, 0, 0, 0); }
                    S[j] = d;
                    __builtin_amdgcn_sched_barrier(0);
                }
                float mx = -1e30f;
#pragma unroll
                for (int j = 0; j < 4; ++j) { const unsigned wsel = ((j < 2) ? mw[rt].x : mw[rt].y) >> (4 * fq);
#pragma unroll
                    for (int r = 0; r < 4; ++r) { const bool on = wsel & (1u << (16 * (j & 1) + r));
                        const float v = S[j][r] + kbias[j][r];
                        S[j][r] = on ? v : -INFINITY; mx = fmaxf(mx, S[j][r]); } }
                mx = fmaxf(mx, __shfl_xor(mx, 16)); mx = fmaxf(mx, __shfl_xor(mx, 32));
                const float mnew = fmaxf(mrun[rt], mx);
                const float alpha = __builtin_amdgcn_exp2f(mrun[rt] - mnew);
                float rs = 0.f;
#pragma unroll
                for (int j = 0; j < 4; ++j)
#pragma unroll
                    for (int r = 0; r < 4; ++r) { const float p = __builtin_amdgcn_exp2f(S[j][r] - mnew); S[j][r] = p; rs += p; }
                rs += __shfl_xor(rs, 16); rs += __shfl_xor(rs, 32);
                lrun[rt] = lrun[rt] * alpha + rs; mrun[rt] = mnew;
#pragma unroll
                for (int n = 0; n < 8; ++n) O[rt][n] *= alpha;
                bf16x8 Pf[2];
#pragma unroll
                for (int ks2 = 0; ks2 < 2; ++ks2) { u32x4 w; w.x = pk2(S[2 * ks2][0], S[2 * ks2][1]); w.y = pk2(S[2 * ks2][2], S[2 * ks2][3]);
                    w.z = pk2(S[2 * ks2 + 1][0], S[2 * ks2 + 1][1]); w.w = pk2(S[2 * ks2 + 1][2], S[2 * ks2 + 1][3]);
                    Pf[ks2] = __builtin_bit_cast(bf16x8, w); }
#pragma unroll
                for (int n = 0; n < 8; ++n)
#pragma unroll
                    for (int ks2 = 0; ks2 < 2; ++ks2) {
                        const u32x2 a0 = *(const LAS u32x2*)(KT + (16 * n + fr) * AT_KT_LD + 32 * ks2 + 4 * fq), a1 = *(const LAS u32x2*)(KT + (16 * n + fr) * AT_KT_LD + 32 * ks2 + 16 + 4 * fq);
                        const bf16x8 af = __builtin_bit_cast(bf16x8, (u32x4){a0.x, a0.y, a1.x, a1.y});
                        O[rt][n] = __builtin_amdgcn_mfma_f32_16x16x32_bf16(af, Pf[ks2], O[rt][n], 0, 0, 0);
                        if (ks2 == 1 && (n & 1)) __builtin_amdgcn_sched_barrier(0);
                    }
            }
        }
#undef AT_LOAD
#pragma unroll
        for (int rt = 0; rt < 2; ++rt) { const float inv = 1.f / lrun[rt];
#pragma unroll
            for (int n = 0; n < 8; ++n) st_bf4(OLAT + (tg0 + 16 * rt + fr) * 1024 + h * 128 + 16 * n + 4 * fq, O[rt][n] * inv); }
        __syncthreads();
    }
}

__device__ __forceinline__ void expert_convert(const Ctx& c, int l, int gw, int NGW) {

        LAS float* scr = (LAS float*)(c.lds + c.wave * 16384);
        constexpr int I_GU = (512 / 32) * (1024 / 64), I_D = (1024 / 32) * (256 / 64), PER_E = I_GU + I_D;
        for (int it = gw; it < NEX * PER_E; it += NGW) {
            const int e = it / PER_E; int r = it % PER_E;
            if (r < I_GU) {
                const int n0 = (r / 16) * 32, pn = n0 >> 8, wi = n0 & 255, j0 = 128 * pn + (wi & 127);
                const float* Wg; const float* Wu;
                if (e < NE) { Wg = c.in[IN_EWG] + ((size_t)l * NE + e) * 1024 * 256; Wu = c.in[IN_EWU] + ((size_t)l * NE + e) * 1024 * 256; }
                else { Wg = c.in[IN_SWG] + (size_t)l * 1024 * 256; Wu = c.in[IN_SWU] + (size_t)l * 1024 * 256; }
                if (wi < 128) { SrcPlain s{Wg + j0 - n0, 256}; tr_item(s, (bf16*)(c.ws + WS_WGU) + (size_t)e * 512 * 1024, 1024, n0, (r % 16) * 64, scr, c.lane); }
                else { SrcPlain s{Wu + j0 - n0, 256}; tr_item(s, (bf16*)(c.ws + WS_WGU) + (size_t)e * 512 * 1024, 1024, n0, (r % 16) * 64, scr, c.lane); }
            } else { r -= I_GU;
                SrcPlain s; s.ld = 1024; s.W = e < NE ? c.in[IN_EWD] + ((size_t)l * NE + e) * 256 * 1024 : c.in[IN_SWD] + (size_t)l * 256 * 1024;
                tr_item(s, (bf16*)(c.ws + WS_WD) + (size_t)e * 1024 * 256, 256, (r / 4) * 32, (r % 4) * 64, scr, c.lane);
            }
        }
    }
__device__ __forceinline__ void route_one(int t, float logit, float rbias, int lane, unsigned* CNT, int* ROWL, float* WL, unsigned* TOKPOS) {
    const float score = sigmoidf_(logit), sel = score + rbias;
    const int g = lane >> 3;
    int rk8 = 0;
#pragma unroll
    for (int d = 1; d < 8; ++d) { const int ol = (lane & ~7) | ((lane + d) & 7); const float o = __shfl(sel, ol); rk8 += (o > sel || (o == sel && ol < lane)) ? 1 : 0; }
    float t2 = rk8 < 2 ? sel : 0.f;
    t2 += __shfl_xor(t2, 1); t2 += __shfl_xor(t2, 2); t2 += __shfl_xor(t2, 4);
    int rkg = 0;
#pragma unroll
    for (int d = 1; d < 8; ++d) { const int og = (g + d) & 7; const float o = __shfl(t2, og * 8); rkg += (o > t2 || (o == t2 && og < g)) ? 1 : 0; }
    const bool gsel = rkg < 4;
    bool chosen = false; float cur = gsel ? sel : -INFINITY;
#pragma unroll 1
    for (int it6 = 0; it6 < TOPK; ++it6) {
        const float mx = wave_max(cur);
        const unsigned long long me = __ballot(cur == mx);
        const int win = __ffsll((long long)me) - 1;
        if (lane == win) { chosen = true; cur = -INFINITY; }
    }
    const float wsum = wave_sum(chosen ? score : 0.f);
    const unsigned long long mk = __ballot(chosen);
    if (chosen) {
        const int hf = t >= HALF_T ? 1 : 0;
        const int kk = __popcll(mk & ((1ull << lane) - 1ull));
        const unsigned slot = atomicAdd(&CNT[hf * 64 + lane], 1u);
        ROWL[((size_t)hf * 64 + lane) * 16384 + slot] = t;
        WL[((size_t)hf * 64 + lane) * 16384 + slot] = score / wsum * 2.5f;
        if (kk < TOPK) TOKPOS[(size_t)t * 6 + kk] = ((unsigned)lane << 16) | slot;
    }
}
__device__ __forceinline__ void phase_route(const Ctx& c, int l, const float* x1) {
    expert_convert(c, l, c.bid * NWAVES + c.wave, c.nblk * NWAVES);
    __syncthreads();
    {
        LAS float* H = (LAS float*)c.lds;
        const int lane = c.lane, w = c.wave;
        const float* MOD = (const float*)(c.ws + WS_MOD) + (size_t)l * 16 * 6144;
        bf16* XN2 = (bf16*)(c.ws + WS_XN2);
        const float* RW = c.in[IN_RW] + (size_t)l * 1024 * 64; const float rbias = c.in[IN_RB][l * 64 + lane];
        unsigned* CNT = (unsigned*)(c.ws + WS_CTL) + CW_CNT + l * 128;
        int* ROWL = (int*)(c.ws + WS_ROWL); float* WL = (float*)(c.ws + WS_WL); unsigned* TOKPOS = (unsigned*)(c.ws + WS_TOKPOS);
        const float* gain = c.in[IN_NFFN] + l * D;
        for (int it = c.bid; it < T / 32; it += c.nblk) {
            const int t0 = it * 32, b = t0 >> 11;
            const float* sh = MOD + (size_t)b * 6144 + 3072; const float* sc = MOD + (size_t)b * 6144 + 4096;
            __syncthreads();
#pragma unroll
            for (int r = 0; r < 4; ++r) {
                const int rr = 4 * w + r;
                const float* xrow = x1 + (size_t)(t0 + rr) * D;
                f32x4 v[4]; float ssum = 0.f;
#pragma unroll
                for (int j = 0; j < 4; ++j) { v[j] = *(const f32x4*)(xrow + 4 * (lane + 64 * j)); ssum += v[j][0] * v[j][0] + v[j][1] * v[j][1] + v[j][2] * v[j][2] + v[j][3] * v[j][3]; }
                const float rstd = rsqrtf(wave_sum(ssum) * (1.f / D) + EPS);
#pragma unroll
                for (int j = 0; j < 4; ++j) { const int cc = 4 * (lane + 64 * j);
                    const f32x4 g = *(const f32x4*)(gain + cc), a4 = *(const f32x4*)(sc + cc), bb = *(const f32x4*)(sh + cc);
                    const f32x4 hv = v[j] * rstd * g * (a4 + 1.f) + bb;
                    st_bf4(XN2 + (size_t)(t0 + rr) * D + cc, hv); *(LAS f32x4*)(H + rr * 1024 + cc) = hv; }
            }
            __syncthreads();
            float acc[32];
#pragma unroll
            for (int r = 0; r < 32; ++r) acc[r] = 0.f;
            const float* rwp = RW + (size_t)(128 * w) * 64 + lane;
#pragma unroll 2
            for (int k = 0; k < 128; k += 4) {
                const float w0 = rwp[(size_t)k * 64], w1 = rwp[(size_t)(k + 1) * 64], w2 = rwp[(size_t)(k + 2) * 64], w3 = rwp[(size_t)(k + 3) * 64];
#pragma unroll
                for (int r = 0; r < 32; ++r) { const f32x4 hv = *(const LAS f32x4*)(H + r * 1024 + 128 * w + k); acc[r] += hv[0] * w0 + hv[1] * w1 + hv[2] * w2 + hv[3] * w3; }
            }
            __syncthreads();
#pragma unroll
            for (int r = 0; r < 32; ++r) H[(w * 32 + r) * 64 + lane] = acc[r];
            __syncthreads();
#pragma unroll 1
            for (int r = 0; r < 4; ++r) {
                const int rr = 4 * w + r; float lg = 0.f;
#pragma unroll
                for (int ww = 0; ww < 8; ++ww) lg += H[(ww * 32 + rr) * 64 + lane];
                route_one(t0 + rr, lg, rbias, lane, CNT, ROWL, WL, TOKPOS);
            }
        }
        __syncthreads();
    }
}

__device__ __forceinline__ void moe_tables(const Ctx& c, int l, int hf) {
    LAS int* cnt = (LAS int*)(c.lds + 140000); LAS int* off = cnt + 65; LAS int* tst = off + 65;
    __syncthreads();
    if (c.tid == 0) {
        const unsigned* CNT = (const unsigned*)(c.ws + WS_CTL) + CW_CNT + l * 128 + hf * 64;
        int o = 0, ts = 0;
        for (int e = 0; e < NEX; ++e) { const int n = e < NE ? (int)CNT[e] : HALF_T; cnt[e] = n; off[e] = o; tst[e] = ts; o += (n + 255) & ~255; ts += (n + 255) >> 8; }
        tst[NEX] = ts;
    }
    __syncthreads();
}
struct MoeSched1 { LAS const int* cnt; LAS const int* off; LAS const int* tst; int G, c; const char* XN2; const char* WGU; const int* ROWL; const float* WL; const int* IDENT;
    __device__ __forceinline__ bool next(int i, g8::GUnit& u) const {
        const int L = i * G + c; if (L >= 2 * tst[NEX]) return false;
        const int rt = L >> 1, pn = L & 1; int e = 0; while (tst[e + 1] <= rt) ++e;
        const int r0 = (rt - tst[e]) * 256;
        u.A = XN2; u.B = WGU + ((size_t)e * 512 + (size_t)pn * 256) * 2048;
        u.rl = e < NE ? ROWL + (size_t)e * 16384 + r0 : IDENT + r0; u.nvalid = cnt[e] - r0; u.erow0 = 0; u.ecol0 = pn * 256; u.x0 = off[e] + r0; u.xp = e < NE ? WL + (size_t)e * 16384 + r0 : nullptr; return true; } };
struct MoeSched2 { LAS const int* cnt; LAS const int* off; LAS const int* tst; int G, c; const char* HID; const char* WD;
    __device__ __forceinline__ bool next(int i, g8::GUnit& u) const {
        const int L = i * G + c; if (L >= 4 * tst[NEX]) return false;
        const int rt = L >> 2, pn = L & 3; int e = 0; while (tst[e + 1] <= rt) ++e;
        const int r0 = (rt - tst[e]) * 256;
        u.A = HID + (size_t)(off[e] + r0) * 512; u.B = WD + ((size_t)e * 1024 + (size_t)pn * 256) * 512;
        u.rl = nullptr; u.nvalid = 0; u.erow0 = 0; u.ecol0 = pn * 256; u.x0 = off[e] + r0; u.xp = nullptr; return true; } };
struct EpiG1u { bf16* HID;
    __device__ __forceinline__ void operator()(const g8::GUnit& u, int row, int col, f32x4 lo, f32x4 hi) const {
        const int hc = col - 128 * (col >> 8);
        f32x4 v = (f32x4){0.f, 0.f, 0.f, 0.f};
        if (row < u.nvalid) { const float w = u.xp ? u.xp[row] : 1.f;
#pragma unroll
            for (int i = 0; i < 4; ++i) v[i] = siluf_(lo[i]) * hi[i] * w; }
        st_bf4(HID + (size_t)(u.x0 + row) * 256 + hc, v);
    } };
struct EpiG2u { bf16* Y;
    __device__ __forceinline__ void operator()(const g8::GUnit& u, int row, int col, f32x4 lo, f32x4 hi) const {
        st_bf4(Y + (size_t)(u.x0 + row) * 1024 + col, lo); st_bf4(Y + (size_t)(u.x0 + row) * 1024 + col + 128, hi);
    } };
__device__ __forceinline__ void phase_gemm1(const Ctx& c, int l, int hf) {
    moe_tables(c, l, hf);
    LAS int* cnt = (LAS int*)(c.lds + 140000); LAS int* off = cnt + 65; LAS int* tst = off + 65;
    MoeSched1 S{cnt, off, tst, c.nblk, c.bid, (const char*)(c.ws + WS_XN2), (const char*)(c.ws + WS_WGU), (const int*)(c.ws + WS_ROWL) + (size_t)hf * 64 * 16384, (const float*)(c.ws + WS_WL) + (size_t)hf * 64 * 16384,
                (const int*)(c.ws + WS_IDENT) + (size_t)hf * HALF_T};
    EpiG1u E{(bf16*)(c.ws + WS_HID)};
    g8::gemm_phase<true>(c.lds, 2048u, 1024, S, E);
    __syncthreads();
}
__device__ __forceinline__ void phase_gemm2(const Ctx& c, int l, int hf) {
    moe_tables(c, l, hf);
    LAS int* cnt = (LAS int*)(c.lds + 140000); LAS int* off = cnt + 65; LAS int* tst = off + 65;
    MoeSched2 S{cnt, off, tst, c.nblk, c.bid, (const char*)(c.ws + WS_HID), (const char*)(c.ws + WS_WD)};
    EpiG2u E{(bf16*)(c.ws + WS_Y)};
    g8::gemm_phase<false>(c.lds, 512u, 256, S, E);
    __syncthreads();
}
__device__ __forceinline__ void phase_combine(const Ctx& c, int l, int hf, float* xio) {
    moe_tables(c, l, hf);
    LAS int* off = (LAS int*)(c.lds + 140000) + 65;
    const int gw = c.bid * NWAVES + c.wave, NGW = c.nblk * NWAVES, lane = c.lane;
    const bf16* Y = (const bf16*)(c.ws + WS_Y); const unsigned* TOKPOS = (const unsigned*)(c.ws + WS_TOKPOS);
    const float* MODl = (const float*)(c.ws + WS_MOD) + (size_t)l * 16 * 6144;
    const float* MODn = (const float*)(c.ws + WS_MOD) + (size_t)1 * 16 * 6144;
    bf16* XN = (bf16*)(c.ws + WS_XN);
    unsigned tpn[TOPK];
    if (gw < HALF_T) {
#pragma unroll
        for (int kk = 0; kk < TOPK; ++kk) tpn[kk] = TOKPOS[(size_t)(hf * HALF_T + gw) * 6 + kk]; }
#pragma unroll 1
    for (int tt = gw; tt < HALF_T; tt += NGW) {
        const int t = hf * HALF_T + tt, b = t >> 11;
        unsigned tp[TOPK];
#pragma unroll
        for (int kk = 0; kk < TOPK; ++kk) tp[kk] = tpn[kk];
        f32x4 acc[4];
        u32x2 yv[TOPK + 1][4];
        { const bf16* yr = Y + (size_t)(off[NE] + tt) * 1024;
#pragma unroll
          for (int j = 0; j < 4; ++j) yv[TOPK][j] = *(const u32x2*)(yr + 4 * (lane + 64 * j)); }
#pragma unroll
        for (int kk = 0; kk < TOPK; ++kk) {
            const int e = tp[kk] >> 16, slot = tp[kk] & 0xffff;
            const bf16* yr = Y + (size_t)(off[e] + slot) * 1024;
#pragma unroll
            for (int j = 0; j < 4; ++j) yv[kk][j] = *(const u32x2*)(yr + 4 * (lane + 64 * j));
        }
        if (tt + NGW < HALF_T) {
#pragma unroll
            for (int kk = 0; kk < TOPK; ++kk) tpn[kk] = TOKPOS[(size_t)(t + NGW) * 6 + kk]; }
#pragma unroll
        for (int j = 0; j < 4; ++j) { acc[j] = (f32x4){bflo(yv[TOPK][j].x), bfhi(yv[TOPK][j].x), bflo(yv[TOPK][j].y), bfhi(yv[TOPK][j].y)};
#pragma unroll
            for (int kk = 0; kk < TOPK; ++kk) acc[j] += (f32x4){bflo(yv[kk][j].x), bfhi(yv[kk][j].x), bflo(yv[kk][j].y), bfhi(yv[kk][j].y)}; }
        float* xr = xio + (size_t)t * D; const float* g2 = MODl + (size_t)b * 6144 + 5120;
        f32x4 v[4]; float s = 0.f;
#pragma unroll
        for (int j = 0; j < 4; ++j) { const int cc = 4 * (lane + 64 * j); v[j] = *(const f32x4*)(xr + cc) + *(const f32x4*)(g2 + cc) * acc[j]; s += v[j][0] * v[j][0] + v[j][1] * v[j][1] + v[j][2] * v[j][2] + v[j][3] * v[j][3]; }
        const float rstd = rsqrtf(wave_sum(s) * (1.f / D) + EPS);
        if (l == 0) {
#pragma unroll
            for (int j = 0; j < 4; ++j) { const int cc = 4 * (lane + 64 * j); *(f32x4*)(xr + cc) = v[j];
                const f32x4 g = *(const f32x4*)(c.in[IN_NMIX] + D + cc), a = *(const f32x4*)(MODn + (size_t)b * 6144 + 1024 + cc), bb = *(const f32x4*)(MODn + (size_t)b * 6144 + cc);
                st_bf4(XN + (size_t)t * D + cc, v[j] * rstd * g * (a + 1.f) + bb); }
        } else {
#pragma unroll
            for (int j = 0; j < 4; ++j) { const int cc = 4 * (lane + 64 * j); *(f32x4*)(xr + cc) = v[j] * rstd * *(const f32x4*)(c.in[IN_NFIN] + cc); }
        }
    }
}

#ifdef DSA_NO_SEL
#define DSA_SEL_CALL
#else
#define DSA_SEL_CALL phase_ckvt(c); for (int r2 = 0; r2 < REPN(20); ++r2) phase_dsa_sel(c, l);
#endif
#ifdef DSA_NO_ATT
#define DSA_ATT_CALL
#else
#define DSA_ATT_CALL for (int r2 = 0; r2 < REPN(21); ++r2) phase_dsa_att(c, l);
#endif
constexpr int PH_PER_L = 18, N_PHASES = 1 + NL * PH_PER_L;
#ifndef PH_MASK
#define PH_MASK 0xFFFFFFFFu
#endif
#define IN(k) (lo <= (k) && (k) < hi)
#define EN(b) ((PH_MASK >> (b)) & 1u)
#ifndef REP_MASK
#define REP_MASK 0u
#endif
#define REPN(b) (((REP_MASK >> (b)) & 1u) ? 2 : 1)
#define SEAM(k) do { if (MK_ONE_LAUNCH && IN(k) && IN((k) + 1)) xcd_barrier(bar); } while (0)
template <int l>
__device__ __forceinline__ void layer_program(const Ctx& c, const XcdBarrier& bar, int lo, int hi) {
        const int P = 1 + l * PH_PER_L;
        const float* xin = l == 0 ? c.in[IN_X] : c.out;
        bf16* PB = (bf16*)(c.ws + WS_PB); float* SM = (float*)(c.ws + WS_SM);
        const bf16* XN = (const bf16*)(c.ws + WS_XN);
        const bf16* WIN = (const bf16*)(c.ws + WS_WIN) + (size_t)l * NINP * 1024;
        if (EN(1) && IN(P + 0)) { for (int rep = 0; rep < REPN(1); ++rep) {  if (l == 0) phase_norm1(c, 0, c.in[IN_X]);  if (rep + 1 < REPN(1)) xcd_barrier(bar); } } if (l == 0) SEAM(P + 0);
        if (EN(2) && IN(P + 1)) { for (int rep = 0; rep < REPN(2); ++rep) {  EpiInPB E{PB, SM}; dgemm_phase(c, XN, 1024, T, WIN, NPB / 256, 1024, EpiU<decltype(E)>{E});  if (rep + 1 < REPN(2)) xcd_barrier(bar); } } SEAM(P + 1);
        if (EN(3) && IN(P + 2)) { for (int rep = 0; rep < REPN(3); ++rep) {  phase_prep(c, l);  if (rep + 1 < REPN(3)) xcd_barrier(bar); } } SEAM(P + 2);
        if (EN(4) && IN(P + 3)) { for (int rep = 0; rep < REPN(4); ++rep) {
#if SCAN_3PASS
            for (int r2 = 0; r2 < REPN(22); ++r2) phase_scanA(c, l);
            xcd_barrier(bar); scanB(c);
            { EpiQ Eq{(bf16*)(c.ws + WS_QLAT), (bf16*)(c.ws + WS_QIDX), (const float*)(c.ws + WS_RSTDQ)};
              dgemm_phase(c, PB + PB_CQ, NPB, T, (const bf16*)(c.ws + WS_WQ) + (size_t)l * 1280 * 256, 5, 256, EpiU<decltype(Eq)>{Eq}); }
            xcd_barrier(bar); phase_scanC(c, l);
#else
            phase_scans(c, l);
#endif
            if (rep + 1 < REPN(4)) xcd_barrier(bar); } } SEAM(P + 3);
        if (EN(6) && IN(P + 5)) { for (int rep = 0; rep < REPN(6); ++rep) {  EpiGate E{(bf16*)(c.ws + WS_G)}; dgemm_phase(c, XN, 1024, T, WIN + (size_t)NPB * 1024, NG / 256, 1024, EpiU<decltype(E)>{E});  if (rep + 1 < REPN(6)) xcd_barrier(bar); } }
        if (EN(7) && IN(P + 6)) { for (int rep = 0; rep < REPN(7); ++rep) {  DSA_SEL_CALL xcd_barrier(bar); DSA_ATT_CALL  if (rep + 1 < REPN(7)) xcd_barrier(bar); } } SEAM(P + 6);
        if (EN(8) && IN(P + 7)) {
            { EpiUp E{(bf16*)(c.ws + WS_M1), (const bf16*)(c.ws + WS_G), 0, 1};
              dgemm_phase(c, (const bf16*)(c.ws + WS_UA), 512, T, (const bf16*)(c.ws + WS_WUPA) + (size_t)l * 1024 * 512, 4, 512, EpiU<decltype(E)>{E}); }
            { EpiUp E{(bf16*)(c.ws + WS_M1), (const bf16*)(c.ws + WS_G), 1024, 0};
              dgemm_phase(c, (const bf16*)(c.ws + WS_OLAT), 1024, T, (const bf16*)(c.ws + WS_WUVB) + (size_t)l * 1024 * 1024, 4, 1024, EpiU<decltype(E)>{E}); }
            { EpiUp E{(bf16*)(c.ws + WS_M1), (const bf16*)(c.ws + WS_G), 2048, 0};
              dgemm_phase(c, (const bf16*)(c.ws + WS_UC), 512, T, (const bf16*)(c.ws + WS_WUPC) + (size_t)l * 1024 * 512, 4, 512, EpiU<decltype(E)>{E}); }
        } SEAM(P + 9);
        if (EN(11) && IN(P + 10)) { for (int rep = 0; rep < REPN(11); ++rep) {  EpiWo E{xin, c.out, (const float*)(c.ws + WS_MOD) + (size_t)l * 16 * 6144 + 2048};
            dgemm_phase(c, (const bf16*)(c.ws + WS_M1), 1024, T, (const bf16*)(c.ws + WS_WO) + (size_t)l * 1024 * 1024, 4, 1024, EpiU<decltype(E)>{E});  if (rep + 1 < REPN(11)) xcd_barrier(bar); } } SEAM(P + 10);
        if (EN(12) && IN(P + 11)) { for (int rep = 0; rep < REPN(12); ++rep) {  phase_route(c, l, c.out);  if (rep + 1 < REPN(12)) xcd_barrier(bar); } } SEAM(P + 11);
        if (EN(13) && IN(P + 12)) { for (int rep = 0; rep < REPN(13); ++rep) {  phase_gemm1(c, l, 0);  if (rep + 1 < REPN(13)) xcd_barrier(bar); } } SEAM(P + 12);
        if (EN(14) && IN(P + 13)) { for (int rep = 0; rep < REPN(14); ++rep) {  phase_gemm2(c, l, 0);  if (rep + 1 < REPN(14)) xcd_barrier(bar); } } SEAM(P + 13);
        if (EN(15) && IN(P + 14)) { phase_gemm1(c, l, 1); phase_combine(c, l, 0, c.out); } SEAM(P + 14);
        if (EN(17) && IN(P + 16)) { for (int rep = 0; rep < REPN(17); ++rep) {  phase_gemm2(c, l, 1);  if (rep + 1 < REPN(17)) xcd_barrier(bar); } } SEAM(P + 16);
        if (EN(18) && IN(P + 17)) { for (int rep = 0; rep < REPN(18); ++rep) {  phase_combine(c, l, 1, c.out);  if (rep + 1 < REPN(18)) xcd_barrier(bar); } } SEAM(P + 17);
    }
__global__ void __launch_bounds__(NTHR, 2) fwd(Args args) {
    extern __shared__ __attribute__((aligned(16))) unsigned char lds_raw[];
    Ctx c;
    c.lds = (LAS unsigned char*)lds_raw;
    c.tid = threadIdx.x; c.lane = c.tid & 63; c.wave = __builtin_amdgcn_readfirstlane(c.tid >> 6);
    c.bid = blockIdx.x; c.nblk = gridDim.x;
    c.in = args.in; c.out = args.out; c.ws = args.ws;
    for (int u = c.tid; u < (LDS_BYTES - LDS_MISC) / 4; u += NTHR) ((LAS unsigned*)(c.lds + LDS_MISC))[u] = 0u;
    __syncthreads();
    XcdBarrier bar; bar.bar = (unsigned*)(c.ws + WS_CTL) + CW_BAR; bar.x = 0; bar.st = (volatile LAS unsigned*)(c.lds + LDS_MISC);
    if (MK_ONE_LAUNCH) bar = xcd_barrier_post((unsigned*)(c.ws + WS_CTL) + CW_BAR, (volatile LAS unsigned*)(c.lds + LDS_MISC));
    const int lo = args.ph_lo, hi = args.ph_hi;
    if (EN(0) && IN(0)) { for (int rep = 0; rep < REPN(0); ++rep) { phase_prologue(c); if (rep + 1 < REPN(0)) xcd_barrier(bar); } } SEAM(0);
    layer_program<0>(c, bar, lo, hi);
    layer_program<1>(c, bar, lo, hi);
#undef IN
#undef SEAM
}

extern "C" void kernel_launch(void* const* d_in, const int* in_sizes, int n_in, void* d_out, int out_size, void* d_ws, size_t ws_size, hipStream_t stream) {
    static int grid = 0;
    if (grid == 0) {
        if (n_in != 33 || out_size != T * D || ws_size < WS_END) { fprintf(stderr, "kernel_launch: unexpected problem (n_in %d out %d ws %zu)\n", n_in, out_size, ws_size); grid = -1; return; }
        int dev = 0, cus = 0, per_cu = 0;
        if (hipGetDevice(&dev) != hipSuccess || hipDeviceGetAttribute(&cus, hipDeviceAttributeMultiprocessorCount, dev) != hipSuccess) { grid = -1; return; }
        if (hipFuncSetAttribute((const void*)fwd, hipFuncAttributeMaxDynamicSharedMemorySize, LDS_BYTES) != hipSuccess) { fprintf(stderr, "kernel_launch: hipFuncSetAttribute failed\n"); grid = -1; return; }
        if (hipOccupancyMaxActiveBlocksPerMultiprocessor(&per_cu, (const void*)fwd, NTHR, LDS_BYTES) != hipSuccess || per_cu < 1) { fprintf(stderr, "kernel_launch: occupancy query says %d\n", per_cu); }
        (void)hipGetLastError();
        grid = cus;
    }
    if (grid < 0) return;
    (void)hipMemsetAsync((char*)d_ws + WS_CTL, 0, CTL_BYTES, stream);
    Args a{};
    for (int i = 0; i < 33; ++i) a.in[i] = (const float*)d_in[i];
    a.out = (float*)d_out; a.ws = (unsigned char*)d_ws;
#if MK_ONE_LAUNCH
    a.ph_lo = 0; a.ph_hi = N_PHASES;
    hipLaunchKernelGGL(fwd, dim3(grid), dim3(NTHR), LDS_BYTES, stream, a);
#else
    for (int p = 0; p < N_PHASES; ++p) {
        if (p == 1 + PH_PER_L) continue;
        a.ph_lo = p; a.ph_hi = p + 1;
        hipLaunchKernelGGL(fwd, dim3(grid), dim3(NTHR), LDS_BYTES, stream, a);
    }
#endif
}
```

```cpp
#include <hip/hip_runtime.h>
#include <cstdio>
#include <cstdint>

#define LAS __attribute__((address_space(3)))
#define GAS __attribute__((address_space(1)))
typedef unsigned short bf16;
typedef short bf16x8 __attribute__((ext_vector_type(8)));
typedef float f32x4 __attribute__((ext_vector_type(4)));
typedef float f32x2 __attribute__((ext_vector_type(2)));
typedef unsigned u32x4 __attribute__((ext_vector_type(4)));
typedef unsigned u32x2 __attribute__((ext_vector_type(2)));
typedef GAS unsigned gu32;

#ifndef SCAN_3PASS
#define SCAN_3PASS 1
#endif
#ifndef SCAN_RECURRENT
#define SCAN_RECURRENT 0
#endif
#ifndef MK_ONE_LAUNCH
#define MK_ONE_LAUNCH 1
#endif

constexpr int NB = 16, SEQ = 2048, D = 1024, T = NB * SEQ, NL = 2;
constexpr int NIN = 6592, NPB = 3584, NG = 3072, NINP = NPB + NG;
constexpr int NE = 64, NEX = 65, EFF = 256, TOPK = 6;
constexpr int HALF_T = T / 2;
constexpr int DSA_K = 256;
constexpr float EPS = 1e-6f;
constexpr int NTHR = 512, NWAVES = 8;

constexpr int PB_QA = 0, PB_KA = 256, PB_VA = 512, PB_GA = 1024, PB_CQ = 1536, PB_CKV = 1792, PB_QC = 2048, PB_KC = 2304, PB_VC = 2560, PB_OC = 3072;
constexpr int SM_KIDX = 0, SM_ALR = 32, SM_WIDX = 48, SM_IC = 56, SM_FC = 60;

constexpr size_t MiB = 1u << 20;
constexpr size_t WS_CTL = 0, CTL_BYTES = 1 * MiB;
constexpr size_t WS_MOD = 1 * MiB;
constexpr size_t WS_RSTDQ = 2 * MiB;
constexpr size_t WS_TOKPOS = 3 * MiB;
constexpr size_t WS_IDENT = 3 * MiB + 800 * 1024;
constexpr size_t WS_WIN = 4 * MiB;
constexpr size_t WS_WQ = 30 * MiB;
constexpr size_t WS_WUPA = 32 * MiB;
constexpr size_t WS_WUPC = 34 * MiB;
constexpr size_t WS_WUVB = 36 * MiB;
constexpr size_t WS_WO = 40 * MiB;
constexpr size_t WS_WGU = 44 * MiB;
constexpr size_t WS_WD = 109 * MiB;
constexpr size_t WS_XN = 142 * MiB;
constexpr size_t WS_OLAT = WS_XN;
constexpr size_t WS_UA = 206 * MiB;
constexpr size_t WS_UC = 238 * MiB;
constexpr size_t WS_XN2 = 206 * MiB;
constexpr size_t WS_QLAT = 270 * MiB;
constexpr size_t WS_M1 = WS_QLAT;
constexpr size_t WS_QIDX = 334 * MiB;
constexpr size_t WS_CKVN = 350 * MiB;
constexpr size_t WS_KIDX = 358 * MiB;
constexpr size_t WS_SM = 360 * MiB;
constexpr size_t WS_PB = 376 * MiB;
constexpr size_t WS_G = WS_PB;
constexpr size_t WS_HID = 270 * MiB;
constexpr size_t WS_Y = 334 * MiB;
constexpr size_t WS_ROWL = 590 * MiB;
constexpr size_t WS_WL = 598 * MiB;
constexpr size_t WS_CKVT = 576 * MiB;
constexpr size_t WS_MASK = 584 * MiB;
static_assert(WS_CKVT >= WS_G + (size_t)T * NG * 2 && WS_MASK + (size_t)T * 64 * 4 <= WS_PB + (size_t)T * NPB * 2, "CKVT/MASK placement");
constexpr size_t WS_QS = 44 * MiB;
constexpr size_t WS_DSG = 76 * MiB;
constexpr size_t WS_DSM = 600 * MiB;
constexpr size_t WS_ET = 108 * MiB;
constexpr size_t WS_CT = 108 * MiB + 512 * 1024;
constexpr size_t WS_MP = 108 * MiB + 768 * 1024;
constexpr size_t WS_GPM = 109 * MiB;
constexpr size_t WS_GBC = 110 * MiB;
constexpr size_t WS_DN = 111 * MiB;
constexpr size_t WS_END = 636 * MiB;
static_assert(WS_PB + (size_t)T * NPB * 2 <= 600 * MiB, "PB");
static_assert(WS_Y + (size_t)131072 * 1024 * 2 <= WS_ROWL, "Y");

constexpr int CW_BAR = 4096;
constexpr int CW_CNT = 16384;

constexpr int LDS_BYTES = 147456;
constexpr int LDS_MISC = 145408;

__device__ __forceinline__ unsigned f2bf(float f) { unsigned u = __builtin_bit_cast(unsigned, f); return (u + 0x7fffu + ((u >> 16) & 1u)) >> 16; }
__device__ __forceinline__ float bf2f(unsigned b) { return __builtin_bit_cast(float, b << 16); }
typedef __bf16 bf16x2_t __attribute__((ext_vector_type(2)));
__device__ __forceinline__ unsigned pk2(float lo, float hi) { const f32x2 v = {lo, hi}; const bf16x2_t b = __builtin_convertvector(v, bf16x2_t); return __builtin_bit_cast(unsigned, b); }
__device__ __forceinline__ float bflo(unsigned w) { return __builtin_bit_cast(float, w << 16); }
__device__ __forceinline__ float bfhi(unsigned w) { return __builtin_bit_cast(float, w & 0xffff0000u); }
__device__ __forceinline__ float wave_sum(float v) {
#pragma unroll
    for (int o = 1; o < 64; o <<= 1) v += __shfl_xor(v, o);
    return v;
}
__device__ __forceinline__ float wave_max(float v) {
#pragma unroll
    for (int o = 1; o < 64; o <<= 1) v = fmaxf(v, __shfl_xor(v, o));
    return v;
}
__device__ __forceinline__ int wave_sum_i(int v) {
#pragma unroll
    for (int o = 1; o < 64; o <<= 1) v += __shfl_xor(v, o);
    return v;
}
__device__ __forceinline__ void lds_barrier() { asm volatile("s_waitcnt lgkmcnt(0)" ::: "memory"); __builtin_amdgcn_s_barrier(); asm volatile("" ::: "memory"); }
__device__ __forceinline__ float sigmoidf_(float x) { return 1.f / (1.f + __expf(-x)); }
__device__ __forceinline__ float siluf_(float x) { return x / (1.f + __expf(-x)); }
__device__ __forceinline__ float logsigmoidf_(float x) { return fminf(x, 0.f) - log1pf(__expf(-fabsf(x))); }
__device__ __forceinline__ float logsigmoid_fast(float x) { return fminf(x, 0.f) - __logf(1.f + __expf(-fabsf(x))); }
__device__ __forceinline__ void st_bf4(bf16* p, f32x4 v) { u32x2 w; w.x = pk2(v[0], v[1]); w.y = pk2(v[2], v[3]); *(u32x2*)p = w; }
__device__ __forceinline__ f32x4 ld_bf4_l2(const bf16* p) { const unsigned long long q = __hip_atomic_load((const unsigned long long*)p, __ATOMIC_RELAXED, __HIP_MEMORY_SCOPE_AGENT); const unsigned lo = (unsigned)q, hi = (unsigned)(q >> 32); return (f32x4){bflo(lo), bfhi(lo), bflo(hi), bfhi(hi)}; }
__device__ __forceinline__ f32x4 ld_bf4(const bf16* p) { u32x2 w = *(const u32x2*)p; return (f32x4){bflo(w.x), bfhi(w.x), bflo(w.y), bfhi(w.y)}; }

#define XB_TMO      128
#define XB_XCNT(j)  (256  + 64 * (j))
#define XB_XSUB(j)  (1280 + 64 * (j))
#define XB_XGEN(j)  (2304 + 64 * (j))
#define XB_TOP      3328
#define XB_TOPGEN   3392
#define XCD_BAR_WORDS 3456
#define XB_SPIN_CAP (1u << 22)
__device__ __forceinline__ unsigned xb_ld(unsigned* p)              { return __hip_atomic_load(p, __ATOMIC_RELAXED, __HIP_MEMORY_SCOPE_AGENT); }
__device__ __forceinline__ unsigned xb_add(unsigned* p, unsigned v) { return __hip_atomic_fetch_add(p, v, __ATOMIC_RELAXED, __HIP_MEMORY_SCOPE_AGENT); }
__device__ __forceinline__ unsigned xb_xcc_id() { return (unsigned)__builtin_amdgcn_s_getreg((3 << 11) | 20) & 0xFu; }
#define XB_SPIN(cond, bar) do { unsigned _sp = 0; while (cond) { __builtin_amdgcn_s_sleep(1); \
    if ((++_sp & 255u) == 0u) { if (xb_ld(&(bar)[XB_TMO])) break; if (_sp > XB_SPIN_CAP) { atomicAdd(&(bar)[XB_TMO], 1u); break; } } } } while (0)
struct XcdBarrier { unsigned* bar; unsigned x; volatile LAS unsigned* st; };
__device__ __forceinline__ XcdBarrier xcd_barrier_post(unsigned* bar, volatile LAS unsigned* st) {
    XcdBarrier b; b.bar = bar; b.x = xb_xcc_id(); b.st = st;
    if (threadIdx.x == 0) (void)xb_add(&bar[XB_XCNT(b.x)], 1u);
    return b;
}
__device__ __forceinline__ void xcd_barrier_complete(unsigned* bar, unsigned x, unsigned& nloc, unsigned& nx) {
    const unsigned G = gridDim.x * gridDim.y * gridDim.z;
    unsigned sum, cnt, mine, sp = 0u;
    for (;;) {
        sum = 0u; cnt = 0u; mine = 0u;
#pragma unroll
        for (unsigned j = 0; j < 16; ++j) { const unsigned c = xb_ld(&bar[XB_XCNT(j)]); sum += c; cnt += (c > 0u) ? 1u : 0u; mine = (j == x) ? c : mine; }
        if (sum == G) break;
        __builtin_amdgcn_s_sleep(1);
        if ((++sp & 255u) == 0u) { if (xb_ld(&bar[XB_TMO])) break; if (sp > XB_SPIN_CAP) { atomicAdd(&bar[XB_TMO], 1u); break; } }
    }
    nloc = mine > 0u ? mine : 1u; nx = cnt > 0u ? cnt : 1u;
}
__device__ __forceinline__ void xcd_barrier(const XcdBarrier& b) {
    asm volatile("s_waitcnt vmcnt(0)" ::: "memory");
    __syncthreads();
    if (threadIdx.x == 0) {
        unsigned* bar = b.bar;
        __builtin_amdgcn_s_waitcnt(0);
        unsigned nloc = b.st[0], nx = b.st[1];
        if (nloc == 0u) { xcd_barrier_complete(bar, b.x, nloc, nx); b.st[0] = nloc; b.st[1] = nx; }
        const unsigned old = xb_add(&bar[XB_XSUB(b.x)], 1u);
        const unsigned gen = old / nloc;
        if (old + 1u == (gen + 1u) * nloc) {
            __builtin_amdgcn_fence(__ATOMIC_RELEASE, "agent");
            asm volatile("s_waitcnt vmcnt(0)" ::: "memory");
            const unsigned og = xb_add(&bar[XB_TOP], 1u);
            const unsigned tg = og / nx;
            if (og + 1u == (tg + 1u) * nx) xb_add(&bar[XB_TOPGEN], 1u);
            else XB_SPIN(xb_ld(&bar[XB_TOPGEN]) == tg, bar);
            __builtin_amdgcn_fence(__ATOMIC_ACQUIRE, "agent");
            xb_add(&bar[XB_XGEN(b.x)], 1u);
            asm volatile("s_waitcnt vmcnt(0)" ::: "memory");
        } else {
            XB_SPIN(xb_ld(&bar[XB_XGEN(b.x)]) == gen, bar);
            __builtin_amdgcn_fence(__ATOMIC_ACQUIRE, "agent");
            asm volatile("s_waitcnt vmcnt(0)" ::: "memory");
        }
    }
    __syncthreads();
}

struct Args { const float* in[33]; float* out; unsigned char* ws; int ph_lo, ph_hi; };

struct Ctx {
    LAS unsigned char* lds;
    int tid, lane, wave, bid, nblk;
    const float* const* in;
    float* out; unsigned char* ws;
};
#define IN_X 0
#define IN_C 1
#define IN_ADAW 2
#define IN_ADAB 3
#define IN_NMIX 4
#define IN_NFFN 5
#define IN_WIN 6
#define IN_GLA_WA2 7
#define IN_GLA_BA 8
#define IN_GLA_NORM 9
#define IN_DSA_NQ 10
#define IN_DSA_NKV 11
#define IN_DSA_WUQ 12
#define IN_DSA_WUK 13
#define IN_DSA_WUV 14
#define IN_DSA_WQI 15
#define IN_ML_CONV 16
#define IN_ML_BI 17
#define IN_ML_BF 18
#define IN_ML_NORM 19
#define IN_WUPA 20
#define IN_WUPB 21
#define IN_WUPC 22
#define IN_WO 23
#define IN_RW 24
#define IN_RB 25
#define IN_EWG 26
#define IN_EWU 27
#define IN_EWD 28
#define IN_SWG 29
#define IN_SWU 30
#define IN_SWD 31
#define IN_NFIN 32

template <class SrcF>
__device__ __forceinline__ void tr_item(const SrcF& src, bf16* dst, int dst_ld, int n0, int k0, LAS float* scr, int lane) {
    const int j = lane & 31;
    const float* colp = src(n0 + j);
    const long ld = src.ld;
    float tv[32];
#pragma unroll
    for (int i = 0; i < 32; ++i) { const int kk = 2 * i + (lane >> 5); tv[i] = colp ? colp[(long)(k0 + kk) * ld] : 0.f; }
#pragma unroll
    for (int i = 0; i < 32; ++i) { const int kk = 2 * i + (lane >> 5); scr[kk * 33 + j] = tv[i]; }
    asm volatile("s_waitcnt lgkmcnt(0)" ::: "memory");
    const int c = lane & 7;
#pragma unroll
    for (int jj = 0; jj < 4; ++jj) { const int n = (lane >> 3) + 8 * jj; const LAS float* s = scr + (8 * c) * 33 + n;
        u32x4 o; o.x = pk2(s[0 * 33], s[1 * 33]); o.y = pk2(s[2 * 33], s[3 * 33]); o.z = pk2(s[4 * 33], s[5 * 33]); o.w = pk2(s[6 * 33], s[7 * 33]);
        *(u32x4*)(dst + (size_t)(n0 + n) * dst_ld + k0 + 8 * c) = o; }
    asm volatile("s_waitcnt lgkmcnt(0)" ::: "memory");
}
struct SrcPlain { const float* W; long ld; __device__ __forceinline__ const float* operator()(int n) const { return W + n; } };
__device__ __forceinline__ int win_src_col(int r) {
    if (r < 1536) return r;
    if (r < 1792) return 1552 + (r - 1536);
    if (r < 1920) return 1808 + (r - 1792);
    if (r < 1952) return 1936 + (r - 1920);
    if (r < 1968) return 1536 + (r - 1952);
    if (r < 1976) return 1968 + (r - 1968);
    if (r < 1980) return 3000 + (r - 1976);
    if (r < 1984) return 3004 + (r - 1980);
    if (r < 2048) return -1;
    if (r < 2560) return 1976 + (r - 2048);
    if (r < 3072) return 2488 + (r - 2560);
    if (r < 3584) return 3008 + (r - 3072);
    return 3520 + (r - 3584);
}
struct SrcWin { const float* W; long ld; __device__ __forceinline__ const float* operator()(int n) const { const int c = win_src_col(n); return c < 0 ? nullptr : W + c; } };
struct SrcGU { const float* Wg; const float* Wu; long ld;
    __device__ __forceinline__ const float* operator()(int r) const { const int pn = r >> 8, w = r & 255, j = 128 * pn + (w & 127); return (w < 128 ? Wg : Wu) + j; } };

constexpr int SG_LD = 40;
template <class Epi>
__device__ __forceinline__ void sgemm_unit(const Ctx& c, const bf16* A, int lda, const int* rowlist, int nvalid, int arow0, const bf16* Bt, int K, const Epi& E, int erow0, int ecol0) {
    LAS bf16* As = (LAS bf16*)c.lds;
    LAS bf16* Bs = (LAS bf16*)(c.lds + 128 * SG_LD * 2);
    const int tid = c.tid, lane = c.lane, wave = c.wave, wr = wave >> 2, wc = wave & 3, fr = lane & 15, fq = lane >> 4;
    const int lr = tid >> 2, ch = tid & 3;
    int srow = arow0 + lr;
    if (rowlist) { srow = (arow0 + lr < nvalid) ? rowlist[arow0 + lr] : 0; }
    const bf16* ap = A + (size_t)srow * lda + ch * 8;
    const bf16* bp0 = Bt + (size_t)lr * K + ch * 8;
    const bf16* bp1 = Bt + (size_t)(128 + lr) * K + ch * 8;
    f32x4 acc[2][4][2];
#pragma unroll
    for (int a = 0; a < 2; ++a)
#pragma unroll
        for (int m = 0; m < 4; ++m)
#pragma unroll
            for (int n = 0; n < 2; ++n) acc[a][m][n] = (f32x4){0.f, 0.f, 0.f, 0.f};
    u32x4 ra = *(const u32x4*)ap, rb0 = *(const u32x4*)bp0, rb1 = *(const u32x4*)bp1;
    for (int k0 = 0; k0 < K; k0 += 32) {
        __syncthreads();
        *(LAS u32x4*)(As + lr * SG_LD + ch * 8) = ra;
        *(LAS u32x4*)(Bs + lr * SG_LD + ch * 8) = rb0;
        *(LAS u32x4*)(Bs + (128 + lr) * SG_LD + ch * 8) = rb1;
        __syncthreads();
        if (k0 + 32 < K) { ra = *(const u32x4*)(ap + k0 + 32); rb0 = *(const u32x4*)(bp0 + k0 + 32); rb1 = *(const u32x4*)(bp1 + k0 + 32); }
        bf16x8 af[4], bfr[2][2];
#pragma unroll
        for (int m = 0; m < 4; ++m) af[m] = *(const LAS bf16x8*)(As + (wr * 64 + m * 16 + fr) * SG_LD + fq * 8);
#pragma unroll
        for (int bj = 0; bj < 2; ++bj)
#pragma unroll
            for (int n = 0; n < 2; ++n) bfr[bj][n] = *(const LAS bf16x8*)(Bs + (bj * 128 + wc * 32 + n * 16 + fr) * SG_LD + fq * 8);
#pragma unroll
        for (int bj = 0; bj < 2; ++bj)
#pragma unroll
            for (int m = 0; m < 4; ++m)
#pragma unroll
                for (int n = 0; n < 2; ++n) acc[bj][m][n] = __builtin_amdgcn_mfma_f32_16x16x32_bf16(bfr[bj][n], af[m], acc[bj][m][n], 0, 0, 0);
    }
#pragma unroll
    for (int m = 0; m < 4; ++m)
#pragma unroll
        for (int n = 0; n < 2; ++n) E(erow0 + wr * 64 + m * 16 + fr, ecol0 + wc * 32 + n * 16 + 4 * fq, acc[0][m][n], acc[1][m][n]);
}
template <class Epi>
__device__ __forceinline__ void sgemm_phase(const Ctx& c, const bf16* A, int lda, int M, const bf16* Bt, int ntn, int K, const Epi& E) {
    const int nu = (M / 128) * ntn;
    for (int u = c.bid; u < nu; u += c.nblk) {
        const int pm = u / ntn, pn = u % ntn;
        sgemm_unit(c, A, lda, nullptr, 0, pm * 128, Bt + (size_t)pn * 256 * K, K, E, pm * 128, pn * 256);
    }
    __syncthreads();
}


namespace g8 {
constexpr int BM = 256, BK = 64, HALF = 128, HTB = HALF * BK * 2, STAGE_BYTES = 8 * HTB, NXCD = 8, WGM = 8;
__host__ __device__ __forceinline__ int lds_byte(int r, int c) { const int st = (r >> 4) * 2 + (c >> 5), rr = r & 15, cc = c & 31, ob = rr * 64 + cc * 2; return st * 1024 + (ob ^ (((ob >> 9) & 1) << 5)); }
__host__ __device__ __forceinline__ void stage_rc(int b, int& R, int& C) { const int st = b / 1024, sb = b % 1024, swz = sb ^ (((sb >> 9) & 1) << 5); R = (st >> 1) * 16 + swz / 64; C = (st & 1) * 32 + (swz % 64) / 2; }
struct GUnit { const char* A; const char* B; const int* rl; int nvalid; int erow0, ecol0; int x0; const float* xp; };
__device__ __forceinline__ bool static_order(int nM, int nN, int G, int c, int i, int& pm, int& pn) {
    const int nwg = nM * nN; const long L = (long)i * G + c; if (L >= nwg) return false;
    int wgid = (int)L; { const int q = nwg / NXCD, r = nwg % NXCD, xcd = wgid % NXCD, off = wgid / NXCD; wgid = (xcd < r ? xcd * (q + 1) : r * (q + 1) + (xcd - r) * q) + off; }
    const int nig = WGM * nN, gid = wgid / nig, fm = gid * WGM, gsz = (nM - fm) < WGM ? (nM - fm) : WGM;
    pm = fm + ((wgid % nig) % gsz); pn = (wgid % nig) / gsz; return true;
}
struct DenseSched { const char* A; const char* Bt; size_t ldaB, ldbB; int nM, nN, G, c;
    __device__ __forceinline__ bool next(int i, GUnit& u) const { int pm, pn; if (!static_order(nM, nN, G, c, i, pm, pn)) return false;
        u.A = A + (size_t)pm * 256 * ldaB; u.B = Bt + (size_t)pn * 256 * ldbB; u.rl = nullptr; u.nvalid = 0; u.erow0 = pm * 256; u.ecol0 = pn * 256; u.x0 = 0; u.xp = nullptr; return true; } };

template <bool GATHER, class Epi, class Sched>
__device__ __forceinline__ void gemm_phase(LAS unsigned char* lds, unsigned ldaB, int K, const Sched& S, const Epi& E) {
    const int tid = threadIdx.x, wid = __builtin_amdgcn_readfirstlane(tid >> 6), lane = tid & 63, wr = wid >> 2, wc = wid & 3, fr = lane & 15, fq = lane >> 4;
    const int nt = K / BK;
    int R0, C0, R1, C1; stage_rc(tid * 16, R0, C0); stage_rc(tid * 16 + 8192, R1, C1);
    unsigned voffB[2]; voffB[0] = (unsigned)(R0 * K + C0) * 2u; voffB[1] = (unsigned)(R1 * K + C1) * 2u;
    unsigned ac0[2], ac1[2], an0[2], an1[2];
    const size_t kstep = (size_t)(BK * 2);
    const size_t hstepB = (size_t)HALF * K * 2;
    const unsigned ldsw = (unsigned)wid * 1024u;
    const int aoff = lds_byte(wr * 64 + fr, fq * 8), boff = lds_byte(wc * 32 + fr, fq * 8);
#define G8_SA(b, h) (((b) * 2 + (h)) * HTB)
#define G8_SB(b, h) ((4 + (b) * 2 + (h)) * HTB)
#define G8_STAGE(bufoff, gbase, voff) do { _Pragma("unroll") for (int _i = 0; _i < 2; ++_i) \
        __builtin_amdgcn_global_load_lds((const unsigned*)((const char*)(gbase) + (voff)[_i]), (LAS unsigned*)(lds + (bufoff) + ldsw + _i * 8192), 16, 0, 0); } while (0)
#define G8_LDA(dst, b, h) do { _Pragma("unroll") for (int m = 0; m < 4; ++m) _Pragma("unroll") for (int k = 0; k < 2; ++k) dst[m][k] = *(const LAS bf16x8*)(lds + G8_SA(b, h) + aoff + m * 2048 + k * 1024); } while (0)
#define G8_LDB(dst, b, h) do { _Pragma("unroll") for (int n = 0; n < 2; ++n) _Pragma("unroll") for (int k = 0; k < 2; ++k) dst[n][k] = *(const LAS bf16x8*)(lds + G8_SB(b, h) + boff + n * 2048 + k * 1024); } while (0)
#define G8_MMA(ai, bj, At, Bt) do { __builtin_amdgcn_s_setprio(1); _Pragma("unroll") for (int m = 0; m < 4; ++m) _Pragma("unroll") for (int n = 0; n < 2; ++n) _Pragma("unroll") for (int k = 0; k < 2; ++k) \
        acc[ai][bj][m][n] = __builtin_amdgcn_mfma_f32_16x16x32_bf16(Bt[n][k], At[m][k], acc[ai][bj][m][n], 0, 0, 0); __builtin_amdgcn_s_setprio(0); } while (0)
#define G8_WAIT_V(n) asm volatile("s_waitcnt vmcnt(" #n ")" ::: "memory")
#define G8_WAIT_L(n) asm volatile("s_waitcnt lgkmcnt(" #n ")" ::: "memory")
#define G8_BAR __builtin_amdgcn_s_barrier()
#define G8_SCHED __builtin_amdgcn_sched_barrier(0)
#define G8_XLOAD(u) __builtin_amdgcn_global_load_lds((const unsigned*)((u).rl + lane * 4), (LAS unsigned*)(lds + STAGE_BYTES + wid * 1024), 16, 0, 0)
#define G8_AOFF(u, o0, o1) do { if (GATHER) { const LAS int* _rs = (const LAS int*)(lds + STAGE_BYTES + wid * 1024); const int _nv = (u).nvalid - 1; \
        const int _r00 = _rs[min(R0, _nv)], _r01 = _rs[min(R1, _nv)], _r10 = _rs[min(128 + R0, _nv)], _r11 = _rs[min(128 + R1, _nv)]; \
        o0[0] = (unsigned)_r00 * ldaB + (unsigned)C0 * 2u; o0[1] = (unsigned)_r01 * ldaB + (unsigned)C1 * 2u; o1[0] = (unsigned)_r10 * ldaB + (unsigned)C0 * 2u; o1[1] = (unsigned)_r11 * ldaB + (unsigned)C1 * 2u; \
    } else { o0[0] = (unsigned)R0 * ldaB + (unsigned)C0 * 2u; o0[1] = (unsigned)R1 * ldaB + (unsigned)C1 * 2u; o1[0] = (unsigned)(128 + R0) * ldaB + (unsigned)C0 * 2u; o1[1] = (unsigned)(128 + R1) * ldaB + (unsigned)C1 * 2u; } } while (0)
    GUnit cur, nxt; int ui = 0;
    if (!S.next(0, cur)) return;
    f32x4 acc[2][2][4][2];
#pragma unroll
    for (int a = 0; a < 2; ++a)
#pragma unroll
        for (int b = 0; b < 2; ++b)
#pragma unroll
            for (int m = 0; m < 4; ++m)
#pragma unroll
                for (int n = 0; n < 2; ++n) acc[a][b][m][n] = (f32x4){0.f, 0.f, 0.f, 0.f};
    bf16x8 At[4][2], B0[2][2], B1[2][2];
    if (GATHER) { G8_XLOAD(cur); G8_WAIT_V(0); }
    G8_AOFF(cur, ac0, ac1);
    if (GATHER) { G8_WAIT_L(0); }
    const char* cA = cur.A; const char* cB = cur.B;
    G8_STAGE(G8_SB(0, 0), cB, voffB); G8_STAGE(G8_SB(0, 1), cB + hstepB, voffB); G8_STAGE(G8_SA(0, 0), cA, ac0); G8_STAGE(G8_SA(0, 1), cA, ac1);
    if (wr == 1) G8_BAR;
    G8_WAIT_V(2); G8_BAR;
    G8_STAGE(G8_SB(1, 0), cB + kstep, voffB); G8_STAGE(G8_SA(1, 0), cA + kstep, ac0); G8_STAGE(G8_SB(1, 1), cB + hstepB + kstep, voffB);
    G8_WAIT_V(6); G8_BAR;
    for (;;) {
        const bool has_next = S.next(ui + 1, nxt);
        const char* nA = has_next ? nxt.A : cA; const char* nB = has_next ? nxt.B : cB;
        an0[0] = ac0[0]; an0[1] = ac0[1]; an1[0] = ac1[0]; an1[1] = ac1[1];
        const bool xload = GATHER && has_next;
        if (xload) { G8_XLOAD(nxt); }
#pragma unroll 1
        for (int t = 0; t < nt; t += 2) {
            const bool last = (t == nt - 2);
            const char* a1 = cA + (size_t)(t + 1) * kstep;
            const char* a2 = last ? nA : cA + (size_t)(t + 2) * kstep; const char* b2 = last ? nB : cB + (size_t)(t + 2) * kstep;
            const char* a3 = a2 + kstep; const char* b3 = b2 + kstep;
            unsigned* x0 = last ? an0 : ac0; unsigned* x1 = last ? an1 : ac1;
            unsigned s0[2], s1[2]; s0[0] = x0[0]; s0[1] = x0[1]; s1[0] = x1[0]; s1[1] = x1[1];
            G8_LDB(B0, 0, 0); G8_LDB(B1, 0, 1); G8_SCHED; G8_LDA(At, 0, 0); G8_STAGE(G8_SA(1, 1), a1, ac1);
            if (xload && t == 0) { G8_WAIT_V(9); } else { G8_WAIT_V(8); }
            G8_WAIT_L(0); G8_BAR; G8_MMA(0, 0, At, B0); G8_MMA(0, 1, At, B1); G8_BAR; G8_SCHED;
            G8_LDA(At, 0, 1); G8_STAGE(G8_SB(0, 0), b2, voffB); G8_STAGE(G8_SB(0, 1), b2 + hstepB, voffB); G8_STAGE(G8_SA(0, 0), a2, s0);
            G8_WAIT_V(8); G8_WAIT_L(0); G8_BAR; G8_MMA(1, 0, At, B0); G8_MMA(1, 1, At, B1); G8_BAR; G8_SCHED;
            if (xload && t == 0) { G8_AOFF(nxt, an0, an1); }
            G8_LDB(B0, 1, 0); G8_LDB(B1, 1, 1); G8_SCHED; G8_LDA(At, 1, 0); G8_STAGE(G8_SA(0, 1), a2, s1);
            G8_WAIT_V(8); G8_WAIT_L(0); G8_BAR; G8_MMA(0, 0, At, B0); G8_MMA(0, 1, At, B1); G8_BAR; G8_SCHED;
            G8_LDA(At, 1, 1); G8_STAGE(G8_SB(1, 0), b3, voffB); G8_STAGE(G8_SB(1, 1), b3 + hstepB, voffB); G8_STAGE(G8_SA(1, 0), a3, s0);
            G8_WAIT_V(8); G8_WAIT_L(0); G8_BAR; G8_MMA(1, 0, At, B0); G8_MMA(1, 1, At, B1); G8_BAR; G8_SCHED;
        }
        if (wr == 0) G8_BAR;
#pragma unroll
        for (int ai = 0; ai < 2; ++ai)
#pragma unroll
            for (int m = 0; m < 4; ++m)
#pragma unroll
                for (int n = 0; n < 2; ++n) E(cur, cur.erow0 + ai * HALF + wr * 64 + m * 16 + fr, cur.ecol0 + wc * 32 + n * 16 + 4 * fq, acc[ai][0][m][n], acc[ai][1][m][n]);
        if (!has_next) break;
#pragma unroll
        for (int a = 0; a < 2; ++a)
#pragma unroll
            for (int b = 0; b < 2; ++b)
#pragma unroll
                for (int m = 0; m < 4; ++m)
#pragma unroll
                    for (int n = 0; n < 2; ++n) acc[a][b][m][n] = (f32x4){0.f, 0.f, 0.f, 0.f};
        cur = nxt; cA = nA; cB = nB; ++ui;
        ac0[0] = an0[0]; ac0[1] = an0[1]; ac1[0] = an1[0]; ac1[1] = an1[1];
        if (wr == 1) G8_BAR;
    }
    G8_WAIT_V(0);
    G8_BAR;
#undef G8_SA
#undef G8_SB
#undef G8_STAGE
#undef G8_LDA
#undef G8_LDB
#undef G8_MMA
#undef G8_WAIT_V
#undef G8_WAIT_L
#undef G8_BAR
#undef G8_SCHED
#undef G8_AOFF
#undef G8_XLOAD
}
}
template <class Epi>
__device__ __forceinline__ void dgemm_phase(const Ctx& c, const bf16* A, int lda, int M, const bf16* Bt, int ntn, int K, const Epi& E, int G = -1, int cid = -1) {
    g8::DenseSched S{(const char*)A, (const char*)Bt, (size_t)lda * 2, (size_t)K * 2, M / 256, ntn, G < 0 ? c.nblk : G, cid < 0 ? c.bid : cid};
    g8::gemm_phase<false>(c.lds, (unsigned)lda * 2u, K, S, E);
    __syncthreads();
}

struct EpiInPB { bf16* PB; float* SM;
    __device__ __forceinline__ void operator()(int row, int col, f32x4 lo, f32x4 hi) const {
        st_bf4(PB + (size_t)row * NPB + col, lo);
        if ((col >> 8) == 7) *(f32x4*)(SM + (size_t)row * 128 + (col & 127)) = hi;
        else st_bf4(PB + (size_t)row * NPB + col + 128, hi);
    } };
struct EpiQ { bf16* QLAT; bf16* QIDX; const float* rstd;
    __device__ __forceinline__ void operator()(int row, int col, f32x4 lo, f32x4 hi) const {
        const float r = rstd[row];
        if (col < 1024) { st_bf4(QLAT + (size_t)row * 1024 + col, lo * r); st_bf4(QLAT + (size_t)row * 1024 + col + 128, hi * r); }
        else { st_bf4(QIDX + (size_t)row * 256 + (col - 1024), lo * r); st_bf4(QIDX + (size_t)row * 256 + (col - 1024) + 128, hi * r); }
    } };
struct EpiGate { bf16* G;
    __device__ __forceinline__ void operator()(int row, int col, f32x4 lo, f32x4 hi) const {
        f32x4 a, b;
#pragma unroll
        for (int i = 0; i < 4; ++i) { a[i] = sigmoidf_(lo[i]); b[i] = sigmoidf_(hi[i]); }
        st_bf4(G + (size_t)row * NG + col, a); st_bf4(G + (size_t)row * NG + col + 128, b);
    } };
struct EpiUp { bf16* M1; const bf16* G; int goff; int first;
    __device__ __forceinline__ void operator()(int row, int col, f32x4 lo, f32x4 hi) const {
        bf16* m = M1 + (size_t)row * 1024 + col; const bf16* g = G + (size_t)row * NG + goff + col;
        f32x4 a = ld_bf4(g) * lo, b = ld_bf4(g + 128) * hi;
        if (!first) { a += ld_bf4_l2(m); b += ld_bf4_l2(m + 128); }
        st_bf4(m, a); st_bf4(m + 128, b);
    } };
struct EpiWo { const float* res; float* out; const float* g1;
    __device__ __forceinline__ void operator()(int row, int col, f32x4 lo, f32x4 hi) const {
        const float* gp = g1 + (size_t)(row >> 11) * 6144 + col; const size_t o = (size_t)row * 1024 + col;
        const f32x4 ga = *(const f32x4*)gp, gb = *(const f32x4*)(gp + 128);
        const f32x4 ra = *(const f32x4*)(res + o), rb = *(const f32x4*)(res + o + 128);
        *(f32x4*)(out + o) = ra + ga * lo; *(f32x4*)(out + o + 128) = rb + gb * hi;
    } };
struct EpiG1 { bf16* HID; const float* wl; int cnt; int orow0;
    __device__ __forceinline__ void operator()(int row, int col, f32x4 lo, f32x4 hi) const {
        const int hc = col - 128 * (col >> 8);
        f32x4 v = (f32x4){0.f, 0.f, 0.f, 0.f};
        if (row < cnt) { const float w = wl ? wl[row] : 1.f;
#pragma unroll
            for (int i = 0; i < 4; ++i) v[i] = siluf_(lo[i]) * hi[i] * w; }
        st_bf4(HID + (size_t)(orow0 + row) * 256 + hc, v);
    } };
struct EpiG2 { bf16* Y; int orow0;
    __device__ __forceinline__ void operator()(int row, int col, f32x4 lo, f32x4 hi) const {
        st_bf4(Y + (size_t)(orow0 + row) * 1024 + col, lo); st_bf4(Y + (size_t)(orow0 + row) * 1024 + col + 128, hi);
    } };


template <class F> struct EpiU { F f; __device__ __forceinline__ void operator()(const g8::GUnit&, int row, int col, f32x4 lo, f32x4 hi) const { f(row, col, lo, hi); } };

__device__ __forceinline__ void phase_prologue(const Ctx& c) {
    {
        LAS float* cs = (LAS float*)c.lds;
        LAS float* red = (LAS float*)(c.lds + 65536);
        const float* cin = c.in[IN_C];
        if (c.bid < 192) {
            for (int i = c.tid; i < 16 * 1024; i += NTHR) cs[i] = siluf_(cin[i]);
            __syncthreads();
        }
        float* MOD = (float*)(c.ws + WS_MOD);
        for (int it = c.bid; it < 192; it += c.nblk) {
            const int l = it / 96, cg = it % 96, col = cg * 64 + c.lane;
            const float* W = c.in[IN_ADAW] + (size_t)l * 1024 * 6144 + col;
            float acc[16];
#pragma unroll
            for (int b = 0; b < 16; ++b) acc[b] = 0.f;
            const int kbeg = c.wave * 128;
            for (int k = kbeg; k < kbeg + 128; k += 4) {
                const float w0 = W[(size_t)k * 6144], w1 = W[(size_t)(k + 1) * 6144], w2 = W[(size_t)(k + 2) * 6144], w3 = W[(size_t)(k + 3) * 6144];
#pragma unroll
                for (int b = 0; b < 16; ++b) { const f32x4 v = *(const LAS f32x4*)(cs + b * 1024 + k); acc[b] += v[0] * w0 + v[1] * w1 + v[2] * w2 + v[3] * w3; }
            }
#pragma unroll
            for (int b = 0; b < 16; ++b) red[(c.wave * 16 + b) * 64 + c.lane] = acc[b];
            __syncthreads();
            for (int i = c.tid; i < 16 * 64; i += NTHR) { const int b = i >> 6, ln = i & 63; float s = 0.f;
#pragma unroll
                for (int w = 0; w < 8; ++w) s += red[(w * 16 + b) * 64 + ln];
                MOD[((size_t)l * 16 + b) * 6144 + cg * 64 + ln] = s + c.in[IN_ADAB][l * 6144 + cg * 64 + ln]; }
            __syncthreads();
        }
        __syncthreads();
    }
    {
        LAS float* scr = (LAS float*)(c.lds + c.wave * 16384);
        const int gw = c.bid * NWAVES + c.wave, NGW = c.nblk * NWAVES;
        constexpr int I_WIN = (NINP / 32) * (1024 / 64), I_UP = (1024 / 32) * (512 / 64), I_WO = (1024 / 32) * (1024 / 64);
        constexpr int PER_L = I_WIN + 2 * I_UP + I_WO;
        for (int it = gw; it < NL * PER_L; it += NGW) {
            const int l = it / PER_L; int r = it % PER_L;
            if (r < I_WIN) { SrcWin s{c.in[IN_WIN] + (size_t)l * 1024 * NIN, NIN}; tr_item(s, (bf16*)(c.ws + WS_WIN) + (size_t)l * NINP * 1024, 1024, (r / 16) * 32, (r % 16) * 64, scr, c.lane); continue; }
            r -= I_WIN;
            if (r < I_UP) { SrcPlain s{c.in[IN_WUPA] + (size_t)l * 512 * 1024, 1024}; tr_item(s, (bf16*)(c.ws + WS_WUPA) + (size_t)l * 1024 * 512, 512, (r / 8) * 32, (r % 8) * 64, scr, c.lane); continue; }
            r -= I_UP;
            if (r < I_UP) { SrcPlain s{c.in[IN_WUPC] + (size_t)l * 512 * 1024, 1024}; tr_item(s, (bf16*)(c.ws + WS_WUPC) + (size_t)l * 1024 * 512, 512, (r / 8) * 32, (r % 8) * 64, scr, c.lane); continue; }
            r -= I_UP;
            { SrcPlain s{c.in[IN_WO] + (size_t)l * 1024 * 1024, 1024}; tr_item(s, (bf16*)(c.ws + WS_WO) + (size_t)l * 1024 * 1024, 1024, (r / 16) * 32, (r % 16) * 64, scr, c.lane); }
        }
    }
    {
        const int gt = c.bid * NTHR + c.tid, NGT = c.nblk * NTHR;
        for (int i = gt; i < T; i += NGT) ((int*)(c.ws + WS_IDENT))[i] = i;
        for (int it = gt; it < NL * 1280 * 32; it += NGT) {
            const int l = it / (1280 * 32), rem = it % (1280 * 32), n = rem / 32, r0 = (rem % 32) * 8;
            const float* gq = c.in[IN_DSA_NQ] + l * 256;
            float o[8];
            if (n < 1024) {
                const int h = n >> 7, cc = n & 127;
                const float* uk = c.in[IN_DSA_WUK] + (size_t)l * 128 * 512 + (size_t)cc * 512 + h * 64;
#pragma unroll
                for (int i = 0; i < 8; ++i) { const float* uq = c.in[IN_DSA_WUQ] + (size_t)l * 256 * 512 + (size_t)(r0 + i) * 512 + h * 64; float s = 0.f;
                    for (int d = 0; d < 64; ++d) s += uq[d] * uk[d];
                    o[i] = s * (0.125f * 1.4426950408889634f) * gq[r0 + i]; }
            } else {
                const int m = n - 1024;
#pragma unroll
                for (int i = 0; i < 8; ++i) o[i] = c.in[IN_DSA_WQI][(size_t)l * 256 * 256 + (size_t)(r0 + i) * 256 + m] * 0.17677669529663687f * gq[r0 + i];
            }
            u32x4 w; w.x = pk2(o[0], o[1]); w.y = pk2(o[2], o[3]); w.z = pk2(o[4], o[5]); w.w = pk2(o[6], o[7]);
            *(u32x4*)((bf16*)(c.ws + WS_WQ) + (size_t)l * 1280 * 256 + (size_t)n * 256 + r0) = w;
        }
    }
    {
        const int gt = c.bid * NTHR + c.tid, NGT = c.nblk * NTHR;
        for (int it = gt; it < NL * 128 * 1024; it += NGT) {
            const int l = it / (128 * 1024), rem = it % (128 * 1024), kc = rem / 1024, n = rem % 1024;
            const int h = kc >> 4, r0 = (kc & 15) * 8;
            const float* uv = c.in[IN_DSA_WUV] + (size_t)l * 128 * 512;
            const float* ub = c.in[IN_WUPB] + (size_t)l * 512 * 1024 + (size_t)(h * 64) * 1024 + n;
            float o[8];
#pragma unroll
            for (int i = 0; i < 8; ++i) o[i] = 0.f;
            for (int v = 0; v < 64; ++v) { const float b = ub[(size_t)v * 1024];
#pragma unroll
                for (int i = 0; i < 8; ++i) o[i] += uv[(size_t)(r0 + i) * 512 + h * 64 + v] * b; }
            u32x4 w; w.x = pk2(o[0], o[1]); w.y = pk2(o[2], o[3]); w.z = pk2(o[4], o[5]); w.w = pk2(o[6], o[7]);
            *(u32x4*)((bf16*)(c.ws + WS_WUVB) + (size_t)l * 1024 * 1024 + (size_t)n * 1024 + h * 128 + r0) = w;
        }
    }
}

__device__ __forceinline__ void norm_mod_row(const float* xrow, const float* gain, const float* sh, const float* sc, bf16* orow, int lane) {
    f32x4 v[4]; float s = 0.f;
#pragma unroll
    for (int j = 0; j < 4; ++j) { v[j] = *(const f32x4*)(xrow + 4 * (lane + 64 * j)); s += v[j][0] * v[j][0] + v[j][1] * v[j][1] + v[j][2] * v[j][2] + v[j][3] * v[j][3]; }
    const float rstd = rsqrtf(wave_sum(s) * (1.f / D) + EPS);
#pragma unroll
    for (int j = 0; j < 4; ++j) { const int cc = 4 * (lane + 64 * j);
        const f32x4 g = *(const f32x4*)(gain + cc), a = *(const f32x4*)(sc + cc), b = *(const f32x4*)(sh + cc);
        st_bf4(orow + cc, v[j] * rstd * g * (a + 1.f) + b); }
}
__device__ __forceinline__ void phase_norm1(const Ctx& c, int l, const float* xsrc) {
    const int gw = c.bid * NWAVES + c.wave, NGW = c.nblk * NWAVES;
    const float* MOD = (const float*)(c.ws + WS_MOD) + (size_t)l * 16 * 6144;
    bf16* XN = (bf16*)(c.ws + WS_XN);
    for (int t = gw; t < T; t += NGW) { const int b = t >> 11;
        norm_mod_row(xsrc + (size_t)t * D, c.in[IN_NMIX] + l * D, MOD + (size_t)b * 6144, MOD + (size_t)b * 6144 + 1024, XN + (size_t)t * D, c.lane); }
}

__device__ __forceinline__ void phase_prep(const Ctx& c, int l) {
    const int gw = c.bid * NWAVES + c.wave, NGW = c.nblk * NWAVES;
    const bf16* PB = (const bf16*)(c.ws + WS_PB); const float* SM = (const float*)(c.ws + WS_SM);
    bf16* CKVN = (bf16*)(c.ws + WS_CKVN); bf16* KIDX = (bf16*)(c.ws + WS_KIDX); float* RSTDQ = (float*)(c.ws + WS_RSTDQ);
    const float* gkv = c.in[IN_DSA_NKV] + l * 128;
    const float g0 = gkv[2 * c.lane], g1 = gkv[2 * c.lane + 1];
    for (int t = gw; t < T; t += NGW) {
        const bf16* row = PB + (size_t)t * NPB;
        const unsigned kv = *(const unsigned*)(row + PB_CKV + 2 * c.lane);
        const float k0 = bflo(kv), k1 = bfhi(kv);
        const float rs = rsqrtf(wave_sum(k0 * k0 + k1 * k1) * (1.f / 128.f) + EPS);
        *(unsigned*)(CKVN + (size_t)t * 128 + 2 * c.lane) = pk2(k0 * rs * g0, k1 * rs * g1);
        const f32x4 q = ld_bf4(row + PB_CQ + 4 * c.lane);
        const float rq = rsqrtf(wave_sum(q[0] * q[0] + q[1] * q[1] + q[2] * q[2] + q[3] * q[3]) * (1.f / 256.f) + EPS);
        if (c.lane == 0) RSTDQ[t] = rq;
        if (c.lane < 32) KIDX[(size_t)t * 32 + c.lane] = (bf16)f2bf(SM[(size_t)t * 128 + SM_KIDX + c.lane]);
    }
}
__device__ __forceinline__ void phase_ckvt(const Ctx& c) {
    const bf16* CKVN = (const bf16*)(c.ws + WS_CKVN); bf16* CKVT = (bf16*)(c.ws + WS_CKVT);
    LAS bf16* tile = (LAS bf16*)c.lds;
    for (int it = c.bid; it < T / 64; it += c.nblk) {
        const int tb = it * 64, b = tb >> 11, p0 = tb & 2047;
        __syncthreads();
        { const int r = c.tid >> 3, ch = (c.tid & 7) * 8;
          *(LAS u32x4*)(tile + r * 136 + ch) = *(const u32x4*)(CKVN + (size_t)(tb + r) * 128 + ch); *(LAS u32x4*)(tile + r * 136 + 64 + ch) = *(const u32x4*)(CKVN + (size_t)(tb + r) * 128 + 64 + ch); }
        __syncthreads();
        { const int r = c.tid >> 2, part = c.tid & 3;
          unsigned w[8];
#pragma unroll
          for (int j = 0; j < 8; ++j) w[j] = (unsigned)tile[(16 * part + 2 * j) * 136 + r] | ((unsigned)tile[(16 * part + 2 * j + 1) * 136 + r] << 16);
          bf16* dst = CKVT + (((size_t)b * 32 + (p0 >> 6)) * 128 + r) * 64 + 16 * part;
          *(u32x4*)dst = (u32x4){w[0], w[1], w[2], w[3]}; *(u32x4*)(dst + 8) = (u32x4){w[4], w[5], w[6], w[7]}; }
    }
    __syncthreads();
}

constexpr int TS = 16;
__device__ __forceinline__ void scan_gla_item(const Ctx& c, int l, int b, int h) {
    LAS float* q_s = (LAS float*)c.lds;
    LAS float* k_s = q_s + TS * 64;
    LAS float* a_s = k_s + TS * 64;
    LAS float* v_s = a_s + TS * 64;
    LAS float* part = v_s + TS * 128;
    LAS float* wa2 = part + TS * 4 * 128;
    LAS float* ba = wa2 + 16 * 64;
    LAS float* alr = ba + 64;
    const bf16* PB = (const bf16*)(c.ws + WS_PB); const float* SM = (const float*)(c.ws + WS_SM);
    bf16* UA = (bf16*)(c.ws + WS_UA);
    const float* gn = c.in[IN_GLA_NORM] + l * 512 + h * 128;
    for (int i = c.tid; i < 16 * 64; i += NTHR) wa2[i] = c.in[IN_GLA_WA2][(size_t)l * 16 * 256 + (i >> 6) * 256 + h * 64 + (i & 63)];
    if (c.tid < 64) ba[c.tid] = c.in[IN_GLA_BA][l * 256 + h * 64 + c.tid];
    const int v = c.tid & 127, kg = c.tid >> 7;
    float S[16];
#pragma unroll
    for (int i = 0; i < 16; ++i) S[i] = 0.f;
    for (int t0 = 0; t0 < SEQ; t0 += TS) {
        __syncthreads();
        const size_t rb = (size_t)b * SEQ + t0;
        for (int i = c.tid; i < TS * 64; i += NTHR) { const int s = i >> 6, cc = i & 63; const bf16* row = PB + (rb + s) * NPB;
            q_s[i] = bf2f(row[PB_QA + h * 64 + cc]) * 0.125f; k_s[i] = bf2f(row[PB_KA + h * 64 + cc]); }
        for (int i = c.tid; i < TS * 128; i += NTHR) { const int s = i >> 7, cc = i & 127; v_s[i] = bf2f(PB[(rb + s) * NPB + PB_VA + h * 128 + cc]); }
        if (c.tid < TS * 16) alr[c.tid] = SM[(rb + (c.tid >> 4)) * 128 + SM_ALR + (c.tid & 15)];
        __syncthreads();
        for (int i = c.tid; i < TS * 64; i += NTHR) { const int s = i >> 6, cc = i & 63; float x = ba[cc];
#pragma unroll
            for (int j = 0; j < 16; ++j) x += alr[s * 16 + j] * wa2[j * 64 + cc];
            a_s[i] = __expf(logsigmoidf_(x) * (1.f / 16.f)); }
        __syncthreads();
#pragma unroll 1
        for (int s = 0; s < TS; ++s) {
            const float vv = v_s[s * 128 + v]; float acc = 0.f;
#pragma unroll
            for (int i4 = 0; i4 < 4; ++i4) {
                const f32x4 a4 = *(const LAS f32x4*)(a_s + s * 64 + kg * 16 + i4 * 4), k4 = *(const LAS f32x4*)(k_s + s * 64 + kg * 16 + i4 * 4), q4 = *(const LAS f32x4*)(q_s + s * 64 + kg * 16 + i4 * 4);
#pragma unroll
                for (int j = 0; j < 4; ++j) { S[i4 * 4 + j] = a4[j] * S[i4 * 4 + j] + k4[j] * vv; acc += q4[j] * S[i4 * 4 + j]; }
            }
            part[(s * 4 + kg) * 128 + v] = acc;
        }
        __syncthreads();
        {
            const int s = c.tid >> 5, vq = c.tid & 31, v0 = vq * 4;
            f32x4 o = (f32x4){0.f, 0.f, 0.f, 0.f};
#pragma unroll
            for (int g = 0; g < 4; ++g) o += *(const LAS f32x4*)(part + (s * 4 + g) * 128 + v0);
            float ss = o[0] * o[0] + o[1] * o[1] + o[2] * o[2] + o[3] * o[3];
#pragma unroll
            for (int m = 1; m < 32; m <<= 1) ss += __shfl_xor(ss, m);
            const float rstd = rsqrtf(ss * (1.f / 128.f) + EPS);
            const f32x4 ga = ld_bf4(PB + (rb + s) * NPB + PB_GA + h * 128 + v0);
            f32x4 r;
#pragma unroll
            for (int j = 0; j < 4; ++j) r[j] = o[j] * rstd * gn[v0 + j] * siluf_(ga[j]);
            st_bf4(UA + (rb + s) * 512 + h * 128 + v0, r);
        }
    }
    __syncthreads();
}
__device__ __forceinline__ void scan_mlstm_item(const Ctx& c, int l, int b, int h) {
    LAS float* q_s = (LAS float*)c.lds;
    LAS float* k_s = q_s + TS * 64;
    LAS float* v_s = k_s + TS * 64;
    LAS float* part = v_s + TS * 128;
    LAS float* dpart = part + TS * 4 * 128;
    LAS float* lf_s = dpart + TS * 4;
    LAS float* ip_s = lf_s + TS;
    LAS float* m_s = ip_s + TS;
    LAS float* cw = m_s + TS;
    const bf16* PB = (const bf16*)(c.ws + WS_PB); const float* SM = (const float*)(c.ws + WS_SM);
    bf16* UC = (bf16*)(c.ws + WS_UC);
    const float* mn = c.in[IN_ML_NORM] + l * 512 + h * 128;
    if (c.tid < 4 * 128) { const int j = c.tid >> 7, cc = c.tid & 127; cw[c.tid] = c.in[IN_ML_CONV][(size_t)l * 4 * 512 + j * 512 + (cc < 64 ? h * 64 + cc : 256 + h * 64 + (cc - 64))]; }
    const float bi = c.in[IN_ML_BI][l * 4 + h], bfv = c.in[IN_ML_BF][l * 4 + h];
    const int v = c.tid & 127, kg = c.tid >> 7;
    float C[16], n[16]; float m = 0.f;
#pragma unroll
    for (int i = 0; i < 16; ++i) { C[i] = 0.f; n[i] = 0.f; }
    for (int t0 = 0; t0 < SEQ; t0 += TS) {
        __syncthreads();
        const size_t rb = (size_t)b * SEQ + t0;
        for (int i = c.tid; i < TS * 128; i += NTHR) { const int s = i >> 7, cc = i & 127;
            const int col = cc < 64 ? PB_QC + h * 64 + cc : PB_KC + h * 64 + (cc - 64);
            float x = 0.f;
#pragma unroll
            for (int j = 0; j < 4; ++j) { const int tt = t0 + s - 3 + j; if (tt >= 0) x += cw[j * 128 + cc] * bf2f(PB[((size_t)b * SEQ + tt) * NPB + col]); }
            x = siluf_(x);
            if (cc < 64) q_s[s * 64 + cc] = x * 0.125f; else k_s[s * 64 + (cc - 64)] = x; }
        for (int i = c.tid; i < TS * 128; i += NTHR) { const int s = i >> 7, cc = i & 127; v_s[i] = bf2f(PB[(rb + s) * NPB + PB_VC + h * 128 + cc]); }
        if (c.tid < TS) { ip_s[c.tid] = SM[(rb + c.tid) * 128 + SM_IC + h] + bi; lf_s[c.tid] = logsigmoidf_(SM[(rb + c.tid) * 128 + SM_FC + h] + bfv); }
        __syncthreads();
#pragma unroll 1
        for (int s = 0; s < TS; ++s) {
            const float lf = lf_s[s], ip = ip_s[s];
            const float mnew = fmaxf(lf + m, ip), fg = __expf(lf + m - mnew), ig = __expf(ip - mnew);
            m = mnew;
            const float vv = v_s[s * 128 + v] * ig; float num = 0.f, den = 0.f;
#pragma unroll
            for (int i4 = 0; i4 < 4; ++i4) {
                const f32x4 k4 = *(const LAS f32x4*)(k_s + s * 64 + kg * 16 + i4 * 4), q4 = *(const LAS f32x4*)(q_s + s * 64 + kg * 16 + i4 * 4);
#pragma unroll
                for (int j = 0; j < 4; ++j) { C[i4 * 4 + j] = fg * C[i4 * 4 + j] + k4[j] * vv; n[i4 * 4 + j] = fg * n[i4 * 4 + j] + ig * k4[j]; num += q4[j] * C[i4 * 4 + j]; den += q4[j] * n[i4 * 4 + j]; }
            }
            part[(s * 4 + kg) * 128 + v] = num;
            if (v == 0) dpart[s * 4 + kg] = den;
            if (c.tid == 0) m_s[s] = m;
        }
        __syncthreads();
        {
            const int s = c.tid >> 5, vq = c.tid & 31, v0 = vq * 4;
            f32x4 o = (f32x4){0.f, 0.f, 0.f, 0.f};
#pragma unroll
            for (int g = 0; g < 4; ++g) o += *(const LAS f32x4*)(part + (s * 4 + g) * 128 + v0);
            const float den = dpart[s * 4] + dpart[s * 4 + 1] + dpart[s * 4 + 2] + dpart[s * 4 + 3];
            const float dd = 1.f / fmaxf(fabsf(den), __expf(-m_s[s]));
            o = o * dd;
            float ss = o[0] * o[0] + o[1] * o[1] + o[2] * o[2] + o[3] * o[3];
#pragma unroll
            for (int mm = 1; mm < 32; mm <<= 1) ss += __shfl_xor(ss, mm);
            const float rstd = rsqrtf(ss * (1.f / 128.f) + EPS);
            const f32x4 oc = ld_bf4(PB + (rb + s) * NPB + PB_OC + h * 128 + v0);
            f32x4 r;
#pragma unroll
            for (int j = 0; j < 4; ++j) r[j] = o[j] * rstd * mn[v0 + j] * sigmoidf_(oc[j]);
            st_bf4(UC + (rb + s) * 512 + h * 128 + v0, r);
        }
    }
    __syncthreads();
}

constexpr int LQ = 72;
constexpr int SC_QT = 0, SC_KT = 9216, SC_KTT = 18432, SC_Q2 = 27648, SC_SC = 36864, SC_VT = 46080, SC_ST = 66816, SC_FL = 108288;
__device__ __forceinline__ float wave_scan_add(float x, int lane) {
#pragma unroll
    for (int d = 1; d < 64; d <<= 1) { const float y = __shfl_up(x, d); if (lane >= d) x += y; }
    return x;
}
__device__ __forceinline__ float wave_scan_max(float x, int lane) {
#pragma unroll
    for (int d = 1; d < 64; d <<= 1) { const float y = __shfl_up(x, d); if (lane >= d) x = fmaxf(x, y); }
    return x;
}
__device__ __forceinline__ void unpack8(u32x4 w, float (&f)[8]) { f[0] = bflo(w.x); f[1] = bfhi(w.x); f[2] = bflo(w.y); f[3] = bfhi(w.y); f[4] = bflo(w.z); f[5] = bfhi(w.z); f[6] = bflo(w.w); f[7] = bfhi(w.w); }
__device__ __forceinline__ u32x4 pack8(const float (&f)[8]) { u32x4 w; w.x = pk2(f[0], f[1]); w.y = pk2(f[2], f[3]); w.z = pk2(f[4], f[5]); w.w = pk2(f[6], f[7]); return w; }
template <bool ML>
__device__ __forceinline__ void scan_chunked_item(const Ctx& c, int l, int b, int h) {
    LAS bf16* Qt0 = (LAS bf16*)(c.lds + SC_QT); LAS bf16* Kt0 = (LAS bf16*)(c.lds + SC_KT); LAS bf16* KtT0 = (LAS bf16*)(c.lds + SC_KTT);
    LAS bf16* Q20 = (LAS bf16*)(c.lds + SC_Q2); LAS bf16* Sc0 = (LAS bf16*)(c.lds + SC_SC); LAS bf16* VT0 = (LAS bf16*)(c.lds + SC_VT);
    LAS bf16* ST0 = (LAS bf16*)(c.lds + SC_ST);
    LAS float* segtot = (LAS float*)(c.lds + SC_FL);
    LAS float* etot = segtot + 512;
    LAS float* ssq = etot + 64;
    LAS float* dn = ssq + 512;
    LAS float* wa2 = dn + 64;
    LAS float* ba = wa2 + 1024;
    LAS float* cw = ba + 64;
    const int tid = c.tid, lane = c.lane, w = c.wave, fr = lane & 15, fq = lane >> 4;
    const int srow = tid >> 3, kg = tid & 7, k8 = kg * 8, vrow = tid >> 4, vc8 = (tid & 15) * 8;
    const bf16* PB = (const bf16*)(c.ws + WS_PB); const float* SM = (const float*)(c.ws + WS_SM);
    bf16* UO = (bf16*)(c.ws + (ML ? WS_UC : WS_UA));
    const int QCOL = (ML ? PB_QC : PB_QA) + h * 64, KCOL = (ML ? PB_KC : PB_KA) + h * 64, VCOL = (ML ? PB_VC : PB_VA) + h * 128, GCOL = (ML ? PB_OC : PB_GA) + h * 128;
    const float* gnorm = c.in[ML ? IN_ML_NORM : IN_GLA_NORM] + l * 512 + h * 128;
    __syncthreads();
    if (!ML) { for (int i = tid; i < 1024; i += NTHR) wa2[i] = c.in[IN_GLA_WA2][(size_t)l * 16 * 256 + (i >> 6) * 256 + h * 64 + (i & 63)];
               if (tid < 64) ba[tid] = c.in[IN_GLA_BA][l * 256 + h * 64 + tid]; }
    else { if (tid < 512) { const int j = tid >> 7, cc = tid & 127; cw[tid] = c.in[IN_ML_CONV][(size_t)l * 4 * 512 + j * 512 + (cc < 64 ? h * 64 + cc : 256 + h * 64 + (cc - 64))]; } }
    for (int i = tid; i < 144 * LQ / 2; i += NTHR) ((LAS unsigned*)ST0)[i] = 0u;
    if (ML) { for (int i = tid; i < 16 * LQ; i += NTHR) VT0[128 * LQ + i] = (i < 64) ? (bf16)0x3f80u : (bf16)0u; }
    const float bi = ML ? c.in[IN_ML_BI][l * 4 + h] : 0.f, bfv = ML ? c.in[IN_ML_BF][l * 4 + h] : 0.f;
    float m_prev = 0.f;
    f32x4 Sacc[4], Nacc = (f32x4){0.f, 0.f, 0.f, 0.f};
#pragma unroll
    for (int i = 0; i < 4; ++i) Sacc[i] = (f32x4){0.f, 0.f, 0.f, 0.f};
    u32x4 rq[ML ? 4 : 1], rk[ML ? 4 : 1], rv[2]; f32x4 ra[4]; float ric = 0.f, rfc = 0.f;
    const u32x4 z4 = (u32x4){0u, 0u, 0u, 0u};
#define SC_LOAD(cch) do { const size_t _g = (size_t)b * SEQ + (size_t)(cch) * 64; \
        if (ML) { _Pragma("unroll") for (int _j = 0; _j < 4; ++_j) { const int _tt = (cch) * 64 + srow - 3 + _j; \
                rq[_j] = _tt >= 0 ? *(const u32x4*)(PB + ((size_t)b * SEQ + _tt) * NPB + QCOL + k8) : z4; rk[_j] = _tt >= 0 ? *(const u32x4*)(PB + ((size_t)b * SEQ + _tt) * NPB + KCOL + k8) : z4; } \
            ric = SM[(_g + lane) * 128 + SM_IC + h]; rfc = SM[(_g + lane) * 128 + SM_FC + h]; } \
        else { rq[0] = *(const u32x4*)(PB + (_g + srow) * NPB + QCOL + k8); rk[0] = *(const u32x4*)(PB + (_g + srow) * NPB + KCOL + k8); \
            _Pragma("unroll") for (int _j = 0; _j < 4; ++_j) ra[_j] = *(const f32x4*)(SM + (_g + srow) * 128 + SM_ALR + 4 * _j); } \
        rv[0] = *(const u32x4*)(PB + (_g + vrow) * NPB + VCOL + vc8); rv[1] = *(const u32x4*)(PB + (_g + 32 + vrow) * NPB + VCOL + vc8); } while (0)
    SC_LOAD(0);
    __syncthreads();
#pragma unroll 1
    for (int cch = 0; cch < SEQ / 64; ++cch) {
        const size_t grow = (size_t)b * SEQ + (size_t)cch * 64;
        int lz; asm volatile("v_mov_b32 %0, 0" : "=v"(lz));
        LAS bf16* Qt = Qt0 + lz; LAS bf16* Kt = Kt0 + lz; LAS bf16* KtT = KtT0 + lz; LAS bf16* Q2 = Q20 + lz; LAS bf16* Sc = Sc0 + lz; LAS bf16* VT = VT0 + lz; LAS bf16* ST = ST0 + lz;
        LAS bf16* STc = ST + (cch & 1) * 144 * LQ; LAS bf16* STn = ST + ((cch & 1) ^ 1) * 144 * LQ;
        float qv[8], kv[8];
        float g_a = 0.f, g_M = 0.f, g_bc = 0.f, M63 = 0.f, wc = 1.f;
        if (!ML) {
            unpack8(rq[0], qv); unpack8(rk[0], kv);
            float la[8];
#pragma unroll
            for (int i = 0; i < 8; ++i) la[i] = ba[k8 + i];
#pragma unroll
            for (int j4 = 0; j4 < 4; ++j4)
#pragma unroll
                for (int jj = 0; jj < 4; ++jj) { const float a = ra[j4][jj]; const LAS float* wr_ = wa2 + (j4 * 4 + jj) * 64 + k8;
                    const f32x4 w0 = *(const LAS f32x4*)wr_, w1 = *(const LAS f32x4*)(wr_ + 4);
                    la[0] += a * w0[0]; la[1] += a * w0[1]; la[2] += a * w0[2]; la[3] += a * w0[3]; la[4] += a * w1[0]; la[5] += a * w1[1]; la[6] += a * w1[2]; la[7] += a * w1[3]; }
#pragma unroll
            for (int i = 0; i < 8; ++i) { float x = logsigmoid_fast(la[i]) * (1.f / 16.f);
#pragma unroll
                for (int d = 8; d < 64; d <<= 1) { const float y = __shfl_up(x, d); if (lane >= d) x += y; }
                la[i] = x; }
            if ((lane >> 3) == 7) { *(LAS f32x4*)(segtot + w * 64 + k8) = (f32x4){la[0], la[1], la[2], la[3]}; *(LAS f32x4*)(segtot + w * 64 + k8 + 4) = (f32x4){la[4], la[5], la[6], la[7]}; }
            lds_barrier();
            float tot[8];
#pragma unroll
            for (int i = 0; i < 8; ++i) tot[i] = 0.f;
#pragma unroll
            for (int ww = 0; ww < 8; ++ww) { const f32x4 s0 = *(const LAS f32x4*)(segtot + ww * 64 + k8), s1 = *(const LAS f32x4*)(segtot + ww * 64 + k8 + 4);
                const float sel = ww < w ? 1.f : 0.f;
                la[0] += sel * s0[0]; la[1] += sel * s0[1]; la[2] += sel * s0[2]; la[3] += sel * s0[3]; la[4] += sel * s1[0]; la[5] += sel * s1[1]; la[6] += sel * s1[2]; la[7] += sel * s1[3];
                tot[0] += s0[0]; tot[1] += s0[1]; tot[2] += s0[2]; tot[3] += s0[3]; tot[4] += s1[0]; tot[5] += s1[1]; tot[6] += s1[2]; tot[7] += s1[3]; }
            if (tid < 8) {
#pragma unroll
                for (int i = 0; i < 8; ++i) etot[k8 + i] = __expf(tot[i]); }
            float kt[8];
#pragma unroll
            for (int i = 0; i < 8; ++i) { qv[i] = qv[i] * 0.125f * __expf(la[i]); kt[i] = kv[i] * __expf(-la[i]); }
            *(LAS u32x4*)(Qt + srow * LQ + k8) = pack8(qv); *(LAS u32x4*)(Kt + srow * LQ + k8) = pack8(kt);
#pragma unroll
            for (int i = 0; i < 8; ++i) KtT[(k8 + i) * LQ + srow] = (bf16)f2bf(kt[i]);
        } else {
            float x4[4][8];
#pragma unroll
            for (int j = 0; j < 4; ++j) unpack8(rq[j], x4[j]);
#pragma unroll
            for (int i = 0; i < 8; ++i) { float x = 0.f;
#pragma unroll
                for (int j = 0; j < 4; ++j) x += cw[j * 128 + k8 + i] * x4[j][i];
                qv[i] = siluf_(x) * 0.125f; }
#pragma unroll
            for (int j = 0; j < 4; ++j) unpack8(rk[j], x4[j]);
#pragma unroll
            for (int i = 0; i < 8; ++i) { float x = 0.f;
#pragma unroll
                for (int j = 0; j < 4; ++j) x += cw[j * 128 + 64 + k8 + i] * x4[j][i];
                kv[i] = siluf_(x); }
            const float lf = logsigmoid_fast(rfc + bfv), ip = ric + bi;
            g_bc = wave_scan_add(lf, lane); g_a = ip - g_bc;
            const float pm = wave_scan_max(g_a, lane); g_M = fmaxf(m_prev, pm);
            M63 = __shfl(g_M, 63); const float totb = __shfl(g_bc, 63);
            wc = __expf(m_prev - M63);
            const float Ms = __shfl(g_M, srow), as = __shfl(g_a, srow);
            const float e1 = __expf(m_prev - Ms), e2 = __expf(as - M63);
            float q2[8], kw[8];
#pragma unroll
            for (int i = 0; i < 8; ++i) { q2[i] = qv[i] * e1; kw[i] = kv[i] * e2; }
            *(LAS u32x4*)(Qt + srow * LQ + k8) = pack8(qv); *(LAS u32x4*)(Kt + srow * LQ + k8) = pack8(kv); *(LAS u32x4*)(Q2 + srow * LQ + k8) = pack8(q2);
#pragma unroll
            for (int i = 0; i < 8; ++i) KtT[(k8 + i) * LQ + srow] = (bf16)f2bf(kw[i]);
            m_prev = totb + M63;
        }
        { float v0[8], v1[8]; unpack8(rv[0], v0); unpack8(rv[1], v1);
#pragma unroll
          for (int i = 0; i < 8; ++i) { VT[(vc8 + i) * LQ + vrow] = (bf16)f2bf(v0[i]); VT[(vc8 + i) * LQ + 32 + vrow] = (bf16)f2bf(v1[i]); } }
        u32x2 gate[4];
#pragma unroll
        for (int ti = 0; ti < 4; ++ti) gate[ti] = *(const u32x2*)(PB + (grow + 16 * ti + fr) * NPB + GCOL + 16 * w + 4 * fq);
        if (cch + 1 < SEQ / 64) SC_LOAD(cch + 1);
        lds_barrier();
        {
            const int ti = w >> 1;
#pragma unroll
            for (int u = 0; u < 2; ++u) {
                const int sj = 2 * (w & 1) + u;
                f32x4 d = (f32x4){0.f, 0.f, 0.f, 0.f};
                if (sj <= ti) {
#pragma unroll
                    for (int ks = 0; ks < 2; ++ks) { const bf16x8 a = *(const LAS bf16x8*)(Kt + (16 * sj + fr) * LQ + 32 * ks + 8 * fq), bb = *(const LAS bf16x8*)(Qt + (16 * ti + fr) * LQ + 32 * ks + 8 * fq);
                        d = __builtin_amdgcn_mfma_f32_16x16x32_bf16(a, bb, d, 0, 0, 0); }
                    const int t = 16 * ti + fr, s0 = 16 * sj + 4 * fq;
                    if (ML) { const float Mt = __shfl(g_M, t);
#pragma unroll
                        for (int r = 0; r < 4; ++r) { const float as = __shfl(g_a, s0 + r); d[r] = (s0 + r <= t) ? d[r] * __expf(as - Mt) : 0.f; } }
                    else {
#pragma unroll
                        for (int r = 0; r < 4; ++r) d[r] = (s0 + r <= t) ? d[r] : 0.f; }
                }
                { u32x2 pk; pk.x = pk2(d[0], d[1]); pk.y = pk2(d[2], d[3]); *(LAS u32x2*)(Sc + (16 * ti + fr) * LQ + 16 * sj + 4 * fq) = pk; }
            }
        }
        lds_barrier();
        const LAS bf16* Qm = ML ? Q2 : Qt;
        f32x4 o[4];
        {
            bf16x8 vt[2], stf[2];
#pragma unroll
            for (int ks = 0; ks < 2; ++ks) { vt[ks] = *(const LAS bf16x8*)(VT + (16 * w + fr) * LQ + 32 * ks + 8 * fq); stf[ks] = *(const LAS bf16x8*)(STc + (16 * w + fr) * LQ + 32 * ks + 8 * fq); }
#pragma unroll
            for (int ti = 0; ti < 4; ++ti) {
                f32x4 d = (f32x4){0.f, 0.f, 0.f, 0.f};
#pragma unroll
                for (int ks = 0; ks < 2; ++ks) { const bf16x8 sc = *(const LAS bf16x8*)(Sc + (16 * ti + fr) * LQ + 32 * ks + 8 * fq); d = __builtin_amdgcn_mfma_f32_16x16x32_bf16(vt[ks], sc, d, 0, 0, 0); }
#pragma unroll
                for (int ks = 0; ks < 2; ++ks) { const bf16x8 qq = *(const LAS bf16x8*)(Qm + (16 * ti + fr) * LQ + 32 * ks + 8 * fq); d = __builtin_amdgcn_mfma_f32_16x16x32_bf16(stf[ks], qq, d, 0, 0, 0); }
                o[ti] = d;
            }
#pragma unroll
            for (int kj = 0; kj < 4; ++kj) {
                f32x4 d = (f32x4){0.f, 0.f, 0.f, 0.f};
#pragma unroll
                for (int ks = 0; ks < 2; ++ks) { const bf16x8 kk = *(const LAS bf16x8*)(KtT + (16 * kj + fr) * LQ + 32 * ks + 8 * fq); d = __builtin_amdgcn_mfma_f32_16x16x32_bf16(kk, vt[ks], d, 0, 0, 0); }
                if (ML) Sacc[kj] = Sacc[kj] * wc + d;
                else { const f32x4 e4 = *(const LAS f32x4*)(etot + 16 * kj + 4 * fq); Sacc[kj] = e4 * (Sacc[kj] + d); }
                u32x2 pk; pk.x = pk2(Sacc[kj][0], Sacc[kj][1]); pk.y = pk2(Sacc[kj][2], Sacc[kj][3]);
                *(LAS u32x2*)(STn + (16 * w + fr) * LQ + 16 * kj + 4 * fq) = pk;
            }
            if (ML) {
                if (w < 4) {
                    f32x4 d = (f32x4){0.f, 0.f, 0.f, 0.f};
#pragma unroll
                    for (int ks = 0; ks < 2; ++ks) { const bf16x8 a = *(const LAS bf16x8*)(VT + (128 + fr) * LQ + 32 * ks + 8 * fq), sc = *(const LAS bf16x8*)(Sc + (16 * w + fr) * LQ + 32 * ks + 8 * fq);
                        d = __builtin_amdgcn_mfma_f32_16x16x32_bf16(a, sc, d, 0, 0, 0); }
#pragma unroll
                    for (int ks = 0; ks < 2; ++ks) { const bf16x8 a = *(const LAS bf16x8*)(STc + (128 + fr) * LQ + 32 * ks + 8 * fq), qq = *(const LAS bf16x8*)(Qm + (16 * w + fr) * LQ + 32 * ks + 8 * fq);
                        d = __builtin_amdgcn_mfma_f32_16x16x32_bf16(a, qq, d, 0, 0, 0); }
                    if (fq == 0) dn[16 * w + fr] = d[0];
                } else {
                    const int kj = w - 4;
                    f32x4 d = (f32x4){0.f, 0.f, 0.f, 0.f};
#pragma unroll
                    for (int ks = 0; ks < 2; ++ks) { const bf16x8 kk = *(const LAS bf16x8*)(KtT + (16 * kj + fr) * LQ + 32 * ks + 8 * fq), a = *(const LAS bf16x8*)(VT + (128 + fr) * LQ + 32 * ks + 8 * fq);
                        d = __builtin_amdgcn_mfma_f32_16x16x32_bf16(kk, a, d, 0, 0, 0); }
                    Nacc = Nacc * wc + d;
                    u32x2 pk; pk.x = pk2(Nacc[0], Nacc[1]); pk.y = pk2(Nacc[2], Nacc[3]);
                    *(LAS u32x2*)(STn + (128 + fr) * LQ + 16 * kj + 4 * fq) = pk;
                }
            }
        }
#pragma unroll
        for (int ti = 0; ti < 4; ++ti) { float p = o[ti][0] * o[ti][0] + o[ti][1] * o[ti][1] + o[ti][2] * o[ti][2] + o[ti][3] * o[ti][3];
            p += __shfl_xor(p, 16); p += __shfl_xor(p, 32);
            if (fq == 0) ssq[w * 64 + 16 * ti + fr] = p; }
        lds_barrier();
#pragma unroll
        for (int ti = 0; ti < 4; ++ti) {
            const int t = 16 * ti + fr;
            float ss = 0.f;
#pragma unroll
            for (int ww = 0; ww < 8; ++ww) ss += ssq[ww * 64 + t];
            float dd = 1.f;
            if (ML) { const float bc = __shfl(g_bc, t), Mt = __shfl(g_M, t); dd = 1.f / fmaxf(fabsf(dn[t]), __expf(-(bc + Mt))); }
            const float rstd = rsqrtf(ss * dd * dd * (1.f / 128.f) + EPS) * dd;
            const f32x4 gn = *(const f32x4*)(gnorm + 16 * w + 4 * fq);
            const float g0 = bflo(gate[ti].x), g1 = bfhi(gate[ti].x), g2 = bflo(gate[ti].y), g3 = bfhi(gate[ti].y);
            f32x4 r;
            if (ML) { r[0] = o[ti][0] * rstd * gn[0] * sigmoidf_(g0); r[1] = o[ti][1] * rstd * gn[1] * sigmoidf_(g1); r[2] = o[ti][2] * rstd * gn[2] * sigmoidf_(g2); r[3] = o[ti][3] * rstd * gn[3] * sigmoidf_(g3); }
            else { r[0] = o[ti][0] * rstd * gn[0] * siluf_(g0); r[1] = o[ti][1] * rstd * gn[1] * siluf_(g1); r[2] = o[ti][2] * rstd * gn[2] * siluf_(g2); r[3] = o[ti][3] * rstd * gn[3] * siluf_(g3); }
            st_bf4(UO + (grow + t) * 512 + h * 128 + 16 * w + 4 * fq, r);
        }
    }
#undef SC_LOAD
    __syncthreads();
}

template <bool ML>
__device__ __forceinline__ void scanA_loop(const Ctx& c, int l, int it0, int it_end, int stride) {
    LAS bf16* Qt0 = (LAS bf16*)(c.lds + SC_QT); LAS bf16* Kt0 = (LAS bf16*)(c.lds + SC_KT); LAS bf16* KtT0 = (LAS bf16*)(c.lds + SC_KTT);
    LAS bf16* Sc0 = (LAS bf16*)(c.lds + SC_SC); LAS bf16* VT0 = (LAS bf16*)(c.lds + SC_VT);
    LAS float* segtot = (LAS float*)(c.lds + SC_FL);
    LAS float* wa2 = segtot + 512 + 64 + 512 + 64;
    LAS float* ba = wa2 + 1024;
    LAS float* cw = ba + 64;
    const int tid = c.tid, lane = c.lane, w = c.wave, fr = lane & 15, fq = lane >> 4;
    const int srow = tid >> 3, kg = tid & 7, k8 = kg * 8, vrow = tid >> 4, vc8 = (tid & 15) * 8;
    const bf16* PB = (const bf16*)(c.ws + WS_PB); const float* SM = (const float*)(c.ws + WS_SM);
    bf16* UO = (bf16*)(c.ws + (ML ? WS_UC : WS_UA));
    bf16* QS = (bf16*)(c.ws + WS_QS) + (ML ? (size_t)T * 256 : 0);
    u32x4 rq[ML ? 4 : 1], rk[ML ? 4 : 1], rv[2]; f32x4 ra[4]; float ric = 0.f, rfc = 0.f;
    const u32x4 z4 = (u32x4){0u, 0u, 0u, 0u};
#define SA_LOAD(it_) do { const int _rem = (it_) & 2047, _seq = _rem >> 5, _cch = _rem & 31, _b = _seq >> 2, _h = _seq & 3; \
        const size_t _g = (size_t)_b * SEQ + (size_t)_cch * 64; \
        const int _qc = (ML ? PB_QC : PB_QA) + _h * 64, _kc = (ML ? PB_KC : PB_KA) + _h * 64, _vc = (ML ? PB_VC : PB_VA) + _h * 128; \
        if (ML) { _Pragma("unroll") for (int _j = 0; _j < 4; ++_j) { const int _tt = _cch * 64 + srow - 3 + _j; \
                rq[_j] = _tt >= 0 ? *(const u32x4*)(PB + ((size_t)_b * SEQ + _tt) * NPB + _qc + k8) : z4; rk[_j] = _tt >= 0 ? *(const u32x4*)(PB + ((size_t)_b * SEQ + _tt) * NPB + _kc + k8) : z4; } \
            ric = SM[(_g + lane) * 128 + SM_IC + _h]; rfc = SM[(_g + lane) * 128 + SM_FC + _h]; } \
        else { rq[0] = *(const u32x4*)(PB + (_g + srow) * NPB + _qc + k8); rk[0] = *(const u32x4*)(PB + (_g + srow) * NPB + _kc + k8); \
            _Pragma("unroll") for (int _j = 0; _j < 4; ++_j) ra[_j] = *(const f32x4*)(SM + (_g + srow) * 128 + SM_ALR + 4 * _j); } \
        rv[0] = *(const u32x4*)(PB + (_g + vrow) * NPB + _vc + vc8); rv[1] = *(const u32x4*)(PB + (_g + 32 + vrow) * NPB + _vc + vc8); } while (0)
    if (it0 < it_end) SA_LOAD(it0);
    int hprev = -1;
#pragma unroll 1
    for (int it = it0; it < it_end; it += stride) {
    const int rem_ = it & 2047, seq_ = rem_ >> 5, cch = rem_ & 31, b = seq_ >> 2, h = seq_ & 3;
    const int slot = (b * 4 + h) * 32 + cch;
    bf16* DS = ML ? (bf16*)(c.ws + WS_DSM) + (size_t)slot * 144 * 64 : (bf16*)(c.ws + WS_DSG) + (size_t)slot * 128 * 64;
    const size_t grow = (size_t)b * SEQ + (size_t)cch * 64;
    int lz; asm volatile("v_mov_b32 %0, 0" : "=v"(lz));
    LAS bf16* Qt = Qt0 + lz; LAS bf16* Kt = Kt0 + lz; LAS bf16* KtT = KtT0 + lz; LAS bf16* Sc = Sc0 + lz; LAS bf16* VT = VT0 + lz;
    __syncthreads();
    if (h != hprev) {
        if (!ML) { for (int i = tid; i < 1024; i += NTHR) wa2[i] = c.in[IN_GLA_WA2][(size_t)l * 16 * 256 + (i >> 6) * 256 + h * 64 + (i & 63)];
                   if (tid < 64) ba[tid] = c.in[IN_GLA_BA][l * 256 + h * 64 + tid]; }
        else { { const int j = tid >> 7, cc = tid & 127; cw[tid] = c.in[IN_ML_CONV][(size_t)l * 4 * 512 + j * 512 + (cc < 64 ? h * 64 + cc : 256 + h * 64 + (cc - 64))]; }
               for (int i = tid; i < 16 * LQ; i += NTHR) VT[128 * LQ + i] = (i < 64) ? (bf16)0x3f80u : (bf16)0u; }
        hprev = h;
        __syncthreads();
    }
    const float bi = ML ? c.in[IN_ML_BI][l * 4 + h] : 0.f, bfv = ML ? c.in[IN_ML_BF][l * 4 + h] : 0.f;
    float qv[8], kv[8];
    float g_a = 0.f, g_pm = 0.f;
    if (!ML) {
        unpack8(rq[0], qv); unpack8(rk[0], kv);
        float la[8];
#pragma unroll
        for (int i = 0; i < 8; ++i) la[i] = ba[k8 + i];
#pragma unroll
        for (int j4 = 0; j4 < 4; ++j4)
#pragma unroll
            for (int jj = 0; jj < 4; ++jj) { const float a = ra[j4][jj]; const LAS float* wr_ = wa2 + (j4 * 4 + jj) * 64 + k8;
                const f32x4 w0 = *(const LAS f32x4*)wr_, w1 = *(const LAS f32x4*)(wr_ + 4);
                la[0] += a * w0[0]; la[1] += a * w0[1]; la[2] += a * w0[2]; la[3] += a * w0[3]; la[4] += a * w1[0]; la[5] += a * w1[1]; la[6] += a * w1[2]; la[7] += a * w1[3]; }
#pragma unroll
        for (int i = 0; i < 8; ++i) { float x = logsigmoid_fast(la[i]) * (1.f / 16.f);
#pragma unroll
            for (int d = 8; d < 64; d <<= 1) { const float y = __shfl_up(x, d); if (lane >= d) x += y; }
            la[i] = x; }
        if ((lane >> 3) == 7) { *(LAS f32x4*)(segtot + w * 64 + k8) = (f32x4){la[0], la[1], la[2], la[3]}; *(LAS f32x4*)(segtot + w * 64 + k8 + 4) = (f32x4){la[4], la[5], la[6], la[7]}; }
        lds_barrier();
        float tot[8];
#pragma unroll
        for (int i = 0; i < 8; ++i) tot[i] = 0.f;
#pragma unroll
        for (int ww = 0; ww < 8; ++ww) { const f32x4 s0 = *(const LAS f32x4*)(segtot + ww * 64 + k8), s1 = *(const LAS f32x4*)(segtot + ww * 64 + k8 + 4);
            const float sel = ww < w ? 1.f : 0.f;
            la[0] += sel * s0[0]; la[1] += sel * s0[1]; la[2] += sel * s0[2]; la[3] += sel * s0[3]; la[4] += sel * s1[0]; la[5] += sel * s1[1]; la[6] += sel * s1[2]; la[7] += sel * s1[3];
            tot[0] += s0[0]; tot[1] += s0[1]; tot[2] += s0[2]; tot[3] += s0[3]; tot[4] += s1[0]; tot[5] += s1[1]; tot[6] += s1[2]; tot[7] += s1[3]; }
        if (tid < 8) { float* et = (float*)(c.ws + WS_ET) + (size_t)slot * 64 + k8;
            *(f32x4*)et = (f32x4){__expf(tot[0]), __expf(tot[1]), __expf(tot[2]), __expf(tot[3])}; *(f32x4*)(et + 4) = (f32x4){__expf(tot[4]), __expf(tot[5]), __expf(tot[6]), __expf(tot[7])}; }
        float kt[8];
#pragma unroll
        for (int i = 0; i < 8; ++i) { qv[i] = qv[i] * 0.125f * __expf(la[i]); kt[i] = kv[i] * __expf(-la[i]); }
        const u32x4 qp = pack8(qv);
        *(LAS u32x4*)(Qt + srow * LQ + k8) = qp; *(LAS u32x4*)(Kt + srow * LQ + k8) = pack8(kt);
        *(u32x4*)(QS + (grow + srow) * 256 + h * 64 + k8) = qp;
#pragma unroll
        for (int i = 0; i < 8; ++i) KtT[(k8 + i) * LQ + srow] = (bf16)f2bf(kt[i]);
    } else {
        float x4[4][8];
#pragma unroll
        for (int j = 0; j < 4; ++j) unpack8(rq[j], x4[j]);
#pragma unroll
        for (int i = 0; i < 8; ++i) { float x = 0.f;
#pragma unroll
            for (int j = 0; j < 4; ++j) x += cw[j * 128 + k8 + i] * x4[j][i];
            qv[i] = siluf_(x) * 0.125f; }
#pragma unroll
        for (int j = 0; j < 4; ++j) unpack8(rk[j], x4[j]);
#pragma unroll
        for (int i = 0; i < 8; ++i) { float x = 0.f;
#pragma unroll
            for (int j = 0; j < 4; ++j) x += cw[j * 128 + 64 + k8 + i] * x4[j][i];
            kv[i] = siluf_(x); }
        const float lf = logsigmoid_fast(rfc + bfv), ip = ric + bi;
        const float g_bc = wave_scan_add(lf, lane); g_a = ip - g_bc;
        g_pm = wave_scan_max(g_a, lane);
        const float pm63 = __shfl(g_pm, 63), totb = __shfl(g_bc, 63);
        if (w == 0) { ((float*)(c.ws + WS_GPM))[(grow + lane) * 4 + h] = g_pm; ((float*)(c.ws + WS_GBC))[(grow + lane) * 4 + h] = g_bc;
            if (lane == 0) { float* ct = (float*)(c.ws + WS_CT) + (size_t)slot * 2; ct[0] = totb; ct[1] = pm63; } }
        const float as = __shfl(g_a, srow);
        const float e2 = __expf(as - pm63);
        float kw[8];
#pragma unroll
        for (int i = 0; i < 8; ++i) kw[i] = kv[i] * e2;
        const u32x4 qp = pack8(qv);
        *(LAS u32x4*)(Qt + srow * LQ + k8) = qp; *(LAS u32x4*)(Kt + srow * LQ + k8) = pack8(kv);
        *(u32x4*)(QS + (grow + srow) * 256 + h * 64 + k8) = qp;
#pragma unroll
        for (int i = 0; i < 8; ++i) KtT[(k8 + i) * LQ + srow] = (bf16)f2bf(kw[i]);
    }
    { float v0[8], v1[8]; unpack8(rv[0], v0); unpack8(rv[1], v1);
#pragma unroll
      for (int i = 0; i < 8; ++i) { VT[(vc8 + i) * LQ + vrow] = (bf16)f2bf(v0[i]); VT[(vc8 + i) * LQ + 32 + vrow] = (bf16)f2bf(v1[i]); } }
    if (it + stride < it_end) SA_LOAD(it + stride);
    lds_barrier();
    {
        const int ti = w >> 1;
#pragma unroll
        for (int u = 0; u < 2; ++u) {
            const int sj = 2 * (w & 1) + u;
            f32x4 d = (f32x4){0.f, 0.f, 0.f, 0.f};
            if (sj <= ti) {
#pragma unroll
                for (int ks = 0; ks < 2; ++ks) { const bf16x8 a = *(const LAS bf16x8*)(Kt + (16 * sj + fr) * LQ + 32 * ks + 8 * fq), bb = *(const LAS bf16x8*)(Qt + (16 * ti + fr) * LQ + 32 * ks + 8 * fq);
                    d = __builtin_amdgcn_mfma_f32_16x16x32_bf16(a, bb, d, 0, 0, 0); }
                const int t = 16 * ti + fr, s0 = 16 * sj + 4 * fq;
                if (ML) { const float pt = __shfl(g_pm, t);
#pragma unroll
                    for (int r = 0; r < 4; ++r) { const float as = __shfl(g_a, s0 + r); d[r] = (s0 + r <= t) ? d[r] * __expf(as - pt) : 0.f; } }
                else {
#pragma unroll
                    for (int r = 0; r < 4; ++r) d[r] = (s0 + r <= t) ? d[r] : 0.f; }
            }
            { u32x2 pk; pk.x = pk2(d[0], d[1]); pk.y = pk2(d[2], d[3]); *(LAS u32x2*)(Sc + (16 * ti + fr) * LQ + 16 * sj + 4 * fq) = pk; }
        }
    }
    lds_barrier();
    {
        bf16x8 vt[2];
#pragma unroll
        for (int ks = 0; ks < 2; ++ks) vt[ks] = *(const LAS bf16x8*)(VT + (16 * w + fr) * LQ + 32 * ks + 8 * fq);
#pragma unroll
        for (int ti = 0; ti < 4; ++ti) {
            f32x4 d = (f32x4){0.f, 0.f, 0.f, 0.f};
#pragma unroll
            for (int ks = 0; ks < 2; ++ks) { const bf16x8 sc = *(const LAS bf16x8*)(Sc + (16 * ti + fr) * LQ + 32 * ks + 8 * fq); d = __builtin_amdgcn_mfma_f32_16x16x32_bf16(vt[ks], sc, d, 0, 0, 0); }
            st_bf4(UO + (grow + 16 * ti + fr) * 512 + h * 128 + 16 * w + 4 * fq, d);
        }
#pragma unroll
        for (int kj = 0; kj < 4; ++kj) {
            f32x4 d = (f32x4){0.f, 0.f, 0.f, 0.f};
#pragma unroll
            for (int ks = 0; ks < 2; ++ks) { const bf16x8 kk = *(const LAS bf16x8*)(KtT + (16 * kj + fr) * LQ + 32 * ks + 8 * fq); d = __builtin_amdgcn_mfma_f32_16x16x32_bf16(kk, vt[ks], d, 0, 0, 0); }
            st_bf4(DS + (16 * w + fr) * 64 + 16 * kj + 4 * fq, d);
        }
        if (ML) {
            if (w < 4) {
                f32x4 d = (f32x4){0.f, 0.f, 0.f, 0.f};
#pragma unroll
                for (int ks = 0; ks < 2; ++ks) { const bf16x8 a = *(const LAS bf16x8*)(VT + (128 + fr) * LQ + 32 * ks + 8 * fq), sc = *(const LAS bf16x8*)(Sc + (16 * w + fr) * LQ + 32 * ks + 8 * fq);
                    d = __builtin_amdgcn_mfma_f32_16x16x32_bf16(a, sc, d, 0, 0, 0); }
                if (fq == 0) ((float*)(c.ws + WS_DN))[(grow + 16 * w + fr) * 4 + h] = d[0];
            } else {
                const int kj = w - 4;
                f32x4 d = (f32x4){0.f, 0.f, 0.f, 0.f};
#pragma unroll
                for (int ks = 0; ks < 2; ++ks) { const bf16x8 kk = *(const LAS bf16x8*)(KtT + (16 * kj + fr) * LQ + 32 * ks + 8 * fq), a = *(const LAS bf16x8*)(VT + (128 + fr) * LQ + 32 * ks + 8 * fq);
                    d = __builtin_amdgcn_mfma_f32_16x16x32_bf16(kk, a, d, 0, 0, 0); }
                st_bf4(DS + (128 + fr) * 64 + 16 * kj + 4 * fq, d);
            }
        }
    }
    }
#undef SA_LOAD
}
__device__ __forceinline__ void scanB(const Ctx& c) {
    const int gt = c.bid * NTHR + c.tid, NGT = c.nblk * NTHR;
    constexpr int NG = 64 * 128 * 8, NM = 64 * 144 * 8;
    for (int idx = gt; idx < NG + NM; idx += NGT) {
        float S[8];
#pragma unroll
        for (int i = 0; i < 8; ++i) S[i] = 0.f;
        if (idx < NG) {
            const int seq = idx >> 10, v = (idx >> 3) & 127, kg = idx & 7;
            bf16* p = (bf16*)(c.ws + WS_DSG) + (size_t)seq * 32 * 8192 + v * 64 + kg * 8;
            const float* et = (const float*)(c.ws + WS_ET) + (size_t)seq * 32 * 64 + kg * 8;
#pragma unroll 1
            for (int c4 = 0; c4 < 32; c4 += 4) {
                u32x4 dv[4]; f32x4 e0[4], e1[4];
#pragma unroll
                for (int j = 0; j < 4; ++j) { dv[j] = *(const u32x4*)(p + (size_t)(c4 + j) * 8192); e0[j] = *(const f32x4*)(et + (c4 + j) * 64); e1[j] = *(const f32x4*)(et + (c4 + j) * 64 + 4); }
#pragma unroll
                for (int j = 0; j < 4; ++j) {
                    float d[8]; unpack8(dv[j], d);
                    const u32x4 sp = pack8(S);
                    S[0] = e0[j][0] * (S[0] + d[0]); S[1] = e0[j][1] * (S[1] + d[1]); S[2] = e0[j][2] * (S[2] + d[2]); S[3] = e0[j][3] * (S[3] + d[3]);
                    S[4] = e1[j][0] * (S[4] + d[4]); S[5] = e1[j][1] * (S[5] + d[5]); S[6] = e1[j][2] * (S[6] + d[6]); S[7] = e1[j][3] * (S[7] + d[7]);
                    *(u32x4*)(p + (size_t)(c4 + j) * 8192) = sp;
                }
            }
        } else {
            const int j0 = idx - NG, seq = j0 / 1152, rem = j0 % 1152, v = rem >> 3, kg = rem & 7;
            bf16* p = (bf16*)(c.ws + WS_DSM) + (size_t)seq * 32 * 9216 + v * 64 + kg * 8;
            const float* ct = (const float*)(c.ws + WS_CT) + (size_t)seq * 32 * 2;
            float* mp = (float*)(c.ws + WS_MP) + (size_t)seq * 32;
            float m = 0.f;
#pragma unroll 1
            for (int c4 = 0; c4 < 32; c4 += 4) {
                u32x4 dv[4]; f32x2 cc[4];
#pragma unroll
                for (int j = 0; j < 4; ++j) { dv[j] = *(const u32x4*)(p + (size_t)(c4 + j) * 9216); cc[j] = *(const f32x2*)(ct + (c4 + j) * 2); }
#pragma unroll
                for (int j = 0; j < 4; ++j) {
                    float d[8]; unpack8(dv[j], d);
                    const float M63 = fmaxf(m, cc[j][1]), wc = __expf(m - M63), ws = __expf(cc[j][1] - M63);
                    const u32x4 sp = pack8(S);
                    if (rem == 0) mp[c4 + j] = m;
#pragma unroll
                    for (int i = 0; i < 8; ++i) S[i] = wc * S[i] + ws * d[i];
                    m = cc[j][0] + M63;
                    *(u32x4*)(p + (size_t)(c4 + j) * 9216) = sp;
                }
            }
        }
    }
}
template <bool ML>
__device__ __forceinline__ void scanC_wave(const Ctx& c, int l, int b, int h, int cch, int ti) {
    const int lane = c.lane, fr = lane & 15, fq = lane >> 4;
    const bf16* PB = (const bf16*)(c.ws + WS_PB);
    bf16* UO = (bf16*)(c.ws + (ML ? WS_UC : WS_UA));
    const bf16* QS = (const bf16*)(c.ws + WS_QS) + (ML ? (size_t)T * 256 : 0);
    const int slot = (b * 4 + h) * 32 + cch;
    const bf16* SP = ML ? (const bf16*)(c.ws + WS_DSM) + (size_t)slot * 144 * 64 : (const bf16*)(c.ws + WS_DSG) + (size_t)slot * 128 * 64;
    const int GCOL = (ML ? PB_OC : PB_GA) + h * 128;
    const float* gnorm = c.in[ML ? IN_ML_NORM : IN_GLA_NORM] + l * 512 + h * 128;
    const size_t trow = (size_t)b * SEQ + (size_t)cch * 64 + 16 * ti + fr;
    bf16x8 qf[2], sf[8][2], nf[2];
#pragma unroll
    for (int ks = 0; ks < 2; ++ks) qf[ks] = *(const bf16x8*)(QS + trow * 256 + h * 64 + 32 * ks + 8 * fq);
#pragma unroll
    for (int n = 0; n < 8; ++n)
#pragma unroll
        for (int ks = 0; ks < 2; ++ks) sf[n][ks] = *(const bf16x8*)(SP + (16 * n + fr) * 64 + 32 * ks + 8 * fq);
    if (ML) {
#pragma unroll
        for (int ks = 0; ks < 2; ++ks) nf[ks] = *(const bf16x8*)(SP + (128 + fr) * 64 + 32 * ks + 8 * fq); }
    u32x2 gate[8], oi[8];
#pragma unroll
    for (int n = 0; n < 8; ++n) { gate[n] = *(const u32x2*)(PB + trow * NPB + GCOL + 16 * n + 4 * fq); oi[n] = *(const u32x2*)(UO + trow * 512 + h * 128 + 16 * n + 4 * fq); }
    float e_in = 1.f, e_st = 1.f, dd = 1.f;
    if (ML) {
        const float pm = ((const float*)(c.ws + WS_GPM))[trow * 4 + h], bc = ((const float*)(c.ws + WS_GBC))[trow * 4 + h], m_prev = ((const float*)(c.ws + WS_MP))[slot], dni = ((const float*)(c.ws + WS_DN))[trow * 4 + h];
        const float Mt = fmaxf(m_prev, pm); e_in = __expf(pm - Mt); e_st = __expf(m_prev - Mt);
        f32x4 d = (f32x4){0.f, 0.f, 0.f, 0.f};
#pragma unroll
        for (int ks = 0; ks < 2; ++ks) d = __builtin_amdgcn_mfma_f32_16x16x32_bf16(nf[ks], qf[ks], d, 0, 0, 0);
        const float dst = __shfl(d[0], fr);
        const float den = dni * e_in + dst * e_st;
        dd = 1.f / fmaxf(fabsf(den), __expf(-(bc + Mt)));
    }
    f32x4 o[8]; float ss = 0.f;
#pragma unroll
    for (int n = 0; n < 8; ++n) {
        f32x4 d = (f32x4){0.f, 0.f, 0.f, 0.f};
#pragma unroll
        for (int ks = 0; ks < 2; ++ks) d = __builtin_amdgcn_mfma_f32_16x16x32_bf16(sf[n][ks], qf[ks], d, 0, 0, 0);
        const f32x4 oiv = (f32x4){bflo(oi[n].x), bfhi(oi[n].x), bflo(oi[n].y), bfhi(oi[n].y)};
        o[n] = ML ? oiv * e_in + d * e_st : oiv + d;
        ss += o[n][0] * o[n][0] + o[n][1] * o[n][1] + o[n][2] * o[n][2] + o[n][3] * o[n][3];
    }
    ss += __shfl_xor(ss, 16); ss += __shfl_xor(ss, 32);
    const float rstd = rsqrtf(ss * dd * dd * (1.f / 128.f) + EPS) * dd;
#pragma unroll
    for (int n = 0; n < 8; ++n) {
        const f32x4 gn = *(const f32x4*)(gnorm + 16 * n + 4 * fq);
        const float g0 = bflo(gate[n].x), g1 = bfhi(gate[n].x), g2 = bflo(gate[n].y), g3 = bfhi(gate[n].y);
        f32x4 r;
        if (ML) { r[0] = o[n][0] * rstd * gn[0] * sigmoidf_(g0); r[1] = o[n][1] * rstd * gn[1] * sigmoidf_(g1); r[2] = o[n][2] * rstd * gn[2] * sigmoidf_(g2); r[3] = o[n][3] * rstd * gn[3] * sigmoidf_(g3); }
        else { r[0] = o[n][0] * rstd * gn[0] * siluf_(g0); r[1] = o[n][1] * rstd * gn[1] * siluf_(g1); r[2] = o[n][2] * rstd * gn[2] * siluf_(g2); r[3] = o[n][3] * rstd * gn[3] * siluf_(g3); }
        st_bf4(UO + trow * 512 + h * 128 + 16 * n + 4 * fq, r);
    }
}
__device__ __forceinline__ void phase_scanA(const Ctx& c, int l) {
    const int nG = c.bid < 2048 ? (2048 - c.bid + c.nblk - 1) / c.nblk : 0;
    const int firstM = c.bid + nG * c.nblk;
    scanA_loop<false>(c, l, c.bid, 2048, c.nblk);
    scanA_loop<true>(c, l, firstM, 4096, c.nblk);
    __syncthreads();
}
__device__ __forceinline__ void phase_scanC(const Ctx& c, int l) {
    const int gw = c.bid * NWAVES + c.wave, NGW = c.nblk * NWAVES;
#pragma unroll 1
    for (int it = gw; it < 16384; it += NGW) { const int br = it >> 13, rem = it & 8191, seq = rem >> 7, cch = (rem >> 2) & 31, ti = rem & 3;
        if (br == 0) scanC_wave<false>(c, l, seq >> 2, seq & 3, cch, ti); else scanC_wave<true>(c, l, seq >> 2, seq & 3, cch, ti); }
}
__device__ __forceinline__ void phase_scans(const Ctx& c, int l) {
    for (int it = c.bid; it < 128; it += c.nblk) {
#if SCAN_RECURRENT
        if (it < 64) scan_gla_item(c, l, it >> 2, it & 3);
        else scan_mlstm_item(c, l, (it - 64) >> 2, (it - 64) & 3);
#else
        if (it < 64) scan_chunked_item<false>(c, l, it >> 2, it & 3);
        else scan_chunked_item<true>(c, l, (it - 64) >> 2, (it - 64) & 3);
#endif
    }
}

__device__ __forceinline__ unsigned ord_key(float f) { const unsigned u = __builtin_bit_cast(unsigned, f); return (u & 0x80000000u) ? ~u : (u | 0x80000000u); }
__device__ __forceinline__ void phase_dsa(const Ctx& c, int l) {
    LAS unsigned char* wl = c.lds + c.wave * 14336;
    LAS float* I_s = (LAS float*)wl;
    LAS int* list = (LAS int*)(wl + 8192);
    LAS float* qi_s = (LAS float*)(wl + 9216);
    LAS float* ql_s = (LAS float*)(wl + 10240);
    const bf16* QLAT = (const bf16*)(c.ws + WS_QLAT); const bf16* QIDX = (const bf16*)(c.ws + WS_QIDX);
    const bf16* CKVN = (const bf16*)(c.ws + WS_CKVN); const float* SM = (const float*)(c.ws + WS_SM);
    bf16* OLAT = (bf16*)(c.ws + WS_OLAT);
    const int gw = c.bid * NWAVES + c.wave, NGW = c.nblk * NWAVES, lane = c.lane;
    for (int tq = gw; tq < T; tq += NGW) {
        const int b = tq >> 11, pos = tq & 2047, nvalid = pos + 1;
        const size_t kb = (size_t)b * SEQ;
        { const f32x4 q = ld_bf4(QIDX + (size_t)tq * 256 + 4 * lane); *(LAS f32x4*)(qi_s + 4 * lane) = q;
#pragma unroll
          for (int j = 0; j < 4; ++j) { const f32x4 ql = ld_bf4(QLAT + (size_t)tq * 1024 + 4 * (lane + 64 * j)); *(LAS f32x4*)(ql_s + 4 * (lane + 64 * j)) = ql; } }
        float wh[8];
#pragma unroll
        for (int hh = 0; hh < 8; ++hh) wh[hh] = SM[(size_t)tq * 128 + SM_WIDX + hh] * 0.35355339059327373f;
        asm volatile("s_waitcnt lgkmcnt(0)" ::: "memory");
        int nsel;
        if (nvalid <= DSA_K) {
            for (int i = lane; i < DSA_K; i += 64) list[i] = i;
            nsel = nvalid;
        } else {
            const int nj = (nvalid + 63) >> 6;
            for (int j = 0; j < nj; ++j) {
                const int s = lane + 64 * j;
                float val = -INFINITY;
                if (s < nvalid) {
                    const float* kr = SM + (kb + s) * 128 + SM_KIDX;
                    f32x4 kk[8];
#pragma unroll
                    for (int i = 0; i < 8; ++i) kk[i] = *(const f32x4*)(kr + 4 * i);
                    val = 0.f;
#pragma unroll
                    for (int hh = 0; hh < 8; ++hh) { float d = 0.f;
#pragma unroll
                        for (int i = 0; i < 8; ++i) { const f32x4 q = *(const LAS f32x4*)(qi_s + hh * 32 + 4 * i); d += q[0] * kk[i][0] + q[1] * kk[i][1] + q[2] * kk[i][2] + q[3] * kk[i][3]; }
                        val += wh[hh] * fmaxf(d, 0.f); }
                }
                I_s[s] = val;
            }
            for (int j = nj; j < 32; ++j) I_s[lane + 64 * j] = -INFINITY;
            asm volatile("s_waitcnt lgkmcnt(0)" ::: "memory");
            LAS unsigned* K_s = (LAS unsigned*)I_s;
#pragma unroll 4
            for (int j = 0; j < 32; ++j) K_s[lane + 64 * j] = ord_key(I_s[lane + 64 * j]);
            unsigned thr = 0u;
#pragma unroll 1
            for (int bit = 31; bit >= 0; --bit) {
                const unsigned cand = thr | (1u << bit); int cnt = 0;
#pragma unroll 8
                for (int j = 0; j < 32; ++j) cnt += (K_s[lane + 64 * j] >= cand) ? 1 : 0;
                cnt = wave_sum_i(cnt);
                if (cnt >= DSA_K) thr = cand;
            }
            int cgt = 0;
#pragma unroll 8
            for (int j = 0; j < 32; ++j) cgt += (K_s[lane + 64 * j] > thr) ? 1 : 0;
            cgt = wave_sum_i(cgt);
            int need = DSA_K - cgt, base = 0;
            const unsigned long long lt = (1ull << lane) - 1ull;
#pragma unroll 2
            for (int j = 0; j < 32; ++j) {
                const unsigned kj = K_s[lane + 64 * j];
                const bool gt = kj > thr, eq = kj == thr;
                const unsigned long long meq = __ballot(eq);
                const int rk = __popcll(meq & lt);
                const bool sel = gt || (eq && rk < need);
                need -= __popcll(meq); if (need < 0) need = 0;
                const unsigned long long ms = __ballot(sel);
                if (sel) list[base + __popcll(ms & lt)] = lane + 64 * j;
                base += __popcll(ms);
            }
            nsel = DSA_K;
        }
        asm volatile("s_waitcnt lgkmcnt(0)" ::: "memory");
        int ks[4]; float lg[4][8];
#pragma unroll
        for (int i = 0; i < 4; ++i) { const int li = lane + 64 * i; ks[i] = (li < nsel) ? list[li] : 0;
#pragma unroll
            for (int hh = 0; hh < 8; ++hh) lg[i][hh] = 0.f; }
#pragma unroll 1
        for (int ch = 0; ch < 16; ++ch) {
            f32x4 ka[4], kc[4];
#pragma unroll
            for (int i = 0; i < 4; ++i) { const u32x4 w = *(const u32x4*)(CKVN + (kb + ks[i]) * 128 + ch * 8);
                ka[i] = (f32x4){bflo(w.x), bfhi(w.x), bflo(w.y), bfhi(w.y)}; kc[i] = (f32x4){bflo(w.z), bfhi(w.z), bflo(w.w), bfhi(w.w)}; }
#pragma unroll
            for (int hh = 0; hh < 8; ++hh) { const f32x4 qa = *(const LAS f32x4*)(ql_s + hh * 128 + ch * 8), qb = *(const LAS f32x4*)(ql_s + hh * 128 + ch * 8 + 4);
#pragma unroll
                for (int i = 0; i < 4; ++i) lg[i][hh] += qa[0] * ka[i][0] + qa[1] * ka[i][1] + qa[2] * ka[i][2] + qa[3] * ka[i][3] + qb[0] * kc[i][0] + qb[1] * kc[i][1] + qb[2] * kc[i][2] + qb[3] * kc[i][3]; }
        }
#pragma unroll
        for (int hh = 0; hh < 8; ++hh) {
            const float slope = exp2f(-(float)(hh + 1));
            float mx = -INFINITY;
#pragma unroll
            for (int i = 0; i < 4; ++i) { const bool ok = (lane + 64 * i) < nsel; lg[i][hh] = ok ? lg[i][hh] - slope * (float)(pos - ks[i]) : -INFINITY; mx = fmaxf(mx, lg[i][hh]); }
            mx = wave_max(mx);
            float sm = 0.f;
#pragma unroll
            for (int i = 0; i < 4; ++i) { lg[i][hh] = __expf(lg[i][hh] - mx); sm += lg[i][hh]; }
            sm = wave_sum(sm);
            const float inv = 1.f / sm;
#pragma unroll
            for (int i = 0; i < 4; ++i) lg[i][hh] *= inv;
        }
#pragma unroll
        for (int i = 0; i < 4; ++i) { const int li = lane + 64 * i;
            *(LAS f32x4*)(I_s + li * 8) = (f32x4){lg[i][0], lg[i][1], lg[i][2], lg[i][3]}; *(LAS f32x4*)(I_s + li * 8 + 4) = (f32x4){lg[i][4], lg[i][5], lg[i][6], lg[i][7]}; }
        asm volatile("s_waitcnt lgkmcnt(0)" ::: "memory");
        float o0[8], o1[8];
#pragma unroll
        for (int hh = 0; hh < 8; ++hh) { o0[hh] = 0.f; o1[hh] = 0.f; }
#pragma unroll 2
        for (int kidx = 0; kidx < nsel; ++kidx) {
            const int s = list[kidx];
            const unsigned w = *(const unsigned*)(CKVN + (kb + s) * 128 + 2 * lane);
            const float v0 = bflo(w), v1 = bfhi(w);
            const f32x4 pa = *(const LAS f32x4*)(I_s + kidx * 8), pb = *(const LAS f32x4*)(I_s + kidx * 8 + 4);
            o0[0] += pa[0] * v0; o1[0] += pa[0] * v1; o0[1] += pa[1] * v0; o1[1] += pa[1] * v1; o0[2] += pa[2] * v0; o1[2] += pa[2] * v1; o0[3] += pa[3] * v0; o1[3] += pa[3] * v1;
            o0[4] += pb[0] * v0; o1[4] += pb[0] * v1; o0[5] += pb[1] * v0; o1[5] += pb[1] * v1; o0[6] += pb[2] * v0; o1[6] += pb[2] * v1; o0[7] += pb[3] * v0; o1[7] += pb[3] * v1;
        }
#pragma unroll
        for (int hh = 0; hh < 8; ++hh) *(unsigned*)(OLAT + (size_t)tq * 1024 + hh * 128 + 2 * lane) = pk2(o0[hh], o1[hh]);
        asm volatile("s_waitcnt lgkmcnt(0)" ::: "memory");
    }
}


typedef float f32x16 __attribute__((ext_vector_type(16)));
__device__ __forceinline__ void phase_dsa_sel(const Ctx& c, int l) {
    const bf16* QIDX = (const bf16*)(c.ws + WS_QIDX); const bf16* KIDX = (const bf16*)(c.ws + WS_KIDX); const float* SM = (const float*)(c.ws + WS_SM);
    unsigned* MASK = (unsigned*)(c.ws + WS_MASK);
    const int lane = c.lane, hf = lane >> 5, l31 = lane & 31;
    const int rho = l31, tl = 2 * ((rho >> 2) & 1) + (rho >> 4), hd = (rho & 3) + 4 * ((rho >> 3) & 1);
    const unsigned ltmask = (1u << l31) - 1u;
    LAS unsigned* KL = (LAS unsigned*)(c.lds + c.wave * 16384);
    LAS unsigned* MW = (LAS unsigned*)(c.lds + 131072 + c.wave * 512);
    const int npass = (c.nblk == 256) ? 2 : (T / 64 + c.nblk - 1) / c.nblk;
#pragma unroll 1
    for (int ps = 0; ps < npass; ++ps) {
        int b, q64;
        if (c.nblk == 256) { b = c.bid & 15; q64 = ps == 0 ? 31 - (c.bid >> 4) : (c.bid >> 4); }
        else { const int it = c.bid + ps * c.nblk; if (it >= T / 64) break; b = it >> 5; q64 = it & 31; }
        const int pb = q64 * 64;
#pragma unroll 1
        for (int wi = 0; wi < 2; ++wi) {
        const int pos0 = pb + 8 * c.wave + 4 * wi, t0 = b * SEQ + pos0;
        unsigned wA0 = 0u, wB0 = 0u, wA1 = 0u, wB1 = 0u;
        if (pos0 + 3 < DSA_K) {
            const int p_0 = pos0 + 2 * hf, p_1 = p_0 + 1;
            { const int lo = 32 * l31; wA0 = p_0 >= lo + 31 ? 0xffffffffu : (p_0 < lo ? 0u : ((2u << (p_0 - lo)) - 1u)); wA1 = p_1 >= lo + 31 ? 0xffffffffu : (p_1 < lo ? 0u : ((2u << (p_1 - lo)) - 1u)); }
        } else {
            const int ng = ((pos0 + 3) / 32 + 4) / 4, nkt = 4 * ng;
            bf16x8 af[2];
#pragma unroll
            for (int ks = 0; ks < 2; ++ks) af[ks] = *(const bf16x8*)(QIDX + (size_t)(t0 + tl) * 256 + hd * 32 + 16 * ks + 8 * hf);
            const bf16* kbase = KIDX + ((size_t)b * SEQ + l31) * 32 + 8 * hf;
#pragma unroll 1
            for (int tsel = 0; tsel < 2; ++tsel) {
                float whv[8];
#pragma unroll
                for (int r = 0; r < 8; ++r) whv[r] = SM[(size_t)(t0 + 2 * hf + tsel) * 128 + SM_WIDX + r] * 0.35355339059327373f;
                const int p_t = pos0 + 2 * hf + tsel;
                bf16x8 bq[4][2], bn[4][2];
#pragma unroll
                for (int j = 0; j < 4; ++j) { bq[j][0] = *(const bf16x8*)(kbase + (size_t)(32 * j) * 32); bq[j][1] = *(const bf16x8*)(kbase + (size_t)(32 * j) * 32 + 16); }
#pragma unroll 1
                for (int g = 0; g < ng; ++g) {
                    const int gn = (g + 1 < ng) ? g + 1 : g;
#pragma unroll
                    for (int j = 0; j < 4; ++j) { bn[j][0] = *(const bf16x8*)(kbase + (size_t)(32 * (4 * gn + j)) * 32); bn[j][1] = *(const bf16x8*)(kbase + (size_t)(32 * (4 * gn + j)) * 32 + 16); }
#pragma unroll
                    for (int j = 0; j < 4; ++j) {
                        f32x16 d;
#pragma unroll
                        for (int r = 0; r < 16; ++r) d[r] = 0.f;
                        d = __builtin_amdgcn_mfma_f32_32x32x16_bf16(af[0], bq[j][0], d, 0, 0, 0);
                        d = __builtin_amdgcn_mfma_f32_32x32x16_bf16(af[1], bq[j][1], d, 0, 0, 0);
                        float iv = 0.f;
                        if (tsel == 0) {
#pragma unroll
                            for (int r = 0; r < 8; ++r) iv += whv[r] * fmaxf(d[r], 0.f);
                        } else {
#pragma unroll
                            for (int r = 0; r < 8; ++r) iv += whv[r] * fmaxf(d[8 + r], 0.f);
                        }
                        const int kt = 4 * g + j, row = 32 * kt + l31;
                        KL[kt * 64 + lane] = row <= p_t ? ord_key(iv) : 0u;
                    }
#pragma unroll
                    for (int j = 0; j < 4; ++j) { bq[j][0] = bn[j][0]; bq[j][1] = bn[j][1]; }
                }
                unsigned thr = 0u; bool dlo = false, dhi = false;
#pragma unroll 1
                for (int bit = 31; bit >= 0 && !(dlo && dhi); --bit) {
                    const unsigned cand = thr | (1u << bit); int clo = 0, chi = 0;
#pragma unroll 16
                    for (int kt = 0; kt < nkt; ++kt) { const unsigned long long m = __ballot(KL[kt * 64 + lane] >= cand); clo += __popc((unsigned)m); chi += __popc((unsigned)(m >> 32)); }
                    const bool tlo = !dlo && clo >= DSA_K, thi = !dhi && chi >= DSA_K;
                    if (hf ? thi : tlo) thr = cand;
                    dlo = dlo || clo == DSA_K; dhi = dhi || chi == DSA_K;
                }
                int glo = 0, ghi = 0;
#pragma unroll 16
                for (int kt = 0; kt < nkt; ++kt) { const unsigned long long m = __ballot(KL[kt * 64 + lane] > thr); glo += __popc((unsigned)m); ghi += __popc((unsigned)(m >> 32)); }
                int nlo = DSA_K - glo, nhi = DSA_K - ghi;
                MW[lane] = 0u; MW[64 + lane] = 0u;
#pragma unroll 2
                for (int kt = 0; kt < nkt; ++kt) {
                    const unsigned kv = KL[kt * 64 + lane];
                    const bool gt = kv > thr, eq = kv == thr;
                    const unsigned long long meq = __ballot(eq); const unsigned mh = hf ? (unsigned)(meq >> 32) : (unsigned)meq;
                    const int need = hf ? nhi : nlo;
                    const bool sel = gt || (eq && (__popc(mh & ltmask) < need));
                    nlo -= __popc((unsigned)meq); nhi -= __popc((unsigned)(meq >> 32)); nlo = nlo < 0 ? 0 : nlo; nhi = nhi < 0 ? 0 : nhi;
                    const unsigned long long ms = __ballot(sel);
                    if (l31 == 0) MW[hf * 64 + kt] = hf ? (unsigned)(ms >> 32) : (unsigned)ms;
                }
                const unsigned wA = MW[hf * 64 + l31], wB = MW[hf * 64 + 32 + l31];
                if (tsel == 0) { wA0 = wA; wB0 = wB; } else { wA1 = wA; wB1 = wB; }
            }
        }
        unsigned* m0 = MASK + (size_t)(t0 + 2 * hf) * 64;
        m0[l31] = wA0; m0[32 + l31] = wB0; m0[64 + l31] = wA1; m0[96 + l31] = wB1;
        }
    }
    __syncthreads();
}

constexpr int AT_STAGE = 32768;
__device__ __forceinline__ void phase_dsa_att(const Ctx& c, int l) {
    const bf16* QLAT = (const bf16*)(c.ws + WS_QLAT); const bf16* CKVN = (const bf16*)(c.ws + WS_CKVN); const bf16* CKVT = (const bf16*)(c.ws + WS_CKVT);
    const unsigned* MASK = (const unsigned*)(c.ws + WS_MASK); bf16* OLAT = (bf16*)(c.ws + WS_OLAT);
    const int tid = c.tid, lane = c.lane, h = c.wave, fr = lane & 15, fq = lane >> 4;
    const float slope2 = exp2f(-(float)(h + 1)) * 1.4426950408889634f;
    const int dn_r = tid >> 4, dn_c = ((tid & 15) ^ ((tid >> 4) & 15)) * 8;
    const int dt_r = tid >> 3, dt_c = ((tid & 7) ^ ((tid >> 3) & 7)) * 8;
    const unsigned ldsw = (unsigned)h * 1024u;
#pragma unroll 1
    for (int k4 = 0; k4 < 1024; ++k4) {
        const int idx = c.bid + c.nblk * k4; if (idx >= 1024) break;
        const int b = idx & 15, g = idx >> 4, gk = g >> 4, gi = g & 15;
        const int qt = 63 - 16 * gk - ((gk & 1) ? (15 - gi) : gi);
        const int tq0 = qt * 32;
        const size_t tg0 = (size_t)b * SEQ + tq0;
        const int nkt = (tq0 + 31) / 64 + 1;
        bf16x8 Qf[2][4];
#pragma unroll
        for (int rt = 0; rt < 2; ++rt)
#pragma unroll
            for (int ks = 0; ks < 4; ++ks) Qf[rt][ks] = *(const bf16x8*)(QLAT + (tg0 + 16 * rt + fr) * 1024 + h * 128 + 32 * ks + 8 * fq);
        f32x4 O[2][8];
        float mrun[2], lrun[2];
#pragma unroll
        for (int rt = 0; rt < 2; ++rt) { mrun[rt] = -1e30f; lrun[rt] = 0.f;
#pragma unroll
            for (int n = 0; n < 8; ++n) O[rt][n] = (f32x4){0.f, 0.f, 0.f, 0.f}; }
#define AT_DMA(kt_, stg_) do { const bf16* _kn = CKVN + ((size_t)b * SEQ + 64 * (kt_) + dn_r) * 128 + dn_c; const bf16* _kt = CKVT + (((size_t)b * 32 + (kt_)) * 128 + dt_r) * 64 + dt_c; \
            LAS unsigned char* _d = c.lds + (stg_) * AT_STAGE + ldsw; \
            __builtin_amdgcn_global_load_lds((const unsigned*)_kn, (LAS unsigned*)_d, 16, 0, 0); __builtin_amdgcn_global_load_lds((const unsigned*)(_kn + 32 * 128), (LAS unsigned*)(_d + 8192), 16, 0, 0); \
            __builtin_amdgcn_global_load_lds((const unsigned*)_kt, (LAS unsigned*)(_d + 16384), 16, 0, 0); __builtin_amdgcn_global_load_lds((const unsigned*)(_kt + 64 * 64), (LAS unsigned*)(_d + 16384 + 8192), 16, 0, 0); } while (0)
        __syncthreads();
        AT_DMA(0, 0);
#pragma unroll 1
        for (int kt = 0; kt < nkt; ++kt) {
            u32x2 mw[2];
#pragma unroll
            for (int rt = 0; rt < 2; ++rt) mw[rt] = *(const u32x2*)(MASK + (tg0 + 16 * rt + fr) * 64 + 2 * kt);
            asm volatile("s_waitcnt vmcnt(2)" ::: "memory");
            __builtin_amdgcn_s_barrier(); asm volatile("" ::: "memory");
            if (kt + 1 < nkt) AT_DMA(kt + 1, (kt + 1) & 1);
            int lz; asm volatile("v_mov_b32 %0, 0" : "=v"(lz));
            const LAS unsigned char* Kn = c.lds + (kt & 1) * AT_STAGE + lz; const LAS unsigned char* KT = Kn + 16384;
            const float kb0 = slope2 * (float)(64 * kt + 4 * fq);
#pragma unroll
            for (int rt = 0; rt < 2; ++rt) {
                f32x4 S[4];
                {
                    bf16x8 kfa[4], kfb[4];
#pragma unroll
                    for (int ks = 0; ks < 4; ++ks) kfa[ks] = *(const LAS bf16x8*)(Kn + fr * 256 + (((4 * ks + fq) ^ fr) << 4));
#pragma unroll
                    for (int j = 0; j < 4; ++j) {
                        if (j + 1 < 4) {
#pragma unroll
                            for (int ks = 0; ks < 4; ++ks) { const bf16x8 t = *(const LAS bf16x8*)(Kn + (16 * (j + 1) + fr) * 256 + (((4 * ks + fq) ^ fr) << 4)); if (j & 1) kfa[ks] = t; else kfb[ks] = t; } }
                        f32x4 d = (f32x4){0.f, 0.f, 0.f, 0.f};
#pragma unroll
                        for (int ks = 0; ks < 4; ++ks) d = __builtin_amdgcn_mfma_f32_16x16x32_bf16((j & 1) ? kfb[ks] : kfa[ks], Qf[rt][ks], d, 0, 0, 0);
                        S[j] = d;
                        __builtin_amdgcn_sched_barrier(0);
                    }
                }
                float mx = -1e30f;
#pragma unroll
                for (int j = 0; j < 4; ++j) { const unsigned wsel = ((j < 2) ? mw[rt].x : mw[rt].y) >> (4 * fq);
#pragma unroll
                    for (int r = 0; r < 4; ++r) { const bool on = wsel & (1u << (16 * (j & 1) + r));
                        const float v = S[j][r] + fmaf(slope2, (float)(16 * j + r), kb0);
                        S[j][r] = on ? v : -INFINITY; mx = fmaxf(mx, S[j][r]); } }
                mx = fmaxf(mx, __shfl_xor(mx, 16)); mx = fmaxf(mx, __shfl_xor(mx, 32));
                const float mnew = fmaxf(mrun[rt], mx);
                const float alpha = __builtin_amdgcn_exp2f(mrun[rt] - mnew);
                float rs = 0.f;
#pragma unroll
                for (int j = 0; j < 4; ++j)
#pragma unroll
                    for (int r = 0; r < 4; ++r) { const float p = __builtin_amdgcn_exp2f(S[j][r] - mnew); S[j][r] = p; rs += p; }
                rs += __shfl_xor(rs, 16); rs += __shfl_xor(rs, 32);
                lrun[rt] = lrun[rt] * alpha + rs; mrun[rt] = mnew;
#pragma unroll
                for (int n = 0; n < 8; ++n) O[rt][n] *= alpha;
                bf16x8 Pf[2];
#pragma unroll
                for (int ks2 = 0; ks2 < 2; ++ks2) { u32x4 w; w.x = pk2(S[2 * ks2][0], S[2 * ks2][1]); w.y = pk2(S[2 * ks2][2], S[2 * ks2][3]);
                    w.z = pk2(S[2 * ks2 + 1][0], S[2 * ks2 + 1][1]); w.w = pk2(S[2 * ks2 + 1][2], S[2 * ks2 + 1][3]);
                    Pf[ks2] = __builtin_bit_cast(bf16x8, w); }
                {
                    const int sw = fr & 7, hb = (fq & 1) * 8;
                    u32x2 ta[4], tb[4];
#pragma unroll
                    for (int ks2 = 0; ks2 < 2; ++ks2) { const int c0 = 4 * ks2 + (fq >> 1);
                        ta[2 * ks2] = *(const LAS u32x2*)(KT + fr * 128 + ((c0 ^ sw) << 4) + hb); ta[2 * ks2 + 1] = *(const LAS u32x2*)(KT + fr * 128 + (((c0 + 2) ^ sw) << 4) + hb); }
#pragma unroll
                    for (int n = 0; n < 8; ++n) {
                        if (n + 1 < 8) {
#pragma unroll
                            for (int ks2 = 0; ks2 < 2; ++ks2) { const int c0 = 4 * ks2 + (fq >> 1);
                                const u32x2 x0 = *(const LAS u32x2*)(KT + (16 * (n + 1) + fr) * 128 + ((c0 ^ sw) << 4) + hb), x1 = *(const LAS u32x2*)(KT + (16 * (n + 1) + fr) * 128 + (((c0 + 2) ^ sw) << 4) + hb);
                                if (n & 1) { ta[2 * ks2] = x0; ta[2 * ks2 + 1] = x1; } else { tb[2 * ks2] = x0; tb[2 * ks2 + 1] = x1; } } }
#pragma unroll
                        for (int ks2 = 0; ks2 < 2; ++ks2) {
                            const u32x2 a0 = (n & 1) ? tb[2 * ks2] : ta[2 * ks2], a1 = (n & 1) ? tb[2 * ks2 + 1] : ta[2 * ks2 + 1];
                            const bf16x8 af = __builtin_bit_cast(bf16x8, (u32x4){a0.x, a0.y, a1.x, a1.y});
                            O[rt][n] = __builtin_amdgcn_mfma_f32_16x16x32_bf16(af, Pf[ks2], O[rt][n], 0, 0, 0);
                        }
                        __builtin_amdgcn_sched_barrier(0);
                    }
                }
            }
        }
#undef AT_DMA
#pragma unroll
        for (int rt = 0; rt < 2; ++rt) { const float inv = 1.f / lrun[rt];
#pragma unroll
            for (int n = 0; n < 8; ++n) st_bf4(OLAT + (tg0 + 16 * rt + fr) * 1024 + h * 128 + 16 * n + 4 * fq, O[rt][n] * inv); }
    }
    asm volatile("s_waitcnt vmcnt(0)" ::: "memory");
    __syncthreads();
}

__device__ __forceinline__ void expert_convert(const Ctx& c, int l, int gw, int NGW) {

        LAS float* scr = (LAS float*)(c.lds + c.wave * 16384);
        constexpr int I_GU = (512 / 32) * (1024 / 64), I_D = (1024 / 32) * (256 / 64), PER_E = I_GU + I_D;
        for (int it = gw; it < NEX * PER_E; it += NGW) {
            const int e = it / PER_E; int r = it % PER_E;
            if (r < I_GU) {
                const int n0 = (r / 16) * 32, pn = n0 >> 8, wi = n0 & 255, j0 = 128 * pn + (wi & 127);
                const float* Wg; const float* Wu;
                if (e < NE) { Wg = c.in[IN_EWG] + ((size_t)l * NE + e) * 1024 * 256; Wu = c.in[IN_EWU] + ((size_t)l * NE + e) * 1024 * 256; }
                else { Wg = c.in[IN_SWG] + (size_t)l * 1024 * 256; Wu = c.in[IN_SWU] + (size_t)l * 1024 * 256; }
                if (wi < 128) { SrcPlain s{Wg + j0 - n0, 256}; tr_item(s, (bf16*)(c.ws + WS_WGU) + (size_t)e * 512 * 1024, 1024, n0, (r % 16) * 64, scr, c.lane); }
                else { SrcPlain s{Wu + j0 - n0, 256}; tr_item(s, (bf16*)(c.ws + WS_WGU) + (size_t)e * 512 * 1024, 1024, n0, (r % 16) * 64, scr, c.lane); }
            } else { r -= I_GU;
                SrcPlain s; s.ld = 1024; s.W = e < NE ? c.in[IN_EWD] + ((size_t)l * NE + e) * 256 * 1024 : c.in[IN_SWD] + (size_t)l * 256 * 1024;
                tr_item(s, (bf16*)(c.ws + WS_WD) + (size_t)e * 1024 * 256, 256, (r / 4) * 32, (r % 4) * 64, scr, c.lane);
            }
        }
    }
__device__ __forceinline__ void route_one(int t, float logit, float rbias, int lane, unsigned* CNT, int* ROWL, float* WL, unsigned* TOKPOS) {
    const float score = sigmoidf_(logit), sel = score + rbias;
    const int g = lane >> 3;
    int rk8 = 0;
#pragma unroll
    for (int d = 1; d < 8; ++d) { const int ol = (lane & ~7) | ((lane + d) & 7); const float o = __shfl(sel, ol); rk8 += (o > sel || (o == sel && ol < lane)) ? 1 : 0; }
    float t2 = rk8 < 2 ? sel : 0.f;
    t2 += __shfl_xor(t2, 1); t2 += __shfl_xor(t2, 2); t2 += __shfl_xor(t2, 4);
    int rkg = 0;
#pragma unroll
    for (int d = 1; d < 8; ++d) { const int og = (g + d) & 7; const float o = __shfl(t2, og * 8); rkg += (o > t2 || (o == t2 && og < g)) ? 1 : 0; }
    const bool gsel = rkg < 4;
    bool chosen = false; float cur = gsel ? sel : -INFINITY;
#pragma unroll 1
    for (int it6 = 0; it6 < TOPK; ++it6) {
        const float mx = wave_max(cur);
        const unsigned long long me = __ballot(cur == mx);
        const int win = __ffsll((long long)me) - 1;
        if (lane == win) { chosen = true; cur = -INFINITY; }
    }
    const float wsum = wave_sum(chosen ? score : 0.f);
    const unsigned long long mk = __ballot(chosen);
    if (chosen) {
        const int hf = t >= HALF_T ? 1 : 0;
        const int kk = __popcll(mk & ((1ull << lane) - 1ull));
        const unsigned slot = atomicAdd(&CNT[hf * 64 + lane], 1u);
        ROWL[((size_t)hf * 64 + lane) * 16384 + slot] = t;
        WL[((size_t)hf * 64 + lane) * 16384 + slot] = score / wsum * 2.5f;
        if (kk < TOPK) TOKPOS[(size_t)t * 6 + kk] = ((unsigned)lane << 16) | slot;
    }
}
__device__ __forceinline__ void phase_route(const Ctx& c, int l, const float* x1) {
    expert_convert(c, l, c.bid * NWAVES + c.wave, c.nblk * NWAVES);
    __syncthreads();
    {
        LAS float* H = (LAS float*)c.lds;
        const int lane = c.lane, w = c.wave;
        const float* MOD = (const float*)(c.ws + WS_MOD) + (size_t)l * 16 * 6144;
        bf16* XN2 = (bf16*)(c.ws + WS_XN2);
        const float* RW = c.in[IN_RW] + (size_t)l * 1024 * 64; const float rbias = c.in[IN_RB][l * 64 + lane];
        unsigned* CNT = (unsigned*)(c.ws + WS_CTL) + CW_CNT + l * 128;
        int* ROWL = (int*)(c.ws + WS_ROWL); float* WL = (float*)(c.ws + WS_WL); unsigned* TOKPOS = (unsigned*)(c.ws + WS_TOKPOS);
        const float* gain = c.in[IN_NFFN] + l * D;
        for (int it = c.bid; it < T / 32; it += c.nblk) {
            const int t0 = it * 32, b = t0 >> 11;
            const float* sh = MOD + (size_t)b * 6144 + 3072; const float* sc = MOD + (size_t)b * 6144 + 4096;
            __syncthreads();
#pragma unroll
            for (int r = 0; r < 4; ++r) {
                const int rr = 4 * w + r;
                const float* xrow = x1 + (size_t)(t0 + rr) * D;
                f32x4 v[4]; float ssum = 0.f;
#pragma unroll
                for (int j = 0; j < 4; ++j) { v[j] = *(const f32x4*)(xrow + 4 * (lane + 64 * j)); ssum += v[j][0] * v[j][0] + v[j][1] * v[j][1] + v[j][2] * v[j][2] + v[j][3] * v[j][3]; }
                const float rstd = rsqrtf(wave_sum(ssum) * (1.f / D) + EPS);
#pragma unroll
                for (int j = 0; j < 4; ++j) { const int cc = 4 * (lane + 64 * j);
                    const f32x4 g = *(const f32x4*)(gain + cc), a4 = *(const f32x4*)(sc + cc), bb = *(const f32x4*)(sh + cc);
                    const f32x4 hv = v[j] * rstd * g * (a4 + 1.f) + bb;
                    st_bf4(XN2 + (size_t)(t0 + rr) * D + cc, hv); *(LAS f32x4*)(H + rr * 1024 + cc) = hv; }
            }
            __syncthreads();
            float acc[32];
#pragma unroll
            for (int r = 0; r < 32; ++r) acc[r] = 0.f;
            const float* rwp = RW + (size_t)(128 * w) * 64 + lane;
#pragma unroll 2
            for (int k = 0; k < 128; k += 4) {
                const float w0 = rwp[(size_t)k * 64], w1 = rwp[(size_t)(k + 1) * 64], w2 = rwp[(size_t)(k + 2) * 64], w3 = rwp[(size_t)(k + 3) * 64];
#pragma unroll
                for (int r = 0; r < 32; ++r) { const f32x4 hv = *(const LAS f32x4*)(H + r * 1024 + 128 * w + k); acc[r] += hv[0] * w0 + hv[1] * w1 + hv[2] * w2 + hv[3] * w3; }
            }
            __syncthreads();
#pragma unroll
            for (int r = 0; r < 32; ++r) H[(w * 32 + r) * 64 + lane] = acc[r];
            __syncthreads();
#pragma unroll 1
            for (int r = 0; r < 4; ++r) {
                const int rr = 4 * w + r; float lg = 0.f;
#pragma unroll
                for (int ww = 0; ww < 8; ++ww) lg += H[(ww * 32 + rr) * 64 + lane];
                route_one(t0 + rr, lg, rbias, lane, CNT, ROWL, WL, TOKPOS);
            }
        }
        __syncthreads();
    }
}

__device__ __forceinline__ void moe_tables(const Ctx& c, int l, int hf) {
    LAS int* cnt = (LAS int*)(c.lds + 140000); LAS int* off = cnt + 65; LAS int* tst = off + 65;
    __syncthreads();
    if (c.tid == 0) {
        const unsigned* CNT = (const unsigned*)(c.ws + WS_CTL) + CW_CNT + l * 128 + hf * 64;
        int o = 0, ts = 0;
        for (int e = 0; e < NEX; ++e) { const int n = e < NE ? (int)CNT[e] : HALF_T; cnt[e] = n; off[e] = o; tst[e] = ts; o += (n + 255) & ~255; ts += (n + 255) >> 8; }
        tst[NEX] = ts;
    }
    __syncthreads();
}
struct MoeSched1 { LAS const int* cnt; LAS const int* off; LAS const int* tst; int G, c; const char* XN2; const char* WGU; const int* ROWL; const float* WL; const int* IDENT;
    __device__ __forceinline__ bool next(int i, g8::GUnit& u) const {
        const int L = i * G + c; if (L >= 2 * tst[NEX]) return false;
        const int rt = L >> 1, pn = L & 1; int e = 0; while (tst[e + 1] <= rt) ++e;
        const int r0 = (rt - tst[e]) * 256;
        u.A = XN2; u.B = WGU + ((size_t)e * 512 + (size_t)pn * 256) * 2048;
        u.rl = e < NE ? ROWL + (size_t)e * 16384 + r0 : IDENT + r0; u.nvalid = cnt[e] - r0; u.erow0 = 0; u.ecol0 = pn * 256; u.x0 = off[e] + r0; u.xp = e < NE ? WL + (size_t)e * 16384 + r0 : nullptr; return true; } };
struct MoeSched2 { LAS const int* cnt; LAS const int* off; LAS const int* tst; int G, c; const char* HID; const char* WD;
    __device__ __forceinline__ bool next(int i, g8::GUnit& u) const {
        const int L = i * G + c; if (L >= 4 * tst[NEX]) return false;
        const int rt = L >> 2, pn = L & 3; int e = 0; while (tst[e + 1] <= rt) ++e;
        const int r0 = (rt - tst[e]) * 256;
        u.A = HID + (size_t)(off[e] + r0) * 512; u.B = WD + ((size_t)e * 1024 + (size_t)pn * 256) * 512;
        u.rl = nullptr; u.nvalid = 0; u.erow0 = 0; u.ecol0 = pn * 256; u.x0 = off[e] + r0; u.xp = nullptr; return true; } };
struct EpiG1u { bf16* HID;
    __device__ __forceinline__ void operator()(const g8::GUnit& u, int row, int col, f32x4 lo, f32x4 hi) const {
        const int hc = col - 128 * (col >> 8);
        f32x4 v = (f32x4){0.f, 0.f, 0.f, 0.f};
        if (row < u.nvalid) { const float w = u.xp ? u.xp[row] : 1.f;
#pragma unroll
            for (int i = 0; i < 4; ++i) v[i] = siluf_(lo[i]) * hi[i] * w; }
        st_bf4(HID + (size_t)(u.x0 + row) * 256 + hc, v);
    } };
struct EpiG2u { bf16* Y;
    __device__ __forceinline__ void operator()(const g8::GUnit& u, int row, int col, f32x4 lo, f32x4 hi) const {
        st_bf4(Y + (size_t)(u.x0 + row) * 1024 + col, lo); st_bf4(Y + (size_t)(u.x0 + row) * 1024 + col + 128, hi);
    } };
__device__ __forceinline__ void phase_gemm1(const Ctx& c, int l, int hf) {
    moe_tables(c, l, hf);
    LAS int* cnt = (LAS int*)(c.lds + 140000); LAS int* off = cnt + 65; LAS int* tst = off + 65;
    MoeSched1 S{cnt, off, tst, c.nblk, c.bid, (const char*)(c.ws + WS_XN2), (const char*)(c.ws + WS_WGU), (const int*)(c.ws + WS_ROWL) + (size_t)hf * 64 * 16384, (const float*)(c.ws + WS_WL) + (size_t)hf * 64 * 16384,
                (const int*)(c.ws + WS_IDENT) + (size_t)hf * HALF_T};
    EpiG1u E{(bf16*)(c.ws + WS_HID)};
    g8::gemm_phase<true>(c.lds, 2048u, 1024, S, E);
    __syncthreads();
}
__device__ __forceinline__ void phase_gemm2(const Ctx& c, int l, int hf) {
    moe_tables(c, l, hf);
    LAS int* cnt = (LAS int*)(c.lds + 140000); LAS int* off = cnt + 65; LAS int* tst = off + 65;
    MoeSched2 S{cnt, off, tst, c.nblk, c.bid, (const char*)(c.ws + WS_HID), (const char*)(c.ws + WS_WD)};
    EpiG2u E{(bf16*)(c.ws + WS_Y)};
    g8::gemm_phase<false>(c.lds, 512u, 256, S, E);
    __syncthreads();
}
__device__ __forceinline__ void phase_combine(const Ctx& c, int l, int hf, float* xio) {
    moe_tables(c, l, hf);
    LAS int* off = (LAS int*)(c.lds + 140000) + 65;
    const int gw = c.bid * NWAVES + c.wave, NGW = c.nblk * NWAVES, lane = c.lane;
    const bf16* Y = (const bf16*)(c.ws + WS_Y); const unsigned* TOKPOS = (const unsigned*)(c.ws + WS_TOKPOS);
    const float* MODl = (const float*)(c.ws + WS_MOD) + (size_t)l * 16 * 6144;
    const float* MODn = (const float*)(c.ws + WS_MOD) + (size_t)1 * 16 * 6144;
    bf16* XN = (bf16*)(c.ws + WS_XN);
    unsigned tpn[TOPK];
    if (gw < HALF_T) {
#pragma unroll
        for (int kk = 0; kk < TOPK; ++kk) tpn[kk] = TOKPOS[(size_t)(hf * HALF_T + gw) * 6 + kk]; }
#pragma unroll 1
    for (int tt = gw; tt < HALF_T; tt += NGW) {
        const int t = hf * HALF_T + tt, b = t >> 11;
        unsigned tp[TOPK];
#pragma unroll
        for (int kk = 0; kk < TOPK; ++kk) tp[kk] = tpn[kk];
        f32x4 acc[4];
        u32x2 yv[TOPK + 1][4];
        { const bf16* yr = Y + (size_t)(off[NE] + tt) * 1024;
#pragma unroll
          for (int j = 0; j < 4; ++j) yv[TOPK][j] = *(const u32x2*)(yr + 4 * (lane + 64 * j)); }
#pragma unroll
        for (int kk = 0; kk < TOPK; ++kk) {
            const int e = tp[kk] >> 16, slot = tp[kk] & 0xffff;
            const bf16* yr = Y + (size_t)(off[e] + slot) * 1024;
#pragma unroll
            for (int j = 0; j < 4; ++j) yv[kk][j] = *(const u32x2*)(yr + 4 * (lane + 64 * j));
        }
        if (tt + NGW < HALF_T) {
#pragma unroll
            for (int kk = 0; kk < TOPK; ++kk) tpn[kk] = TOKPOS[(size_t)(t + NGW) * 6 + kk]; }
#pragma unroll
        for (int j = 0; j < 4; ++j) { acc[j] = (f32x4){bflo(yv[TOPK][j].x), bfhi(yv[TOPK][j].x), bflo(yv[TOPK][j].y), bfhi(yv[TOPK][j].y)};
#pragma unroll
            for (int kk = 0; kk < TOPK; ++kk) acc[j] += (f32x4){bflo(yv[kk][j].x), bfhi(yv[kk][j].x), bflo(yv[kk][j].y), bfhi(yv[kk][j].y)}; }
        float* xr = xio + (size_t)t * D; const float* g2 = MODl + (size_t)b * 6144 + 5120;
        f32x4 v[4]; float s = 0.f;
#pragma unroll
        for (int j = 0; j < 4; ++j) { const int cc = 4 * (lane + 64 * j); v[j] = *(const f32x4*)(xr + cc) + *(const f32x4*)(g2 + cc) * acc[j]; s += v[j][0] * v[j][0] + v[j][1] * v[j][1] + v[j][2] * v[j][2] + v[j][3] * v[j][3]; }
        const float rstd = rsqrtf(wave_sum(s) * (1.f / D) + EPS);
        if (l == 0) {
#pragma unroll
            for (int j = 0; j < 4; ++j) { const int cc = 4 * (lane + 64 * j); *(f32x4*)(xr + cc) = v[j];
                const f32x4 g = *(const f32x4*)(c.in[IN_NMIX] + D + cc), a = *(const f32x4*)(MODn + (size_t)b * 6144 + 1024 + cc), bb = *(const f32x4*)(MODn + (size_t)b * 6144 + cc);
                st_bf4(XN + (size_t)t * D + cc, v[j] * rstd * g * (a + 1.f) + bb); }
        } else {
#pragma unroll
            for (int j = 0; j < 4; ++j) { const int cc = 4 * (lane + 64 * j); *(f32x4*)(xr + cc) = v[j] * rstd * *(const f32x4*)(c.in[IN_NFIN] + cc); }
        }
    }
}

#ifdef DSA_NO_SEL
#define DSA_SEL_CALL
#else
#define DSA_SEL_CALL phase_ckvt(c); for (int r2 = 0; r2 < REPN(20); ++r2) phase_dsa_sel(c, l);
#endif
#ifdef DSA_NO_ATT
#define DSA_ATT_CALL
#else
#define DSA_ATT_CALL for (int r2 = 0; r2 < REPN(21); ++r2) phase_dsa_att(c, l);
#endif
constexpr int PH_PER_L = 18, N_PHASES = 1 + NL * PH_PER_L;
#ifndef PH_MASK
#define PH_MASK 0xFFFFFFFFu
#endif
#define IN(k) (lo <= (k) && (k) < hi)
#define EN(b) ((PH_MASK >> (b)) & 1u)
#ifndef REP_MASK
#define REP_MASK 0u
#endif
#define REPN(b) (((REP_MASK >> (b)) & 1u) ? 2 : 1)
#define SEAM(k) do { if (MK_ONE_LAUNCH && IN(k) && IN((k) + 1)) xcd_barrier(bar); } while (0)
template <int l>
__device__ __forceinline__ void layer_program(const Ctx& c, const XcdBarrier& bar, int lo, int hi) {
        const int P = 1 + l * PH_PER_L;
        const float* xin = l == 0 ? c.in[IN_X] : c.out;
        bf16* PB = (bf16*)(c.ws + WS_PB); float* SM = (float*)(c.ws + WS_SM);
        const bf16* XN = (const bf16*)(c.ws + WS_XN);
        const bf16* WIN = (const bf16*)(c.ws + WS_WIN) + (size_t)l * NINP * 1024;
        if (EN(1) && IN(P + 0)) { for (int rep = 0; rep < REPN(1); ++rep) {  if (l == 0) phase_norm1(c, 0, c.in[IN_X]);  if (rep + 1 < REPN(1)) xcd_barrier(bar); } } if (l == 0) SEAM(P + 0);
        if (EN(2) && IN(P + 1)) { for (int rep = 0; rep < REPN(2); ++rep) {  EpiInPB E{PB, SM}; dgemm_phase(c, XN, 1024, T, WIN, NPB / 256, 1024, EpiU<decltype(E)>{E});  if (rep + 1 < REPN(2)) xcd_barrier(bar); } } SEAM(P + 1);
        if (EN(3) && IN(P + 2)) { for (int rep = 0; rep < REPN(3); ++rep) {  phase_prep(c, l);  if (rep + 1 < REPN(3)) xcd_barrier(bar); } } SEAM(P + 2);
        if (EN(4) && IN(P + 3)) { for (int rep = 0; rep < REPN(4); ++rep) {
#if SCAN_3PASS
            for (int r2 = 0; r2 < REPN(22); ++r2) phase_scanA(c, l);
            xcd_barrier(bar); scanB(c);
            { EpiQ Eq{(bf16*)(c.ws + WS_QLAT), (bf16*)(c.ws + WS_QIDX), (const float*)(c.ws + WS_RSTDQ)};
              dgemm_phase(c, PB + PB_CQ, NPB, T, (const bf16*)(c.ws + WS_WQ) + (size_t)l * 1280 * 256, 5, 256, EpiU<decltype(Eq)>{Eq}); }
            xcd_barrier(bar); phase_scanC(c, l);
#else
            phase_scans(c, l);
#endif
            if (rep + 1 < REPN(4)) xcd_barrier(bar); } } SEAM(P + 3);
        if (EN(6) && IN(P + 5)) { for (int rep = 0; rep < REPN(6); ++rep) {  EpiGate E{(bf16*)(c.ws + WS_G)}; dgemm_phase(c, XN, 1024, T, WIN + (size_t)NPB * 1024, NG / 256, 1024, EpiU<decltype(E)>{E});  if (rep + 1 < REPN(6)) xcd_barrier(bar); } }
        if (EN(7) && IN(P + 6)) { for (int rep = 0; rep < REPN(7); ++rep) {  DSA_SEL_CALL xcd_barrier(bar); DSA_ATT_CALL  if (rep + 1 < REPN(7)) xcd_barrier(bar); } } SEAM(P + 6);
        if (EN(8) && IN(P + 7)) {
            { EpiUp E{(bf16*)(c.ws + WS_M1), (const bf16*)(c.ws + WS_G), 0, 1};
              dgemm_phase(c, (const bf16*)(c.ws + WS_UA), 512, T, (const bf16*)(c.ws + WS_WUPA) + (size_t)l * 1024 * 512, 4, 512, EpiU<decltype(E)>{E}); }
            { EpiUp E{(bf16*)(c.ws + WS_M1), (const bf16*)(c.ws + WS_G), 1024, 0};
              dgemm_phase(c, (const bf16*)(c.ws + WS_OLAT), 1024, T, (const bf16*)(c.ws + WS_WUVB) + (size_t)l * 1024 * 1024, 4, 1024, EpiU<decltype(E)>{E}); }
            { EpiUp E{(bf16*)(c.ws + WS_M1), (const bf16*)(c.ws + WS_G), 2048, 0};
              dgemm_phase(c, (const bf16*)(c.ws + WS_UC), 512, T, (const bf16*)(c.ws + WS_WUPC) + (size_t)l * 1024 * 512, 4, 512, EpiU<decltype(E)>{E}); }
        } SEAM(P + 9);
        if (EN(11) && IN(P + 10)) { for (int rep = 0; rep < REPN(11); ++rep) {  EpiWo E{xin, c.out, (const float*)(c.ws + WS_MOD) + (size_t)l * 16 * 6144 + 2048};
            dgemm_phase(c, (const bf16*)(c.ws + WS_M1), 1024, T, (const bf16*)(c.ws + WS_WO) + (size_t)l * 1024 * 1024, 4, 1024, EpiU<decltype(E)>{E});  if (rep + 1 < REPN(11)) xcd_barrier(bar); } } SEAM(P + 10);
        if (EN(12) && IN(P + 11)) { for (int rep = 0; rep < REPN(12); ++rep) {  phase_route(c, l, c.out);  if (rep + 1 < REPN(12)) xcd_barrier(bar); } } SEAM(P + 11);
        if (EN(13) && IN(P + 12)) { for (int rep = 0; rep < REPN(13); ++rep) {  phase_gemm1(c, l, 0);  if (rep + 1 < REPN(13)) xcd_barrier(bar); } } SEAM(P + 12);
        if (EN(14) && IN(P + 13)) { for (int rep = 0; rep < REPN(14); ++rep) {  phase_gemm2(c, l, 0);  if (rep + 1 < REPN(14)) xcd_barrier(bar); } } SEAM(P + 13);
        if (EN(15) && IN(P + 14)) { phase_gemm1(c, l, 1); phase_combine(c, l, 0, c.out); } SEAM(P + 14);
        if (EN(17) && IN(P + 16)) { for (int rep = 0; rep < REPN(17); ++rep) {  phase_gemm2(c, l, 1);  if (rep + 1 < REPN(17)) xcd_barrier(bar); } } SEAM(P + 16);
        if (EN(18) && IN(P + 17)) { for (int rep = 0; rep < REPN(18); ++rep) {  phase_combine(c, l, 1, c.out);  if (rep + 1 < REPN(18)) xcd_barrier(bar); } } SEAM(P + 17);
    }
__global__ void __launch_bounds__(NTHR, 2) fwd(Args args) {
    extern __shared__ __attribute__((aligned(16))) unsigned char lds_raw[];
    Ctx c;
    c.lds = (LAS unsigned char*)lds_raw;
    c.tid = threadIdx.x; c.lane = c.tid & 63; c.wave = __builtin_amdgcn_readfirstlane(c.tid >> 6);
    c.bid = blockIdx.x; c.nblk = gridDim.x;
    c.in = args.in; c.out = args.out; c.ws = args.ws;
    for (int u = c.tid; u < (LDS_BYTES - LDS_MISC) / 4; u += NTHR) ((LAS unsigned*)(c.lds + LDS_MISC))[u] = 0u;
    __syncthreads();
    XcdBarrier bar; bar.bar = (unsigned*)(c.ws + WS_CTL) + CW_BAR; bar.x = 0; bar.st = (volatile LAS unsigned*)(c.lds + LDS_MISC);
    if (MK_ONE_LAUNCH) bar = xcd_barrier_post((unsigned*)(c.ws + WS_CTL) + CW_BAR, (volatile LAS unsigned*)(c.lds + LDS_MISC));
    const int lo = args.ph_lo, hi = args.ph_hi;
    if (EN(0) && IN(0)) { for (int rep = 0; rep < REPN(0); ++rep) { phase_prologue(c); if (rep + 1 < REPN(0)) xcd_barrier(bar); } } SEAM(0);
    layer_program<0>(c, bar, lo, hi);
    layer_program<1>(c, bar, lo, hi);
#undef IN
#undef SEAM
}

extern "C" void kernel_launch(void* const* d_in, const int* in_sizes, int n_in, void* d_out, int out_size, void* d_ws, size_t ws_size, hipStream_t stream) {
    static int grid = 0;
    if (grid == 0) {
        if (n_in != 33 || out_size != T * D || ws_size < WS_END) { fprintf(stderr, "kernel_launch: unexpected problem (n_in %d out %d ws %zu)\n", n_in, out_size, ws_size); grid = -1; return; }
        int dev = 0, cus = 0, per_cu = 0;
        if (hipGetDevice(&dev) != hipSuccess || hipDeviceGetAttribute(&cus, hipDeviceAttributeMultiprocessorCount, dev) != hipSuccess) { grid = -1; return; }
        if (hipFuncSetAttribute((const void*)fwd, hipFuncAttributeMaxDynamicSharedMemorySize, LDS_BYTES) != hipSuccess) { fprintf(stderr, "kernel_launch: hipFuncSetAttribute failed\n"); grid = -1; return; }
        if (hipOccupancyMaxActiveBlocksPerMultiprocessor(&per_cu, (const void*)fwd, NTHR, LDS_BYTES) != hipSuccess || per_cu < 1) { fprintf(stderr, "kernel_launch: occupancy query says %d\n", per_cu); }
        (void)hipGetLastError();
        grid = cus;
    }
    if (grid < 0) return;
    (void)hipMemsetAsync((char*)d_ws + WS_CTL, 0, CTL_BYTES, stream);
    Args a{};
    for (int i = 0; i < 33; ++i) a.in[i] = (const float*)d_in[i];
    a.out = (float*)d_out; a.ws = (unsigned char*)d_ws;
#if MK_ONE_LAUNCH
    a.ph_lo = 0; a.ph_hi = N_PHASES;
    hipLaunchKernelGGL(fwd, dim3(grid), dim3(NTHR), LDS_BYTES, stream, a);
#else
    for (int p = 0; p < N_PHASES; ++p) {
        if (p == 1 + PH_PER_L) continue;
        a.ph_lo = p; a.ph_hi = p + 1;
        hipLaunchKernelGGL(fwd, dim3(grid), dim3(NTHR), LDS_BYTES, stream, a);
    }
#endif
}
```

```cpp
#include <hip/hip_runtime.h>
#include <cstdio>
#include <cstdint>

#define LAS __attribute__((address_space(3)))
#define GAS __attribute__((address_space(1)))
typedef unsigned short bf16;
typedef short bf16x8 __attribute__((ext_vector_type(8)));
typedef float f32x4 __attribute__((ext_vector_type(4)));
typedef float f32x2 __attribute__((ext_vector_type(2)));
typedef unsigned u32x4 __attribute__((ext_vector_type(4)));
typedef unsigned u32x2 __attribute__((ext_vector_type(2)));
typedef GAS unsigned gu32;

#ifndef PROBE_SEAM
#define PROBE_SEAM -1
#endif
#ifndef SCAN_3PASS
#define SCAN_3PASS 1
#endif
#ifndef SCAN_RECURRENT
#define SCAN_RECURRENT 0
#endif
#ifndef CONV_REP
#define CONV_REP 1
#endif
#ifndef MK_ONE_LAUNCH
#define MK_ONE_LAUNCH 1
#endif

constexpr int NB = 16, SEQ = 2048, D = 1024, T = NB * SEQ, NL = 2;
constexpr int NIN = 6592, NPB = 3584, NG = 3072, NINP = NPB + NG;
constexpr int NE = 64, NEX = 65, EFF = 256, TOPK = 6;
constexpr int HALF_T = T / 2;
constexpr int DSA_K = 256;
constexpr float EPS = 1e-6f;
constexpr int NTHR = 512, NWAVES = 8;

constexpr int PB_QA = 0, PB_KA = 256, PB_VA = 512, PB_GA = 1024, PB_CQ = 1536, PB_CKV = 1792, PB_QC = 2048, PB_KC = 2304, PB_VC = 2560, PB_OC = 3072;
constexpr int SM_KIDX = 0, SM_ALR = 32, SM_WIDX = 48, SM_IC = 56, SM_FC = 60;

constexpr size_t MiB = 1u << 20;
constexpr size_t WS_CTL = 0, CTL_BYTES = 1 * MiB;
constexpr size_t WS_MOD = 1 * MiB;
constexpr size_t WS_RSTDQ = 2 * MiB;
constexpr size_t WS_TOKPOS = 3 * MiB;
constexpr size_t WS_IDENT = 3 * MiB + 800 * 1024;
constexpr size_t WS_WIN = 4 * MiB;
constexpr size_t WS_WQ = 30 * MiB;
constexpr size_t WS_WUPA = 32 * MiB;
constexpr size_t WS_WUPC = 34 * MiB;
constexpr size_t WS_WUPB = 36 * MiB;
constexpr size_t WS_WUVF = 38 * MiB;
constexpr size_t WS_WO = 40 * MiB;
constexpr size_t WS_WGU = 44 * MiB;
constexpr size_t WS_WD = 109 * MiB;
constexpr size_t WS_XN = 142 * MiB;
constexpr size_t WS_OLAT = WS_XN;
constexpr size_t WS_UA = 206 * MiB;
constexpr size_t WS_UC = 238 * MiB;
constexpr size_t WS_XN2 = 206 * MiB;
constexpr size_t WS_QLAT = 270 * MiB;
constexpr size_t WS_M1 = WS_QLAT;
constexpr size_t WS_QIDX = 334 * MiB;
constexpr size_t WS_CKVN = 350 * MiB;
constexpr size_t WS_KIDX = 358 * MiB;
constexpr size_t WS_SM = 360 * MiB;
constexpr size_t WS_PB = 376 * MiB;
constexpr size_t WS_G = WS_PB;
constexpr size_t WS_HID = 270 * MiB;
constexpr size_t WS_Y = 334 * MiB;
constexpr size_t WS_ROWL = 590 * MiB;
constexpr size_t WS_WL = 598 * MiB;
constexpr size_t WS_CKVT = 576 * MiB;
constexpr size_t WS_MASK = 584 * MiB;
static_assert(WS_CKVT >= WS_G + (size_t)T * NG * 2 && WS_MASK + (size_t)T * 64 * 4 <= WS_PB + (size_t)T * NPB * 2, "CKVT/MASK placement");
constexpr size_t WS_QS = 44 * MiB;
constexpr size_t WS_DSG = 76 * MiB;
constexpr size_t WS_DSM = 600 * MiB;
constexpr size_t WS_ET = 108 * MiB;
constexpr size_t WS_CT = 108 * MiB + 512 * 1024;
constexpr size_t WS_MP = 108 * MiB + 768 * 1024;
constexpr size_t WS_GPM = 109 * MiB;
constexpr size_t WS_GBC = 110 * MiB;
constexpr size_t WS_DN = 111 * MiB;
constexpr size_t WS_KEYB = 44 * MiB;
constexpr size_t WS_MF = 568 * MiB;
constexpr size_t WS_END = 636 * MiB;
static_assert(WS_PB + (size_t)T * NPB * 2 <= 600 * MiB, "PB");
static_assert(WS_Y + (size_t)131072 * 1024 * 2 <= WS_ROWL, "Y");

constexpr int CW_BAR = 4096;
constexpr int CW_CNT = 16384;
constexpr int CNT_STRIDE = 64;

constexpr int LDS_BYTES = 147456;
constexpr int LDS_MISC = 145408;

__device__ __forceinline__ unsigned f2bf(float f) { unsigned u = __builtin_bit_cast(unsigned, f); return (u + 0x7fffu + ((u >> 16) & 1u)) >> 16; }
__device__ __forceinline__ float bf2f(unsigned b) { return __builtin_bit_cast(float, b << 16); }
typedef __bf16 bf16x2_t __attribute__((ext_vector_type(2)));
__device__ __forceinline__ unsigned pk2(float lo, float hi) { const f32x2 v = {lo, hi}; const bf16x2_t b = __builtin_convertvector(v, bf16x2_t); return __builtin_bit_cast(unsigned, b); }
__device__ __forceinline__ float bflo(unsigned w) { return __builtin_bit_cast(float, w << 16); }
__device__ __forceinline__ float bfhi(unsigned w) { return __builtin_bit_cast(float, w & 0xffff0000u); }
__device__ __forceinline__ float wave_sum(float v) {
#pragma unroll
    for (int o = 1; o < 64; o <<= 1) v += __shfl_xor(v, o);
    return v;
}
__device__ __forceinline__ float wave_max(float v) {
#pragma unroll
    for (int o = 1; o < 64; o <<= 1) v = fmaxf(v, __shfl_xor(v, o));
    return v;
}
__device__ __forceinline__ int wave_sum_i(int v) {
#pragma unroll
    for (int o = 1; o < 64; o <<= 1) v += __shfl_xor(v, o);
    return v;
}
__device__ __forceinline__ void lds_barrier() { asm volatile("s_waitcnt lgkmcnt(0)" ::: "memory"); __builtin_amdgcn_s_barrier(); asm volatile("" ::: "memory"); }
__device__ __forceinline__ float sigmoid_exact(float x) { return 1.f / (1.f + __expf(-x)); }
__device__ __forceinline__ float sigmoidf_(float x) { return __builtin_amdgcn_rcpf(1.f + __builtin_amdgcn_exp2f(-1.4426950408889634f * x)); }
__device__ __forceinline__ float siluf_(float x) { return x * __builtin_amdgcn_rcpf(1.f + __builtin_amdgcn_exp2f(-1.4426950408889634f * x)); }
__device__ __forceinline__ float logsigmoidf_(float x) { return fminf(x, 0.f) - log1pf(__expf(-fabsf(x))); }
__device__ __forceinline__ float logsigmoid_fast(float x) { return fminf(x, 0.f) - __logf(1.f + __expf(-fabsf(x))); }
__device__ __forceinline__ void st_bf4(bf16* p, f32x4 v) { u32x2 w; w.x = pk2(v[0], v[1]); w.y = pk2(v[2], v[3]); *(u32x2*)p = w; }
__device__ __forceinline__ void st_bf8(bf16* p, f32x4 a, f32x4 b) { u32x4 w; w.x = pk2(a[0], a[1]); w.y = pk2(a[2], a[3]); w.z = pk2(b[0], b[1]); w.w = pk2(b[2], b[3]); *(u32x4*)p = w; }
__device__ __forceinline__ f32x4 ld_bf4_l2(const bf16* p) { const unsigned long long q = __hip_atomic_load((const unsigned long long*)p, __ATOMIC_RELAXED, __HIP_MEMORY_SCOPE_AGENT); const unsigned lo = (unsigned)q, hi = (unsigned)(q >> 32); return (f32x4){bflo(lo), bfhi(lo), bflo(hi), bfhi(hi)}; }
__device__ __forceinline__ f32x4 ld_bf4(const bf16* p) { u32x2 w = *(const u32x2*)p; return (f32x4){bflo(w.x), bfhi(w.x), bflo(w.y), bfhi(w.y)}; }

#define XB_TMO      128
#define XB_XCNT(j)  (256  + 64 * (j))
#define XB_XSUB(j)  (1280 + 64 * (j))
#define XB_XGEN(j)  (2304 + 64 * (j))
#define XB_TOP      3328
#define XB_TOPGEN   3392
#define XCD_BAR_WORDS 3456
#define XB_SPIN_CAP (1u << 22)
__device__ __forceinline__ unsigned xb_ld(unsigned* p)              { return __hip_atomic_load(p, __ATOMIC_RELAXED, __HIP_MEMORY_SCOPE_AGENT); }
__device__ __forceinline__ unsigned xb_add(unsigned* p, unsigned v) { return __hip_atomic_fetch_add(p, v, __ATOMIC_RELAXED, __HIP_MEMORY_SCOPE_AGENT); }
__device__ __forceinline__ unsigned xb_xcc_id() { return (unsigned)__builtin_amdgcn_s_getreg((3 << 11) | 20) & 0xFu; }
#define XB_SPIN(cond, bar) do { unsigned _sp = 0; while (cond) { __builtin_amdgcn_s_sleep(1); \
    if ((++_sp & 255u) == 0u) { if (xb_ld(&(bar)[XB_TMO])) break; if (_sp > XB_SPIN_CAP) { atomicAdd(&(bar)[XB_TMO], 1u); break; } } } } while (0)
struct XcdBarrier { unsigned* bar; unsigned x; volatile LAS unsigned* st; };
__device__ __forceinline__ XcdBarrier xcd_barrier_post(unsigned* bar, volatile LAS unsigned* st) {
    XcdBarrier b; b.bar = bar; b.x = xb_xcc_id(); b.st = st;
    if (threadIdx.x == 0) (void)xb_add(&bar[XB_XCNT(b.x)], 1u);
    return b;
}
__device__ __forceinline__ void xcd_barrier_complete(unsigned* bar, unsigned x, unsigned& nloc, unsigned& nx) {
    const unsigned G = gridDim.x * gridDim.y * gridDim.z;
    unsigned sum, cnt, mine, sp = 0u;
    for (;;) {
        sum = 0u; cnt = 0u; mine = 0u;
#pragma unroll
        for (unsigned j = 0; j < 16; ++j) { const unsigned c = xb_ld(&bar[XB_XCNT(j)]); sum += c; cnt += (c > 0u) ? 1u : 0u; mine = (j == x) ? c : mine; }
        if (sum == G) break;
        __builtin_amdgcn_s_sleep(1);
        if ((++sp & 255u) == 0u) { if (xb_ld(&bar[XB_TMO])) break; if (sp > XB_SPIN_CAP) { atomicAdd(&bar[XB_TMO], 1u); break; } }
    }
    nloc = mine > 0u ? mine : 1u; nx = cnt > 0u ? cnt : 1u;
}
__device__ __forceinline__ void xcd_barrier(const XcdBarrier& b) {
    asm volatile("s_waitcnt vmcnt(0)" ::: "memory");
    __syncthreads();
    if (threadIdx.x == 0) {
        unsigned* bar = b.bar;
        __builtin_amdgcn_s_waitcnt(0);
        unsigned nloc = b.st[0], nx = b.st[1];
        if (nloc == 0u) { xcd_barrier_complete(bar, b.x, nloc, nx); b.st[0] = nloc; b.st[1] = nx; }
        const unsigned old = xb_add(&bar[XB_XSUB(b.x)], 1u);
        const unsigned gen = old / nloc;
        if (old + 1u == (gen + 1u) * nloc) {
            __builtin_amdgcn_fence(__ATOMIC_RELEASE, "agent");
            asm volatile("s_waitcnt vmcnt(0)" ::: "memory");
            const unsigned og = xb_add(&bar[XB_TOP], 1u);
            const unsigned tg = og / nx;
            if (og + 1u == (tg + 1u) * nx) xb_add(&bar[XB_TOPGEN], 1u);
            else XB_SPIN(xb_ld(&bar[XB_TOPGEN]) == tg, bar);
            __builtin_amdgcn_fence(__ATOMIC_ACQUIRE, "agent");
            xb_add(&bar[XB_XGEN(b.x)], 1u);
            asm volatile("s_waitcnt vmcnt(0)" ::: "memory");
        } else {
            XB_SPIN(xb_ld(&bar[XB_XGEN(b.x)]) == gen, bar);
            __builtin_amdgcn_fence(__ATOMIC_ACQUIRE, "agent");
            asm volatile("s_waitcnt vmcnt(0)" ::: "memory");
        }
#if PROBE_SEAM >= 0
        if (blockIdx.x == 0) { const unsigned n = b.st[2]; ((unsigned long long*)(b.bar + 8192))[n] = wall_clock64(); b.st[2] = n + 1u; }
#endif
    }
    __syncthreads();
}

struct Args { const float* in[33]; float* out; unsigned char* ws; int ph_lo, ph_hi; };

struct Ctx {
    LAS unsigned char* lds;
    int tid, lane, wave, bid, nblk;
    const float* const* in;
    float* out; unsigned char* ws;
};
#define IN_X 0
#define IN_C 1
#define IN_ADAW 2
#define IN_ADAB 3
#define IN_NMIX 4
#define IN_NFFN 5
#define IN_WIN 6
#define IN_GLA_WA2 7
#define IN_GLA_BA 8
#define IN_GLA_NORM 9
#define IN_DSA_NQ 10
#define IN_DSA_NKV 11
#define IN_DSA_WUQ 12
#define IN_DSA_WUK 13
#define IN_DSA_WUV 14
#define IN_DSA_WQI 15
#define IN_ML_CONV 16
#define IN_ML_BI 17
#define IN_ML_BF 18
#define IN_ML_NORM 19
#define IN_WUPA 20
#define IN_WUPB 21
#define IN_WUPC 22
#define IN_WO 23
#define IN_RW 24
#define IN_RB 25
#define IN_EWG 26
#define IN_EWU 27
#define IN_EWD 28
#define IN_SWG 29
#define IN_SWU 30
#define IN_SWD 31
#define IN_NFIN 32

template <class SrcF>
__device__ __forceinline__ void tr_item(const SrcF& src, bf16* dst, int dst_ld, int n0, int k0, LAS float* scr, int lane) {
    const int j = lane & 31;
    const float* colp = src(n0 + j);
    const long ld = src.ld;
    float tv[32];
#pragma unroll
    for (int i = 0; i < 32; ++i) { const int kk = 2 * i + (lane >> 5); tv[i] = colp ? colp[(long)(k0 + kk) * ld] : 0.f; }
#pragma unroll
    for (int i = 0; i < 32; ++i) { const int kk = 2 * i + (lane >> 5); scr[kk * 33 + j] = tv[i]; }
    asm volatile("s_waitcnt lgkmcnt(0)" ::: "memory");
    const int c = lane & 7;
#pragma unroll
    for (int jj = 0; jj < 4; ++jj) { const int n = (lane >> 3) + 8 * jj; const LAS float* s = scr + (8 * c) * 33 + n;
        u32x4 o; o.x = pk2(s[0 * 33], s[1 * 33]); o.y = pk2(s[2 * 33], s[3 * 33]); o.z = pk2(s[4 * 33], s[5 * 33]); o.w = pk2(s[6 * 33], s[7 * 33]);
        *(u32x4*)(dst + (size_t)(n0 + n) * dst_ld + k0 + 8 * c) = o; }
    asm volatile("s_waitcnt lgkmcnt(0)" ::: "memory");
}
struct SrcPlain { const float* W; long ld; __device__ __forceinline__ const float* operator()(int n) const { return W + n; } };
__device__ __forceinline__ int win_src_col(int r) {
    if (r < 1536) return r;
    if (r < 1792) return 1552 + (r - 1536);
    if (r < 1920) return 1808 + (r - 1792);
    if (r < 1952) return 1936 + (r - 1920);
    if (r < 1968) return 1536 + (r - 1952);
    if (r < 1976) return 1968 + (r - 1968);
    if (r < 1980) return 3000 + (r - 1976);
    if (r < 1984) return 3004 + (r - 1980);
    if (r < 2048) return -1;
    if (r < 2560) return 1976 + (r - 2048);
    if (r < 3072) return 2488 + (r - 2560);
    if (r < 3584) return 3008 + (r - 3072);
    return 3520 + (r - 3584);
}
struct SrcWin { const float* W; long ld; __device__ __forceinline__ const float* operator()(int n) const { const int c = win_src_col(n); return c < 0 ? nullptr : W + c; } };
struct SrcGU { const float* Wg; const float* Wu; long ld;
    __device__ __forceinline__ const float* operator()(int r) const { const int pn = r >> 8, w = r & 255, j = 128 * pn + (w & 127); return (w < 128 ? Wg : Wu) + j; } };

constexpr int SG_LD = 40;
template <class Epi>
__device__ __forceinline__ void sgemm_unit(const Ctx& c, const bf16* A, int lda, const int* rowlist, int nvalid, int arow0, const bf16* Bt, int K, const Epi& E, int erow0, int ecol0) {
    LAS bf16* As = (LAS bf16*)c.lds;
    LAS bf16* Bs = (LAS bf16*)(c.lds + 128 * SG_LD * 2);
    const int tid = c.tid, lane = c.lane, wave = c.wave, wr = wave >> 2, wc = wave & 3, fr = lane & 15, fq = lane >> 4;
    const int lr = tid >> 2, ch = tid & 3;
    int srow = arow0 + lr;
    if (rowlist) { srow = (arow0 + lr < nvalid) ? rowlist[arow0 + lr] : 0; }
    const bf16* ap = A + (size_t)srow * lda + ch * 8;
    const bf16* bp0 = Bt + (size_t)lr * K + ch * 8;
    const bf16* bp1 = Bt + (size_t)(128 + lr) * K + ch * 8;
    f32x4 acc[2][4][2];
#pragma unroll
    for (int a = 0; a < 2; ++a)
#pragma unroll
        for (int m = 0; m < 4; ++m)
#pragma unroll
            for (int n = 0; n < 2; ++n) acc[a][m][n] = (f32x4){0.f, 0.f, 0.f, 0.f};
    u32x4 ra = *(const u32x4*)ap, rb0 = *(const u32x4*)bp0, rb1 = *(const u32x4*)bp1;
    for (int k0 = 0; k0 < K; k0 += 32) {
        __syncthreads();
        *(LAS u32x4*)(As + lr * SG_LD + ch * 8) = ra;
        *(LAS u32x4*)(Bs + lr * SG_LD + ch * 8) = rb0;
        *(LAS u32x4*)(Bs + (128 + lr) * SG_LD + ch * 8) = rb1;
        __syncthreads();
        if (k0 + 32 < K) { ra = *(const u32x4*)(ap + k0 + 32); rb0 = *(const u32x4*)(bp0 + k0 + 32); rb1 = *(const u32x4*)(bp1 + k0 + 32); }
        bf16x8 af[4], bfr[2][2];
#pragma unroll
        for (int m = 0; m < 4; ++m) af[m] = *(const LAS bf16x8*)(As + (wr * 64 + m * 16 + fr) * SG_LD + fq * 8);
#pragma unroll
        for (int bj = 0; bj < 2; ++bj)
#pragma unroll
            for (int n = 0; n < 2; ++n) bfr[bj][n] = *(const LAS bf16x8*)(Bs + (bj * 128 + wc * 32 + n * 16 + fr) * SG_LD + fq * 8);
#pragma unroll
        for (int bj = 0; bj < 2; ++bj)
#pragma unroll
            for (int m = 0; m < 4; ++m)
#pragma unroll
                for (int n = 0; n < 2; ++n) acc[bj][m][n] = __builtin_amdgcn_mfma_f32_16x16x32_bf16(bfr[bj][n], af[m], acc[bj][m][n], 0, 0, 0);
    }
#pragma unroll
    for (int m = 0; m < 4; ++m)
#pragma unroll
        for (int n = 0; n < 2; ++n) E(erow0 + wr * 64 + m * 16 + fr, ecol0 + wc * 32 + n * 16 + 4 * fq, acc[0][m][n], acc[1][m][n]);
}
template <class Epi>
__device__ __forceinline__ void sgemm_phase(const Ctx& c, const bf16* A, int lda, int M, const bf16* Bt, int ntn, int K, const Epi& E) {
    const int nu = (M / 128) * ntn;
    for (int u = c.bid; u < nu; u += c.nblk) {
        const int pm = u / ntn, pn = u % ntn;
        sgemm_unit(c, A, lda, nullptr, 0, pm * 128, Bt + (size_t)pn * 256 * K, K, E, pm * 128, pn * 256);
    }
    __syncthreads();
}


namespace g8 {
constexpr int BM = 256, BK = 64, HALF = 128, HTB = HALF * BK * 2, STAGE_BYTES = 8 * HTB, NXCD = 8, WGM = 8;
__host__ __device__ __forceinline__ int lds_byte(int r, int c) { const int st = (r >> 4) * 2 + (c >> 5), rr = r & 15, cc = c & 31, ob = rr * 64 + cc * 2; return st * 1024 + (ob ^ (((ob >> 9) & 1) << 5)); }
__host__ __device__ __forceinline__ void stage_rc(int b, int& R, int& C) { const int st = b / 1024, sb = b % 1024, swz = sb ^ (((sb >> 9) & 1) << 5); R = (st >> 1) * 16 + swz / 64; C = (st & 1) * 32 + (swz % 64) / 2; }
__host__ __device__ __forceinline__ int perm32(int rho) { const int n = rho >> 4, i = rho & 15; return 8 * (i >> 2) + 4 * n + (i & 3); }
struct GUnit { const char* A; const char* B; const int* rl; int nvalid; int erow0, ecol0; int x0; const float* xp; };
__device__ __forceinline__ bool static_order(int nM, int nN, int G, int c, int i, int& pm, int& pn) {
    const int nwg = nM * nN; const long L = (long)i * G + c; if (L >= nwg) return false;
    int wgid = (int)L; { const int q = nwg / NXCD, r = nwg % NXCD, xcd = wgid % NXCD, off = wgid / NXCD; wgid = (xcd < r ? xcd * (q + 1) : r * (q + 1) + (xcd - r) * q) + off; }
    const int nig = WGM * nN, gid = wgid / nig, fm = gid * WGM, gsz = (nM - fm) < WGM ? (nM - fm) : WGM;
    pm = fm + ((wgid % nig) % gsz); pn = (wgid % nig) / gsz; return true;
}
struct DenseSched { const char* A; const char* Bt; size_t ldaB, ldbB; int nM, nN, G, c;
    __device__ __forceinline__ bool next(int i, GUnit& u) const { int pm, pn; if (!static_order(nM, nN, G, c, i, pm, pn)) return false;
        u.A = A + (size_t)pm * 256 * ldaB; u.B = Bt + (size_t)pn * 256 * ldbB; u.rl = nullptr; u.nvalid = 0; u.erow0 = pm * 256; u.ecol0 = pn * 256; u.x0 = 0; u.xp = nullptr; return true; } };

template <bool GATHER, class Epi, class Sched>
__device__ __forceinline__ void gemm_phase(LAS unsigned char* lds, unsigned ldaB, int K, const Sched& S, const Epi& E) {
    const int tid = threadIdx.x, wid = __builtin_amdgcn_readfirstlane(tid >> 6), lane = tid & 63, wr = wid >> 2, wc = wid & 3, fr = lane & 15, fq = lane >> 4;
    const int nt = K / BK;
    int R0, C0, R1, C1; stage_rc(tid * 16, R0, C0); stage_rc(tid * 16 + 8192, R1, C1);
    unsigned voffB[2];
    if (Epi::PERM) { voffB[0] = (unsigned)(((R0 & ~31) + perm32(R0 & 31)) * K + C0) * 2u; voffB[1] = (unsigned)(((R1 & ~31) + perm32(R1 & 31)) * K + C1) * 2u; }
    else { voffB[0] = (unsigned)(R0 * K + C0) * 2u; voffB[1] = (unsigned)(R1 * K + C1) * 2u; }
    unsigned ac0[2], ac1[2], an0[2], an1[2];
    const size_t kstep = (size_t)(BK * 2);
    const size_t hstepB = (size_t)HALF * K * 2;
    const unsigned ldsw = (unsigned)wid * 1024u;
    const int aoff = lds_byte(wr * 64 + fr, fq * 8), boff = lds_byte(wc * 32 + fr, fq * 8);
#define G8_SA(b, h) (((b) * 2 + (h)) * HTB)
#define G8_SB(b, h) ((4 + (b) * 2 + (h)) * HTB)
#define G8_STAGE(bufoff, gbase, voff) do { _Pragma("unroll") for (int _i = 0; _i < 2; ++_i) \
        __builtin_amdgcn_global_load_lds((const unsigned*)((const char*)(gbase) + (voff)[_i]), (LAS unsigned*)(lds + (bufoff) + ldsw + _i * 8192), 16, 0, 0); } while (0)
#define G8_LDA(dst, b, h) do { _Pragma("unroll") for (int m = 0; m < 4; ++m) _Pragma("unroll") for (int k = 0; k < 2; ++k) dst[m][k] = *(const LAS bf16x8*)(lds + G8_SA(b, h) + aoff + m * 2048 + k * 1024); } while (0)
#define G8_LDB(dst, b, h) do { _Pragma("unroll") for (int n = 0; n < 2; ++n) _Pragma("unroll") for (int k = 0; k < 2; ++k) dst[n][k] = *(const LAS bf16x8*)(lds + G8_SB(b, h) + boff + n * 2048 + k * 1024); } while (0)
#define G8_MMA(ai, bj, At, Bt) do { __builtin_amdgcn_s_setprio(1); _Pragma("unroll") for (int m = 0; m < 4; ++m) _Pragma("unroll") for (int n = 0; n < 2; ++n) _Pragma("unroll") for (int k = 0; k < 2; ++k) \
        acc[ai][bj][m][n] = __builtin_amdgcn_mfma_f32_16x16x32_bf16(Bt[n][k], At[m][k], acc[ai][bj][m][n], 0, 0, 0); __builtin_amdgcn_s_setprio(0); } while (0)
#define G8_WAIT_V(n) asm volatile("s_waitcnt vmcnt(" #n ")" ::: "memory")
#define G8_WAIT_L(n) asm volatile("s_waitcnt lgkmcnt(" #n ")" ::: "memory")
#define G8_BAR __builtin_amdgcn_s_barrier()
#define G8_SCHED __builtin_amdgcn_sched_barrier(0)
#define G8_XLOAD(u) __builtin_amdgcn_global_load_lds((const unsigned*)((u).rl + lane * 4), (LAS unsigned*)(lds + STAGE_BYTES + wid * 1024), 16, 0, 0)
#define G8_AOFF(u, o0, o1) do { if (GATHER) { const LAS int* _rs = (const LAS int*)(lds + STAGE_BYTES + wid * 1024); const int _nv = (u).nvalid - 1; \
        const int _r00 = _rs[min(R0, _nv)], _r01 = _rs[min(R1, _nv)], _r10 = _rs[min(128 + R0, _nv)], _r11 = _rs[min(128 + R1, _nv)]; \
        o0[0] = (unsigned)_r00 * ldaB + (unsigned)C0 * 2u; o0[1] = (unsigned)_r01 * ldaB + (unsigned)C1 * 2u; o1[0] = (unsigned)_r10 * ldaB + (unsigned)C0 * 2u; o1[1] = (unsigned)_r11 * ldaB + (unsigned)C1 * 2u; \
    } else { o0[0] = (unsigned)R0 * ldaB + (unsigned)C0 * 2u; o0[1] = (unsigned)R1 * ldaB + (unsigned)C1 * 2u; o1[0] = (unsigned)(128 + R0) * ldaB + (unsigned)C0 * 2u; o1[1] = (unsigned)(128 + R1) * ldaB + (unsigned)C1 * 2u; } } while (0)
    GUnit cur, nxt; int ui = 0;
    if (!S.next(0, cur)) return;
    f32x4 acc[2][2][4][2];
#pragma unroll
    for (int a = 0; a < 2; ++a)
#pragma unroll
        for (int b = 0; b < 2; ++b)
#pragma unroll
            for (int m = 0; m < 4; ++m)
#pragma unroll
                for (int n = 0; n < 2; ++n) acc[a][b][m][n] = (f32x4){0.f, 0.f, 0.f, 0.f};
    bf16x8 At[4][2], B0[2][2], B1[2][2];
    if (GATHER) { G8_XLOAD(cur); G8_WAIT_V(0); }
    G8_AOFF(cur, ac0, ac1);
    if (GATHER) { G8_WAIT_L(0); }
    const char* cA = cur.A; const char* cB = cur.B;
    G8_STAGE(G8_SB(0, 0), cB, voffB); G8_STAGE(G8_SB(0, 1), cB + hstepB, voffB); G8_STAGE(G8_SA(0, 0), cA, ac0); G8_STAGE(G8_SA(0, 1), cA, ac1);
    if (wr == 1) G8_BAR;
    G8_WAIT_V(2); G8_BAR;
    G8_STAGE(G8_SB(1, 0), cB + kstep, voffB); G8_STAGE(G8_SA(1, 0), cA + kstep, ac0); G8_STAGE(G8_SB(1, 1), cB + hstepB + kstep, voffB);
    G8_WAIT_V(6); G8_BAR;
    for (;;) {
        const bool has_next = S.next(ui + 1, nxt);
        const char* nA = has_next ? nxt.A : cA; const char* nB = has_next ? nxt.B : cB;
        an0[0] = ac0[0]; an0[1] = ac0[1]; an1[0] = ac1[0]; an1[1] = ac1[1];
        const bool xload = GATHER && has_next;
        if (xload) { G8_XLOAD(nxt); }
#pragma unroll 1
        for (int t = 0; t < nt; t += 2) {
            const bool last = (t == nt - 2);
            const char* a1 = cA + (size_t)(t + 1) * kstep;
            const char* a2 = last ? nA : cA + (size_t)(t + 2) * kstep; const char* b2 = last ? nB : cB + (size_t)(t + 2) * kstep;
            const char* a3 = a2 + kstep; const char* b3 = b2 + kstep;
            unsigned* x0 = last ? an0 : ac0; unsigned* x1 = last ? an1 : ac1;
            unsigned s0[2], s1[2]; s0[0] = x0[0]; s0[1] = x0[1]; s1[0] = x1[0]; s1[1] = x1[1];
            G8_LDB(B0, 0, 0); G8_LDB(B1, 0, 1); G8_SCHED; G8_LDA(At, 0, 0); G8_STAGE(G8_SA(1, 1), a1, ac1);
            if (xload && t == 0) { G8_WAIT_V(9); } else { G8_WAIT_V(8); }
            G8_WAIT_L(0); G8_BAR; G8_MMA(0, 0, At, B0); G8_MMA(0, 1, At, B1); G8_BAR; G8_SCHED;
            G8_LDA(At, 0, 1); G8_STAGE(G8_SB(0, 0), b2, voffB); G8_STAGE(G8_SB(0, 1), b2 + hstepB, voffB); G8_STAGE(G8_SA(0, 0), a2, s0);
            G8_WAIT_V(8); G8_WAIT_L(0); G8_BAR; G8_MMA(1, 0, At, B0); G8_MMA(1, 1, At, B1); G8_BAR; G8_SCHED;
            if (xload && t == 0) { G8_AOFF(nxt, an0, an1); }
            G8_LDB(B0, 1, 0); G8_LDB(B1, 1, 1); G8_SCHED; G8_LDA(At, 1, 0); G8_STAGE(G8_SA(0, 1), a2, s1);
            G8_WAIT_V(8); G8_WAIT_L(0); G8_BAR; G8_MMA(0, 0, At, B0); G8_MMA(0, 1, At, B1); G8_BAR; G8_SCHED;
            G8_LDA(At, 1, 1); G8_STAGE(G8_SB(1, 0), b3, voffB); G8_STAGE(G8_SB(1, 1), b3 + hstepB, voffB); G8_STAGE(G8_SA(1, 0), a3, s0);
            G8_WAIT_V(8); G8_WAIT_L(0); G8_BAR; G8_MMA(1, 0, At, B0); G8_MMA(1, 1, At, B1); G8_BAR; G8_SCHED;
        }
        if (wr == 0) G8_BAR;
#pragma unroll
        for (int ai = 0; ai < 2; ++ai) {
            if constexpr (Epi::PERM) {
                typename Epi::Pre pr8[4];
                const int fb8 = (wid * 16 * 64 + lane) * 8;
#pragma unroll
                for (int m = 0; m < 4; ++m) pr8[m] = E.pre(cur, cur.erow0 + ai * HALF + wr * 64 + m * 16 + fr, cur.ecol0 + wc * 32 + 8 * fq, fb8 + ((ai * 4 + m) * 2) * 512);
#pragma unroll
                for (int m = 0; m < 4; ++m) E.post8(cur, cur.erow0 + ai * HALF + wr * 64 + m * 16 + fr, cur.ecol0 + wc * 32 + 8 * fq, acc[ai][0][m][0], acc[ai][0][m][1], acc[ai][1][m][0], acc[ai][1][m][1], pr8[m], fb8 + ((ai * 4 + m) * 2) * 512);
            } else {
            const int fragbase = (wid * 32 * 64 + lane) * 4;
            constexpr int BMR = Epi::BATCH_M;
#pragma unroll
            for (int m0 = 0; m0 < 4; m0 += BMR) {
                typename Epi::Pre pr[BMR][2];
#pragma unroll
                for (int mm = 0; mm < BMR; ++mm)
#pragma unroll
                    for (int n = 0; n < 2; ++n) { const int m = m0 + mm; pr[mm][n] = E.pre(cur, cur.erow0 + ai * HALF + wr * 64 + m * 16 + fr, cur.ecol0 + wc * 32 + n * 16 + 4 * fq, fragbase + (((ai * 4 + m) * 2 + n) * 2) * 256); }
#pragma unroll
                for (int mm = 0; mm < BMR; ++mm)
#pragma unroll
                    for (int n = 0; n < 2; ++n) { const int m = m0 + mm; E.post(cur, cur.erow0 + ai * HALF + wr * 64 + m * 16 + fr, cur.ecol0 + wc * 32 + n * 16 + 4 * fq, acc[ai][0][m][n], acc[ai][1][m][n], pr[mm][n], fragbase + (((ai * 4 + m) * 2 + n) * 2) * 256); }
            }
            }
        }
        if (!has_next) break;
#pragma unroll
        for (int a = 0; a < 2; ++a)
#pragma unroll
            for (int b = 0; b < 2; ++b)
#pragma unroll
                for (int m = 0; m < 4; ++m)
#pragma unroll
                    for (int n = 0; n < 2; ++n) acc[a][b][m][n] = (f32x4){0.f, 0.f, 0.f, 0.f};
        cur = nxt; cA = nA; cB = nB; ++ui;
        ac0[0] = an0[0]; ac0[1] = an0[1]; ac1[0] = an1[0]; ac1[1] = an1[1];
        if (wr == 1) G8_BAR;
    }
    G8_WAIT_V(0);
    G8_BAR;
#undef G8_SA
#undef G8_SB
#undef G8_STAGE
#undef G8_LDA
#undef G8_LDB
#undef G8_MMA
#undef G8_WAIT_V
#undef G8_WAIT_L
#undef G8_BAR
#undef G8_SCHED
#undef G8_AOFF
#undef G8_XLOAD
}
}
template <class Epi>
__device__ __forceinline__ void dgemm_phase(const Ctx& c, const bf16* A, int lda, int M, const bf16* Bt, int ntn, int K, const Epi& E, int G = -1, int cid = -1) {
    g8::DenseSched S{(const char*)A, (const char*)Bt, (size_t)lda * 2, (size_t)K * 2, M / 256, ntn, G < 0 ? c.nblk : G, cid < 0 ? c.bid : cid};
    g8::gemm_phase<false>(c.lds, (unsigned)lda * 2u, K, S, E);
    __syncthreads();
}


__device__ __forceinline__ size_t frag_off(int tile, int row, int col, int bj) {
    const int ai = row >> 7, wr = (row >> 6) & 1, m = (row >> 4) & 3, fr = row & 15, wc = col >> 5, n = (col >> 4) & 1, fq = (col >> 2) & 3;
    const int wave = wr * 4 + wc, lane = fq * 16 + fr, f = ((ai * 4 + m) * 2 + n) * 2 + bj;
    return ((((size_t)tile * 8 + wave) * 32 + f) * 64 + lane) * 4;
}
struct NoPre {};
struct EpiInPB { bf16* PB; float* SM; typedef NoPre Pre; static constexpr int BATCH_M = 4; static constexpr bool PERM = true;
    __device__ __forceinline__ void post8(int row, int col, f32x4 a0, f32x4 a1, f32x4 b0, f32x4 b1, const Pre&, int, int, int) const {
        st_bf8(PB + (size_t)row * NPB + col, a0, a1);
        if ((col >> 8) == 7) { float* sp = SM + (size_t)row * 128 + (col & 127); *(f32x4*)sp = b0; *(f32x4*)(sp + 4) = b1; }
        else st_bf8(PB + (size_t)row * NPB + col + 128, b0, b1);
    }
    __device__ __forceinline__ Pre pre(int, int, int, int, int) const { return Pre{}; }
    __device__ __forceinline__ void post(int row, int col, f32x4 lo, f32x4 hi, const Pre&, int, int, int) const { (*this)(row, col, lo, hi); }
    __device__ __forceinline__ void operator()(int row, int col, f32x4 lo, f32x4 hi) const {
        st_bf4(PB + (size_t)row * NPB + col, lo);
        if ((col >> 8) == 7) *(f32x4*)(SM + (size_t)row * 128 + (col & 127)) = hi;
        else st_bf4(PB + (size_t)row * NPB + col + 128, hi);
    } };
struct EpiQ { bf16* QLAT; bf16* QIDX; const float* rstd; struct Pre { float r; }; static constexpr int BATCH_M = 4; static constexpr bool PERM = true;
    __device__ __forceinline__ void post8(int row, int col, f32x4 a0, f32x4 a1, f32x4 b0, f32x4 b1, const Pre& p, int, int, int) const {
        const float r = p.r;
        if (col < 1024) { st_bf8(QLAT + (size_t)row * 1024 + col, a0 * r, a1 * r); st_bf8(QLAT + (size_t)row * 1024 + col + 128, b0 * r, b1 * r); }
        else { st_bf8(QIDX + (size_t)row * 256 + (col - 1024), a0 * r, a1 * r); st_bf8(QIDX + (size_t)row * 256 + (col - 1024) + 128, b0 * r, b1 * r); }
    }
    __device__ __forceinline__ Pre pre(int row, int, int, int, int) const { return Pre{rstd[row]}; }
    __device__ __forceinline__ void post(int row, int col, f32x4 lo, f32x4 hi, const Pre& p, int, int, int) const {
        const float r = p.r;
        if (col < 1024) { st_bf4(QLAT + (size_t)row * 1024 + col, lo * r); st_bf4(QLAT + (size_t)row * 1024 + col + 128, hi * r); }
        else { st_bf4(QIDX + (size_t)row * 256 + (col - 1024), lo * r); st_bf4(QIDX + (size_t)row * 256 + (col - 1024) + 128, hi * r); }
    } };
struct EpiGate { bf16* G; typedef NoPre Pre; static constexpr int BATCH_M = 4; static constexpr bool PERM = true;
    __device__ __forceinline__ Pre pre(int, int, int, int, int) const { return Pre{}; }
    __device__ __forceinline__ void post(int, int, f32x4, f32x4, const Pre&, int, int, int) const {}
    __device__ __forceinline__ void post8(int, int, f32x4 a0, f32x4 a1, f32x4 b0, f32x4 b1, const Pre&, int pm, int pn, int foff) const {
#pragma unroll
        for (int i = 0; i < 4; ++i) { a0[i] = sigmoidf_(a0[i]); a1[i] = sigmoidf_(a1[i]); b0[i] = sigmoidf_(b0[i]); b1[i] = sigmoidf_(b1[i]); }
        bf16* gt = G + (size_t)(((pn >> 2) * 128 + pm) * 4 + (pn & 3)) * 65536 + foff;
        st_bf8(gt, a0, a1); st_bf8(gt + 512, b0, b1);
    } };
struct EpiUp { bf16* M1; bf16* MF; const bf16* G; int br; int first; int last; struct Pre { u32x4 g0, g1, m0, m1; }; static constexpr int BATCH_M = 2; static constexpr bool PERM = true;
    __device__ __forceinline__ Pre pre(int, int, int pm, int pn, int foff) const {
        const bf16* gt = G + (size_t)((br * 128 + pm) * 4 + pn) * 65536 + foff; const bf16* mt = MF + (size_t)(pm * 4 + pn) * 65536 + foff;
        Pre p; p.g0 = *(const u32x4*)gt; p.g1 = *(const u32x4*)(gt + 512);
        p.m0 = (u32x4){0u, 0u, 0u, 0u}; p.m1 = p.m0;
        if (!first) { p.m0 = __builtin_nontemporal_load((const u32x4*)mt); p.m1 = __builtin_nontemporal_load((const u32x4*)(mt + 512)); }
        return p; }
    __device__ __forceinline__ void post(int, int, f32x4, f32x4, const Pre&, int, int, int) const {}
    __device__ __forceinline__ void post8(int row, int col, f32x4 a0, f32x4 a1, f32x4 b0, f32x4 b1, const Pre& p, int pm, int pn, int foff) const {
        a0 *= (f32x4){bflo(p.g0.x), bfhi(p.g0.x), bflo(p.g0.y), bfhi(p.g0.y)}; a1 *= (f32x4){bflo(p.g0.z), bfhi(p.g0.z), bflo(p.g0.w), bfhi(p.g0.w)};
        b0 *= (f32x4){bflo(p.g1.x), bfhi(p.g1.x), bflo(p.g1.y), bfhi(p.g1.y)}; b1 *= (f32x4){bflo(p.g1.z), bfhi(p.g1.z), bflo(p.g1.w), bfhi(p.g1.w)};
        if (!first) { a0 += (f32x4){bflo(p.m0.x), bfhi(p.m0.x), bflo(p.m0.y), bfhi(p.m0.y)}; a1 += (f32x4){bflo(p.m0.z), bfhi(p.m0.z), bflo(p.m0.w), bfhi(p.m0.w)};
                      b0 += (f32x4){bflo(p.m1.x), bfhi(p.m1.x), bflo(p.m1.y), bfhi(p.m1.y)}; b1 += (f32x4){bflo(p.m1.z), bfhi(p.m1.z), bflo(p.m1.w), bfhi(p.m1.w)}; }
        if (last) { bf16* m = M1 + (size_t)row * 1024 + col; st_bf8(m, a0, a1); st_bf8(m + 128, b0, b1); }
        else { bf16* mt = MF + (size_t)(pm * 4 + pn) * 65536 + foff; st_bf8(mt, a0, a1); st_bf8(mt + 512, b0, b1); }
    } };
struct EpiWo { const float* res; float* out; const float* g1;
    struct Pre { f32x4 ra, rb; }; static constexpr int BATCH_M = 4; static constexpr bool PERM = false;
    __device__ __forceinline__ void post8(int, int, f32x4, f32x4, f32x4, f32x4, const Pre&, int, int, int) const {}
    __device__ __forceinline__ Pre pre(int row, int col, int, int, int) const { const size_t o = (size_t)row * 1024 + col; return Pre{*(const f32x4*)(res + o), *(const f32x4*)(res + o + 128)}; }
    __device__ __forceinline__ void post(int row, int col, f32x4 lo, f32x4 hi, const Pre& p, int, int, int) const {
        const float* gp = g1 + (size_t)(row >> 11) * 6144 + col; const size_t o = (size_t)row * 1024 + col;
        const f32x4 ga = *(const f32x4*)gp, gb = *(const f32x4*)(gp + 128);
        *(f32x4*)(out + o) = p.ra + ga * lo; *(f32x4*)(out + o + 128) = p.rb + gb * hi;
    } };
struct EpiG1 { bf16* HID; const float* wl; int cnt; int orow0;
    __device__ __forceinline__ void operator()(int row, int col, f32x4 lo, f32x4 hi) const {
        const int hc = col - 128 * (col >> 8);
        f32x4 v = (f32x4){0.f, 0.f, 0.f, 0.f};
        if (row < cnt) { const float w = wl ? wl[row] : 1.f;
#pragma unroll
            for (int i = 0; i < 4; ++i) v[i] = siluf_(lo[i]) * hi[i] * w; }
        st_bf4(HID + (size_t)(orow0 + row) * 256 + hc, v);
    } };
struct EpiG2 { bf16* Y; int orow0;
    __device__ __forceinline__ void operator()(int row, int col, f32x4 lo, f32x4 hi) const {
        st_bf4(Y + (size_t)(orow0 + row) * 1024 + col, lo); st_bf4(Y + (size_t)(orow0 + row) * 1024 + col + 128, hi);
    } };


template <class F> struct EpiU { F f; typedef typename F::Pre Pre; static constexpr int BATCH_M = F::BATCH_M; static constexpr bool PERM = F::PERM;
    __device__ __forceinline__ void post8(const g8::GUnit& u, int row, int col, f32x4 a0, f32x4 a1, f32x4 b0, f32x4 b1, const Pre& p, int foff) const { f.post8(row, col, a0, a1, b0, b1, p, u.erow0 >> 8, u.ecol0 >> 8, foff); }
    __device__ __forceinline__ Pre pre(const g8::GUnit& u, int row, int col, int foff) const { return f.pre(row, col, u.erow0 >> 8, u.ecol0 >> 8, foff); }
    __device__ __forceinline__ void post(const g8::GUnit& u, int row, int col, f32x4 lo, f32x4 hi, const Pre& p, int foff) const { f.post(row, col, lo, hi, p, u.erow0 >> 8, u.ecol0 >> 8, foff); } };

__device__ __forceinline__ void phase_prologue(const Ctx& c) {
    {
        LAS float* cs = (LAS float*)c.lds;
        LAS float* red = (LAS float*)(c.lds + 65536);
        const float* cin = c.in[IN_C];
        if (c.bid < 192) {
            for (int i = c.tid; i < 16 * 1024; i += NTHR) cs[i] = siluf_(cin[i]);
            __syncthreads();
        }
        float* MOD = (float*)(c.ws + WS_MOD);
        for (int it = c.bid; it < 192; it += c.nblk) {
            const int l = it / 96, cg = it % 96, col = cg * 64 + c.lane;
            const float* W = c.in[IN_ADAW] + (size_t)l * 1024 * 6144 + col;
            float acc[16];
#pragma unroll
            for (int b = 0; b < 16; ++b) acc[b] = 0.f;
            const int kbeg = c.wave * 128;
#pragma unroll 4
            for (int k = kbeg; k < kbeg + 128; k += 4) {
                const float w0 = W[(size_t)k * 6144], w1 = W[(size_t)(k + 1) * 6144], w2 = W[(size_t)(k + 2) * 6144], w3 = W[(size_t)(k + 3) * 6144];
#pragma unroll
                for (int b = 0; b < 16; ++b) { const f32x4 v = *(const LAS f32x4*)(cs + b * 1024 + k); acc[b] += v[0] * w0 + v[1] * w1 + v[2] * w2 + v[3] * w3; }
            }
#pragma unroll
            for (int b = 0; b < 16; ++b) red[(c.wave * 16 + b) * 64 + c.lane] = acc[b];
            __syncthreads();
            for (int i = c.tid; i < 16 * 64; i += NTHR) { const int b = i >> 6, ln = i & 63; float s = 0.f;
#pragma unroll
                for (int w = 0; w < 8; ++w) s += red[(w * 16 + b) * 64 + ln];
                MOD[((size_t)l * 16 + b) * 6144 + cg * 64 + ln] = s + c.in[IN_ADAB][l * 6144 + cg * 64 + ln]; }
            __syncthreads();
        }
        __syncthreads();
    }
    {
        LAS float* scr = (LAS float*)(c.lds + c.wave * 16384);
        const int gw = c.bid * NWAVES + c.wave, NGW = c.nblk * NWAVES;
        constexpr int I_WIN = (NINP / 32) * (1024 / 64), I_UP = (1024 / 32) * (512 / 64), I_WO = (1024 / 32) * (1024 / 64);
        constexpr int PER_L = I_WIN + 3 * I_UP + I_WO;
        for (int it = gw; it < NL * PER_L; it += NGW) {
            const int l = it / PER_L; int r = it % PER_L;
            if (r < I_WIN) { SrcWin s{c.in[IN_WIN] + (size_t)l * 1024 * NIN, NIN}; tr_item(s, (bf16*)(c.ws + WS_WIN) + (size_t)l * NINP * 1024, 1024, (r / 16) * 32, (r % 16) * 64, scr, c.lane); continue; }
            r -= I_WIN;
            if (r < I_UP) { SrcPlain s{c.in[IN_WUPA] + (size_t)l * 512 * 1024, 1024}; tr_item(s, (bf16*)(c.ws + WS_WUPA) + (size_t)l * 1024 * 512, 512, (r / 8) * 32, (r % 8) * 64, scr, c.lane); continue; }
            r -= I_UP;
            if (r < I_UP) { SrcPlain s{c.in[IN_WUPC] + (size_t)l * 512 * 1024, 1024}; tr_item(s, (bf16*)(c.ws + WS_WUPC) + (size_t)l * 1024 * 512, 512, (r / 8) * 32, (r % 8) * 64, scr, c.lane); continue; }
            r -= I_UP;
            if (r < I_UP) { SrcPlain s{c.in[IN_WUPB] + (size_t)l * 512 * 1024, 1024}; tr_item(s, (bf16*)(c.ws + WS_WUPB) + (size_t)l * 1024 * 512, 512, (r / 8) * 32, (r % 8) * 64, scr, c.lane); continue; }
            r -= I_UP;
            { SrcPlain s{c.in[IN_WO] + (size_t)l * 1024 * 1024, 1024}; tr_item(s, (bf16*)(c.ws + WS_WO) + (size_t)l * 1024 * 1024, 1024, (r / 16) * 32, (r % 16) * 64, scr, c.lane); }
        }
    }
    {
        LAS float* uk_s = (LAS float*)c.lds;
        for (int it = (c.bid + 16 >= c.nblk) ? c.bid + 16 - c.nblk : c.bid + 16; it < NL * 8; it += c.nblk) {
            const int l = it >> 3, h = it & 7;
            __syncthreads();
            for (int i = c.tid; i < 128 * 16; i += NTHR) { const int cc = i >> 4, d4 = (i & 15) * 4;
                *(LAS f32x4*)(uk_s + cc * 64 + d4) = *(const f32x4*)(c.in[IN_DSA_WUK] + (size_t)l * 128 * 512 + (size_t)cc * 512 + h * 64 + d4); }
            const int r = c.tid & 255, ch = c.tid >> 8;
            f32x4 uq[16];
            { const float* up = c.in[IN_DSA_WUQ] + (size_t)l * 256 * 512 + (size_t)r * 512 + h * 64;
#pragma unroll
              for (int j = 0; j < 16; ++j) uq[j] = *(const f32x4*)(up + 4 * j); }
            const float sc = c.in[IN_DSA_NQ][l * 256 + r] * (0.125f * 1.4426950408889634f);
            __syncthreads();
            bf16* dst = (bf16*)(c.ws + WS_WQ) + (size_t)l * 1280 * 256 + (size_t)(h * 128 + ch * 64) * 256 + r;
#pragma unroll 2
            for (int cc = 0; cc < 64; ++cc) { const LAS float* kp = uk_s + (ch * 64 + cc) * 64; float acc = 0.f;
#pragma unroll
                for (int j = 0; j < 16; ++j) { const f32x4 kv = *(const LAS f32x4*)(kp + 4 * j); acc += uq[j][0] * kv[0] + uq[j][1] * kv[1] + uq[j][2] * kv[2] + uq[j][3] * kv[3]; }
                dst[(size_t)cc * 256] = (bf16)f2bf(acc * sc); }
        }
        __syncthreads();
    }
    {
        const int gt = c.bid * NTHR + c.tid, NGT = c.nblk * NTHR;
        for (int i = gt; i < T; i += NGT) ((int*)(c.ws + WS_IDENT))[i] = i;
        for (int it = gt; it < NL * 256 * 32; it += NGT) {
            const int l = it / (256 * 32), rem = it % (256 * 32), m = rem / 32, r0 = (rem % 32) * 8;
            const float* gq = c.in[IN_DSA_NQ] + l * 256;
            float o[8];
#pragma unroll
            for (int i = 0; i < 8; ++i) o[i] = c.in[IN_DSA_WQI][(size_t)l * 256 * 256 + (size_t)(r0 + i) * 256 + m] * 0.17677669529663687f * gq[r0 + i];
            u32x4 w; w.x = pk2(o[0], o[1]); w.y = pk2(o[2], o[3]); w.z = pk2(o[4], o[5]); w.w = pk2(o[6], o[7]);
            *(u32x4*)((bf16*)(c.ws + WS_WQ) + (size_t)l * 1280 * 256 + (size_t)(1024 + m) * 256 + r0) = w;
        }
    }
    {
        const int gt = c.bid * NTHR + c.tid, NGT = c.nblk * NTHR;
        for (int it = gt; it < NL * 8 * 4 * 4 * 64; it += NGT) {
            const int ln = it & 63, ks = (it >> 6) & 3, vt = (it >> 8) & 3, h = (it >> 10) & 7, l = it >> 13;
            const int fr = ln & 15, fq = ln >> 4;
            const float* uv = c.in[IN_DSA_WUV] + (size_t)l * 128 * 512 + h * 64 + 16 * vt + fr;
            float o[8];
#pragma unroll
            for (int e = 0; e < 8; ++e) { const int lat = 32 * ks + (e < 4 ? 4 * fq + e : 16 + 4 * fq + e - 4); o[e] = uv[(size_t)lat * 512]; }
            u32x4 w; w.x = pk2(o[0], o[1]); w.y = pk2(o[2], o[3]); w.z = pk2(o[4], o[5]); w.w = pk2(o[6], o[7]);
            *(u32x4*)((bf16*)(c.ws + WS_WUVF) + (size_t)it * 8) = w;
        }
    }
}

__device__ __forceinline__ void norm_mod_row(const float* xrow, const float* gain, const float* sh, const float* sc, bf16* orow, int lane) {
    f32x4 v[4]; float s = 0.f;
#pragma unroll
    for (int j = 0; j < 4; ++j) { v[j] = *(const f32x4*)(xrow + 4 * (lane + 64 * j)); s += v[j][0] * v[j][0] + v[j][1] * v[j][1] + v[j][2] * v[j][2] + v[j][3] * v[j][3]; }
    const float rstd = rsqrtf(wave_sum(s) * (1.f / D) + EPS);
#pragma unroll
    for (int j = 0; j < 4; ++j) { const int cc = 4 * (lane + 64 * j);
        const f32x4 g = *(const f32x4*)(gain + cc), a = *(const f32x4*)(sc + cc), b = *(const f32x4*)(sh + cc);
        st_bf4(orow + cc, v[j] * rstd * g * (a + 1.f) + b); }
}
__device__ __forceinline__ void phase_norm1(const Ctx& c, int l, const float* xsrc) {
    const int gw = c.bid * NWAVES + c.wave, NGW = c.nblk * NWAVES;
    const float* MOD = (const float*)(c.ws + WS_MOD) + (size_t)l * 16 * 6144;
    bf16* XN = (bf16*)(c.ws + WS_XN);
    for (int t = gw; t < T; t += NGW) { const int b = t >> 11;
        norm_mod_row(xsrc + (size_t)t * D, c.in[IN_NMIX] + l * D, MOD + (size_t)b * 6144, MOD + (size_t)b * 6144 + 1024, XN + (size_t)t * D, c.lane); }
}

__device__ __forceinline__ void phase_prep(const Ctx& c, int l) {
    const int gw = c.bid * NWAVES + c.wave, NGW = c.nblk * NWAVES;
    const bf16* PB = (const bf16*)(c.ws + WS_PB); const float* SM = (const float*)(c.ws + WS_SM);
    bf16* CKVN = (bf16*)(c.ws + WS_CKVN); bf16* KIDX = (bf16*)(c.ws + WS_KIDX); float* RSTDQ = (float*)(c.ws + WS_RSTDQ);
    const float* gkv = c.in[IN_DSA_NKV] + l * 128;
    const float g0 = gkv[2 * c.lane], g1 = gkv[2 * c.lane + 1];
    for (int t4 = gw * 4; t4 < T; t4 += NGW * 4) {
        unsigned kv[4]; u32x2 qv[4]; float ki[4];
#pragma unroll
        for (int r = 0; r < 4; ++r) { const bf16* row = PB + (size_t)(t4 + r) * NPB;
            kv[r] = *(const unsigned*)(row + PB_CKV + 2 * c.lane); qv[r] = *(const u32x2*)(row + PB_CQ + 4 * c.lane);
            ki[r] = c.lane < 32 ? SM[(size_t)(t4 + r) * 128 + SM_KIDX + c.lane] : 0.f; }
#pragma unroll
        for (int r = 0; r < 4; ++r) { const int t = t4 + r;
            const float k0 = bflo(kv[r]), k1 = bfhi(kv[r]);
            const float rs = rsqrtf(wave_sum(k0 * k0 + k1 * k1) * (1.f / 128.f) + EPS);
            *(unsigned*)(CKVN + (size_t)t * 128 + 2 * c.lane) = pk2(k0 * rs * g0, k1 * rs * g1);
            const float q0 = bflo(qv[r].x), q1 = bfhi(qv[r].x), q2 = bflo(qv[r].y), q3 = bfhi(qv[r].y);
            const float rq = rsqrtf(wave_sum(q0 * q0 + q1 * q1 + q2 * q2 + q3 * q3) * (1.f / 256.f) + EPS);
            if (c.lane == 0) RSTDQ[t] = rq;
            if (c.lane < 32) KIDX[(size_t)t * 32 + c.lane] = (bf16)f2bf(ki[r]); }
    }
}
__device__ __forceinline__ void phase_ckvt(const Ctx& c) {
    const bf16* CKVN = (const bf16*)(c.ws + WS_CKVN); bf16* CKVT = (bf16*)(c.ws + WS_CKVT);
    LAS bf16* tile = (LAS bf16*)c.lds;
    for (int it = c.bid; it < T / 64; it += c.nblk) {
        const int tb = it * 64, b = tb >> 11, p0 = tb & 2047;
        __syncthreads();
        { const int r = c.tid >> 3, ch = (c.tid & 7) * 8;
          *(LAS u32x4*)(tile + r * 136 + ch) = *(const u32x4*)(CKVN + (size_t)(tb + r) * 128 + ch); *(LAS u32x4*)(tile + r * 136 + 64 + ch) = *(const u32x4*)(CKVN + (size_t)(tb + r) * 128 + 64 + ch); }
        __syncthreads();
        { const int r = c.tid >> 2, part = c.tid & 3;
          unsigned w[8];
#pragma unroll
          for (int j = 0; j < 8; ++j) w[j] = (unsigned)tile[(16 * part + 2 * j) * 136 + r] | ((unsigned)tile[(16 * part + 2 * j + 1) * 136 + r] << 16);
          bf16* dst = CKVT + (((size_t)b * 32 + (p0 >> 6)) * 128 + r) * 64 + 32 * (part >> 1) + 4 * (part & 1);
          *(u32x2*)dst = (u32x2){w[0], w[1]}; *(u32x2*)(dst + 8) = (u32x2){w[2], w[3]}; *(u32x2*)(dst + 16) = (u32x2){w[4], w[5]}; *(u32x2*)(dst + 24) = (u32x2){w[6], w[7]}; }
    }
    __syncthreads();
}

constexpr int TS = 16;
__device__ __forceinline__ void scan_gla_item(const Ctx& c, int l, int b, int h) {
    LAS float* q_s = (LAS float*)c.lds;
    LAS float* k_s = q_s + TS * 64;
    LAS float* a_s = k_s + TS * 64;
    LAS float* v_s = a_s + TS * 64;
    LAS float* part = v_s + TS * 128;
    LAS float* wa2 = part + TS * 4 * 128;
    LAS float* ba = wa2 + 16 * 64;
    LAS float* alr = ba + 64;
    const bf16* PB = (const bf16*)(c.ws + WS_PB); const float* SM = (const float*)(c.ws + WS_SM);
    bf16* UA = (bf16*)(c.ws + WS_UA);
    const float* gn = c.in[IN_GLA_NORM] + l * 512 + h * 128;
    for (int i = c.tid; i < 16 * 64; i += NTHR) wa2[i] = c.in[IN_GLA_WA2][(size_t)l * 16 * 256 + (i >> 6) * 256 + h * 64 + (i & 63)];
    if (c.tid < 64) ba[c.tid] = c.in[IN_GLA_BA][l * 256 + h * 64 + c.tid];
    const int v = c.tid & 127, kg = c.tid >> 7;
    float S[16];
#pragma unroll
    for (int i = 0; i < 16; ++i) S[i] = 0.f;
    for (int t0 = 0; t0 < SEQ; t0 += TS) {
        __syncthreads();
        const size_t rb = (size_t)b * SEQ + t0;
        for (int i = c.tid; i < TS * 64; i += NTHR) { const int s = i >> 6, cc = i & 63; const bf16* row = PB + (rb + s) * NPB;
            q_s[i] = bf2f(row[PB_QA + h * 64 + cc]) * 0.125f; k_s[i] = bf2f(row[PB_KA + h * 64 + cc]); }
        for (int i = c.tid; i < TS * 128; i += NTHR) { const int s = i >> 7, cc = i & 127; v_s[i] = bf2f(PB[(rb + s) * NPB + PB_VA + h * 128 + cc]); }
        if (c.tid < TS * 16) alr[c.tid] = SM[(rb + (c.tid >> 4)) * 128 + SM_ALR + (c.tid & 15)];
        __syncthreads();
        for (int i = c.tid; i < TS * 64; i += NTHR) { const int s = i >> 6, cc = i & 63; float x = ba[cc];
#pragma unroll
            for (int j = 0; j < 16; ++j) x += alr[s * 16 + j] * wa2[j * 64 + cc];
            a_s[i] = __expf(logsigmoidf_(x) * (1.f / 16.f)); }
        __syncthreads();
#pragma unroll 1
        for (int s = 0; s < TS; ++s) {
            const float vv = v_s[s * 128 + v]; float acc = 0.f;
#pragma unroll
            for (int i4 = 0; i4 < 4; ++i4) {
                const f32x4 a4 = *(const LAS f32x4*)(a_s + s * 64 + kg * 16 + i4 * 4), k4 = *(const LAS f32x4*)(k_s + s * 64 + kg * 16 + i4 * 4), q4 = *(const LAS f32x4*)(q_s + s * 64 + kg * 16 + i4 * 4);
#pragma unroll
                for (int j = 0; j < 4; ++j) { S[i4 * 4 + j] = a4[j] * S[i4 * 4 + j] + k4[j] * vv; acc += q4[j] * S[i4 * 4 + j]; }
            }
            part[(s * 4 + kg) * 128 + v] = acc;
        }
        __syncthreads();
        {
            const int s = c.tid >> 5, vq = c.tid & 31, v0 = vq * 4;
            f32x4 o = (f32x4){0.f, 0.f, 0.f, 0.f};
#pragma unroll
            for (int g = 0; g < 4; ++g) o += *(const LAS f32x4*)(part + (s * 4 + g) * 128 + v0);
            float ss = o[0] * o[0] + o[1] * o[1] + o[2] * o[2] + o[3] * o[3];
#pragma unroll
            for (int m = 1; m < 32; m <<= 1) ss += __shfl_xor(ss, m);
            const float rstd = rsqrtf(ss * (1.f / 128.f) + EPS);
            const f32x4 ga = ld_bf4(PB + (rb + s) * NPB + PB_GA + h * 128 + v0);
            f32x4 r;
#pragma unroll
            for (int j = 0; j < 4; ++j) r[j] = o[j] * rstd * gn[v0 + j] * siluf_(ga[j]);
            st_bf4(UA + (rb + s) * 512 + h * 128 + v0, r);
        }
    }
    __syncthreads();
}
__device__ __forceinline__ void scan_mlstm_item(const Ctx& c, int l, int b, int h) {
    LAS float* q_s = (LAS float*)c.lds;
    LAS float* k_s = q_s + TS * 64;
    LAS float* v_s = k_s + TS * 64;
    LAS float* part = v_s + TS * 128;
    LAS float* dpart = part + TS * 4 * 128;
    LAS float* lf_s = dpart + TS * 4;
    LAS float* ip_s = lf_s + TS;
    LAS float* m_s = ip_s + TS;
    LAS float* cw = m_s + TS;
    const bf16* PB = (const bf16*)(c.ws + WS_PB); const float* SM = (const float*)(c.ws + WS_SM);
    bf16* UC = (bf16*)(c.ws + WS_UC);
    const float* mn = c.in[IN_ML_NORM] + l * 512 + h * 128;
    if (c.tid < 4 * 128) { const int j = c.tid >> 7, cc = c.tid & 127; cw[c.tid] = c.in[IN_ML_CONV][(size_t)l * 4 * 512 + j * 512 + (cc < 64 ? h * 64 + cc : 256 + h * 64 + (cc - 64))]; }
    const float bi = c.in[IN_ML_BI][l * 4 + h], bfv = c.in[IN_ML_BF][l * 4 + h];
    const int v = c.tid & 127, kg = c.tid >> 7;
    float C[16], n[16]; float m = 0.f;
#pragma unroll
    for (int i = 0; i < 16; ++i) { C[i] = 0.f; n[i] = 0.f; }
    for (int t0 = 0; t0 < SEQ; t0 += TS) {
        __syncthreads();
        const size_t rb = (size_t)b * SEQ + t0;
        for (int i = c.tid; i < TS * 128; i += NTHR) { const int s = i >> 7, cc = i & 127;
            const int col = cc < 64 ? PB_QC + h * 64 + cc : PB_KC + h * 64 + (cc - 64);
            float x = 0.f;
#pragma unroll
            for (int j = 0; j < 4; ++j) { const int tt = t0 + s - 3 + j; if (tt >= 0) x += cw[j * 128 + cc] * bf2f(PB[((size_t)b * SEQ + tt) * NPB + col]); }
            x = siluf_(x);
            if (cc < 64) q_s[s * 64 + cc] = x * 0.125f; else k_s[s * 64 + (cc - 64)] = x; }
        for (int i = c.tid; i < TS * 128; i += NTHR) { const int s = i >> 7, cc = i & 127; v_s[i] = bf2f(PB[(rb + s) * NPB + PB_VC + h * 128 + cc]); }
        if (c.tid < TS) { ip_s[c.tid] = SM[(rb + c.tid) * 128 + SM_IC + h] + bi; lf_s[c.tid] = logsigmoidf_(SM[(rb + c.tid) * 128 + SM_FC + h] + bfv); }
        __syncthreads();
#pragma unroll 1
        for (int s = 0; s < TS; ++s) {
            const float lf = lf_s[s], ip = ip_s[s];
            const float mnew = fmaxf(lf + m, ip), fg = __expf(lf + m - mnew), ig = __expf(ip - mnew);
            m = mnew;
            const float vv = v_s[s * 128 + v] * ig; float num = 0.f, den = 0.f;
#pragma unroll
            for (int i4 = 0; i4 < 4; ++i4) {
                const f32x4 k4 = *(const LAS f32x4*)(k_s + s * 64 + kg * 16 + i4 * 4), q4 = *(const LAS f32x4*)(q_s + s * 64 + kg * 16 + i4 * 4);
#pragma unroll
                for (int j = 0; j < 4; ++j) { C[i4 * 4 + j] = fg * C[i4 * 4 + j] + k4[j] * vv; n[i4 * 4 + j] = fg * n[i4 * 4 + j] + ig * k4[j]; num += q4[j] * C[i4 * 4 + j]; den += q4[j] * n[i4 * 4 + j]; }
            }
            part[(s * 4 + kg) * 128 + v] = num;
            if (v == 0) dpart[s * 4 + kg] = den;
            if (c.tid == 0) m_s[s] = m;
        }
        __syncthreads();
        {
            const int s = c.tid >> 5, vq = c.tid & 31, v0 = vq * 4;
            f32x4 o = (f32x4){0.f, 0.f, 0.f, 0.f};
#pragma unroll
            for (int g = 0; g < 4; ++g) o += *(const LAS f32x4*)(part + (s * 4 + g) * 128 + v0);
            const float den = dpart[s * 4] + dpart[s * 4 + 1] + dpart[s * 4 + 2] + dpart[s * 4 + 3];
            const float dd = 1.f / fmaxf(fabsf(den), __expf(-m_s[s]));
            o = o * dd;
            float ss = o[0] * o[0] + o[1] * o[1] + o[2] * o[2] + o[3] * o[3];
#pragma unroll
            for (int mm = 1; mm < 32; mm <<= 1) ss += __shfl_xor(ss, mm);
            const float rstd = rsqrtf(ss * (1.f / 128.f) + EPS);
            const f32x4 oc = ld_bf4(PB + (rb + s) * NPB + PB_OC + h * 128 + v0);
            f32x4 r;
#pragma unroll
            for (int j = 0; j < 4; ++j) r[j] = o[j] * rstd * mn[v0 + j] * sigmoidf_(oc[j]);
            st_bf4(UC + (rb + s) * 512 + h * 128 + v0, r);
        }
    }
    __syncthreads();
}

constexpr int LQ = 72;
constexpr int SC_QT = 0, SC_KT = 9216, SC_KTT = 18432, SC_Q2 = 27648, SC_SC = 36864, SC_VT = 46080, SC_ST = 66816, SC_FL = 108288;
__device__ __forceinline__ float wave_scan_add(float x, int lane) {
#pragma unroll
    for (int d = 1; d < 64; d <<= 1) { const float y = __shfl_up(x, d); if (lane >= d) x += y; }
    return x;
}
__device__ __forceinline__ float wave_scan_max(float x, int lane) {
#pragma unroll
    for (int d = 1; d < 64; d <<= 1) { const float y = __shfl_up(x, d); if (lane >= d) x = fmaxf(x, y); }
    return x;
}
__device__ __forceinline__ void unpack8(u32x4 w, float (&f)[8]) { f[0] = bflo(w.x); f[1] = bfhi(w.x); f[2] = bflo(w.y); f[3] = bfhi(w.y); f[4] = bflo(w.z); f[5] = bfhi(w.z); f[6] = bflo(w.w); f[7] = bfhi(w.w); }
__device__ __forceinline__ u32x4 pack8(const float (&f)[8]) { u32x4 w; w.x = pk2(f[0], f[1]); w.y = pk2(f[2], f[3]); w.z = pk2(f[4], f[5]); w.w = pk2(f[6], f[7]); return w; }
template <bool ML>
__device__ __forceinline__ void scan_chunked_item(const Ctx& c, int l, int b, int h) {
    LAS bf16* Qt0 = (LAS bf16*)(c.lds + SC_QT); LAS bf16* Kt0 = (LAS bf16*)(c.lds + SC_KT); LAS bf16* KtT0 = (LAS bf16*)(c.lds + SC_KTT);
    LAS bf16* Q20 = (LAS bf16*)(c.lds + SC_Q2); LAS bf16* Sc0 = (LAS bf16*)(c.lds + SC_SC); LAS bf16* VT0 = (LAS bf16*)(c.lds + SC_VT);
    LAS bf16* ST0 = (LAS bf16*)(c.lds + SC_ST);
    LAS float* segtot = (LAS float*)(c.lds + SC_FL);
    LAS float* etot = segtot + 512;
    LAS float* ssq = etot + 64;
    LAS float* dn = ssq + 512;
    LAS float* wa2 = dn + 64;
    LAS float* ba = wa2 + 1024;
    LAS float* cw = ba + 64;
    const int tid = c.tid, lane = c.lane, w = c.wave, fr = lane & 15, fq = lane >> 4;
    const int srow = tid >> 3, kg = tid & 7, k8 = kg * 8, vrow = tid >> 4, vc8 = (tid & 15) * 8;
    const bf16* PB = (const bf16*)(c.ws + WS_PB); const float* SM = (const float*)(c.ws + WS_SM);
    bf16* UO = (bf16*)(c.ws + (ML ? WS_UC : WS_UA));
    const int QCOL = (ML ? PB_QC : PB_QA) + h * 64, KCOL = (ML ? PB_KC : PB_KA) + h * 64, VCOL = (ML ? PB_VC : PB_VA) + h * 128, GCOL = (ML ? PB_OC : PB_GA) + h * 128;
    const float* gnorm = c.in[ML ? IN_ML_NORM : IN_GLA_NORM] + l * 512 + h * 128;
    __syncthreads();
    if (!ML) { for (int i = tid; i < 1024; i += NTHR) wa2[i] = c.in[IN_GLA_WA2][(size_t)l * 16 * 256 + (i >> 6) * 256 + h * 64 + (i & 63)];
               if (tid < 64) ba[tid] = c.in[IN_GLA_BA][l * 256 + h * 64 + tid]; }
    else { if (tid < 512) { const int j = tid >> 7, cc = tid & 127; cw[tid] = c.in[IN_ML_CONV][(size_t)l * 4 * 512 + j * 512 + (cc < 64 ? h * 64 + cc : 256 + h * 64 + (cc - 64))]; } }
    for (int i = tid; i < 144 * LQ / 2; i += NTHR) ((LAS unsigned*)ST0)[i] = 0u;
    if (ML) { for (int i = tid; i < 16 * LQ; i += NTHR) VT0[128 * LQ + i] = (i < 64) ? (bf16)0x3f80u : (bf16)0u; }
    const float bi = ML ? c.in[IN_ML_BI][l * 4 + h] : 0.f, bfv = ML ? c.in[IN_ML_BF][l * 4 + h] : 0.f;
    float m_prev = 0.f;
    f32x4 Sacc[4], Nacc = (f32x4){0.f, 0.f, 0.f, 0.f};
#pragma unroll
    for (int i = 0; i < 4; ++i) Sacc[i] = (f32x4){0.f, 0.f, 0.f, 0.f};
    u32x4 rq[ML ? 4 : 1], rk[ML ? 4 : 1], rv[2]; f32x4 ra[4]; float ric = 0.f, rfc = 0.f;
    const u32x4 z4 = (u32x4){0u, 0u, 0u, 0u};
#define SC_LOAD(cch) do { const size_t _g = (size_t)b * SEQ + (size_t)(cch) * 64; \
        if (ML) { _Pragma("unroll") for (int _j = 0; _j < 4; ++_j) { const int _tt = (cch) * 64 + srow - 3 + _j; \
                rq[_j] = _tt >= 0 ? *(const u32x4*)(PB + ((size_t)b * SEQ + _tt) * NPB + QCOL + k8) : z4; rk[_j] = _tt >= 0 ? *(const u32x4*)(PB + ((size_t)b * SEQ + _tt) * NPB + KCOL + k8) : z4; } \
            ric = SM[(_g + lane) * 128 + SM_IC + h]; rfc = SM[(_g + lane) * 128 + SM_FC + h]; } \
        else { rq[0] = *(const u32x4*)(PB + (_g + srow) * NPB + QCOL + k8); rk[0] = *(const u32x4*)(PB + (_g + srow) * NPB + KCOL + k8); \
            _Pragma("unroll") for (int _j = 0; _j < 4; ++_j) ra[_j] = *(const f32x4*)(SM + (_g + srow) * 128 + SM_ALR + 4 * _j); } \
        rv[0] = *(const u32x4*)(PB + (_g + vrow) * NPB + VCOL + vc8); rv[1] = *(const u32x4*)(PB + (_g + 32 + vrow) * NPB + VCOL + vc8); } while (0)
    SC_LOAD(0);
    __syncthreads();
#pragma unroll 1
    for (int cch = 0; cch < SEQ / 64; ++cch) {
        const size_t grow = (size_t)b * SEQ + (size_t)cch * 64;
        int lz; asm volatile("v_mov_b32 %0, 0" : "=v"(lz));
        LAS bf16* Qt = Qt0 + lz; LAS bf16* Kt = Kt0 + lz; LAS bf16* KtT = KtT0 + lz; LAS bf16* Q2 = Q20 + lz; LAS bf16* Sc = Sc0 + lz; LAS bf16* VT = VT0 + lz; LAS bf16* ST = ST0 + lz;
        LAS bf16* STc = ST + (cch & 1) * 144 * LQ; LAS bf16* STn = ST + ((cch & 1) ^ 1) * 144 * LQ;
        float qv[8], kv[8];
        float g_a = 0.f, g_M = 0.f, g_bc = 0.f, M63 = 0.f, wc = 1.f;
        if (!ML) {
            unpack8(rq[0], qv); unpack8(rk[0], kv);
            float la[8];
#pragma unroll
            for (int i = 0; i < 8; ++i) la[i] = ba[k8 + i];
#pragma unroll
            for (int j4 = 0; j4 < 4; ++j4)
#pragma unroll
                for (int jj = 0; jj < 4; ++jj) { const float a = ra[j4][jj]; const LAS float* wr_ = wa2 + (j4 * 4 + jj) * 64 + k8;
                    const f32x4 w0 = *(const LAS f32x4*)wr_, w1 = *(const LAS f32x4*)(wr_ + 4);
                    la[0] += a * w0[0]; la[1] += a * w0[1]; la[2] += a * w0[2]; la[3] += a * w0[3]; la[4] += a * w1[0]; la[5] += a * w1[1]; la[6] += a * w1[2]; la[7] += a * w1[3]; }
#pragma unroll
            for (int i = 0; i < 8; ++i) { float x = logsigmoid_fast(la[i]) * (1.f / 16.f);
#pragma unroll
                for (int d = 8; d < 64; d <<= 1) { const float y = __shfl_up(x, d); if (lane >= d) x += y; }
                la[i] = x; }
            if ((lane >> 3) == 7) { *(LAS f32x4*)(segtot + w * 64 + k8) = (f32x4){la[0], la[1], la[2], la[3]}; *(LAS f32x4*)(segtot + w * 64 + k8 + 4) = (f32x4){la[4], la[5], la[6], la[7]}; }
            lds_barrier();
            float tot[8];
#pragma unroll
            for (int i = 0; i < 8; ++i) tot[i] = 0.f;
#pragma unroll
            for (int ww = 0; ww < 8; ++ww) { const f32x4 s0 = *(const LAS f32x4*)(segtot + ww * 64 + k8), s1 = *(const LAS f32x4*)(segtot + ww * 64 + k8 + 4);
                const float sel = ww < w ? 1.f : 0.f;
                la[0] += sel * s0[0]; la[1] += sel * s0[1]; la[2] += sel * s0[2]; la[3] += sel * s0[3]; la[4] += sel * s1[0]; la[5] += sel * s1[1]; la[6] += sel * s1[2]; la[7] += sel * s1[3];
                tot[0] += s0[0]; tot[1] += s0[1]; tot[2] += s0[2]; tot[3] += s0[3]; tot[4] += s1[0]; tot[5] += s1[1]; tot[6] += s1[2]; tot[7] += s1[3]; }
            if (tid < 8) {
#pragma unroll
                for (int i = 0; i < 8; ++i) etot[k8 + i] = __expf(tot[i]); }
            float kt[8];
#pragma unroll
            for (int i = 0; i < 8; ++i) { qv[i] = qv[i] * 0.125f * __expf(la[i]); kt[i] = kv[i] * __expf(-la[i]); }
            *(LAS u32x4*)(Qt + srow * LQ + k8) = pack8(qv); *(LAS u32x4*)(Kt + srow * LQ + k8) = pack8(kt);
#pragma unroll
            for (int i = 0; i < 8; ++i) KtT[(k8 + i) * LQ + srow] = (bf16)f2bf(kt[i]);
        } else {
            float x4[4][8];
#pragma unroll
            for (int j = 0; j < 4; ++j) unpack8(rq[j], x4[j]);
#pragma unroll
            for (int i = 0; i < 8; ++i) { float x = 0.f;
#pragma unroll
                for (int j = 0; j < 4; ++j) x += cw[j * 128 + k8 + i] * x4[j][i];
                qv[i] = siluf_(x) * 0.125f; }
#pragma unroll
            for (int j = 0; j < 4; ++j) unpack8(rk[j], x4[j]);
#pragma unroll
            for (int i = 0; i < 8; ++i) { float x = 0.f;
#pragma unroll
                for (int j = 0; j < 4; ++j) x += cw[j * 128 + 64 + k8 + i] * x4[j][i];
                kv[i] = siluf_(x); }
            const float lf = logsigmoid_fast(rfc + bfv), ip = ric + bi;
            g_bc = wave_scan_add(lf, lane); g_a = ip - g_bc;
            const float pm = wave_scan_max(g_a, lane); g_M = fmaxf(m_prev, pm);
            M63 = __shfl(g_M, 63); const float totb = __shfl(g_bc, 63);
            wc = __expf(m_prev - M63);
            const float Ms = __shfl(g_M, srow), as = __shfl(g_a, srow);
            const float e1 = __expf(m_prev - Ms), e2 = __expf(as - M63);
            float q2[8], kw[8];
#pragma unroll
            for (int i = 0; i < 8; ++i) { q2[i] = qv[i] * e1; kw[i] = kv[i] * e2; }
            *(LAS u32x4*)(Qt + srow * LQ + k8) = pack8(qv); *(LAS u32x4*)(Kt + srow * LQ + k8) = pack8(kv); *(LAS u32x4*)(Q2 + srow * LQ + k8) = pack8(q2);
#pragma unroll
            for (int i = 0; i < 8; ++i) KtT[(k8 + i) * LQ + srow] = (bf16)f2bf(kw[i]);
            m_prev = totb + M63;
        }
        { float v0[8], v1[8]; unpack8(rv[0], v0); unpack8(rv[1], v1);
#pragma unroll
          for (int i = 0; i < 8; ++i) { VT[(vc8 + i) * LQ + vrow] = (bf16)f2bf(v0[i]); VT[(vc8 + i) * LQ + 32 + vrow] = (bf16)f2bf(v1[i]); } }
        u32x2 gate[4];
#pragma unroll
        for (int ti = 0; ti < 4; ++ti) gate[ti] = *(const u32x2*)(PB + (grow + 16 * ti + fr) * NPB + GCOL + 16 * w + 4 * fq);
        if (cch + 1 < SEQ / 64) SC_LOAD(cch + 1);
        lds_barrier();
        {
            const int ti = w >> 1;
#pragma unroll
            for (int u = 0; u < 2; ++u) {
                const int sj = 2 * (w & 1) + u;
                f32x4 d = (f32x4){0.f, 0.f, 0.f, 0.f};
                if (sj <= ti) {
#pragma unroll
                    for (int ks = 0; ks < 2; ++ks) { const bf16x8 a = *(const LAS bf16x8*)(Kt + (16 * sj + fr) * LQ + 32 * ks + 8 * fq), bb = *(const LAS bf16x8*)(Qt + (16 * ti + fr) * LQ + 32 * ks + 8 * fq);
                        d = __builtin_amdgcn_mfma_f32_16x16x32_bf16(a, bb, d, 0, 0, 0); }
                    const int t = 16 * ti + fr, s0 = 16 * sj + 4 * fq;
                    if (ML) { const float Mt = __shfl(g_M, t);
#pragma unroll
                        for (int r = 0; r < 4; ++r) { const float as = __shfl(g_a, s0 + r); d[r] = (s0 + r <= t) ? d[r] * __expf(as - Mt) : 0.f; } }
                    else {
#pragma unroll
                        for (int r = 0; r < 4; ++r) d[r] = (s0 + r <= t) ? d[r] : 0.f; }
                }
                { u32x2 pk; pk.x = pk2(d[0], d[1]); pk.y = pk2(d[2], d[3]); *(LAS u32x2*)(Sc + (16 * ti + fr) * LQ + 16 * sj + 4 * fq) = pk; }
            }
        }
        lds_barrier();
        const LAS bf16* Qm = ML ? Q2 : Qt;
        f32x4 o[4];
        {
            bf16x8 vt[2], stf[2];
#pragma unroll
            for (int ks = 0; ks < 2; ++ks) { vt[ks] = *(const LAS bf16x8*)(VT + (16 * w + fr) * LQ + 32 * ks + 8 * fq); stf[ks] = *(const LAS bf16x8*)(STc + (16 * w + fr) * LQ + 32 * ks + 8 * fq); }
#pragma unroll
            for (int ti = 0; ti < 4; ++ti) {
                f32x4 d = (f32x4){0.f, 0.f, 0.f, 0.f};
#pragma unroll
                for (int ks = 0; ks < 2; ++ks) { const bf16x8 sc = *(const LAS bf16x8*)(Sc + (16 * ti + fr) * LQ + 32 * ks + 8 * fq); d = __builtin_amdgcn_mfma_f32_16x16x32_bf16(vt[ks], sc, d, 0, 0, 0); }
#pragma unroll
                for (int ks = 0; ks < 2; ++ks) { const bf16x8 qq = *(const LAS bf16x8*)(Qm + (16 * ti + fr) * LQ + 32 * ks + 8 * fq); d = __builtin_amdgcn_mfma_f32_16x16x32_bf16(stf[ks], qq, d, 0, 0, 0); }
                o[ti] = d;
            }
#pragma unroll
            for (int kj = 0; kj < 4; ++kj) {
                f32x4 d = (f32x4){0.f, 0.f, 0.f, 0.f};
#pragma unroll
                for (int ks = 0; ks < 2; ++ks) { const bf16x8 kk = *(const LAS bf16x8*)(KtT + (16 * kj + fr) * LQ + 32 * ks + 8 * fq); d = __builtin_amdgcn_mfma_f32_16x16x32_bf16(kk, vt[ks], d, 0, 0, 0); }
                if (ML) Sacc[kj] = Sacc[kj] * wc + d;
                else { const f32x4 e4 = *(const LAS f32x4*)(etot + 16 * kj + 4 * fq); Sacc[kj] = e4 * (Sacc[kj] + d); }
                u32x2 pk; pk.x = pk2(Sacc[kj][0], Sacc[kj][1]); pk.y = pk2(Sacc[kj][2], Sacc[kj][3]);
                *(LAS u32x2*)(STn + (16 * w + fr) * LQ + 16 * kj + 4 * fq) = pk;
            }
            if (ML) {
                if (w < 4) {
                    f32x4 d = (f32x4){0.f, 0.f, 0.f, 0.f};
#pragma unroll
                    for (int ks = 0; ks < 2; ++ks) { const bf16x8 a = *(const LAS bf16x8*)(VT + (128 + fr) * LQ + 32 * ks + 8 * fq), sc = *(const LAS bf16x8*)(Sc + (16 * w + fr) * LQ + 32 * ks + 8 * fq);
                        d = __builtin_amdgcn_mfma_f32_16x16x32_bf16(a, sc, d, 0, 0, 0); }
#pragma unroll
                    for (int ks = 0; ks < 2; ++ks) { const bf16x8 a = *(const LAS bf16x8*)(STc + (128 + fr) * LQ + 32 * ks + 8 * fq), qq = *(const LAS bf16x8*)(Qm + (16 * w + fr) * LQ + 32 * ks + 8 * fq);
                        d = __builtin_amdgcn_mfma_f32_16x16x32_bf16(a, qq, d, 0, 0, 0); }
                    if (fq == 0) dn[16 * w + fr] = d[0];
                } else {
                    const int kj = w - 4;
                    f32x4 d = (f32x4){0.f, 0.f, 0.f, 0.f};
#pragma unroll
                    for (int ks = 0; ks < 2; ++ks) { const bf16x8 kk = *(const LAS bf16x8*)(KtT + (16 * kj + fr) * LQ + 32 * ks + 8 * fq), a = *(const LAS bf16x8*)(VT + (128 + fr) * LQ + 32 * ks + 8 * fq);
                        d = __builtin_amdgcn_mfma_f32_16x16x32_bf16(kk, a, d, 0, 0, 0); }
                    Nacc = Nacc * wc + d;
                    u32x2 pk; pk.x = pk2(Nacc[0], Nacc[1]); pk.y = pk2(Nacc[2], Nacc[3]);
                    *(LAS u32x2*)(STn + (128 + fr) * LQ + 16 * kj + 4 * fq) = pk;
                }
            }
        }
#pragma unroll
        for (int ti = 0; ti < 4; ++ti) { float p = o[ti][0] * o[ti][0] + o[ti][1] * o[ti][1] + o[ti][2] * o[ti][2] + o[ti][3] * o[ti][3];
            p += __shfl_xor(p, 16); p += __shfl_xor(p, 32);
            if (fq == 0) ssq[w * 64 + 16 * ti + fr] = p; }
        lds_barrier();
#pragma unroll
        for (int ti = 0; ti < 4; ++ti) {
            const int t = 16 * ti + fr;
            float ss = 0.f;
#pragma unroll
            for (int ww = 0; ww < 8; ++ww) ss += ssq[ww * 64 + t];
            float dd = 1.f;
            if (ML) { const float bc = __shfl(g_bc, t), Mt = __shfl(g_M, t); dd = 1.f / fmaxf(fabsf(dn[t]), __expf(-(bc + Mt))); }
            const float rstd = rsqrtf(ss * dd * dd * (1.f / 128.f) + EPS) * dd;
            const f32x4 gn = *(const f32x4*)(gnorm + 16 * w + 4 * fq);
            const float g0 = bflo(gate[ti].x), g1 = bfhi(gate[ti].x), g2 = bflo(gate[ti].y), g3 = bfhi(gate[ti].y);
            f32x4 r;
            if (ML) { r[0] = o[ti][0] * rstd * gn[0] * sigmoidf_(g0); r[1] = o[ti][1] * rstd * gn[1] * sigmoidf_(g1); r[2] = o[ti][2] * rstd * gn[2] * sigmoidf_(g2); r[3] = o[ti][3] * rstd * gn[3] * sigmoidf_(g3); }
            else { r[0] = o[ti][0] * rstd * gn[0] * siluf_(g0); r[1] = o[ti][1] * rstd * gn[1] * siluf_(g1); r[2] = o[ti][2] * rstd * gn[2] * siluf_(g2); r[3] = o[ti][3] * rstd * gn[3] * siluf_(g3); }
            st_bf4(UO + (grow + t) * 512 + h * 128 + 16 * w + 4 * fq, r);
        }
    }
#undef SC_LOAD
    __syncthreads();
}

template <bool ML>
__device__ __forceinline__ void scanA_loop(const Ctx& c, int l, int it0, int it_end, int stride) {
    LAS bf16* Qt0 = (LAS bf16*)(c.lds + SC_QT); LAS bf16* Kt0 = (LAS bf16*)(c.lds + SC_KT); LAS bf16* KtT0 = (LAS bf16*)(c.lds + SC_KTT);
    LAS bf16* Sc0 = (LAS bf16*)(c.lds + SC_SC); LAS bf16* VT0 = (LAS bf16*)(c.lds + SC_VT);
    LAS float* segtot = (LAS float*)(c.lds + SC_FL);
    LAS float* wa2 = segtot + 512 + 64 + 512 + 64;
    LAS float* ba = wa2 + 1024;
    LAS float* cw = ba + 64;
    const int tid = c.tid, lane = c.lane, w = c.wave, fr = lane & 15, fq = lane >> 4;
    const int srow = tid >> 3, kg = tid & 7, k8 = kg * 8, vrow = tid >> 4, vc8 = (tid & 15) * 8;
    const bf16* PB = (const bf16*)(c.ws + WS_PB); const float* SM = (const float*)(c.ws + WS_SM);
    bf16* UO = (bf16*)(c.ws + (ML ? WS_UC : WS_UA));
    bf16* QS = (bf16*)(c.ws + WS_QS) + (ML ? (size_t)T * 256 : 0);
    u32x4 rq[ML ? 4 : 1], rk[ML ? 4 : 1], rv[2]; f32x4 ra[4]; float ric = 0.f, rfc = 0.f;
    const u32x4 z4 = (u32x4){0u, 0u, 0u, 0u};
#define SA_LOAD(it_) do { const int _rem = (it_) & 2047, _seq = _rem >> 5, _cch = _rem & 31, _b = _seq >> 2, _h = _seq & 3; \
        const size_t _g = (size_t)_b * SEQ + (size_t)_cch * 64; \
        const int _qc = (ML ? PB_QC : PB_QA) + _h * 64, _kc = (ML ? PB_KC : PB_KA) + _h * 64, _vc = (ML ? PB_VC : PB_VA) + _h * 128; \
        if (ML) { _Pragma("unroll") for (int _j = 0; _j < 4; ++_j) { const int _tt = _cch * 64 + srow - 3 + _j; \
                rq[_j] = _tt >= 0 ? *(const u32x4*)(PB + ((size_t)_b * SEQ + _tt) * NPB + _qc + k8) : z4; rk[_j] = _tt >= 0 ? *(const u32x4*)(PB + ((size_t)_b * SEQ + _tt) * NPB + _kc + k8) : z4; } \
            ric = SM[(_g + lane) * 128 + SM_IC + _h]; rfc = SM[(_g + lane) * 128 + SM_FC + _h]; } \
        else { rq[0] = *(const u32x4*)(PB + (_g + srow) * NPB + _qc + k8); rk[0] = *(const u32x4*)(PB + (_g + srow) * NPB + _kc + k8); \
            _Pragma("unroll") for (int _j = 0; _j < 4; ++_j) ra[_j] = *(const f32x4*)(SM + (_g + srow) * 128 + SM_ALR + 4 * _j); } \
        rv[0] = *(const u32x4*)(PB + (_g + vrow) * NPB + _vc + vc8); rv[1] = *(const u32x4*)(PB + (_g + 32 + vrow) * NPB + _vc + vc8); } while (0)
    if (it0 < it_end) SA_LOAD(it0);
    int hprev = -1;
#pragma unroll 1
    for (int it = it0; it < it_end; it += stride) {
    const int rem_ = it & 2047, seq_ = rem_ >> 5, cch = rem_ & 31, b = seq_ >> 2, h = seq_ & 3;
    const int slot = (b * 4 + h) * 32 + cch;
    bf16* DS = ML ? (bf16*)(c.ws + WS_DSM) + (size_t)slot * 144 * 64 : (bf16*)(c.ws + WS_DSG) + (size_t)slot * 128 * 64;
    const size_t grow = (size_t)b * SEQ + (size_t)cch * 64;
    int lz; asm volatile("v_mov_b32 %0, 0" : "=v"(lz));
    LAS bf16* Qt = Qt0 + lz; LAS bf16* Kt = Kt0 + lz; LAS bf16* KtT = KtT0 + lz; LAS bf16* Sc = Sc0 + lz; LAS bf16* VT = VT0 + lz;
    __syncthreads();
    if (h != hprev) {
        if (!ML) { for (int i = tid; i < 1024; i += NTHR) wa2[i] = c.in[IN_GLA_WA2][(size_t)l * 16 * 256 + (i >> 6) * 256 + h * 64 + (i & 63)];
                   if (tid < 64) ba[tid] = c.in[IN_GLA_BA][l * 256 + h * 64 + tid]; }
        else { { const int j = tid >> 7, cc = tid & 127; cw[tid] = c.in[IN_ML_CONV][(size_t)l * 4 * 512 + j * 512 + (cc < 64 ? h * 64 + cc : 256 + h * 64 + (cc - 64))]; }
               for (int i = tid; i < 16 * LQ; i += NTHR) VT[128 * LQ + i] = (i < 64) ? (bf16)0x3f80u : (bf16)0u; }
        hprev = h;
        __syncthreads();
    }
    const float bi = ML ? c.in[IN_ML_BI][l * 4 + h] : 0.f, bfv = ML ? c.in[IN_ML_BF][l * 4 + h] : 0.f;
    float qv[8], kv[8];
    float g_a = 0.f, g_pm = 0.f;
    if (!ML) {
        unpack8(rq[0], qv); unpack8(rk[0], kv);
        float la[8];
#pragma unroll
        for (int i = 0; i < 8; ++i) la[i] = ba[k8 + i];
#pragma unroll
        for (int j4 = 0; j4 < 4; ++j4)
#pragma unroll
            for (int jj = 0; jj < 4; ++jj) { const float a = ra[j4][jj]; const LAS float* wr_ = wa2 + (j4 * 4 + jj) * 64 + k8;
                const f32x4 w0 = *(const LAS f32x4*)wr_, w1 = *(const LAS f32x4*)(wr_ + 4);
                la[0] += a * w0[0]; la[1] += a * w0[1]; la[2] += a * w0[2]; la[3] += a * w0[3]; la[4] += a * w1[0]; la[5] += a * w1[1]; la[6] += a * w1[2]; la[7] += a * w1[3]; }
#pragma unroll
        for (int i = 0; i < 8; ++i) { float x = logsigmoid_fast(la[i]) * (1.f / 16.f);
#pragma unroll
            for (int d = 8; d < 64; d <<= 1) { const float y = __shfl_up(x, d); if (lane >= d) x += y; }
            la[i] = x; }
        if ((lane >> 3) == 7) { *(LAS f32x4*)(segtot + w * 64 + k8) = (f32x4){la[0], la[1], la[2], la[3]}; *(LAS f32x4*)(segtot + w * 64 + k8 + 4) = (f32x4){la[4], la[5], la[6], la[7]}; }
        lds_barrier();
        float tot[8];
#pragma unroll
        for (int i = 0; i < 8; ++i) tot[i] = 0.f;
#pragma unroll
        for (int ww = 0; ww < 8; ++ww) { const f32x4 s0 = *(const LAS f32x4*)(segtot + ww * 64 + k8), s1 = *(const LAS f32x4*)(segtot + ww * 64 + k8 + 4);
            const float sel = ww < w ? 1.f : 0.f;
            la[0] += sel * s0[0]; la[1] += sel * s0[1]; la[2] += sel * s0[2]; la[3] += sel * s0[3]; la[4] += sel * s1[0]; la[5] += sel * s1[1]; la[6] += sel * s1[2]; la[7] += sel * s1[3];
            tot[0] += s0[0]; tot[1] += s0[1]; tot[2] += s0[2]; tot[3] += s0[3]; tot[4] += s1[0]; tot[5] += s1[1]; tot[6] += s1[2]; tot[7] += s1[3]; }
        if (tid < 8) { float* et = (float*)(c.ws + WS_ET) + (size_t)slot * 64 + k8;
            *(f32x4*)et = (f32x4){__expf(tot[0]), __expf(tot[1]), __expf(tot[2]), __expf(tot[3])}; *(f32x4*)(et + 4) = (f32x4){__expf(tot[4]), __expf(tot[5]), __expf(tot[6]), __expf(tot[7])}; }
        float kt[8];
#pragma unroll
        for (int i = 0; i < 8; ++i) { qv[i] = qv[i] * 0.125f * __expf(la[i]); kt[i] = kv[i] * __expf(-la[i]); }
        const u32x4 qp = pack8(qv);
        *(LAS u32x4*)(Qt + srow * LQ + k8) = qp; *(LAS u32x4*)(Kt + srow * LQ + k8) = pack8(kt);
        *(u32x4*)(QS + (grow + srow) * 256 + h * 64 + k8) = qp;
#pragma unroll
        for (int i = 0; i < 8; ++i) KtT[(k8 + i) * LQ + srow] = (bf16)f2bf(kt[i]);
    } else {
        float x4[4][8];
#pragma unroll
        for (int j = 0; j < 4; ++j) unpack8(rq[j], x4[j]);
#pragma unroll
        for (int i = 0; i < 8; ++i) { float x = 0.f;
#pragma unroll
            for (int j = 0; j < 4; ++j) x += cw[j * 128 + k8 + i] * x4[j][i];
            qv[i] = siluf_(x) * 0.125f; }
#pragma unroll
        for (int j = 0; j < 4; ++j) unpack8(rk[j], x4[j]);
#pragma unroll
        for (int i = 0; i < 8; ++i) { float x = 0.f;
#pragma unroll
            for (int j = 0; j < 4; ++j) x += cw[j * 128 + 64 + k8 + i] * x4[j][i];
            kv[i] = siluf_(x); }
        const float lf = logsigmoid_fast(rfc + bfv), ip = ric + bi;
        const float g_bc = wave_scan_add(lf, lane); g_a = ip - g_bc;
        g_pm = wave_scan_max(g_a, lane);
        const float pm63 = __shfl(g_pm, 63), totb = __shfl(g_bc, 63);
        if (w == 0) { ((float*)(c.ws + WS_GPM))[(grow + lane) * 4 + h] = g_pm; ((float*)(c.ws + WS_GBC))[(grow + lane) * 4 + h] = g_bc;
            if (lane == 0) { float* ct = (float*)(c.ws + WS_CT) + (size_t)slot * 2; ct[0] = totb; ct[1] = pm63; } }
        const float as = __shfl(g_a, srow);
        const float e2 = __expf(as - pm63);
        float kw[8];
#pragma unroll
        for (int i = 0; i < 8; ++i) kw[i] = kv[i] * e2;
        const u32x4 qp = pack8(qv);
        *(LAS u32x4*)(Qt + srow * LQ + k8) = qp; *(LAS u32x4*)(Kt + srow * LQ + k8) = pack8(kv);
        *(u32x4*)(QS + (grow + srow) * 256 + h * 64 + k8) = qp;
#pragma unroll
        for (int i = 0; i < 8; ++i) KtT[(k8 + i) * LQ + srow] = (bf16)f2bf(kw[i]);
    }
    { float v0[8], v1[8]; unpack8(rv[0], v0); unpack8(rv[1], v1);
#pragma unroll
      for (int i = 0; i < 8; ++i) { VT[(vc8 + i) * LQ + vrow] = (bf16)f2bf(v0[i]); VT[(vc8 + i) * LQ + 32 + vrow] = (bf16)f2bf(v1[i]); } }
    if (it + stride < it_end) SA_LOAD(it + stride);
    lds_barrier();
    {
        const int ti = w >> 1;
#pragma unroll
        for (int u = 0; u < 2; ++u) {
            const int sj = 2 * (w & 1) + u;
            f32x4 d = (f32x4){0.f, 0.f, 0.f, 0.f};
            if (sj <= ti) {
#pragma unroll
                for (int ks = 0; ks < 2; ++ks) { const bf16x8 a = *(const LAS bf16x8*)(Kt + (16 * sj + fr) * LQ + 32 * ks + 8 * fq), bb = *(const LAS bf16x8*)(Qt + (16 * ti + fr) * LQ + 32 * ks + 8 * fq);
                    d = __builtin_amdgcn_mfma_f32_16x16x32_bf16(a, bb, d, 0, 0, 0); }
                const int t = 16 * ti + fr, s0 = 16 * sj + 4 * fq;
                if (ML) { const float pt = __shfl(g_pm, t);
#pragma unroll
                    for (int r = 0; r < 4; ++r) { const float as = __shfl(g_a, s0 + r); d[r] = (s0 + r <= t) ? d[r] * __expf(as - pt) : 0.f; } }
                else {
#pragma unroll
                    for (int r = 0; r < 4; ++r) d[r] = (s0 + r <= t) ? d[r] : 0.f; }
            }
            { u32x2 pk; pk.x = pk2(d[0], d[1]); pk.y = pk2(d[2], d[3]); *(LAS u32x2*)(Sc + (16 * ti + fr) * LQ + 16 * sj + 4 * fq) = pk; }
        }
    }
    lds_barrier();
    {
        bf16x8 vt[2];
#pragma unroll
        for (int ks = 0; ks < 2; ++ks) vt[ks] = *(const LAS bf16x8*)(VT + (16 * w + fr) * LQ + 32 * ks + 8 * fq);
#pragma unroll
        for (int ti = 0; ti < 4; ++ti) {
            f32x4 d = (f32x4){0.f, 0.f, 0.f, 0.f};
#pragma unroll
            for (int ks = 0; ks < 2; ++ks) { const bf16x8 sc = *(const LAS bf16x8*)(Sc + (16 * ti + fr) * LQ + 32 * ks + 8 * fq); d = __builtin_amdgcn_mfma_f32_16x16x32_bf16(vt[ks], sc, d, 0, 0, 0); }
            st_bf4(UO + (grow + 16 * ti + fr) * 512 + h * 128 + 16 * w + 4 * fq, d);
        }
#pragma unroll
        for (int kj = 0; kj < 4; ++kj) {
            f32x4 d = (f32x4){0.f, 0.f, 0.f, 0.f};
#pragma unroll
            for (int ks = 0; ks < 2; ++ks) { const bf16x8 kk = *(const LAS bf16x8*)(KtT + (16 * kj + fr) * LQ + 32 * ks + 8 * fq); d = __builtin_amdgcn_mfma_f32_16x16x32_bf16(kk, vt[ks], d, 0, 0, 0); }
            st_bf4(DS + (16 * w + fr) * 64 + 16 * kj + 4 * fq, d);
        }
        if (ML) {
            if (w < 4) {
                f32x4 d = (f32x4){0.f, 0.f, 0.f, 0.f};
#pragma unroll
                for (int ks = 0; ks < 2; ++ks) { const bf16x8 a = *(const LAS bf16x8*)(VT + (128 + fr) * LQ + 32 * ks + 8 * fq), sc = *(const LAS bf16x8*)(Sc + (16 * w + fr) * LQ + 32 * ks + 8 * fq);
                    d = __builtin_amdgcn_mfma_f32_16x16x32_bf16(a, sc, d, 0, 0, 0); }
                if (fq == 0) ((float*)(c.ws + WS_DN))[(grow + 16 * w + fr) * 4 + h] = d[0];
            } else {
                const int kj = w - 4;
                f32x4 d = (f32x4){0.f, 0.f, 0.f, 0.f};
#pragma unroll
                for (int ks = 0; ks < 2; ++ks) { const bf16x8 kk = *(const LAS bf16x8*)(KtT + (16 * kj + fr) * LQ + 32 * ks + 8 * fq), a = *(const LAS bf16x8*)(VT + (128 + fr) * LQ + 32 * ks + 8 * fq);
                    d = __builtin_amdgcn_mfma_f32_16x16x32_bf16(kk, a, d, 0, 0, 0); }
                st_bf4(DS + (128 + fr) * 64 + 16 * kj + 4 * fq, d);
            }
        }
    }
    }
#undef SA_LOAD
}
__device__ __forceinline__ void scanB(const Ctx& c) {
    const int gt = c.bid * NTHR + c.tid, NGT = c.nblk * NTHR;
    constexpr int NG = 64 * 128 * 8, NM = 64 * 128 * 8;
    for (int idx = gt; idx < NG + NM; idx += NGT) {
        float S[8];
#pragma unroll
        for (int i = 0; i < 8; ++i) S[i] = 0.f;
        if (idx < NG) {
            const int seq = idx >> 10, v = (idx >> 3) & 127, kg = idx & 7;
            bf16* p = (bf16*)(c.ws + WS_DSG) + (size_t)seq * 32 * 8192 + v * 64 + kg * 8;
            const float* et = (const float*)(c.ws + WS_ET) + (size_t)seq * 32 * 64 + kg * 8;
#pragma unroll 1
            for (int c4 = 0; c4 < 32; c4 += 4) {
                u32x4 dv[4]; f32x4 e0[4], e1[4];
#pragma unroll
                for (int j = 0; j < 4; ++j) { dv[j] = *(const u32x4*)(p + (size_t)(c4 + j) * 8192); e0[j] = *(const f32x4*)(et + (c4 + j) * 64); e1[j] = *(const f32x4*)(et + (c4 + j) * 64 + 4); }
#pragma unroll
                for (int j = 0; j < 4; ++j) {
                    float d[8]; unpack8(dv[j], d);
                    const u32x4 sp = pack8(S);
                    S[0] = e0[j][0] * (S[0] + d[0]); S[1] = e0[j][1] * (S[1] + d[1]); S[2] = e0[j][2] * (S[2] + d[2]); S[3] = e0[j][3] * (S[3] + d[3]);
                    S[4] = e1[j][0] * (S[4] + d[4]); S[5] = e1[j][1] * (S[5] + d[5]); S[6] = e1[j][2] * (S[6] + d[6]); S[7] = e1[j][3] * (S[7] + d[7]);
                    *(u32x4*)(p + (size_t)(c4 + j) * 8192) = sp;
                }
            }
        } else {
            const int j0 = idx - NG, seq = j0 >> 10, v = (j0 >> 3) & 127, kg = j0 & 7;
            const bool nrow = v == 0;
            bf16* p = (bf16*)(c.ws + WS_DSM) + (size_t)seq * 32 * 9216 + v * 64 + kg * 8;
            bf16* pn = (bf16*)(c.ws + WS_DSM) + (size_t)seq * 32 * 9216 + 128 * 64 + kg * 8;
            const float* ct = (const float*)(c.ws + WS_CT) + (size_t)seq * 32 * 2;
            float* mp = (float*)(c.ws + WS_MP) + (size_t)seq * 32;
            float m = 0.f, N[8];
#pragma unroll
            for (int i = 0; i < 8; ++i) N[i] = 0.f;
#pragma unroll 1
            for (int c4 = 0; c4 < 32; c4 += 4) {
                u32x4 dv[4], nv[4]; f32x2 cc[4];
#pragma unroll
                for (int j = 0; j < 4; ++j) { dv[j] = *(const u32x4*)(p + (size_t)(c4 + j) * 9216); cc[j] = *(const f32x2*)(ct + (c4 + j) * 2); nv[j] = nrow ? *(const u32x4*)(pn + (size_t)(c4 + j) * 9216) : (u32x4){0u, 0u, 0u, 0u}; }
#pragma unroll
                for (int j = 0; j < 4; ++j) {
                    float d[8]; unpack8(dv[j], d);
                    const float M63 = fmaxf(m, cc[j][1]), wc = __expf(m - M63), ws = __expf(cc[j][1] - M63);
                    const u32x4 sp = pack8(S);
                    if (nrow && kg == 0) mp[c4 + j] = m;
#pragma unroll
                    for (int i = 0; i < 8; ++i) S[i] = wc * S[i] + ws * d[i];
                    *(u32x4*)(p + (size_t)(c4 + j) * 9216) = sp;
                    if (nrow) { float dnv[8]; unpack8(nv[j], dnv); const u32x4 np = pack8(N);
#pragma unroll
                        for (int i = 0; i < 8; ++i) N[i] = wc * N[i] + ws * dnv[i];
                        *(u32x4*)(pn + (size_t)(c4 + j) * 9216) = np; }
                    m = cc[j][0] + M63;
                }
            }
        }
    }
}
template <bool ML>
__device__ __forceinline__ void scanC_wave(const Ctx& c, int l, int b, int h, int cch, int ti) {
    const int lane = c.lane, fr = lane & 15, fq = lane >> 4;
    const bf16* PB = (const bf16*)(c.ws + WS_PB);
    bf16* UO = (bf16*)(c.ws + (ML ? WS_UC : WS_UA));
    const bf16* QS = (const bf16*)(c.ws + WS_QS) + (ML ? (size_t)T * 256 : 0);
    const int slot = (b * 4 + h) * 32 + cch;
    const bf16* SP = ML ? (const bf16*)(c.ws + WS_DSM) + (size_t)slot * 144 * 64 : (const bf16*)(c.ws + WS_DSG) + (size_t)slot * 128 * 64;
    const int GCOL = (ML ? PB_OC : PB_GA) + h * 128;
    const float* gnorm = c.in[ML ? IN_ML_NORM : IN_GLA_NORM] + l * 512 + h * 128;
    const size_t trow = (size_t)b * SEQ + (size_t)cch * 64 + 16 * ti + fr;
    bf16x8 qf[2], sf[8][2], nf[2];
#pragma unroll
    for (int ks = 0; ks < 2; ++ks) qf[ks] = *(const bf16x8*)(QS + trow * 256 + h * 64 + 32 * ks + 8 * fq);
#pragma unroll
    for (int n = 0; n < 8; ++n)
#pragma unroll
        for (int ks = 0; ks < 2; ++ks) sf[n][ks] = *(const bf16x8*)(SP + (16 * n + fr) * 64 + 32 * ks + 8 * fq);
    if (ML) {
#pragma unroll
        for (int ks = 0; ks < 2; ++ks) nf[ks] = *(const bf16x8*)(SP + (128 + fr) * 64 + 32 * ks + 8 * fq); }
    u32x2 gate[8], oi[8];
#pragma unroll
    for (int n = 0; n < 8; ++n) { gate[n] = *(const u32x2*)(PB + trow * NPB + GCOL + 16 * n + 4 * fq); oi[n] = *(const u32x2*)(UO + trow * 512 + h * 128 + 16 * n + 4 * fq); }
    float e_in = 1.f, e_st = 1.f, dd = 1.f;
    if (ML) {
        const float pm = ((const float*)(c.ws + WS_GPM))[trow * 4 + h], bc = ((const float*)(c.ws + WS_GBC))[trow * 4 + h], m_prev = ((const float*)(c.ws + WS_MP))[slot], dni = ((const float*)(c.ws + WS_DN))[trow * 4 + h];
        const float Mt = fmaxf(m_prev, pm); e_in = __expf(pm - Mt); e_st = __expf(m_prev - Mt);
        f32x4 d = (f32x4){0.f, 0.f, 0.f, 0.f};
#pragma unroll
        for (int ks = 0; ks < 2; ++ks) d = __builtin_amdgcn_mfma_f32_16x16x32_bf16(nf[ks], qf[ks], d, 0, 0, 0);
        const float dst = __shfl(d[0], fr);
        const float den = dni * e_in + dst * e_st;
        dd = 1.f / fmaxf(fabsf(den), __expf(-(bc + Mt)));
    }
    f32x4 o[8]; float ss = 0.f;
#pragma unroll
    for (int n = 0; n < 8; ++n) {
        f32x4 d = (f32x4){0.f, 0.f, 0.f, 0.f};
#pragma unroll
        for (int ks = 0; ks < 2; ++ks) d = __builtin_amdgcn_mfma_f32_16x16x32_bf16(sf[n][ks], qf[ks], d, 0, 0, 0);
        const f32x4 oiv = (f32x4){bflo(oi[n].x), bfhi(oi[n].x), bflo(oi[n].y), bfhi(oi[n].y)};
        o[n] = ML ? oiv * e_in + d * e_st : oiv + d;
        ss += o[n][0] * o[n][0] + o[n][1] * o[n][1] + o[n][2] * o[n][2] + o[n][3] * o[n][3];
    }
    ss += __shfl_xor(ss, 16); ss += __shfl_xor(ss, 32);
    const float rstd = rsqrtf(ss * dd * dd * (1.f / 128.f) + EPS) * dd;
#pragma unroll
    for (int n = 0; n < 8; ++n) {
        const f32x4 gn = *(const f32x4*)(gnorm + 16 * n + 4 * fq);
        const float g0 = bflo(gate[n].x), g1 = bfhi(gate[n].x), g2 = bflo(gate[n].y), g3 = bfhi(gate[n].y);
        f32x4 r;
        if (ML) { r[0] = o[n][0] * rstd * gn[0] * sigmoidf_(g0); r[1] = o[n][1] * rstd * gn[1] * sigmoidf_(g1); r[2] = o[n][2] * rstd * gn[2] * sigmoidf_(g2); r[3] = o[n][3] * rstd * gn[3] * sigmoidf_(g3); }
        else { r[0] = o[n][0] * rstd * gn[0] * siluf_(g0); r[1] = o[n][1] * rstd * gn[1] * siluf_(g1); r[2] = o[n][2] * rstd * gn[2] * siluf_(g2); r[3] = o[n][3] * rstd * gn[3] * siluf_(g3); }
        st_bf4(UO + trow * 512 + h * 128 + 16 * n + 4 * fq, r);
    }
}
__device__ __forceinline__ void phase_scanA(const Ctx& c, int l) {
    const int nG = c.bid < 2048 ? (2048 - c.bid + c.nblk - 1) / c.nblk : 0;
    const int firstM = c.bid + nG * c.nblk;
    scanA_loop<false>(c, l, c.bid, 2048, c.nblk);
    scanA_loop<true>(c, l, firstM, 4096, c.nblk);
    __syncthreads();
}
__device__ __forceinline__ void phase_scanC(const Ctx& c, int l) {
    const int gw = c.bid * NWAVES + c.wave, NGW = c.nblk * NWAVES;
#pragma unroll 1
    for (int it = gw; it < 16384; it += NGW) { const int br = it >> 13, rem = it & 8191, seq = rem >> 7, cch = (rem >> 2) & 31, ti = rem & 3;
        if (br == 0) scanC_wave<false>(c, l, seq >> 2, seq & 3, cch, ti); else scanC_wave<true>(c, l, seq >> 2, seq & 3, cch, ti); }
}
__device__ __forceinline__ void phase_scans(const Ctx& c, int l) {
    for (int it = c.bid; it < 128; it += c.nblk) {
#if SCAN_RECURRENT
        if (it < 64) scan_gla_item(c, l, it >> 2, it & 3);
        else scan_mlstm_item(c, l, (it - 64) >> 2, (it - 64) & 3);
#else
        if (it < 64) scan_chunked_item<false>(c, l, it >> 2, it & 3);
        else scan_chunked_item<true>(c, l, (it - 64) >> 2, (it - 64) & 3);
#endif
    }
}

__device__ __forceinline__ unsigned ord_key(float f) { const unsigned u = __builtin_bit_cast(unsigned, f); return (u & 0x80000000u) ? ~u : (u | 0x80000000u); }
__device__ __forceinline__ void phase_dsa(const Ctx& c, int l) {
    LAS unsigned char* wl = c.lds + c.wave * 14336;
    LAS float* I_s = (LAS float*)wl;
    LAS int* list = (LAS int*)(wl + 8192);
    LAS float* qi_s = (LAS float*)(wl + 9216);
    LAS float* ql_s = (LAS float*)(wl + 10240);
    const bf16* QLAT = (const bf16*)(c.ws + WS_QLAT); const bf16* QIDX = (const bf16*)(c.ws + WS_QIDX);
    const bf16* CKVN = (const bf16*)(c.ws + WS_CKVN); const float* SM = (const float*)(c.ws + WS_SM);
    bf16* OLAT = (bf16*)(c.ws + WS_OLAT);
    const int gw = c.bid * NWAVES + c.wave, NGW = c.nblk * NWAVES, lane = c.lane;
    for (int tq = gw; tq < T; tq += NGW) {
        const int b = tq >> 11, pos = tq & 2047, nvalid = pos + 1;
        const size_t kb = (size_t)b * SEQ;
        { const f32x4 q = ld_bf4(QIDX + (size_t)tq * 256 + 4 * lane); *(LAS f32x4*)(qi_s + 4 * lane) = q;
#pragma unroll
          for (int j = 0; j < 4; ++j) { const f32x4 ql = ld_bf4(QLAT + (size_t)tq * 1024 + 4 * (lane + 64 * j)); *(LAS f32x4*)(ql_s + 4 * (lane + 64 * j)) = ql; } }
        float wh[8];
#pragma unroll
        for (int hh = 0; hh < 8; ++hh) wh[hh] = SM[(size_t)tq * 128 + SM_WIDX + hh] * 0.35355339059327373f;
        asm volatile("s_waitcnt lgkmcnt(0)" ::: "memory");
        int nsel;
        if (nvalid <= DSA_K) {
            for (int i = lane; i < DSA_K; i += 64) list[i] = i;
            nsel = nvalid;
        } else {
            const int nj = (nvalid + 63) >> 6;
            for (int j = 0; j < nj; ++j) {
                const int s = lane + 64 * j;
                float val = -INFINITY;
                if (s < nvalid) {
                    const float* kr = SM + (kb + s) * 128 + SM_KIDX;
                    f32x4 kk[8];
#pragma unroll
                    for (int i = 0; i < 8; ++i) kk[i] = *(const f32x4*)(kr + 4 * i);
                    val = 0.f;
#pragma unroll
                    for (int hh = 0; hh < 8; ++hh) { float d = 0.f;
#pragma unroll
                        for (int i = 0; i < 8; ++i) { const f32x4 q = *(const LAS f32x4*)(qi_s + hh * 32 + 4 * i); d += q[0] * kk[i][0] + q[1] * kk[i][1] + q[2] * kk[i][2] + q[3] * kk[i][3]; }
                        val += wh[hh] * fmaxf(d, 0.f); }
                }
                I_s[s] = val;
            }
            for (int j = nj; j < 32; ++j) I_s[lane + 64 * j] = -INFINITY;
            asm volatile("s_waitcnt lgkmcnt(0)" ::: "memory");
            LAS unsigned* K_s = (LAS unsigned*)I_s;
#pragma unroll 4
            for (int j = 0; j < 32; ++j) K_s[lane + 64 * j] = ord_key(I_s[lane + 64 * j]);
            unsigned thr = 0u;
#pragma unroll 1
            for (int bit = 31; bit >= 0; --bit) {
                const unsigned cand = thr | (1u << bit); int cnt = 0;
#pragma unroll 8
                for (int j = 0; j < 32; ++j) cnt += (K_s[lane + 64 * j] >= cand) ? 1 : 0;
                cnt = wave_sum_i(cnt);
                if (cnt >= DSA_K) thr = cand;
            }
            int cgt = 0;
#pragma unroll 8
            for (int j = 0; j < 32; ++j) cgt += (K_s[lane + 64 * j] > thr) ? 1 : 0;
            cgt = wave_sum_i(cgt);
            int need = DSA_K - cgt, base = 0;
            const unsigned long long lt = (1ull << lane) - 1ull;
#pragma unroll 2
            for (int j = 0; j < 32; ++j) {
                const unsigned kj = K_s[lane + 64 * j];
                const bool gt = kj > thr, eq = kj == thr;
                const unsigned long long meq = __ballot(eq);
                const int rk = __popcll(meq & lt);
                const bool sel = gt || (eq && rk < need);
                need -= __popcll(meq); if (need < 0) need = 0;
                const unsigned long long ms = __ballot(sel);
                if (sel) list[base + __popcll(ms & lt)] = lane + 64 * j;
                base += __popcll(ms);
            }
            nsel = DSA_K;
        }
        asm volatile("s_waitcnt lgkmcnt(0)" ::: "memory");
        int ks[4]; float lg[4][8];
#pragma unroll
        for (int i = 0; i < 4; ++i) { const int li = lane + 64 * i; ks[i] = (li < nsel) ? list[li] : 0;
#pragma unroll
            for (int hh = 0; hh < 8; ++hh) lg[i][hh] = 0.f; }
#pragma unroll 1
        for (int ch = 0; ch < 16; ++ch) {
            f32x4 ka[4], kc[4];
#pragma unroll
            for (int i = 0; i < 4; ++i) { const u32x4 w = *(const u32x4*)(CKVN + (kb + ks[i]) * 128 + ch * 8);
                ka[i] = (f32x4){bflo(w.x), bfhi(w.x), bflo(w.y), bfhi(w.y)}; kc[i] = (f32x4){bflo(w.z), bfhi(w.z), bflo(w.w), bfhi(w.w)}; }
#pragma unroll
            for (int hh = 0; hh < 8; ++hh) { const f32x4 qa = *(const LAS f32x4*)(ql_s + hh * 128 + ch * 8), qb = *(const LAS f32x4*)(ql_s + hh * 128 + ch * 8 + 4);
#pragma unroll
                for (int i = 0; i < 4; ++i) lg[i][hh] += qa[0] * ka[i][0] + qa[1] * ka[i][1] + qa[2] * ka[i][2] + qa[3] * ka[i][3] + qb[0] * kc[i][0] + qb[1] * kc[i][1] + qb[2] * kc[i][2] + qb[3] * kc[i][3]; }
        }
#pragma unroll
        for (int hh = 0; hh < 8; ++hh) {
            const float slope = exp2f(-(float)(hh + 1));
            float mx = -INFINITY;
#pragma unroll
            for (int i = 0; i < 4; ++i) { const bool ok = (lane + 64 * i) < nsel; lg[i][hh] = ok ? lg[i][hh] - slope * (float)(pos - ks[i]) : -INFINITY; mx = fmaxf(mx, lg[i][hh]); }
            mx = wave_max(mx);
            float sm = 0.f;
#pragma unroll
            for (int i = 0; i < 4; ++i) { lg[i][hh] = __expf(lg[i][hh] - mx); sm += lg[i][hh]; }
            sm = wave_sum(sm);
            const float inv = 1.f / sm;
#pragma unroll
            for (int i = 0; i < 4; ++i) lg[i][hh] *= inv;
        }
#pragma unroll
        for (int i = 0; i < 4; ++i) { const int li = lane + 64 * i;
            *(LAS f32x4*)(I_s + li * 8) = (f32x4){lg[i][0], lg[i][1], lg[i][2], lg[i][3]}; *(LAS f32x4*)(I_s + li * 8 + 4) = (f32x4){lg[i][4], lg[i][5], lg[i][6], lg[i][7]}; }
        asm volatile("s_waitcnt lgkmcnt(0)" ::: "memory");
        float o0[8], o1[8];
#pragma unroll
        for (int hh = 0; hh < 8; ++hh) { o0[hh] = 0.f; o1[hh] = 0.f; }
#pragma unroll 2
        for (int kidx = 0; kidx < nsel; ++kidx) {
            const int s = list[kidx];
            const unsigned w = *(const unsigned*)(CKVN + (kb + s) * 128 + 2 * lane);
            const float v0 = bflo(w), v1 = bfhi(w);
            const f32x4 pa = *(const LAS f32x4*)(I_s + kidx * 8), pb = *(const LAS f32x4*)(I_s + kidx * 8 + 4);
            o0[0] += pa[0] * v0; o1[0] += pa[0] * v1; o0[1] += pa[1] * v0; o1[1] += pa[1] * v1; o0[2] += pa[2] * v0; o1[2] += pa[2] * v1; o0[3] += pa[3] * v0; o1[3] += pa[3] * v1;
            o0[4] += pb[0] * v0; o1[4] += pb[0] * v1; o0[5] += pb[1] * v0; o1[5] += pb[1] * v1; o0[6] += pb[2] * v0; o1[6] += pb[2] * v1; o0[7] += pb[3] * v0; o1[7] += pb[3] * v1;
        }
#pragma unroll
        for (int hh = 0; hh < 8; ++hh) *(unsigned*)(OLAT + (size_t)tq * 1024 + hh * 128 + 2 * lane) = pk2(o0[hh], o1[hh]);
        asm volatile("s_waitcnt lgkmcnt(0)" ::: "memory");
    }
}


__device__ __forceinline__ int half_sum(int v) {
    v += __builtin_amdgcn_update_dpp(0, v, 0xB1, 0xF, 0xF, false);
    v += __builtin_amdgcn_update_dpp(0, v, 0x4E, 0xF, 0xF, false);
    v += __builtin_amdgcn_update_dpp(0, v, 0x141, 0xF, 0xF, false);
    v += __builtin_amdgcn_update_dpp(0, v, 0x140, 0xF, 0xF, false);
    v += __shfl_xor(v, 16);
    return v;
}
typedef float f32x16 __attribute__((ext_vector_type(16)));
__device__ __forceinline__ void phase_dsa_sel(const Ctx& c, int l) {
    const bf16* QIDX = (const bf16*)(c.ws + WS_QIDX); const bf16* KIDX = (const bf16*)(c.ws + WS_KIDX); const float* SM = (const float*)(c.ws + WS_SM);
    unsigned* MASK = (unsigned*)(c.ws + WS_MASK);
    const int lane = c.lane, hf = lane >> 5, l31 = lane & 31;
    const int rho = l31, tl = 2 * ((rho >> 2) & 1) + (rho >> 4), hd = (rho & 3) + 4 * ((rho >> 3) & 1);
    const unsigned ltmask = (1u << l31) - 1u;
    LAS unsigned* KL = (LAS unsigned*)(c.lds + c.wave * 16384);
    LAS unsigned* MW = (LAS unsigned*)(c.lds + 131072 + c.wave * 512);
    unsigned* KEYB = (unsigned*)(c.ws + WS_KEYB) + (size_t)(c.bid * NWAVES + c.wave) * 4096;
    const int npass = (c.nblk == 256) ? 2 : (T / 64 + c.nblk - 1) / c.nblk;
#pragma unroll 1
    for (int ps = 0; ps < npass; ++ps) {
        int b, q64;
        if (c.nblk == 256) { b = c.bid & 15; q64 = ps == 0 ? 31 - (c.bid >> 4) : (c.bid >> 4); }
        else { const int it = c.bid + ps * c.nblk; if (it >= T / 64) break; b = it >> 5; q64 = it & 31; }
        const int pb = q64 * 64;
#pragma unroll 1
        for (int wi = 0; wi < 2; ++wi) {
        const int pos0 = pb + 8 * c.wave + 4 * wi, t0 = b * SEQ + pos0;
        unsigned wA0 = 0u, wB0 = 0u, wA1 = 0u, wB1 = 0u;
        if (pos0 + 3 < DSA_K) {
            const int p_0 = pos0 + 2 * hf, p_1 = p_0 + 1;
            { const int lo = 32 * l31; wA0 = p_0 >= lo + 31 ? 0xffffffffu : (p_0 < lo ? 0u : ((2u << (p_0 - lo)) - 1u)); wA1 = p_1 >= lo + 31 ? 0xffffffffu : (p_1 < lo ? 0u : ((2u << (p_1 - lo)) - 1u)); }
        } else {
            const int ng = ((pos0 + 3) / 32 + 4) / 4, nkt = 4 * ng;
            bf16x8 af[2];
#pragma unroll
            for (int ks = 0; ks < 2; ++ks) af[ks] = *(const bf16x8*)(QIDX + (size_t)(t0 + tl) * 256 + hd * 32 + 16 * ks + 8 * hf);
            const bf16* kbase = KIDX + ((size_t)b * SEQ + l31) * 32 + 8 * hf;
#pragma unroll 1
            for (int tsel = 0; tsel < 2; ++tsel) {
                const int p_t = pos0 + 2 * hf + tsel;
                if (tsel == 0) {
                    float whv[16];
#pragma unroll
                    for (int r = 0; r < 16; ++r) whv[r] = SM[(size_t)(t0 + 2 * hf + (r >> 3)) * 128 + SM_WIDX + (r & 7)] * 0.35355339059327373f;
                    bf16x8 bq[4][2], bn[4][2];
#pragma unroll
                    for (int j = 0; j < 4; ++j) { bq[j][0] = *(const bf16x8*)(kbase + (size_t)(32 * j) * 32); bq[j][1] = *(const bf16x8*)(kbase + (size_t)(32 * j) * 32 + 16); }
#pragma unroll 1
                    for (int g = 0; g < ng; ++g) {
                        const int gn = (g + 1 < ng) ? g + 1 : g;
#pragma unroll
                        for (int j = 0; j < 4; ++j) { bn[j][0] = *(const bf16x8*)(kbase + (size_t)(32 * (4 * gn + j)) * 32); bn[j][1] = *(const bf16x8*)(kbase + (size_t)(32 * (4 * gn + j)) * 32 + 16); }
                        u32x4 ka, kb;
#pragma unroll
                        for (int j = 0; j < 4; ++j) {
                            f32x16 d;
#pragma unroll
                            for (int r = 0; r < 16; ++r) d[r] = 0.f;
                            d = __builtin_amdgcn_mfma_f32_32x32x16_bf16(af[0], bq[j][0], d, 0, 0, 0);
                            d = __builtin_amdgcn_mfma_f32_32x32x16_bf16(af[1], bq[j][1], d, 0, 0, 0);
                            float iv0 = 0.f, iv1 = 0.f;
#pragma unroll
                            for (int r = 0; r < 8; ++r) { iv0 += whv[r] * fmaxf(d[r], 0.f); iv1 += whv[8 + r] * fmaxf(d[8 + r], 0.f); }
                            const int row = 32 * (4 * g + j) + l31;
                            ka[j] = row <= p_t ? ord_key(iv0) : 0u; kb[j] = row <= p_t + 1 ? ord_key(iv1) : 0u;
                        }
                        *(LAS u32x4*)(KL + (g * 64 + lane) * 4) = ka;
                        *(u32x4*)(KEYB + ((size_t)g * 64 + lane) * 4) = kb;
#pragma unroll
                        for (int j = 0; j < 4; ++j) { bq[j][0] = bn[j][0]; bq[j][1] = bn[j][1]; }
                    }
                } else {
#pragma unroll 4
                    for (int g = 0; g < ng; ++g) *(LAS u32x4*)(KL + (g * 64 + lane) * 4) = __builtin_nontemporal_load((const u32x4*)(KEYB + ((size_t)g * 64 + lane) * 4));
                }
                unsigned thr = 0u; bool done = false, alld = false;
#pragma unroll 1
                for (int bit = 31; bit >= 0 && !alld; --bit) {
                    const unsigned cand = thr | (1u << bit); int cn = 0;
#pragma unroll 4
                    for (int g = 0; g < ng; ++g) { const u32x4 k4 = *(const LAS u32x4*)(KL + (g * 64 + lane) * 4);
                        cn += (k4.x >= cand ? 1 : 0) + (k4.y >= cand ? 1 : 0) + (k4.z >= cand ? 1 : 0) + (k4.w >= cand ? 1 : 0); }
                    cn = half_sum(cn);
                    if (!done && cn >= DSA_K) thr = cand;
                    done = done || cn == DSA_K;
                    alld = __ballot(!done) == 0ull;
                }
                const bool dlo = alld, dhi = alld;
                MW[lane] = 0u; MW[64 + lane] = 0u;
                if (dlo && dhi) {
#pragma unroll 4
                    for (int kt = 0; kt < nkt; ++kt) { const unsigned long long ms = __ballot(KL[((kt >> 2) * 64 + lane) * 4 + (kt & 3)] >= thr);
                        if (l31 == 0) MW[hf * 64 + kt] = hf ? (unsigned)(ms >> 32) : (unsigned)ms; }
                } else {
                int glo = 0, ghi = 0;
#pragma unroll 16
                for (int kt = 0; kt < nkt; ++kt) { const unsigned long long m = __ballot(KL[((kt >> 2) * 64 + lane) * 4 + (kt & 3)] > thr); glo += __popc((unsigned)m); ghi += __popc((unsigned)(m >> 32)); }
                int nlo = DSA_K - glo, nhi = DSA_K - ghi;
#pragma unroll 2
                for (int kt = 0; kt < nkt; ++kt) {
                    const unsigned kv = KL[((kt >> 2) * 64 + lane) * 4 + (kt & 3)];
                    const bool gt = kv > thr, eq = kv == thr;
                    const unsigned long long meq = __ballot(eq); const unsigned mh = hf ? (unsigned)(meq >> 32) : (unsigned)meq;
                    const int need = hf ? nhi : nlo;
                    const bool sel = gt || (eq && (__popc(mh & ltmask) < need));
                    nlo -= __popc((unsigned)meq); nhi -= __popc((unsigned)(meq >> 32)); nlo = nlo < 0 ? 0 : nlo; nhi = nhi < 0 ? 0 : nhi;
                    const unsigned long long ms = __ballot(sel);
                    if (l31 == 0) MW[hf * 64 + kt] = hf ? (unsigned)(ms >> 32) : (unsigned)ms;
                }
                }
                const unsigned wA = MW[hf * 64 + l31], wB = MW[hf * 64 + 32 + l31];
                if (tsel == 0) { wA0 = wA; wB0 = wB; } else { wA1 = wA; wB1 = wB; }
            }
        }
        unsigned* m0 = MASK + (size_t)(t0 + 2 * hf) * 64;
        m0[l31] = wA0; m0[32 + l31] = wB0; m0[64 + l31] = wA1; m0[96 + l31] = wB1;
        }
    }
    __syncthreads();
}

constexpr int AT_STAGE = 32768;
__device__ __forceinline__ void phase_dsa_att(const Ctx& c, int l) {
    const bf16* QLAT = (const bf16*)(c.ws + WS_QLAT); const bf16* CKVN = (const bf16*)(c.ws + WS_CKVN); const bf16* CKVT = (const bf16*)(c.ws + WS_CKVT);
    const unsigned* MASK = (const unsigned*)(c.ws + WS_MASK); bf16* OLAT = (bf16*)(c.ws + WS_OLAT);
    const int tid = c.tid, lane = c.lane, h = c.wave, fr = lane & 15, fq = lane >> 4;
    const float slope2 = exp2f(-(float)(h + 1)) * 1.4426950408889634f;
    const int dn_r = tid >> 4, dn_c = ((tid & 15) ^ ((tid >> 4) & 15)) * 8;
    const int dt_r = tid >> 3, dt_c = ((tid & 7) ^ ((tid >> 3) & 7)) * 8;
    const unsigned ldsw = (unsigned)h * 1024u;
#pragma unroll 1
    for (int k4 = 0; k4 < 1024; ++k4) {
        const int idx = c.bid + c.nblk * k4; if (idx >= 1024) break;
        const int b = idx & 15, g = idx >> 4, gk = g >> 4, gi = g & 15;
        const int qt = 63 - 16 * gk - ((gk & 1) ? (15 - gi) : gi);
        const int tq0 = qt * 32;
        const size_t tg0 = (size_t)b * SEQ + tq0;
        const int nkt = (tq0 + 31) / 64 + 1;
        bf16x8 Qf[2][4];
#pragma unroll
        for (int rt = 0; rt < 2; ++rt)
#pragma unroll
            for (int ks = 0; ks < 4; ++ks) Qf[rt][ks] = *(const bf16x8*)(QLAT + (tg0 + 16 * rt + fr) * 1024 + h * 128 + 32 * ks + 8 * fq);
        f32x4 O[2][8];
        float mrun[2], lrun[2];
#pragma unroll
        for (int rt = 0; rt < 2; ++rt) { mrun[rt] = -1e30f; lrun[rt] = 0.f;
#pragma unroll
            for (int n = 0; n < 8; ++n) O[rt][n] = (f32x4){0.f, 0.f, 0.f, 0.f}; }
#define AT_DMA(kt_, stg_) do { const bf16* _kn = CKVN + ((size_t)b * SEQ + 64 * (kt_) + dn_r) * 128 + dn_c; const bf16* _kt = CKVT + (((size_t)b * 32 + (kt_)) * 128 + dt_r) * 64 + dt_c; \
            LAS unsigned char* _d = c.lds + (stg_) * AT_STAGE + ldsw; \
            __builtin_amdgcn_global_load_lds((const unsigned*)_kn, (LAS unsigned*)_d, 16, 0, 0); __builtin_amdgcn_global_load_lds((const unsigned*)(_kn + 32 * 128), (LAS unsigned*)(_d + 8192), 16, 0, 0); \
            __builtin_amdgcn_global_load_lds((const unsigned*)_kt, (LAS unsigned*)(_d + 16384), 16, 0, 0); __builtin_amdgcn_global_load_lds((const unsigned*)(_kt + 64 * 64), (LAS unsigned*)(_d + 16384 + 8192), 16, 0, 0); } while (0)
        __syncthreads();
        AT_DMA(0, 0);
#pragma unroll 1
        for (int kt = 0; kt < nkt; ++kt) {
            u32x2 mw[2];
#pragma unroll
            for (int rt = 0; rt < 2; ++rt) mw[rt] = *(const u32x2*)(MASK + (tg0 + 16 * rt + fr) * 64 + 2 * kt);
            asm volatile("s_waitcnt vmcnt(2)" ::: "memory");
            __builtin_amdgcn_s_barrier(); asm volatile("" ::: "memory");
            if (kt + 1 < nkt) AT_DMA(kt + 1, (kt + 1) & 1);
            int lz; asm volatile("v_mov_b32 %0, 0" : "=v"(lz));
            const LAS unsigned char* Kn = c.lds + (kt & 1) * AT_STAGE + lz; const LAS unsigned char* KT = Kn + 16384;
            const float kb0 = slope2 * (float)(64 * kt + 4 * fq);
            f32x4 S[2][4];
            {
                bf16x8 kfa[4], kfb[4];
#pragma unroll
                for (int ks = 0; ks < 4; ++ks) kfa[ks] = *(const LAS bf16x8*)(Kn + fr * 256 + (((4 * ks + fq) ^ fr) << 4));
#pragma unroll
                for (int j = 0; j < 4; ++j) {
                    if (j + 1 < 4) {
#pragma unroll
                        for (int ks = 0; ks < 4; ++ks) { const bf16x8 t = *(const LAS bf16x8*)(Kn + (16 * (j + 1) + fr) * 256 + (((4 * ks + fq) ^ fr) << 4)); if (j & 1) kfa[ks] = t; else kfb[ks] = t; } }
#pragma unroll
                    for (int rt = 0; rt < 2; ++rt) { f32x4 d = (f32x4){0.f, 0.f, 0.f, 0.f};
#pragma unroll
                        for (int ks = 0; ks < 4; ++ks) d = __builtin_amdgcn_mfma_f32_16x16x32_bf16((j & 1) ? kfb[ks] : kfa[ks], Qf[rt][ks], d, 0, 0, 0);
                        S[rt][j] = d; }
                    __builtin_amdgcn_sched_barrier(0);
                }
            }
            bf16x8 Pf[2][2];
#pragma unroll
            for (int rt = 0; rt < 2; ++rt) {
                float mx = -1e30f;
#pragma unroll
                for (int j = 0; j < 4; ++j) { const unsigned wsel = ((j < 2) ? mw[rt].x : mw[rt].y) >> (4 * fq);
#pragma unroll
                    for (int r = 0; r < 4; ++r) { const bool on = wsel & (1u << (16 * (j & 1) + r));
                        const float v = S[rt][j][r] + fmaf(slope2, (float)(16 * j + r), kb0);
                        S[rt][j][r] = on ? v : -INFINITY; mx = fmaxf(mx, S[rt][j][r]); } }
                mx = fmaxf(mx, __shfl_xor(mx, 16)); mx = fmaxf(mx, __shfl_xor(mx, 32));
                const float mnew = fmaxf(mrun[rt], mx);
                const float alpha = __builtin_amdgcn_exp2f(mrun[rt] - mnew);
                float rs = 0.f;
#pragma unroll
                for (int j = 0; j < 4; ++j)
#pragma unroll
                    for (int r = 0; r < 4; ++r) { const float p = __builtin_amdgcn_exp2f(S[rt][j][r] - mnew); S[rt][j][r] = p; rs += p; }
                rs += __shfl_xor(rs, 16); rs += __shfl_xor(rs, 32);
                lrun[rt] = lrun[rt] * alpha + rs; mrun[rt] = mnew;
#pragma unroll
                for (int n = 0; n < 8; ++n) O[rt][n] *= alpha;
#pragma unroll
                for (int ks2 = 0; ks2 < 2; ++ks2) { u32x4 w; w.x = pk2(S[rt][2 * ks2][0], S[rt][2 * ks2][1]); w.y = pk2(S[rt][2 * ks2][2], S[rt][2 * ks2][3]);
                    w.z = pk2(S[rt][2 * ks2 + 1][0], S[rt][2 * ks2 + 1][1]); w.w = pk2(S[rt][2 * ks2 + 1][2], S[rt][2 * ks2 + 1][3]);
                    Pf[rt][ks2] = __builtin_bit_cast(bf16x8, w); }
            }
            {
                const int sw = fr & 7;
#pragma unroll
                for (int n = 0; n < 8; ++n) {
#pragma unroll
                    for (int ks2 = 0; ks2 < 2; ++ks2) {
                        const bf16x8 af = *(const LAS bf16x8*)(KT + (16 * n + fr) * 128 + (((4 * ks2 + fq) ^ sw) << 4));
#pragma unroll
                        for (int rt = 0; rt < 2; ++rt) O[rt][n] = __builtin_amdgcn_mfma_f32_16x16x32_bf16(af, Pf[rt][ks2], O[rt][n], 0, 0, 0);
                    }
                    if (n & 1) __builtin_amdgcn_sched_barrier(0);
                }
            }
        }
#undef AT_DMA
        {
            const bf16x8* WF = (const bf16x8*)((const bf16*)(c.ws + WS_WUVF) + (size_t)(l * 8 + h) * 16 * 64 * 8) + lane;
            bf16x8 wf[4][4];
#pragma unroll
            for (int vt = 0; vt < 4; ++vt)
#pragma unroll
                for (int ks = 0; ks < 4; ++ks) wf[vt][ks] = WF[(vt * 4 + ks) * 64];
#pragma unroll
            for (int rt = 0; rt < 2; ++rt) { const float inv = 1.f / lrun[rt];
                bf16x8 of[4];
#pragma unroll
                for (int ks = 0; ks < 4; ++ks) { const f32x4 x0 = O[rt][2 * ks] * inv, x1 = O[rt][2 * ks + 1] * inv;
                    u32x4 w; w.x = pk2(x0[0], x0[1]); w.y = pk2(x0[2], x0[3]); w.z = pk2(x1[0], x1[1]); w.w = pk2(x1[2], x1[3]); of[ks] = __builtin_bit_cast(bf16x8, w); }
#pragma unroll
                for (int vt = 0; vt < 4; ++vt) { f32x4 d = (f32x4){0.f, 0.f, 0.f, 0.f};
#pragma unroll
                    for (int ks = 0; ks < 4; ++ks) d = __builtin_amdgcn_mfma_f32_16x16x32_bf16(wf[vt][ks], of[ks], d, 0, 0, 0);
                    st_bf4(OLAT + (tg0 + 16 * rt + fr) * 512 + h * 64 + 16 * vt + 4 * fq, d); }
            }
        }
    }
    asm volatile("s_waitcnt vmcnt(0)" ::: "memory");
    __syncthreads();
}

__device__ __forceinline__ void expert_convert(const Ctx& c, int l, int gw, int NGW) {

        LAS float* scr = (LAS float*)(c.lds + c.wave * 16384);
        constexpr int I_GU = (512 / 32) * (1024 / 64), I_D = (1024 / 32) * (256 / 64), PER_E = I_GU + I_D;
        for (int it = gw; it < NEX * PER_E; it += NGW) {
            const int e = it / PER_E; int r = it % PER_E;
            if (r < I_GU) {
                const int n0 = (r / 16) * 32, pn = n0 >> 8, wi = n0 & 255, j0 = 128 * pn + (wi & 127);
                const float* Wg; const float* Wu;
                if (e < NE) { Wg = c.in[IN_EWG] + ((size_t)l * NE + e) * 1024 * 256; Wu = c.in[IN_EWU] + ((size_t)l * NE + e) * 1024 * 256; }
                else { Wg = c.in[IN_SWG] + (size_t)l * 1024 * 256; Wu = c.in[IN_SWU] + (size_t)l * 1024 * 256; }
                if (wi < 128) { SrcPlain s{Wg + j0 - n0, 256}; tr_item(s, (bf16*)(c.ws + WS_WGU) + (size_t)e * 512 * 1024, 1024, n0, (r % 16) * 64, scr, c.lane); }
                else { SrcPlain s{Wu + j0 - n0, 256}; tr_item(s, (bf16*)(c.ws + WS_WGU) + (size_t)e * 512 * 1024, 1024, n0, (r % 16) * 64, scr, c.lane); }
            } else { r -= I_GU;
                SrcPlain s; s.ld = 1024; s.W = e < NE ? c.in[IN_EWD] + ((size_t)l * NE + e) * 256 * 1024 : c.in[IN_SWD] + (size_t)l * 256 * 1024;
                tr_item(s, (bf16*)(c.ws + WS_WD) + (size_t)e * 1024 * 256, 256, (r / 4) * 32, (r % 4) * 64, scr, c.lane);
            }
        }
    }
__device__ __forceinline__ void route_one(int t, float logit, float rbias, int lane, LAS unsigned* lcnt, LAS unsigned* stash, int ridx) {
    const float score = sigmoid_exact(logit), sel = score + rbias;
    const int g = lane >> 3;
    float m1 = sel, m2 = -INFINITY;
#pragma unroll
    for (int d = 1; d < 8; d <<= 1) { const float o1 = __shfl_xor(m1, d), o2 = __shfl_xor(m2, d);
        const float n1 = fmaxf(m1, o1), n2 = fmaxf(fminf(m1, o1), fmaxf(m2, o2)); m1 = n1; m2 = n2; }
    const float gs = m1 + m2;
    int rkg = 0;
#pragma unroll
    for (int og = 0; og < 8; ++og) { const float o = __builtin_bit_cast(float, __builtin_amdgcn_readlane(__builtin_bit_cast(int, gs), og * 8)); rkg += (o > gs || (o == gs && og < g)) ? 1 : 0; }
    const bool gsel = rkg < 4;
    const float msel = gsel ? sel : -INFINITY;
    int rk = 0;
#pragma unroll 8
    for (int j = 0; j < 64; ++j) { const float o = __builtin_bit_cast(float, __builtin_amdgcn_readlane(__builtin_bit_cast(int, msel), j)); rk += (o > msel || (o == msel && j < lane)) ? 1 : 0; }
    const bool chosen = gsel && rk < TOPK;
    const unsigned long long mk = __ballot(chosen);
    float wsum = 0.f;
    { unsigned long long mm = mk;
#pragma unroll 1
      while (mm) { const int j = __ffsll((long long)mm) - 1; mm &= mm - 1; wsum += __builtin_bit_cast(float, __builtin_amdgcn_readlane(__builtin_bit_cast(int, score), j)); } }
    if (chosen) {
        const int hf = t >= HALF_T ? 1 : 0;
        const int kk = __popcll(mk & ((1ull << lane) - 1ull));
        const unsigned rank = __hip_atomic_fetch_add(&lcnt[hf * 64 + lane], 1u, __ATOMIC_RELAXED, __HIP_MEMORY_SCOPE_WORKGROUP);
        LAS unsigned* st = stash + (size_t)(ridx * 6 + (kk < TOPK ? kk : 0)) * 4;
        st[0] = (unsigned)t; st[1] = ((unsigned)hf << 24) | ((unsigned)lane << 16) | rank; st[2] = __builtin_bit_cast(unsigned, score / wsum * 2.5f);
    }
}
__device__ __forceinline__ void phase_route(const Ctx& c, int l, const float* x1) {
    for (int r2 = 0; r2 < CONV_REP; ++r2) expert_convert(c, l, c.bid * NWAVES + c.wave, c.nblk * NWAVES);
    __syncthreads();
    {
        LAS float* H = (LAS float*)c.lds;
        constexpr int HLD = 1028;
        const int lane = c.lane, w = c.wave;
        const float* MOD = (const float*)(c.ws + WS_MOD) + (size_t)l * 16 * 6144;
        bf16* XN2 = (bf16*)(c.ws + WS_XN2);
        const float* RW = c.in[IN_RW] + (size_t)l * 1024 * 64; const float rbias = c.in[IN_RB][l * 64 + lane];
        unsigned* CNT = (unsigned*)(c.ws + WS_CTL) + CW_CNT + l * 128 * CNT_STRIDE;
        int* ROWL = (int*)(c.ws + WS_ROWL); float* WL = (float*)(c.ws + WS_WL); unsigned* TOKPOS = (unsigned*)(c.ws + WS_TOKPOS);
        const float* gain = c.in[IN_NFFN] + l * D;
        LAS unsigned* lcnt = (LAS unsigned*)(c.lds + 131584);
        LAS unsigned* stash = lcnt + 128;
        constexpr int STASH_ROWS = 128;
        int nrow_done = 0;
        if (c.tid < 128) lcnt[c.tid] = 0u;
        for (int it = c.bid; it < T / 32; it += c.nblk) {
            const int t0 = it * 32, b = t0 >> 11;
            const float* sh = MOD + (size_t)b * 6144 + 3072; const float* sc = MOD + (size_t)b * 6144 + 4096;
            __syncthreads();
#pragma unroll
            for (int r = 0; r < 4; ++r) {
                const int rr = 4 * w + r;
                const float* xrow = x1 + (size_t)(t0 + rr) * D;
                f32x4 v[4]; float ssum = 0.f;
#pragma unroll
                for (int j = 0; j < 4; ++j) { v[j] = *(const f32x4*)(xrow + 4 * (lane + 64 * j)); ssum += v[j][0] * v[j][0] + v[j][1] * v[j][1] + v[j][2] * v[j][2] + v[j][3] * v[j][3]; }
                const float rstd = rsqrtf(wave_sum(ssum) * (1.f / D) + EPS);
#pragma unroll
                for (int j = 0; j < 4; ++j) { const int cc = 4 * (lane + 64 * j);
                    const f32x4 g = *(const f32x4*)(gain + cc), a4 = *(const f32x4*)(sc + cc), bb = *(const f32x4*)(sh + cc);
                    const f32x4 hv = v[j] * rstd * g * (a4 + 1.f) + bb;
                    st_bf4(XN2 + (size_t)(t0 + rr) * D + cc, hv); *(LAS f32x4*)(H + rr * HLD + cc) = hv; }
            }
            __syncthreads();
            {
                const int rt = w >> 2, et = w & 3, fr = lane & 15, fq = lane >> 4;
                const LAS float* hp = H + (16 * rt + fr) * HLD + fq;
                const float* bp = RW + (size_t)fq * 64 + 16 * et + fr;
                f32x4 c0 = (f32x4){0.f, 0.f, 0.f, 0.f}, c1 = (f32x4){0.f, 0.f, 0.f, 0.f};
                float bq[8], bn[8];
#pragma unroll
                for (int j = 0; j < 8; ++j) bq[j] = bp[(size_t)(4 * j) * 64];
#pragma unroll 1
                for (int k8 = 0; k8 < 256; k8 += 8) {
                    const int kn = (k8 + 8) & 255;
#pragma unroll
                    for (int j = 0; j < 8; ++j) bn[j] = bp[(size_t)(4 * (kn + j)) * 64];
#pragma unroll
                    for (int j = 0; j < 8; j += 2) {
                        c0 = __builtin_amdgcn_mfma_f32_16x16x4f32(hp[4 * (k8 + j)], bq[j], c0, 0, 0, 0);
                        c1 = __builtin_amdgcn_mfma_f32_16x16x4f32(hp[4 * (k8 + j + 1)], bq[j + 1], c1, 0, 0, 0);
                    }
#pragma unroll
                    for (int j = 0; j < 8; ++j) bq[j] = bn[j];
                }
                const f32x4 cc = c0 + c1;
                __syncthreads();
                LAS float* LG = H;
#pragma unroll
                for (int r = 0; r < 4; ++r) LG[(16 * rt + 4 * fq + r) * 64 + 16 * et + fr] = cc[r];
            }
            __syncthreads();
#pragma unroll 1
            for (int r = 0; r < 4; ++r) {
                const int rr = 4 * w + r; const float lg = H[rr * 64 + lane];
                route_one(t0 + rr, lg, rbias, lane, lcnt, stash, nrow_done + rr);
            }
            nrow_done += 32;
            const bool last = it + c.nblk >= T / 32;
            if (nrow_done + 32 > STASH_ROWS || last) {
                __syncthreads();
                if (c.tid < 128) { const unsigned n = lcnt[c.tid]; lcnt[c.tid] = n ? atomicAdd(&CNT[c.tid * CNT_STRIDE], n) : 0u; }
                __syncthreads();
                for (int i = c.tid; i < nrow_done * 6; i += NTHR) { const LAS unsigned* st = stash + (size_t)i * 4;
                    const unsigned tt = st[0], m = st[1]; const int hf = m >> 24, e = (m >> 16) & 0xff; const unsigned slot = lcnt[hf * 64 + e] + (m & 0xffffu);
                    ROWL[((size_t)hf * 64 + e) * 16384 + slot] = (int)tt; WL[((size_t)hf * 64 + e) * 16384 + slot] = __builtin_bit_cast(float, st[2]);
                    TOKPOS[(size_t)tt * 6 + (i % 6)] = ((unsigned)e << 16) | slot; }
                __syncthreads();
                if (c.tid < 128) lcnt[c.tid] = 0u;
                nrow_done = 0;
            }
        }
        __syncthreads();
    }
}

__device__ __forceinline__ void moe_tables(const Ctx& c, int l, int hf) {
    LAS int* cnt = (LAS int*)(c.lds + 140000); LAS int* off = cnt + 65; LAS int* tst = off + 65;
    __syncthreads();
    if (c.tid == 0) {
        const unsigned* CNT = (const unsigned*)(c.ws + WS_CTL) + CW_CNT + (l * 128 + hf * 64) * CNT_STRIDE;
        int o = 0, ts = 0;
        for (int e = 0; e < NEX; ++e) { const int n = e < NE ? (int)CNT[e * CNT_STRIDE] : HALF_T; cnt[e] = n; off[e] = o; tst[e] = ts; o += (n + 255) & ~255; ts += (n + 255) >> 8; }
        tst[NEX] = ts;
    }
    __syncthreads();
}
struct MoeSched1 { LAS const int* cnt; LAS const int* off; LAS const int* tst; int G, c; const char* XN2; const char* WGU; const int* ROWL; const float* WL; const int* IDENT;
    __device__ __forceinline__ bool next(int i, g8::GUnit& u) const {
        const int L = i * G + c; if (L >= 2 * tst[NEX]) return false;
        const int rt = L >> 1, pn = L & 1; int e = 0; while (tst[e + 1] <= rt) ++e;
        const int r0 = (rt - tst[e]) * 256;
        u.A = XN2; u.B = WGU + ((size_t)e * 512 + (size_t)pn * 256) * 2048;
        u.rl = e < NE ? ROWL + (size_t)e * 16384 + r0 : IDENT + r0; u.nvalid = cnt[e] - r0; u.erow0 = 0; u.ecol0 = pn * 256; u.x0 = off[e] + r0; u.xp = e < NE ? WL + (size_t)e * 16384 + r0 : nullptr; return true; } };
struct MoeSched2 { LAS const int* cnt; LAS const int* off; LAS const int* tst; int G, c; const char* HID; const char* WD;
    __device__ __forceinline__ bool next(int i, g8::GUnit& u) const {
        const int L = i * G + c; if (L >= 4 * tst[NEX]) return false;
        const int rt = L >> 2, pn = L & 3; int e = 0; while (tst[e + 1] <= rt) ++e;
        const int r0 = (rt - tst[e]) * 256;
        u.A = HID + (size_t)(off[e] + r0) * 512; u.B = WD + ((size_t)e * 1024 + (size_t)pn * 256) * 512;
        u.rl = nullptr; u.nvalid = 0; u.erow0 = 0; u.ecol0 = pn * 256; u.x0 = off[e] + r0; u.xp = nullptr; return true; } };
struct EpiG1u { bf16* HID; struct Pre { float w; }; static constexpr int BATCH_M = 4; static constexpr bool PERM = true;
    __device__ __forceinline__ void post8(const g8::GUnit& u, int row, int col, f32x4 a0, f32x4 a1, f32x4 b0, f32x4 b1, const Pre& p, int) const {
        const int hc = col - 128 * (col >> 8);
        f32x4 v0 = (f32x4){0.f, 0.f, 0.f, 0.f}, v1 = v0;
        if (row < u.nvalid) {
#pragma unroll
            for (int i = 0; i < 4; ++i) { v0[i] = siluf_(a0[i]) * b0[i] * p.w; v1[i] = siluf_(a1[i]) * b1[i] * p.w; } }
        st_bf8(HID + (size_t)(u.x0 + row) * 256 + hc, v0, v1);
    }
    __device__ __forceinline__ Pre pre(const g8::GUnit& u, int row, int, int) const { return Pre{(u.xp && row < u.nvalid) ? u.xp[row] : 1.f}; }
    __device__ __forceinline__ void post(const g8::GUnit& u, int row, int col, f32x4 lo, f32x4 hi, const Pre& p, int) const {
        const int hc = col - 128 * (col >> 8);
        f32x4 v = (f32x4){0.f, 0.f, 0.f, 0.f};
        if (row < u.nvalid) { const float w = p.w;
#pragma unroll
            for (int i = 0; i < 4; ++i) v[i] = siluf_(lo[i]) * hi[i] * w; }
        st_bf4(HID + (size_t)(u.x0 + row) * 256 + hc, v);
    } };
struct EpiG2u { bf16* Y; typedef NoPre Pre; static constexpr int BATCH_M = 4; static constexpr bool PERM = true;
    __device__ __forceinline__ Pre pre(const g8::GUnit&, int, int, int) const { return Pre{}; }
    __device__ __forceinline__ void post(const g8::GUnit&, int, int, f32x4, f32x4, const Pre&, int) const {}
    __device__ __forceinline__ void post8(const g8::GUnit& u, int row, int col, f32x4 a0, f32x4 a1, f32x4 b0, f32x4 b1, const Pre&, int) const {
        bf16* y = Y + (size_t)(u.x0 + row) * 1024 + col;
        u32x4 w; w.x = pk2(a0[0], a0[1]); w.y = pk2(a0[2], a0[3]); w.z = pk2(a1[0], a1[1]); w.w = pk2(a1[2], a1[3]); *(u32x4*)y = w;
        u32x4 v; v.x = pk2(b0[0], b0[1]); v.y = pk2(b0[2], b0[3]); v.z = pk2(b1[0], b1[1]); v.w = pk2(b1[2], b1[3]); *(u32x4*)(y + 128) = v;
    } };
__device__ __forceinline__ void phase_gemm1(const Ctx& c, int l, int hf) {
    moe_tables(c, l, hf);
    LAS int* cnt = (LAS int*)(c.lds + 140000); LAS int* off = cnt + 65; LAS int* tst = off + 65;
    MoeSched1 S{cnt, off, tst, c.nblk, c.bid, (const char*)(c.ws + WS_XN2), (const char*)(c.ws + WS_WGU), (const int*)(c.ws + WS_ROWL) + (size_t)hf * 64 * 16384, (const float*)(c.ws + WS_WL) + (size_t)hf * 64 * 16384,
                (const int*)(c.ws + WS_IDENT) + (size_t)hf * HALF_T};
    EpiG1u E{(bf16*)(c.ws + WS_HID)};
    g8::gemm_phase<true>(c.lds, 2048u, 1024, S, E);
    __syncthreads();
}
__device__ __forceinline__ void phase_gemm2(const Ctx& c, int l, int hf) {
    moe_tables(c, l, hf);
    LAS int* cnt = (LAS int*)(c.lds + 140000); LAS int* off = cnt + 65; LAS int* tst = off + 65;
    MoeSched2 S{cnt, off, tst, c.nblk, c.bid, (const char*)(c.ws + WS_HID), (const char*)(c.ws + WS_WD)};
    EpiG2u E{(bf16*)(c.ws + WS_Y)};
    g8::gemm_phase<false>(c.lds, 512u, 256, S, E);
    __syncthreads();
}
__device__ __forceinline__ void phase_combine(const Ctx& c, int l, int hf, float* xio) {
    moe_tables(c, l, hf);
    LAS int* off = (LAS int*)(c.lds + 140000) + 65;
    const int gw = c.bid * NWAVES + c.wave, NGW = c.nblk * NWAVES, lane = c.lane;
    const bf16* Y = (const bf16*)(c.ws + WS_Y); const unsigned* TOKPOS = (const unsigned*)(c.ws + WS_TOKPOS);
    const float* MODl = (const float*)(c.ws + WS_MOD) + (size_t)l * 16 * 6144;
    const float* MODn = (const float*)(c.ws + WS_MOD) + (size_t)1 * 16 * 6144;
    bf16* XN = (bf16*)(c.ws + WS_XN);
    unsigned tpn[TOPK];
    if (gw < HALF_T) {
#pragma unroll
        for (int kk = 0; kk < TOPK; ++kk) tpn[kk] = TOKPOS[(size_t)(hf * HALF_T + gw) * 6 + kk]; }
#pragma unroll 1
    for (int tt = gw; tt < HALF_T; tt += NGW) {
        const int t = hf * HALF_T + tt, b = t >> 11;
        unsigned tp[TOPK];
#pragma unroll
        for (int kk = 0; kk < TOPK; ++kk) tp[kk] = tpn[kk];
        f32x4 acc[4];
        u32x2 yv[TOPK + 1][4];
        { const bf16* yr = Y + (size_t)(off[NE] + tt) * 1024;
#pragma unroll
          for (int j = 0; j < 4; ++j) yv[TOPK][j] = *(const u32x2*)(yr + 4 * (lane + 64 * j)); }
#pragma unroll
        for (int kk = 0; kk < TOPK; ++kk) {
            const int e = tp[kk] >> 16, slot = tp[kk] & 0xffff;
            const bf16* yr = Y + (size_t)(off[e] + slot) * 1024;
#pragma unroll
            for (int j = 0; j < 4; ++j) yv[kk][j] = *(const u32x2*)(yr + 4 * (lane + 64 * j));
        }
        if (tt + NGW < HALF_T) {
#pragma unroll
            for (int kk = 0; kk < TOPK; ++kk) tpn[kk] = TOKPOS[(size_t)(t + NGW) * 6 + kk]; }
#pragma unroll
        for (int j = 0; j < 4; ++j) { acc[j] = (f32x4){bflo(yv[TOPK][j].x), bfhi(yv[TOPK][j].x), bflo(yv[TOPK][j].y), bfhi(yv[TOPK][j].y)};
#pragma unroll
            for (int kk = 0; kk < TOPK; ++kk) acc[j] += (f32x4){bflo(yv[kk][j].x), bfhi(yv[kk][j].x), bflo(yv[kk][j].y), bfhi(yv[kk][j].y)}; }
        float* xr = xio + (size_t)t * D; const float* g2 = MODl + (size_t)b * 6144 + 5120;
        f32x4 v[4]; float s = 0.f;
#pragma unroll
        for (int j = 0; j < 4; ++j) { const int cc = 4 * (lane + 64 * j); v[j] = *(const f32x4*)(xr + cc) + *(const f32x4*)(g2 + cc) * acc[j]; s += v[j][0] * v[j][0] + v[j][1] * v[j][1] + v[j][2] * v[j][2] + v[j][3] * v[j][3]; }
        const float rstd = rsqrtf(wave_sum(s) * (1.f / D) + EPS);
        if (l == 0) {
#pragma unroll
            for (int j = 0; j < 4; ++j) { const int cc = 4 * (lane + 64 * j); *(f32x4*)(xr + cc) = v[j];
                const f32x4 g = *(const f32x4*)(c.in[IN_NMIX] + D + cc), a = *(const f32x4*)(MODn + (size_t)b * 6144 + 1024 + cc), bb = *(const f32x4*)(MODn + (size_t)b * 6144 + cc);
                st_bf4(XN + (size_t)t * D + cc, v[j] * rstd * g * (a + 1.f) + bb); }
        } else {
#pragma unroll
            for (int j = 0; j < 4; ++j) { const int cc = 4 * (lane + 64 * j); *(f32x4*)(xr + cc) = v[j] * rstd * *(const f32x4*)(c.in[IN_NFIN] + cc); }
        }
    }
}

#ifdef DSA_NO_SEL
#define DSA_SEL_CALL
#else
#define DSA_SEL_CALL phase_ckvt(c); for (int r2 = 0; r2 < REPN(20); ++r2) phase_dsa_sel(c, l);
#endif
#ifdef DSA_NO_ATT
#define DSA_ATT_CALL
#else
#define DSA_ATT_CALL for (int r2 = 0; r2 < REPN(21); ++r2) phase_dsa_att(c, l);
#endif
constexpr int PH_PER_L = 18, N_PHASES = 1 + NL * PH_PER_L;
#ifndef PH_MASK
#define PH_MASK 0xFFFFFFFFu
#endif
#define IN(k) (lo <= (k) && (k) < hi)
#define EN(b) ((PH_MASK >> (b)) & 1u)
#ifndef REP_MASK
#define REP_MASK 0u
#endif
#define REPN(b) (((REP_MASK >> (b)) & 1u) ? 2 : 1)
#define SEAM(k) do { if (MK_ONE_LAUNCH && IN(k) && IN((k) + 1)) xcd_barrier(bar); } while (0)
template <int l>
__device__ __forceinline__ void layer_program(const Ctx& c, const XcdBarrier& bar, int lo, int hi) {
        const int P = 1 + l * PH_PER_L;
        const float* xin = l == 0 ? c.in[IN_X] : c.out;
        bf16* PB = (bf16*)(c.ws + WS_PB); float* SM = (float*)(c.ws + WS_SM);
        const bf16* XN = (const bf16*)(c.ws + WS_XN);
        const bf16* WIN = (const bf16*)(c.ws + WS_WIN) + (size_t)l * NINP * 1024;
        if (EN(1) && IN(P + 0)) { for (int rep = 0; rep < REPN(1); ++rep) {  if (l == 0) phase_norm1(c, 0, c.in[IN_X]);  if (rep + 1 < REPN(1)) xcd_barrier(bar); } } if (l == 0) SEAM(P + 0);
        if (EN(2) && IN(P + 1)) { for (int rep = 0; rep < REPN(2); ++rep) {  EpiInPB E{PB, SM}; dgemm_phase(c, XN, 1024, T, WIN, NPB / 256, 1024, EpiU<decltype(E)>{E});  if (rep + 1 < REPN(2)) xcd_barrier(bar); } } SEAM(P + 1);
        if (EN(3) && IN(P + 2)) { for (int rep = 0; rep < REPN(3); ++rep) {  phase_prep(c, l);  if (rep + 1 < REPN(3)) xcd_barrier(bar); } } SEAM(P + 2);
        if (EN(4) && IN(P + 3)) { for (int rep = 0; rep < REPN(4); ++rep) {
#if SCAN_3PASS
            for (int r2 = 0; r2 < REPN(22); ++r2) phase_scanA(c, l);
            xcd_barrier(bar); scanB(c);
            { EpiQ Eq{(bf16*)(c.ws + WS_QLAT), (bf16*)(c.ws + WS_QIDX), (const float*)(c.ws + WS_RSTDQ)};
              dgemm_phase(c, PB + PB_CQ, NPB, T, (const bf16*)(c.ws + WS_WQ) + (size_t)l * 1280 * 256, 5, 256, EpiU<decltype(Eq)>{Eq}); }
            xcd_barrier(bar); phase_scanC(c, l);
#else
            phase_scans(c, l);
#endif
            if (rep + 1 < REPN(4)) xcd_barrier(bar); } } SEAM(P + 3);
        if (EN(6) && IN(P + 5)) { for (int rep = 0; rep < REPN(6); ++rep) {  EpiGate E{(bf16*)(c.ws + WS_G)}; dgemm_phase(c, XN, 1024, T, WIN + (size_t)NPB * 1024, NG / 256, 1024, EpiU<decltype(E)>{E});  if (rep + 1 < REPN(6)) xcd_barrier(bar); } }
        if (EN(7) && IN(P + 6)) { for (int rep = 0; rep < REPN(7); ++rep) {  DSA_SEL_CALL xcd_barrier(bar); DSA_ATT_CALL  if (rep + 1 < REPN(7)) xcd_barrier(bar); } } SEAM(P + 6);
        if (EN(8) && IN(P + 7)) {
            { EpiUp E{(bf16*)(c.ws + WS_M1), (bf16*)(c.ws + WS_MF), (const bf16*)(c.ws + WS_G), 0, 1, 0};
              dgemm_phase(c, (const bf16*)(c.ws + WS_UA), 512, T, (const bf16*)(c.ws + WS_WUPA) + (size_t)l * 1024 * 512, 4, 512, EpiU<decltype(E)>{E}); }
            { EpiUp E{(bf16*)(c.ws + WS_M1), (bf16*)(c.ws + WS_MF), (const bf16*)(c.ws + WS_G), 1, 0, 0};
              dgemm_phase(c, (const bf16*)(c.ws + WS_OLAT), 512, T, (const bf16*)(c.ws + WS_WUPB) + (size_t)l * 1024 * 512, 4, 512, EpiU<decltype(E)>{E}); }
            { EpiUp E{(bf16*)(c.ws + WS_M1), (bf16*)(c.ws + WS_MF), (const bf16*)(c.ws + WS_G), 2, 0, 1};
              dgemm_phase(c, (const bf16*)(c.ws + WS_UC), 512, T, (const bf16*)(c.ws + WS_WUPC) + (size_t)l * 1024 * 512, 4, 512, EpiU<decltype(E)>{E}); }
        } SEAM(P + 9);
        if (EN(11) && IN(P + 10)) { for (int rep = 0; rep < REPN(11); ++rep) {  EpiWo E{xin, c.out, (const float*)(c.ws + WS_MOD) + (size_t)l * 16 * 6144 + 2048};
            dgemm_phase(c, (const bf16*)(c.ws + WS_M1), 1024, T, (const bf16*)(c.ws + WS_WO) + (size_t)l * 1024 * 1024, 4, 1024, EpiU<decltype(E)>{E});  if (rep + 1 < REPN(11)) xcd_barrier(bar); } } SEAM(P + 10);
        if (EN(12) && IN(P + 11)) { for (int rep = 0; rep < REPN(12); ++rep) {  phase_route(c, l, c.out);  if (rep + 1 < REPN(12)) xcd_barrier(bar); } } SEAM(P + 11);
        if (EN(13) && IN(P + 12)) { for (int rep = 0; rep < REPN(13); ++rep) {  phase_gemm1(c, l, 0);  if (rep + 1 < REPN(13)) xcd_barrier(bar); } } SEAM(P + 12);
        if (EN(14) && IN(P + 13)) { for (int rep = 0; rep < REPN(14); ++rep) {  phase_gemm2(c, l, 0);  if (rep + 1 < REPN(14)) xcd_barrier(bar); } } SEAM(P + 13);
        if (EN(15) && IN(P + 14)) { phase_combine(c, l, 0, c.out); phase_gemm1(c, l, 1); } SEAM(P + 14);
        if (EN(17) && IN(P + 16)) { for (int rep = 0; rep < REPN(17); ++rep) {  phase_gemm2(c, l, 1);  if (rep + 1 < REPN(17)) xcd_barrier(bar); } } SEAM(P + 16);
        if (EN(18) && IN(P + 17)) { for (int rep = 0; rep < REPN(18); ++rep) {  phase_combine(c, l, 1, c.out);  if (rep + 1 < REPN(18)) xcd_barrier(bar); } } SEAM(P + 17);
    }
__global__ void __launch_bounds__(NTHR, 2) fwd(Args args) {
    extern __shared__ __attribute__((aligned(16))) unsigned char lds_raw[];
    Ctx c;
    c.lds = (LAS unsigned char*)lds_raw;
    c.tid = threadIdx.x; c.lane = c.tid & 63; c.wave = __builtin_amdgcn_readfirstlane(c.tid >> 6);
    c.bid = blockIdx.x; c.nblk = gridDim.x;
    c.in = args.in; c.out = args.out; c.ws = args.ws;
    for (int u = c.tid; u < (LDS_BYTES - LDS_MISC) / 4; u += NTHR) ((LAS unsigned*)(c.lds + LDS_MISC))[u] = 0u;
    __syncthreads();
    XcdBarrier bar; bar.bar = (unsigned*)(c.ws + WS_CTL) + CW_BAR; bar.x = 0; bar.st = (volatile LAS unsigned*)(c.lds + LDS_MISC);
    if (MK_ONE_LAUNCH) bar = xcd_barrier_post((unsigned*)(c.ws + WS_CTL) + CW_BAR, (volatile LAS unsigned*)(c.lds + LDS_MISC));
    const int lo = args.ph_lo, hi = args.ph_hi;
#if PROBE_SEAM >= 0
    const unsigned long long t_start = wall_clock64();
#endif
    if (EN(0) && IN(0)) { for (int rep = 0; rep < REPN(0); ++rep) { phase_prologue(c); if (rep + 1 < REPN(0)) xcd_barrier(bar); } } SEAM(0);
    layer_program<0>(c, bar, lo, hi);
    layer_program<1>(c, bar, lo, hi);
#if PROBE_SEAM >= 0
    if (blockIdx.x == 0 && threadIdx.x == 0) {
        const unsigned long long* st = (const unsigned long long*)(bar.bar + 8192);
        const unsigned long long t = (PROBE_SEAM >= 1000 ? wall_clock64() : st[PROBE_SEAM]) - t_start, t0 = wall_clock64();
        while (wall_clock64() - t0 < 7ull * t) __builtin_amdgcn_s_sleep(8);
    }
#endif
#undef IN
#undef SEAM
}

extern "C" void kernel_launch(void* const* d_in, const int* in_sizes, int n_in, void* d_out, int out_size, void* d_ws, size_t ws_size, hipStream_t stream) {
    static int grid = 0;
    if (grid == 0) {
        if (n_in != 33 || out_size != T * D || ws_size < WS_END) { fprintf(stderr, "kernel_launch: unexpected problem (n_in %d out %d ws %zu)\n", n_in, out_size, ws_size); grid = -1; return; }
        int dev = 0, cus = 0, per_cu = 0;
        if (hipGetDevice(&dev) != hipSuccess || hipDeviceGetAttribute(&cus, hipDeviceAttributeMultiprocessorCount, dev) != hipSuccess) { grid = -1; return; }
        if (hipFuncSetAttribute((const void*)fwd, hipFuncAttributeMaxDynamicSharedMemorySize, LDS_BYTES) != hipSuccess) { fprintf(stderr, "kernel_launch: hipFuncSetAttribute failed\n"); grid = -1; return; }
        if (hipOccupancyMaxActiveBlocksPerMultiprocessor(&per_cu, (const void*)fwd, NTHR, LDS_BYTES) != hipSuccess || per_cu < 1) { fprintf(stderr, "kernel_launch: occupancy query says %d\n", per_cu); }
        (void)hipGetLastError();
        grid = cus;
    }
    if (grid < 0) return;
    (void)hipMemsetAsync((char*)d_ws + WS_CTL, 0, CTL_BYTES, stream);
    Args a{};
    for (int i = 0; i < 33; ++i) a.in[i] = (const float*)d_in[i];
    a.out = (float*)d_out; a.ws = (unsigned char*)d_ws;
#if MK_ONE_LAUNCH
    a.ph_lo = 0; a.ph_hi = N_PHASES;
    hipLaunchKernelGGL(fwd, dim3(grid), dim3(NTHR), LDS_BYTES, stream, a);
#else
    for (int p = 0; p < N_PHASES; ++p) {
        if (p == 1 + PH_PER_L) continue;
        a.ph_lo = p; a.ph_hi = p + 1;
        hipLaunchKernelGGL(fwd, dim3(grid), dim3(NTHR), LDS_BYTES, stream, a);
    }
#endif
}
```

```cpp
#include <hip/hip_runtime.h>
#include <cstdio>
#include <cstdint>

#define LAS __attribute__((address_space(3)))
#define GAS __attribute__((address_space(1)))
typedef unsigned short bf16;
typedef short bf16x8 __attribute__((ext_vector_type(8)));
typedef float f32x4 __attribute__((ext_vector_type(4)));
typedef float f32x2 __attribute__((ext_vector_type(2)));
typedef unsigned u32x4 __attribute__((ext_vector_type(4)));
typedef unsigned u32x2 __attribute__((ext_vector_type(2)));
typedef GAS unsigned gu32;

#ifndef PROBE_SEAM
#define PROBE_SEAM -1
#endif
#ifndef SCAN_3PASS
#define SCAN_3PASS 1
#endif
#ifndef SCAN_RECURRENT
#define SCAN_RECURRENT 0
#endif
#ifndef CONV_REP
#define CONV_REP 1
#endif
#ifndef MK_ONE_LAUNCH
#define MK_ONE_LAUNCH 1
#endif

constexpr int NB = 16, SEQ = 2048, D = 1024, T = NB * SEQ, NL = 2;
constexpr int NIN = 6592, NPB = 3584, NG = 3072, NINP = NPB + NG;
constexpr int NE = 64, NEX = 65, EFF = 256, TOPK = 6;
constexpr int HALF_T = T / 2;
constexpr int DSA_K = 256;
constexpr float EPS = 1e-6f;
constexpr int NTHR = 512, NWAVES = 8;

constexpr int PB_QA = 0, PB_KA = 256, PB_VA = 512, PB_GA = 1024, PB_CQ = 1536, PB_CKV = 1792, PB_QC = 2048, PB_KC = 2304, PB_VC = 2560, PB_OC = 3072;
constexpr int SM_KIDX = 0, SM_ALR = 32, SM_WIDX = 48, SM_IC = 56, SM_FC = 60;

constexpr size_t MiB = 1u << 20;
constexpr size_t WS_CTL = 0, CTL_BYTES = 1 * MiB;
constexpr size_t WS_MOD = 1 * MiB;
constexpr size_t WS_RSTDQ = 2 * MiB;
constexpr size_t WS_TOKPOS = 3 * MiB;
constexpr size_t WS_IDENT = 3 * MiB + 800 * 1024;
constexpr size_t WS_WIN = 4 * MiB;
constexpr size_t WS_WQ = 30 * MiB;
constexpr size_t WS_WUPA = 32 * MiB;
constexpr size_t WS_WUPC = 34 * MiB;
constexpr size_t WS_WUPB = 36 * MiB;
constexpr size_t WS_WUVF = 38 * MiB;
constexpr size_t WS_WO = 40 * MiB;
constexpr size_t WS_WGU = 44 * MiB;
constexpr size_t WS_WD = 109 * MiB;
constexpr size_t WS_XN = 142 * MiB;
constexpr size_t WS_OLAT = WS_XN;
constexpr size_t WS_UA = 206 * MiB;
constexpr size_t WS_UC = 238 * MiB;
constexpr size_t WS_XN2 = 206 * MiB;
constexpr size_t WS_QLAT = 270 * MiB;
constexpr size_t WS_M1 = WS_QLAT;
constexpr size_t WS_QIDX = 334 * MiB;
constexpr size_t WS_CKVN = 350 * MiB;
constexpr size_t WS_KIDX = 358 * MiB;
constexpr size_t WS_SM = 360 * MiB;
constexpr size_t WS_PB = 376 * MiB;
constexpr size_t WS_G = WS_PB;
constexpr size_t WS_HID = 270 * MiB;
constexpr size_t WS_Y = 334 * MiB;
constexpr size_t WS_ROWL = 590 * MiB;
constexpr size_t WS_WL = 598 * MiB;
constexpr size_t WS_CKVT = 576 * MiB;
constexpr size_t WS_MASK = 584 * MiB;
static_assert(WS_CKVT >= WS_G + (size_t)T * NG * 2 && WS_MASK + (size_t)T * 64 * 4 <= WS_PB + (size_t)T * NPB * 2, "CKVT/MASK placement");
constexpr size_t WS_QS = 44 * MiB;
constexpr size_t WS_DSG = 76 * MiB;
constexpr size_t WS_DSM = 600 * MiB;
constexpr size_t WS_ET = 108 * MiB;
constexpr size_t WS_CT = 108 * MiB + 512 * 1024;
constexpr size_t WS_MP = 108 * MiB + 768 * 1024;
constexpr size_t WS_GPM = 109 * MiB;
constexpr size_t WS_GBC = 110 * MiB;
constexpr size_t WS_DN = 111 * MiB;
constexpr size_t WS_KEYB = 44 * MiB;
constexpr size_t WS_MF = 568 * MiB;
constexpr size_t WS_END = 636 * MiB;
static_assert(WS_PB + (size_t)T * NPB * 2 <= 600 * MiB, "PB");
static_assert(WS_Y + (size_t)131072 * 1024 * 2 <= WS_ROWL, "Y");

constexpr int CW_BAR = 4096;
constexpr int CW_CNT = 16384;
constexpr int CNT_STRIDE = 64;

constexpr int LDS_BYTES = 147456;
constexpr int LDS_MISC = 145408;

__device__ __forceinline__ unsigned f2bf(float f) { unsigned u = __builtin_bit_cast(unsigned, f); return (u + 0x7fffu + ((u >> 16) & 1u)) >> 16; }
__device__ __forceinline__ float bf2f(unsigned b) { return __builtin_bit_cast(float, b << 16); }
typedef __bf16 bf16x2_t __attribute__((ext_vector_type(2)));
__device__ __forceinline__ unsigned pk2(float lo, float hi) { const f32x2 v = {lo, hi}; const bf16x2_t b = __builtin_convertvector(v, bf16x2_t); return __builtin_bit_cast(unsigned, b); }
__device__ __forceinline__ float bflo(unsigned w) { return __builtin_bit_cast(float, w << 16); }
__device__ __forceinline__ float bfhi(unsigned w) { return __builtin_bit_cast(float, w & 0xffff0000u); }
__device__ __forceinline__ float wave_sum(float v) {
#pragma unroll
    for (int o = 1; o < 64; o <<= 1) v += __shfl_xor(v, o);
    return v;
}
__device__ __forceinline__ float wave_max(float v) {
#pragma unroll
    for (int o = 1; o < 64; o <<= 1) v = fmaxf(v, __shfl_xor(v, o));
    return v;
}
__device__ __forceinline__ int wave_sum_i(int v) {
#pragma unroll
    for (int o = 1; o < 64; o <<= 1) v += __shfl_xor(v, o);
    return v;
}
__device__ __forceinline__ void lds_barrier() { asm volatile("s_waitcnt lgkmcnt(0)" ::: "memory"); __builtin_amdgcn_s_barrier(); asm volatile("" ::: "memory"); }
__device__ __forceinline__ float sigmoid_exact(float x) { return 1.f / (1.f + __expf(-x)); }
__device__ __forceinline__ float sigmoidf_(float x) { return __builtin_amdgcn_rcpf(1.f + __builtin_amdgcn_exp2f(-1.4426950408889634f * x)); }
__device__ __forceinline__ float siluf_(float x) { return x * __builtin_amdgcn_rcpf(1.f + __builtin_amdgcn_exp2f(-1.4426950408889634f * x)); }
__device__ __forceinline__ float logsigmoidf_(float x) { return fminf(x, 0.f) - log1pf(__expf(-fabsf(x))); }
__device__ __forceinline__ float logsigmoid_fast(float x) { return fminf(x, 0.f) - __logf(1.f + __expf(-fabsf(x))); }
__device__ __forceinline__ void st_bf4(bf16* p, f32x4 v) { u32x2 w; w.x = pk2(v[0], v[1]); w.y = pk2(v[2], v[3]); *(u32x2*)p = w; }
__device__ __forceinline__ void st_bf8(bf16* p, f32x4 a, f32x4 b) { u32x4 w; w.x = pk2(a[0], a[1]); w.y = pk2(a[2], a[3]); w.z = pk2(b[0], b[1]); w.w = pk2(b[2], b[3]); *(u32x4*)p = w; }
__device__ __forceinline__ f32x4 ld_bf4_l2(const bf16* p) { const unsigned long long q = __hip_atomic_load((const unsigned long long*)p, __ATOMIC_RELAXED, __HIP_MEMORY_SCOPE_AGENT); const unsigned lo = (unsigned)q, hi = (unsigned)(q >> 32); return (f32x4){bflo(lo), bfhi(lo), bflo(hi), bfhi(hi)}; }
__device__ __forceinline__ f32x4 ld_bf4(const bf16* p) { u32x2 w = *(const u32x2*)p; return (f32x4){bflo(w.x), bfhi(w.x), bflo(w.y), bfhi(w.y)}; }

#define XB_TMO      128
#define XB_XCNT(j)  (256  + 64 * (j))
#define XB_XSUB(j)  (1280 + 64 * (j))
#define XB_XGEN(j)  (2304 + 64 * (j))
#define XB_TOP      3328
#define XB_TOPGEN   3392
#define XCD_BAR_WORDS 3456
#define XB_SPIN_CAP (1u << 22)
__device__ __forceinline__ unsigned xb_ld(unsigned* p)              { return __hip_atomic_load(p, __ATOMIC_RELAXED, __HIP_MEMORY_SCOPE_AGENT); }
__device__ __forceinline__ unsigned xb_add(unsigned* p, unsigned v) { return __hip_atomic_fetch_add(p, v, __ATOMIC_RELAXED, __HIP_MEMORY_SCOPE_AGENT); }
__device__ __forceinline__ unsigned xb_xcc_id() { return (unsigned)__builtin_amdgcn_s_getreg((3 << 11) | 20) & 0xFu; }
#define XB_SPIN(cond, bar) do { unsigned _sp = 0; while (cond) { __builtin_amdgcn_s_sleep(1); \
    if ((++_sp & 255u) == 0u) { if (xb_ld(&(bar)[XB_TMO])) break; if (_sp > XB_SPIN_CAP) { atomicAdd(&(bar)[XB_TMO], 1u); break; } } } } while (0)
struct XcdBarrier { unsigned* bar; unsigned x; volatile LAS unsigned* st; };
__device__ __forceinline__ XcdBarrier xcd_barrier_post(unsigned* bar, volatile LAS unsigned* st) {
    XcdBarrier b; b.bar = bar; b.x = xb_xcc_id(); b.st = st;
    if (threadIdx.x == 0) (void)xb_add(&bar[XB_XCNT(b.x)], 1u);
    return b;
}
__device__ __forceinline__ void xcd_barrier_complete(unsigned* bar, unsigned x, unsigned& nloc, unsigned& nx) {
    const unsigned G = gridDim.x * gridDim.y * gridDim.z;
    unsigned sum, cnt, mine, sp = 0u;
    for (;;) {
        sum = 0u; cnt = 0u; mine = 0u;
#pragma unroll
        for (unsigned j = 0; j < 16; ++j) { const unsigned c = xb_ld(&bar[XB_XCNT(j)]); sum += c; cnt += (c > 0u) ? 1u : 0u; mine = (j == x) ? c : mine; }
        if (sum == G) break;
        __builtin_amdgcn_s_sleep(1);
        if ((++sp & 255u) == 0u) { if (xb_ld(&bar[XB_TMO])) break; if (sp > XB_SPIN_CAP) { atomicAdd(&bar[XB_TMO], 1u); break; } }
    }
    nloc = mine > 0u ? mine : 1u; nx = cnt > 0u ? cnt : 1u;
}
__device__ __forceinline__ void xcd_barrier(const XcdBarrier& b) {
    asm volatile("s_waitcnt vmcnt(0)" ::: "memory");
    __syncthreads();
    if (threadIdx.x == 0) {
        unsigned* bar = b.bar;
        __builtin_amdgcn_s_waitcnt(0);
        unsigned nloc = b.st[0], nx = b.st[1];
        if (nloc == 0u) { xcd_barrier_complete(bar, b.x, nloc, nx); b.st[0] = nloc; b.st[1] = nx; }
        const unsigned old = xb_add(&bar[XB_XSUB(b.x)], 1u);
        const unsigned gen = old / nloc;
        if (old + 1u == (gen + 1u) * nloc) {
            __builtin_amdgcn_fence(__ATOMIC_RELEASE, "agent");
            asm volatile("s_waitcnt vmcnt(0)" ::: "memory");
            const unsigned og = xb_add(&bar[XB_TOP], 1u);
            const unsigned tg = og / nx;
            if (og + 1u == (tg + 1u) * nx) xb_add(&bar[XB_TOPGEN], 1u);
            else XB_SPIN(xb_ld(&bar[XB_TOPGEN]) == tg, bar);
            __builtin_amdgcn_fence(__ATOMIC_ACQUIRE, "agent");
            xb_add(&bar[XB_XGEN(b.x)], 1u);
            asm volatile("s_waitcnt vmcnt(0)" ::: "memory");
        } else {
            XB_SPIN(xb_ld(&bar[XB_XGEN(b.x)]) == gen, bar);
            __builtin_amdgcn_fence(__ATOMIC_ACQUIRE, "agent");
            asm volatile("s_waitcnt vmcnt(0)" ::: "memory");
        }
#if PROBE_SEAM >= 0
        if (blockIdx.x == 0) { const unsigned n = b.st[2]; ((unsigned long long*)(b.bar + 8192))[n] = wall_clock64(); b.st[2] = n + 1u; }
#endif
    }
    __syncthreads();
}

struct Args { const float* in[33]; float* out; unsigned char* ws; int ph_lo, ph_hi; };

struct Ctx {
    LAS unsigned char* lds;
    int tid, lane, wave, bid, nblk;
    const float* const* in;
    float* out; unsigned char* ws;
};
#define IN_X 0
#define IN_C 1
#define IN_ADAW 2
#define IN_ADAB 3
#define IN_NMIX 4
#define IN_NFFN 5
#define IN_WIN 6
#define IN_GLA_WA2 7
#define IN_GLA_BA 8
#define IN_GLA_NORM 9
#define IN_DSA_NQ 10
#define IN_DSA_NKV 11
#define IN_DSA_WUQ 12
#define IN_DSA_WUK 13
#define IN_DSA_WUV 14
#define IN_DSA_WQI 15
#define IN_ML_CONV 16
#define IN_ML_BI 17
#define IN_ML_BF 18
#define IN_ML_NORM 19
#define IN_WUPA 20
#define IN_WUPB 21
#define IN_WUPC 22
#define IN_WO 23
#define IN_RW 24
#define IN_RB 25
#define IN_EWG 26
#define IN_EWU 27
#define IN_EWD 28
#define IN_SWG 29
#define IN_SWU 30
#define IN_SWD 31
#define IN_NFIN 32

template <class SrcF>
__device__ __forceinline__ void tr_item(const SrcF& src, bf16* dst, int dst_ld, int n0, int k0, LAS float* scr, int lane) {
    const int j = lane & 31;
    const float* colp = src(n0 + j);
    const long ld = src.ld;
    float tv[32];
#pragma unroll
    for (int i = 0; i < 32; ++i) { const int kk = 2 * i + (lane >> 5); tv[i] = colp ? colp[(long)(k0 + kk) * ld] : 0.f; }
#pragma unroll
    for (int i = 0; i < 32; ++i) { const int kk = 2 * i + (lane >> 5); scr[kk * 33 + j] = tv[i]; }
    asm volatile("s_waitcnt lgkmcnt(0)" ::: "memory");
    const int c = lane & 7;
#pragma unroll
    for (int jj = 0; jj < 4; ++jj) { const int n = (lane >> 3) + 8 * jj; const LAS float* s = scr + (8 * c) * 33 + n;
        u32x4 o; o.x = pk2(s[0 * 33], s[1 * 33]); o.y = pk2(s[2 * 33], s[3 * 33]); o.z = pk2(s[4 * 33], s[5 * 33]); o.w = pk2(s[6 * 33], s[7 * 33]);
        *(u32x4*)(dst + (size_t)(n0 + n) * dst_ld + k0 + 8 * c) = o; }
    asm volatile("s_waitcnt lgkmcnt(0)" ::: "memory");
}
struct SrcPlain { const float* W; long ld; __device__ __forceinline__ const float* operator()(int n) const { return W + n; } };
__device__ __forceinline__ int win_src_col(int r) {
    if (r < 1536) return r;
    if (r < 1792) return 1552 + (r - 1536);
    if (r < 1920) return 1808 + (r - 1792);
    if (r < 1952) return 1936 + (r - 1920);
    if (r < 1968) return 1536 + (r - 1952);
    if (r < 1976) return 1968 + (r - 1968);
    if (r < 1980) return 3000 + (r - 1976);
    if (r < 1984) return 3004 + (r - 1980);
    if (r < 2048) return -1;
    if (r < 2560) return 1976 + (r - 2048);
    if (r < 3072) return 2488 + (r - 2560);
    if (r < 3584) return 3008 + (r - 3072);
    return 3520 + (r - 3584);
}
struct SrcWin { const float* W; long ld; __device__ __forceinline__ const float* operator()(int n) const { const int c = win_src_col(n); return c < 0 ? nullptr : W + c; } };
struct SrcGU { const float* Wg; const float* Wu; long ld;
    __device__ __forceinline__ const float* operator()(int r) const { const int pn = r >> 8, w = r & 255, j = 128 * pn + (w & 127); return (w < 128 ? Wg : Wu) + j; } };

constexpr int SG_LD = 40;
template <class Epi>
__device__ __forceinline__ void sgemm_unit(const Ctx& c, const bf16* A, int lda, const int* rowlist, int nvalid, int arow0, const bf16* Bt, int K, const Epi& E, int erow0, int ecol0) {
    LAS bf16* As = (LAS bf16*)c.lds;
    LAS bf16* Bs = (LAS bf16*)(c.lds + 128 * SG_LD * 2);
    const int tid = c.tid, lane = c.lane, wave = c.wave, wr = wave >> 2, wc = wave & 3, fr = lane & 15, fq = lane >> 4;
    const int lr = tid >> 2, ch = tid & 3;
    int srow = arow0 + lr;
    if (rowlist) { srow = (arow0 + lr < nvalid) ? rowlist[arow0 + lr] : 0; }
    const bf16* ap = A + (size_t)srow * lda + ch * 8;
    const bf16* bp0 = Bt + (size_t)lr * K + ch * 8;
    const bf16* bp1 = Bt + (size_t)(128 + lr) * K + ch * 8;
    f32x4 acc[2][4][2];
#pragma unroll
    for (int a = 0; a < 2; ++a)
#pragma unroll
        for (int m = 0; m < 4; ++m)
#pragma unroll
            for (int n = 0; n < 2; ++n) acc[a][m][n] = (f32x4){0.f, 0.f, 0.f, 0.f};
    u32x4 ra = *(const u32x4*)ap, rb0 = *(const u32x4*)bp0, rb1 = *(const u32x4*)bp1;
    for (int k0 = 0; k0 < K; k0 += 32) {
        __syncthreads();
        *(LAS u32x4*)(As + lr * SG_LD + ch * 8) = ra;
        *(LAS u32x4*)(Bs + lr * SG_LD + ch * 8) = rb0;
        *(LAS u32x4*)(Bs + (128 + lr) * SG_LD + ch * 8) = rb1;
        __syncthreads();
        if (k0 + 32 < K) { ra = *(const u32x4*)(ap + k0 + 32); rb0 = *(const u32x4*)(bp0 + k0 + 32); rb1 = *(const u32x4*)(bp1 + k0 + 32); }
        bf16x8 af[4], bfr[2][2];
#pragma unroll
        for (int m = 0; m < 4; ++m) af[m] = *(const LAS bf16x8*)(As + (wr * 64 + m * 16 + fr) * SG_LD + fq * 8);
#pragma unroll
        for (int bj = 0; bj < 2; ++bj)
#pragma unroll
            for (int n = 0; n < 2; ++n) bfr[bj][n] = *(const LAS bf16x8*)(Bs + (bj * 128 + wc * 32 + n * 16 + fr) * SG_LD + fq * 8);
#pragma unroll
        for (int bj = 0; bj < 2; ++bj)
#pragma unroll
            for (int m = 0; m < 4; ++m)
#pragma unroll
                for (int n = 0; n < 2; ++n) acc[bj][m][n] = __builtin_amdgcn_mfma_f32_16x16x32_bf16(bfr[bj][n], af[m], acc[bj][m][n], 0, 0, 0);
    }
#pragma unroll
    for (int m = 0; m < 4; ++m)
#pragma unroll
        for (int n = 0; n < 2; ++n) E(erow0 + wr * 64 + m * 16 + fr, ecol0 + wc * 32 + n * 16 + 4 * fq, acc[0][m][n], acc[1][m][n]);
}
template <class Epi>
__device__ __forceinline__ void sgemm_phase(const Ctx& c, const bf16* A, int lda, int M, const bf16* Bt, int ntn, int K, const Epi& E) {
    const int nu = (M / 128) * ntn;
    for (int u = c.bid; u < nu; u += c.nblk) {
        const int pm = u / ntn, pn = u % ntn;
        sgemm_unit(c, A, lda, nullptr, 0, pm * 128, Bt + (size_t)pn * 256 * K, K, E, pm * 128, pn * 256);
    }
    __syncthreads();
}


namespace g8 {
constexpr int BM = 256, BK = 64, HALF = 128, HTB = HALF * BK * 2, STAGE_BYTES = 8 * HTB, NXCD = 8, WGM = 8;
__host__ __device__ __forceinline__ int lds_byte(int r, int c) { const int st = (r >> 4) * 2 + (c >> 5), rr = r & 15, cc = c & 31, ob = rr * 64 + cc * 2; return st * 1024 + (ob ^ (((ob >> 9) & 1) << 5)); }
__host__ __device__ __forceinline__ void stage_rc(int b, int& R, int& C) { const int st = b / 1024, sb = b % 1024, swz = sb ^ (((sb >> 9) & 1) << 5); R = (st >> 1) * 16 + swz / 64; C = (st & 1) * 32 + (swz % 64) / 2; }
__host__ __device__ __forceinline__ int perm32(int rho) { const int n = rho >> 4, i = rho & 15; return 8 * (i >> 2) + 4 * n + (i & 3); }
struct GUnit { const char* A; const char* B; const int* rl; int nvalid; int erow0, ecol0; int x0; const float* xp; };
__device__ __forceinline__ bool static_order(int nM, int nN, int G, int c, int i, int& pm, int& pn) {
    const int nwg = nM * nN; const long L = (long)i * G + c; if (L >= nwg) return false;
    int wgid = (int)L; { const int q = nwg / NXCD, r = nwg % NXCD, xcd = wgid % NXCD, off = wgid / NXCD; wgid = (xcd < r ? xcd * (q + 1) : r * (q + 1) + (xcd - r) * q) + off; }
    const int nig = WGM * nN, gid = wgid / nig, fm = gid * WGM, gsz = (nM - fm) < WGM ? (nM - fm) : WGM;
    pm = fm + ((wgid % nig) % gsz); pn = (wgid % nig) / gsz; return true;
}
struct DenseSched { const char* A; const char* Bt; size_t ldaB, ldbB; int nM, nN, G, c;
    __device__ __forceinline__ bool next(int i, GUnit& u) const { int pm, pn; if (!static_order(nM, nN, G, c, i, pm, pn)) return false;
        u.A = A + (size_t)pm * 256 * ldaB; u.B = Bt + (size_t)pn * 256 * ldbB; u.rl = nullptr; u.nvalid = 0; u.erow0 = pm * 256; u.ecol0 = pn * 256; u.x0 = 0; u.xp = nullptr; return true; } };

template <bool GATHER, class Epi, class Sched>
__device__ __forceinline__ void gemm_phase(LAS unsigned char* lds, unsigned ldaB, int K, const Sched& S, const Epi& E) {
    const int tid = threadIdx.x, wid = __builtin_amdgcn_readfirstlane(tid >> 6), lane = tid & 63, wr = wid >> 2, wc = wid & 3, fr = lane & 15, fq = lane >> 4;
    const int nt = K / BK;
    int R0, C0, R1, C1; stage_rc(tid * 16, R0, C0); stage_rc(tid * 16 + 8192, R1, C1);
    unsigned voffB[2];
    if (Epi::PERM) { voffB[0] = (unsigned)(((R0 & ~31) + perm32(R0 & 31)) * K + C0) * 2u; voffB[1] = (unsigned)(((R1 & ~31) + perm32(R1 & 31)) * K + C1) * 2u; }
    else { voffB[0] = (unsigned)(R0 * K + C0) * 2u; voffB[1] = (unsigned)(R1 * K + C1) * 2u; }
    unsigned ac0[2], ac1[2], an0[2], an1[2];
    const size_t kstep = (size_t)(BK * 2);
    const size_t hstepB = (size_t)HALF * K * 2;
    const unsigned ldsw = (unsigned)wid * 1024u;
    const int aoff = lds_byte(wr * 64 + fr, fq * 8), boff = lds_byte(wc * 32 + fr, fq * 8);
#define G8_SA(b, h) (((b) * 2 + (h)) * HTB)
#define G8_SB(b, h) ((4 + (b) * 2 + (h)) * HTB)
#define G8_STAGE(bufoff, gbase, voff) do { _Pragma("unroll") for (int _i = 0; _i < 2; ++_i) \
        __builtin_amdgcn_global_load_lds((const unsigned*)((const char*)(gbase) + (voff)[_i]), (LAS unsigned*)(lds + (bufoff) + ldsw + _i * 8192), 16, 0, 0); } while (0)
#define G8_LDA(dst, b, h) do { _Pragma("unroll") for (int m = 0; m < 4; ++m) _Pragma("unroll") for (int k = 0; k < 2; ++k) dst[m][k] = *(const LAS bf16x8*)(lds + G8_SA(b, h) + aoff + m * 2048 + k * 1024); } while (0)
#define G8_LDB(dst, b, h) do { _Pragma("unroll") for (int n = 0; n < 2; ++n) _Pragma("unroll") for (int k = 0; k < 2; ++k) dst[n][k] = *(const LAS bf16x8*)(lds + G8_SB(b, h) + boff + n * 2048 + k * 1024); } while (0)
#define G8_MMA(ai, bj, At, Bt) do { __builtin_amdgcn_s_setprio(1); _Pragma("unroll") for (int m = 0; m < 4; ++m) _Pragma("unroll") for (int n = 0; n < 2; ++n) _Pragma("unroll") for (int k = 0; k < 2; ++k) \
        acc[ai][bj][m][n] = __builtin_amdgcn_mfma_f32_16x16x32_bf16(Bt[n][k], At[m][k], acc[ai][bj][m][n], 0, 0, 0); __builtin_amdgcn_s_setprio(0); } while (0)
#define G8_WAIT_V(n) asm volatile("s_waitcnt vmcnt(" #n ")" ::: "memory")
#define G8_WAIT_L(n) asm volatile("s_waitcnt lgkmcnt(" #n ")" ::: "memory")
#define G8_BAR __builtin_amdgcn_s_barrier()
#define G8_SCHED __builtin_amdgcn_sched_barrier(0)
#define G8_XLOAD(u) __builtin_amdgcn_global_load_lds((const unsigned*)((u).rl + lane * 4), (LAS unsigned*)(lds + STAGE_BYTES + wid * 1024), 16, 0, 0)
#define G8_AOFF(u, o0, o1) do { if (GATHER) { const LAS int* _rs = (const LAS int*)(lds + STAGE_BYTES + wid * 1024); const int _nv = (u).nvalid - 1; \
        const int _r00 = _rs[min(R0, _nv)], _r01 = _rs[min(R1, _nv)], _r10 = _rs[min(128 + R0, _nv)], _r11 = _rs[min(128 + R1, _nv)]; \
        o0[0] = (unsigned)_r00 * ldaB + (unsigned)C0 * 2u; o0[1] = (unsigned)_r01 * ldaB + (unsigned)C1 * 2u; o1[0] = (unsigned)_r10 * ldaB + (unsigned)C0 * 2u; o1[1] = (unsigned)_r11 * ldaB + (unsigned)C1 * 2u; \
    } else { o0[0] = (unsigned)R0 * ldaB + (unsigned)C0 * 2u; o0[1] = (unsigned)R1 * ldaB + (unsigned)C1 * 2u; o1[0] = (unsigned)(128 + R0) * ldaB + (unsigned)C0 * 2u; o1[1] = (unsigned)(128 + R1) * ldaB + (unsigned)C1 * 2u; } } while (0)
    GUnit cur, nxt; int ui = 0;
    if (!S.next(0, cur)) return;
    f32x4 acc[2][2][4][2];
#pragma unroll
    for (int a = 0; a < 2; ++a)
#pragma unroll
        for (int b = 0; b < 2; ++b)
#pragma unroll
            for (int m = 0; m < 4; ++m)
#pragma unroll
                for (int n = 0; n < 2; ++n) acc[a][b][m][n] = (f32x4){0.f, 0.f, 0.f, 0.f};
    bf16x8 At[4][2], B0[2][2], B1[2][2];
    if (GATHER) { G8_XLOAD(cur); G8_WAIT_V(0); }
    G8_AOFF(cur, ac0, ac1);
    if (GATHER) { G8_WAIT_L(0); }
    const char* cA = cur.A; const char* cB = cur.B;
    G8_STAGE(G8_SB(0, 0), cB, voffB); G8_STAGE(G8_SB(0, 1), cB + hstepB, voffB); G8_STAGE(G8_SA(0, 0), cA, ac0); G8_STAGE(G8_SA(0, 1), cA, ac1);
    if (wr == 1) G8_BAR;
    G8_WAIT_V(2); G8_BAR;
    G8_STAGE(G8_SB(1, 0), cB + kstep, voffB); G8_STAGE(G8_SA(1, 0), cA + kstep, ac0); G8_STAGE(G8_SB(1, 1), cB + hstepB + kstep, voffB);
    G8_WAIT_V(6); G8_BAR;
    for (;;) {
        const bool has_next = S.next(ui + 1, nxt);
        const char* nA = has_next ? nxt.A : cA; const char* nB = has_next ? nxt.B : cB;
        an0[0] = ac0[0]; an0[1] = ac0[1]; an1[0] = ac1[0]; an1[1] = ac1[1];
        const bool xload = GATHER && has_next;
        if (xload) { G8_XLOAD(nxt); }
#pragma unroll 1
        for (int t = 0; t < nt; t += 2) {
            const bool last = (t == nt - 2);
            const char* a1 = cA + (size_t)(t + 1) * kstep;
            const char* a2 = last ? nA : cA + (size_t)(t + 2) * kstep; const char* b2 = last ? nB : cB + (size_t)(t + 2) * kstep;
            const char* a3 = a2 + kstep; const char* b3 = b2 + kstep;
            unsigned* x0 = last ? an0 : ac0; unsigned* x1 = last ? an1 : ac1;
            unsigned s0[2], s1[2]; s0[0] = x0[0]; s0[1] = x0[1]; s1[0] = x1[0]; s1[1] = x1[1];
            G8_LDB(B0, 0, 0); G8_LDB(B1, 0, 1); G8_SCHED; G8_LDA(At, 0, 0); G8_STAGE(G8_SA(1, 1), a1, ac1);
            if (xload && t == 0) { G8_WAIT_V(9); } else { G8_WAIT_V(8); }
            G8_WAIT_L(0); G8_BAR; G8_MMA(0, 0, At, B0); G8_MMA(0, 1, At, B1); G8_BAR; G8_SCHED;
            G8_LDA(At, 0, 1); G8_STAGE(G8_SB(0, 0), b2, voffB); G8_STAGE(G8_SB(0, 1), b2 + hstepB, voffB); G8_STAGE(G8_SA(0, 0), a2, s0);
            G8_WAIT_V(8); G8_WAIT_L(0); G8_BAR; G8_MMA(1, 0, At, B0); G8_MMA(1, 1, At, B1); G8_BAR; G8_SCHED;
            if (xload && t == 0) { G8_AOFF(nxt, an0, an1); }
            G8_LDB(B0, 1, 0); G8_LDB(B1, 1, 1); G8_SCHED; G8_LDA(At, 1, 0); G8_STAGE(G8_SA(0, 1), a2, s1);
            G8_WAIT_V(8); G8_WAIT_L(0); G8_BAR; G8_MMA(0, 0, At, B0); G8_MMA(0, 1, At, B1); G8_BAR; G8_SCHED;
            G8_LDA(At, 1, 1); G8_STAGE(G8_SB(1, 0), b3, voffB); G8_STAGE(G8_SB(1, 1), b3 + hstepB, voffB); G8_STAGE(G8_SA(1, 0), a3, s0);
            G8_WAIT_V(8); G8_WAIT_L(0); G8_BAR; G8_MMA(1, 0, At, B0); G8_MMA(1, 1, At, B1); G8_BAR; G8_SCHED;
        }
        if (wr == 0) G8_BAR;
#pragma unroll
        for (int ai = 0; ai < 2; ++ai) {
            if constexpr (Epi::PERM) {
                typename Epi::Pre pr8[4];
                const int fb8 = (wid * 16 * 64 + lane) * 8;
#pragma unroll
                for (int m = 0; m < 4; ++m) pr8[m] = E.pre(cur, cur.erow0 + ai * HALF + wr * 64 + m * 16 + fr, cur.ecol0 + wc * 32 + 8 * fq, fb8 + ((ai * 4 + m) * 2) * 512);
#pragma unroll
                for (int m = 0; m < 4; ++m) E.post8(cur, cur.erow0 + ai * HALF + wr * 64 + m * 16 + fr, cur.ecol0 + wc * 32 + 8 * fq, acc[ai][0][m][0], acc[ai][0][m][1], acc[ai][1][m][0], acc[ai][1][m][1], pr8[m], fb8 + ((ai * 4 + m) * 2) * 512);
            } else {
            const int fragbase = (wid * 32 * 64 + lane) * 4;
            constexpr int BMR = Epi::BATCH_M;
#pragma unroll
            for (int m0 = 0; m0 < 4; m0 += BMR) {
                typename Epi::Pre pr[BMR][2];
#pragma unroll
                for (int mm = 0; mm < BMR; ++mm)
#pragma unroll
                    for (int n = 0; n < 2; ++n) { const int m = m0 + mm; pr[mm][n] = E.pre(cur, cur.erow0 + ai * HALF + wr * 64 + m * 16 + fr, cur.ecol0 + wc * 32 + n * 16 + 4 * fq, fragbase + (((ai * 4 + m) * 2 + n) * 2) * 256); }
#pragma unroll
                for (int mm = 0; mm < BMR; ++mm)
#pragma unroll
                    for (int n = 0; n < 2; ++n) { const int m = m0 + mm; E.post(cur, cur.erow0 + ai * HALF + wr * 64 + m * 16 + fr, cur.ecol0 + wc * 32 + n * 16 + 4 * fq, acc[ai][0][m][n], acc[ai][1][m][n], pr[mm][n], fragbase + (((ai * 4 + m) * 2 + n) * 2) * 256); }
            }
            }
        }
        if (!has_next) break;
#pragma unroll
        for (int a = 0; a < 2; ++a)
#pragma unroll
            for (int b = 0; b < 2; ++b)
#pragma unroll
                for (int m = 0; m < 4; ++m)
#pragma unroll
                    for (int n = 0; n < 2; ++n) acc[a][b][m][n] = (f32x4){0.f, 0.f, 0.f, 0.f};
        cur = nxt; cA = nA; cB = nB; ++ui;
        ac0[0] = an0[0]; ac0[1] = an0[1]; ac1[0] = an1[0]; ac1[1] = an1[1];
        if (wr == 1) G8_BAR;
    }
    G8_WAIT_V(0);
    G8_BAR;
#undef G8_SA
#undef G8_SB
#undef G8_STAGE
#undef G8_LDA
#undef G8_LDB
#undef G8_MMA
#undef G8_WAIT_V
#undef G8_WAIT_L
#undef G8_BAR
#undef G8_SCHED
#undef G8_AOFF
#undef G8_XLOAD
}
}
template <class Epi>
__device__ __forceinline__ void dgemm_phase(const Ctx& c, const bf16* A, int lda, int M, const bf16* Bt, int ntn, int K, const Epi& E, int G = -1, int cid = -1) {
    g8::DenseSched S{(const char*)A, (const char*)Bt, (size_t)lda * 2, (size_t)K * 2, M / 256, ntn, G < 0 ? c.nblk : G, cid < 0 ? c.bid : cid};
    g8::gemm_phase<false>(c.lds, (unsigned)lda * 2u, K, S, E);
    __syncthreads();
}


__device__ __forceinline__ size_t frag_off(int tile, int row, int col, int bj) {
    const int ai = row >> 7, wr = (row >> 6) & 1, m = (row >> 4) & 3, fr = row & 15, wc = col >> 5, n = (col >> 4) & 1, fq = (col >> 2) & 3;
    const int wave = wr * 4 + wc, lane = fq * 16 + fr, f = ((ai * 4 + m) * 2 + n) * 2 + bj;
    return ((((size_t)tile * 8 + wave) * 32 + f) * 64 + lane) * 4;
}
struct NoPre {};
struct EpiInPB { bf16* PB; float* SM; typedef NoPre Pre; static constexpr int BATCH_M = 4; static constexpr bool PERM = true;
    __device__ __forceinline__ void post8(int row, int col, f32x4 a0, f32x4 a1, f32x4 b0, f32x4 b1, const Pre&, int, int, int) const {
        st_bf8(PB + (size_t)row * NPB + col, a0, a1);
        if ((col >> 8) == 7) { float* sp = SM + (size_t)row * 128 + (col & 127); *(f32x4*)sp = b0; *(f32x4*)(sp + 4) = b1; }
        else st_bf8(PB + (size_t)row * NPB + col + 128, b0, b1);
    }
    __device__ __forceinline__ Pre pre(int, int, int, int, int) const { return Pre{}; }
    __device__ __forceinline__ void post(int row, int col, f32x4 lo, f32x4 hi, const Pre&, int, int, int) const { (*this)(row, col, lo, hi); }
    __device__ __forceinline__ void operator()(int row, int col, f32x4 lo, f32x4 hi) const {
        st_bf4(PB + (size_t)row * NPB + col, lo);
        if ((col >> 8) == 7) *(f32x4*)(SM + (size_t)row * 128 + (col & 127)) = hi;
        else st_bf4(PB + (size_t)row * NPB + col + 128, hi);
    } };
struct EpiQ { bf16* QLAT; bf16* QIDX; const float* rstd; struct Pre { float r; }; static constexpr int BATCH_M = 4; static constexpr bool PERM = true;
    __device__ __forceinline__ void post8(int row, int col, f32x4 a0, f32x4 a1, f32x4 b0, f32x4 b1, const Pre& p, int, int, int) const {
        const float r = p.r;
        if (col < 1024) { st_bf8(QLAT + (size_t)row * 1024 + col, a0 * r, a1 * r); st_bf8(QLAT + (size_t)row * 1024 + col + 128, b0 * r, b1 * r); }
        else { st_bf8(QIDX + (size_t)row * 256 + (col - 1024), a0 * r, a1 * r); st_bf8(QIDX + (size_t)row * 256 + (col - 1024) + 128, b0 * r, b1 * r); }
    }
    __device__ __forceinline__ Pre pre(int row, int, int, int, int) const { return Pre{rstd[row]}; }
    __device__ __forceinline__ void post(int row, int col, f32x4 lo, f32x4 hi, const Pre& p, int, int, int) const {
        const float r = p.r;
        if (col < 1024) { st_bf4(QLAT + (size_t)row * 1024 + col, lo * r); st_bf4(QLAT + (size_t)row * 1024 + col + 128, hi * r); }
        else { st_bf4(QIDX + (size_t)row * 256 + (col - 1024), lo * r); st_bf4(QIDX + (size_t)row * 256 + (col - 1024) + 128, hi * r); }
    } };
struct EpiGate { bf16* G; typedef NoPre Pre; static constexpr int BATCH_M = 4; static constexpr bool PERM = true;
    __device__ __forceinline__ Pre pre(int, int, int, int, int) const { return Pre{}; }
    __device__ __forceinline__ void post(int, int, f32x4, f32x4, const Pre&, int, int, int) const {}
    __device__ __forceinline__ void post8(int, int, f32x4 a0, f32x4 a1, f32x4 b0, f32x4 b1, const Pre&, int pm, int pn, int foff) const {
#pragma unroll
        for (int i = 0; i < 4; ++i) { a0[i] = sigmoidf_(a0[i]); a1[i] = sigmoidf_(a1[i]); b0[i] = sigmoidf_(b0[i]); b1[i] = sigmoidf_(b1[i]); }
        bf16* gt = G + (size_t)(((pn >> 2) * 128 + pm) * 4 + (pn & 3)) * 65536 + foff;
        st_bf8(gt, a0, a1); st_bf8(gt + 512, b0, b1);
    } };
struct EpiUp { bf16* M1; bf16* MF; const bf16* G; int br; int first; int last; struct Pre { u32x4 g0, g1, m0, m1; }; static constexpr int BATCH_M = 2; static constexpr bool PERM = true;
    __device__ __forceinline__ Pre pre(int, int, int pm, int pn, int foff) const {
        const bf16* gt = G + (size_t)((br * 128 + pm) * 4 + pn) * 65536 + foff; const bf16* mt = MF + (size_t)(pm * 4 + pn) * 65536 + foff;
        Pre p; p.g0 = *(const u32x4*)gt; p.g1 = *(const u32x4*)(gt + 512);
        p.m0 = (u32x4){0u, 0u, 0u, 0u}; p.m1 = p.m0;
        if (!first) { p.m0 = __builtin_nontemporal_load((const u32x4*)mt); p.m1 = __builtin_nontemporal_load((const u32x4*)(mt + 512)); }
        return p; }
    __device__ __forceinline__ void post(int, int, f32x4, f32x4, const Pre&, int, int, int) const {}
    __device__ __forceinline__ void post8(int row, int col, f32x4 a0, f32x4 a1, f32x4 b0, f32x4 b1, const Pre& p, int pm, int pn, int foff) const {
        a0 *= (f32x4){bflo(p.g0.x), bfhi(p.g0.x), bflo(p.g0.y), bfhi(p.g0.y)}; a1 *= (f32x4){bflo(p.g0.z), bfhi(p.g0.z), bflo(p.g0.w), bfhi(p.g0.w)};
        b0 *= (f32x4){bflo(p.g1.x), bfhi(p.g1.x), bflo(p.g1.y), bfhi(p.g1.y)}; b1 *= (f32x4){bflo(p.g1.z), bfhi(p.g1.z), bflo(p.g1.w), bfhi(p.g1.w)};
        if (!first) { a0 += (f32x4){bflo(p.m0.x), bfhi(p.m0.x), bflo(p.m0.y), bfhi(p.m0.y)}; a1 += (f32x4){bflo(p.m0.z), bfhi(p.m0.z), bflo(p.m0.w), bfhi(p.m0.w)};
                      b0 += (f32x4){bflo(p.m1.x), bfhi(p.m1.x), bflo(p.m1.y), bfhi(p.m1.y)}; b1 += (f32x4){bflo(p.m1.z), bfhi(p.m1.z), bflo(p.m1.w), bfhi(p.m1.w)}; }
        if (last) { bf16* m = M1 + (size_t)row * 1024 + col; st_bf8(m, a0, a1); st_bf8(m + 128, b0, b1); }
        else { bf16* mt = MF + (size_t)(pm * 4 + pn) * 65536 + foff; st_bf8(mt, a0, a1); st_bf8(mt + 512, b0, b1); }
    } };
struct EpiWo { const float* res; float* out; const float* g1;
    struct Pre { f32x4 ra, rb; }; static constexpr int BATCH_M = 4; static constexpr bool PERM = false;
    __device__ __forceinline__ void post8(int, int, f32x4, f32x4, f32x4, f32x4, const Pre&, int, int, int) const {}
    __device__ __forceinline__ Pre pre(int row, int col, int, int, int) const { const size_t o = (size_t)row * 1024 + col; return Pre{*(const f32x4*)(res + o), *(const f32x4*)(res + o + 128)}; }
    __device__ __forceinline__ void post(int row, int col, f32x4 lo, f32x4 hi, const Pre& p, int, int, int) const {
        const float* gp = g1 + (size_t)(row >> 11) * 6144 + col; const size_t o = (size_t)row * 1024 + col;
        const f32x4 ga = *(const f32x4*)gp, gb = *(const f32x4*)(gp + 128);
        *(f32x4*)(out + o) = p.ra + ga * lo; *(f32x4*)(out + o + 128) = p.rb + gb * hi;
    } };
struct EpiG1 { bf16* HID; const float* wl; int cnt; int orow0;
    __device__ __forceinline__ void operator()(int row, int col, f32x4 lo, f32x4 hi) const {
        const int hc = col - 128 * (col >> 8);
        f32x4 v = (f32x4){0.f, 0.f, 0.f, 0.f};
        if (row < cnt) { const float w = wl ? wl[row] : 1.f;
#pragma unroll
            for (int i = 0; i < 4; ++i) v[i] = siluf_(lo[i]) * hi[i] * w; }
        st_bf4(HID + (size_t)(orow0 + row) * 256 + hc, v);
    } };
struct EpiG2 { bf16* Y; int orow0;
    __device__ __forceinline__ void operator()(int row, int col, f32x4 lo, f32x4 hi) const {
        st_bf4(Y + (size_t)(orow0 + row) * 1024 + col, lo); st_bf4(Y + (size_t)(orow0 + row) * 1024 + col + 128, hi);
    } };


template <class F> struct EpiU { F f; typedef typename F::Pre Pre; static constexpr int BATCH_M = F::BATCH_M; static constexpr bool PERM = F::PERM;
    __device__ __forceinline__ void post8(const g8::GUnit& u, int row, int col, f32x4 a0, f32x4 a1, f32x4 b0, f32x4 b1, const Pre& p, int foff) const { f.post8(row, col, a0, a1, b0, b1, p, u.erow0 >> 8, u.ecol0 >> 8, foff); }
    __device__ __forceinline__ Pre pre(const g8::GUnit& u, int row, int col, int foff) const { return f.pre(row, col, u.erow0 >> 8, u.ecol0 >> 8, foff); }
    __device__ __forceinline__ void post(const g8::GUnit& u, int row, int col, f32x4 lo, f32x4 hi, const Pre& p, int foff) const { f.post(row, col, lo, hi, p, u.erow0 >> 8, u.ecol0 >> 8, foff); } };

__device__ __forceinline__ void phase_prologue(const Ctx& c) {
    {
        LAS float* cs = (LAS float*)c.lds;
        LAS float* red = (LAS float*)(c.lds + 65536);
        const float* cin = c.in[IN_C];
        if (c.bid < 192) {
            for (int i = c.tid; i < 16 * 1024; i += NTHR) cs[i] = siluf_(cin[i]);
            __syncthreads();
        }
        float* MOD = (float*)(c.ws + WS_MOD);
        for (int it = c.bid; it < 192; it += c.nblk) {
            const int l = it / 96, cg = it % 96, col = cg * 64 + c.lane;
            const float* W = c.in[IN_ADAW] + (size_t)l * 1024 * 6144 + col;
            float acc[16];
#pragma unroll
            for (int b = 0; b < 16; ++b) acc[b] = 0.f;
            const int kbeg = c.wave * 128;
#pragma unroll 4
            for (int k = kbeg; k < kbeg + 128; k += 4) {
                const float w0 = W[(size_t)k * 6144], w1 = W[(size_t)(k + 1) * 6144], w2 = W[(size_t)(k + 2) * 6144], w3 = W[(size_t)(k + 3) * 6144];
#pragma unroll
                for (int b = 0; b < 16; ++b) { const f32x4 v = *(const LAS f32x4*)(cs + b * 1024 + k); acc[b] += v[0] * w0 + v[1] * w1 + v[2] * w2 + v[3] * w3; }
            }
#pragma unroll
            for (int b = 0; b < 16; ++b) red[(c.wave * 16 + b) * 64 + c.lane] = acc[b];
            __syncthreads();
            for (int i = c.tid; i < 16 * 64; i += NTHR) { const int b = i >> 6, ln = i & 63; float s = 0.f;
#pragma unroll
                for (int w = 0; w < 8; ++w) s += red[(w * 16 + b) * 64 + ln];
                MOD[((size_t)l * 16 + b) * 6144 + cg * 64 + ln] = s + c.in[IN_ADAB][l * 6144 + cg * 64 + ln]; }
            __syncthreads();
        }
        __syncthreads();
    }
    {
        LAS float* scr = (LAS float*)(c.lds + c.wave * 16384);
        const int gw = c.bid * NWAVES + c.wave, NGW = c.nblk * NWAVES;
        constexpr int I_WIN = (NINP / 32) * (1024 / 64), I_UP = (1024 / 32) * (512 / 64), I_WO = (1024 / 32) * (1024 / 64);
        constexpr int PER_L = I_WIN + 3 * I_UP + I_WO;
        for (int it = gw; it < NL * PER_L; it += NGW) {
            const int l = it / PER_L; int r = it % PER_L;
            if (r < I_WIN) { SrcWin s{c.in[IN_WIN] + (size_t)l * 1024 * NIN, NIN}; tr_item(s, (bf16*)(c.ws + WS_WIN) + (size_t)l * NINP * 1024, 1024, (r / 16) * 32, (r % 16) * 64, scr, c.lane); continue; }
            r -= I_WIN;
            if (r < I_UP) { SrcPlain s{c.in[IN_WUPA] + (size_t)l * 512 * 1024, 1024}; tr_item(s, (bf16*)(c.ws + WS_WUPA) + (size_t)l * 1024 * 512, 512, (r / 8) * 32, (r % 8) * 64, scr, c.lane); continue; }
            r -= I_UP;
            if (r < I_UP) { SrcPlain s{c.in[IN_WUPC] + (size_t)l * 512 * 1024, 1024}; tr_item(s, (bf16*)(c.ws + WS_WUPC) + (size_t)l * 1024 * 512, 512, (r / 8) * 32, (r % 8) * 64, scr, c.lane); continue; }
            r -= I_UP;
            if (r < I_UP) { SrcPlain s{c.in[IN_WUPB] + (size_t)l * 512 * 1024, 1024}; tr_item(s, (bf16*)(c.ws + WS_WUPB) + (size_t)l * 1024 * 512, 512, (r / 8) * 32, (r % 8) * 64, scr, c.lane); continue; }
            r -= I_UP;
            { SrcPlain s{c.in[IN_WO] + (size_t)l * 1024 * 1024, 1024}; tr_item(s, (bf16*)(c.ws + WS_WO) + (size_t)l * 1024 * 1024, 1024, (r / 16) * 32, (r % 16) * 64, scr, c.lane); }
        }
    }
    {
        LAS float* uk_s = (LAS float*)c.lds;
        for (int it = (c.bid + 16 >= c.nblk) ? c.bid + 16 - c.nblk : c.bid + 16; it < NL * 8; it += c.nblk) {
            const int l = it >> 3, h = it & 7;
            __syncthreads();
            for (int i = c.tid; i < 128 * 16; i += NTHR) { const int cc = i >> 4, d4 = (i & 15) * 4;
                *(LAS f32x4*)(uk_s + cc * 64 + d4) = *(const f32x4*)(c.in[IN_DSA_WUK] + (size_t)l * 128 * 512 + (size_t)cc * 512 + h * 64 + d4); }
            const int r = c.tid & 255, ch = c.tid >> 8;
            f32x4 uq[16];
            { const float* up = c.in[IN_DSA_WUQ] + (size_t)l * 256 * 512 + (size_t)r * 512 + h * 64;
#pragma unroll
              for (int j = 0; j < 16; ++j) uq[j] = *(const f32x4*)(up + 4 * j); }
            const float sc = c.in[IN_DSA_NQ][l * 256 + r] * (0.125f * 1.4426950408889634f);
            __syncthreads();
            bf16* dst = (bf16*)(c.ws + WS_WQ) + (size_t)l * 1280 * 256 + (size_t)(h * 128 + ch * 64) * 256 + r;
#pragma unroll 2
            for (int cc = 0; cc < 64; ++cc) { const LAS float* kp = uk_s + (ch * 64 + cc) * 64; float acc = 0.f;
#pragma unroll
                for (int j = 0; j < 16; ++j) { const f32x4 kv = *(const LAS f32x4*)(kp + 4 * j); acc += uq[j][0] * kv[0] + uq[j][1] * kv[1] + uq[j][2] * kv[2] + uq[j][3] * kv[3]; }
                dst[(size_t)cc * 256] = (bf16)f2bf(acc * sc); }
        }
        __syncthreads();
    }
    {
        const int gt = c.bid * NTHR + c.tid, NGT = c.nblk * NTHR;
        for (int i = gt; i < T; i += NGT) ((int*)(c.ws + WS_IDENT))[i] = i;
        for (int it = gt; it < NL * 256 * 32; it += NGT) {
            const int l = it / (256 * 32), rem = it % (256 * 32), m = rem / 32, r0 = (rem % 32) * 8;
            const float* gq = c.in[IN_DSA_NQ] + l * 256;
            float o[8];
#pragma unroll
            for (int i = 0; i < 8; ++i) o[i] = c.in[IN_DSA_WQI][(size_t)l * 256 * 256 + (size_t)(r0 + i) * 256 + m] * 0.17677669529663687f * gq[r0 + i];
            u32x4 w; w.x = pk2(o[0], o[1]); w.y = pk2(o[2], o[3]); w.z = pk2(o[4], o[5]); w.w = pk2(o[6], o[7]);
            *(u32x4*)((bf16*)(c.ws + WS_WQ) + (size_t)l * 1280 * 256 + (size_t)(1024 + m) * 256 + r0) = w;
        }
    }
    {
        const int gt = c.bid * NTHR + c.tid, NGT = c.nblk * NTHR;
        for (int it = gt; it < NL * 8 * 4 * 4 * 64; it += NGT) {
            const int ln = it & 63, ks = (it >> 6) & 3, vt = (it >> 8) & 3, h = (it >> 10) & 7, l = it >> 13;
            const int fr = ln & 15, fq = ln >> 4;
            const float* uv = c.in[IN_DSA_WUV] + (size_t)l * 128 * 512 + h * 64 + 16 * vt + fr;
            float o[8];
#pragma unroll
            for (int e = 0; e < 8; ++e) { const int lat = 32 * ks + (e < 4 ? 4 * fq + e : 16 + 4 * fq + e - 4); o[e] = uv[(size_t)lat * 512]; }
            u32x4 w; w.x = pk2(o[0], o[1]); w.y = pk2(o[2], o[3]); w.z = pk2(o[4], o[5]); w.w = pk2(o[6], o[7]);
            *(u32x4*)((bf16*)(c.ws + WS_WUVF) + (size_t)it * 8) = w;
        }
    }
}

__device__ __forceinline__ void norm_mod_row(const float* xrow, const float* gain, const float* sh, const float* sc, bf16* orow, int lane) {
    f32x4 v[4]; float s = 0.f;
#pragma unroll
    for (int j = 0; j < 4; ++j) { v[j] = *(const f32x4*)(xrow + 4 * (lane + 64 * j)); s += v[j][0] * v[j][0] + v[j][1] * v[j][1] + v[j][2] * v[j][2] + v[j][3] * v[j][3]; }
    const float rstd = rsqrtf(wave_sum(s) * (1.f / D) + EPS);
#pragma unroll
    for (int j = 0; j < 4; ++j) { const int cc = 4 * (lane + 64 * j);
        const f32x4 g = *(const f32x4*)(gain + cc), a = *(const f32x4*)(sc + cc), b = *(const f32x4*)(sh + cc);
        st_bf4(orow + cc, v[j] * rstd * g * (a + 1.f) + b); }
}
__device__ __forceinline__ void phase_norm1(const Ctx& c, int l, const float* xsrc) {
    const int gw = c.bid * NWAVES + c.wave, NGW = c.nblk * NWAVES;
    const float* MOD = (const float*)(c.ws + WS_MOD) + (size_t)l * 16 * 6144;
    bf16* XN = (bf16*)(c.ws + WS_XN);
    for (int t = gw; t < T; t += NGW) { const int b = t >> 11;
        norm_mod_row(xsrc + (size_t)t * D, c.in[IN_NMIX] + l * D, MOD + (size_t)b * 6144, MOD + (size_t)b * 6144 + 1024, XN + (size_t)t * D, c.lane); }
}

__device__ __forceinline__ void phase_prep(const Ctx& c, int l) {
    const int gw = c.bid * NWAVES + c.wave, NGW = c.nblk * NWAVES;
    const bf16* PB = (const bf16*)(c.ws + WS_PB); const float* SM = (const float*)(c.ws + WS_SM);
    bf16* CKVN = (bf16*)(c.ws + WS_CKVN); bf16* KIDX = (bf16*)(c.ws + WS_KIDX); float* RSTDQ = (float*)(c.ws + WS_RSTDQ);
    const float* gkv = c.in[IN_DSA_NKV] + l * 128;
    const float g0 = gkv[2 * c.lane], g1 = gkv[2 * c.lane + 1];
    for (int t4 = gw * 4; t4 < T; t4 += NGW * 4) {
        unsigned kv[4]; u32x2 qv[4]; float ki[4];
#pragma unroll
        for (int r = 0; r < 4; ++r) { const bf16* row = PB + (size_t)(t4 + r) * NPB;
            kv[r] = *(const unsigned*)(row + PB_CKV + 2 * c.lane); qv[r] = *(const u32x2*)(row + PB_CQ + 4 * c.lane);
            ki[r] = c.lane < 32 ? SM[(size_t)(t4 + r) * 128 + SM_KIDX + c.lane] : 0.f; }
#pragma unroll
        for (int r = 0; r < 4; ++r) { const int t = t4 + r;
            const float k0 = bflo(kv[r]), k1 = bfhi(kv[r]);
            const float rs = rsqrtf(wave_sum(k0 * k0 + k1 * k1) * (1.f / 128.f) + EPS);
            *(unsigned*)(CKVN + (size_t)t * 128 + 2 * c.lane) = pk2(k0 * rs * g0, k1 * rs * g1);
            const float q0 = bflo(qv[r].x), q1 = bfhi(qv[r].x), q2 = bflo(qv[r].y), q3 = bfhi(qv[r].y);
            const float rq = rsqrtf(wave_sum(q0 * q0 + q1 * q1 + q2 * q2 + q3 * q3) * (1.f / 256.f) + EPS);
            if (c.lane == 0) RSTDQ[t] = rq;
            if (c.lane < 32) KIDX[(size_t)t * 32 + c.lane] = (bf16)f2bf(ki[r]); }
    }
}
__device__ __forceinline__ void phase_ckvt(const Ctx& c) {
    const bf16* CKVN = (const bf16*)(c.ws + WS_CKVN); bf16* CKVT = (bf16*)(c.ws + WS_CKVT);
    LAS bf16* tile = (LAS bf16*)c.lds;
    for (int it = c.bid; it < T / 64; it += c.nblk) {
        const int tb = it * 64, b = tb >> 11, p0 = tb & 2047;
        __syncthreads();
        { const int r = c.tid >> 3, ch = (c.tid & 7) * 8;
          *(LAS u32x4*)(tile + r * 136 + ch) = *(const u32x4*)(CKVN + (size_t)(tb + r) * 128 + ch); *(LAS u32x4*)(tile + r * 136 + 64 + ch) = *(const u32x4*)(CKVN + (size_t)(tb + r) * 128 + 64 + ch); }
        __syncthreads();
        { const int r = c.tid >> 2, part = c.tid & 3;
          unsigned w[8];
#pragma unroll
          for (int j = 0; j < 8; ++j) w[j] = (unsigned)tile[(16 * part + 2 * j) * 136 + r] | ((unsigned)tile[(16 * part + 2 * j + 1) * 136 + r] << 16);
          bf16* dst = CKVT + (((size_t)b * 32 + (p0 >> 6)) * 128 + r) * 64 + 32 * (part >> 1) + 4 * (part & 1);
          *(u32x2*)dst = (u32x2){w[0], w[1]}; *(u32x2*)(dst + 8) = (u32x2){w[2], w[3]}; *(u32x2*)(dst + 16) = (u32x2){w[4], w[5]}; *(u32x2*)(dst + 24) = (u32x2){w[6], w[7]}; }
    }
    __syncthreads();
}

constexpr int TS = 16;
__device__ __forceinline__ void scan_gla_item(const Ctx& c, int l, int b, int h) {
    LAS float* q_s = (LAS float*)c.lds;
    LAS float* k_s = q_s + TS * 64;
    LAS float* a_s = k_s + TS * 64;
    LAS float* v_s = a_s + TS * 64;
    LAS float* part = v_s + TS * 128;
    LAS float* wa2 = part + TS * 4 * 128;
    LAS float* ba = wa2 + 16 * 64;
    LAS float* alr = ba + 64;
    const bf16* PB = (const bf16*)(c.ws + WS_PB); const float* SM = (const float*)(c.ws + WS_SM);
    bf16* UA = (bf16*)(c.ws + WS_UA);
    const float* gn = c.in[IN_GLA_NORM] + l * 512 + h * 128;
    for (int i = c.tid; i < 16 * 64; i += NTHR) wa2[i] = c.in[IN_GLA_WA2][(size_t)l * 16 * 256 + (i >> 6) * 256 + h * 64 + (i & 63)];
    if (c.tid < 64) ba[c.tid] = c.in[IN_GLA_BA][l * 256 + h * 64 + c.tid];
    const int v = c.tid & 127, kg = c.tid >> 7;
    float S[16];
#pragma unroll
    for (int i = 0; i < 16; ++i) S[i] = 0.f;
    for (int t0 = 0; t0 < SEQ; t0 += TS) {
        __syncthreads();
        const size_t rb = (size_t)b * SEQ + t0;
        for (int i = c.tid; i < TS * 64; i += NTHR) { const int s = i >> 6, cc = i & 63; const bf16* row = PB + (rb + s) * NPB;
            q_s[i] = bf2f(row[PB_QA + h * 64 + cc]) * 0.125f; k_s[i] = bf2f(row[PB_KA + h * 64 + cc]); }
        for (int i = c.tid; i < TS * 128; i += NTHR) { const int s = i >> 7, cc = i & 127; v_s[i] = bf2f(PB[(rb + s) * NPB + PB_VA + h * 128 + cc]); }
        if (c.tid < TS * 16) alr[c.tid] = SM[(rb + (c.tid >> 4)) * 128 + SM_ALR + (c.tid & 15)];
        __syncthreads();
        for (int i = c.tid; i < TS * 64; i += NTHR) { const int s = i >> 6, cc = i & 63; float x = ba[cc];
#pragma unroll
            for (int j = 0; j < 16; ++j) x += alr[s * 16 + j] * wa2[j * 64 + cc];
            a_s[i] = __expf(logsigmoidf_(x) * (1.f / 16.f)); }
        __syncthreads();
#pragma unroll 1
        for (int s = 0; s < TS; ++s) {
            const float vv = v_s[s * 128 + v]; float acc = 0.f;
#pragma unroll
            for (int i4 = 0; i4 < 4; ++i4) {
                const f32x4 a4 = *(const LAS f32x4*)(a_s + s * 64 + kg * 16 + i4 * 4), k4 = *(const LAS f32x4*)(k_s + s * 64 + kg * 16 + i4 * 4), q4 = *(const LAS f32x4*)(q_s + s * 64 + kg * 16 + i4 * 4);
#pragma unroll
                for (int j = 0; j < 4; ++j) { S[i4 * 4 + j] = a4[j] * S[i4 * 4 + j] + k4[j] * vv; acc += q4[j] * S[i4 * 4 + j]; }
            }
            part[(s * 4 + kg) * 128 + v] = acc;
        }
        __syncthreads();
        {
            const int s = c.tid >> 5, vq = c.tid & 31, v0 = vq * 4;
            f32x4 o = (f32x4){0.f, 0.f, 0.f, 0.f};
#pragma unroll
            for (int g = 0; g < 4; ++g) o += *(const LAS f32x4*)(part + (s * 4 + g) * 128 + v0);
            float ss = o[0] * o[0] + o[1] * o[1] + o[2] * o[2] + o[3] * o[3];
#pragma unroll
            for (int m = 1; m < 32; m <<= 1) ss += __shfl_xor(ss, m);
            const float rstd = rsqrtf(ss * (1.f / 128.f) + EPS);
            const f32x4 ga = ld_bf4(PB + (rb + s) * NPB + PB_GA + h * 128 + v0);
            f32x4 r;
#pragma unroll
            for (int j = 0; j < 4; ++j) r[j] = o[j] * rstd * gn[v0 + j] * siluf_(ga[j]);
            st_bf4(UA + (rb + s) * 512 + h * 128 + v0, r);
        }
    }
    __syncthreads();
}
__device__ __forceinline__ void scan_mlstm_item(const Ctx& c, int l, int b, int h) {
    LAS float* q_s = (LAS float*)c.lds;
    LAS float* k_s = q_s + TS * 64;
    LAS float* v_s = k_s + TS * 64;
    LAS float* part = v_s + TS * 128;
    LAS float* dpart = part + TS * 4 * 128;
    LAS float* lf_s = dpart + TS * 4;
    LAS float* ip_s = lf_s + TS;
    LAS float* m_s = ip_s + TS;
    LAS float* cw = m_s + TS;
    const bf16* PB = (const bf16*)(c.ws + WS_PB); const float* SM = (const float*)(c.ws + WS_SM);
    bf16* UC = (bf16*)(c.ws + WS_UC);
    const float* mn = c.in[IN_ML_NORM] + l * 512 + h * 128;
    if (c.tid < 4 * 128) { const int j = c.tid >> 7, cc = c.tid & 127; cw[c.tid] = c.in[IN_ML_CONV][(size_t)l * 4 * 512 + j * 512 + (cc < 64 ? h * 64 + cc : 256 + h * 64 + (cc - 64))]; }
    const float bi = c.in[IN_ML_BI][l * 4 + h], bfv = c.in[IN_ML_BF][l * 4 + h];
    const int v = c.tid & 127, kg = c.tid >> 7;
    float C[16], n[16]; float m = 0.f;
#pragma unroll
    for (int i = 0; i < 16; ++i) { C[i] = 0.f; n[i] = 0.f; }
    for (int t0 = 0; t0 < SEQ; t0 += TS) {
        __syncthreads();
        const size_t rb = (size_t)b * SEQ + t0;
        for (int i = c.tid; i < TS * 128; i += NTHR) { const int s = i >> 7, cc = i & 127;
            const int col = cc < 64 ? PB_QC + h * 64 + cc : PB_KC + h * 64 + (cc - 64);
            float x = 0.f;
#pragma unroll
            for (int j = 0; j < 4; ++j) { const int tt = t0 + s - 3 + j; if (tt >= 0) x += cw[j * 128 + cc] * bf2f(PB[((size_t)b * SEQ + tt) * NPB + col]); }
            x = siluf_(x);
            if (cc < 64) q_s[s * 64 + cc] = x * 0.125f; else k_s[s * 64 + (cc - 64)] = x; }
        for (int i = c.tid; i < TS * 128; i += NTHR) { const int s = i >> 7, cc = i & 127; v_s[i] = bf2f(PB[(rb + s) * NPB + PB_VC + h * 128 + cc]); }
        if (c.tid < TS) { ip_s[c.tid] = SM[(rb + c.tid) * 128 + SM_IC + h] + bi; lf_s[c.tid] = logsigmoidf_(SM[(rb + c.tid) * 128 + SM_FC + h] + bfv); }
        __syncthreads();
#pragma unroll 1
        for (int s = 0; s < TS; ++s) {
            const float lf = lf_s[s], ip = ip_s[s];
            const float mnew = fmaxf(lf + m, ip), fg = __expf(lf + m - mnew), ig = __expf(ip - mnew);
            m = mnew;
            const float vv = v_s[s * 128 + v] * ig; float num = 0.f, den = 0.f;
#pragma unroll
            for (int i4 = 0; i4 < 4; ++i4) {
                const f32x4 k4 = *(const LAS f32x4*)(k_s + s * 64 + kg * 16 + i4 * 4), q4 = *(const LAS f32x4*)(q_s + s * 64 + kg * 16 + i4 * 4);
#pragma unroll
                for (int j = 0; j < 4; ++j) { C[i4 * 4 + j] = fg * C[i4 * 4 + j] + k4[j] * vv; n[i4 * 4 + j] = fg * n[i4 * 4 + j] + ig * k4[j]; num += q4[j] * C[i4 * 4 + j]; den += q4[j] * n[i4 * 4 + j]; }
            }
            part[(s * 4 + kg) * 128 + v] = num;
            if (v == 0) dpart[s * 4 + kg] = den;
            if (c.tid == 0) m_s[s] = m;
        }
        __syncthreads();
        {
            const int s = c.tid >> 5, vq = c.tid & 31, v0 = vq * 4;
            f32x4 o = (f32x4){0.f, 0.f, 0.f, 0.f};
#pragma unroll
            for (int g = 0; g < 4; ++g) o += *(const LAS f32x4*)(part + (s * 4 + g) * 128 + v0);
            const float den = dpart[s * 4] + dpart[s * 4 + 1] + dpart[s * 4 + 2] + dpart[s * 4 + 3];
            const float dd = 1.f / fmaxf(fabsf(den), __expf(-m_s[s]));
            o = o * dd;
            float ss = o[0] * o[0] + o[1] * o[1] + o[2] * o[2] + o[3] * o[3];
#pragma unroll
            for (int mm = 1; mm < 32; mm <<= 1) ss += __shfl_xor(ss, mm);
            const float rstd = rsqrtf(ss * (1.f / 128.f) + EPS);
            const f32x4 oc = ld_bf4(PB + (rb + s) * NPB + PB_OC + h * 128 + v0);
            f32x4 r;
#pragma unroll
            for (int j = 0; j < 4; ++j) r[j] = o[j] * rstd * mn[v0 + j] * sigmoidf_(oc[j]);
            st_bf4(UC + (rb + s) * 512 + h * 128 + v0, r);
        }
    }
    __syncthreads();
}

constexpr int LQ = 72;
constexpr int SC_QT = 0, SC_KT = 9216, SC_KTT = 18432, SC_Q2 = 27648, SC_SC = 36864, SC_VT = 46080, SC_ST = 66816, SC_FL = 108288;
__device__ __forceinline__ float wave_scan_add(float x, int lane) {
#pragma unroll
    for (int d = 1; d < 64; d <<= 1) { const float y = __shfl_up(x, d); if (lane >= d) x += y; }
    return x;
}
__device__ __forceinline__ float wave_scan_max(float x, int lane) {
#pragma unroll
    for (int d = 1; d < 64; d <<= 1) { const float y = __shfl_up(x, d); if (lane >= d) x = fmaxf(x, y); }
    return x;
}
__device__ __forceinline__ void unpack8(u32x4 w, float (&f)[8]) { f[0] = bflo(w.x); f[1] = bfhi(w.x); f[2] = bflo(w.y); f[3] = bfhi(w.y); f[4] = bflo(w.z); f[5] = bfhi(w.z); f[6] = bflo(w.w); f[7] = bfhi(w.w); }
__device__ __forceinline__ u32x4 pack8(const float (&f)[8]) { u32x4 w; w.x = pk2(f[0], f[1]); w.y = pk2(f[2], f[3]); w.z = pk2(f[4], f[5]); w.w = pk2(f[6], f[7]); return w; }
template <bool ML>
__device__ __forceinline__ void scan_chunked_item(const Ctx& c, int l, int b, int h) {
    LAS bf16* Qt0 = (LAS bf16*)(c.lds + SC_QT); LAS bf16* Kt0 = (LAS bf16*)(c.lds + SC_KT); LAS bf16* KtT0 = (LAS bf16*)(c.lds + SC_KTT);
    LAS bf16* Q20 = (LAS bf16*)(c.lds + SC_Q2); LAS bf16* Sc0 = (LAS bf16*)(c.lds + SC_SC); LAS bf16* VT0 = (LAS bf16*)(c.lds + SC_VT);
    LAS bf16* ST0 = (LAS bf16*)(c.lds + SC_ST);
    LAS float* segtot = (LAS float*)(c.lds + SC_FL);
    LAS float* etot = segtot + 512;
    LAS float* ssq = etot + 64;
    LAS float* dn = ssq + 512;
    LAS float* wa2 = dn + 64;
    LAS float* ba = wa2 + 1024;
    LAS float* cw = ba + 64;
    const int tid = c.tid, lane = c.lane, w = c.wave, fr = lane & 15, fq = lane >> 4;
    const int srow = tid >> 3, kg = tid & 7, k8 = kg * 8, vrow = tid >> 4, vc8 = (tid & 15) * 8;
    const bf16* PB = (const bf16*)(c.ws + WS_PB); const float* SM = (const float*)(c.ws + WS_SM);
    bf16* UO = (bf16*)(c.ws + (ML ? WS_UC : WS_UA));
    const int QCOL = (ML ? PB_QC : PB_QA) + h * 64, KCOL = (ML ? PB_KC : PB_KA) + h * 64, VCOL = (ML ? PB_VC : PB_VA) + h * 128, GCOL = (ML ? PB_OC : PB_GA) + h * 128;
    const float* gnorm = c.in[ML ? IN_ML_NORM : IN_GLA_NORM] + l * 512 + h * 128;
    __syncthreads();
    if (!ML) { for (int i = tid; i < 1024; i += NTHR) wa2[i] = c.in[IN_GLA_WA2][(size_t)l * 16 * 256 + (i >> 6) * 256 + h * 64 + (i & 63)];
               if (tid < 64) ba[tid] = c.in[IN_GLA_BA][l * 256 + h * 64 + tid]; }
    else { if (tid < 512) { const int j = tid >> 7, cc = tid & 127; cw[tid] = c.in[IN_ML_CONV][(size_t)l * 4 * 512 + j * 512 + (cc < 64 ? h * 64 + cc : 256 + h * 64 + (cc - 64))]; } }
    for (int i = tid; i < 144 * LQ / 2; i += NTHR) ((LAS unsigned*)ST0)[i] = 0u;
    if (ML) { for (int i = tid; i < 16 * LQ; i += NTHR) VT0[128 * LQ + i] = (i < 64) ? (bf16)0x3f80u : (bf16)0u; }
    const float bi = ML ? c.in[IN_ML_BI][l * 4 + h] : 0.f, bfv = ML ? c.in[IN_ML_BF][l * 4 + h] : 0.f;
    float m_prev = 0.f;
    f32x4 Sacc[4], Nacc = (f32x4){0.f, 0.f, 0.f, 0.f};
#pragma unroll
    for (int i = 0; i < 4; ++i) Sacc[i] = (f32x4){0.f, 0.f, 0.f, 0.f};
    u32x4 rq[ML ? 4 : 1], rk[ML ? 4 : 1], rv[2]; f32x4 ra[4]; float ric = 0.f, rfc = 0.f;
    const u32x4 z4 = (u32x4){0u, 0u, 0u, 0u};
#define SC_LOAD(cch) do { const size_t _g = (size_t)b * SEQ + (size_t)(cch) * 64; \
        if (ML) { _Pragma("unroll") for (int _j = 0; _j < 4; ++_j) { const int _tt = (cch) * 64 + srow - 3 + _j; \
                rq[_j] = _tt >= 0 ? *(const u32x4*)(PB + ((size_t)b * SEQ + _tt) * NPB + QCOL + k8) : z4; rk[_j] = _tt >= 0 ? *(const u32x4*)(PB + ((size_t)b * SEQ + _tt) * NPB + KCOL + k8) : z4; } \
            ric = SM[(_g + lane) * 128 + SM_IC + h]; rfc = SM[(_g + lane) * 128 + SM_FC + h]; } \
        else { rq[0] = *(const u32x4*)(PB + (_g + srow) * NPB + QCOL + k8); rk[0] = *(const u32x4*)(PB + (_g + srow) * NPB + KCOL + k8); \
            _Pragma("unroll") for (int _j = 0; _j < 4; ++_j) ra[_j] = *(const f32x4*)(SM + (_g + srow) * 128 + SM_ALR + 4 * _j); } \
        rv[0] = *(const u32x4*)(PB + (_g + vrow) * NPB + VCOL + vc8); rv[1] = *(const u32x4*)(PB + (_g + 32 + vrow) * NPB + VCOL + vc8); } while (0)
    SC_LOAD(0);
    __syncthreads();
#pragma unroll 1
    for (int cch = 0; cch < SEQ / 64; ++cch) {
        const size_t grow = (size_t)b * SEQ + (size_t)cch * 64;
        int lz; asm volatile("v_mov_b32 %0, 0" : "=v"(lz));
        LAS bf16* Qt = Qt0 + lz; LAS bf16* Kt = Kt0 + lz; LAS bf16* KtT = KtT0 + lz; LAS bf16* Q2 = Q20 + lz; LAS bf16* Sc = Sc0 + lz; LAS bf16* VT = VT0 + lz; LAS bf16* ST = ST0 + lz;
        LAS bf16* STc = ST + (cch & 1) * 144 * LQ; LAS bf16* STn = ST + ((cch & 1) ^ 1) * 144 * LQ;
        float qv[8], kv[8];
        float g_a = 0.f, g_M = 0.f, g_bc = 0.f, M63 = 0.f, wc = 1.f;
        if (!ML) {
            unpack8(rq[0], qv); unpack8(rk[0], kv);
            float la[8];
#pragma unroll
            for (int i = 0; i < 8; ++i) la[i] = ba[k8 + i];
#pragma unroll
            for (int j4 = 0; j4 < 4; ++j4)
#pragma unroll
                for (int jj = 0; jj < 4; ++jj) { const float a = ra[j4][jj]; const LAS float* wr_ = wa2 + (j4 * 4 + jj) * 64 + k8;
                    const f32x4 w0 = *(const LAS f32x4*)wr_, w1 = *(const LAS f32x4*)(wr_ + 4);
                    la[0] += a * w0[0]; la[1] += a * w0[1]; la[2] += a * w0[2]; la[3] += a * w0[3]; la[4] += a * w1[0]; la[5] += a * w1[1]; la[6] += a * w1[2]; la[7] += a * w1[3]; }
#pragma unroll
            for (int i = 0; i < 8; ++i) { float x = logsigmoid_fast(la[i]) * (1.f / 16.f);
#pragma unroll
                for (int d = 8; d < 64; d <<= 1) { const float y = __shfl_up(x, d); if (lane >= d) x += y; }
                la[i] = x; }
            if ((lane >> 3) == 7) { *(LAS f32x4*)(segtot + w * 64 + k8) = (f32x4){la[0], la[1], la[2], la[3]}; *(LAS f32x4*)(segtot + w * 64 + k8 + 4) = (f32x4){la[4], la[5], la[6], la[7]}; }
            lds_barrier();
            float tot[8];
#pragma unroll
            for (int i = 0; i < 8; ++i) tot[i] = 0.f;
#pragma unroll
            for (int ww = 0; ww < 8; ++ww) { const f32x4 s0 = *(const LAS f32x4*)(segtot + ww * 64 + k8), s1 = *(const LAS f32x4*)(segtot + ww * 64 + k8 + 4);
                const float sel = ww < w ? 1.f : 0.f;
                la[0] += sel * s0[0]; la[1] += sel * s0[1]; la[2] += sel * s0[2]; la[3] += sel * s0[3]; la[4] += sel * s1[0]; la[5] += sel * s1[1]; la[6] += sel * s1[2]; la[7] += sel * s1[3];
                tot[0] += s0[0]; tot[1] += s0[1]; tot[2] += s0[2]; tot[3] += s0[3]; tot[4] += s1[0]; tot[5] += s1[1]; tot[6] += s1[2]; tot[7] += s1[3]; }
            if (tid < 8) {
#pragma unroll
                for (int i = 0; i < 8; ++i) etot[k8 + i] = __expf(tot[i]); }
            float kt[8];
#pragma unroll
            for (int i = 0; i < 8; ++i) { qv[i] = qv[i] * 0.125f * __expf(la[i]); kt[i] = kv[i] * __expf(-la[i]); }
            *(LAS u32x4*)(Qt + srow * LQ + k8) = pack8(qv); *(LAS u32x4*)(Kt + srow * LQ + k8) = pack8(kt);
#pragma unroll
            for (int i = 0; i < 8; ++i) KtT[(k8 + i) * LQ + srow] = (bf16)f2bf(kt[i]);
        } else {
            float x4[4][8];
#pragma unroll
            for (int j = 0; j < 4; ++j) unpack8(rq[j], x4[j]);
#pragma unroll
            for (int i = 0; i < 8; ++i) { float x = 0.f;
#pragma unroll
                for (int j = 0; j < 4; ++j) x += cw[j * 128 + k8 + i] * x4[j][i];
                qv[i] = siluf_(x) * 0.125f; }
#pragma unroll
            for (int j = 0; j < 4; ++j) unpack8(rk[j], x4[j]);
#pragma unroll
            for (int i = 0; i < 8; ++i) { float x = 0.f;
#pragma unroll
                for (int j = 0; j < 4; ++j) x += cw[j * 128 + 64 + k8 + i] * x4[j][i];
                kv[i] = siluf_(x); }
            const float lf = logsigmoid_fast(rfc + bfv), ip = ric + bi;
            g_bc = wave_scan_add(lf, lane); g_a = ip - g_bc;
            const float pm = wave_scan_max(g_a, lane); g_M = fmaxf(m_prev, pm);
            M63 = __shfl(g_M, 63); const float totb = __shfl(g_bc, 63);
            wc = __expf(m_prev - M63);
            const float Ms = __shfl(g_M, srow), as = __shfl(g_a, srow);
            const float e1 = __expf(m_prev - Ms), e2 = __expf(as - M63);
            float q2[8], kw[8];
#pragma unroll
            for (int i = 0; i < 8; ++i) { q2[i] = qv[i] * e1; kw[i] = kv[i] * e2; }
            *(LAS u32x4*)(Qt + srow * LQ + k8) = pack8(qv); *(LAS u32x4*)(Kt + srow * LQ + k8) = pack8(kv); *(LAS u32x4*)(Q2 + srow * LQ + k8) = pack8(q2);
#pragma unroll
            for (int i = 0; i < 8; ++i) KtT[(k8 + i) * LQ + srow] = (bf16)f2bf(kw[i]);
            m_prev = totb + M63;
        }
        { float v0[8], v1[8]; unpack8(rv[0], v0); unpack8(rv[1], v1);
#pragma unroll
          for (int i = 0; i < 8; ++i) { VT[(vc8 + i) * LQ + vrow] = (bf16)f2bf(v0[i]); VT[(vc8 + i) * LQ + 32 + vrow] = (bf16)f2bf(v1[i]); } }
        u32x2 gate[4];
#pragma unroll
        for (int ti = 0; ti < 4; ++ti) gate[ti] = *(const u32x2*)(PB + (grow + 16 * ti + fr) * NPB + GCOL + 16 * w + 4 * fq);
        if (cch + 1 < SEQ / 64) SC_LOAD(cch + 1);
        lds_barrier();
        {
            const int ti = w >> 1;
#pragma unroll
            for (int u = 0; u < 2; ++u) {
                const int sj = 2 * (w & 1) + u;
                f32x4 d = (f32x4){0.f, 0.f, 0.f, 0.f};
                if (sj <= ti) {
#pragma unroll
                    for (int ks = 0; ks < 2; ++ks) { const bf16x8 a = *(const LAS bf16x8*)(Kt + (16 * sj + fr) * LQ + 32 * ks + 8 * fq), bb = *(const LAS bf16x8*)(Qt + (16 * ti + fr) * LQ + 32 * ks + 8 * fq);
                        d = __builtin_amdgcn_mfma_f32_16x16x32_bf16(a, bb, d, 0, 0, 0); }
                    const int t = 16 * ti + fr, s0 = 16 * sj + 4 * fq;
                    if (ML) { const float Mt = __shfl(g_M, t);
#pragma unroll
                        for (int r = 0; r < 4; ++r) { const float as = __shfl(g_a, s0 + r); d[r] = (s0 + r <= t) ? d[r] * __expf(as - Mt) : 0.f; } }
                    else {
#pragma unroll
                        for (int r = 0; r < 4; ++r) d[r] = (s0 + r <= t) ? d[r] : 0.f; }
                }
                { u32x2 pk; pk.x = pk2(d[0], d[1]); pk.y = pk2(d[2], d[3]); *(LAS u32x2*)(Sc + (16 * ti + fr) * LQ + 16 * sj + 4 * fq) = pk; }
            }
        }
        lds_barrier();
        const LAS bf16* Qm = ML ? Q2 : Qt;
        f32x4 o[4];
        {
            bf16x8 vt[2], stf[2];
#pragma unroll
            for (int ks = 0; ks < 2; ++ks) { vt[ks] = *(const LAS bf16x8*)(VT + (16 * w + fr) * LQ + 32 * ks + 8 * fq); stf[ks] = *(const LAS bf16x8*)(STc + (16 * w + fr) * LQ + 32 * ks + 8 * fq); }
#pragma unroll
            for (int ti = 0; ti < 4; ++ti) {
                f32x4 d = (f32x4){0.f, 0.f, 0.f, 0.f};
#pragma unroll
                for (int ks = 0; ks < 2; ++ks) { const bf16x8 sc = *(const LAS bf16x8*)(Sc + (16 * ti + fr) * LQ + 32 * ks + 8 * fq); d = __builtin_amdgcn_mfma_f32_16x16x32_bf16(vt[ks], sc, d, 0, 0, 0); }
#pragma unroll
                for (int ks = 0; ks < 2; ++ks) { const bf16x8 qq = *(const LAS bf16x8*)(Qm + (16 * ti + fr) * LQ + 32 * ks + 8 * fq); d = __builtin_amdgcn_mfma_f32_16x16x32_bf16(stf[ks], qq, d, 0, 0, 0); }
                o[ti] = d;
            }
#pragma unroll
            for (int kj = 0; kj < 4; ++kj) {
                f32x4 d = (f32x4){0.f, 0.f, 0.f, 0.f};
#pragma unroll
                for (int ks = 0; ks < 2; ++ks) { const bf16x8 kk = *(const LAS bf16x8*)(KtT + (16 * kj + fr) * LQ + 32 * ks + 8 * fq); d = __builtin_amdgcn_mfma_f32_16x16x32_bf16(kk, vt[ks], d, 0, 0, 0); }
                if (ML) Sacc[kj] = Sacc[kj] * wc + d;
                else { const f32x4 e4 = *(const LAS f32x4*)(etot + 16 * kj + 4 * fq); Sacc[kj] = e4 * (Sacc[kj] + d); }
                u32x2 pk; pk.x = pk2(Sacc[kj][0], Sacc[kj][1]); pk.y = pk2(Sacc[kj][2], Sacc[kj][3]);
                *(LAS u32x2*)(STn + (16 * w + fr) * LQ + 16 * kj + 4 * fq) = pk;
            }
            if (ML) {
                if (w < 4) {
                    f32x4 d = (f32x4){0.f, 0.f, 0.f, 0.f};
#pragma unroll
                    for (int ks = 0; ks < 2; ++ks) { const bf16x8 a = *(const LAS bf16x8*)(VT + (128 + fr) * LQ + 32 * ks + 8 * fq), sc = *(const LAS bf16x8*)(Sc + (16 * w + fr) * LQ + 32 * ks + 8 * fq);
                        d = __builtin_amdgcn_mfma_f32_16x16x32_bf16(a, sc, d, 0, 0, 0); }
#pragma unroll
                    for (int ks = 0; ks < 2; ++ks) { const bf16x8 a = *(const LAS bf16x8*)(STc + (128 + fr) * LQ + 32 * ks + 8 * fq), qq = *(const LAS bf16x8*)(Qm + (16 * w + fr) * LQ + 32 * ks + 8 * fq);
                        d = __builtin_amdgcn_mfma_f32_16x16x32_bf16(a, qq, d, 0, 0, 0); }
                    if (fq == 0) dn[16 * w + fr] = d[0];
                } else {
                    const int kj = w - 4;
                    f32x4 d = (f32x4){0.f, 0.f, 0.f, 0.f};
#pragma unroll
                    for (int ks = 0; ks < 2; ++ks) { const bf16x8 kk = *(const LAS bf16x8*)(KtT + (16 * kj + fr) * LQ + 32 * ks + 8 * fq), a = *(const LAS bf16x8*)(VT + (128 + fr) * LQ + 32 * ks + 8 * fq);
                        d = __builtin_amdgcn_mfma_f32_16x16x32_bf16(kk, a, d, 0, 0, 0); }
                    Nacc = Nacc * wc + d;
                    u32x2 pk; pk.x = pk2(Nacc[0], Nacc[1]); pk.y = pk2(Nacc[2], Nacc[3]);
                    *(LAS u32x2*)(STn + (128 + fr) * LQ + 16 * kj + 4 * fq) = pk;
                }
            }
        }
#pragma unroll
        for (int ti = 0; ti < 4; ++ti) { float p = o[ti][0] * o[ti][0] + o[ti][1] * o[ti][1] + o[ti][2] * o[ti][2] + o[ti][3] * o[ti][3];
            p += __shfl_xor(p, 16); p += __shfl_xor(p, 32);
            if (fq == 0) ssq[w * 64 + 16 * ti + fr] = p; }
        lds_barrier();
#pragma unroll
        for (int ti = 0; ti < 4; ++ti) {
            const int t = 16 * ti + fr;
            float ss = 0.f;
#pragma unroll
            for (int ww = 0; ww < 8; ++ww) ss += ssq[ww * 64 + t];
            float dd = 1.f;
            if (ML) { const float bc = __shfl(g_bc, t), Mt = __shfl(g_M, t); dd = 1.f / fmaxf(fabsf(dn[t]), __expf(-(bc + Mt))); }
            const float rstd = rsqrtf(ss * dd * dd * (1.f / 128.f) + EPS) * dd;
            const f32x4 gn = *(const f32x4*)(gnorm + 16 * w + 4 * fq);
            const float g0 = bflo(gate[ti].x), g1 = bfhi(gate[ti].x), g2 = bflo(gate[ti].y), g3 = bfhi(gate[ti].y);
            f32x4 r;
            if (ML) { r[0] = o[ti][0] * rstd * gn[0] * sigmoidf_(g0); r[1] = o[ti][1] * rstd * gn[1] * sigmoidf_(g1); r[2] = o[ti][2] * rstd * gn[2] * sigmoidf_(g2); r[3] = o[ti][3] * rstd * gn[3] * sigmoidf_(g3); }
            else { r[0] = o[ti][0] * rstd * gn[0] * siluf_(g0); r[1] = o[ti][1] * rstd * gn[1] * siluf_(g1); r[2] = o[ti][2] * rstd * gn[2] * siluf_(g2); r[3] = o[ti][3] * rstd * gn[3] * siluf_(g3); }
            st_bf4(UO + (grow + t) * 512 + h * 128 + 16 * w + 4 * fq, r);
        }
    }
#undef SC_LOAD
    __syncthreads();
}

template <bool ML>
__device__ __forceinline__ void scanA_loop(const Ctx& c, int l, int it0, int it_end, int stride) {
    LAS bf16* Qt0 = (LAS bf16*)(c.lds + SC_QT); LAS bf16* Kt0 = (LAS bf16*)(c.lds + SC_KT); LAS bf16* KtT0 = (LAS bf16*)(c.lds + SC_KTT);
    LAS bf16* Sc0 = (LAS bf16*)(c.lds + SC_SC); LAS bf16* VT0 = (LAS bf16*)(c.lds + SC_VT);
    LAS float* segtot = (LAS float*)(c.lds + SC_FL);
    LAS float* wa2 = segtot + 512 + 64 + 512 + 64;
    LAS float* ba = wa2 + 1024;
    LAS float* cw = ba + 64;
    const int tid = c.tid, lane = c.lane, w = c.wave, fr = lane & 15, fq = lane >> 4;
    const int srow = tid >> 3, kg = tid & 7, k8 = kg * 8, vrow = tid >> 4, vc8 = (tid & 15) * 8;
    const bf16* PB = (const bf16*)(c.ws + WS_PB); const float* SM = (const float*)(c.ws + WS_SM);
    bf16* UO = (bf16*)(c.ws + (ML ? WS_UC : WS_UA));
    bf16* QS = (bf16*)(c.ws + WS_QS) + (ML ? (size_t)T * 256 : 0);
    u32x4 rq[ML ? 4 : 1], rk[ML ? 4 : 1], rv[2]; f32x4 ra[4]; float ric = 0.f, rfc = 0.f;
    const u32x4 z4 = (u32x4){0u, 0u, 0u, 0u};
#define SA_LOAD(it_) do { const int _rem = (it_) & 2047, _seq = _rem >> 5, _cch = _rem & 31, _b = _seq >> 2, _h = _seq & 3; \
        const size_t _g = (size_t)_b * SEQ + (size_t)_cch * 64; \
        const int _qc = (ML ? PB_QC : PB_QA) + _h * 64, _kc = (ML ? PB_KC : PB_KA) + _h * 64, _vc = (ML ? PB_VC : PB_VA) + _h * 128; \
        if (ML) { _Pragma("unroll") for (int _j = 0; _j < 4; ++_j) { const int _tt = _cch * 64 + srow - 3 + _j; \
                rq[_j] = _tt >= 0 ? *(const u32x4*)(PB + ((size_t)_b * SEQ + _tt) * NPB + _qc + k8) : z4; rk[_j] = _tt >= 0 ? *(const u32x4*)(PB + ((size_t)_b * SEQ + _tt) * NPB + _kc + k8) : z4; } \
            ric = SM[(_g + lane) * 128 + SM_IC + _h]; rfc = SM[(_g + lane) * 128 + SM_FC + _h]; } \
        else { rq[0] = *(const u32x4*)(PB + (_g + srow) * NPB + _qc + k8); rk[0] = *(const u32x4*)(PB + (_g + srow) * NPB + _kc + k8); \
            _Pragma("unroll") for (int _j = 0; _j < 4; ++_j) ra[_j] = *(const f32x4*)(SM + (_g + srow) * 128 + SM_ALR + 4 * _j); } \
        rv[0] = *(const u32x4*)(PB + (_g + vrow) * NPB + _vc + vc8); rv[1] = *(const u32x4*)(PB + (_g + 32 + vrow) * NPB + _vc + vc8); } while (0)
    if (it0 < it_end) SA_LOAD(it0);
    int hprev = -1;
#pragma unroll 1
    for (int it = it0; it < it_end; it += stride) {
    const int rem_ = it & 2047, seq_ = rem_ >> 5, cch = rem_ & 31, b = seq_ >> 2, h = seq_ & 3;
    const int slot = (b * 4 + h) * 32 + cch;
    bf16* DS = ML ? (bf16*)(c.ws + WS_DSM) + (size_t)slot * 144 * 64 : (bf16*)(c.ws + WS_DSG) + (size_t)slot * 128 * 64;
    const size_t grow = (size_t)b * SEQ + (size_t)cch * 64;
    int lz; asm volatile("v_mov_b32 %0, 0" : "=v"(lz));
    LAS bf16* Qt = Qt0 + lz; LAS bf16* Kt = Kt0 + lz; LAS bf16* KtT = KtT0 + lz; LAS bf16* Sc = Sc0 + lz; LAS bf16* VT = VT0 + lz;
    __syncthreads();
    if (h != hprev) {
        if (!ML) { for (int i = tid; i < 1024; i += NTHR) wa2[i] = c.in[IN_GLA_WA2][(size_t)l * 16 * 256 + (i >> 6) * 256 + h * 64 + (i & 63)];
                   if (tid < 64) ba[tid] = c.in[IN_GLA_BA][l * 256 + h * 64 + tid]; }
        else { { const int j = tid >> 7, cc = tid & 127; cw[tid] = c.in[IN_ML_CONV][(size_t)l * 4 * 512 + j * 512 + (cc < 64 ? h * 64 + cc : 256 + h * 64 + (cc - 64))]; }
               for (int i = tid; i < 16 * LQ; i += NTHR) VT[128 * LQ + i] = (i < 64) ? (bf16)0x3f80u : (bf16)0u; }
        hprev = h;
        __syncthreads();
    }
    const float bi = ML ? c.in[IN_ML_BI][l * 4 + h] : 0.f, bfv = ML ? c.in[IN_ML_BF][l * 4 + h] : 0.f;
    float qv[8], kv[8];
    float g_a = 0.f, g_pm = 0.f;
    if (!ML) {
        unpack8(rq[0], qv); unpack8(rk[0], kv);
        float la[8];
#pragma unroll
        for (int i = 0; i < 8; ++i) la[i] = ba[k8 + i];
#pragma unroll
        for (int j4 = 0; j4 < 4; ++j4)
#pragma unroll
            for (int jj = 0; jj < 4; ++jj) { const float a = ra[j4][jj]; const LAS float* wr_ = wa2 + (j4 * 4 + jj) * 64 + k8;
                const f32x4 w0 = *(const LAS f32x4*)wr_, w1 = *(const LAS f32x4*)(wr_ + 4);
                la[0] += a * w0[0]; la[1] += a * w0[1]; la[2] += a * w0[2]; la[3] += a * w0[3]; la[4] += a * w1[0]; la[5] += a * w1[1]; la[6] += a * w1[2]; la[7] += a * w1[3]; }
#pragma unroll
        for (int i = 0; i < 8; ++i) { float x = logsigmoid_fast(la[i]) * (1.f / 16.f);
#pragma unroll
            for (int d = 8; d < 64; d <<= 1) { const float y = __shfl_up(x, d); if (lane >= d) x += y; }
            la[i] = x; }
        if ((lane >> 3) == 7) { *(LAS f32x4*)(segtot + w * 64 + k8) = (f32x4){la[0], la[1], la[2], la[3]}; *(LAS f32x4*)(segtot + w * 64 + k8 + 4) = (f32x4){la[4], la[5], la[6], la[7]}; }
        lds_barrier();
        float tot[8];
#pragma unroll
        for (int i = 0; i < 8; ++i) tot[i] = 0.f;
#pragma unroll
        for (int ww = 0; ww < 8; ++ww) { const f32x4 s0 = *(const LAS f32x4*)(segtot + ww * 64 + k8), s1 = *(const LAS f32x4*)(segtot + ww * 64 + k8 + 4);
            const float sel = ww < w ? 1.f : 0.f;
            la[0] += sel * s0[0]; la[1] += sel * s0[1]; la[2] += sel * s0[2]; la[3] += sel * s0[3]; la[4] += sel * s1[0]; la[5] += sel * s1[1]; la[6] += sel * s1[2]; la[7] += sel * s1[3];
            tot[0] += s0[0]; tot[1] += s0[1]; tot[2] += s0[2]; tot[3] += s0[3]; tot[4] += s1[0]; tot[5] += s1[1]; tot[6] += s1[2]; tot[7] += s1[3]; }
        if (tid < 8) { float* et = (float*)(c.ws + WS_ET) + (size_t)slot * 64 + k8;
            *(f32x4*)et = (f32x4){__expf(tot[0]), __expf(tot[1]), __expf(tot[2]), __expf(tot[3])}; *(f32x4*)(et + 4) = (f32x4){__expf(tot[4]), __expf(tot[5]), __expf(tot[6]), __expf(tot[7])}; }
        float kt[8];
#pragma unroll
        for (int i = 0; i < 8; ++i) { qv[i] = qv[i] * 0.125f * __expf(la[i]); kt[i] = kv[i] * __expf(-la[i]); }
        const u32x4 qp = pack8(qv);
        *(LAS u32x4*)(Qt + srow * LQ + k8) = qp; *(LAS u32x4*)(Kt + srow * LQ + k8) = pack8(kt);
        *(u32x4*)(QS + (grow + srow) * 256 + h * 64 + k8) = qp;
#pragma unroll
        for (int i = 0; i < 8; ++i) KtT[(k8 + i) * LQ + srow] = (bf16)f2bf(kt[i]);
    } else {
        float x4[4][8];
#pragma unroll
        for (int j = 0; j < 4; ++j) unpack8(rq[j], x4[j]);
#pragma unroll
        for (int i = 0; i < 8; ++i) { float x = 0.f;
#pragma unroll
            for (int j = 0; j < 4; ++j) x += cw[j * 128 + k8 + i] * x4[j][i];
            qv[i] = siluf_(x) * 0.125f; }
#pragma unroll
        for (int j = 0; j < 4; ++j) unpack8(rk[j], x4[j]);
#pragma unroll
        for (int i = 0; i < 8; ++i) { float x = 0.f;
#pragma unroll
            for (int j = 0; j < 4; ++j) x += cw[j * 128 + 64 + k8 + i] * x4[j][i];
            kv[i] = siluf_(x); }
        const float lf = logsigmoid_fast(rfc + bfv), ip = ric + bi;
        const float g_bc = wave_scan_add(lf, lane); g_a = ip - g_bc;
        g_pm = wave_scan_max(g_a, lane);
        const float pm63 = __shfl(g_pm, 63), totb = __shfl(g_bc, 63);
        if (w == 0) { ((float*)(c.ws + WS_GPM))[(grow + lane) * 4 + h] = g_pm; ((float*)(c.ws + WS_GBC))[(grow + lane) * 4 + h] = g_bc;
            if (lane == 0) { float* ct = (float*)(c.ws + WS_CT) + (size_t)slot * 2; ct[0] = totb; ct[1] = pm63; } }
        const float as = __shfl(g_a, srow);
        const float e2 = __expf(as - pm63);
        float kw[8];
#pragma unroll
        for (int i = 0; i < 8; ++i) kw[i] = kv[i] * e2;
        const u32x4 qp = pack8(qv);
        *(LAS u32x4*)(Qt + srow * LQ + k8) = qp; *(LAS u32x4*)(Kt + srow * LQ + k8) = pack8(kv);
        *(u32x4*)(QS + (grow + srow) * 256 + h * 64 + k8) = qp;
#pragma unroll
        for (int i = 0; i < 8; ++i) KtT[(k8 + i) * LQ + srow] = (bf16)f2bf(kw[i]);
    }
    { float v0[8], v1[8]; unpack8(rv[0], v0); unpack8(rv[1], v1);
#pragma unroll
      for (int i = 0; i < 8; ++i) { VT[(vc8 + i) * LQ + vrow] = (bf16)f2bf(v0[i]); VT[(vc8 + i) * LQ + 32 + vrow] = (bf16)f2bf(v1[i]); } }
    if (it + stride < it_end) SA_LOAD(it + stride);
    lds_barrier();
    {
        const int ti = w >> 1;
#pragma unroll
        for (int u = 0; u < 2; ++u) {
            const int sj = 2 * (w & 1) + u;
            f32x4 d = (f32x4){0.f, 0.f, 0.f, 0.f};
            if (sj <= ti) {
#pragma unroll
                for (int ks = 0; ks < 2; ++ks) { const bf16x8 a = *(const LAS bf16x8*)(Kt + (16 * sj + fr) * LQ + 32 * ks + 8 * fq), bb = *(const LAS bf16x8*)(Qt + (16 * ti + fr) * LQ + 32 * ks + 8 * fq);
                    d = __builtin_amdgcn_mfma_f32_16x16x32_bf16(a, bb, d, 0, 0, 0); }
                const int t = 16 * ti + fr, s0 = 16 * sj + 4 * fq;
                if (ML) { const float pt = __shfl(g_pm, t);
#pragma unroll
                    for (int r = 0; r < 4; ++r) { const float as = __shfl(g_a, s0 + r); d[r] = (s0 + r <= t) ? d[r] * __expf(as - pt) : 0.f; } }
                else {
#pragma unroll
                    for (int r = 0; r < 4; ++r) d[r] = (s0 + r <= t) ? d[r] : 0.f; }
            }
            { u32x2 pk; pk.x = pk2(d[0], d[1]); pk.y = pk2(d[2], d[3]); *(LAS u32x2*)(Sc + (16 * ti + fr) * LQ + 16 * sj + 4 * fq) = pk; }
        }
    }
    lds_barrier();
    {
        bf16x8 vt[2];
#pragma unroll
        for (int ks = 0; ks < 2; ++ks) vt[ks] = *(const LAS bf16x8*)(VT + (16 * w + fr) * LQ + 32 * ks + 8 * fq);
#pragma unroll
        for (int ti = 0; ti < 4; ++ti) {
            f32x4 d = (f32x4){0.f, 0.f, 0.f, 0.f};
#pragma unroll
            for (int ks = 0; ks < 2; ++ks) { const bf16x8 sc = *(const LAS bf16x8*)(Sc + (16 * ti + fr) * LQ + 32 * ks + 8 * fq); d = __builtin_amdgcn_mfma_f32_16x16x32_bf16(vt[ks], sc, d, 0, 0, 0); }
            st_bf4(UO + (grow + 16 * ti + fr) * 512 + h * 128 + 16 * w + 4 * fq, d);
        }
#pragma unroll
        for (int kj = 0; kj < 4; ++kj) {
            f32x4 d = (f32x4){0.f, 0.f, 0.f, 0.f};
#pragma unroll
            for (int ks = 0; ks < 2; ++ks) { const bf16x8 kk = *(const LAS bf16x8*)(KtT + (16 * kj + fr) * LQ + 32 * ks + 8 * fq); d = __builtin_amdgcn_mfma_f32_16x16x32_bf16(kk, vt[ks], d, 0, 0, 0); }
            st_bf4(DS + (16 * w + fr) * 64 + 16 * kj + 4 * fq, d);
        }
        if (ML) {
            if (w < 4) {
                f32x4 d = (f32x4){0.f, 0.f, 0.f, 0.f};
#pragma unroll
                for (int ks = 0; ks < 2; ++ks) { const bf16x8 a = *(const LAS bf16x8*)(VT + (128 + fr) * LQ + 32 * ks + 8 * fq), sc = *(const LAS bf16x8*)(Sc + (16 * w + fr) * LQ + 32 * ks + 8 * fq);
                    d = __builtin_amdgcn_mfma_f32_16x16x32_bf16(a, sc, d, 0, 0, 0); }
                if (fq == 0) ((float*)(c.ws + WS_DN))[(grow + 16 * w + fr) * 4 + h] = d[0];
            } else {
                const int kj = w - 4;
                f32x4 d = (f32x4){0.f, 0.f, 0.f, 0.f};
#pragma unroll
                for (int ks = 0; ks < 2; ++ks) { const bf16x8 kk = *(const LAS bf16x8*)(KtT + (16 * kj + fr) * LQ + 32 * ks + 8 * fq), a = *(const LAS bf16x8*)(VT + (128 + fr) * LQ + 32 * ks + 8 * fq);
                    d = __builtin_amdgcn_mfma_f32_16x16x32_bf16(kk, a, d, 0, 0, 0); }
                st_bf4(DS + (128 + fr) * 64 + 16 * kj + 4 * fq, d);
            }
        }
    }
    }
#undef SA_LOAD
}
__device__ __forceinline__ void scanB(const Ctx& c) {
    const int gt = c.bid * NTHR + c.tid, NGT = c.nblk * NTHR;
    constexpr int NG = 64 * 128 * 8, NM = 64 * 128 * 8;
    for (int idx = gt; idx < NG + NM; idx += NGT) {
        float S[8];
#pragma unroll
        for (int i = 0; i < 8; ++i) S[i] = 0.f;
        if (idx < NG) {
            const int seq = idx >> 10, v = (idx >> 3) & 127, kg = idx & 7;
            bf16* p = (bf16*)(c.ws + WS_DSG) + (size_t)seq * 32 * 8192 + v * 64 + kg * 8;
            const float* et = (const float*)(c.ws + WS_ET) + (size_t)seq * 32 * 64 + kg * 8;
#pragma unroll 1
            for (int c4 = 0; c4 < 32; c4 += 4) {
                u32x4 dv[4]; f32x4 e0[4], e1[4];
#pragma unroll
                for (int j = 0; j < 4; ++j) { dv[j] = *(const u32x4*)(p + (size_t)(c4 + j) * 8192); e0[j] = *(const f32x4*)(et + (c4 + j) * 64); e1[j] = *(const f32x4*)(et + (c4 + j) * 64 + 4); }
#pragma unroll
                for (int j = 0; j < 4; ++j) {
                    float d[8]; unpack8(dv[j], d);
                    const u32x4 sp = pack8(S);
                    S[0] = e0[j][0] * (S[0] + d[0]); S[1] = e0[j][1] * (S[1] + d[1]); S[2] = e0[j][2] * (S[2] + d[2]); S[3] = e0[j][3] * (S[3] + d[3]);
                    S[4] = e1[j][0] * (S[4] + d[4]); S[5] = e1[j][1] * (S[5] + d[5]); S[6] = e1[j][2] * (S[6] + d[6]); S[7] = e1[j][3] * (S[7] + d[7]);
                    *(u32x4*)(p + (size_t)(c4 + j) * 8192) = sp;
                }
            }
        } else {
            const int j0 = idx - NG, seq = j0 >> 10, v = (j0 >> 3) & 127, kg = j0 & 7;
            const bool nrow = v == 0;
            bf16* p = (bf16*)(c.ws + WS_DSM) + (size_t)seq * 32 * 9216 + v * 64 + kg * 8;
            bf16* pn = (bf16*)(c.ws + WS_DSM) + (size_t)seq * 32 * 9216 + 128 * 64 + kg * 8;
            const float* ct = (const float*)(c.ws + WS_CT) + (size_t)seq * 32 * 2;
            float* mp = (float*)(c.ws + WS_MP) + (size_t)seq * 32;
            float m = 0.f, N[8];
#pragma unroll
            for (int i = 0; i < 8; ++i) N[i] = 0.f;
#pragma unroll 1
            for (int c4 = 0; c4 < 32; c4 += 4) {
                u32x4 dv[4], nv[4]; f32x2 cc[4];
#pragma unroll
                for (int j = 0; j < 4; ++j) { dv[j] = *(const u32x4*)(p + (size_t)(c4 + j) * 9216); cc[j] = *(const f32x2*)(ct + (c4 + j) * 2); nv[j] = nrow ? *(const u32x4*)(pn + (size_t)(c4 + j) * 9216) : (u32x4){0u, 0u, 0u, 0u}; }
#pragma unroll
                for (int j = 0; j < 4; ++j) {
                    float d[8]; unpack8(dv[j], d);
                    const float M63 = fmaxf(m, cc[j][1]), wc = __expf(m - M63), ws = __expf(cc[j][1] - M63);
                    const u32x4 sp = pack8(S);
                    if (nrow && kg == 0) mp[c4 + j] = m;
#pragma unroll
                    for (int i = 0; i < 8; ++i) S[i] = wc * S[i] + ws * d[i];
                    *(u32x4*)(p + (size_t)(c4 + j) * 9216) = sp;
                    if (nrow) { float dnv[8]; unpack8(nv[j], dnv); const u32x4 np = pack8(N);
#pragma unroll
                        for (int i = 0; i < 8; ++i) N[i] = wc * N[i] + ws * dnv[i];
                        *(u32x4*)(pn + (size_t)(c4 + j) * 9216) = np; }
                    m = cc[j][0] + M63;
                }
            }
        }
    }
}
template <bool ML>
__device__ __forceinline__ void scanC_wave(const Ctx& c, int l, int b, int h, int cch, int ti) {
    const int lane = c.lane, fr = lane & 15, fq = lane >> 4;
    const bf16* PB = (const bf16*)(c.ws + WS_PB);
    bf16* UO = (bf16*)(c.ws + (ML ? WS_UC : WS_UA));
    const bf16* QS = (const bf16*)(c.ws + WS_QS) + (ML ? (size_t)T * 256 : 0);
    const int slot = (b * 4 + h) * 32 + cch;
    const bf16* SP = ML ? (const bf16*)(c.ws + WS_DSM) + (size_t)slot * 144 * 64 : (const bf16*)(c.ws + WS_DSG) + (size_t)slot * 128 * 64;
    const int GCOL = (ML ? PB_OC : PB_GA) + h * 128;
    const float* gnorm = c.in[ML ? IN_ML_NORM : IN_GLA_NORM] + l * 512 + h * 128;
    const size_t trow = (size_t)b * SEQ + (size_t)cch * 64 + 16 * ti + fr;
    bf16x8 qf[2], sf[8][2], nf[2];
#pragma unroll
    for (int ks = 0; ks < 2; ++ks) qf[ks] = *(const bf16x8*)(QS + trow * 256 + h * 64 + 32 * ks + 8 * fq);
#pragma unroll
    for (int n = 0; n < 8; ++n)
#pragma unroll
        for (int ks = 0; ks < 2; ++ks) sf[n][ks] = *(const bf16x8*)(SP + (16 * n + fr) * 64 + 32 * ks + 8 * fq);
    if (ML) {
#pragma unroll
        for (int ks = 0; ks < 2; ++ks) nf[ks] = *(const bf16x8*)(SP + (128 + fr) * 64 + 32 * ks + 8 * fq); }
    u32x2 gate[8], oi[8];
#pragma unroll
    for (int n = 0; n < 8; ++n) { gate[n] = *(const u32x2*)(PB + trow * NPB + GCOL + 16 * n + 4 * fq); oi[n] = *(const u32x2*)(UO + trow * 512 + h * 128 + 16 * n + 4 * fq); }
    float e_in = 1.f, e_st = 1.f, dd = 1.f;
    if (ML) {
        const float pm = ((const float*)(c.ws + WS_GPM))[trow * 4 + h], bc = ((const float*)(c.ws + WS_GBC))[trow * 4 + h], m_prev = ((const float*)(c.ws + WS_MP))[slot], dni = ((const float*)(c.ws + WS_DN))[trow * 4 + h];
        const float Mt = fmaxf(m_prev, pm); e_in = __expf(pm - Mt); e_st = __expf(m_prev - Mt);
        f32x4 d = (f32x4){0.f, 0.f, 0.f, 0.f};
#pragma unroll
        for (int ks = 0; ks < 2; ++ks) d = __builtin_amdgcn_mfma_f32_16x16x32_bf16(nf[ks], qf[ks], d, 0, 0, 0);
        const float dst = __shfl(d[0], fr);
        const float den = dni * e_in + dst * e_st;
        dd = 1.f / fmaxf(fabsf(den), __expf(-(bc + Mt)));
    }
    f32x4 o[8]; float ss = 0.f;
#pragma unroll
    for (int n = 0; n < 8; ++n) {
        f32x4 d = (f32x4){0.f, 0.f, 0.f, 0.f};
#pragma unroll
        for (int ks = 0; ks < 2; ++ks) d = __builtin_amdgcn_mfma_f32_16x16x32_bf16(sf[n][ks], qf[ks], d, 0, 0, 0);
        const f32x4 oiv = (f32x4){bflo(oi[n].x), bfhi(oi[n].x), bflo(oi[n].y), bfhi(oi[n].y)};
        o[n] = ML ? oiv * e_in + d * e_st : oiv + d;
        ss += o[n][0] * o[n][0] + o[n][1] * o[n][1] + o[n][2] * o[n][2] + o[n][3] * o[n][3];
    }
    ss += __shfl_xor(ss, 16); ss += __shfl_xor(ss, 32);
    const float rstd = rsqrtf(ss * dd * dd * (1.f / 128.f) + EPS) * dd;
#pragma unroll
    for (int n = 0; n < 8; ++n) {
        const f32x4 gn = *(const f32x4*)(gnorm + 16 * n + 4 * fq);
        const float g0 = bflo(gate[n].x), g1 = bfhi(gate[n].x), g2 = bflo(gate[n].y), g3 = bfhi(gate[n].y);
        f32x4 r;
        if (ML) { r[0] = o[n][0] * rstd * gn[0] * sigmoidf_(g0); r[1] = o[n][1] * rstd * gn[1] * sigmoidf_(g1); r[2] = o[n][2] * rstd * gn[2] * sigmoidf_(g2); r[3] = o[n][3] * rstd * gn[3] * sigmoidf_(g3); }
        else { r[0] = o[n][0] * rstd * gn[0] * siluf_(g0); r[1] = o[n][1] * rstd * gn[1] * siluf_(g1); r[2] = o[n][2] * rstd * gn[2] * siluf_(g2); r[3] = o[n][3] * rstd * gn[3] * siluf_(g3); }
        st_bf4(UO + trow * 512 + h * 128 + 16 * n + 4 * fq, r);
    }
}
__device__ __forceinline__ void phase_scanA(const Ctx& c, int l) {
    const int nG = c.bid < 2048 ? (2048 - c.bid + c.nblk - 1) / c.nblk : 0;
    const int firstM = c.bid + nG * c.nblk;
    scanA_loop<false>(c, l, c.bid, 2048, c.nblk);
    scanA_loop<true>(c, l, firstM, 4096, c.nblk);
    __syncthreads();
}
__device__ __forceinline__ void phase_scanC(const Ctx& c, int l) {
    const int gw = c.bid * NWAVES + c.wave, NGW = c.nblk * NWAVES;
#pragma unroll 1
    for (int it = gw; it < 16384; it += NGW) { const int br = it >> 13, rem = it & 8191, seq = rem >> 7, cch = (rem >> 2) & 31, ti = rem & 3;
        if (br == 0) scanC_wave<false>(c, l, seq >> 2, seq & 3, cch, ti); else scanC_wave<true>(c, l, seq >> 2, seq & 3, cch, ti); }
}
__device__ __forceinline__ void phase_scans(const Ctx& c, int l) {
    for (int it = c.bid; it < 128; it += c.nblk) {
#if SCAN_RECURRENT
        if (it < 64) scan_gla_item(c, l, it >> 2, it & 3);
        else scan_mlstm_item(c, l, (it - 64) >> 2, (it - 64) & 3);
#else
        if (it < 64) scan_chunked_item<false>(c, l, it >> 2, it & 3);
        else scan_chunked_item<true>(c, l, (it - 64) >> 2, (it - 64) & 3);
#endif
    }
}

__device__ __forceinline__ unsigned ord_key(float f) { const unsigned u = __builtin_bit_cast(unsigned, f); return (u & 0x80000000u) ? ~u : (u | 0x80000000u); }
__device__ __forceinline__ void phase_dsa(const Ctx& c, int l) {
    LAS unsigned char* wl = c.lds + c.wave * 14336;
    LAS float* I_s = (LAS float*)wl;
    LAS int* list = (LAS int*)(wl + 8192);
    LAS float* qi_s = (LAS float*)(wl + 9216);
    LAS float* ql_s = (LAS float*)(wl + 10240);
    const bf16* QLAT = (const bf16*)(c.ws + WS_QLAT); const bf16* QIDX = (const bf16*)(c.ws + WS_QIDX);
    const bf16* CKVN = (const bf16*)(c.ws + WS_CKVN); const float* SM = (const float*)(c.ws + WS_SM);
    bf16* OLAT = (bf16*)(c.ws + WS_OLAT);
    const int gw = c.bid * NWAVES + c.wave, NGW = c.nblk * NWAVES, lane = c.lane;
    for (int tq = gw; tq < T; tq += NGW) {
        const int b = tq >> 11, pos = tq & 2047, nvalid = pos + 1;
        const size_t kb = (size_t)b * SEQ;
        { const f32x4 q = ld_bf4(QIDX + (size_t)tq * 256 + 4 * lane); *(LAS f32x4*)(qi_s + 4 * lane) = q;
#pragma unroll
          for (int j = 0; j < 4; ++j) { const f32x4 ql = ld_bf4(QLAT + (size_t)tq * 1024 + 4 * (lane + 64 * j)); *(LAS f32x4*)(ql_s + 4 * (lane + 64 * j)) = ql; } }
        float wh[8];
#pragma unroll
        for (int hh = 0; hh < 8; ++hh) wh[hh] = SM[(size_t)tq * 128 + SM_WIDX + hh] * 0.35355339059327373f;
        asm volatile("s_waitcnt lgkmcnt(0)" ::: "memory");
        int nsel;
        if (nvalid <= DSA_K) {
            for (int i = lane; i < DSA_K; i += 64) list[i] = i;
            nsel = nvalid;
        } else {
            const int nj = (nvalid + 63) >> 6;
            for (int j = 0; j < nj; ++j) {
                const int s = lane + 64 * j;
                float val = -INFINITY;
                if (s < nvalid) {
                    const float* kr = SM + (kb + s) * 128 + SM_KIDX;
                    f32x4 kk[8];
#pragma unroll
                    for (int i = 0; i < 8; ++i) kk[i] = *(const f32x4*)(kr + 4 * i);
                    val = 0.f;
#pragma unroll
                    for (int hh = 0; hh < 8; ++hh) { float d = 0.f;
#pragma unroll
                        for (int i = 0; i < 8; ++i) { const f32x4 q = *(const LAS f32x4*)(qi_s + hh * 32 + 4 * i); d += q[0] * kk[i][0] + q[1] * kk[i][1] + q[2] * kk[i][2] + q[3] * kk[i][3]; }
                        val += wh[hh] * fmaxf(d, 0.f); }
                }
                I_s[s] = val;
            }
            for (int j = nj; j < 32; ++j) I_s[lane + 64 * j] = -INFINITY;
            asm volatile("s_waitcnt lgkmcnt(0)" ::: "memory");
            LAS unsigned* K_s = (LAS unsigned*)I_s;
#pragma unroll 4
            for (int j = 0; j < 32; ++j) K_s[lane + 64 * j] = ord_key(I_s[lane + 64 * j]);
            unsigned thr = 0u;
#pragma unroll 1
            for (int bit = 31; bit >= 0; --bit) {
                const unsigned cand = thr | (1u << bit); int cnt = 0;
#pragma unroll 8
                for (int j = 0; j < 32; ++j) cnt += (K_s[lane + 64 * j] >= cand) ? 1 : 0;
                cnt = wave_sum_i(cnt);
                if (cnt >= DSA_K) thr = cand;
            }
            int cgt = 0;
#pragma unroll 8
            for (int j = 0; j < 32; ++j) cgt += (K_s[lane + 64 * j] > thr) ? 1 : 0;
            cgt = wave_sum_i(cgt);
            int need = DSA_K - cgt, base = 0;
            const unsigned long long lt = (1ull << lane) - 1ull;
#pragma unroll 2
            for (int j = 0; j < 32; ++j) {
                const unsigned kj = K_s[lane + 64 * j];
                const bool gt = kj > thr, eq = kj == thr;
                const unsigned long long meq = __ballot(eq);
                const int rk = __popcll(meq & lt);
                const bool sel = gt || (eq && rk < need);
                need -= __popcll(meq); if (need < 0) need = 0;
                const unsigned long long ms = __ballot(sel);
                if (sel) list[base + __popcll(ms & lt)] = lane + 64 * j;
                base += __popcll(ms);
            }
            nsel = DSA_K;
        }
        asm volatile("s_waitcnt lgkmcnt(0)" ::: "memory");
        int ks[4]; float lg[4][8];
#pragma unroll
        for (int i = 0; i < 4; ++i) { const int li = lane + 64 * i; ks[i] = (li < nsel) ? list[li] : 0;
#pragma unroll
            for (int hh = 0; hh < 8; ++hh) lg[i][hh] = 0.f; }
#pragma unroll 1
        for (int ch = 0; ch < 16; ++ch) {
            f32x4 ka[4], kc[4];
#pragma unroll
            for (int i = 0; i < 4; ++i) { const u32x4 w = *(const u32x4*)(CKVN + (kb + ks[i]) * 128 + ch * 8);
                ka[i] = (f32x4){bflo(w.x), bfhi(w.x), bflo(w.y), bfhi(w.y)}; kc[i] = (f32x4){bflo(w.z), bfhi(w.z), bflo(w.w), bfhi(w.w)}; }
#pragma unroll
            for (int hh = 0; hh < 8; ++hh) { const f32x4 qa = *(const LAS f32x4*)(ql_s + hh * 128 + ch * 8), qb = *(const LAS f32x4*)(ql_s + hh * 128 + ch * 8 + 4);
#pragma unroll
                for (int i = 0; i < 4; ++i) lg[i][hh] += qa[0] * ka[i][0] + qa[1] * ka[i][1] + qa[2] * ka[i][2] + qa[3] * ka[i][3] + qb[0] * kc[i][0] + qb[1] * kc[i][1] + qb[2] * kc[i][2] + qb[3] * kc[i][3]; }
        }
#pragma unroll
        for (int hh = 0; hh < 8; ++hh) {
            const float slope = exp2f(-(float)(hh + 1));
            float mx = -INFINITY;
#pragma unroll
            for (int i = 0; i < 4; ++i) { const bool ok = (lane + 64 * i) < nsel; lg[i][hh] = ok ? lg[i][hh] - slope * (float)(pos - ks[i]) : -INFINITY; mx = fmaxf(mx, lg[i][hh]); }
            mx = wave_max(mx);
            float sm = 0.f;
#pragma unroll
            for (int i = 0; i < 4; ++i) { lg[i][hh] = __expf(lg[i][hh] - mx); sm += lg[i][hh]; }
            sm = wave_sum(sm);
            const float inv = 1.f / sm;
#pragma unroll
            for (int i = 0; i < 4; ++i) lg[i][hh] *= inv;
        }
#pragma unroll
        for (int i = 0; i < 4; ++i) { const int li = lane + 64 * i;
            *(LAS f32x4*)(I_s + li * 8) = (f32x4){lg[i][0], lg[i][1], lg[i][2], lg[i][3]}; *(LAS f32x4*)(I_s + li * 8 + 4) = (f32x4){lg[i][4], lg[i][5], lg[i][6], lg[i][7]}; }
        asm volatile("s_waitcnt lgkmcnt(0)" ::: "memory");
        float o0[8], o1[8];
#pragma unroll
        for (int hh = 0; hh < 8; ++hh) { o0[hh] = 0.f; o1[hh] = 0.f; }
#pragma unroll 2
        for (int kidx = 0; kidx < nsel; ++kidx) {
            const int s = list[kidx];
            const unsigned w = *(const unsigned*)(CKVN + (kb + s) * 128 + 2 * lane);
            const float v0 = bflo(w), v1 = bfhi(w);
            const f32x4 pa = *(const LAS f32x4*)(I_s + kidx * 8), pb = *(const LAS f32x4*)(I_s + kidx * 8 + 4);
            o0[0] += pa[0] * v0; o1[0] += pa[0] * v1; o0[1] += pa[1] * v0; o1[1] += pa[1] * v1; o0[2] += pa[2] * v0; o1[2] += pa[2] * v1; o0[3] += pa[3] * v0; o1[3] += pa[3] * v1;
            o0[4] += pb[0] * v0; o1[4] += pb[0] * v1; o0[5] += pb[1] * v0; o1[5] += pb[1] * v1; o0[6] += pb[2] * v0; o1[6] += pb[2] * v1; o0[7] += pb[3] * v0; o1[7] += pb[3] * v1;
        }
#pragma unroll
        for (int hh = 0; hh < 8; ++hh) *(unsigned*)(OLAT + (size_t)tq * 1024 + hh * 128 + 2 * lane) = pk2(o0[hh], o1[hh]);
        asm volatile("s_waitcnt lgkmcnt(0)" ::: "memory");
    }
}


__device__ __forceinline__ int half_sum(int v) {
    v += __builtin_amdgcn_update_dpp(0, v, 0xB1, 0xF, 0xF, false);
    v += __builtin_amdgcn_update_dpp(0, v, 0x4E, 0xF, 0xF, false);
    v += __builtin_amdgcn_update_dpp(0, v, 0x141, 0xF, 0xF, false);
    v += __builtin_amdgcn_update_dpp(0, v, 0x140, 0xF, 0xF, false);
    v += __shfl_xor(v, 16);
    return v;
}
typedef float f32x16 __attribute__((ext_vector_type(16)));
__device__ __forceinline__ void phase_dsa_sel(const Ctx& c, int l) {
    const bf16* QIDX = (const bf16*)(c.ws + WS_QIDX); const bf16* KIDX = (const bf16*)(c.ws + WS_KIDX); const float* SM = (const float*)(c.ws + WS_SM);
    unsigned* MASK = (unsigned*)(c.ws + WS_MASK);
    const int lane = c.lane, hf = lane >> 5, l31 = lane & 31;
    const int rho = l31, tl = 2 * ((rho >> 2) & 1) + (rho >> 4), hd = (rho & 3) + 4 * ((rho >> 3) & 1);
    const unsigned ltmask = (1u << l31) - 1u;
    LAS unsigned* KL = (LAS unsigned*)(c.lds + c.wave * 16384);
    LAS unsigned* MW = (LAS unsigned*)(c.lds + 131072 + c.wave * 512);
    unsigned* KEYB = (unsigned*)(c.ws + WS_KEYB) + (size_t)(c.bid * NWAVES + c.wave) * 4096;
    const int npass = (c.nblk == 256) ? 2 : (T / 64 + c.nblk - 1) / c.nblk;
#pragma unroll 1
    for (int ps = 0; ps < npass; ++ps) {
        int b, q64;
        if (c.nblk == 256) { b = c.bid & 15; q64 = ps == 0 ? 31 - (c.bid >> 4) : (c.bid >> 4); }
        else { const int it = c.bid + ps * c.nblk; if (it >= T / 64) break; b = it >> 5; q64 = it & 31; }
        const int pb = q64 * 64;
#pragma unroll 1
        for (int wi = 0; wi < 2; ++wi) {
        const int pos0 = pb + 8 * c.wave + 4 * wi, t0 = b * SEQ + pos0;
        unsigned wA0 = 0u, wB0 = 0u, wA1 = 0u, wB1 = 0u;
        if (pos0 + 3 < DSA_K) {
            const int p_0 = pos0 + 2 * hf, p_1 = p_0 + 1;
            { const int lo = 32 * l31; wA0 = p_0 >= lo + 31 ? 0xffffffffu : (p_0 < lo ? 0u : ((2u << (p_0 - lo)) - 1u)); wA1 = p_1 >= lo + 31 ? 0xffffffffu : (p_1 < lo ? 0u : ((2u << (p_1 - lo)) - 1u)); }
        } else {
            const int ng = ((pos0 + 3) / 32 + 4) / 4, nkt = 4 * ng;
            bf16x8 af[2];
#pragma unroll
            for (int ks = 0; ks < 2; ++ks) af[ks] = *(const bf16x8*)(QIDX + (size_t)(t0 + tl) * 256 + hd * 32 + 16 * ks + 8 * hf);
            const bf16* kbase = KIDX + ((size_t)b * SEQ + l31) * 32 + 8 * hf;
#pragma unroll 1
            for (int tsel = 0; tsel < 2; ++tsel) {
                const int p_t = pos0 + 2 * hf + tsel;
                if (tsel == 0) {
                    float whv[16];
#pragma unroll
                    for (int r = 0; r < 16; ++r) whv[r] = SM[(size_t)(t0 + 2 * hf + (r >> 3)) * 128 + SM_WIDX + (r & 7)] * 0.35355339059327373f;
                    bf16x8 bq[4][2], bn[4][2];
#pragma unroll
                    for (int j = 0; j < 4; ++j) { bq[j][0] = *(const bf16x8*)(kbase + (size_t)(32 * j) * 32); bq[j][1] = *(const bf16x8*)(kbase + (size_t)(32 * j) * 32 + 16); }
#pragma unroll 1
                    for (int g = 0; g < ng; ++g) {
                        const int gn = (g + 1 < ng) ? g + 1 : g;
#pragma unroll
                        for (int j = 0; j < 4; ++j) { bn[j][0] = *(const bf16x8*)(kbase + (size_t)(32 * (4 * gn + j)) * 32); bn[j][1] = *(const bf16x8*)(kbase + (size_t)(32 * (4 * gn + j)) * 32 + 16); }
                        u32x4 ka, kb;
#pragma unroll
                        for (int j = 0; j < 4; ++j) {
                            f32x16 d;
#pragma unroll
                            for (int r = 0; r < 16; ++r) d[r] = 0.f;
                            d = __builtin_amdgcn_mfma_f32_32x32x16_bf16(af[0], bq[j][0], d, 0, 0, 0);
                            d = __builtin_amdgcn_mfma_f32_32x32x16_bf16(af[1], bq[j][1], d, 0, 0, 0);
                            float iv0 = 0.f, iv1 = 0.f;
#pragma unroll
                            for (int r = 0; r < 8; ++r) { iv0 += whv[r] * fmaxf(d[r], 0.f); iv1 += whv[8 + r] * fmaxf(d[8 + r], 0.f); }
                            const int row = 32 * (4 * g + j) + l31;
                            ka[j] = row <= p_t ? ord_key(iv0) : 0u; kb[j] = row <= p_t + 1 ? ord_key(iv1) : 0u;
                        }
                        *(LAS u32x4*)(KL + (g * 64 + lane) * 4) = ka;
                        *(u32x4*)(KEYB + ((size_t)g * 64 + lane) * 4) = kb;
#pragma unroll
                        for (int j = 0; j < 4; ++j) { bq[j][0] = bn[j][0]; bq[j][1] = bn[j][1]; }
                    }
                } else {
#pragma unroll 4
                    for (int g = 0; g < ng; ++g) *(LAS u32x4*)(KL + (g * 64 + lane) * 4) = __builtin_nontemporal_load((const u32x4*)(KEYB + ((size_t)g * 64 + lane) * 4));
                }
                unsigned thr = 0u; bool done = false, alld = false;
#pragma unroll 1
                for (int bit = 31; bit >= 0 && !alld; --bit) {
                    const unsigned cand = thr | (1u << bit); int cn = 0;
#pragma unroll 4
                    for (int g = 0; g < ng; ++g) { const u32x4 k4 = *(const LAS u32x4*)(KL + (g * 64 + lane) * 4);
                        cn += (k4.x >= cand ? 1 : 0) + (k4.y >= cand ? 1 : 0) + (k4.z >= cand ? 1 : 0) + (k4.w >= cand ? 1 : 0); }
                    cn = half_sum(cn);
                    if (!done && cn >= DSA_K) thr = cand;
                    done = done || cn == DSA_K;
                    alld = __ballot(!done) == 0ull;
                }
                const bool dlo = alld, dhi = alld;
                MW[lane] = 0u; MW[64 + lane] = 0u;
                if (dlo && dhi) {
#pragma unroll 4
                    for (int kt = 0; kt < nkt; ++kt) { const unsigned long long ms = __ballot(KL[((kt >> 2) * 64 + lane) * 4 + (kt & 3)] >= thr);
                        if (l31 == 0) MW[hf * 64 + kt] = hf ? (unsigned)(ms >> 32) : (unsigned)ms; }
                } else {
                int glo = 0, ghi = 0;
#pragma unroll 16
                for (int kt = 0; kt < nkt; ++kt) { const unsigned long long m = __ballot(KL[((kt >> 2) * 64 + lane) * 4 + (kt & 3)] > thr); glo += __popc((unsigned)m); ghi += __popc((unsigned)(m >> 32)); }
                int nlo = DSA_K - glo, nhi = DSA_K - ghi;
#pragma unroll 2
                for (int kt = 0; kt < nkt; ++kt) {
                    const unsigned kv = KL[((kt >> 2) * 64 + lane) * 4 + (kt & 3)];
                    const bool gt = kv > thr, eq = kv == thr;
                    const unsigned long long meq = __ballot(eq); const unsigned mh = hf ? (unsigned)(meq >> 32) : (unsigned)meq;
                    const int need = hf ? nhi : nlo;
                    const bool sel = gt || (eq && (__popc(mh & ltmask) < need));
                    nlo -= __popc((unsigned)meq); nhi -= __popc((unsigned)(meq >> 32)); nlo = nlo < 0 ? 0 : nlo; nhi = nhi < 0 ? 0 : nhi;
                    const unsigned long long ms = __ballot(sel);
                    if (l31 == 0) MW[hf * 64 + kt] = hf ? (unsigned)(ms >> 32) : (unsigned)ms;
                }
                }
                const unsigned wA = MW[hf * 64 + l31], wB = MW[hf * 64 + 32 + l31];
                if (tsel == 0) { wA0 = wA; wB0 = wB; } else { wA1 = wA; wB1 = wB; }
            }
        }
        unsigned* m0 = MASK + (size_t)(t0 + 2 * hf) * 64;
        m0[l31] = wA0; m0[32 + l31] = wB0; m0[64 + l31] = wA1; m0[96 + l31] = wB1;
        }
    }
    __syncthreads();
}

constexpr int AT_STAGE = 32768;
__device__ __forceinline__ void phase_dsa_att(const Ctx& c, int l) {
    const bf16* QLAT = (const bf16*)(c.ws + WS_QLAT); const bf16* CKVN = (const bf16*)(c.ws + WS_CKVN); const bf16* CKVT = (const bf16*)(c.ws + WS_CKVT);
    const unsigned* MASK = (const unsigned*)(c.ws + WS_MASK); bf16* OLAT = (bf16*)(c.ws + WS_OLAT);
    const int tid = c.tid, lane = c.lane, h = c.wave, fr = lane & 15, fq = lane >> 4;
    const float slope2 = exp2f(-(float)(h + 1)) * 1.4426950408889634f;
    const int dn_r = tid >> 4, dn_c = ((tid & 15) ^ ((tid >> 4) & 15)) * 8;
    const int dt_r = tid >> 3, dt_c = ((tid & 7) ^ ((tid >> 3) & 7)) * 8;
    const unsigned ldsw = (unsigned)h * 1024u;
#pragma unroll 1
    for (int k4 = 0; k4 < 1024; ++k4) {
        const int idx = c.bid + c.nblk * k4; if (idx >= 1024) break;
        const int b = idx & 15, g = idx >> 4, gk = g >> 4, gi = g & 15;
        const int qt = 63 - 16 * gk - ((gk & 1) ? (15 - gi) : gi);
        const int tq0 = qt * 32;
        const size_t tg0 = (size_t)b * SEQ + tq0;
        const int nkt = (tq0 + 31) / 64 + 1;
        bf16x8 Qf[2][4];
#pragma unroll
        for (int rt = 0; rt < 2; ++rt)
#pragma unroll
            for (int ks = 0; ks < 4; ++ks) Qf[rt][ks] = *(const bf16x8*)(QLAT + (tg0 + 16 * rt + fr) * 1024 + h * 128 + 32 * ks + 8 * fq);
        f32x4 O[2][8];
        float mrun[2], lrun[2];
#pragma unroll
        for (int rt = 0; rt < 2; ++rt) { mrun[rt] = -1e30f; lrun[rt] = 0.f;
#pragma unroll
            for (int n = 0; n < 8; ++n) O[rt][n] = (f32x4){0.f, 0.f, 0.f, 0.f}; }
#define AT_DMA(kt_, stg_) do { const bf16* _kn = CKVN + ((size_t)b * SEQ + 64 * (kt_) + dn_r) * 128 + dn_c; const bf16* _kt = CKVT + (((size_t)b * 32 + (kt_)) * 128 + dt_r) * 64 + dt_c; \
            LAS unsigned char* _d = c.lds + (stg_) * AT_STAGE + ldsw; \
            __builtin_amdgcn_global_load_lds((const unsigned*)_kn, (LAS unsigned*)_d, 16, 0, 0); __builtin_amdgcn_global_load_lds((const unsigned*)(_kn + 32 * 128), (LAS unsigned*)(_d + 8192), 16, 0, 0); \
            __builtin_amdgcn_global_load_lds((const unsigned*)_kt, (LAS unsigned*)(_d + 16384), 16, 0, 0); __builtin_amdgcn_global_load_lds((const unsigned*)(_kt + 64 * 64), (LAS unsigned*)(_d + 16384 + 8192), 16, 0, 0); } while (0)
        __syncthreads();
        AT_DMA(0, 0);
#pragma unroll 1
        for (int kt = 0; kt < nkt; ++kt) {
            u32x2 mw[2];
#pragma unroll
            for (int rt = 0; rt < 2; ++rt) mw[rt] = *(const u32x2*)(MASK + (tg0 + 16 * rt + fr) * 64 + 2 * kt);
            asm volatile("s_waitcnt vmcnt(2)" ::: "memory");
            __builtin_amdgcn_s_barrier(); asm volatile("" ::: "memory");
            if (kt + 1 < nkt) AT_DMA(kt + 1, (kt + 1) & 1);
            int lz; asm volatile("v_mov_b32 %0, 0" : "=v"(lz));
            const LAS unsigned char* Kn = c.lds + (kt & 1) * AT_STAGE + lz; const LAS unsigned char* KT = Kn + 16384;
            const float kb0 = slope2 * (float)(64 * kt + 4 * fq);
            f32x4 S[2][4];
            {
                bf16x8 kfa[4], kfb[4];
#pragma unroll
                for (int ks = 0; ks < 4; ++ks) kfa[ks] = *(const LAS bf16x8*)(Kn + fr * 256 + (((4 * ks + fq) ^ fr) << 4));
#pragma unroll
                for (int j = 0; j < 4; ++j) {
                    if (j + 1 < 4) {
#pragma unroll
                        for (int ks = 0; ks < 4; ++ks) { const bf16x8 t = *(const LAS bf16x8*)(Kn + (16 * (j + 1) + fr) * 256 + (((4 * ks + fq) ^ fr) << 4)); if (j & 1) kfa[ks] = t; else kfb[ks] = t; } }
#pragma unroll
                    for (int rt = 0; rt < 2; ++rt) { f32x4 d = (f32x4){0.f, 0.f, 0.f, 0.f};
#pragma unroll
                        for (int ks = 0; ks < 4; ++ks) d = __builtin_amdgcn_mfma_f32_16x16x32_bf16((j & 1) ? kfb[ks] : kfa[ks], Qf[rt][ks], d, 0, 0, 0);
                        S[rt][j] = d; }
                    __builtin_amdgcn_sched_barrier(0);
                }
            }
            bf16x8 Pf[2][2];
#pragma unroll
            for (int rt = 0; rt < 2; ++rt) {
                float mx = -1e30f;
#pragma unroll
                for (int j = 0; j < 4; ++j) { const unsigned wsel = ((j < 2) ? mw[rt].x : mw[rt].y) >> (4 * fq);
#pragma unroll
                    for (int r = 0; r < 4; ++r) { const bool on = wsel & (1u << (16 * (j & 1) + r));
                        const float v = S[rt][j][r] + fmaf(slope2, (float)(16 * j + r), kb0);
                        S[rt][j][r] = on ? v : -INFINITY; mx = fmaxf(mx, S[rt][j][r]); } }
                mx = fmaxf(mx, __shfl_xor(mx, 16)); mx = fmaxf(mx, __shfl_xor(mx, 32));
                const float mnew = fmaxf(mrun[rt], mx);
                const float alpha = __builtin_amdgcn_exp2f(mrun[rt] - mnew);
                float rs = 0.f;
#pragma unroll
                for (int j = 0; j < 4; ++j)
#pragma unroll
                    for (int r = 0; r < 4; ++r) { const float p = __builtin_amdgcn_exp2f(S[rt][j][r] - mnew); S[rt][j][r] = p; rs += p; }
                rs += __shfl_xor(rs, 16); rs += __shfl_xor(rs, 32);
                lrun[rt] = lrun[rt] * alpha + rs; mrun[rt] = mnew;
#pragma unroll
                for (int n = 0; n < 8; ++n) O[rt][n] *= alpha;
#pragma unroll
                for (int ks2 = 0; ks2 < 2; ++ks2) { u32x4 w; w.x = pk2(S[rt][2 * ks2][0], S[rt][2 * ks2][1]); w.y = pk2(S[rt][2 * ks2][2], S[rt][2 * ks2][3]);
                    w.z = pk2(S[rt][2 * ks2 + 1][0], S[rt][2 * ks2 + 1][1]); w.w = pk2(S[rt][2 * ks2 + 1][2], S[rt][2 * ks2 + 1][3]);
                    Pf[rt][ks2] = __builtin_bit_cast(bf16x8, w); }
            }
            {
                const int sw = fr & 7;
#pragma unroll
                for (int n = 0; n < 8; ++n) {
#pragma unroll
                    for (int ks2 = 0; ks2 < 2; ++ks2) {
                        const bf16x8 af = *(const LAS bf16x8*)(KT + (16 * n + fr) * 128 + (((4 * ks2 + fq) ^ sw) << 4));
#pragma unroll
                        for (int rt = 0; rt < 2; ++rt) O[rt][n] = __builtin_amdgcn_mfma_f32_16x16x32_bf16(af, Pf[rt][ks2], O[rt][n], 0, 0, 0);
                    }
                    if (n & 1) __builtin_amdgcn_sched_barrier(0);
                }
            }
        }
#undef AT_DMA
        {
            const bf16x8* WF = (const bf16x8*)((const bf16*)(c.ws + WS_WUVF) + (size_t)(l * 8 + h) * 16 * 64 * 8) + lane;
            bf16x8 wf[4][4];
#pragma unroll
            for (int vt = 0; vt < 4; ++vt)
#pragma unroll
                for (int ks = 0; ks < 4; ++ks) wf[vt][ks] = WF[(vt * 4 + ks) * 64];
#pragma unroll
            for (int rt = 0; rt < 2; ++rt) { const float inv = 1.f / lrun[rt];
                bf16x8 of[4];
#pragma unroll
                for (int ks = 0; ks < 4; ++ks) { const f32x4 x0 = O[rt][2 * ks] * inv, x1 = O[rt][2 * ks + 1] * inv;
                    u32x4 w; w.x = pk2(x0[0], x0[1]); w.y = pk2(x0[2], x0[3]); w.z = pk2(x1[0], x1[1]); w.w = pk2(x1[2], x1[3]); of[ks] = __builtin_bit_cast(bf16x8, w); }
#pragma unroll
                for (int vt = 0; vt < 4; ++vt) { f32x4 d = (f32x4){0.f, 0.f, 0.f, 0.f};
#pragma unroll
                    for (int ks = 0; ks < 4; ++ks) d = __builtin_amdgcn_mfma_f32_16x16x32_bf16(wf[vt][ks], of[ks], d, 0, 0, 0);
                    st_bf4(OLAT + (tg0 + 16 * rt + fr) * 512 + h * 64 + 16 * vt + 4 * fq, d); }
            }
        }
    }
    asm volatile("s_waitcnt vmcnt(0)" ::: "memory");
    __syncthreads();
}

__device__ __forceinline__ void expert_convert(const Ctx& c, int l, int gw, int NGW) {

        LAS float* scr = (LAS float*)(c.lds + c.wave * 16384);
        constexpr int I_GU = (512 / 32) * (1024 / 64), I_D = (1024 / 32) * (256 / 64), PER_E = I_GU + I_D;
        for (int it = gw; it < NEX * PER_E; it += NGW) {
            const int e = it / PER_E; int r = it % PER_E;
            if (r < I_GU) {
                const int n0 = (r / 16) * 32, pn = n0 >> 8, wi = n0 & 255, j0 = 128 * pn + (wi & 127);
                const float* Wg; const float* Wu;
                if (e < NE) { Wg = c.in[IN_EWG] + ((size_t)l * NE + e) * 1024 * 256; Wu = c.in[IN_EWU] + ((size_t)l * NE + e) * 1024 * 256; }
                else { Wg = c.in[IN_SWG] + (size_t)l * 1024 * 256; Wu = c.in[IN_SWU] + (size_t)l * 1024 * 256; }
                if (wi < 128) { SrcPlain s{Wg + j0 - n0, 256}; tr_item(s, (bf16*)(c.ws + WS_WGU) + (size_t)e * 512 * 1024, 1024, n0, (r % 16) * 64, scr, c.lane); }
                else { SrcPlain s{Wu + j0 - n0, 256}; tr_item(s, (bf16*)(c.ws + WS_WGU) + (size_t)e * 512 * 1024, 1024, n0, (r % 16) * 64, scr, c.lane); }
            } else { r -= I_GU;
                SrcPlain s; s.ld = 1024; s.W = e < NE ? c.in[IN_EWD] + ((size_t)l * NE + e) * 256 * 1024 : c.in[IN_SWD] + (size_t)l * 256 * 1024;
                tr_item(s, (bf16*)(c.ws + WS_WD) + (size_t)e * 1024 * 256, 256, (r / 4) * 32, (r % 4) * 64, scr, c.lane);
            }
        }
    }
__device__ __forceinline__ void route_one(int t, float logit, float rbias, int lane, LAS unsigned* lcnt, LAS unsigned* stash, int ridx) {
    const float score = sigmoid_exact(logit), sel = score + rbias;
    const int g = lane >> 3;
    float m1 = sel, m2 = -INFINITY;
#pragma unroll
    for (int d = 1; d < 8; d <<= 1) { const float o1 = __shfl_xor(m1, d), o2 = __shfl_xor(m2, d);
        const float n1 = fmaxf(m1, o1), n2 = fmaxf(fminf(m1, o1), fmaxf(m2, o2)); m1 = n1; m2 = n2; }
    const float gs = m1 + m2;
    int rkg = 0;
#pragma unroll
    for (int og = 0; og < 8; ++og) { const float o = __builtin_bit_cast(float, __builtin_amdgcn_readlane(__builtin_bit_cast(int, gs), og * 8)); rkg += (o > gs || (o == gs && og < g)) ? 1 : 0; }
    const bool gsel = rkg < 4;
    const float msel = gsel ? sel : -INFINITY;
    int rk = 0;
#pragma unroll 8
    for (int j = 0; j < 64; ++j) { const float o = __builtin_bit_cast(float, __builtin_amdgcn_readlane(__builtin_bit_cast(int, msel), j)); rk += (o > msel || (o == msel && j < lane)) ? 1 : 0; }
    const bool chosen = gsel && rk < TOPK;
    const unsigned long long mk = __ballot(chosen);
    float wsum = 0.f;
    { unsigned long long mm = mk;
#pragma unroll 1
      while (mm) { const int j = __ffsll((long long)mm) - 1; mm &= mm - 1; wsum += __builtin_bit_cast(float, __builtin_amdgcn_readlane(__builtin_bit_cast(int, score), j)); } }
    if (chosen) {
        const int hf = t >= HALF_T ? 1 : 0;
        const int kk = __popcll(mk & ((1ull << lane) - 1ull));
        const unsigned rank = __hip_atomic_fetch_add(&lcnt[hf * 64 + lane], 1u, __ATOMIC_RELAXED, __HIP_MEMORY_SCOPE_WORKGROUP);
        LAS unsigned* st = stash + (size_t)(ridx * 6 + (kk < TOPK ? kk : 0)) * 4;
        st[0] = (unsigned)t; st[1] = ((unsigned)hf << 24) | ((unsigned)lane << 16) | rank; st[2] = __builtin_bit_cast(unsigned, score / wsum * 2.5f);
    }
}
__device__ __forceinline__ void phase_route(const Ctx& c, int l, const float* x1) {
    for (int r2 = 0; r2 < CONV_REP; ++r2) expert_convert(c, l, c.bid * NWAVES + c.wave, c.nblk * NWAVES);
    __syncthreads();
    {
        LAS float* H = (LAS float*)c.lds;
        constexpr int HLD = 1028;
        const int lane = c.lane, w = c.wave;
        const float* MOD = (const float*)(c.ws + WS_MOD) + (size_t)l * 16 * 6144;
        bf16* XN2 = (bf16*)(c.ws + WS_XN2);
        const float* RW = c.in[IN_RW] + (size_t)l * 1024 * 64; const float rbias = c.in[IN_RB][l * 64 + lane];
        unsigned* CNT = (unsigned*)(c.ws + WS_CTL) + CW_CNT + l * 128 * CNT_STRIDE;
        int* ROWL = (int*)(c.ws + WS_ROWL); float* WL = (float*)(c.ws + WS_WL); unsigned* TOKPOS = (unsigned*)(c.ws + WS_TOKPOS);
        const float* gain = c.in[IN_NFFN] + l * D;
        LAS unsigned* lcnt = (LAS unsigned*)(c.lds + 131584);
        LAS unsigned* stash = lcnt + 128;
        constexpr int STASH_ROWS = 128;
        int nrow_done = 0;
        if (c.tid < 128) lcnt[c.tid] = 0u;
        for (int it = c.bid; it < T / 32; it += c.nblk) {
            const int t0 = it * 32, b = t0 >> 11;
            const float* sh = MOD + (size_t)b * 6144 + 3072; const float* sc = MOD + (size_t)b * 6144 + 4096;
            __syncthreads();
#pragma unroll
            for (int r = 0; r < 4; ++r) {
                const int rr = 4 * w + r;
                const float* xrow = x1 + (size_t)(t0 + rr) * D;
                f32x4 v[4]; float ssum = 0.f;
#pragma unroll
                for (int j = 0; j < 4; ++j) { v[j] = *(const f32x4*)(xrow + 4 * (lane + 64 * j)); ssum += v[j][0] * v[j][0] + v[j][1] * v[j][1] + v[j][2] * v[j][2] + v[j][3] * v[j][3]; }
                const float rstd = rsqrtf(wave_sum(ssum) * (1.f / D) + EPS);
#pragma unroll
                for (int j = 0; j < 4; ++j) { const int cc = 4 * (lane + 64 * j);
                    const f32x4 g = *(const f32x4*)(gain + cc), a4 = *(const f32x4*)(sc + cc), bb = *(const f32x4*)(sh + cc);
                    const f32x4 hv = v[j] * rstd * g * (a4 + 1.f) + bb;
                    st_bf4(XN2 + (size_t)(t0 + rr) * D + cc, hv); *(LAS f32x4*)(H + rr * HLD + cc) = hv; }
            }
            __syncthreads();
            {
                const int rt = w >> 2, et = w & 3, fr = lane & 15, fq = lane >> 4;
                const LAS float* hp = H + (16 * rt + fr) * HLD + fq;
                const float* bp = RW + (size_t)fq * 64 + 16 * et + fr;
                f32x4 c0 = (f32x4){0.f, 0.f, 0.f, 0.f}, c1 = (f32x4){0.f, 0.f, 0.f, 0.f};
                float bq[8], bn[8];
#pragma unroll
                for (int j = 0; j < 8; ++j) bq[j] = bp[(size_t)(4 * j) * 64];
#pragma unroll 1
                for (int k8 = 0; k8 < 256; k8 += 8) {
                    const int kn = (k8 + 8) & 255;
#pragma unroll
                    for (int j = 0; j < 8; ++j) bn[j] = bp[(size_t)(4 * (kn + j)) * 64];
#pragma unroll
                    for (int j = 0; j < 8; j += 2) {
                        c0 = __builtin_amdgcn_mfma_f32_16x16x4f32(hp[4 * (k8 + j)], bq[j], c0, 0, 0, 0);
                        c1 = __builtin_amdgcn_mfma_f32_16x16x4f32(hp[4 * (k8 + j + 1)], bq[j + 1], c1, 0, 0, 0);
                    }
#pragma unroll
                    for (int j = 0; j < 8; ++j) bq[j] = bn[j];
                }
                const f32x4 cc = c0 + c1;
                __syncthreads();
                LAS float* LG = H;
#pragma unroll
                for (int r = 0; r < 4; ++r) LG[(16 * rt + 4 * fq + r) * 64 + 16 * et + fr] = cc[r];
            }
            __syncthreads();
#pragma unroll 1
            for (int r = 0; r < 4; ++r) {
                const int rr = 4 * w + r; const float lg = H[rr * 64 + lane];
                route_one(t0 + rr, lg, rbias, lane, lcnt, stash, nrow_done + rr);
            }
            nrow_done += 32;
            const bool last = it + c.nblk >= T / 32;
            if (nrow_done + 32 > STASH_ROWS || last) {
                __syncthreads();
                if (c.tid < 128) { const unsigned n = lcnt[c.tid]; lcnt[c.tid] = n ? atomicAdd(&CNT[c.tid * CNT_STRIDE], n) : 0u; }
                __syncthreads();
                for (int i = c.tid; i < nrow_done * 6; i += NTHR) { const LAS unsigned* st = stash + (size_t)i * 4;
                    const unsigned tt = st[0], m = st[1]; const int hf = m >> 24, e = (m >> 16) & 0xff; const unsigned slot = lcnt[hf * 64 + e] + (m & 0xffffu);
                    ROWL[((size_t)hf * 64 + e) * 16384 + slot] = (int)tt; WL[((size_t)hf * 64 + e) * 16384 + slot] = __builtin_bit_cast(float, st[2]);
                    TOKPOS[(size_t)tt * 6 + (i % 6)] = ((unsigned)e << 16) | slot; }
                __syncthreads();
                if (c.tid < 128) lcnt[c.tid] = 0u;
                nrow_done = 0;
            }
        }
        __syncthreads();
    }
}

__device__ __forceinline__ void moe_tables(const Ctx& c, int l, int hf) {
    LAS int* cnt = (LAS int*)(c.lds + 140000); LAS int* off = cnt + 65; LAS int* tst = off + 65;
    __syncthreads();
    if (c.tid == 0) {
        const unsigned* CNT = (const unsigned*)(c.ws + WS_CTL) + CW_CNT + (l * 128 + hf * 64) * CNT_STRIDE;
        int o = 0, ts = 0;
        for (int e = 0; e < NEX; ++e) { const int n = e < NE ? (int)CNT[e * CNT_STRIDE] : HALF_T; cnt[e] = n; off[e] = o; tst[e] = ts; o += (n + 255) & ~255; ts += (n + 255) >> 8; }
        tst[NEX] = ts;
    }
    __syncthreads();
}
struct MoeSched1 { LAS const int* cnt; LAS const int* off; LAS const int* tst; int G, c; const char* XN2; const char* WGU; const int* ROWL; const float* WL; const int* IDENT;
    __device__ __forceinline__ bool next(int i, g8::GUnit& u) const {
        const int L = i * G + c; if (L >= 2 * tst[NEX]) return false;
        const int rt = L >> 1, pn = L & 1; int e = 0; while (tst[e + 1] <= rt) ++e;
        const int r0 = (rt - tst[e]) * 256;
        u.A = XN2; u.B = WGU + ((size_t)e * 512 + (size_t)pn * 256) * 2048;
        u.rl = e < NE ? ROWL + (size_t)e * 16384 + r0 : IDENT + r0; u.nvalid = cnt[e] - r0; u.erow0 = 0; u.ecol0 = pn * 256; u.x0 = off[e] + r0; u.xp = e < NE ? WL + (size_t)e * 16384 + r0 : nullptr; return true; } };
struct MoeSched2 { LAS const int* cnt; LAS const int* off; LAS const int* tst; int G, c; const char* HID; const char* WD;
    __device__ __forceinline__ bool next(int i, g8::GUnit& u) const {
        const int L = i * G + c; if (L >= 4 * tst[NEX]) return false;
        const int rt = L >> 2, pn = L & 3; int e = 0; while (tst[e + 1] <= rt) ++e;
        const int r0 = (rt - tst[e]) * 256;
        u.A = HID + (size_t)(off[e] + r0) * 512; u.B = WD + ((size_t)e * 1024 + (size_t)pn * 256) * 512;
        u.rl = nullptr; u.nvalid = 0; u.erow0 = 0; u.ecol0 = pn * 256; u.x0 = off[e] + r0; u.xp = nullptr; return true; } };
struct EpiG1u { bf16* HID; struct Pre { float w; }; static constexpr int BATCH_M = 4; static constexpr bool PERM = true;
    __device__ __forceinline__ void post8(const g8::GUnit& u, int row, int col, f32x4 a0, f32x4 a1, f32x4 b0, f32x4 b1, const Pre& p, int) const {
        const int hc = col - 128 * (col >> 8);
        f32x4 v0 = (f32x4){0.f, 0.f, 0.f, 0.f}, v1 = v0;
        if (row < u.nvalid) {
#pragma unroll
            for (int i = 0; i < 4; ++i) { v0[i] = siluf_(a0[i]) * b0[i] * p.w; v1[i] = siluf_(a1[i]) * b1[i] * p.w; } }
        st_bf8(HID + (size_t)(u.x0 + row) * 256 + hc, v0, v1);
    }
    __device__ __forceinline__ Pre pre(const g8::GUnit& u, int row, int, int) const { return Pre{(u.xp && row < u.nvalid) ? u.xp[row] : 1.f}; }
    __device__ __forceinline__ void post(const g8::GUnit& u, int row, int col, f32x4 lo, f32x4 hi, const Pre& p, int) const {
        const int hc = col - 128 * (col >> 8);
        f32x4 v = (f32x4){0.f, 0.f, 0.f, 0.f};
        if (row < u.nvalid) { const float w = p.w;
#pragma unroll
            for (int i = 0; i < 4; ++i) v[i] = siluf_(lo[i]) * hi[i] * w; }
        st_bf4(HID + (size_t)(u.x0 + row) * 256 + hc, v);
    } };
constexpr float Y_SCALE = 16.f, Y_UNSCALE = 1.f / 16.f;
__device__ __forceinline__ unsigned pk4_fp8(f32x4 v) { int w = __builtin_amdgcn_cvt_pk_fp8_f32(v[0] * Y_SCALE, v[1] * Y_SCALE, 0, false); w = __builtin_amdgcn_cvt_pk_fp8_f32(v[2] * Y_SCALE, v[3] * Y_SCALE, w, true); return (unsigned)w; }
__device__ __forceinline__ f32x4 up4_fp8(unsigned q) { return (f32x4){__builtin_amdgcn_cvt_f32_fp8((int)q, 0), __builtin_amdgcn_cvt_f32_fp8((int)q, 1), __builtin_amdgcn_cvt_f32_fp8((int)q, 2), __builtin_amdgcn_cvt_f32_fp8((int)q, 3)}; }
struct EpiG2u { unsigned char* Y; typedef NoPre Pre; static constexpr int BATCH_M = 4; static constexpr bool PERM = true;
    __device__ __forceinline__ Pre pre(const g8::GUnit&, int, int, int) const { return Pre{}; }
    __device__ __forceinline__ void post(const g8::GUnit&, int, int, f32x4, f32x4, const Pre&, int) const {}
    __device__ __forceinline__ void post8(const g8::GUnit& u, int row, int col, f32x4 a0, f32x4 a1, f32x4 b0, f32x4 b1, const Pre&, int) const {
        unsigned char* y = Y + (size_t)(u.x0 + row) * 1024 + col;
        *(u32x2*)y = (u32x2){pk4_fp8(a0), pk4_fp8(a1)}; *(u32x2*)(y + 128) = (u32x2){pk4_fp8(b0), pk4_fp8(b1)};
    } };
__device__ __forceinline__ void phase_gemm1(const Ctx& c, int l, int hf) {
    moe_tables(c, l, hf);
    LAS int* cnt = (LAS int*)(c.lds + 140000); LAS int* off = cnt + 65; LAS int* tst = off + 65;
    MoeSched1 S{cnt, off, tst, c.nblk, c.bid, (const char*)(c.ws + WS_XN2), (const char*)(c.ws + WS_WGU), (const int*)(c.ws + WS_ROWL) + (size_t)hf * 64 * 16384, (const float*)(c.ws + WS_WL) + (size_t)hf * 64 * 16384,
                (const int*)(c.ws + WS_IDENT) + (size_t)hf * HALF_T};
    EpiG1u E{(bf16*)(c.ws + WS_HID)};
    g8::gemm_phase<true>(c.lds, 2048u, 1024, S, E);
    __syncthreads();
}
__device__ __forceinline__ void phase_gemm2(const Ctx& c, int l, int hf) {
    moe_tables(c, l, hf);
    LAS int* cnt = (LAS int*)(c.lds + 140000); LAS int* off = cnt + 65; LAS int* tst = off + 65;
    MoeSched2 S{cnt, off, tst, c.nblk, c.bid, (const char*)(c.ws + WS_HID), (const char*)(c.ws + WS_WD)};
    EpiG2u E{(unsigned char*)(c.ws + WS_Y)};
    g8::gemm_phase<false>(c.lds, 512u, 256, S, E);
    __syncthreads();
}
__device__ __forceinline__ void phase_combine(const Ctx& c, int l, int hf, float* xio) {
    moe_tables(c, l, hf);
    LAS int* off = (LAS int*)(c.lds + 140000) + 65;
    const int gw = c.bid * NWAVES + c.wave, NGW = c.nblk * NWAVES, lane = c.lane;
    const unsigned char* Y = (const unsigned char*)(c.ws + WS_Y); const unsigned* TOKPOS = (const unsigned*)(c.ws + WS_TOKPOS);
    const float* MODl = (const float*)(c.ws + WS_MOD) + (size_t)l * 16 * 6144;
    const float* MODn = (const float*)(c.ws + WS_MOD) + (size_t)1 * 16 * 6144;
    bf16* XN = (bf16*)(c.ws + WS_XN);
    unsigned tpn[TOPK];
    if (gw < HALF_T) {
#pragma unroll
        for (int kk = 0; kk < TOPK; ++kk) tpn[kk] = TOKPOS[(size_t)(hf * HALF_T + gw) * 6 + kk]; }
#pragma unroll 1
    for (int tt = gw; tt < HALF_T; tt += NGW) {
        const int t = hf * HALF_T + tt, b = t >> 11;
        unsigned tp[TOPK];
#pragma unroll
        for (int kk = 0; kk < TOPK; ++kk) tp[kk] = tpn[kk];
        f32x4 acc[4];
        unsigned yv[TOPK + 1][4];
        { const unsigned char* yr = Y + (size_t)(off[NE] + tt) * 1024;
#pragma unroll
          for (int j = 0; j < 4; ++j) yv[TOPK][j] = *(const unsigned*)(yr + 4 * (lane + 64 * j)); }
#pragma unroll
        for (int kk = 0; kk < TOPK; ++kk) {
            const int e = tp[kk] >> 16, slot = tp[kk] & 0xffff;
            const unsigned char* yr = Y + (size_t)(off[e] + slot) * 1024;
#pragma unroll
            for (int j = 0; j < 4; ++j) yv[kk][j] = *(const unsigned*)(yr + 4 * (lane + 64 * j));
        }
        if (tt + NGW < HALF_T) {
#pragma unroll
            for (int kk = 0; kk < TOPK; ++kk) tpn[kk] = TOKPOS[(size_t)(t + NGW) * 6 + kk]; }
#pragma unroll
        for (int j = 0; j < 4; ++j) { acc[j] = up4_fp8(yv[TOPK][j]);
#pragma unroll
            for (int kk = 0; kk < TOPK; ++kk) acc[j] += up4_fp8(yv[kk][j]);
            acc[j] *= Y_UNSCALE; }
        float* xr = xio + (size_t)t * D; const float* g2 = MODl + (size_t)b * 6144 + 5120;
        f32x4 v[4]; float s = 0.f;
#pragma unroll
        for (int j = 0; j < 4; ++j) { const int cc = 4 * (lane + 64 * j); v[j] = *(const f32x4*)(xr + cc) + *(const f32x4*)(g2 + cc) * acc[j]; s += v[j][0] * v[j][0] + v[j][1] * v[j][1] + v[j][2] * v[j][2] + v[j][3] * v[j][3]; }
        const float rstd = rsqrtf(wave_sum(s) * (1.f / D) + EPS);
        if (l == 0) {
#pragma unroll
            for (int j = 0; j < 4; ++j) { const int cc = 4 * (lane + 64 * j); *(f32x4*)(xr + cc) = v[j];
                const f32x4 g = *(const f32x4*)(c.in[IN_NMIX] + D + cc), a = *(const f32x4*)(MODn + (size_t)b * 6144 + 1024 + cc), bb = *(const f32x4*)(MODn + (size_t)b * 6144 + cc);
                st_bf4(XN + (size_t)t * D + cc, v[j] * rstd * g * (a + 1.f) + bb); }
        } else {
#pragma unroll
            for (int j = 0; j < 4; ++j) { const int cc = 4 * (lane + 64 * j); *(f32x4*)(xr + cc) = v[j] * rstd * *(const f32x4*)(c.in[IN_NFIN] + cc); }
        }
    }
}

#ifdef DSA_NO_SEL
#define DSA_SEL_CALL
#else
#define DSA_SEL_CALL phase_ckvt(c); for (int r2 = 0; r2 < REPN(20); ++r2) phase_dsa_sel(c, l);
#endif
#ifdef DSA_NO_ATT
#define DSA_ATT_CALL
#else
#define DSA_ATT_CALL for (int r2 = 0; r2 < REPN(21); ++r2) phase_dsa_att(c, l);
#endif
constexpr int PH_PER_L = 18, N_PHASES = 1 + NL * PH_PER_L;
#ifndef PH_MASK
#define PH_MASK 0xFFFFFFFFu
#endif
#define IN(k) (lo <= (k) && (k) < hi)
#define EN(b) ((PH_MASK >> (b)) & 1u)
#ifndef REP_MASK
#define REP_MASK 0u
#endif
#define REPN(b) (((REP_MASK >> (b)) & 1u) ? 2 : 1)
#define SEAM(k) do { if (MK_ONE_LAUNCH && IN(k) && IN((k) + 1)) xcd_barrier(bar); } while (0)
template <int l>
__device__ __forceinline__ void layer_program(const Ctx& c, const XcdBarrier& bar, int lo, int hi) {
        const int P = 1 + l * PH_PER_L;
        const float* xin = l == 0 ? c.in[IN_X] : c.out;
        bf16* PB = (bf16*)(c.ws + WS_PB); float* SM = (float*)(c.ws + WS_SM);
        const bf16* XN = (const bf16*)(c.ws + WS_XN);
        const bf16* WIN = (const bf16*)(c.ws + WS_WIN) + (size_t)l * NINP * 1024;
        if (EN(1) && IN(P + 0)) { for (int rep = 0; rep < REPN(1); ++rep) {  if (l == 0) phase_norm1(c, 0, c.in[IN_X]);  if (rep + 1 < REPN(1)) xcd_barrier(bar); } } if (l == 0) SEAM(P + 0);
        if (EN(2) && IN(P + 1)) { for (int rep = 0; rep < REPN(2); ++rep) {  EpiInPB E{PB, SM}; dgemm_phase(c, XN, 1024, T, WIN, NPB / 256, 1024, EpiU<decltype(E)>{E});  if (rep + 1 < REPN(2)) xcd_barrier(bar); } } SEAM(P + 1);
        if (EN(3) && IN(P + 2)) { for (int rep = 0; rep < REPN(3); ++rep) {  phase_prep(c, l);  if (rep + 1 < REPN(3)) xcd_barrier(bar); } } SEAM(P + 2);
        if (EN(4) && IN(P + 3)) { for (int rep = 0; rep < REPN(4); ++rep) {
#if SCAN_3PASS
            for (int r2 = 0; r2 < REPN(22); ++r2) phase_scanA(c, l);
            xcd_barrier(bar); scanB(c);
            { EpiQ Eq{(bf16*)(c.ws + WS_QLAT), (bf16*)(c.ws + WS_QIDX), (const float*)(c.ws + WS_RSTDQ)};
              dgemm_phase(c, PB + PB_CQ, NPB, T, (const bf16*)(c.ws + WS_WQ) + (size_t)l * 1280 * 256, 5, 256, EpiU<decltype(Eq)>{Eq}); }
            xcd_barrier(bar); phase_scanC(c, l);
#else
            phase_scans(c, l);
#endif
            if (rep + 1 < REPN(4)) xcd_barrier(bar); } } SEAM(P + 3);
        if (EN(6) && IN(P + 5)) { for (int rep = 0; rep < REPN(6); ++rep) {  EpiGate E{(bf16*)(c.ws + WS_G)}; dgemm_phase(c, XN, 1024, T, WIN + (size_t)NPB * 1024, NG / 256, 1024, EpiU<decltype(E)>{E});  if (rep + 1 < REPN(6)) xcd_barrier(bar); } }
        if (EN(7) && IN(P + 6)) { for (int rep = 0; rep < REPN(7); ++rep) {  DSA_SEL_CALL xcd_barrier(bar); DSA_ATT_CALL  if (rep + 1 < REPN(7)) xcd_barrier(bar); } } SEAM(P + 6);
        if (EN(8) && IN(P + 7)) {
            { EpiUp E{(bf16*)(c.ws + WS_M1), (bf16*)(c.ws + WS_MF), (const bf16*)(c.ws + WS_G), 0, 1, 0};
              dgemm_phase(c, (const bf16*)(c.ws + WS_UA), 512, T, (const bf16*)(c.ws + WS_WUPA) + (size_t)l * 1024 * 512, 4, 512, EpiU<decltype(E)>{E}); }
            { EpiUp E{(bf16*)(c.ws + WS_M1), (bf16*)(c.ws + WS_MF), (const bf16*)(c.ws + WS_G), 1, 0, 0};
              dgemm_phase(c, (const bf16*)(c.ws + WS_OLAT), 512, T, (const bf16*)(c.ws + WS_WUPB) + (size_t)l * 1024 * 512, 4, 512, EpiU<decltype(E)>{E}); }
            { EpiUp E{(bf16*)(c.ws + WS_M1), (bf16*)(c.ws + WS_MF), (const bf16*)(c.ws + WS_G), 2, 0, 1};
              dgemm_phase(c, (const bf16*)(c.ws + WS_UC), 512, T, (const bf16*)(c.ws + WS_WUPC) + (size_t)l * 1024 * 512, 4, 512, EpiU<decltype(E)>{E}); }
        } SEAM(P + 9);
        if (EN(11) && IN(P + 10)) { for (int rep = 0; rep < REPN(11); ++rep) {  EpiWo E{xin, c.out, (const float*)(c.ws + WS_MOD) + (size_t)l * 16 * 6144 + 2048};
            dgemm_phase(c, (const bf16*)(c.ws + WS_M1), 1024, T, (const bf16*)(c.ws + WS_WO) + (size_t)l * 1024 * 1024, 4, 1024, EpiU<decltype(E)>{E});  if (rep + 1 < REPN(11)) xcd_barrier(bar); } } SEAM(P + 10);
        if (EN(12) && IN(P + 11)) { for (int rep = 0; rep < REPN(12); ++rep) {  phase_route(c, l, c.out);  if (rep + 1 < REPN(12)) xcd_barrier(bar); } } SEAM(P + 11);
        if (EN(13) && IN(P + 12)) { for (int rep = 0; rep < REPN(13); ++rep) {  phase_gemm1(c, l, 0);  if (rep + 1 < REPN(13)) xcd_barrier(bar); } } SEAM(P + 12);
        if (EN(14) && IN(P + 13)) { for (int rep = 0; rep < REPN(14); ++rep) {  phase_gemm2(c, l, 0);  if (rep + 1 < REPN(14)) xcd_barrier(bar); } } SEAM(P + 13);
        if (EN(15) && IN(P + 14)) { phase_combine(c, l, 0, c.out); phase_gemm1(c, l, 1); } SEAM(P + 14);
        if (EN(17) && IN(P + 16)) { for (int rep = 0; rep < REPN(17); ++rep) {  phase_gemm2(c, l, 1);  if (rep + 1 < REPN(17)) xcd_barrier(bar); } } SEAM(P + 16);
        if (EN(18) && IN(P + 17)) { for (int rep = 0; rep < REPN(18); ++rep) {  phase_combine(c, l, 1, c.out);  if (rep + 1 < REPN(18)) xcd_barrier(bar); } } SEAM(P + 17);
    }
__global__ void __launch_bounds__(NTHR, 2) fwd(Args args) {
    extern __shared__ __attribute__((aligned(16))) unsigned char lds_raw[];
    Ctx c;
    c.lds = (LAS unsigned char*)lds_raw;
    c.tid = threadIdx.x; c.lane = c.tid & 63; c.wave = __builtin_amdgcn_readfirstlane(c.tid >> 6);
    c.bid = blockIdx.x; c.nblk = gridDim.x;
    c.in = args.in; c.out = args.out; c.ws = args.ws;
    for (int u = c.tid; u < (LDS_BYTES - LDS_MISC) / 4; u += NTHR) ((LAS unsigned*)(c.lds + LDS_MISC))[u] = 0u;
    __syncthreads();
    XcdBarrier bar; bar.bar = (unsigned*)(c.ws + WS_CTL) + CW_BAR; bar.x = 0; bar.st = (volatile LAS unsigned*)(c.lds + LDS_MISC);
    if (MK_ONE_LAUNCH) bar = xcd_barrier_post((unsigned*)(c.ws + WS_CTL) + CW_BAR, (volatile LAS unsigned*)(c.lds + LDS_MISC));
    const int lo = args.ph_lo, hi = args.ph_hi;
#if PROBE_SEAM >= 0
    const unsigned long long t_start = wall_clock64();
#endif
    if (EN(0) && IN(0)) { for (int rep = 0; rep < REPN(0); ++rep) { phase_prologue(c); if (rep + 1 < REPN(0)) xcd_barrier(bar); } } SEAM(0);
    layer_program<0>(c, bar, lo, hi);
    layer_program<1>(c, bar, lo, hi);
#if PROBE_SEAM >= 0
    if (blockIdx.x == 0 && threadIdx.x == 0) {
        const unsigned long long* st = (const unsigned long long*)(bar.bar + 8192);
        const unsigned long long t = (PROBE_SEAM >= 1000 ? wall_clock64() : st[PROBE_SEAM]) - t_start, t0 = wall_clock64();
        while (wall_clock64() - t0 < 7ull * t) __builtin_amdgcn_s_sleep(8);
    }
#endif
#undef IN
#undef SEAM
}

extern "C" void kernel_launch(void* const* d_in, const int* in_sizes, int n_in, void* d_out, int out_size, void* d_ws, size_t ws_size, hipStream_t stream) {
    static int grid = 0;
    if (grid == 0) {
        if (n_in != 33 || out_size != T * D || ws_size < WS_END) { fprintf(stderr, "kernel_launch: unexpected problem (n_in %d out %d ws %zu)\n", n_in, out_size, ws_size); grid = -1; return; }
        int dev = 0, cus = 0, per_cu = 0;
        if (hipGetDevice(&dev) != hipSuccess || hipDeviceGetAttribute(&cus, hipDeviceAttributeMultiprocessorCount, dev) != hipSuccess) { grid = -1; return; }
        if (hipFuncSetAttribute((const void*)fwd, hipFuncAttributeMaxDynamicSharedMemorySize, LDS_BYTES) != hipSuccess) { fprintf(stderr, "kernel_launch: hipFuncSetAttribute failed\n"); grid = -1; return; }
        if (hipOccupancyMaxActiveBlocksPerMultiprocessor(&per_cu, (const void*)fwd, NTHR, LDS_BYTES) != hipSuccess || per_cu < 1) { fprintf(stderr, "kernel_launch: occupancy query says %d\n", per_cu); }
        (void)hipGetLastError();
        grid = cus;
    }
    if (grid < 0) return;
    (void)hipMemsetAsync((char*)d_ws + WS_CTL, 0, CTL_BYTES, stream);
    Args a{};
    for (int i = 0; i < 33; ++i) a.in[i] = (const float*)d_in[i];
    a.out = (float*)d_out; a.ws = (unsigned char*)d_ws;
#if MK_ONE_LAUNCH
    a.ph_lo = 0; a.ph_hi = N_PHASES;
    hipLaunchKernelGGL(fwd, dim3(grid), dim3(NTHR), LDS_BYTES, stream, a);
#else
    for (int p = 0; p < N_PHASES; ++p) {
        if (p == 1 + PH_PER_L) continue;
        a.ph_lo = p; a.ph_hi = p + 1;
        hipLaunchKernelGGL(fwd, dim3(grid), dim3(NTHR), LDS_BYTES, stream, a);
    }
#endif
}
```

```cpp
#include <hip/hip_runtime.h>
#include <cstdio>
#include <cstdint>

#define LAS __attribute__((address_space(3)))
#define GAS __attribute__((address_space(1)))
typedef unsigned short bf16;
typedef short bf16x8 __attribute__((ext_vector_type(8)));
typedef float f32x4 __attribute__((ext_vector_type(4)));
typedef float f32x2 __attribute__((ext_vector_type(2)));
typedef unsigned u32x4 __attribute__((ext_vector_type(4)));
typedef unsigned u32x2 __attribute__((ext_vector_type(2)));
typedef GAS unsigned gu32;

#ifndef PROBE_SEAM
#define PROBE_SEAM -1
#endif
#ifndef SCAN_3PASS
#define SCAN_3PASS 1
#endif
#ifndef SCAN_RECURRENT
#define SCAN_RECURRENT 0
#endif
#ifndef CONV_REP
#define CONV_REP 1
#endif
#ifndef MK_ONE_LAUNCH
#define MK_ONE_LAUNCH 1
#endif

constexpr int NB = 16, SEQ = 2048, D = 1024, T = NB * SEQ, NL = 2;
constexpr int NIN = 6592, NPB = 3584, NG = 3072, NINP = NPB + NG;
constexpr int NE = 64, NEX = 65, EFF = 256, TOPK = 6;
constexpr int HALF_T = T / 2;
constexpr int DSA_K = 256;
constexpr float EPS = 1e-6f;
constexpr int NTHR = 512, NWAVES = 8;

constexpr int PB_QA = 0, PB_KA = 256, PB_VA = 512, PB_GA = 1024, PB_CQ = 1536, PB_CKV = 1792, PB_QC = 2048, PB_KC = 2304, PB_VC = 2560, PB_OC = 3072;
constexpr int SM_KIDX = 0, SM_ALR = 32, SM_WIDX = 48, SM_IC = 56, SM_FC = 60;

constexpr size_t MiB = 1u << 20;
constexpr size_t WS_CTL = 0, CTL_BYTES = 1 * MiB;
constexpr size_t WS_MOD = 1 * MiB;
constexpr size_t WS_RSTDQ = 2 * MiB;
constexpr size_t WS_TOKPOS = 3 * MiB;
constexpr size_t WS_IDENT = 3 * MiB + 800 * 1024;
constexpr size_t WS_WIN = 4 * MiB;
constexpr size_t WS_WQ = 30 * MiB;
constexpr size_t WS_WUPA = 32 * MiB;
constexpr size_t WS_WUPC = 34 * MiB;
constexpr size_t WS_WUPB = 36 * MiB;
constexpr size_t WS_WUVF = 38 * MiB;
constexpr size_t WS_WO = 40 * MiB;
constexpr size_t WS_WGU = 44 * MiB;
constexpr size_t WS_WD = 109 * MiB;
constexpr size_t WS_XN = 142 * MiB;
constexpr size_t WS_OLAT = WS_XN;
constexpr size_t WS_UA = 206 * MiB;
constexpr size_t WS_UC = 238 * MiB;
constexpr size_t WS_XN2 = 206 * MiB;
constexpr size_t WS_QLAT = 270 * MiB;
constexpr size_t WS_M1 = WS_QLAT;
constexpr size_t WS_QIDX = 334 * MiB;
constexpr size_t WS_CKVN = 350 * MiB;
constexpr size_t WS_KIDX = 358 * MiB;
constexpr size_t WS_SM = 360 * MiB;
constexpr size_t WS_PB = 376 * MiB;
constexpr size_t WS_G = WS_PB;
constexpr size_t WS_HID = 270 * MiB;
constexpr size_t WS_Y = 334 * MiB;
constexpr size_t WS_ROWL = 590 * MiB;
constexpr size_t WS_WL = 598 * MiB;
constexpr size_t WS_CKVT = 576 * MiB;
constexpr size_t WS_MASK = 584 * MiB;
static_assert(WS_CKVT >= WS_G + (size_t)T * NG * 2 && WS_MASK + (size_t)T * 64 * 4 <= WS_PB + (size_t)T * NPB * 2, "CKVT/MASK placement");
constexpr size_t WS_QS = 44 * MiB;
constexpr size_t WS_DSG = 76 * MiB;
constexpr size_t WS_DSM = 600 * MiB;
constexpr size_t WS_ET = 108 * MiB;
constexpr size_t WS_CT = 108 * MiB + 512 * 1024;
constexpr size_t WS_MP = 108 * MiB + 768 * 1024;
constexpr size_t WS_GPM = 109 * MiB;
constexpr size_t WS_GBC = 110 * MiB;
constexpr size_t WS_DN = 111 * MiB;
constexpr size_t WS_KEYB = 44 * MiB;
constexpr size_t WS_MF = 568 * MiB;
constexpr size_t WS_END = 636 * MiB;
static_assert(WS_PB + (size_t)T * NPB * 2 <= 600 * MiB, "PB");
static_assert(WS_Y + (size_t)131072 * 1024 * 2 <= WS_ROWL, "Y");

constexpr int CW_BAR = 4096;
constexpr int CW_CNT = 16384;
constexpr int CNT_STRIDE = 64;

constexpr int LDS_BYTES = 147456;
constexpr int LDS_MISC = 145408;

__device__ __forceinline__ unsigned f2bf(float f) { unsigned u = __builtin_bit_cast(unsigned, f); return (u + 0x7fffu + ((u >> 16) & 1u)) >> 16; }
__device__ __forceinline__ float bf2f(unsigned b) { return __builtin_bit_cast(float, b << 16); }
typedef __bf16 bf16x2_t __attribute__((ext_vector_type(2)));
__device__ __forceinline__ unsigned pk2(float lo, float hi) { const f32x2 v = {lo, hi}; const bf16x2_t b = __builtin_convertvector(v, bf16x2_t); return __builtin_bit_cast(unsigned, b); }
__device__ __forceinline__ float bflo(unsigned w) { return __builtin_bit_cast(float, w << 16); }
__device__ __forceinline__ float bfhi(unsigned w) { return __builtin_bit_cast(float, w & 0xffff0000u); }
__device__ __forceinline__ float wave_sum(float v) {
#pragma unroll
    for (int o = 1; o < 64; o <<= 1) v += __shfl_xor(v, o);
    return v;
}
__device__ __forceinline__ float wave_max(float v) {
#pragma unroll
    for (int o = 1; o < 64; o <<= 1) v = fmaxf(v, __shfl_xor(v, o));
    return v;
}
__device__ __forceinline__ int wave_sum_i(int v) {
#pragma unroll
    for (int o = 1; o < 64; o <<= 1) v += __shfl_xor(v, o);
    return v;
}
__device__ __forceinline__ void lds_barrier() { asm volatile("s_waitcnt lgkmcnt(0)" ::: "memory"); __builtin_amdgcn_s_barrier(); asm volatile("" ::: "memory"); }
__device__ __forceinline__ float sigmoid_exact(float x) { return 1.f / (1.f + __expf(-x)); }
__device__ __forceinline__ float sigmoidf_(float x) { return __builtin_amdgcn_rcpf(1.f + __builtin_amdgcn_exp2f(-1.4426950408889634f * x)); }
__device__ __forceinline__ float siluf_(float x) { return x * __builtin_amdgcn_rcpf(1.f + __builtin_amdgcn_exp2f(-1.4426950408889634f * x)); }
__device__ __forceinline__ float logsigmoidf_(float x) { return fminf(x, 0.f) - log1pf(__expf(-fabsf(x))); }
__device__ __forceinline__ float logsigmoid_fast(float x) { return fminf(x, 0.f) - __logf(1.f + __expf(-fabsf(x))); }
__device__ __forceinline__ void st_bf4(bf16* p, f32x4 v) { u32x2 w; w.x = pk2(v[0], v[1]); w.y = pk2(v[2], v[3]); *(u32x2*)p = w; }
__device__ __forceinline__ void st_bf8(bf16* p, f32x4 a, f32x4 b) { u32x4 w; w.x = pk2(a[0], a[1]); w.y = pk2(a[2], a[3]); w.z = pk2(b[0], b[1]); w.w = pk2(b[2], b[3]); *(u32x4*)p = w; }
__device__ __forceinline__ f32x4 ld_bf4_l2(const bf16* p) { const unsigned long long q = __hip_atomic_load((const unsigned long long*)p, __ATOMIC_RELAXED, __HIP_MEMORY_SCOPE_AGENT); const unsigned lo = (unsigned)q, hi = (unsigned)(q >> 32); return (f32x4){bflo(lo), bfhi(lo), bflo(hi), bfhi(hi)}; }
__device__ __forceinline__ f32x4 ld_bf4(const bf16* p) { u32x2 w = *(const u32x2*)p; return (f32x4){bflo(w.x), bfhi(w.x), bflo(w.y), bfhi(w.y)}; }

#define XB_TMO      128
#define XB_XCNT(j)  (256  + 64 * (j))
#define XB_XSUB(j)  (1280 + 64 * (j))
#define XB_XGEN(j)  (2304 + 64 * (j))
#define XB_TOP      3328
#define XB_TOPGEN   3392
#define XCD_BAR_WORDS 3456
#define XB_SPIN_CAP (1u << 22)
__device__ __forceinline__ unsigned xb_ld(unsigned* p)              { return __hip_atomic_load(p, __ATOMIC_RELAXED, __HIP_MEMORY_SCOPE_AGENT); }
__device__ __forceinline__ unsigned xb_add(unsigned* p, unsigned v) { return __hip_atomic_fetch_add(p, v, __ATOMIC_RELAXED, __HIP_MEMORY_SCOPE_AGENT); }
__device__ __forceinline__ unsigned xb_xcc_id() { return (unsigned)__builtin_amdgcn_s_getreg((3 << 11) | 20) & 0xFu; }
#define XB_SPIN(cond, bar) do { unsigned _sp = 0; while (cond) { __builtin_amdgcn_s_sleep(1); \
    if ((++_sp & 255u) == 0u) { if (xb_ld(&(bar)[XB_TMO])) break; if (_sp > XB_SPIN_CAP) { atomicAdd(&(bar)[XB_TMO], 1u); break; } } } } while (0)
struct XcdBarrier { unsigned* bar; unsigned x; volatile LAS unsigned* st; };
__device__ __forceinline__ XcdBarrier xcd_barrier_post(unsigned* bar, volatile LAS unsigned* st) {
    XcdBarrier b; b.bar = bar; b.x = xb_xcc_id(); b.st = st;
    if (threadIdx.x == 0) (void)xb_add(&bar[XB_XCNT(b.x)], 1u);
    return b;
}
__device__ __forceinline__ void xcd_barrier_complete(unsigned* bar, unsigned x, unsigned& nloc, unsigned& nx) {
    const unsigned G = gridDim.x * gridDim.y * gridDim.z;
    unsigned sum, cnt, mine, sp = 0u;
    for (;;) {
        sum = 0u; cnt = 0u; mine = 0u;
#pragma unroll
        for (unsigned j = 0; j < 16; ++j) { const unsigned c = xb_ld(&bar[XB_XCNT(j)]); sum += c; cnt += (c > 0u) ? 1u : 0u; mine = (j == x) ? c : mine; }
        if (sum == G) break;
        __builtin_amdgcn_s_sleep(1);
        if ((++sp & 255u) == 0u) { if (xb_ld(&bar[XB_TMO])) break; if (sp > XB_SPIN_CAP) { atomicAdd(&bar[XB_TMO], 1u); break; } }
    }
    nloc = mine > 0u ? mine : 1u; nx = cnt > 0u ? cnt : 1u;
}
__device__ __forceinline__ void xcd_barrier(const XcdBarrier& b) {
    asm volatile("s_waitcnt vmcnt(0)" ::: "memory");
    __syncthreads();
    if (threadIdx.x == 0) {
        unsigned* bar = b.bar;
        __builtin_amdgcn_s_waitcnt(0);
        unsigned nloc = b.st[0], nx = b.st[1];
        if (nloc == 0u) { xcd_barrier_complete(bar, b.x, nloc, nx); b.st[0] = nloc; b.st[1] = nx; }
        const unsigned old = xb_add(&bar[XB_XSUB(b.x)], 1u);
        const unsigned gen = old / nloc;
        if (old + 1u == (gen + 1u) * nloc) {
            __builtin_amdgcn_fence(__ATOMIC_RELEASE, "agent");
            asm volatile("s_waitcnt vmcnt(0)" ::: "memory");
            const unsigned og = xb_add(&bar[XB_TOP], 1u);
            const unsigned tg = og / nx;
            if (og + 1u == (tg + 1u) * nx) xb_add(&bar[XB_TOPGEN], 1u);
            else XB_SPIN(xb_ld(&bar[XB_TOPGEN]) == tg, bar);
            __builtin_amdgcn_fence(__ATOMIC_ACQUIRE, "agent");
            xb_add(&bar[XB_XGEN(b.x)], 1u);
            asm volatile("s_waitcnt vmcnt(0)" ::: "memory");
        } else {
            XB_SPIN(xb_ld(&bar[XB_XGEN(b.x)]) == gen, bar);
            __builtin_amdgcn_fence(__ATOMIC_ACQUIRE, "agent");
            asm volatile("s_waitcnt vmcnt(0)" ::: "memory");
        }
#if PROBE_SEAM >= 0
        if (blockIdx.x == 0) { const unsigned n = b.st[2]; ((unsigned long long*)(b.bar + 8192))[n] = wall_clock64(); b.st[2] = n + 1u; }
#endif
    }
    __syncthreads();
}

struct Args { const float* in[33]; float* out; unsigned char* ws; int ph_lo, ph_hi; };

struct Ctx {
    LAS unsigned char* lds;
    int tid, lane, wave, bid, nblk;
    const float* const* in;
    float* out; unsigned char* ws;
};
#define IN_X 0
#define IN_C 1
#define IN_ADAW 2
#define IN_ADAB 3
#define IN_NMIX 4
#define IN_NFFN 5
#define IN_WIN 6
#define IN_GLA_WA2 7
#define IN_GLA_BA 8
#define IN_GLA_NORM 9
#define IN_DSA_NQ 10
#define IN_DSA_NKV 11
#define IN_DSA_WUQ 12
#define IN_DSA_WUK 13
#define IN_DSA_WUV 14
#define IN_DSA_WQI 15
#define IN_ML_CONV 16
#define IN_ML_BI 17
#define IN_ML_BF 18
#define IN_ML_NORM 19
#define IN_WUPA 20
#define IN_WUPB 21
#define IN_WUPC 22
#define IN_WO 23
#define IN_RW 24
#define IN_RB 25
#define IN_EWG 26
#define IN_EWU 27
#define IN_EWD 28
#define IN_SWG 29
#define IN_SWU 30
#define IN_SWD 31
#define IN_NFIN 32

template <class SrcF>
__device__ __forceinline__ void tr_item(const SrcF& src, bf16* dst, int dst_ld, int n0, int k0, LAS float* scr, int lane) {
    const int j = lane & 31;
    const float* colp = src(n0 + j);
    const long ld = src.ld;
    float tv[32];
#pragma unroll
    for (int i = 0; i < 32; ++i) { const int kk = 2 * i + (lane >> 5); tv[i] = colp ? colp[(long)(k0 + kk) * ld] : 0.f; }
#pragma unroll
    for (int i = 0; i < 32; ++i) { const int kk = 2 * i + (lane >> 5); scr[kk * 33 + j] = tv[i]; }
    asm volatile("s_waitcnt lgkmcnt(0)" ::: "memory");
    const int c = lane & 7;
#pragma unroll
    for (int jj = 0; jj < 4; ++jj) { const int n = (lane >> 3) + 8 * jj; const LAS float* s = scr + (8 * c) * 33 + n;
        u32x4 o; o.x = pk2(s[0 * 33], s[1 * 33]); o.y = pk2(s[2 * 33], s[3 * 33]); o.z = pk2(s[4 * 33], s[5 * 33]); o.w = pk2(s[6 * 33], s[7 * 33]);
        *(u32x4*)(dst + (size_t)(n0 + n) * dst_ld + k0 + 8 * c) = o; }
    asm volatile("s_waitcnt lgkmcnt(0)" ::: "memory");
}
struct SrcPlain { const float* W; long ld; __device__ __forceinline__ const float* operator()(int n) const { return W + n; } };
__device__ __forceinline__ int win_src_col(int r) {
    if (r < 1536) return r;
    if (r < 1792) return 1552 + (r - 1536);
    if (r < 1920) return 1808 + (r - 1792);
    if (r < 1952) return 1936 + (r - 1920);
    if (r < 1968) return 1536 + (r - 1952);
    if (r < 1976) return 1968 + (r - 1968);
    if (r < 1980) return 3000 + (r - 1976);
    if (r < 1984) return 3004 + (r - 1980);
    if (r < 2048) return -1;
    if (r < 2560) return 1976 + (r - 2048);
    if (r < 3072) return 2488 + (r - 2560);
    if (r < 3584) return 3008 + (r - 3072);
    return 3520 + (r - 3584);
}
struct SrcWin { const float* W; long ld; __device__ __forceinline__ const float* operator()(int n) const { const int c = win_src_col(n); return c < 0 ? nullptr : W + c; } };
struct SrcGU { const float* Wg; const float* Wu; long ld;
    __device__ __forceinline__ const float* operator()(int r) const { const int pn = r >> 8, w = r & 255, j = 128 * pn + (w & 127); return (w < 128 ? Wg : Wu) + j; } };

constexpr int SG_LD = 40;
template <class Epi>
__device__ __forceinline__ void sgemm_unit(const Ctx& c, const bf16* A, int lda, const int* rowlist, int nvalid, int arow0, const bf16* Bt, int K, const Epi& E, int erow0, int ecol0) {
    LAS bf16* As = (LAS bf16*)c.lds;
    LAS bf16* Bs = (LAS bf16*)(c.lds + 128 * SG_LD * 2);
    const int tid = c.tid, lane = c.lane, wave = c.wave, wr = wave >> 2, wc = wave & 3, fr = lane & 15, fq = lane >> 4;
    const int lr = tid >> 2, ch = tid & 3;
    int srow = arow0 + lr;
    if (rowlist) { srow = (arow0 + lr < nvalid) ? rowlist[arow0 + lr] : 0; }
    const bf16* ap = A + (size_t)srow * lda + ch * 8;
    const bf16* bp0 = Bt + (size_t)lr * K + ch * 8;
    const bf16* bp1 = Bt + (size_t)(128 + lr) * K + ch * 8;
    f32x4 acc[2][4][2];
#pragma unroll
    for (int a = 0; a < 2; ++a)
#pragma unroll
        for (int m = 0; m < 4; ++m)
#pragma unroll
            for (int n = 0; n < 2; ++n) acc[a][m][n] = (f32x4){0.f, 0.f, 0.f, 0.f};
    u32x4 ra = *(const u32x4*)ap, rb0 = *(const u32x4*)bp0, rb1 = *(const u32x4*)bp1;
    for (int k0 = 0; k0 < K; k0 += 32) {
        __syncthreads();
        *(LAS u32x4*)(As + lr * SG_LD + ch * 8) = ra;
        *(LAS u32x4*)(Bs + lr * SG_LD + ch * 8) = rb0;
        *(LAS u32x4*)(Bs + (128 + lr) * SG_LD + ch * 8) = rb1;
        __syncthreads();
        if (k0 + 32 < K) { ra = *(const u32x4*)(ap + k0 + 32); rb0 = *(const u32x4*)(bp0 + k0 + 32); rb1 = *(const u32x4*)(bp1 + k0 + 32); }
        bf16x8 af[4], bfr[2][2];
#pragma unroll
        for (int m = 0; m < 4; ++m) af[m] = *(const LAS bf16x8*)(As + (wr * 64 + m * 16 + fr) * SG_LD + fq * 8);
#pragma unroll
        for (int bj = 0; bj < 2; ++bj)
#pragma unroll
            for (int n = 0; n < 2; ++n) bfr[bj][n] = *(const LAS bf16x8*)(Bs + (bj * 128 + wc * 32 + n * 16 + fr) * SG_LD + fq * 8);
#pragma unroll
        for (int bj = 0; bj < 2; ++bj)
#pragma unroll
            for (int m = 0; m < 4; ++m)
#pragma unroll
                for (int n = 0; n < 2; ++n) acc[bj][m][n] = __builtin_amdgcn_mfma_f32_16x16x32_bf16(bfr[bj][n], af[m], acc[bj][m][n], 0, 0, 0);
    }
#pragma unroll
    for (int m = 0; m < 4; ++m)
#pragma unroll
        for (int n = 0; n < 2; ++n) E(erow0 + wr * 64 + m * 16 + fr, ecol0 + wc * 32 + n * 16 + 4 * fq, acc[0][m][n], acc[1][m][n]);
}
template <class Epi>
__device__ __forceinline__ void sgemm_phase(const Ctx& c, const bf16* A, int lda, int M, const bf16* Bt, int ntn, int K, const Epi& E) {
    const int nu = (M / 128) * ntn;
    for (int u = c.bid; u < nu; u += c.nblk) {
        const int pm = u / ntn, pn = u % ntn;
        sgemm_unit(c, A, lda, nullptr, 0, pm * 128, Bt + (size_t)pn * 256 * K, K, E, pm * 128, pn * 256);
    }
    __syncthreads();
}


namespace g8 {
constexpr int BM = 256, BK = 64, HALF = 128, HTB = HALF * BK * 2, STAGE_BYTES = 8 * HTB, NXCD = 8, WGM = 8;
__host__ __device__ __forceinline__ int lds_byte(int r, int c) { const int st = (r >> 4) * 2 + (c >> 5), rr = r & 15, cc = c & 31, ob = rr * 64 + cc * 2; return st * 1024 + (ob ^ (((ob >> 9) & 1) << 5)); }
__host__ __device__ __forceinline__ void stage_rc(int b, int& R, int& C) { const int st = b / 1024, sb = b % 1024, swz = sb ^ (((sb >> 9) & 1) << 5); R = (st >> 1) * 16 + swz / 64; C = (st & 1) * 32 + (swz % 64) / 2; }
__host__ __device__ __forceinline__ int perm32(int rho) { const int n = rho >> 4, i = rho & 15; return 8 * (i >> 2) + 4 * n + (i & 3); }
struct GUnit { const char* A; const char* B; const int* rl; int nvalid; int erow0, ecol0; int x0; const float* xp; };
__device__ __forceinline__ bool static_order(int nM, int nN, int G, int c, int i, int& pm, int& pn) {
    const int nwg = nM * nN; const long L = (long)i * G + c; if (L >= nwg) return false;
    int wgid = (int)L; { const int q = nwg / NXCD, r = nwg % NXCD, xcd = wgid % NXCD, off = wgid / NXCD; wgid = (xcd < r ? xcd * (q + 1) : r * (q + 1) + (xcd - r) * q) + off; }
    const int nig = WGM * nN, gid = wgid / nig, fm = gid * WGM, gsz = (nM - fm) < WGM ? (nM - fm) : WGM;
    pm = fm + ((wgid % nig) % gsz); pn = (wgid % nig) / gsz; return true;
}
struct DenseSched { const char* A; const char* Bt; size_t ldaB, ldbB; int nM, nN, G, c;
    __device__ __forceinline__ bool next(int i, GUnit& u) const { int pm, pn; if (!static_order(nM, nN, G, c, i, pm, pn)) return false;
        u.A = A + (size_t)pm * 256 * ldaB; u.B = Bt + (size_t)pn * 256 * ldbB; u.rl = nullptr; u.nvalid = 0; u.erow0 = pm * 256; u.ecol0 = pn * 256; u.x0 = 0; u.xp = nullptr; return true; } };

template <bool GATHER, class Epi, class Sched>
__device__ __forceinline__ void gemm_phase(LAS unsigned char* lds, unsigned ldaB, int K, const Sched& S, const Epi& E) {
    const int tid = threadIdx.x, wid = __builtin_amdgcn_readfirstlane(tid >> 6), lane = tid & 63, wr = wid >> 2, wc = wid & 3, fr = lane & 15, fq = lane >> 4;
    const int nt = K / BK;
    int R0, C0, R1, C1; stage_rc(tid * 16, R0, C0); stage_rc(tid * 16 + 8192, R1, C1);
    unsigned voffB[2];
    if (Epi::PERM) { voffB[0] = (unsigned)(((R0 & ~31) + perm32(R0 & 31)) * K + C0) * 2u; voffB[1] = (unsigned)(((R1 & ~31) + perm32(R1 & 31)) * K + C1) * 2u; }
    else { voffB[0] = (unsigned)(R0 * K + C0) * 2u; voffB[1] = (unsigned)(R1 * K + C1) * 2u; }
    unsigned ac0[2], ac1[2], an0[2], an1[2];
    const size_t kstep = (size_t)(BK * 2);
    const size_t hstepB = (size_t)HALF * K * 2;
    const unsigned ldsw = (unsigned)wid * 1024u;
    const int aoff = lds_byte(wr * 64 + fr, fq * 8), boff = lds_byte(wc * 32 + fr, fq * 8);
#define G8_SA(b, h) (((b) * 2 + (h)) * HTB)
#define G8_SB(b, h) ((4 + (b) * 2 + (h)) * HTB)
#define G8_STAGE(bufoff, gbase, voff) do { _Pragma("unroll") for (int _i = 0; _i < 2; ++_i) \
        __builtin_amdgcn_global_load_lds((const unsigned*)((const char*)(gbase) + (voff)[_i]), (LAS unsigned*)(lds + (bufoff) + ldsw + _i * 8192), 16, 0, 0); } while (0)
#define G8_LDA(dst, b, h) do { _Pragma("unroll") for (int m = 0; m < 4; ++m) _Pragma("unroll") for (int k = 0; k < 2; ++k) dst[m][k] = *(const LAS bf16x8*)(lds + G8_SA(b, h) + aoff + m * 2048 + k * 1024); } while (0)
#define G8_LDB(dst, b, h) do { _Pragma("unroll") for (int n = 0; n < 2; ++n) _Pragma("unroll") for (int k = 0; k < 2; ++k) dst[n][k] = *(const LAS bf16x8*)(lds + G8_SB(b, h) + boff + n * 2048 + k * 1024); } while (0)
#define G8_MMA(ai, bj, At, Bt) do { __builtin_amdgcn_s_setprio(1); _Pragma("unroll") for (int m = 0; m < 4; ++m) _Pragma("unroll") for (int n = 0; n < 2; ++n) _Pragma("unroll") for (int k = 0; k < 2; ++k) \
        acc[ai][bj][m][n] = __builtin_amdgcn_mfma_f32_16x16x32_bf16(Bt[n][k], At[m][k], acc[ai][bj][m][n], 0, 0, 0); __builtin_amdgcn_s_setprio(0); } while (0)
#define G8_WAIT_V(n) asm volatile("s_waitcnt vmcnt(" #n ")" ::: "memory")
#define G8_WAIT_L(n) asm volatile("s_waitcnt lgkmcnt(" #n ")" ::: "memory")
#define G8_BAR __builtin_amdgcn_s_barrier()
#define G8_SCHED __builtin_amdgcn_sched_barrier(0)
#define G8_XLOAD(u) __builtin_amdgcn_global_load_lds((const unsigned*)((u).rl + lane * 4), (LAS unsigned*)(lds + STAGE_BYTES + wid * 1024), 16, 0, 0)
#define G8_AOFF(u, o0, o1) do { if (GATHER) { const LAS int* _rs = (const LAS int*)(lds + STAGE_BYTES + wid * 1024); const int _nv = (u).nvalid - 1; \
        const int _r00 = _rs[min(R0, _nv)], _r01 = _rs[min(R1, _nv)], _r10 = _rs[min(128 + R0, _nv)], _r11 = _rs[min(128 + R1, _nv)]; \
        o0[0] = (unsigned)_r00 * ldaB + (unsigned)C0 * 2u; o0[1] = (unsigned)_r01 * ldaB + (unsigned)C1 * 2u; o1[0] = (unsigned)_r10 * ldaB + (unsigned)C0 * 2u; o1[1] = (unsigned)_r11 * ldaB + (unsigned)C1 * 2u; \
    } else { o0[0] = (unsigned)R0 * ldaB + (unsigned)C0 * 2u; o0[1] = (unsigned)R1 * ldaB + (unsigned)C1 * 2u; o1[0] = (unsigned)(128 + R0) * ldaB + (unsigned)C0 * 2u; o1[1] = (unsigned)(128 + R1) * ldaB + (unsigned)C1 * 2u; } } while (0)
    GUnit cur, nxt; int ui = 0;
    if (!S.next(0, cur)) return;
    f32x4 acc[2][2][4][2];
#pragma unroll
    for (int a = 0; a < 2; ++a)
#pragma unroll
        for (int b = 0; b < 2; ++b)
#pragma unroll
            for (int m = 0; m < 4; ++m)
#pragma unroll
                for (int n = 0; n < 2; ++n) acc[a][b][m][n] = (f32x4){0.f, 0.f, 0.f, 0.f};
    bf16x8 At[4][2], B0[2][2], B1[2][2];
    if (GATHER) { G8_XLOAD(cur); G8_WAIT_V(0); }
    G8_AOFF(cur, ac0, ac1);
    if (GATHER) { G8_WAIT_L(0); }
    const char* cA = cur.A; const char* cB = cur.B;
    G8_STAGE(G8_SB(0, 0), cB, voffB); G8_STAGE(G8_SB(0, 1), cB + hstepB, voffB); G8_STAGE(G8_SA(0, 0), cA, ac0); G8_STAGE(G8_SA(0, 1), cA, ac1);
    if (wr == 1) G8_BAR;
    G8_WAIT_V(2); G8_BAR;
    G8_STAGE(G8_SB(1, 0), cB + kstep, voffB); G8_STAGE(G8_SA(1, 0), cA + kstep, ac0); G8_STAGE(G8_SB(1, 1), cB + hstepB + kstep, voffB);
    G8_WAIT_V(6); G8_BAR;
    for (;;) {
        const bool has_next = S.next(ui + 1, nxt);
        const char* nA = has_next ? nxt.A : cA; const char* nB = has_next ? nxt.B : cB;
        an0[0] = ac0[0]; an0[1] = ac0[1]; an1[0] = ac1[0]; an1[1] = ac1[1];
        const bool xload = GATHER && has_next;
        if (xload) { G8_XLOAD(nxt); }
#pragma unroll 1
        for (int t = 0; t < nt; t += 2) {
            const bool last = (t == nt - 2);
            const char* a1 = cA + (size_t)(t + 1) * kstep;
            const char* a2 = last ? nA : cA + (size_t)(t + 2) * kstep; const char* b2 = last ? nB : cB + (size_t)(t + 2) * kstep;
            const char* a3 = a2 + kstep; const char* b3 = b2 + kstep;
            unsigned* x0 = last ? an0 : ac0; unsigned* x1 = last ? an1 : ac1;
            unsigned s0[2], s1[2]; s0[0] = x0[0]; s0[1] = x0[1]; s1[0] = x1[0]; s1[1] = x1[1];
            G8_LDB(B0, 0, 0); G8_LDB(B1, 0, 1); G8_SCHED; G8_LDA(At, 0, 0); G8_STAGE(G8_SA(1, 1), a1, ac1);
            if (xload && t == 0) { G8_WAIT_V(9); } else { G8_WAIT_V(8); }
            G8_WAIT_L(0); G8_BAR; G8_MMA(0, 0, At, B0); G8_MMA(0, 1, At, B1); G8_BAR; G8_SCHED;
            G8_LDA(At, 0, 1); G8_STAGE(G8_SB(0, 0), b2, voffB); G8_STAGE(G8_SB(0, 1), b2 + hstepB, voffB); G8_STAGE(G8_SA(0, 0), a2, s0);
            G8_WAIT_V(8); G8_WAIT_L(0); G8_BAR; G8_MMA(1, 0, At, B0); G8_MMA(1, 1, At, B1); G8_BAR; G8_SCHED;
            if (xload && t == 0) { G8_AOFF(nxt, an0, an1); }
            G8_LDB(B0, 1, 0); G8_LDB(B1, 1, 1); G8_SCHED; G8_LDA(At, 1, 0); G8_STAGE(G8_SA(0, 1), a2, s1);
            G8_WAIT_V(8); G8_WAIT_L(0); G8_BAR; G8_MMA(0, 0, At, B0); G8_MMA(0, 1, At, B1); G8_BAR; G8_SCHED;
            G8_LDA(At, 1, 1); G8_STAGE(G8_SB(1, 0), b3, voffB); G8_STAGE(G8_SB(1, 1), b3 + hstepB, voffB); G8_STAGE(G8_SA(1, 0), a3, s0);
            G8_WAIT_V(8); G8_WAIT_L(0); G8_BAR; G8_MMA(1, 0, At, B0); G8_MMA(1, 1, At, B1); G8_BAR; G8_SCHED;
        }
        if (wr == 0) G8_BAR;
#pragma unroll
        for (int ai = 0; ai < 2; ++ai) {
            if constexpr (Epi::PERM) {
                typename Epi::Pre pr8[4];
                const int fb8 = (wid * 16 * 64 + lane) * 8;
#pragma unroll
                for (int m = 0; m < 4; ++m) pr8[m] = E.pre(cur, cur.erow0 + ai * HALF + wr * 64 + m * 16 + fr, cur.ecol0 + wc * 32 + 8 * fq, fb8 + ((ai * 4 + m) * 2) * 512);
#pragma unroll
                for (int m = 0; m < 4; ++m) E.post8(cur, cur.erow0 + ai * HALF + wr * 64 + m * 16 + fr, cur.ecol0 + wc * 32 + 8 * fq, acc[ai][0][m][0], acc[ai][0][m][1], acc[ai][1][m][0], acc[ai][1][m][1], pr8[m], fb8 + ((ai * 4 + m) * 2) * 512);
            } else {
            const int fragbase = (wid * 32 * 64 + lane) * 4;
            constexpr int BMR = Epi::BATCH_M;
#pragma unroll
            for (int m0 = 0; m0 < 4; m0 += BMR) {
                typename Epi::Pre pr[BMR][2];
#pragma unroll
                for (int mm = 0; mm < BMR; ++mm)
#pragma unroll
                    for (int n = 0; n < 2; ++n) { const int m = m0 + mm; pr[mm][n] = E.pre(cur, cur.erow0 + ai * HALF + wr * 64 + m * 16 + fr, cur.ecol0 + wc * 32 + n * 16 + 4 * fq, fragbase + (((ai * 4 + m) * 2 + n) * 2) * 256); }
#pragma unroll
                for (int mm = 0; mm < BMR; ++mm)
#pragma unroll
                    for (int n = 0; n < 2; ++n) { const int m = m0 + mm; E.post(cur, cur.erow0 + ai * HALF + wr * 64 + m * 16 + fr, cur.ecol0 + wc * 32 + n * 16 + 4 * fq, acc[ai][0][m][n], acc[ai][1][m][n], pr[mm][n], fragbase + (((ai * 4 + m) * 2 + n) * 2) * 256); }
            }
            }
        }
        if (!has_next) break;
#pragma unroll
        for (int a = 0; a < 2; ++a)
#pragma unroll
            for (int b = 0; b < 2; ++b)
#pragma unroll
                for (int m = 0; m < 4; ++m)
#pragma unroll
                    for (int n = 0; n < 2; ++n) acc[a][b][m][n] = (f32x4){0.f, 0.f, 0.f, 0.f};
        cur = nxt; cA = nA; cB = nB; ++ui;
        ac0[0] = an0[0]; ac0[1] = an0[1]; ac1[0] = an1[0]; ac1[1] = an1[1];
        if (wr == 1) G8_BAR;
    }
    G8_WAIT_V(0);
    G8_BAR;
#undef G8_SA
#undef G8_SB
#undef G8_STAGE
#undef G8_LDA
#undef G8_LDB
#undef G8_MMA
#undef G8_WAIT_V
#undef G8_WAIT_L
#undef G8_BAR
#undef G8_SCHED
#undef G8_AOFF
#undef G8_XLOAD
}
}
template <class Epi>
__device__ __forceinline__ void dgemm_phase(const Ctx& c, const bf16* A, int lda, int M, const bf16* Bt, int ntn, int K, const Epi& E, int G = -1, int cid = -1) {
    g8::DenseSched S{(const char*)A, (const char*)Bt, (size_t)lda * 2, (size_t)K * 2, M / 256, ntn, G < 0 ? c.nblk : G, cid < 0 ? c.bid : cid};
    g8::gemm_phase<false>(c.lds, (unsigned)lda * 2u, K, S, E);
    __syncthreads();
}


__device__ __forceinline__ size_t frag_off(int tile, int row, int col, int bj) {
    const int ai = row >> 7, wr = (row >> 6) & 1, m = (row >> 4) & 3, fr = row & 15, wc = col >> 5, n = (col >> 4) & 1, fq = (col >> 2) & 3;
    const int wave = wr * 4 + wc, lane = fq * 16 + fr, f = ((ai * 4 + m) * 2 + n) * 2 + bj;
    return ((((size_t)tile * 8 + wave) * 32 + f) * 64 + lane) * 4;
}
struct NoPre {};
struct EpiInPB { bf16* PB; float* SM; typedef NoPre Pre; static constexpr int BATCH_M = 4; static constexpr bool PERM = true;
    __device__ __forceinline__ void post8(int row, int col, f32x4 a0, f32x4 a1, f32x4 b0, f32x4 b1, const Pre&, int, int, int) const {
        st_bf8(PB + (size_t)row * NPB + col, a0, a1);
        if ((col >> 8) == 7) { float* sp = SM + (size_t)row * 128 + (col & 127); *(f32x4*)sp = b0; *(f32x4*)(sp + 4) = b1; }
        else st_bf8(PB + (size_t)row * NPB + col + 128, b0, b1);
    }
    __device__ __forceinline__ Pre pre(int, int, int, int, int) const { return Pre{}; }
    __device__ __forceinline__ void post(int row, int col, f32x4 lo, f32x4 hi, const Pre&, int, int, int) const { (*this)(row, col, lo, hi); }
    __device__ __forceinline__ void operator()(int row, int col, f32x4 lo, f32x4 hi) const {
        st_bf4(PB + (size_t)row * NPB + col, lo);
        if ((col >> 8) == 7) *(f32x4*)(SM + (size_t)row * 128 + (col & 127)) = hi;
        else st_bf4(PB + (size_t)row * NPB + col + 128, hi);
    } };
struct EpiQ { bf16* QLAT; bf16* QIDX; const float* rstd; struct Pre { float r; }; static constexpr int BATCH_M = 4; static constexpr bool PERM = true;
    __device__ __forceinline__ void post8(int row, int col, f32x4 a0, f32x4 a1, f32x4 b0, f32x4 b1, const Pre& p, int, int, int) const {
        const float r = p.r;
        if (col < 1024) { st_bf8(QLAT + (size_t)row * 1024 + col, a0 * r, a1 * r); st_bf8(QLAT + (size_t)row * 1024 + col + 128, b0 * r, b1 * r); }
        else { st_bf8(QIDX + (size_t)row * 256 + (col - 1024), a0 * r, a1 * r); st_bf8(QIDX + (size_t)row * 256 + (col - 1024) + 128, b0 * r, b1 * r); }
    }
    __device__ __forceinline__ Pre pre(int row, int, int, int, int) const { return Pre{rstd[row]}; }
    __device__ __forceinline__ void post(int row, int col, f32x4 lo, f32x4 hi, const Pre& p, int, int, int) const {
        const float r = p.r;
        if (col < 1024) { st_bf4(QLAT + (size_t)row * 1024 + col, lo * r); st_bf4(QLAT + (size_t)row * 1024 + col + 128, hi * r); }
        else { st_bf4(QIDX + (size_t)row * 256 + (col - 1024), lo * r); st_bf4(QIDX + (size_t)row * 256 + (col - 1024) + 128, hi * r); }
    } };
struct EpiGate { bf16* G; typedef NoPre Pre; static constexpr int BATCH_M = 4; static constexpr bool PERM = true;
    __device__ __forceinline__ Pre pre(int, int, int, int, int) const { return Pre{}; }
    __device__ __forceinline__ void post(int, int, f32x4, f32x4, const Pre&, int, int, int) const {}
    __device__ __forceinline__ void post8(int, int, f32x4 a0, f32x4 a1, f32x4 b0, f32x4 b1, const Pre&, int pm, int pn, int foff) const {
#pragma unroll
        for (int i = 0; i < 4; ++i) { a0[i] = sigmoidf_(a0[i]); a1[i] = sigmoidf_(a1[i]); b0[i] = sigmoidf_(b0[i]); b1[i] = sigmoidf_(b1[i]); }
        bf16* gt = G + (size_t)(((pn >> 2) * 128 + pm) * 4 + (pn & 3)) * 65536 + foff;
        st_bf8(gt, a0, a1); st_bf8(gt + 512, b0, b1);
    } };
struct EpiUp { bf16* M1; bf16* MF; const bf16* G; int br; int first; int last; struct Pre { u32x4 g0, g1, m0, m1; }; static constexpr int BATCH_M = 2; static constexpr bool PERM = true;
    __device__ __forceinline__ Pre pre(int, int, int pm, int pn, int foff) const {
        const bf16* gt = G + (size_t)((br * 128 + pm) * 4 + pn) * 65536 + foff; const bf16* mt = MF + (size_t)(pm * 4 + pn) * 65536 + foff;
        Pre p; p.g0 = *(const u32x4*)gt; p.g1 = *(const u32x4*)(gt + 512);
        p.m0 = (u32x4){0u, 0u, 0u, 0u}; p.m1 = p.m0;
        if (!first) { p.m0 = __builtin_nontemporal_load((const u32x4*)mt); p.m1 = __builtin_nontemporal_load((const u32x4*)(mt + 512)); }
        return p; }
    __device__ __forceinline__ void post(int, int, f32x4, f32x4, const Pre&, int, int, int) const {}
    __device__ __forceinline__ void post8(int row, int col, f32x4 a0, f32x4 a1, f32x4 b0, f32x4 b1, const Pre& p, int pm, int pn, int foff) const {
        a0 *= (f32x4){bflo(p.g0.x), bfhi(p.g0.x), bflo(p.g0.y), bfhi(p.g0.y)}; a1 *= (f32x4){bflo(p.g0.z), bfhi(p.g0.z), bflo(p.g0.w), bfhi(p.g0.w)};
        b0 *= (f32x4){bflo(p.g1.x), bfhi(p.g1.x), bflo(p.g1.y), bfhi(p.g1.y)}; b1 *= (f32x4){bflo(p.g1.z), bfhi(p.g1.z), bflo(p.g1.w), bfhi(p.g1.w)};
        if (!first) { a0 += (f32x4){bflo(p.m0.x), bfhi(p.m0.x), bflo(p.m0.y), bfhi(p.m0.y)}; a1 += (f32x4){bflo(p.m0.z), bfhi(p.m0.z), bflo(p.m0.w), bfhi(p.m0.w)};
                      b0 += (f32x4){bflo(p.m1.x), bfhi(p.m1.x), bflo(p.m1.y), bfhi(p.m1.y)}; b1 += (f32x4){bflo(p.m1.z), bfhi(p.m1.z), bflo(p.m1.w), bfhi(p.m1.w)}; }
        if (last) { bf16* m = M1 + (size_t)row * 1024 + col; st_bf8(m, a0, a1); st_bf8(m + 128, b0, b1); }
        else { bf16* mt = MF + (size_t)(pm * 4 + pn) * 65536 + foff; st_bf8(mt, a0, a1); st_bf8(mt + 512, b0, b1); }
    } };
struct EpiWo { const float* res; float* out; const float* g1;
    struct Pre { f32x4 ra, rb; }; static constexpr int BATCH_M = 4; static constexpr bool PERM = false;
    __device__ __forceinline__ void post8(int, int, f32x4, f32x4, f32x4, f32x4, const Pre&, int, int, int) const {}
    __device__ __forceinline__ Pre pre(int row, int col, int, int, int) const { const size_t o = (size_t)row * 1024 + col; return Pre{*(const f32x4*)(res + o), *(const f32x4*)(res + o + 128)}; }
    __device__ __forceinline__ void post(int row, int col, f32x4 lo, f32x4 hi, const Pre& p, int, int, int) const {
        const float* gp = g1 + (size_t)(row >> 11) * 6144 + col; const size_t o = (size_t)row * 1024 + col;
        const f32x4 ga = *(const f32x4*)gp, gb = *(const f32x4*)(gp + 128);
        *(f32x4*)(out + o) = p.ra + ga * lo; *(f32x4*)(out + o + 128) = p.rb + gb * hi;
    } };
struct EpiG1 { bf16* HID; const float* wl; int cnt; int orow0;
    __device__ __forceinline__ void operator()(int row, int col, f32x4 lo, f32x4 hi) const {
        const int hc = col - 128 * (col >> 8);
        f32x4 v = (f32x4){0.f, 0.f, 0.f, 0.f};
        if (row < cnt) { const float w = wl ? wl[row] : 1.f;
#pragma unroll
            for (int i = 0; i < 4; ++i) v[i] = siluf_(lo[i]) * hi[i] * w; }
        st_bf4(HID + (size_t)(orow0 + row) * 256 + hc, v);
    } };
struct EpiG2 { bf16* Y; int orow0;
    __device__ __forceinline__ void operator()(int row, int col, f32x4 lo, f32x4 hi) const {
        st_bf4(Y + (size_t)(orow0 + row) * 1024 + col, lo); st_bf4(Y + (size_t)(orow0 + row) * 1024 + col + 128, hi);
    } };


template <class F> struct EpiU { F f; typedef typename F::Pre Pre; static constexpr int BATCH_M = F::BATCH_M; static constexpr bool PERM = F::PERM;
    __device__ __forceinline__ void post8(const g8::GUnit& u, int row, int col, f32x4 a0, f32x4 a1, f32x4 b0, f32x4 b1, const Pre& p, int foff) const { f.post8(row, col, a0, a1, b0, b1, p, u.erow0 >> 8, u.ecol0 >> 8, foff); }
    __device__ __forceinline__ Pre pre(const g8::GUnit& u, int row, int col, int foff) const { return f.pre(row, col, u.erow0 >> 8, u.ecol0 >> 8, foff); }
    __device__ __forceinline__ void post(const g8::GUnit& u, int row, int col, f32x4 lo, f32x4 hi, const Pre& p, int foff) const { f.post(row, col, lo, hi, p, u.erow0 >> 8, u.ecol0 >> 8, foff); } };

__device__ __forceinline__ void phase_prologue(const Ctx& c) {
    {
        LAS float* cs = (LAS float*)c.lds;
        LAS float* red = (LAS float*)(c.lds + 65536);
        const float* cin = c.in[IN_C];
        if (c.bid < 192) {
            for (int i = c.tid; i < 16 * 1024; i += NTHR) cs[i] = siluf_(cin[i]);
            __syncthreads();
        }
        float* MOD = (float*)(c.ws + WS_MOD);
        for (int it = c.bid; it < 192; it += c.nblk) {
            const int l = it / 96, cg = it % 96, col = cg * 64 + c.lane;
            const float* W = c.in[IN_ADAW] + (size_t)l * 1024 * 6144 + col;
            float acc[16];
#pragma unroll
            for (int b = 0; b < 16; ++b) acc[b] = 0.f;
            const int kbeg = c.wave * 128;
#pragma unroll 4
            for (int k = kbeg; k < kbeg + 128; k += 4) {
                const float w0 = W[(size_t)k * 6144], w1 = W[(size_t)(k + 1) * 6144], w2 = W[(size_t)(k + 2) * 6144], w3 = W[(size_t)(k + 3) * 6144];
#pragma unroll
                for (int b = 0; b < 16; ++b) { const f32x4 v = *(const LAS f32x4*)(cs + b * 1024 + k); acc[b] += v[0] * w0 + v[1] * w1 + v[2] * w2 + v[3] * w3; }
            }
#pragma unroll
            for (int b = 0; b < 16; ++b) red[(c.wave * 16 + b) * 64 + c.lane] = acc[b];
            __syncthreads();
            for (int i = c.tid; i < 16 * 64; i += NTHR) { const int b = i >> 6, ln = i & 63; float s = 0.f;
#pragma unroll
                for (int w = 0; w < 8; ++w) s += red[(w * 16 + b) * 64 + ln];
                MOD[((size_t)l * 16 + b) * 6144 + cg * 64 + ln] = s + c.in[IN_ADAB][l * 6144 + cg * 64 + ln]; }
            __syncthreads();
        }
        __syncthreads();
    }
    {
        LAS float* scr = (LAS float*)(c.lds + c.wave * 16384);
        const int gw = c.bid * NWAVES + c.wave, NGW = c.nblk * NWAVES;
        constexpr int I_WIN = (NINP / 32) * (1024 / 64), I_UP = (1024 / 32) * (512 / 64), I_WO = (1024 / 32) * (1024 / 64);
        constexpr int PER_L = I_WIN + 3 * I_UP + I_WO;
        for (int it = gw; it < NL * PER_L; it += NGW) {
            const int l = it / PER_L; int r = it % PER_L;
            if (r < I_WIN) { SrcWin s{c.in[IN_WIN] + (size_t)l * 1024 * NIN, NIN}; tr_item(s, (bf16*)(c.ws + WS_WIN) + (size_t)l * NINP * 1024, 1024, (r / 16) * 32, (r % 16) * 64, scr, c.lane); continue; }
            r -= I_WIN;
            if (r < I_UP) { SrcPlain s{c.in[IN_WUPA] + (size_t)l * 512 * 1024, 1024}; tr_item(s, (bf16*)(c.ws + WS_WUPA) + (size_t)l * 1024 * 512, 512, (r / 8) * 32, (r % 8) * 64, scr, c.lane); continue; }
            r -= I_UP;
            if (r < I_UP) { SrcPlain s{c.in[IN_WUPC] + (size_t)l * 512 * 1024, 1024}; tr_item(s, (bf16*)(c.ws + WS_WUPC) + (size_t)l * 1024 * 512, 512, (r / 8) * 32, (r % 8) * 64, scr, c.lane); continue; }
            r -= I_UP;
            if (r < I_UP) { SrcPlain s{c.in[IN_WUPB] + (size_t)l * 512 * 1024, 1024}; tr_item(s, (bf16*)(c.ws + WS_WUPB) + (size_t)l * 1024 * 512, 512, (r / 8) * 32, (r % 8) * 64, scr, c.lane); continue; }
            r -= I_UP;
            { SrcPlain s{c.in[IN_WO] + (size_t)l * 1024 * 1024, 1024}; tr_item(s, (bf16*)(c.ws + WS_WO) + (size_t)l * 1024 * 1024, 1024, (r / 16) * 32, (r % 16) * 64, scr, c.lane); }
        }
    }
    {
        LAS float* uk_s = (LAS float*)c.lds;
        for (int it = (c.bid + 16 >= c.nblk) ? c.bid + 16 - c.nblk : c.bid + 16; it < NL * 8; it += c.nblk) {
            const int l = it >> 3, h = it & 7;
            __syncthreads();
            for (int i = c.tid; i < 128 * 16; i += NTHR) { const int cc = i >> 4, d4 = (i & 15) * 4;
                *(LAS f32x4*)(uk_s + cc * 64 + d4) = *(const f32x4*)(c.in[IN_DSA_WUK] + (size_t)l * 128 * 512 + (size_t)cc * 512 + h * 64 + d4); }
            const int r = c.tid & 255, ch = c.tid >> 8;
            f32x4 uq[16];
            { const float* up = c.in[IN_DSA_WUQ] + (size_t)l * 256 * 512 + (size_t)r * 512 + h * 64;
#pragma unroll
              for (int j = 0; j < 16; ++j) uq[j] = *(const f32x4*)(up + 4 * j); }
            const float sc = c.in[IN_DSA_NQ][l * 256 + r] * (0.125f * 1.4426950408889634f);
            __syncthreads();
            bf16* dst = (bf16*)(c.ws + WS_WQ) + (size_t)l * 1280 * 256 + (size_t)(h * 128 + ch * 64) * 256 + r;
#pragma unroll 2
            for (int cc = 0; cc < 64; ++cc) { const LAS float* kp = uk_s + (ch * 64 + cc) * 64; float acc = 0.f;
#pragma unroll
                for (int j = 0; j < 16; ++j) { const f32x4 kv = *(const LAS f32x4*)(kp + 4 * j); acc += uq[j][0] * kv[0] + uq[j][1] * kv[1] + uq[j][2] * kv[2] + uq[j][3] * kv[3]; }
                dst[(size_t)cc * 256] = (bf16)f2bf(acc * sc); }
        }
        __syncthreads();
    }
    {
        const int gt = c.bid * NTHR + c.tid, NGT = c.nblk * NTHR;
        for (int i = gt; i < T; i += NGT) ((int*)(c.ws + WS_IDENT))[i] = i;
        for (int it = gt; it < NL * 256 * 32; it += NGT) {
            const int l = it / (256 * 32), rem = it % (256 * 32), m = rem / 32, r0 = (rem % 32) * 8;
            const float* gq = c.in[IN_DSA_NQ] + l * 256;
            float o[8];
#pragma unroll
            for (int i = 0; i < 8; ++i) o[i] = c.in[IN_DSA_WQI][(size_t)l * 256 * 256 + (size_t)(r0 + i) * 256 + m] * 0.17677669529663687f * gq[r0 + i];
            u32x4 w; w.x = pk2(o[0], o[1]); w.y = pk2(o[2], o[3]); w.z = pk2(o[4], o[5]); w.w = pk2(o[6], o[7]);
            *(u32x4*)((bf16*)(c.ws + WS_WQ) + (size_t)l * 1280 * 256 + (size_t)(1024 + m) * 256 + r0) = w;
        }
    }
    {
        const int gt = c.bid * NTHR + c.tid, NGT = c.nblk * NTHR;
        for (int it = gt; it < NL * 8 * 4 * 4 * 64; it += NGT) {
            const int ln = it & 63, ks = (it >> 6) & 3, vt = (it >> 8) & 3, h = (it >> 10) & 7, l = it >> 13;
            const int fr = ln & 15, fq = ln >> 4;
            const float* uv = c.in[IN_DSA_WUV] + (size_t)l * 128 * 512 + h * 64 + 16 * vt + fr;
            float o[8];
#pragma unroll
            for (int e = 0; e < 8; ++e) { const int lat = 32 * ks + (e < 4 ? 4 * fq + e : 16 + 4 * fq + e - 4); o[e] = uv[(size_t)lat * 512]; }
            u32x4 w; w.x = pk2(o[0], o[1]); w.y = pk2(o[2], o[3]); w.z = pk2(o[4], o[5]); w.w = pk2(o[6], o[7]);
            *(u32x4*)((bf16*)(c.ws + WS_WUVF) + (size_t)it * 8) = w;
        }
    }
}

__device__ __forceinline__ void norm_mod_row(const float* xrow, const float* gain, const float* sh, const float* sc, bf16* orow, int lane) {
    f32x4 v[4]; float s = 0.f;
#pragma unroll
    for (int j = 0; j < 4; ++j) { v[j] = *(const f32x4*)(xrow + 4 * (lane + 64 * j)); s += v[j][0] * v[j][0] + v[j][1] * v[j][1] + v[j][2] * v[j][2] + v[j][3] * v[j][3]; }
    const float rstd = rsqrtf(wave_sum(s) * (1.f / D) + EPS);
#pragma unroll
    for (int j = 0; j < 4; ++j) { const int cc = 4 * (lane + 64 * j);
        const f32x4 g = *(const f32x4*)(gain + cc), a = *(const f32x4*)(sc + cc), b = *(const f32x4*)(sh + cc);
        st_bf4(orow + cc, v[j] * rstd * g * (a + 1.f) + b); }
}
__device__ __forceinline__ void phase_norm1(const Ctx& c, int l, const float* xsrc) {
    const int gw = c.bid * NWAVES + c.wave, NGW = c.nblk * NWAVES;
    const float* MOD = (const float*)(c.ws + WS_MOD) + (size_t)l * 16 * 6144;
    bf16* XN = (bf16*)(c.ws + WS_XN);
    for (int t = gw; t < T; t += NGW) { const int b = t >> 11;
        norm_mod_row(xsrc + (size_t)t * D, c.in[IN_NMIX] + l * D, MOD + (size_t)b * 6144, MOD + (size_t)b * 6144 + 1024, XN + (size_t)t * D, c.lane); }
}

__device__ __forceinline__ void phase_prep(const Ctx& c, int l) {
    const int gw = c.bid * NWAVES + c.wave, NGW = c.nblk * NWAVES;
    const bf16* PB = (const bf16*)(c.ws + WS_PB); const float* SM = (const float*)(c.ws + WS_SM);
    bf16* CKVN = (bf16*)(c.ws + WS_CKVN); bf16* KIDX = (bf16*)(c.ws + WS_KIDX); float* RSTDQ = (float*)(c.ws + WS_RSTDQ);
    const float* gkv = c.in[IN_DSA_NKV] + l * 128;
    const float g0 = gkv[2 * c.lane], g1 = gkv[2 * c.lane + 1];
    for (int t4 = gw * 4; t4 < T; t4 += NGW * 4) {
        unsigned kv[4]; u32x2 qv[4]; float ki[4];
#pragma unroll
        for (int r = 0; r < 4; ++r) { const bf16* row = PB + (size_t)(t4 + r) * NPB;
            kv[r] = *(const unsigned*)(row + PB_CKV + 2 * c.lane); qv[r] = *(const u32x2*)(row + PB_CQ + 4 * c.lane);
            ki[r] = c.lane < 32 ? SM[(size_t)(t4 + r) * 128 + SM_KIDX + c.lane] : 0.f; }
#pragma unroll
        for (int r = 0; r < 4; ++r) { const int t = t4 + r;
            const float k0 = bflo(kv[r]), k1 = bfhi(kv[r]);
            const float rs = rsqrtf(wave_sum(k0 * k0 + k1 * k1) * (1.f / 128.f) + EPS);
            *(unsigned*)(CKVN + (size_t)t * 128 + 2 * c.lane) = pk2(k0 * rs * g0, k1 * rs * g1);
            const float q0 = bflo(qv[r].x), q1 = bfhi(qv[r].x), q2 = bflo(qv[r].y), q3 = bfhi(qv[r].y);
            const float rq = rsqrtf(wave_sum(q0 * q0 + q1 * q1 + q2 * q2 + q3 * q3) * (1.f / 256.f) + EPS);
            if (c.lane == 0) RSTDQ[t] = rq;
            if (c.lane < 32) KIDX[(size_t)t * 32 + c.lane] = (bf16)f2bf(ki[r]); }
    }
}
__device__ __forceinline__ void phase_ckvt(const Ctx& c) {
    const bf16* CKVN = (const bf16*)(c.ws + WS_CKVN); bf16* CKVT = (bf16*)(c.ws + WS_CKVT);
    LAS bf16* tile = (LAS bf16*)c.lds;
    for (int it = c.bid; it < T / 64; it += c.nblk) {
        const int tb = it * 64, b = tb >> 11, p0 = tb & 2047;
        __syncthreads();
        { const int r = c.tid >> 3, ch = (c.tid & 7) * 8;
          *(LAS u32x4*)(tile + r * 136 + ch) = *(const u32x4*)(CKVN + (size_t)(tb + r) * 128 + ch); *(LAS u32x4*)(tile + r * 136 + 64 + ch) = *(const u32x4*)(CKVN + (size_t)(tb + r) * 128 + 64 + ch); }
        __syncthreads();
        { const int r = c.tid >> 2, part = c.tid & 3;
          unsigned w[8];
#pragma unroll
          for (int j = 0; j < 8; ++j) w[j] = (unsigned)tile[(16 * part + 2 * j) * 136 + r] | ((unsigned)tile[(16 * part + 2 * j + 1) * 136 + r] << 16);
          bf16* dst = CKVT + (((size_t)b * 32 + (p0 >> 6)) * 128 + r) * 64 + 32 * (part >> 1) + 4 * (part & 1);
          *(u32x2*)dst = (u32x2){w[0], w[1]}; *(u32x2*)(dst + 8) = (u32x2){w[2], w[3]}; *(u32x2*)(dst + 16) = (u32x2){w[4], w[5]}; *(u32x2*)(dst + 24) = (u32x2){w[6], w[7]}; }
    }
    __syncthreads();
}

constexpr int TS = 16;
__device__ __forceinline__ void scan_gla_item(const Ctx& c, int l, int b, int h) {
    LAS float* q_s = (LAS float*)c.lds;
    LAS float* k_s = q_s + TS * 64;
    LAS float* a_s = k_s + TS * 64;
    LAS float* v_s = a_s + TS * 64;
    LAS float* part = v_s + TS * 128;
    LAS float* wa2 = part + TS * 4 * 128;
    LAS float* ba = wa2 + 16 * 64;
    LAS float* alr = ba + 64;
    const bf16* PB = (const bf16*)(c.ws + WS_PB); const float* SM = (const float*)(c.ws + WS_SM);
    bf16* UA = (bf16*)(c.ws + WS_UA);
    const float* gn = c.in[IN_GLA_NORM] + l * 512 + h * 128;
    for (int i = c.tid; i < 16 * 64; i += NTHR) wa2[i] = c.in[IN_GLA_WA2][(size_t)l * 16 * 256 + (i >> 6) * 256 + h * 64 + (i & 63)];
    if (c.tid < 64) ba[c.tid] = c.in[IN_GLA_BA][l * 256 + h * 64 + c.tid];
    const int v = c.tid & 127, kg = c.tid >> 7;
    float S[16];
#pragma unroll
    for (int i = 0; i < 16; ++i) S[i] = 0.f;
    for (int t0 = 0; t0 < SEQ; t0 += TS) {
        __syncthreads();
        const size_t rb = (size_t)b * SEQ + t0;
        for (int i = c.tid; i < TS * 64; i += NTHR) { const int s = i >> 6, cc = i & 63; const bf16* row = PB + (rb + s) * NPB;
            q_s[i] = bf2f(row[PB_QA + h * 64 + cc]) * 0.125f; k_s[i] = bf2f(row[PB_KA + h * 64 + cc]); }
        for (int i = c.tid; i < TS * 128; i += NTHR) { const int s = i >> 7, cc = i & 127; v_s[i] = bf2f(PB[(rb + s) * NPB + PB_VA + h * 128 + cc]); }
        if (c.tid < TS * 16) alr[c.tid] = SM[(rb + (c.tid >> 4)) * 128 + SM_ALR + (c.tid & 15)];
        __syncthreads();
        for (int i = c.tid; i < TS * 64; i += NTHR) { const int s = i >> 6, cc = i & 63; float x = ba[cc];
#pragma unroll
            for (int j = 0; j < 16; ++j) x += alr[s * 16 + j] * wa2[j * 64 + cc];
            a_s[i] = __expf(logsigmoidf_(x) * (1.f / 16.f)); }
        __syncthreads();
#pragma unroll 1
        for (int s = 0; s < TS; ++s) {
            const float vv = v_s[s * 128 + v]; float acc = 0.f;
#pragma unroll
            for (int i4 = 0; i4 < 4; ++i4) {
                const f32x4 a4 = *(const LAS f32x4*)(a_s + s * 64 + kg * 16 + i4 * 4), k4 = *(const LAS f32x4*)(k_s + s * 64 + kg * 16 + i4 * 4), q4 = *(const LAS f32x4*)(q_s + s * 64 + kg * 16 + i4 * 4);
#pragma unroll
                for (int j = 0; j < 4; ++j) { S[i4 * 4 + j] = a4[j] * S[i4 * 4 + j] + k4[j] * vv; acc += q4[j] * S[i4 * 4 + j]; }
            }
            part[(s * 4 + kg) * 128 + v] = acc;
        }
        __syncthreads();
        {
            const int s = c.tid >> 5, vq = c.tid & 31, v0 = vq * 4;
            f32x4 o = (f32x4){0.f, 0.f, 0.f, 0.f};
#pragma unroll
            for (int g = 0; g < 4; ++g) o += *(const LAS f32x4*)(part + (s * 4 + g) * 128 + v0);
            float ss = o[0] * o[0] + o[1] * o[1] + o[2] * o[2] + o[3] * o[3];
#pragma unroll
            for (int m = 1; m < 32; m <<= 1) ss += __shfl_xor(ss, m);
            const float rstd = rsqrtf(ss * (1.f / 128.f) + EPS);
            const f32x4 ga = ld_bf4(PB + (rb + s) * NPB + PB_GA + h * 128 + v0);
            f32x4 r;
#pragma unroll
            for (int j = 0; j < 4; ++j) r[j] = o[j] * rstd * gn[v0 + j] * siluf_(ga[j]);
            st_bf4(UA + (rb + s) * 512 + h * 128 + v0, r);
        }
    }
    __syncthreads();
}
__device__ __forceinline__ void scan_mlstm_item(const Ctx& c, int l, int b, int h) {
    LAS float* q_s = (LAS float*)c.lds;
    LAS float* k_s = q_s + TS * 64;
    LAS float* v_s = k_s + TS * 64;
    LAS float* part = v_s + TS * 128;
    LAS float* dpart = part + TS * 4 * 128;
    LAS float* lf_s = dpart + TS * 4;
    LAS float* ip_s = lf_s + TS;
    LAS float* m_s = ip_s + TS;
    LAS float* cw = m_s + TS;
    const bf16* PB = (const bf16*)(c.ws + WS_PB); const float* SM = (const float*)(c.ws + WS_SM);
    bf16* UC = (bf16*)(c.ws + WS_UC);
    const float* mn = c.in[IN_ML_NORM] + l * 512 + h * 128;
    if (c.tid < 4 * 128) { const int j = c.tid >> 7, cc = c.tid & 127; cw[c.tid] = c.in[IN_ML_CONV][(size_t)l * 4 * 512 + j * 512 + (cc < 64 ? h * 64 + cc : 256 + h * 64 + (cc - 64))]; }
    const float bi = c.in[IN_ML_BI][l * 4 + h], bfv = c.in[IN_ML_BF][l * 4 + h];
    const int v = c.tid & 127, kg = c.tid >> 7;
    float C[16], n[16]; float m = 0.f;
#pragma unroll
    for (int i = 0; i < 16; ++i) { C[i] = 0.f; n[i] = 0.f; }
    for (int t0 = 0; t0 < SEQ; t0 += TS) {
        __syncthreads();
        const size_t rb = (size_t)b * SEQ + t0;
        for (int i = c.tid; i < TS * 128; i += NTHR) { const int s = i >> 7, cc = i & 127;
            const int col = cc < 64 ? PB_QC + h * 64 + cc : PB_KC + h * 64 + (cc - 64);
            float x = 0.f;
#pragma unroll
            for (int j = 0; j < 4; ++j) { const int tt = t0 + s - 3 + j; if (tt >= 0) x += cw[j * 128 + cc] * bf2f(PB[((size_t)b * SEQ + tt) * NPB + col]); }
            x = siluf_(x);
            if (cc < 64) q_s[s * 64 + cc] = x * 0.125f; else k_s[s * 64 + (cc - 64)] = x; }
        for (int i = c.tid; i < TS * 128; i += NTHR) { const int s = i >> 7, cc = i & 127; v_s[i] = bf2f(PB[(rb + s) * NPB + PB_VC + h * 128 + cc]); }
        if (c.tid < TS) { ip_s[c.tid] = SM[(rb + c.tid) * 128 + SM_IC + h] + bi; lf_s[c.tid] = logsigmoidf_(SM[(rb + c.tid) * 128 + SM_FC + h] + bfv); }
        __syncthreads();
#pragma unroll 1
        for (int s = 0; s < TS; ++s) {
            const float lf = lf_s[s], ip = ip_s[s];
            const float mnew = fmaxf(lf + m, ip), fg = __expf(lf + m - mnew), ig = __expf(ip - mnew);
            m = mnew;
            const float vv = v_s[s * 128 + v] * ig; float num = 0.f, den = 0.f;
#pragma unroll
            for (int i4 = 0; i4 < 4; ++i4) {
                const f32x4 k4 = *(const LAS f32x4*)(k_s + s * 64 + kg * 16 + i4 * 4), q4 = *(const LAS f32x4*)(q_s + s * 64 + kg * 16 + i4 * 4);
#pragma unroll
                for (int j = 0; j < 4; ++j) { C[i4 * 4 + j] = fg * C[i4 * 4 + j] + k4[j] * vv; n[i4 * 4 + j] = fg * n[i4 * 4 + j] + ig * k4[j]; num += q4[j] * C[i4 * 4 + j]; den += q4[j] * n[i4 * 4 + j]; }
            }
            part[(s * 4 + kg) * 128 + v] = num;
            if (v == 0) dpart[s * 4 + kg] = den;
            if (c.tid == 0) m_s[s] = m;
        }
        __syncthreads();
        {
            const int s = c.tid >> 5, vq = c.tid & 31, v0 = vq * 4;
            f32x4 o = (f32x4){0.f, 0.f, 0.f, 0.f};
#pragma unroll
            for (int g = 0; g < 4; ++g) o += *(const LAS f32x4*)(part + (s * 4 + g) * 128 + v0);
            const float den = dpart[s * 4] + dpart[s * 4 + 1] + dpart[s * 4 + 2] + dpart[s * 4 + 3];
            const float dd = 1.f / fmaxf(fabsf(den), __expf(-m_s[s]));
            o = o * dd;
            float ss = o[0] * o[0] + o[1] * o[1] + o[2] * o[2] + o[3] * o[3];
#pragma unroll
            for (int mm = 1; mm < 32; mm <<= 1) ss += __shfl_xor(ss, mm);
            const float rstd = rsqrtf(ss * (1.f / 128.f) + EPS);
            const f32x4 oc = ld_bf4(PB + (rb + s) * NPB + PB_OC + h * 128 + v0);
            f32x4 r;
#pragma unroll
            for (int j = 0; j < 4; ++j) r[j] = o[j] * rstd * mn[v0 + j] * sigmoidf_(oc[j]);
            st_bf4(UC + (rb + s) * 512 + h * 128 + v0, r);
        }
    }
    __syncthreads();
}

constexpr int LQ = 72;
constexpr int SC_QT = 0, SC_KT = 9216, SC_KTT = 18432, SC_Q2 = 27648, SC_SC = 36864, SC_VT = 46080, SC_ST = 66816, SC_FL = 108288;
__device__ __forceinline__ float wave_scan_add(float x, int lane) {
#pragma unroll
    for (int d = 1; d < 64; d <<= 1) { const float y = __shfl_up(x, d); if (lane >= d) x += y; }
    return x;
}
__device__ __forceinline__ float wave_scan_max(float x, int lane) {
#pragma unroll
    for (int d = 1; d < 64; d <<= 1) { const float y = __shfl_up(x, d); if (lane >= d) x = fmaxf(x, y); }
    return x;
}
__device__ __forceinline__ void unpack8(u32x4 w, float (&f)[8]) { f[0] = bflo(w.x); f[1] = bfhi(w.x); f[2] = bflo(w.y); f[3] = bfhi(w.y); f[4] = bflo(w.z); f[5] = bfhi(w.z); f[6] = bflo(w.w); f[7] = bfhi(w.w); }
__device__ __forceinline__ u32x4 pack8(const float (&f)[8]) { u32x4 w; w.x = pk2(f[0], f[1]); w.y = pk2(f[2], f[3]); w.z = pk2(f[4], f[5]); w.w = pk2(f[6], f[7]); return w; }
template <bool ML>
__device__ __forceinline__ void scan_chunked_item(const Ctx& c, int l, int b, int h) {
    LAS bf16* Qt0 = (LAS bf16*)(c.lds + SC_QT); LAS bf16* Kt0 = (LAS bf16*)(c.lds + SC_KT); LAS bf16* KtT0 = (LAS bf16*)(c.lds + SC_KTT);
    LAS bf16* Q20 = (LAS bf16*)(c.lds + SC_Q2); LAS bf16* Sc0 = (LAS bf16*)(c.lds + SC_SC); LAS bf16* VT0 = (LAS bf16*)(c.lds + SC_VT);
    LAS bf16* ST0 = (LAS bf16*)(c.lds + SC_ST);
    LAS float* segtot = (LAS float*)(c.lds + SC_FL);
    LAS float* etot = segtot + 512;
    LAS float* ssq = etot + 64;
    LAS float* dn = ssq + 512;
    LAS float* wa2 = dn + 64;
    LAS float* ba = wa2 + 1024;
    LAS float* cw = ba + 64;
    const int tid = c.tid, lane = c.lane, w = c.wave, fr = lane & 15, fq = lane >> 4;
    const int srow = tid >> 3, kg = tid & 7, k8 = kg * 8, vrow = tid >> 4, vc8 = (tid & 15) * 8;
    const bf16* PB = (const bf16*)(c.ws + WS_PB); const float* SM = (const float*)(c.ws + WS_SM);
    bf16* UO = (bf16*)(c.ws + (ML ? WS_UC : WS_UA));
    const int QCOL = (ML ? PB_QC : PB_QA) + h * 64, KCOL = (ML ? PB_KC : PB_KA) + h * 64, VCOL = (ML ? PB_VC : PB_VA) + h * 128, GCOL = (ML ? PB_OC : PB_GA) + h * 128;
    const float* gnorm = c.in[ML ? IN_ML_NORM : IN_GLA_NORM] + l * 512 + h * 128;
    __syncthreads();
    if (!ML) { for (int i = tid; i < 1024; i += NTHR) wa2[i] = c.in[IN_GLA_WA2][(size_t)l * 16 * 256 + (i >> 6) * 256 + h * 64 + (i & 63)];
               if (tid < 64) ba[tid] = c.in[IN_GLA_BA][l * 256 + h * 64 + tid]; }
    else { if (tid < 512) { const int j = tid >> 7, cc = tid & 127; cw[tid] = c.in[IN_ML_CONV][(size_t)l * 4 * 512 + j * 512 + (cc < 64 ? h * 64 + cc : 256 + h * 64 + (cc - 64))]; } }
    for (int i = tid; i < 144 * LQ / 2; i += NTHR) ((LAS unsigned*)ST0)[i] = 0u;
    if (ML) { for (int i = tid; i < 16 * LQ; i += NTHR) VT0[128 * LQ + i] = (i < 64) ? (bf16)0x3f80u : (bf16)0u; }
    const float bi = ML ? c.in[IN_ML_BI][l * 4 + h] : 0.f, bfv = ML ? c.in[IN_ML_BF][l * 4 + h] : 0.f;
    float m_prev = 0.f;
    f32x4 Sacc[4], Nacc = (f32x4){0.f, 0.f, 0.f, 0.f};
#pragma unroll
    for (int i = 0; i < 4; ++i) Sacc[i] = (f32x4){0.f, 0.f, 0.f, 0.f};
    u32x4 rq[ML ? 4 : 1], rk[ML ? 4 : 1], rv[2]; f32x4 ra[4]; float ric = 0.f, rfc = 0.f;
    const u32x4 z4 = (u32x4){0u, 0u, 0u, 0u};
#define SC_LOAD(cch) do { const size_t _g = (size_t)b * SEQ + (size_t)(cch) * 64; \
        if (ML) { _Pragma("unroll") for (int _j = 0; _j < 4; ++_j) { const int _tt = (cch) * 64 + srow - 3 + _j; \
                rq[_j] = _tt >= 0 ? *(const u32x4*)(PB + ((size_t)b * SEQ + _tt) * NPB + QCOL + k8) : z4; rk[_j] = _tt >= 0 ? *(const u32x4*)(PB + ((size_t)b * SEQ + _tt) * NPB + KCOL + k8) : z4; } \
            ric = SM[(_g + lane) * 128 + SM_IC + h]; rfc = SM[(_g + lane) * 128 + SM_FC + h]; } \
        else { rq[0] = *(const u32x4*)(PB + (_g + srow) * NPB + QCOL + k8); rk[0] = *(const u32x4*)(PB + (_g + srow) * NPB + KCOL + k8); \
            _Pragma("unroll") for (int _j = 0; _j < 4; ++_j) ra[_j] = *(const f32x4*)(SM + (_g + srow) * 128 + SM_ALR + 4 * _j); } \
        rv[0] = *(const u32x4*)(PB + (_g + vrow) * NPB + VCOL + vc8); rv[1] = *(const u32x4*)(PB + (_g + 32 + vrow) * NPB + VCOL + vc8); } while (0)
    SC_LOAD(0);
    __syncthreads();
#pragma unroll 1
    for (int cch = 0; cch < SEQ / 64; ++cch) {
        const size_t grow = (size_t)b * SEQ + (size_t)cch * 64;
        int lz; asm volatile("v_mov_b32 %0, 0" : "=v"(lz));
        LAS bf16* Qt = Qt0 + lz; LAS bf16* Kt = Kt0 + lz; LAS bf16* KtT = KtT0 + lz; LAS bf16* Q2 = Q20 + lz; LAS bf16* Sc = Sc0 + lz; LAS bf16* VT = VT0 + lz; LAS bf16* ST = ST0 + lz;
        LAS bf16* STc = ST + (cch & 1) * 144 * LQ; LAS bf16* STn = ST + ((cch & 1) ^ 1) * 144 * LQ;
        float qv[8], kv[8];
        float g_a = 0.f, g_M = 0.f, g_bc = 0.f, M63 = 0.f, wc = 1.f;
        if (!ML) {
            unpack8(rq[0], qv); unpack8(rk[0], kv);
            float la[8];
#pragma unroll
            for (int i = 0; i < 8; ++i) la[i] = ba[k8 + i];
#pragma unroll
            for (int j4 = 0; j4 < 4; ++j4)
#pragma unroll
                for (int jj = 0; jj < 4; ++jj) { const float a = ra[j4][jj]; const LAS float* wr_ = wa2 + (j4 * 4 + jj) * 64 + k8;
                    const f32x4 w0 = *(const LAS f32x4*)wr_, w1 = *(const LAS f32x4*)(wr_ + 4);
                    la[0] += a * w0[0]; la[1] += a * w0[1]; la[2] += a * w0[2]; la[3] += a * w0[3]; la[4] += a * w1[0]; la[5] += a * w1[1]; la[6] += a * w1[2]; la[7] += a * w1[3]; }
#pragma unroll
            for (int i = 0; i < 8; ++i) { float x = logsigmoid_fast(la[i]) * (1.f / 16.f);
#pragma unroll
                for (int d = 8; d < 64; d <<= 1) { const float y = __shfl_up(x, d); if (lane >= d) x += y; }
                la[i] = x; }
            if ((lane >> 3) == 7) { *(LAS f32x4*)(segtot + w * 64 + k8) = (f32x4){la[0], la[1], la[2], la[3]}; *(LAS f32x4*)(segtot + w * 64 + k8 + 4) = (f32x4){la[4], la[5], la[6], la[7]}; }
            lds_barrier();
            float tot[8];
#pragma unroll
            for (int i = 0; i < 8; ++i) tot[i] = 0.f;
#pragma unroll
            for (int ww = 0; ww < 8; ++ww) { const f32x4 s0 = *(const LAS f32x4*)(segtot + ww * 64 + k8), s1 = *(const LAS f32x4*)(segtot + ww * 64 + k8 + 4);
                const float sel = ww < w ? 1.f : 0.f;
                la[0] += sel * s0[0]; la[1] += sel * s0[1]; la[2] += sel * s0[2]; la[3] += sel * s0[3]; la[4] += sel * s1[0]; la[5] += sel * s1[1]; la[6] += sel * s1[2]; la[7] += sel * s1[3];
                tot[0] += s0[0]; tot[1] += s0[1]; tot[2] += s0[2]; tot[3] += s0[3]; tot[4] += s1[0]; tot[5] += s1[1]; tot[6] += s1[2]; tot[7] += s1[3]; }
            if (tid < 8) {
#pragma unroll
                for (int i = 0; i < 8; ++i) etot[k8 + i] = __expf(tot[i]); }
            float kt[8];
#pragma unroll
            for (int i = 0; i < 8; ++i) { qv[i] = qv[i] * 0.125f * __expf(la[i]); kt[i] = kv[i] * __expf(-la[i]); }
            *(LAS u32x4*)(Qt + srow * LQ + k8) = pack8(qv); *(LAS u32x4*)(Kt + srow * LQ + k8) = pack8(kt);
#pragma unroll
            for (int i = 0; i < 8; ++i) KtT[(k8 + i) * LQ + srow] = (bf16)f2bf(kt[i]);
        } else {
            float x4[4][8];
#pragma unroll
            for (int j = 0; j < 4; ++j) unpack8(rq[j], x4[j]);
#pragma unroll
            for (int i = 0; i < 8; ++i) { float x = 0.f;
#pragma unroll
                for (int j = 0; j < 4; ++j) x += cw[j * 128 + k8 + i] * x4[j][i];
                qv[i] = siluf_(x) * 0.125f; }
#pragma unroll
            for (int j = 0; j < 4; ++j) unpack8(rk[j], x4[j]);
#pragma unroll
            for (int i = 0; i < 8; ++i) { float x = 0.f;
#pragma unroll
                for (int j = 0; j < 4; ++j) x += cw[j * 128 + 64 + k8 + i] * x4[j][i];
                kv[i] = siluf_(x); }
            const float lf = logsigmoid_fast(rfc + bfv), ip = ric + bi;
            g_bc = wave_scan_add(lf, lane); g_a = ip - g_bc;
            const float pm = wave_scan_max(g_a, lane); g_M = fmaxf(m_prev, pm);
            M63 = __shfl(g_M, 63); const float totb = __shfl(g_bc, 63);
            wc = __expf(m_prev - M63);
            const float Ms = __shfl(g_M, srow), as = __shfl(g_a, srow);
            const float e1 = __expf(m_prev - Ms), e2 = __expf(as - M63);
            float q2[8], kw[8];
#pragma unroll
            for (int i = 0; i < 8; ++i) { q2[i] = qv[i] * e1; kw[i] = kv[i] * e2; }
            *(LAS u32x4*)(Qt + srow * LQ + k8) = pack8(qv); *(LAS u32x4*)(Kt + srow * LQ + k8) = pack8(kv); *(LAS u32x4*)(Q2 + srow * LQ + k8) = pack8(q2);
#pragma unroll
            for (int i = 0; i < 8; ++i) KtT[(k8 + i) * LQ + srow] = (bf16)f2bf(kw[i]);
            m_prev = totb + M63;
        }
        { float v0[8], v1[8]; unpack8(rv[0], v0); unpack8(rv[1], v1);
#pragma unroll
          for (int i = 0; i < 8; ++i) { VT[(vc8 + i) * LQ + vrow] = (bf16)f2bf(v0[i]); VT[(vc8 + i) * LQ + 32 + vrow] = (bf16)f2bf(v1[i]); } }
        u32x2 gate[4];
#pragma unroll
        for (int ti = 0; ti < 4; ++ti) gate[ti] = *(const u32x2*)(PB + (grow + 16 * ti + fr) * NPB + GCOL + 16 * w + 4 * fq);
        if (cch + 1 < SEQ / 64) SC_LOAD(cch + 1);
        lds_barrier();
        {
            const int ti = w >> 1;
#pragma unroll
            for (int u = 0; u < 2; ++u) {
                const int sj = 2 * (w & 1) + u;
                f32x4 d = (f32x4){0.f, 0.f, 0.f, 0.f};
                if (sj <= ti) {
#pragma unroll
                    for (int ks = 0; ks < 2; ++ks) { const bf16x8 a = *(const LAS bf16x8*)(Kt + (16 * sj + fr) * LQ + 32 * ks + 8 * fq), bb = *(const LAS bf16x8*)(Qt + (16 * ti + fr) * LQ + 32 * ks + 8 * fq);
                        d = __builtin_amdgcn_mfma_f32_16x16x32_bf16(a, bb, d, 0, 0, 0); }
                    const int t = 16 * ti + fr, s0 = 16 * sj + 4 * fq;
                    if (ML) { const float Mt = __shfl(g_M, t);
#pragma unroll
                        for (int r = 0; r < 4; ++r) { const float as = __shfl(g_a, s0 + r); d[r] = (s0 + r <= t) ? d[r] * __expf(as - Mt) : 0.f; } }
                    else {
#pragma unroll
                        for (int r = 0; r < 4; ++r) d[r] = (s0 + r <= t) ? d[r] : 0.f; }
                }
                { u32x2 pk; pk.x = pk2(d[0], d[1]); pk.y = pk2(d[2], d[3]); *(LAS u32x2*)(Sc + (16 * ti + fr) * LQ + 16 * sj + 4 * fq) = pk; }
            }
        }
        lds_barrier();
        const LAS bf16* Qm = ML ? Q2 : Qt;
        f32x4 o[4];
        {
            bf16x8 vt[2], stf[2];
#pragma unroll
            for (int ks = 0; ks < 2; ++ks) { vt[ks] = *(const LAS bf16x8*)(VT + (16 * w + fr) * LQ + 32 * ks + 8 * fq); stf[ks] = *(const LAS bf16x8*)(STc + (16 * w + fr) * LQ + 32 * ks + 8 * fq); }
#pragma unroll
            for (int ti = 0; ti < 4; ++ti) {
                f32x4 d = (f32x4){0.f, 0.f, 0.f, 0.f};
#pragma unroll
                for (int ks = 0; ks < 2; ++ks) { const bf16x8 sc = *(const LAS bf16x8*)(Sc + (16 * ti + fr) * LQ + 32 * ks + 8 * fq); d = __builtin_amdgcn_mfma_f32_16x16x32_bf16(vt[ks], sc, d, 0, 0, 0); }
#pragma unroll
                for (int ks = 0; ks < 2; ++ks) { const bf16x8 qq = *(const LAS bf16x8*)(Qm + (16 * ti + fr) * LQ + 32 * ks + 8 * fq); d = __builtin_amdgcn_mfma_f32_16x16x32_bf16(stf[ks], qq, d, 0, 0, 0); }
                o[ti] = d;
            }
#pragma unroll
            for (int kj = 0; kj < 4; ++kj) {
                f32x4 d = (f32x4){0.f, 0.f, 0.f, 0.f};
#pragma unroll
                for (int ks = 0; ks < 2; ++ks) { const bf16x8 kk = *(const LAS bf16x8*)(KtT + (16 * kj + fr) * LQ + 32 * ks + 8 * fq); d = __builtin_amdgcn_mfma_f32_16x16x32_bf16(kk, vt[ks], d, 0, 0, 0); }
                if (ML) Sacc[kj] = Sacc[kj] * wc + d;
                else { const f32x4 e4 = *(const LAS f32x4*)(etot + 16 * kj + 4 * fq); Sacc[kj] = e4 * (Sacc[kj] + d); }
                u32x2 pk; pk.x = pk2(Sacc[kj][0], Sacc[kj][1]); pk.y = pk2(Sacc[kj][2], Sacc[kj][3]);
                *(LAS u32x2*)(STn + (16 * w + fr) * LQ + 16 * kj + 4 * fq) = pk;
            }
            if (ML) {
                if (w < 4) {
                    f32x4 d = (f32x4){0.f, 0.f, 0.f, 0.f};
#pragma unroll
                    for (int ks = 0; ks < 2; ++ks) { const bf16x8 a = *(const LAS bf16x8*)(VT + (128 + fr) * LQ + 32 * ks + 8 * fq), sc = *(const LAS bf16x8*)(Sc + (16 * w + fr) * LQ + 32 * ks + 8 * fq);
                        d = __builtin_amdgcn_mfma_f32_16x16x32_bf16(a, sc, d, 0, 0, 0); }
#pragma unroll
                    for (int ks = 0; ks < 2; ++ks) { const bf16x8 a = *(const LAS bf16x8*)(STc + (128 + fr) * LQ + 32 * ks + 8 * fq), qq = *(const LAS bf16x8*)(Qm + (16 * w + fr) * LQ + 32 * ks + 8 * fq);
                        d = __builtin_amdgcn_mfma_f32_16x16x32_bf16(a, qq, d, 0, 0, 0); }
                    if (fq == 0) dn[16 * w + fr] = d[0];
                } else {
                    const int kj = w - 4;
                    f32x4 d = (f32x4){0.f, 0.f, 0.f, 0.f};
#pragma unroll
                    for (int ks = 0; ks < 2; ++ks) { const bf16x8 kk = *(const LAS bf16x8*)(KtT + (16 * kj + fr) * LQ + 32 * ks + 8 * fq), a = *(const LAS bf16x8*)(VT + (128 + fr) * LQ + 32 * ks + 8 * fq);
                        d = __builtin_amdgcn_mfma_f32_16x16x32_bf16(kk, a, d, 0, 0, 0); }
                    Nacc = Nacc * wc + d;
                    u32x2 pk; pk.x = pk2(Nacc[0], Nacc[1]); pk.y = pk2(Nacc[2], Nacc[3]);
                    *(LAS u32x2*)(STn + (128 + fr) * LQ + 16 * kj + 4 * fq) = pk;
                }
            }
        }
#pragma unroll
        for (int ti = 0; ti < 4; ++ti) { float p = o[ti][0] * o[ti][0] + o[ti][1] * o[ti][1] + o[ti][2] * o[ti][2] + o[ti][3] * o[ti][3];
            p += __shfl_xor(p, 16); p += __shfl_xor(p, 32);
            if (fq == 0) ssq[w * 64 + 16 * ti + fr] = p; }
        lds_barrier();
#pragma unroll
        for (int ti = 0; ti < 4; ++ti) {
            const int t = 16 * ti + fr;
            float ss = 0.f;
#pragma unroll
            for (int ww = 0; ww < 8; ++ww) ss += ssq[ww * 64 + t];
            float dd = 1.f;
            if (ML) { const float bc = __shfl(g_bc, t), Mt = __shfl(g_M, t); dd = 1.f / fmaxf(fabsf(dn[t]), __expf(-(bc + Mt))); }
            const float rstd = rsqrtf(ss * dd * dd * (1.f / 128.f) + EPS) * dd;
            const f32x4 gn = *(const f32x4*)(gnorm + 16 * w + 4 * fq);
            const float g0 = bflo(gate[ti].x), g1 = bfhi(gate[ti].x), g2 = bflo(gate[ti].y), g3 = bfhi(gate[ti].y);
            f32x4 r;
            if (ML) { r[0] = o[ti][0] * rstd * gn[0] * sigmoidf_(g0); r[1] = o[ti][1] * rstd * gn[1] * sigmoidf_(g1); r[2] = o[ti][2] * rstd * gn[2] * sigmoidf_(g2); r[3] = o[ti][3] * rstd * gn[3] * sigmoidf_(g3); }
            else { r[0] = o[ti][0] * rstd * gn[0] * siluf_(g0); r[1] = o[ti][1] * rstd * gn[1] * siluf_(g1); r[2] = o[ti][2] * rstd * gn[2] * siluf_(g2); r[3] = o[ti][3] * rstd * gn[3] * siluf_(g3); }
            st_bf4(UO + (grow + t) * 512 + h * 128 + 16 * w + 4 * fq, r);
        }
    }
#undef SC_LOAD
    __syncthreads();
}

template <bool ML>
__device__ __forceinline__ void scanA_loop(const Ctx& c, int l, int it0, int it_end, int stride) {
    LAS bf16* Qt0 = (LAS bf16*)(c.lds + SC_QT); LAS bf16* Kt0 = (LAS bf16*)(c.lds + SC_KT); LAS bf16* KtT0 = (LAS bf16*)(c.lds + SC_KTT);
    LAS bf16* Sc0 = (LAS bf16*)(c.lds + SC_SC); LAS bf16* VT0 = (LAS bf16*)(c.lds + SC_VT);
    LAS float* segtot = (LAS float*)(c.lds + SC_FL);
    LAS float* wa2 = segtot + 512 + 64 + 512 + 64;
    LAS float* ba = wa2 + 1024;
    LAS float* cw = ba + 64;
    const int tid = c.tid, lane = c.lane, w = c.wave, fr = lane & 15, fq = lane >> 4;
    const int srow = tid >> 3, kg = tid & 7, k8 = kg * 8, vrow = tid >> 4, vc8 = (tid & 15) * 8;
    const bf16* PB = (const bf16*)(c.ws + WS_PB); const float* SM = (const float*)(c.ws + WS_SM);
    bf16* UO = (bf16*)(c.ws + (ML ? WS_UC : WS_UA));
    bf16* QS = (bf16*)(c.ws + WS_QS) + (ML ? (size_t)T * 256 : 0);
    u32x4 rq[ML ? 4 : 1], rk[ML ? 4 : 1], rv[2]; f32x4 ra[4]; float ric = 0.f, rfc = 0.f;
    const u32x4 z4 = (u32x4){0u, 0u, 0u, 0u};
#define SA_LOAD(it_) do { const int _rem = (it_) & 2047, _seq = _rem >> 5, _cch = _rem & 31, _b = _seq >> 2, _h = _seq & 3; \
        const size_t _g = (size_t)_b * SEQ + (size_t)_cch * 64; \
        const int _qc = (ML ? PB_QC : PB_QA) + _h * 64, _kc = (ML ? PB_KC : PB_KA) + _h * 64, _vc = (ML ? PB_VC : PB_VA) + _h * 128; \
        if (ML) { _Pragma("unroll") for (int _j = 0; _j < 4; ++_j) { const int _tt = _cch * 64 + srow - 3 + _j; \
                rq[_j] = _tt >= 0 ? *(const u32x4*)(PB + ((size_t)_b * SEQ + _tt) * NPB + _qc + k8) : z4; rk[_j] = _tt >= 0 ? *(const u32x4*)(PB + ((size_t)_b * SEQ + _tt) * NPB + _kc + k8) : z4; } \
            ric = SM[(_g + lane) * 128 + SM_IC + _h]; rfc = SM[(_g + lane) * 128 + SM_FC + _h]; } \
        else { rq[0] = *(const u32x4*)(PB + (_g + srow) * NPB + _qc + k8); rk[0] = *(const u32x4*)(PB + (_g + srow) * NPB + _kc + k8); \
            _Pragma("unroll") for (int _j = 0; _j < 4; ++_j) ra[_j] = *(const f32x4*)(SM + (_g + srow) * 128 + SM_ALR + 4 * _j); } \
        rv[0] = *(const u32x4*)(PB + (_g + vrow) * NPB + _vc + vc8); rv[1] = *(const u32x4*)(PB + (_g + 32 + vrow) * NPB + _vc + vc8); } while (0)
    if (it0 < it_end) SA_LOAD(it0);
    int hprev = -1;
#pragma unroll 1
    for (int it = it0; it < it_end; it += stride) {
    const int rem_ = it & 2047, seq_ = rem_ >> 5, cch = rem_ & 31, b = seq_ >> 2, h = seq_ & 3;
    const int slot = (b * 4 + h) * 32 + cch;
    bf16* DS = ML ? (bf16*)(c.ws + WS_DSM) + (size_t)slot * 144 * 64 : (bf16*)(c.ws + WS_DSG) + (size_t)slot * 128 * 64;
    const size_t grow = (size_t)b * SEQ + (size_t)cch * 64;
    int lz; asm volatile("v_mov_b32 %0, 0" : "=v"(lz));
    LAS bf16* Qt = Qt0 + lz; LAS bf16* Kt = Kt0 + lz; LAS bf16* KtT = KtT0 + lz; LAS bf16* Sc = Sc0 + lz; LAS bf16* VT = VT0 + lz;
    __syncthreads();
    if (h != hprev) {
        if (!ML) { for (int i = tid; i < 1024; i += NTHR) wa2[i] = c.in[IN_GLA_WA2][(size_t)l * 16 * 256 + (i >> 6) * 256 + h * 64 + (i & 63)];
                   if (tid < 64) ba[tid] = c.in[IN_GLA_BA][l * 256 + h * 64 + tid]; }
        else { { const int j = tid >> 7, cc = tid & 127; cw[tid] = c.in[IN_ML_CONV][(size_t)l * 4 * 512 + j * 512 + (cc < 64 ? h * 64 + cc : 256 + h * 64 + (cc - 64))]; }
               for (int i = tid; i < 16 * LQ; i += NTHR) VT[128 * LQ + i] = (i < 64) ? (bf16)0x3f80u : (bf16)0u; }
        hprev = h;
        __syncthreads();
    }
    const float bi = ML ? c.in[IN_ML_BI][l * 4 + h] : 0.f, bfv = ML ? c.in[IN_ML_BF][l * 4 + h] : 0.f;
    float qv[8], kv[8];
    float g_a = 0.f, g_pm = 0.f;
    if (!ML) {
        unpack8(rq[0], qv); unpack8(rk[0], kv);
        float la[8];
#pragma unroll
        for (int i = 0; i < 8; ++i) la[i] = ba[k8 + i];
#pragma unroll
        for (int j4 = 0; j4 < 4; ++j4)
#pragma unroll
            for (int jj = 0; jj < 4; ++jj) { const float a = ra[j4][jj]; const LAS float* wr_ = wa2 + (j4 * 4 + jj) * 64 + k8;
                const f32x4 w0 = *(const LAS f32x4*)wr_, w1 = *(const LAS f32x4*)(wr_ + 4);
                la[0] += a * w0[0]; la[1] += a * w0[1]; la[2] += a * w0[2]; la[3] += a * w0[3]; la[4] += a * w1[0]; la[5] += a * w1[1]; la[6] += a * w1[2]; la[7] += a * w1[3]; }
#pragma unroll
        for (int i = 0; i < 8; ++i) { float x = logsigmoid_fast(la[i]) * (1.f / 16.f);
#pragma unroll
            for (int d = 8; d < 64; d <<= 1) { const float y = __shfl_up(x, d); if (lane >= d) x += y; }
            la[i] = x; }
        if ((lane >> 3) == 7) { *(LAS f32x4*)(segtot + w * 64 + k8) = (f32x4){la[0], la[1], la[2], la[3]}; *(LAS f32x4*)(segtot + w * 64 + k8 + 4) = (f32x4){la[4], la[5], la[6], la[7]}; }
        lds_barrier();
        float tot[8];
#pragma unroll
        for (int i = 0; i < 8; ++i) tot[i] = 0.f;
#pragma unroll
        for (int ww = 0; ww < 8; ++ww) { const f32x4 s0 = *(const LAS f32x4*)(segtot + ww * 64 + k8), s1 = *(const LAS f32x4*)(segtot + ww * 64 + k8 + 4);
            const float sel = ww < w ? 1.f : 0.f;
            la[0] += sel * s0[0]; la[1] += sel * s0[1]; la[2] += sel * s0[2]; la[3] += sel * s0[3]; la[4] += sel * s1[0]; la[5] += sel * s1[1]; la[6] += sel * s1[2]; la[7] += sel * s1[3];
            tot[0] += s0[0]; tot[1] += s0[1]; tot[2] += s0[2]; tot[3] += s0[3]; tot[4] += s1[0]; tot[5] += s1[1]; tot[6] += s1[2]; tot[7] += s1[3]; }
        if (tid < 8) { float* et = (float*)(c.ws + WS_ET) + (size_t)slot * 64 + k8;
            *(f32x4*)et = (f32x4){__expf(tot[0]), __expf(tot[1]), __expf(tot[2]), __expf(tot[3])}; *(f32x4*)(et + 4) = (f32x4){__expf(tot[4]), __expf(tot[5]), __expf(tot[6]), __expf(tot[7])}; }
        float kt[8];
#pragma unroll
        for (int i = 0; i < 8; ++i) { qv[i] = qv[i] * 0.125f * __expf(la[i]); kt[i] = kv[i] * __expf(-la[i]); }
        const u32x4 qp = pack8(qv);
        *(LAS u32x4*)(Qt + srow * LQ + k8) = qp; *(LAS u32x4*)(Kt + srow * LQ + k8) = pack8(kt);
        *(u32x4*)(QS + (grow + srow) * 256 + h * 64 + k8) = qp;
#pragma unroll
        for (int i = 0; i < 8; ++i) KtT[(k8 + i) * LQ + srow] = (bf16)f2bf(kt[i]);
    } else {
        float x4[4][8];
#pragma unroll
        for (int j = 0; j < 4; ++j) unpack8(rq[j], x4[j]);
#pragma unroll
        for (int i = 0; i < 8; ++i) { float x = 0.f;
#pragma unroll
            for (int j = 0; j < 4; ++j) x += cw[j * 128 + k8 + i] * x4[j][i];
            qv[i] = siluf_(x) * 0.125f; }
#pragma unroll
        for (int j = 0; j < 4; ++j) unpack8(rk[j], x4[j]);
#pragma unroll
        for (int i = 0; i < 8; ++i) { float x = 0.f;
#pragma unroll
            for (int j = 0; j < 4; ++j) x += cw[j * 128 + 64 + k8 + i] * x4[j][i];
            kv[i] = siluf_(x); }
        const float lf = logsigmoid_fast(rfc + bfv), ip = ric + bi;
        const float g_bc = wave_scan_add(lf, lane); g_a = ip - g_bc;
        g_pm = wave_scan_max(g_a, lane);
        const float pm63 = __shfl(g_pm, 63), totb = __shfl(g_bc, 63);
        if (w == 0) { ((float*)(c.ws + WS_GPM))[(grow + lane) * 4 + h] = g_pm; ((float*)(c.ws + WS_GBC))[(grow + lane) * 4 + h] = g_bc;
            if (lane == 0) { float* ct = (float*)(c.ws + WS_CT) + (size_t)slot * 2; ct[0] = totb; ct[1] = pm63; } }
        const float as = __shfl(g_a, srow);
        const float e2 = __expf(as - pm63);
        float kw[8];
#pragma unroll
        for (int i = 0; i < 8; ++i) kw[i] = kv[i] * e2;
        const u32x4 qp = pack8(qv);
        *(LAS u32x4*)(Qt + srow * LQ + k8) = qp; *(LAS u32x4*)(Kt + srow * LQ + k8) = pack8(kv);
        *(u32x4*)(QS + (grow + srow) * 256 + h * 64 + k8) = qp;
#pragma unroll
        for (int i = 0; i < 8; ++i) KtT[(k8 + i) * LQ + srow] = (bf16)f2bf(kw[i]);
    }
    { float v0[8], v1[8]; unpack8(rv[0], v0); unpack8(rv[1], v1);
#pragma unroll
      for (int i = 0; i < 8; ++i) { VT[(vc8 + i) * LQ + vrow] = (bf16)f2bf(v0[i]); VT[(vc8 + i) * LQ + 32 + vrow] = (bf16)f2bf(v1[i]); } }
    if (it + stride < it_end) SA_LOAD(it + stride);
    lds_barrier();
    {
        const int ti = w >> 1;
#pragma unroll
        for (int u = 0; u < 2; ++u) {
            const int sj = 2 * (w & 1) + u;
            f32x4 d = (f32x4){0.f, 0.f, 0.f, 0.f};
            if (sj <= ti) {
#pragma unroll
                for (int ks = 0; ks < 2; ++ks) { const bf16x8 a = *(const LAS bf16x8*)(Kt + (16 * sj + fr) * LQ + 32 * ks + 8 * fq), bb = *(const LAS bf16x8*)(Qt + (16 * ti + fr) * LQ + 32 * ks + 8 * fq);
                    d = __builtin_amdgcn_mfma_f32_16x16x32_bf16(a, bb, d, 0, 0, 0); }
                const int t = 16 * ti + fr, s0 = 16 * sj + 4 * fq;
                if (ML) { const float pt = __shfl(g_pm, t);
#pragma unroll
                    for (int r = 0; r < 4; ++r) { const float as = __shfl(g_a, s0 + r); d[r] = (s0 + r <= t) ? d[r] * __expf(as - pt) : 0.f; } }
                else {
#pragma unroll
                    for (int r = 0; r < 4; ++r) d[r] = (s0 + r <= t) ? d[r] : 0.f; }
            }
            { u32x2 pk; pk.x = pk2(d[0], d[1]); pk.y = pk2(d[2], d[3]); *(LAS u32x2*)(Sc + (16 * ti + fr) * LQ + 16 * sj + 4 * fq) = pk; }
        }
    }
    lds_barrier();
    {
        bf16x8 vt[2];
#pragma unroll
        for (int ks = 0; ks < 2; ++ks) vt[ks] = *(const LAS bf16x8*)(VT + (16 * w + fr) * LQ + 32 * ks + 8 * fq);
#pragma unroll
        for (int ti = 0; ti < 4; ++ti) {
            f32x4 d = (f32x4){0.f, 0.f, 0.f, 0.f};
#pragma unroll
            for (int ks = 0; ks < 2; ++ks) { const bf16x8 sc = *(const LAS bf16x8*)(Sc + (16 * ti + fr) * LQ + 32 * ks + 8 * fq); d = __builtin_amdgcn_mfma_f32_16x16x32_bf16(vt[ks], sc, d, 0, 0, 0); }
            st_bf4(UO + (grow + 16 * ti + fr) * 512 + h * 128 + 16 * w + 4 * fq, d);
        }
#pragma unroll
        for (int kj = 0; kj < 4; ++kj) {
            f32x4 d = (f32x4){0.f, 0.f, 0.f, 0.f};
#pragma unroll
            for (int ks = 0; ks < 2; ++ks) { const bf16x8 kk = *(const LAS bf16x8*)(KtT + (16 * kj + fr) * LQ + 32 * ks + 8 * fq); d = __builtin_amdgcn_mfma_f32_16x16x32_bf16(kk, vt[ks], d, 0, 0, 0); }
            st_bf4(DS + (16 * w + fr) * 64 + 16 * kj + 4 * fq, d);
        }
        if (ML) {
            if (w < 4) {
                f32x4 d = (f32x4){0.f, 0.f, 0.f, 0.f};
#pragma unroll
                for (int ks = 0; ks < 2; ++ks) { const bf16x8 a = *(const LAS bf16x8*)(VT + (128 + fr) * LQ + 32 * ks + 8 * fq), sc = *(const LAS bf16x8*)(Sc + (16 * w + fr) * LQ + 32 * ks + 8 * fq);
                    d = __builtin_amdgcn_mfma_f32_16x16x32_bf16(a, sc, d, 0, 0, 0); }
                if (fq == 0) ((float*)(c.ws + WS_DN))[(grow + 16 * w + fr) * 4 + h] = d[0];
            } else {
                const int kj = w - 4;
                f32x4 d = (f32x4){0.f, 0.f, 0.f, 0.f};
#pragma unroll
                for (int ks = 0; ks < 2; ++ks) { const bf16x8 kk = *(const LAS bf16x8*)(KtT + (16 * kj + fr) * LQ + 32 * ks + 8 * fq), a = *(const LAS bf16x8*)(VT + (128 + fr) * LQ + 32 * ks + 8 * fq);
                    d = __builtin_amdgcn_mfma_f32_16x16x32_bf16(kk, a, d, 0, 0, 0); }
                st_bf4(DS + (128 + fr) * 64 + 16 * kj + 4 * fq, d);
            }
        }
    }
    }
#undef SA_LOAD
}
__device__ __forceinline__ void scanB(const Ctx& c) {
    const int gt = c.bid * NTHR + c.tid, NGT = c.nblk * NTHR;
    constexpr int NG = 64 * 128 * 8, NM = 64 * 128 * 8;
    for (int idx = gt; idx < NG + NM; idx += NGT) {
        float S[8];
#pragma unroll
        for (int i = 0; i < 8; ++i) S[i] = 0.f;
        if (idx < NG) {
            const int seq = idx >> 10, v = (idx >> 3) & 127, kg = idx & 7;
            bf16* p = (bf16*)(c.ws + WS_DSG) + (size_t)seq * 32 * 8192 + v * 64 + kg * 8;
            const float* et = (const float*)(c.ws + WS_ET) + (size_t)seq * 32 * 64 + kg * 8;
#pragma unroll 1
            for (int c4 = 0; c4 < 32; c4 += 4) {
                u32x4 dv[4]; f32x4 e0[4], e1[4];
#pragma unroll
                for (int j = 0; j < 4; ++j) { dv[j] = *(const u32x4*)(p + (size_t)(c4 + j) * 8192); e0[j] = *(const f32x4*)(et + (c4 + j) * 64); e1[j] = *(const f32x4*)(et + (c4 + j) * 64 + 4); }
#pragma unroll
                for (int j = 0; j < 4; ++j) {
                    float d[8]; unpack8(dv[j], d);
                    const u32x4 sp = pack8(S);
                    S[0] = e0[j][0] * (S[0] + d[0]); S[1] = e0[j][1] * (S[1] + d[1]); S[2] = e0[j][2] * (S[2] + d[2]); S[3] = e0[j][3] * (S[3] + d[3]);
                    S[4] = e1[j][0] * (S[4] + d[4]); S[5] = e1[j][1] * (S[5] + d[5]); S[6] = e1[j][2] * (S[6] + d[6]); S[7] = e1[j][3] * (S[7] + d[7]);
                    *(u32x4*)(p + (size_t)(c4 + j) * 8192) = sp;
                }
            }
        } else {
            const int j0 = idx - NG, seq = j0 >> 10, v = (j0 >> 3) & 127, kg = j0 & 7;
            const bool nrow = v == 0;
            bf16* p = (bf16*)(c.ws + WS_DSM) + (size_t)seq * 32 * 9216 + v * 64 + kg * 8;
            bf16* pn = (bf16*)(c.ws + WS_DSM) + (size_t)seq * 32 * 9216 + 128 * 64 + kg * 8;
            const float* ct = (const float*)(c.ws + WS_CT) + (size_t)seq * 32 * 2;
            float* mp = (float*)(c.ws + WS_MP) + (size_t)seq * 32;
            float m = 0.f, N[8];
#pragma unroll
            for (int i = 0; i < 8; ++i) N[i] = 0.f;
#pragma unroll 1
            for (int c4 = 0; c4 < 32; c4 += 4) {
                u32x4 dv[4], nv[4]; f32x2 cc[4];
#pragma unroll
                for (int j = 0; j < 4; ++j) { dv[j] = *(const u32x4*)(p + (size_t)(c4 + j) * 9216); cc[j] = *(const f32x2*)(ct + (c4 + j) * 2); nv[j] = nrow ? *(const u32x4*)(pn + (size_t)(c4 + j) * 9216) : (u32x4){0u, 0u, 0u, 0u}; }
#pragma unroll
                for (int j = 0; j < 4; ++j) {
                    float d[8]; unpack8(dv[j], d);
                    const float M63 = fmaxf(m, cc[j][1]), wc = __expf(m - M63), ws = __expf(cc[j][1] - M63);
                    const u32x4 sp = pack8(S);
                    if (nrow && kg == 0) mp[c4 + j] = m;
#pragma unroll
                    for (int i = 0; i < 8; ++i) S[i] = wc * S[i] + ws * d[i];
                    *(u32x4*)(p + (size_t)(c4 + j) * 9216) = sp;
                    if (nrow) { float dnv[8]; unpack8(nv[j], dnv); const u32x4 np = pack8(N);
#pragma unroll
                        for (int i = 0; i < 8; ++i) N[i] = wc * N[i] + ws * dnv[i];
                        *(u32x4*)(pn + (size_t)(c4 + j) * 9216) = np; }
                    m = cc[j][0] + M63;
                }
            }
        }
    }
}
template <bool ML>
__device__ __forceinline__ void scanC_wave(const Ctx& c, int l, int b, int h, int cch, int ti) {
    const int lane = c.lane, fr = lane & 15, fq = lane >> 4;
    const bf16* PB = (const bf16*)(c.ws + WS_PB);
    bf16* UO = (bf16*)(c.ws + (ML ? WS_UC : WS_UA));
    const bf16* QS = (const bf16*)(c.ws + WS_QS) + (ML ? (size_t)T * 256 : 0);
    const int slot = (b * 4 + h) * 32 + cch;
    const bf16* SP = ML ? (const bf16*)(c.ws + WS_DSM) + (size_t)slot * 144 * 64 : (const bf16*)(c.ws + WS_DSG) + (size_t)slot * 128 * 64;
    const int GCOL = (ML ? PB_OC : PB_GA) + h * 128;
    const float* gnorm = c.in[ML ? IN_ML_NORM : IN_GLA_NORM] + l * 512 + h * 128;
    const size_t trow = (size_t)b * SEQ + (size_t)cch * 64 + 16 * ti + fr;
    bf16x8 qf[2], sf[8][2], nf[2];
#pragma unroll
    for (int ks = 0; ks < 2; ++ks) qf[ks] = *(const bf16x8*)(QS + trow * 256 + h * 64 + 32 * ks + 8 * fq);
#pragma unroll
    for (int n = 0; n < 8; ++n)
#pragma unroll
        for (int ks = 0; ks < 2; ++ks) sf[n][ks] = *(const bf16x8*)(SP + (16 * n + fr) * 64 + 32 * ks + 8 * fq);
    if (ML) {
#pragma unroll
        for (int ks = 0; ks < 2; ++ks) nf[ks] = *(const bf16x8*)(SP + (128 + fr) * 64 + 32 * ks + 8 * fq); }
    u32x2 gate[8], oi[8];
#pragma unroll
    for (int n = 0; n < 8; ++n) { gate[n] = *(const u32x2*)(PB + trow * NPB + GCOL + 16 * n + 4 * fq); oi[n] = *(const u32x2*)(UO + trow * 512 + h * 128 + 16 * n + 4 * fq); }
    float e_in = 1.f, e_st = 1.f, dd = 1.f;
    if (ML) {
        const float pm = ((const float*)(c.ws + WS_GPM))[trow * 4 + h], bc = ((const float*)(c.ws + WS_GBC))[trow * 4 + h], m_prev = ((const float*)(c.ws + WS_MP))[slot], dni = ((const float*)(c.ws + WS_DN))[trow * 4 + h];
        const float Mt = fmaxf(m_prev, pm); e_in = __expf(pm - Mt); e_st = __expf(m_prev - Mt);
        f32x4 d = (f32x4){0.f, 0.f, 0.f, 0.f};
#pragma unroll
        for (int ks = 0; ks < 2; ++ks) d = __builtin_amdgcn_mfma_f32_16x16x32_bf16(nf[ks], qf[ks], d, 0, 0, 0);
        const float dst = __shfl(d[0], fr);
        const float den = dni * e_in + dst * e_st;
        dd = 1.f / fmaxf(fabsf(den), __expf(-(bc + Mt)));
    }
    f32x4 o[8]; float ss = 0.f;
#pragma unroll
    for (int n = 0; n < 8; ++n) {
        f32x4 d = (f32x4){0.f, 0.f, 0.f, 0.f};
#pragma unroll
        for (int ks = 0; ks < 2; ++ks) d = __builtin_amdgcn_mfma_f32_16x16x32_bf16(sf[n][ks], qf[ks], d, 0, 0, 0);
        const f32x4 oiv = (f32x4){bflo(oi[n].x), bfhi(oi[n].x), bflo(oi[n].y), bfhi(oi[n].y)};
        o[n] = ML ? oiv * e_in + d * e_st : oiv + d;
        ss += o[n][0] * o[n][0] + o[n][1] * o[n][1] + o[n][2] * o[n][2] + o[n][3] * o[n][3];
    }
    ss += __shfl_xor(ss, 16); ss += __shfl_xor(ss, 32);
    const float rstd = rsqrtf(ss * dd * dd * (1.f / 128.f) + EPS) * dd;
#pragma unroll
    for (int n = 0; n < 8; ++n) {
        const f32x4 gn = *(const f32x4*)(gnorm + 16 * n + 4 * fq);
        const float g0 = bflo(gate[n].x), g1 = bfhi(gate[n].x), g2 = bflo(gate[n].y), g3 = bfhi(gate[n].y);
        f32x4 r;
        if (ML) { r[0] = o[n][0] * rstd * gn[0] * sigmoidf_(g0); r[1] = o[n][1] * rstd * gn[1] * sigmoidf_(g1); r[2] = o[n][2] * rstd * gn[2] * sigmoidf_(g2); r[3] = o[n][3] * rstd * gn[3] * sigmoidf_(g3); }
        else { r[0] = o[n][0] * rstd * gn[0] * siluf_(g0); r[1] = o[n][1] * rstd * gn[1] * siluf_(g1); r[2] = o[n][2] * rstd * gn[2] * siluf_(g2); r[3] = o[n][3] * rstd * gn[3] * siluf_(g3); }
        st_bf4(UO + trow * 512 + h * 128 + 16 * n + 4 * fq, r);
    }
}
__device__ __forceinline__ void phase_scanA(const Ctx& c, int l) {
    const int nG = c.bid < 2048 ? (2048 - c.bid + c.nblk - 1) / c.nblk : 0;
    const int firstM = c.bid + nG * c.nblk;
    scanA_loop<false>(c, l, c.bid, 2048, c.nblk);
    scanA_loop<true>(c, l, firstM, 4096, c.nblk);
    __syncthreads();
}
__device__ __forceinline__ void phase_scanC(const Ctx& c, int l) {
    const int gw = c.bid * NWAVES + c.wave, NGW = c.nblk * NWAVES;
#pragma unroll 1
    for (int it = gw; it < 16384; it += NGW) { const int br = it >> 13, rem = it & 8191, seq = rem >> 7, cch = (rem >> 2) & 31, ti = rem & 3;
        if (br == 0) scanC_wave<false>(c, l, seq >> 2, seq & 3, cch, ti); else scanC_wave<true>(c, l, seq >> 2, seq & 3, cch, ti); }
}
__device__ __forceinline__ void phase_scans(const Ctx& c, int l) {
    for (int it = c.bid; it < 128; it += c.nblk) {
#if SCAN_RECURRENT
        if (it < 64) scan_gla_item(c, l, it >> 2, it & 3);
        else scan_mlstm_item(c, l, (it - 64) >> 2, (it - 64) & 3);
#else
        if (it < 64) scan_chunked_item<false>(c, l, it >> 2, it & 3);
        else scan_chunked_item<true>(c, l, (it - 64) >> 2, (it - 64) & 3);
#endif
    }
}

__device__ __forceinline__ unsigned ord_key(float f) { const unsigned u = __builtin_bit_cast(unsigned, f); return (u & 0x80000000u) ? ~u : (u | 0x80000000u); }
__device__ __forceinline__ void phase_dsa(const Ctx& c, int l) {
    LAS unsigned char* wl = c.lds + c.wave * 14336;
    LAS float* I_s = (LAS float*)wl;
    LAS int* list = (LAS int*)(wl + 8192);
    LAS float* qi_s = (LAS float*)(wl + 9216);
    LAS float* ql_s = (LAS float*)(wl + 10240);
    const bf16* QLAT = (const bf16*)(c.ws + WS_QLAT); const bf16* QIDX = (const bf16*)(c.ws + WS_QIDX);
    const bf16* CKVN = (const bf16*)(c.ws + WS_CKVN); const float* SM = (const float*)(c.ws + WS_SM);
    bf16* OLAT = (bf16*)(c.ws + WS_OLAT);
    const int gw = c.bid * NWAVES + c.wave, NGW = c.nblk * NWAVES, lane = c.lane;
    for (int tq = gw; tq < T; tq += NGW) {
        const int b = tq >> 11, pos = tq & 2047, nvalid = pos + 1;
        const size_t kb = (size_t)b * SEQ;
        { const f32x4 q = ld_bf4(QIDX + (size_t)tq * 256 + 4 * lane); *(LAS f32x4*)(qi_s + 4 * lane) = q;
#pragma unroll
          for (int j = 0; j < 4; ++j) { const f32x4 ql = ld_bf4(QLAT + (size_t)tq * 1024 + 4 * (lane + 64 * j)); *(LAS f32x4*)(ql_s + 4 * (lane + 64 * j)) = ql; } }
        float wh[8];
#pragma unroll
        for (int hh = 0; hh < 8; ++hh) wh[hh] = SM[(size_t)tq * 128 + SM_WIDX + hh] * 0.35355339059327373f;
        asm volatile("s_waitcnt lgkmcnt(0)" ::: "memory");
        int nsel;
        if (nvalid <= DSA_K) {
            for (int i = lane; i < DSA_K; i += 64) list[i] = i;
            nsel = nvalid;
        } else {
            const int nj = (nvalid + 63) >> 6;
            for (int j = 0; j < nj; ++j) {
                const int s = lane + 64 * j;
                float val = -INFINITY;
                if (s < nvalid) {
                    const float* kr = SM + (kb + s) * 128 + SM_KIDX;
                    f32x4 kk[8];
#pragma unroll
                    for (int i = 0; i < 8; ++i) kk[i] = *(const f32x4*)(kr + 4 * i);
                    val = 0.f;
#pragma unroll
                    for (int hh = 0; hh < 8; ++hh) { float d = 0.f;
#pragma unroll
                        for (int i = 0; i < 8; ++i) { const f32x4 q = *(const LAS f32x4*)(qi_s + hh * 32 + 4 * i); d += q[0] * kk[i][0] + q[1] * kk[i][1] + q[2] * kk[i][2] + q[3] * kk[i][3]; }
                        val += wh[hh] * fmaxf(d, 0.f); }
                }
                I_s[s] = val;
            }
            for (int j = nj; j < 32; ++j) I_s[lane + 64 * j] = -INFINITY;
            asm volatile("s_waitcnt lgkmcnt(0)" ::: "memory");
            LAS unsigned* K_s = (LAS unsigned*)I_s;
#pragma unroll 4
            for (int j = 0; j < 32; ++j) K_s[lane + 64 * j] = ord_key(I_s[lane + 64 * j]);
            unsigned thr = 0u;
#pragma unroll 1
            for (int bit = 31; bit >= 0; --bit) {
                const unsigned cand = thr | (1u << bit); int cnt = 0;
#pragma unroll 8
                for (int j = 0; j < 32; ++j) cnt += (K_s[lane + 64 * j] >= cand) ? 1 : 0;
                cnt = wave_sum_i(cnt);
                if (cnt >= DSA_K) thr = cand;
            }
            int cgt = 0;
#pragma unroll 8
            for (int j = 0; j < 32; ++j) cgt += (K_s[lane + 64 * j] > thr) ? 1 : 0;
            cgt = wave_sum_i(cgt);
            int need = DSA_K - cgt, base = 0;
            const unsigned long long lt = (1ull << lane) - 1ull;
#pragma unroll 2
            for (int j = 0; j < 32; ++j) {
                const unsigned kj = K_s[lane + 64 * j];
                const bool gt = kj > thr, eq = kj == thr;
                const unsigned long long meq = __ballot(eq);
                const int rk = __popcll(meq & lt);
                const bool sel = gt || (eq && rk < need);
                need -= __popcll(meq); if (need < 0) need = 0;
                const unsigned long long ms = __ballot(sel);
                if (sel) list[base + __popcll(ms & lt)] = lane + 64 * j;
                base += __popcll(ms);
            }
            nsel = DSA_K;
        }
        asm volatile("s_waitcnt lgkmcnt(0)" ::: "memory");
        int ks[4]; float lg[4][8];
#pragma unroll
        for (int i = 0; i < 4; ++i) { const int li = lane + 64 * i; ks[i] = (li < nsel) ? list[li] : 0;
#pragma unroll
            for (int hh = 0; hh < 8; ++hh) lg[i][hh] = 0.f; }
#pragma unroll 1
        for (int ch = 0; ch < 16; ++ch) {
            f32x4 ka[4], kc[4];
#pragma unroll
            for (int i = 0; i < 4; ++i) { const u32x4 w = *(const u32x4*)(CKVN + (kb + ks[i]) * 128 + ch * 8);
                ka[i] = (f32x4){bflo(w.x), bfhi(w.x), bflo(w.y), bfhi(w.y)}; kc[i] = (f32x4){bflo(w.z), bfhi(w.z), bflo(w.w), bfhi(w.w)}; }
#pragma unroll
            for (int hh = 0; hh < 8; ++hh) { const f32x4 qa = *(const LAS f32x4*)(ql_s + hh * 128 + ch * 8), qb = *(const LAS f32x4*)(ql_s + hh * 128 + ch * 8 + 4);
#pragma unroll
                for (int i = 0; i < 4; ++i) lg[i][hh] += qa[0] * ka[i][0] + qa[1] * ka[i][1] + qa[2] * ka[i][2] + qa[3] * ka[i][3] + qb[0] * kc[i][0] + qb[1] * kc[i][1] + qb[2] * kc[i][2] + qb[3] * kc[i][3]; }
        }
#pragma unroll
        for (int hh = 0; hh < 8; ++hh) {
            const float slope = exp2f(-(float)(hh + 1));
            float mx = -INFINITY;
#pragma unroll
            for (int i = 0; i < 4; ++i) { const bool ok = (lane + 64 * i) < nsel; lg[i][hh] = ok ? lg[i][hh] - slope * (float)(pos - ks[i]) : -INFINITY; mx = fmaxf(mx, lg[i][hh]); }
            mx = wave_max(mx);
            float sm = 0.f;
#pragma unroll
            for (int i = 0; i < 4; ++i) { lg[i][hh] = __expf(lg[i][hh] - mx); sm += lg[i][hh]; }
            sm = wave_sum(sm);
            const float inv = 1.f / sm;
#pragma unroll
            for (int i = 0; i < 4; ++i) lg[i][hh] *= inv;
        }
#pragma unroll
        for (int i = 0; i < 4; ++i) { const int li = lane + 64 * i;
            *(LAS f32x4*)(I_s + li * 8) = (f32x4){lg[i][0], lg[i][1], lg[i][2], lg[i][3]}; *(LAS f32x4*)(I_s + li * 8 + 4) = (f32x4){lg[i][4], lg[i][5], lg[i][6], lg[i][7]}; }
        asm volatile("s_waitcnt lgkmcnt(0)" ::: "memory");
        float o0[8], o1[8];
#pragma unroll
        for (int hh = 0; hh < 8; ++hh) { o0[hh] = 0.f; o1[hh] = 0.f; }
#pragma unroll 2
        for (int kidx = 0; kidx < nsel; ++kidx) {
            const int s = list[kidx];
            const unsigned w = *(const unsigned*)(CKVN + (kb + s) * 128 + 2 * lane);
            const float v0 = bflo(w), v1 = bfhi(w);
            const f32x4 pa = *(const LAS f32x4*)(I_s + kidx * 8), pb = *(const LAS f32x4*)(I_s + kidx * 8 + 4);
            o0[0] += pa[0] * v0; o1[0] += pa[0] * v1; o0[1] += pa[1] * v0; o1[1] += pa[1] * v1; o0[2] += pa[2] * v0; o1[2] += pa[2] * v1; o0[3] += pa[3] * v0; o1[3] += pa[3] * v1;
            o0[4] += pb[0] * v0; o1[4] += pb[0] * v1; o0[5] += pb[1] * v0; o1[5] += pb[1] * v1; o0[6] += pb[2] * v0; o1[6] += pb[2] * v1; o0[7] += pb[3] * v0; o1[7] += pb[3] * v1;
        }
#pragma unroll
        for (int hh = 0; hh < 8; ++hh) *(unsigned*)(OLAT + (size_t)tq * 1024 + hh * 128 + 2 * lane) = pk2(o0[hh], o1[hh]);
        asm volatile("s_waitcnt lgkmcnt(0)" ::: "memory");
    }
}


__device__ __forceinline__ int half_sum(int v) {
    v += __builtin_amdgcn_update_dpp(0, v, 0xB1, 0xF, 0xF, false);
    v += __builtin_amdgcn_update_dpp(0, v, 0x4E, 0xF, 0xF, false);
    v += __builtin_amdgcn_update_dpp(0, v, 0x141, 0xF, 0xF, false);
    v += __builtin_amdgcn_update_dpp(0, v, 0x140, 0xF, 0xF, false);
    v += __shfl_xor(v, 16);
    return v;
}
typedef float f32x16 __attribute__((ext_vector_type(16)));
__device__ __forceinline__ void phase_dsa_sel(const Ctx& c, int l) {
    const bf16* QIDX = (const bf16*)(c.ws + WS_QIDX); const bf16* KIDX = (const bf16*)(c.ws + WS_KIDX); const float* SM = (const float*)(c.ws + WS_SM);
    unsigned* MASK = (unsigned*)(c.ws + WS_MASK);
    const int lane = c.lane, hf = lane >> 5, l31 = lane & 31;
    const int rho = l31, tl = 2 * ((rho >> 2) & 1) + (rho >> 4), hd = (rho & 3) + 4 * ((rho >> 3) & 1);
    const unsigned ltmask = (1u << l31) - 1u;
    LAS unsigned* KL = (LAS unsigned*)(c.lds + c.wave * 16384);
    LAS unsigned* MW = (LAS unsigned*)(c.lds + 131072 + c.wave * 512);
    unsigned* KEYB = (unsigned*)(c.ws + WS_KEYB) + (size_t)(c.bid * NWAVES + c.wave) * 4096;
    const int npass = (c.nblk == 256) ? 2 : (T / 64 + c.nblk - 1) / c.nblk;
#pragma unroll 1
    for (int ps = 0; ps < npass; ++ps) {
        int b, q64;
        if (c.nblk == 256) { b = c.bid & 15; q64 = ps == 0 ? 31 - (c.bid >> 4) : (c.bid >> 4); }
        else { const int it = c.bid + ps * c.nblk; if (it >= T / 64) break; b = it >> 5; q64 = it & 31; }
        const int pb = q64 * 64;
#pragma unroll 1
        for (int wi = 0; wi < 2; ++wi) {
        const int pos0 = pb + 8 * c.wave + 4 * wi, t0 = b * SEQ + pos0;
        unsigned wA0 = 0u, wB0 = 0u, wA1 = 0u, wB1 = 0u;
        if (pos0 + 3 < DSA_K) {
            const int p_0 = pos0 + 2 * hf, p_1 = p_0 + 1;
            { const int lo = 32 * l31; wA0 = p_0 >= lo + 31 ? 0xffffffffu : (p_0 < lo ? 0u : ((2u << (p_0 - lo)) - 1u)); wA1 = p_1 >= lo + 31 ? 0xffffffffu : (p_1 < lo ? 0u : ((2u << (p_1 - lo)) - 1u)); }
        } else {
            const int ng = ((pos0 + 3) / 32 + 4) / 4, nkt = 4 * ng;
            bf16x8 af[2];
#pragma unroll
            for (int ks = 0; ks < 2; ++ks) af[ks] = *(const bf16x8*)(QIDX + (size_t)(t0 + tl) * 256 + hd * 32 + 16 * ks + 8 * hf);
            const bf16* kbase = KIDX + ((size_t)b * SEQ + l31) * 32 + 8 * hf;
#pragma unroll 1
            for (int tsel = 0; tsel < 2; ++tsel) {
                const int p_t = pos0 + 2 * hf + tsel;
                if (tsel == 0) {
                    float whv[16];
#pragma unroll
                    for (int r = 0; r < 16; ++r) whv[r] = SM[(size_t)(t0 + 2 * hf + (r >> 3)) * 128 + SM_WIDX + (r & 7)] * 0.35355339059327373f;
                    bf16x8 bq[4][2], bn[4][2];
#pragma unroll
                    for (int j = 0; j < 4; ++j) { bq[j][0] = *(const bf16x8*)(kbase + (size_t)(32 * j) * 32); bq[j][1] = *(const bf16x8*)(kbase + (size_t)(32 * j) * 32 + 16); }
#pragma unroll 1
                    for (int g = 0; g < ng; ++g) {
                        const int gn = (g + 1 < ng) ? g + 1 : g;
#pragma unroll
                        for (int j = 0; j < 4; ++j) { bn[j][0] = *(const bf16x8*)(kbase + (size_t)(32 * (4 * gn + j)) * 32); bn[j][1] = *(const bf16x8*)(kbase + (size_t)(32 * (4 * gn + j)) * 32 + 16); }
                        u32x4 ka, kb;
#pragma unroll
                        for (int j = 0; j < 4; ++j) {
                            f32x16 d;
#pragma unroll
                            for (int r = 0; r < 16; ++r) d[r] = 0.f;
                            d = __builtin_amdgcn_mfma_f32_32x32x16_bf16(af[0], bq[j][0], d, 0, 0, 0);
                            d = __builtin_amdgcn_mfma_f32_32x32x16_bf16(af[1], bq[j][1], d, 0, 0, 0);
                            float iv0 = 0.f, iv1 = 0.f;
#pragma unroll
                            for (int r = 0; r < 8; ++r) { iv0 += whv[r] * fmaxf(d[r], 0.f); iv1 += whv[8 + r] * fmaxf(d[8 + r], 0.f); }
                            const int row = 32 * (4 * g + j) + l31;
                            ka[j] = row <= p_t ? ord_key(iv0) : 0u; kb[j] = row <= p_t + 1 ? ord_key(iv1) : 0u;
                        }
                        *(LAS u32x4*)(KL + (g * 64 + lane) * 4) = ka;
                        *(u32x4*)(KEYB + ((size_t)g * 64 + lane) * 4) = kb;
#pragma unroll
                        for (int j = 0; j < 4; ++j) { bq[j][0] = bn[j][0]; bq[j][1] = bn[j][1]; }
                    }
                } else {
#pragma unroll 4
                    for (int g = 0; g < ng; ++g) *(LAS u32x4*)(KL + (g * 64 + lane) * 4) = __builtin_nontemporal_load((const u32x4*)(KEYB + ((size_t)g * 64 + lane) * 4));
                }
                unsigned thr = 0u; bool done = false, alld = false;
#pragma unroll 1
                for (int bit = 31; bit >= 0 && !alld; --bit) {
                    const unsigned cand = thr | (1u << bit); int cn = 0;
#pragma unroll 4
                    for (int g = 0; g < ng; ++g) { const u32x4 k4 = *(const LAS u32x4*)(KL + (g * 64 + lane) * 4);
                        cn += (k4.x >= cand ? 1 : 0) + (k4.y >= cand ? 1 : 0) + (k4.z >= cand ? 1 : 0) + (k4.w >= cand ? 1 : 0); }
                    cn = half_sum(cn);
                    if (!done && cn >= DSA_K) thr = cand;
                    done = done || cn == DSA_K;
                    alld = __ballot(!done) == 0ull;
                }
                const bool dlo = alld, dhi = alld;
                MW[lane] = 0u; MW[64 + lane] = 0u;
                if (dlo && dhi) {
#pragma unroll 4
                    for (int kt = 0; kt < nkt; ++kt) { const unsigned long long ms = __ballot(KL[((kt >> 2) * 64 + lane) * 4 + (kt & 3)] >= thr);
                        if (l31 == 0) MW[hf * 64 + kt] = hf ? (unsigned)(ms >> 32) : (unsigned)ms; }
                } else {
                int glo = 0, ghi = 0;
#pragma unroll 16
                for (int kt = 0; kt < nkt; ++kt) { const unsigned long long m = __ballot(KL[((kt >> 2) * 64 + lane) * 4 + (kt & 3)] > thr); glo += __popc((unsigned)m); ghi += __popc((unsigned)(m >> 32)); }
                int nlo = DSA_K - glo, nhi = DSA_K - ghi;
#pragma unroll 2
                for (int kt = 0; kt < nkt; ++kt) {
                    const unsigned kv = KL[((kt >> 2) * 64 + lane) * 4 + (kt & 3)];
                    const bool gt = kv > thr, eq = kv == thr;
                    const unsigned long long meq = __ballot(eq); const unsigned mh = hf ? (unsigned)(meq >> 32) : (unsigned)meq;
                    const int need = hf ? nhi : nlo;
                    const bool sel = gt || (eq && (__popc(mh & ltmask) < need));
                    nlo -= __popc((unsigned)meq); nhi -= __popc((unsigned)(meq >> 32)); nlo = nlo < 0 ? 0 : nlo; nhi = nhi < 0 ? 0 : nhi;
                    const unsigned long long ms = __ballot(sel);
                    if (l31 == 0) MW[hf * 64 + kt] = hf ? (unsigned)(ms >> 32) : (unsigned)ms;
                }
                }
                const unsigned wA = MW[hf * 64 + l31], wB = MW[hf * 64 + 32 + l31];
                if (tsel == 0) { wA0 = wA; wB0 = wB; } else { wA1 = wA; wB1 = wB; }
            }
        }
        unsigned* m0 = MASK + (size_t)(t0 + 2 * hf) * 64;
        m0[l31] = wA0; m0[32 + l31] = wB0; m0[64 + l31] = wA1; m0[96 + l31] = wB1;
        }
    }
    __syncthreads();
}

constexpr int AT_STAGE = 32768;
__device__ __forceinline__ void phase_dsa_att(const Ctx& c, int l) {
    const bf16* QLAT = (const bf16*)(c.ws + WS_QLAT); const bf16* CKVN = (const bf16*)(c.ws + WS_CKVN); const bf16* CKVT = (const bf16*)(c.ws + WS_CKVT);
    const unsigned* MASK = (const unsigned*)(c.ws + WS_MASK); bf16* OLAT = (bf16*)(c.ws + WS_OLAT);
    const int tid = c.tid, lane = c.lane, h = c.wave, fr = lane & 15, fq = lane >> 4;
    const float slope2 = exp2f(-(float)(h + 1)) * 1.4426950408889634f;
    const int dn_r = tid >> 4, dn_c = ((tid & 15) ^ ((tid >> 4) & 15)) * 8;
    const int dt_r = tid >> 3, dt_c = ((tid & 7) ^ ((tid >> 3) & 7)) * 8;
    const unsigned ldsw = (unsigned)h * 1024u;
#pragma unroll 1
    for (int k4 = 0; k4 < 1024; ++k4) {
        const int idx = c.bid + c.nblk * k4; if (idx >= 1024) break;
        const int b = idx & 15, g = idx >> 4, gk = g >> 4, gi = g & 15;
        const int qt = 63 - 16 * gk - ((gk & 1) ? (15 - gi) : gi);
        const int tq0 = qt * 32;
        const size_t tg0 = (size_t)b * SEQ + tq0;
        const int nkt = (tq0 + 31) / 64 + 1;
        bf16x8 Qf[2][4];
#pragma unroll
        for (int rt = 0; rt < 2; ++rt)
#pragma unroll
            for (int ks = 0; ks < 4; ++ks) Qf[rt][ks] = *(const bf16x8*)(QLAT + (tg0 + 16 * rt + fr) * 1024 + h * 128 + 32 * ks + 8 * fq);
        f32x4 O[2][8];
        float mrun[2], lrun[2];
#pragma unroll
        for (int rt = 0; rt < 2; ++rt) { mrun[rt] = -1e30f; lrun[rt] = 0.f;
#pragma unroll
            for (int n = 0; n < 8; ++n) O[rt][n] = (f32x4){0.f, 0.f, 0.f, 0.f}; }
#define AT_DMA(kt_, stg_) do { const bf16* _kn = CKVN + ((size_t)b * SEQ + 64 * (kt_) + dn_r) * 128 + dn_c; const bf16* _kt = CKVT + (((size_t)b * 32 + (kt_)) * 128 + dt_r) * 64 + dt_c; \
            LAS unsigned char* _d = c.lds + (stg_) * AT_STAGE + ldsw; \
            __builtin_amdgcn_global_load_lds((const unsigned*)_kn, (LAS unsigned*)_d, 16, 0, 0); __builtin_amdgcn_global_load_lds((const unsigned*)(_kn + 32 * 128), (LAS unsigned*)(_d + 8192), 16, 0, 0); \
            __builtin_amdgcn_global_load_lds((const unsigned*)_kt, (LAS unsigned*)(_d + 16384), 16, 0, 0); __builtin_amdgcn_global_load_lds((const unsigned*)(_kt + 64 * 64), (LAS unsigned*)(_d + 16384 + 8192), 16, 0, 0); } while (0)
        __syncthreads();
        AT_DMA(0, 0);
#pragma unroll 1
        for (int kt = 0; kt < nkt; ++kt) {
            u32x2 mw[2];
#pragma unroll
            for (int rt = 0; rt < 2; ++rt) mw[rt] = *(const u32x2*)(MASK + (tg0 + 16 * rt + fr) * 64 + 2 * kt);
            asm volatile("s_waitcnt vmcnt(2)" ::: "memory");
            __builtin_amdgcn_s_barrier(); asm volatile("" ::: "memory");
            if (kt + 1 < nkt) AT_DMA(kt + 1, (kt + 1) & 1);
            int lz; asm volatile("v_mov_b32 %0, 0" : "=v"(lz));
            const LAS unsigned char* Kn = c.lds + (kt & 1) * AT_STAGE + lz; const LAS unsigned char* KT = Kn + 16384;
            const float kb0 = slope2 * (float)(64 * kt + 4 * fq);
            f32x4 S[2][4];
            {
                bf16x8 kfa[4], kfb[4];
#pragma unroll
                for (int ks = 0; ks < 4; ++ks) kfa[ks] = *(const LAS bf16x8*)(Kn + fr * 256 + (((4 * ks + fq) ^ fr) << 4));
#pragma unroll
                for (int j = 0; j < 4; ++j) {
                    if (j + 1 < 4) {
#pragma unroll
                        for (int ks = 0; ks < 4; ++ks) { const bf16x8 t = *(const LAS bf16x8*)(Kn + (16 * (j + 1) + fr) * 256 + (((4 * ks + fq) ^ fr) << 4)); if (j & 1) kfa[ks] = t; else kfb[ks] = t; } }
#pragma unroll
                    for (int rt = 0; rt < 2; ++rt) { f32x4 d = (f32x4){0.f, 0.f, 0.f, 0.f};
#pragma unroll
                        for (int ks = 0; ks < 4; ++ks) d = __builtin_amdgcn_mfma_f32_16x16x32_bf16((j & 1) ? kfb[ks] : kfa[ks], Qf[rt][ks], d, 0, 0, 0);
                        S[rt][j] = d; }
                    __builtin_amdgcn_sched_barrier(0);
                }
            }
            bf16x8 Pf[2][2];
#pragma unroll
            for (int rt = 0; rt < 2; ++rt) {
                float mx = -1e30f;
#pragma unroll
                for (int j = 0; j < 4; ++j) { const unsigned wsel = ((j < 2) ? mw[rt].x : mw[rt].y) >> (4 * fq);
#pragma unroll
                    for (int r = 0; r < 4; ++r) { const bool on = wsel & (1u << (16 * (j & 1) + r));
                        const float v = S[rt][j][r] + fmaf(slope2, (float)(16 * j + r), kb0);
                        S[rt][j][r] = on ? v : -INFINITY; mx = fmaxf(mx, S[rt][j][r]); } }
                mx = fmaxf(mx, __shfl_xor(mx, 16)); mx = fmaxf(mx, __shfl_xor(mx, 32));
                const float mnew = fmaxf(mrun[rt], mx);
                const float alpha = __builtin_amdgcn_exp2f(mrun[rt] - mnew);
                float rs = 0.f;
#pragma unroll
                for (int j = 0; j < 4; ++j)
#pragma unroll
                    for (int r = 0; r < 4; ++r) { const float p = __builtin_amdgcn_exp2f(S[rt][j][r] - mnew); S[rt][j][r] = p; rs += p; }
                rs += __shfl_xor(rs, 16); rs += __shfl_xor(rs, 32);
                lrun[rt] = lrun[rt] * alpha + rs; mrun[rt] = mnew;
#pragma unroll
                for (int n = 0; n < 8; ++n) O[rt][n] *= alpha;
#pragma unroll
                for (int ks2 = 0; ks2 < 2; ++ks2) { u32x4 w; w.x = pk2(S[rt][2 * ks2][0], S[rt][2 * ks2][1]); w.y = pk2(S[rt][2 * ks2][2], S[rt][2 * ks2][3]);
                    w.z = pk2(S[rt][2 * ks2 + 1][0], S[rt][2 * ks2 + 1][1]); w.w = pk2(S[rt][2 * ks2 + 1][2], S[rt][2 * ks2 + 1][3]);
                    Pf[rt][ks2] = __builtin_bit_cast(bf16x8, w); }
            }
            {
                const int sw = fr & 7;
#pragma unroll
                for (int n = 0; n < 8; ++n) {
#pragma unroll
                    for (int ks2 = 0; ks2 < 2; ++ks2) {
                        const bf16x8 af = *(const LAS bf16x8*)(KT + (16 * n + fr) * 128 + (((4 * ks2 + fq) ^ sw) << 4));
#pragma unroll
                        for (int rt = 0; rt < 2; ++rt) O[rt][n] = __builtin_amdgcn_mfma_f32_16x16x32_bf16(af, Pf[rt][ks2], O[rt][n], 0, 0, 0);
                    }
                    if (n & 1) __builtin_amdgcn_sched_barrier(0);
                }
            }
        }
#undef AT_DMA
        {
            const bf16x8* WF = (const bf16x8*)((const bf16*)(c.ws + WS_WUVF) + (size_t)(l * 8 + h) * 16 * 64 * 8) + lane;
            bf16x8 wf[4][4];
#pragma unroll
            for (int vt = 0; vt < 4; ++vt)
#pragma unroll
                for (int ks = 0; ks < 4; ++ks) wf[vt][ks] = WF[(vt * 4 + ks) * 64];
#pragma unroll
            for (int rt = 0; rt < 2; ++rt) { const float inv = 1.f / lrun[rt];
                bf16x8 of[4];
#pragma unroll
                for (int ks = 0; ks < 4; ++ks) { const f32x4 x0 = O[rt][2 * ks] * inv, x1 = O[rt][2 * ks + 1] * inv;
                    u32x4 w; w.x = pk2(x0[0], x0[1]); w.y = pk2(x0[2], x0[3]); w.z = pk2(x1[0], x1[1]); w.w = pk2(x1[2], x1[3]); of[ks] = __builtin_bit_cast(bf16x8, w); }
#pragma unroll
                for (int vt = 0; vt < 4; ++vt) { f32x4 d = (f32x4){0.f, 0.f, 0.f, 0.f};
#pragma unroll
                    for (int ks = 0; ks < 4; ++ks) d = __builtin_amdgcn_mfma_f32_16x16x32_bf16(wf[vt][ks], of[ks], d, 0, 0, 0);
                    st_bf4(OLAT + (tg0 + 16 * rt + fr) * 512 + h * 64 + 16 * vt + 4 * fq, d); }
            }
        }
    }
    asm volatile("s_waitcnt vmcnt(0)" ::: "memory");
    __syncthreads();
}

__device__ __forceinline__ void expert_convert(const Ctx& c, int l, int gw, int NGW) {

        LAS float* scr = (LAS float*)(c.lds + c.wave * 16384);
        constexpr int I_GU = (512 / 32) * (1024 / 64), I_D = (1024 / 32) * (256 / 64), PER_E = I_GU + I_D;
        for (int it = gw; it < NEX * PER_E; it += NGW) {
            const int e = it / PER_E; int r = it % PER_E;
            if (r < I_GU) {
                const int n0 = (r / 16) * 32, pn = n0 >> 8, wi = n0 & 255, j0 = 128 * pn + (wi & 127);
                const float* Wg; const float* Wu;
                if (e < NE) { Wg = c.in[IN_EWG] + ((size_t)l * NE + e) * 1024 * 256; Wu = c.in[IN_EWU] + ((size_t)l * NE + e) * 1024 * 256; }
                else { Wg = c.in[IN_SWG] + (size_t)l * 1024 * 256; Wu = c.in[IN_SWU] + (size_t)l * 1024 * 256; }
                if (wi < 128) { SrcPlain s{Wg + j0 - n0, 256}; tr_item(s, (bf16*)(c.ws + WS_WGU) + (size_t)e * 512 * 1024, 1024, n0, (r % 16) * 64, scr, c.lane); }
                else { SrcPlain s{Wu + j0 - n0, 256}; tr_item(s, (bf16*)(c.ws + WS_WGU) + (size_t)e * 512 * 1024, 1024, n0, (r % 16) * 64, scr, c.lane); }
            } else { r -= I_GU;
                SrcPlain s; s.ld = 1024; s.W = e < NE ? c.in[IN_EWD] + ((size_t)l * NE + e) * 256 * 1024 : c.in[IN_SWD] + (size_t)l * 256 * 1024;
                tr_item(s, (bf16*)(c.ws + WS_WD) + (size_t)e * 1024 * 256, 256, (r / 4) * 32, (r % 4) * 64, scr, c.lane);
            }
        }
    }
__device__ __forceinline__ void route_one(int t, float logit, float rbias, int lane, LAS unsigned* lcnt, LAS unsigned* stash, int ridx) {
    const float score = sigmoid_exact(logit), sel = score + rbias;
    const int g = lane >> 3;
    float m1 = sel, m2 = -INFINITY;
#pragma unroll
    for (int d = 1; d < 8; d <<= 1) { const float o1 = __shfl_xor(m1, d), o2 = __shfl_xor(m2, d);
        const float n1 = fmaxf(m1, o1), n2 = fmaxf(fminf(m1, o1), fmaxf(m2, o2)); m1 = n1; m2 = n2; }
    const float gs = m1 + m2;
    int rkg = 0;
#pragma unroll
    for (int og = 0; og < 8; ++og) { const float o = __builtin_bit_cast(float, __builtin_amdgcn_readlane(__builtin_bit_cast(int, gs), og * 8)); rkg += (o > gs || (o == gs && og < g)) ? 1 : 0; }
    const bool gsel = rkg < 4;
    const float msel = gsel ? sel : -INFINITY;
    int rk = 0;
#pragma unroll 8
    for (int j = 0; j < 64; ++j) { const float o = __builtin_bit_cast(float, __builtin_amdgcn_readlane(__builtin_bit_cast(int, msel), j)); rk += (o > msel || (o == msel && j < lane)) ? 1 : 0; }
    const bool chosen = gsel && rk < TOPK;
    const unsigned long long mk = __ballot(chosen);
    float wsum = 0.f;
    { unsigned long long mm = mk;
#pragma unroll 1
      while (mm) { const int j = __ffsll((long long)mm) - 1; mm &= mm - 1; wsum += __builtin_bit_cast(float, __builtin_amdgcn_readlane(__builtin_bit_cast(int, score), j)); } }
    if (chosen) {
        const int hf = t >= HALF_T ? 1 : 0;
        const int kk = __popcll(mk & ((1ull << lane) - 1ull));
        const unsigned rank = __hip_atomic_fetch_add(&lcnt[hf * 64 + lane], 1u, __ATOMIC_RELAXED, __HIP_MEMORY_SCOPE_WORKGROUP);
        LAS unsigned* st = stash + (size_t)(ridx * 6 + (kk < TOPK ? kk : 0)) * 4;
        st[0] = (unsigned)t; st[1] = ((unsigned)hf << 24) | ((unsigned)lane << 16) | rank; st[2] = __builtin_bit_cast(unsigned, score / wsum * 2.5f);
    }
}
__device__ __forceinline__ void phase_route(const Ctx& c, int l, const float* x1) {
    for (int r2 = 0; r2 < CONV_REP; ++r2) expert_convert(c, l, c.bid * NWAVES + c.wave, c.nblk * NWAVES);
    __syncthreads();
    {
        LAS float* H = (LAS float*)c.lds;
        constexpr int HLD = 1028;
        const int lane = c.lane, w = c.wave;
        const float* MOD = (const float*)(c.ws + WS_MOD) + (size_t)l * 16 * 6144;
        bf16* XN2 = (bf16*)(c.ws + WS_XN2);
        const float* RW = c.in[IN_RW] + (size_t)l * 1024 * 64; const float rbias = c.in[IN_RB][l * 64 + lane];
        unsigned* CNT = (unsigned*)(c.ws + WS_CTL) + CW_CNT + l * 128 * CNT_STRIDE;
        int* ROWL = (int*)(c.ws + WS_ROWL); float* WL = (float*)(c.ws + WS_WL); unsigned* TOKPOS = (unsigned*)(c.ws + WS_TOKPOS);
        const float* gain = c.in[IN_NFFN] + l * D;
        LAS unsigned* lcnt = (LAS unsigned*)(c.lds + 131584);
        LAS unsigned* stash = lcnt + 128;
        constexpr int STASH_ROWS = 128;
        int nrow_done = 0;
        if (c.tid < 128) lcnt[c.tid] = 0u;
        for (int it = c.bid; it < T / 32; it += c.nblk) {
            const int t0 = it * 32, b = t0 >> 11;
            const float* sh = MOD + (size_t)b * 6144 + 3072; const float* sc = MOD + (size_t)b * 6144 + 4096;
            __syncthreads();
#pragma unroll
            for (int r = 0; r < 4; ++r) {
                const int rr = 4 * w + r;
                const float* xrow = x1 + (size_t)(t0 + rr) * D;
                f32x4 v[4]; float ssum = 0.f;
#pragma unroll
                for (int j = 0; j < 4; ++j) { v[j] = *(const f32x4*)(xrow + 4 * (lane + 64 * j)); ssum += v[j][0] * v[j][0] + v[j][1] * v[j][1] + v[j][2] * v[j][2] + v[j][3] * v[j][3]; }
                const float rstd = rsqrtf(wave_sum(ssum) * (1.f / D) + EPS);
#pragma unroll
                for (int j = 0; j < 4; ++j) { const int cc = 4 * (lane + 64 * j);
                    const f32x4 g = *(const f32x4*)(gain + cc), a4 = *(const f32x4*)(sc + cc), bb = *(const f32x4*)(sh + cc);
                    const f32x4 hv = v[j] * rstd * g * (a4 + 1.f) + bb;
                    st_bf4(XN2 + (size_t)(t0 + rr) * D + cc, hv); *(LAS f32x4*)(H + rr * HLD + cc) = hv; }
            }
            __syncthreads();
            {
                const int rt = w >> 2, et = w & 3, fr = lane & 15, fq = lane >> 4;
                const LAS float* hp = H + (16 * rt + fr) * HLD + fq;
                const float* bp = RW + (size_t)fq * 64 + 16 * et + fr;
                f32x4 c0 = (f32x4){0.f, 0.f, 0.f, 0.f}, c1 = (f32x4){0.f, 0.f, 0.f, 0.f};
                float bq[8], bn[8];
#pragma unroll
                for (int j = 0; j < 8; ++j) bq[j] = bp[(size_t)(4 * j) * 64];
#pragma unroll 1
                for (int k8 = 0; k8 < 256; k8 += 8) {
                    const int kn = (k8 + 8) & 255;
#pragma unroll
                    for (int j = 0; j < 8; ++j) bn[j] = bp[(size_t)(4 * (kn + j)) * 64];
#pragma unroll
                    for (int j = 0; j < 8; j += 2) {
                        c0 = __builtin_amdgcn_mfma_f32_16x16x4f32(hp[4 * (k8 + j)], bq[j], c0, 0, 0, 0);
                        c1 = __builtin_amdgcn_mfma_f32_16x16x4f32(hp[4 * (k8 + j + 1)], bq[j + 1], c1, 0, 0, 0);
                    }
#pragma unroll
                    for (int j = 0; j < 8; ++j) bq[j] = bn[j];
                }
                const f32x4 cc = c0 + c1;
                __syncthreads();
                LAS float* LG = H;
#pragma unroll
                for (int r = 0; r < 4; ++r) LG[(16 * rt + 4 * fq + r) * 64 + 16 * et + fr] = cc[r];
            }
            __syncthreads();
#pragma unroll 1
            for (int r = 0; r < 4; ++r) {
                const int rr = 4 * w + r; const float lg = H[rr * 64 + lane];
                route_one(t0 + rr, lg, rbias, lane, lcnt, stash, nrow_done + rr);
            }
            nrow_done += 32;
            const bool last = it + c.nblk >= T / 32;
            if (nrow_done + 32 > STASH_ROWS || last) {
                __syncthreads();
                if (c.tid < 128) { const unsigned n = lcnt[c.tid]; lcnt[c.tid] = n ? atomicAdd(&CNT[c.tid * CNT_STRIDE], n) : 0u; }
                __syncthreads();
                for (int i = c.tid; i < nrow_done * 6; i += NTHR) { const LAS unsigned* st = stash + (size_t)i * 4;
                    const unsigned tt = st[0], m = st[1]; const int hf = m >> 24, e = (m >> 16) & 0xff; const unsigned slot = lcnt[hf * 64 + e] + (m & 0xffffu);
                    ROWL[((size_t)hf * 64 + e) * 16384 + slot] = (int)tt; WL[((size_t)hf * 64 + e) * 16384 + slot] = __builtin_bit_cast(float, st[2]);
                    TOKPOS[(size_t)tt * 6 + (i % 6)] = ((unsigned)e << 16) | slot; }
                __syncthreads();
                if (c.tid < 128) lcnt[c.tid] = 0u;
                nrow_done = 0;
            }
        }
        __syncthreads();
    }
}

__device__ __forceinline__ void moe_tables(const Ctx& c, int l, int hf) {
    LAS int* cnt = (LAS int*)(c.lds + 140000); LAS int* off = cnt + 65; LAS int* tst = off + 65;
    __syncthreads();
    if (c.tid == 0) {
        const unsigned* CNT = (const unsigned*)(c.ws + WS_CTL) + CW_CNT + (l * 128 + hf * 64) * CNT_STRIDE;
        int o = 0, ts = 0;
        for (int e = 0; e < NEX; ++e) { const int n = e < NE ? (int)CNT[e * CNT_STRIDE] : HALF_T; cnt[e] = n; off[e] = o; tst[e] = ts; o += (n + 255) & ~255; ts += (n + 255) >> 8; }
        tst[NEX] = ts;
    }
    __syncthreads();
}
struct MoeSched1 { LAS const int* cnt; LAS const int* off; LAS const int* tst; int G, c; const char* XN2; const char* WGU; const int* ROWL; const float* WL; const int* IDENT;
    __device__ __forceinline__ bool next(int i, g8::GUnit& u) const {
        const int L = i * G + c; if (L >= 2 * tst[NEX]) return false;
        const int rt = L >> 1, pn = L & 1; int e = 0; while (tst[e + 1] <= rt) ++e;
        const int r0 = (rt - tst[e]) * 256;
        u.A = XN2; u.B = WGU + ((size_t)e * 512 + (size_t)pn * 256) * 2048;
        u.rl = e < NE ? ROWL + (size_t)e * 16384 + r0 : IDENT + r0; u.nvalid = cnt[e] - r0; u.erow0 = 0; u.ecol0 = pn * 256; u.x0 = off[e] + r0; u.xp = e < NE ? WL + (size_t)e * 16384 + r0 : nullptr; return true; } };
struct MoeSched2 { LAS const int* cnt; LAS const int* off; LAS const int* tst; int G, c; const char* HID; const char* WD;
    __device__ __forceinline__ bool next(int i, g8::GUnit& u) const {
        const int L = i * G + c; if (L >= 4 * tst[NEX]) return false;
        const int rt = L >> 2, pn = L & 3; int e = 0; while (tst[e + 1] <= rt) ++e;
        const int r0 = (rt - tst[e]) * 256;
        u.A = HID + (size_t)(off[e] + r0) * 512; u.B = WD + ((size_t)e * 1024 + (size_t)pn * 256) * 512;
        u.rl = nullptr; u.nvalid = 0; u.erow0 = 0; u.ecol0 = pn * 256; u.x0 = off[e] + r0; u.xp = nullptr; return true; } };
struct EpiG1u { bf16* HID; struct Pre { float w; }; static constexpr int BATCH_M = 4; static constexpr bool PERM = true;
    __device__ __forceinline__ void post8(const g8::GUnit& u, int row, int col, f32x4 a0, f32x4 a1, f32x4 b0, f32x4 b1, const Pre& p, int) const {
        const int hc = col - 128 * (col >> 8);
        f32x4 v0 = (f32x4){0.f, 0.f, 0.f, 0.f}, v1 = v0;
        if (row < u.nvalid) {
#pragma unroll
            for (int i = 0; i < 4; ++i) { v0[i] = siluf_(a0[i]) * b0[i] * p.w; v1[i] = siluf_(a1[i]) * b1[i] * p.w; } }
        st_bf8(HID + (size_t)(u.x0 + row) * 256 + hc, v0, v1);
    }
    __device__ __forceinline__ Pre pre(const g8::GUnit& u, int row, int, int) const { return Pre{(u.xp && row < u.nvalid) ? u.xp[row] : 1.f}; }
    __device__ __forceinline__ void post(const g8::GUnit& u, int row, int col, f32x4 lo, f32x4 hi, const Pre& p, int) const {
        const int hc = col - 128 * (col >> 8);
        f32x4 v = (f32x4){0.f, 0.f, 0.f, 0.f};
        if (row < u.nvalid) { const float w = p.w;
#pragma unroll
            for (int i = 0; i < 4; ++i) v[i] = siluf_(lo[i]) * hi[i] * w; }
        st_bf4(HID + (size_t)(u.x0 + row) * 256 + hc, v);
    } };
constexpr float Y_SCALE = 16.f, Y_UNSCALE = 1.f / 16.f;
__device__ __forceinline__ unsigned pk4_fp8(f32x4 v) { int w = __builtin_amdgcn_cvt_pk_fp8_f32(v[0] * Y_SCALE, v[1] * Y_SCALE, 0, false); w = __builtin_amdgcn_cvt_pk_fp8_f32(v[2] * Y_SCALE, v[3] * Y_SCALE, w, true); return (unsigned)w; }
__device__ __forceinline__ f32x4 up4_fp8(unsigned q) { return (f32x4){__builtin_amdgcn_cvt_f32_fp8((int)q, 0), __builtin_amdgcn_cvt_f32_fp8((int)q, 1), __builtin_amdgcn_cvt_f32_fp8((int)q, 2), __builtin_amdgcn_cvt_f32_fp8((int)q, 3)}; }
struct EpiG2u { unsigned char* Y; typedef NoPre Pre; static constexpr int BATCH_M = 4; static constexpr bool PERM = true;
    __device__ __forceinline__ Pre pre(const g8::GUnit&, int, int, int) const { return Pre{}; }
    __device__ __forceinline__ void post(const g8::GUnit&, int, int, f32x4, f32x4, const Pre&, int) const {}
    __device__ __forceinline__ void post8(const g8::GUnit& u, int row, int col, f32x4 a0, f32x4 a1, f32x4 b0, f32x4 b1, const Pre&, int) const {
        unsigned char* y = Y + (size_t)(u.x0 + row) * 1024 + col;
        *(u32x2*)y = (u32x2){pk4_fp8(a0), pk4_fp8(a1)}; *(u32x2*)(y + 128) = (u32x2){pk4_fp8(b0), pk4_fp8(b1)};
    } };
__device__ __forceinline__ void phase_gemm1(const Ctx& c, int l, int hf) {
    moe_tables(c, l, hf);
    LAS int* cnt = (LAS int*)(c.lds + 140000); LAS int* off = cnt + 65; LAS int* tst = off + 65;
    MoeSched1 S{cnt, off, tst, c.nblk, c.bid, (const char*)(c.ws + WS_XN2), (const char*)(c.ws + WS_WGU), (const int*)(c.ws + WS_ROWL) + (size_t)hf * 64 * 16384, (const float*)(c.ws + WS_WL) + (size_t)hf * 64 * 16384,
                (const int*)(c.ws + WS_IDENT) + (size_t)hf * HALF_T};
    EpiG1u E{(bf16*)(c.ws + WS_HID)};
    g8::gemm_phase<true>(c.lds, 2048u, 1024, S, E);
    __syncthreads();
}
__device__ __forceinline__ void phase_gemm2(const Ctx& c, int l, int hf) {
    moe_tables(c, l, hf);
    LAS int* cnt = (LAS int*)(c.lds + 140000); LAS int* off = cnt + 65; LAS int* tst = off + 65;
    MoeSched2 S{cnt, off, tst, c.nblk, c.bid, (const char*)(c.ws + WS_HID), (const char*)(c.ws + WS_WD)};
    EpiG2u E{(unsigned char*)(c.ws + WS_Y)};
    g8::gemm_phase<false>(c.lds, 512u, 256, S, E);
    __syncthreads();
}
__device__ __forceinline__ void phase_combine(const Ctx& c, int l, int hf, float* xio) {
    moe_tables(c, l, hf);
    LAS int* off = (LAS int*)(c.lds + 140000) + 65;
    const int gw = c.bid * NWAVES + c.wave, NGW = c.nblk * NWAVES, lane = c.lane;
    const unsigned char* Y = (const unsigned char*)(c.ws + WS_Y); const unsigned* TOKPOS = (const unsigned*)(c.ws + WS_TOKPOS);
    const float* MODl = (const float*)(c.ws + WS_MOD) + (size_t)l * 16 * 6144;
    const float* MODn = (const float*)(c.ws + WS_MOD) + (size_t)1 * 16 * 6144;
    bf16* XN = (bf16*)(c.ws + WS_XN);
    unsigned tpn[TOPK];
    if (gw < HALF_T) {
#pragma unroll
        for (int kk = 0; kk < TOPK; ++kk) tpn[kk] = TOKPOS[(size_t)(hf * HALF_T + gw) * 6 + kk]; }
#pragma unroll 1
    for (int tt = gw; tt < HALF_T; tt += NGW) {
        const int t = hf * HALF_T + tt, b = t >> 11;
        unsigned tp[TOPK];
#pragma unroll
        for (int kk = 0; kk < TOPK; ++kk) tp[kk] = tpn[kk];
        f32x4 acc[4];
        unsigned yv[TOPK + 1][4];
        { const unsigned char* yr = Y + (size_t)(off[NE] + tt) * 1024;
#pragma unroll
          for (int j = 0; j < 4; ++j) yv[TOPK][j] = *(const unsigned*)(yr + 4 * (lane + 64 * j)); }
#pragma unroll
        for (int kk = 0; kk < TOPK; ++kk) {
            const int e = tp[kk] >> 16, slot = tp[kk] & 0xffff;
            const unsigned char* yr = Y + (size_t)(off[e] + slot) * 1024;
#pragma unroll
            for (int j = 0; j < 4; ++j) yv[kk][j] = *(const unsigned*)(yr + 4 * (lane + 64 * j));
        }
        if (tt + NGW < HALF_T) {
#pragma unroll
            for (int kk = 0; kk < TOPK; ++kk) tpn[kk] = TOKPOS[(size_t)(t + NGW) * 6 + kk]; }
#pragma unroll
        for (int j = 0; j < 4; ++j) { acc[j] = up4_fp8(yv[TOPK][j]);
#pragma unroll
            for (int kk = 0; kk < TOPK; ++kk) acc[j] += up4_fp8(yv[kk][j]);
            acc[j] *= Y_UNSCALE; }
        float* xr = xio + (size_t)t * D; const float* g2 = MODl + (size_t)b * 6144 + 5120;
        f32x4 v[4]; float s = 0.f;
#pragma unroll
        for (int j = 0; j < 4; ++j) { const int cc = 4 * (lane + 64 * j); v[j] = *(const f32x4*)(xr + cc) + *(const f32x4*)(g2 + cc) * acc[j]; s += v[j][0] * v[j][0] + v[j][1] * v[j][1] + v[j][2] * v[j][2] + v[j][3] * v[j][3]; }
        const float rstd = rsqrtf(wave_sum(s) * (1.f / D) + EPS);
        if (l == 0) {
#pragma unroll
            for (int j = 0; j < 4; ++j) { const int cc = 4 * (lane + 64 * j); *(f32x4*)(xr + cc) = v[j];
                const f32x4 g = *(const f32x4*)(c.in[IN_NMIX] + D + cc), a = *(const f32x4*)(MODn + (size_t)b * 6144 + 1024 + cc), bb = *(const f32x4*)(MODn + (size_t)b * 6144 + cc);
                st_bf4(XN + (size_t)t * D + cc, v[j] * rstd * g * (a + 1.f) + bb); }
        } else {
#pragma unroll
            for (int j = 0; j < 4; ++j) { const int cc = 4 * (lane + 64 * j); *(f32x4*)(xr + cc) = v[j] * rstd * *(const f32x4*)(c.in[IN_NFIN] + cc); }
        }
    }
}

#ifdef DSA_NO_SEL
#define DSA_SEL_CALL
#else
#define DSA_SEL_CALL phase_ckvt(c); for (int r2 = 0; r2 < REPN(20); ++r2) phase_dsa_sel(c, l);
#endif
#ifdef DSA_NO_ATT
#define DSA_ATT_CALL
#else
#define DSA_ATT_CALL for (int r2 = 0; r2 < REPN(21); ++r2) phase_dsa_att(c, l);
#endif
constexpr int PH_PER_L = 18, N_PHASES = 1 + NL * PH_PER_L;
#ifndef PH_MASK
#define PH_MASK 0xFFFFFFFFu
#endif
#define IN(k) (lo <= (k) && (k) < hi)
#define EN(b) ((PH_MASK >> (b)) & 1u)
#ifndef REP_MASK
#define REP_MASK 0u
#endif
#define REPN(b) (((REP_MASK >> (b)) & 1u) ? 2 : 1)
#define SEAM(k) do { if (MK_ONE_LAUNCH && IN(k) && IN((k) + 1)) xcd_barrier(bar); } while (0)
template <int l>
__device__ __forceinline__ void layer_program(const Ctx& c, const XcdBarrier& bar, int lo, int hi) {
        const int P = 1 + l * PH_PER_L;
        const float* xin = l == 0 ? c.in[IN_X] : c.out;
        bf16* PB = (bf16*)(c.ws + WS_PB); float* SM = (float*)(c.ws + WS_SM);
        const bf16* XN = (const bf16*)(c.ws + WS_XN);
        const bf16* WIN = (const bf16*)(c.ws + WS_WIN) + (size_t)l * NINP * 1024;
        if (EN(1) && IN(P + 0)) { for (int rep = 0; rep < REPN(1); ++rep) {  if (l == 0) phase_norm1(c, 0, c.in[IN_X]);  if (rep + 1 < REPN(1)) xcd_barrier(bar); } } if (l == 0) SEAM(P + 0);
        if (EN(2) && IN(P + 1)) { for (int rep = 0; rep < REPN(2); ++rep) {  EpiInPB E{PB, SM}; dgemm_phase(c, XN, 1024, T, WIN, NPB / 256, 1024, EpiU<decltype(E)>{E});  if (rep + 1 < REPN(2)) xcd_barrier(bar); } } SEAM(P + 1);
        if (EN(4) && IN(P + 3)) { for (int rep = 0; rep < REPN(4); ++rep) {
#if SCAN_3PASS
            phase_prep(c, l);
            for (int r2 = 0; r2 < REPN(22); ++r2) phase_scanA(c, l);
            xcd_barrier(bar); scanB(c);
            { EpiQ Eq{(bf16*)(c.ws + WS_QLAT), (bf16*)(c.ws + WS_QIDX), (const float*)(c.ws + WS_RSTDQ)};
              dgemm_phase(c, PB + PB_CQ, NPB, T, (const bf16*)(c.ws + WS_WQ) + (size_t)l * 1280 * 256, 5, 256, EpiU<decltype(Eq)>{Eq}); }
            xcd_barrier(bar); phase_scanC(c, l);
#else
            phase_scans(c, l);
#endif
            if (rep + 1 < REPN(4)) xcd_barrier(bar); } } SEAM(P + 3);
        if (EN(6) && IN(P + 5)) { for (int rep = 0; rep < REPN(6); ++rep) {  EpiGate E{(bf16*)(c.ws + WS_G)}; dgemm_phase(c, XN, 1024, T, WIN + (size_t)NPB * 1024, NG / 256, 1024, EpiU<decltype(E)>{E});  if (rep + 1 < REPN(6)) xcd_barrier(bar); } }
        if (EN(7) && IN(P + 6)) { for (int rep = 0; rep < REPN(7); ++rep) {  DSA_SEL_CALL xcd_barrier(bar); DSA_ATT_CALL  if (rep + 1 < REPN(7)) xcd_barrier(bar); } } SEAM(P + 6);
        if (EN(8) && IN(P + 7)) {
            { EpiUp E{(bf16*)(c.ws + WS_M1), (bf16*)(c.ws + WS_MF), (const bf16*)(c.ws + WS_G), 0, 1, 0};
              dgemm_phase(c, (const bf16*)(c.ws + WS_UA), 512, T, (const bf16*)(c.ws + WS_WUPA) + (size_t)l * 1024 * 512, 4, 512, EpiU<decltype(E)>{E}); }
            { EpiUp E{(bf16*)(c.ws + WS_M1), (bf16*)(c.ws + WS_MF), (const bf16*)(c.ws + WS_G), 1, 0, 0};
              dgemm_phase(c, (const bf16*)(c.ws + WS_OLAT), 512, T, (const bf16*)(c.ws + WS_WUPB) + (size_t)l * 1024 * 512, 4, 512, EpiU<decltype(E)>{E}); }
            { EpiUp E{(bf16*)(c.ws + WS_M1), (bf16*)(c.ws + WS_MF), (const bf16*)(c.ws + WS_G), 2, 0, 1};
              dgemm_phase(c, (const bf16*)(c.ws + WS_UC), 512, T, (const bf16*)(c.ws + WS_WUPC) + (size_t)l * 1024 * 512, 4, 512, EpiU<decltype(E)>{E}); }
        } SEAM(P + 9);
        if (EN(11) && IN(P + 10)) { for (int rep = 0; rep < REPN(11); ++rep) {  EpiWo E{xin, c.out, (const float*)(c.ws + WS_MOD) + (size_t)l * 16 * 6144 + 2048};
            dgemm_phase(c, (const bf16*)(c.ws + WS_M1), 1024, T, (const bf16*)(c.ws + WS_WO) + (size_t)l * 1024 * 1024, 4, 1024, EpiU<decltype(E)>{E});  if (rep + 1 < REPN(11)) xcd_barrier(bar); } } SEAM(P + 10);
        if (EN(12) && IN(P + 11)) { for (int rep = 0; rep < REPN(12); ++rep) {  phase_route(c, l, c.out);  if (rep + 1 < REPN(12)) xcd_barrier(bar); } } SEAM(P + 11);
        if (EN(13) && IN(P + 12)) { for (int rep = 0; rep < REPN(13); ++rep) {  phase_gemm1(c, l, 0);  if (rep + 1 < REPN(13)) xcd_barrier(bar); } } SEAM(P + 12);
        if (EN(14) && IN(P + 13)) { for (int rep = 0; rep < REPN(14); ++rep) {  phase_gemm2(c, l, 0);  if (rep + 1 < REPN(14)) xcd_barrier(bar); } } SEAM(P + 13);
        if (EN(15) && IN(P + 14)) { phase_combine(c, l, 0, c.out); phase_gemm1(c, l, 1); } SEAM(P + 14);
        if (EN(17) && IN(P + 16)) { for (int rep = 0; rep < REPN(17); ++rep) {  phase_gemm2(c, l, 1);  if (rep + 1 < REPN(17)) xcd_barrier(bar); } } SEAM(P + 16);
        if (EN(18) && IN(P + 17)) { for (int rep = 0; rep < REPN(18); ++rep) {  phase_combine(c, l, 1, c.out);  if (rep + 1 < REPN(18)) xcd_barrier(bar); } } SEAM(P + 17);
    }
__global__ void __launch_bounds__(NTHR, 2) fwd(Args args) {
    extern __shared__ __attribute__((aligned(16))) unsigned char lds_raw[];
    Ctx c;
    c.lds = (LAS unsigned char*)lds_raw;
    c.tid = threadIdx.x; c.lane = c.tid & 63; c.wave = __builtin_amdgcn_readfirstlane(c.tid >> 6);
    c.bid = blockIdx.x; c.nblk = gridDim.x;
    c.in = args.in; c.out = args.out; c.ws = args.ws;
    for (int u = c.tid; u < (LDS_BYTES - LDS_MISC) / 4; u += NTHR) ((LAS unsigned*)(c.lds + LDS_MISC))[u] = 0u;
    __syncthreads();
    XcdBarrier bar; bar.bar = (unsigned*)(c.ws + WS_CTL) + CW_BAR; bar.x = 0; bar.st = (volatile LAS unsigned*)(c.lds + LDS_MISC);
    if (MK_ONE_LAUNCH) bar = xcd_barrier_post((unsigned*)(c.ws + WS_CTL) + CW_BAR, (volatile LAS unsigned*)(c.lds + LDS_MISC));
    const int lo = args.ph_lo, hi = args.ph_hi;
#if PROBE_SEAM >= 0
    const unsigned long long t_start = wall_clock64();
#endif
    if (EN(0) && IN(0)) { for (int rep = 0; rep < REPN(0); ++rep) { phase_prologue(c); if (rep + 1 < REPN(0)) xcd_barrier(bar); } } SEAM(0);
    layer_program<0>(c, bar, lo, hi);
    layer_program<1>(c, bar, lo, hi);
#if PROBE_SEAM >= 0
    if (blockIdx.x == 0 && threadIdx.x == 0) {
        const unsigned long long* st = (const unsigned long long*)(bar.bar + 8192);
        const unsigned long long t = (PROBE_SEAM >= 1000 ? wall_clock64() : st[PROBE_SEAM]) - t_start, t0 = wall_clock64();
        while (wall_clock64() - t0 < 7ull * t) __builtin_amdgcn_s_sleep(8);
    }
#endif
#undef IN
#undef SEAM
}

extern "C" void kernel_launch(void* const* d_in, const int* in_sizes, int n_in, void* d_out, int out_size, void* d_ws, size_t ws_size, hipStream_t stream) {
    static int grid = 0;
    if (grid == 0) {
        if (n_in != 33 || out_size != T * D || ws_size < WS_END) { fprintf(stderr, "kernel_launch: unexpected problem (n_in %d out %d ws %zu)\n", n_in, out_size, ws_size); grid = -1; return; }
        int dev = 0, cus = 0, per_cu = 0;
        if (hipGetDevice(&dev) != hipSuccess || hipDeviceGetAttribute(&cus, hipDeviceAttributeMultiprocessorCount, dev) != hipSuccess) { grid = -1; return; }
        if (hipFuncSetAttribute((const void*)fwd, hipFuncAttributeMaxDynamicSharedMemorySize, LDS_BYTES) != hipSuccess) { fprintf(stderr, "kernel_launch: hipFuncSetAttribute failed\n"); grid = -1; return; }
        if (hipOccupancyMaxActiveBlocksPerMultiprocessor(&per_cu, (const void*)fwd, NTHR, LDS_BYTES) != hipSuccess || per_cu < 1) { fprintf(stderr, "kernel_launch: occupancy query says %d\n", per_cu); }
        (void)hipGetLastError();
        grid = cus;
    }
    if (grid < 0) return;
    (void)hipMemsetAsync((char*)d_ws + WS_CTL, 0, CTL_BYTES, stream);
    Args a{};
    for (int i = 0; i < 33; ++i) a.in[i] = (const float*)d_in[i];
    a.out = (float*)d_out; a.ws = (unsigned char*)d_ws;
#if MK_ONE_LAUNCH
    a.ph_lo = 0; a.ph_hi = N_PHASES;
    hipLaunchKernelGGL(fwd, dim3(grid), dim3(NTHR), LDS_BYTES, stream, a);
#else
    for (int p = 0; p < N_PHASES; ++p) {
        if (p == 1 + PH_PER_L) continue;
        a.ph_lo = p; a.ph_hi = p + 1;
        hipLaunchKernelGGL(fwd, dim3(grid), dim3(NTHR), LDS_BYTES, stream, a);
    }
#endif
}
```

```cpp
#include <hip/hip_runtime.h>
#include <cstdio>
#include <cstdint>

#define LAS __attribute__((address_space(3)))
#define GAS __attribute__((address_space(1)))
typedef unsigned short bf16;
typedef short bf16x8 __attribute__((ext_vector_type(8)));
typedef float f32x4 __attribute__((ext_vector_type(4)));
typedef float f32x2 __attribute__((ext_vector_type(2)));
typedef unsigned u32x4 __attribute__((ext_vector_type(4)));
typedef unsigned u32x2 __attribute__((ext_vector_type(2)));
typedef GAS unsigned gu32;

#ifndef PROBE_SEAM
#define PROBE_SEAM -1
#endif
#ifndef SCAN_3PASS
#define SCAN_3PASS 1
#endif
#ifndef SCAN_RECURRENT
#define SCAN_RECURRENT 0
#endif
#ifndef CONV_REP
#define CONV_REP 1
#endif
#ifndef MK_ONE_LAUNCH
#define MK_ONE_LAUNCH 1
#endif

constexpr int NB = 16, SEQ = 2048, D = 1024, T = NB * SEQ, NL = 2;
constexpr int NIN = 6592, NPB = 3584, NG = 3072, NINP = NPB + NG;
constexpr int NE = 64, NEX = 65, EFF = 256, TOPK = 6;
constexpr int HALF_T = T / 2;
constexpr int DSA_K = 256;
constexpr float EPS = 1e-6f;
constexpr int NTHR = 512, NWAVES = 8;

constexpr int PB_QA = 0, PB_KA = 256, PB_VA = 512, PB_GA = 1024, PB_CQ = 1536, PB_CKV = 1792, PB_QC = 2048, PB_KC = 2304, PB_VC = 2560, PB_OC = 3072;
constexpr int SM_KIDX = 0, SM_ALR = 32, SM_WIDX = 48, SM_IC = 56, SM_FC = 60;

constexpr size_t MiB = 1u << 20;
constexpr size_t WS_CTL = 0, CTL_BYTES = 1 * MiB;
constexpr size_t WS_MOD = 1 * MiB;
constexpr size_t WS_RSTDQ = 2 * MiB;
constexpr size_t WS_TOKPOS = 3 * MiB;
constexpr size_t WS_IDENT = 3 * MiB + 800 * 1024;
constexpr size_t WS_WIN = 4 * MiB;
constexpr size_t WS_WQ = 30 * MiB;
constexpr size_t WS_WUPA = 32 * MiB;
constexpr size_t WS_WUPC = 34 * MiB;
constexpr size_t WS_WUPB = 36 * MiB;
constexpr size_t WS_WUVF = 38 * MiB;
constexpr size_t WS_WO = 40 * MiB;
constexpr size_t WS_WGU = 44 * MiB;
constexpr size_t WS_WD = 109 * MiB;
constexpr size_t WS_XN = 142 * MiB;
constexpr size_t WS_OLAT = WS_XN;
constexpr size_t WS_UA = 206 * MiB;
constexpr size_t WS_UC = 238 * MiB;
constexpr size_t WS_XN2 = 206 * MiB;
constexpr size_t WS_QLAT = 270 * MiB;
constexpr size_t WS_M1 = WS_QLAT;
constexpr size_t WS_QIDX = 334 * MiB;
constexpr size_t WS_CKVN = 350 * MiB;
constexpr size_t WS_KIDX = 358 * MiB;
constexpr size_t WS_SM = 360 * MiB;
constexpr size_t WS_PB = 376 * MiB;
constexpr size_t WS_G = WS_PB;
constexpr size_t WS_HID = 270 * MiB;
constexpr size_t WS_Y = 334 * MiB;
constexpr size_t WS_ROWL = 590 * MiB;
constexpr size_t WS_WL = 598 * MiB;
constexpr size_t WS_CKVT = 576 * MiB;
constexpr size_t WS_MASK = 584 * MiB;
static_assert(WS_CKVT >= WS_G + (size_t)T * NG * 2 && WS_MASK + (size_t)T * 64 * 4 <= WS_PB + (size_t)T * NPB * 2, "CKVT/MASK placement");
constexpr size_t WS_QS = 44 * MiB;
constexpr size_t WS_DSG = 76 * MiB;
constexpr size_t WS_DSM = 600 * MiB;
constexpr size_t WS_ET = 108 * MiB;
constexpr size_t WS_CT = 108 * MiB + 512 * 1024;
constexpr size_t WS_MP = 108 * MiB + 768 * 1024;
constexpr size_t WS_GPM = 109 * MiB;
constexpr size_t WS_GBC = 110 * MiB;
constexpr size_t WS_DN = 111 * MiB;
constexpr size_t WS_KEYB = 44 * MiB;
constexpr size_t WS_MF = 568 * MiB;
constexpr size_t WS_END = 636 * MiB;
static_assert(WS_PB + (size_t)T * NPB * 2 <= 600 * MiB, "PB");
static_assert(WS_Y + (size_t)131072 * 1024 * 2 <= WS_ROWL, "Y");

constexpr int CW_BAR = 4096;
constexpr int CW_CNT = 16384;
constexpr int CNT_STRIDE = 64;

constexpr int LDS_BYTES = 147456;
constexpr int LDS_MISC = 145408;

__device__ __forceinline__ unsigned f2bf(float f) { unsigned u = __builtin_bit_cast(unsigned, f); return (u + 0x7fffu + ((u >> 16) & 1u)) >> 16; }
__device__ __forceinline__ float bf2f(unsigned b) { return __builtin_bit_cast(float, b << 16); }
typedef __bf16 bf16x2_t __attribute__((ext_vector_type(2)));
__device__ __forceinline__ unsigned pk2(float lo, float hi) { const f32x2 v = {lo, hi}; const bf16x2_t b = __builtin_convertvector(v, bf16x2_t); return __builtin_bit_cast(unsigned, b); }
__device__ __forceinline__ float bflo(unsigned w) { return __builtin_bit_cast(float, w << 16); }
__device__ __forceinline__ float bfhi(unsigned w) { return __builtin_bit_cast(float, w & 0xffff0000u); }
__device__ __forceinline__ float wave_sum(float v) {
#pragma unroll
    for (int o = 1; o < 64; o <<= 1) v += __shfl_xor(v, o);
    return v;
}
__device__ __forceinline__ float wave_max(float v) {
#pragma unroll
    for (int o = 1; o < 64; o <<= 1) v = fmaxf(v, __shfl_xor(v, o));
    return v;
}
__device__ __forceinline__ int wave_sum_i(int v) {
#pragma unroll
    for (int o = 1; o < 64; o <<= 1) v += __shfl_xor(v, o);
    return v;
}
__device__ __forceinline__ void lds_barrier() { asm volatile("s_waitcnt lgkmcnt(0)" ::: "memory"); __builtin_amdgcn_s_barrier(); asm volatile("" ::: "memory"); }
__device__ __forceinline__ float sigmoid_exact(float x) { return 1.f / (1.f + __expf(-x)); }
__device__ __forceinline__ float sigmoidf_(float x) { return __builtin_amdgcn_rcpf(1.f + __builtin_amdgcn_exp2f(-1.4426950408889634f * x)); }
__device__ __forceinline__ float siluf_(float x) { return x * __builtin_amdgcn_rcpf(1.f + __builtin_amdgcn_exp2f(-1.4426950408889634f * x)); }
__device__ __forceinline__ float logsigmoidf_(float x) { return fminf(x, 0.f) - log1pf(__expf(-fabsf(x))); }
__device__ __forceinline__ float logsigmoid_fast(float x) { return fminf(x, 0.f) - __logf(1.f + __expf(-fabsf(x))); }
__device__ __forceinline__ void st_bf4(bf16* p, f32x4 v) { u32x2 w; w.x = pk2(v[0], v[1]); w.y = pk2(v[2], v[3]); *(u32x2*)p = w; }
__device__ __forceinline__ void st_bf8(bf16* p, f32x4 a, f32x4 b) { u32x4 w; w.x = pk2(a[0], a[1]); w.y = pk2(a[2], a[3]); w.z = pk2(b[0], b[1]); w.w = pk2(b[2], b[3]); *(u32x4*)p = w; }
__device__ __forceinline__ f32x4 ld_bf4_l2(const bf16* p) { const unsigned long long q = __hip_atomic_load((const unsigned long long*)p, __ATOMIC_RELAXED, __HIP_MEMORY_SCOPE_AGENT); const unsigned lo = (unsigned)q, hi = (unsigned)(q >> 32); return (f32x4){bflo(lo), bfhi(lo), bflo(hi), bfhi(hi)}; }
__device__ __forceinline__ f32x4 ld_bf4(const bf16* p) { u32x2 w = *(const u32x2*)p; return (f32x4){bflo(w.x), bfhi(w.x), bflo(w.y), bfhi(w.y)}; }

#define XB_TMO      128
#define XB_XCNT(j)  (256  + 64 * (j))
#define XB_XSUB(j)  (1280 + 64 * (j))
#define XB_XGEN(j)  (2304 + 64 * (j))
#define XB_TOP      3328
#define XB_TOPGEN   3392
#define XCD_BAR_WORDS 3456
#define XB_SPIN_CAP (1u << 22)
__device__ __forceinline__ unsigned xb_ld(unsigned* p)              { return __hip_atomic_load(p, __ATOMIC_RELAXED, __HIP_MEMORY_SCOPE_AGENT); }
__device__ __forceinline__ unsigned xb_add(unsigned* p, unsigned v) { return __hip_atomic_fetch_add(p, v, __ATOMIC_RELAXED, __HIP_MEMORY_SCOPE_AGENT); }
__device__ __forceinline__ unsigned xb_xcc_id() { return (unsigned)__builtin_amdgcn_s_getreg((3 << 11) | 20) & 0xFu; }
#define XB_SPIN(cond, bar) do { unsigned _sp = 0; while (cond) { __builtin_amdgcn_s_sleep(1); \
    if ((++_sp & 255u) == 0u) { if (xb_ld(&(bar)[XB_TMO])) break; if (_sp > XB_SPIN_CAP) { atomicAdd(&(bar)[XB_TMO], 1u); break; } } } } while (0)
struct XcdBarrier { unsigned* bar; unsigned x; volatile LAS unsigned* st; };
__device__ __forceinline__ XcdBarrier xcd_barrier_post(unsigned* bar, volatile LAS unsigned* st) {
    XcdBarrier b; b.bar = bar; b.x = xb_xcc_id(); b.st = st;
    if (threadIdx.x == 0) (void)xb_add(&bar[XB_XCNT(b.x)], 1u);
    return b;
}
__device__ __forceinline__ void xcd_barrier_complete(unsigned* bar, unsigned x, unsigned& nloc, unsigned& nx) {
    const unsigned G = gridDim.x * gridDim.y * gridDim.z;
    unsigned sum, cnt, mine, sp = 0u;
    for (;;) {
        sum = 0u; cnt = 0u; mine = 0u;
#pragma unroll
        for (unsigned j = 0; j < 16; ++j) { const unsigned c = xb_ld(&bar[XB_XCNT(j)]); sum += c; cnt += (c > 0u) ? 1u : 0u; mine = (j == x) ? c : mine; }
        if (sum == G) break;
        __builtin_amdgcn_s_sleep(1);
        if ((++sp & 255u) == 0u) { if (xb_ld(&bar[XB_TMO])) break; if (sp > XB_SPIN_CAP) { atomicAdd(&bar[XB_TMO], 1u); break; } }
    }
    nloc = mine > 0u ? mine : 1u; nx = cnt > 0u ? cnt : 1u;
}
__device__ __forceinline__ void xcd_barrier(const XcdBarrier& b) {
    asm volatile("s_waitcnt vmcnt(0)" ::: "memory");
    __syncthreads();
    if (threadIdx.x == 0) {
        unsigned* bar = b.bar;
        __builtin_amdgcn_s_waitcnt(0);
        unsigned nloc = b.st[0], nx = b.st[1];
        if (nloc == 0u) { xcd_barrier_complete(bar, b.x, nloc, nx); b.st[0] = nloc; b.st[1] = nx; }
        const unsigned old = xb_add(&bar[XB_XSUB(b.x)], 1u);
        const unsigned gen = old / nloc;
        if (old + 1u == (gen + 1u) * nloc) {
            __builtin_amdgcn_fence(__ATOMIC_RELEASE, "agent");
            asm volatile("s_waitcnt vmcnt(0)" ::: "memory");
            const unsigned og = xb_add(&bar[XB_TOP], 1u);
            const unsigned tg = og / nx;
            if (og + 1u == (tg + 1u) * nx) xb_add(&bar[XB_TOPGEN], 1u);
            else XB_SPIN(xb_ld(&bar[XB_TOPGEN]) == tg, bar);
            __builtin_amdgcn_fence(__ATOMIC_ACQUIRE, "agent");
            xb_add(&bar[XB_XGEN(b.x)], 1u);
            asm volatile("s_waitcnt vmcnt(0)" ::: "memory");
        } else {
            XB_SPIN(xb_ld(&bar[XB_XGEN(b.x)]) == gen, bar);
            __builtin_amdgcn_fence(__ATOMIC_ACQUIRE, "agent");
            asm volatile("s_waitcnt vmcnt(0)" ::: "memory");
        }
#if PROBE_SEAM >= 0
        if (blockIdx.x == 0) { const unsigned n = b.st[2]; ((unsigned long long*)(b.bar + 8192))[n] = wall_clock64(); b.st[2] = n + 1u; }
#endif
    }
    __syncthreads();
}

struct Args { const float* in[33]; float* out; unsigned char* ws; int ph_lo, ph_hi; };

struct Ctx {
    LAS unsigned char* lds;
    int tid, lane, wave, bid, nblk;
    const float* const* in;
    float* out; unsigned char* ws;
};
#define IN_X 0
#define IN_C 1
#define IN_ADAW 2
#define IN_ADAB 3
#define IN_NMIX 4
#define IN_NFFN 5
#define IN_WIN 6
#define IN_GLA_WA2 7
#define IN_GLA_BA 8
#define IN_GLA_NORM 9
#define IN_DSA_NQ 10
#define IN_DSA_NKV 11
#define IN_DSA_WUQ 12
#define IN_DSA_WUK 13
#define IN_DSA_WUV 14
#define IN_DSA_WQI 15
#define IN_ML_CONV 16
#define IN_ML_BI 17
#define IN_ML_BF 18
#define IN_ML_NORM 19
#define IN_WUPA 20
#define IN_WUPB 21
#define IN_WUPC 22
#define IN_WO 23
#define IN_RW 24
#define IN_RB 25
#define IN_EWG 26
#define IN_EWU 27
#define IN_EWD 28
#define IN_SWG 29
#define IN_SWU 30
#define IN_SWD 31
#define IN_NFIN 32

template <class SrcF>
__device__ __forceinline__ void tr_item(const SrcF& src, bf16* dst, int dst_ld, int n0, int k0, LAS float* scr, int lane) {
    const int j = lane & 31;
    const float* colp = src(n0 + j);
    const long ld = src.ld;
    float tv[32];
#pragma unroll
    for (int i = 0; i < 32; ++i) { const int kk = 2 * i + (lane >> 5); tv[i] = colp ? __builtin_nontemporal_load(colp + (long)(k0 + kk) * ld) : 0.f; }
#pragma unroll
    for (int i = 0; i < 32; ++i) { const int kk = 2 * i + (lane >> 5); scr[kk * 33 + j] = tv[i]; }
    asm volatile("s_waitcnt lgkmcnt(0)" ::: "memory");
    const int c = lane & 7;
#pragma unroll
    for (int jj = 0; jj < 4; ++jj) { const int n = (lane >> 3) + 8 * jj; const LAS float* s = scr + (8 * c) * 33 + n;
        u32x4 o; o.x = pk2(s[0 * 33], s[1 * 33]); o.y = pk2(s[2 * 33], s[3 * 33]); o.z = pk2(s[4 * 33], s[5 * 33]); o.w = pk2(s[6 * 33], s[7 * 33]);
        *(u32x4*)(dst + (size_t)(n0 + n) * dst_ld + k0 + 8 * c) = o; }
    asm volatile("s_waitcnt lgkmcnt(0)" ::: "memory");
}
struct SrcPlain { const float* W; long ld; __device__ __forceinline__ const float* operator()(int n) const { return W + n; } };
__device__ __forceinline__ int win_src_col(int r) {
    if (r < 1536) return r;
    if (r < 1792) return 1552 + (r - 1536);
    if (r < 1920) return 1808 + (r - 1792);
    if (r < 1952) return 1936 + (r - 1920);
    if (r < 1968) return 1536 + (r - 1952);
    if (r < 1976) return 1968 + (r - 1968);
    if (r < 1980) return 3000 + (r - 1976);
    if (r < 1984) return 3004 + (r - 1980);
    if (r < 2048) return -1;
    if (r < 2560) return 1976 + (r - 2048);
    if (r < 3072) return 2488 + (r - 2560);
    if (r < 3584) return 3008 + (r - 3072);
    return 3520 + (r - 3584);
}
struct SrcWin { const float* W; long ld; __device__ __forceinline__ const float* operator()(int n) const { const int c = win_src_col(n); return c < 0 ? nullptr : W + c; } };
struct SrcGU { const float* Wg; const float* Wu; long ld;
    __device__ __forceinline__ const float* operator()(int r) const { const int pn = r >> 8, w = r & 255, j = 128 * pn + (w & 127); return (w < 128 ? Wg : Wu) + j; } };

constexpr int SG_LD = 40;
template <class Epi>
__device__ __forceinline__ void sgemm_unit(const Ctx& c, const bf16* A, int lda, const int* rowlist, int nvalid, int arow0, const bf16* Bt, int K, const Epi& E, int erow0, int ecol0) {
    LAS bf16* As = (LAS bf16*)c.lds;
    LAS bf16* Bs = (LAS bf16*)(c.lds + 128 * SG_LD * 2);
    const int tid = c.tid, lane = c.lane, wave = c.wave, wr = wave >> 2, wc = wave & 3, fr = lane & 15, fq = lane >> 4;
    const int lr = tid >> 2, ch = tid & 3;
    int srow = arow0 + lr;
    if (rowlist) { srow = (arow0 + lr < nvalid) ? rowlist[arow0 + lr] : 0; }
    const bf16* ap = A + (size_t)srow * lda + ch * 8;
    const bf16* bp0 = Bt + (size_t)lr * K + ch * 8;
    const bf16* bp1 = Bt + (size_t)(128 + lr) * K + ch * 8;
    f32x4 acc[2][4][2];
#pragma unroll
    for (int a = 0; a < 2; ++a)
#pragma unroll
        for (int m = 0; m < 4; ++m)
#pragma unroll
            for (int n = 0; n < 2; ++n) acc[a][m][n] = (f32x4){0.f, 0.f, 0.f, 0.f};
    u32x4 ra = *(const u32x4*)ap, rb0 = *(const u32x4*)bp0, rb1 = *(const u32x4*)bp1;
    for (int k0 = 0; k0 < K; k0 += 32) {
        __syncthreads();
        *(LAS u32x4*)(As + lr * SG_LD + ch * 8) = ra;
        *(LAS u32x4*)(Bs + lr * SG_LD + ch * 8) = rb0;
        *(LAS u32x4*)(Bs + (128 + lr) * SG_LD + ch * 8) = rb1;
        __syncthreads();
        if (k0 + 32 < K) { ra = *(const u32x4*)(ap + k0 + 32); rb0 = *(const u32x4*)(bp0 + k0 + 32); rb1 = *(const u32x4*)(bp1 + k0 + 32); }
        bf16x8 af[4], bfr[2][2];
#pragma unroll
        for (int m = 0; m < 4; ++m) af[m] = *(const LAS bf16x8*)(As + (wr * 64 + m * 16 + fr) * SG_LD + fq * 8);
#pragma unroll
        for (int bj = 0; bj < 2; ++bj)
#pragma unroll
            for (int n = 0; n < 2; ++n) bfr[bj][n] = *(const LAS bf16x8*)(Bs + (bj * 128 + wc * 32 + n * 16 + fr) * SG_LD + fq * 8);
#pragma unroll
        for (int bj = 0; bj < 2; ++bj)
#pragma unroll
            for (int m = 0; m < 4; ++m)
#pragma unroll
                for (int n = 0; n < 2; ++n) acc[bj][m][n] = __builtin_amdgcn_mfma_f32_16x16x32_bf16(bfr[bj][n], af[m], acc[bj][m][n], 0, 0, 0);
    }
#pragma unroll
    for (int m = 0; m < 4; ++m)
#pragma unroll
        for (int n = 0; n < 2; ++n) E(erow0 + wr * 64 + m * 16 + fr, ecol0 + wc * 32 + n * 16 + 4 * fq, acc[0][m][n], acc[1][m][n]);
}
template <class Epi>
__device__ __forceinline__ void sgemm_phase(const Ctx& c, const bf16* A, int lda, int M, const bf16* Bt, int ntn, int K, const Epi& E) {
    const int nu = (M / 128) * ntn;
    for (int u = c.bid; u < nu; u += c.nblk) {
        const int pm = u / ntn, pn = u % ntn;
        sgemm_unit(c, A, lda, nullptr, 0, pm * 128, Bt + (size_t)pn * 256 * K, K, E, pm * 128, pn * 256);
    }
    __syncthreads();
}


namespace g8 {
constexpr int BM = 256, BK = 64, HALF = 128, HTB = HALF * BK * 2, STAGE_BYTES = 8 * HTB, NXCD = 8, WGM = 8;
__host__ __device__ __forceinline__ int lds_byte(int r, int c) { const int st = (r >> 4) * 2 + (c >> 5), rr = r & 15, cc = c & 31, ob = rr * 64 + cc * 2; return st * 1024 + (ob ^ (((ob >> 9) & 1) << 5)); }
__host__ __device__ __forceinline__ void stage_rc(int b, int& R, int& C) { const int st = b / 1024, sb = b % 1024, swz = sb ^ (((sb >> 9) & 1) << 5); R = (st >> 1) * 16 + swz / 64; C = (st & 1) * 32 + (swz % 64) / 2; }
__host__ __device__ __forceinline__ int perm32(int rho) { const int n = rho >> 4, i = rho & 15; return 8 * (i >> 2) + 4 * n + (i & 3); }
struct GUnit { const char* A; const char* B; const int* rl; int nvalid; int erow0, ecol0; int x0; const float* xp; };
__device__ __forceinline__ bool static_order(int nM, int nN, int G, int c, int i, int& pm, int& pn) {
    const int nwg = nM * nN; const long L = (long)i * G + c; if (L >= nwg) return false;
    int wgid = (int)L; { const int q = nwg / NXCD, r = nwg % NXCD, xcd = wgid % NXCD, off = wgid / NXCD; wgid = (xcd < r ? xcd * (q + 1) : r * (q + 1) + (xcd - r) * q) + off; }
    const int nig = WGM * nN, gid = wgid / nig, fm = gid * WGM, gsz = (nM - fm) < WGM ? (nM - fm) : WGM;
    pm = fm + ((wgid % nig) % gsz); pn = (wgid % nig) / gsz; return true;
}
struct DenseSched { const char* A; const char* Bt; size_t ldaB, ldbB; int nM, nN, G, c;
    __device__ __forceinline__ bool next(int i, GUnit& u) const { int pm, pn; if (!static_order(nM, nN, G, c, i, pm, pn)) return false;
        u.A = A + (size_t)pm * 256 * ldaB; u.B = Bt + (size_t)pn * 256 * ldbB; u.rl = nullptr; u.nvalid = 0; u.erow0 = pm * 256; u.ecol0 = pn * 256; u.x0 = 0; u.xp = nullptr; return true; } };

template <bool GATHER, class Epi, class Sched>
__device__ __forceinline__ void gemm_phase(LAS unsigned char* lds, unsigned ldaB, int K, const Sched& S, const Epi& E) {
    const int tid = threadIdx.x, wid = __builtin_amdgcn_readfirstlane(tid >> 6), lane = tid & 63, wr = wid >> 2, wc = wid & 3, fr = lane & 15, fq = lane >> 4;
    const int nt = K / BK;
    int R0, C0, R1, C1; stage_rc(tid * 16, R0, C0); stage_rc(tid * 16 + 8192, R1, C1);
    unsigned voffB[2];
    if (Epi::PERM) { voffB[0] = (unsigned)(((R0 & ~31) + perm32(R0 & 31)) * K + C0) * 2u; voffB[1] = (unsigned)(((R1 & ~31) + perm32(R1 & 31)) * K + C1) * 2u; }
    else { voffB[0] = (unsigned)(R0 * K + C0) * 2u; voffB[1] = (unsigned)(R1 * K + C1) * 2u; }
    unsigned ac0[2], ac1[2], an0[2], an1[2];
    const size_t kstep = (size_t)(BK * 2);
    const size_t hstepB = (size_t)HALF * K * 2;
    const unsigned ldsw = (unsigned)wid * 1024u;
    const int aoff = lds_byte(wr * 64 + fr, fq * 8), boff = lds_byte(wc * 32 + fr, fq * 8);
#define G8_SA(b, h) (((b) * 2 + (h)) * HTB)
#define G8_SB(b, h) ((4 + (b) * 2 + (h)) * HTB)
#define G8_STAGE(bufoff, gbase, voff) do { _Pragma("unroll") for (int _i = 0; _i < 2; ++_i) \
        __builtin_amdgcn_global_load_lds((const unsigned*)((const char*)(gbase) + (voff)[_i]), (LAS unsigned*)(lds + (bufoff) + ldsw + _i * 8192), 16, 0, 0); } while (0)
#define G8_LDA(dst, b, h) do { _Pragma("unroll") for (int m = 0; m < 4; ++m) _Pragma("unroll") for (int k = 0; k < 2; ++k) dst[m][k] = *(const LAS bf16x8*)(lds + G8_SA(b, h) + aoff + m * 2048 + k * 1024); } while (0)
#define G8_LDB(dst, b, h) do { _Pragma("unroll") for (int n = 0; n < 2; ++n) _Pragma("unroll") for (int k = 0; k < 2; ++k) dst[n][k] = *(const LAS bf16x8*)(lds + G8_SB(b, h) + boff + n * 2048 + k * 1024); } while (0)
#define G8_MMA(ai, bj, At, Bt) do { __builtin_amdgcn_s_setprio(1); _Pragma("unroll") for (int m = 0; m < 4; ++m) _Pragma("unroll") for (int n = 0; n < 2; ++n) _Pragma("unroll") for (int k = 0; k < 2; ++k) \
        acc[ai][bj][m][n] = __builtin_amdgcn_mfma_f32_16x16x32_bf16(Bt[n][k], At[m][k], acc[ai][bj][m][n], 0, 0, 0); __builtin_amdgcn_s_setprio(0); } while (0)
#define G8_WAIT_V(n) asm volatile("s_waitcnt vmcnt(" #n ")" ::: "memory")
#define G8_WAIT_L(n) asm volatile("s_waitcnt lgkmcnt(" #n ")" ::: "memory")
#define G8_BAR __builtin_amdgcn_s_barrier()
#define G8_SCHED __builtin_amdgcn_sched_barrier(0)
#define G8_XLOAD(u) __builtin_amdgcn_global_load_lds((const unsigned*)((u).rl + lane * 4), (LAS unsigned*)(lds + STAGE_BYTES + wid * 1024), 16, 0, 0)
#define G8_AOFF(u, o0, o1) do { if (GATHER) { const LAS int* _rs = (const LAS int*)(lds + STAGE_BYTES + wid * 1024); const int _nv = (u).nvalid - 1; \
        const int _r00 = _rs[min(R0, _nv)], _r01 = _rs[min(R1, _nv)], _r10 = _rs[min(128 + R0, _nv)], _r11 = _rs[min(128 + R1, _nv)]; \
        o0[0] = (unsigned)_r00 * ldaB + (unsigned)C0 * 2u; o0[1] = (unsigned)_r01 * ldaB + (unsigned)C1 * 2u; o1[0] = (unsigned)_r10 * ldaB + (unsigned)C0 * 2u; o1[1] = (unsigned)_r11 * ldaB + (unsigned)C1 * 2u; \
    } else { o0[0] = (unsigned)R0 * ldaB + (unsigned)C0 * 2u; o0[1] = (unsigned)R1 * ldaB + (unsigned)C1 * 2u; o1[0] = (unsigned)(128 + R0) * ldaB + (unsigned)C0 * 2u; o1[1] = (unsigned)(128 + R1) * ldaB + (unsigned)C1 * 2u; } } while (0)
    GUnit cur, nxt; int ui = 0;
    if (!S.next(0, cur)) return;
    f32x4 acc[2][2][4][2];
#pragma unroll
    for (int a = 0; a < 2; ++a)
#pragma unroll
        for (int b = 0; b < 2; ++b)
#pragma unroll
            for (int m = 0; m < 4; ++m)
#pragma unroll
                for (int n = 0; n < 2; ++n) acc[a][b][m][n] = (f32x4){0.f, 0.f, 0.f, 0.f};
    bf16x8 At[4][2], B0[2][2], B1[2][2];
    if (GATHER) { G8_XLOAD(cur); G8_WAIT_V(0); }
    G8_AOFF(cur, ac0, ac1);
    if (GATHER) { G8_WAIT_L(0); }
    const char* cA = cur.A; const char* cB = cur.B;
    G8_STAGE(G8_SB(0, 0), cB, voffB); G8_STAGE(G8_SB(0, 1), cB + hstepB, voffB); G8_STAGE(G8_SA(0, 0), cA, ac0); G8_STAGE(G8_SA(0, 1), cA, ac1);
    if (wr == 1) G8_BAR;
    G8_WAIT_V(2); G8_BAR;
    G8_STAGE(G8_SB(1, 0), cB + kstep, voffB); G8_STAGE(G8_SA(1, 0), cA + kstep, ac0); G8_STAGE(G8_SB(1, 1), cB + hstepB + kstep, voffB);
    G8_WAIT_V(6); G8_BAR;
    for (;;) {
        const bool has_next = S.next(ui + 1, nxt);
        const char* nA = has_next ? nxt.A : cA; const char* nB = has_next ? nxt.B : cB;
        an0[0] = ac0[0]; an0[1] = ac0[1]; an1[0] = ac1[0]; an1[1] = ac1[1];
        const bool xload = GATHER && has_next;
        if (xload) { G8_XLOAD(nxt); }
#pragma unroll 1
        for (int t = 0; t < nt; t += 2) {
            const bool last = (t == nt - 2);
            const char* a1 = cA + (size_t)(t + 1) * kstep;
            const char* a2 = last ? nA : cA + (size_t)(t + 2) * kstep; const char* b2 = last ? nB : cB + (size_t)(t + 2) * kstep;
            const char* a3 = a2 + kstep; const char* b3 = b2 + kstep;
            unsigned* x0 = last ? an0 : ac0; unsigned* x1 = last ? an1 : ac1;
            unsigned s0[2], s1[2]; s0[0] = x0[0]; s0[1] = x0[1]; s1[0] = x1[0]; s1[1] = x1[1];
            G8_LDB(B0, 0, 0); G8_LDB(B1, 0, 1); G8_SCHED; G8_LDA(At, 0, 0); G8_STAGE(G8_SA(1, 1), a1, ac1);
            if (xload && t == 0) { G8_WAIT_V(9); } else { G8_WAIT_V(8); }
            G8_WAIT_L(0); G8_BAR; G8_MMA(0, 0, At, B0); G8_MMA(0, 1, At, B1); G8_BAR; G8_SCHED;
            G8_LDA(At, 0, 1); G8_STAGE(G8_SB(0, 0), b2, voffB); G8_STAGE(G8_SB(0, 1), b2 + hstepB, voffB); G8_STAGE(G8_SA(0, 0), a2, s0);
            G8_WAIT_V(8); G8_WAIT_L(0); G8_BAR; G8_MMA(1, 0, At, B0); G8_MMA(1, 1, At, B1); G8_BAR; G8_SCHED;
            if (xload && t == 0) { G8_AOFF(nxt, an0, an1); }
            G8_LDB(B0, 1, 0); G8_LDB(B1, 1, 1); G8_SCHED; G8_LDA(At, 1, 0); G8_STAGE(G8_SA(0, 1), a2, s1);
            G8_WAIT_V(8); G8_WAIT_L(0); G8_BAR; G8_MMA(0, 0, At, B0); G8_MMA(0, 1, At, B1); G8_BAR; G8_SCHED;
            G8_LDA(At, 1, 1); G8_STAGE(G8_SB(1, 0), b3, voffB); G8_STAGE(G8_SB(1, 1), b3 + hstepB, voffB); G8_STAGE(G8_SA(1, 0), a3, s0);
            G8_WAIT_V(8); G8_WAIT_L(0); G8_BAR; G8_MMA(1, 0, At, B0); G8_MMA(1, 1, At, B1); G8_BAR; G8_SCHED;
        }
        if (wr == 0) G8_BAR;
#pragma unroll
        for (int ai = 0; ai < 2; ++ai) {
            if constexpr (Epi::PERM) {
                typename Epi::Pre pr8[4];
                const int fb8 = (wid * 16 * 64 + lane) * 8;
#pragma unroll
                for (int m = 0; m < 4; ++m) pr8[m] = E.pre(cur, cur.erow0 + ai * HALF + wr * 64 + m * 16 + fr, cur.ecol0 + wc * 32 + 8 * fq, fb8 + ((ai * 4 + m) * 2) * 512);
#pragma unroll
                for (int m = 0; m < 4; ++m) E.post8(cur, cur.erow0 + ai * HALF + wr * 64 + m * 16 + fr, cur.ecol0 + wc * 32 + 8 * fq, acc[ai][0][m][0], acc[ai][0][m][1], acc[ai][1][m][0], acc[ai][1][m][1], pr8[m], fb8 + ((ai * 4 + m) * 2) * 512);
            } else {
            const int fragbase = (wid * 32 * 64 + lane) * 4;
            constexpr int BMR = Epi::BATCH_M;
#pragma unroll
            for (int m0 = 0; m0 < 4; m0 += BMR) {
                typename Epi::Pre pr[BMR][2];
#pragma unroll
                for (int mm = 0; mm < BMR; ++mm)
#pragma unroll
                    for (int n = 0; n < 2; ++n) { const int m = m0 + mm; pr[mm][n] = E.pre(cur, cur.erow0 + ai * HALF + wr * 64 + m * 16 + fr, cur.ecol0 + wc * 32 + n * 16 + 4 * fq, fragbase + (((ai * 4 + m) * 2 + n) * 2) * 256); }
#pragma unroll
                for (int mm = 0; mm < BMR; ++mm)
#pragma unroll
                    for (int n = 0; n < 2; ++n) { const int m = m0 + mm; E.post(cur, cur.erow0 + ai * HALF + wr * 64 + m * 16 + fr, cur.ecol0 + wc * 32 + n * 16 + 4 * fq, acc[ai][0][m][n], acc[ai][1][m][n], pr[mm][n], fragbase + (((ai * 4 + m) * 2 + n) * 2) * 256); }
            }
            }
        }
        if (!has_next) break;
#pragma unroll
        for (int a = 0; a < 2; ++a)
#pragma unroll
            for (int b = 0; b < 2; ++b)
#pragma unroll
                for (int m = 0; m < 4; ++m)
#pragma unroll
                    for (int n = 0; n < 2; ++n) acc[a][b][m][n] = (f32x4){0.f, 0.f, 0.f, 0.f};
        cur = nxt; cA = nA; cB = nB; ++ui;
        ac0[0] = an0[0]; ac0[1] = an0[1]; ac1[0] = an1[0]; ac1[1] = an1[1];
        if (wr == 1) G8_BAR;
    }
    G8_WAIT_V(0);
    G8_BAR;
#undef G8_SA
#undef G8_SB
#undef G8_STAGE
#undef G8_LDA
#undef G8_LDB
#undef G8_MMA
#undef G8_WAIT_V
#undef G8_WAIT_L
#undef G8_BAR
#undef G8_SCHED
#undef G8_AOFF
#undef G8_XLOAD
}
}
template <class Epi>
__device__ __forceinline__ void dgemm_phase(const Ctx& c, const bf16* A, int lda, int M, const bf16* Bt, int ntn, int K, const Epi& E, int G = -1, int cid = -1) {
    g8::DenseSched S{(const char*)A, (const char*)Bt, (size_t)lda * 2, (size_t)K * 2, M / 256, ntn, G < 0 ? c.nblk : G, cid < 0 ? c.bid : cid};
    g8::gemm_phase<false>(c.lds, (unsigned)lda * 2u, K, S, E);
    __syncthreads();
}


__device__ __forceinline__ size_t frag_off(int tile, int row, int col, int bj) {
    const int ai = row >> 7, wr = (row >> 6) & 1, m = (row >> 4) & 3, fr = row & 15, wc = col >> 5, n = (col >> 4) & 1, fq = (col >> 2) & 3;
    const int wave = wr * 4 + wc, lane = fq * 16 + fr, f = ((ai * 4 + m) * 2 + n) * 2 + bj;
    return ((((size_t)tile * 8 + wave) * 32 + f) * 64 + lane) * 4;
}
struct NoPre {};
struct EpiInPB { bf16* PB; float* SM; typedef NoPre Pre; static constexpr int BATCH_M = 4; static constexpr bool PERM = true;
    __device__ __forceinline__ void post8(int row, int col, f32x4 a0, f32x4 a1, f32x4 b0, f32x4 b1, const Pre&, int, int, int) const {
        st_bf8(PB + (size_t)row * NPB + col, a0, a1);
        if ((col >> 8) == 7) { float* sp = SM + (size_t)row * 128 + (col & 127); *(f32x4*)sp = b0; *(f32x4*)(sp + 4) = b1; }
        else st_bf8(PB + (size_t)row * NPB + col + 128, b0, b1);
    }
    __device__ __forceinline__ Pre pre(int, int, int, int, int) const { return Pre{}; }
    __device__ __forceinline__ void post(int row, int col, f32x4 lo, f32x4 hi, const Pre&, int, int, int) const { (*this)(row, col, lo, hi); }
    __device__ __forceinline__ void operator()(int row, int col, f32x4 lo, f32x4 hi) const {
        st_bf4(PB + (size_t)row * NPB + col, lo);
        if ((col >> 8) == 7) *(f32x4*)(SM + (size_t)row * 128 + (col & 127)) = hi;
        else st_bf4(PB + (size_t)row * NPB + col + 128, hi);
    } };
struct EpiQ { bf16* QLAT; bf16* QIDX; const float* rstd; struct Pre { float r; }; static constexpr int BATCH_M = 4; static constexpr bool PERM = true;
    __device__ __forceinline__ void post8(int row, int col, f32x4 a0, f32x4 a1, f32x4 b0, f32x4 b1, const Pre& p, int, int, int) const {
        const float r = p.r;
        if (col < 1024) { st_bf8(QLAT + (size_t)row * 1024 + col, a0 * r, a1 * r); st_bf8(QLAT + (size_t)row * 1024 + col + 128, b0 * r, b1 * r); }
        else { st_bf8(QIDX + (size_t)row * 256 + (col - 1024), a0 * r, a1 * r); st_bf8(QIDX + (size_t)row * 256 + (col - 1024) + 128, b0 * r, b1 * r); }
    }
    __device__ __forceinline__ Pre pre(int row, int, int, int, int) const { return Pre{rstd[row]}; }
    __device__ __forceinline__ void post(int row, int col, f32x4 lo, f32x4 hi, const Pre& p, int, int, int) const {
        const float r = p.r;
        if (col < 1024) { st_bf4(QLAT + (size_t)row * 1024 + col, lo * r); st_bf4(QLAT + (size_t)row * 1024 + col + 128, hi * r); }
        else { st_bf4(QIDX + (size_t)row * 256 + (col - 1024), lo * r); st_bf4(QIDX + (size_t)row * 256 + (col - 1024) + 128, hi * r); }
    } };
__device__ __forceinline__ unsigned pk4_fp8s(f32x4 v, float sc) { int w = __builtin_amdgcn_cvt_pk_fp8_f32(v[0] * sc, v[1] * sc, 0, false); w = __builtin_amdgcn_cvt_pk_fp8_f32(v[2] * sc, v[3] * sc, w, true); return (unsigned)w; }
__device__ __forceinline__ f32x4 up4_fp8r(unsigned q) { return (f32x4){__builtin_amdgcn_cvt_f32_fp8((int)q, 0), __builtin_amdgcn_cvt_f32_fp8((int)q, 1), __builtin_amdgcn_cvt_f32_fp8((int)q, 2), __builtin_amdgcn_cvt_f32_fp8((int)q, 3)}; }
constexpr float G_SCALE = 256.f, G_UNSCALE = 1.f / 256.f;
struct EpiGate { unsigned char* G; typedef NoPre Pre; static constexpr int BATCH_M = 4; static constexpr bool PERM = true;
    __device__ __forceinline__ Pre pre(int, int, int, int, int) const { return Pre{}; }
    __device__ __forceinline__ void post(int, int, f32x4, f32x4, const Pre&, int, int, int) const {}
    __device__ __forceinline__ void post8(int, int, f32x4 a0, f32x4 a1, f32x4 b0, f32x4 b1, const Pre&, int pm, int pn, int foff) const {
#pragma unroll
        for (int i = 0; i < 4; ++i) { a0[i] = sigmoidf_(a0[i]); a1[i] = sigmoidf_(a1[i]); b0[i] = sigmoidf_(b0[i]); b1[i] = sigmoidf_(b1[i]); }
        unsigned char* gt = G + (size_t)(((pn >> 2) * 128 + pm) * 4 + (pn & 3)) * 65536 + foff;
        *(u32x2*)gt = (u32x2){pk4_fp8s(a0, G_SCALE), pk4_fp8s(a1, G_SCALE)}; *(u32x2*)(gt + 512) = (u32x2){pk4_fp8s(b0, G_SCALE), pk4_fp8s(b1, G_SCALE)};
    } };
struct EpiUp { bf16* M1; bf16* MF; const unsigned char* G; int br; int first; int last; struct Pre { u32x2 g0, g1; u32x4 m0, m1; }; static constexpr int BATCH_M = 2; static constexpr bool PERM = true;
    __device__ __forceinline__ Pre pre(int, int, int pm, int pn, int foff) const {
        const unsigned char* gt = G + (size_t)((br * 128 + pm) * 4 + pn) * 65536 + foff; const bf16* mt = MF + (size_t)(pm * 4 + pn) * 65536 + foff;
        Pre p; p.g0 = __builtin_nontemporal_load((const u32x2*)gt); p.g1 = __builtin_nontemporal_load((const u32x2*)(gt + 512));
        p.m0 = (u32x4){0u, 0u, 0u, 0u}; p.m1 = p.m0;
        if (!first) { p.m0 = __builtin_nontemporal_load((const u32x4*)mt); p.m1 = __builtin_nontemporal_load((const u32x4*)(mt + 512)); }
        return p; }
    __device__ __forceinline__ void post(int, int, f32x4, f32x4, const Pre&, int, int, int) const {}
    __device__ __forceinline__ void post8(int row, int col, f32x4 a0, f32x4 a1, f32x4 b0, f32x4 b1, const Pre& p, int pm, int pn, int foff) const {
        a0 *= up4_fp8r(p.g0.x) * G_UNSCALE; a1 *= up4_fp8r(p.g0.y) * G_UNSCALE; b0 *= up4_fp8r(p.g1.x) * G_UNSCALE; b1 *= up4_fp8r(p.g1.y) * G_UNSCALE;
        if (!first) { a0 += (f32x4){bflo(p.m0.x), bfhi(p.m0.x), bflo(p.m0.y), bfhi(p.m0.y)}; a1 += (f32x4){bflo(p.m0.z), bfhi(p.m0.z), bflo(p.m0.w), bfhi(p.m0.w)};
                      b0 += (f32x4){bflo(p.m1.x), bfhi(p.m1.x), bflo(p.m1.y), bfhi(p.m1.y)}; b1 += (f32x4){bflo(p.m1.z), bfhi(p.m1.z), bflo(p.m1.w), bfhi(p.m1.w)}; }
        if (last) { bf16* m = M1 + (size_t)row * 1024 + col; st_bf8(m, a0, a1); st_bf8(m + 128, b0, b1); }
        else { bf16* mt = MF + (size_t)(pm * 4 + pn) * 65536 + foff; st_bf8(mt, a0, a1); st_bf8(mt + 512, b0, b1); }
    } };
template <bool RES_F32> struct EpiWoT { const void* res; bf16* out; const float* g1;
    struct Pre { f32x4 r0, r1, r2, r3; }; static constexpr int BATCH_M = 4; static constexpr bool PERM = true;
    __device__ __forceinline__ Pre pre(int row, int col, int, int, int) const { const size_t o = (size_t)row * 1024 + col; Pre p;
        if (RES_F32) { const float* r = (const float*)res + o; p.r0 = __builtin_nontemporal_load((const f32x4*)r); p.r1 = __builtin_nontemporal_load((const f32x4*)(r + 4)); p.r2 = __builtin_nontemporal_load((const f32x4*)(r + 128)); p.r3 = __builtin_nontemporal_load((const f32x4*)(r + 132)); }
        else { const bf16* r = (const bf16*)res + o; const u32x4 a = *(const u32x4*)r, bq = *(const u32x4*)(r + 128);
            p.r0 = (f32x4){bflo(a.x), bfhi(a.x), bflo(a.y), bfhi(a.y)}; p.r1 = (f32x4){bflo(a.z), bfhi(a.z), bflo(a.w), bfhi(a.w)};
            p.r2 = (f32x4){bflo(bq.x), bfhi(bq.x), bflo(bq.y), bfhi(bq.y)}; p.r3 = (f32x4){bflo(bq.z), bfhi(bq.z), bflo(bq.w), bfhi(bq.w)}; }
        return p; }
    __device__ __forceinline__ void post(int, int, f32x4, f32x4, const Pre&, int, int, int) const {}
    __device__ __forceinline__ void post8(int row, int col, f32x4 a0, f32x4 a1, f32x4 b0, f32x4 b1, const Pre& p, int, int, int) const {
        const float* gp = g1 + (size_t)(row >> 11) * 6144 + col; bf16* o = out + (size_t)row * 1024 + col;
        st_bf8(o, p.r0 + *(const f32x4*)gp * a0, p.r1 + *(const f32x4*)(gp + 4) * a1);
        st_bf8(o + 128, p.r2 + *(const f32x4*)(gp + 128) * b0, p.r3 + *(const f32x4*)(gp + 132) * b1);
    } };
struct EpiG1 { bf16* HID; const float* wl; int cnt; int orow0;
    __device__ __forceinline__ void operator()(int row, int col, f32x4 lo, f32x4 hi) const {
        const int hc = col - 128 * (col >> 8);
        f32x4 v = (f32x4){0.f, 0.f, 0.f, 0.f};
        if (row < cnt) { const float w = wl ? wl[row] : 1.f;
#pragma unroll
            for (int i = 0; i < 4; ++i) v[i] = siluf_(lo[i]) * hi[i] * w; }
        st_bf4(HID + (size_t)(orow0 + row) * 256 + hc, v);
    } };
struct EpiG2 { bf16* Y; int orow0;
    __device__ __forceinline__ void operator()(int row, int col, f32x4 lo, f32x4 hi) const {
        st_bf4(Y + (size_t)(orow0 + row) * 1024 + col, lo); st_bf4(Y + (size_t)(orow0 + row) * 1024 + col + 128, hi);
    } };


template <class F> struct EpiU { F f; typedef typename F::Pre Pre; static constexpr int BATCH_M = F::BATCH_M; static constexpr bool PERM = F::PERM;
    __device__ __forceinline__ void post8(const g8::GUnit& u, int row, int col, f32x4 a0, f32x4 a1, f32x4 b0, f32x4 b1, const Pre& p, int foff) const { f.post8(row, col, a0, a1, b0, b1, p, u.erow0 >> 8, u.ecol0 >> 8, foff); }
    __device__ __forceinline__ Pre pre(const g8::GUnit& u, int row, int col, int foff) const { return f.pre(row, col, u.erow0 >> 8, u.ecol0 >> 8, foff); }
    __device__ __forceinline__ void post(const g8::GUnit& u, int row, int col, f32x4 lo, f32x4 hi, const Pre& p, int foff) const { f.post(row, col, lo, hi, p, u.erow0 >> 8, u.ecol0 >> 8, foff); } };

__device__ __forceinline__ void phase_prologue(const Ctx& c) {
    {
        LAS float* cs = (LAS float*)c.lds;
        LAS float* red = (LAS float*)(c.lds + 66048);
        const float* cin = c.in[IN_C];
        if (c.bid < 192) {
            for (int i = c.tid; i < 16 * 1024; i += NTHR) cs[(i >> 10) * 1028 + (i & 1023)] = siluf_(cin[i]);
            __syncthreads();
        }
        float* MOD = (float*)(c.ws + WS_MOD);
        for (int it = c.bid; it < 192; it += c.nblk) {
            const int l = it / 96, cg = it % 96, fr = c.lane & 15, fq = c.lane >> 4, kbeg = c.wave * 128;
            const float* W = c.in[IN_ADAW] + (size_t)l * 1024 * 6144 + (size_t)(kbeg + fq) * 6144 + cg * 64 + fr;
            float bv[32][4];
#pragma unroll
            for (int ks = 0; ks < 32; ++ks)
#pragma unroll
                for (int ct = 0; ct < 4; ++ct) bv[ks][ct] = W[(size_t)(4 * ks) * 6144 + 16 * ct];
            f32x4 acc[4];
#pragma unroll
            for (int ct = 0; ct < 4; ++ct) acc[ct] = (f32x4){0.f, 0.f, 0.f, 0.f};
            const LAS float* ap = cs + fr * 1028 + kbeg + fq;
#pragma unroll
            for (int ks = 0; ks < 32; ++ks) { const float a = ap[4 * ks];
#pragma unroll
                for (int ct = 0; ct < 4; ++ct) acc[ct] = __builtin_amdgcn_mfma_f32_16x16x4f32(a, bv[ks][ct], acc[ct], 0, 0, 0); }
#pragma unroll
            for (int ct = 0; ct < 4; ++ct)
#pragma unroll
                for (int r = 0; r < 4; ++r) red[(c.wave * 16 + 4 * fq + r) * 64 + 16 * ct + fr] = acc[ct][r];
            __syncthreads();
            for (int i = c.tid; i < 16 * 64; i += NTHR) { const int b = i >> 6, ln = i & 63; float s = 0.f;
#pragma unroll
                for (int w = 0; w < 8; ++w) s += red[(w * 16 + b) * 64 + ln];
                MOD[((size_t)l * 16 + b) * 6144 + cg * 64 + ln] = s + c.in[IN_ADAB][l * 6144 + cg * 64 + ln]; }
            __syncthreads();
        }
        __syncthreads();
    }
    const int first3 = c.nblk > 192 ? 192 : 0;
    if (c.bid >= first3) {
        LAS float* uk_s = (LAS float*)c.lds;
        for (int it = c.bid - first3; it < NL * 8 * 4; it += c.nblk - first3) {
            const int l = it >> 5, h = (it >> 2) & 7, q = it & 3;
            __syncthreads();
            for (int i = c.tid; i < 32 * 16; i += NTHR) { const int cc = i >> 4, d4 = (i & 15) * 4;
                *(LAS f32x4*)(uk_s + cc * 64 + d4) = *(const f32x4*)(c.in[IN_DSA_WUK] + (size_t)l * 128 * 512 + (size_t)(q * 32 + cc) * 512 + h * 64 + d4); }
            const int r = c.tid & 255, ch = c.tid >> 8;
            f32x4 uq[16];
            { const float* up = c.in[IN_DSA_WUQ] + (size_t)l * 256 * 512 + (size_t)r * 512 + h * 64;
#pragma unroll
              for (int j = 0; j < 16; ++j) uq[j] = *(const f32x4*)(up + 4 * j); }
            const float sc = c.in[IN_DSA_NQ][l * 256 + r] * (0.125f * 1.4426950408889634f);
            __syncthreads();
            bf16* dst = (bf16*)(c.ws + WS_WQ) + (size_t)l * 1280 * 256 + (size_t)(h * 128 + q * 32 + ch * 16) * 256 + r;
#pragma unroll 2
            for (int cc = 0; cc < 16; ++cc) { const LAS float* kp = uk_s + (ch * 16 + cc) * 64; float acc = 0.f;
#pragma unroll
                for (int j = 0; j < 16; ++j) { const f32x4 kv = *(const LAS f32x4*)(kp + 4 * j); acc += uq[j][0] * kv[0] + uq[j][1] * kv[1] + uq[j][2] * kv[2] + uq[j][3] * kv[3]; }
                dst[(size_t)cc * 256] = (bf16)f2bf(acc * sc); }
        }
        __syncthreads();
    }
    {
        LAS float* scr = (LAS float*)(c.lds + c.wave * 16384);
        const int gw = c.bid * NWAVES + c.wave, NGW = c.nblk * NWAVES;
        constexpr int I_WIN = (NINP / 32) * (1024 / 64), I_UP = (1024 / 32) * (512 / 64), I_WO = (1024 / 32) * (1024 / 64);
        constexpr int PER_L = I_WIN + 3 * I_UP + I_WO;
        for (int it = gw; it < NL * PER_L; it += NGW) {
            const int l = it / PER_L; int r = it % PER_L;
            if (r < I_WIN) { SrcWin s{c.in[IN_WIN] + (size_t)l * 1024 * NIN, NIN}; tr_item(s, (bf16*)(c.ws + WS_WIN) + (size_t)l * NINP * 1024, 1024, (r / 16) * 32, (r % 16) * 64, scr, c.lane); continue; }
            r -= I_WIN;
            if (r < I_UP) { SrcPlain s{c.in[IN_WUPA] + (size_t)l * 512 * 1024, 1024}; tr_item(s, (bf16*)(c.ws + WS_WUPA) + (size_t)l * 1024 * 512, 512, (r / 8) * 32, (r % 8) * 64, scr, c.lane); continue; }
            r -= I_UP;
            if (r < I_UP) { SrcPlain s{c.in[IN_WUPC] + (size_t)l * 512 * 1024, 1024}; tr_item(s, (bf16*)(c.ws + WS_WUPC) + (size_t)l * 1024 * 512, 512, (r / 8) * 32, (r % 8) * 64, scr, c.lane); continue; }
            r -= I_UP;
            if (r < I_UP) { SrcPlain s{c.in[IN_WUPB] + (size_t)l * 512 * 1024, 1024}; tr_item(s, (bf16*)(c.ws + WS_WUPB) + (size_t)l * 1024 * 512, 512, (r / 8) * 32, (r % 8) * 64, scr, c.lane); continue; }
            r -= I_UP;
            { SrcPlain s{c.in[IN_WO] + (size_t)l * 1024 * 1024, 1024}; tr_item(s, (bf16*)(c.ws + WS_WO) + (size_t)l * 1024 * 1024, 1024, (r / 16) * 32, (r % 16) * 64, scr, c.lane); }
        }
    }
    {
        const int gt = c.bid * NTHR + c.tid, NGT = c.nblk * NTHR;
        for (int i = gt; i < T; i += NGT) ((int*)(c.ws + WS_IDENT))[i] = i;
        for (int it = gt; it < NL * 256 * 32; it += NGT) {
            const int l = it / (256 * 32), rem = it % (256 * 32), m = rem / 32, r0 = (rem % 32) * 8;
            const float* gq = c.in[IN_DSA_NQ] + l * 256;
            float o[8];
#pragma unroll
            for (int i = 0; i < 8; ++i) o[i] = c.in[IN_DSA_WQI][(size_t)l * 256 * 256 + (size_t)(r0 + i) * 256 + m] * 0.17677669529663687f * gq[r0 + i];
            u32x4 w; w.x = pk2(o[0], o[1]); w.y = pk2(o[2], o[3]); w.z = pk2(o[4], o[5]); w.w = pk2(o[6], o[7]);
            *(u32x4*)((bf16*)(c.ws + WS_WQ) + (size_t)l * 1280 * 256 + (size_t)(1024 + m) * 256 + r0) = w;
        }
    }
    {
        const int gt = c.bid * NTHR + c.tid, NGT = c.nblk * NTHR;
        for (int it = gt; it < NL * 8 * 4 * 4 * 64; it += NGT) {
            const int ln = it & 63, ks = (it >> 6) & 3, vt = (it >> 8) & 3, h = (it >> 10) & 7, l = it >> 13;
            const int fr = ln & 15, fq = ln >> 4;
            const float* uv = c.in[IN_DSA_WUV] + (size_t)l * 128 * 512 + h * 64 + 16 * vt + fr;
            float o[8];
#pragma unroll
            for (int e = 0; e < 8; ++e) { const int lat = 32 * ks + (e < 4 ? 4 * fq + e : 16 + 4 * fq + e - 4); o[e] = uv[(size_t)lat * 512]; }
            u32x4 w; w.x = pk2(o[0], o[1]); w.y = pk2(o[2], o[3]); w.z = pk2(o[4], o[5]); w.w = pk2(o[6], o[7]);
            *(u32x4*)((bf16*)(c.ws + WS_WUVF) + (size_t)it * 8) = w;
        }
    }
}

__device__ __forceinline__ void norm_mod_row(const float* xrow, const float* gain, const float* sh, const float* sc, bf16* orow, int lane) {
    f32x4 v[4]; float s = 0.f;
#pragma unroll
    for (int j = 0; j < 4; ++j) { v[j] = *(const f32x4*)(xrow + 4 * (lane + 64 * j)); s += v[j][0] * v[j][0] + v[j][1] * v[j][1] + v[j][2] * v[j][2] + v[j][3] * v[j][3]; }
    const float rstd = rsqrtf(wave_sum(s) * (1.f / D) + EPS);
#pragma unroll
    for (int j = 0; j < 4; ++j) { const int cc = 4 * (lane + 64 * j);
        const f32x4 g = *(const f32x4*)(gain + cc), a = *(const f32x4*)(sc + cc), b = *(const f32x4*)(sh + cc);
        st_bf4(orow + cc, v[j] * rstd * g * (a + 1.f) + b); }
}
__device__ __forceinline__ void phase_norm1(const Ctx& c, int l, const float* xsrc) {
    const int gw = c.bid * NWAVES + c.wave, NGW = c.nblk * NWAVES;
    const float* MOD = (const float*)(c.ws + WS_MOD) + (size_t)l * 16 * 6144;
    bf16* XN = (bf16*)(c.ws + WS_XN);
    const float* gain = c.in[IN_NMIX] + l * D; const int lane = c.lane;
    for (int t4 = gw * 4; t4 < T; t4 += NGW * 4) {
        const int b = t4 >> 11;
        const float* sh = MOD + (size_t)b * 6144; const float* sc = MOD + (size_t)b * 6144 + 1024;
        f32x4 v[4][4]; float rstd[4];
#pragma unroll
        for (int r = 0; r < 4; ++r)
#pragma unroll
            for (int j = 0; j < 4; ++j) v[r][j] = __builtin_nontemporal_load((const f32x4*)(xsrc + (size_t)(t4 + r) * D + 4 * (lane + 64 * j)));
#pragma unroll
        for (int r = 0; r < 4; ++r) { float s = 0.f;
#pragma unroll
            for (int j = 0; j < 4; ++j) s += v[r][j][0] * v[r][j][0] + v[r][j][1] * v[r][j][1] + v[r][j][2] * v[r][j][2] + v[r][j][3] * v[r][j][3];
            rstd[r] = rsqrtf(wave_sum(s) * (1.f / D) + EPS); }
#pragma unroll
        for (int j = 0; j < 4; ++j) { const int cc = 4 * (lane + 64 * j);
            const f32x4 g = *(const f32x4*)(gain + cc), a = *(const f32x4*)(sc + cc), bb = *(const f32x4*)(sh + cc);
#pragma unroll
            for (int r = 0; r < 4; ++r) st_bf4(XN + (size_t)(t4 + r) * D + cc, v[r][j] * rstd[r] * g * (a + 1.f) + bb); }
    }
}

__device__ __forceinline__ void phase_prep(const Ctx& c, int l) {
    const int gw = c.bid * NWAVES + c.wave, NGW = c.nblk * NWAVES;
    const bf16* PB = (const bf16*)(c.ws + WS_PB); const float* SM = (const float*)(c.ws + WS_SM);
    bf16* CKVN = (bf16*)(c.ws + WS_CKVN); bf16* KIDX = (bf16*)(c.ws + WS_KIDX); float* RSTDQ = (float*)(c.ws + WS_RSTDQ);
    const float* gkv = c.in[IN_DSA_NKV] + l * 128;
    const float g0 = gkv[2 * c.lane], g1 = gkv[2 * c.lane + 1];
    for (int t4 = gw * 4; t4 < T; t4 += NGW * 4) {
        unsigned kv[4]; u32x2 qv[4]; float ki[4];
#pragma unroll
        for (int r = 0; r < 4; ++r) { const bf16* row = PB + (size_t)(t4 + r) * NPB;
            kv[r] = *(const unsigned*)(row + PB_CKV + 2 * c.lane); qv[r] = *(const u32x2*)(row + PB_CQ + 4 * c.lane);
            ki[r] = c.lane < 32 ? SM[(size_t)(t4 + r) * 128 + SM_KIDX + c.lane] : 0.f; }
#pragma unroll
        for (int r = 0; r < 4; ++r) { const int t = t4 + r;
            const float k0 = bflo(kv[r]), k1 = bfhi(kv[r]);
            const float rs = rsqrtf(wave_sum(k0 * k0 + k1 * k1) * (1.f / 128.f) + EPS);
            *(unsigned*)(CKVN + (size_t)t * 128 + 2 * c.lane) = pk2(k0 * rs * g0, k1 * rs * g1);
            const float q0 = bflo(qv[r].x), q1 = bfhi(qv[r].x), q2 = bflo(qv[r].y), q3 = bfhi(qv[r].y);
            const float rq = rsqrtf(wave_sum(q0 * q0 + q1 * q1 + q2 * q2 + q3 * q3) * (1.f / 256.f) + EPS);
            if (c.lane == 0) RSTDQ[t] = rq;
            if (c.lane < 32) KIDX[(size_t)t * 32 + c.lane] = (bf16)f2bf(ki[r]); }
    }
}
__device__ __forceinline__ void phase_ckvt(const Ctx& c) {
    const bf16* CKVN = (const bf16*)(c.ws + WS_CKVN); bf16* CKVT = (bf16*)(c.ws + WS_CKVT);
    LAS bf16* tile = (LAS bf16*)c.lds;
    for (int it = c.bid; it < T / 64; it += c.nblk) {
        const int tb = it * 64, b = tb >> 11, p0 = tb & 2047;
        __syncthreads();
        { const int r = c.tid >> 3, ch = (c.tid & 7) * 8;
          *(LAS u32x4*)(tile + r * 136 + ch) = *(const u32x4*)(CKVN + (size_t)(tb + r) * 128 + ch); *(LAS u32x4*)(tile + r * 136 + 64 + ch) = *(const u32x4*)(CKVN + (size_t)(tb + r) * 128 + 64 + ch); }
        __syncthreads();
        { const int r = c.tid >> 2, part = c.tid & 3;
          unsigned w[8];
#pragma unroll
          for (int j = 0; j < 8; ++j) w[j] = (unsigned)tile[(16 * part + 2 * j) * 136 + r] | ((unsigned)tile[(16 * part + 2 * j + 1) * 136 + r] << 16);
          bf16* dst = CKVT + (((size_t)b * 32 + (p0 >> 6)) * 128 + r) * 64 + 32 * (part >> 1) + 4 * (part & 1);
          *(u32x2*)dst = (u32x2){w[0], w[1]}; *(u32x2*)(dst + 8) = (u32x2){w[2], w[3]}; *(u32x2*)(dst + 16) = (u32x2){w[4], w[5]}; *(u32x2*)(dst + 24) = (u32x2){w[6], w[7]}; }
    }
    __syncthreads();
}

constexpr int TS = 16;
__device__ __forceinline__ void scan_gla_item(const Ctx& c, int l, int b, int h) {
    LAS float* q_s = (LAS float*)c.lds;
    LAS float* k_s = q_s + TS * 64;
    LAS float* a_s = k_s + TS * 64;
    LAS float* v_s = a_s + TS * 64;
    LAS float* part = v_s + TS * 128;
    LAS float* wa2 = part + TS * 4 * 128;
    LAS float* ba = wa2 + 16 * 64;
    LAS float* alr = ba + 64;
    const bf16* PB = (const bf16*)(c.ws + WS_PB); const float* SM = (const float*)(c.ws + WS_SM);
    bf16* UA = (bf16*)(c.ws + WS_UA);
    const float* gn = c.in[IN_GLA_NORM] + l * 512 + h * 128;
    for (int i = c.tid; i < 16 * 64; i += NTHR) wa2[i] = c.in[IN_GLA_WA2][(size_t)l * 16 * 256 + (i >> 6) * 256 + h * 64 + (i & 63)];
    if (c.tid < 64) ba[c.tid] = c.in[IN_GLA_BA][l * 256 + h * 64 + c.tid];
    const int v = c.tid & 127, kg = c.tid >> 7;
    float S[16];
#pragma unroll
    for (int i = 0; i < 16; ++i) S[i] = 0.f;
    for (int t0 = 0; t0 < SEQ; t0 += TS) {
        __syncthreads();
        const size_t rb = (size_t)b * SEQ + t0;
        for (int i = c.tid; i < TS * 64; i += NTHR) { const int s = i >> 6, cc = i & 63; const bf16* row = PB + (rb + s) * NPB;
            q_s[i] = bf2f(row[PB_QA + h * 64 + cc]) * 0.125f; k_s[i] = bf2f(row[PB_KA + h * 64 + cc]); }
        for (int i = c.tid; i < TS * 128; i += NTHR) { const int s = i >> 7, cc = i & 127; v_s[i] = bf2f(PB[(rb + s) * NPB + PB_VA + h * 128 + cc]); }
        if (c.tid < TS * 16) alr[c.tid] = SM[(rb + (c.tid >> 4)) * 128 + SM_ALR + (c.tid & 15)];
        __syncthreads();
        for (int i = c.tid; i < TS * 64; i += NTHR) { const int s = i >> 6, cc = i & 63; float x = ba[cc];
#pragma unroll
            for (int j = 0; j < 16; ++j) x += alr[s * 16 + j] * wa2[j * 64 + cc];
            a_s[i] = __expf(logsigmoidf_(x) * (1.f / 16.f)); }
        __syncthreads();
#pragma unroll 1
        for (int s = 0; s < TS; ++s) {
            const float vv = v_s[s * 128 + v]; float acc = 0.f;
#pragma unroll
            for (int i4 = 0; i4 < 4; ++i4) {
                const f32x4 a4 = *(const LAS f32x4*)(a_s + s * 64 + kg * 16 + i4 * 4), k4 = *(const LAS f32x4*)(k_s + s * 64 + kg * 16 + i4 * 4), q4 = *(const LAS f32x4*)(q_s + s * 64 + kg * 16 + i4 * 4);
#pragma unroll
                for (int j = 0; j < 4; ++j) { S[i4 * 4 + j] = a4[j] * S[i4 * 4 + j] + k4[j] * vv; acc += q4[j] * S[i4 * 4 + j]; }
            }
            part[(s * 4 + kg) * 128 + v] = acc;
        }
        __syncthreads();
        {
            const int s = c.tid >> 5, vq = c.tid & 31, v0 = vq * 4;
            f32x4 o = (f32x4){0.f, 0.f, 0.f, 0.f};
#pragma unroll
            for (int g = 0; g < 4; ++g) o += *(const LAS f32x4*)(part + (s * 4 + g) * 128 + v0);
            float ss = o[0] * o[0] + o[1] * o[1] + o[2] * o[2] + o[3] * o[3];
#pragma unroll
            for (int m = 1; m < 32; m <<= 1) ss += __shfl_xor(ss, m);
            const float rstd = rsqrtf(ss * (1.f / 128.f) + EPS);
            const f32x4 ga = ld_bf4(PB + (rb + s) * NPB + PB_GA + h * 128 + v0);
            f32x4 r;
#pragma unroll
            for (int j = 0; j < 4; ++j) r[j] = o[j] * rstd * gn[v0 + j] * siluf_(ga[j]);
            st_bf4(UA + (rb + s) * 512 + h * 128 + v0, r);
        }
    }
    __syncthreads();
}
__device__ __forceinline__ void scan_mlstm_item(const Ctx& c, int l, int b, int h) {
    LAS float* q_s = (LAS float*)c.lds;
    LAS float* k_s = q_s + TS * 64;
    LAS float* v_s = k_s + TS * 64;
    LAS float* part = v_s + TS * 128;
    LAS float* dpart = part + TS * 4 * 128;
    LAS float* lf_s = dpart + TS * 4;
    LAS float* ip_s = lf_s + TS;
    LAS float* m_s = ip_s + TS;
    LAS float* cw = m_s + TS;
    const bf16* PB = (const bf16*)(c.ws + WS_PB); const float* SM = (const float*)(c.ws + WS_SM);
    bf16* UC = (bf16*)(c.ws + WS_UC);
    const float* mn = c.in[IN_ML_NORM] + l * 512 + h * 128;
    if (c.tid < 4 * 128) { const int j = c.tid >> 7, cc = c.tid & 127; cw[c.tid] = c.in[IN_ML_CONV][(size_t)l * 4 * 512 + j * 512 + (cc < 64 ? h * 64 + cc : 256 + h * 64 + (cc - 64))]; }
    const float bi = c.in[IN_ML_BI][l * 4 + h], bfv = c.in[IN_ML_BF][l * 4 + h];
    const int v = c.tid & 127, kg = c.tid >> 7;
    float C[16], n[16]; float m = 0.f;
#pragma unroll
    for (int i = 0; i < 16; ++i) { C[i] = 0.f; n[i] = 0.f; }
    for (int t0 = 0; t0 < SEQ; t0 += TS) {
        __syncthreads();
        const size_t rb = (size_t)b * SEQ + t0;
        for (int i = c.tid; i < TS * 128; i += NTHR) { const int s = i >> 7, cc = i & 127;
            const int col = cc < 64 ? PB_QC + h * 64 + cc : PB_KC + h * 64 + (cc - 64);
            float x = 0.f;
#pragma unroll
            for (int j = 0; j < 4; ++j) { const int tt = t0 + s - 3 + j; if (tt >= 0) x += cw[j * 128 + cc] * bf2f(PB[((size_t)b * SEQ + tt) * NPB + col]); }
            x = siluf_(x);
            if (cc < 64) q_s[s * 64 + cc] = x * 0.125f; else k_s[s * 64 + (cc - 64)] = x; }
        for (int i = c.tid; i < TS * 128; i += NTHR) { const int s = i >> 7, cc = i & 127; v_s[i] = bf2f(PB[(rb + s) * NPB + PB_VC + h * 128 + cc]); }
        if (c.tid < TS) { ip_s[c.tid] = SM[(rb + c.tid) * 128 + SM_IC + h] + bi; lf_s[c.tid] = logsigmoidf_(SM[(rb + c.tid) * 128 + SM_FC + h] + bfv); }
        __syncthreads();
#pragma unroll 1
        for (int s = 0; s < TS; ++s) {
            const float lf = lf_s[s], ip = ip_s[s];
            const float mnew = fmaxf(lf + m, ip), fg = __expf(lf + m - mnew), ig = __expf(ip - mnew);
            m = mnew;
            const float vv = v_s[s * 128 + v] * ig; float num = 0.f, den = 0.f;
#pragma unroll
            for (int i4 = 0; i4 < 4; ++i4) {
                const f32x4 k4 = *(const LAS f32x4*)(k_s + s * 64 + kg * 16 + i4 * 4), q4 = *(const LAS f32x4*)(q_s + s * 64 + kg * 16 + i4 * 4);
#pragma unroll
                for (int j = 0; j < 4; ++j) { C[i4 * 4 + j] = fg * C[i4 * 4 + j] + k4[j] * vv; n[i4 * 4 + j] = fg * n[i4 * 4 + j] + ig * k4[j]; num += q4[j] * C[i4 * 4 + j]; den += q4[j] * n[i4 * 4 + j]; }
            }
            part[(s * 4 + kg) * 128 + v] = num;
            if (v == 0) dpart[s * 4 + kg] = den;
            if (c.tid == 0) m_s[s] = m;
        }
        __syncthreads();
        {
            const int s = c.tid >> 5, vq = c.tid & 31, v0 = vq * 4;
            f32x4 o = (f32x4){0.f, 0.f, 0.f, 0.f};
#pragma unroll
            for (int g = 0; g < 4; ++g) o += *(const LAS f32x4*)(part + (s * 4 + g) * 128 + v0);
            const float den = dpart[s * 4] + dpart[s * 4 + 1] + dpart[s * 4 + 2] + dpart[s * 4 + 3];
            const float dd = 1.f / fmaxf(fabsf(den), __expf(-m_s[s]));
            o = o * dd;
            float ss = o[0] * o[0] + o[1] * o[1] + o[2] * o[2] + o[3] * o[3];
#pragma unroll
            for (int mm = 1; mm < 32; mm <<= 1) ss += __shfl_xor(ss, mm);
            const float rstd = rsqrtf(ss * (1.f / 128.f) + EPS);
            const f32x4 oc = ld_bf4(PB + (rb + s) * NPB + PB_OC + h * 128 + v0);
            f32x4 r;
#pragma unroll
            for (int j = 0; j < 4; ++j) r[j] = o[j] * rstd * mn[v0 + j] * sigmoidf_(oc[j]);
            st_bf4(UC + (rb + s) * 512 + h * 128 + v0, r);
        }
    }
    __syncthreads();
}

constexpr int LQ = 72;
constexpr int SC_QT = 0, SC_KT = 9216, SC_KTT = 18432, SC_Q2 = 27648, SC_SC = 36864, SC_VT = 46080, SC_ST = 66816, SC_FL = 108288;
__device__ __forceinline__ float wave_scan_add(float x, int lane) {
#pragma unroll
    for (int d = 1; d < 64; d <<= 1) { const float y = __shfl_up(x, d); if (lane >= d) x += y; }
    return x;
}
__device__ __forceinline__ float wave_scan_max(float x, int lane) {
#pragma unroll
    for (int d = 1; d < 64; d <<= 1) { const float y = __shfl_up(x, d); if (lane >= d) x = fmaxf(x, y); }
    return x;
}
__device__ __forceinline__ void unpack8(u32x4 w, float (&f)[8]) { f[0] = bflo(w.x); f[1] = bfhi(w.x); f[2] = bflo(w.y); f[3] = bfhi(w.y); f[4] = bflo(w.z); f[5] = bfhi(w.z); f[6] = bflo(w.w); f[7] = bfhi(w.w); }
__device__ __forceinline__ u32x4 pack8(const float (&f)[8]) { u32x4 w; w.x = pk2(f[0], f[1]); w.y = pk2(f[2], f[3]); w.z = pk2(f[4], f[5]); w.w = pk2(f[6], f[7]); return w; }
template <bool ML>
__device__ __forceinline__ void scan_chunked_item(const Ctx& c, int l, int b, int h) {
    LAS bf16* Qt0 = (LAS bf16*)(c.lds + SC_QT); LAS bf16* Kt0 = (LAS bf16*)(c.lds + SC_KT); LAS bf16* KtT0 = (LAS bf16*)(c.lds + SC_KTT);
    LAS bf16* Q20 = (LAS bf16*)(c.lds + SC_Q2); LAS bf16* Sc0 = (LAS bf16*)(c.lds + SC_SC); LAS bf16* VT0 = (LAS bf16*)(c.lds + SC_VT);
    LAS bf16* ST0 = (LAS bf16*)(c.lds + SC_ST);
    LAS float* segtot = (LAS float*)(c.lds + SC_FL);
    LAS float* etot = segtot + 512;
    LAS float* ssq = etot + 64;
    LAS float* dn = ssq + 512;
    LAS float* wa2 = dn + 64;
    LAS float* ba = wa2 + 1024;
    LAS float* cw = ba + 64;
    const int tid = c.tid, lane = c.lane, w = c.wave, fr = lane & 15, fq = lane >> 4;
    const int srow = tid >> 3, kg = tid & 7, k8 = kg * 8, vrow = tid >> 4, vc8 = (tid & 15) * 8;
    const bf16* PB = (const bf16*)(c.ws + WS_PB); const float* SM = (const float*)(c.ws + WS_SM);
    bf16* UO = (bf16*)(c.ws + (ML ? WS_UC : WS_UA));
    const int QCOL = (ML ? PB_QC : PB_QA) + h * 64, KCOL = (ML ? PB_KC : PB_KA) + h * 64, VCOL = (ML ? PB_VC : PB_VA) + h * 128, GCOL = (ML ? PB_OC : PB_GA) + h * 128;
    const float* gnorm = c.in[ML ? IN_ML_NORM : IN_GLA_NORM] + l * 512 + h * 128;
    __syncthreads();
    if (!ML) { for (int i = tid; i < 1024; i += NTHR) wa2[i] = c.in[IN_GLA_WA2][(size_t)l * 16 * 256 + (i >> 6) * 256 + h * 64 + (i & 63)];
               if (tid < 64) ba[tid] = c.in[IN_GLA_BA][l * 256 + h * 64 + tid]; }
    else { if (tid < 512) { const int j = tid >> 7, cc = tid & 127; cw[tid] = c.in[IN_ML_CONV][(size_t)l * 4 * 512 + j * 512 + (cc < 64 ? h * 64 + cc : 256 + h * 64 + (cc - 64))]; } }
    for (int i = tid; i < 144 * LQ / 2; i += NTHR) ((LAS unsigned*)ST0)[i] = 0u;
    if (ML) { for (int i = tid; i < 16 * LQ; i += NTHR) VT0[128 * LQ + i] = (i < 64) ? (bf16)0x3f80u : (bf16)0u; }
    const float bi = ML ? c.in[IN_ML_BI][l * 4 + h] : 0.f, bfv = ML ? c.in[IN_ML_BF][l * 4 + h] : 0.f;
    float m_prev = 0.f;
    f32x4 Sacc[4], Nacc = (f32x4){0.f, 0.f, 0.f, 0.f};
#pragma unroll
    for (int i = 0; i < 4; ++i) Sacc[i] = (f32x4){0.f, 0.f, 0.f, 0.f};
    u32x4 rq[ML ? 4 : 1], rk[ML ? 4 : 1], rv[2]; f32x4 ra[4]; float ric = 0.f, rfc = 0.f;
    const u32x4 z4 = (u32x4){0u, 0u, 0u, 0u};
#define SC_LOAD(cch) do { const size_t _g = (size_t)b * SEQ + (size_t)(cch) * 64; \
        if (ML) { _Pragma("unroll") for (int _j = 0; _j < 4; ++_j) { const int _tt = (cch) * 64 + srow - 3 + _j; \
                rq[_j] = _tt >= 0 ? *(const u32x4*)(PB + ((size_t)b * SEQ + _tt) * NPB + QCOL + k8) : z4; rk[_j] = _tt >= 0 ? *(const u32x4*)(PB + ((size_t)b * SEQ + _tt) * NPB + KCOL + k8) : z4; } \
            ric = SM[(_g + lane) * 128 + SM_IC + h]; rfc = SM[(_g + lane) * 128 + SM_FC + h]; } \
        else { rq[0] = *(const u32x4*)(PB + (_g + srow) * NPB + QCOL + k8); rk[0] = *(const u32x4*)(PB + (_g + srow) * NPB + KCOL + k8); \
            _Pragma("unroll") for (int _j = 0; _j < 4; ++_j) ra[_j] = *(const f32x4*)(SM + (_g + srow) * 128 + SM_ALR + 4 * _j); } \
        rv[0] = *(const u32x4*)(PB + (_g + vrow) * NPB + VCOL + vc8); rv[1] = *(const u32x4*)(PB + (_g + 32 + vrow) * NPB + VCOL + vc8); } while (0)
    SC_LOAD(0);
    __syncthreads();
#pragma unroll 1
    for (int cch = 0; cch < SEQ / 64; ++cch) {
        const size_t grow = (size_t)b * SEQ + (size_t)cch * 64;
        int lz; asm volatile("v_mov_b32 %0, 0" : "=v"(lz));
        LAS bf16* Qt = Qt0 + lz; LAS bf16* Kt = Kt0 + lz; LAS bf16* KtT = KtT0 + lz; LAS bf16* Q2 = Q20 + lz; LAS bf16* Sc = Sc0 + lz; LAS bf16* VT = VT0 + lz; LAS bf16* ST = ST0 + lz;
        LAS bf16* STc = ST + (cch & 1) * 144 * LQ; LAS bf16* STn = ST + ((cch & 1) ^ 1) * 144 * LQ;
        float qv[8], kv[8];
        float g_a = 0.f, g_M = 0.f, g_bc = 0.f, M63 = 0.f, wc = 1.f;
        if (!ML) {
            unpack8(rq[0], qv); unpack8(rk[0], kv);
            float la[8];
#pragma unroll
            for (int i = 0; i < 8; ++i) la[i] = ba[k8 + i];
#pragma unroll
            for (int j4 = 0; j4 < 4; ++j4)
#pragma unroll
                for (int jj = 0; jj < 4; ++jj) { const float a = ra[j4][jj]; const LAS float* wr_ = wa2 + (j4 * 4 + jj) * 64 + k8;
                    const f32x4 w0 = *(const LAS f32x4*)wr_, w1 = *(const LAS f32x4*)(wr_ + 4);
                    la[0] += a * w0[0]; la[1] += a * w0[1]; la[2] += a * w0[2]; la[3] += a * w0[3]; la[4] += a * w1[0]; la[5] += a * w1[1]; la[6] += a * w1[2]; la[7] += a * w1[3]; }
#pragma unroll
            for (int i = 0; i < 8; ++i) { float x = logsigmoid_fast(la[i]) * (1.f / 16.f);
#pragma unroll
                for (int d = 8; d < 64; d <<= 1) { const float y = __shfl_up(x, d); if (lane >= d) x += y; }
                la[i] = x; }
            if ((lane >> 3) == 7) { *(LAS f32x4*)(segtot + w * 64 + k8) = (f32x4){la[0], la[1], la[2], la[3]}; *(LAS f32x4*)(segtot + w * 64 + k8 + 4) = (f32x4){la[4], la[5], la[6], la[7]}; }
            lds_barrier();
            float tot[8];
#pragma unroll
            for (int i = 0; i < 8; ++i) tot[i] = 0.f;
#pragma unroll
            for (int ww = 0; ww < 8; ++ww) { const f32x4 s0 = *(const LAS f32x4*)(segtot + ww * 64 + k8), s1 = *(const LAS f32x4*)(segtot + ww * 64 + k8 + 4);
                const float sel = ww < w ? 1.f : 0.f;
                la[0] += sel * s0[0]; la[1] += sel * s0[1]; la[2] += sel * s0[2]; la[3] += sel * s0[3]; la[4] += sel * s1[0]; la[5] += sel * s1[1]; la[6] += sel * s1[2]; la[7] += sel * s1[3];
                tot[0] += s0[0]; tot[1] += s0[1]; tot[2] += s0[2]; tot[3] += s0[3]; tot[4] += s1[0]; tot[5] += s1[1]; tot[6] += s1[2]; tot[7] += s1[3]; }
            if (tid < 8) {
#pragma unroll
                for (int i = 0; i < 8; ++i) etot[k8 + i] = __expf(tot[i]); }
            float kt[8];
#pragma unroll
            for (int i = 0; i < 8; ++i) { qv[i] = qv[i] * 0.125f * __expf(la[i]); kt[i] = kv[i] * __expf(-la[i]); }
            *(LAS u32x4*)(Qt + srow * LQ + k8) = pack8(qv); *(LAS u32x4*)(Kt + srow * LQ + k8) = pack8(kt);
#pragma unroll
            for (int i = 0; i < 8; ++i) KtT[(k8 + i) * LQ + srow] = (bf16)f2bf(kt[i]);
        } else {
            float x4[4][8];
#pragma unroll
            for (int j = 0; j < 4; ++j) unpack8(rq[j], x4[j]);
#pragma unroll
            for (int i = 0; i < 8; ++i) { float x = 0.f;
#pragma unroll
                for (int j = 0; j < 4; ++j) x += cw[j * 128 + k8 + i] * x4[j][i];
                qv[i] = siluf_(x) * 0.125f; }
#pragma unroll
            for (int j = 0; j < 4; ++j) unpack8(rk[j], x4[j]);
#pragma unroll
            for (int i = 0; i < 8; ++i) { float x = 0.f;
#pragma unroll
                for (int j = 0; j < 4; ++j) x += cw[j * 128 + 64 + k8 + i] * x4[j][i];
                kv[i] = siluf_(x); }
            const float lf = logsigmoid_fast(rfc + bfv), ip = ric + bi;
            g_bc = wave_scan_add(lf, lane); g_a = ip - g_bc;
            const float pm = wave_scan_max(g_a, lane); g_M = fmaxf(m_prev, pm);
            M63 = __shfl(g_M, 63); const float totb = __shfl(g_bc, 63);
            wc = __expf(m_prev - M63);
            const float Ms = __shfl(g_M, srow), as = __shfl(g_a, srow);
            const float e1 = __expf(m_prev - Ms), e2 = __expf(as - M63);
            float q2[8], kw[8];
#pragma unroll
            for (int i = 0; i < 8; ++i) { q2[i] = qv[i] * e1; kw[i] = kv[i] * e2; }
            *(LAS u32x4*)(Qt + srow * LQ + k8) = pack8(qv); *(LAS u32x4*)(Kt + srow * LQ + k8) = pack8(kv); *(LAS u32x4*)(Q2 + srow * LQ + k8) = pack8(q2);
#pragma unroll
            for (int i = 0; i < 8; ++i) KtT[(k8 + i) * LQ + srow] = (bf16)f2bf(kw[i]);
            m_prev = totb + M63;
        }
        { float v0[8], v1[8]; unpack8(rv[0], v0); unpack8(rv[1], v1);
#pragma unroll
          for (int i = 0; i < 8; ++i) { VT[(vc8 + i) * LQ + vrow] = (bf16)f2bf(v0[i]); VT[(vc8 + i) * LQ + 32 + vrow] = (bf16)f2bf(v1[i]); } }
        u32x2 gate[4];
#pragma unroll
        for (int ti = 0; ti < 4; ++ti) gate[ti] = *(const u32x2*)(PB + (grow + 16 * ti + fr) * NPB + GCOL + 16 * w + 4 * fq);
        if (cch + 1 < SEQ / 64) SC_LOAD(cch + 1);
        lds_barrier();
        {
            const int ti = w >> 1;
#pragma unroll
            for (int u = 0; u < 2; ++u) {
                const int sj = 2 * (w & 1) + u;
                f32x4 d = (f32x4){0.f, 0.f, 0.f, 0.f};
                if (sj <= ti) {
#pragma unroll
                    for (int ks = 0; ks < 2; ++ks) { const bf16x8 a = *(const LAS bf16x8*)(Kt + (16 * sj + fr) * LQ + 32 * ks + 8 * fq), bb = *(const LAS bf16x8*)(Qt + (16 * ti + fr) * LQ + 32 * ks + 8 * fq);
                        d = __builtin_amdgcn_mfma_f32_16x16x32_bf16(a, bb, d, 0, 0, 0); }
                    const int t = 16 * ti + fr, s0 = 16 * sj + 4 * fq;
                    if (ML) { const float Mt = __shfl(g_M, t);
#pragma unroll
                        for (int r = 0; r < 4; ++r) { const float as = __shfl(g_a, s0 + r); d[r] = (s0 + r <= t) ? d[r] * __expf(as - Mt) : 0.f; } }
                    else {
#pragma unroll
                        for (int r = 0; r < 4; ++r) d[r] = (s0 + r <= t) ? d[r] : 0.f; }
                }
                { u32x2 pk; pk.x = pk2(d[0], d[1]); pk.y = pk2(d[2], d[3]); *(LAS u32x2*)(Sc + (16 * ti + fr) * LQ + 16 * sj + 4 * fq) = pk; }
            }
        }
        lds_barrier();
        const LAS bf16* Qm = ML ? Q2 : Qt;
        f32x4 o[4];
        {
            bf16x8 vt[2], stf[2];
#pragma unroll
            for (int ks = 0; ks < 2; ++ks) { vt[ks] = *(const LAS bf16x8*)(VT + (16 * w + fr) * LQ + 32 * ks + 8 * fq); stf[ks] = *(const LAS bf16x8*)(STc + (16 * w + fr) * LQ + 32 * ks + 8 * fq); }
#pragma unroll
            for (int ti = 0; ti < 4; ++ti) {
                f32x4 d = (f32x4){0.f, 0.f, 0.f, 0.f};
#pragma unroll
                for (int ks = 0; ks < 2; ++ks) { const bf16x8 sc = *(const LAS bf16x8*)(Sc + (16 * ti + fr) * LQ + 32 * ks + 8 * fq); d = __builtin_amdgcn_mfma_f32_16x16x32_bf16(vt[ks], sc, d, 0, 0, 0); }
#pragma unroll
                for (int ks = 0; ks < 2; ++ks) { const bf16x8 qq = *(const LAS bf16x8*)(Qm + (16 * ti + fr) * LQ + 32 * ks + 8 * fq); d = __builtin_amdgcn_mfma_f32_16x16x32_bf16(stf[ks], qq, d, 0, 0, 0); }
                o[ti] = d;
            }
#pragma unroll
            for (int kj = 0; kj < 4; ++kj) {
                f32x4 d = (f32x4){0.f, 0.f, 0.f, 0.f};
#pragma unroll
                for (int ks = 0; ks < 2; ++ks) { const bf16x8 kk = *(const LAS bf16x8*)(KtT + (16 * kj + fr) * LQ + 32 * ks + 8 * fq); d = __builtin_amdgcn_mfma_f32_16x16x32_bf16(kk, vt[ks], d, 0, 0, 0); }
                if (ML) Sacc[kj] = Sacc[kj] * wc + d;
                else { const f32x4 e4 = *(const LAS f32x4*)(etot + 16 * kj + 4 * fq); Sacc[kj] = e4 * (Sacc[kj] + d); }
                u32x2 pk; pk.x = pk2(Sacc[kj][0], Sacc[kj][1]); pk.y = pk2(Sacc[kj][2], Sacc[kj][3]);
                *(LAS u32x2*)(STn + (16 * w + fr) * LQ + 16 * kj + 4 * fq) = pk;
            }
            if (ML) {
                if (w < 4) {
                    f32x4 d = (f32x4){0.f, 0.f, 0.f, 0.f};
#pragma unroll
                    for (int ks = 0; ks < 2; ++ks) { const bf16x8 a = *(const LAS bf16x8*)(VT + (128 + fr) * LQ + 32 * ks + 8 * fq), sc = *(const LAS bf16x8*)(Sc + (16 * w + fr) * LQ + 32 * ks + 8 * fq);
                        d = __builtin_amdgcn_mfma_f32_16x16x32_bf16(a, sc, d, 0, 0, 0); }
#pragma unroll
                    for (int ks = 0; ks < 2; ++ks) { const bf16x8 a = *(const LAS bf16x8*)(STc + (128 + fr) * LQ + 32 * ks + 8 * fq), qq = *(const LAS bf16x8*)(Qm + (16 * w + fr) * LQ + 32 * ks + 8 * fq);
                        d = __builtin_amdgcn_mfma_f32_16x16x32_bf16(a, qq, d, 0, 0, 0); }
                    if (fq == 0) dn[16 * w + fr] = d[0];
                } else {
                    const int kj = w - 4;
                    f32x4 d = (f32x4){0.f, 0.f, 0.f, 0.f};
#pragma unroll
                    for (int ks = 0; ks < 2; ++ks) { const bf16x8 kk = *(const LAS bf16x8*)(KtT + (16 * kj + fr) * LQ + 32 * ks + 8 * fq), a = *(const LAS bf16x8*)(VT + (128 + fr) * LQ + 32 * ks + 8 * fq);
                        d = __builtin_amdgcn_mfma_f32_16x16x32_bf16(kk, a, d, 0, 0, 0); }
                    Nacc = Nacc * wc + d;
                    u32x2 pk; pk.x = pk2(Nacc[0], Nacc[1]); pk.y = pk2(Nacc[2], Nacc[3]);
                    *(LAS u32x2*)(STn + (128 + fr) * LQ + 16 * kj + 4 * fq) = pk;
                }
            }
        }
#pragma unroll
        for (int ti = 0; ti < 4; ++ti) { float p = o[ti][0] * o[ti][0] + o[ti][1] * o[ti][1] + o[ti][2] * o[ti][2] + o[ti][3] * o[ti][3];
            p += __shfl_xor(p, 16); p += __shfl_xor(p, 32);
            if (fq == 0) ssq[w * 64 + 16 * ti + fr] = p; }
        lds_barrier();
#pragma unroll
        for (int ti = 0; ti < 4; ++ti) {
            const int t = 16 * ti + fr;
            float ss = 0.f;
#pragma unroll
            for (int ww = 0; ww < 8; ++ww) ss += ssq[ww * 64 + t];
            float dd = 1.f;
            if (ML) { const float bc = __shfl(g_bc, t), Mt = __shfl(g_M, t); dd = 1.f / fmaxf(fabsf(dn[t]), __expf(-(bc + Mt))); }
            const float rstd = rsqrtf(ss * dd * dd * (1.f / 128.f) + EPS) * dd;
            const f32x4 gn = *(const f32x4*)(gnorm + 16 * w + 4 * fq);
            const float g0 = bflo(gate[ti].x), g1 = bfhi(gate[ti].x), g2 = bflo(gate[ti].y), g3 = bfhi(gate[ti].y);
            f32x4 r;
            if (ML) { r[0] = o[ti][0] * rstd * gn[0] * sigmoidf_(g0); r[1] = o[ti][1] * rstd * gn[1] * sigmoidf_(g1); r[2] = o[ti][2] * rstd * gn[2] * sigmoidf_(g2); r[3] = o[ti][3] * rstd * gn[3] * sigmoidf_(g3); }
            else { r[0] = o[ti][0] * rstd * gn[0] * siluf_(g0); r[1] = o[ti][1] * rstd * gn[1] * siluf_(g1); r[2] = o[ti][2] * rstd * gn[2] * siluf_(g2); r[3] = o[ti][3] * rstd * gn[3] * siluf_(g3); }
            st_bf4(UO + (grow + t) * 512 + h * 128 + 16 * w + 4 * fq, r);
        }
    }
#undef SC_LOAD
    __syncthreads();
}

template <bool ML>
__device__ __forceinline__ void scanA_loop(const Ctx& c, int l, int it0, int it_end, int stride) {
    LAS bf16* Qt0 = (LAS bf16*)(c.lds + SC_QT); LAS bf16* Kt0 = (LAS bf16*)(c.lds + SC_KT); LAS bf16* KtT0 = (LAS bf16*)(c.lds + SC_KTT);
    LAS bf16* Sc0 = (LAS bf16*)(c.lds + SC_SC); LAS bf16* VT0 = (LAS bf16*)(c.lds + SC_VT);
    LAS float* segtot = (LAS float*)(c.lds + SC_FL);
    LAS float* wa2 = segtot + 512 + 64 + 512 + 64;
    LAS float* ba = wa2 + 1024;
    LAS float* cw = ba + 64;
    const int tid = c.tid, lane = c.lane, w = c.wave, fr = lane & 15, fq = lane >> 4;
    const int srow = tid >> 3, kg = tid & 7, k8 = kg * 8, vrow = tid >> 4, vc8 = (tid & 15) * 8;
    const bf16* PB = (const bf16*)(c.ws + WS_PB); const float* SM = (const float*)(c.ws + WS_SM);
    bf16* UO = (bf16*)(c.ws + (ML ? WS_UC : WS_UA));
    bf16* QS = (bf16*)(c.ws + WS_QS) + (ML ? (size_t)T * 256 : 0);
    u32x4 rq[ML ? 4 : 1], rk[ML ? 4 : 1], rv[2]; f32x4 ra[4]; float ric = 0.f, rfc = 0.f;
    const u32x4 z4 = (u32x4){0u, 0u, 0u, 0u};
#define SA_LOAD(it_) do { const int _rem = (it_) & 2047, _seq = _rem >> 5, _cch = _rem & 31, _b = _seq >> 2, _h = _seq & 3; \
        const size_t _g = (size_t)_b * SEQ + (size_t)_cch * 64; \
        const int _qc = (ML ? PB_QC : PB_QA) + _h * 64, _kc = (ML ? PB_KC : PB_KA) + _h * 64, _vc = (ML ? PB_VC : PB_VA) + _h * 128; \
        if (ML) { _Pragma("unroll") for (int _j = 0; _j < 4; ++_j) { const int _tt = _cch * 64 + srow - 3 + _j; \
                rq[_j] = _tt >= 0 ? *(const u32x4*)(PB + ((size_t)_b * SEQ + _tt) * NPB + _qc + k8) : z4; rk[_j] = _tt >= 0 ? *(const u32x4*)(PB + ((size_t)_b * SEQ + _tt) * NPB + _kc + k8) : z4; } \
            ric = SM[(_g + lane) * 128 + SM_IC + _h]; rfc = SM[(_g + lane) * 128 + SM_FC + _h]; } \
        else { rq[0] = *(const u32x4*)(PB + (_g + srow) * NPB + _qc + k8); rk[0] = *(const u32x4*)(PB + (_g + srow) * NPB + _kc + k8); \
            _Pragma("unroll") for (int _j = 0; _j < 4; ++_j) ra[_j] = *(const f32x4*)(SM + (_g + srow) * 128 + SM_ALR + 4 * _j); } \
        rv[0] = *(const u32x4*)(PB + (_g + vrow) * NPB + _vc + vc8); rv[1] = *(const u32x4*)(PB + (_g + 32 + vrow) * NPB + _vc + vc8); } while (0)
    if (it0 < it_end) SA_LOAD(it0);
    int hprev = -1;
#pragma unroll 1
    for (int it = it0; it < it_end; it += stride) {
    const int rem_ = it & 2047, seq_ = rem_ >> 5, cch = rem_ & 31, b = seq_ >> 2, h = seq_ & 3;
    const int slot = (b * 4 + h) * 32 + cch;
    bf16* DS = ML ? (bf16*)(c.ws + WS_DSM) + (size_t)slot * 144 * 64 : (bf16*)(c.ws + WS_DSG) + (size_t)slot * 128 * 64;
    const size_t grow = (size_t)b * SEQ + (size_t)cch * 64;
    int lz; asm volatile("v_mov_b32 %0, 0" : "=v"(lz));
    LAS bf16* Qt = Qt0 + lz; LAS bf16* Kt = Kt0 + lz; LAS bf16* KtT = KtT0 + lz; LAS bf16* Sc = Sc0 + lz; LAS bf16* VT = VT0 + lz;
    __syncthreads();
    if (h != hprev) {
        if (!ML) { for (int i = tid; i < 1024; i += NTHR) wa2[i] = c.in[IN_GLA_WA2][(size_t)l * 16 * 256 + (i >> 6) * 256 + h * 64 + (i & 63)];
                   if (tid < 64) ba[tid] = c.in[IN_GLA_BA][l * 256 + h * 64 + tid]; }
        else { { const int j = tid >> 7, cc = tid & 127; cw[tid] = c.in[IN_ML_CONV][(size_t)l * 4 * 512 + j * 512 + (cc < 64 ? h * 64 + cc : 256 + h * 64 + (cc - 64))]; }
               for (int i = tid; i < 16 * LQ; i += NTHR) VT[128 * LQ + i] = (i < 64) ? (bf16)0x3f80u : (bf16)0u; }
        hprev = h;
        __syncthreads();
    }
    const float bi = ML ? c.in[IN_ML_BI][l * 4 + h] : 0.f, bfv = ML ? c.in[IN_ML_BF][l * 4 + h] : 0.f;
    float qv[8], kv[8];
    float g_a = 0.f, g_pm = 0.f;
    if (!ML) {
        unpack8(rq[0], qv); unpack8(rk[0], kv);
        float la[8];
#pragma unroll
        for (int i = 0; i < 8; ++i) la[i] = ba[k8 + i];
#pragma unroll
        for (int j4 = 0; j4 < 4; ++j4)
#pragma unroll
            for (int jj = 0; jj < 4; ++jj) { const float a = ra[j4][jj]; const LAS float* wr_ = wa2 + (j4 * 4 + jj) * 64 + k8;
                const f32x4 w0 = *(const LAS f32x4*)wr_, w1 = *(const LAS f32x4*)(wr_ + 4);
                la[0] += a * w0[0]; la[1] += a * w0[1]; la[2] += a * w0[2]; la[3] += a * w0[3]; la[4] += a * w1[0]; la[5] += a * w1[1]; la[6] += a * w1[2]; la[7] += a * w1[3]; }
#pragma unroll
        for (int i = 0; i < 8; ++i) { float x = logsigmoid_fast(la[i]) * (1.f / 16.f);
#pragma unroll
            for (int d = 8; d < 64; d <<= 1) { const float y = __shfl_up(x, d); if (lane >= d) x += y; }
            la[i] = x; }
        if ((lane >> 3) == 7) { *(LAS f32x4*)(segtot + w * 64 + k8) = (f32x4){la[0], la[1], la[2], la[3]}; *(LAS f32x4*)(segtot + w * 64 + k8 + 4) = (f32x4){la[4], la[5], la[6], la[7]}; }
        lds_barrier();
        float tot[8];
#pragma unroll
        for (int i = 0; i < 8; ++i) tot[i] = 0.f;
#pragma unroll
        for (int ww = 0; ww < 8; ++ww) { const f32x4 s0 = *(const LAS f32x4*)(segtot + ww * 64 + k8), s1 = *(const LAS f32x4*)(segtot + ww * 64 + k8 + 4);
            const float sel = ww < w ? 1.f : 0.f;
            la[0] += sel * s0[0]; la[1] += sel * s0[1]; la[2] += sel * s0[2]; la[3] += sel * s0[3]; la[4] += sel * s1[0]; la[5] += sel * s1[1]; la[6] += sel * s1[2]; la[7] += sel * s1[3];
            tot[0] += s0[0]; tot[1] += s0[1]; tot[2] += s0[2]; tot[3] += s0[3]; tot[4] += s1[0]; tot[5] += s1[1]; tot[6] += s1[2]; tot[7] += s1[3]; }
        if (tid < 8) { float* et = (float*)(c.ws + WS_ET) + (size_t)slot * 64 + k8;
            *(f32x4*)et = (f32x4){__expf(tot[0]), __expf(tot[1]), __expf(tot[2]), __expf(tot[3])}; *(f32x4*)(et + 4) = (f32x4){__expf(tot[4]), __expf(tot[5]), __expf(tot[6]), __expf(tot[7])}; }
        float kt[8];
#pragma unroll
        for (int i = 0; i < 8; ++i) { qv[i] = qv[i] * 0.125f * __expf(la[i]); kt[i] = kv[i] * __expf(-la[i]); }
        const u32x4 qp = pack8(qv);
        *(LAS u32x4*)(Qt + srow * LQ + k8) = qp; *(LAS u32x4*)(Kt + srow * LQ + k8) = pack8(kt);
        *(u32x4*)(QS + (grow + srow) * 256 + h * 64 + k8) = qp;
#pragma unroll
        for (int i = 0; i < 8; ++i) KtT[(k8 + i) * LQ + srow] = (bf16)f2bf(kt[i]);
    } else {
        float x4[4][8];
#pragma unroll
        for (int j = 0; j < 4; ++j) unpack8(rq[j], x4[j]);
#pragma unroll
        for (int i = 0; i < 8; ++i) { float x = 0.f;
#pragma unroll
            for (int j = 0; j < 4; ++j) x += cw[j * 128 + k8 + i] * x4[j][i];
            qv[i] = siluf_(x) * 0.125f; }
#pragma unroll
        for (int j = 0; j < 4; ++j) unpack8(rk[j], x4[j]);
#pragma unroll
        for (int i = 0; i < 8; ++i) { float x = 0.f;
#pragma unroll
            for (int j = 0; j < 4; ++j) x += cw[j * 128 + 64 + k8 + i] * x4[j][i];
            kv[i] = siluf_(x); }
        const float lf = logsigmoid_fast(rfc + bfv), ip = ric + bi;
        const float g_bc = wave_scan_add(lf, lane); g_a = ip - g_bc;
        g_pm = wave_scan_max(g_a, lane);
        const float pm63 = __shfl(g_pm, 63), totb = __shfl(g_bc, 63);
        if (w == 0) { ((float*)(c.ws + WS_GPM))[(grow + lane) * 4 + h] = g_pm; ((float*)(c.ws + WS_GBC))[(grow + lane) * 4 + h] = g_bc;
            if (lane == 0) { float* ct = (float*)(c.ws + WS_CT) + (size_t)slot * 2; ct[0] = totb; ct[1] = pm63; } }
        const float as = __shfl(g_a, srow);
        const float e2 = __expf(as - pm63);
        float kw[8];
#pragma unroll
        for (int i = 0; i < 8; ++i) kw[i] = kv[i] * e2;
        const u32x4 qp = pack8(qv);
        *(LAS u32x4*)(Qt + srow * LQ + k8) = qp; *(LAS u32x4*)(Kt + srow * LQ + k8) = pack8(kv);
        *(u32x4*)(QS + (grow + srow) * 256 + h * 64 + k8) = qp;
#pragma unroll
        for (int i = 0; i < 8; ++i) KtT[(k8 + i) * LQ + srow] = (bf16)f2bf(kw[i]);
    }
    { float v0[8], v1[8]; unpack8(rv[0], v0); unpack8(rv[1], v1);
#pragma unroll
      for (int i = 0; i < 8; ++i) { VT[(vc8 + i) * LQ + vrow] = (bf16)f2bf(v0[i]); VT[(vc8 + i) * LQ + 32 + vrow] = (bf16)f2bf(v1[i]); } }
    if (it + stride < it_end) SA_LOAD(it + stride);
    lds_barrier();
    {
        const int ti = w >> 1;
#pragma unroll
        for (int u = 0; u < 2; ++u) {
            const int sj = 2 * (w & 1) + u;
            f32x4 d = (f32x4){0.f, 0.f, 0.f, 0.f};
            if (sj <= ti) {
#pragma unroll
                for (int ks = 0; ks < 2; ++ks) { const bf16x8 a = *(const LAS bf16x8*)(Kt + (16 * sj + fr) * LQ + 32 * ks + 8 * fq), bb = *(const LAS bf16x8*)(Qt + (16 * ti + fr) * LQ + 32 * ks + 8 * fq);
                    d = __builtin_amdgcn_mfma_f32_16x16x32_bf16(a, bb, d, 0, 0, 0); }
                const int t = 16 * ti + fr, s0 = 16 * sj + 4 * fq;
                if (ML) { const float pt = __shfl(g_pm, t);
#pragma unroll
                    for (int r = 0; r < 4; ++r) { const float as = __shfl(g_a, s0 + r); d[r] = (s0 + r <= t) ? d[r] * __expf(as - pt) : 0.f; } }
                else {
#pragma unroll
                    for (int r = 0; r < 4; ++r) d[r] = (s0 + r <= t) ? d[r] : 0.f; }
            }
            { u32x2 pk; pk.x = pk2(d[0], d[1]); pk.y = pk2(d[2], d[3]); *(LAS u32x2*)(Sc + (16 * ti + fr) * LQ + 16 * sj + 4 * fq) = pk; }
        }
    }
    lds_barrier();
    {
        bf16x8 vt[2];
#pragma unroll
        for (int ks = 0; ks < 2; ++ks) vt[ks] = *(const LAS bf16x8*)(VT + (16 * w + fr) * LQ + 32 * ks + 8 * fq);
#pragma unroll
        for (int ti = 0; ti < 4; ++ti) {
            f32x4 d = (f32x4){0.f, 0.f, 0.f, 0.f};
#pragma unroll
            for (int ks = 0; ks < 2; ++ks) { const bf16x8 sc = *(const LAS bf16x8*)(Sc + (16 * ti + fr) * LQ + 32 * ks + 8 * fq); d = __builtin_amdgcn_mfma_f32_16x16x32_bf16(vt[ks], sc, d, 0, 0, 0); }
            st_bf4(UO + (grow + 16 * ti + fr) * 512 + h * 128 + 16 * w + 4 * fq, d);
        }
#pragma unroll
        for (int kj = 0; kj < 4; ++kj) {
            f32x4 d = (f32x4){0.f, 0.f, 0.f, 0.f};
#pragma unroll
            for (int ks = 0; ks < 2; ++ks) { const bf16x8 kk = *(const LAS bf16x8*)(KtT + (16 * kj + fr) * LQ + 32 * ks + 8 * fq); d = __builtin_amdgcn_mfma_f32_16x16x32_bf16(kk, vt[ks], d, 0, 0, 0); }
            st_bf4(DS + (16 * w + fr) * 64 + 16 * kj + 4 * fq, d);
        }
        if (ML) {
            if (w < 4) {
                f32x4 d = (f32x4){0.f, 0.f, 0.f, 0.f};
#pragma unroll
                for (int ks = 0; ks < 2; ++ks) { const bf16x8 a = *(const LAS bf16x8*)(VT + (128 + fr) * LQ + 32 * ks + 8 * fq), sc = *(const LAS bf16x8*)(Sc + (16 * w + fr) * LQ + 32 * ks + 8 * fq);
                    d = __builtin_amdgcn_mfma_f32_16x16x32_bf16(a, sc, d, 0, 0, 0); }
                if (fq == 0) ((float*)(c.ws + WS_DN))[(grow + 16 * w + fr) * 4 + h] = d[0];
            } else {
                const int kj = w - 4;
                f32x4 d = (f32x4){0.f, 0.f, 0.f, 0.f};
#pragma unroll
                for (int ks = 0; ks < 2; ++ks) { const bf16x8 kk = *(const LAS bf16x8*)(KtT + (16 * kj + fr) * LQ + 32 * ks + 8 * fq), a = *(const LAS bf16x8*)(VT + (128 + fr) * LQ + 32 * ks + 8 * fq);
                    d = __builtin_amdgcn_mfma_f32_16x16x32_bf16(kk, a, d, 0, 0, 0); }
                st_bf4(DS + (128 + fr) * 64 + 16 * kj + 4 * fq, d);
            }
        }
    }
    }
#undef SA_LOAD
}
__device__ __forceinline__ void scanB(const Ctx& c) {
    const int gt = c.bid * NTHR + c.tid, NGT = c.nblk * NTHR;
    constexpr int NG = 64 * 128 * 8, NM = 64 * 128 * 8;
    for (int idx = gt; idx < NG + NM; idx += NGT) {
        float S[8];
#pragma unroll
        for (int i = 0; i < 8; ++i) S[i] = 0.f;
        if (idx < NG) {
            const int seq = idx >> 10, v = (idx >> 3) & 127, kg = idx & 7;
            bf16* p = (bf16*)(c.ws + WS_DSG) + (size_t)seq * 32 * 8192 + v * 64 + kg * 8;
            const float* et = (const float*)(c.ws + WS_ET) + (size_t)seq * 32 * 64 + kg * 8;
#pragma unroll 1
            for (int c4 = 0; c4 < 32; c4 += 8) {
                u32x4 dv[8]; f32x4 e0[8], e1[8];
#pragma unroll
                for (int j = 0; j < 8; ++j) { dv[j] = *(const u32x4*)(p + (size_t)(c4 + j) * 8192); e0[j] = *(const f32x4*)(et + (c4 + j) * 64); e1[j] = *(const f32x4*)(et + (c4 + j) * 64 + 4); }
#pragma unroll
                for (int j = 0; j < 8; ++j) {
                    float d[8]; unpack8(dv[j], d);
                    const u32x4 sp = pack8(S);
                    S[0] = e0[j][0] * (S[0] + d[0]); S[1] = e0[j][1] * (S[1] + d[1]); S[2] = e0[j][2] * (S[2] + d[2]); S[3] = e0[j][3] * (S[3] + d[3]);
                    S[4] = e1[j][0] * (S[4] + d[4]); S[5] = e1[j][1] * (S[5] + d[5]); S[6] = e1[j][2] * (S[6] + d[6]); S[7] = e1[j][3] * (S[7] + d[7]);
                    *(u32x4*)(p + (size_t)(c4 + j) * 8192) = sp;
                }
            }
        } else {
            const int j0 = idx - NG, seq = j0 >> 10, v = (j0 >> 3) & 127, kg = j0 & 7;
            const bool nrow = v == 0;
            bf16* p = (bf16*)(c.ws + WS_DSM) + (size_t)seq * 32 * 9216 + v * 64 + kg * 8;
            bf16* pn = (bf16*)(c.ws + WS_DSM) + (size_t)seq * 32 * 9216 + 128 * 64 + kg * 8;
            const float* ct = (const float*)(c.ws + WS_CT) + (size_t)seq * 32 * 2;
            float* mp = (float*)(c.ws + WS_MP) + (size_t)seq * 32;
            float m = 0.f, N[8];
#pragma unroll
            for (int i = 0; i < 8; ++i) N[i] = 0.f;
#pragma unroll 1
            for (int c4 = 0; c4 < 32; c4 += 8) {
                u32x4 dv[8], nv[8]; f32x2 cc[8];
#pragma unroll
                for (int j = 0; j < 8; ++j) { dv[j] = *(const u32x4*)(p + (size_t)(c4 + j) * 9216); cc[j] = *(const f32x2*)(ct + (c4 + j) * 2); nv[j] = nrow ? *(const u32x4*)(pn + (size_t)(c4 + j) * 9216) : (u32x4){0u, 0u, 0u, 0u}; }
#pragma unroll
                for (int j = 0; j < 8; ++j) {
                    float d[8]; unpack8(dv[j], d);
                    const float M63 = fmaxf(m, cc[j][1]), wc = __expf(m - M63), ws = __expf(cc[j][1] - M63);
                    const u32x4 sp = pack8(S);
                    if (nrow && kg == 0) mp[c4 + j] = m;
#pragma unroll
                    for (int i = 0; i < 8; ++i) S[i] = wc * S[i] + ws * d[i];
                    *(u32x4*)(p + (size_t)(c4 + j) * 9216) = sp;
                    if (nrow) { float dnv[8]; unpack8(nv[j], dnv); const u32x4 np = pack8(N);
#pragma unroll
                        for (int i = 0; i < 8; ++i) N[i] = wc * N[i] + ws * dnv[i];
                        *(u32x4*)(pn + (size_t)(c4 + j) * 9216) = np; }
                    m = cc[j][0] + M63;
                }
            }
        }
    }
}
template <bool ML>
__device__ __forceinline__ void scanC_wave(const Ctx& c, int l, int b, int h, int cch) {
    const int lane = c.lane, fr = lane & 15, fq = lane >> 4;
    const bf16* PB = (const bf16*)(c.ws + WS_PB);
    bf16* UO = (bf16*)(c.ws + (ML ? WS_UC : WS_UA));
    const bf16* QS = (const bf16*)(c.ws + WS_QS) + (ML ? (size_t)T * 256 : 0);
    const int slot = (b * 4 + h) * 32 + cch;
    const bf16* SP = ML ? (const bf16*)(c.ws + WS_DSM) + (size_t)slot * 144 * 64 : (const bf16*)(c.ws + WS_DSG) + (size_t)slot * 128 * 64;
    const int GCOL = (ML ? PB_OC : PB_GA) + h * 128;
    const float* gnorm = c.in[ML ? IN_ML_NORM : IN_GLA_NORM] + l * 512 + h * 128;
    const size_t trow0 = (size_t)b * SEQ + (size_t)cch * 64 + fr;
    bf16x8 sf[8][2], nf[2];
#pragma unroll
    for (int n = 0; n < 8; ++n)
#pragma unroll
        for (int ks = 0; ks < 2; ++ks) sf[n][ks] = *(const bf16x8*)(SP + (16 * n + fr) * 64 + 32 * ks + 8 * fq);
    if (ML) {
#pragma unroll
        for (int ks = 0; ks < 2; ++ks) nf[ks] = *(const bf16x8*)(SP + (128 + fr) * 64 + 32 * ks + 8 * fq); }
    const float m_prev = ML ? ((const float*)(c.ws + WS_MP))[slot] : 0.f;
    bf16x8 qf[2], qfn[2]; u32x2 gate[8], oi[8], oin[8]; float sc4[4] = {0.f, 0.f, 0.f, 0.f}, sc4n[4] = {0.f, 0.f, 0.f, 0.f};
#define SCC_LOAD(ti_, QF, OI, SC) do { const size_t _tr = trow0 + 16 * (ti_); \
        _Pragma("unroll") for (int ks = 0; ks < 2; ++ks) QF[ks] = *(const bf16x8*)(QS + _tr * 256 + h * 64 + 32 * ks + 8 * fq); \
        _Pragma("unroll") for (int n = 0; n < 8; ++n) OI[n] = *(const u32x2*)(UO + _tr * 512 + h * 128 + 16 * n + 4 * fq); \
        if (ML) { SC[0] = ((const float*)(c.ws + WS_GPM))[_tr * 4 + h]; SC[1] = ((const float*)(c.ws + WS_GBC))[_tr * 4 + h]; SC[2] = ((const float*)(c.ws + WS_DN))[_tr * 4 + h]; } } while (0)
    SCC_LOAD(0, qf, oi, sc4);
#pragma unroll 1
    for (int ti = 0; ti < 4; ++ti) {
        int lz; asm volatile("v_mov_b32 %0, 0" : "=v"(lz));
        const size_t trow = trow0 + 16 * ti;
#pragma unroll
        for (int n = 0; n < 8; ++n) gate[n] = *(const u32x2*)(PB + trow * NPB + GCOL + 16 * n + 4 * fq);
        if (ti + 1 < 4) SCC_LOAD(ti + 1, qfn, oin, sc4n);
        float e_in = 1.f, e_st = 1.f, dd = 1.f;
        if (ML) {
            const float pm = sc4[0], bc = sc4[1], dni = sc4[2];
            const float Mt = fmaxf(m_prev, pm); e_in = __expf(pm - Mt); e_st = __expf(m_prev - Mt);
            f32x4 d = (f32x4){0.f, 0.f, 0.f, 0.f};
#pragma unroll
            for (int ks = 0; ks < 2; ++ks) d = __builtin_amdgcn_mfma_f32_16x16x32_bf16(nf[ks], qf[ks], d, 0, 0, 0);
            const float dst = __shfl(d[0], fr);
            const float den = dni * e_in + dst * e_st;
            dd = 1.f / fmaxf(fabsf(den), __expf(-(bc + Mt)));
        }
        f32x4 o[8]; float ss = 0.f;
#pragma unroll
        for (int n = 0; n < 8; ++n) {
            f32x4 d = (f32x4){0.f, 0.f, 0.f, 0.f};
#pragma unroll
            for (int ks = 0; ks < 2; ++ks) d = __builtin_amdgcn_mfma_f32_16x16x32_bf16(sf[n][ks], qf[ks], d, 0, 0, 0);
            const f32x4 oiv = (f32x4){bflo(oi[n].x), bfhi(oi[n].x), bflo(oi[n].y), bfhi(oi[n].y)};
            o[n] = ML ? oiv * e_in + d * e_st : oiv + d;
            ss += o[n][0] * o[n][0] + o[n][1] * o[n][1] + o[n][2] * o[n][2] + o[n][3] * o[n][3];
        }
        ss += __shfl_xor(ss, 16); ss += __shfl_xor(ss, 32);
        const float rstd = rsqrtf(ss * dd * dd * (1.f / 128.f) + EPS) * dd;
#pragma unroll
        for (int n = 0; n < 8; ++n) {
            const f32x4 gn = *(const f32x4*)(gnorm + lz + 16 * n + 4 * fq);
            const float g0 = bflo(gate[n].x), g1 = bfhi(gate[n].x), g2 = bflo(gate[n].y), g3 = bfhi(gate[n].y);
            f32x4 r;
            if (ML) { r[0] = o[n][0] * rstd * gn[0] * sigmoidf_(g0); r[1] = o[n][1] * rstd * gn[1] * sigmoidf_(g1); r[2] = o[n][2] * rstd * gn[2] * sigmoidf_(g2); r[3] = o[n][3] * rstd * gn[3] * sigmoidf_(g3); }
            else { r[0] = o[n][0] * rstd * gn[0] * siluf_(g0); r[1] = o[n][1] * rstd * gn[1] * siluf_(g1); r[2] = o[n][2] * rstd * gn[2] * siluf_(g2); r[3] = o[n][3] * rstd * gn[3] * siluf_(g3); }
            st_bf4(UO + trow * 512 + h * 128 + 16 * n + 4 * fq, r);
        }
        if (ti + 1 < 4) {
#pragma unroll
            for (int ks = 0; ks < 2; ++ks) qf[ks] = qfn[ks];
#pragma unroll
            for (int n = 0; n < 8; ++n) oi[n] = oin[n];
#pragma unroll
            for (int i = 0; i < 4; ++i) sc4[i] = sc4n[i];
        }
    }
#undef SCC_LOAD
}
__device__ __forceinline__ void phase_scanA(const Ctx& c, int l) {
    const int nG = c.bid < 2048 ? (2048 - c.bid + c.nblk - 1) / c.nblk : 0;
    const int firstM = c.bid + nG * c.nblk;
    scanA_loop<false>(c, l, c.bid, 2048, c.nblk);
    scanA_loop<true>(c, l, firstM, 4096, c.nblk);
    __syncthreads();
}
__device__ __forceinline__ void phase_scanC(const Ctx& c, int l) {
    const int gw = c.bid * NWAVES + c.wave, NGW = c.nblk * NWAVES;
#pragma unroll 1
    for (int it = gw; it < 4096; it += NGW) { const int br = it >> 11, rem = it & 2047, seq = rem >> 5, cch = rem & 31;
        if (br == 0) scanC_wave<false>(c, l, seq >> 2, seq & 3, cch); else scanC_wave<true>(c, l, seq >> 2, seq & 3, cch); }
}
__device__ __forceinline__ void phase_scans(const Ctx& c, int l) {
    for (int it = c.bid; it < 128; it += c.nblk) {
#if SCAN_RECURRENT
        if (it < 64) scan_gla_item(c, l, it >> 2, it & 3);
        else scan_mlstm_item(c, l, (it - 64) >> 2, (it - 64) & 3);
#else
        if (it < 64) scan_chunked_item<false>(c, l, it >> 2, it & 3);
        else scan_chunked_item<true>(c, l, (it - 64) >> 2, (it - 64) & 3);
#endif
    }
}

__device__ __forceinline__ unsigned ord_key(float f) { const unsigned u = __builtin_bit_cast(unsigned, f); return (u & 0x80000000u) ? ~u : (u | 0x80000000u); }
__device__ __forceinline__ void phase_dsa(const Ctx& c, int l) {
    LAS unsigned char* wl = c.lds + c.wave * 14336;
    LAS float* I_s = (LAS float*)wl;
    LAS int* list = (LAS int*)(wl + 8192);
    LAS float* qi_s = (LAS float*)(wl + 9216);
    LAS float* ql_s = (LAS float*)(wl + 10240);
    const bf16* QLAT = (const bf16*)(c.ws + WS_QLAT); const bf16* QIDX = (const bf16*)(c.ws + WS_QIDX);
    const bf16* CKVN = (const bf16*)(c.ws + WS_CKVN); const float* SM = (const float*)(c.ws + WS_SM);
    bf16* OLAT = (bf16*)(c.ws + WS_OLAT);
    const int gw = c.bid * NWAVES + c.wave, NGW = c.nblk * NWAVES, lane = c.lane;
    for (int tq = gw; tq < T; tq += NGW) {
        const int b = tq >> 11, pos = tq & 2047, nvalid = pos + 1;
        const size_t kb = (size_t)b * SEQ;
        { const f32x4 q = ld_bf4(QIDX + (size_t)tq * 256 + 4 * lane); *(LAS f32x4*)(qi_s + 4 * lane) = q;
#pragma unroll
          for (int j = 0; j < 4; ++j) { const f32x4 ql = ld_bf4(QLAT + (size_t)tq * 1024 + 4 * (lane + 64 * j)); *(LAS f32x4*)(ql_s + 4 * (lane + 64 * j)) = ql; } }
        float wh[8];
#pragma unroll
        for (int hh = 0; hh < 8; ++hh) wh[hh] = SM[(size_t)tq * 128 + SM_WIDX + hh] * 0.35355339059327373f;
        asm volatile("s_waitcnt lgkmcnt(0)" ::: "memory");
        int nsel;
        if (nvalid <= DSA_K) {
            for (int i = lane; i < DSA_K; i += 64) list[i] = i;
            nsel = nvalid;
        } else {
            const int nj = (nvalid + 63) >> 6;
            for (int j = 0; j < nj; ++j) {
                const int s = lane + 64 * j;
                float val = -INFINITY;
                if (s < nvalid) {
                    const float* kr = SM + (kb + s) * 128 + SM_KIDX;
                    f32x4 kk[8];
#pragma unroll
                    for (int i = 0; i < 8; ++i) kk[i] = *(const f32x4*)(kr + 4 * i);
                    val = 0.f;
#pragma unroll
                    for (int hh = 0; hh < 8; ++hh) { float d = 0.f;
#pragma unroll
                        for (int i = 0; i < 8; ++i) { const f32x4 q = *(const LAS f32x4*)(qi_s + hh * 32 + 4 * i); d += q[0] * kk[i][0] + q[1] * kk[i][1] + q[2] * kk[i][2] + q[3] * kk[i][3]; }
                        val += wh[hh] * fmaxf(d, 0.f); }
                }
                I_s[s] = val;
            }
            for (int j = nj; j < 32; ++j) I_s[lane + 64 * j] = -INFINITY;
            asm volatile("s_waitcnt lgkmcnt(0)" ::: "memory");
            LAS unsigned* K_s = (LAS unsigned*)I_s;
#pragma unroll 4
            for (int j = 0; j < 32; ++j) K_s[lane + 64 * j] = ord_key(I_s[lane + 64 * j]);
            unsigned thr = 0u;
#pragma unroll 1
            for (int bit = 31; bit >= 0; --bit) {
                const unsigned cand = thr | (1u << bit); int cnt = 0;
#pragma unroll 8
                for (int j = 0; j < 32; ++j) cnt += (K_s[lane + 64 * j] >= cand) ? 1 : 0;
                cnt = wave_sum_i(cnt);
                if (cnt >= DSA_K) thr = cand;
            }
            int cgt = 0;
#pragma unroll 8
            for (int j = 0; j < 32; ++j) cgt += (K_s[lane + 64 * j] > thr) ? 1 : 0;
            cgt = wave_sum_i(cgt);
            int need = DSA_K - cgt, base = 0;
            const unsigned long long lt = (1ull << lane) - 1ull;
#pragma unroll 2
            for (int j = 0; j < 32; ++j) {
                const unsigned kj = K_s[lane + 64 * j];
                const bool gt = kj > thr, eq = kj == thr;
                const unsigned long long meq = __ballot(eq);
                const int rk = __popcll(meq & lt);
                const bool sel = gt || (eq && rk < need);
                need -= __popcll(meq); if (need < 0) need = 0;
                const unsigned long long ms = __ballot(sel);
                if (sel) list[base + __popcll(ms & lt)] = lane + 64 * j;
                base += __popcll(ms);
            }
            nsel = DSA_K;
        }
        asm volatile("s_waitcnt lgkmcnt(0)" ::: "memory");
        int ks[4]; float lg[4][8];
#pragma unroll
        for (int i = 0; i < 4; ++i) { const int li = lane + 64 * i; ks[i] = (li < nsel) ? list[li] : 0;
#pragma unroll
            for (int hh = 0; hh < 8; ++hh) lg[i][hh] = 0.f; }
#pragma unroll 1
        for (int ch = 0; ch < 16; ++ch) {
            f32x4 ka[4], kc[4];
#pragma unroll
            for (int i = 0; i < 4; ++i) { const u32x4 w = *(const u32x4*)(CKVN + (kb + ks[i]) * 128 + ch * 8);
                ka[i] = (f32x4){bflo(w.x), bfhi(w.x), bflo(w.y), bfhi(w.y)}; kc[i] = (f32x4){bflo(w.z), bfhi(w.z), bflo(w.w), bfhi(w.w)}; }
#pragma unroll
            for (int hh = 0; hh < 8; ++hh) { const f32x4 qa = *(const LAS f32x4*)(ql_s + hh * 128 + ch * 8), qb = *(const LAS f32x4*)(ql_s + hh * 128 + ch * 8 + 4);
#pragma unroll
                for (int i = 0; i < 4; ++i) lg[i][hh] += qa[0] * ka[i][0] + qa[1] * ka[i][1] + qa[2] * ka[i][2] + qa[3] * ka[i][3] + qb[0] * kc[i][0] + qb[1] * kc[i][1] + qb[2] * kc[i][2] + qb[3] * kc[i][3]; }
        }
#pragma unroll
        for (int hh = 0; hh < 8; ++hh) {
            const float slope = exp2f(-(float)(hh + 1));
            float mx = -INFINITY;
#pragma unroll
            for (int i = 0; i < 4; ++i) { const bool ok = (lane + 64 * i) < nsel; lg[i][hh] = ok ? lg[i][hh] - slope * (float)(pos - ks[i]) : -INFINITY; mx = fmaxf(mx, lg[i][hh]); }
            mx = wave_max(mx);
            float sm = 0.f;
#pragma unroll
            for (int i = 0; i < 4; ++i) { lg[i][hh] = __expf(lg[i][hh] - mx); sm += lg[i][hh]; }
            sm = wave_sum(sm);
            const float inv = 1.f / sm;
#pragma unroll
            for (int i = 0; i < 4; ++i) lg[i][hh] *= inv;
        }
#pragma unroll
        for (int i = 0; i < 4; ++i) { const int li = lane + 64 * i;
            *(LAS f32x4*)(I_s + li * 8) = (f32x4){lg[i][0], lg[i][1], lg[i][2], lg[i][3]}; *(LAS f32x4*)(I_s + li * 8 + 4) = (f32x4){lg[i][4], lg[i][5], lg[i][6], lg[i][7]}; }
        asm volatile("s_waitcnt lgkmcnt(0)" ::: "memory");
        float o0[8], o1[8];
#pragma unroll
        for (int hh = 0; hh < 8; ++hh) { o0[hh] = 0.f; o1[hh] = 0.f; }
#pragma unroll 2
        for (int kidx = 0; kidx < nsel; ++kidx) {
            const int s = list[kidx];
            const unsigned w = *(const unsigned*)(CKVN + (kb + s) * 128 + 2 * lane);
            const float v0 = bflo(w), v1 = bfhi(w);
            const f32x4 pa = *(const LAS f32x4*)(I_s + kidx * 8), pb = *(const LAS f32x4*)(I_s + kidx * 8 + 4);
            o0[0] += pa[0] * v0; o1[0] += pa[0] * v1; o0[1] += pa[1] * v0; o1[1] += pa[1] * v1; o0[2] += pa[2] * v0; o1[2] += pa[2] * v1; o0[3] += pa[3] * v0; o1[3] += pa[3] * v1;
            o0[4] += pb[0] * v0; o1[4] += pb[0] * v1; o0[5] += pb[1] * v0; o1[5] += pb[1] * v1; o0[6] += pb[2] * v0; o1[6] += pb[2] * v1; o0[7] += pb[3] * v0; o1[7] += pb[3] * v1;
        }
#pragma unroll
        for (int hh = 0; hh < 8; ++hh) *(unsigned*)(OLAT + (size_t)tq * 1024 + hh * 128 + 2 * lane) = pk2(o0[hh], o1[hh]);
        asm volatile("s_waitcnt lgkmcnt(0)" ::: "memory");
    }
}


__device__ __forceinline__ int half_sum(int v) {
    v += __builtin_amdgcn_update_dpp(0, v, 0xB1, 0xF, 0xF, false);
    v += __builtin_amdgcn_update_dpp(0, v, 0x4E, 0xF, 0xF, false);
    v += __builtin_amdgcn_update_dpp(0, v, 0x141, 0xF, 0xF, false);
    v += __builtin_amdgcn_update_dpp(0, v, 0x140, 0xF, 0xF, false);
    v += __shfl_xor(v, 16);
    return v;
}
typedef float f32x16 __attribute__((ext_vector_type(16)));
__device__ __forceinline__ void phase_dsa_sel(const Ctx& c, int l) {
    const bf16* QIDX = (const bf16*)(c.ws + WS_QIDX); const bf16* KIDX = (const bf16*)(c.ws + WS_KIDX); const float* SM = (const float*)(c.ws + WS_SM);
    unsigned* MASK = (unsigned*)(c.ws + WS_MASK);
    const int lane = c.lane, hf = lane >> 5, l31 = lane & 31;
    const int rho = l31, tl = 2 * ((rho >> 2) & 1) + (rho >> 4), hd = (rho & 3) + 4 * ((rho >> 3) & 1);
    const unsigned ltmask = (1u << l31) - 1u;
    LAS unsigned* KL = (LAS unsigned*)(c.lds + c.wave * 16384);
    LAS unsigned* MW = (LAS unsigned*)(c.lds + 131072 + c.wave * 512);
    unsigned* KEYB = (unsigned*)(c.ws + WS_KEYB) + (size_t)(c.bid * NWAVES + c.wave) * 4096;
    const int npass = (c.nblk == 256) ? 2 : (T / 64 + c.nblk - 1) / c.nblk;
#pragma unroll 1
    for (int ps = 0; ps < npass; ++ps) {
        int b, q64;
        if (c.nblk == 256) { b = c.bid & 15; q64 = ps == 0 ? 31 - (c.bid >> 4) : (c.bid >> 4); }
        else { const int it = c.bid + ps * c.nblk; if (it >= T / 64) break; b = it >> 5; q64 = it & 31; }
        const int pb = q64 * 64;
#pragma unroll 1
        for (int wi = 0; wi < 2; ++wi) {
        const int pos0 = pb + 8 * c.wave + 4 * wi, t0 = b * SEQ + pos0;
        unsigned wA0 = 0u, wB0 = 0u, wA1 = 0u, wB1 = 0u;
        if (pos0 + 3 < DSA_K) {
            const int p_0 = pos0 + 2 * hf, p_1 = p_0 + 1;
            { const int lo = 32 * l31; wA0 = p_0 >= lo + 31 ? 0xffffffffu : (p_0 < lo ? 0u : ((2u << (p_0 - lo)) - 1u)); wA1 = p_1 >= lo + 31 ? 0xffffffffu : (p_1 < lo ? 0u : ((2u << (p_1 - lo)) - 1u)); }
        } else {
            const int ng = ((pos0 + 3) / 32 + 4) / 4, nkt = 4 * ng;
            bf16x8 af[2];
#pragma unroll
            for (int ks = 0; ks < 2; ++ks) af[ks] = *(const bf16x8*)(QIDX + (size_t)(t0 + tl) * 256 + hd * 32 + 16 * ks + 8 * hf);
            const bf16* kbase = KIDX + ((size_t)b * SEQ + l31) * 32 + 8 * hf;
#pragma unroll 1
            for (int tsel = 0; tsel < 2; ++tsel) {
                const int p_t = pos0 + 2 * hf + tsel;
                if (tsel == 0) {
                    float whv[16];
#pragma unroll
                    for (int r = 0; r < 16; ++r) whv[r] = SM[(size_t)(t0 + 2 * hf + (r >> 3)) * 128 + SM_WIDX + (r & 7)] * 0.35355339059327373f;
                    bf16x8 bq[4][2], bn[4][2];
#pragma unroll
                    for (int j = 0; j < 4; ++j) { bq[j][0] = *(const bf16x8*)(kbase + (size_t)(32 * j) * 32); bq[j][1] = *(const bf16x8*)(kbase + (size_t)(32 * j) * 32 + 16); }
#pragma unroll 1
                    for (int g = 0; g < ng; ++g) {
                        const int gn = (g + 1 < ng) ? g + 1 : g;
#pragma unroll
                        for (int j = 0; j < 4; ++j) { bn[j][0] = *(const bf16x8*)(kbase + (size_t)(32 * (4 * gn + j)) * 32); bn[j][1] = *(const bf16x8*)(kbase + (size_t)(32 * (4 * gn + j)) * 32 + 16); }
                        u32x4 ka, kb;
#pragma unroll
                        for (int j = 0; j < 4; ++j) {
                            f32x16 d;
#pragma unroll
                            for (int r = 0; r < 16; ++r) d[r] = 0.f;
                            d = __builtin_amdgcn_mfma_f32_32x32x16_bf16(af[0], bq[j][0], d, 0, 0, 0);
                            d = __builtin_amdgcn_mfma_f32_32x32x16_bf16(af[1], bq[j][1], d, 0, 0, 0);
                            float iv0 = 0.f, iv1 = 0.f;
#pragma unroll
                            for (int r = 0; r < 8; ++r) { iv0 += whv[r] * fmaxf(d[r], 0.f); iv1 += whv[8 + r] * fmaxf(d[8 + r], 0.f); }
                            const int row = 32 * (4 * g + j) + l31;
                            ka[j] = row <= p_t ? ord_key(iv0) : 0u; kb[j] = row <= p_t + 1 ? ord_key(iv1) : 0u;
                        }
                        *(LAS u32x4*)(KL + (g * 64 + lane) * 4) = ka;
                        *(u32x4*)(KEYB + ((size_t)g * 64 + lane) * 4) = kb;
#pragma unroll
                        for (int j = 0; j < 4; ++j) { bq[j][0] = bn[j][0]; bq[j][1] = bn[j][1]; }
                    }
                } else {
#pragma unroll 4
                    for (int g = 0; g < ng; ++g) *(LAS u32x4*)(KL + (g * 64 + lane) * 4) = __builtin_nontemporal_load((const u32x4*)(KEYB + ((size_t)g * 64 + lane) * 4));
                }
                unsigned thr = 0u; bool done = false, alld = false;
#pragma unroll 1
                for (int bit = 31; bit >= 0 && !alld; --bit) {
                    const unsigned cand = thr | (1u << bit); int cn = 0;
#pragma unroll 4
                    for (int g = 0; g < ng; ++g) { const u32x4 k4 = *(const LAS u32x4*)(KL + (g * 64 + lane) * 4);
                        cn += (k4.x >= cand ? 1 : 0) + (k4.y >= cand ? 1 : 0) + (k4.z >= cand ? 1 : 0) + (k4.w >= cand ? 1 : 0); }
                    cn = half_sum(cn);
                    if (!done && cn >= DSA_K) thr = cand;
                    done = done || cn == DSA_K;
                    alld = __ballot(!done) == 0ull;
                }
                const bool dlo = alld, dhi = alld;
                MW[lane] = 0u; MW[64 + lane] = 0u;
                if (dlo && dhi) {
#pragma unroll 4
                    for (int kt = 0; kt < nkt; ++kt) { const unsigned long long ms = __ballot(KL[((kt >> 2) * 64 + lane) * 4 + (kt & 3)] >= thr);
                        if (l31 == 0) MW[hf * 64 + kt] = hf ? (unsigned)(ms >> 32) : (unsigned)ms; }
                } else {
                int glo = 0, ghi = 0;
#pragma unroll 16
                for (int kt = 0; kt < nkt; ++kt) { const unsigned long long m = __ballot(KL[((kt >> 2) * 64 + lane) * 4 + (kt & 3)] > thr); glo += __popc((unsigned)m); ghi += __popc((unsigned)(m >> 32)); }
                int nlo = DSA_K - glo, nhi = DSA_K - ghi;
#pragma unroll 2
                for (int kt = 0; kt < nkt; ++kt) {
                    const unsigned kv = KL[((kt >> 2) * 64 + lane) * 4 + (kt & 3)];
                    const bool gt = kv > thr, eq = kv == thr;
                    const unsigned long long meq = __ballot(eq); const unsigned mh = hf ? (unsigned)(meq >> 32) : (unsigned)meq;
                    const int need = hf ? nhi : nlo;
                    const bool sel = gt || (eq && (__popc(mh & ltmask) < need));
                    nlo -= __popc((unsigned)meq); nhi -= __popc((unsigned)(meq >> 32)); nlo = nlo < 0 ? 0 : nlo; nhi = nhi < 0 ? 0 : nhi;
                    const unsigned long long ms = __ballot(sel);
                    if (l31 == 0) MW[hf * 64 + kt] = hf ? (unsigned)(ms >> 32) : (unsigned)ms;
                }
                }
                const unsigned wA = MW[hf * 64 + l31], wB = MW[hf * 64 + 32 + l31];
                if (tsel == 0) { wA0 = wA; wB0 = wB; } else { wA1 = wA; wB1 = wB; }
            }
        }
        unsigned* m0 = MASK + (size_t)(t0 + 2 * hf) * 64;
        m0[l31] = wA0; m0[32 + l31] = wB0; m0[64 + l31] = wA1; m0[96 + l31] = wB1;
        }
    }
    __syncthreads();
}

constexpr int AT_STAGE = 32768;
__device__ __forceinline__ void phase_dsa_att(const Ctx& c, int l) {
    const bf16* QLAT = (const bf16*)(c.ws + WS_QLAT); const bf16* CKVN = (const bf16*)(c.ws + WS_CKVN); const bf16* CKVT = (const bf16*)(c.ws + WS_CKVT);
    const unsigned* MASK = (const unsigned*)(c.ws + WS_MASK); bf16* OLAT = (bf16*)(c.ws + WS_OLAT);
    const int tid = c.tid, lane = c.lane, h = c.wave, fr = lane & 15, fq = lane >> 4;
    const float slope2 = exp2f(-(float)(h + 1)) * 1.4426950408889634f;
    const int dn_r = tid >> 4, dn_c = ((tid & 15) ^ ((tid >> 4) & 15)) * 8;
    const int dt_r = tid >> 3, dt_c = ((tid & 7) ^ ((tid >> 3) & 7)) * 8;
    const unsigned ldsw = (unsigned)h * 1024u;
#pragma unroll 1
    for (int k4 = 0; k4 < 1024; ++k4) {
        const int idx = c.bid + c.nblk * k4; if (idx >= 1024) break;
        const int b = idx & 15, g = idx >> 4, gk = g >> 4, gi = g & 15;
        const int qt = 63 - 16 * gk - ((gk & 1) ? (15 - gi) : gi);
        const int tq0 = qt * 32;
        const size_t tg0 = (size_t)b * SEQ + tq0;
        const int nkt = (tq0 + 31) / 64 + 1;
        bf16x8 Qf[2][4];
#pragma unroll
        for (int rt = 0; rt < 2; ++rt)
#pragma unroll
            for (int ks = 0; ks < 4; ++ks) Qf[rt][ks] = *(const bf16x8*)(QLAT + (tg0 + 16 * rt + fr) * 1024 + h * 128 + 32 * ks + 8 * fq);
        f32x4 O[2][8];
        float mrun[2], lrun[2];
#pragma unroll
        for (int rt = 0; rt < 2; ++rt) { mrun[rt] = -1e30f; lrun[rt] = 0.f;
#pragma unroll
            for (int n = 0; n < 8; ++n) O[rt][n] = (f32x4){0.f, 0.f, 0.f, 0.f}; }
#define AT_DMA(kt_, stg_) do { const bf16* _kn = CKVN + ((size_t)b * SEQ + 64 * (kt_) + dn_r) * 128 + dn_c; const bf16* _kt = CKVT + (((size_t)b * 32 + (kt_)) * 128 + dt_r) * 64 + dt_c; \
            LAS unsigned char* _d = c.lds + (stg_) * AT_STAGE + ldsw; \
            __builtin_amdgcn_global_load_lds((const unsigned*)_kn, (LAS unsigned*)_d, 16, 0, 0); __builtin_amdgcn_global_load_lds((const unsigned*)(_kn + 32 * 128), (LAS unsigned*)(_d + 8192), 16, 0, 0); \
            __builtin_amdgcn_global_load_lds((const unsigned*)_kt, (LAS unsigned*)(_d + 16384), 16, 0, 0); __builtin_amdgcn_global_load_lds((const unsigned*)(_kt + 64 * 64), (LAS unsigned*)(_d + 16384 + 8192), 16, 0, 0); } while (0)
        __syncthreads();
        AT_DMA(0, 0);
#pragma unroll 1
        for (int kt = 0; kt < nkt; ++kt) {
            u32x2 mw[2];
#pragma unroll
            for (int rt = 0; rt < 2; ++rt) mw[rt] = *(const u32x2*)(MASK + (tg0 + 16 * rt + fr) * 64 + 2 * kt);
            asm volatile("s_waitcnt vmcnt(2)" ::: "memory");
            __builtin_amdgcn_s_barrier(); asm volatile("" ::: "memory");
            if (kt + 1 < nkt) AT_DMA(kt + 1, (kt + 1) & 1);
            int lz; asm volatile("v_mov_b32 %0, 0" : "=v"(lz));
            const LAS unsigned char* Kn = c.lds + (kt & 1) * AT_STAGE + lz; const LAS unsigned char* KT = Kn + 16384;
            const float kb0 = slope2 * (float)(64 * kt + 4 * fq);
            f32x4 S[2][4];
            {
                bf16x8 kfa[4], kfb[4];
#pragma unroll
                for (int ks = 0; ks < 4; ++ks) kfa[ks] = *(const LAS bf16x8*)(Kn + fr * 256 + (((4 * ks + fq) ^ fr) << 4));
#pragma unroll
                for (int j = 0; j < 4; ++j) {
                    if (j + 1 < 4) {
#pragma unroll
                        for (int ks = 0; ks < 4; ++ks) { const bf16x8 t = *(const LAS bf16x8*)(Kn + (16 * (j + 1) + fr) * 256 + (((4 * ks + fq) ^ fr) << 4)); if (j & 1) kfa[ks] = t; else kfb[ks] = t; } }
#pragma unroll
                    for (int rt = 0; rt < 2; ++rt) { f32x4 d = (f32x4){0.f, 0.f, 0.f, 0.f};
#pragma unroll
                        for (int ks = 0; ks < 4; ++ks) d = __builtin_amdgcn_mfma_f32_16x16x32_bf16((j & 1) ? kfb[ks] : kfa[ks], Qf[rt][ks], d, 0, 0, 0);
                        S[rt][j] = d; }
                    __builtin_amdgcn_sched_barrier(0);
                }
            }
            bf16x8 Pf[2][2];
#pragma unroll
            for (int rt = 0; rt < 2; ++rt) {
                float mx = -1e30f;
#pragma unroll
                for (int j = 0; j < 4; ++j) { const unsigned wsel = ((j < 2) ? mw[rt].x : mw[rt].y) >> (4 * fq);
#pragma unroll
                    for (int r = 0; r < 4; ++r) { const bool on = wsel & (1u << (16 * (j & 1) + r));
                        const float v = S[rt][j][r] + fmaf(slope2, (float)(16 * j + r), kb0);
                        S[rt][j][r] = on ? v : -INFINITY; mx = fmaxf(mx, S[rt][j][r]); } }
                mx = fmaxf(mx, __shfl_xor(mx, 16)); mx = fmaxf(mx, __shfl_xor(mx, 32));
                const float mnew = fmaxf(mrun[rt], mx);
                const float alpha = __builtin_amdgcn_exp2f(mrun[rt] - mnew);
                float rs = 0.f;
#pragma unroll
                for (int j = 0; j < 4; ++j)
#pragma unroll
                    for (int r = 0; r < 4; ++r) { const float p = __builtin_amdgcn_exp2f(S[rt][j][r] - mnew); S[rt][j][r] = p; rs += p; }
                rs += __shfl_xor(rs, 16); rs += __shfl_xor(rs, 32);
                lrun[rt] = lrun[rt] * alpha + rs; mrun[rt] = mnew;
#pragma unroll
                for (int n = 0; n < 8; ++n) O[rt][n] *= alpha;
#pragma unroll
                for (int ks2 = 0; ks2 < 2; ++ks2) { u32x4 w; w.x = pk2(S[rt][2 * ks2][0], S[rt][2 * ks2][1]); w.y = pk2(S[rt][2 * ks2][2], S[rt][2 * ks2][3]);
                    w.z = pk2(S[rt][2 * ks2 + 1][0], S[rt][2 * ks2 + 1][1]); w.w = pk2(S[rt][2 * ks2 + 1][2], S[rt][2 * ks2 + 1][3]);
                    Pf[rt][ks2] = __builtin_bit_cast(bf16x8, w); }
            }
            {
                const int sw = fr & 7;
#pragma unroll
                for (int n = 0; n < 8; ++n) {
#pragma unroll
                    for (int ks2 = 0; ks2 < 2; ++ks2) {
                        const bf16x8 af = *(const LAS bf16x8*)(KT + (16 * n + fr) * 128 + (((4 * ks2 + fq) ^ sw) << 4));
#pragma unroll
                        for (int rt = 0; rt < 2; ++rt) O[rt][n] = __builtin_amdgcn_mfma_f32_16x16x32_bf16(af, Pf[rt][ks2], O[rt][n], 0, 0, 0);
                    }
                    if (n & 1) __builtin_amdgcn_sched_barrier(0);
                }
            }
        }
#undef AT_DMA
        {
            const bf16x8* WF = (const bf16x8*)((const bf16*)(c.ws + WS_WUVF) + (size_t)(l * 8 + h) * 16 * 64 * 8) + lane;
            bf16x8 wf[4][4];
#pragma unroll
            for (int vt = 0; vt < 4; ++vt)
#pragma unroll
                for (int ks = 0; ks < 4; ++ks) wf[vt][ks] = WF[(vt * 4 + ks) * 64];
#pragma unroll
            for (int rt = 0; rt < 2; ++rt) { const float inv = 1.f / lrun[rt];
                bf16x8 of[4];
#pragma unroll
                for (int ks = 0; ks < 4; ++ks) { const f32x4 x0 = O[rt][2 * ks] * inv, x1 = O[rt][2 * ks + 1] * inv;
                    u32x4 w; w.x = pk2(x0[0], x0[1]); w.y = pk2(x0[2], x0[3]); w.z = pk2(x1[0], x1[1]); w.w = pk2(x1[2], x1[3]); of[ks] = __builtin_bit_cast(bf16x8, w); }
#pragma unroll
                for (int vt = 0; vt < 4; ++vt) { f32x4 d = (f32x4){0.f, 0.f, 0.f, 0.f};
#pragma unroll
                    for (int ks = 0; ks < 4; ++ks) d = __builtin_amdgcn_mfma_f32_16x16x32_bf16(wf[vt][ks], of[ks], d, 0, 0, 0);
                    st_bf4(OLAT + (tg0 + 16 * rt + fr) * 512 + h * 64 + 16 * vt + 4 * fq, d); }
            }
        }
    }
    asm volatile("s_waitcnt vmcnt(0)" ::: "memory");
    __syncthreads();
}

__device__ __forceinline__ void tr_item64(const float* W, long ld, bf16* dst, long dst_ld, int n0, int k0, LAS unsigned* scr, int lane) {
    const float* p = W + (long)k0 * ld + n0 + lane;
    float tv[64];
#pragma unroll
    for (int i = 0; i < 64; ++i) tv[i] = __builtin_nontemporal_load(p + (long)i * ld);
#pragma unroll
    for (int i = 0; i < 32; ++i) scr[i * 65 + lane] = pk2(tv[2 * i], tv[2 * i + 1]);
    asm volatile("s_waitcnt lgkmcnt(0)" ::: "memory");
    const int cq = lane & 7, nr = lane >> 3;
#pragma unroll
    for (int jj = 0; jj < 8; ++jj) { const LAS unsigned* sp = scr + (4 * cq) * 65 + nr + 8 * jj;
        u32x4 o; o.x = sp[0]; o.y = sp[65]; o.z = sp[130]; o.w = sp[195];
        *(u32x4*)(dst + (long)(n0 + nr + 8 * jj) * dst_ld + k0 + 8 * cq) = o; }
    asm volatile("s_waitcnt lgkmcnt(0)" ::: "memory");
}
__device__ __forceinline__ void expert_convert(const Ctx& c, int l, int gw, int NGW) {
        LAS unsigned* scr = (LAS unsigned*)(c.lds + c.wave * 16384);
        constexpr int I_GU = (512 / 64) * (1024 / 64), I_D = (1024 / 64) * (256 / 64), PER_E = I_GU + I_D;
        for (int it = gw; it < NEX * PER_E; it += NGW) {
            const int e = it / PER_E; int r = it % PER_E;
            if (r < I_GU) {
                const int n0 = (r / 16) * 64, pn = n0 >> 8, wi = n0 & 255, j0 = 128 * pn + (wi & 127);
                const float* Wg; const float* Wu;
                if (e < NE) { Wg = c.in[IN_EWG] + ((size_t)l * NE + e) * 1024 * 256; Wu = c.in[IN_EWU] + ((size_t)l * NE + e) * 1024 * 256; }
                else { Wg = c.in[IN_SWG] + (size_t)l * 1024 * 256; Wu = c.in[IN_SWU] + (size_t)l * 1024 * 256; }
                if (wi < 128) tr_item64(Wg + j0 - n0, 256, (bf16*)(c.ws + WS_WGU) + (size_t)e * 512 * 1024, 1024, n0, (r % 16) * 64, scr, c.lane);
                else tr_item64(Wu + j0 - n0, 256, (bf16*)(c.ws + WS_WGU) + (size_t)e * 512 * 1024, 1024, n0, (r % 16) * 64, scr, c.lane);
            } else { r -= I_GU;
                const float* Wd = e < NE ? c.in[IN_EWD] + ((size_t)l * NE + e) * 256 * 1024 : c.in[IN_SWD] + (size_t)l * 256 * 1024;
                tr_item64(Wd, 1024, (bf16*)(c.ws + WS_WD) + (size_t)e * 1024 * 256, 256, (r / 4) * 64, (r % 4) * 64, scr, c.lane);
            }
        }
    }
__device__ __forceinline__ unsigned wave_max_u32(unsigned v) {
    v = max(v, (unsigned)__builtin_amdgcn_update_dpp(0, (int)v, 0xB1, 0xF, 0xF, false));
    v = max(v, (unsigned)__builtin_amdgcn_update_dpp(0, (int)v, 0x4E, 0xF, 0xF, false));
    v = max(v, (unsigned)__builtin_amdgcn_update_dpp(0, (int)v, 0x141, 0xF, 0xF, false));
    v = max(v, (unsigned)__builtin_amdgcn_update_dpp(0, (int)v, 0x140, 0xF, 0xF, false));
    const unsigned a = (unsigned)__builtin_amdgcn_readlane((int)v, 0), b = (unsigned)__builtin_amdgcn_readlane((int)v, 16), cc = (unsigned)__builtin_amdgcn_readlane((int)v, 32), d = (unsigned)__builtin_amdgcn_readlane((int)v, 48);
    return max(max(a, b), max(cc, d));
}
__device__ __forceinline__ void route_one(int t, float logit, float rbias, int lane, LAS unsigned* lcnt, LAS unsigned* stash, int ridx) {
    const float score = sigmoid_exact(logit), sel = score + rbias;
    const int g = lane >> 3;
    float m1 = sel, m2 = -INFINITY;
#pragma unroll
    for (int d = 1; d < 8; d <<= 1) { const float o1 = __shfl_xor(m1, d), o2 = __shfl_xor(m2, d);
        const float n1 = fmaxf(m1, o1), n2 = fmaxf(fminf(m1, o1), fmaxf(m2, o2)); m1 = n1; m2 = n2; }
    const float gs = m1 + m2;
    int rkg = 0;
#pragma unroll
    for (int og = 0; og < 8; ++og) { const float o = __builtin_bit_cast(float, __builtin_amdgcn_readlane(__builtin_bit_cast(int, gs), og * 8)); rkg += (o > gs || (o == gs && og < g)) ? 1 : 0; }
    const bool gsel = rkg < 4;
    const float msel = gsel ? sel : -INFINITY;
    const unsigned sb = __builtin_bit_cast(unsigned, sel);
    unsigned key = gsel ? ((sb & 0x80000000u) ? ~sb : (sb | 0x80000000u)) : 0u;
    unsigned long long mk = 0ull; float wsum = 0.f;
#pragma unroll
    for (int r = 0; r < TOPK; ++r) {
        const unsigned m = wave_max_u32(key);
        const unsigned long long eq = __ballot(key == m);
        const int j = __ffsll((long long)eq) - 1;
        mk |= 1ull << j;
        wsum += __builtin_bit_cast(float, __builtin_amdgcn_readlane(__builtin_bit_cast(int, score), j));
        if (lane == j) key = 0u;
    }
    const bool chosen = (mk >> lane) & 1ull;
    if (chosen) {
        const int hf = t >= HALF_T ? 1 : 0;
        const int kk = __popcll(mk & ((1ull << lane) - 1ull));
        const unsigned rank = __hip_atomic_fetch_add(&lcnt[hf * 64 + lane], 1u, __ATOMIC_RELAXED, __HIP_MEMORY_SCOPE_WORKGROUP);
        LAS unsigned* st = stash + (size_t)(ridx * 6 + (kk < TOPK ? kk : 0)) * 4;
        st[0] = (unsigned)t; st[1] = ((unsigned)hf << 24) | ((unsigned)lane << 16) | rank; st[2] = __builtin_bit_cast(unsigned, score / wsum * 2.5f);
    }
}
__device__ __forceinline__ void phase_route(const Ctx& c, int l, const bf16* x1) {
    for (int r2 = 0; r2 < CONV_REP; ++r2) expert_convert(c, l, c.bid * NWAVES + c.wave, c.nblk * NWAVES);
    __syncthreads();
    {
        LAS float* H = (LAS float*)c.lds;
        constexpr int HLD = 1028;
        const int lane = c.lane, w = c.wave;
        const float* MOD = (const float*)(c.ws + WS_MOD) + (size_t)l * 16 * 6144;
        bf16* XN2 = (bf16*)(c.ws + WS_XN2);
        const float* RW = c.in[IN_RW] + (size_t)l * 1024 * 64; const float rbias = c.in[IN_RB][l * 64 + lane];
        unsigned* CNT = (unsigned*)(c.ws + WS_CTL) + CW_CNT + l * 128 * CNT_STRIDE;
        int* ROWL = (int*)(c.ws + WS_ROWL); float* WL = (float*)(c.ws + WS_WL); unsigned* TOKPOS = (unsigned*)(c.ws + WS_TOKPOS);
        const float* gain = c.in[IN_NFFN] + l * D;
        LAS unsigned* lcnt = (LAS unsigned*)(c.lds + 131584);
        LAS unsigned* stash = lcnt + 128;
        constexpr int STASH_ROWS = 128;
        int nrow_done = 0;
        if (c.tid < 128) lcnt[c.tid] = 0u;
        const int fr = lane & 15, fq = lane >> 4;
        bf16x8 W1[4][4], W2[4][4];
#pragma unroll
        for (int kb = 0; kb < 4; ++kb)
#pragma unroll
            for (int et = 0; et < 4; ++et) { float x[8];
#pragma unroll
                for (int i = 0; i < 8; ++i) x[i] = RW[(size_t)(128 * w + 32 * kb + 8 * fq + i) * 64 + 16 * et + fr];
                u32x4 h, lo;
                h.x = pk2(x[0], x[1]); h.y = pk2(x[2], x[3]); h.z = pk2(x[4], x[5]); h.w = pk2(x[6], x[7]);
                lo.x = pk2(x[0] - bflo(h.x), x[1] - bfhi(h.x)); lo.y = pk2(x[2] - bflo(h.y), x[3] - bfhi(h.y)); lo.z = pk2(x[4] - bflo(h.z), x[5] - bfhi(h.z)); lo.w = pk2(x[6] - bflo(h.w), x[7] - bfhi(h.w));
                W1[kb][et] = __builtin_bit_cast(bf16x8, h); W2[kb][et] = __builtin_bit_cast(bf16x8, lo); }
        LAS unsigned char* Hb = c.lds;
        for (int it = c.bid; it < T / 32; it += c.nblk) {
            const int t0 = it * 32, b = t0 >> 11;
            const float* sh = MOD + (size_t)b * 6144 + 3072; const float* sc = MOD + (size_t)b * 6144 + 4096;
            lds_barrier();
#pragma unroll
            for (int r = 0; r < 4; ++r) {
                const int rr = 4 * w + r;
                const bf16* xrow = x1 + (size_t)(t0 + rr) * D;
                f32x4 v[4]; float ssum = 0.f;
#pragma unroll
                for (int j = 0; j < 4; ++j) { v[j] = ld_bf4(xrow + 4 * (lane + 64 * j)); ssum += v[j][0] * v[j][0] + v[j][1] * v[j][1] + v[j][2] * v[j][2] + v[j][3] * v[j][3]; }
                const float rstd = rsqrtf(wave_sum(ssum) * (1.f / D) + EPS);
#pragma unroll
                for (int j = 0; j < 4; ++j) { const int cc = 4 * (lane + 64 * j);
                    const f32x4 g = *(const f32x4*)(gain + cc), a4 = *(const f32x4*)(sc + cc), bb = *(const f32x4*)(sh + cc);
                    const f32x4 hv = v[j] * rstd * g * (a4 + 1.f) + bb;
                    u32x2 h1, h2; h1.x = pk2(hv[0], hv[1]); h1.y = pk2(hv[2], hv[3]);
                    h2.x = pk2(hv[0] - bflo(h1.x), hv[1] - bfhi(h1.x)); h2.y = pk2(hv[2] - bflo(h1.y), hv[3] - bfhi(h1.y));
                    *(u32x2*)(XN2 + (size_t)(t0 + rr) * D + cc) = h1;
                    *(LAS u32x2*)(Hb + rr * 4112 + 2 * cc) = h1; *(LAS u32x2*)(Hb + rr * 4112 + 2048 + 2 * cc) = h2; }
            }
            lds_barrier();
            {
                const LAS unsigned char* hp = Hb + fr * 4112 + 2 * (128 * w + 8 * fq);
                f32x4 acc[2][4];
#pragma unroll
                for (int i = 0; i < 2; ++i)
#pragma unroll
                    for (int et = 0; et < 4; ++et) acc[i][et] = (f32x4){0.f, 0.f, 0.f, 0.f};
#pragma unroll
                for (int kb = 0; kb < 4; ++kb)
#pragma unroll
                    for (int rt = 0; rt < 2; ++rt) {
                        const bf16x8 a1 = *(const LAS bf16x8*)(hp + rt * 16 * 4112 + 64 * kb), a2 = *(const LAS bf16x8*)(hp + rt * 16 * 4112 + 64 * kb + 2048);
#pragma unroll
                        for (int et = 0; et < 4; ++et) {
                            acc[rt][et] = __builtin_amdgcn_mfma_f32_16x16x32_bf16(a2, W1[kb][et], acc[rt][et], 0, 0, 0);
                            acc[rt][et] = __builtin_amdgcn_mfma_f32_16x16x32_bf16(a1, W2[kb][et], acc[rt][et], 0, 0, 0);
                            acc[rt][et] = __builtin_amdgcn_mfma_f32_16x16x32_bf16(a1, W1[kb][et], acc[rt][et], 0, 0, 0);
                        }
                    }
                lds_barrier();
                LAS float* LG = H + w * 2048;
#pragma unroll
                for (int et = 0; et < 4; ++et)
#pragma unroll
                    for (int r = 0; r < 4; ++r) { LG[(4 * fq + r) * 64 + 16 * et + fr] = acc[0][et][r]; LG[(16 + 4 * fq + r) * 64 + 16 * et + fr] = acc[1][et][r]; }
            }
            lds_barrier();
#pragma unroll 1
            for (int r = 0; r < 4; ++r) {
                const int rr = 4 * w + r; float lg = 0.f;
#pragma unroll
                for (int ww = 0; ww < 8; ++ww) lg += H[ww * 2048 + rr * 64 + lane];
                route_one(t0 + rr, lg, rbias, lane, lcnt, stash, nrow_done + rr);
            }
            nrow_done += 32;
            const bool last = it + c.nblk >= T / 32;
            if (nrow_done + 32 > STASH_ROWS || last) {
                __syncthreads();
                if (c.tid < 128) { const unsigned n = lcnt[c.tid]; lcnt[c.tid] = n ? atomicAdd(&CNT[c.tid * CNT_STRIDE], n) : 0u; }
                __syncthreads();
                for (int i = c.tid; i < nrow_done * 6; i += NTHR) { const LAS unsigned* st = stash + (size_t)i * 4;
                    const unsigned tt = st[0], m = st[1]; const int hf = m >> 24, e = (m >> 16) & 0xff; const unsigned slot = lcnt[hf * 64 + e] + (m & 0xffffu);
                    ROWL[((size_t)hf * 64 + e) * 16384 + slot] = (int)tt; WL[((size_t)hf * 64 + e) * 16384 + slot] = __builtin_bit_cast(float, st[2]);
                    TOKPOS[(size_t)tt * 6 + (i % 6)] = ((unsigned)e << 16) | slot; }
                __syncthreads();
                if (c.tid < 128) lcnt[c.tid] = 0u;
                nrow_done = 0;
            }
        }
        __syncthreads();
    }
}

__device__ __forceinline__ void moe_tables(const Ctx& c, int l, int hf) {
    LAS int* cnt = (LAS int*)(c.lds + 140000); LAS int* off = cnt + 65; LAS int* tst = off + 65;
    __syncthreads();
    if (c.wave == 0) {
        const unsigned* CNT = (const unsigned*)(c.ws + WS_CTL) + CW_CNT + (l * 128 + hf * 64) * CNT_STRIDE;
        const int lane = c.lane, n = (int)CNT[lane * CNT_STRIDE], tl = (n + 255) >> 8;
        int inc = tl;
#pragma unroll
        for (int d = 1; d < 64; d <<= 1) { const int o = __shfl_up(inc, d); if (lane >= d) inc += o; }
        const int ex = inc - tl;
        cnt[lane] = n; off[lane] = ex * 256; tst[lane] = ex;
        if (lane == 63) { cnt[NE] = HALF_T; off[NE] = inc * 256; tst[NE] = inc; tst[NEX] = inc + ((HALF_T + 255) >> 8); }
    }
    __syncthreads();
}
struct MoeSched1 { LAS const int* cnt; LAS const int* off; LAS const int* tst; int G, c; const char* XN2; const char* WGU; const int* ROWL; const float* WL; const int* IDENT; mutable int eh;
    __device__ __forceinline__ bool next(int i, g8::GUnit& u) const {
        const int L = i * G + c; if (L >= 2 * tst[NEX]) return false;
        const int rt = L >> 1, pn = L & 1; int e = eh; while (tst[e + 1] <= rt) ++e; eh = e;
        const int r0 = (rt - tst[e]) * 256;
        u.A = XN2; u.B = WGU + ((size_t)e * 512 + (size_t)pn * 256) * 2048;
        u.rl = e < NE ? ROWL + (size_t)e * 16384 + r0 : IDENT + r0; u.nvalid = cnt[e] - r0; u.erow0 = 0; u.ecol0 = pn * 256; u.x0 = off[e] + r0; u.xp = e < NE ? WL + (size_t)e * 16384 + r0 : nullptr; return true; } };
struct MoeSched2 { LAS const int* cnt; LAS const int* off; LAS const int* tst; int G, c; const char* HID; const char* WD; mutable int eh;
    __device__ __forceinline__ bool next(int i, g8::GUnit& u) const {
        const int L = i * G + c; if (L >= 4 * tst[NEX]) return false;
        const int rt = L >> 2, pn = L & 3; int e = eh; while (tst[e + 1] <= rt) ++e; eh = e;
        const int r0 = (rt - tst[e]) * 256;
        u.A = HID + (size_t)(off[e] + r0) * 512; u.B = WD + ((size_t)e * 1024 + (size_t)pn * 256) * 512;
        u.rl = nullptr; u.nvalid = 0; u.erow0 = 0; u.ecol0 = pn * 256; u.x0 = off[e] + r0; u.xp = nullptr; return true; } };
struct EpiG1u { bf16* HID; struct Pre { float w; }; static constexpr int BATCH_M = 4; static constexpr bool PERM = true;
    __device__ __forceinline__ void post8(const g8::GUnit& u, int row, int col, f32x4 a0, f32x4 a1, f32x4 b0, f32x4 b1, const Pre& p, int) const {
        const int hc = col - 128 * (col >> 8);
        f32x4 v0 = (f32x4){0.f, 0.f, 0.f, 0.f}, v1 = v0;
        if (row < u.nvalid) {
#pragma unroll
            for (int i = 0; i < 4; ++i) { v0[i] = siluf_(a0[i]) * b0[i] * p.w; v1[i] = siluf_(a1[i]) * b1[i] * p.w; } }
        st_bf8(HID + (size_t)(u.x0 + row) * 256 + hc, v0, v1);
    }
    __device__ __forceinline__ Pre pre(const g8::GUnit& u, int row, int, int) const { return Pre{(u.xp && row < u.nvalid) ? u.xp[row] : 1.f}; }
    __device__ __forceinline__ void post(const g8::GUnit& u, int row, int col, f32x4 lo, f32x4 hi, const Pre& p, int) const {
        const int hc = col - 128 * (col >> 8);
        f32x4 v = (f32x4){0.f, 0.f, 0.f, 0.f};
        if (row < u.nvalid) { const float w = p.w;
#pragma unroll
            for (int i = 0; i < 4; ++i) v[i] = siluf_(lo[i]) * hi[i] * w; }
        st_bf4(HID + (size_t)(u.x0 + row) * 256 + hc, v);
    } };
constexpr float Y_SCALE = 16.f, Y_UNSCALE = 1.f / 16.f;
__device__ __forceinline__ unsigned pk4_fp8(f32x4 v) { int w = __builtin_amdgcn_cvt_pk_fp8_f32(v[0] * Y_SCALE, v[1] * Y_SCALE, 0, false); w = __builtin_amdgcn_cvt_pk_fp8_f32(v[2] * Y_SCALE, v[3] * Y_SCALE, w, true); return (unsigned)w; }
__device__ __forceinline__ f32x4 up4_fp8(unsigned q) { return (f32x4){__builtin_amdgcn_cvt_f32_fp8((int)q, 0), __builtin_amdgcn_cvt_f32_fp8((int)q, 1), __builtin_amdgcn_cvt_f32_fp8((int)q, 2), __builtin_amdgcn_cvt_f32_fp8((int)q, 3)}; }
struct EpiG2u { unsigned char* Y; typedef NoPre Pre; static constexpr int BATCH_M = 4; static constexpr bool PERM = true;
    __device__ __forceinline__ Pre pre(const g8::GUnit&, int, int, int) const { return Pre{}; }
    __device__ __forceinline__ void post(const g8::GUnit&, int, int, f32x4, f32x4, const Pre&, int) const {}
    __device__ __forceinline__ void post8(const g8::GUnit& u, int row, int col, f32x4 a0, f32x4 a1, f32x4 b0, f32x4 b1, const Pre&, int) const {
        unsigned char* y = Y + (size_t)(u.x0 + row) * 1024 + col;
        *(u32x2*)y = (u32x2){pk4_fp8(a0), pk4_fp8(a1)}; *(u32x2*)(y + 128) = (u32x2){pk4_fp8(b0), pk4_fp8(b1)};
    } };
__device__ __forceinline__ void phase_gemm1(const Ctx& c, int l, int hf) {
    moe_tables(c, l, hf);
    LAS int* cnt = (LAS int*)(c.lds + 140000); LAS int* off = cnt + 65; LAS int* tst = off + 65;
    const int cx = (c.nblk & 7) == 0 ? (c.bid & 7) * (c.nblk >> 3) + (c.bid >> 3) : c.bid;
    MoeSched1 S{cnt, off, tst, c.nblk, cx, (const char*)(c.ws + WS_XN2), (const char*)(c.ws + WS_WGU), (const int*)(c.ws + WS_ROWL) + (size_t)hf * 64 * 16384, (const float*)(c.ws + WS_WL) + (size_t)hf * 64 * 16384,
                (const int*)(c.ws + WS_IDENT) + (size_t)hf * HALF_T, 0};
    EpiG1u E{(bf16*)(c.ws + WS_HID)};
    g8::gemm_phase<true>(c.lds, 2048u, 1024, S, E);
    __syncthreads();
}
__device__ __forceinline__ void phase_gemm2(const Ctx& c, int l, int hf) {
    moe_tables(c, l, hf);
    LAS int* cnt = (LAS int*)(c.lds + 140000); LAS int* off = cnt + 65; LAS int* tst = off + 65;
    const int cx = (c.nblk & 7) == 0 ? (c.bid & 7) * (c.nblk >> 3) + (c.bid >> 3) : c.bid;
    MoeSched2 S{cnt, off, tst, c.nblk, cx, (const char*)(c.ws + WS_HID), (const char*)(c.ws + WS_WD), 0};
    EpiG2u E{(unsigned char*)(c.ws + WS_Y)};
    g8::gemm_phase<false>(c.lds, 512u, 256, S, E);
    __syncthreads();
}
__device__ __forceinline__ void phase_combine(const Ctx& c, int l, int hf, bf16* xres, float* outf) {
    moe_tables(c, l, hf);
    LAS int* off = (LAS int*)(c.lds + 140000) + 65;
    const int gw = c.bid * NWAVES + c.wave, NGW = c.nblk * NWAVES, lane = c.lane;
    const unsigned char* Y = (const unsigned char*)(c.ws + WS_Y); const unsigned* TOKPOS = (const unsigned*)(c.ws + WS_TOKPOS);
    const float* MODl = (const float*)(c.ws + WS_MOD) + (size_t)l * 16 * 6144;
    const float* MODn = (const float*)(c.ws + WS_MOD) + (size_t)1 * 16 * 6144;
    bf16* XN = (bf16*)(c.ws + WS_XN);
    unsigned tpn[TOPK];
    if (gw < HALF_T) {
#pragma unroll
        for (int kk = 0; kk < TOPK; ++kk) tpn[kk] = TOKPOS[(size_t)(hf * HALF_T + gw) * 6 + kk]; }
#pragma unroll 1
    for (int tt = gw; tt < HALF_T; tt += NGW) {
        const int t = hf * HALF_T + tt, b = t >> 11;
        unsigned tp[TOPK];
#pragma unroll
        for (int kk = 0; kk < TOPK; ++kk) tp[kk] = tpn[kk];
        f32x4 acc[4];
        unsigned yv[TOPK + 1][4];
        { const unsigned char* yr = Y + (size_t)(off[NE] + tt) * 1024;
#pragma unroll
          for (int j = 0; j < 4; ++j) yv[TOPK][j] = __builtin_nontemporal_load((const unsigned*)(yr + 4 * (lane + 64 * j))); }
#pragma unroll
        for (int kk = 0; kk < TOPK; ++kk) {
            const int e = tp[kk] >> 16, slot = tp[kk] & 0xffff;
            const unsigned char* yr = Y + (size_t)(off[e] + slot) * 1024;
#pragma unroll
            for (int j = 0; j < 4; ++j) yv[kk][j] = __builtin_nontemporal_load((const unsigned*)(yr + 4 * (lane + 64 * j)));
        }
        if (tt + NGW < HALF_T) {
#pragma unroll
            for (int kk = 0; kk < TOPK; ++kk) tpn[kk] = TOKPOS[(size_t)(t + NGW) * 6 + kk]; }
#pragma unroll
        for (int j = 0; j < 4; ++j) { acc[j] = up4_fp8(yv[TOPK][j]);
#pragma unroll
            for (int kk = 0; kk < TOPK; ++kk) acc[j] += up4_fp8(yv[kk][j]);
            acc[j] *= Y_UNSCALE; }
        bf16* xr = xres + (size_t)t * D; const float* g2 = MODl + (size_t)b * 6144 + 5120;
        f32x4 v[4]; float s = 0.f;
#pragma unroll
        for (int j = 0; j < 4; ++j) { const int cc = 4 * (lane + 64 * j); v[j] = ld_bf4(xr + cc) + *(const f32x4*)(g2 + cc) * acc[j]; s += v[j][0] * v[j][0] + v[j][1] * v[j][1] + v[j][2] * v[j][2] + v[j][3] * v[j][3]; }
        const float rstd = rsqrtf(wave_sum(s) * (1.f / D) + EPS);
        if (l == 0) {
#pragma unroll
            for (int j = 0; j < 4; ++j) { const int cc = 4 * (lane + 64 * j); st_bf4(xr + cc, v[j]);
                const f32x4 g = *(const f32x4*)(c.in[IN_NMIX] + D + cc), a = *(const f32x4*)(MODn + (size_t)b * 6144 + 1024 + cc), bb = *(const f32x4*)(MODn + (size_t)b * 6144 + cc);
                st_bf4(XN + (size_t)t * D + cc, v[j] * rstd * g * (a + 1.f) + bb); }
        } else {
#pragma unroll
            for (int j = 0; j < 4; ++j) { const int cc = 4 * (lane + 64 * j); __builtin_nontemporal_store(v[j] * rstd * *(const f32x4*)(c.in[IN_NFIN] + cc), (f32x4*)(outf + (size_t)t * D + cc)); }
        }
    }
}

#ifdef DSA_NO_SEL
#define DSA_SEL_CALL
#else
#define DSA_SEL_CALL phase_ckvt(c); for (int r2 = 0; r2 < REPN(20); ++r2) phase_dsa_sel(c, l);
#endif
#ifdef DSA_NO_ATT
#define DSA_ATT_CALL
#else
#define DSA_ATT_CALL for (int r2 = 0; r2 < REPN(21); ++r2) phase_dsa_att(c, l);
#endif
constexpr int PH_PER_L = 18, N_PHASES = 1 + NL * PH_PER_L;
#ifndef PH_MASK
#define PH_MASK 0xFFFFFFFFu
#endif
#define IN(k) (lo <= (k) && (k) < hi)
#define EN(b) ((PH_MASK >> (b)) & 1u)
#ifndef REP_MASK
#define REP_MASK 0u
#endif
#define REPN(b) (((REP_MASK >> (b)) & 1u) ? 2 : 1)
#define SEAM(k) do { if (MK_ONE_LAUNCH && IN(k) && IN((k) + 1)) xcd_barrier(bar); } while (0)
template <int l>
__device__ __forceinline__ void layer_program(const Ctx& c, const XcdBarrier& bar, int lo, int hi) {
        const int P = 1 + l * PH_PER_L;
        const float* xin = l == 0 ? c.in[IN_X] : c.out;
        bf16* PB = (bf16*)(c.ws + WS_PB); float* SM = (float*)(c.ws + WS_SM);
        const bf16* XN = (const bf16*)(c.ws + WS_XN);
        const bf16* WIN = (const bf16*)(c.ws + WS_WIN) + (size_t)l * NINP * 1024;
        if (EN(1) && IN(P + 0)) { for (int rep = 0; rep < REPN(1); ++rep) {  if (l == 0) phase_norm1(c, 0, c.in[IN_X]);  if (rep + 1 < REPN(1)) xcd_barrier(bar); } } if (l == 0) SEAM(P + 0);
        if (EN(2) && IN(P + 1)) { for (int rep = 0; rep < REPN(2); ++rep) {  EpiInPB E{PB, SM}; dgemm_phase(c, XN, 1024, T, WIN, NPB / 256, 1024, EpiU<decltype(E)>{E});  if (rep + 1 < REPN(2)) xcd_barrier(bar); } } SEAM(P + 1);
        if (EN(4) && IN(P + 3)) { for (int rep = 0; rep < REPN(4); ++rep) {
#if SCAN_3PASS
            phase_prep(c, l);
            for (int r2 = 0; r2 < REPN(22); ++r2) phase_scanA(c, l);
            xcd_barrier(bar); scanB(c);
            { EpiQ Eq{(bf16*)(c.ws + WS_QLAT), (bf16*)(c.ws + WS_QIDX), (const float*)(c.ws + WS_RSTDQ)};
              dgemm_phase(c, PB + PB_CQ, NPB, T, (const bf16*)(c.ws + WS_WQ) + (size_t)l * 1280 * 256, 5, 256, EpiU<decltype(Eq)>{Eq}); }
            xcd_barrier(bar); phase_scanC(c, l);
#else
            phase_scans(c, l);
#endif
            if (rep + 1 < REPN(4)) xcd_barrier(bar); } } SEAM(P + 3);
        if (EN(6) && IN(P + 5)) { for (int rep = 0; rep < REPN(6); ++rep) {  EpiGate E{(unsigned char*)(c.ws + WS_G)}; dgemm_phase(c, XN, 1024, T, WIN + (size_t)NPB * 1024, NG / 256, 1024, EpiU<decltype(E)>{E});  if (rep + 1 < REPN(6)) xcd_barrier(bar); } }
        if (EN(7) && IN(P + 6)) { for (int rep = 0; rep < REPN(7); ++rep) {  DSA_SEL_CALL xcd_barrier(bar); DSA_ATT_CALL  if (rep + 1 < REPN(7)) xcd_barrier(bar); } } SEAM(P + 6);
        if (EN(8) && IN(P + 7)) {
            { EpiUp E{(bf16*)(c.ws + WS_M1), (bf16*)(c.ws + WS_MF), (const unsigned char*)(c.ws + WS_G), 0, 1, 0};
              dgemm_phase(c, (const bf16*)(c.ws + WS_UA), 512, T, (const bf16*)(c.ws + WS_WUPA) + (size_t)l * 1024 * 512, 4, 512, EpiU<decltype(E)>{E}); }
            { EpiUp E{(bf16*)(c.ws + WS_M1), (bf16*)(c.ws + WS_MF), (const unsigned char*)(c.ws + WS_G), 1, 0, 0};
              dgemm_phase(c, (const bf16*)(c.ws + WS_OLAT), 512, T, (const bf16*)(c.ws + WS_WUPB) + (size_t)l * 1024 * 512, 4, 512, EpiU<decltype(E)>{E}); }
            { EpiUp E{(bf16*)(c.ws + WS_M1), (bf16*)(c.ws + WS_MF), (const unsigned char*)(c.ws + WS_G), 2, 0, 1};
              dgemm_phase(c, (const bf16*)(c.ws + WS_UC), 512, T, (const bf16*)(c.ws + WS_WUPC) + (size_t)l * 1024 * 512, 4, 512, EpiU<decltype(E)>{E}); }
        } SEAM(P + 9);
        if (EN(11) && IN(P + 10)) {
            if (l == 0) { EpiWoT<true> E{(const void*)c.in[IN_X], (bf16*)c.out, (const float*)(c.ws + WS_MOD) + (size_t)l * 16 * 6144 + 2048};
                dgemm_phase(c, (const bf16*)(c.ws + WS_M1), 1024, T, (const bf16*)(c.ws + WS_WO) + (size_t)l * 1024 * 1024, 4, 1024, EpiU<decltype(E)>{E}); }
            else { EpiWoT<false> E{(const void*)c.out, (bf16*)(c.ws + WS_XN), (const float*)(c.ws + WS_MOD) + (size_t)l * 16 * 6144 + 2048};
                dgemm_phase(c, (const bf16*)(c.ws + WS_M1), 1024, T, (const bf16*)(c.ws + WS_WO) + (size_t)l * 1024 * 1024, 4, 1024, EpiU<decltype(E)>{E}); }
        } SEAM(P + 10);
        if (EN(12) && IN(P + 11)) { for (int rep = 0; rep < REPN(12); ++rep) {  phase_route(c, l, l == 0 ? (const bf16*)c.out : (const bf16*)(c.ws + WS_XN));  if (rep + 1 < REPN(12)) xcd_barrier(bar); } } SEAM(P + 11);
        if (EN(13) && IN(P + 12)) { for (int rep = 0; rep < REPN(13); ++rep) {  phase_gemm1(c, l, 0);  if (rep + 1 < REPN(13)) xcd_barrier(bar); } } SEAM(P + 12);
        if (EN(14) && IN(P + 13)) { for (int rep = 0; rep < REPN(14); ++rep) {  phase_gemm2(c, l, 0);  if (rep + 1 < REPN(14)) xcd_barrier(bar); } } SEAM(P + 13);
        if (EN(15) && IN(P + 14)) { phase_combine(c, l, 0, l == 0 ? (bf16*)c.out : (bf16*)(c.ws + WS_XN), c.out); phase_gemm1(c, l, 1); } SEAM(P + 14);
        if (EN(17) && IN(P + 16)) { for (int rep = 0; rep < REPN(17); ++rep) {  phase_gemm2(c, l, 1);  if (rep + 1 < REPN(17)) xcd_barrier(bar); } } SEAM(P + 16);
        if (EN(18) && IN(P + 17)) { for (int rep = 0; rep < REPN(18); ++rep) {  phase_combine(c, l, 1, l == 0 ? (bf16*)c.out : (bf16*)(c.ws + WS_XN), c.out);  if (rep + 1 < REPN(18)) xcd_barrier(bar); } } if (l == 0 || PROBE_SEAM >= 0) SEAM(P + 17);
    }
__global__ void __launch_bounds__(NTHR, 2) fwd(Args args) {
    extern __shared__ __attribute__((aligned(16))) unsigned char lds_raw[];
    Ctx c;
    c.lds = (LAS unsigned char*)lds_raw;
    c.tid = threadIdx.x; c.lane = c.tid & 63; c.wave = __builtin_amdgcn_readfirstlane(c.tid >> 6);
    c.bid = blockIdx.x; c.nblk = gridDim.x;
    c.in = args.in; c.out = args.out; c.ws = args.ws;
    for (int u = c.tid; u < (LDS_BYTES - LDS_MISC) / 4; u += NTHR) ((LAS unsigned*)(c.lds + LDS_MISC))[u] = 0u;
    __syncthreads();
    XcdBarrier bar; bar.bar = (unsigned*)(c.ws + WS_CTL) + CW_BAR; bar.x = 0; bar.st = (volatile LAS unsigned*)(c.lds + LDS_MISC);
    if (MK_ONE_LAUNCH) bar = xcd_barrier_post((unsigned*)(c.ws + WS_CTL) + CW_BAR, (volatile LAS unsigned*)(c.lds + LDS_MISC));
    const int lo = args.ph_lo, hi = args.ph_hi;
#if PROBE_SEAM >= 0
    const unsigned long long t_start = wall_clock64();
#endif
    if (EN(0) && IN(0)) { for (int rep = 0; rep < REPN(0); ++rep) { phase_prologue(c); if (rep + 1 < REPN(0)) xcd_barrier(bar); } } SEAM(0);
    layer_program<0>(c, bar, lo, hi);
    layer_program<1>(c, bar, lo, hi);
#if PROBE_SEAM >= 0
    if (blockIdx.x == 0 && threadIdx.x == 0) {
        const unsigned long long* st = (const unsigned long long*)(bar.bar + 8192);
        const unsigned long long t = (PROBE_SEAM >= 1000 ? wall_clock64() : st[PROBE_SEAM]) - t_start, t0 = wall_clock64();
        while (wall_clock64() - t0 < 7ull * t) __builtin_amdgcn_s_sleep(8);
    }
#endif
#undef IN
#undef SEAM
}

extern "C" void kernel_launch(void* const* d_in, const int* in_sizes, int n_in, void* d_out, int out_size, void* d_ws, size_t ws_size, hipStream_t stream) {
    static int grid = 0;
    if (grid == 0) {
        if (n_in != 33 || out_size != T * D || ws_size < WS_END) { fprintf(stderr, "kernel_launch: unexpected problem (n_in %d out %d ws %zu)\n", n_in, out_size, ws_size); grid = -1; return; }
        int dev = 0, cus = 0, per_cu = 0;
        if (hipGetDevice(&dev) != hipSuccess || hipDeviceGetAttribute(&cus, hipDeviceAttributeMultiprocessorCount, dev) != hipSuccess) { grid = -1; return; }
        if (hipFuncSetAttribute((const void*)fwd, hipFuncAttributeMaxDynamicSharedMemorySize, LDS_BYTES) != hipSuccess) { fprintf(stderr, "kernel_launch: hipFuncSetAttribute failed\n"); grid = -1; return; }
        if (hipOccupancyMaxActiveBlocksPerMultiprocessor(&per_cu, (const void*)fwd, NTHR, LDS_BYTES) != hipSuccess || per_cu < 1) { fprintf(stderr, "kernel_launch: occupancy query says %d\n", per_cu); }
        (void)hipGetLastError();
        grid = cus;
    }
    if (grid < 0) return;
    (void)hipMemsetAsync((char*)d_ws + WS_CTL, 0, CTL_BYTES, stream);
    Args a{};
    for (int i = 0; i < 33; ++i) a.in[i] = (const float*)d_in[i];
    a.out = (float*)d_out; a.ws = (unsigned char*)d_ws;
#if MK_ONE_LAUNCH
    a.ph_lo = 0; a.ph_hi = N_PHASES;
    hipLaunchKernelGGL(fwd, dim3(grid), dim3(NTHR), LDS_BYTES, stream, a);
#else
    for (int p = 0; p < N_PHASES; ++p) {
        if (p == 1 + PH_PER_L) continue;
        a.ph_lo = p; a.ph_hi = p + 1;
        hipLaunchKernelGGL(fwd, dim3(grid), dim3(NTHR), LDS_BYTES, stream, a);
    }
#endif
}
```
